# Optimizing an MI355X kernel written in HIP

```python
import math
import jax, jax.numpy as jnp
from jax import lax
import numpy as np

D_MODEL = 1024
BATCH = 4
SEQ = 8192
DEPTH = 4

GRID_W = 64
CTX_LEN = 256
N_EVEN = (DEPTH + 1) // 2
N_ODD = DEPTH // 2

NA_HEADS = 8
NA_HEAD_DIM = 64
NA_W = NA_HEADS * NA_HEAD_DIM
NA_WIN_R = 8
NA_WIN_C = 16
NA_ROW_BLOCK = 2
RW_HEADS = 8
RW_HEAD_DIM = 64
RW_W = RW_HEADS * RW_HEAD_DIM
RW_DECAY_LORA = 64
RW_AAA_LORA = 64
RW_GATE_LORA = 128
RW_IN = 3 * RW_W + RW_DECAY_LORA + RW_AAA_LORA + RW_GATE_LORA
RW_SPLITS = (RW_W, 2 * RW_W, 3 * RW_W, 3 * RW_W + RW_DECAY_LORA, 3 * RW_W + RW_DECAY_LORA + RW_AAA_LORA)
RW_GN_EPS = 64e-5
SHIFT_WIDTH = 3
EVEN_IN = 3 * NA_W + RW_IN
EVEN_OUT = NA_W + RW_W
DA_HEADS = 8
DA_HEAD_DIM = 64
DA_QK = DA_HEADS * 2 * DA_HEAD_DIM
DA_V = DA_HEADS * 2 * DA_HEAD_DIM
ODD_IN = 2 * DA_QK + DA_V
Q_BLOCK = 128
ROPE_THETA = 10000.0
N_EXPERTS = 16
N_GROUPS = 4
EXP_PER_GROUP = N_EXPERTS // N_GROUPS
TOP_K = 2
D_EXPERT = 512
ALPHA = (2 * DEPTH) ** 0.25
BETA = (8 * DEPTH) ** -0.25
LN_EPS = 1e-5
F32 = jnp.float32

kernel_name = "hybrid_na_rwkv7_diffattn_grouped_moe_dit"


def _layer_norm(x, g, b):
    xf = x.astype(F32)
    mu = xf.mean(-1, keepdims=True)
    var = jnp.square(xf - mu).mean(-1, keepdims=True)
    return ((xf - mu) * lax.rsqrt(var + LN_EPS) * g + b).astype(x.dtype)


def _ada(cvec, w, b):
    return jnp.split(jax.nn.silu(cvec) @ w + b, 6, axis=-1)


def _modulate(h, shift, scale):
    return h * (1.0 + scale[:, None, :]) + shift[:, None, :]


def _axial_rope(z, pos_r, pos_c):
    half = z.shape[-1] // 2
    nf = half // 2
    inv = ROPE_THETA ** (-jnp.arange(nf, dtype=F32) / nf)

    def rot(za, pos):
        ang = pos.astype(F32)[:, None] * inv
        cos = jnp.cos(ang)[None, :, None, :]
        sin = jnp.sin(ang)[None, :, None, :]
        z1, z2 = za[..., :nf].astype(F32), za[..., nf:].astype(F32)
        return jnp.concatenate([z1 * cos - z2 * sin, z1 * sin + z2 * cos], -1)

    return jnp.concatenate([rot(z[..., :half], pos_r), rot(z[..., half:], pos_c)], -1).astype(z.dtype)


def _short_conv(z, w):
    pad = SHIFT_WIDTH // 2
    n = z.shape[1]
    zp = jnp.pad(z, ((0, 0), (pad, pad), (0, 0)))
    return sum(zp[:, j:j + n] * w[j] for j in range(SHIFT_WIDTH))


def _context_attention(q, k, v):
    B, L, H, Dh = q.shape
    s = jnp.einsum('bqhd,bkhd->bhqk', q, k).astype(F32) * Dh ** -0.5
    p = jax.nn.softmax(s, -1).astype(v.dtype)
    return jnp.einsum('bhqk,bkhd->bqhd', p, v).reshape(B, L, H * Dh)


def _na_attention(q, k, v, kc, vc, rpb):
    B, T, H, Dh = q.shape
    rows = T // GRID_W
    wr = min(NA_WIN_R, rows)
    r = np.arange(rows)
    row_idx = np.clip(r - wr // 2, 0, rows - wr)[:, None] + np.arange(wr)[None]
    c = np.arange(GRID_W)
    col_idx = np.clip(c - NA_WIN_C // 2, 0, GRID_W - NA_WIN_C)[:, None] + np.arange(NA_WIN_C)[None]
    d_row = row_idx - r[:, None] + (NA_WIN_R - 1)
    d_col = jnp.asarray(col_idx - c[:, None] + (NA_WIN_C - 1), jnp.int32)
    col_idx = jnp.asarray(col_idx, jnp.int32)
    n_blk = rows // NA_ROW_BLOCK
    row_idx_b = jnp.asarray(row_idx.reshape(n_blk, NA_ROW_BLOCK, wr), jnp.int32)
    d_row_b = jnp.asarray(d_row.reshape(n_blk, NA_ROW_BLOCK, wr), jnp.int32)
    qg = (q * Dh ** -0.5).reshape(B, rows, GRID_W, H, Dh)
    kg = k.reshape(B, rows, GRID_W, H, Dh)
    vg = v.reshape(B, rows, GRID_W, H, Dh)
    q_b = jnp.moveaxis(qg.reshape(B, n_blk, NA_ROW_BLOCK, GRID_W, H, Dh), 1, 0)
    n_loc = wr * NA_WIN_C

    def block(args):
        qb, ridx, dri = args
        kw = kg[:, ridx][:, :, :, col_idx]
        vw = vg[:, ridx][:, :, :, col_idx]
        bias = rpb[:, dri[:, :, None, None], d_col[None, None]]
        s_loc = jnp.einsum('bqchd,bqrcjhd->bhqcrj', qb, kw).astype(F32) + jnp.swapaxes(bias, 2, 3).astype(F32)
        s_ctx = jnp.einsum('bqchd,blhd->bhqcl', qb, kc).astype(F32)
        s = jnp.concatenate([s_loc.reshape(B, H, NA_ROW_BLOCK, GRID_W, n_loc), s_ctx], -1)
        p = jax.nn.softmax(s, -1).astype(v.dtype)
        p_loc = p[..., :n_loc].reshape(B, H, NA_ROW_BLOCK, GRID_W, wr, NA_WIN_C)
        return (jnp.einsum('bhqcrj,bqrcjhd->bqchd', p_loc, vw)
                + jnp.einsum('bhqcl,blhd->bqchd', p[..., n_loc:], vc))

    o = lax.map(block, (q_b, row_idx_b, d_row_b))
    return jnp.moveaxis(o, 0, 1).reshape(B, T, H * Dh)


def _rw_heads(z):
    return z.reshape(*z.shape[:-1], RW_HEADS, RW_HEAD_DIM)


def _rw_direction(p, w0, w_up, a0, a_up, k_k, k_a, r_k):
    r, k, v, xw, xa, _ = jnp.split(p.astype(F32), RW_SPLITS, axis=-1)
    decay = jnp.exp(-jnp.exp(-jax.nn.softplus(-(w0 + jnp.tanh(xw) @ w_up)) - 0.5))
    a = jax.nn.sigmoid(a0 + xa @ a_up)
    kk = _rw_heads(k * k_k)
    kk = kk / jnp.maximum(jnp.sqrt(jnp.sum(kk * kk, -1, keepdims=True)), 1e-12)
    k_eff = _rw_heads(k * (1.0 + (a - 1.0) * k_a))
    r, v, a = _rw_heads(r), _rw_heads(v), _rw_heads(a)
    bonus = jnp.sum(r * k_eff * r_k, -1, keepdims=True) * v
    return (r, _rw_heads(decay), k_eff, v, -kk, kk * a), bonus


def _rw_step(S, inp):
    r_t, w_t, k_t, v_t, a_t, b_t = inp
    sa = jnp.einsum('bhij,bhj->bhi', S, a_t)
    S = S * w_t[:, :, None, :] + sa[..., None] * b_t[:, :, None, :] + v_t[..., None] * k_t[:, :, None, :]
    return S, jnp.einsum('bhij,bhj->bhi', S, r_t)


def _rw_scan(S0, seq_inputs, reverse):
    xs = tuple(jnp.moveaxis(z, 1, 0) for z in seq_inputs)
    S, ys = lax.scan(_rw_step, S0, xs, reverse=reverse)
    return S, jnp.moveaxis(ys, 0, 1)


def _rwkv7_bidir(p_lat, p_ctx, w0, w_up, a0, a_up, g_up, k_k, k_a, r_k, gn_g, gn_b):
    B = p_lat.shape[0]
    S0 = jnp.zeros((B, RW_HEADS, RW_HEAD_DIM, RW_HEAD_DIM), F32)
    ys_lat, ys_ctx, bon_lat, bon_ctx = [], [], [], []
    for d, reverse in enumerate((False, True)):
        in_ctx, b_ctx = _rw_direction(p_ctx, w0[d], w_up[d], a0[d], a_up[d], k_k, k_a, r_k)
        in_lat, b_lat = _rw_direction(p_lat, w0[d], w_up[d], a0[d], a_up[d], k_k, k_a, r_k)
        S_ctx, y_c = _rw_scan(S0, in_ctx, reverse)
        _, y_l = _rw_scan(S_ctx, in_lat, reverse)
        ys_ctx.append(y_c); ys_lat.append(y_l); bon_ctx.append(b_ctx); bon_lat.append(b_lat)

    def finish(y, bonus, p):
        g = jax.nn.sigmoid(p[..., RW_SPLITS[-1]:].astype(F32)) @ g_up
        mu = y.mean(-1, keepdims=True)
        var = jnp.square(y - mu).mean(-1, keepdims=True)
        yn = ((y - mu) * lax.rsqrt(var + RW_GN_EPS)).reshape(*y.shape[:-2], RW_W) * gn_g + gn_b
        return ((yn + bonus.reshape(*bonus.shape[:-2], RW_W)) * g).astype(p.dtype)

    return (finish(ys_lat[0] + ys_lat[1], bon_lat[0] + bon_lat[1], p_lat),
            finish(ys_ctx[0] + ys_ctx[1], bon_ctx[0] + bon_ctx[1], p_ctx))


def _even_mixer(u_lat, u_ctx, w_in, w_out, conv_w, rpb, w0, w_up, a0, a_up, g_up, k_k, k_a, r_k, gn_g, gn_b):
    B, T, _ = u_lat.shape
    L = u_ctx.shape[1]
    p_lat = u_lat @ w_in
    p_ctx = u_ctx @ w_in

    def na_qkv(p, n):
        q, k, v = jnp.split(p[..., :3 * NA_W], 3, axis=-1)
        sh = (B, n, NA_HEADS, NA_HEAD_DIM)
        return q.reshape(sh), k.reshape(sh), v.reshape(sh)

    q, k, v = na_qkv(p_lat, T)
    qc, kc, vc = na_qkv(p_ctx, L)
    o_na_lat = _na_attention(q, k, v, kc, vc, rpb)
    o_na_ctx = _context_attention(qc, kc, vc)
    o_rw_lat, o_rw_ctx = _rwkv7_bidir(_short_conv(p_lat[..., 3 * NA_W:], conv_w),
                                      _short_conv(p_ctx[..., 3 * NA_W:], conv_w),
                                      w0, w_up, a0, a_up, g_up, k_k, k_a, r_k, gn_g, gn_b)
    y_lat = jnp.concatenate([o_na_lat, o_rw_lat], -1) @ w_out
    y_ctx = jnp.concatenate([o_na_ctx, o_rw_ctx], -1) @ w_out
    return y_lat, y_ctx


def _diff_mix(q, k, v, lam):
    s = jnp.einsum('bqhmd,bkhmd->bhmqk', q, k).astype(F32) * DA_HEAD_DIM ** -0.5
    p = jax.nn.softmax(s, -1)
    a = p[:, :, 0] - lam * p[:, :, 1]
    return jnp.einsum('bhqk,bkhe->bqhe', a.astype(v.dtype), v)


def _diff_attention_blocks(q, k, v, lam):
    B, T = q.shape[:2]
    nb = T // Q_BLOCK
    qb = jnp.moveaxis(q.reshape(B, nb, Q_BLOCK, *q.shape[2:]), 1, 0)
    o = lax.map(lambda blk: _diff_mix(blk, k, v, lam), qb)
    return jnp.moveaxis(o, 0, 1).reshape(B, T, *o.shape[3:])


def _odd_mixer(u_lat, u_ctx, w_in, w_out, lq1, lk1, lq2, lk2, subln_g, lambda_init, pos_r, pos_c, with_ctx_out):
    B, T, _ = u_lat.shape
    L = u_ctx.shape[1]
    lam = (jnp.exp(jnp.sum(lq1.astype(F32) * lk1.astype(F32)))
           - jnp.exp(jnp.sum(lq2.astype(F32) * lk2.astype(F32))) + lambda_init)

    def qkv(u, n):
        p = u @ w_in
        q = p[..., :DA_QK].reshape(B, n, DA_HEADS, 2, DA_HEAD_DIM)
        k = p[..., DA_QK:2 * DA_QK].reshape(B, n, DA_HEADS, 2, DA_HEAD_DIM)
        v = p[..., 2 * DA_QK:].reshape(B, n, DA_HEADS, 2 * DA_HEAD_DIM)
        return q, k, v

    def rot(z):
        return _axial_rope(z.reshape(B, T, 2 * DA_HEADS, DA_HEAD_DIM), pos_r, pos_c).reshape(z.shape)

    def head_norm(o):
        of = o.astype(F32)
        of = of * lax.rsqrt(jnp.mean(of * of, -1, keepdims=True) + 1e-5) * subln_g * (1.0 - lambda_init)
        return of.astype(o.dtype)

    q, k, v = qkv(u_lat, T)
    qc, kc, vc = qkv(u_ctx, L)
    q, k = rot(q), rot(k)
    k_all = jnp.concatenate([k, kc], axis=1)
    v_all = jnp.concatenate([v, vc], axis=1)
    y_lat = head_norm(_diff_attention_blocks(q, k_all, v_all, lam)).reshape(B, T, DA_V) @ w_out
    y_ctx = head_norm(_diff_mix(qc, kc, vc, lam)).reshape(B, L, DA_V) @ w_out if with_ctx_out else None
    return y_lat, y_ctx


def _moe(h, router_w, router_b, w_gate, w_up, w_down):
    s = jax.nn.sigmoid((h @ router_w).astype(F32))
    sel = (s + router_b.astype(F32)).reshape(-1, N_GROUPS, EXP_PER_GROUP)
    grp = jnp.argmax(lax.top_k(sel, TOP_K)[0].sum(-1), axis=-1)
    in_grp = jnp.take_along_axis(sel, grp[:, None, None], axis=1)[:, 0]
    _, idx = lax.top_k(in_grp, TOP_K)
    eid = grp[:, None] * EXP_PER_GROUP + idx
    gate = jnp.take_along_axis(s, eid, axis=-1)
    gate = gate / gate.sum(-1, keepdims=True)
    combine = jnp.einsum('nk,nke->ne', gate, jax.nn.one_hot(eid, N_EXPERTS, dtype=F32)).astype(h.dtype)
    out = jnp.zeros_like(h)
    for e in range(N_EXPERTS):
        he = jax.nn.silu(h @ w_gate[e]) * (h @ w_up[e])
        out = out + combine[:, e:e + 1] * (he @ w_down[e])
    return out


def setup_inputs(seed: int = 0) -> dict:
    key = jax.random.key(seed)
    keys = jax.random.split(key, 40)
    counter = iter(range(40))

    def nk():
        return keys[next(counter)]

    def nrm(shape, std):
        return jax.random.normal(nk(), shape, F32) * std

    D = D_MODEL
    even_scale = np.ones((EVEN_IN,), np.float32)
    even_scale[2 * NA_W:3 * NA_W] = BETA
    even_scale[3 * NA_W + 2 * RW_W:3 * NA_W + 3 * RW_W] = BETA
    odd_scale = np.ones((ODD_IN,), np.float32)
    odd_scale[2 * DA_QK:] = BETA
    return {
        "x": nrm((BATCH, SEQ, D), 1.0),
        "c": nrm((BATCH, D), 1.0),
        "ctx": nrm((BATCH, CTX_LEN, D), 1.0),
        "c_ctx": nrm((D,), 1.0),
        "ada_w": nrm((DEPTH, D, 6 * D), 0.5 * D ** -0.5),
        "ada_b": nrm((DEPTH, 6 * D), 0.02),
        "ln_g": 1.0 + nrm((DEPTH, 2, D), 0.02),
        "ln_b": nrm((DEPTH, 2, D), 0.02),
        "even_w_in": nrm((N_EVEN, D, EVEN_IN), D ** -0.5) * jnp.asarray(even_scale),
        "even_w_out": nrm((N_EVEN, EVEN_OUT, D), BETA * EVEN_OUT ** -0.5),
        "shift_w": jnp.array([0.3, 1.0, 0.3], F32)[None, :, None] + nrm((N_EVEN, SHIFT_WIDTH, RW_IN), 0.1),
        "na_rpb": nrm((N_EVEN, NA_HEADS, 2 * NA_WIN_R - 1, 2 * NA_WIN_C - 1), 0.1),
        "rw_w0": jax.random.uniform(nk(), (N_EVEN, 2, RW_W), F32, minval=-4.0, maxval=1.0),
        "rw_w_up": nrm((N_EVEN, 2, RW_DECAY_LORA, RW_W), 0.1 * RW_DECAY_LORA ** -0.5),
        "rw_a0": nrm((N_EVEN, 2, RW_W), 0.1),
        "rw_a_up": nrm((N_EVEN, 2, RW_AAA_LORA, RW_W), 0.5 * RW_AAA_LORA ** -0.5),
        "rw_g_up": nrm((N_EVEN, RW_GATE_LORA, RW_W), RW_GATE_LORA ** -0.5),
        "rw_k_k": 0.85 + nrm((N_EVEN, RW_W), 0.05),
        "rw_k_a": 1.0 + nrm((N_EVEN, RW_W), 0.05),
        "rw_r_k": nrm((N_EVEN, RW_HEADS, RW_HEAD_DIM), 0.1),
        "rw_gn_g": 1.0 + nrm((N_EVEN, RW_W), 0.02),
        "rw_gn_b": nrm((N_EVEN, RW_W), 0.02),
        "odd_w_in": nrm((N_ODD, D, ODD_IN), D ** -0.5) * jnp.asarray(odd_scale),
        "odd_w_out": nrm((N_ODD, DA_V, D), BETA * DA_V ** -0.5),
        "da_lq1": nrm((N_ODD, DA_HEAD_DIM), 0.1),
        "da_lk1": nrm((N_ODD, DA_HEAD_DIM), 0.1),
        "da_lq2": nrm((N_ODD, DA_HEAD_DIM), 0.1),
        "da_lk2": nrm((N_ODD, DA_HEAD_DIM), 0.1),
        "da_subln_g": 1.0 + nrm((N_ODD, 2 * DA_HEAD_DIM), 0.02),
        "router_w": nrm((D, N_EXPERTS), D ** -0.5),
        "router_b": nrm((N_EXPERTS,), 0.01),
        "exp_w_gate": nrm((DEPTH, N_EXPERTS, D, D_EXPERT), D ** -0.5),
        "exp_w_up": nrm((DEPTH, N_EXPERTS, D, D_EXPERT), D ** -0.5),
        "exp_w_down": nrm((DEPTH, N_EXPERTS, D_EXPERT, D), BETA * D_EXPERT ** -0.5),
    }


def reference(x, c, ctx, c_ctx, ada_w, ada_b, ln_g, ln_b, even_w_in, even_w_out, shift_w, na_rpb,
              rw_w0, rw_w_up, rw_a0, rw_a_up, rw_g_up, rw_k_k, rw_k_a, rw_r_k, rw_gn_g, rw_gn_b,
              odd_w_in, odd_w_out, da_lq1, da_lk1, da_lq2, da_lk2, da_subln_g,
              router_w, router_b, exp_w_gate, exp_w_up, exp_w_down):
    B, T, D = x.shape
    t = jnp.arange(T)
    pos_r, pos_c = t // GRID_W, t % GRID_W
    h_lat, h_ctx = x, ctx
    for l in range(DEPTH):
        last = l == DEPTH - 1
        m_lat = _ada(c, ada_w[l], ada_b[l])
        m_ctx = _ada(c_ctx[None], ada_w[l], ada_b[l])
        u_lat = _modulate(h_lat, m_lat[0], m_lat[1])
        u_ctx = _modulate(h_ctx, m_ctx[0], m_ctx[1])
        if l % 2 == 0:
            i = l // 2
            y_lat, y_ctx = _even_mixer(u_lat, u_ctx, even_w_in[i], even_w_out[i], shift_w[i], na_rpb[i],
                                       rw_w0[i], rw_w_up[i], rw_a0[i], rw_a_up[i], rw_g_up[i],
                                       rw_k_k[i], rw_k_a[i], rw_r_k[i], rw_gn_g[i], rw_gn_b[i])
        else:
            i = l // 2
            lambda_init = 0.8 - 0.6 * math.exp(-0.3 * l)
            y_lat, y_ctx = _odd_mixer(u_lat, u_ctx, odd_w_in[i], odd_w_out[i], da_lq1[i], da_lk1[i],
                                      da_lq2[i], da_lk2[i], da_subln_g[i], lambda_init, pos_r, pos_c,
                                      not last)
        h_lat = _layer_norm(ALPHA * h_lat + m_lat[2][:, None, :] * y_lat, ln_g[l, 0], ln_b[l, 0])
        u_lat = _modulate(h_lat, m_lat[3], m_lat[4])
        if last:
            f_lat = _moe(u_lat.reshape(-1, D), router_w, router_b,
                         exp_w_gate[l], exp_w_up[l], exp_w_down[l]).reshape(B, T, D)
        else:
            h_ctx = _layer_norm(ALPHA * h_ctx + m_ctx[2][:, None, :] * y_ctx, ln_g[l, 0], ln_b[l, 0])
            u_ctx = _modulate(h_ctx, m_ctx[3], m_ctx[4])
            L = u_ctx.shape[1]
            f = _moe(jnp.concatenate([u_lat.reshape(-1, D), u_ctx.reshape(-1, D)], 0), router_w, router_b,
                     exp_w_gate[l], exp_w_up[l], exp_w_down[l])
            f_lat = f[:B * T].reshape(B, T, D)
            h_ctx = _layer_norm(ALPHA * h_ctx + m_ctx[5][:, None, :] * f[B * T:].reshape(B, L, D),
                                ln_g[l, 1], ln_b[l, 1])
        h_lat = _layer_norm(ALPHA * h_lat + m_lat[5][:, None, :] * f_lat, ln_g[l, 1], ln_b[l, 1])
    return h_lat
```

```cpp
#include <hip/hip_runtime.h>
#include <stdint.h>

namespace nv {
constexpr int B = 4, T = 8192, L = 256, D = 1024, NLAT = B * T, NCTX = B * L, NTOK = NLAT + NCTX;
constexpr int DEPTH = 4;
constexpr int EVEN_IN = 3328, ODD_IN = 3072, RW_OFF = 1536, RW_IN = 1792;
constexpr int NE = 16, DE = 512;
constexpr int MOE_ROWS = 2 * NTOK + 1024;
constexpr float ALPHA = 1.681792830507429f;
constexpr float LN_EPS = 1e-5f;

constexpr size_t OFF_MOD = 0;
constexpr size_t OFF_HCTX = OFF_MOD + (size_t)4 * 5 * 6144 * 4;
constexpr size_t OFF_EID = OFF_HCTX + (size_t)NCTX * D * 4;
constexpr size_t OFF_GATE = OFF_EID + (size_t)NTOK * 2 * 4;
constexpr size_t OFF_POS = OFF_GATE + (size_t)NTOK * 2 * 4;
constexpr size_t OFF_CNT = OFF_POS + (size_t)NTOK * 2 * 4;
constexpr size_t OFF_PERM = OFF_CNT + 256;
constexpr size_t OFF_CSUM = OFF_PERM + (size_t)MOE_ROWS * 4;
constexpr size_t OFF_SMALL_END = OFF_CSUM + (size_t)2 * NTOK * 8 * 4;
constexpr size_t OFF_UO = (OFF_SMALL_END + 255) / 256 * 256;
constexpr size_t OFF_P = OFF_UO + (size_t)NTOK * D * 4;
constexpr size_t OFF_YS = OFF_P + (size_t)NTOK * EVEN_IN * 4;
constexpr size_t WS_END = OFF_YS + (size_t)NTOK * 512 * 4;

__device__ __forceinline__ float sigmoidf_(float x) { return 1.0f / (1.0f + expf(-x)); }
__device__ __forceinline__ float siluf_(float x) { return x / (1.0f + expf(-x)); }
__device__ __forceinline__ float wave_sum(float v) {
#pragma unroll
  for (int o = 32; o > 0; o >>= 1) v += __shfl_xor(v, o);
  return v;
}

__global__ __launch_bounds__(256) void k_ada(const float* __restrict__ c, const float* __restrict__ c_ctx, const float* __restrict__ ada_w,
                                             const float* __restrict__ ada_b, float* __restrict__ mod) {
  const int idx = blockIdx.x * 256 + threadIdx.x;
  if (idx >= DEPTH * 6144) return;
  const int l = idx / 6144, n = idx % 6144;
  float a0 = 0, a1 = 0, a2 = 0, a3 = 0, a4 = 0;
  const float* w = ada_w + (size_t)l * D * 6144 + n;
  for (int k = 0; k < D; ++k) {
    const float wv = w[(size_t)k * 6144];
    a0 += siluf_(c[k]) * wv; a1 += siluf_(c[D + k]) * wv; a2 += siluf_(c[2 * D + k]) * wv; a3 += siluf_(c[3 * D + k]) * wv; a4 += siluf_(c_ctx[k]) * wv;
  }
  const float bv = ada_b[l * 6144 + n];
  float* m = mod + (size_t)l * 5 * 6144 + n;
  m[0] = a0 + bv; m[6144] = a1 + bv; m[2 * 6144] = a2 + bv; m[3 * 6144] = a3 + bv; m[4 * 6144] = a4 + bv;
}

__device__ __forceinline__ int bidx_of_row(int row) { return row < NLAT ? row / T : 4; }

__global__ __launch_bounds__(256) void k_modulate(const float* __restrict__ hlat, const float* __restrict__ hctx, const float* __restrict__ modl,
                                                  int shift_chunk, float* __restrict__ U) {
  const int row = blockIdx.x; const int bi = bidx_of_row(row);
  const float* h = row < NLAT ? hlat + (size_t)row * D : hctx + (size_t)(row - NLAT) * D;
  const float* sh = modl + (size_t)bi * 6144 + shift_chunk * D; const float* sc = sh + D;
  for (int d = threadIdx.x; d < D; d += 256) U[(size_t)row * D + d] = h[d] * (1.0f + sc[d]) + sh[d];
}

__global__ __launch_bounds__(256) void k_gemm(const float* __restrict__ A, int lda, const float* __restrict__ Bm, int ldb, float* __restrict__ C, int ldc, int K) {
  __shared__ float As[16][68]; __shared__ float Bs[16][64];
  const int tid = threadIdx.x, tx = tid & 15, ty = tid >> 4;
  const int m0 = blockIdx.y * 64, n0 = blockIdx.x * 64;
  float acc[4][4];
#pragma unroll
  for (int i = 0; i < 4; ++i)
#pragma unroll
    for (int j = 0; j < 4; ++j) acc[i][j] = 0.f;
  const int ar = tid >> 2, ac = (tid & 3) * 4, br = tid >> 4, bc = (tid & 15) * 4;
  for (int k0 = 0; k0 < K; k0 += 16) {
    const float4 av = *(const float4*)(A + (size_t)(m0 + ar) * lda + k0 + ac);
    const float4 bv = *(const float4*)(Bm + (size_t)(k0 + br) * ldb + n0 + bc);
    As[ac + 0][ar] = av.x; As[ac + 1][ar] = av.y; As[ac + 2][ar] = av.z; As[ac + 3][ar] = av.w;
    *(float4*)&Bs[br][bc] = bv;
    __syncthreads();
#pragma unroll
    for (int kk = 0; kk < 16; ++kk) {
      const float4 a4 = *(const float4*)&As[kk][ty * 4]; const float4 b4 = *(const float4*)&Bs[kk][tx * 4];
      const float a[4] = {a4.x, a4.y, a4.z, a4.w}; const float b[4] = {b4.x, b4.y, b4.z, b4.w};
#pragma unroll
      for (int i = 0; i < 4; ++i)
#pragma unroll
        for (int j = 0; j < 4; ++j) acc[i][j] += a[i] * b[j];
    }
    __syncthreads();
  }
#pragma unroll
  for (int i = 0; i < 4; ++i) *(float4*)(C + (size_t)(m0 + ty * 4 + i) * ldc + n0 + tx * 4) = make_float4(acc[i][0], acc[i][1], acc[i][2], acc[i][3]);
}

__global__ __launch_bounds__(256) void k_na(const float* __restrict__ P, const float* __restrict__ rpb, float* __restrict__ O) {
  const int idx = blockIdx.x * 256 + threadIdx.x; if (idx >= NTOK * 8) return;
  const int h = idx & 7, row = idx >> 3;
  const float* qp = P + (size_t)row * EVEN_IN + h * 64;
  float q[64], o[64];
#pragma unroll
  for (int d = 0; d < 64; ++d) { q[d] = qp[d] * 0.125f; o[d] = 0.f; }
  float m = -1e30f, l = 0.f;
  int b;
  if (row < NLAT) {
    b = row / T; const int t = row % T, r = t >> 6, c = t & 63;
    int rs = r - 4; rs = rs < 0 ? 0 : (rs > 120 ? 120 : rs);
    int cs = c - 8; cs = cs < 0 ? 0 : (cs > 48 ? 48 : cs);
    for (int i = 0; i < 8; ++i) for (int j = 0; j < 16; ++j) {
      const int kr = rs + i, kc = cs + j; const int krow = b * T + kr * 64 + kc;
      const float* kp = P + (size_t)krow * EVEN_IN + 512 + h * 64; const float* vp = kp + 512;
      float s = 0.f;
#pragma unroll
      for (int d = 0; d < 64; ++d) s += q[d] * kp[d];
      s += rpb[(h * 15 + (kr - r + 7)) * 31 + (kc - c + 15)];
      const float mn = fmaxf(m, s), al = expf(m - mn), p = expf(s - mn);
      l = l * al + p; m = mn;
#pragma unroll
      for (int d = 0; d < 64; ++d) o[d] = o[d] * al + p * vp[d];
    }
  } else b = (row - NLAT) / L;
  for (int j = 0; j < L; ++j) {
    const int krow = NLAT + b * L + j;
    const float* kp = P + (size_t)krow * EVEN_IN + 512 + h * 64; const float* vp = kp + 512;
    float s = 0.f;
#pragma unroll
    for (int d = 0; d < 64; ++d) s += q[d] * kp[d];
    const float mn = fmaxf(m, s), al = expf(m - mn), p = expf(s - mn);
    l = l * al + p; m = mn;
#pragma unroll
    for (int d = 0; d < 64; ++d) o[d] = o[d] * al + p * vp[d];
  }
  const float inv = 1.0f / l;
  float* op = O + (size_t)row * D + h * 64;
#pragma unroll
  for (int d = 0; d < 64; ++d) op[d] = o[d] * inv;
}

__device__ __forceinline__ float rw_conv(const float* __restrict__ P, const float* __restrict__ cw, int row, int col) {
  int lo, hi;
  if (row < NLAT) { lo = (row / T) * T; hi = lo + T - 1; } else { lo = NLAT + ((row - NLAT) / L) * L; hi = lo + L - 1; }
  const float* p = P + (size_t)row * EVEN_IN + RW_OFF + col;
  float v = p[0] * cw[RW_IN + col];
  if (row > lo) v += p[-EVEN_IN] * cw[col];
  if (row < hi) v += p[EVEN_IN] * cw[2 * RW_IN + col];
  return v;
}

__global__ __launch_bounds__(64) void k_rwscan(const float* __restrict__ P, const float* __restrict__ cw, const float* __restrict__ w0, const float* __restrict__ w_up,
                                               const float* __restrict__ a0, const float* __restrict__ a_up, const float* __restrict__ k_k, const float* __restrict__ k_a,
                                               const float* __restrict__ r_k, float* __restrict__ ysum, float* __restrict__ csum) {
  __shared__ float s_wup[64][64], s_aup[64][64]; __shared__ float s_xw[64], s_xa[64], s_w[64], s_a[64], s_b[64], s_k[64], s_r[64];
  const int j = threadIdx.x; const int chain = blockIdx.x; const int dir = chain >> 5, b = (chain >> 3) & 3, h = chain & 7;
  const int col = h * 64 + j;
  for (int m = 0; m < 64; ++m) { s_wup[m][j] = w_up[((size_t)dir * 64 + m) * 512 + col]; s_aup[m][j] = a_up[((size_t)dir * 64 + m) * 512 + col]; }
  const float w0j = w0[dir * 512 + col], a0j = a0[dir * 512 + col], kkj = k_k[col], kaj = k_a[col], rkj = r_k[col];
  float S[64];
#pragma unroll
  for (int i = 0; i < 64; ++i) S[i] = 0.f;
  __syncthreads();
  for (int step = 0; step < L + T; ++step) {
    int row;
    if (step < L) { const int tc = dir ? (L - 1 - step) : step; row = NLAT + b * L + tc; }
    else { const int tl = dir ? (T - 1 - (step - L)) : (step - L); row = b * T + tl; }
    const float rj = rw_conv(P, cw, row, col), kj = rw_conv(P, cw, row, 512 + col), vj = rw_conv(P, cw, row, 1024 + col);
    s_xw[j] = tanhf(rw_conv(P, cw, row, 1536 + j)); s_xa[j] = rw_conv(P, cw, row, 1600 + j);
    __syncthreads();
    float xw = w0j, xa = a0j;
    for (int m = 0; m < 64; ++m) { xw += s_xw[m] * s_wup[m][j]; xa += s_xa[m] * s_aup[m][j]; }
    const float z = -xw; const float sp = fmaxf(z, 0.f) + log1pf(expf(-fabsf(z)));
    const float decay = expf(-expf(-sp - 0.5f));
    const float av = sigmoidf_(xa);
    float kk = kj * kkj; const float nrm = sqrtf(wave_sum(kk * kk)); kk = kk / fmaxf(nrm, 1e-12f);
    const float keff = kj * (1.0f + (av - 1.0f) * kaj);
    const float cb = wave_sum(rj * keff * rkj);
    if (j == 0) csum[((size_t)dir * NTOK + row) * 8 + h] = cb;
    s_w[j] = decay; s_a[j] = -kk; s_b[j] = kk * av; s_k[j] = keff; s_r[j] = rj;
    __syncthreads();
    float sa = 0.f;
#pragma unroll
    for (int i = 0; i < 64; ++i) sa += S[i] * s_a[i];
    float y = 0.f;
#pragma unroll
    for (int i = 0; i < 64; ++i) { S[i] = S[i] * s_w[i] + sa * s_b[i] + vj * s_k[i]; y += S[i] * s_r[i]; }
    atomicAdd(ysum + (size_t)row * 512 + col, y);
    __syncthreads();
  }
}

__global__ __launch_bounds__(512) void k_rwfinish(const float* __restrict__ P, const float* __restrict__ cw, const float* __restrict__ g_up, const float* __restrict__ gn_g,
                                                  const float* __restrict__ gn_b, const float* __restrict__ ysum, const float* __restrict__ csum, float* __restrict__ O) {
  __shared__ float s_g[128];
  const int row = blockIdx.x, col = threadIdx.x, h = col >> 6;
  if (col < 128) s_g[col] = sigmoidf_(rw_conv(P, cw, row, 1664 + col));
  __syncthreads();
  float g = 0.f;
  for (int m = 0; m < 128; ++m) g += s_g[m] * g_up[(size_t)m * 512 + col];
  const float y = ysum[(size_t)row * 512 + col];
  const float mu = wave_sum(y) * (1.0f / 64.0f); const float dv = y - mu; const float var = wave_sum(dv * dv) * (1.0f / 64.0f);
  const float yn = dv * rsqrtf(var + 64e-5f) * gn_g[col] + gn_b[col];
  const float v = rw_conv(P, cw, row, 1024 + col);
  const float bonus = (csum[(size_t)row * 8 + h] + csum[((size_t)NTOK + row) * 8 + h]) * v;
  O[(size_t)row * D + 512 + col] = (yn + bonus) * g;
}

__global__ __launch_bounds__(256) void k_rope(float* __restrict__ P) {
  const int idx = blockIdx.x * 256 + threadIdx.x;
  if (idx >= NLAT * 32 * 32) return;
  const int i = idx & 15, half = (idx >> 4) & 1, z = (idx >> 5) & 31, row = idx >> 10;
  const int t = row % T; const float pos = half ? (float)(t & 63) : (float)(t >> 6);
  const float inv = exp2f(-(float)i * (13.287712379549449f / 16.0f));
  float sn, cs; sincosf(pos * inv, &sn, &cs);
  float* p = P + (size_t)row * ODD_IN + z * 64 + half * 32 + i;
  const float z1 = p[0], z2 = p[16];
  p[0] = z1 * cs - z2 * sn; p[16] = z1 * sn + z2 * cs;
}

__global__ __launch_bounds__(256) void k_diffattn(const float* __restrict__ P, const float* __restrict__ subln_g, const float* __restrict__ lq1, const float* __restrict__ lk1,
                                                  const float* __restrict__ lq2, const float* __restrict__ lk2, float lambda_init, float* __restrict__ O) {
  __shared__ float sK[32][128]; __shared__ float sV[32][128];
  const int tid = threadIdx.x, mp = tid & 1, qi = tid >> 1;
  float d1 = 0.f, d2 = 0.f;
  for (int i = 0; i < 64; ++i) { d1 += lq1[i] * lk1[i]; d2 += lq2[i] * lk2[i]; }
  const float lam = expf(d1) - expf(d2) + lambda_init, one_minus_li = 1.0f - lambda_init;
  int blk = blockIdx.x; int b, h, qrow, nk_lat;
  if (blk < B * 8 * 64) { b = blk / 512; h = (blk >> 6) & 7; qrow = b * T + (blk & 63) * 128 + qi; nk_lat = T; }
  else { blk -= B * 8 * 64; b = blk / 16; h = (blk >> 1) & 7; qrow = NLAT + b * L + (blk & 1) * 128 + qi; nk_lat = 0; }
  const float* qp = P + (size_t)qrow * ODD_IN + h * 128 + mp * 64;
  float q[64], o[128];
#pragma unroll
  for (int d = 0; d < 64; ++d) q[d] = qp[d] * 0.125f;
#pragma unroll
  for (int d = 0; d < 128; ++d) o[d] = 0.f;
  float m = -1e30f, l = 0.f;
  const int nk = nk_lat + L;
  for (int k0 = 0; k0 < nk; k0 += 32) {
    __syncthreads();
    for (int e = tid; e < 32 * 32; e += 256) {
      const int kr = e >> 5, c4 = (e & 31) * 4; const int kk = k0 + kr;
      const int krow = kk < nk_lat ? b * T + kk : NLAT + b * L + (kk - nk_lat);
      *(float4*)&sK[kr][c4] = *(const float4*)(P + (size_t)krow * ODD_IN + 1024 + h * 128 + c4);
      *(float4*)&sV[kr][c4] = *(const float4*)(P + (size_t)krow * ODD_IN + 2048 + h * 128 + c4);
    }
    __syncthreads();
    for (int kr = 0; kr < 32; ++kr) {
      float s = 0.f;
#pragma unroll
      for (int d = 0; d < 64; ++d) s += q[d] * sK[kr][mp * 64 + d];
      const float mn = fmaxf(m, s), al = expf(m - mn), p = expf(s - mn);
      l = l * al + p; m = mn;
#pragma unroll
      for (int d = 0; d < 128; ++d) o[d] = o[d] * al + p * sV[kr][d];
    }
  }
  const float inv = 1.0f / l;
  float ss = 0.f;
#pragma unroll
  for (int d = 0; d < 128; ++d) { const float mine = o[d] * inv; const float other = __shfl_xor(mine, 1); const float a = mp == 0 ? mine - lam * other : other - lam * mine; o[d] = a; ss += a * a; }
  const float rs = rsqrtf(ss * (1.0f / 128.0f) + 1e-5f) * one_minus_li;
  if (mp == 0) {
    float* op = O + (size_t)qrow * D + h * 128;
#pragma unroll
    for (int d = 0; d < 128; ++d) op[d] = o[d] * rs * subln_g[d];
  }
}

__device__ __forceinline__ float block_sum256(float v, float* red) {
  v = wave_sum(v);
  __syncthreads();
  if ((threadIdx.x & 63) == 0) red[threadIdx.x >> 6] = v;
  __syncthreads();
  return red[0] + red[1] + red[2] + red[3];
}
template <int MOE>
__global__ __launch_bounds__(256) void k_resln(const float* __restrict__ hlat_in, const float* __restrict__ hctx_in, float* __restrict__ hlat_out, float* __restrict__ hctx_out,
                                               const float* __restrict__ Y, const int* __restrict__ pos, const float* __restrict__ gatev, const float* __restrict__ modl, int gate_chunk,
                                               const float* __restrict__ g, const float* __restrict__ bta, int mod_chunk, float* __restrict__ U) {
  __shared__ float red[4];
  const int row = blockIdx.x; const int bi = bidx_of_row(row);
  const float* h = row < NLAT ? hlat_in + (size_t)row * D : hctx_in + (size_t)(row - NLAT) * D;
  float* ho = row < NLAT ? hlat_out + (size_t)row * D : hctx_out + (size_t)(row - NLAT) * D;
  const float* gt = modl + (size_t)bi * 6144 + gate_chunk * D;
  float v[4]; float s = 0.f;
#pragma unroll
  for (int i = 0; i < 4; ++i) {
    const int d = threadIdx.x + i * 256; float y;
    if (MOE) { const int p0 = pos[row * 2], p1 = pos[row * 2 + 1]; y = gatev[row * 2] * Y[(size_t)p0 * D + d] + gatev[row * 2 + 1] * Y[(size_t)p1 * D + d]; }
    else y = Y[(size_t)row * D + d];
    v[i] = ALPHA * h[d] + gt[d] * y; s += v[i];
  }
  const float mu = block_sum256(s, red) * (1.0f / D);
  float q = 0.f;
#pragma unroll
  for (int i = 0; i < 4; ++i) { const float dd = v[i] - mu; q += dd * dd; }
  const float var = block_sum256(q, red) * (1.0f / D);
  const float rstd = rsqrtf(var + LN_EPS);
#pragma unroll
  for (int i = 0; i < 4; ++i) {
    const int d = threadIdx.x + i * 256; const float hn = (v[i] - mu) * rstd * g[d] + bta[d];
    ho[d] = hn;
    if (U) { const float* sh = modl + (size_t)bi * 6144 + mod_chunk * D; U[(size_t)row * D + d] = hn * (1.0f + sh[D + d]) + sh[d]; }
  }
}

__global__ __launch_bounds__(256) void k_router(const float* __restrict__ U, const float* __restrict__ rw, const float* __restrict__ rb, int ntok, int* __restrict__ eid, float* __restrict__ gatev, int* __restrict__ counts) {
  const int lane = threadIdx.x & 63; const int tok = blockIdx.x * 4 + (threadIdx.x >> 6); if (tok >= ntok) return;
  float acc[16];
#pragma unroll
  for (int e = 0; e < 16; ++e) acc[e] = 0.f;
  for (int d = lane; d < D; d += 64) { const float u = U[(size_t)tok * D + d]; const float* w = rw + (size_t)d * 16;
#pragma unroll
    for (int e = 0; e < 16; ++e) acc[e] += u * w[e]; }
  float s[16], sel[16];
#pragma unroll
  for (int e = 0; e < 16; ++e) { s[e] = sigmoidf_(wave_sum(acc[e])); sel[e] = s[e] + rb[e]; }
  float best = -1e30f; int grp = 0;
#pragma unroll
  for (int gI = 0; gI < 4; ++gI) {
    const float a = sel[gI * 4], b2 = sel[gI * 4 + 1], c = sel[gI * 4 + 2], d = sel[gI * 4 + 3];
    const float mx = fmaxf(fmaxf(a, b2), fmaxf(c, d));
    const float lo1 = fminf(a, b2), hi1 = fmaxf(a, b2), lo2 = fminf(c, d), hi2 = fmaxf(c, d);
    const float second = fmaxf(fminf(hi1, hi2), fmaxf(lo1, lo2));
    const float gs = mx + second;
    if (gs > best) { best = gs; grp = gI; }
  }
  float v0 = 0, v1 = 0, v2 = 0, v3 = 0, s0 = 0, s1 = 0, s2 = 0, s3 = 0;
#pragma unroll
  for (int gI = 0; gI < 4; ++gI) if (gI == grp) { v0 = sel[gI * 4]; v1 = sel[gI * 4 + 1]; v2 = sel[gI * 4 + 2]; v3 = sel[gI * 4 + 3]; s0 = s[gI * 4]; s1 = s[gI * 4 + 1]; s2 = s[gI * 4 + 2]; s3 = s[gI * 4 + 3]; }
  int i1 = 0; float b1 = v0; if (v1 > b1) { b1 = v1; i1 = 1; } if (v2 > b1) { b1 = v2; i1 = 2; } if (v3 > b1) { b1 = v3; i1 = 3; }
  int i2 = -1; float bb = -1e30f;
  if (i1 != 0 && v0 > bb) { bb = v0; i2 = 0; } if (i1 != 1 && v1 > bb) { bb = v1; i2 = 1; } if (i1 != 2 && v2 > bb) { bb = v2; i2 = 2; } if (i1 != 3 && v3 > bb) { bb = v3; i2 = 3; }
  const float g1 = i1 == 0 ? s0 : i1 == 1 ? s1 : i1 == 2 ? s2 : s3; const float g2 = i2 == 0 ? s0 : i2 == 1 ? s1 : i2 == 2 ? s2 : s3;
  if (lane == 0) {
    const int e1 = grp * 4 + i1, e2 = grp * 4 + i2;
    eid[tok * 2] = e1; eid[tok * 2 + 1] = e2; gatev[tok * 2] = g1 / (g1 + g2); gatev[tok * 2 + 1] = g2 / (g1 + g2);
    atomicAdd(counts + e1, 1); atomicAdd(counts + e2, 1);
  }
}
__global__ void k_offsets(int* cnt) {
  if (threadIdx.x == 0) { int o = 0; for (int e = 0; e < 16; ++e) { cnt[32 + e] = o; o += (cnt[e] + 63) / 64 * 64; } cnt[48] = o; }
}
__global__ __launch_bounds__(256) void k_scatter(const int* __restrict__ eid, int ntok, int* __restrict__ cnt, int* __restrict__ perm, int* __restrict__ pos) {
  const int i = blockIdx.x * 256 + threadIdx.x; if (i >= ntok * 2) return;
  const int e = eid[i]; const int p = cnt[32 + e] + atomicAdd(cnt + 16 + e, 1);
  perm[p] = i >> 1; pos[i] = p;
}
__global__ __launch_bounds__(256) void k_moe_gu(const float* __restrict__ U, const int* __restrict__ perm, const int* __restrict__ cnt, const float* __restrict__ wg, const float* __restrict__ wu, float* __restrict__ He) {
  __shared__ float As[16][68]; __shared__ float Bg[16][64]; __shared__ float Bu[16][64];
  const int m0 = blockIdx.y * 64; if (m0 >= cnt[48]) return;
  int e = 0;
#pragma unroll
  for (int i = 1; i < 16; ++i) if (m0 >= cnt[32 + i]) e = i;
  const float* G = wg + (size_t)e * D * DE; const float* Uw = wu + (size_t)e * D * DE;
  const int tid = threadIdx.x, tx = tid & 15, ty = tid >> 4, n0 = blockIdx.x * 64;
  float ag[4][4], au[4][4];
#pragma unroll
  for (int i = 0; i < 4; ++i)
#pragma unroll
    for (int j = 0; j < 4; ++j) { ag[i][j] = 0.f; au[i][j] = 0.f; }
  const int ar = tid >> 2, ac = (tid & 3) * 4, br = tid >> 4, bc = (tid & 15) * 4;
  const int src = perm[m0 + ar];
  for (int k0 = 0; k0 < D; k0 += 16) {
    float4 av = make_float4(0.f, 0.f, 0.f, 0.f); if (src >= 0) av = *(const float4*)(U + (size_t)src * D + k0 + ac);
    As[ac + 0][ar] = av.x; As[ac + 1][ar] = av.y; As[ac + 2][ar] = av.z; As[ac + 3][ar] = av.w;
    *(float4*)&Bg[br][bc] = *(const float4*)(G + (size_t)(k0 + br) * DE + n0 + bc);
    *(float4*)&Bu[br][bc] = *(const float4*)(Uw + (size_t)(k0 + br) * DE + n0 + bc);
    __syncthreads();
#pragma unroll
    for (int kk = 0; kk < 16; ++kk) {
      const float4 a4 = *(const float4*)&As[kk][ty * 4]; const float4 g4 = *(const float4*)&Bg[kk][tx * 4]; const float4 u4 = *(const float4*)&Bu[kk][tx * 4];
      const float a[4] = {a4.x, a4.y, a4.z, a4.w}; const float gg[4] = {g4.x, g4.y, g4.z, g4.w}; const float uu[4] = {u4.x, u4.y, u4.z, u4.w};
#pragma unroll
      for (int i = 0; i < 4; ++i)
#pragma unroll
        for (int j = 0; j < 4; ++j) { ag[i][j] += a[i] * gg[j]; au[i][j] += a[i] * uu[j]; }
    }
    __syncthreads();
  }
#pragma unroll
  for (int i = 0; i < 4; ++i) *(float4*)(He + (size_t)(m0 + ty * 4 + i) * DE + n0 + tx * 4) =
      make_float4(siluf_(ag[i][0]) * au[i][0], siluf_(ag[i][1]) * au[i][1], siluf_(ag[i][2]) * au[i][2], siluf_(ag[i][3]) * au[i][3]);
}
__global__ __launch_bounds__(256) void k_moe_down(const float* __restrict__ He, const int* __restrict__ cnt, const float* __restrict__ wd, float* __restrict__ Ys) {
  __shared__ float As[16][68]; __shared__ float Bs[16][64];
  const int m0 = blockIdx.y * 64; if (m0 >= cnt[48]) return;
  int e = 0;
#pragma unroll
  for (int i = 1; i < 16; ++i) if (m0 >= cnt[32 + i]) e = i;
  const float* W = wd + (size_t)e * DE * D;
  const int tid = threadIdx.x, tx = tid & 15, ty = tid >> 4, n0 = blockIdx.x * 64;
  float acc[4][4];
#pragma unroll
  for (int i = 0; i < 4; ++i)
#pragma unroll
    for (int j = 0; j < 4; ++j) acc[i][j] = 0.f;
  const int ar = tid >> 2, ac = (tid & 3) * 4, br = tid >> 4, bc = (tid & 15) * 4;
  for (int k0 = 0; k0 < DE; k0 += 16) {
    const float4 av = *(const float4*)(He + (size_t)(m0 + ar) * DE + k0 + ac);
    As[ac + 0][ar] = av.x; As[ac + 1][ar] = av.y; As[ac + 2][ar] = av.z; As[ac + 3][ar] = av.w;
    *(float4*)&Bs[br][bc] = *(const float4*)(W + (size_t)(k0 + br) * D + n0 + bc);
    __syncthreads();
#pragma unroll
    for (int kk = 0; kk < 16; ++kk) {
      const float4 a4 = *(const float4*)&As[kk][ty * 4]; const float4 b4 = *(const float4*)&Bs[kk][tx * 4];
      const float a[4] = {a4.x, a4.y, a4.z, a4.w}; const float b[4] = {b4.x, b4.y, b4.z, b4.w};
#pragma unroll
      for (int i = 0; i < 4; ++i)
#pragma unroll
        for (int j = 0; j < 4; ++j) acc[i][j] += a[i] * b[j];
    }
    __syncthreads();
  }
#pragma unroll
  for (int i = 0; i < 4; ++i) *(float4*)(Ys + (size_t)(m0 + ty * 4 + i) * D + n0 + tx * 4) = make_float4(acc[i][0], acc[i][1], acc[i][2], acc[i][3]);
}
}

extern "C" void kernel_launch(void* const* d_in, const int* in_sizes, int n_in, void* d_out, int out_size, void* d_ws, size_t ws_size, hipStream_t stream) {
  using namespace nv;
  const float* x = (const float*)d_in[0]; const float* c = (const float*)d_in[1]; const float* ctx = (const float*)d_in[2]; const float* c_ctx = (const float*)d_in[3];
  const float* ada_w = (const float*)d_in[4]; const float* ada_b = (const float*)d_in[5]; const float* ln_g = (const float*)d_in[6]; const float* ln_b = (const float*)d_in[7];
  const float* even_w_in = (const float*)d_in[8]; const float* even_w_out = (const float*)d_in[9]; const float* shift_w = (const float*)d_in[10]; const float* na_rpb = (const float*)d_in[11];
  const float* rw_w0 = (const float*)d_in[12]; const float* rw_w_up = (const float*)d_in[13]; const float* rw_a0 = (const float*)d_in[14]; const float* rw_a_up = (const float*)d_in[15];
  const float* rw_g_up = (const float*)d_in[16]; const float* rw_k_k = (const float*)d_in[17]; const float* rw_k_a = (const float*)d_in[18]; const float* rw_r_k = (const float*)d_in[19];
  const float* rw_gn_g = (const float*)d_in[20]; const float* rw_gn_b = (const float*)d_in[21]; const float* odd_w_in = (const float*)d_in[22]; const float* odd_w_out = (const float*)d_in[23];
  const float* da_lq1 = (const float*)d_in[24]; const float* da_lk1 = (const float*)d_in[25]; const float* da_lq2 = (const float*)d_in[26]; const float* da_lk2 = (const float*)d_in[27];
  const float* da_subln_g = (const float*)d_in[28]; const float* router_w = (const float*)d_in[29]; const float* router_b = (const float*)d_in[30];
  const float* exp_w_gate = (const float*)d_in[31]; const float* exp_w_up = (const float*)d_in[32]; const float* exp_w_down = (const float*)d_in[33];
  char* ws = (char*)d_ws;
  if (ws_size < WS_END) return;
  float* mod = (float*)(ws + OFF_MOD); float* hctx = (float*)(ws + OFF_HCTX); int* eid = (int*)(ws + OFF_EID); float* gatev = (float*)(ws + OFF_GATE); int* pos = (int*)(ws + OFF_POS);
  int* cnt = (int*)(ws + OFF_CNT); int* perm = (int*)(ws + OFF_PERM); float* csum = (float*)(ws + OFF_CSUM); float* UO = (float*)(ws + OFF_UO); float* Pb = (float*)(ws + OFF_P);
  float* ysum = (float*)(ws + OFF_YS); float* hlat = (float*)d_out;
  float* Ybuf = Pb; float* He = Pb; float* Ys = Pb + (size_t)MOE_ROWS * DE;

  k_ada<<<(DEPTH * 6144 + 255) / 256, 256, 0, stream>>>(c, c_ctx, ada_w, ada_b, mod);
  for (int l = 0; l < DEPTH; ++l) {
    const float* modl = mod + (size_t)l * 5 * 6144; const int i = l / 2; const bool last = l == DEPTH - 1;
    const float* hl_in = l == 0 ? x : hlat; const float* hc_in = l == 0 ? ctx : hctx;
    k_modulate<<<NTOK, 256, 0, stream>>>(hl_in, hc_in, modl, 0, UO);
    if (l % 2 == 0) {
      k_gemm<<<dim3(EVEN_IN / 64, NTOK / 64), 256, 0, stream>>>(UO, D, even_w_in + (size_t)i * D * EVEN_IN, EVEN_IN, Pb, EVEN_IN, D);
      k_na<<<(NTOK * 8 + 255) / 256, 256, 0, stream>>>(Pb, na_rpb + (size_t)i * 8 * 15 * 31, UO);
      hipMemsetAsync(ysum, 0, (size_t)NTOK * 512 * 4, stream);
      k_rwscan<<<64, 64, 0, stream>>>(Pb, shift_w + (size_t)i * 3 * RW_IN, rw_w0 + i * 1024, rw_w_up + (size_t)i * 2 * 64 * 512, rw_a0 + i * 1024, rw_a_up + (size_t)i * 2 * 64 * 512,
                                      rw_k_k + i * 512, rw_k_a + i * 512, rw_r_k + i * 512, ysum, csum);
      k_rwfinish<<<NTOK, 512, 0, stream>>>(Pb, shift_w + (size_t)i * 3 * RW_IN, rw_g_up + (size_t)i * 128 * 512, rw_gn_g + i * 512, rw_gn_b + i * 512, ysum, csum, UO);
      k_gemm<<<dim3(D / 64, NTOK / 64), 256, 0, stream>>>(UO, D, even_w_out + (size_t)i * D * D, D, Ybuf, D, D);
    } else {
      k_gemm<<<dim3(ODD_IN / 64, NTOK / 64), 256, 0, stream>>>(UO, D, odd_w_in + (size_t)i * D * ODD_IN, ODD_IN, Pb, ODD_IN, D);
      k_rope<<<(NLAT * 1024 + 255) / 256, 256, 0, stream>>>(Pb);
      const float li = 0.8f - 0.6f * expf(-0.3f * (float)l);
      k_diffattn<<<B * 8 * 64 + B * 8 * 2, 256, 0, stream>>>(Pb, da_subln_g + i * 128, da_lq1 + i * 64, da_lk1 + i * 64, da_lq2 + i * 64, da_lk2 + i * 64, li, UO);
      k_gemm<<<dim3(D / 64, NTOK / 64), 256, 0, stream>>>(UO, D, odd_w_out + (size_t)i * D * D, D, Ybuf, D, D);
    }
    k_resln<0><<<NTOK, 256, 0, stream>>>(hl_in, hc_in, hlat, hctx, Ybuf, nullptr, nullptr, modl, 2, ln_g + (size_t)(l * 2) * D, ln_b + (size_t)(l * 2) * D, 3, UO);
    const int ntok = last ? NLAT : NTOK;
    hipMemsetAsync(cnt, 0, 256, stream);
    hipMemsetAsync(perm, 0xFF, (size_t)MOE_ROWS * 4, stream);
    k_router<<<(ntok + 3) / 4, 256, 0, stream>>>(UO, router_w, router_b, ntok, eid, gatev, cnt);
    k_offsets<<<1, 64, 0, stream>>>(cnt);
    k_scatter<<<(ntok * 2 + 255) / 256, 256, 0, stream>>>(eid, ntok, cnt, perm, pos);
    k_moe_gu<<<dim3(DE / 64, MOE_ROWS / 64), 256, 0, stream>>>(UO, perm, cnt, exp_w_gate + (size_t)l * NE * D * DE, exp_w_up + (size_t)l * NE * D * DE, He);
    k_moe_down<<<dim3(D / 64, MOE_ROWS / 64), 256, 0, stream>>>(He, cnt, exp_w_down + (size_t)l * NE * DE * D, Ys);
    k_resln<1><<<ntok, 256, 0, stream>>>(hlat, hctx, hlat, hctx, Ys, pos, gatev, modl, 5, ln_g + (size_t)(l * 2 + 1) * D, ln_b + (size_t)(l * 2 + 1) * D, 0, nullptr);
  }
}
```

```cpp
#include <hip/hip_runtime.h>
#include <stdint.h>
#include <stdio.h>

typedef unsigned short bf16_t;
typedef short bf16x8 __attribute__((ext_vector_type(8)));
typedef float f32x4 __attribute__((ext_vector_type(4)));
typedef float f32x2 __attribute__((ext_vector_type(2)));
typedef float f32x16 __attribute__((ext_vector_type(16)));
typedef unsigned u32x4 __attribute__((ext_vector_type(4)));
typedef unsigned u32x2 __attribute__((ext_vector_type(2)));
#define LAS __attribute__((address_space(3)))

namespace mk {
constexpr int B = 4, T = 8192, L = 256, D = 1024, NLAT = B * T, NCTX = B * L, NTOK = NLAT + NCTX;
constexpr int DEPTH = 4, EVEN_IN = 3328, ODD_IN = 3072, RW_OFF = 1536, RW_IN = 1792, NE = 16, DE = 512;
constexpr float ALPHA = 1.681792830507429f, LN_EPS = 1e-5f;
constexpr int NTHR = 512, LDS_BYTES = 147456;
constexpr int MOE_TILES = 280, MOE_ROWS = MOE_TILES * 256;

__device__ __forceinline__ unsigned cvt_pk_bf16(float lo, float hi) { unsigned r; asm volatile("v_cvt_pk_bf16_f32 %0, %1, %2" : "=v"(r) : "v"(lo), "v"(hi)); return r; }
__device__ __forceinline__ float bf2f(bf16_t b) { return __uint_as_float(((unsigned)b) << 16); }
__device__ __forceinline__ float bflo(unsigned w) { return __uint_as_float(w << 16); }
__device__ __forceinline__ float bfhi(unsigned w) { return __uint_as_float(w & 0xffff0000u); }
__device__ __forceinline__ bf16_t f2bf(float f) { return (bf16_t)(cvt_pk_bf16(f, 0.f) & 0xffffu); }
__device__ __forceinline__ float sigmoidf_(float x) { return 1.0f / (1.0f + __expf(-x)); }
__device__ __forceinline__ float siluf_(float x) { return x / (1.0f + __expf(-x)); }
__device__ __forceinline__ float wave_sum(float v) {
#pragma unroll
  for (int o = 32; o > 0; o >>= 1) v += __shfl_xor(v, o);
  return v;
}
__device__ __forceinline__ int otid() { int t = threadIdx.x; asm volatile("" : "+v"(t)); return t; }
__device__ __forceinline__ int bidx_of_row(int row) { return row < NLAT ? row / T : 4; }
}

#include <vector>

#define XB_TMO      128
#define XB_XCNT(j)  (256  + 64 * (j))
#define XB_XSUB(j)  (1280 + 64 * (j))
#define XB_XGEN(j)  (2304 + 64 * (j))
#define XB_TOP      3328
#define XB_TOPGEN   3392
#define XCD_BAR_WORDS 3456
#define XB_SPIN_CAP (1u << 18)
#define LAS __attribute__((address_space(3)))

__device__ __forceinline__ unsigned xb_ld(unsigned* p)              { return __hip_atomic_load(p, __ATOMIC_RELAXED, __HIP_MEMORY_SCOPE_AGENT); }
__device__ __forceinline__ unsigned xb_add(unsigned* p, unsigned v) { return __hip_atomic_fetch_add(p, v, __ATOMIC_RELAXED, __HIP_MEMORY_SCOPE_AGENT); }
__device__ __forceinline__ unsigned xb_xcc_id() { return (unsigned)__builtin_amdgcn_s_getreg((3 << 11) | 20) & 0xFu; }
#define XB_SPIN(cond, bar) do { unsigned _sp = 0; while (cond) { __builtin_amdgcn_s_sleep(1); \
    if ((++_sp & 255u) == 0u) { if (xb_ld(&(bar)[XB_TMO])) break; if (_sp > XB_SPIN_CAP) { atomicAdd(&(bar)[XB_TMO], 1u); break; } } } } while (0)

struct XcdBarrier {
    unsigned* bar; unsigned x;
    volatile LAS unsigned* st;
};

__device__ __forceinline__ XcdBarrier xcd_barrier_post(unsigned* bar, volatile LAS unsigned* st) {
    XcdBarrier b; b.bar = bar; b.x = xb_xcc_id(); b.st = st;
    if (threadIdx.x == 0) (void)xb_add(&bar[XB_XCNT(b.x)], 1u);
    return b;
}
__device__ __forceinline__ void xcd_barrier_complete(unsigned* bar, unsigned x, unsigned& nloc, unsigned& nx) {
    const unsigned G = gridDim.x * gridDim.y * gridDim.z;
    unsigned sum, cnt, mine, sp = 0u;
    for (;;) {
        sum = 0u; cnt = 0u; mine = 0u;
#pragma unroll
        for (unsigned j = 0; j < 16; ++j) { const unsigned c = xb_ld(&bar[XB_XCNT(j)]); sum += c; cnt += (c > 0u) ? 1u : 0u; mine = (j == x) ? c : mine; }
        if (sum == G) break;
        __builtin_amdgcn_s_sleep(1);
        if ((++sp & 255u) == 0u) { if (xb_ld(&bar[XB_TMO])) break; if (sp > XB_SPIN_CAP) { atomicAdd(&bar[XB_TMO], 1u); break; } }
    }
    nloc = mine > 0u ? mine : 1u; nx = cnt > 0u ? cnt : 1u;
}

__device__ __forceinline__ void xcd_barrier(const XcdBarrier& b) {
    asm volatile("s_waitcnt vmcnt(0)" ::: "memory");
    __syncthreads();
    if (threadIdx.x == 0) {
        unsigned* bar = b.bar;
        __builtin_amdgcn_s_waitcnt(0);
        unsigned nloc = b.st[0], nx = b.st[1];
        if (nloc == 0u) { xcd_barrier_complete(bar, b.x, nloc, nx); b.st[0] = nloc; b.st[1] = nx; }
        const unsigned old = xb_add(&bar[XB_XSUB(b.x)], 1u);
        const unsigned gen = old / nloc;
        if (old + 1u == (gen + 1u) * nloc) {
            __builtin_amdgcn_fence(__ATOMIC_RELEASE, "agent");
            asm volatile("s_waitcnt vmcnt(0)" ::: "memory");
            const unsigned og = xb_add(&bar[XB_TOP], 1u);
            const unsigned tg = og / nx;
            if (og + 1u == (tg + 1u) * nx) xb_add(&bar[XB_TOPGEN], 1u);
            else XB_SPIN(xb_ld(&bar[XB_TOPGEN]) == tg, bar);
            __builtin_amdgcn_fence(__ATOMIC_ACQUIRE, "agent");
            xb_add(&bar[XB_XGEN(b.x)], 1u);
            asm volatile("s_waitcnt vmcnt(0)" ::: "memory");
        } else {
            XB_SPIN(xb_ld(&bar[XB_XGEN(b.x)]) == gen, bar);
            __builtin_amdgcn_fence(__ATOMIC_ACQUIRE, "agent");
            asm volatile("s_waitcnt vmcnt(0)" ::: "memory");
        }
    }
    __syncthreads();
}

namespace pg8 {
using mk::cvt_pk_bf16;
constexpr int BM = 256, BK = 64, HALF = 128, HTB = HALF * BK * 2  , STAGE_BYTES = 8 * HTB;
__host__ __device__ __forceinline__ int lds_byte(int r, int c) { const int st = (r >> 4) * 2 + (c >> 5), rr = r & 15, cc = c & 31, ob = rr * 64 + cc * 2; return st * 1024 + (ob ^ (((ob >> 9) & 1) << 5)); }
__host__ __device__ __forceinline__ void stage_rc(int b, int& R, int& C) { const int st = b / 1024, sb = b % 1024, swz = sb ^ (((sb >> 9) & 1) << 5); R = (st >> 1) * 16 + swz / 64; C = (st & 1) * 32 + (swz % 64) / 2; }
__host__ __device__ __forceinline__ int perm32(int rho) { const int n = rho >> 4, i = rho & 15; return 8 * (i >> 2) + 4 * n + (i & 3); }

struct Unit { const char* A; const char* Bt; bf16_t* out; int pm, pn, x0, x1, ldo, kind; };

template <class Epi, class Sched>
__device__ __forceinline__ void gemm_phase(LAS unsigned char* lds, const int K, const Sched& S, const Epi& E) {
    const int tid = mk::otid(), wid = __builtin_amdgcn_readfirstlane(tid >> 6), lane = tid & 63, wr = wid >> 2, wc = wid & 3, fr = lane & 15, fq = lane >> 4;
    const int nt = K / BK;
    unsigned voffA[2], voffB[2];
#pragma unroll
    for (int i = 0; i < 2; ++i) { int R, C; stage_rc(tid * 16 + i * 8192, R, C); const int Rb = Epi::PERM ? ((R & ~31) + perm32(R & 31)) : R;
        voffA[i] = (unsigned)(R * K + C) * 2u; voffB[i] = (unsigned)(Rb * K + C) * 2u; }
    const size_t kstep = (size_t)(BK * 2);
    const size_t hstep = (size_t)HALF * K * 2;
    const unsigned ldsw = (unsigned)wid * 1024u;
    const int aoff = lds_byte(wr * 64 + fr, fq * 8), boff = lds_byte(wc * 32 + fr, fq * 8);
#define PG8_SA(b, h) (((b) * 2 + (h)) * HTB)
#define PG8_SB(b, h) ((4 + (b) * 2 + (h)) * HTB)
#define PG8_STAGE(bufoff, gbase, voff) do { _Pragma("unroll") for (int _i = 0; _i < 2; ++_i) \
        __builtin_amdgcn_global_load_lds((const unsigned*)((const char*)(gbase) + (voff)[_i]), (LAS unsigned*)(lds + (bufoff) + ldsw + _i * 8192), 16, 0, 0); } while (0)
#define PG8_LDA(dst, b, h) do { _Pragma("unroll") for (int m = 0; m < 4; ++m) _Pragma("unroll") for (int k = 0; k < 2; ++k) dst[m][k] = *(const LAS bf16x8*)(lds + PG8_SA(b, h) + aoff + m * 2048 + k * 1024); } while (0)
#define PG8_LDB(dst, b, h) do { _Pragma("unroll") for (int n = 0; n < 2; ++n) _Pragma("unroll") for (int k = 0; k < 2; ++k) dst[n][k] = *(const LAS bf16x8*)(lds + PG8_SB(b, h) + boff + n * 2048 + k * 1024); } while (0)
#define PG8_MMA(ai, bj, At, Bt) do { __builtin_amdgcn_s_setprio(1); _Pragma("unroll") for (int m = 0; m < 4; ++m) _Pragma("unroll") for (int n = 0; n < 2; ++n) _Pragma("unroll") for (int k = 0; k < 2; ++k) \
        acc[ai][bj][m][n] = __builtin_amdgcn_mfma_f32_16x16x32_bf16(Bt[n][k], At[m][k], acc[ai][bj][m][n], 0, 0, 0); __builtin_amdgcn_s_setprio(0); } while (0)
#define PG8_WAIT_V(n) asm volatile("s_waitcnt vmcnt(" #n ")" ::: "memory")
#define PG8_WAIT_L(n) asm volatile("s_waitcnt lgkmcnt(" #n ")" ::: "memory")
#define PG8_BAR __builtin_amdgcn_s_barrier()
#define PG8_SCHED __builtin_amdgcn_sched_barrier(0)
    Unit cur, nxt; int ui = 0;
    if (!S.next(0, cur)) return;
    f32x4 acc[2][2][4][2];
#pragma unroll
    for (int a = 0; a < 2; ++a)
#pragma unroll
        for (int b = 0; b < 2; ++b)
#pragma unroll
            for (int m = 0; m < 4; ++m)
#pragma unroll
                for (int n = 0; n < 2; ++n) acc[a][b][m][n] = (f32x4){0.f, 0.f, 0.f, 0.f};
    bf16x8 At[4][2], B0[2][2], B1[2][2];
    const char* cA = cur.A; const char* cB = cur.Bt;
    PG8_STAGE(PG8_SB(0, 0), cB, voffB); PG8_STAGE(PG8_SA(0, 0), cA, voffA); PG8_STAGE(PG8_SB(0, 1), cB + hstep, voffB); PG8_STAGE(PG8_SA(0, 1), cA + hstep, voffA);
    if (wr == 1) PG8_BAR;
    PG8_WAIT_V(4); PG8_BAR;
    PG8_STAGE(PG8_SB(1, 0), cB + kstep, voffB); PG8_STAGE(PG8_SA(1, 0), cA + kstep, voffA); PG8_STAGE(PG8_SB(1, 1), cB + hstep + kstep, voffB);
    PG8_WAIT_V(6); PG8_BAR;
    for (;;) {
        const bool has_next = S.next(ui + 1, nxt);
        const char* nA = has_next ? nxt.A : cA; const char* nB = has_next ? nxt.Bt : cB;
        for (int t = 0; t < nt; t += 2) {
            const bool last = (t == nt - 2);
            const char* a1 = cA + (size_t)(t + 1) * kstep;
            const char* a2 = last ? nA : cA + (size_t)(t + 2) * kstep; const char* b2 = last ? nB : cB + (size_t)(t + 2) * kstep;
            const char* a3 = a2 + kstep; const char* b3 = b2 + kstep;
            PG8_LDB(B0, 0, 0); PG8_SCHED; PG8_LDA(At, 0, 0); PG8_STAGE(PG8_SA(1, 1), a1 + hstep, voffA);
            PG8_WAIT_L(8); PG8_BAR; PG8_WAIT_L(0); PG8_MMA(0, 0, At, B0); PG8_BAR; PG8_SCHED;
            PG8_LDB(B1, 0, 1); PG8_STAGE(PG8_SB(0, 0), b2, voffB);
            PG8_BAR; PG8_WAIT_L(0); PG8_MMA(0, 1, At, B1); PG8_BAR;
            PG8_LDA(At, 0, 1); PG8_STAGE(PG8_SA(0, 0), a2, voffA);
            PG8_BAR; PG8_WAIT_L(0); PG8_MMA(1, 0, At, B0); PG8_BAR; PG8_SCHED;
            PG8_STAGE(PG8_SB(0, 1), b2 + hstep, voffB);
            PG8_WAIT_V(6); PG8_BAR; PG8_MMA(1, 1, At, B1); PG8_BAR;
            PG8_LDB(B0, 1, 0); PG8_SCHED; PG8_LDA(At, 1, 0); PG8_STAGE(PG8_SA(0, 1), a2 + hstep, voffA);
            PG8_WAIT_L(8); PG8_BAR; PG8_WAIT_L(0); PG8_MMA(0, 0, At, B0); PG8_BAR; PG8_SCHED;
            PG8_LDB(B1, 1, 1); PG8_STAGE(PG8_SB(1, 0), b3, voffB);
            PG8_BAR; PG8_WAIT_L(0); PG8_MMA(0, 1, At, B1); PG8_BAR;
            PG8_LDA(At, 1, 1); PG8_STAGE(PG8_SA(1, 0), a3, voffA);
            PG8_BAR; PG8_WAIT_L(0); PG8_MMA(1, 0, At, B0); PG8_BAR; PG8_SCHED;
            PG8_STAGE(PG8_SB(1, 1), b3 + hstep, voffB);
            PG8_WAIT_V(6); PG8_BAR; PG8_MMA(1, 1, At, B1); PG8_BAR;
        }
        E(acc, cur, wr, wc, fr, fq);
        if (!has_next) break;
#pragma unroll
        for (int a = 0; a < 2; ++a)
#pragma unroll
            for (int b = 0; b < 2; ++b)
#pragma unroll
                for (int m = 0; m < 4; ++m)
#pragma unroll
                    for (int n = 0; n < 2; ++n) acc[a][b][m][n] = (f32x4){0.f, 0.f, 0.f, 0.f};
        cur = nxt; cA = nA; cB = nB; ++ui;
    }
    PG8_WAIT_V(0);
    if (wr == 0) PG8_BAR;
    PG8_BAR;
#undef PG8_SA
#undef PG8_SB
#undef PG8_STAGE
#undef PG8_LDA
#undef PG8_LDB
#undef PG8_MMA
#undef PG8_WAIT_V
#undef PG8_WAIT_L
#undef PG8_BAR
#undef PG8_SCHED
}

struct EpiStoreBf16 {
    static constexpr bool PERM = true;
    __device__ __forceinline__ void operator()(const f32x4 (&acc)[2][2][4][2], const Unit& u, int wr, int wc, int fr, int fq) const {
        bf16_t* O = u.out; const int ldc = u.ldo;
        const int row0 = u.x0 + wr * 64 + fr, col0 = u.x1 + wc * 32 + 8 * fq;
#pragma unroll
        for (int ai = 0; ai < 2; ++ai)
#pragma unroll
            for (int m = 0; m < 4; ++m) { bf16_t* rowp = O + (size_t)(row0 + ai * HALF + m * 16) * ldc + col0;
#pragma unroll
                for (int bj = 0; bj < 2; ++bj) { const f32x4 v0 = acc[ai][bj][m][0], v1 = acc[ai][bj][m][1];
                    u32x4 w; w.x = cvt_pk_bf16(v0[0], v0[1]); w.y = cvt_pk_bf16(v0[2], v0[3]); w.z = cvt_pk_bf16(v1[0], v1[1]); w.w = cvt_pk_bf16(v1[2], v1[3]);
                    *(u32x4*)(rowp + bj * HALF) = w; } }
    }
};
}

namespace mk {
struct NMapId { int off; __device__ __forceinline__ int operator()(int n) const { return n + off; } };
struct NMapInterleave { int which; __device__ __forceinline__ int operator()(int n) const { return 2 * n + which; } };
struct NMapRope { __device__ __forceinline__ int operator()(int n) const { if (n >= 2048) return n; const int ch = n >> 6, c = n & 63, half = c >> 5, w = c & 31, z = w >> 4, i = w & 15; return ch * 64 + half * 32 + 2 * i + z; } };

template <class NMap>
__device__ __forceinline__ void cvt_tile(const float* __restrict__ src, int ldsrc, int K, bf16_t* __restrict__ dst, int k0, int n0, const NMap& nmap, LAS float* tile) {
  const int t = mk::otid();
  { const int k = t >> 3, c = (t & 7) * 8; const float* p = src + (size_t)(k0 + k) * ldsrc + n0 + c;
    const f32x4 a = *(const f32x4*)p, b = *(const f32x4*)(p + 4);
    LAS float* q = tile + k * 65 + c; q[0] = a[0]; q[1] = a[1]; q[2] = a[2]; q[3] = a[3]; q[4] = b[0]; q[5] = b[1]; q[6] = b[2]; q[7] = b[3]; }
  __syncthreads();
  { const int n = t >> 3, kc = (t & 7) * 8; const LAS float* q = tile + kc * 65 + n;
    u32x4 w; w.x = cvt_pk_bf16(q[0], q[65]); w.y = cvt_pk_bf16(q[130], q[195]); w.z = cvt_pk_bf16(q[260], q[325]); w.w = cvt_pk_bf16(q[390], q[455]);
    *(u32x4*)(dst + (size_t)nmap(n0 + n) * K + k0 + kc) = w; }
  __syncthreads();
}
template <class NMap>
__device__ __forceinline__ int cvt_matrix(const float* src, int ldsrc, int K, int N, bf16_t* dst, const NMap& nmap, LAS float* tile, int ubase, int bid, int nblk) {
  const int nkt = K / 64, nnt = N / 64, tot = nkt * nnt;
  int first = ubase + ((bid - ubase % nblk) + nblk) % nblk;
  for (int u = first; u < ubase + tot; u += nblk) { const int v = u - ubase; cvt_tile(src, ldsrc, K, dst, (v / nnt) * 64, (v % nnt) * 64, nmap, tile); }
  return tot;
}
}

namespace att {
using namespace mk;
constexpr int KB_BYTES = 64 * 128, VB_BYTES = 128 * 128, DA_LDS = 2 * (KB_BYTES + VB_BYTES);
__device__ __forceinline__ int pi32(int r) { return (r & ~12) | ((r & 4) << 1) | ((r & 8) >> 1); }
__device__ __forceinline__ int swz(int row, int chunk) { return row * 128 + ((chunk ^ ((row >> 1) & 7)) << 4); }
__device__ __forceinline__ int crow(int r, int hi) { return (r & 3) + 8 * (r >> 2) + 4 * hi; }

__device__ __forceinline__ void diff_attn_unit(const bf16_t* __restrict__ Pqk, const bf16_t* __restrict__ Vt, bf16_t* __restrict__ O12, int hh, int q0, int klat0, int nlat, int kctx0, LAS unsigned char* lds) {
  const int tid = mk::otid(), wid = tid >> 6, lane = tid & 63, r = lane & 31, hi = lane >> 5;
  const int NT = (nlat + L) / 64, NTL = nlat / 64;
  constexpr float C = 0.125f * 1.4426950408889634f;
  const int srow = tid >> 3, sch = tid & 7;
  const bf16_t* kbase = Pqk + 1024 + hh * 64 + sch * 8;
  const bf16_t* vbase = Vt + (size_t)((hh >> 1) * 128 + srow) * NTOK + sch * 8;
  const int kdst = swz(srow, sch), vdst0 = swz(srow, sch), vdst1 = swz(srow + 64, sch);
  bf16x8 qf[4];
  { const bf16_t* qp = Pqk + (size_t)(q0 + wid * 32 + r) * 2048 + hh * 64 + hi * 8;
#pragma unroll
    for (int ks = 0; ks < 4; ++ks) qf[ks] = *(const bf16x8*)(qp + ks * 16); }
  int kaddr[2];
#pragma unroll
  for (int kb = 0; kb < 2; ++kb) kaddr[kb] = (kb * 32 + pi32(r)) * 128;
  const int kx = (pi32(r) >> 1) & 7;
  const int vx = (r >> 1) & 7;
  f32x16 o[4];
#pragma unroll
  for (int vb = 0; vb < 4; ++vb)
#pragma unroll
    for (int i = 0; i < 16; ++i) o[vb][i] = 0.f;
  float m_run = -1e30f, l_run = 0.f;
  u32x4 kreg, vreg0, vreg1;
#define DA_LOAD(t) do { const int tok = (t) < NTL ? klat0 + (t) * 64 : kctx0 + ((t) - NTL) * 64; \
    kreg = *(const u32x4*)(kbase + (size_t)(tok + srow) * 2048); vreg0 = *(const u32x4*)(vbase + tok); vreg1 = *(const u32x4*)(vbase + (size_t)64 * NTOK + tok); } while (0)
#define DA_WRITE(bufi) do { LAS unsigned char* kb_ = lds + (bufi) * KB_BYTES; LAS unsigned char* vb_ = lds + 2 * KB_BYTES + (bufi) * VB_BYTES; \
    *(LAS u32x4*)(kb_ + kdst) = kreg; *(LAS u32x4*)(vb_ + vdst0) = vreg0; *(LAS u32x4*)(vb_ + vdst1) = vreg1; } while (0)
  DA_LOAD(0); DA_WRITE(0); __syncthreads();
  for (int t = 0; t < NT; ++t) {
    const bool more = t + 1 < NT;
    if (more) DA_LOAD(t + 1);
    const LAS unsigned char* kb_ = lds + (t & 1) * KB_BYTES; const LAS unsigned char* vb_ = lds + 2 * KB_BYTES + (t & 1) * VB_BYTES;
    f32x16 s0, s1;
#pragma unroll
    for (int i = 0; i < 16; ++i) { s0[i] = 0.f; s1[i] = 0.f; }
#pragma unroll
    for (int ks = 0; ks < 4; ++ks) {
      const int ch = ((ks * 2 + hi) ^ kx) << 4;
      const bf16x8 a0 = *(const LAS bf16x8*)(kb_ + kaddr[0] + ch), a1 = *(const LAS bf16x8*)(kb_ + kaddr[1] + ch);
      s0 = __builtin_amdgcn_mfma_f32_32x32x16_bf16(a0, qf[ks], s0, 0, 0, 0);
      s1 = __builtin_amdgcn_mfma_f32_32x32x16_bf16(a1, qf[ks], s1, 0, 0, 0);
    }
    float mx = s0[0];
#pragma unroll
    for (int i = 1; i < 16; ++i) mx = fmaxf(mx, s0[i]);
#pragma unroll
    for (int i = 0; i < 16; ++i) mx = fmaxf(mx, s1[i]);
    mx = fmaxf(mx, __shfl_xor(mx, 32));
    const float m_new = fmaxf(m_run, mx);
    const float alpha = __builtin_amdgcn_exp2f((m_run - m_new) * C);
    m_run = m_new;
    const float mc = -m_new * C;
    float ps = 0.f;
#pragma unroll
    for (int i = 0; i < 16; ++i) { s0[i] = __builtin_amdgcn_exp2f(fmaf(s0[i], C, mc)); ps += s0[i]; }
#pragma unroll
    for (int i = 0; i < 16; ++i) { s1[i] = __builtin_amdgcn_exp2f(fmaf(s1[i], C, mc)); ps += s1[i]; }
    l_run = l_run * alpha + ps;
    if (__any(alpha < 1.0f)) {
#pragma unroll
      for (int vb = 0; vb < 4; ++vb)
#pragma unroll
        for (int i = 0; i < 16; ++i) o[vb][i] *= alpha;
    }
    bf16x8 pf[2][2];
#pragma unroll
    for (int s = 0; s < 2; ++s) {
      u32x4 w0, w1;
      w0.x = cvt_pk_bf16(s0[8 * s + 0], s0[8 * s + 1]); w0.y = cvt_pk_bf16(s0[8 * s + 2], s0[8 * s + 3]); w0.z = cvt_pk_bf16(s0[8 * s + 4], s0[8 * s + 5]); w0.w = cvt_pk_bf16(s0[8 * s + 6], s0[8 * s + 7]);
      w1.x = cvt_pk_bf16(s1[8 * s + 0], s1[8 * s + 1]); w1.y = cvt_pk_bf16(s1[8 * s + 2], s1[8 * s + 3]); w1.z = cvt_pk_bf16(s1[8 * s + 4], s1[8 * s + 5]); w1.w = cvt_pk_bf16(s1[8 * s + 6], s1[8 * s + 7]);
      pf[0][s] = __builtin_bit_cast(bf16x8, w0); pf[1][s] = __builtin_bit_cast(bf16x8, w1);
    }
#pragma unroll
    for (int vb = 0; vb < 4; ++vb) {
      const LAS unsigned char* vrow = vb_ + (vb * 32 + r) * 128;
#pragma unroll
      for (int kb = 0; kb < 2; ++kb)
#pragma unroll
        for (int s = 0; s < 2; ++s) {
          const bf16x8 a = *(const LAS bf16x8*)(vrow + (((kb * 4 + 2 * s + hi) ^ vx) << 4));
          o[vb] = __builtin_amdgcn_mfma_f32_32x32x16_bf16(a, pf[kb][s], o[vb], 0, 0, 0);
        }
    }
    if (more) DA_WRITE((t + 1) & 1);
    __syncthreads();
  }
#undef DA_LOAD
#undef DA_WRITE
  const float l_tot = l_run + __shfl_xor(l_run, 32);
  const float inv = 1.0f / l_tot;
  bf16_t* op = O12 + (size_t)(q0 + wid * 32 + r) * 2048 + hh * 128 + 4 * hi;
#pragma unroll
  for (int vb = 0; vb < 4; ++vb)
#pragma unroll
    for (int g = 0; g < 4; ++g) {
      u32x2 w; w.x = cvt_pk_bf16(o[vb][4 * g] * inv, o[vb][4 * g + 1] * inv); w.y = cvt_pk_bf16(o[vb][4 * g + 2] * inv, o[vb][4 * g + 3] * inv);
      *(u32x2*)(op + vb * 32 + 8 * g) = w;
    }
}

__device__ __forceinline__ void diff_combine_row(const bf16_t* __restrict__ O12, const float* __restrict__ subln_g, float lam, float oml, bf16_t* __restrict__ O, int row, int h, int lane) {
  const unsigned a = *(const unsigned*)(O12 + (size_t)row * 2048 + (2 * h) * 128 + 2 * lane), b = *(const unsigned*)(O12 + (size_t)row * 2048 + (2 * h + 1) * 128 + 2 * lane);
  const float x0 = bflo(a) - lam * bflo(b), x1 = bfhi(a) - lam * bfhi(b);
  const float ss = wave_sum(x0 * x0 + x1 * x1);
  const float rs = rsqrtf(ss * (1.0f / 128.0f) + 1e-5f) * oml;
  *(unsigned*)(O + (size_t)row * 1024 + h * 128 + 2 * lane) = cvt_pk_bf16(x0 * rs * subln_g[2 * lane], x1 * rs * subln_g[2 * lane + 1]);
}
}

namespace natt {
using namespace mk;
using att::pi32; using att::swz;
constexpr int TB = 64 * 128;
constexpr int NA_LDS = 4 * TB + 2048;
__device__ __forceinline__ void na_attn_unit(const bf16_t* __restrict__ Pe, const bf16_t* __restrict__ Vte, const float* __restrict__ rpb_h, bf16_t* __restrict__ O, int b, int h, int rq, LAS unsigned char* lds) {
  const int tid = mk::otid(), wid = tid >> 6, lane = tid & 63, r = lane & 31, hi = lane >> 5;
  constexpr float LOG2E = 1.4426950408889634f;
  LAS float* sb = (LAS float*)(lds + 4 * TB);
  for (int i = tid; i < 465; i += NTHR) sb[i] = rpb_h[i];
  const bool is_ctx = rq < 0;
  int qrow = 0, qcol = 0, qtok, rs_q = 0, cs_q = 0, span0 = 0, wlo = 0, whi = -1, lo = 0, ntl = 0;
  if (!is_ctx) {
    const int r0 = rq * 4, ra = r0 + (wid >> 2) * 2;
    qrow = ra + (r >> 4); qcol = (wid & 3) * 16 + (r & 15); qtok = b * T + qrow * 64 + qcol;
    rs_q = min(max(qrow - 4, 0), 120); cs_q = min(max(qcol - 8, 0), 48);
    span0 = min(max((wid & 3) * 16 - 8, 0), 32);
    wlo = min(max(ra - 4, 0), 120); whi = min(max(ra - 3, 0), 120) + 7;
    lo = min(max(r0 - 4, 0), 120); const int hi_ = min(max(r0 - 1, 0), 120) + 7; ntl = hi_ - lo + 1;
  } else qtok = NLAT + b * L + wid * 32 + r;
  const int NT = ntl + 4;
  const int srow = tid >> 3, sch = tid & 7;
  const bf16_t* kbase = Pe + 512 + h * 64 + sch * 8;
  const bf16_t* vbase = Vte + (size_t)(h * 64 + srow) * NTOK + sch * 8;
  const int sdst = swz(srow, sch);
  bf16x8 qf[4];
  { const bf16_t* qp = Pe + (size_t)qtok * 1024 + h * 64 + hi * 8;
#pragma unroll
    for (int ks = 0; ks < 4; ++ks) qf[ks] = *(const bf16x8*)(qp + ks * 16); }
  const int kx = (pi32(r) >> 1) & 7, vx = (r >> 1) & 7;
  const int ka_loc = (span0 + pi32(r)) * 128; const int kx_loc = ((span0 + pi32(r)) >> 1) & 7;
  f32x16 o[2];
#pragma unroll
  for (int vb = 0; vb < 2; ++vb)
#pragma unroll
    for (int i = 0; i < 16; ++i) o[vb][i] = 0.f;
  float m_run = -1e30f, l_run = 0.f;
  u32x4 kreg, vreg;
#define NA_LOAD(t) do { const int tok = (t) < ntl ? b * T + (lo + (t)) * 64 : NLAT + b * L + ((t) - ntl) * 64; \
    kreg = *(const u32x4*)(kbase + (size_t)(tok + srow) * 1024); vreg = *(const u32x4*)(vbase + tok); } while (0)
#define NA_WRITE(bufi) do { *(LAS u32x4*)(lds + (bufi) * TB + sdst) = kreg; *(LAS u32x4*)(lds + 2 * TB + (bufi) * TB + sdst) = vreg; } while (0)
  NA_LOAD(0); NA_WRITE(0); __syncthreads();
  for (int t = 0; t < NT; ++t) {
    const bool more = t + 1 < NT;
    if (more) NA_LOAD(t + 1);
    const LAS unsigned char* kb_ = lds + (t & 1) * TB; const LAS unsigned char* vb_ = lds + 2 * TB + (t & 1) * TB;
    const bool local = t < ntl; const int kr = lo + t;
    const bool active = !local || (kr >= wlo && kr <= whi);
    if (active) {
      f32x16 s0, s1;
#pragma unroll
      for (int i = 0; i < 16; ++i) { s0[i] = 0.f; s1[i] = 0.f; }
      if (local) {
#pragma unroll
        for (int ks = 0; ks < 4; ++ks) {
          const bf16x8 a0 = *(const LAS bf16x8*)(kb_ + ka_loc + (((ks * 2 + hi) ^ kx_loc) << 4));
          s0 = __builtin_amdgcn_mfma_f32_32x32x16_bf16(a0, qf[ks], s0, 0, 0, 0);
        }
        const bool row_ok = kr >= rs_q && kr < rs_q + 8; const int dr31 = (kr - qrow + 7) * 31;
#pragma unroll
        for (int i = 0; i < 16; ++i) {
          const int kc = span0 + (i & 7) + 8 * hi + 16 * (i >> 3);
          const bool ok = row_ok && kc >= cs_q && kc < cs_q + 16;
          const int bi = ok ? dr31 + (kc - qcol + 15) : 0;
          const float bv = sb[bi];
          s0[i] = ok ? fmaf(s0[i], 0.125f, bv) : -1e30f; s1[i] = -1e30f;
        }
      } else {
#pragma unroll
        for (int ks = 0; ks < 4; ++ks) {
          const int ch = ((ks * 2 + hi) ^ kx) << 4;
          const bf16x8 a0 = *(const LAS bf16x8*)(kb_ + pi32(r) * 128 + ch), a1 = *(const LAS bf16x8*)(kb_ + (32 + pi32(r)) * 128 + ch);
          s0 = __builtin_amdgcn_mfma_f32_32x32x16_bf16(a0, qf[ks], s0, 0, 0, 0);
          s1 = __builtin_amdgcn_mfma_f32_32x32x16_bf16(a1, qf[ks], s1, 0, 0, 0);
        }
#pragma unroll
        for (int i = 0; i < 16; ++i) { s0[i] *= 0.125f; s1[i] *= 0.125f; }
      }
      float mx = s0[0];
#pragma unroll
      for (int i = 1; i < 16; ++i) mx = fmaxf(mx, s0[i]);
#pragma unroll
      for (int i = 0; i < 16; ++i) mx = fmaxf(mx, s1[i]);
      mx = fmaxf(mx, __shfl_xor(mx, 32));
      const float m_new = fmaxf(m_run, mx);
      const float alpha = __builtin_amdgcn_exp2f((m_run - m_new) * LOG2E);
      m_run = m_new;
      const float mc = -m_new * LOG2E;
      float ps = 0.f;
#pragma unroll
      for (int i = 0; i < 16; ++i) { const float p = s0[i] > -1e29f ? __builtin_amdgcn_exp2f(fmaf(s0[i], LOG2E, mc)) : 0.f; s0[i] = p; ps += p; }
#pragma unroll
      for (int i = 0; i < 16; ++i) { const float p = s1[i] > -1e29f ? __builtin_amdgcn_exp2f(fmaf(s1[i], LOG2E, mc)) : 0.f; s1[i] = p; ps += p; }
      l_run = l_run * alpha + ps;
      if (__any(alpha < 1.0f)) {
#pragma unroll
        for (int vb = 0; vb < 2; ++vb)
#pragma unroll
          for (int i = 0; i < 16; ++i) o[vb][i] *= alpha;
      }
      bf16x8 pf[2][2];
#pragma unroll
      for (int s = 0; s < 2; ++s) {
        u32x4 w0, w1;
        w0.x = cvt_pk_bf16(s0[8 * s + 0], s0[8 * s + 1]); w0.y = cvt_pk_bf16(s0[8 * s + 2], s0[8 * s + 3]); w0.z = cvt_pk_bf16(s0[8 * s + 4], s0[8 * s + 5]); w0.w = cvt_pk_bf16(s0[8 * s + 6], s0[8 * s + 7]);
        w1.x = cvt_pk_bf16(s1[8 * s + 0], s1[8 * s + 1]); w1.y = cvt_pk_bf16(s1[8 * s + 2], s1[8 * s + 3]); w1.z = cvt_pk_bf16(s1[8 * s + 4], s1[8 * s + 5]); w1.w = cvt_pk_bf16(s1[8 * s + 6], s1[8 * s + 7]);
        pf[0][s] = __builtin_bit_cast(bf16x8, w0); pf[1][s] = __builtin_bit_cast(bf16x8, w1);
      }
      const int cbase = local ? (span0 >> 3) : 0;
#pragma unroll
      for (int vb = 0; vb < 2; ++vb) {
        const LAS unsigned char* vrow = vb_ + (vb * 32 + r) * 128;
#pragma unroll
        for (int s = 0; s < 2; ++s) {
          const bf16x8 a = *(const LAS bf16x8*)(vrow + (((cbase + 2 * s + hi) ^ vx) << 4));
          o[vb] = __builtin_amdgcn_mfma_f32_32x32x16_bf16(a, pf[0][s], o[vb], 0, 0, 0);
        }
        if (!local) {
#pragma unroll
          for (int s = 0; s < 2; ++s) {
            const bf16x8 a = *(const LAS bf16x8*)(vrow + (((4 + 2 * s + hi) ^ vx) << 4));
            o[vb] = __builtin_amdgcn_mfma_f32_32x32x16_bf16(a, pf[1][s], o[vb], 0, 0, 0);
          }
        }
      }
    }
    if (more) NA_WRITE((t + 1) & 1);
    __syncthreads();
  }
#undef NA_LOAD
#undef NA_WRITE
  const float l_tot = l_run + __shfl_xor(l_run, 32);
  const float inv = 1.0f / l_tot;
  bf16_t* op = O + (size_t)qtok * 1024 + h * 64 + 4 * hi;
#pragma unroll
  for (int vb = 0; vb < 2; ++vb)
#pragma unroll
    for (int g = 0; g < 4; ++g) {
      u32x2 w; w.x = cvt_pk_bf16(o[vb][4 * g] * inv, o[vb][4 * g + 1] * inv); w.y = cvt_pk_bf16(o[vb][4 * g + 2] * inv, o[vb][4 * g + 3] * inv);
      *(u32x2*)(op + vb * 32 + 8 * g) = w;
    }
}
}

namespace rw {
using namespace mk;
constexpr int CL = 256, NCH = T / CL;
constexpr int NCHAIN = 2 * B * 8;
constexpr float LOG2E = 1.4426950408889634f;
struct Bufs {
  u32x2* SH;
  unsigned* DR;
  bf16_t* G; int gstride;
  float* CS;
  float* PQ;
  float* SST;
  bf16_t* Y;
};

__device__ __forceinline__ void prep_tile(const bf16_t* __restrict__ Prw, const float* __restrict__ cw, const float* __restrict__ w0, const float* __restrict__ w_up, const float* __restrict__ a0,
                                          const float* __restrict__ a_up, const float* __restrict__ g_up, const float* __restrict__ k_k, const float* __restrict__ k_a, const float* __restrict__ r_k,
                                          const Bufs& bf, int tile, LAS float* xs  ) {
  const int c = mk::otid(), lane = c & 63, h = c >> 6;
  const int row0 = tile * 16;
  int lo, hi;
  if (row0 < NLAT) { lo = (row0 / T) * T; hi = lo + T - 1; } else { lo = NLAT + ((row0 - NLAT) / L) * L; hi = lo + L - 1; }
  float rr[16], kv[16], vv[16];
#define RW_CONV(dst, col) do { const float c0 = cw[(col)], c1 = cw[RW_IN + (col)], c2 = cw[2 * RW_IN + (col)]; const bf16_t* p = Prw + (size_t)row0 * RW_IN + (col); \
    float pm = row0 > lo ? bf2f(p[-RW_IN]) : 0.f, pc = bf2f(p[0]); \
    _Pragma("unroll") for (int tt = 0; tt < 16; ++tt) { const float pn = (row0 + tt + 1 <= hi) ? bf2f(p[(size_t)(tt + 1) * RW_IN]) : 0.f; dst[tt] = pm * c0 + pc * c1 + pn * c2; pm = pc; pc = pn; } } while (0)
  RW_CONV(rr, c); RW_CONV(kv, 512 + c); RW_CONV(vv, 1024 + c);
  if (c < 256) {
    float xv[16]; RW_CONV(xv, 1536 + c);
#pragma unroll
    for (int tt = 0; tt < 16; ++tt) { float v = xv[tt]; if (c < 64) v = tanhf(v); else if (c >= 128) v = sigmoidf_(v); xs[c * 16 + tt] = v; }
  }
#undef RW_CONV
  __syncthreads();
  float aw0[16], aw1[16], aa0[16], aa1[16], ag[16];
#pragma unroll
  for (int tt = 0; tt < 16; ++tt) { aw0[tt] = 0.f; aw1[tt] = 0.f; aa0[tt] = 0.f; aa1[tt] = 0.f; ag[tt] = 0.f; }
#pragma unroll 2
  for (int m = 0; m < 64; ++m) {
    const float ww0 = w_up[(size_t)m * 512 + c], ww1 = w_up[(size_t)(64 + m) * 512 + c], av0 = a_up[(size_t)m * 512 + c], av1 = a_up[(size_t)(64 + m) * 512 + c];
#pragma unroll
    for (int q = 0; q < 4; ++q) {
      const f32x4 xw = *(const LAS f32x4*)(xs + m * 16 + q * 4), xa = *(const LAS f32x4*)(xs + (64 + m) * 16 + q * 4);
#pragma unroll
      for (int e = 0; e < 4; ++e) { aw0[q * 4 + e] += xw[e] * ww0; aw1[q * 4 + e] += xw[e] * ww1; aa0[q * 4 + e] += xa[e] * av0; aa1[q * 4 + e] += xa[e] * av1; }
    }
  }
#pragma unroll 2
  for (int m = 0; m < 128; ++m) {
    const float gg = g_up[(size_t)m * 512 + c];
#pragma unroll
    for (int q = 0; q < 4; ++q) { const f32x4 xg = *(const LAS f32x4*)(xs + (128 + m) * 16 + q * 4);
#pragma unroll
      for (int e = 0; e < 4; ++e) ag[q * 4 + e] += xg[e] * gg; }
  }
  const float w00 = w0[c], w01 = w0[512 + c], a00 = a0[c], a01 = a0[512 + c], kkc = k_k[c], kac = k_a[c], rkc = r_k[c];
#pragma unroll
  for (int tt = 0; tt < 16; ++tt) {
    const int row = row0 + tt;
    float kk = kv[tt] * kkc; const float nrm = sqrtf(wave_sum(kk * kk)); kk = kk / fmaxf(nrm, 1e-12f);
    u32x2 sh; sh.x = cvt_pk_bf16(rr[tt], kv[tt]); sh.y = cvt_pk_bf16(kk, vv[tt]);
    bf.SH[(size_t)row * 512 + c] = sh;
    const float rq = bflo(sh.x), kq = bfhi(sh.x);
#pragma unroll
    for (int d = 0; d < 2; ++d) {
      const float xw = (d ? w01 : w00) + (d ? aw1[tt] : aw0[tt]); const float z = -xw; const float sp = fmaxf(z, 0.f) + log1pf(__expf(-fabsf(z)));
      const float e = __expf(-sp - 0.5f);
      const float asg = sigmoidf_((d ? a01 : a00) + (d ? aa1[tt] : aa0[tt]));
      const unsigned dw = cvt_pk_bf16(e, asg);
      bf.DR[((size_t)d * NTOK + row) * 512 + c] = dw;
      const float asq = bfhi(dw);
      const float keff = kq * (1.0f + (asq - 1.0f) * kac);
      const float cb = wave_sum(rq * keff * rkc);
      if (lane == 0) bf.CS[((size_t)row * 2 + d) * 8 + h] = cb;
    }
    bf.G[(size_t)row * bf.gstride + c] = f2bf(ag[tt]);
  }
  __syncthreads();
}

struct StepRaw { u32x2 s; unsigned d; };
__device__ __forceinline__ int scan_row(int dir, int b, bool ctx, int chunk, int s) {
  if (ctx) return NLAT + b * L + (dir ? (L - 1 - s) : s);
  const int p = chunk * CL + s; return b * T + (dir ? (T - 1 - p) : p);
}
#define RW_RL(x, j) __int_as_float(__builtin_amdgcn_readlane(__float_as_int(x), (j)))
template <int MODE>
__device__ __forceinline__ void scan_unit(const Bufs& bf, const float* __restrict__ k_a, int chain, bool ctx, int chunk) {
  const int lane = mk::otid() & 63;
  const int dir = chain >> 5, b = (chain >> 3) & 3, h = chain & 7, ch = h * 64 + lane;
  const float kac = k_a[ch];
  float S[64], P[64];
  if (MODE == 0) {
#pragma unroll
    for (int j = 0; j < 64; ++j) { S[j] = 0.f; P[j] = (j == lane) ? 1.f : 0.f; }
  } else {
    if (ctx) {
#pragma unroll
      for (int j = 0; j < 64; ++j) S[j] = 0.f;
    } else {
      const float* sp = bf.SST + ((size_t)chain * NCH + chunk) * 4096 + lane * 64;
#pragma unroll
      for (int q = 0; q < 16; ++q) { const f32x4 v = *(const f32x4*)(sp + q * 4); S[q * 4] = v[0]; S[q * 4 + 1] = v[1]; S[q * 4 + 2] = v[2]; S[q * 4 + 3] = v[3]; }
    }
  }
  StepRaw nx; { const int row = scan_row(dir, b, ctx, chunk, 0); nx.s = bf.SH[(size_t)row * 512 + ch]; nx.d = bf.DR[((size_t)dir * NTOK + row) * 512 + ch]; }
  for (int s = 0; s < CL; ++s) {
    const StepRaw cu = nx; const int row = scan_row(dir, b, ctx, chunk, s);
    if (s + 1 < CL) { const int rn = scan_row(dir, b, ctx, chunk, s + 1); nx.s = bf.SH[(size_t)rn * 512 + ch]; nx.d = bf.DR[((size_t)dir * NTOK + rn) * 512 + ch]; }
    const float r = bflo(cu.s.x), k = bfhi(cu.s.x), kk = bflo(cu.s.y), v = bfhi(cu.s.y), e = bflo(cu.d), asg = bfhi(cu.d);
    const float w = __builtin_amdgcn_exp2f(-e * LOG2E), a = -kk, bb = kk * asg, keff = k * (1.0f + (asg - 1.0f) * kac);
    float sa = 0.f, sap = 0.f;
#pragma unroll
    for (int j = 0; j < 64; ++j) { const float aj = RW_RL(a, j); sa = fmaf(S[j], aj, sa); if (MODE == 0) sap = fmaf(P[j], aj, sap); }
    float y = 0.f;
#pragma unroll
    for (int j = 0; j < 64; ++j) {
      const float wj = RW_RL(w, j), bj = RW_RL(bb, j), kj = RW_RL(keff, j);
      float t = v * kj; t = fmaf(sa, bj, t); S[j] = fmaf(S[j], wj, t);
      if (MODE == 0) P[j] = fmaf(P[j], wj, sap * bj);
      else { const float rj = RW_RL(r, j); y = fmaf(S[j], rj, y); }
    }
    if (MODE == 1) bf.Y[((size_t)dir * NTOK + row) * 512 + ch] = f2bf(y);
  }
  if (MODE == 0) {
    float* pq = bf.PQ + (((size_t)chain * (NCH - 1) + chunk) * 2) * 4096 + lane * 64;
#pragma unroll
    for (int q = 0; q < 16; ++q) { *(f32x4*)(pq + q * 4) = (f32x4){P[q * 4], P[q * 4 + 1], P[q * 4 + 2], P[q * 4 + 3]}; *(f32x4*)(pq + 4096 + q * 4) = (f32x4){S[q * 4], S[q * 4 + 1], S[q * 4 + 2], S[q * 4 + 3]}; }
  } else if (ctx) {
    float* sp = bf.SST + ((size_t)chain * NCH) * 4096 + lane * 64;
#pragma unroll
    for (int q = 0; q < 16; ++q) *(f32x4*)(sp + q * 4) = (f32x4){S[q * 4], S[q * 4 + 1], S[q * 4 + 2], S[q * 4 + 3]};
  }
}

__device__ __forceinline__ void propagate_chain(const Bufs& bf, int chain, LAS float* lds) {
  LAS float* Sl = lds; LAS float* Pl = lds + 64 * 65;
  const int tid = mk::otid(), i = tid >> 3, jg = (tid & 7) * 8;
  float* sst = bf.SST + (size_t)chain * NCH * 4096;
  { const f32x4 a = *(const f32x4*)(sst + i * 64 + jg), b2 = *(const f32x4*)(sst + i * 64 + jg + 4);
    Sl[i * 65 + jg] = a[0]; Sl[i * 65 + jg + 1] = a[1]; Sl[i * 65 + jg + 2] = a[2]; Sl[i * 65 + jg + 3] = a[3]; Sl[i * 65 + jg + 4] = b2[0]; Sl[i * 65 + jg + 5] = b2[1]; Sl[i * 65 + jg + 6] = b2[2]; Sl[i * 65 + jg + 7] = b2[3]; }
  for (int c = 0; c < NCH - 1; ++c) {
    const float* pq = bf.PQ + (((size_t)chain * (NCH - 1) + c) * 2) * 4096;
    const f32x4 p0 = *(const f32x4*)(pq + i * 64 + jg), p1 = *(const f32x4*)(pq + i * 64 + jg + 4);
    f32x4 q0 = *(const f32x4*)(pq + 4096 + i * 64 + jg), q1 = *(const f32x4*)(pq + 4096 + i * 64 + jg + 4);
    *(LAS f32x4*)(Pl + i * 64 + jg) = p0; *(LAS f32x4*)(Pl + i * 64 + jg + 4) = p1;
    __syncthreads();
#pragma unroll 8
    for (int k = 0; k < 64; ++k) { const float sv = Sl[i * 65 + k]; const f32x4 a = *(const LAS f32x4*)(Pl + k * 64 + jg), b2 = *(const LAS f32x4*)(Pl + k * 64 + jg + 4); q0 += sv * a; q1 += sv * b2; }
    __syncthreads();
    Sl[i * 65 + jg] = q0[0]; Sl[i * 65 + jg + 1] = q0[1]; Sl[i * 65 + jg + 2] = q0[2]; Sl[i * 65 + jg + 3] = q0[3]; Sl[i * 65 + jg + 4] = q1[0]; Sl[i * 65 + jg + 5] = q1[1]; Sl[i * 65 + jg + 6] = q1[2]; Sl[i * 65 + jg + 7] = q1[3];
    *(f32x4*)(sst + (size_t)(c + 1) * 4096 + i * 64 + jg) = q0; *(f32x4*)(sst + (size_t)(c + 1) * 4096 + i * 64 + jg + 4) = q1;
  }
  __syncthreads();
}

__device__ __forceinline__ void finish_row(const Bufs& bf, const float* __restrict__ gn_g, const float* __restrict__ gn_b, bf16_t* __restrict__ O, int row) {
  const int c = mk::otid(), h = c >> 6;
  const float y = bf2f(bf.Y[(size_t)row * 512 + c]) + bf2f(bf.Y[((size_t)NTOK + row) * 512 + c]);
  const float mu = wave_sum(y) * (1.0f / 64.0f); const float dv = y - mu; const float var = wave_sum(dv * dv) * (1.0f / 64.0f);
  const float yn = dv * rsqrtf(var + 64e-5f) * gn_g[c] + gn_b[c];
  const float v = bfhi(bf.SH[(size_t)row * 512 + c].y);
  const float bonus = (bf.CS[(size_t)row * 16 + h] + bf.CS[(size_t)row * 16 + 8 + h]) * v;
  O[(size_t)row * 1024 + 512 + c] = f2bf((yn + bonus) * bf2f(bf.G[(size_t)row * bf.gstride + c]));
}
}

namespace mk {
constexpr size_t al256(size_t x) { return (x + 255) / 256 * 256; }
constexpr size_t WS_BAR = 0;
constexpr size_t WS_BCNT = al256(WS_BAR + (size_t)XCD_BAR_WORDS * 4);
constexpr size_t WS_MOFF = al256(WS_BCNT + 256 * 16 * 4);
constexpr size_t WS_MOD = al256(WS_MOFF + 256);
constexpr size_t WS_ROPE = al256(WS_MOD + (size_t)4 * 5 * 6144 * 4);
constexpr size_t WS_HCTX = al256(WS_ROPE + 128 * 16 * 2 * 4);
constexpr size_t WS_EID = al256(WS_HCTX + (size_t)NCTX * D * 4);
constexpr size_t WS_GATE = al256(WS_EID + (size_t)NTOK * 2 * 4);
constexpr size_t WS_POS = al256(WS_GATE + (size_t)NTOK * 2 * 4);
constexpr size_t WS_WEIN = al256(WS_POS + (size_t)NTOK * 2 * 4);
constexpr size_t WS_WOIN = al256(WS_WEIN + (size_t)2 * EVEN_IN * D * 2);
constexpr size_t WS_WEOUT = al256(WS_WOIN + (size_t)2 * ODD_IN * D * 2);
constexpr size_t WS_WOOUT = al256(WS_WEOUT + (size_t)2 * D * D * 2);
constexpr size_t WS_WGU = al256(WS_WOOUT + (size_t)2 * D * D * 2);
constexpr size_t WS_WDN = al256(WS_WGU + (size_t)NE * 1024 * D * 2);
constexpr size_t WS_UO = al256(WS_WDN + (size_t)NE * D * DE * 2);
constexpr size_t WS_SCR = al256(WS_UO + (size_t)NTOK * D * 2);
constexpr size_t SE_PQK = 0;
constexpr size_t SE_VT = al256(SE_PQK + (size_t)NTOK * 1024 * 2);
constexpr size_t SE_PRW = al256(SE_VT + (size_t)512 * NTOK * 2);
constexpr size_t SE_SH = al256(SE_PRW + (size_t)NTOK * RW_IN * 2);
constexpr size_t SE_DR = al256(SE_SH + (size_t)NTOK * 512 * 8);
constexpr size_t SE_CS = al256(SE_DR + (size_t)2 * NTOK * 512 * 4);
constexpr size_t SE_END = al256(SE_CS + (size_t)NTOK * 16 * 4);
constexpr size_t SE_PQ = 0;
constexpr size_t SE_SST = al256(SE_PQ + (size_t)rw::NCHAIN * (rw::NCH - 1) * 2 * 4096 * 4);
constexpr size_t SE_Y = al256(SE_SST + (size_t)rw::NCHAIN * rw::NCH * 4096 * 4);
constexpr size_t SE_YEND = al256(SE_Y + (size_t)2 * NTOK * 512 * 2);
static_assert(SE_YEND <= SE_SH, "scan buffers must fit below SH");
constexpr size_t SE_YBUF = 0;
constexpr size_t SO_PQK = 0;
constexpr size_t SO_VT = al256(SO_PQK + (size_t)NTOK * 2048 * 2);
constexpr size_t SO_O12 = al256(SO_VT + (size_t)1024 * NTOK * 2);
constexpr size_t SO_END = al256(SO_O12 + (size_t)NTOK * 2048 * 2);
constexpr size_t SO_YBUF = 0;
constexpr size_t SM_XS = 0;
constexpr size_t SM_HE = al256(SM_XS + (size_t)MOE_ROWS * D * 2);
constexpr size_t SM_YS = al256(SM_HE + (size_t)MOE_ROWS * DE * 2);
constexpr size_t SM_END = al256(SM_YS + (size_t)MOE_ROWS * D * 2);
constexpr size_t SCR_BYTES = SE_END > SO_END ? (SE_END > SM_END ? SE_END : SM_END) : (SO_END > SM_END ? SO_END : SM_END);
constexpr size_t WS_END = WS_SCR + SCR_BYTES;
constexpr int LDS_BARW = 131072;
constexpr int LDS_MISC = 131072 + 64;

struct Params {
  const float *x, *c, *ctx, *c_ctx, *ada_w, *ada_b, *ln_g, *ln_b, *even_w_in, *even_w_out, *shift_w, *na_rpb, *rw_w0, *rw_w_up, *rw_a0, *rw_a_up, *rw_g_up, *rw_k_k, *rw_k_a, *rw_r_k,
      *rw_gn_g, *rw_gn_b, *odd_w_in, *odd_w_out, *da_lq1, *da_lk1, *da_lq2, *da_lk2, *da_subln_g, *router_w, *router_b, *exp_w_gate, *exp_w_up, *exp_w_down;
  float* out; unsigned char* ws; int ph_lo, ph_hi;
};
template <class Tp> __device__ __forceinline__ Tp* wsp(const Params& p, size_t off) { return (Tp*)(p.ws + off); }

__device__ __forceinline__ void ada_unit(const Params& p, int u, LAS float* lds) {
  LAS float* sc = lds; LAS float* red = lds + 5 * 1024;
  const int tid = mk::otid(), l = u / 96, n = (u % 96) * 64 + (tid & 63), kp = tid >> 6;
  for (int i = tid; i < 5 * 1024; i += NTHR) { const float v = i < 4096 ? p.c[i] : p.c_ctx[i - 4096]; sc[i] = siluf_(v); }
  __syncthreads();
  float a[5] = {0.f, 0.f, 0.f, 0.f, 0.f};
  const float* w = p.ada_w + ((size_t)l * D + kp * 128) * 6144 + n;
#pragma unroll 4
  for (int k = 0; k < 128; ++k) { const float wv = w[(size_t)k * 6144]; const int kk = kp * 128 + k;
#pragma unroll
    for (int r = 0; r < 5; ++r) a[r] = fmaf(sc[r * 1024 + kk], wv, a[r]); }
#pragma unroll
  for (int r = 0; r < 5; ++r) red[(kp * 5 + r) * 64 + (tid & 63)] = a[r];
  __syncthreads();
  if (tid < 320) { const int r = tid >> 6, nn = tid & 63; float s = 0.f;
#pragma unroll
    for (int q = 0; q < 8; ++q) s += red[(q * 5 + r) * 64 + nn];
    const int col = (u % 96) * 64 + nn;
    wsp<float>(p, WS_MOD)[((size_t)l * 5 + r) * 6144 + col] = s + p.ada_b[l * 6144 + col]; }
  __syncthreads();
}
__device__ __forceinline__ void phase_prologue(const Params& p, LAS unsigned char* lds) {
  const int bid = blockIdx.x, nb = gridDim.x; LAS float* tile = (LAS float*)lds;
  int ub = 0;
  for (int i = 0; i < 2; ++i) ub += cvt_matrix(p.even_w_in + (size_t)i * D * EVEN_IN, EVEN_IN, D, EVEN_IN, wsp<bf16_t>(p, WS_WEIN) + (size_t)i * EVEN_IN * D, NMapId{0}, tile, ub, bid, nb);
  for (int i = 0; i < 2; ++i) ub += cvt_matrix(p.odd_w_in + (size_t)i * D * ODD_IN, ODD_IN, D, ODD_IN, wsp<bf16_t>(p, WS_WOIN) + (size_t)i * ODD_IN * D, NMapRope{}, tile, ub, bid, nb);
  for (int i = 0; i < 2; ++i) ub += cvt_matrix(p.even_w_out + (size_t)i * D * D, D, D, D, wsp<bf16_t>(p, WS_WEOUT) + (size_t)i * D * D, NMapId{0}, tile, ub, bid, nb);
  for (int i = 0; i < 2; ++i) ub += cvt_matrix(p.odd_w_out + (size_t)i * D * D, D, D, D, wsp<bf16_t>(p, WS_WOOUT) + (size_t)i * D * D, NMapId{0}, tile, ub, bid, nb);
  for (int u = (bid + nb - ub % nb) % nb; u < 384; u += nb) ada_unit(p, u, (LAS float*)lds);
  const int gt = bid * NTHR + mk::otid();
  if (gt < 128 * 16) { const int pos = gt >> 4, i = gt & 15; const float inv = exp2f(-(float)i * (13.287712379549449f / 16.0f)); float sn, cs; sincosf((float)pos * inv, &sn, &cs);
    wsp<float>(p, WS_ROPE)[gt * 2] = cs; wsp<float>(p, WS_ROPE)[gt * 2 + 1] = sn; }
}
__device__ __forceinline__ void cvt_experts(const Params& p, int l, LAS float* tile) {
  const int bid = blockIdx.x, nb = gridDim.x; int ub = 0;
  for (int e = 0; e < NE; ++e) {
    const size_t so = ((size_t)l * NE + e) * D * DE;
    ub += cvt_matrix(p.exp_w_gate + so, DE, D, DE, wsp<bf16_t>(p, WS_WGU) + (size_t)e * 1024 * D, NMapInterleave{0}, tile, ub, bid, nb);
    ub += cvt_matrix(p.exp_w_up + so, DE, D, DE, wsp<bf16_t>(p, WS_WGU) + (size_t)e * 1024 * D, NMapInterleave{1}, tile, ub, bid, nb);
    ub += cvt_matrix(p.exp_w_down + so, D, DE, D, wsp<bf16_t>(p, WS_WDN) + (size_t)e * D * DE, NMapId{0}, tile, ub, bid, nb);
  }
}

__device__ __forceinline__ const float* h_in_ptr(const Params& p, int l, int row) {
  if (l == 0) return row < NLAT ? p.x + (size_t)row * D : p.ctx + (size_t)(row - NLAT) * D;
  return row < NLAT ? p.out + (size_t)row * D : wsp<float>(p, WS_HCTX) + (size_t)(row - NLAT) * D;
}
__device__ __forceinline__ float* h_out_ptr(const Params& p, int row) { return row < NLAT ? p.out + (size_t)row * D : wsp<float>(p, WS_HCTX) + (size_t)(row - NLAT) * D; }
__device__ __forceinline__ void store_bf16x4(bf16_t* dst, f32x4 v) { u32x2 w; w.x = cvt_pk_bf16(v[0], v[1]); w.y = cvt_pk_bf16(v[2], v[3]); *(u32x2*)dst = w; }
__device__ __forceinline__ f32x4 load_bf16x4(const bf16_t* src) { const u32x2 w = *(const u32x2*)src; return (f32x4){bflo(w.x), bfhi(w.x), bflo(w.y), bfhi(w.y)}; }

__device__ __forceinline__ void phase_mod0(const Params& p) {
  const int lane = mk::otid() & 63, wid = mk::otid() >> 6;
  bf16_t* U = wsp<bf16_t>(p, WS_UO);
  for (int row = blockIdx.x * 8 + wid; row < NTOK; row += gridDim.x * 8) {
    const float* h = h_in_ptr(p, 0, row); const float* modl = wsp<float>(p, WS_MOD) + (size_t)bidx_of_row(row) * 6144;
#pragma unroll
    for (int q = 0; q < 4; ++q) { const int col = q * 256 + lane * 4; const f32x4 hv = *(const f32x4*)(h + col), sh = *(const f32x4*)(modl + col), sc = *(const f32x4*)(modl + 1024 + col);
      store_bf16x4(U + (size_t)row * D + col, hv * (1.0f + sc) + sh); }
  }
}
__device__ __forceinline__ void ln_row(f32x4 (&v)[4], const float* __restrict__ g, const float* __restrict__ b, int lane) {
  float s = 0.f;
#pragma unroll
  for (int q = 0; q < 4; ++q) s += (v[q][0] + v[q][1]) + (v[q][2] + v[q][3]);
  const float mu = wave_sum(s) * (1.0f / D);
  float qq = 0.f;
#pragma unroll
  for (int q = 0; q < 4; ++q) { const f32x4 d = v[q] - mu; qq += (d[0] * d[0] + d[1] * d[1]) + (d[2] * d[2] + d[3] * d[3]); }
  const float rstd = rsqrtf(wave_sum(qq) * (1.0f / D) + LN_EPS);
#pragma unroll
  for (int q = 0; q < 4; ++q) { const int col = q * 256 + lane * 4; v[q] = (v[q] - mu) * rstd * *(const f32x4*)(g + col) + *(const f32x4*)(b + col); }
}
__device__ __forceinline__ void phase_ln1(const Params& p, int l, const bf16_t* __restrict__ Ybuf, LAS unsigned char* lds) {
  const int tid = mk::otid(), lane = tid & 63, wid = tid >> 6, bid = blockIdx.x;
  const bool last = l == DEPTH - 1; const int ntok = last ? NLAT : NTOK;
  LAS float* rwl = (LAS float*)lds; LAS int* lcnt = (LAS int*)(lds + 65536);
  for (int idx = tid; idx < 16384; idx += NTHR) { const int d = idx >> 4, e = idx & 15; rwl[(((d >> 8) * 16 + e) * 64 + ((d >> 2) & 63)) * 4 + (d & 3)] = p.router_w[idx]; }
  if (tid < 16) lcnt[tid] = 0;
  __syncthreads();
  bf16_t* U2 = wsp<bf16_t>(p, WS_UO); int* eid = wsp<int>(p, WS_EID); float* gatev = wsp<float>(p, WS_GATE);
  const float* lg = p.ln_g + (size_t)(l * 2) * D; const float* lb = p.ln_b + (size_t)(l * 2) * D;
  for (int row = bid * 8 + wid; row < ntok; row += gridDim.x * 8) {
    const float* h = h_in_ptr(p, l, row); float* ho = h_out_ptr(p, row);
    const float* modl = wsp<float>(p, WS_MOD) + ((size_t)l * 5 + bidx_of_row(row)) * 6144;
    f32x4 v[4];
#pragma unroll
    for (int q = 0; q < 4; ++q) { const int col = q * 256 + lane * 4; v[q] = ALPHA * *(const f32x4*)(h + col) + *(const f32x4*)(modl + 2 * 1024 + col) * load_bf16x4(Ybuf + (size_t)row * D + col); }
    ln_row(v, lg, lb, lane);
    float acc[16];
#pragma unroll
    for (int e = 0; e < 16; ++e) acc[e] = 0.f;
#pragma unroll
    for (int q = 0; q < 4; ++q) { const int col = q * 256 + lane * 4;
      *(f32x4*)(ho + col) = v[q];
      const f32x4 u = v[q] * (1.0f + *(const f32x4*)(modl + 4 * 1024 + col)) + *(const f32x4*)(modl + 3 * 1024 + col);
      store_bf16x4(U2 + (size_t)row * D + col, u);
#pragma unroll
      for (int e = 0; e < 16; ++e) { const f32x4 w = *(const LAS f32x4*)(rwl + ((q * 16 + e) * 64 + lane) * 4); acc[e] += (u[0] * w[0] + u[1] * w[1]) + (u[2] * w[2] + u[3] * w[3]); }
    }
    float s[16], sel[16];
#pragma unroll
    for (int e = 0; e < 16; ++e) { s[e] = 1.0f / (1.0f + expf(-wave_sum(acc[e]))); sel[e] = s[e] + p.router_b[e]; }
    float best = -1e30f; int grp = 0;
#pragma unroll
    for (int gI = 0; gI < 4; ++gI) {
      const float a = sel[gI * 4], b2 = sel[gI * 4 + 1], c = sel[gI * 4 + 2], d = sel[gI * 4 + 3];
      const float lo1 = fminf(a, b2), hi1 = fmaxf(a, b2), lo2 = fminf(c, d), hi2 = fmaxf(c, d);
      const float gs = fmaxf(hi1, hi2) + fmaxf(fminf(hi1, hi2), fmaxf(lo1, lo2));
      if (gs > best) { best = gs; grp = gI; }
    }
    float v0 = 0, v1 = 0, v2 = 0, v3 = 0, s0 = 0, s1 = 0, s2 = 0, s3 = 0;
#pragma unroll
    for (int gI = 0; gI < 4; ++gI) if (gI == grp) { v0 = sel[gI * 4]; v1 = sel[gI * 4 + 1]; v2 = sel[gI * 4 + 2]; v3 = sel[gI * 4 + 3]; s0 = s[gI * 4]; s1 = s[gI * 4 + 1]; s2 = s[gI * 4 + 2]; s3 = s[gI * 4 + 3]; }
    int i1 = 0; float b1 = v0; if (v1 > b1) { b1 = v1; i1 = 1; } if (v2 > b1) { b1 = v2; i1 = 2; } if (v3 > b1) { b1 = v3; i1 = 3; }
    int i2 = -1; float bb = -1e30f;
    if (i1 != 0 && v0 > bb) { bb = v0; i2 = 0; } if (i1 != 1 && v1 > bb) { bb = v1; i2 = 1; } if (i1 != 2 && v2 > bb) { bb = v2; i2 = 2; } if (i1 != 3 && v3 > bb) { bb = v3; i2 = 3; }
    const float g1 = i1 == 0 ? s0 : i1 == 1 ? s1 : i1 == 2 ? s2 : s3; const float g2 = i2 == 0 ? s0 : i2 == 1 ? s1 : i2 == 2 ? s2 : s3;
    if (lane == 0) { const int e1 = grp * 4 + i1, e2 = grp * 4 + i2;
      eid[row * 2] = e1; eid[row * 2 + 1] = e2; gatev[row * 2] = g1 / (g1 + g2); gatev[row * 2 + 1] = g2 / (g1 + g2);
      __hip_atomic_fetch_add(lcnt + e1, 1, __ATOMIC_RELAXED, __HIP_MEMORY_SCOPE_WORKGROUP); __hip_atomic_fetch_add(lcnt + e2, 1, __ATOMIC_RELAXED, __HIP_MEMORY_SCOPE_WORKGROUP); }
  }
  __syncthreads();
  if (tid < 16) wsp<int>(p, WS_BCNT)[bid * 16 + tid] = lcnt[tid];
  __syncthreads();
  cvt_experts(p, l, (LAS float*)lds);
}
__device__ __forceinline__ void phase_scatter(const Params& p, int l, LAS unsigned char* lds) {
  const int tid = mk::otid(), lane = tid & 63, wid = tid >> 6, bid = blockIdx.x;
  const bool last = l == DEPTH - 1; const int ntok = last ? NLAT : NTOK;
  LAS int* tot = (LAS int*)lds; LAS int* pre = tot + 16; LAS int* base = tot + 32; LAS int* lcur = tot + 48;
  const int* bc = wsp<int>(p, WS_BCNT);
  if (tid < 16) { int t = 0, pr = 0; for (int b2 = 0; b2 < (int)gridDim.x; ++b2) { const int v = bc[b2 * 16 + tid]; pr += b2 < bid ? v : 0; t += v; } tot[tid] = t; pre[tid] = pr; lcur[tid] = 0; }
  __syncthreads();
  if (tid == 0) { int o = 0; int* mo = wsp<int>(p, WS_MOFF); for (int e = 0; e < 16; ++e) { base[e] = o + pre[e]; if (bid == 0) mo[e] = o; o += (tot[e] + 255) / 256 * 256; } if (bid == 0) mo[16] = o; }
  __syncthreads();
  const bf16_t* U2 = wsp<bf16_t>(p, WS_UO); bf16_t* Xs = wsp<bf16_t>(p, WS_SCR + SM_XS); const int* eid = wsp<int>(p, WS_EID); int* pos = wsp<int>(p, WS_POS);
  for (int row = bid * 8 + wid; row < ntok; row += gridDim.x * 8) {
    int p1 = 0, p2 = 0;
    if (lane == 0) { const int e1 = eid[row * 2], e2 = eid[row * 2 + 1]; p1 = base[e1] + __hip_atomic_fetch_add(lcur + e1, 1, __ATOMIC_RELAXED, __HIP_MEMORY_SCOPE_WORKGROUP); p2 = base[e2] + __hip_atomic_fetch_add(lcur + e2, 1, __ATOMIC_RELAXED, __HIP_MEMORY_SCOPE_WORKGROUP); pos[row * 2] = p1; pos[row * 2 + 1] = p2; }
    p1 = __builtin_amdgcn_readfirstlane(p1); p2 = __builtin_amdgcn_readfirstlane(p2);
    const u32x4 a = *(const u32x4*)(U2 + (size_t)row * D + lane * 8), b2 = *(const u32x4*)(U2 + (size_t)row * D + 512 + lane * 8);
    *(u32x4*)(Xs + (size_t)p1 * D + lane * 8) = a; *(u32x4*)(Xs + (size_t)p1 * D + 512 + lane * 8) = b2;
    *(u32x4*)(Xs + (size_t)p2 * D + lane * 8) = a; *(u32x4*)(Xs + (size_t)p2 * D + 512 + lane * 8) = b2;
  }
}
__device__ __forceinline__ void phase_ln2(const Params& p, int l) {
  const int lane = mk::otid() & 63, wid = mk::otid() >> 6;
  const bool last = l == DEPTH - 1; const int ntok = last ? NLAT : NTOK;
  const bf16_t* Ys = wsp<bf16_t>(p, WS_SCR + SM_YS); const int* pos = wsp<int>(p, WS_POS); const float* gatev = wsp<float>(p, WS_GATE); bf16_t* U = wsp<bf16_t>(p, WS_UO);
  const float* lg = p.ln_g + (size_t)(l * 2 + 1) * D; const float* lb = p.ln_b + (size_t)(l * 2 + 1) * D;
  for (int row = blockIdx.x * 8 + wid; row < ntok; row += gridDim.x * 8) {
    float* ho = h_out_ptr(p, row); const int bi = bidx_of_row(row);
    const float* modl = wsp<float>(p, WS_MOD) + ((size_t)l * 5 + bi) * 6144;
    const int p1 = pos[row * 2], p2 = pos[row * 2 + 1]; const float g1 = gatev[row * 2], g2 = gatev[row * 2 + 1];
    f32x4 v[4];
#pragma unroll
    for (int q = 0; q < 4; ++q) { const int col = q * 256 + lane * 4;
      const f32x4 f = g1 * load_bf16x4(Ys + (size_t)p1 * D + col) + g2 * load_bf16x4(Ys + (size_t)p2 * D + col);
      v[q] = ALPHA * *(const f32x4*)(ho + col) + *(const f32x4*)(modl + 5 * 1024 + col) * f; }
    ln_row(v, lg, lb, lane);
    const float* modn = wsp<float>(p, WS_MOD) + ((size_t)(last ? l : l + 1) * 5 + bi) * 6144;
#pragma unroll
    for (int q = 0; q < 4; ++q) { const int col = q * 256 + lane * 4; *(f32x4*)(ho + col) = v[q];
      if (!last) store_bf16x4(U + (size_t)row * D + col, v[q] * (1.0f + *(const f32x4*)(modn + 1024 + col)) + *(const f32x4*)(modn + col)); }
  }
}

struct SchedEvenIn { const bf16_t* U; const bf16_t* W; bf16_t* Pqk; bf16_t* Prw; bf16_t* Vt; int G, c;
  __device__ __forceinline__ bool next(int i, pg8::Unit& u) const { const int Lx = i * G + c; u.kind = 0;
    if (Lx < 1452) { const int grp = Lx / 44, rem = Lx % 44, pm = grp * 4 + (rem & 3), pi = rem >> 2; u.pm = pm; u.pn = pi;
      u.A = (const char*)(U + (size_t)pm * 256 * D); const int brow = pi < 4 ? pi * 256 : 1536 + (pi - 4) * 256; u.Bt = (const char*)(W + (size_t)brow * D);
      if (pi < 4) { u.out = Pqk; u.ldo = 1024; u.x1 = pi * 256; } else { u.out = Prw; u.ldo = RW_IN; u.x1 = (pi - 4) * 256; } u.x0 = pm * 256; return true; }
    if (Lx < 1452 + 264) { const int v = Lx - 1452, pmv = v & 1, pnv = v >> 1; u.pm = pmv; u.pn = pnv; u.A = (const char*)(W + (size_t)(1024 + pmv * 256) * D); u.Bt = (const char*)(U + (size_t)pnv * 256 * D);
      u.out = Vt; u.ldo = NTOK; u.x0 = pmv * 256; u.x1 = pnv * 256; return true; }
    return false; } };
struct SchedOddIn { const bf16_t* U; const bf16_t* W; bf16_t* Pqk; bf16_t* Vt; int G, c;
  __device__ __forceinline__ bool next(int i, pg8::Unit& u) const { const int Lx = i * G + c;
    if (Lx < 1056) { const int grp = Lx / 32, rem = Lx % 32, pm = grp * 4 + (rem & 3), pi = rem >> 2; u.pm = pm; u.pn = pi; u.kind = pm < 128 ? 1 : 0;
      u.A = (const char*)(U + (size_t)pm * 256 * D); u.Bt = (const char*)(W + (size_t)pi * 256 * D); u.out = Pqk; u.ldo = 2048; u.x0 = pm * 256; u.x1 = pi * 256; return true; }
    if (Lx < 1056 + 528) { const int v = Lx - 1056, pmv = v & 3, pnv = v >> 2; u.pm = pmv; u.pn = pnv; u.kind = 0; u.A = (const char*)(W + (size_t)(2048 + pmv * 256) * D); u.Bt = (const char*)(U + (size_t)pnv * 256 * D);
      u.out = Vt; u.ldo = NTOK; u.x0 = pmv * 256; u.x1 = pnv * 256; return true; }
    return false; } };
struct SchedOut { const bf16_t* O; const bf16_t* W; bf16_t* Y; int G, c;
  __device__ __forceinline__ bool next(int i, pg8::Unit& u) const { const int Lx = i * G + c; if (Lx >= 528) return false; const int pm = (Lx / 16) * 4 + (Lx & 3), pn = (Lx & 15) >> 2; u.pm = pm; u.pn = pn; u.kind = 0;
    u.A = (const char*)(O + (size_t)pm * 256 * D); u.Bt = (const char*)(W + (size_t)pn * 256 * D); u.out = Y; u.ldo = 1024; u.x0 = pm * 256; u.x1 = pn * 256; return true; } };
struct SchedMoe { const bf16_t* A; const bf16_t* W; bf16_t* out; const LAS int* moff; int Kd, ldo, ncol, G, c;
  __device__ __forceinline__ bool next(int i, pg8::Unit& u) const { const int Lx = i * G + c; const int ntile = moff[16] >> 8; if (Lx >= ntile * 4) return false;
    const int pm = Lx >> 2, pn = Lx & 3; int e = 0;
#pragma unroll
    for (int j = 1; j < 16; ++j) e += (pm * 256 >= moff[j]) ? 1 : 0;
    u.pm = pm; u.pn = pn; u.kind = 0; u.A = (const char*)(A + (size_t)pm * 256 * Kd); u.Bt = (const char*)(W + ((size_t)e * 1024 + pn * 256) * Kd); u.out = out; u.ldo = ldo; u.x0 = pm * 256; u.x1 = pn * ncol; return true; } };

struct EpiOddIn {
  static constexpr bool PERM = true; const float* rope;
  __device__ __forceinline__ void operator()(const f32x4 (&acc)[2][2][4][2], const pg8::Unit& u, int wr, int wc, int fr, int fq) const {
    if (u.kind == 0) { pg8::EpiStoreBf16{}(acc, u, wr, wc, fr, fq); return; }
    const int row0 = u.x0 + wr * 64 + fr, col0 = u.x1 + wc * 32 + 8 * fq; const int half = wc & 1;
#pragma unroll
    for (int ai = 0; ai < 2; ++ai)
#pragma unroll
      for (int m = 0; m < 4; ++m) { const int row = row0 + ai * 128 + m * 16; const int t = row & (T - 1); const int pos = half ? (t & 63) : (t >> 6);
        const f32x4 cs0 = *(const f32x4*)(rope + (pos * 16 + 4 * fq) * 2), cs1 = *(const f32x4*)(rope + (pos * 16 + 4 * fq + 2) * 2);
        bf16_t* rowp = u.out + (size_t)row * u.ldo + col0;
#pragma unroll
        for (int bj = 0; bj < 2; ++bj) { const f32x4 v0 = acc[ai][bj][m][0], v1 = acc[ai][bj][m][1];
          u32x4 w; w.x = cvt_pk_bf16(v0[0] * cs0[0] - v0[1] * cs0[1], v0[0] * cs0[1] + v0[1] * cs0[0]); w.y = cvt_pk_bf16(v0[2] * cs0[2] - v0[3] * cs0[3], v0[2] * cs0[3] + v0[3] * cs0[2]);
          w.z = cvt_pk_bf16(v1[0] * cs1[0] - v1[1] * cs1[1], v1[0] * cs1[1] + v1[1] * cs1[0]); w.w = cvt_pk_bf16(v1[2] * cs1[2] - v1[3] * cs1[3], v1[2] * cs1[3] + v1[3] * cs1[2]);
          *(u32x4*)(rowp + bj * 128) = w; } }
  }
};
struct EpiGateUp {
  static constexpr bool PERM = true;
  __device__ __forceinline__ void operator()(const f32x4 (&acc)[2][2][4][2], const pg8::Unit& u, int wr, int wc, int fr, int fq) const {
    const int row0 = u.x0 + wr * 64 + fr, col0 = u.x1 + wc * 16 + 4 * fq;
#pragma unroll
    for (int ai = 0; ai < 2; ++ai)
#pragma unroll
      for (int m = 0; m < 4; ++m) { bf16_t* rowp = u.out + (size_t)(row0 + ai * 128 + m * 16) * u.ldo + col0;
#pragma unroll
        for (int bj = 0; bj < 2; ++bj) { const f32x4 v0 = acc[ai][bj][m][0], v1 = acc[ai][bj][m][1];
          u32x2 w; w.x = cvt_pk_bf16(siluf_(v0[0]) * v0[1], siluf_(v0[2]) * v0[3]); w.y = cvt_pk_bf16(siluf_(v1[0]) * v1[1], siluf_(v1[2]) * v1[3]);
          *(u32x2*)(rowp + bj * 64) = w; } }
  }
};
}

namespace mk {
constexpr int N_PHASES = 2 + 2 * (13 + 9);
__global__ void __launch_bounds__(NTHR, 2) mega(Params p) {
  extern __shared__ __attribute__((aligned(16))) unsigned char shm[];
  LAS unsigned char* lds = (LAS unsigned char*)shm;
  const int tid = mk::otid(), wid = tid >> 6, bid = blockIdx.x, nb = gridDim.x;
  if (tid == 0) *(LAS u32x4*)(lds + LDS_BARW) = (u32x4){0u, 0u, 0u, 0u};
  __syncthreads();
  XcdBarrier bar = xcd_barrier_post(wsp<unsigned>(p, WS_BAR), (volatile LAS unsigned*)(lds + LDS_BARW));
  int ph = 0;
#ifndef MK_MASK
#define MK_MASK 0xFFFFFFFFu
#endif
#define PHASE_BEGIN_K(k) if ((((MK_MASK) >> (k)) & 1u) && ph >= p.ph_lo && ph < p.ph_hi) {
#define PHASE_END   if (ph + 1 < p.ph_hi) xcd_barrier(bar); } ++ph;
  bf16_t* UO = wsp<bf16_t>(p, WS_UO);
  unsigned char* scr = p.ws + WS_SCR;
  PHASE_BEGIN_K(0) phase_prologue(p, lds); PHASE_END
  PHASE_BEGIN_K(1) phase_mod0(p); PHASE_END
  for (int lp = 0; lp < 2; ++lp) {
    {
      const int l = 2 * lp;
      bf16_t* Pqk = (bf16_t*)(scr + SE_PQK); bf16_t* Vt = (bf16_t*)(scr + SE_VT); bf16_t* Prw = (bf16_t*)(scr + SE_PRW); bf16_t* Ybuf = (bf16_t*)(scr + SE_YBUF);
      rw::Bufs bf; bf.SH = (u32x2*)(scr + SE_SH); bf.DR = (unsigned*)(scr + SE_DR); bf.G = UO + 512; bf.gstride = 1024; bf.CS = (float*)(scr + SE_CS); bf.PQ = (float*)(scr + SE_PQ); bf.SST = (float*)(scr + SE_SST); bf.Y = (bf16_t*)(scr + SE_Y);
      PHASE_BEGIN_K(2) { SchedEvenIn S{UO, wsp<bf16_t>(p, WS_WEIN) + (size_t)lp * EVEN_IN * D, Pqk, Prw, Vt, nb, bid}; pg8::gemm_phase(lds, D, S, pg8::EpiStoreBf16{}); } PHASE_END
      PHASE_BEGIN_K(3) for (int u = bid; u < 1024 + 32; u += nb) { int b, h, rq; if (u < 1024) { b = u >> 8; h = (u >> 5) & 7; rq = u & 31; } else { const int v = u - 1024; b = v >> 3; h = v & 7; rq = -1; }
        natt::na_attn_unit(Pqk, Vt, p.na_rpb + ((size_t)lp * 8 + h) * 465, UO, b, h, rq, lds); } PHASE_END
      PHASE_BEGIN_K(4) for (int t = bid; t < NTOK / 16; t += nb) rw::prep_tile(Prw, p.shift_w + (size_t)lp * 3 * RW_IN, p.rw_w0 + lp * 1024, p.rw_w_up + (size_t)lp * 2 * 64 * 512, p.rw_a0 + lp * 1024,
            p.rw_a_up + (size_t)lp * 2 * 64 * 512, p.rw_g_up + (size_t)lp * 128 * 512, p.rw_k_k + lp * 512, p.rw_k_a + lp * 512, p.rw_r_k + lp * 512, bf, t, (LAS float*)lds); PHASE_END
      PHASE_BEGIN_K(5) for (int u = bid * 8 + wid; u < rw::NCHAIN * rw::NCH; u += nb * 8) {
        if (u < rw::NCHAIN * (rw::NCH - 1)) rw::scan_unit<0>(bf, p.rw_k_a + lp * 512, u / (rw::NCH - 1), false, u % (rw::NCH - 1));
        else rw::scan_unit<1>(bf, p.rw_k_a + lp * 512, u - rw::NCHAIN * (rw::NCH - 1), true, 0); } PHASE_END
      PHASE_BEGIN_K(6) for (int c = bid; c < rw::NCHAIN; c += nb) rw::propagate_chain(bf, c, (LAS float*)lds); PHASE_END
      PHASE_BEGIN_K(7) for (int u = bid * 8 + wid; u < rw::NCHAIN * rw::NCH; u += nb * 8) rw::scan_unit<1>(bf, p.rw_k_a + lp * 512, u / rw::NCH, false, u % rw::NCH); PHASE_END
      PHASE_BEGIN_K(8) for (int r = bid; r < NTOK; r += nb) rw::finish_row(bf, p.rw_gn_g + lp * 512, p.rw_gn_b + lp * 512, UO, r); PHASE_END
      PHASE_BEGIN_K(9) { SchedOut S{UO, wsp<bf16_t>(p, WS_WEOUT) + (size_t)lp * D * D, Ybuf, nb, bid}; pg8::gemm_phase(lds, D, S, pg8::EpiStoreBf16{}); } PHASE_END
      PHASE_BEGIN_K(10) phase_ln1(p, l, Ybuf, lds); PHASE_END
      PHASE_BEGIN_K(11) phase_scatter(p, l, lds); PHASE_END
      PHASE_BEGIN_K(12) { LAS int* mo = (LAS int*)(lds + LDS_MISC); if (tid < 17) mo[tid] = wsp<int>(p, WS_MOFF)[tid]; __syncthreads();
        SchedMoe S{(bf16_t*)(scr + SM_XS), wsp<bf16_t>(p, WS_WGU), (bf16_t*)(scr + SM_HE), mo, D, DE, 128, nb, bid}; pg8::gemm_phase(lds, D, S, EpiGateUp{}); } PHASE_END
      PHASE_BEGIN_K(13) { LAS int* mo = (LAS int*)(lds + LDS_MISC); if (tid < 17) mo[tid] = wsp<int>(p, WS_MOFF)[tid]; __syncthreads();
        SchedMoe S{(bf16_t*)(scr + SM_HE), wsp<bf16_t>(p, WS_WDN), (bf16_t*)(scr + SM_YS), mo, DE, D, 256, nb, bid}; pg8::gemm_phase(lds, DE, S, pg8::EpiStoreBf16{}); } PHASE_END
      PHASE_BEGIN_K(14) phase_ln2(p, l); PHASE_END
    }
    {
      const int l = 2 * lp + 1; const bool last = l == DEPTH - 1;
      bf16_t* Pqk = (bf16_t*)(scr + SO_PQK); bf16_t* Vt = (bf16_t*)(scr + SO_VT); bf16_t* O12 = (bf16_t*)(scr + SO_O12); bf16_t* Ybuf = (bf16_t*)(scr + SO_YBUF);
      PHASE_BEGIN_K(15) { SchedOddIn S{UO, wsp<bf16_t>(p, WS_WOIN) + (size_t)lp * ODD_IN * D, Pqk, Vt, nb, bid}; pg8::gemm_phase(lds, D, S, EpiOddIn{wsp<float>(p, WS_ROPE)}); } PHASE_END
      PHASE_BEGIN_K(16) for (int u = bid; u < 2048 + (last ? 0 : 64); u += nb) { int b, hh, q0, nlat;
        if (u < 2048) { b = u >> 9; hh = (u >> 5) & 15; q0 = b * T + (u & 31) * 256; nlat = T; } else { const int v = u - 2048; b = v >> 4; hh = v & 15; q0 = NLAT + b * L; nlat = 0; }
        att::diff_attn_unit(Pqk, Vt, O12, hh, q0, b * T, nlat, NLAT + b * L, lds); } PHASE_END
      PHASE_BEGIN_K(17) { float d1 = 0.f, d2 = 0.f; for (int i = 0; i < 64; ++i) { d1 += p.da_lq1[lp * 64 + i] * p.da_lk1[lp * 64 + i]; d2 += p.da_lq2[lp * 64 + i] * p.da_lk2[lp * 64 + i]; }
        const float li = 0.8f - 0.6f * expf(-0.3f * (float)l), lam = expf(d1) - expf(d2) + li;
        for (int w = bid * 8 + wid; w < (last ? NLAT : NTOK) * 8; w += nb * 8) att::diff_combine_row(O12, p.da_subln_g + lp * 128, lam, 1.0f - li, UO, w >> 3, w & 7, tid & 63); } PHASE_END
      PHASE_BEGIN_K(18) { SchedOut S{UO, wsp<bf16_t>(p, WS_WOOUT) + (size_t)lp * D * D, Ybuf, nb, bid}; pg8::gemm_phase(lds, D, S, pg8::EpiStoreBf16{}); } PHASE_END
      PHASE_BEGIN_K(19) phase_ln1(p, l, Ybuf, lds); PHASE_END
      PHASE_BEGIN_K(20) phase_scatter(p, l, lds); PHASE_END
      PHASE_BEGIN_K(21) { LAS int* mo = (LAS int*)(lds + LDS_MISC); if (tid < 17) mo[tid] = wsp<int>(p, WS_MOFF)[tid]; __syncthreads();
        SchedMoe S{(bf16_t*)(scr + SM_XS), wsp<bf16_t>(p, WS_WGU), (bf16_t*)(scr + SM_HE), mo, D, DE, 128, nb, bid}; pg8::gemm_phase(lds, D, S, EpiGateUp{}); } PHASE_END
      PHASE_BEGIN_K(22) { LAS int* mo = (LAS int*)(lds + LDS_MISC); if (tid < 17) mo[tid] = wsp<int>(p, WS_MOFF)[tid]; __syncthreads();
        SchedMoe S{(bf16_t*)(scr + SM_HE), wsp<bf16_t>(p, WS_WDN), (bf16_t*)(scr + SM_YS), mo, DE, D, 256, nb, bid}; pg8::gemm_phase(lds, DE, S, pg8::EpiStoreBf16{}); } PHASE_END
      PHASE_BEGIN_K(23) phase_ln2(p, l); PHASE_END
    }
  }
#undef PHASE_BEGIN_K
#undef PHASE_END
}
}

#ifndef MK_SINGLE_LAUNCH
#define MK_SINGLE_LAUNCH 1
#endif
extern "C" void kernel_launch(void* const* d_in, const int* in_sizes, int n_in, void* d_out, int out_size, void* d_ws, size_t ws_size, hipStream_t stream) {
  using namespace mk;
  static int grid = 0;
  if (grid == 0) {
    if (n_in != 34 || out_size != NLAT * D || ws_size < WS_END) { fprintf(stderr, "kernel_launch: unexpected shapes (n_in %d out %d ws %zu need %zu)\n", n_in, out_size, ws_size, (size_t)WS_END); grid = -1; return; }
    if (hipFuncSetAttribute((const void*)mega, hipFuncAttributeMaxDynamicSharedMemorySize, LDS_BYTES) != hipSuccess) { grid = -1; return; }
    int dev = 0, cus = 0, per_cu = 0;
    if (hipGetDevice(&dev) != hipSuccess || hipDeviceGetAttribute(&cus, hipDeviceAttributeMultiprocessorCount, dev) != hipSuccess) { grid = -1; return; }
    if (hipOccupancyMaxActiveBlocksPerMultiprocessor(&per_cu, (const void*)mega, NTHR, LDS_BYTES) != hipSuccess || per_cu < 1) { fprintf(stderr, "kernel_launch: occupancy query says %d\n", per_cu); }
    (void)hipGetLastError();
    grid = cus;
  }
  if (grid < 0) return;
  (void)hipMemsetAsync((char*)d_ws + WS_BAR, 0, (size_t)XCD_BAR_WORDS * 4, stream);
  Params p{};
  const float** pp = (const float**)&p;
  for (int i = 0; i < 34; ++i) pp[i] = (const float*)d_in[i];
  p.out = (float*)d_out; p.ws = (unsigned char*)d_ws;
#if MK_SINGLE_LAUNCH
  p.ph_lo = 0; p.ph_hi = N_PHASES;
  hipLaunchKernelGGL(mega, dim3(grid), dim3(NTHR), LDS_BYTES, stream, p);
#else
  for (int ph = 0; ph < N_PHASES; ++ph) { p.ph_lo = ph; p.ph_hi = ph + 1; hipLaunchKernelGGL(mega, dim3(grid), dim3(NTHR), LDS_BYTES, stream, p); }
#endif
}
```

```cpp
#include <hip/hip_runtime.h>
#include <stdint.h>
#include <stdio.h>

typedef unsigned short bf16_t;
typedef short bf16x8 __attribute__((ext_vector_type(8)));
typedef float f32x4 __attribute__((ext_vector_type(4)));
typedef float f32x2 __attribute__((ext_vector_type(2)));
typedef float f32x16 __attribute__((ext_vector_type(16)));
typedef unsigned u32x4 __attribute__((ext_vector_type(4)));
typedef unsigned u32x2 __attribute__((ext_vector_type(2)));
#define LAS __attribute__((address_space(3)))

namespace mk {
constexpr int B = 4, T = 8192, L = 256, D = 1024, NLAT = B * T, NCTX = B * L, NTOK = NLAT + NCTX;
constexpr int DEPTH = 4, EVEN_IN = 3328, ODD_IN = 3072, RW_OFF = 1536, RW_IN = 1792, NE = 16, DE = 512;
constexpr float ALPHA = 1.681792830507429f, LN_EPS = 1e-5f;
constexpr int NTHR = 512, LDS_BYTES = 147456;
constexpr int MOE_TILES = 280, MOE_ROWS = MOE_TILES * 256;

__device__ __forceinline__ unsigned cvt_pk_bf16(float lo, float hi) { unsigned r; asm volatile("v_cvt_pk_bf16_f32 %0, %1, %2" : "=v"(r) : "v"(lo), "v"(hi)); return r; }
__device__ __forceinline__ float bf2f(bf16_t b) { return __uint_as_float(((unsigned)b) << 16); }
__device__ __forceinline__ float bflo(unsigned w) { return __uint_as_float(w << 16); }
__device__ __forceinline__ float bfhi(unsigned w) { return __uint_as_float(w & 0xffff0000u); }
__device__ __forceinline__ bf16_t f2bf(float f) { return (bf16_t)(cvt_pk_bf16(f, 0.f) & 0xffffu); }
__device__ __forceinline__ float sigmoidf_(float x) { return 1.0f / (1.0f + __expf(-x)); }
__device__ __forceinline__ float siluf_(float x) { return x / (1.0f + __expf(-x)); }
__device__ __forceinline__ float wave_sum(float v) {
#pragma unroll
  for (int o = 32; o > 0; o >>= 1) v += __shfl_xor(v, o);
  return v;
}
template <int CTRL, int RM, int BM> __device__ __forceinline__ float dpp_mov(float old, float v) { return __int_as_float(__builtin_amdgcn_update_dpp(__float_as_int(old), __float_as_int(v), CTRL, RM, BM, false)); }
__device__ __forceinline__ float wave_sum_u(float v) {
  v += dpp_mov<0xB1, 0xf, 0xf>(v, v);
  v += dpp_mov<0x4E, 0xf, 0xf>(v, v);
  v += dpp_mov<0x141, 0xf, 0xf>(v, v);
  v += dpp_mov<0x140, 0xf, 0xf>(v, v);
  v += dpp_mov<0x142, 0xa, 0xf>(0.f, v);
  v += dpp_mov<0x143, 0xc, 0xf>(0.f, v);
  return __int_as_float(__builtin_amdgcn_readlane(__float_as_int(v), 63));
}
__device__ __forceinline__ f32x16 zero16() { float z = 0.f; asm volatile("" : "+v"(z)); f32x16 r;
#pragma unroll
  for (int i = 0; i < 16; ++i) r[i] = z;
  return r; }
__device__ __forceinline__ int otid() { int t = threadIdx.x; asm volatile("" : "+v"(t)); return t; }
__device__ __forceinline__ int obid() { int b = blockIdx.x; asm volatile("" : "+s"(b)); return b; }
__device__ __forceinline__ int bidx_of_row(int row) { return row < NLAT ? row / T : 4; }
}

#include <vector>

#define XB_TMO      128
#define XB_XCNT(j)  (256  + 64 * (j))
#define XB_XSUB(j)  (1280 + 64 * (j))
#define XB_XGEN(j)  (2304 + 64 * (j))
#define XB_TOP      3328
#define XB_TOPGEN   3392
#define XCD_BAR_WORDS 3456
#define XB_SPIN_CAP (1u << 18)
#define LAS __attribute__((address_space(3)))

__device__ __forceinline__ unsigned xb_ld(unsigned* p)              { return __hip_atomic_load(p, __ATOMIC_RELAXED, __HIP_MEMORY_SCOPE_AGENT); }
__device__ __forceinline__ unsigned xb_add(unsigned* p, unsigned v) { return __hip_atomic_fetch_add(p, v, __ATOMIC_RELAXED, __HIP_MEMORY_SCOPE_AGENT); }
__device__ __forceinline__ unsigned xb_xcc_id() { return (unsigned)__builtin_amdgcn_s_getreg((3 << 11) | 20) & 0xFu; }
#define XB_SPIN(cond, bar) do { unsigned _sp = 0; while (cond) { __builtin_amdgcn_s_sleep(1); \
    if ((++_sp & 255u) == 0u) { if (xb_ld(&(bar)[XB_TMO])) break; if (_sp > XB_SPIN_CAP) { atomicAdd(&(bar)[XB_TMO], 1u); break; } } } } while (0)

struct XcdBarrier {
    unsigned* bar; unsigned x;
    volatile LAS unsigned* st;
};

__device__ __forceinline__ XcdBarrier xcd_barrier_post(unsigned* bar, volatile LAS unsigned* st) {
    XcdBarrier b; b.bar = bar; b.x = xb_xcc_id(); b.st = st;
    if (threadIdx.x == 0) (void)xb_add(&bar[XB_XCNT(b.x)], 1u);
    return b;
}
__device__ __forceinline__ void xcd_barrier_complete(unsigned* bar, unsigned x, unsigned& nloc, unsigned& nx) {
    const unsigned G = gridDim.x * gridDim.y * gridDim.z;
    unsigned sum, cnt, mine, sp = 0u;
    for (;;) {
        sum = 0u; cnt = 0u; mine = 0u;
#pragma unroll
        for (unsigned j = 0; j < 16; ++j) { const unsigned c = xb_ld(&bar[XB_XCNT(j)]); sum += c; cnt += (c > 0u) ? 1u : 0u; mine = (j == x) ? c : mine; }
        if (sum == G) break;
        __builtin_amdgcn_s_sleep(1);
        if ((++sp & 255u) == 0u) { if (xb_ld(&bar[XB_TMO])) break; if (sp > XB_SPIN_CAP) { atomicAdd(&bar[XB_TMO], 1u); break; } }
    }
    nloc = mine > 0u ? mine : 1u; nx = cnt > 0u ? cnt : 1u;
}

__device__ __forceinline__ void xcd_barrier(const XcdBarrier& b) {
    asm volatile("s_waitcnt vmcnt(0)" ::: "memory");
    __syncthreads();
    if (threadIdx.x == 0) {
        unsigned* bar = b.bar;
        __builtin_amdgcn_s_waitcnt(0);
        unsigned nloc = b.st[0], nx = b.st[1];
        if (nloc == 0u) { xcd_barrier_complete(bar, b.x, nloc, nx); b.st[0] = nloc; b.st[1] = nx; }
        const unsigned old = xb_add(&bar[XB_XSUB(b.x)], 1u);
        const unsigned gen = old / nloc;
        if (old + 1u == (gen + 1u) * nloc) {
            __builtin_amdgcn_fence(__ATOMIC_RELEASE, "agent");
            asm volatile("s_waitcnt vmcnt(0)" ::: "memory");
            const unsigned og = xb_add(&bar[XB_TOP], 1u);
            const unsigned tg = og / nx;
            if (og + 1u == (tg + 1u) * nx) xb_add(&bar[XB_TOPGEN], 1u);
            else XB_SPIN(xb_ld(&bar[XB_TOPGEN]) == tg, bar);
            __builtin_amdgcn_fence(__ATOMIC_ACQUIRE, "agent");
            xb_add(&bar[XB_XGEN(b.x)], 1u);
            asm volatile("s_waitcnt vmcnt(0)" ::: "memory");
        } else {
            XB_SPIN(xb_ld(&bar[XB_XGEN(b.x)]) == gen, bar);
            __builtin_amdgcn_fence(__ATOMIC_ACQUIRE, "agent");
            asm volatile("s_waitcnt vmcnt(0)" ::: "memory");
        }
    }
    __syncthreads();
}

namespace pg8 {
using mk::cvt_pk_bf16;
constexpr int BM = 256, BK = 64, HALF = 128, HTB = HALF * BK * 2  , STAGE_BYTES = 8 * HTB;
__host__ __device__ __forceinline__ int lds_byte(int r, int c) { const int st = (r >> 4) * 2 + (c >> 5), rr = r & 15, cc = c & 31, ob = rr * 64 + cc * 2; return st * 1024 + (ob ^ (((ob >> 9) & 1) << 5)); }
__host__ __device__ __forceinline__ void stage_rc(int b, int& R, int& C) { const int st = b / 1024, sb = b % 1024, swz = sb ^ (((sb >> 9) & 1) << 5); R = (st >> 1) * 16 + swz / 64; C = (st & 1) * 32 + (swz % 64) / 2; }
__host__ __device__ __forceinline__ int perm32(int rho) { const int n = rho >> 4, i = rho & 15; return 8 * (i >> 2) + 4 * n + (i & 3); }

struct Unit { const char* A; const char* Bt; bf16_t* out; int pm, pn, x0, x1, ldo, kind; };

template <class Epi, class Sched>
__device__ __forceinline__ void gemm_phase(LAS unsigned char* lds, const int K, const Sched& S, const Epi& E) {
    const int tid = mk::otid(), wid = __builtin_amdgcn_readfirstlane(tid >> 6), lane = tid & 63, wr = wid >> 2, wc = wid & 3, fr = lane & 15, fq = lane >> 4;
    const int nt = K / BK;
    unsigned voffA[2], voffB[2];
#pragma unroll
    for (int i = 0; i < 2; ++i) { int R, C; stage_rc(tid * 16 + i * 8192, R, C); const int Rb = Epi::PERM ? ((R & ~31) + perm32(R & 31)) : R;
        voffA[i] = (unsigned)(R * K + C) * 2u; voffB[i] = (unsigned)(Rb * K + C) * 2u; }
    const size_t kstep = (size_t)(BK * 2);
    const size_t hstep = (size_t)HALF * K * 2;
    const unsigned ldsw = (unsigned)wid * 1024u;
    const int aoff = lds_byte(wr * 64 + fr, fq * 8), boff = lds_byte(wc * 32 + fr, fq * 8);
#define PG8_SA(b, h) (((b) * 2 + (h)) * HTB)
#define PG8_SB(b, h) ((4 + (b) * 2 + (h)) * HTB)
#define PG8_STAGE(bufoff, gbase, voff) do { _Pragma("unroll") for (int _i = 0; _i < 2; ++_i) \
        __builtin_amdgcn_global_load_lds((const unsigned*)((const char*)(gbase) + (voff)[_i]), (LAS unsigned*)(lds + (bufoff) + ldsw + _i * 8192), 16, 0, 0); } while (0)
#define PG8_LDA(dst, b, h) do { _Pragma("unroll") for (int m = 0; m < 4; ++m) _Pragma("unroll") for (int k = 0; k < 2; ++k) dst[m][k] = *(const LAS bf16x8*)(lds + PG8_SA(b, h) + aoff + m * 2048 + k * 1024); } while (0)
#define PG8_LDB(dst, b, h) do { _Pragma("unroll") for (int n = 0; n < 2; ++n) _Pragma("unroll") for (int k = 0; k < 2; ++k) dst[n][k] = *(const LAS bf16x8*)(lds + PG8_SB(b, h) + boff + n * 2048 + k * 1024); } while (0)
#define PG8_MMA(ai, bj, At, Bt) do { __builtin_amdgcn_s_setprio(1); _Pragma("unroll") for (int m = 0; m < 4; ++m) _Pragma("unroll") for (int n = 0; n < 2; ++n) _Pragma("unroll") for (int k = 0; k < 2; ++k) \
        acc[ai][bj][m][n] = __builtin_amdgcn_mfma_f32_16x16x32_bf16(Bt[n][k], At[m][k], acc[ai][bj][m][n], 0, 0, 0); __builtin_amdgcn_s_setprio(0); } while (0)
#define PG8_WAIT_V(n) asm volatile("s_waitcnt vmcnt(" #n ")" ::: "memory")
#define PG8_WAIT_L(n) asm volatile("s_waitcnt lgkmcnt(" #n ")" ::: "memory")
#define PG8_BAR __builtin_amdgcn_s_barrier()
#define PG8_SCHED __builtin_amdgcn_sched_barrier(0)
    Unit cur, nxt; int ui = 0;
    if (!S.next(0, cur)) return;
    f32x4 acc[2][2][4][2];
#pragma unroll
    for (int a = 0; a < 2; ++a)
#pragma unroll
        for (int b = 0; b < 2; ++b)
#pragma unroll
            for (int m = 0; m < 4; ++m)
#pragma unroll
                for (int n = 0; n < 2; ++n) acc[a][b][m][n] = (f32x4){0.f, 0.f, 0.f, 0.f};
    bf16x8 At[4][2], B0[2][2], B1[2][2];
    const char* cA = cur.A; const char* cB = cur.Bt;
    PG8_STAGE(PG8_SB(0, 0), cB, voffB); PG8_STAGE(PG8_SA(0, 0), cA, voffA); PG8_STAGE(PG8_SB(0, 1), cB + hstep, voffB); PG8_STAGE(PG8_SA(0, 1), cA + hstep, voffA);
    if (wr == 1) PG8_BAR;
    PG8_WAIT_V(4); PG8_BAR;
    PG8_STAGE(PG8_SB(1, 0), cB + kstep, voffB); PG8_STAGE(PG8_SA(1, 0), cA + kstep, voffA); PG8_STAGE(PG8_SB(1, 1), cB + hstep + kstep, voffB);
    PG8_WAIT_V(6); PG8_BAR;
    for (;;) {
        const bool has_next = S.next(ui + 1, nxt);
        const char* nA = has_next ? nxt.A : cA; const char* nB = has_next ? nxt.Bt : cB;
        for (int t = 0; t < nt; t += 2) {
            const bool last = (t == nt - 2);
            const char* a1 = cA + (size_t)(t + 1) * kstep;
            const char* a2 = last ? nA : cA + (size_t)(t + 2) * kstep; const char* b2 = last ? nB : cB + (size_t)(t + 2) * kstep;
            const char* a3 = a2 + kstep; const char* b3 = b2 + kstep;
            PG8_LDB(B0, 0, 0); PG8_SCHED; PG8_LDA(At, 0, 0); PG8_STAGE(PG8_SA(1, 1), a1 + hstep, voffA);
            PG8_WAIT_L(8); PG8_BAR; PG8_WAIT_L(0); PG8_MMA(0, 0, At, B0); PG8_BAR; PG8_SCHED;
            PG8_LDB(B1, 0, 1); PG8_STAGE(PG8_SB(0, 0), b2, voffB);
            PG8_BAR; PG8_WAIT_L(0); PG8_MMA(0, 1, At, B1); PG8_BAR;
            PG8_LDA(At, 0, 1); PG8_STAGE(PG8_SA(0, 0), a2, voffA);
            PG8_BAR; PG8_WAIT_L(0); PG8_MMA(1, 0, At, B0); PG8_BAR; PG8_SCHED;
            PG8_STAGE(PG8_SB(0, 1), b2 + hstep, voffB);
            PG8_WAIT_V(6); PG8_BAR; PG8_MMA(1, 1, At, B1); PG8_BAR;
            PG8_LDB(B0, 1, 0); PG8_SCHED; PG8_LDA(At, 1, 0); PG8_STAGE(PG8_SA(0, 1), a2 + hstep, voffA);
            PG8_WAIT_L(8); PG8_BAR; PG8_WAIT_L(0); PG8_MMA(0, 0, At, B0); PG8_BAR; PG8_SCHED;
            PG8_LDB(B1, 1, 1); PG8_STAGE(PG8_SB(1, 0), b3, voffB);
            PG8_BAR; PG8_WAIT_L(0); PG8_MMA(0, 1, At, B1); PG8_BAR;
            PG8_LDA(At, 1, 1); PG8_STAGE(PG8_SA(1, 0), a3, voffA);
            PG8_BAR; PG8_WAIT_L(0); PG8_MMA(1, 0, At, B0); PG8_BAR; PG8_SCHED;
            PG8_STAGE(PG8_SB(1, 1), b3 + hstep, voffB);
            PG8_WAIT_V(6); PG8_BAR; PG8_MMA(1, 1, At, B1); PG8_BAR;
        }
        E(acc, cur, wr, wc, fr, fq);
        if (!has_next) break;
#pragma unroll
        for (int a = 0; a < 2; ++a)
#pragma unroll
            for (int b = 0; b < 2; ++b)
#pragma unroll
                for (int m = 0; m < 4; ++m)
#pragma unroll
                    for (int n = 0; n < 2; ++n) acc[a][b][m][n] = (f32x4){0.f, 0.f, 0.f, 0.f};
        cur = nxt; cA = nA; cB = nB; ++ui;
    }
    PG8_WAIT_V(0);
    if (wr == 0) PG8_BAR;
    PG8_BAR;
#undef PG8_SA
#undef PG8_SB
#undef PG8_STAGE
#undef PG8_LDA
#undef PG8_LDB
#undef PG8_MMA
#undef PG8_WAIT_V
#undef PG8_WAIT_L
#undef PG8_BAR
#undef PG8_SCHED
}

struct EpiStoreBf16 {
    static constexpr bool PERM = true;
    __device__ __forceinline__ void operator()(const f32x4 (&acc)[2][2][4][2], const Unit& u, int wr, int wc, int fr, int fq) const {
        bf16_t* O = u.out; const int ldc = u.ldo;
        const int row0 = u.x0 + wr * 64 + fr, col0 = u.x1 + wc * 32 + 8 * fq;
#pragma unroll
        for (int ai = 0; ai < 2; ++ai)
#pragma unroll
            for (int m = 0; m < 4; ++m) { bf16_t* rowp = O + (size_t)(row0 + ai * HALF + m * 16) * ldc + col0;
#pragma unroll
                for (int bj = 0; bj < 2; ++bj) { const f32x4 v0 = acc[ai][bj][m][0], v1 = acc[ai][bj][m][1];
                    u32x4 w; w.x = cvt_pk_bf16(v0[0], v0[1]); w.y = cvt_pk_bf16(v0[2], v0[3]); w.z = cvt_pk_bf16(v1[0], v1[1]); w.w = cvt_pk_bf16(v1[2], v1[3]);
                    *(u32x4*)(rowp + bj * HALF) = w; } }
    }
};
}

namespace mk {
struct NMapId { int off; __device__ __forceinline__ int operator()(int n) const { return n + off; } };
struct NMapInterleave { int which; __device__ __forceinline__ int operator()(int n) const { return 2 * n + which; } };
struct NMapRope { __device__ __forceinline__ int operator()(int n) const { if (n >= 2048) return n; const int ch = n >> 6, c = n & 63, half = c >> 5, w = c & 31, z = w >> 4, i = w & 15; return ch * 64 + half * 32 + 2 * i + z; } };

template <class NMap>
__device__ __forceinline__ void cvt_tile(const float* __restrict__ src, int ldsrc, int K, bf16_t* __restrict__ dst, int k0, int n0, const NMap& nmap, LAS float* tile) {
  const int t = mk::otid();
  { const int k = t >> 3, c = (t & 7) * 8; const float* p = src + (size_t)(k0 + k) * ldsrc + n0 + c;
    const f32x4 a = *(const f32x4*)p, b = *(const f32x4*)(p + 4);
    LAS float* q = tile + k * 65 + c; q[0] = a[0]; q[1] = a[1]; q[2] = a[2]; q[3] = a[3]; q[4] = b[0]; q[5] = b[1]; q[6] = b[2]; q[7] = b[3]; }
  __syncthreads();
  { const int n = t >> 3, kc = (t & 7) * 8; const LAS float* q = tile + kc * 65 + n;
    u32x4 w; w.x = cvt_pk_bf16(q[0], q[65]); w.y = cvt_pk_bf16(q[130], q[195]); w.z = cvt_pk_bf16(q[260], q[325]); w.w = cvt_pk_bf16(q[390], q[455]);
    *(u32x4*)(dst + (size_t)nmap(n0 + n) * K + k0 + kc) = w; }
  __syncthreads();
}
template <class NMap>
__device__ __forceinline__ int cvt_matrix(const float* src, int ldsrc, int K, int N, bf16_t* dst, const NMap& nmap, LAS float* tile, int ubase, int bid, int nblk) {
  const int nkt = K / 64, nnt = N / 64, tot = nkt * nnt;
  int first = ubase + ((bid - ubase % nblk) + nblk) % nblk;
  for (int u = first; u < ubase + tot; u += nblk) { const int v = u - ubase; cvt_tile(src, ldsrc, K, dst, (v / nnt) * 64, (v % nnt) * 64, nmap, tile); }
  return tot;
}
}

namespace att {
using namespace mk;
constexpr int KB_BYTES = 64 * 128, VB_BYTES = 128 * 128, DA_LDS = 2 * (KB_BYTES + VB_BYTES);
__device__ __forceinline__ int pi32(int r) { return (r & ~12) | ((r & 4) << 1) | ((r & 8) >> 1); }
__device__ __forceinline__ int swz(int row, int chunk) { return row * 128 + ((chunk ^ ((row >> 1) & 7)) << 4); }
__device__ __forceinline__ int crow(int r, int hi) { return (r & 3) + 8 * (r >> 2) + 4 * hi; }

__device__ __forceinline__ void diff_attn_unit(const bf16_t* __restrict__ Pqk, const bf16_t* __restrict__ Vt, bf16_t* __restrict__ O12, int hh, int q0, int klat0, int nlat, int kctx0, LAS unsigned char* lds) {
  const int tid = mk::otid(), wid = tid >> 6, lane = tid & 63, r = lane & 31, hi = lane >> 5;
  const int NT = (nlat + L) / 64, NTL = nlat / 64;
  constexpr float C = 0.125f * 1.4426950408889634f;
  constexpr float THR = 8.0f / 0.125f;
  const int srow = tid >> 3, sch = tid & 7;
  const bf16_t* kbase = Pqk + 1024 + hh * 64 + sch * 8;
  const bf16_t* vbase = Vt + (size_t)((hh >> 1) * 128 + srow) * NTOK + sch * 8;
  const int kdst = swz(srow, sch), vdst0 = swz(srow, sch), vdst1 = swz(srow + 64, sch);
  bf16x8 qf[4];
  { const bf16_t* qp = Pqk + (size_t)(q0 + wid * 32 + r) * 2048 + hh * 64 + hi * 8;
#pragma unroll
    for (int ks = 0; ks < 4; ++ks) qf[ks] = *(const bf16x8*)(qp + ks * 16); }
  int kaddr[2];
#pragma unroll
  for (int kb = 0; kb < 2; ++kb) kaddr[kb] = (kb * 32 + pi32(r)) * 128;
  const int kx = (pi32(r) >> 1) & 7;
  const int vx = (r >> 1) & 7;
  f32x16 o[4];
#pragma unroll
  for (int vb = 0; vb < 4; ++vb)
#pragma unroll
    for (int i = 0; i < 16; ++i) o[vb][i] = 0.f;
  float m_run = -1e30f, l_run = 0.f;
  u32x4 kreg, vreg0, vreg1;
#define DA_LOAD(t) do { const int tok = (t) < NTL ? klat0 + (t) * 64 : kctx0 + ((t) - NTL) * 64; \
    kreg = *(const u32x4*)(kbase + (size_t)(tok + srow) * 2048); vreg0 = *(const u32x4*)(vbase + tok); vreg1 = *(const u32x4*)(vbase + (size_t)64 * NTOK + tok); } while (0)
#define DA_WRITE(bufi) do { LAS unsigned char* kb_ = lds + (bufi) * KB_BYTES; LAS unsigned char* vb_ = lds + 2 * KB_BYTES + (bufi) * VB_BYTES; \
    *(LAS u32x4*)(kb_ + kdst) = kreg; *(LAS u32x4*)(vb_ + vdst0) = vreg0; *(LAS u32x4*)(vb_ + vdst1) = vreg1; } while (0)
  DA_LOAD(0); DA_WRITE(0); __syncthreads();
  for (int t = 0; t < NT; ++t) {
    const bool more = t + 1 < NT;
    if (more) DA_LOAD(t + 1);
    const LAS unsigned char* kb_ = lds + (t & 1) * KB_BYTES; const LAS unsigned char* vb_ = lds + 2 * KB_BYTES + (t & 1) * VB_BYTES;
    f32x16 s0, s1;
#pragma unroll
    for (int i = 0; i < 16; ++i) { s0[i] = 0.f; s1[i] = 0.f; }
#pragma unroll
    for (int ks = 0; ks < 4; ++ks) {
      const int ch = ((ks * 2 + hi) ^ kx) << 4;
      const bf16x8 a0 = *(const LAS bf16x8*)(kb_ + kaddr[0] + ch), a1 = *(const LAS bf16x8*)(kb_ + kaddr[1] + ch);
      s0 = __builtin_amdgcn_mfma_f32_32x32x16_bf16(a0, qf[ks], s0, 0, 0, 0);
      s1 = __builtin_amdgcn_mfma_f32_32x32x16_bf16(a1, qf[ks], s1, 0, 0, 0);
    }
    bf16x8 va[4][4];
#pragma unroll
    for (int vb = 0; vb < 4; ++vb) {
      const LAS unsigned char* vrow = vb_ + (vb * 32 + r) * 128;
#pragma unroll
      for (int c4 = 0; c4 < 4; ++c4) va[vb][c4] = *(const LAS bf16x8*)(vrow + (((2 * c4 + hi) ^ vx) << 4));
    }
    float mx = fmaxf(s0[0], s1[0]);
#pragma unroll
    for (int i = 1; i < 16; ++i) mx = fmaxf(mx, fmaxf(s0[i], s1[i]));
    { const u32x2 sw = __builtin_amdgcn_permlane32_swap(__float_as_uint(mx), __float_as_uint(mx), false, false); mx = fmaxf(__uint_as_float(sw.x), __uint_as_float(sw.y)); }
    float alpha = 1.0f;
    if (!__all(mx - m_run <= THR)) {
      const float m_new = fmaxf(m_run, mx);
      alpha = __builtin_amdgcn_exp2f((m_run - m_new) * C);
      m_run = m_new;
#pragma unroll
      for (int vb = 0; vb < 4; ++vb)
#pragma unroll
        for (int i = 0; i < 16; ++i) o[vb][i] *= alpha;
    }
    const float mc = -m_run * C;
    float ps = 0.f;
#pragma unroll
    for (int i = 0; i < 16; ++i) { s0[i] = __builtin_amdgcn_exp2f(fmaf(s0[i], C, mc)); ps += s0[i]; }
#pragma unroll
    for (int i = 0; i < 16; ++i) { s1[i] = __builtin_amdgcn_exp2f(fmaf(s1[i], C, mc)); ps += s1[i]; }
    l_run = l_run * alpha + ps;
    bf16x8 pf[2][2];
#pragma unroll
    for (int s = 0; s < 2; ++s) {
      u32x4 w0, w1;
      w0.x = cvt_pk_bf16(s0[8 * s + 0], s0[8 * s + 1]); w0.y = cvt_pk_bf16(s0[8 * s + 2], s0[8 * s + 3]); w0.z = cvt_pk_bf16(s0[8 * s + 4], s0[8 * s + 5]); w0.w = cvt_pk_bf16(s0[8 * s + 6], s0[8 * s + 7]);
      w1.x = cvt_pk_bf16(s1[8 * s + 0], s1[8 * s + 1]); w1.y = cvt_pk_bf16(s1[8 * s + 2], s1[8 * s + 3]); w1.z = cvt_pk_bf16(s1[8 * s + 4], s1[8 * s + 5]); w1.w = cvt_pk_bf16(s1[8 * s + 6], s1[8 * s + 7]);
      pf[0][s] = __builtin_bit_cast(bf16x8, w0); pf[1][s] = __builtin_bit_cast(bf16x8, w1);
    }
#pragma unroll
    for (int vb = 0; vb < 4; ++vb)
#pragma unroll
      for (int kb = 0; kb < 2; ++kb)
#pragma unroll
        for (int s = 0; s < 2; ++s) o[vb] = __builtin_amdgcn_mfma_f32_32x32x16_bf16(va[vb][kb * 2 + s], pf[kb][s], o[vb], 0, 0, 0);
    if (more) DA_WRITE((t + 1) & 1);
    __syncthreads();
  }
#undef DA_LOAD
#undef DA_WRITE
  float l_tot; { const u32x2 sw = __builtin_amdgcn_permlane32_swap(__float_as_uint(l_run), __float_as_uint(l_run), false, false); l_tot = __uint_as_float(sw.x) + __uint_as_float(sw.y); }
  const float inv = 1.0f / l_tot;
  bf16_t* op = O12 + (size_t)(q0 + wid * 32 + r) * 2048 + hh * 128 + 4 * hi;
#pragma unroll
  for (int vb = 0; vb < 4; ++vb)
#pragma unroll
    for (int g = 0; g < 4; ++g) {
      u32x2 w; w.x = cvt_pk_bf16(o[vb][4 * g] * inv, o[vb][4 * g + 1] * inv); w.y = cvt_pk_bf16(o[vb][4 * g + 2] * inv, o[vb][4 * g + 3] * inv);
      *(u32x2*)(op + vb * 32 + 8 * g) = w;
    }
}

__device__ __forceinline__ void diff_combine_rows4(const bf16_t* __restrict__ O12, const float* __restrict__ subln_g, float lam, float oml, bf16_t* __restrict__ O, int row0, int h, int lane) {
  unsigned a[4], b[4];
#pragma unroll
  for (int i = 0; i < 4; ++i) { a[i] = *(const unsigned*)(O12 + (size_t)(row0 + i) * 2048 + (2 * h) * 128 + 2 * lane); b[i] = *(const unsigned*)(O12 + (size_t)(row0 + i) * 2048 + (2 * h + 1) * 128 + 2 * lane); }
  const float g0 = subln_g[2 * lane], g1 = subln_g[2 * lane + 1];
#pragma unroll
  for (int i = 0; i < 4; ++i) {
    const float x0 = bflo(a[i]) - lam * bflo(b[i]), x1 = bfhi(a[i]) - lam * bfhi(b[i]);
    const float ss = wave_sum_u(x0 * x0 + x1 * x1);
    const float rs = rsqrtf(ss * (1.0f / 128.0f) + 1e-5f) * oml;
    *(unsigned*)(O + (size_t)(row0 + i) * 1024 + h * 128 + 2 * lane) = cvt_pk_bf16(x0 * rs * g0, x1 * rs * g1);
  }
}
}

namespace natt {
using namespace mk;
using att::pi32; using att::swz;
constexpr int TB = 64 * 128;
constexpr int NA_LDS = 4 * TB + 2048;
__device__ __forceinline__ void na_attn_unit(const bf16_t* __restrict__ Pe, const bf16_t* __restrict__ Vte, const float* __restrict__ rpb_h, bf16_t* __restrict__ O, int b, int h, int rq, LAS unsigned char* lds) {
  const int tid = mk::otid(), wid = tid >> 6, lane = tid & 63, r = lane & 31, hi = lane >> 5;
  constexpr float LOG2E = 1.4426950408889634f;
  LAS float* sb = (LAS float*)(lds + 4 * TB);
  for (int i = tid; i < 465; i += NTHR) sb[i] = rpb_h[i];
  const bool is_ctx = rq < 0;
  int qrow = 0, qcol = 0, qtok, rs_q = 0, cs_q = 0, span0 = 0, wlo = 0, whi = -1, lo = 0, ntl = 0;
  if (!is_ctx) {
    const int r0 = rq * 4, ra = r0 + (wid >> 2) * 2;
    qrow = ra + (r >> 4); qcol = (wid & 3) * 16 + (r & 15); qtok = b * T + qrow * 64 + qcol;
    rs_q = min(max(qrow - 4, 0), 120); cs_q = min(max(qcol - 8, 0), 48);
    span0 = min(max((wid & 3) * 16 - 8, 0), 32);
    wlo = min(max(ra - 4, 0), 120); whi = min(max(ra - 3, 0), 120) + 7;
    lo = min(max(r0 - 4, 0), 120); const int hi_ = min(max(r0 - 1, 0), 120) + 7; ntl = hi_ - lo + 1;
  } else qtok = NLAT + b * L + wid * 32 + r;
  const int NT = ntl + 4;
  const int srow = tid >> 3, sch = tid & 7;
  const bf16_t* kbase = Pe + 512 + h * 64 + sch * 8;
  const bf16_t* vbase = Vte + (size_t)(h * 64 + srow) * NTOK + sch * 8;
  const int sdst = swz(srow, sch);
  bf16x8 qf[4];
  { const bf16_t* qp = Pe + (size_t)qtok * 1024 + h * 64 + hi * 8;
#pragma unroll
    for (int ks = 0; ks < 4; ++ks) qf[ks] = *(const bf16x8*)(qp + ks * 16); }
  const int kx = (pi32(r) >> 1) & 7, vx = (r >> 1) & 7;
  const int ka_loc = (span0 + pi32(r)) * 128; const int kx_loc = ((span0 + pi32(r)) >> 1) & 7;
  f32x16 o[2];
#pragma unroll
  for (int vb = 0; vb < 2; ++vb)
#pragma unroll
    for (int i = 0; i < 16; ++i) o[vb][i] = 0.f;
  float m_run = -1e30f, l_run = 0.f;
  u32x4 kreg, vreg;
#define NA_LOAD(t) do { const int tok = (t) < ntl ? b * T + (lo + (t)) * 64 : NLAT + b * L + ((t) - ntl) * 64; \
    kreg = *(const u32x4*)(kbase + (size_t)(tok + srow) * 1024); vreg = *(const u32x4*)(vbase + tok); } while (0)
#define NA_WRITE(bufi) do { *(LAS u32x4*)(lds + (bufi) * TB + sdst) = kreg; *(LAS u32x4*)(lds + 2 * TB + (bufi) * TB + sdst) = vreg; } while (0)
  NA_LOAD(0); NA_WRITE(0); __syncthreads();
  for (int t = 0; t < NT; ++t) {
    const bool more = t + 1 < NT;
    if (more) NA_LOAD(t + 1);
    const LAS unsigned char* kb_ = lds + (t & 1) * TB; const LAS unsigned char* vb_ = lds + 2 * TB + (t & 1) * TB;
    const bool local = t < ntl; const int kr = lo + t;
    const bool active = !local || (kr >= wlo && kr <= whi);
    if (active) {
      f32x16 s0, s1;
#pragma unroll
      for (int i = 0; i < 16; ++i) { s0[i] = 0.f; s1[i] = 0.f; }
      if (local) {
#pragma unroll
        for (int ks = 0; ks < 4; ++ks) {
          const bf16x8 a0 = *(const LAS bf16x8*)(kb_ + ka_loc + (((ks * 2 + hi) ^ kx_loc) << 4));
          s0 = __builtin_amdgcn_mfma_f32_32x32x16_bf16(a0, qf[ks], s0, 0, 0, 0);
        }
        const bool row_ok = kr >= rs_q && kr < rs_q + 8; const int dr31 = (kr - qrow + 7) * 31;
#pragma unroll
        for (int i = 0; i < 16; ++i) {
          const int kc = span0 + (i & 7) + 8 * hi + 16 * (i >> 3);
          const bool ok = row_ok && kc >= cs_q && kc < cs_q + 16;
          const int bi = ok ? dr31 + (kc - qcol + 15) : 0;
          const float bv = sb[bi];
          s0[i] = ok ? fmaf(s0[i], 0.125f, bv) : -1e30f; s1[i] = -1e30f;
        }
      } else {
#pragma unroll
        for (int ks = 0; ks < 4; ++ks) {
          const int ch = ((ks * 2 + hi) ^ kx) << 4;
          const bf16x8 a0 = *(const LAS bf16x8*)(kb_ + pi32(r) * 128 + ch), a1 = *(const LAS bf16x8*)(kb_ + (32 + pi32(r)) * 128 + ch);
          s0 = __builtin_amdgcn_mfma_f32_32x32x16_bf16(a0, qf[ks], s0, 0, 0, 0);
          s1 = __builtin_amdgcn_mfma_f32_32x32x16_bf16(a1, qf[ks], s1, 0, 0, 0);
        }
#pragma unroll
        for (int i = 0; i < 16; ++i) { s0[i] *= 0.125f; s1[i] *= 0.125f; }
      }
      float mx = s0[0];
#pragma unroll
      for (int i = 1; i < 16; ++i) mx = fmaxf(mx, s0[i]);
#pragma unroll
      for (int i = 0; i < 16; ++i) mx = fmaxf(mx, s1[i]);
      { const u32x2 sw = __builtin_amdgcn_permlane32_swap(__float_as_uint(mx), __float_as_uint(mx), false, false); mx = fmaxf(__uint_as_float(sw.x), __uint_as_float(sw.y)); }
      const float m_new = fmaxf(m_run, mx);
      const float alpha = __builtin_amdgcn_exp2f((m_run - m_new) * LOG2E);
      m_run = m_new;
      const float mc = -m_new * LOG2E;
      float ps = 0.f;
#pragma unroll
      for (int i = 0; i < 16; ++i) { const float p = s0[i] > -1e29f ? __builtin_amdgcn_exp2f(fmaf(s0[i], LOG2E, mc)) : 0.f; s0[i] = p; ps += p; }
#pragma unroll
      for (int i = 0; i < 16; ++i) { const float p = s1[i] > -1e29f ? __builtin_amdgcn_exp2f(fmaf(s1[i], LOG2E, mc)) : 0.f; s1[i] = p; ps += p; }
      l_run = l_run * alpha + ps;
      if (__any(alpha < 1.0f)) {
#pragma unroll
        for (int vb = 0; vb < 2; ++vb)
#pragma unroll
          for (int i = 0; i < 16; ++i) o[vb][i] *= alpha;
      }
      bf16x8 pf[2][2];
#pragma unroll
      for (int s = 0; s < 2; ++s) {
        u32x4 w0, w1;
        w0.x = cvt_pk_bf16(s0[8 * s + 0], s0[8 * s + 1]); w0.y = cvt_pk_bf16(s0[8 * s + 2], s0[8 * s + 3]); w0.z = cvt_pk_bf16(s0[8 * s + 4], s0[8 * s + 5]); w0.w = cvt_pk_bf16(s0[8 * s + 6], s0[8 * s + 7]);
        w1.x = cvt_pk_bf16(s1[8 * s + 0], s1[8 * s + 1]); w1.y = cvt_pk_bf16(s1[8 * s + 2], s1[8 * s + 3]); w1.z = cvt_pk_bf16(s1[8 * s + 4], s1[8 * s + 5]); w1.w = cvt_pk_bf16(s1[8 * s + 6], s1[8 * s + 7]);
        pf[0][s] = __builtin_bit_cast(bf16x8, w0); pf[1][s] = __builtin_bit_cast(bf16x8, w1);
      }
      const int cbase = local ? (span0 >> 3) : 0;
#pragma unroll
      for (int vb = 0; vb < 2; ++vb) {
        const LAS unsigned char* vrow = vb_ + (vb * 32 + r) * 128;
#pragma unroll
        for (int s = 0; s < 2; ++s) {
          const bf16x8 a = *(const LAS bf16x8*)(vrow + (((cbase + 2 * s + hi) ^ vx) << 4));
          o[vb] = __builtin_amdgcn_mfma_f32_32x32x16_bf16(a, pf[0][s], o[vb], 0, 0, 0);
        }
        if (!local) {
#pragma unroll
          for (int s = 0; s < 2; ++s) {
            const bf16x8 a = *(const LAS bf16x8*)(vrow + (((4 + 2 * s + hi) ^ vx) << 4));
            o[vb] = __builtin_amdgcn_mfma_f32_32x32x16_bf16(a, pf[1][s], o[vb], 0, 0, 0);
          }
        }
      }
    }
    if (more) NA_WRITE((t + 1) & 1);
    __syncthreads();
  }
#undef NA_LOAD
#undef NA_WRITE
  float l_tot; { const u32x2 sw = __builtin_amdgcn_permlane32_swap(__float_as_uint(l_run), __float_as_uint(l_run), false, false); l_tot = __uint_as_float(sw.x) + __uint_as_float(sw.y); }
  const float inv = 1.0f / l_tot;
  bf16_t* op = O + (size_t)qtok * 1024 + h * 64 + 4 * hi;
#pragma unroll
  for (int vb = 0; vb < 2; ++vb)
#pragma unroll
    for (int g = 0; g < 4; ++g) {
      u32x2 w; w.x = cvt_pk_bf16(o[vb][4 * g] * inv, o[vb][4 * g + 1] * inv); w.y = cvt_pk_bf16(o[vb][4 * g + 2] * inv, o[vb][4 * g + 3] * inv);
      *(u32x2*)(op + vb * 32 + 8 * g) = w;
    }
}
}

namespace rw {
using namespace mk;
constexpr int CL = 256, NCH = T / CL;
constexpr int NCHAIN = 2 * B * 8;
constexpr float LOG2E = 1.4426950408889634f;
struct Bufs {
  u32x2* SH;
  unsigned* DR;
  bf16_t* G; int gstride;
  float* CS;
  float* PQ;
  float* SST;
  bf16_t* Y;
};

__device__ __forceinline__ void prep_tile(const bf16_t* __restrict__ Prw, const float* __restrict__ cw, const float* __restrict__ w0, const float* __restrict__ w_up, const float* __restrict__ a0,
                                          const float* __restrict__ a_up, const float* __restrict__ g_up, const float* __restrict__ k_k, const float* __restrict__ k_a, const float* __restrict__ r_k,
                                          const Bufs& bf, int tile, LAS float* xs  ) {
  const int c = mk::otid(), lane = c & 63, h = c >> 6;
  const int row0 = tile * 16;
  int lo, hi;
  if (row0 < NLAT) { lo = (row0 / T) * T; hi = lo + T - 1; } else { lo = NLAT + ((row0 - NLAT) / L) * L; hi = lo + L - 1; }
#define RW_CONV(dst, col) do { const float c0 = cw[(col)], c1 = cw[RW_IN + (col)], c2 = cw[2 * RW_IN + (col)]; const bf16_t* p = Prw + (size_t)row0 * RW_IN + (col); \
    float pm = row0 > lo ? bf2f(p[-RW_IN]) : 0.f, pc = bf2f(p[0]); \
    _Pragma("unroll") for (int tt = 0; tt < 16; ++tt) { const float pn = (row0 + tt + 1 <= hi) ? bf2f(p[(size_t)(tt + 1) * RW_IN]) : 0.f; dst[tt] = pm * c0 + pc * c1 + pn * c2; pm = pc; pc = pn; } } while (0)
  if (c < 256) {
    float xv[16]; RW_CONV(xv, 1536 + c);
#pragma unroll
    for (int tt = 0; tt < 16; ++tt) { float v = xv[tt]; if (c < 64) v = tanhf(v); else if (c >= 128) v = sigmoidf_(v); xs[c * 16 + tt] = v; }
  }
  __syncthreads();
  const float w00 = w0[c], w01 = w0[512 + c], a00 = a0[c], a01 = a0[512 + c], kkc = k_k[c], kac = k_a[c], rkc = r_k[c];
  float e0[16], e1[16];
  {
    float aw0[16], aw1[16];
#pragma unroll
    for (int tt = 0; tt < 16; ++tt) { aw0[tt] = 0.f; aw1[tt] = 0.f; }
    float nw0[8], nw1[8];
#pragma unroll
    for (int u = 0; u < 8; ++u) { nw0[u] = w_up[(size_t)u * 512 + c]; nw1[u] = w_up[(size_t)(64 + u) * 512 + c]; }
    for (int m0 = 0; m0 < 64; m0 += 8) {
      float ww0[8], ww1[8];
      const int mn = m0 + 8 < 64 ? m0 + 8 : m0;
#pragma unroll
      for (int u = 0; u < 8; ++u) { ww0[u] = nw0[u]; ww1[u] = nw1[u]; nw0[u] = w_up[(size_t)(mn + u) * 512 + c]; nw1[u] = w_up[(size_t)(64 + mn + u) * 512 + c]; }
#pragma unroll
      for (int u = 0; u < 8; ++u) {
#pragma unroll
        for (int q = 0; q < 4; ++q) { const f32x4 xw = *(const LAS f32x4*)(xs + (m0 + u) * 16 + q * 4);
#pragma unroll
          for (int e = 0; e < 4; ++e) { aw0[q * 4 + e] += xw[e] * ww0[u]; aw1[q * 4 + e] += xw[e] * ww1[u]; } }
      }
    }
#pragma unroll
    for (int tt = 0; tt < 16; ++tt) {
      { const float z = -(w00 + aw0[tt]); const float sp = fmaxf(z, 0.f) + log1pf(__expf(-fabsf(z))); e0[tt] = __expf(-sp - 0.5f); }
      { const float z = -(w01 + aw1[tt]); const float sp = fmaxf(z, 0.f) + log1pf(__expf(-fabsf(z))); e1[tt] = __expf(-sp - 0.5f); }
    }
  }
  LAS float* asl = xs + 256 * 16;
  {
    float aa0[16], aa1[16];
#pragma unroll
    for (int tt = 0; tt < 16; ++tt) { aa0[tt] = 0.f; aa1[tt] = 0.f; }
    float na0[8], na1[8];
#pragma unroll
    for (int u = 0; u < 8; ++u) { na0[u] = a_up[(size_t)u * 512 + c]; na1[u] = a_up[(size_t)(64 + u) * 512 + c]; }
    for (int m0 = 0; m0 < 64; m0 += 8) {
      float av0[8], av1[8];
      const int mn = m0 + 8 < 64 ? m0 + 8 : m0;
#pragma unroll
      for (int u = 0; u < 8; ++u) { av0[u] = na0[u]; av1[u] = na1[u]; na0[u] = a_up[(size_t)(mn + u) * 512 + c]; na1[u] = a_up[(size_t)(64 + mn + u) * 512 + c]; }
#pragma unroll
      for (int u = 0; u < 8; ++u) {
#pragma unroll
        for (int q = 0; q < 4; ++q) { const f32x4 xa = *(const LAS f32x4*)(xs + (64 + m0 + u) * 16 + q * 4);
#pragma unroll
          for (int e = 0; e < 4; ++e) { aa0[q * 4 + e] += xa[e] * av0[u]; aa1[q * 4 + e] += xa[e] * av1[u]; } }
      }
    }
#pragma unroll
    for (int tt = 0; tt < 16; ++tt) { const unsigned d0 = cvt_pk_bf16(e0[tt], sigmoidf_(a00 + aa0[tt])), d1 = cvt_pk_bf16(e1[tt], sigmoidf_(a01 + aa1[tt]));
      bf.DR[((size_t)(row0 + tt)) * 512 + c] = d0; bf.DR[((size_t)NTOK + row0 + tt) * 512 + c] = d1; asl[tt * 512 + c] = bfhi(d0); asl[(16 + tt) * 512 + c] = bfhi(d1); }
  }
  {
    float ag[16];
#pragma unroll
    for (int tt = 0; tt < 16; ++tt) ag[tt] = 0.f;
    float ng[16];
#pragma unroll
    for (int u = 0; u < 16; ++u) ng[u] = g_up[(size_t)u * 512 + c];
    for (int m0 = 0; m0 < 128; m0 += 16) {
      float gg[16];
      const int mn = m0 + 16 < 128 ? m0 + 16 : m0;
#pragma unroll
      for (int u = 0; u < 16; ++u) { gg[u] = ng[u]; ng[u] = g_up[(size_t)(mn + u) * 512 + c]; }
#pragma unroll
      for (int u = 0; u < 16; ++u) {
#pragma unroll
        for (int q = 0; q < 4; ++q) { const f32x4 xg = *(const LAS f32x4*)(xs + (128 + m0 + u) * 16 + q * 4);
#pragma unroll
          for (int e = 0; e < 4; ++e) ag[q * 4 + e] += xg[e] * gg[u]; }
      }
    }
#pragma unroll
    for (int tt = 0; tt < 16; ++tt) bf.G[(size_t)(row0 + tt) * bf.gstride + c] = f2bf(ag[tt]);
  }
#undef RW_CONV
  const float cr0 = cw[c], cr1 = cw[RW_IN + c], cr2 = cw[2 * RW_IN + c], ck0 = cw[512 + c], ck1 = cw[RW_IN + 512 + c], ck2 = cw[2 * RW_IN + 512 + c], cv0 = cw[1024 + c], cv1 = cw[RW_IN + 1024 + c], cv2 = cw[2 * RW_IN + 1024 + c];
  const bf16_t* pr = Prw + (size_t)row0 * RW_IN + c;
  float rm = row0 > lo ? bf2f(pr[-RW_IN]) : 0.f, km = row0 > lo ? bf2f(pr[512 - RW_IN]) : 0.f, vm = row0 > lo ? bf2f(pr[1024 - RW_IN]) : 0.f;
  float rc = bf2f(pr[0]), kc = bf2f(pr[512]), vc = bf2f(pr[1024]);
#pragma unroll 2
  for (int tt = 0; tt < 16; ++tt) {
    const int row = row0 + tt;
    const bool has_n = row + 1 <= hi; const bf16_t* pn = pr + (size_t)(tt + 1) * RW_IN;
    const float rn = has_n ? bf2f(pn[0]) : 0.f, kn = has_n ? bf2f(pn[512]) : 0.f, vn = has_n ? bf2f(pn[1024]) : 0.f;
    const float rv = rm * cr0 + rc * cr1 + rn * cr2, kvv = km * ck0 + kc * ck1 + kn * ck2, vvv = vm * cv0 + vc * cv1 + vn * cv2;
    rm = rc; rc = rn; km = kc; kc = kn; vm = vc; vc = vn;
    float kk = kvv * kkc; const float nrm = sqrtf(wave_sum_u(kk * kk)); kk = kk / fmaxf(nrm, 1e-12f);
    u32x2 sh; sh.x = cvt_pk_bf16(rv, kvv); sh.y = cvt_pk_bf16(kk, vvv);
    bf.SH[(size_t)row * 512 + c] = sh;
    const float rq = bflo(sh.x), kq = bfhi(sh.x);
    const float cb0 = wave_sum_u(rq * kq * (1.0f + (asl[tt * 512 + c] - 1.0f) * kac) * rkc), cb1 = wave_sum_u(rq * kq * (1.0f + (asl[(16 + tt) * 512 + c] - 1.0f) * kac) * rkc);
    if (lane == 0) { bf.CS[(size_t)row * 16 + h] = cb0; bf.CS[(size_t)row * 16 + 8 + h] = cb1; }
  }
  __syncthreads();
}

struct StepRaw { u32x2 s; unsigned d; };
__device__ __forceinline__ int scan_row(int dir, int b, bool ctx, int chunk, int s) {
  if (ctx) return NLAT + b * L + (dir ? (L - 1 - s) : s);
  const int p = chunk * CL + s; return b * T + (dir ? (T - 1 - p) : p);
}
#define RW_RL(x, j) __int_as_float(__builtin_amdgcn_readlane(__float_as_int(x), (j)))
template <int MODE>
__device__ __forceinline__ void scan_unit(const Bufs& bf, const float* __restrict__ k_a, int chain, bool ctx, int chunk) {
  const int lane = mk::otid() & 63;
  const int dir = chain >> 5, b = (chain >> 3) & 3, h = chain & 7, ch = h * 64 + lane;
  const float kac = k_a[ch];
  float S[64], P[64];
  if (MODE == 0) {
#pragma unroll
    for (int j = 0; j < 64; ++j) { S[j] = 0.f; P[j] = (j == lane) ? 1.f : 0.f; }
  } else {
    if (ctx) {
#pragma unroll
      for (int j = 0; j < 64; ++j) S[j] = 0.f;
    } else {
      const float* sp = bf.SST + ((size_t)chain * NCH + chunk) * 4096 + lane * 64;
#pragma unroll
      for (int q = 0; q < 16; ++q) { const f32x4 v = *(const f32x4*)(sp + q * 4); S[q * 4] = v[0]; S[q * 4 + 1] = v[1]; S[q * 4 + 2] = v[2]; S[q * 4 + 3] = v[3]; }
    }
  }
  StepRaw nx; { const int row = scan_row(dir, b, ctx, chunk, 0); nx.s = bf.SH[(size_t)row * 512 + ch]; nx.d = bf.DR[((size_t)dir * NTOK + row) * 512 + ch]; }
  for (int s = 0; s < CL; ++s) {
    const StepRaw cu = nx; const int row = scan_row(dir, b, ctx, chunk, s);
    if (s + 1 < CL) { const int rn = scan_row(dir, b, ctx, chunk, s + 1); nx.s = bf.SH[(size_t)rn * 512 + ch]; nx.d = bf.DR[((size_t)dir * NTOK + rn) * 512 + ch]; }
    const float r = bflo(cu.s.x), k = bfhi(cu.s.x), kk = bflo(cu.s.y), v = bfhi(cu.s.y), e = bflo(cu.d), asg = bfhi(cu.d);
    const float w = __builtin_amdgcn_exp2f(-e * LOG2E), a = -kk, bb = kk * asg, keff = k * (1.0f + (asg - 1.0f) * kac);
    float sa = 0.f, sap = 0.f;
#pragma unroll
    for (int j = 0; j < 64; ++j) { const float aj = RW_RL(a, j); sa = fmaf(S[j], aj, sa); if (MODE == 0) sap = fmaf(P[j], aj, sap); }
    float y = 0.f;
#pragma unroll
    for (int j = 0; j < 64; ++j) {
      const float wj = RW_RL(w, j), bj = RW_RL(bb, j), kj = RW_RL(keff, j);
      float t = v * kj; t = fmaf(sa, bj, t); S[j] = fmaf(S[j], wj, t);
      if (MODE == 0) P[j] = fmaf(P[j], wj, sap * bj);
      else { const float rj = RW_RL(r, j); y = fmaf(S[j], rj, y); }
    }
    if (MODE == 1) bf.Y[((size_t)dir * NTOK + row) * 512 + ch] = f2bf(y);
  }
  if (MODE == 0) {
    float* pq = bf.PQ + (((size_t)chain * (NCH - 1) + chunk) * 2) * 4096 + lane * 64;
#pragma unroll
    for (int q = 0; q < 16; ++q) { *(f32x4*)(pq + q * 4) = (f32x4){P[q * 4], P[q * 4 + 1], P[q * 4 + 2], P[q * 4 + 3]}; *(f32x4*)(pq + 4096 + q * 4) = (f32x4){S[q * 4], S[q * 4 + 1], S[q * 4 + 2], S[q * 4 + 3]}; }
  } else if (ctx) {
    float* sp = bf.SST + ((size_t)chain * NCH) * 4096 + lane * 64;
#pragma unroll
    for (int q = 0; q < 16; ++q) *(f32x4*)(sp + q * 4) = (f32x4){S[q * 4], S[q * 4 + 1], S[q * 4 + 2], S[q * 4 + 3]};
  }
}

__device__ __forceinline__ void propagate_chain(const Bufs& bf, int chain, LAS float* lds) {
  LAS float* Sl = lds; LAS float* Pl = lds + 64 * 65;
  const int tid = mk::otid(), i = tid >> 3, jg = (tid & 7) * 8;
  float* sst = bf.SST + (size_t)chain * NCH * 4096;
  { const f32x4 a = *(const f32x4*)(sst + i * 64 + jg), b2 = *(const f32x4*)(sst + i * 64 + jg + 4);
    Sl[i * 65 + jg] = a[0]; Sl[i * 65 + jg + 1] = a[1]; Sl[i * 65 + jg + 2] = a[2]; Sl[i * 65 + jg + 3] = a[3]; Sl[i * 65 + jg + 4] = b2[0]; Sl[i * 65 + jg + 5] = b2[1]; Sl[i * 65 + jg + 6] = b2[2]; Sl[i * 65 + jg + 7] = b2[3]; }
  for (int c = 0; c < NCH - 1; ++c) {
    const float* pq = bf.PQ + (((size_t)chain * (NCH - 1) + c) * 2) * 4096;
    const f32x4 p0 = *(const f32x4*)(pq + i * 64 + jg), p1 = *(const f32x4*)(pq + i * 64 + jg + 4);
    f32x4 q0 = *(const f32x4*)(pq + 4096 + i * 64 + jg), q1 = *(const f32x4*)(pq + 4096 + i * 64 + jg + 4);
    *(LAS f32x4*)(Pl + i * 64 + jg) = p0; *(LAS f32x4*)(Pl + i * 64 + jg + 4) = p1;
    __syncthreads();
#pragma unroll 8
    for (int k = 0; k < 64; ++k) { const float sv = Sl[i * 65 + k]; const f32x4 a = *(const LAS f32x4*)(Pl + k * 64 + jg), b2 = *(const LAS f32x4*)(Pl + k * 64 + jg + 4); q0 += sv * a; q1 += sv * b2; }
    __syncthreads();
    Sl[i * 65 + jg] = q0[0]; Sl[i * 65 + jg + 1] = q0[1]; Sl[i * 65 + jg + 2] = q0[2]; Sl[i * 65 + jg + 3] = q0[3]; Sl[i * 65 + jg + 4] = q1[0]; Sl[i * 65 + jg + 5] = q1[1]; Sl[i * 65 + jg + 6] = q1[2]; Sl[i * 65 + jg + 7] = q1[3];
    *(f32x4*)(sst + (size_t)(c + 1) * 4096 + i * 64 + jg) = q0; *(f32x4*)(sst + (size_t)(c + 1) * 4096 + i * 64 + jg + 4) = q1;
  }
  __syncthreads();
}

__device__ __forceinline__ void finish_rows4(const Bufs& bf, const float* __restrict__ gn_g, const float* __restrict__ gn_b, bf16_t* __restrict__ O, int row0) {
  const int c = mk::otid(), h = c >> 6;
  float y[4], v[4], g[4], cs[4];
#pragma unroll
  for (int i = 0; i < 4; ++i) { const int row = row0 + i;
    y[i] = bf2f(bf.Y[(size_t)row * 512 + c]) + bf2f(bf.Y[((size_t)NTOK + row) * 512 + c]);
    v[i] = bfhi(bf.SH[(size_t)row * 512 + c].y); g[i] = bf2f(bf.G[(size_t)row * bf.gstride + c]);
    cs[i] = bf.CS[(size_t)row * 16 + h] + bf.CS[(size_t)row * 16 + 8 + h]; }
  const float gg = gn_g[c], gb = gn_b[c];
  float o[4];
#pragma unroll
  for (int i = 0; i < 4; ++i) { const float mu = wave_sum_u(y[i]) * (1.0f / 64.0f); const float dv = y[i] - mu; const float var = wave_sum_u(dv * dv) * (1.0f / 64.0f);
    o[i] = (dv * rsqrtf(var + 64e-5f) * gg + gb + cs[i] * v[i]) * g[i]; }
#pragma unroll
  for (int i = 0; i < 4; ++i) O[(size_t)(row0 + i) * 1024 + 512 + c] = f2bf(o[i]);
}
}

namespace mk {
constexpr size_t al256(size_t x) { return (x + 255) / 256 * 256; }
constexpr size_t WS_BAR = 0;
constexpr size_t WS_BCNT = al256(WS_BAR + (size_t)XCD_BAR_WORDS * 4);
constexpr size_t WS_MOFF = al256(WS_BCNT + 256 * 16 * 4);
constexpr size_t WS_MOD = al256(WS_MOFF + 256);
constexpr size_t WS_ROPE = al256(WS_MOD + (size_t)4 * 5 * 6144 * 4);
constexpr size_t WS_HCTX = al256(WS_ROPE + 128 * 16 * 2 * 4);
constexpr size_t WS_EID = al256(WS_HCTX + (size_t)NCTX * D * 4);
constexpr size_t WS_GATE = al256(WS_EID + (size_t)NTOK * 2 * 4);
constexpr size_t WS_POS = al256(WS_GATE + (size_t)NTOK * 2 * 4);
constexpr size_t WS_WEIN = al256(WS_POS + (size_t)NTOK * 2 * 4);
constexpr size_t WS_WOIN = al256(WS_WEIN + (size_t)2 * EVEN_IN * D * 2);
constexpr size_t WS_WEOUT = al256(WS_WOIN + (size_t)2 * ODD_IN * D * 2);
constexpr size_t WS_WOOUT = al256(WS_WEOUT + (size_t)2 * D * D * 2);
constexpr size_t WS_WGU = al256(WS_WOOUT + (size_t)2 * D * D * 2);
constexpr size_t WS_WDN = al256(WS_WGU + (size_t)NE * 1024 * D * 2);
constexpr size_t WS_UO = al256(WS_WDN + (size_t)NE * D * DE * 2);
constexpr size_t WS_SCR = al256(WS_UO + (size_t)NTOK * D * 2);
constexpr size_t SE_PQK = 0;
constexpr size_t SE_VT = al256(SE_PQK + (size_t)NTOK * 1024 * 2);
constexpr size_t SE_PRW = al256(SE_VT + (size_t)512 * NTOK * 2);
constexpr size_t SE_SH = al256(SE_PRW + (size_t)NTOK * RW_IN * 2);
constexpr size_t SE_DR = al256(SE_SH + (size_t)NTOK * 512 * 8);
constexpr size_t SE_CS = al256(SE_DR + (size_t)2 * NTOK * 512 * 4);
constexpr size_t SE_END = al256(SE_CS + (size_t)NTOK * 16 * 4);
constexpr size_t SE_PQ = 0;
constexpr size_t SE_SST = al256(SE_PQ + (size_t)rw::NCHAIN * (rw::NCH - 1) * 2 * 4096 * 4);
constexpr size_t SE_Y = al256(SE_SST + (size_t)rw::NCHAIN * rw::NCH * 4096 * 4);
constexpr size_t SE_YEND = al256(SE_Y + (size_t)2 * NTOK * 512 * 2);
static_assert(SE_YEND <= SE_SH, "scan buffers must fit below SH");
constexpr size_t SE_YBUF = 0;
constexpr size_t SO_PQK = 0;
constexpr size_t SO_VT = al256(SO_PQK + (size_t)NTOK * 2048 * 2);
constexpr size_t SO_O12 = al256(SO_VT + (size_t)1024 * NTOK * 2);
constexpr size_t SO_END = al256(SO_O12 + (size_t)NTOK * 2048 * 2);
constexpr size_t SO_YBUF = 0;
constexpr size_t SM_XS = 0;
constexpr size_t SM_HE = al256(SM_XS + (size_t)MOE_ROWS * D * 2);
constexpr size_t SM_YS = al256(SM_HE + (size_t)MOE_ROWS * DE * 2);
constexpr size_t SM_END = al256(SM_YS + (size_t)MOE_ROWS * D * 2);
constexpr size_t SCR_BYTES = SE_END > SO_END ? (SE_END > SM_END ? SE_END : SM_END) : (SO_END > SM_END ? SO_END : SM_END);
constexpr size_t WS_END = WS_SCR + SCR_BYTES;
constexpr int LDS_BARW = 131072;
constexpr int LDS_MISC = 131072 + 64;

struct Params {
  const float *x, *c, *ctx, *c_ctx, *ada_w, *ada_b, *ln_g, *ln_b, *even_w_in, *even_w_out, *shift_w, *na_rpb, *rw_w0, *rw_w_up, *rw_a0, *rw_a_up, *rw_g_up, *rw_k_k, *rw_k_a, *rw_r_k,
      *rw_gn_g, *rw_gn_b, *odd_w_in, *odd_w_out, *da_lq1, *da_lk1, *da_lq2, *da_lk2, *da_subln_g, *router_w, *router_b, *exp_w_gate, *exp_w_up, *exp_w_down;
  float* out; unsigned char* ws; int ph_lo, ph_hi;
};
template <class Tp> __device__ __forceinline__ Tp* wsp(const Params& p, size_t off) { return (Tp*)(p.ws + off); }

__device__ __forceinline__ void ada_unit(const Params& p, int u, LAS float* lds) {
  LAS float* sc = lds; LAS float* red = lds + 5 * 1024;
  const int tid = mk::otid(), l = u / 96, n = (u % 96) * 64 + (tid & 63), kp = tid >> 6;
  for (int i = tid; i < 5 * 1024; i += NTHR) { const float v = i < 4096 ? p.c[i] : p.c_ctx[i - 4096]; sc[i] = siluf_(v); }
  __syncthreads();
  float a[5] = {0.f, 0.f, 0.f, 0.f, 0.f};
  const float* w = p.ada_w + ((size_t)l * D + kp * 128) * 6144 + n;
#pragma unroll 4
  for (int k = 0; k < 128; ++k) { const float wv = w[(size_t)k * 6144]; const int kk = kp * 128 + k;
#pragma unroll
    for (int r = 0; r < 5; ++r) a[r] = fmaf(sc[r * 1024 + kk], wv, a[r]); }
#pragma unroll
  for (int r = 0; r < 5; ++r) red[(kp * 5 + r) * 64 + (tid & 63)] = a[r];
  __syncthreads();
  if (tid < 320) { const int r = tid >> 6, nn = tid & 63; float s = 0.f;
#pragma unroll
    for (int q = 0; q < 8; ++q) s += red[(q * 5 + r) * 64 + nn];
    const int col = (u % 96) * 64 + nn;
    wsp<float>(p, WS_MOD)[((size_t)l * 5 + r) * 6144 + col] = s + p.ada_b[l * 6144 + col]; }
  __syncthreads();
}
__device__ __forceinline__ void phase_prologue(const Params& p, LAS unsigned char* lds) {
  const int bid = mk::obid(), nb = gridDim.x; LAS float* tile = (LAS float*)lds;
  int ub = 0;
  for (int i = 0; i < 2; ++i) ub += cvt_matrix(p.even_w_in + (size_t)i * D * EVEN_IN, EVEN_IN, D, EVEN_IN, wsp<bf16_t>(p, WS_WEIN) + (size_t)i * EVEN_IN * D, NMapId{0}, tile, ub, bid, nb);
  for (int i = 0; i < 2; ++i) ub += cvt_matrix(p.odd_w_in + (size_t)i * D * ODD_IN, ODD_IN, D, ODD_IN, wsp<bf16_t>(p, WS_WOIN) + (size_t)i * ODD_IN * D, NMapRope{}, tile, ub, bid, nb);
  for (int i = 0; i < 2; ++i) ub += cvt_matrix(p.even_w_out + (size_t)i * D * D, D, D, D, wsp<bf16_t>(p, WS_WEOUT) + (size_t)i * D * D, NMapId{0}, tile, ub, bid, nb);
  for (int i = 0; i < 2; ++i) ub += cvt_matrix(p.odd_w_out + (size_t)i * D * D, D, D, D, wsp<bf16_t>(p, WS_WOOUT) + (size_t)i * D * D, NMapId{0}, tile, ub, bid, nb);
  for (int u = (bid + nb - ub % nb) % nb; u < 384; u += nb) ada_unit(p, u, (LAS float*)lds);
  const int gt = bid * NTHR + mk::otid();
  if (gt < 128 * 16) { const int pos = gt >> 4, i = gt & 15; const float inv = exp2f(-(float)i * (13.287712379549449f / 16.0f)); float sn, cs; sincosf((float)pos * inv, &sn, &cs);
    wsp<float>(p, WS_ROPE)[gt * 2] = cs; wsp<float>(p, WS_ROPE)[gt * 2 + 1] = sn; }
}
__device__ __forceinline__ void cvt_experts(const Params& p, int l, LAS float* tile) {
  const int bid = mk::obid(), nb = gridDim.x; int ub = 0;
  for (int e = 0; e < NE; ++e) {
    const size_t so = ((size_t)l * NE + e) * D * DE;
    ub += cvt_matrix(p.exp_w_gate + so, DE, D, DE, wsp<bf16_t>(p, WS_WGU) + (size_t)e * 1024 * D, NMapInterleave{0}, tile, ub, bid, nb);
    ub += cvt_matrix(p.exp_w_up + so, DE, D, DE, wsp<bf16_t>(p, WS_WGU) + (size_t)e * 1024 * D, NMapInterleave{1}, tile, ub, bid, nb);
    ub += cvt_matrix(p.exp_w_down + so, D, DE, D, wsp<bf16_t>(p, WS_WDN) + (size_t)e * D * DE, NMapId{0}, tile, ub, bid, nb);
  }
}

__device__ __forceinline__ const float* h_in_ptr(const Params& p, int l, int row) {
  if (l == 0) return row < NLAT ? p.x + (size_t)row * D : p.ctx + (size_t)(row - NLAT) * D;
  return row < NLAT ? p.out + (size_t)row * D : wsp<float>(p, WS_HCTX) + (size_t)(row - NLAT) * D;
}
__device__ __forceinline__ float* h_out_ptr(const Params& p, int row) { return row < NLAT ? p.out + (size_t)row * D : wsp<float>(p, WS_HCTX) + (size_t)(row - NLAT) * D; }
__device__ __forceinline__ void store_bf16x4(bf16_t* dst, f32x4 v) { u32x2 w; w.x = cvt_pk_bf16(v[0], v[1]); w.y = cvt_pk_bf16(v[2], v[3]); *(u32x2*)dst = w; }
__device__ __forceinline__ f32x4 load_bf16x4(const bf16_t* src) { const u32x2 w = *(const u32x2*)src; return (f32x4){bflo(w.x), bfhi(w.x), bflo(w.y), bfhi(w.y)}; }

__device__ __forceinline__ void phase_mod0(const Params& p) {
  const int lane = mk::otid() & 63, wid = mk::otid() >> 6;
  bf16_t* U = wsp<bf16_t>(p, WS_UO);
  for (int row = mk::obid() * 8 + wid; row < NTOK; row += gridDim.x * 8) {
    const float* h = h_in_ptr(p, 0, row); const float* modl = wsp<float>(p, WS_MOD) + (size_t)bidx_of_row(row) * 6144;
#pragma unroll
    for (int q = 0; q < 4; ++q) { const int col = q * 256 + lane * 4; const f32x4 hv = *(const f32x4*)(h + col), sh = *(const f32x4*)(modl + col), sc = *(const f32x4*)(modl + 1024 + col);
      store_bf16x4(U + (size_t)row * D + col, hv * (1.0f + sc) + sh); }
  }
}
__device__ __forceinline__ void ln_row(f32x4 (&v)[4], const float* __restrict__ g, const float* __restrict__ b, int lane) {
  float s = 0.f;
#pragma unroll
  for (int q = 0; q < 4; ++q) s += (v[q][0] + v[q][1]) + (v[q][2] + v[q][3]);
  const float mu = wave_sum_u(s) * (1.0f / D);
  float qq = 0.f;
#pragma unroll
  for (int q = 0; q < 4; ++q) { const f32x4 d = v[q] - mu; qq += (d[0] * d[0] + d[1] * d[1]) + (d[2] * d[2] + d[3] * d[3]); }
  const float rstd = rsqrtf(wave_sum_u(qq) * (1.0f / D) + LN_EPS);
#pragma unroll
  for (int q = 0; q < 4; ++q) { const int col = q * 256 + lane * 4; v[q] = (v[q] - mu) * rstd * *(const f32x4*)(g + col) + *(const f32x4*)(b + col); }
}
template <int NR>
__device__ __forceinline__ void ln1_rows(const Params& p, int l, const bf16_t* __restrict__ Ybuf, const int (&rows)[NR], int lane, const LAS float* rwl, LAS int* lcnt, bool dry) {
  bf16_t* U2 = wsp<bf16_t>(p, WS_UO); int* eid = wsp<int>(p, WS_EID); float* gatev = wsp<float>(p, WS_GATE);
  const float* lg = p.ln_g + (size_t)(l * 2) * D; const float* lb = p.ln_b + (size_t)(l * 2) * D;
  f32x4 v[NR][4];
#pragma unroll
  for (int r = 0; r < NR; ++r) { const int row = rows[r]; const float* h = h_in_ptr(p, l, row); const float* modl = wsp<float>(p, WS_MOD) + ((size_t)l * 5 + bidx_of_row(row)) * 6144;
#pragma unroll
    for (int q = 0; q < 4; ++q) { const int col = q * 256 + lane * 4; v[r][q] = ALPHA * *(const f32x4*)(h + col) + *(const f32x4*)(modl + 2 * 1024 + col) * load_bf16x4(Ybuf + (size_t)row * D + col); } }
#pragma unroll
  for (int r = 0; r < NR; ++r) {
    const int row = rows[r]; float* ho = h_out_ptr(p, row); const float* modl = wsp<float>(p, WS_MOD) + ((size_t)l * 5 + bidx_of_row(row)) * 6144;
    ln_row(v[r], lg, lb, lane);
    float acc[16];
#pragma unroll
    for (int e = 0; e < 16; ++e) acc[e] = 0.f;
#pragma unroll
    for (int q = 0; q < 4; ++q) { const int col = q * 256 + lane * 4;
      if (!dry) *(f32x4*)(ho + col) = v[r][q];
      const f32x4 u = v[r][q] * (1.0f + *(const f32x4*)(modl + 4 * 1024 + col)) + *(const f32x4*)(modl + 3 * 1024 + col);
      if (!dry) store_bf16x4(U2 + (size_t)row * D + col, u);
#pragma unroll
      for (int e = 0; e < 16; ++e) { const f32x4 w = *(const LAS f32x4*)(rwl + ((q * 16 + e) * 64 + lane) * 4); acc[e] += (u[0] * w[0] + u[1] * w[1]) + (u[2] * w[2] + u[3] * w[3]); }
      asm volatile("" ::: "memory");
    }
    float s[16], sel[16];
#pragma unroll
    for (int e = 0; e < 16; ++e) { s[e] = 1.0f / (1.0f + expf(-wave_sum_u(acc[e]))); sel[e] = s[e] + p.router_b[e]; }
    float best = -1e30f; int grp = 0;
#pragma unroll
    for (int gI = 0; gI < 4; ++gI) {
      const float a = sel[gI * 4], b2 = sel[gI * 4 + 1], c = sel[gI * 4 + 2], d = sel[gI * 4 + 3];
      const float lo1 = fminf(a, b2), hi1 = fmaxf(a, b2), lo2 = fminf(c, d), hi2 = fmaxf(c, d);
      const float gs = fmaxf(hi1, hi2) + fmaxf(fminf(hi1, hi2), fmaxf(lo1, lo2));
      if (gs > best) { best = gs; grp = gI; }
    }
    float v0 = 0, v1 = 0, v2 = 0, v3 = 0, s0 = 0, s1 = 0, s2 = 0, s3 = 0;
#pragma unroll
    for (int gI = 0; gI < 4; ++gI) if (gI == grp) { v0 = sel[gI * 4]; v1 = sel[gI * 4 + 1]; v2 = sel[gI * 4 + 2]; v3 = sel[gI * 4 + 3]; s0 = s[gI * 4]; s1 = s[gI * 4 + 1]; s2 = s[gI * 4 + 2]; s3 = s[gI * 4 + 3]; }
    int i1 = 0; float b1 = v0; if (v1 > b1) { b1 = v1; i1 = 1; } if (v2 > b1) { b1 = v2; i1 = 2; } if (v3 > b1) { b1 = v3; i1 = 3; }
    int i2 = -1; float bb = -1e30f;
    if (i1 != 0 && v0 > bb) { bb = v0; i2 = 0; } if (i1 != 1 && v1 > bb) { bb = v1; i2 = 1; } if (i1 != 2 && v2 > bb) { bb = v2; i2 = 2; } if (i1 != 3 && v3 > bb) { bb = v3; i2 = 3; }
    const float g1 = i1 == 0 ? s0 : i1 == 1 ? s1 : i1 == 2 ? s2 : s3; const float g2 = i2 == 0 ? s0 : i2 == 1 ? s1 : i2 == 2 ? s2 : s3;
    if (lane == 0 && !dry) { const int e1 = grp * 4 + i1, e2 = grp * 4 + i2;
      eid[row * 2] = e1; eid[row * 2 + 1] = e2; gatev[row * 2] = g1 / (g1 + g2); gatev[row * 2 + 1] = g2 / (g1 + g2);
      __hip_atomic_fetch_add(lcnt + e1, 1, __ATOMIC_RELAXED, __HIP_MEMORY_SCOPE_WORKGROUP); __hip_atomic_fetch_add(lcnt + e2, 1, __ATOMIC_RELAXED, __HIP_MEMORY_SCOPE_WORKGROUP); }
  }
}
__device__ __forceinline__ void phase_ln1(const Params& p, int l, const bf16_t* __restrict__ Ybuf, LAS unsigned char* lds, bool dry) {
  const int tid = mk::otid(), lane = tid & 63, wid = tid >> 6, bid = mk::obid();
  const bool last = l == DEPTH - 1; const int ntok = last ? NLAT : NTOK;
  LAS float* rwl = (LAS float*)lds; LAS int* lcnt = (LAS int*)(lds + 65536);
  for (int idx = tid; idx < 16384; idx += NTHR) { const int d = idx >> 4, e = idx & 15; rwl[(((d >> 8) * 16 + e) * 64 + ((d >> 2) & 63)) * 4 + (d & 3)] = p.router_w[idx]; }
  if (tid < 16) lcnt[tid] = 0;
  __syncthreads();
  const int stride = gridDim.x * 8;
  int row = bid * 8 + wid;
  for (; row + stride < ntok; row += 2 * stride) { const int rows[2] = {row, row + stride}; ln1_rows<2>(p, l, Ybuf, rows, lane, rwl, lcnt, dry); }
  if (row < ntok) { const int rows[1] = {row}; ln1_rows<1>(p, l, Ybuf, rows, lane, rwl, lcnt, dry); }
  __syncthreads();
  if (tid < 16 && !dry) wsp<int>(p, WS_BCNT)[bid * 16 + tid] = lcnt[tid];
  __syncthreads();
  if (!dry) cvt_experts(p, l, (LAS float*)lds);
}
__device__ __forceinline__ void phase_scatter(const Params& p, int l, LAS unsigned char* lds) {
  const int tid = mk::otid(), lane = tid & 63, wid = tid >> 6, bid = mk::obid();
  const bool last = l == DEPTH - 1; const int ntok = last ? NLAT : NTOK;
  LAS int* tot = (LAS int*)lds; LAS int* pre = tot + 16; LAS int* base = tot + 32; LAS int* lcur = tot + 48;
  const int* bc = wsp<int>(p, WS_BCNT);
  if (tid < 16) { int t = 0, pr = 0; for (int b2 = 0; b2 < (int)gridDim.x; ++b2) { const int v = bc[b2 * 16 + tid]; pr += b2 < bid ? v : 0; t += v; } tot[tid] = t; pre[tid] = pr; lcur[tid] = 0; }
  __syncthreads();
  if (tid == 0) { int o = 0; int* mo = wsp<int>(p, WS_MOFF); for (int e = 0; e < 16; ++e) { base[e] = o + pre[e]; if (bid == 0) mo[e] = o; o += (tot[e] + 255) / 256 * 256; } if (bid == 0) mo[16] = o; }
  __syncthreads();
  const bf16_t* U2 = wsp<bf16_t>(p, WS_UO); bf16_t* Xs = wsp<bf16_t>(p, WS_SCR + SM_XS); const int* eid = wsp<int>(p, WS_EID); int* pos = wsp<int>(p, WS_POS);
  for (int row = bid * 8 + wid; row < ntok; row += gridDim.x * 8) {
    int p1 = 0, p2 = 0;
    if (lane == 0) { const int e1 = eid[row * 2], e2 = eid[row * 2 + 1]; p1 = base[e1] + __hip_atomic_fetch_add(lcur + e1, 1, __ATOMIC_RELAXED, __HIP_MEMORY_SCOPE_WORKGROUP); p2 = base[e2] + __hip_atomic_fetch_add(lcur + e2, 1, __ATOMIC_RELAXED, __HIP_MEMORY_SCOPE_WORKGROUP); pos[row * 2] = p1; pos[row * 2 + 1] = p2; }
    p1 = __builtin_amdgcn_readfirstlane(p1); p2 = __builtin_amdgcn_readfirstlane(p2);
    const u32x4 a = *(const u32x4*)(U2 + (size_t)row * D + lane * 8), b2 = *(const u32x4*)(U2 + (size_t)row * D + 512 + lane * 8);
    *(u32x4*)(Xs + (size_t)p1 * D + lane * 8) = a; *(u32x4*)(Xs + (size_t)p1 * D + 512 + lane * 8) = b2;
    *(u32x4*)(Xs + (size_t)p2 * D + lane * 8) = a; *(u32x4*)(Xs + (size_t)p2 * D + 512 + lane * 8) = b2;
  }
}
template <int NR>
__device__ __forceinline__ void ln2_rows(const Params& p, int l, const int (&rows)[NR], int lane, bool dry) {
  const bool last = l == DEPTH - 1;
  const bf16_t* Ys = wsp<bf16_t>(p, WS_SCR + SM_YS); const int* pos = wsp<int>(p, WS_POS); const float* gatev = wsp<float>(p, WS_GATE); bf16_t* U = wsp<bf16_t>(p, WS_UO);
  const float* lg = p.ln_g + (size_t)(l * 2 + 1) * D; const float* lb = p.ln_b + (size_t)(l * 2 + 1) * D;
  f32x4 v[NR][4];
#pragma unroll
  for (int r = 0; r < NR; ++r) { const int row = rows[r]; const float* ho = h_out_ptr(p, row); const float* modl = wsp<float>(p, WS_MOD) + ((size_t)l * 5 + bidx_of_row(row)) * 6144;
    const int p1 = pos[row * 2], p2 = pos[row * 2 + 1]; const float g1 = gatev[row * 2], g2 = gatev[row * 2 + 1];
#pragma unroll
    for (int q = 0; q < 4; ++q) { const int col = q * 256 + lane * 4;
      const f32x4 f = g1 * load_bf16x4(Ys + (size_t)p1 * D + col) + g2 * load_bf16x4(Ys + (size_t)p2 * D + col);
      v[r][q] = ALPHA * *(const f32x4*)(ho + col) + *(const f32x4*)(modl + 5 * 1024 + col) * f; } }
#pragma unroll
  for (int r = 0; r < NR; ++r) { const int row = rows[r]; float* ho = h_out_ptr(p, row);
    ln_row(v[r], lg, lb, lane);
    const float* modn = wsp<float>(p, WS_MOD) + ((size_t)(last ? l : l + 1) * 5 + bidx_of_row(row)) * 6144;
#pragma unroll
    for (int q = 0; q < 4; ++q) { const int col = q * 256 + lane * 4; if (!dry) *(f32x4*)(ho + col) = v[r][q];
      if (!last && !dry) store_bf16x4(U + (size_t)row * D + col, v[r][q] * (1.0f + *(const f32x4*)(modn + 1024 + col)) + *(const f32x4*)(modn + col)); } }
}
__device__ __forceinline__ void phase_ln2(const Params& p, int l, bool dry) {
  const int tid = mk::otid(), lane = tid & 63, wid = tid >> 6;
  const bool last = l == DEPTH - 1; const int ntok = last ? NLAT : NTOK;
  const int stride = gridDim.x * 8;
  int row = mk::obid() * 8 + wid;
  for (; row + stride < ntok; row += 2 * stride) { const int rows[2] = {row, row + stride}; ln2_rows<2>(p, l, rows, lane, dry); }
  if (row < ntok) { const int rows[1] = {row}; ln2_rows<1>(p, l, rows, lane, dry); }
}

struct SchedEvenIn { const bf16_t* U; const bf16_t* W; bf16_t* Pqk; bf16_t* Prw; bf16_t* Vt; int G, c;
  __device__ __forceinline__ bool next(int i, pg8::Unit& u) const { const int Lx = i * G + c; u.kind = 0;
    if (Lx < 1452) { const int grp = Lx / 44, rem = Lx % 44, pm = grp * 4 + (rem & 3), pi = rem >> 2; u.pm = pm; u.pn = pi;
      u.A = (const char*)(U + (size_t)pm * 256 * D); const int brow = pi < 4 ? pi * 256 : 1536 + (pi - 4) * 256; u.Bt = (const char*)(W + (size_t)brow * D);
      if (pi < 4) { u.out = Pqk; u.ldo = 1024; u.x1 = pi * 256; } else { u.out = Prw; u.ldo = RW_IN; u.x1 = (pi - 4) * 256; } u.x0 = pm * 256; return true; }
    if (Lx < 1452 + 264) { const int v = Lx - 1452, pmv = v & 1, pnv = v >> 1; u.pm = pmv; u.pn = pnv; u.A = (const char*)(W + (size_t)(1024 + pmv * 256) * D); u.Bt = (const char*)(U + (size_t)pnv * 256 * D);
      u.out = Vt; u.ldo = NTOK; u.x0 = pmv * 256; u.x1 = pnv * 256; return true; }
    return false; } };
struct SchedOddIn { const bf16_t* U; const bf16_t* W; bf16_t* Pqk; bf16_t* Vt; int G, c;
  __device__ __forceinline__ bool next(int i, pg8::Unit& u) const { const int Lx = i * G + c;
    if (Lx < 1056) { const int grp = Lx / 32, rem = Lx % 32, pm = grp * 4 + (rem & 3), pi = rem >> 2; u.pm = pm; u.pn = pi; u.kind = pm < 128 ? 1 : 0;
      u.A = (const char*)(U + (size_t)pm * 256 * D); u.Bt = (const char*)(W + (size_t)pi * 256 * D); u.out = Pqk; u.ldo = 2048; u.x0 = pm * 256; u.x1 = pi * 256; return true; }
    if (Lx < 1056 + 528) { const int v = Lx - 1056, pmv = v & 3, pnv = v >> 2; u.pm = pmv; u.pn = pnv; u.kind = 0; u.A = (const char*)(W + (size_t)(2048 + pmv * 256) * D); u.Bt = (const char*)(U + (size_t)pnv * 256 * D);
      u.out = Vt; u.ldo = NTOK; u.x0 = pmv * 256; u.x1 = pnv * 256; return true; }
    return false; } };
struct SchedOut { const bf16_t* O; const bf16_t* W; bf16_t* Y; int G, c;
  __device__ __forceinline__ bool next(int i, pg8::Unit& u) const { const int Lx = i * G + c; if (Lx >= 528) return false; const int pm = (Lx / 16) * 4 + (Lx & 3), pn = (Lx & 15) >> 2; u.pm = pm; u.pn = pn; u.kind = 0;
    u.A = (const char*)(O + (size_t)pm * 256 * D); u.Bt = (const char*)(W + (size_t)pn * 256 * D); u.out = Y; u.ldo = 1024; u.x0 = pm * 256; u.x1 = pn * 256; return true; } };
struct SchedMoe { const bf16_t* A; const bf16_t* W; bf16_t* out; const LAS int* moff; int Kd, ldo, ncol, G, c;
  __device__ __forceinline__ bool next(int i, pg8::Unit& u) const { const int Lx = i * G + c; const int ntile = moff[16] >> 8; if (Lx >= ntile * 4) return false;
    const int pm = Lx >> 2, pn = Lx & 3; int e = 0;
#pragma unroll
    for (int j = 1; j < 16; ++j) e += (pm * 256 >= moff[j]) ? 1 : 0;
    u.pm = pm; u.pn = pn; u.kind = 0; u.A = (const char*)(A + (size_t)pm * 256 * Kd); u.Bt = (const char*)(W + ((size_t)e * 1024 + pn * 256) * Kd); u.out = out; u.ldo = ldo; u.x0 = pm * 256; u.x1 = pn * ncol; return true; } };

struct EpiOddIn {
  static constexpr bool PERM = true; const float* rope;
  __device__ __forceinline__ void operator()(const f32x4 (&acc)[2][2][4][2], const pg8::Unit& u, int wr, int wc, int fr, int fq) const {
    if (u.kind == 0) { pg8::EpiStoreBf16{}(acc, u, wr, wc, fr, fq); return; }
    const int row0 = u.x0 + wr * 64 + fr, col0 = u.x1 + wc * 32 + 8 * fq; const int half = wc & 1;
#pragma unroll
    for (int ai = 0; ai < 2; ++ai)
#pragma unroll
      for (int m = 0; m < 4; ++m) { const int row = row0 + ai * 128 + m * 16; const int t = row & (T - 1); const int pos = half ? (t & 63) : (t >> 6);
        const f32x4 cs0 = *(const f32x4*)(rope + (pos * 16 + 4 * fq) * 2), cs1 = *(const f32x4*)(rope + (pos * 16 + 4 * fq + 2) * 2);
        bf16_t* rowp = u.out + (size_t)row * u.ldo + col0;
#pragma unroll
        for (int bj = 0; bj < 2; ++bj) { const f32x4 v0 = acc[ai][bj][m][0], v1 = acc[ai][bj][m][1];
          u32x4 w; w.x = cvt_pk_bf16(v0[0] * cs0[0] - v0[1] * cs0[1], v0[0] * cs0[1] + v0[1] * cs0[0]); w.y = cvt_pk_bf16(v0[2] * cs0[2] - v0[3] * cs0[3], v0[2] * cs0[3] + v0[3] * cs0[2]);
          w.z = cvt_pk_bf16(v1[0] * cs1[0] - v1[1] * cs1[1], v1[0] * cs1[1] + v1[1] * cs1[0]); w.w = cvt_pk_bf16(v1[2] * cs1[2] - v1[3] * cs1[3], v1[2] * cs1[3] + v1[3] * cs1[2]);
          *(u32x4*)(rowp + bj * 128) = w; } }
  }
};
struct EpiGateUp {
  static constexpr bool PERM = true;
  __device__ __forceinline__ void operator()(const f32x4 (&acc)[2][2][4][2], const pg8::Unit& u, int wr, int wc, int fr, int fq) const {
    const int row0 = u.x0 + wr * 64 + fr, col0 = u.x1 + wc * 16 + 4 * fq;
#pragma unroll
    for (int ai = 0; ai < 2; ++ai)
#pragma unroll
      for (int m = 0; m < 4; ++m) { bf16_t* rowp = u.out + (size_t)(row0 + ai * 128 + m * 16) * u.ldo + col0;
#pragma unroll
        for (int bj = 0; bj < 2; ++bj) { const f32x4 v0 = acc[ai][bj][m][0], v1 = acc[ai][bj][m][1];
          u32x2 w; w.x = cvt_pk_bf16(siluf_(v0[0]) * v0[1], siluf_(v0[2]) * v0[3]); w.y = cvt_pk_bf16(siluf_(v1[0]) * v1[1], siluf_(v1[2]) * v1[3]);
          *(u32x2*)(rowp + bj * 64) = w; } }
  }
};
}

namespace mk {
constexpr int N_PHASES = 2 + 2 * (13 + 9);
__global__ void __launch_bounds__(NTHR, 2) mega(Params p) {
  extern __shared__ __attribute__((aligned(16))) unsigned char shm[];
  LAS unsigned char* lds = (LAS unsigned char*)shm;
  const int nb = gridDim.x;
  if (threadIdx.x == 0) *(LAS u32x4*)(lds + LDS_BARW) = (u32x4){0u, 0u, 0u, 0u};
  __syncthreads();
  XcdBarrier bar = xcd_barrier_post(wsp<unsigned>(p, WS_BAR), (volatile LAS unsigned*)(lds + LDS_BARW));
  int ph = 0;
#ifndef MK_MASK
#define MK_MASK 0xFFFFFFFFu
#endif
#ifndef MK_REP
#define MK_REP 0u
#endif
#define PHASE_BEGIN_K(k) if ((((MK_MASK) >> (k)) & 1u) && ph >= p.ph_lo && ph < p.ph_hi) { const int bid = mk::obid(); const int nrep_ = ((((MK_REP) >> (k)) & 1u) ? 2 : 1); for (int rep_ = 0; rep_ < nrep_; ++rep_) { const bool dry = rep_ + 1 < nrep_; (void)dry;
#define PHASE_END   } if (ph + 1 < p.ph_hi) xcd_barrier(bar); } ++ph;
  bf16_t* UO = wsp<bf16_t>(p, WS_UO);
  unsigned char* scr = p.ws + WS_SCR;
  PHASE_BEGIN_K(0) phase_prologue(p, lds); PHASE_END
  PHASE_BEGIN_K(1) phase_mod0(p); PHASE_END
  for (int lp = 0; lp < 2; ++lp) {
    {
      const int l = 2 * lp;
      bf16_t* Pqk = (bf16_t*)(scr + SE_PQK); bf16_t* Vt = (bf16_t*)(scr + SE_VT); bf16_t* Prw = (bf16_t*)(scr + SE_PRW); bf16_t* Ybuf = (bf16_t*)(scr + SE_YBUF);
      rw::Bufs bf; bf.SH = (u32x2*)(scr + SE_SH); bf.DR = (unsigned*)(scr + SE_DR); bf.G = UO + 512; bf.gstride = 1024; bf.CS = (float*)(scr + SE_CS); bf.PQ = (float*)(scr + SE_PQ); bf.SST = (float*)(scr + SE_SST); bf.Y = (bf16_t*)(scr + SE_Y);
      PHASE_BEGIN_K(2) { SchedEvenIn S{UO, wsp<bf16_t>(p, WS_WEIN) + (size_t)lp * EVEN_IN * D, Pqk, Prw, Vt, nb, bid}; pg8::gemm_phase(lds, D, S, pg8::EpiStoreBf16{}); } PHASE_END
      PHASE_BEGIN_K(3) for (int u = bid; u < 1024 + 32; u += nb) { int b, h, rq; if (u < 1024) { b = u >> 8; h = (u >> 5) & 7; rq = u & 31; } else { const int v = u - 1024; b = v >> 3; h = v & 7; rq = -1; }
        natt::na_attn_unit(Pqk, Vt, p.na_rpb + ((size_t)lp * 8 + h) * 465, UO, b, h, rq, lds); } PHASE_END
      PHASE_BEGIN_K(4) for (int t = bid; t < NTOK / 16; t += nb) rw::prep_tile(Prw, p.shift_w + (size_t)lp * 3 * RW_IN, p.rw_w0 + lp * 1024, p.rw_w_up + (size_t)lp * 2 * 64 * 512, p.rw_a0 + lp * 1024,
            p.rw_a_up + (size_t)lp * 2 * 64 * 512, p.rw_g_up + (size_t)lp * 128 * 512, p.rw_k_k + lp * 512, p.rw_k_a + lp * 512, p.rw_r_k + lp * 512, bf, t, (LAS float*)lds); PHASE_END
      PHASE_BEGIN_K(5) for (int u = bid * 8 + (mk::otid() >> 6); u < rw::NCHAIN * rw::NCH; u += nb * 8) {
        if (u < rw::NCHAIN * (rw::NCH - 1)) rw::scan_unit<0>(bf, p.rw_k_a + lp * 512, u / (rw::NCH - 1), false, u % (rw::NCH - 1));
        else rw::scan_unit<1>(bf, p.rw_k_a + lp * 512, u - rw::NCHAIN * (rw::NCH - 1), true, 0); } PHASE_END
      PHASE_BEGIN_K(6) for (int c = bid; c < rw::NCHAIN; c += nb) rw::propagate_chain(bf, c, (LAS float*)lds); PHASE_END
      PHASE_BEGIN_K(7) for (int u = bid * 8 + (mk::otid() >> 6); u < rw::NCHAIN * rw::NCH; u += nb * 8) rw::scan_unit<1>(bf, p.rw_k_a + lp * 512, u / rw::NCH, false, u % rw::NCH); PHASE_END
      PHASE_BEGIN_K(8) for (int r = bid * 4; r < NTOK; r += nb * 4) rw::finish_rows4(bf, p.rw_gn_g + lp * 512, p.rw_gn_b + lp * 512, UO, r); PHASE_END
      PHASE_BEGIN_K(9) { SchedOut S{UO, wsp<bf16_t>(p, WS_WEOUT) + (size_t)lp * D * D, Ybuf, nb, bid}; pg8::gemm_phase(lds, D, S, pg8::EpiStoreBf16{}); } PHASE_END
      PHASE_BEGIN_K(10) phase_ln1(p, l, Ybuf, lds, dry); PHASE_END
      PHASE_BEGIN_K(11) phase_scatter(p, l, lds); PHASE_END
      PHASE_BEGIN_K(12) { LAS int* mo = (LAS int*)(lds + LDS_MISC); { const int tq = mk::otid(); if (tq < 17) mo[tq] = wsp<int>(p, WS_MOFF)[tq]; } __syncthreads();
        SchedMoe S{(bf16_t*)(scr + SM_XS), wsp<bf16_t>(p, WS_WGU), (bf16_t*)(scr + SM_HE), mo, D, DE, 128, nb, bid}; pg8::gemm_phase(lds, D, S, EpiGateUp{}); } PHASE_END
      PHASE_BEGIN_K(13) { LAS int* mo = (LAS int*)(lds + LDS_MISC); { const int tq = mk::otid(); if (tq < 17) mo[tq] = wsp<int>(p, WS_MOFF)[tq]; } __syncthreads();
        SchedMoe S{(bf16_t*)(scr + SM_HE), wsp<bf16_t>(p, WS_WDN), (bf16_t*)(scr + SM_YS), mo, DE, D, 256, nb, bid}; pg8::gemm_phase(lds, DE, S, pg8::EpiStoreBf16{}); } PHASE_END
      PHASE_BEGIN_K(14) phase_ln2(p, l, dry); PHASE_END
    }
    {
      const int l = 2 * lp + 1; const bool last = l == DEPTH - 1;
      bf16_t* Pqk = (bf16_t*)(scr + SO_PQK); bf16_t* Vt = (bf16_t*)(scr + SO_VT); bf16_t* O12 = (bf16_t*)(scr + SO_O12); bf16_t* Ybuf = (bf16_t*)(scr + SO_YBUF);
      PHASE_BEGIN_K(15) { SchedOddIn S{UO, wsp<bf16_t>(p, WS_WOIN) + (size_t)lp * ODD_IN * D, Pqk, Vt, nb, bid}; pg8::gemm_phase(lds, D, S, EpiOddIn{wsp<float>(p, WS_ROPE)}); } PHASE_END
      PHASE_BEGIN_K(16) for (int u = bid; u < 2048 + (last ? 0 : 64); u += nb) { int b, hh, q0, nlat;
        if (u < 2048) { b = u >> 9; hh = (u >> 5) & 15; q0 = b * T + (u & 31) * 256; nlat = T; } else { const int v = u - 2048; b = v >> 4; hh = v & 15; q0 = NLAT + b * L; nlat = 0; }
        att::diff_attn_unit(Pqk, Vt, O12, hh, q0, b * T, nlat, NLAT + b * L, lds); } PHASE_END
      PHASE_BEGIN_K(17) { float d1 = 0.f, d2 = 0.f; for (int i = 0; i < 64; ++i) { d1 += p.da_lq1[lp * 64 + i] * p.da_lk1[lp * 64 + i]; d2 += p.da_lq2[lp * 64 + i] * p.da_lk2[lp * 64 + i]; }
        const float li = 0.8f - 0.6f * expf(-0.3f * (float)l), lam = expf(d1) - expf(d2) + li;
        const int tq = mk::otid(); for (int r4 = bid; r4 < (last ? NLAT : NTOK) / 4; r4 += nb) att::diff_combine_rows4(O12, p.da_subln_g + lp * 128, lam, 1.0f - li, UO, r4 * 4, tq >> 6, tq & 63); } PHASE_END
      PHASE_BEGIN_K(18) { SchedOut S{UO, wsp<bf16_t>(p, WS_WOOUT) + (size_t)lp * D * D, Ybuf, nb, bid}; pg8::gemm_phase(lds, D, S, pg8::EpiStoreBf16{}); } PHASE_END
      PHASE_BEGIN_K(19) phase_ln1(p, l, Ybuf, lds, dry); PHASE_END
      PHASE_BEGIN_K(20) phase_scatter(p, l, lds); PHASE_END
      PHASE_BEGIN_K(21) { LAS int* mo = (LAS int*)(lds + LDS_MISC); { const int tq = mk::otid(); if (tq < 17) mo[tq] = wsp<int>(p, WS_MOFF)[tq]; } __syncthreads();
        SchedMoe S{(bf16_t*)(scr + SM_XS), wsp<bf16_t>(p, WS_WGU), (bf16_t*)(scr + SM_HE), mo, D, DE, 128, nb, bid}; pg8::gemm_phase(lds, D, S, EpiGateUp{}); } PHASE_END
      PHASE_BEGIN_K(22) { LAS int* mo = (LAS int*)(lds + LDS_MISC); { const int tq = mk::otid(); if (tq < 17) mo[tq] = wsp<int>(p, WS_MOFF)[tq]; } __syncthreads();
        SchedMoe S{(bf16_t*)(scr + SM_HE), wsp<bf16_t>(p, WS_WDN), (bf16_t*)(scr + SM_YS), mo, DE, D, 256, nb, bid}; pg8::gemm_phase(lds, DE, S, pg8::EpiStoreBf16{}); } PHASE_END
      PHASE_BEGIN_K(23) phase_ln2(p, l, dry); PHASE_END
    }
  }
#undef PHASE_BEGIN_K
#undef PHASE_END
}
}

#ifndef MK_SINGLE_LAUNCH
#define MK_SINGLE_LAUNCH 1
#endif
extern "C" void kernel_launch(void* const* d_in, const int* in_sizes, int n_in, void* d_out, int out_size, void* d_ws, size_t ws_size, hipStream_t stream) {
  using namespace mk;
  static int grid = 0;
  if (grid == 0) {
    if (n_in != 34 || out_size != NLAT * D || ws_size < WS_END) { fprintf(stderr, "kernel_launch: unexpected shapes (n_in %d out %d ws %zu need %zu)\n", n_in, out_size, ws_size, (size_t)WS_END); grid = -1; return; }
    if (hipFuncSetAttribute((const void*)mega, hipFuncAttributeMaxDynamicSharedMemorySize, LDS_BYTES) != hipSuccess) { grid = -1; return; }
    int dev = 0, cus = 0, per_cu = 0;
    if (hipGetDevice(&dev) != hipSuccess || hipDeviceGetAttribute(&cus, hipDeviceAttributeMultiprocessorCount, dev) != hipSuccess) { grid = -1; return; }
    if (hipOccupancyMaxActiveBlocksPerMultiprocessor(&per_cu, (const void*)mega, NTHR, LDS_BYTES) != hipSuccess || per_cu < 1) { fprintf(stderr, "kernel_launch: occupancy query says %d\n", per_cu); }
    (void)hipGetLastError();
    grid = cus;
  }
  if (grid < 0) return;
  (void)hipMemsetAsync((char*)d_ws + WS_BAR, 0, (size_t)XCD_BAR_WORDS * 4, stream);
  Params p{};
  const float** pp = (const float**)&p;
  for (int i = 0; i < 34; ++i) pp[i] = (const float*)d_in[i];
  p.out = (float*)d_out; p.ws = (unsigned char*)d_ws;
#if MK_SINGLE_LAUNCH
  p.ph_lo = 0; p.ph_hi = N_PHASES;
  hipLaunchKernelGGL(mega, dim3(grid), dim3(NTHR), LDS_BYTES, stream, p);
#else
  for (int ph = 0; ph < N_PHASES; ++ph) { p.ph_lo = ph; p.ph_hi = ph + 1; hipLaunchKernelGGL(mega, dim3(grid), dim3(NTHR), LDS_BYTES, stream, p); }
#endif
}
```

```cpp
#include <hip/hip_runtime.h>
#include <stdint.h>
#include <stdio.h>

typedef unsigned short bf16_t;
typedef short bf16x8 __attribute__((ext_vector_type(8)));
typedef float f32x4 __attribute__((ext_vector_type(4)));
typedef float f32x2 __attribute__((ext_vector_type(2)));
typedef float f32x16 __attribute__((ext_vector_type(16)));
typedef unsigned u32x4 __attribute__((ext_vector_type(4)));
typedef unsigned u32x2 __attribute__((ext_vector_type(2)));
#define LAS __attribute__((address_space(3)))

namespace mk {
constexpr int B = 4, T = 8192, L = 256, D = 1024, NLAT = B * T, NCTX = B * L, NTOK = NLAT + NCTX;
constexpr int DEPTH = 4, EVEN_IN = 3328, ODD_IN = 3072, RW_OFF = 1536, RW_IN = 1792, NE = 16, DE = 512;
constexpr float ALPHA = 1.681792830507429f, LN_EPS = 1e-5f;
constexpr int NTHR = 512, LDS_BYTES = 147456;
constexpr int MOE_TILES = 280, MOE_ROWS = MOE_TILES * 256;

__device__ __forceinline__ unsigned cvt_pk_bf16(float lo, float hi) { unsigned r; asm volatile("v_cvt_pk_bf16_f32 %0, %1, %2" : "=v"(r) : "v"(lo), "v"(hi)); return r; }
__device__ __forceinline__ float bf2f(bf16_t b) { return __uint_as_float(((unsigned)b) << 16); }
__device__ __forceinline__ float bflo(unsigned w) { return __uint_as_float(w << 16); }
__device__ __forceinline__ float bfhi(unsigned w) { return __uint_as_float(w & 0xffff0000u); }
__device__ __forceinline__ bf16_t f2bf(float f) { return (bf16_t)(cvt_pk_bf16(f, 0.f) & 0xffffu); }
__device__ __forceinline__ float sigmoidf_(float x) { return 1.0f / (1.0f + __expf(-x)); }
__device__ __forceinline__ float siluf_(float x) { return x / (1.0f + __expf(-x)); }
__device__ __forceinline__ float wave_sum(float v) {
#pragma unroll
  for (int o = 32; o > 0; o >>= 1) v += __shfl_xor(v, o);
  return v;
}
template <int CTRL, int RM, int BM> __device__ __forceinline__ float dpp_mov(float old, float v) { return __int_as_float(__builtin_amdgcn_update_dpp(__float_as_int(old), __float_as_int(v), CTRL, RM, BM, false)); }
__device__ __forceinline__ float wave_sum_u(float v) {
  v += dpp_mov<0xB1, 0xf, 0xf>(v, v);
  v += dpp_mov<0x4E, 0xf, 0xf>(v, v);
  v += dpp_mov<0x141, 0xf, 0xf>(v, v);
  v += dpp_mov<0x140, 0xf, 0xf>(v, v);
  v += dpp_mov<0x142, 0xa, 0xf>(0.f, v);
  v += dpp_mov<0x143, 0xc, 0xf>(0.f, v);
  return __int_as_float(__builtin_amdgcn_readlane(__float_as_int(v), 63));
}
__device__ __forceinline__ f32x16 zero16() { float z = 0.f; asm volatile("" : "+v"(z)); f32x16 r;
#pragma unroll
  for (int i = 0; i < 16; ++i) r[i] = z;
  return r; }
__device__ __forceinline__ int otid() { int t = threadIdx.x; asm volatile("" : "+v"(t)); return t; }
__device__ __forceinline__ int obid() { int b = blockIdx.x; asm volatile("" : "+s"(b)); return b; }
__device__ __forceinline__ int bidx_of_row(int row) { return row < NLAT ? row / T : 4; }
}

#include <vector>

#define XB_TMO      128
#define XB_XCNT(j)  (256  + 64 * (j))
#define XB_XSUB(j)  (1280 + 64 * (j))
#define XB_XGEN(j)  (2304 + 64 * (j))
#define XB_TOP      3328
#define XB_TOPGEN   3392
#define XCD_BAR_WORDS 3456
#define XB_SPIN_CAP (1u << 18)
#define LAS __attribute__((address_space(3)))

__device__ __forceinline__ unsigned xb_ld(unsigned* p)              { return __hip_atomic_load(p, __ATOMIC_RELAXED, __HIP_MEMORY_SCOPE_AGENT); }
__device__ __forceinline__ unsigned xb_add(unsigned* p, unsigned v) { return __hip_atomic_fetch_add(p, v, __ATOMIC_RELAXED, __HIP_MEMORY_SCOPE_AGENT); }
__device__ __forceinline__ unsigned xb_xcc_id() { return (unsigned)__builtin_amdgcn_s_getreg((3 << 11) | 20) & 0xFu; }
#define XB_SPIN(cond, bar) do { unsigned _sp = 0; while (cond) { __builtin_amdgcn_s_sleep(1); \
    if ((++_sp & 255u) == 0u) { if (xb_ld(&(bar)[XB_TMO])) break; if (_sp > XB_SPIN_CAP) { atomicAdd(&(bar)[XB_TMO], 1u); break; } } } } while (0)

struct XcdBarrier {
    unsigned* bar; unsigned x;
    volatile LAS unsigned* st;
};

__device__ __forceinline__ XcdBarrier xcd_barrier_post(unsigned* bar, volatile LAS unsigned* st) {
    XcdBarrier b; b.bar = bar; b.x = xb_xcc_id(); b.st = st;
    if (threadIdx.x == 0) (void)xb_add(&bar[XB_XCNT(b.x)], 1u);
    return b;
}
__device__ __forceinline__ void xcd_barrier_complete(unsigned* bar, unsigned x, unsigned& nloc, unsigned& nx) {
    const unsigned G = gridDim.x * gridDim.y * gridDim.z;
    unsigned sum, cnt, mine, sp = 0u;
    for (;;) {
        sum = 0u; cnt = 0u; mine = 0u;
#pragma unroll
        for (unsigned j = 0; j < 16; ++j) { const unsigned c = xb_ld(&bar[XB_XCNT(j)]); sum += c; cnt += (c > 0u) ? 1u : 0u; mine = (j == x) ? c : mine; }
        if (sum == G) break;
        __builtin_amdgcn_s_sleep(1);
        if ((++sp & 255u) == 0u) { if (xb_ld(&bar[XB_TMO])) break; if (sp > XB_SPIN_CAP) { atomicAdd(&bar[XB_TMO], 1u); break; } }
    }
    nloc = mine > 0u ? mine : 1u; nx = cnt > 0u ? cnt : 1u;
}

__device__ __forceinline__ void xcd_barrier(const XcdBarrier& b) {
    asm volatile("s_waitcnt vmcnt(0)" ::: "memory");
    __syncthreads();
    if (threadIdx.x == 0) {
        unsigned* bar = b.bar;
        __builtin_amdgcn_s_waitcnt(0);
        unsigned nloc = b.st[0], nx = b.st[1];
        if (nloc == 0u) { xcd_barrier_complete(bar, b.x, nloc, nx); b.st[0] = nloc; b.st[1] = nx; }
        const unsigned old = xb_add(&bar[XB_XSUB(b.x)], 1u);
        const unsigned gen = old / nloc;
        if (old + 1u == (gen + 1u) * nloc) {
            __builtin_amdgcn_fence(__ATOMIC_RELEASE, "agent");
            asm volatile("s_waitcnt vmcnt(0)" ::: "memory");
            const unsigned og = xb_add(&bar[XB_TOP], 1u);
            const unsigned tg = og / nx;
            if (og + 1u == (tg + 1u) * nx) xb_add(&bar[XB_TOPGEN], 1u);
            else XB_SPIN(xb_ld(&bar[XB_TOPGEN]) == tg, bar);
            __builtin_amdgcn_fence(__ATOMIC_ACQUIRE, "agent");
            xb_add(&bar[XB_XGEN(b.x)], 1u);
            asm volatile("s_waitcnt vmcnt(0)" ::: "memory");
        } else {
            XB_SPIN(xb_ld(&bar[XB_XGEN(b.x)]) == gen, bar);
            __builtin_amdgcn_fence(__ATOMIC_ACQUIRE, "agent");
            asm volatile("s_waitcnt vmcnt(0)" ::: "memory");
        }
    }
    __syncthreads();
}

namespace pg8 {
using mk::cvt_pk_bf16;
constexpr int BM = 256, BK = 64, HALF = 128, HTB = HALF * BK * 2  , STAGE_BYTES = 8 * HTB;
__host__ __device__ __forceinline__ int lds_byte(int r, int c) { const int st = (r >> 4) * 2 + (c >> 5), rr = r & 15, cc = c & 31, ob = rr * 64 + cc * 2; return st * 1024 + (ob ^ (((ob >> 9) & 1) << 5)); }
__host__ __device__ __forceinline__ void stage_rc(int b, int& R, int& C) { const int st = b / 1024, sb = b % 1024, swz = sb ^ (((sb >> 9) & 1) << 5); R = (st >> 1) * 16 + swz / 64; C = (st & 1) * 32 + (swz % 64) / 2; }
__host__ __device__ __forceinline__ int perm32(int rho) { const int n = rho >> 4, i = rho & 15; return 8 * (i >> 2) + 4 * n + (i & 3); }

struct Unit { const char* A; const char* Bt; bf16_t* out; int pm, pn, x0, x1, ldo, kind; };

template <class Epi, class Sched>
__device__ __forceinline__ void gemm_phase(LAS unsigned char* lds, const int K, const Sched& S, const Epi& E) {
    const int tid = mk::otid(), wid = __builtin_amdgcn_readfirstlane(tid >> 6), lane = tid & 63, wr = wid >> 2, wc = wid & 3, fr = lane & 15, fq = lane >> 4;
    const int nt = K / BK;
    unsigned voffA[2], voffB[2];
#pragma unroll
    for (int i = 0; i < 2; ++i) { int R, C; stage_rc(tid * 16 + i * 8192, R, C); const int Rb = Epi::PERM ? ((R & ~31) + perm32(R & 31)) : R;
        voffA[i] = (unsigned)(R * K + C) * 2u; voffB[i] = (unsigned)(Rb * K + C) * 2u; }
    const size_t kstep = (size_t)(BK * 2);
    const size_t hstep = (size_t)HALF * K * 2;
    const unsigned ldsw = (unsigned)wid * 1024u;
    const int aoff = lds_byte(wr * 64 + fr, fq * 8), boff = lds_byte(wc * 32 + fr, fq * 8);
#define PG8_SA(b, h) (((b) * 2 + (h)) * HTB)
#define PG8_SB(b, h) ((4 + (b) * 2 + (h)) * HTB)
#define PG8_STAGE(bufoff, gbase, voff) do { _Pragma("unroll") for (int _i = 0; _i < 2; ++_i) \
        __builtin_amdgcn_global_load_lds((const unsigned*)((const char*)(gbase) + (voff)[_i]), (LAS unsigned*)(lds + (bufoff) + ldsw + _i * 8192), 16, 0, 0); } while (0)
#define PG8_LDA(dst, b, h) do { _Pragma("unroll") for (int m = 0; m < 4; ++m) _Pragma("unroll") for (int k = 0; k < 2; ++k) dst[m][k] = *(const LAS bf16x8*)(lds + PG8_SA(b, h) + aoff + m * 2048 + k * 1024); } while (0)
#define PG8_LDB(dst, b, h) do { _Pragma("unroll") for (int n = 0; n < 2; ++n) _Pragma("unroll") for (int k = 0; k < 2; ++k) dst[n][k] = *(const LAS bf16x8*)(lds + PG8_SB(b, h) + boff + n * 2048 + k * 1024); } while (0)
#define PG8_MMA(ai, bj, At, Bt) do { __builtin_amdgcn_s_setprio(1); _Pragma("unroll") for (int m = 0; m < 4; ++m) _Pragma("unroll") for (int n = 0; n < 2; ++n) _Pragma("unroll") for (int k = 0; k < 2; ++k) \
        acc[ai][bj][m][n] = __builtin_amdgcn_mfma_f32_16x16x32_bf16(Bt[n][k], At[m][k], acc[ai][bj][m][n], 0, 0, 0); __builtin_amdgcn_s_setprio(0); } while (0)
#define PG8_WAIT_V(n) asm volatile("s_waitcnt vmcnt(" #n ")" ::: "memory")
#define PG8_WAIT_L(n) asm volatile("s_waitcnt lgkmcnt(" #n ")" ::: "memory")
#define PG8_BAR __builtin_amdgcn_s_barrier()
#define PG8_SCHED __builtin_amdgcn_sched_barrier(0)
    Unit cur, nxt; int ui = 0;
    if (!S.next(0, cur)) return;
    f32x4 acc[2][2][4][2];
#pragma unroll
    for (int a = 0; a < 2; ++a)
#pragma unroll
        for (int b = 0; b < 2; ++b)
#pragma unroll
            for (int m = 0; m < 4; ++m)
#pragma unroll
                for (int n = 0; n < 2; ++n) acc[a][b][m][n] = (f32x4){0.f, 0.f, 0.f, 0.f};
    bf16x8 At[4][2], B0[2][2], B1[2][2];
    const char* cA = cur.A; const char* cB = cur.Bt;
    PG8_STAGE(PG8_SB(0, 0), cB, voffB); PG8_STAGE(PG8_SA(0, 0), cA, voffA); PG8_STAGE(PG8_SB(0, 1), cB + hstep, voffB); PG8_STAGE(PG8_SA(0, 1), cA + hstep, voffA);
    if (wr == 1) PG8_BAR;
    PG8_WAIT_V(4); PG8_BAR;
    PG8_STAGE(PG8_SB(1, 0), cB + kstep, voffB); PG8_STAGE(PG8_SA(1, 0), cA + kstep, voffA); PG8_STAGE(PG8_SB(1, 1), cB + hstep + kstep, voffB);
    PG8_WAIT_V(6); PG8_BAR;
    for (;;) {
        const bool has_next = S.next(ui + 1, nxt);
        const char* nA = has_next ? nxt.A : cA; const char* nB = has_next ? nxt.Bt : cB;
        for (int t = 0; t < nt; t += 2) {
            const bool last = (t == nt - 2);
            const char* a1 = cA + (size_t)(t + 1) * kstep;
            const char* a2 = last ? nA : cA + (size_t)(t + 2) * kstep; const char* b2 = last ? nB : cB + (size_t)(t + 2) * kstep;
            const char* a3 = a2 + kstep; const char* b3 = b2 + kstep;
            PG8_LDB(B0, 0, 0); PG8_SCHED; PG8_LDA(At, 0, 0); PG8_STAGE(PG8_SA(1, 1), a1 + hstep, voffA);
            PG8_WAIT_L(8); PG8_BAR; PG8_WAIT_L(0); PG8_MMA(0, 0, At, B0); PG8_BAR; PG8_SCHED;
            PG8_LDB(B1, 0, 1); PG8_STAGE(PG8_SB(0, 0), b2, voffB);
            PG8_BAR; PG8_WAIT_L(0); PG8_MMA(0, 1, At, B1); PG8_BAR;
            PG8_LDA(At, 0, 1); PG8_STAGE(PG8_SA(0, 0), a2, voffA);
            PG8_BAR; PG8_WAIT_L(0); PG8_MMA(1, 0, At, B0); PG8_BAR; PG8_SCHED;
            PG8_STAGE(PG8_SB(0, 1), b2 + hstep, voffB);
            PG8_WAIT_V(6); PG8_BAR; PG8_MMA(1, 1, At, B1); PG8_BAR;
            PG8_LDB(B0, 1, 0); PG8_SCHED; PG8_LDA(At, 1, 0); PG8_STAGE(PG8_SA(0, 1), a2 + hstep, voffA);
            PG8_WAIT_L(8); PG8_BAR; PG8_WAIT_L(0); PG8_MMA(0, 0, At, B0); PG8_BAR; PG8_SCHED;
            PG8_LDB(B1, 1, 1); PG8_STAGE(PG8_SB(1, 0), b3, voffB);
            PG8_BAR; PG8_WAIT_L(0); PG8_MMA(0, 1, At, B1); PG8_BAR;
            PG8_LDA(At, 1, 1); PG8_STAGE(PG8_SA(1, 0), a3, voffA);
            PG8_BAR; PG8_WAIT_L(0); PG8_MMA(1, 0, At, B0); PG8_BAR; PG8_SCHED;
            PG8_STAGE(PG8_SB(1, 1), b3 + hstep, voffB);
            PG8_WAIT_V(6); PG8_BAR; PG8_MMA(1, 1, At, B1); PG8_BAR;
        }
        E(acc, cur, wr, wc, fr, fq);
        if (!has_next) break;
#pragma unroll
        for (int a = 0; a < 2; ++a)
#pragma unroll
            for (int b = 0; b < 2; ++b)
#pragma unroll
                for (int m = 0; m < 4; ++m)
#pragma unroll
                    for (int n = 0; n < 2; ++n) acc[a][b][m][n] = (f32x4){0.f, 0.f, 0.f, 0.f};
        cur = nxt; cA = nA; cB = nB; ++ui;
    }
    PG8_WAIT_V(0);
    if (wr == 0) PG8_BAR;
    PG8_BAR;
#undef PG8_SA
#undef PG8_SB
#undef PG8_STAGE
#undef PG8_LDA
#undef PG8_LDB
#undef PG8_MMA
#undef PG8_WAIT_V
#undef PG8_WAIT_L
#undef PG8_BAR
#undef PG8_SCHED
}

struct EpiStoreBf16 {
    static constexpr bool PERM = true;
    __device__ __forceinline__ void operator()(const f32x4 (&acc)[2][2][4][2], const Unit& u, int wr, int wc, int fr, int fq) const {
        bf16_t* O = u.out; const int ldc = u.ldo;
        const int row0 = u.x0 + wr * 64 + fr, col0 = u.x1 + wc * 32 + 8 * fq;
#pragma unroll
        for (int ai = 0; ai < 2; ++ai)
#pragma unroll
            for (int m = 0; m < 4; ++m) { bf16_t* rowp = O + (size_t)(row0 + ai * HALF + m * 16) * ldc + col0;
#pragma unroll
                for (int bj = 0; bj < 2; ++bj) { const f32x4 v0 = acc[ai][bj][m][0], v1 = acc[ai][bj][m][1];
                    u32x4 w; w.x = cvt_pk_bf16(v0[0], v0[1]); w.y = cvt_pk_bf16(v0[2], v0[3]); w.z = cvt_pk_bf16(v1[0], v1[1]); w.w = cvt_pk_bf16(v1[2], v1[3]);
                    *(u32x4*)(rowp + bj * HALF) = w; } }
    }
};
}

namespace mk {
struct NMapId { int off; __device__ __forceinline__ int operator()(int n) const { return n + off; } };
struct NMapInterleave { int which; __device__ __forceinline__ int operator()(int n) const { return 2 * n + which; } };
struct NMapRope { __device__ __forceinline__ int operator()(int n) const { if (n >= 2048) return n; const int ch = n >> 6, c = n & 63, half = c >> 5, w = c & 31, z = w >> 4, i = w & 15; return ch * 64 + half * 32 + 2 * i + z; } };

template <class NMap>
__device__ __forceinline__ void cvt_tile(const float* __restrict__ src, int ldsrc, int K, bf16_t* __restrict__ dst, int k0, int n0, const NMap& nmap, LAS float* tile) {
  const int t = mk::otid();
  { const int k = t >> 3, c = (t & 7) * 8; const float* p = src + (size_t)(k0 + k) * ldsrc + n0 + c;
    const f32x4 a = *(const f32x4*)p, b = *(const f32x4*)(p + 4);
    LAS float* q = tile + k * 65 + c; q[0] = a[0]; q[1] = a[1]; q[2] = a[2]; q[3] = a[3]; q[4] = b[0]; q[5] = b[1]; q[6] = b[2]; q[7] = b[3]; }
  __syncthreads();
  { const int n = t >> 3, kc = (t & 7) * 8; const LAS float* q = tile + kc * 65 + n;
    u32x4 w; w.x = cvt_pk_bf16(q[0], q[65]); w.y = cvt_pk_bf16(q[130], q[195]); w.z = cvt_pk_bf16(q[260], q[325]); w.w = cvt_pk_bf16(q[390], q[455]);
    *(u32x4*)(dst + (size_t)nmap(n0 + n) * K + k0 + kc) = w; }
  __syncthreads();
}
template <class NMap>
__device__ __forceinline__ int cvt_matrix(const float* src, int ldsrc, int K, int N, bf16_t* dst, const NMap& nmap, LAS float* tile, int ubase, int bid, int nblk) {
  const int nkt = K / 64, nnt = N / 64, tot = nkt * nnt;
  int first = ubase + ((bid - ubase % nblk) + nblk) % nblk;
  for (int u = first; u < ubase + tot; u += nblk) { const int v = u - ubase; cvt_tile(src, ldsrc, K, dst, (v / nnt) * 64, (v % nnt) * 64, nmap, tile); }
  return tot;
}
}

namespace att {
using namespace mk;
constexpr int KB_BYTES = 64 * 128, VB_BYTES = 128 * 128, DA_LDS = 2 * (KB_BYTES + VB_BYTES);
__device__ __forceinline__ int pi32(int r) { return (r & ~12) | ((r & 4) << 1) | ((r & 8) >> 1); }
__device__ __forceinline__ int swz(int row, int chunk) { return row * 128 + ((chunk ^ ((row >> 1) & 7)) << 4); }
__device__ __forceinline__ int crow(int r, int hi) { return (r & 3) + 8 * (r >> 2) + 4 * hi; }

__device__ __forceinline__ void diff_attn_unit(const bf16_t* __restrict__ Pqk, const bf16_t* __restrict__ Vt, bf16_t* __restrict__ O12, int hh, int q0, int klat0, int nlat, int kctx0, LAS unsigned char* lds) {
  const int tid = mk::otid(), wid = tid >> 6, lane = tid & 63, r = lane & 31, hi = lane >> 5;
  const int NT = (nlat + L) / 64, NTL = nlat / 64;
  constexpr float C = 0.125f * 1.4426950408889634f;
  constexpr float THR = 8.0f / 0.125f;
  const int srow = tid >> 3, sch = tid & 7;
  const bf16_t* kbase = Pqk + 1024 + hh * 64 + sch * 8;
  const bf16_t* vbase = Vt + (size_t)((hh >> 1) * 128 + srow) * NTOK + sch * 8;
  const int kdst = swz(srow, sch), vdst0 = swz(srow, sch), vdst1 = swz(srow + 64, sch);
  bf16x8 qf[4];
  { const bf16_t* qp = Pqk + (size_t)(q0 + wid * 32 + r) * 2048 + hh * 64 + hi * 8;
#pragma unroll
    for (int ks = 0; ks < 4; ++ks) qf[ks] = *(const bf16x8*)(qp + ks * 16); }
  int kaddr[2];
#pragma unroll
  for (int kb = 0; kb < 2; ++kb) kaddr[kb] = (kb * 32 + pi32(r)) * 128;
  const int kx = (pi32(r) >> 1) & 7;
  const int vx = (r >> 1) & 7;
  f32x16 o[4];
#pragma unroll
  for (int vb = 0; vb < 4; ++vb)
#pragma unroll
    for (int i = 0; i < 16; ++i) o[vb][i] = 0.f;
  float m_run = -1e30f, l_run = 0.f;
  u32x4 kreg, vreg0, vreg1;
#define DA_LOAD(t) do { const int tok = (t) < NTL ? klat0 + (t) * 64 : kctx0 + ((t) - NTL) * 64; \
    kreg = *(const u32x4*)(kbase + (size_t)(tok + srow) * 2048); vreg0 = *(const u32x4*)(vbase + tok); vreg1 = *(const u32x4*)(vbase + (size_t)64 * NTOK + tok); } while (0)
#define DA_WRITE(bufi) do { LAS unsigned char* kb_ = lds + (bufi) * KB_BYTES; LAS unsigned char* vb_ = lds + 2 * KB_BYTES + (bufi) * VB_BYTES; \
    *(LAS u32x4*)(kb_ + kdst) = kreg; *(LAS u32x4*)(vb_ + vdst0) = vreg0; *(LAS u32x4*)(vb_ + vdst1) = vreg1; } while (0)
  DA_LOAD(0); DA_WRITE(0); __syncthreads();
  for (int t = 0; t < NT; ++t) {
    const bool more = t + 1 < NT;
    if (more) DA_LOAD(t + 1);
    const LAS unsigned char* kb_ = lds + (t & 1) * KB_BYTES; const LAS unsigned char* vb_ = lds + 2 * KB_BYTES + (t & 1) * VB_BYTES;
    f32x16 s0, s1;
#pragma unroll
    for (int i = 0; i < 16; ++i) { s0[i] = 0.f; s1[i] = 0.f; }
#pragma unroll
    for (int ks = 0; ks < 4; ++ks) {
      const int ch = ((ks * 2 + hi) ^ kx) << 4;
      const bf16x8 a0 = *(const LAS bf16x8*)(kb_ + kaddr[0] + ch), a1 = *(const LAS bf16x8*)(kb_ + kaddr[1] + ch);
      s0 = __builtin_amdgcn_mfma_f32_32x32x16_bf16(a0, qf[ks], s0, 0, 0, 0);
      s1 = __builtin_amdgcn_mfma_f32_32x32x16_bf16(a1, qf[ks], s1, 0, 0, 0);
    }
    bf16x8 va[4][4];
#pragma unroll
    for (int vb = 0; vb < 4; ++vb) {
      const LAS unsigned char* vrow = vb_ + (vb * 32 + r) * 128;
#pragma unroll
      for (int c4 = 0; c4 < 4; ++c4) va[vb][c4] = *(const LAS bf16x8*)(vrow + (((2 * c4 + hi) ^ vx) << 4));
    }
    float mx = fmaxf(s0[0], s1[0]);
#pragma unroll
    for (int i = 1; i < 16; ++i) mx = fmaxf(mx, fmaxf(s0[i], s1[i]));
    { const u32x2 sw = __builtin_amdgcn_permlane32_swap(__float_as_uint(mx), __float_as_uint(mx), false, false); mx = fmaxf(__uint_as_float(sw.x), __uint_as_float(sw.y)); }
    float alpha = 1.0f;
    if (!__all(mx - m_run <= THR)) {
      const float m_new = fmaxf(m_run, mx);
      alpha = __builtin_amdgcn_exp2f((m_run - m_new) * C);
      m_run = m_new;
#pragma unroll
      for (int vb = 0; vb < 4; ++vb)
#pragma unroll
        for (int i = 0; i < 16; ++i) o[vb][i] *= alpha;
    }
    const float mc = -m_run * C;
    float ps = 0.f;
#pragma unroll
    for (int i = 0; i < 16; ++i) { s0[i] = __builtin_amdgcn_exp2f(fmaf(s0[i], C, mc)); ps += s0[i]; }
#pragma unroll
    for (int i = 0; i < 16; ++i) { s1[i] = __builtin_amdgcn_exp2f(fmaf(s1[i], C, mc)); ps += s1[i]; }
    l_run = l_run * alpha + ps;
    bf16x8 pf[2][2];
#pragma unroll
    for (int s = 0; s < 2; ++s) {
      u32x4 w0, w1;
      w0.x = cvt_pk_bf16(s0[8 * s + 0], s0[8 * s + 1]); w0.y = cvt_pk_bf16(s0[8 * s + 2], s0[8 * s + 3]); w0.z = cvt_pk_bf16(s0[8 * s + 4], s0[8 * s + 5]); w0.w = cvt_pk_bf16(s0[8 * s + 6], s0[8 * s + 7]);
      w1.x = cvt_pk_bf16(s1[8 * s + 0], s1[8 * s + 1]); w1.y = cvt_pk_bf16(s1[8 * s + 2], s1[8 * s + 3]); w1.z = cvt_pk_bf16(s1[8 * s + 4], s1[8 * s + 5]); w1.w = cvt_pk_bf16(s1[8 * s + 6], s1[8 * s + 7]);
      pf[0][s] = __builtin_bit_cast(bf16x8, w0); pf[1][s] = __builtin_bit_cast(bf16x8, w1);
    }
#pragma unroll
    for (int vb = 0; vb < 4; ++vb)
#pragma unroll
      for (int kb = 0; kb < 2; ++kb)
#pragma unroll
        for (int s = 0; s < 2; ++s) o[vb] = __builtin_amdgcn_mfma_f32_32x32x16_bf16(va[vb][kb * 2 + s], pf[kb][s], o[vb], 0, 0, 0);
    if (more) DA_WRITE((t + 1) & 1);
    __syncthreads();
  }
#undef DA_LOAD
#undef DA_WRITE
  float l_tot; { const u32x2 sw = __builtin_amdgcn_permlane32_swap(__float_as_uint(l_run), __float_as_uint(l_run), false, false); l_tot = __uint_as_float(sw.x) + __uint_as_float(sw.y); }
  const float inv = 1.0f / l_tot;
  bf16_t* op = O12 + (size_t)(q0 + wid * 32 + r) * 2048 + hh * 128 + 4 * hi;
#pragma unroll
  for (int vb = 0; vb < 4; ++vb)
#pragma unroll
    for (int g = 0; g < 4; ++g) {
      u32x2 w; w.x = cvt_pk_bf16(o[vb][4 * g] * inv, o[vb][4 * g + 1] * inv); w.y = cvt_pk_bf16(o[vb][4 * g + 2] * inv, o[vb][4 * g + 3] * inv);
      *(u32x2*)(op + vb * 32 + 8 * g) = w;
    }
}

__device__ __forceinline__ void diff_combine_rows4(const bf16_t* __restrict__ O12, const float* __restrict__ subln_g, float lam, float oml, bf16_t* __restrict__ O, int row0, int h, int lane) {
  unsigned a[4], b[4];
#pragma unroll
  for (int i = 0; i < 4; ++i) { a[i] = *(const unsigned*)(O12 + (size_t)(row0 + i) * 2048 + (2 * h) * 128 + 2 * lane); b[i] = *(const unsigned*)(O12 + (size_t)(row0 + i) * 2048 + (2 * h + 1) * 128 + 2 * lane); }
  const float g0 = subln_g[2 * lane], g1 = subln_g[2 * lane + 1];
#pragma unroll
  for (int i = 0; i < 4; ++i) {
    const float x0 = bflo(a[i]) - lam * bflo(b[i]), x1 = bfhi(a[i]) - lam * bfhi(b[i]);
    const float ss = wave_sum_u(x0 * x0 + x1 * x1);
    const float rs = rsqrtf(ss * (1.0f / 128.0f) + 1e-5f) * oml;
    *(unsigned*)(O + (size_t)(row0 + i) * 1024 + h * 128 + 2 * lane) = cvt_pk_bf16(x0 * rs * g0, x1 * rs * g1);
  }
}
}

namespace natt {
using namespace mk;
using att::pi32; using att::swz;
constexpr int TB = 64 * 128;
constexpr int NA_LDS = 4 * TB + 2048;
__device__ __forceinline__ void na_attn_unit(const bf16_t* __restrict__ Pe, const bf16_t* __restrict__ Vte, const float* __restrict__ rpb_h, bf16_t* __restrict__ O, int b, int h, int rq, LAS unsigned char* lds) {
  const int tid = mk::otid(), wid = tid >> 6, lane = tid & 63, r = lane & 31, hi = lane >> 5;
  constexpr float LOG2E = 1.4426950408889634f;
  LAS float* sb = (LAS float*)(lds + 4 * TB);
  for (int i = tid; i < 465; i += NTHR) sb[i] = rpb_h[i];
  const bool is_ctx = rq < 0;
  int qrow = 0, qcol = 0, qtok, rs_q = 0, cs_q = 0, span0 = 0, wlo = 0, whi = -1, lo = 0, ntl = 0;
  if (!is_ctx) {
    const int r0 = rq * 4, ra = r0 + (wid >> 2) * 2;
    qrow = ra + (r >> 4); qcol = (wid & 3) * 16 + (r & 15); qtok = b * T + qrow * 64 + qcol;
    rs_q = min(max(qrow - 4, 0), 120); cs_q = min(max(qcol - 8, 0), 48);
    span0 = min(max((wid & 3) * 16 - 8, 0), 32);
    wlo = min(max(ra - 4, 0), 120); whi = min(max(ra - 3, 0), 120) + 7;
    lo = min(max(r0 - 4, 0), 120); const int hi_ = min(max(r0 - 1, 0), 120) + 7; ntl = hi_ - lo + 1;
  } else qtok = NLAT + b * L + wid * 32 + r;
  const int NT = ntl + 4;
  const int srow = tid >> 3, sch = tid & 7;
  const bf16_t* kbase = Pe + 512 + h * 64 + sch * 8;
  const bf16_t* vbase = Vte + (size_t)(h * 64 + srow) * NTOK + sch * 8;
  const int sdst = swz(srow, sch);
  bf16x8 qf[4];
  { const bf16_t* qp = Pe + (size_t)qtok * 1024 + h * 64 + hi * 8;
#pragma unroll
    for (int ks = 0; ks < 4; ++ks) qf[ks] = *(const bf16x8*)(qp + ks * 16); }
  const int kx = (pi32(r) >> 1) & 7, vx = (r >> 1) & 7;
  const int ka_loc = (span0 + pi32(r)) * 128; const int kx_loc = ((span0 + pi32(r)) >> 1) & 7;
  f32x16 o[2];
#pragma unroll
  for (int vb = 0; vb < 2; ++vb)
#pragma unroll
    for (int i = 0; i < 16; ++i) o[vb][i] = 0.f;
  float m_run = -1e30f, l_run = 0.f;
  u32x4 kreg, vreg;
#define NA_LOAD(t) do { const int tok = (t) < ntl ? b * T + (lo + (t)) * 64 : NLAT + b * L + ((t) - ntl) * 64; \
    kreg = *(const u32x4*)(kbase + (size_t)(tok + srow) * 1024); vreg = *(const u32x4*)(vbase + tok); } while (0)
#define NA_WRITE(bufi) do { *(LAS u32x4*)(lds + (bufi) * TB + sdst) = kreg; *(LAS u32x4*)(lds + 2 * TB + (bufi) * TB + sdst) = vreg; } while (0)
  NA_LOAD(0); NA_WRITE(0); __syncthreads();
  for (int t = 0; t < NT; ++t) {
    const bool more = t + 1 < NT;
    if (more) NA_LOAD(t + 1);
    const LAS unsigned char* kb_ = lds + (t & 1) * TB; const LAS unsigned char* vb_ = lds + 2 * TB + (t & 1) * TB;
    const bool local = t < ntl; const int kr = lo + t;
    const bool active = !local || (kr >= wlo && kr <= whi);
    if (active) {
      f32x16 s0, s1;
#pragma unroll
      for (int i = 0; i < 16; ++i) { s0[i] = 0.f; s1[i] = 0.f; }
      if (local) {
#pragma unroll
        for (int ks = 0; ks < 4; ++ks) {
          const bf16x8 a0 = *(const LAS bf16x8*)(kb_ + ka_loc + (((ks * 2 + hi) ^ kx_loc) << 4));
          s0 = __builtin_amdgcn_mfma_f32_32x32x16_bf16(a0, qf[ks], s0, 0, 0, 0);
        }
        const bool row_ok = kr >= rs_q && kr < rs_q + 8; const int dr31 = (kr - qrow + 7) * 31;
#pragma unroll
        for (int i = 0; i < 16; ++i) {
          const int kc = span0 + (i & 7) + 8 * hi + 16 * (i >> 3);
          const bool ok = row_ok && kc >= cs_q && kc < cs_q + 16;
          const int bi = ok ? dr31 + (kc - qcol + 15) : 0;
          const float bv = sb[bi];
          s0[i] = ok ? fmaf(s0[i], 0.125f, bv) : -1e30f; s1[i] = -1e30f;
        }
      } else {
#pragma unroll
        for (int ks = 0; ks < 4; ++ks) {
          const int ch = ((ks * 2 + hi) ^ kx) << 4;
          const bf16x8 a0 = *(const LAS bf16x8*)(kb_ + pi32(r) * 128 + ch), a1 = *(const LAS bf16x8*)(kb_ + (32 + pi32(r)) * 128 + ch);
          s0 = __builtin_amdgcn_mfma_f32_32x32x16_bf16(a0, qf[ks], s0, 0, 0, 0);
          s1 = __builtin_amdgcn_mfma_f32_32x32x16_bf16(a1, qf[ks], s1, 0, 0, 0);
        }
#pragma unroll
        for (int i = 0; i < 16; ++i) { s0[i] *= 0.125f; s1[i] *= 0.125f; }
      }
      float mx = s0[0];
#pragma unroll
      for (int i = 1; i < 16; ++i) mx = fmaxf(mx, s0[i]);
#pragma unroll
      for (int i = 0; i < 16; ++i) mx = fmaxf(mx, s1[i]);
      { const u32x2 sw = __builtin_amdgcn_permlane32_swap(__float_as_uint(mx), __float_as_uint(mx), false, false); mx = fmaxf(__uint_as_float(sw.x), __uint_as_float(sw.y)); }
      const float m_new = fmaxf(m_run, mx);
      const float alpha = __builtin_amdgcn_exp2f((m_run - m_new) * LOG2E);
      m_run = m_new;
      const float mc = -m_new * LOG2E;
      float ps = 0.f;
#pragma unroll
      for (int i = 0; i < 16; ++i) { const float p = s0[i] > -1e29f ? __builtin_amdgcn_exp2f(fmaf(s0[i], LOG2E, mc)) : 0.f; s0[i] = p; ps += p; }
#pragma unroll
      for (int i = 0; i < 16; ++i) { const float p = s1[i] > -1e29f ? __builtin_amdgcn_exp2f(fmaf(s1[i], LOG2E, mc)) : 0.f; s1[i] = p; ps += p; }
      l_run = l_run * alpha + ps;
      if (__any(alpha < 1.0f)) {
#pragma unroll
        for (int vb = 0; vb < 2; ++vb)
#pragma unroll
          for (int i = 0; i < 16; ++i) o[vb][i] *= alpha;
      }
      bf16x8 pf[2][2];
#pragma unroll
      for (int s = 0; s < 2; ++s) {
        u32x4 w0, w1;
        w0.x = cvt_pk_bf16(s0[8 * s + 0], s0[8 * s + 1]); w0.y = cvt_pk_bf16(s0[8 * s + 2], s0[8 * s + 3]); w0.z = cvt_pk_bf16(s0[8 * s + 4], s0[8 * s + 5]); w0.w = cvt_pk_bf16(s0[8 * s + 6], s0[8 * s + 7]);
        w1.x = cvt_pk_bf16(s1[8 * s + 0], s1[8 * s + 1]); w1.y = cvt_pk_bf16(s1[8 * s + 2], s1[8 * s + 3]); w1.z = cvt_pk_bf16(s1[8 * s + 4], s1[8 * s + 5]); w1.w = cvt_pk_bf16(s1[8 * s + 6], s1[8 * s + 7]);
        pf[0][s] = __builtin_bit_cast(bf16x8, w0); pf[1][s] = __builtin_bit_cast(bf16x8, w1);
      }
      const int cbase = local ? (span0 >> 3) : 0;
#pragma unroll
      for (int vb = 0; vb < 2; ++vb) {
        const LAS unsigned char* vrow = vb_ + (vb * 32 + r) * 128;
#pragma unroll
        for (int s = 0; s < 2; ++s) {
          const bf16x8 a = *(const LAS bf16x8*)(vrow + (((cbase + 2 * s + hi) ^ vx) << 4));
          o[vb] = __builtin_amdgcn_mfma_f32_32x32x16_bf16(a, pf[0][s], o[vb], 0, 0, 0);
        }
        if (!local) {
#pragma unroll
          for (int s = 0; s < 2; ++s) {
            const bf16x8 a = *(const LAS bf16x8*)(vrow + (((4 + 2 * s + hi) ^ vx) << 4));
            o[vb] = __builtin_amdgcn_mfma_f32_32x32x16_bf16(a, pf[1][s], o[vb], 0, 0, 0);
          }
        }
      }
    }
    if (more) NA_WRITE((t + 1) & 1);
    __syncthreads();
  }
#undef NA_LOAD
#undef NA_WRITE
  float l_tot; { const u32x2 sw = __builtin_amdgcn_permlane32_swap(__float_as_uint(l_run), __float_as_uint(l_run), false, false); l_tot = __uint_as_float(sw.x) + __uint_as_float(sw.y); }
  const float inv = 1.0f / l_tot;
  bf16_t* op = O + (size_t)qtok * 1024 + h * 64 + 4 * hi;
#pragma unroll
  for (int vb = 0; vb < 2; ++vb)
#pragma unroll
    for (int g = 0; g < 4; ++g) {
      u32x2 w; w.x = cvt_pk_bf16(o[vb][4 * g] * inv, o[vb][4 * g + 1] * inv); w.y = cvt_pk_bf16(o[vb][4 * g + 2] * inv, o[vb][4 * g + 3] * inv);
      *(u32x2*)(op + vb * 32 + 8 * g) = w;
    }
}
}

namespace rw {
using namespace mk;
constexpr int CL = 256, NCH = T / CL;
constexpr int NCHAIN = 2 * B * 8;
constexpr float LOG2E = 1.4426950408889634f;
struct Bufs {
  u32x2* SH;
  unsigned* DR;
  bf16_t* G; int gstride;
  float* CS;
  float* PQ;
  float* SST;
  bf16_t* Y;
};

__device__ __forceinline__ void prep_tile(const bf16_t* __restrict__ Prw, const float* __restrict__ cw, const float* __restrict__ w0, const float* __restrict__ w_up, const float* __restrict__ a0,
                                          const float* __restrict__ a_up, const float* __restrict__ g_up, const float* __restrict__ k_k, const float* __restrict__ k_a, const float* __restrict__ r_k,
                                          const Bufs& bf, int tile, LAS float* xs  ) {
  const int c = mk::otid(), lane = c & 63, h = c >> 6;
  const int row0 = tile * 16;
  int lo, hi;
  if (row0 < NLAT) { lo = (row0 / T) * T; hi = lo + T - 1; } else { lo = NLAT + ((row0 - NLAT) / L) * L; hi = lo + L - 1; }
#define RW_CONV(dst, col) do { const float c0 = cw[(col)], c1 = cw[RW_IN + (col)], c2 = cw[2 * RW_IN + (col)]; const bf16_t* p = Prw + (size_t)row0 * RW_IN + (col); \
    float pm = row0 > lo ? bf2f(p[-RW_IN]) : 0.f, pc = bf2f(p[0]); \
    _Pragma("unroll") for (int tt = 0; tt < 16; ++tt) { const float pn = (row0 + tt + 1 <= hi) ? bf2f(p[(size_t)(tt + 1) * RW_IN]) : 0.f; dst[tt] = pm * c0 + pc * c1 + pn * c2; pm = pc; pc = pn; } } while (0)
  if (c < 256) {
    float xv[16]; RW_CONV(xv, 1536 + c);
#pragma unroll
    for (int tt = 0; tt < 16; ++tt) { float v = xv[tt]; if (c < 64) v = tanhf(v); else if (c >= 128) v = sigmoidf_(v); xs[c * 16 + tt] = v; }
  }
  __syncthreads();
  const float w00 = w0[c], w01 = w0[512 + c], a00 = a0[c], a01 = a0[512 + c], kkc = k_k[c], kac = k_a[c], rkc = r_k[c];
  float e0[16], e1[16];
  {
    float aw0[16], aw1[16];
#pragma unroll
    for (int tt = 0; tt < 16; ++tt) { aw0[tt] = 0.f; aw1[tt] = 0.f; }
    float nw0[8], nw1[8];
#pragma unroll
    for (int u = 0; u < 8; ++u) { nw0[u] = w_up[(size_t)u * 512 + c]; nw1[u] = w_up[(size_t)(64 + u) * 512 + c]; }
    for (int m0 = 0; m0 < 64; m0 += 8) {
      float ww0[8], ww1[8];
      const int mn = m0 + 8 < 64 ? m0 + 8 : m0;
#pragma unroll
      for (int u = 0; u < 8; ++u) { ww0[u] = nw0[u]; ww1[u] = nw1[u]; nw0[u] = w_up[(size_t)(mn + u) * 512 + c]; nw1[u] = w_up[(size_t)(64 + mn + u) * 512 + c]; }
#pragma unroll
      for (int u = 0; u < 8; ++u) {
#pragma unroll
        for (int q = 0; q < 4; ++q) { const f32x4 xw = *(const LAS f32x4*)(xs + (m0 + u) * 16 + q * 4);
#pragma unroll
          for (int e = 0; e < 4; ++e) { aw0[q * 4 + e] += xw[e] * ww0[u]; aw1[q * 4 + e] += xw[e] * ww1[u]; } }
      }
    }
#pragma unroll
    for (int tt = 0; tt < 16; ++tt) {
      { const float z = -(w00 + aw0[tt]); const float sp = fmaxf(z, 0.f) + __logf(1.0f + __expf(-fabsf(z))); e0[tt] = __expf(-sp - 0.5f); }
      { const float z = -(w01 + aw1[tt]); const float sp = fmaxf(z, 0.f) + __logf(1.0f + __expf(-fabsf(z))); e1[tt] = __expf(-sp - 0.5f); }
    }
  }
  LAS float* asl = xs + 256 * 16;
  {
    float aa0[16], aa1[16];
#pragma unroll
    for (int tt = 0; tt < 16; ++tt) { aa0[tt] = 0.f; aa1[tt] = 0.f; }
    float na0[8], na1[8];
#pragma unroll
    for (int u = 0; u < 8; ++u) { na0[u] = a_up[(size_t)u * 512 + c]; na1[u] = a_up[(size_t)(64 + u) * 512 + c]; }
    for (int m0 = 0; m0 < 64; m0 += 8) {
      float av0[8], av1[8];
      const int mn = m0 + 8 < 64 ? m0 + 8 : m0;
#pragma unroll
      for (int u = 0; u < 8; ++u) { av0[u] = na0[u]; av1[u] = na1[u]; na0[u] = a_up[(size_t)(mn + u) * 512 + c]; na1[u] = a_up[(size_t)(64 + mn + u) * 512 + c]; }
#pragma unroll
      for (int u = 0; u < 8; ++u) {
#pragma unroll
        for (int q = 0; q < 4; ++q) { const f32x4 xa = *(const LAS f32x4*)(xs + (64 + m0 + u) * 16 + q * 4);
#pragma unroll
          for (int e = 0; e < 4; ++e) { aa0[q * 4 + e] += xa[e] * av0[u]; aa1[q * 4 + e] += xa[e] * av1[u]; } }
      }
    }
#pragma unroll
    for (int tt = 0; tt < 16; ++tt) { const unsigned d0 = cvt_pk_bf16(e0[tt], sigmoidf_(a00 + aa0[tt])), d1 = cvt_pk_bf16(e1[tt], sigmoidf_(a01 + aa1[tt]));
      bf.DR[((size_t)(row0 + tt)) * 512 + c] = d0; bf.DR[((size_t)NTOK + row0 + tt) * 512 + c] = d1; asl[tt * 512 + c] = bfhi(d0); asl[(16 + tt) * 512 + c] = bfhi(d1); }
  }
  {
    float ag[16];
#pragma unroll
    for (int tt = 0; tt < 16; ++tt) ag[tt] = 0.f;
    float ng[16];
#pragma unroll
    for (int u = 0; u < 16; ++u) ng[u] = g_up[(size_t)u * 512 + c];
    for (int m0 = 0; m0 < 128; m0 += 16) {
      float gg[16];
      const int mn = m0 + 16 < 128 ? m0 + 16 : m0;
#pragma unroll
      for (int u = 0; u < 16; ++u) { gg[u] = ng[u]; ng[u] = g_up[(size_t)(mn + u) * 512 + c]; }
#pragma unroll
      for (int u = 0; u < 16; ++u) {
#pragma unroll
        for (int q = 0; q < 4; ++q) { const f32x4 xg = *(const LAS f32x4*)(xs + (128 + m0 + u) * 16 + q * 4);
#pragma unroll
          for (int e = 0; e < 4; ++e) ag[q * 4 + e] += xg[e] * gg[u]; }
      }
    }
#pragma unroll
    for (int tt = 0; tt < 16; ++tt) bf.G[(size_t)(row0 + tt) * bf.gstride + c] = f2bf(ag[tt]);
  }
#undef RW_CONV
  const float cr0 = cw[c], cr1 = cw[RW_IN + c], cr2 = cw[2 * RW_IN + c], ck0 = cw[512 + c], ck1 = cw[RW_IN + 512 + c], ck2 = cw[2 * RW_IN + 512 + c], cv0 = cw[1024 + c], cv1 = cw[RW_IN + 1024 + c], cv2 = cw[2 * RW_IN + 1024 + c];
  const bf16_t* pr = Prw + (size_t)row0 * RW_IN + c;
  float rm = row0 > lo ? bf2f(pr[-RW_IN]) : 0.f, km = row0 > lo ? bf2f(pr[512 - RW_IN]) : 0.f, vm = row0 > lo ? bf2f(pr[1024 - RW_IN]) : 0.f;
  float rc = bf2f(pr[0]), kc = bf2f(pr[512]), vc = bf2f(pr[1024]);
#pragma unroll 2
  for (int tt = 0; tt < 16; ++tt) {
    const int row = row0 + tt;
    const bool has_n = row + 1 <= hi; const bf16_t* pn = pr + (size_t)(tt + 1) * RW_IN;
    const float rn = has_n ? bf2f(pn[0]) : 0.f, kn = has_n ? bf2f(pn[512]) : 0.f, vn = has_n ? bf2f(pn[1024]) : 0.f;
    const float rv = rm * cr0 + rc * cr1 + rn * cr2, kvv = km * ck0 + kc * ck1 + kn * ck2, vvv = vm * cv0 + vc * cv1 + vn * cv2;
    rm = rc; rc = rn; km = kc; kc = kn; vm = vc; vc = vn;
    float kk = kvv * kkc; const float nrm = sqrtf(wave_sum_u(kk * kk)); kk = kk * __builtin_amdgcn_rcpf(fmaxf(nrm, 1e-12f));
    u32x2 sh; sh.x = cvt_pk_bf16(rv, kvv); sh.y = cvt_pk_bf16(kk, vvv);
    bf.SH[(size_t)row * 512 + c] = sh;
    const float rq = bflo(sh.x), kq = bfhi(sh.x);
    const float cb0 = wave_sum_u(rq * kq * (1.0f + (asl[tt * 512 + c] - 1.0f) * kac) * rkc), cb1 = wave_sum_u(rq * kq * (1.0f + (asl[(16 + tt) * 512 + c] - 1.0f) * kac) * rkc);
    if (lane == 0) { bf.CS[(size_t)row * 16 + h] = cb0; bf.CS[(size_t)row * 16 + 8 + h] = cb1; }
  }
  __syncthreads();
}

struct StepRaw { u32x2 s; unsigned d; };
__device__ __forceinline__ int scan_row(int dir, int b, bool ctx, int chunk, int s) {
  if (ctx) return NLAT + b * L + (dir ? (L - 1 - s) : s);
  const int p = chunk * CL + s; return b * T + (dir ? (T - 1 - p) : p);
}
#define RW_RL(x, j) __int_as_float(__builtin_amdgcn_readlane(__float_as_int(x), (j)))
template <int MODE>
__device__ __forceinline__ void scan_unit(const Bufs& bf, const float* __restrict__ k_a, int chain, bool ctx, int chunk) {
  const int lane = mk::otid() & 63;
  const int dir = chain >> 5, b = (chain >> 3) & 3, h = chain & 7, ch = h * 64 + lane;
  const float kac = k_a[ch];
  float S[64], P[64];
  if (MODE == 0) {
#pragma unroll
    for (int j = 0; j < 64; ++j) { S[j] = 0.f; P[j] = (j == lane) ? 1.f : 0.f; }
  } else {
    if (ctx) {
#pragma unroll
      for (int j = 0; j < 64; ++j) S[j] = 0.f;
    } else {
      const float* sp = bf.SST + ((size_t)chain * NCH + chunk) * 4096 + lane * 64;
#pragma unroll
      for (int q = 0; q < 16; ++q) { const f32x4 v = *(const f32x4*)(sp + q * 4); S[q * 4] = v[0]; S[q * 4 + 1] = v[1]; S[q * 4 + 2] = v[2]; S[q * 4 + 3] = v[3]; }
    }
  }
  StepRaw nx; { const int row = scan_row(dir, b, ctx, chunk, 0); nx.s = bf.SH[(size_t)row * 512 + ch]; nx.d = bf.DR[((size_t)dir * NTOK + row) * 512 + ch]; }
  for (int s = 0; s < CL; ++s) {
    const StepRaw cu = nx; const int row = scan_row(dir, b, ctx, chunk, s);
    if (s + 1 < CL) { const int rn = scan_row(dir, b, ctx, chunk, s + 1); nx.s = bf.SH[(size_t)rn * 512 + ch]; nx.d = bf.DR[((size_t)dir * NTOK + rn) * 512 + ch]; }
    const float r = bflo(cu.s.x), k = bfhi(cu.s.x), kk = bflo(cu.s.y), v = bfhi(cu.s.y), e = bflo(cu.d), asg = bfhi(cu.d);
    const float w = __builtin_amdgcn_exp2f(-e * LOG2E), a = -kk, bb = kk * asg, keff = k * (1.0f + (asg - 1.0f) * kac);
    float sa = 0.f, sap = 0.f;
#pragma unroll
    for (int j = 0; j < 64; ++j) { const float aj = RW_RL(a, j); sa = fmaf(S[j], aj, sa); if (MODE == 0) sap = fmaf(P[j], aj, sap); }
    float y = 0.f;
#pragma unroll
    for (int j = 0; j < 64; ++j) {
      const float wj = RW_RL(w, j), bj = RW_RL(bb, j), kj = RW_RL(keff, j);
      float t = v * kj; t = fmaf(sa, bj, t); S[j] = fmaf(S[j], wj, t);
      if (MODE == 0) P[j] = fmaf(P[j], wj, sap * bj);
      else { const float rj = RW_RL(r, j); y = fmaf(S[j], rj, y); }
    }
    if (MODE == 1) bf.Y[((size_t)dir * NTOK + row) * 512 + ch] = f2bf(y);
  }
  if (MODE == 0) {
    float* pq = bf.PQ + (((size_t)chain * (NCH - 1) + chunk) * 2) * 4096 + lane * 64;
#pragma unroll
    for (int q = 0; q < 16; ++q) { *(f32x4*)(pq + q * 4) = (f32x4){P[q * 4], P[q * 4 + 1], P[q * 4 + 2], P[q * 4 + 3]}; *(f32x4*)(pq + 4096 + q * 4) = (f32x4){S[q * 4], S[q * 4 + 1], S[q * 4 + 2], S[q * 4 + 3]}; }
  } else if (ctx) {
    float* sp = bf.SST + ((size_t)chain * NCH) * 4096 + lane * 64;
#pragma unroll
    for (int q = 0; q < 16; ++q) *(f32x4*)(sp + q * 4) = (f32x4){S[q * 4], S[q * 4 + 1], S[q * 4 + 2], S[q * 4 + 3]};
  }
}

__device__ __forceinline__ void propagate_chain(const Bufs& bf, int chain, LAS float* lds) {
  LAS float* Sl = lds; LAS float* Pl = lds + 64 * 65;
  const int tid = mk::otid(), i = tid >> 3, jg = (tid & 7) * 8;
  float* sst = bf.SST + (size_t)chain * NCH * 4096;
  { const f32x4 a = *(const f32x4*)(sst + i * 64 + jg), b2 = *(const f32x4*)(sst + i * 64 + jg + 4);
    Sl[i * 65 + jg] = a[0]; Sl[i * 65 + jg + 1] = a[1]; Sl[i * 65 + jg + 2] = a[2]; Sl[i * 65 + jg + 3] = a[3]; Sl[i * 65 + jg + 4] = b2[0]; Sl[i * 65 + jg + 5] = b2[1]; Sl[i * 65 + jg + 6] = b2[2]; Sl[i * 65 + jg + 7] = b2[3]; }
  for (int c = 0; c < NCH - 1; ++c) {
    const float* pq = bf.PQ + (((size_t)chain * (NCH - 1) + c) * 2) * 4096;
    const f32x4 p0 = *(const f32x4*)(pq + i * 64 + jg), p1 = *(const f32x4*)(pq + i * 64 + jg + 4);
    f32x4 q0 = *(const f32x4*)(pq + 4096 + i * 64 + jg), q1 = *(const f32x4*)(pq + 4096 + i * 64 + jg + 4);
    *(LAS f32x4*)(Pl + i * 64 + jg) = p0; *(LAS f32x4*)(Pl + i * 64 + jg + 4) = p1;
    __syncthreads();
#pragma unroll 8
    for (int k = 0; k < 64; ++k) { const float sv = Sl[i * 65 + k]; const f32x4 a = *(const LAS f32x4*)(Pl + k * 64 + jg), b2 = *(const LAS f32x4*)(Pl + k * 64 + jg + 4); q0 += sv * a; q1 += sv * b2; }
    __syncthreads();
    Sl[i * 65 + jg] = q0[0]; Sl[i * 65 + jg + 1] = q0[1]; Sl[i * 65 + jg + 2] = q0[2]; Sl[i * 65 + jg + 3] = q0[3]; Sl[i * 65 + jg + 4] = q1[0]; Sl[i * 65 + jg + 5] = q1[1]; Sl[i * 65 + jg + 6] = q1[2]; Sl[i * 65 + jg + 7] = q1[3];
    *(f32x4*)(sst + (size_t)(c + 1) * 4096 + i * 64 + jg) = q0; *(f32x4*)(sst + (size_t)(c + 1) * 4096 + i * 64 + jg + 4) = q1;
  }
  __syncthreads();
}

__device__ __forceinline__ void finish_rows4(const Bufs& bf, const float* __restrict__ gn_g, const float* __restrict__ gn_b, bf16_t* __restrict__ O, int row0) {
  const int c = mk::otid(), h = c >> 6;
  float y[4], v[4], g[4], cs[4];
#pragma unroll
  for (int i = 0; i < 4; ++i) { const int row = row0 + i;
    y[i] = bf2f(bf.Y[(size_t)row * 512 + c]) + bf2f(bf.Y[((size_t)NTOK + row) * 512 + c]);
    v[i] = bfhi(bf.SH[(size_t)row * 512 + c].y); g[i] = bf2f(bf.G[(size_t)row * bf.gstride + c]);
    cs[i] = bf.CS[(size_t)row * 16 + h] + bf.CS[(size_t)row * 16 + 8 + h]; }
  const float gg = gn_g[c], gb = gn_b[c];
  float o[4];
#pragma unroll
  for (int i = 0; i < 4; ++i) { const float mu = wave_sum_u(y[i]) * (1.0f / 64.0f); const float dv = y[i] - mu; const float var = wave_sum_u(dv * dv) * (1.0f / 64.0f);
    o[i] = (dv * rsqrtf(var + 64e-5f) * gg + gb + cs[i] * v[i]) * g[i]; }
#pragma unroll
  for (int i = 0; i < 4; ++i) O[(size_t)(row0 + i) * 1024 + 512 + c] = f2bf(o[i]);
}
}

namespace mk {
constexpr size_t al256(size_t x) { return (x + 255) / 256 * 256; }
constexpr size_t WS_BAR = 0;
constexpr size_t WS_BCNT = al256(WS_BAR + (size_t)XCD_BAR_WORDS * 4);
constexpr size_t WS_MOFF = al256(WS_BCNT + (size_t)4 * 256 * 64 * 4);
constexpr size_t WS_MOD = al256(WS_MOFF + 4 * 256);
constexpr size_t WS_ROPE = al256(WS_MOD + (size_t)4 * 5 * 6144 * 4);
constexpr size_t WS_HCTX = al256(WS_ROPE + 128 * 16 * 2 * 4);
constexpr size_t WS_EID = al256(WS_HCTX + (size_t)NCTX * D * 4);
constexpr size_t WS_GATE = al256(WS_EID + (size_t)NTOK * 2 * 4);
constexpr size_t WS_POS = al256(WS_GATE + (size_t)NTOK * 2 * 4);
constexpr size_t WS_WEIN = al256(WS_POS + (size_t)NTOK * 2 * 4);
constexpr size_t WS_WOIN = al256(WS_WEIN + (size_t)2 * EVEN_IN * D * 2);
constexpr size_t WS_WEOUT = al256(WS_WOIN + (size_t)2 * ODD_IN * D * 2);
constexpr size_t WS_WOOUT = al256(WS_WEOUT + (size_t)2 * D * D * 2);
constexpr size_t WS_WGU = al256(WS_WOOUT + (size_t)2 * D * D * 2);
constexpr size_t WS_WDN = al256(WS_WGU + (size_t)NE * 1024 * D * 2);
constexpr size_t WS_UO = al256(WS_WDN + (size_t)NE * D * DE * 2);
constexpr size_t WS_SCR = al256(WS_UO + (size_t)NTOK * D * 2);
constexpr size_t SE_PQK = 0;
constexpr size_t SE_VT = al256(SE_PQK + (size_t)NTOK * 1024 * 2);
constexpr size_t SE_PRW = al256(SE_VT + (size_t)512 * NTOK * 2);
constexpr size_t SE_SH = al256(SE_PRW + (size_t)NTOK * RW_IN * 2);
constexpr size_t SE_DR = al256(SE_SH + (size_t)NTOK * 512 * 8);
constexpr size_t SE_CS = al256(SE_DR + (size_t)2 * NTOK * 512 * 4);
constexpr size_t SE_END = al256(SE_CS + (size_t)2 * NTOK * 16 * 4);
constexpr size_t SE_PQ = 0;
constexpr size_t SE_SST = al256(SE_PQ + (size_t)rw::NCHAIN * (rw::NCH - 1) * 2 * 4096 * 4);
constexpr size_t SE_Y = al256(SE_SST + (size_t)rw::NCHAIN * rw::NCH * 4096 * 4);
constexpr size_t SE_YEND = al256(SE_Y + (size_t)2 * NTOK * 512 * 2);
static_assert(SE_YEND <= SE_SH, "scan buffers must fit below SH");
constexpr size_t SE_YBUF = 0;
constexpr size_t SO_PQK = 0;
constexpr size_t SO_VT = al256(SO_PQK + (size_t)NTOK * 2048 * 2);
constexpr size_t SO_O12 = al256(SO_VT + (size_t)1024 * NTOK * 2);
constexpr size_t SO_END = al256(SO_O12 + (size_t)NTOK * 2048 * 2);
constexpr size_t SO_YBUF = 0;
constexpr size_t SM_XS = 0;
constexpr size_t SM_HE = al256(SM_XS + (size_t)MOE_ROWS * D * 2);
constexpr size_t SM_YS = al256(SM_HE + (size_t)MOE_ROWS * DE * 2);
constexpr size_t SM_END = al256(SM_YS + (size_t)MOE_ROWS * D * 2);
constexpr size_t SCR_BYTES = SE_END > SO_END ? (SE_END > SM_END ? SE_END : SM_END) : (SO_END > SM_END ? SO_END : SM_END);
constexpr size_t WS_END = WS_SCR + SCR_BYTES;
constexpr int LDS_BARW = 131072;
constexpr int LDS_MISC = 131072 + 64;

struct Params {
  const float *x, *c, *ctx, *c_ctx, *ada_w, *ada_b, *ln_g, *ln_b, *even_w_in, *even_w_out, *shift_w, *na_rpb, *rw_w0, *rw_w_up, *rw_a0, *rw_a_up, *rw_g_up, *rw_k_k, *rw_k_a, *rw_r_k,
      *rw_gn_g, *rw_gn_b, *odd_w_in, *odd_w_out, *da_lq1, *da_lk1, *da_lq2, *da_lk2, *da_subln_g, *router_w, *router_b, *exp_w_gate, *exp_w_up, *exp_w_down;
  float* out; unsigned char* ws; int ph_lo, ph_hi;
};
template <class Tp> __device__ __forceinline__ Tp* wsp(const Params& p, size_t off) { return (Tp*)(p.ws + off); }

__device__ __forceinline__ void ada_unit(const Params& p, int u, LAS float* lds) {
  LAS float* sc = lds; LAS float* red = lds + 5 * 1024;
  const int tid = mk::otid(), l = u / 96, n = (u % 96) * 64 + (tid & 63), kp = tid >> 6;
  for (int i = tid; i < 5 * 1024; i += NTHR) { const float v = i < 4096 ? p.c[i] : p.c_ctx[i - 4096]; sc[i] = siluf_(v); }
  __syncthreads();
  float a[5] = {0.f, 0.f, 0.f, 0.f, 0.f};
  const float* w = p.ada_w + ((size_t)l * D + kp * 128) * 6144 + n;
#pragma unroll 4
  for (int k = 0; k < 128; ++k) { const float wv = w[(size_t)k * 6144]; const int kk = kp * 128 + k;
#pragma unroll
    for (int r = 0; r < 5; ++r) a[r] = fmaf(sc[r * 1024 + kk], wv, a[r]); }
#pragma unroll
  for (int r = 0; r < 5; ++r) red[(kp * 5 + r) * 64 + (tid & 63)] = a[r];
  __syncthreads();
  if (tid < 320) { const int r = tid >> 6, nn = tid & 63; float s = 0.f;
#pragma unroll
    for (int q = 0; q < 8; ++q) s += red[(q * 5 + r) * 64 + nn];
    const int col = (u % 96) * 64 + nn;
    wsp<float>(p, WS_MOD)[((size_t)l * 5 + r) * 6144 + col] = s + p.ada_b[l * 6144 + col]; }
  __syncthreads();
}
__device__ __forceinline__ void phase_prologue(const Params& p, LAS unsigned char* lds) {
  const int bid = mk::obid(), nb = gridDim.x; LAS float* tile = (LAS float*)lds;
  int ub = 0;
  for (int i = 0; i < 2; ++i) ub += cvt_matrix(p.even_w_in + (size_t)i * D * EVEN_IN, EVEN_IN, D, EVEN_IN, wsp<bf16_t>(p, WS_WEIN) + (size_t)i * EVEN_IN * D, NMapId{0}, tile, ub, bid, nb);
  for (int i = 0; i < 2; ++i) ub += cvt_matrix(p.odd_w_in + (size_t)i * D * ODD_IN, ODD_IN, D, ODD_IN, wsp<bf16_t>(p, WS_WOIN) + (size_t)i * ODD_IN * D, NMapRope{}, tile, ub, bid, nb);
  for (int i = 0; i < 2; ++i) ub += cvt_matrix(p.even_w_out + (size_t)i * D * D, D, D, D, wsp<bf16_t>(p, WS_WEOUT) + (size_t)i * D * D, NMapId{0}, tile, ub, bid, nb);
  for (int i = 0; i < 2; ++i) ub += cvt_matrix(p.odd_w_out + (size_t)i * D * D, D, D, D, wsp<bf16_t>(p, WS_WOOUT) + (size_t)i * D * D, NMapId{0}, tile, ub, bid, nb);
  for (int u = (bid + nb - ub % nb) % nb; u < 384; u += nb) ada_unit(p, u, (LAS float*)lds);
  const int gt = bid * NTHR + mk::otid();
  if (gt < 128 * 16) { const int pos = gt >> 4, i = gt & 15; const float inv = exp2f(-(float)i * (13.287712379549449f / 16.0f)); float sn, cs; sincosf((float)pos * inv, &sn, &cs);
    wsp<float>(p, WS_ROPE)[gt * 2] = cs; wsp<float>(p, WS_ROPE)[gt * 2 + 1] = sn; }
}
__device__ __forceinline__ void cvt_experts(const Params& p, int l, LAS float* tile) {
  const int bid = mk::obid(), nb = gridDim.x; int ub = 0;
  for (int e = 0; e < NE; ++e) {
    const size_t so = ((size_t)l * NE + e) * D * DE;
    ub += cvt_matrix(p.exp_w_gate + so, DE, D, DE, wsp<bf16_t>(p, WS_WGU) + (size_t)e * 1024 * D, NMapInterleave{0}, tile, ub, bid, nb);
    ub += cvt_matrix(p.exp_w_up + so, DE, D, DE, wsp<bf16_t>(p, WS_WGU) + (size_t)e * 1024 * D, NMapInterleave{1}, tile, ub, bid, nb);
    ub += cvt_matrix(p.exp_w_down + so, D, DE, D, wsp<bf16_t>(p, WS_WDN) + (size_t)e * D * DE, NMapId{0}, tile, ub, bid, nb);
  }
}

__device__ __forceinline__ const float* h_in_ptr(const Params& p, int l, int row) {
  if (l == 0) return row < NLAT ? p.x + (size_t)row * D : p.ctx + (size_t)(row - NLAT) * D;
  return row < NLAT ? p.out + (size_t)row * D : wsp<float>(p, WS_HCTX) + (size_t)(row - NLAT) * D;
}
__device__ __forceinline__ float* h_out_ptr(const Params& p, int row) { return row < NLAT ? p.out + (size_t)row * D : wsp<float>(p, WS_HCTX) + (size_t)(row - NLAT) * D; }
__device__ __forceinline__ void store_bf16x4(bf16_t* dst, f32x4 v) { u32x2 w; w.x = cvt_pk_bf16(v[0], v[1]); w.y = cvt_pk_bf16(v[2], v[3]); *(u32x2*)dst = w; }
__device__ __forceinline__ f32x4 load_bf16x4(const bf16_t* src) { const u32x2 w = *(const u32x2*)src; return (f32x4){bflo(w.x), bfhi(w.x), bflo(w.y), bfhi(w.y)}; }

__device__ __forceinline__ void phase_mod0(const Params& p) {
  const int lane = mk::otid() & 63, wid = mk::otid() >> 6;
  bf16_t* U = wsp<bf16_t>(p, WS_UO);
  for (int row = mk::obid() * 8 + wid; row < NTOK; row += gridDim.x * 8) {
    const float* h = h_in_ptr(p, 0, row); const float* modl = wsp<float>(p, WS_MOD) + (size_t)bidx_of_row(row) * 6144;
#pragma unroll
    for (int q = 0; q < 4; ++q) { const int col = q * 256 + lane * 4; const f32x4 hv = *(const f32x4*)(h + col), sh = *(const f32x4*)(modl + col), sc = *(const f32x4*)(modl + 1024 + col);
      store_bf16x4(U + (size_t)row * D + col, hv * (1.0f + sc) + sh); }
  }
}
__device__ __forceinline__ void ln_row(f32x4 (&v)[4], const float* __restrict__ g, const float* __restrict__ b, int lane) {
  float s = 0.f;
#pragma unroll
  for (int q = 0; q < 4; ++q) s += (v[q][0] + v[q][1]) + (v[q][2] + v[q][3]);
  const float mu = wave_sum_u(s) * (1.0f / D);
  float qq = 0.f;
#pragma unroll
  for (int q = 0; q < 4; ++q) { const f32x4 d = v[q] - mu; qq += (d[0] * d[0] + d[1] * d[1]) + (d[2] * d[2] + d[3] * d[3]); }
  const float rstd = rsqrtf(wave_sum_u(qq) * (1.0f / D) + LN_EPS);
#pragma unroll
  for (int q = 0; q < 4; ++q) { const int col = q * 256 + lane * 4; v[q] = (v[q] - mu) * rstd * *(const f32x4*)(g + col) + *(const f32x4*)(b + col); }
}
template <int NR>
__device__ __forceinline__ void ln1_rows(const Params& p, int l, const bf16_t* __restrict__ Ybuf, const int (&rows)[NR], int lane, const LAS float* rwl, LAS int* lcnt, bool dry) {
  bf16_t* U2 = wsp<bf16_t>(p, WS_UO); int* eid = wsp<int>(p, WS_EID); float* gatev = wsp<float>(p, WS_GATE);
  const float* lg = p.ln_g + (size_t)(l * 2) * D; const float* lb = p.ln_b + (size_t)(l * 2) * D;
  f32x4 v[NR][4];
#pragma unroll
  for (int r = 0; r < NR; ++r) { const int row = rows[r]; const float* h = h_in_ptr(p, l, row); const float* modl = wsp<float>(p, WS_MOD) + ((size_t)l * 5 + bidx_of_row(row)) * 6144;
#pragma unroll
    for (int q = 0; q < 4; ++q) { const int col = q * 256 + lane * 4; v[r][q] = ALPHA * *(const f32x4*)(h + col) + *(const f32x4*)(modl + 2 * 1024 + col) * load_bf16x4(Ybuf + (size_t)row * D + col); } }
#pragma unroll
  for (int r = 0; r < NR; ++r) {
    const int row = rows[r]; float* ho = h_out_ptr(p, row); const float* modl = wsp<float>(p, WS_MOD) + ((size_t)l * 5 + bidx_of_row(row)) * 6144;
    ln_row(v[r], lg, lb, lane);
    float acc[16];
#pragma unroll
    for (int e = 0; e < 16; ++e) acc[e] = 0.f;
#pragma unroll
    for (int q = 0; q < 4; ++q) { const int col = q * 256 + lane * 4;
      if (!dry) *(f32x4*)(ho + col) = v[r][q];
      const f32x4 u = v[r][q] * (1.0f + *(const f32x4*)(modl + 4 * 1024 + col)) + *(const f32x4*)(modl + 3 * 1024 + col);
      if (!dry) store_bf16x4(U2 + (size_t)row * D + col, u);
#pragma unroll
      for (int e = 0; e < 16; ++e) { const f32x4 w = *(const LAS f32x4*)(rwl + ((q * 16 + e) * 64 + lane) * 4); acc[e] += (u[0] * w[0] + u[1] * w[1]) + (u[2] * w[2] + u[3] * w[3]); }
      asm volatile("" ::: "memory");
    }
    float s[16], sel[16];
#pragma unroll
    for (int e = 0; e < 16; ++e) { s[e] = 1.0f / (1.0f + expf(-wave_sum_u(acc[e]))); sel[e] = s[e] + p.router_b[e]; }
    float best = -1e30f; int grp = 0;
#pragma unroll
    for (int gI = 0; gI < 4; ++gI) {
      const float a = sel[gI * 4], b2 = sel[gI * 4 + 1], c = sel[gI * 4 + 2], d = sel[gI * 4 + 3];
      const float lo1 = fminf(a, b2), hi1 = fmaxf(a, b2), lo2 = fminf(c, d), hi2 = fmaxf(c, d);
      const float gs = fmaxf(hi1, hi2) + fmaxf(fminf(hi1, hi2), fmaxf(lo1, lo2));
      if (gs > best) { best = gs; grp = gI; }
    }
    float v0 = 0, v1 = 0, v2 = 0, v3 = 0, s0 = 0, s1 = 0, s2 = 0, s3 = 0;
#pragma unroll
    for (int gI = 0; gI < 4; ++gI) if (gI == grp) { v0 = sel[gI * 4]; v1 = sel[gI * 4 + 1]; v2 = sel[gI * 4 + 2]; v3 = sel[gI * 4 + 3]; s0 = s[gI * 4]; s1 = s[gI * 4 + 1]; s2 = s[gI * 4 + 2]; s3 = s[gI * 4 + 3]; }
    int i1 = 0; float b1 = v0; if (v1 > b1) { b1 = v1; i1 = 1; } if (v2 > b1) { b1 = v2; i1 = 2; } if (v3 > b1) { b1 = v3; i1 = 3; }
    int i2 = -1; float bb = -1e30f;
    if (i1 != 0 && v0 > bb) { bb = v0; i2 = 0; } if (i1 != 1 && v1 > bb) { bb = v1; i2 = 1; } if (i1 != 2 && v2 > bb) { bb = v2; i2 = 2; } if (i1 != 3 && v3 > bb) { bb = v3; i2 = 3; }
    const float g1 = i1 == 0 ? s0 : i1 == 1 ? s1 : i1 == 2 ? s2 : s3; const float g2 = i2 == 0 ? s0 : i2 == 1 ? s1 : i2 == 2 ? s2 : s3;
    if (lane == 0 && !dry) { const int e1 = grp * 4 + i1, e2 = grp * 4 + i2;
      eid[row * 2] = e1; eid[row * 2 + 1] = e2; gatev[row * 2] = g1 / (g1 + g2); gatev[row * 2 + 1] = g2 / (g1 + g2);
      __hip_atomic_fetch_add(lcnt + e1, 1, __ATOMIC_RELAXED, __HIP_MEMORY_SCOPE_WORKGROUP); __hip_atomic_fetch_add(lcnt + e2, 1, __ATOMIC_RELAXED, __HIP_MEMORY_SCOPE_WORKGROUP); }
  }
}
__device__ __forceinline__ void phase_ln1(const Params& p, int l, const bf16_t* __restrict__ Ybuf, LAS unsigned char* lds, bool dry) {
  const int tid = mk::otid(), lane = tid & 63, wid = tid >> 6, bid = mk::obid();
  const bool last = l == DEPTH - 1; const int ntok = last ? NLAT : NTOK;
  LAS float* rwl = (LAS float*)lds; LAS int* lcnt = (LAS int*)(lds + 65536);
  for (int idx = tid; idx < 16384; idx += NTHR) { const int d = idx >> 4, e = idx & 15; rwl[(((d >> 8) * 16 + e) * 64 + ((d >> 2) & 63)) * 4 + (d & 3)] = p.router_w[idx]; }
  if (tid < 16) lcnt[tid] = 0;
  __syncthreads();
  const int stride = gridDim.x * 8;
  int row = bid * 8 + wid;
  for (; row + stride < ntok; row += 2 * stride) { const int rows[2] = {row, row + stride}; ln1_rows<2>(p, l, Ybuf, rows, lane, rwl, lcnt, dry); }
  if (row < ntok) { const int rows[1] = {row}; ln1_rows<1>(p, l, Ybuf, rows, lane, rwl, lcnt, dry); }
  __syncthreads();
  if (tid < 16 && !dry) wsp<int>(p, WS_BCNT)[((size_t)l * 256 + bid) * 64 + tid] = lcnt[tid];
  __syncthreads();
  if (!dry) cvt_experts(p, l, (LAS float*)lds);
}
__device__ __forceinline__ void phase_scatter(const Params& p, int l, LAS unsigned char* lds) {
  const int tid = mk::otid(), lane = tid & 63, wid = tid >> 6, bid = mk::obid();
  const bool last = l == DEPTH - 1; const int ntok = last ? NLAT : NTOK;
  LAS int* tot = (LAS int*)lds; LAS int* pre = tot + 16; LAS int* base = tot + 32; LAS int* lcur = tot + 48;
  const int* bc = wsp<int>(p, WS_BCNT) + (size_t)l * 256 * 64;
  if (tid < 16) { int t = 0, pr = 0; for (int b2 = 0; b2 < (int)gridDim.x; ++b2) { const int v = bc[b2 * 64 + tid]; pr += b2 < bid ? v : 0; t += v; } tot[tid] = t; pre[tid] = pr; lcur[tid] = 0; }
  __syncthreads();
  if (tid == 0) { int o = 0; int* mo = wsp<int>(p, WS_MOFF) + l * 64; for (int e = 0; e < 16; ++e) { base[e] = o + pre[e]; if (bid == 0) mo[e] = o; o += (tot[e] + 255) / 256 * 256; } if (bid == 0) mo[16] = o; }
  __syncthreads();
  const bf16_t* U2 = wsp<bf16_t>(p, WS_UO); bf16_t* Xs = wsp<bf16_t>(p, WS_SCR + SM_XS); const int* eid = wsp<int>(p, WS_EID); int* pos = wsp<int>(p, WS_POS);
  for (int row = bid * 8 + wid; row < ntok; row += gridDim.x * 8) {
    int p1 = 0, p2 = 0;
    if (lane == 0) { const int e1 = eid[row * 2], e2 = eid[row * 2 + 1]; p1 = base[e1] + __hip_atomic_fetch_add(lcur + e1, 1, __ATOMIC_RELAXED, __HIP_MEMORY_SCOPE_WORKGROUP); p2 = base[e2] + __hip_atomic_fetch_add(lcur + e2, 1, __ATOMIC_RELAXED, __HIP_MEMORY_SCOPE_WORKGROUP); pos[row * 2] = p1; pos[row * 2 + 1] = p2; }
    p1 = __builtin_amdgcn_readfirstlane(p1); p2 = __builtin_amdgcn_readfirstlane(p2);
    const u32x4 a = *(const u32x4*)(U2 + (size_t)row * D + lane * 8), b2 = *(const u32x4*)(U2 + (size_t)row * D + 512 + lane * 8);
    *(u32x4*)(Xs + (size_t)p1 * D + lane * 8) = a; *(u32x4*)(Xs + (size_t)p1 * D + 512 + lane * 8) = b2;
    *(u32x4*)(Xs + (size_t)p2 * D + lane * 8) = a; *(u32x4*)(Xs + (size_t)p2 * D + 512 + lane * 8) = b2;
  }
}
template <int NR>
__device__ __forceinline__ void ln2_rows(const Params& p, int l, const int (&rows)[NR], int lane, bool dry) {
  const bool last = l == DEPTH - 1;
  const bf16_t* Ys = wsp<bf16_t>(p, WS_SCR + SM_YS); const int* pos = wsp<int>(p, WS_POS); const float* gatev = wsp<float>(p, WS_GATE); bf16_t* U = wsp<bf16_t>(p, WS_UO);
  const float* lg = p.ln_g + (size_t)(l * 2 + 1) * D; const float* lb = p.ln_b + (size_t)(l * 2 + 1) * D;
  f32x4 v[NR][4];
#pragma unroll
  for (int r = 0; r < NR; ++r) { const int row = rows[r]; const float* ho = h_out_ptr(p, row); const float* modl = wsp<float>(p, WS_MOD) + ((size_t)l * 5 + bidx_of_row(row)) * 6144;
    const int p1 = pos[row * 2], p2 = pos[row * 2 + 1]; const float g1 = gatev[row * 2], g2 = gatev[row * 2 + 1];
#pragma unroll
    for (int q = 0; q < 4; ++q) { const int col = q * 256 + lane * 4;
      const f32x4 f = g1 * load_bf16x4(Ys + (size_t)p1 * D + col) + g2 * load_bf16x4(Ys + (size_t)p2 * D + col);
      v[r][q] = ALPHA * *(const f32x4*)(ho + col) + *(const f32x4*)(modl + 5 * 1024 + col) * f; } }
#pragma unroll
  for (int r = 0; r < NR; ++r) { const int row = rows[r]; float* ho = h_out_ptr(p, row);
    ln_row(v[r], lg, lb, lane);
    const float* modn = wsp<float>(p, WS_MOD) + ((size_t)(last ? l : l + 1) * 5 + bidx_of_row(row)) * 6144;
#pragma unroll
    for (int q = 0; q < 4; ++q) { const int col = q * 256 + lane * 4; if (!dry) *(f32x4*)(ho + col) = v[r][q];
      if (!last && !dry) store_bf16x4(U + (size_t)row * D + col, v[r][q] * (1.0f + *(const f32x4*)(modn + 1024 + col)) + *(const f32x4*)(modn + col)); } }
}
__device__ __forceinline__ void phase_ln2(const Params& p, int l, bool dry) {
  const int tid = mk::otid(), lane = tid & 63, wid = tid >> 6;
  const bool last = l == DEPTH - 1; const int ntok = last ? NLAT : NTOK;
  const int stride = gridDim.x * 8;
  int row = mk::obid() * 8 + wid;
  for (; row + stride < ntok; row += 2 * stride) { const int rows[2] = {row, row + stride}; ln2_rows<2>(p, l, rows, lane, dry); }
  if (row < ntok) { const int rows[1] = {row}; ln2_rows<1>(p, l, rows, lane, dry); }
}

struct SchedEvenIn { const bf16_t* U; const bf16_t* W; bf16_t* Pqk; bf16_t* Prw; bf16_t* Vt; int G, c;
  __device__ __forceinline__ bool next(int i, pg8::Unit& u) const { const int Lx = i * G + c; u.kind = 0;
    if (Lx < 1452) { const int grp = Lx / 44, rem = Lx % 44, pm = grp * 4 + (rem & 3), pi = rem >> 2; u.pm = pm; u.pn = pi;
      u.A = (const char*)(U + (size_t)pm * 256 * D); const int brow = pi < 4 ? pi * 256 : 1536 + (pi - 4) * 256; u.Bt = (const char*)(W + (size_t)brow * D);
      if (pi < 4) { u.out = Pqk; u.ldo = 1024; u.x1 = pi * 256; } else { u.out = Prw; u.ldo = RW_IN; u.x1 = (pi - 4) * 256; } u.x0 = pm * 256; return true; }
    if (Lx < 1452 + 264) { const int v = Lx - 1452, pmv = v & 1, pnv = v >> 1; u.pm = pmv; u.pn = pnv; u.A = (const char*)(W + (size_t)(1024 + pmv * 256) * D); u.Bt = (const char*)(U + (size_t)pnv * 256 * D);
      u.out = Vt; u.ldo = NTOK; u.x0 = pmv * 256; u.x1 = pnv * 256; return true; }
    return false; } };
struct SchedOddIn { const bf16_t* U; const bf16_t* W; bf16_t* Pqk; bf16_t* Vt; int G, c;
  __device__ __forceinline__ bool next(int i, pg8::Unit& u) const { const int Lx = i * G + c;
    if (Lx < 1056) { const int grp = Lx / 32, rem = Lx % 32, pm = grp * 4 + (rem & 3), pi = rem >> 2; u.pm = pm; u.pn = pi; u.kind = pm < 128 ? 1 : 0;
      u.A = (const char*)(U + (size_t)pm * 256 * D); u.Bt = (const char*)(W + (size_t)pi * 256 * D); u.out = Pqk; u.ldo = 2048; u.x0 = pm * 256; u.x1 = pi * 256; return true; }
    if (Lx < 1056 + 528) { const int v = Lx - 1056, pmv = v & 3, pnv = v >> 2; u.pm = pmv; u.pn = pnv; u.kind = 0; u.A = (const char*)(W + (size_t)(2048 + pmv * 256) * D); u.Bt = (const char*)(U + (size_t)pnv * 256 * D);
      u.out = Vt; u.ldo = NTOK; u.x0 = pmv * 256; u.x1 = pnv * 256; return true; }
    return false; } };
struct SchedOut { const bf16_t* O; const bf16_t* W; bf16_t* Y; int G, c;
  __device__ __forceinline__ bool next(int i, pg8::Unit& u) const { const int Lx = i * G + c; if (Lx >= 528) return false; const int pm = (Lx / 16) * 4 + (Lx & 3), pn = (Lx & 15) >> 2; u.pm = pm; u.pn = pn; u.kind = 0;
    u.A = (const char*)(O + (size_t)pm * 256 * D); u.Bt = (const char*)(W + (size_t)pn * 256 * D); u.out = Y; u.ldo = 1024; u.x0 = pm * 256; u.x1 = pn * 256; return true; } };
struct SchedMoe { const bf16_t* A; const bf16_t* W; bf16_t* out; const LAS int* moff; int Kd, ldo, ncol, G, c;
  __device__ __forceinline__ bool next(int i, pg8::Unit& u) const { const int Lx = i * G + c; const int ntile = moff[16] >> 8; if (Lx >= ntile * 4) return false;
    const int pm = Lx >> 2, pn = Lx & 3; int e = 0;
#pragma unroll
    for (int j = 1; j < 16; ++j) e += (pm * 256 >= moff[j]) ? 1 : 0;
    u.pm = pm; u.pn = pn; u.kind = 0; u.A = (const char*)(A + (size_t)pm * 256 * Kd); u.Bt = (const char*)(W + ((size_t)e * 1024 + pn * 256) * Kd); u.out = out; u.ldo = ldo; u.x0 = pm * 256; u.x1 = pn * ncol; return true; } };

struct EpiOddIn {
  static constexpr bool PERM = true; const float* rope;
  __device__ __forceinline__ void operator()(const f32x4 (&acc)[2][2][4][2], const pg8::Unit& u, int wr, int wc, int fr, int fq) const {
    if (u.kind == 0) { pg8::EpiStoreBf16{}(acc, u, wr, wc, fr, fq); return; }
    const int row0 = u.x0 + wr * 64 + fr, col0 = u.x1 + wc * 32 + 8 * fq; const int half = wc & 1;
#pragma unroll
    for (int ai = 0; ai < 2; ++ai)
#pragma unroll
      for (int m = 0; m < 4; ++m) { const int row = row0 + ai * 128 + m * 16; const int t = row & (T - 1); const int pos = half ? (t & 63) : (t >> 6);
        const f32x4 cs0 = *(const f32x4*)(rope + (pos * 16 + 4 * fq) * 2), cs1 = *(const f32x4*)(rope + (pos * 16 + 4 * fq + 2) * 2);
        bf16_t* rowp = u.out + (size_t)row * u.ldo + col0;
#pragma unroll
        for (int bj = 0; bj < 2; ++bj) { const f32x4 v0 = acc[ai][bj][m][0], v1 = acc[ai][bj][m][1];
          u32x4 w; w.x = cvt_pk_bf16(v0[0] * cs0[0] - v0[1] * cs0[1], v0[0] * cs0[1] + v0[1] * cs0[0]); w.y = cvt_pk_bf16(v0[2] * cs0[2] - v0[3] * cs0[3], v0[2] * cs0[3] + v0[3] * cs0[2]);
          w.z = cvt_pk_bf16(v1[0] * cs1[0] - v1[1] * cs1[1], v1[0] * cs1[1] + v1[1] * cs1[0]); w.w = cvt_pk_bf16(v1[2] * cs1[2] - v1[3] * cs1[3], v1[2] * cs1[3] + v1[3] * cs1[2]);
          *(u32x4*)(rowp + bj * 128) = w; } }
  }
};
struct EpiGateUp {
  static constexpr bool PERM = true;
  __device__ __forceinline__ void operator()(const f32x4 (&acc)[2][2][4][2], const pg8::Unit& u, int wr, int wc, int fr, int fq) const {
    const int row0 = u.x0 + wr * 64 + fr, col0 = u.x1 + wc * 16 + 4 * fq;
#pragma unroll
    for (int ai = 0; ai < 2; ++ai)
#pragma unroll
      for (int m = 0; m < 4; ++m) { bf16_t* rowp = u.out + (size_t)(row0 + ai * 128 + m * 16) * u.ldo + col0;
#pragma unroll
        for (int bj = 0; bj < 2; ++bj) { const f32x4 v0 = acc[ai][bj][m][0], v1 = acc[ai][bj][m][1];
          u32x2 w; w.x = cvt_pk_bf16(siluf_(v0[0]) * v0[1], siluf_(v0[2]) * v0[3]); w.y = cvt_pk_bf16(siluf_(v1[0]) * v1[1], siluf_(v1[2]) * v1[3]);
          *(u32x2*)(rowp + bj * 64) = w; } }
  }
};
}

namespace mk {
constexpr int N_PHASES = 2 + 2 * (13 + 9);
__global__ void __launch_bounds__(NTHR, 2) mega(Params p) {
  extern __shared__ __attribute__((aligned(16))) unsigned char shm[];
  LAS unsigned char* lds = (LAS unsigned char*)shm;
  const int nb = gridDim.x;
  if (threadIdx.x == 0) *(LAS u32x4*)(lds + LDS_BARW) = (u32x4){0u, 0u, 0u, 0u};
  __syncthreads();
  XcdBarrier bar = xcd_barrier_post(wsp<unsigned>(p, WS_BAR), (volatile LAS unsigned*)(lds + LDS_BARW));
  int ph = 0;
#ifndef MK_MASK
#define MK_MASK 0xFFFFFFFFu
#endif
#ifndef MK_REP
#define MK_REP 0u
#endif
#define PHASE_BEGIN_K(k) if ((((MK_MASK) >> (k)) & 1u) && ph >= p.ph_lo && ph < p.ph_hi) { const int bid = mk::obid(); const int nrep_ = ((((MK_REP) >> (k)) & 1u) ? 2 : 1); for (int rep_ = 0; rep_ < nrep_; ++rep_) { const bool dry = rep_ + 1 < nrep_; (void)dry;
#define PHASE_END   } if (ph + 1 < p.ph_hi) xcd_barrier(bar); } ++ph;
  bf16_t* UO = wsp<bf16_t>(p, WS_UO);
  unsigned char* scr = p.ws + WS_SCR;
  PHASE_BEGIN_K(0) phase_prologue(p, lds); PHASE_END
  PHASE_BEGIN_K(1) phase_mod0(p); PHASE_END
  for (int lp = 0; lp < 2; ++lp) {
    {
      const int l = 2 * lp;
      bf16_t* Pqk = (bf16_t*)(scr + SE_PQK); bf16_t* Vt = (bf16_t*)(scr + SE_VT); bf16_t* Prw = (bf16_t*)(scr + SE_PRW); bf16_t* Ybuf = (bf16_t*)(scr + SE_YBUF);
      rw::Bufs bf; bf.SH = (u32x2*)(scr + SE_SH); bf.DR = (unsigned*)(scr + SE_DR); bf.G = UO + 512; bf.gstride = 1024; bf.CS = (float*)(scr + SE_CS) + (size_t)lp * NTOK * 16; bf.PQ = (float*)(scr + SE_PQ); bf.SST = (float*)(scr + SE_SST); bf.Y = (bf16_t*)(scr + SE_Y);
      PHASE_BEGIN_K(2) { SchedEvenIn S{UO, wsp<bf16_t>(p, WS_WEIN) + (size_t)lp * EVEN_IN * D, Pqk, Prw, Vt, nb, bid}; pg8::gemm_phase(lds, D, S, pg8::EpiStoreBf16{}); } PHASE_END
      PHASE_BEGIN_K(3) for (int u = bid; u < 1024 + 32; u += nb) { int b, h, rq; if (u < 1024) { b = u >> 8; h = (u >> 5) & 7; rq = u & 31; } else { const int v = u - 1024; b = v >> 3; h = v & 7; rq = -1; }
        natt::na_attn_unit(Pqk, Vt, p.na_rpb + ((size_t)lp * 8 + h) * 465, UO, b, h, rq, lds); } PHASE_END
      PHASE_BEGIN_K(4) for (int t = bid; t < NTOK / 16; t += nb) rw::prep_tile(Prw, p.shift_w + (size_t)lp * 3 * RW_IN, p.rw_w0 + lp * 1024, p.rw_w_up + (size_t)lp * 2 * 64 * 512, p.rw_a0 + lp * 1024,
            p.rw_a_up + (size_t)lp * 2 * 64 * 512, p.rw_g_up + (size_t)lp * 128 * 512, p.rw_k_k + lp * 512, p.rw_k_a + lp * 512, p.rw_r_k + lp * 512, bf, t, (LAS float*)lds); PHASE_END
      PHASE_BEGIN_K(5) for (int u = bid * 8 + (mk::otid() >> 6); u < rw::NCHAIN * rw::NCH; u += nb * 8) {
        if (u < rw::NCHAIN * (rw::NCH - 1)) rw::scan_unit<0>(bf, p.rw_k_a + lp * 512, u / (rw::NCH - 1), false, u % (rw::NCH - 1));
        else rw::scan_unit<1>(bf, p.rw_k_a + lp * 512, u - rw::NCHAIN * (rw::NCH - 1), true, 0); } PHASE_END
      PHASE_BEGIN_K(6) for (int c = bid; c < rw::NCHAIN; c += nb) rw::propagate_chain(bf, c, (LAS float*)lds); PHASE_END
      PHASE_BEGIN_K(7) for (int u = bid * 8 + (mk::otid() >> 6); u < rw::NCHAIN * rw::NCH; u += nb * 8) rw::scan_unit<1>(bf, p.rw_k_a + lp * 512, u / rw::NCH, false, u % rw::NCH); PHASE_END
      PHASE_BEGIN_K(8) for (int r = bid * 4; r < NTOK; r += nb * 4) rw::finish_rows4(bf, p.rw_gn_g + lp * 512, p.rw_gn_b + lp * 512, UO, r); PHASE_END
      PHASE_BEGIN_K(9) { SchedOut S{UO, wsp<bf16_t>(p, WS_WEOUT) + (size_t)lp * D * D, Ybuf, nb, bid}; pg8::gemm_phase(lds, D, S, pg8::EpiStoreBf16{}); } PHASE_END
      PHASE_BEGIN_K(10) phase_ln1(p, l, Ybuf, lds, dry); PHASE_END
      PHASE_BEGIN_K(11) phase_scatter(p, l, lds); PHASE_END
      PHASE_BEGIN_K(12) { LAS int* mo = (LAS int*)(lds + LDS_MISC); { const int tq = mk::otid(); if (tq < 17) mo[tq] = wsp<int>(p, WS_MOFF)[l * 64 + tq]; } __syncthreads();
        SchedMoe S{(bf16_t*)(scr + SM_XS), wsp<bf16_t>(p, WS_WGU), (bf16_t*)(scr + SM_HE), mo, D, DE, 128, nb, bid}; pg8::gemm_phase(lds, D, S, EpiGateUp{}); } PHASE_END
      PHASE_BEGIN_K(13) { LAS int* mo = (LAS int*)(lds + LDS_MISC); { const int tq = mk::otid(); if (tq < 17) mo[tq] = wsp<int>(p, WS_MOFF)[l * 64 + tq]; } __syncthreads();
        SchedMoe S{(bf16_t*)(scr + SM_HE), wsp<bf16_t>(p, WS_WDN), (bf16_t*)(scr + SM_YS), mo, DE, D, 256, nb, bid}; pg8::gemm_phase(lds, DE, S, pg8::EpiStoreBf16{}); } PHASE_END
      PHASE_BEGIN_K(14) phase_ln2(p, l, dry); PHASE_END
    }
    {
      const int l = 2 * lp + 1; const bool last = l == DEPTH - 1;
      bf16_t* Pqk = (bf16_t*)(scr + SO_PQK); bf16_t* Vt = (bf16_t*)(scr + SO_VT); bf16_t* O12 = (bf16_t*)(scr + SO_O12); bf16_t* Ybuf = (bf16_t*)(scr + SO_YBUF);
      PHASE_BEGIN_K(15) { SchedOddIn S{UO, wsp<bf16_t>(p, WS_WOIN) + (size_t)lp * ODD_IN * D, Pqk, Vt, nb, bid}; pg8::gemm_phase(lds, D, S, EpiOddIn{wsp<float>(p, WS_ROPE)}); } PHASE_END
      PHASE_BEGIN_K(16) for (int u = bid; u < 2048 + (last ? 0 : 64); u += nb) { int b, hh, q0, nlat;
        if (u < 2048) { b = u >> 9; hh = (u >> 5) & 15; q0 = b * T + (u & 31) * 256; nlat = T; } else { const int v = u - 2048; b = v >> 4; hh = v & 15; q0 = NLAT + b * L; nlat = 0; }
        att::diff_attn_unit(Pqk, Vt, O12, hh, q0, b * T, nlat, NLAT + b * L, lds); } PHASE_END
      PHASE_BEGIN_K(17) { float d1 = 0.f, d2 = 0.f; for (int i = 0; i < 64; ++i) { d1 += p.da_lq1[lp * 64 + i] * p.da_lk1[lp * 64 + i]; d2 += p.da_lq2[lp * 64 + i] * p.da_lk2[lp * 64 + i]; }
        const float li = 0.8f - 0.6f * expf(-0.3f * (float)l), lam = expf(d1) - expf(d2) + li;
        const int tq = mk::otid(); for (int r4 = bid; r4 < (last ? NLAT : NTOK) / 4; r4 += nb) att::diff_combine_rows4(O12, p.da_subln_g + lp * 128, lam, 1.0f - li, UO, r4 * 4, tq >> 6, tq & 63); } PHASE_END
      PHASE_BEGIN_K(18) { SchedOut S{UO, wsp<bf16_t>(p, WS_WOOUT) + (size_t)lp * D * D, Ybuf, nb, bid}; pg8::gemm_phase(lds, D, S, pg8::EpiStoreBf16{}); } PHASE_END
      PHASE_BEGIN_K(19) phase_ln1(p, l, Ybuf, lds, dry); PHASE_END
      PHASE_BEGIN_K(20) phase_scatter(p, l, lds); PHASE_END
      PHASE_BEGIN_K(21) { LAS int* mo = (LAS int*)(lds + LDS_MISC); { const int tq = mk::otid(); if (tq < 17) mo[tq] = wsp<int>(p, WS_MOFF)[l * 64 + tq]; } __syncthreads();
        SchedMoe S{(bf16_t*)(scr + SM_XS), wsp<bf16_t>(p, WS_WGU), (bf16_t*)(scr + SM_HE), mo, D, DE, 128, nb, bid}; pg8::gemm_phase(lds, D, S, EpiGateUp{}); } PHASE_END
      PHASE_BEGIN_K(22) { LAS int* mo = (LAS int*)(lds + LDS_MISC); { const int tq = mk::otid(); if (tq < 17) mo[tq] = wsp<int>(p, WS_MOFF)[l * 64 + tq]; } __syncthreads();
        SchedMoe S{(bf16_t*)(scr + SM_HE), wsp<bf16_t>(p, WS_WDN), (bf16_t*)(scr + SM_YS), mo, DE, D, 256, nb, bid}; pg8::gemm_phase(lds, DE, S, pg8::EpiStoreBf16{}); } PHASE_END
      PHASE_BEGIN_K(23) phase_ln2(p, l, dry); PHASE_END
    }
  }
#undef PHASE_BEGIN_K
#undef PHASE_END
}
}

#ifndef MK_SINGLE_LAUNCH
#define MK_SINGLE_LAUNCH 1
#endif
extern "C" void kernel_launch(void* const* d_in, const int* in_sizes, int n_in, void* d_out, int out_size, void* d_ws, size_t ws_size, hipStream_t stream) {
  using namespace mk;
  static int grid = 0;
  if (grid == 0) {
    if (n_in != 34 || out_size != NLAT * D || ws_size < WS_END) { fprintf(stderr, "kernel_launch: unexpected shapes (n_in %d out %d ws %zu need %zu)\n", n_in, out_size, ws_size, (size_t)WS_END); grid = -1; return; }
    if (hipFuncSetAttribute((const void*)mega, hipFuncAttributeMaxDynamicSharedMemorySize, LDS_BYTES) != hipSuccess) { grid = -1; return; }
    int dev = 0, cus = 0, per_cu = 0;
    if (hipGetDevice(&dev) != hipSuccess || hipDeviceGetAttribute(&cus, hipDeviceAttributeMultiprocessorCount, dev) != hipSuccess) { grid = -1; return; }
    if (hipOccupancyMaxActiveBlocksPerMultiprocessor(&per_cu, (const void*)mega, NTHR, LDS_BYTES) != hipSuccess || per_cu < 1) { fprintf(stderr, "kernel_launch: occupancy query says %d\n", per_cu); }
    (void)hipGetLastError();
    grid = cus;
  }
  if (grid < 0) return;
  (void)hipMemsetAsync((char*)d_ws + WS_BAR, 0, (size_t)XCD_BAR_WORDS * 4, stream);
  Params p{};
  const float** pp = (const float**)&p;
  for (int i = 0; i < 34; ++i) pp[i] = (const float*)d_in[i];
  p.out = (float*)d_out; p.ws = (unsigned char*)d_ws;
#if MK_SINGLE_LAUNCH
  p.ph_lo = 0; p.ph_hi = N_PHASES;
  hipLaunchKernelGGL(mega, dim3(grid), dim3(NTHR), LDS_BYTES, stream, p);
#else
  for (int ph = 0; ph < N_PHASES; ++ph) { p.ph_lo = ph; p.ph_hi = ph + 1; hipLaunchKernelGGL(mega, dim3(grid), dim3(NTHR), LDS_BYTES, stream, p); }
#endif
}
```

```cpp
#include <hip/hip_runtime.h>
#include <stdint.h>
#include <stdio.h>

typedef unsigned short bf16_t;
typedef short bf16x8 __attribute__((ext_vector_type(8)));
typedef float f32x4 __attribute__((ext_vector_type(4)));
typedef float f32x2 __attribute__((ext_vector_type(2)));
typedef float f32x16 __attribute__((ext_vector_type(16)));
typedef unsigned u32x4 __attribute__((ext_vector_type(4)));
typedef unsigned u32x2 __attribute__((ext_vector_type(2)));
#define LAS __attribute__((address_space(3)))

namespace mk {
constexpr int B = 4, T = 8192, L = 256, D = 1024, NLAT = B * T, NCTX = B * L, NTOK = NLAT + NCTX;
constexpr int DEPTH = 4, EVEN_IN = 3328, ODD_IN = 3072, RW_OFF = 1536, RW_IN = 1792, NE = 16, DE = 512;
constexpr float ALPHA = 1.681792830507429f, LN_EPS = 1e-5f;
constexpr int NTHR = 512, LDS_BYTES = 147456;
constexpr int MOE_TILES = 280, MOE_ROWS = MOE_TILES * 256;

__device__ __forceinline__ unsigned cvt_pk_bf16(float lo, float hi) { unsigned r; asm volatile("v_cvt_pk_bf16_f32 %0, %1, %2" : "=v"(r) : "v"(lo), "v"(hi)); return r; }
__device__ __forceinline__ float bf2f(bf16_t b) { return __uint_as_float(((unsigned)b) << 16); }
__device__ __forceinline__ float bflo(unsigned w) { return __uint_as_float(w << 16); }
__device__ __forceinline__ float bfhi(unsigned w) { return __uint_as_float(w & 0xffff0000u); }
__device__ __forceinline__ bf16_t f2bf(float f) { return (bf16_t)(cvt_pk_bf16(f, 0.f) & 0xffffu); }
__device__ __forceinline__ float sigmoidf_(float x) { return 1.0f / (1.0f + __expf(-x)); }
__device__ __forceinline__ float siluf_(float x) { return x / (1.0f + __expf(-x)); }
__device__ __forceinline__ float wave_sum(float v) {
#pragma unroll
  for (int o = 32; o > 0; o >>= 1) v += __shfl_xor(v, o);
  return v;
}
template <int CTRL, int RM, int BM> __device__ __forceinline__ float dpp_mov(float old, float v) { return __int_as_float(__builtin_amdgcn_update_dpp(__float_as_int(old), __float_as_int(v), CTRL, RM, BM, false)); }
__device__ __forceinline__ float wave_sum_u(float v) {
  v += dpp_mov<0xB1, 0xf, 0xf>(v, v);
  v += dpp_mov<0x4E, 0xf, 0xf>(v, v);
  v += dpp_mov<0x141, 0xf, 0xf>(v, v);
  v += dpp_mov<0x140, 0xf, 0xf>(v, v);
  v += dpp_mov<0x142, 0xa, 0xf>(0.f, v);
  v += dpp_mov<0x143, 0xc, 0xf>(0.f, v);
  return __int_as_float(__builtin_amdgcn_readlane(__float_as_int(v), 63));
}
__device__ __forceinline__ f32x16 zero16() { float z = 0.f; asm volatile("" : "+v"(z)); f32x16 r;
#pragma unroll
  for (int i = 0; i < 16; ++i) r[i] = z;
  return r; }
__device__ __forceinline__ int otid() { int t = threadIdx.x; asm volatile("" : "+v"(t)); return t; }
__device__ __forceinline__ int obid() { int b = blockIdx.x; asm volatile("" : "+s"(b)); return b; }
__device__ __forceinline__ int bidx_of_row(int row) { return row < NLAT ? row / T : 4; }
}

#include <vector>

#define XB_TMO      128
#define XB_XCNT(j)  (256  + 64 * (j))
#define XB_XSUB(j)  (1280 + 64 * (j))
#define XB_XGEN(j)  (2304 + 64 * (j))
#define XB_TOP      3328
#define XB_TOPGEN   3392
#define XCD_BAR_WORDS 3456
#define XB_SPIN_CAP (1u << 18)
#define LAS __attribute__((address_space(3)))

__device__ __forceinline__ unsigned xb_ld(unsigned* p)              { return __hip_atomic_load(p, __ATOMIC_RELAXED, __HIP_MEMORY_SCOPE_AGENT); }
__device__ __forceinline__ unsigned xb_add(unsigned* p, unsigned v) { return __hip_atomic_fetch_add(p, v, __ATOMIC_RELAXED, __HIP_MEMORY_SCOPE_AGENT); }
__device__ __forceinline__ unsigned xb_xcc_id() { return (unsigned)__builtin_amdgcn_s_getreg((3 << 11) | 20) & 0xFu; }
#define XB_SPIN(cond, bar) do { unsigned _sp = 0; while (cond) { __builtin_amdgcn_s_sleep(1); \
    if ((++_sp & 255u) == 0u) { if (xb_ld(&(bar)[XB_TMO])) break; if (_sp > XB_SPIN_CAP) { atomicAdd(&(bar)[XB_TMO], 1u); break; } } } } while (0)

struct XcdBarrier {
    unsigned* bar; unsigned x;
    volatile LAS unsigned* st;
};

__device__ __forceinline__ XcdBarrier xcd_barrier_post(unsigned* bar, volatile LAS unsigned* st) {
    XcdBarrier b; b.bar = bar; b.x = xb_xcc_id(); b.st = st;
    if (threadIdx.x == 0) (void)xb_add(&bar[XB_XCNT(b.x)], 1u);
    return b;
}
__device__ __forceinline__ void xcd_barrier_complete(unsigned* bar, unsigned x, unsigned& nloc, unsigned& nx) {
    const unsigned G = gridDim.x * gridDim.y * gridDim.z;
    unsigned sum, cnt, mine, sp = 0u;
    for (;;) {
        sum = 0u; cnt = 0u; mine = 0u;
#pragma unroll
        for (unsigned j = 0; j < 16; ++j) { const unsigned c = xb_ld(&bar[XB_XCNT(j)]); sum += c; cnt += (c > 0u) ? 1u : 0u; mine = (j == x) ? c : mine; }
        if (sum == G) break;
        __builtin_amdgcn_s_sleep(1);
        if ((++sp & 255u) == 0u) { if (xb_ld(&bar[XB_TMO])) break; if (sp > XB_SPIN_CAP) { atomicAdd(&bar[XB_TMO], 1u); break; } }
    }
    nloc = mine > 0u ? mine : 1u; nx = cnt > 0u ? cnt : 1u;
}

__device__ __forceinline__ void xcd_barrier(const XcdBarrier& b) {
    asm volatile("s_waitcnt vmcnt(0)" ::: "memory");
    __syncthreads();
    if (threadIdx.x == 0) {
        unsigned* bar = b.bar;
        __builtin_amdgcn_s_waitcnt(0);
        unsigned nloc = b.st[0], nx = b.st[1];
        if (nloc == 0u) { xcd_barrier_complete(bar, b.x, nloc, nx); b.st[0] = nloc; b.st[1] = nx; }
        const unsigned old = xb_add(&bar[XB_XSUB(b.x)], 1u);
        const unsigned gen = old / nloc;
        if (old + 1u == (gen + 1u) * nloc) {
            __builtin_amdgcn_fence(__ATOMIC_RELEASE, "agent");
            asm volatile("s_waitcnt vmcnt(0)" ::: "memory");
            const unsigned og = xb_add(&bar[XB_TOP], 1u);
            const unsigned tg = og / nx;
            if (og + 1u == (tg + 1u) * nx) xb_add(&bar[XB_TOPGEN], 1u);
            else XB_SPIN(xb_ld(&bar[XB_TOPGEN]) == tg, bar);
            __builtin_amdgcn_fence(__ATOMIC_ACQUIRE, "agent");
            xb_add(&bar[XB_XGEN(b.x)], 1u);
            asm volatile("s_waitcnt vmcnt(0)" ::: "memory");
        } else {
            XB_SPIN(xb_ld(&bar[XB_XGEN(b.x)]) == gen, bar);
            __builtin_amdgcn_fence(__ATOMIC_ACQUIRE, "agent");
            asm volatile("s_waitcnt vmcnt(0)" ::: "memory");
        }
    }
    __syncthreads();
}

namespace pg8 {
using mk::cvt_pk_bf16;
constexpr int BM = 256, BK = 64, HALF = 128, HTB = HALF * BK * 2  , STAGE_BYTES = 8 * HTB;
__host__ __device__ __forceinline__ int lds_byte(int r, int c) { const int st = (r >> 4) * 2 + (c >> 5), rr = r & 15, cc = c & 31, ob = rr * 64 + cc * 2; return st * 1024 + (ob ^ (((ob >> 9) & 1) << 5)); }
__host__ __device__ __forceinline__ void stage_rc(int b, int& R, int& C) { const int st = b / 1024, sb = b % 1024, swz = sb ^ (((sb >> 9) & 1) << 5); R = (st >> 1) * 16 + swz / 64; C = (st & 1) * 32 + (swz % 64) / 2; }
__host__ __device__ __forceinline__ int perm32(int rho) { const int n = rho >> 4, i = rho & 15; return 8 * (i >> 2) + 4 * n + (i & 3); }

struct Unit { const char* A; const char* Bt; bf16_t* out; int pm, pn, x0, x1, ldo, kind; };

template <class Epi, class Sched>
__device__ __forceinline__ void gemm_phase(LAS unsigned char* lds, const int K, const Sched& S, const Epi& E) {
    const int tid = mk::otid(), wid = __builtin_amdgcn_readfirstlane(tid >> 6), lane = tid & 63, wr = wid >> 2, wc = wid & 3, fr = lane & 15, fq = lane >> 4;
    const int nt = K / BK;
    unsigned voffA[2], voffB[2];
#pragma unroll
    for (int i = 0; i < 2; ++i) { int R, C; stage_rc(tid * 16 + i * 8192, R, C); const int Rb = Epi::PERM ? ((R & ~31) + perm32(R & 31)) : R;
        voffA[i] = (unsigned)(R * K + C) * 2u; voffB[i] = (unsigned)(Rb * K + C) * 2u; }
    const size_t kstep = (size_t)(BK * 2);
    const size_t hstep = (size_t)HALF * K * 2;
    const unsigned ldsw = (unsigned)wid * 1024u;
    const int aoff = lds_byte(wr * 64 + fr, fq * 8), boff = lds_byte(wc * 32 + fr, fq * 8);
#define PG8_SA(b, h) (((b) * 2 + (h)) * HTB)
#define PG8_SB(b, h) ((4 + (b) * 2 + (h)) * HTB)
#define PG8_STAGE(bufoff, gbase, voff) do { _Pragma("unroll") for (int _i = 0; _i < 2; ++_i) \
        __builtin_amdgcn_global_load_lds((const unsigned*)((const char*)(gbase) + (voff)[_i]), (LAS unsigned*)(lds + (bufoff) + ldsw + _i * 8192), 16, 0, 0); } while (0)
#define PG8_LDA(dst, b, h) do { _Pragma("unroll") for (int m = 0; m < 4; ++m) _Pragma("unroll") for (int k = 0; k < 2; ++k) dst[m][k] = *(const LAS bf16x8*)(lds + PG8_SA(b, h) + aoff + m * 2048 + k * 1024); } while (0)
#define PG8_LDB(dst, b, h) do { _Pragma("unroll") for (int n = 0; n < 2; ++n) _Pragma("unroll") for (int k = 0; k < 2; ++k) dst[n][k] = *(const LAS bf16x8*)(lds + PG8_SB(b, h) + boff + n * 2048 + k * 1024); } while (0)
#define PG8_MMA(ai, bj, At, Bt) do { __builtin_amdgcn_s_setprio(1); _Pragma("unroll") for (int m = 0; m < 4; ++m) _Pragma("unroll") for (int n = 0; n < 2; ++n) _Pragma("unroll") for (int k = 0; k < 2; ++k) \
        acc[ai][bj][m][n] = __builtin_amdgcn_mfma_f32_16x16x32_bf16(Bt[n][k], At[m][k], acc[ai][bj][m][n], 0, 0, 0); __builtin_amdgcn_s_setprio(0); } while (0)
#define PG8_WAIT_V(n) asm volatile("s_waitcnt vmcnt(" #n ")" ::: "memory")
#define PG8_WAIT_L(n) asm volatile("s_waitcnt lgkmcnt(" #n ")" ::: "memory")
#define PG8_BAR __builtin_amdgcn_s_barrier()
#define PG8_SCHED __builtin_amdgcn_sched_barrier(0)
    Unit cur, nxt; int ui = 0;
    if (!S.next(0, cur)) return;
    f32x4 acc[2][2][4][2];
#pragma unroll
    for (int a = 0; a < 2; ++a)
#pragma unroll
        for (int b = 0; b < 2; ++b)
#pragma unroll
            for (int m = 0; m < 4; ++m)
#pragma unroll
                for (int n = 0; n < 2; ++n) acc[a][b][m][n] = (f32x4){0.f, 0.f, 0.f, 0.f};
    bf16x8 At[4][2], B0[2][2], B1[2][2];
    const char* cA = cur.A; const char* cB = cur.Bt;
    PG8_STAGE(PG8_SB(0, 0), cB, voffB); PG8_STAGE(PG8_SA(0, 0), cA, voffA); PG8_STAGE(PG8_SB(0, 1), cB + hstep, voffB); PG8_STAGE(PG8_SA(0, 1), cA + hstep, voffA);
    if (wr == 1) PG8_BAR;
    PG8_WAIT_V(4); PG8_BAR;
    PG8_STAGE(PG8_SB(1, 0), cB + kstep, voffB); PG8_STAGE(PG8_SA(1, 0), cA + kstep, voffA); PG8_STAGE(PG8_SB(1, 1), cB + hstep + kstep, voffB);
    PG8_WAIT_V(6); PG8_BAR;
    for (;;) {
        const bool has_next = S.next(ui + 1, nxt);
        const char* nA = has_next ? nxt.A : cA; const char* nB = has_next ? nxt.Bt : cB;
        for (int t = 0; t < nt; t += 2) {
            const bool last = (t == nt - 2);
            const char* a1 = cA + (size_t)(t + 1) * kstep;
            const char* a2 = last ? nA : cA + (size_t)(t + 2) * kstep; const char* b2 = last ? nB : cB + (size_t)(t + 2) * kstep;
            const char* a3 = a2 + kstep; const char* b3 = b2 + kstep;
            PG8_LDB(B0, 0, 0); PG8_SCHED; PG8_LDA(At, 0, 0); PG8_STAGE(PG8_SA(1, 1), a1 + hstep, voffA);
            PG8_WAIT_L(8); PG8_BAR; PG8_WAIT_L(0); PG8_MMA(0, 0, At, B0); PG8_BAR; PG8_SCHED;
            PG8_LDB(B1, 0, 1); PG8_STAGE(PG8_SB(0, 0), b2, voffB);
            PG8_BAR; PG8_WAIT_L(0); PG8_MMA(0, 1, At, B1); PG8_BAR;
            PG8_LDA(At, 0, 1); PG8_STAGE(PG8_SA(0, 0), a2, voffA);
            PG8_BAR; PG8_WAIT_L(0); PG8_MMA(1, 0, At, B0); PG8_BAR; PG8_SCHED;
            PG8_STAGE(PG8_SB(0, 1), b2 + hstep, voffB);
            PG8_WAIT_V(6); PG8_BAR; PG8_MMA(1, 1, At, B1); PG8_BAR;
            PG8_LDB(B0, 1, 0); PG8_SCHED; PG8_LDA(At, 1, 0); PG8_STAGE(PG8_SA(0, 1), a2 + hstep, voffA);
            PG8_WAIT_L(8); PG8_BAR; PG8_WAIT_L(0); PG8_MMA(0, 0, At, B0); PG8_BAR; PG8_SCHED;
            PG8_LDB(B1, 1, 1); PG8_STAGE(PG8_SB(1, 0), b3, voffB);
            PG8_BAR; PG8_WAIT_L(0); PG8_MMA(0, 1, At, B1); PG8_BAR;
            PG8_LDA(At, 1, 1); PG8_STAGE(PG8_SA(1, 0), a3, voffA);
            PG8_BAR; PG8_WAIT_L(0); PG8_MMA(1, 0, At, B0); PG8_BAR; PG8_SCHED;
            PG8_STAGE(PG8_SB(1, 1), b3 + hstep, voffB);
            PG8_WAIT_V(6); PG8_BAR; PG8_MMA(1, 1, At, B1); PG8_BAR;
        }
        E(acc, cur, wr, wc, fr, fq);
        if (!has_next) break;
#pragma unroll
        for (int a = 0; a < 2; ++a)
#pragma unroll
            for (int b = 0; b < 2; ++b)
#pragma unroll
                for (int m = 0; m < 4; ++m)
#pragma unroll
                    for (int n = 0; n < 2; ++n) acc[a][b][m][n] = (f32x4){0.f, 0.f, 0.f, 0.f};
        cur = nxt; cA = nA; cB = nB; ++ui;
    }
    PG8_WAIT_V(0);
    if (wr == 0) PG8_BAR;
    PG8_BAR;
#undef PG8_SA
#undef PG8_SB
#undef PG8_STAGE
#undef PG8_LDA
#undef PG8_LDB
#undef PG8_MMA
#undef PG8_WAIT_V
#undef PG8_WAIT_L
#undef PG8_BAR
#undef PG8_SCHED
}

struct EpiStoreBf16 {
    static constexpr bool PERM = true;
    __device__ __forceinline__ void operator()(const f32x4 (&acc)[2][2][4][2], const Unit& u, int wr, int wc, int fr, int fq) const {
        bf16_t* O = u.out; const int ldc = u.ldo;
        const int row0 = u.x0 + wr * 64 + fr, col0 = u.x1 + wc * 32 + 8 * fq;
#pragma unroll
        for (int ai = 0; ai < 2; ++ai)
#pragma unroll
            for (int m = 0; m < 4; ++m) { bf16_t* rowp = O + (size_t)(row0 + ai * HALF + m * 16) * ldc + col0;
#pragma unroll
                for (int bj = 0; bj < 2; ++bj) { const f32x4 v0 = acc[ai][bj][m][0], v1 = acc[ai][bj][m][1];
                    u32x4 w; w.x = cvt_pk_bf16(v0[0], v0[1]); w.y = cvt_pk_bf16(v0[2], v0[3]); w.z = cvt_pk_bf16(v1[0], v1[1]); w.w = cvt_pk_bf16(v1[2], v1[3]);
                    *(u32x4*)(rowp + bj * HALF) = w; } }
    }
};
}

namespace mk {
struct NMapId { int off; __device__ __forceinline__ int operator()(int n) const { return n + off; } };
struct NMapInterleave { int which; __device__ __forceinline__ int operator()(int n) const { return 2 * n + which; } };
struct NMapRope { __device__ __forceinline__ int operator()(int n) const { if (n >= 2048) return n; const int ch = n >> 6, c = n & 63, half = c >> 5, w = c & 31, z = w >> 4, i = w & 15; return ch * 64 + half * 32 + 2 * i + z; } };

template <class NMap>
__device__ __forceinline__ void cvt_tile(const float* __restrict__ src, int ldsrc, int K, bf16_t* __restrict__ dst, int k0, int n0, const NMap& nmap, LAS float* tile) {
  const int t = mk::otid();
  { const int k = t >> 3, c = (t & 7) * 8; const float* p = src + (size_t)(k0 + k) * ldsrc + n0 + c;
    const f32x4 a = *(const f32x4*)p, b = *(const f32x4*)(p + 4);
    LAS float* q = tile + k * 65 + c; q[0] = a[0]; q[1] = a[1]; q[2] = a[2]; q[3] = a[3]; q[4] = b[0]; q[5] = b[1]; q[6] = b[2]; q[7] = b[3]; }
  __syncthreads();
  { const int n = t >> 3, kc = (t & 7) * 8; const LAS float* q = tile + kc * 65 + n;
    u32x4 w; w.x = cvt_pk_bf16(q[0], q[65]); w.y = cvt_pk_bf16(q[130], q[195]); w.z = cvt_pk_bf16(q[260], q[325]); w.w = cvt_pk_bf16(q[390], q[455]);
    *(u32x4*)(dst + (size_t)nmap(n0 + n) * K + k0 + kc) = w; }
  __syncthreads();
}
template <class NMap>
__device__ __forceinline__ int cvt_matrix(const float* src, int ldsrc, int K, int N, bf16_t* dst, const NMap& nmap, LAS float* tile, int ubase, int bid, int nblk) {
  const int nkt = K / 64, nnt = N / 64, tot = nkt * nnt;
  int first = ubase + ((bid - ubase % nblk) + nblk) % nblk;
  for (int u = first; u < ubase + tot; u += nblk) { const int v = u - ubase; cvt_tile(src, ldsrc, K, dst, (v / nnt) * 64, (v % nnt) * 64, nmap, tile); }
  return tot;
}
}

namespace att {
using namespace mk;
constexpr int KB_BYTES = 64 * 128, VB_BYTES = 128 * 128, DA_LDS = 2 * (KB_BYTES + VB_BYTES);
__device__ __forceinline__ int pi32(int r) { return (r & ~12) | ((r & 4) << 1) | ((r & 8) >> 1); }
__device__ __forceinline__ int swz(int row, int chunk) { return row * 128 + ((chunk ^ ((row >> 1) & 7)) << 4); }
__device__ __forceinline__ int crow(int r, int hi) { return (r & 3) + 8 * (r >> 2) + 4 * hi; }

__device__ __forceinline__ void diff_attn_unit(const bf16_t* __restrict__ Pqk, const bf16_t* __restrict__ Vt, bf16_t* __restrict__ O12, int hh, int q0, int klat0, int nlat, int kctx0, LAS unsigned char* lds) {
  const int tid = mk::otid(), wid = tid >> 6, lane = tid & 63, r = lane & 31, hi = lane >> 5;
  const int NT = (nlat + L) / 64, NTL = nlat / 64;
  constexpr float C = 0.125f * 1.4426950408889634f;
  constexpr float THR = 8.0f / 0.125f;
  const int srow = tid >> 3, sch = tid & 7;
  const bf16_t* kbase = Pqk + 1024 + hh * 64 + sch * 8;
  const bf16_t* vbase = Vt + (size_t)((hh >> 1) * 128 + srow) * NTOK + sch * 8;
  const int kdst = swz(srow, sch), vdst0 = swz(srow, sch), vdst1 = swz(srow + 64, sch);
  bf16x8 qf[4];
  { const bf16_t* qp = Pqk + (size_t)(q0 + wid * 32 + r) * 2048 + hh * 64 + hi * 8;
#pragma unroll
    for (int ks = 0; ks < 4; ++ks) qf[ks] = *(const bf16x8*)(qp + ks * 16); }
  int kaddr[2];
#pragma unroll
  for (int kb = 0; kb < 2; ++kb) kaddr[kb] = (kb * 32 + pi32(r)) * 128;
  const int kx = (pi32(r) >> 1) & 7;
  const int vx = (r >> 1) & 7;
  f32x16 o[4];
#pragma unroll
  for (int vb = 0; vb < 4; ++vb)
#pragma unroll
    for (int i = 0; i < 16; ++i) o[vb][i] = 0.f;
  float m_run = -1e30f, l_run = 0.f;
  u32x4 kreg, vreg0, vreg1;
#define DA_LOAD(t) do { const int tok = (t) < NTL ? klat0 + (t) * 64 : kctx0 + ((t) - NTL) * 64; \
    kreg = *(const u32x4*)(kbase + (size_t)(tok + srow) * 2048); vreg0 = *(const u32x4*)(vbase + tok); vreg1 = *(const u32x4*)(vbase + (size_t)64 * NTOK + tok); } while (0)
#define DA_WRITE(bufi) do { LAS unsigned char* kb_ = lds + (bufi) * KB_BYTES; LAS unsigned char* vb_ = lds + 2 * KB_BYTES + (bufi) * VB_BYTES; \
    *(LAS u32x4*)(kb_ + kdst) = kreg; *(LAS u32x4*)(vb_ + vdst0) = vreg0; *(LAS u32x4*)(vb_ + vdst1) = vreg1; } while (0)
  DA_LOAD(0); DA_WRITE(0); __syncthreads();
  for (int t = 0; t < NT; ++t) {
    const bool more = t + 1 < NT;
    if (more) DA_LOAD(t + 1);
    const LAS unsigned char* kb_ = lds + (t & 1) * KB_BYTES; const LAS unsigned char* vb_ = lds + 2 * KB_BYTES + (t & 1) * VB_BYTES;
    f32x16 s0, s1;
#pragma unroll
    for (int i = 0; i < 16; ++i) { s0[i] = 0.f; s1[i] = 0.f; }
#pragma unroll
    for (int ks = 0; ks < 4; ++ks) {
      const int ch = ((ks * 2 + hi) ^ kx) << 4;
      const bf16x8 a0 = *(const LAS bf16x8*)(kb_ + kaddr[0] + ch), a1 = *(const LAS bf16x8*)(kb_ + kaddr[1] + ch);
      s0 = __builtin_amdgcn_mfma_f32_32x32x16_bf16(a0, qf[ks], s0, 0, 0, 0);
      s1 = __builtin_amdgcn_mfma_f32_32x32x16_bf16(a1, qf[ks], s1, 0, 0, 0);
    }
    bf16x8 va[4][4];
#pragma unroll
    for (int vb = 0; vb < 4; ++vb) {
      const LAS unsigned char* vrow = vb_ + (vb * 32 + r) * 128;
#pragma unroll
      for (int c4 = 0; c4 < 4; ++c4) va[vb][c4] = *(const LAS bf16x8*)(vrow + (((2 * c4 + hi) ^ vx) << 4));
    }
    float mx = fmaxf(s0[0], s1[0]);
#pragma unroll
    for (int i = 1; i < 16; ++i) mx = fmaxf(mx, fmaxf(s0[i], s1[i]));
    { const u32x2 sw = __builtin_amdgcn_permlane32_swap(__float_as_uint(mx), __float_as_uint(mx), false, false); mx = fmaxf(__uint_as_float(sw.x), __uint_as_float(sw.y)); }
    float alpha = 1.0f;
    if (!__all(mx - m_run <= THR)) {
      const float m_new = fmaxf(m_run, mx);
      alpha = __builtin_amdgcn_exp2f((m_run - m_new) * C);
      m_run = m_new;
#pragma unroll
      for (int vb = 0; vb < 4; ++vb)
#pragma unroll
        for (int i = 0; i < 16; ++i) o[vb][i] *= alpha;
    }
    const float mc = -m_run * C;
    float ps = 0.f;
#pragma unroll
    for (int i = 0; i < 16; ++i) { s0[i] = __builtin_amdgcn_exp2f(fmaf(s0[i], C, mc)); ps += s0[i]; }
#pragma unroll
    for (int i = 0; i < 16; ++i) { s1[i] = __builtin_amdgcn_exp2f(fmaf(s1[i], C, mc)); ps += s1[i]; }
    l_run = l_run * alpha + ps;
    bf16x8 pf[2][2];
#pragma unroll
    for (int s = 0; s < 2; ++s) {
      u32x4 w0, w1;
      w0.x = cvt_pk_bf16(s0[8 * s + 0], s0[8 * s + 1]); w0.y = cvt_pk_bf16(s0[8 * s + 2], s0[8 * s + 3]); w0.z = cvt_pk_bf16(s0[8 * s + 4], s0[8 * s + 5]); w0.w = cvt_pk_bf16(s0[8 * s + 6], s0[8 * s + 7]);
      w1.x = cvt_pk_bf16(s1[8 * s + 0], s1[8 * s + 1]); w1.y = cvt_pk_bf16(s1[8 * s + 2], s1[8 * s + 3]); w1.z = cvt_pk_bf16(s1[8 * s + 4], s1[8 * s + 5]); w1.w = cvt_pk_bf16(s1[8 * s + 6], s1[8 * s + 7]);
      pf[0][s] = __builtin_bit_cast(bf16x8, w0); pf[1][s] = __builtin_bit_cast(bf16x8, w1);
    }
#pragma unroll
    for (int vb = 0; vb < 4; ++vb)
#pragma unroll
      for (int kb = 0; kb < 2; ++kb)
#pragma unroll
        for (int s = 0; s < 2; ++s) o[vb] = __builtin_amdgcn_mfma_f32_32x32x16_bf16(va[vb][kb * 2 + s], pf[kb][s], o[vb], 0, 0, 0);
    if (more) DA_WRITE((t + 1) & 1);
    __syncthreads();
  }
#undef DA_LOAD
#undef DA_WRITE
  float l_tot; { const u32x2 sw = __builtin_amdgcn_permlane32_swap(__float_as_uint(l_run), __float_as_uint(l_run), false, false); l_tot = __uint_as_float(sw.x) + __uint_as_float(sw.y); }
  const float inv = 1.0f / l_tot;
  bf16_t* op = O12 + (size_t)(q0 + wid * 32 + r) * 2048 + hh * 128 + 4 * hi;
#pragma unroll
  for (int vb = 0; vb < 4; ++vb)
#pragma unroll
    for (int g = 0; g < 4; ++g) {
      u32x2 w; w.x = cvt_pk_bf16(o[vb][4 * g] * inv, o[vb][4 * g + 1] * inv); w.y = cvt_pk_bf16(o[vb][4 * g + 2] * inv, o[vb][4 * g + 3] * inv);
      *(u32x2*)(op + vb * 32 + 8 * g) = w;
    }
}

__device__ __forceinline__ void diff_combine_rows4(const bf16_t* __restrict__ O12, const float* __restrict__ subln_g, float lam, float oml, bf16_t* __restrict__ O, int row0, int h, int lane) {
  unsigned a[4], b[4];
#pragma unroll
  for (int i = 0; i < 4; ++i) { a[i] = *(const unsigned*)(O12 + (size_t)(row0 + i) * 2048 + (2 * h) * 128 + 2 * lane); b[i] = *(const unsigned*)(O12 + (size_t)(row0 + i) * 2048 + (2 * h + 1) * 128 + 2 * lane); }
  const float g0 = subln_g[2 * lane], g1 = subln_g[2 * lane + 1];
#pragma unroll
  for (int i = 0; i < 4; ++i) {
    const float x0 = bflo(a[i]) - lam * bflo(b[i]), x1 = bfhi(a[i]) - lam * bfhi(b[i]);
    const float ss = wave_sum_u(x0 * x0 + x1 * x1);
    const float rs = rsqrtf(ss * (1.0f / 128.0f) + 1e-5f) * oml;
    *(unsigned*)(O + (size_t)(row0 + i) * 1024 + h * 128 + 2 * lane) = cvt_pk_bf16(x0 * rs * g0, x1 * rs * g1);
  }
}
}

namespace natt {
using namespace mk;
using att::pi32; using att::swz;
constexpr int TB = 64 * 128;
constexpr int NA_LDS = 4 * TB + 2048;
__device__ __forceinline__ void na_attn_unit(const bf16_t* __restrict__ Pe, const bf16_t* __restrict__ Vte, const float* __restrict__ rpb_h, bf16_t* __restrict__ O, int b, int h, int rq, LAS unsigned char* lds) {
  const int tid = mk::otid(), wid = tid >> 6, lane = tid & 63, r = lane & 31, hi = lane >> 5;
  constexpr float LOG2E = 1.4426950408889634f;
  LAS float* sb = (LAS float*)(lds + 4 * TB);
  for (int i = tid; i < 465; i += NTHR) sb[i] = rpb_h[i];
  const bool is_ctx = rq < 0;
  int qrow = 0, qcol = 0, qtok, rs_q = 0, cs_q = 0, span0 = 0, wlo = 0, whi = -1, lo = 0, ntl = 0;
  if (!is_ctx) {
    const int r0 = rq * 4, ra = r0 + (wid >> 2) * 2;
    qrow = ra + (r >> 4); qcol = (wid & 3) * 16 + (r & 15); qtok = b * T + qrow * 64 + qcol;
    rs_q = min(max(qrow - 4, 0), 120); cs_q = min(max(qcol - 8, 0), 48);
    span0 = min(max((wid & 3) * 16 - 8, 0), 32);
    wlo = min(max(ra - 4, 0), 120); whi = min(max(ra - 3, 0), 120) + 7;
    lo = min(max(r0 - 4, 0), 120); const int hi_ = min(max(r0 - 1, 0), 120) + 7; ntl = hi_ - lo + 1;
  } else qtok = NLAT + b * L + wid * 32 + r;
  const int NT = ntl + 4;
  const int srow = tid >> 3, sch = tid & 7;
  const bf16_t* kbase = Pe + 512 + h * 64 + sch * 8;
  const bf16_t* vbase = Vte + (size_t)(h * 64 + srow) * NTOK + sch * 8;
  const int sdst = swz(srow, sch);
  bf16x8 qf[4];
  { const bf16_t* qp = Pe + (size_t)qtok * 1024 + h * 64 + hi * 8;
#pragma unroll
    for (int ks = 0; ks < 4; ++ks) qf[ks] = *(const bf16x8*)(qp + ks * 16); }
  const int kx = (pi32(r) >> 1) & 7, vx = (r >> 1) & 7;
  const int ka_loc = (span0 + pi32(r)) * 128; const int kx_loc = ((span0 + pi32(r)) >> 1) & 7;
  f32x16 o[2];
#pragma unroll
  for (int vb = 0; vb < 2; ++vb)
#pragma unroll
    for (int i = 0; i < 16; ++i) o[vb][i] = 0.f;
  float m_run = -1e30f, l_run = 0.f;
  u32x4 kreg, vreg;
#define NA_LOAD(t) do { const int tok = (t) < ntl ? b * T + (lo + (t)) * 64 : NLAT + b * L + ((t) - ntl) * 64; \
    kreg = *(const u32x4*)(kbase + (size_t)(tok + srow) * 1024); vreg = *(const u32x4*)(vbase + tok); } while (0)
#define NA_WRITE(bufi) do { *(LAS u32x4*)(lds + (bufi) * TB + sdst) = kreg; *(LAS u32x4*)(lds + 2 * TB + (bufi) * TB + sdst) = vreg; } while (0)
  NA_LOAD(0); NA_WRITE(0); __syncthreads();
  for (int t = 0; t < NT; ++t) {
    const bool more = t + 1 < NT;
    if (more) NA_LOAD(t + 1);
    const LAS unsigned char* kb_ = lds + (t & 1) * TB; const LAS unsigned char* vb_ = lds + 2 * TB + (t & 1) * TB;
    const bool local = t < ntl; const int kr = lo + t;
    const bool active = !local || (kr >= wlo && kr <= whi);
    if (active) {
      f32x16 s0, s1;
#pragma unroll
      for (int i = 0; i < 16; ++i) { s0[i] = 0.f; s1[i] = 0.f; }
      if (local) {
#pragma unroll
        for (int ks = 0; ks < 4; ++ks) {
          const bf16x8 a0 = *(const LAS bf16x8*)(kb_ + ka_loc + (((ks * 2 + hi) ^ kx_loc) << 4));
          s0 = __builtin_amdgcn_mfma_f32_32x32x16_bf16(a0, qf[ks], s0, 0, 0, 0);
        }
        const bool row_ok = kr >= rs_q && kr < rs_q + 8; const int dr31 = (kr - qrow + 7) * 31;
#pragma unroll
        for (int i = 0; i < 16; ++i) {
          const int kc = span0 + (i & 7) + 8 * hi + 16 * (i >> 3);
          const bool ok = row_ok && kc >= cs_q && kc < cs_q + 16;
          const int bi = ok ? dr31 + (kc - qcol + 15) : 0;
          const float bv = sb[bi];
          s0[i] = ok ? fmaf(s0[i], 0.125f, bv) : -1e30f; s1[i] = -1e30f;
        }
      } else {
#pragma unroll
        for (int ks = 0; ks < 4; ++ks) {
          const int ch = ((ks * 2 + hi) ^ kx) << 4;
          const bf16x8 a0 = *(const LAS bf16x8*)(kb_ + pi32(r) * 128 + ch), a1 = *(const LAS bf16x8*)(kb_ + (32 + pi32(r)) * 128 + ch);
          s0 = __builtin_amdgcn_mfma_f32_32x32x16_bf16(a0, qf[ks], s0, 0, 0, 0);
          s1 = __builtin_amdgcn_mfma_f32_32x32x16_bf16(a1, qf[ks], s1, 0, 0, 0);
        }
#pragma unroll
        for (int i = 0; i < 16; ++i) { s0[i] *= 0.125f; s1[i] *= 0.125f; }
      }
      float mx = s0[0];
#pragma unroll
      for (int i = 1; i < 16; ++i) mx = fmaxf(mx, s0[i]);
#pragma unroll
      for (int i = 0; i < 16; ++i) mx = fmaxf(mx, s1[i]);
      { const u32x2 sw = __builtin_amdgcn_permlane32_swap(__float_as_uint(mx), __float_as_uint(mx), false, false); mx = fmaxf(__uint_as_float(sw.x), __uint_as_float(sw.y)); }
      const float m_new = fmaxf(m_run, mx);
      const float alpha = __builtin_amdgcn_exp2f((m_run - m_new) * LOG2E);
      m_run = m_new;
      const float mc = -m_new * LOG2E;
      float ps = 0.f;
#pragma unroll
      for (int i = 0; i < 16; ++i) { const float p = s0[i] > -1e29f ? __builtin_amdgcn_exp2f(fmaf(s0[i], LOG2E, mc)) : 0.f; s0[i] = p; ps += p; }
#pragma unroll
      for (int i = 0; i < 16; ++i) { const float p = s1[i] > -1e29f ? __builtin_amdgcn_exp2f(fmaf(s1[i], LOG2E, mc)) : 0.f; s1[i] = p; ps += p; }
      l_run = l_run * alpha + ps;
      if (__any(alpha < 1.0f)) {
#pragma unroll
        for (int vb = 0; vb < 2; ++vb)
#pragma unroll
          for (int i = 0; i < 16; ++i) o[vb][i] *= alpha;
      }
      bf16x8 pf[2][2];
#pragma unroll
      for (int s = 0; s < 2; ++s) {
        u32x4 w0, w1;
        w0.x = cvt_pk_bf16(s0[8 * s + 0], s0[8 * s + 1]); w0.y = cvt_pk_bf16(s0[8 * s + 2], s0[8 * s + 3]); w0.z = cvt_pk_bf16(s0[8 * s + 4], s0[8 * s + 5]); w0.w = cvt_pk_bf16(s0[8 * s + 6], s0[8 * s + 7]);
        w1.x = cvt_pk_bf16(s1[8 * s + 0], s1[8 * s + 1]); w1.y = cvt_pk_bf16(s1[8 * s + 2], s1[8 * s + 3]); w1.z = cvt_pk_bf16(s1[8 * s + 4], s1[8 * s + 5]); w1.w = cvt_pk_bf16(s1[8 * s + 6], s1[8 * s + 7]);
        pf[0][s] = __builtin_bit_cast(bf16x8, w0); pf[1][s] = __builtin_bit_cast(bf16x8, w1);
      }
      const int cbase = local ? (span0 >> 3) : 0;
#pragma unroll
      for (int vb = 0; vb < 2; ++vb) {
        const LAS unsigned char* vrow = vb_ + (vb * 32 + r) * 128;
#pragma unroll
        for (int s = 0; s < 2; ++s) {
          const bf16x8 a = *(const LAS bf16x8*)(vrow + (((cbase + 2 * s + hi) ^ vx) << 4));
          o[vb] = __builtin_amdgcn_mfma_f32_32x32x16_bf16(a, pf[0][s], o[vb], 0, 0, 0);
        }
        if (!local) {
#pragma unroll
          for (int s = 0; s < 2; ++s) {
            const bf16x8 a = *(const LAS bf16x8*)(vrow + (((4 + 2 * s + hi) ^ vx) << 4));
            o[vb] = __builtin_amdgcn_mfma_f32_32x32x16_bf16(a, pf[1][s], o[vb], 0, 0, 0);
          }
        }
      }
    }
    if (more) NA_WRITE((t + 1) & 1);
    __syncthreads();
  }
#undef NA_LOAD
#undef NA_WRITE
  float l_tot; { const u32x2 sw = __builtin_amdgcn_permlane32_swap(__float_as_uint(l_run), __float_as_uint(l_run), false, false); l_tot = __uint_as_float(sw.x) + __uint_as_float(sw.y); }
  const float inv = 1.0f / l_tot;
  bf16_t* op = O + (size_t)qtok * 1024 + h * 64 + 4 * hi;
#pragma unroll
  for (int vb = 0; vb < 2; ++vb)
#pragma unroll
    for (int g = 0; g < 4; ++g) {
      u32x2 w; w.x = cvt_pk_bf16(o[vb][4 * g] * inv, o[vb][4 * g + 1] * inv); w.y = cvt_pk_bf16(o[vb][4 * g + 2] * inv, o[vb][4 * g + 3] * inv);
      *(u32x2*)(op + vb * 32 + 8 * g) = w;
    }
}
}

namespace rw {
using namespace mk;
constexpr int NSTEP = L + T, NCH = 32, CL = NSTEP / NCH;
constexpr int NCHAIN = 2 * B * 8;
constexpr float LOG2E = 1.4426950408889634f;
struct Bufs {
  u32x2* SH;
  unsigned* DR;
  bf16_t* G; int gstride;
  float* CS;
  float* PQ;
  float* SST;
  bf16_t* Y;
  bf16_t* Z;
};

__device__ __forceinline__ void prep_tile(const bf16_t* __restrict__ Prw, const float* __restrict__ cw, const float* __restrict__ w0, const float* __restrict__ w_up, const float* __restrict__ a0,
                                          const float* __restrict__ a_up, const float* __restrict__ g_up, const float* __restrict__ k_k, const float* __restrict__ k_a, const float* __restrict__ r_k,
                                          const Bufs& bf, int tile, LAS float* xs  ) {
  const int c = mk::otid(), lane = c & 63, h = c >> 6;
  const int row0 = tile * 16;
  int lo, hi;
  if (row0 < NLAT) { lo = (row0 / T) * T; hi = lo + T - 1; } else { lo = NLAT + ((row0 - NLAT) / L) * L; hi = lo + L - 1; }
#define RW_CONV(dst, col) do { const float c0 = cw[(col)], c1 = cw[RW_IN + (col)], c2 = cw[2 * RW_IN + (col)]; const bf16_t* p = Prw + (size_t)row0 * RW_IN + (col); \
    float pm = row0 > lo ? bf2f(p[-RW_IN]) : 0.f, pc = bf2f(p[0]); \
    _Pragma("unroll") for (int tt = 0; tt < 16; ++tt) { const float pn = (row0 + tt + 1 <= hi) ? bf2f(p[(size_t)(tt + 1) * RW_IN]) : 0.f; dst[tt] = pm * c0 + pc * c1 + pn * c2; pm = pc; pc = pn; } } while (0)
  if (c < 256) {
    float xv[16]; RW_CONV(xv, 1536 + c);
#pragma unroll
    for (int tt = 0; tt < 16; ++tt) { float v = xv[tt]; if (c < 64) v = tanhf(v); else if (c >= 128) v = sigmoidf_(v); xs[c * 16 + tt] = v; }
  }
  __syncthreads();
  const float w00 = w0[c], w01 = w0[512 + c], a00 = a0[c], a01 = a0[512 + c], kkc = k_k[c], kac = k_a[c], rkc = r_k[c];
  float e0[16], e1[16];
  {
    float aw0[16], aw1[16];
#pragma unroll
    for (int tt = 0; tt < 16; ++tt) { aw0[tt] = 0.f; aw1[tt] = 0.f; }
    float nw0[8], nw1[8];
#pragma unroll
    for (int u = 0; u < 8; ++u) { nw0[u] = w_up[(size_t)u * 512 + c]; nw1[u] = w_up[(size_t)(64 + u) * 512 + c]; }
    for (int m0 = 0; m0 < 64; m0 += 8) {
      float ww0[8], ww1[8];
      const int mn = m0 + 8 < 64 ? m0 + 8 : m0;
#pragma unroll
      for (int u = 0; u < 8; ++u) { ww0[u] = nw0[u]; ww1[u] = nw1[u]; nw0[u] = w_up[(size_t)(mn + u) * 512 + c]; nw1[u] = w_up[(size_t)(64 + mn + u) * 512 + c]; }
#pragma unroll
      for (int u = 0; u < 8; ++u) {
#pragma unroll
        for (int q = 0; q < 4; ++q) { const f32x4 xw = *(const LAS f32x4*)(xs + (m0 + u) * 16 + q * 4);
#pragma unroll
          for (int e = 0; e < 4; ++e) { aw0[q * 4 + e] += xw[e] * ww0[u]; aw1[q * 4 + e] += xw[e] * ww1[u]; } }
      }
    }
#pragma unroll
    for (int tt = 0; tt < 16; ++tt) {
      { const float z = -(w00 + aw0[tt]); const float sp = fmaxf(z, 0.f) + __logf(1.0f + __expf(-fabsf(z))); e0[tt] = __expf(-sp - 0.5f); }
      { const float z = -(w01 + aw1[tt]); const float sp = fmaxf(z, 0.f) + __logf(1.0f + __expf(-fabsf(z))); e1[tt] = __expf(-sp - 0.5f); }
    }
  }
  LAS float* asl = xs + 256 * 16;
  {
    float aa0[16], aa1[16];
#pragma unroll
    for (int tt = 0; tt < 16; ++tt) { aa0[tt] = 0.f; aa1[tt] = 0.f; }
    float na0[8], na1[8];
#pragma unroll
    for (int u = 0; u < 8; ++u) { na0[u] = a_up[(size_t)u * 512 + c]; na1[u] = a_up[(size_t)(64 + u) * 512 + c]; }
    for (int m0 = 0; m0 < 64; m0 += 8) {
      float av0[8], av1[8];
      const int mn = m0 + 8 < 64 ? m0 + 8 : m0;
#pragma unroll
      for (int u = 0; u < 8; ++u) { av0[u] = na0[u]; av1[u] = na1[u]; na0[u] = a_up[(size_t)(mn + u) * 512 + c]; na1[u] = a_up[(size_t)(64 + mn + u) * 512 + c]; }
#pragma unroll
      for (int u = 0; u < 8; ++u) {
#pragma unroll
        for (int q = 0; q < 4; ++q) { const f32x4 xa = *(const LAS f32x4*)(xs + (64 + m0 + u) * 16 + q * 4);
#pragma unroll
          for (int e = 0; e < 4; ++e) { aa0[q * 4 + e] += xa[e] * av0[u]; aa1[q * 4 + e] += xa[e] * av1[u]; } }
      }
    }
#pragma unroll
    for (int tt = 0; tt < 16; ++tt) { const unsigned d0 = cvt_pk_bf16(e0[tt], sigmoidf_(a00 + aa0[tt])), d1 = cvt_pk_bf16(e1[tt], sigmoidf_(a01 + aa1[tt]));
      bf.DR[((size_t)(row0 + tt)) * 512 + c] = d0; bf.DR[((size_t)NTOK + row0 + tt) * 512 + c] = d1; asl[tt * 512 + c] = bfhi(d0); asl[(16 + tt) * 512 + c] = bfhi(d1); }
  }
  {
    float ag[16];
#pragma unroll
    for (int tt = 0; tt < 16; ++tt) ag[tt] = 0.f;
    float ng[16];
#pragma unroll
    for (int u = 0; u < 16; ++u) ng[u] = g_up[(size_t)u * 512 + c];
    for (int m0 = 0; m0 < 128; m0 += 16) {
      float gg[16];
      const int mn = m0 + 16 < 128 ? m0 + 16 : m0;
#pragma unroll
      for (int u = 0; u < 16; ++u) { gg[u] = ng[u]; ng[u] = g_up[(size_t)(mn + u) * 512 + c]; }
#pragma unroll
      for (int u = 0; u < 16; ++u) {
#pragma unroll
        for (int q = 0; q < 4; ++q) { const f32x4 xg = *(const LAS f32x4*)(xs + (128 + m0 + u) * 16 + q * 4);
#pragma unroll
          for (int e = 0; e < 4; ++e) ag[q * 4 + e] += xg[e] * gg[u]; }
      }
    }
#pragma unroll
    for (int tt = 0; tt < 16; ++tt) bf.G[(size_t)(row0 + tt) * bf.gstride + c] = f2bf(ag[tt]);
  }
#undef RW_CONV
  const float cr0 = cw[c], cr1 = cw[RW_IN + c], cr2 = cw[2 * RW_IN + c], ck0 = cw[512 + c], ck1 = cw[RW_IN + 512 + c], ck2 = cw[2 * RW_IN + 512 + c], cv0 = cw[1024 + c], cv1 = cw[RW_IN + 1024 + c], cv2 = cw[2 * RW_IN + 1024 + c];
  const bf16_t* pr = Prw + (size_t)row0 * RW_IN + c;
  float rm = row0 > lo ? bf2f(pr[-RW_IN]) : 0.f, km = row0 > lo ? bf2f(pr[512 - RW_IN]) : 0.f, vm = row0 > lo ? bf2f(pr[1024 - RW_IN]) : 0.f;
  float rc = bf2f(pr[0]), kc = bf2f(pr[512]), vc = bf2f(pr[1024]);
#pragma unroll 2
  for (int tt = 0; tt < 16; ++tt) {
    const int row = row0 + tt;
    const bool has_n = row + 1 <= hi; const bf16_t* pn = pr + (size_t)(tt + 1) * RW_IN;
    const float rn = has_n ? bf2f(pn[0]) : 0.f, kn = has_n ? bf2f(pn[512]) : 0.f, vn = has_n ? bf2f(pn[1024]) : 0.f;
    const float rv = rm * cr0 + rc * cr1 + rn * cr2, kvv = km * ck0 + kc * ck1 + kn * ck2, vvv = vm * cv0 + vc * cv1 + vn * cv2;
    rm = rc; rc = rn; km = kc; kc = kn; vm = vc; vc = vn;
    float kk = kvv * kkc; const float nrm = sqrtf(wave_sum_u(kk * kk)); kk = kk * __builtin_amdgcn_rcpf(fmaxf(nrm, 1e-12f));
    u32x2 sh; sh.x = cvt_pk_bf16(rv, kvv); sh.y = cvt_pk_bf16(kk, vvv);
    bf.SH[(size_t)row * 512 + c] = sh;
    const float rq = bflo(sh.x), kq = bfhi(sh.x);
    const float cb0 = wave_sum_u(rq * kq * (1.0f + (asl[tt * 512 + c] - 1.0f) * kac) * rkc), cb1 = wave_sum_u(rq * kq * (1.0f + (asl[(16 + tt) * 512 + c] - 1.0f) * kac) * rkc);
    if (lane == 0) { bf.CS[(size_t)row * 16 + h] = cb0; bf.CS[(size_t)row * 16 + 8 + h] = cb1; }
  }
  __syncthreads();
}

struct StepRaw { u32x2 s; unsigned d; };
__device__ __forceinline__ int scan_row(int dir, int b, int p) {
  if (p < L) return NLAT + b * L + (dir ? (L - 1 - p) : p);
  const int q = p - L; return b * T + (dir ? (T - 1 - q) : q);
}
#define RW_RL(x, j) __int_as_float(__builtin_amdgcn_readlane(__float_as_int(x), (j)))
__device__ __forceinline__ void scan_unit(const Bufs& bf, const float* __restrict__ k_a, int chain, int chunk, LAS float* wl  ) {
  const int lane = mk::otid() & 63;
  const int dir = chain >> 5, b = (chain >> 3) & 3, h = chain & 7, ch = h * 64 + lane;
  const float kac = k_a[ch];
  float S[64], P[64];
#pragma unroll
  for (int j = 0; j < 64; ++j) { S[j] = 0.f; P[j] = (j == lane) ? 1.f : 0.f; }
  const int p0 = chunk * CL;
  StepRaw nx; { const int row = scan_row(dir, b, p0); nx.s = bf.SH[(size_t)row * 512 + ch]; nx.d = bf.DR[((size_t)dir * NTOK + row) * 512 + ch]; }
  for (int s = 0; s < CL; ++s) {
    const StepRaw cu = nx; const int row = scan_row(dir, b, p0 + s);
    if (s + 1 < CL) { const int rn = scan_row(dir, b, p0 + s + 1); nx.s = bf.SH[(size_t)rn * 512 + ch]; nx.d = bf.DR[((size_t)dir * NTOK + rn) * 512 + ch]; }
    const float r = bflo(cu.s.x), k = bfhi(cu.s.x), kk = bflo(cu.s.y), v = bfhi(cu.s.y), e = bflo(cu.d), asg = bfhi(cu.d);
    const float w = __builtin_amdgcn_exp2f(-e * LOG2E), a = -kk, bb = kk * asg, keff = k * (1.0f + (asg - 1.0f) * kac);
    wl[lane] = a; wl[64 + lane] = w; wl[128 + lane] = bb; wl[192 + lane] = keff; wl[256 + lane] = r;
    float sa = 0.f, sap = 0.f;
#pragma unroll
    for (int j4 = 0; j4 < 16; ++j4) { const f32x4 av = *(const LAS f32x4*)(wl + 4 * j4);
#pragma unroll
      for (int e2 = 0; e2 < 4; ++e2) { sa = fmaf(S[4 * j4 + e2], av[e2], sa); sap = fmaf(P[4 * j4 + e2], av[e2], sap); } }
    float y = 0.f, z = 0.f;
#pragma unroll
    for (int j4 = 0; j4 < 16; ++j4) {
      const f32x4 wv = *(const LAS f32x4*)(wl + 64 + 4 * j4), bv = *(const LAS f32x4*)(wl + 128 + 4 * j4), kv = *(const LAS f32x4*)(wl + 192 + 4 * j4), rv = *(const LAS f32x4*)(wl + 256 + 4 * j4);
#pragma unroll
      for (int e2 = 0; e2 < 4; ++e2) { const int j = 4 * j4 + e2;
        float t = v * kv[e2]; t = fmaf(sa, bv[e2], t); S[j] = fmaf(S[j], wv[e2], t);
        P[j] = fmaf(P[j], wv[e2], sap * bv[e2]);
        y = fmaf(S[j], rv[e2], y); z = fmaf(P[j], rv[e2], z); }
    }
    const size_t oi = ((size_t)dir * NTOK + row) * 512 + ch;
    bf.Y[oi] = f2bf(y); bf.Z[oi] = f2bf(z);
  }
  if (chunk < NCH - 1) {
    float* pq = bf.PQ + (((size_t)chain * (NCH - 1) + chunk) * 2) * 4096 + lane * 64;
#pragma unroll
    for (int q = 0; q < 16; ++q) { *(f32x4*)(pq + q * 4) = (f32x4){P[q * 4], P[q * 4 + 1], P[q * 4 + 2], P[q * 4 + 3]}; *(f32x4*)(pq + 4096 + q * 4) = (f32x4){S[q * 4], S[q * 4 + 1], S[q * 4 + 2], S[q * 4 + 3]}; }
  }
}

__device__ __forceinline__ void propagate_chain(const Bufs& bf, int chain, LAS float* lds) {
  LAS float* Sl = lds; LAS float* Pl = lds + 64 * 65;
  const int tid = mk::otid(), i = tid >> 3, jg = (tid & 7) * 8;
  float* sst = bf.SST + (size_t)chain * NCH * 4096;
#pragma unroll
  for (int e = 0; e < 8; ++e) Sl[i * 65 + jg + e] = 0.f;
  for (int c = 0; c < NCH - 1; ++c) {
    const float* pq = bf.PQ + (((size_t)chain * (NCH - 1) + c) * 2) * 4096;
    const f32x4 p0 = *(const f32x4*)(pq + i * 64 + jg), p1 = *(const f32x4*)(pq + i * 64 + jg + 4);
    f32x4 q0 = *(const f32x4*)(pq + 4096 + i * 64 + jg), q1 = *(const f32x4*)(pq + 4096 + i * 64 + jg + 4);
    *(LAS f32x4*)(Pl + i * 64 + jg) = p0; *(LAS f32x4*)(Pl + i * 64 + jg + 4) = p1;
    __syncthreads();
#pragma unroll 8
    for (int k = 0; k < 64; ++k) { const float sv = Sl[i * 65 + k]; const f32x4 a = *(const LAS f32x4*)(Pl + k * 64 + jg), b2 = *(const LAS f32x4*)(Pl + k * 64 + jg + 4); q0 += sv * a; q1 += sv * b2; }
    __syncthreads();
    Sl[i * 65 + jg] = q0[0]; Sl[i * 65 + jg + 1] = q0[1]; Sl[i * 65 + jg + 2] = q0[2]; Sl[i * 65 + jg + 3] = q0[3]; Sl[i * 65 + jg + 4] = q1[0]; Sl[i * 65 + jg + 5] = q1[1]; Sl[i * 65 + jg + 6] = q1[2]; Sl[i * 65 + jg + 7] = q1[3];
    *(f32x4*)(sst + (size_t)(c + 1) * 4096 + i * 64 + jg) = q0; *(f32x4*)(sst + (size_t)(c + 1) * 4096 + i * 64 + jg + 4) = q1;
  }
  __syncthreads();
}

__device__ __forceinline__ void corr_unit(const Bufs& bf, int chain, int chunk) {
  const int lane = mk::otid() & 63, r = lane & 31, hi = lane >> 5;
  const int dir = chain >> 5, b = (chain >> 3) & 3, h = chain & 7;
  const float* ss = bf.SST + ((size_t)chain * NCH + chunk) * 4096;
  bf16x8 bfr[2][4];
#pragma unroll
  for (int nt = 0; nt < 2; ++nt)
#pragma unroll
    for (int ks = 0; ks < 4; ++ks) { const float* q = ss + (size_t)(nt * 32 + r) * 64 + ks * 16 + hi * 8; const f32x4 x0 = *(const f32x4*)q, x1 = *(const f32x4*)(q + 4);
      u32x4 w; w.x = cvt_pk_bf16(x0[0], x0[1]); w.y = cvt_pk_bf16(x0[2], x0[3]); w.z = cvt_pk_bf16(x1[0], x1[1]); w.w = cvt_pk_bf16(x1[2], x1[3]); bfr[nt][ks] = __builtin_bit_cast(bf16x8, w); }
  const int p0 = chunk * CL;
  const size_t dbase = (size_t)dir * NTOK;
  for (int mt = 0; mt < (CL + 31) / 32; ++mt) {
    const int sa_ = min(mt * 32 + r, CL - 1);
    const bf16_t* zp = bf.Z + (dbase + scan_row(dir, b, p0 + sa_)) * 512 + h * 64 + hi * 8;
    bf16x8 af[4];
#pragma unroll
    for (int ks = 0; ks < 4; ++ks) af[ks] = *(const bf16x8*)(zp + ks * 16);
    f32x16 acc[2];
#pragma unroll
    for (int nt = 0; nt < 2; ++nt) { acc[nt] = zero16();
#pragma unroll
      for (int ks = 0; ks < 4; ++ks) acc[nt] = __builtin_amdgcn_mfma_f32_32x32x16_bf16(af[ks], bfr[nt][ks], acc[nt], 0, 0, 0); }
#pragma unroll
    for (int i = 0; i < 16; ++i) { const int so = mt * 32 + (i & 3) + 8 * (i >> 2) + 4 * hi;
      if (so < CL) { bf16_t* yp = bf.Y + (dbase + scan_row(dir, b, p0 + so)) * 512 + h * 64 + r;
        yp[0] = f2bf(bf2f(yp[0]) + acc[0][i]); yp[32] = f2bf(bf2f(yp[32]) + acc[1][i]); } }
  }
}

__device__ __forceinline__ void finish_rows4(const Bufs& bf, const float* __restrict__ gn_g, const float* __restrict__ gn_b, bf16_t* __restrict__ O, int row0) {
  const int c = mk::otid(), h = c >> 6;
  float y[4], v[4], g[4], cs[4];
#pragma unroll
  for (int i = 0; i < 4; ++i) { const int row = row0 + i;
    y[i] = bf2f(bf.Y[(size_t)row * 512 + c]) + bf2f(bf.Y[((size_t)NTOK + row) * 512 + c]);
    v[i] = bfhi(bf.SH[(size_t)row * 512 + c].y); g[i] = bf2f(bf.G[(size_t)row * bf.gstride + c]);
    cs[i] = bf.CS[(size_t)row * 16 + h] + bf.CS[(size_t)row * 16 + 8 + h]; }
  const float gg = gn_g[c], gb = gn_b[c];
  float o[4];
#pragma unroll
  for (int i = 0; i < 4; ++i) { const float mu = wave_sum_u(y[i]) * (1.0f / 64.0f); const float dv = y[i] - mu; const float var = wave_sum_u(dv * dv) * (1.0f / 64.0f);
    o[i] = (dv * rsqrtf(var + 64e-5f) * gg + gb + cs[i] * v[i]) * g[i]; }
#pragma unroll
  for (int i = 0; i < 4; ++i) O[(size_t)(row0 + i) * 1024 + 512 + c] = f2bf(o[i]);
}
}

namespace mk {
constexpr size_t al256(size_t x) { return (x + 255) / 256 * 256; }
constexpr size_t WS_BAR = 0;
constexpr size_t WS_BCNT = al256(WS_BAR + (size_t)XCD_BAR_WORDS * 4);
constexpr size_t WS_MOFF = al256(WS_BCNT + (size_t)4 * 256 * 64 * 4);
constexpr size_t WS_MOD = al256(WS_MOFF + 4 * 256);
constexpr size_t WS_ROPE = al256(WS_MOD + (size_t)4 * 5 * 6144 * 4);
constexpr size_t WS_HCTX = al256(WS_ROPE + 128 * 16 * 2 * 4);
constexpr size_t WS_EID = al256(WS_HCTX + (size_t)NCTX * D * 4);
constexpr size_t WS_GATE = al256(WS_EID + (size_t)NTOK * 2 * 4);
constexpr size_t WS_POS = al256(WS_GATE + (size_t)NTOK * 2 * 4);
constexpr size_t WS_WEIN = al256(WS_POS + (size_t)NTOK * 2 * 4);
constexpr size_t WS_WOIN = al256(WS_WEIN + (size_t)2 * EVEN_IN * D * 2);
constexpr size_t WS_WEOUT = al256(WS_WOIN + (size_t)2 * ODD_IN * D * 2);
constexpr size_t WS_WOOUT = al256(WS_WEOUT + (size_t)2 * D * D * 2);
constexpr size_t WS_WGU = al256(WS_WOOUT + (size_t)2 * D * D * 2);
constexpr size_t WS_WDN = al256(WS_WGU + (size_t)NE * 1024 * D * 2);
constexpr size_t WS_UO = al256(WS_WDN + (size_t)NE * D * DE * 2);
constexpr size_t WS_SCR = al256(WS_UO + (size_t)NTOK * D * 2);
constexpr size_t SE_PQK = 0;
constexpr size_t SE_VT = al256(SE_PQK + (size_t)NTOK * 1024 * 2);
constexpr size_t SE_PRW = al256(SE_VT + (size_t)512 * NTOK * 2);
constexpr size_t SE_PQ = 0;
constexpr size_t SE_SST = al256(SE_PQ + (size_t)rw::NCHAIN * (rw::NCH - 1) * 2 * 4096 * 4);
constexpr size_t SE_Y = al256(SE_SST + (size_t)rw::NCHAIN * rw::NCH * 4096 * 4);
constexpr size_t SE_Z = al256(SE_Y + (size_t)2 * NTOK * 512 * 2);
constexpr size_t SE_ZEND = al256(SE_Z + (size_t)2 * NTOK * 512 * 2);
constexpr size_t SE_PRWEND = al256(SE_PRW + (size_t)NTOK * RW_IN * 2);
constexpr size_t SE_SH = SE_PRWEND > SE_ZEND ? SE_PRWEND : SE_ZEND;
constexpr size_t SE_DR = al256(SE_SH + (size_t)NTOK * 512 * 8);
constexpr size_t SE_CS = al256(SE_DR + (size_t)2 * NTOK * 512 * 4);
constexpr size_t SE_END = al256(SE_CS + (size_t)2 * NTOK * 16 * 4);
constexpr size_t SE_YBUF = 0;
constexpr size_t SO_PQK = 0;
constexpr size_t SO_VT = al256(SO_PQK + (size_t)NTOK * 2048 * 2);
constexpr size_t SO_O12 = al256(SO_VT + (size_t)1024 * NTOK * 2);
constexpr size_t SO_END = al256(SO_O12 + (size_t)NTOK * 2048 * 2);
constexpr size_t SO_YBUF = 0;
constexpr size_t SM_XS = 0;
constexpr size_t SM_HE = al256(SM_XS + (size_t)MOE_ROWS * D * 2);
constexpr size_t SM_YS = al256(SM_HE + (size_t)MOE_ROWS * DE * 2);
constexpr size_t SM_END = al256(SM_YS + (size_t)MOE_ROWS * D * 2);
constexpr size_t SCR_BYTES = SE_END > SO_END ? (SE_END > SM_END ? SE_END : SM_END) : (SO_END > SM_END ? SO_END : SM_END);
constexpr size_t WS_END = WS_SCR + SCR_BYTES;
constexpr int LDS_BARW = 131072;
constexpr int LDS_MISC = 131072 + 64;

struct Params {
  const float *x, *c, *ctx, *c_ctx, *ada_w, *ada_b, *ln_g, *ln_b, *even_w_in, *even_w_out, *shift_w, *na_rpb, *rw_w0, *rw_w_up, *rw_a0, *rw_a_up, *rw_g_up, *rw_k_k, *rw_k_a, *rw_r_k,
      *rw_gn_g, *rw_gn_b, *odd_w_in, *odd_w_out, *da_lq1, *da_lk1, *da_lq2, *da_lk2, *da_subln_g, *router_w, *router_b, *exp_w_gate, *exp_w_up, *exp_w_down;
  float* out; unsigned char* ws; int ph_lo, ph_hi;
};
template <class Tp> __device__ __forceinline__ Tp* wsp(const Params& p, size_t off) { return (Tp*)(p.ws + off); }

__device__ __forceinline__ void ada_unit(const Params& p, int u, LAS float* lds) {
  LAS float* sc = lds; LAS float* red = lds + 5 * 1024;
  const int tid = mk::otid(), l = u / 96, n = (u % 96) * 64 + (tid & 63), kp = tid >> 6;
  for (int i = tid; i < 5 * 1024; i += NTHR) { const float v = i < 4096 ? p.c[i] : p.c_ctx[i - 4096]; sc[i] = siluf_(v); }
  __syncthreads();
  float a[5] = {0.f, 0.f, 0.f, 0.f, 0.f};
  const float* w = p.ada_w + ((size_t)l * D + kp * 128) * 6144 + n;
#pragma unroll 4
  for (int k = 0; k < 128; ++k) { const float wv = w[(size_t)k * 6144]; const int kk = kp * 128 + k;
#pragma unroll
    for (int r = 0; r < 5; ++r) a[r] = fmaf(sc[r * 1024 + kk], wv, a[r]); }
#pragma unroll
  for (int r = 0; r < 5; ++r) red[(kp * 5 + r) * 64 + (tid & 63)] = a[r];
  __syncthreads();
  if (tid < 320) { const int r = tid >> 6, nn = tid & 63; float s = 0.f;
#pragma unroll
    for (int q = 0; q < 8; ++q) s += red[(q * 5 + r) * 64 + nn];
    const int col = (u % 96) * 64 + nn;
    wsp<float>(p, WS_MOD)[((size_t)l * 5 + r) * 6144 + col] = s + p.ada_b[l * 6144 + col]; }
  __syncthreads();
}
__device__ __forceinline__ void phase_prologue(const Params& p, LAS unsigned char* lds) {
  const int bid = mk::obid(), nb = gridDim.x; LAS float* tile = (LAS float*)lds;
  int ub = 0;
  for (int i = 0; i < 2; ++i) ub += cvt_matrix(p.even_w_in + (size_t)i * D * EVEN_IN, EVEN_IN, D, EVEN_IN, wsp<bf16_t>(p, WS_WEIN) + (size_t)i * EVEN_IN * D, NMapId{0}, tile, ub, bid, nb);
  for (int i = 0; i < 2; ++i) ub += cvt_matrix(p.odd_w_in + (size_t)i * D * ODD_IN, ODD_IN, D, ODD_IN, wsp<bf16_t>(p, WS_WOIN) + (size_t)i * ODD_IN * D, NMapRope{}, tile, ub, bid, nb);
  for (int i = 0; i < 2; ++i) ub += cvt_matrix(p.even_w_out + (size_t)i * D * D, D, D, D, wsp<bf16_t>(p, WS_WEOUT) + (size_t)i * D * D, NMapId{0}, tile, ub, bid, nb);
  for (int i = 0; i < 2; ++i) ub += cvt_matrix(p.odd_w_out + (size_t)i * D * D, D, D, D, wsp<bf16_t>(p, WS_WOOUT) + (size_t)i * D * D, NMapId{0}, tile, ub, bid, nb);
  for (int u = (bid + nb - ub % nb) % nb; u < 384; u += nb) ada_unit(p, u, (LAS float*)lds);
  const int gt = bid * NTHR + mk::otid();
  if (gt < 128 * 16) { const int pos = gt >> 4, i = gt & 15; const float inv = exp2f(-(float)i * (13.287712379549449f / 16.0f)); float sn, cs; sincosf((float)pos * inv, &sn, &cs);
    wsp<float>(p, WS_ROPE)[gt * 2] = cs; wsp<float>(p, WS_ROPE)[gt * 2 + 1] = sn; }
}
__device__ __forceinline__ void cvt_experts(const Params& p, int l, LAS float* tile, int b0) {
  const int bid = mk::obid() - b0, nb = (int)gridDim.x - b0; int ub = 0;
  if (bid < 0) return;
  for (int e = 0; e < NE; ++e) {
    const size_t so = ((size_t)l * NE + e) * D * DE;
    ub += cvt_matrix(p.exp_w_gate + so, DE, D, DE, wsp<bf16_t>(p, WS_WGU) + (size_t)e * 1024 * D, NMapInterleave{0}, tile, ub, bid, nb);
    ub += cvt_matrix(p.exp_w_up + so, DE, D, DE, wsp<bf16_t>(p, WS_WGU) + (size_t)e * 1024 * D, NMapInterleave{1}, tile, ub, bid, nb);
    ub += cvt_matrix(p.exp_w_down + so, D, DE, D, wsp<bf16_t>(p, WS_WDN) + (size_t)e * D * DE, NMapId{0}, tile, ub, bid, nb);
  }
}

__device__ __forceinline__ const float* h_in_ptr(const Params& p, int l, int row) {
  if (l == 0) return row < NLAT ? p.x + (size_t)row * D : p.ctx + (size_t)(row - NLAT) * D;
  return row < NLAT ? p.out + (size_t)row * D : wsp<float>(p, WS_HCTX) + (size_t)(row - NLAT) * D;
}
__device__ __forceinline__ float* h_out_ptr(const Params& p, int row) { return row < NLAT ? p.out + (size_t)row * D : wsp<float>(p, WS_HCTX) + (size_t)(row - NLAT) * D; }
__device__ __forceinline__ void store_bf16x4(bf16_t* dst, f32x4 v) { u32x2 w; w.x = cvt_pk_bf16(v[0], v[1]); w.y = cvt_pk_bf16(v[2], v[3]); *(u32x2*)dst = w; }
__device__ __forceinline__ f32x4 load_bf16x4(const bf16_t* src) { const u32x2 w = *(const u32x2*)src; return (f32x4){bflo(w.x), bfhi(w.x), bflo(w.y), bfhi(w.y)}; }

__device__ __forceinline__ void phase_mod0(const Params& p) {
  const int lane = mk::otid() & 63, wid = mk::otid() >> 6;
  bf16_t* U = wsp<bf16_t>(p, WS_UO);
  for (int row = mk::obid() * 8 + wid; row < NTOK; row += gridDim.x * 8) {
    const float* h = h_in_ptr(p, 0, row); const float* modl = wsp<float>(p, WS_MOD) + (size_t)bidx_of_row(row) * 6144;
#pragma unroll
    for (int q = 0; q < 4; ++q) { const int col = q * 256 + lane * 4; const f32x4 hv = *(const f32x4*)(h + col), sh = *(const f32x4*)(modl + col), sc = *(const f32x4*)(modl + 1024 + col);
      store_bf16x4(U + (size_t)row * D + col, hv * (1.0f + sc) + sh); }
  }
}
__device__ __forceinline__ void ln_row(f32x4 (&v)[4], const float* __restrict__ g, const float* __restrict__ b, int lane) {
  float s = 0.f;
#pragma unroll
  for (int q = 0; q < 4; ++q) s += (v[q][0] + v[q][1]) + (v[q][2] + v[q][3]);
  const float mu = wave_sum_u(s) * (1.0f / D);
  float qq = 0.f;
#pragma unroll
  for (int q = 0; q < 4; ++q) { const f32x4 d = v[q] - mu; qq += (d[0] * d[0] + d[1] * d[1]) + (d[2] * d[2] + d[3] * d[3]); }
  const float rstd = rsqrtf(wave_sum_u(qq) * (1.0f / D) + LN_EPS);
#pragma unroll
  for (int q = 0; q < 4; ++q) { const int col = q * 256 + lane * 4; v[q] = (v[q] - mu) * rstd * *(const f32x4*)(g + col) + *(const f32x4*)(b + col); }
}
template <int NR>
__device__ __forceinline__ void ln1_rows(const Params& p, int l, const bf16_t* __restrict__ Ybuf, const int (&rows)[NR], int lane, const LAS float* rwl, LAS int* lcnt, bool dry) {
  bf16_t* U2 = wsp<bf16_t>(p, WS_UO); int* eid = wsp<int>(p, WS_EID); float* gatev = wsp<float>(p, WS_GATE);
  const float* lg = p.ln_g + (size_t)(l * 2) * D; const float* lb = p.ln_b + (size_t)(l * 2) * D;
  f32x4 v[NR][4];
#pragma unroll
  for (int r = 0; r < NR; ++r) { const int row = rows[r]; const float* h = h_in_ptr(p, l, row); const float* modl = wsp<float>(p, WS_MOD) + ((size_t)l * 5 + bidx_of_row(row)) * 6144;
#pragma unroll
    for (int q = 0; q < 4; ++q) { const int col = q * 256 + lane * 4; v[r][q] = ALPHA * *(const f32x4*)(h + col) + *(const f32x4*)(modl + 2 * 1024 + col) * load_bf16x4(Ybuf + (size_t)row * D + col); } }
#pragma unroll
  for (int r = 0; r < NR; ++r) {
    const int row = rows[r]; float* ho = h_out_ptr(p, row); const float* modl = wsp<float>(p, WS_MOD) + ((size_t)l * 5 + bidx_of_row(row)) * 6144;
    ln_row(v[r], lg, lb, lane);
    float acc[16];
#pragma unroll
    for (int e = 0; e < 16; ++e) acc[e] = 0.f;
#pragma unroll
    for (int q = 0; q < 4; ++q) { const int col = q * 256 + lane * 4;
      if (!dry) *(f32x4*)(ho + col) = v[r][q];
      const f32x4 u = v[r][q] * (1.0f + *(const f32x4*)(modl + 4 * 1024 + col)) + *(const f32x4*)(modl + 3 * 1024 + col);
      if (!dry) store_bf16x4(U2 + (size_t)row * D + col, u);
#pragma unroll
      for (int e = 0; e < 16; ++e) { const f32x4 w = *(const LAS f32x4*)(rwl + ((q * 16 + e) * 64 + lane) * 4); acc[e] += (u[0] * w[0] + u[1] * w[1]) + (u[2] * w[2] + u[3] * w[3]); }
      asm volatile("" ::: "memory");
    }
    float s[16], sel[16];
#pragma unroll
    for (int e = 0; e < 16; ++e) { s[e] = 1.0f / (1.0f + expf(-wave_sum_u(acc[e]))); sel[e] = s[e] + p.router_b[e]; }
    float best = -1e30f; int grp = 0;
#pragma unroll
    for (int gI = 0; gI < 4; ++gI) {
      const float a = sel[gI * 4], b2 = sel[gI * 4 + 1], c = sel[gI * 4 + 2], d = sel[gI * 4 + 3];
      const float lo1 = fminf(a, b2), hi1 = fmaxf(a, b2), lo2 = fminf(c, d), hi2 = fmaxf(c, d);
      const float gs = fmaxf(hi1, hi2) + fmaxf(fminf(hi1, hi2), fmaxf(lo1, lo2));
      if (gs > best) { best = gs; grp = gI; }
    }
    float v0 = 0, v1 = 0, v2 = 0, v3 = 0, s0 = 0, s1 = 0, s2 = 0, s3 = 0;
#pragma unroll
    for (int gI = 0; gI < 4; ++gI) if (gI == grp) { v0 = sel[gI * 4]; v1 = sel[gI * 4 + 1]; v2 = sel[gI * 4 + 2]; v3 = sel[gI * 4 + 3]; s0 = s[gI * 4]; s1 = s[gI * 4 + 1]; s2 = s[gI * 4 + 2]; s3 = s[gI * 4 + 3]; }
    int i1 = 0; float b1 = v0; if (v1 > b1) { b1 = v1; i1 = 1; } if (v2 > b1) { b1 = v2; i1 = 2; } if (v3 > b1) { b1 = v3; i1 = 3; }
    int i2 = -1; float bb = -1e30f;
    if (i1 != 0 && v0 > bb) { bb = v0; i2 = 0; } if (i1 != 1 && v1 > bb) { bb = v1; i2 = 1; } if (i1 != 2 && v2 > bb) { bb = v2; i2 = 2; } if (i1 != 3 && v3 > bb) { bb = v3; i2 = 3; }
    const float g1 = i1 == 0 ? s0 : i1 == 1 ? s1 : i1 == 2 ? s2 : s3; const float g2 = i2 == 0 ? s0 : i2 == 1 ? s1 : i2 == 2 ? s2 : s3;
    if (lane == 0 && !dry) { const int e1 = grp * 4 + i1, e2 = grp * 4 + i2;
      eid[row * 2] = e1; eid[row * 2 + 1] = e2; gatev[row * 2] = g1 / (g1 + g2); gatev[row * 2 + 1] = g2 / (g1 + g2);
      __hip_atomic_fetch_add(lcnt + e1, 1, __ATOMIC_RELAXED, __HIP_MEMORY_SCOPE_WORKGROUP); __hip_atomic_fetch_add(lcnt + e2, 1, __ATOMIC_RELAXED, __HIP_MEMORY_SCOPE_WORKGROUP); }
  }
}
__device__ __forceinline__ void phase_ln1(const Params& p, int l, const bf16_t* __restrict__ Ybuf, LAS unsigned char* lds, bool dry) {
  const int tid = mk::otid(), lane = tid & 63, wid = tid >> 6, bid = mk::obid();
  const bool last = l == DEPTH - 1; const int ntok = last ? NLAT : NTOK;
  LAS float* rwl = (LAS float*)lds; LAS int* lcnt = (LAS int*)(lds + 65536);
  for (int idx = tid; idx < 16384; idx += NTHR) { const int d = idx >> 4, e = idx & 15; rwl[(((d >> 8) * 16 + e) * 64 + ((d >> 2) & 63)) * 4 + (d & 3)] = p.router_w[idx]; }
  if (tid < 16) lcnt[tid] = 0;
  __syncthreads();
  const int stride = gridDim.x * 8;
  int row = bid * 8 + wid;
  for (; row + stride < ntok; row += 2 * stride) { const int rows[2] = {row, row + stride}; ln1_rows<2>(p, l, Ybuf, rows, lane, rwl, lcnt, dry); }
  if (row < ntok) { const int rows[1] = {row}; ln1_rows<1>(p, l, Ybuf, rows, lane, rwl, lcnt, dry); }
  __syncthreads();
  if (tid < 16 && !dry) wsp<int>(p, WS_BCNT)[((size_t)l * 256 + bid) * 64 + tid] = lcnt[tid];
  __syncthreads();
}
__device__ __forceinline__ void phase_scatter(const Params& p, int l, LAS unsigned char* lds) {
  const int tid = mk::otid(), lane = tid & 63, wid = tid >> 6, bid = mk::obid();
  const bool last = l == DEPTH - 1; const int ntok = last ? NLAT : NTOK;
  LAS int* tot = (LAS int*)lds; LAS int* pre = tot + 16; LAS int* base = tot + 32; LAS int* lcur = tot + 48;
  const int* bc = wsp<int>(p, WS_BCNT) + (size_t)l * 256 * 64;
  if (tid < 16) { int t = 0, pr = 0; for (int b2 = 0; b2 < (int)gridDim.x; ++b2) { const int v = bc[b2 * 64 + tid]; pr += b2 < bid ? v : 0; t += v; } tot[tid] = t; pre[tid] = pr; lcur[tid] = 0; }
  __syncthreads();
  if (tid == 0) { int o = 0; int* mo = wsp<int>(p, WS_MOFF) + l * 64; for (int e = 0; e < 16; ++e) { base[e] = o + pre[e]; if (bid == 0) mo[e] = o; o += (tot[e] + 255) / 256 * 256; } if (bid == 0) mo[16] = o; }
  __syncthreads();
  const bf16_t* U2 = wsp<bf16_t>(p, WS_UO); bf16_t* Xs = wsp<bf16_t>(p, WS_SCR + SM_XS); const int* eid = wsp<int>(p, WS_EID); int* pos = wsp<int>(p, WS_POS);
  for (int row = bid * 8 + wid; row < ntok; row += gridDim.x * 8) {
    int p1 = 0, p2 = 0;
    if (lane == 0) { const int e1 = eid[row * 2], e2 = eid[row * 2 + 1]; p1 = base[e1] + __hip_atomic_fetch_add(lcur + e1, 1, __ATOMIC_RELAXED, __HIP_MEMORY_SCOPE_WORKGROUP); p2 = base[e2] + __hip_atomic_fetch_add(lcur + e2, 1, __ATOMIC_RELAXED, __HIP_MEMORY_SCOPE_WORKGROUP); pos[row * 2] = p1; pos[row * 2 + 1] = p2; }
    p1 = __builtin_amdgcn_readfirstlane(p1); p2 = __builtin_amdgcn_readfirstlane(p2);
    const u32x4 a = *(const u32x4*)(U2 + (size_t)row * D + lane * 8), b2 = *(const u32x4*)(U2 + (size_t)row * D + 512 + lane * 8);
    *(u32x4*)(Xs + (size_t)p1 * D + lane * 8) = a; *(u32x4*)(Xs + (size_t)p1 * D + 512 + lane * 8) = b2;
    *(u32x4*)(Xs + (size_t)p2 * D + lane * 8) = a; *(u32x4*)(Xs + (size_t)p2 * D + 512 + lane * 8) = b2;
  }
}
template <int NR>
__device__ __forceinline__ void ln2_rows(const Params& p, int l, const int (&rows)[NR], int lane, bool dry) {
  const bool last = l == DEPTH - 1;
  const bf16_t* Ys = wsp<bf16_t>(p, WS_SCR + SM_YS); const int* pos = wsp<int>(p, WS_POS); const float* gatev = wsp<float>(p, WS_GATE); bf16_t* U = wsp<bf16_t>(p, WS_UO);
  const float* lg = p.ln_g + (size_t)(l * 2 + 1) * D; const float* lb = p.ln_b + (size_t)(l * 2 + 1) * D;
  f32x4 v[NR][4];
#pragma unroll
  for (int r = 0; r < NR; ++r) { const int row = rows[r]; const float* ho = h_out_ptr(p, row); const float* modl = wsp<float>(p, WS_MOD) + ((size_t)l * 5 + bidx_of_row(row)) * 6144;
    const int p1 = pos[row * 2], p2 = pos[row * 2 + 1]; const float g1 = gatev[row * 2], g2 = gatev[row * 2 + 1];
#pragma unroll
    for (int q = 0; q < 4; ++q) { const int col = q * 256 + lane * 4;
      const f32x4 f = g1 * load_bf16x4(Ys + (size_t)p1 * D + col) + g2 * load_bf16x4(Ys + (size_t)p2 * D + col);
      v[r][q] = ALPHA * *(const f32x4*)(ho + col) + *(const f32x4*)(modl + 5 * 1024 + col) * f; } }
#pragma unroll
  for (int r = 0; r < NR; ++r) { const int row = rows[r]; float* ho = h_out_ptr(p, row);
    ln_row(v[r], lg, lb, lane);
    const float* modn = wsp<float>(p, WS_MOD) + ((size_t)(last ? l : l + 1) * 5 + bidx_of_row(row)) * 6144;
#pragma unroll
    for (int q = 0; q < 4; ++q) { const int col = q * 256 + lane * 4; if (!dry) *(f32x4*)(ho + col) = v[r][q];
      if (!last && !dry) store_bf16x4(U + (size_t)row * D + col, v[r][q] * (1.0f + *(const f32x4*)(modn + 1024 + col)) + *(const f32x4*)(modn + col)); } }
}
__device__ __forceinline__ void phase_ln2(const Params& p, int l, bool dry) {
  const int tid = mk::otid(), lane = tid & 63, wid = tid >> 6;
  const bool last = l == DEPTH - 1; const int ntok = last ? NLAT : NTOK;
  const int stride = gridDim.x * 8;
  int row = mk::obid() * 8 + wid;
  for (; row + stride < ntok; row += 2 * stride) { const int rows[2] = {row, row + stride}; ln2_rows<2>(p, l, rows, lane, dry); }
  if (row < ntok) { const int rows[1] = {row}; ln2_rows<1>(p, l, rows, lane, dry); }
}

struct SchedEvenIn { const bf16_t* U; const bf16_t* W; bf16_t* Pqk; bf16_t* Prw; bf16_t* Vt; int G, c;
  __device__ __forceinline__ bool next(int i, pg8::Unit& u) const { const int Lx = i * G + c; u.kind = 0;
    if (Lx < 1452) { const int grp = Lx / 44, rem = Lx % 44, pm = grp * 4 + (rem & 3), pi = rem >> 2; u.pm = pm; u.pn = pi;
      u.A = (const char*)(U + (size_t)pm * 256 * D); const int brow = pi < 4 ? pi * 256 : 1536 + (pi - 4) * 256; u.Bt = (const char*)(W + (size_t)brow * D);
      if (pi < 4) { u.out = Pqk; u.ldo = 1024; u.x1 = pi * 256; } else { u.out = Prw; u.ldo = RW_IN; u.x1 = (pi - 4) * 256; } u.x0 = pm * 256; return true; }
    if (Lx < 1452 + 264) { const int v = Lx - 1452, pmv = v & 1, pnv = v >> 1; u.pm = pmv; u.pn = pnv; u.A = (const char*)(W + (size_t)(1024 + pmv * 256) * D); u.Bt = (const char*)(U + (size_t)pnv * 256 * D);
      u.out = Vt; u.ldo = NTOK; u.x0 = pmv * 256; u.x1 = pnv * 256; return true; }
    return false; } };
struct SchedOddIn { const bf16_t* U; const bf16_t* W; bf16_t* Pqk; bf16_t* Vt; int G, c;
  __device__ __forceinline__ bool next(int i, pg8::Unit& u) const { const int Lx = i * G + c;
    if (Lx < 1056) { const int grp = Lx / 32, rem = Lx % 32, pm = grp * 4 + (rem & 3), pi = rem >> 2; u.pm = pm; u.pn = pi; u.kind = pm < 128 ? 1 : 0;
      u.A = (const char*)(U + (size_t)pm * 256 * D); u.Bt = (const char*)(W + (size_t)pi * 256 * D); u.out = Pqk; u.ldo = 2048; u.x0 = pm * 256; u.x1 = pi * 256; return true; }
    if (Lx < 1056 + 528) { const int v = Lx - 1056, pmv = v & 3, pnv = v >> 2; u.pm = pmv; u.pn = pnv; u.kind = 0; u.A = (const char*)(W + (size_t)(2048 + pmv * 256) * D); u.Bt = (const char*)(U + (size_t)pnv * 256 * D);
      u.out = Vt; u.ldo = NTOK; u.x0 = pmv * 256; u.x1 = pnv * 256; return true; }
    return false; } };
struct SchedOut { const bf16_t* O; const bf16_t* W; bf16_t* Y; int G, c;
  __device__ __forceinline__ bool next(int i, pg8::Unit& u) const { const int Lx = i * G + c; if (Lx >= 528) return false; const int pm = (Lx / 16) * 4 + (Lx & 3), pn = (Lx & 15) >> 2; u.pm = pm; u.pn = pn; u.kind = 0;
    u.A = (const char*)(O + (size_t)pm * 256 * D); u.Bt = (const char*)(W + (size_t)pn * 256 * D); u.out = Y; u.ldo = 1024; u.x0 = pm * 256; u.x1 = pn * 256; return true; } };
struct SchedMoe { const bf16_t* A; const bf16_t* W; bf16_t* out; const LAS int* moff; int Kd, ldo, ncol, G, c;
  __device__ __forceinline__ bool next(int i, pg8::Unit& u) const { const int Lx = i * G + c; const int ntile = moff[16] >> 8; if (Lx >= ntile * 4) return false;
    const int pm = Lx >> 2, pn = Lx & 3; int e = 0;
#pragma unroll
    for (int j = 1; j < 16; ++j) e += (pm * 256 >= moff[j]) ? 1 : 0;
    u.pm = pm; u.pn = pn; u.kind = 0; u.A = (const char*)(A + (size_t)pm * 256 * Kd); u.Bt = (const char*)(W + ((size_t)e * 1024 + pn * 256) * Kd); u.out = out; u.ldo = ldo; u.x0 = pm * 256; u.x1 = pn * ncol; return true; } };

struct EpiOddIn {
  static constexpr bool PERM = true; const float* rope;
  __device__ __forceinline__ void operator()(const f32x4 (&acc)[2][2][4][2], const pg8::Unit& u, int wr, int wc, int fr, int fq) const {
    if (u.kind == 0) { pg8::EpiStoreBf16{}(acc, u, wr, wc, fr, fq); return; }
    const int row0 = u.x0 + wr * 64 + fr, col0 = u.x1 + wc * 32 + 8 * fq; const int half = wc & 1;
#pragma unroll
    for (int ai = 0; ai < 2; ++ai)
#pragma unroll
      for (int m = 0; m < 4; ++m) { const int row = row0 + ai * 128 + m * 16; const int t = row & (T - 1); const int pos = half ? (t & 63) : (t >> 6);
        const f32x4 cs0 = *(const f32x4*)(rope + (pos * 16 + 4 * fq) * 2), cs1 = *(const f32x4*)(rope + (pos * 16 + 4 * fq + 2) * 2);
        bf16_t* rowp = u.out + (size_t)row * u.ldo + col0;
#pragma unroll
        for (int bj = 0; bj < 2; ++bj) { const f32x4 v0 = acc[ai][bj][m][0], v1 = acc[ai][bj][m][1];
          u32x4 w; w.x = cvt_pk_bf16(v0[0] * cs0[0] - v0[1] * cs0[1], v0[0] * cs0[1] + v0[1] * cs0[0]); w.y = cvt_pk_bf16(v0[2] * cs0[2] - v0[3] * cs0[3], v0[2] * cs0[3] + v0[3] * cs0[2]);
          w.z = cvt_pk_bf16(v1[0] * cs1[0] - v1[1] * cs1[1], v1[0] * cs1[1] + v1[1] * cs1[0]); w.w = cvt_pk_bf16(v1[2] * cs1[2] - v1[3] * cs1[3], v1[2] * cs1[3] + v1[3] * cs1[2]);
          *(u32x4*)(rowp + bj * 128) = w; } }
  }
};
struct EpiGateUp {
  static constexpr bool PERM = true;
  __device__ __forceinline__ void operator()(const f32x4 (&acc)[2][2][4][2], const pg8::Unit& u, int wr, int wc, int fr, int fq) const {
    const int row0 = u.x0 + wr * 64 + fr, col0 = u.x1 + wc * 16 + 4 * fq;
#pragma unroll
    for (int ai = 0; ai < 2; ++ai)
#pragma unroll
      for (int m = 0; m < 4; ++m) { bf16_t* rowp = u.out + (size_t)(row0 + ai * 128 + m * 16) * u.ldo + col0;
#pragma unroll
        for (int bj = 0; bj < 2; ++bj) { const f32x4 v0 = acc[ai][bj][m][0], v1 = acc[ai][bj][m][1];
          u32x2 w; w.x = cvt_pk_bf16(siluf_(v0[0]) * v0[1], siluf_(v0[2]) * v0[3]); w.y = cvt_pk_bf16(siluf_(v1[0]) * v1[1], siluf_(v1[2]) * v1[3]);
          *(u32x2*)(rowp + bj * 64) = w; } }
  }
};
}

namespace mk {
constexpr int N_PHASES = 2 + 2 * (12 + 9);
__global__ void __launch_bounds__(NTHR, 2) mega(Params p) {
  extern __shared__ __attribute__((aligned(16))) unsigned char shm[];
  LAS unsigned char* lds = (LAS unsigned char*)shm;
  const int nb = gridDim.x;
  if (threadIdx.x == 0) *(LAS u32x4*)(lds + LDS_BARW) = (u32x4){0u, 0u, 0u, 0u};
  __syncthreads();
  XcdBarrier bar = xcd_barrier_post(wsp<unsigned>(p, WS_BAR), (volatile LAS unsigned*)(lds + LDS_BARW));
  int ph = 0;
#ifndef MK_MASK
#define MK_MASK 0xFFFFFFFFu
#endif
#ifndef MK_REP
#define MK_REP 0u
#endif
#define PHASE_BEGIN_K(k) if ((((MK_MASK) >> (k)) & 1u) && ph >= p.ph_lo && ph < p.ph_hi) { const int bid = mk::obid(); const int nrep_ = ((((MK_REP) >> (k)) & 1u) ? 2 : 1); for (int rep_ = 0; rep_ < nrep_; ++rep_) { const bool dry = rep_ + 1 < nrep_; (void)dry;
#define PHASE_END   } if (ph + 1 < p.ph_hi) xcd_barrier(bar); } ++ph;
  bf16_t* UO = wsp<bf16_t>(p, WS_UO);
  unsigned char* scr = p.ws + WS_SCR;
  PHASE_BEGIN_K(0) phase_prologue(p, lds); PHASE_END
  PHASE_BEGIN_K(1) phase_mod0(p); PHASE_END
  for (int lp = 0; lp < 2; ++lp) {
    {
      const int l = 2 * lp;
      bf16_t* Pqk = (bf16_t*)(scr + SE_PQK); bf16_t* Vt = (bf16_t*)(scr + SE_VT); bf16_t* Prw = (bf16_t*)(scr + SE_PRW); bf16_t* Ybuf = (bf16_t*)(scr + SE_YBUF);
      rw::Bufs bf; bf.SH = (u32x2*)(scr + SE_SH); bf.DR = (unsigned*)(scr + SE_DR); bf.G = UO + 512; bf.gstride = 1024; bf.CS = (float*)(scr + SE_CS) + (size_t)lp * NTOK * 16; bf.PQ = (float*)(scr + SE_PQ); bf.SST = (float*)(scr + SE_SST); bf.Y = (bf16_t*)(scr + SE_Y); bf.Z = (bf16_t*)(scr + SE_Z);
      PHASE_BEGIN_K(2) { SchedEvenIn S{UO, wsp<bf16_t>(p, WS_WEIN) + (size_t)lp * EVEN_IN * D, Pqk, Prw, Vt, nb, bid}; pg8::gemm_phase(lds, D, S, pg8::EpiStoreBf16{}); } PHASE_END
      PHASE_BEGIN_K(3) { for (int u = bid; u < 1024 + 32; u += nb) { int b, h, rq; if (u < 1024) { b = u >> 8; h = (u >> 5) & 7; rq = u & 31; } else { const int v = u - 1024; b = v >> 3; h = v & 7; rq = -1; }
          natt::na_attn_unit(Pqk, Vt, p.na_rpb + ((size_t)lp * 8 + h) * 465, UO, b, h, rq, lds); }
        const int pb = (bid + nb / 2) % nb;
        for (int t = pb; t < NTOK / 16; t += nb) rw::prep_tile(Prw, p.shift_w + (size_t)lp * 3 * RW_IN, p.rw_w0 + lp * 1024, p.rw_w_up + (size_t)lp * 2 * 64 * 512, p.rw_a0 + lp * 1024,
            p.rw_a_up + (size_t)lp * 2 * 64 * 512, p.rw_g_up + (size_t)lp * 128 * 512, p.rw_k_k + lp * 512, p.rw_k_a + lp * 512, p.rw_r_k + lp * 512, bf, t, (LAS float*)lds); } PHASE_END
      PHASE_BEGIN_K(4) for (int u = bid * 8 + (mk::otid() >> 6); u < rw::NCHAIN * rw::NCH; u += nb * 8) rw::scan_unit(bf, p.rw_k_a + lp * 512, u / rw::NCH, u % rw::NCH, (LAS float*)lds + (mk::otid() >> 6) * 320); PHASE_END
      PHASE_BEGIN_K(5) for (int c = bid; c < rw::NCHAIN; c += nb) rw::propagate_chain(bf, c, (LAS float*)lds); PHASE_END
      PHASE_BEGIN_K(6) for (int u = bid * 8 + (mk::otid() >> 6); u < rw::NCHAIN * (rw::NCH - 1); u += nb * 8) rw::corr_unit(bf, u / (rw::NCH - 1), 1 + u % (rw::NCH - 1)); PHASE_END
      PHASE_BEGIN_K(7) for (int r = bid * 4; r < NTOK; r += nb * 4) rw::finish_rows4(bf, p.rw_gn_g + lp * 512, p.rw_gn_b + lp * 512, UO, r); PHASE_END
      PHASE_BEGIN_K(8) { SchedOut S{UO, wsp<bf16_t>(p, WS_WEOUT) + (size_t)lp * D * D, Ybuf, nb, bid}; pg8::gemm_phase(lds, D, S, pg8::EpiStoreBf16{}); __syncthreads(); cvt_experts(p, l, (LAS float*)lds, 528 - 2 * nb > 0 ? 528 - 2 * nb : 0); } PHASE_END
      PHASE_BEGIN_K(9) phase_ln1(p, l, Ybuf, lds, dry); PHASE_END
      PHASE_BEGIN_K(10) phase_scatter(p, l, lds); PHASE_END
      PHASE_BEGIN_K(11) { LAS int* mo = (LAS int*)(lds + LDS_MISC); { const int tq = mk::otid(); if (tq < 17) mo[tq] = wsp<int>(p, WS_MOFF)[l * 64 + tq]; } __syncthreads();
        SchedMoe S{(bf16_t*)(scr + SM_XS), wsp<bf16_t>(p, WS_WGU), (bf16_t*)(scr + SM_HE), mo, D, DE, 128, nb, bid}; pg8::gemm_phase(lds, D, S, EpiGateUp{}); } PHASE_END
      PHASE_BEGIN_K(12) { LAS int* mo = (LAS int*)(lds + LDS_MISC); { const int tq = mk::otid(); if (tq < 17) mo[tq] = wsp<int>(p, WS_MOFF)[l * 64 + tq]; } __syncthreads();
        SchedMoe S{(bf16_t*)(scr + SM_HE), wsp<bf16_t>(p, WS_WDN), (bf16_t*)(scr + SM_YS), mo, DE, D, 256, nb, bid}; pg8::gemm_phase(lds, DE, S, pg8::EpiStoreBf16{}); } PHASE_END
      PHASE_BEGIN_K(13) phase_ln2(p, l, dry); PHASE_END
    }
    {
      const int l = 2 * lp + 1; const bool last = l == DEPTH - 1;
      bf16_t* Pqk = (bf16_t*)(scr + SO_PQK); bf16_t* Vt = (bf16_t*)(scr + SO_VT); bf16_t* O12 = (bf16_t*)(scr + SO_O12); bf16_t* Ybuf = (bf16_t*)(scr + SO_YBUF);
      PHASE_BEGIN_K(14) { SchedOddIn S{UO, wsp<bf16_t>(p, WS_WOIN) + (size_t)lp * ODD_IN * D, Pqk, Vt, nb, bid}; pg8::gemm_phase(lds, D, S, EpiOddIn{wsp<float>(p, WS_ROPE)}); } PHASE_END
      PHASE_BEGIN_K(15) for (int u = bid; u < 2048 + (last ? 0 : 64); u += nb) { int b, hh, q0, nlat;
        if (u < 2048) { b = u >> 9; hh = (u >> 5) & 15; q0 = b * T + (u & 31) * 256; nlat = T; } else { const int v = u - 2048; b = v >> 4; hh = v & 15; q0 = NLAT + b * L; nlat = 0; }
        att::diff_attn_unit(Pqk, Vt, O12, hh, q0, b * T, nlat, NLAT + b * L, lds); } PHASE_END
      PHASE_BEGIN_K(16) { float d1 = 0.f, d2 = 0.f; for (int i = 0; i < 64; ++i) { d1 += p.da_lq1[lp * 64 + i] * p.da_lk1[lp * 64 + i]; d2 += p.da_lq2[lp * 64 + i] * p.da_lk2[lp * 64 + i]; }
        const float li = 0.8f - 0.6f * expf(-0.3f * (float)l), lam = expf(d1) - expf(d2) + li;
        const int tq = mk::otid(); for (int r4 = bid; r4 < (last ? NLAT : NTOK) / 4; r4 += nb) att::diff_combine_rows4(O12, p.da_subln_g + lp * 128, lam, 1.0f - li, UO, r4 * 4, tq >> 6, tq & 63); } PHASE_END
      PHASE_BEGIN_K(17) { SchedOut S{UO, wsp<bf16_t>(p, WS_WOOUT) + (size_t)lp * D * D, Ybuf, nb, bid}; pg8::gemm_phase(lds, D, S, pg8::EpiStoreBf16{}); __syncthreads(); cvt_experts(p, l, (LAS float*)lds, 528 - 2 * nb > 0 ? 528 - 2 * nb : 0); } PHASE_END
      PHASE_BEGIN_K(18) phase_ln1(p, l, Ybuf, lds, dry); PHASE_END
      PHASE_BEGIN_K(19) phase_scatter(p, l, lds); PHASE_END
      PHASE_BEGIN_K(20) { LAS int* mo = (LAS int*)(lds + LDS_MISC); { const int tq = mk::otid(); if (tq < 17) mo[tq] = wsp<int>(p, WS_MOFF)[l * 64 + tq]; } __syncthreads();
        SchedMoe S{(bf16_t*)(scr + SM_XS), wsp<bf16_t>(p, WS_WGU), (bf16_t*)(scr + SM_HE), mo, D, DE, 128, nb, bid}; pg8::gemm_phase(lds, D, S, EpiGateUp{}); } PHASE_END
      PHASE_BEGIN_K(21) { LAS int* mo = (LAS int*)(lds + LDS_MISC); { const int tq = mk::otid(); if (tq < 17) mo[tq] = wsp<int>(p, WS_MOFF)[l * 64 + tq]; } __syncthreads();
        SchedMoe S{(bf16_t*)(scr + SM_HE), wsp<bf16_t>(p, WS_WDN), (bf16_t*)(scr + SM_YS), mo, DE, D, 256, nb, bid}; pg8::gemm_phase(lds, DE, S, pg8::EpiStoreBf16{}); } PHASE_END
      PHASE_BEGIN_K(22) phase_ln2(p, l, dry); PHASE_END
    }
  }
#undef PHASE_BEGIN_K
#undef PHASE_END
}
}

#ifndef MK_SINGLE_LAUNCH
#define MK_SINGLE_LAUNCH 1
#endif
extern "C" void kernel_launch(void* const* d_in, const int* in_sizes, int n_in, void* d_out, int out_size, void* d_ws, size_t ws_size, hipStream_t stream) {
  using namespace mk;
  static int grid = 0;
  if (grid == 0) {
    if (n_in != 34 || out_size != NLAT * D || ws_size < WS_END) { fprintf(stderr, "kernel_launch: unexpected shapes (n_in %d out %d ws %zu need %zu)\n", n_in, out_size, ws_size, (size_t)WS_END); grid = -1; return; }
    if (hipFuncSetAttribute((const void*)mega, hipFuncAttributeMaxDynamicSharedMemorySize, LDS_BYTES) != hipSuccess) { grid = -1; return; }
    int dev = 0, cus = 0, per_cu = 0;
    if (hipGetDevice(&dev) != hipSuccess || hipDeviceGetAttribute(&cus, hipDeviceAttributeMultiprocessorCount, dev) != hipSuccess) { grid = -1; return; }
    if (hipOccupancyMaxActiveBlocksPerMultiprocessor(&per_cu, (const void*)mega, NTHR, LDS_BYTES) != hipSuccess || per_cu < 1) { fprintf(stderr, "kernel_launch: occupancy query says %d\n", per_cu); }
    (void)hipGetLastError();
    grid = cus;
  }
  if (grid < 0) return;
  (void)hipMemsetAsync((char*)d_ws + WS_BAR, 0, (size_t)XCD_BAR_WORDS * 4, stream);
  Params p{};
  const float** pp = (const float**)&p;
  for (int i = 0; i < 34; ++i) pp[i] = (const float*)d_in[i];
  p.out = (float*)d_out; p.ws = (unsigned char*)d_ws;
#if MK_SINGLE_LAUNCH
  p.ph_lo = 0; p.ph_hi = N_PHASES;
  hipLaunchKernelGGL(mega, dim3(grid), dim3(NTHR), LDS_BYTES, stream, p);
#else
  for (int ph = 0; ph < N_PHASES; ++ph) { p.ph_lo = ph; p.ph_hi = ph + 1; hipLaunchKernelGGL(mega, dim3(grid), dim3(NTHR), LDS_BYTES, stream, p); }
#endif
}
```

```cpp
#include <hip/hip_runtime.h>
#include <stdint.h>
#include <stdio.h>

typedef unsigned short bf16_t;
typedef short bf16x8 __attribute__((ext_vector_type(8)));
typedef float f32x4 __attribute__((ext_vector_type(4)));
typedef float f32x2 __attribute__((ext_vector_type(2)));
typedef float f32x16 __attribute__((ext_vector_type(16)));
typedef unsigned u32x4 __attribute__((ext_vector_type(4)));
typedef unsigned u32x2 __attribute__((ext_vector_type(2)));
#define LAS __attribute__((address_space(3)))

namespace mk {
constexpr int B = 4, T = 8192, L = 256, D = 1024, NLAT = B * T, NCTX = B * L, NTOK = NLAT + NCTX;
constexpr int DEPTH = 4, EVEN_IN = 3328, ODD_IN = 3072, RW_OFF = 1536, RW_IN = 1792, NE = 16, DE = 512;
constexpr float ALPHA = 1.681792830507429f, LN_EPS = 1e-5f;
constexpr int NTHR = 512, LDS_BYTES = 147456;
constexpr int MOE_TILES = 280, MOE_ROWS = MOE_TILES * 256;

__device__ __forceinline__ unsigned cvt_pk_bf16(float lo, float hi) { unsigned r; asm volatile("v_cvt_pk_bf16_f32 %0, %1, %2" : "=v"(r) : "v"(lo), "v"(hi)); return r; }
__device__ __forceinline__ float bf2f(bf16_t b) { return __uint_as_float(((unsigned)b) << 16); }
__device__ __forceinline__ float bflo(unsigned w) { return __uint_as_float(w << 16); }
__device__ __forceinline__ float bfhi(unsigned w) { return __uint_as_float(w & 0xffff0000u); }
__device__ __forceinline__ bf16_t f2bf(float f) { return (bf16_t)(cvt_pk_bf16(f, 0.f) & 0xffffu); }
__device__ __forceinline__ float sigmoidf_(float x) { return 1.0f / (1.0f + __expf(-x)); }
__device__ __forceinline__ float siluf_(float x) { return x / (1.0f + __expf(-x)); }
__device__ __forceinline__ float wave_sum(float v) {
#pragma unroll
  for (int o = 32; o > 0; o >>= 1) v += __shfl_xor(v, o);
  return v;
}
template <int CTRL, int RM, int BM> __device__ __forceinline__ float dpp_mov(float old, float v) { return __int_as_float(__builtin_amdgcn_update_dpp(__float_as_int(old), __float_as_int(v), CTRL, RM, BM, false)); }
__device__ __forceinline__ float wave_sum_u(float v) {
  v += dpp_mov<0xB1, 0xf, 0xf>(v, v);
  v += dpp_mov<0x4E, 0xf, 0xf>(v, v);
  v += dpp_mov<0x141, 0xf, 0xf>(v, v);
  v += dpp_mov<0x140, 0xf, 0xf>(v, v);
  v += dpp_mov<0x142, 0xa, 0xf>(0.f, v);
  v += dpp_mov<0x143, 0xc, 0xf>(0.f, v);
  return __int_as_float(__builtin_amdgcn_readlane(__float_as_int(v), 63));
}
__device__ __forceinline__ f32x16 zero16() { float z = 0.f; asm volatile("" : "+v"(z)); f32x16 r;
#pragma unroll
  for (int i = 0; i < 16; ++i) r[i] = z;
  return r; }
__device__ __forceinline__ int otid() { int t = threadIdx.x; asm volatile("" : "+v"(t)); return t; }
__device__ __forceinline__ int obid() { int b = blockIdx.x; asm volatile("" : "+s"(b)); return b; }
__device__ __forceinline__ int bidx_of_row(int row) { return row < NLAT ? row / T : 4; }
}

#include <vector>

#define XB_TMO      128
#define XB_XCNT(j)  (256  + 64 * (j))
#define XB_XSUB(j)  (1280 + 64 * (j))
#define XB_XGEN(j)  (2304 + 64 * (j))
#define XB_TOP      3328
#define XB_TOPGEN   3392
#define XCD_BAR_WORDS 3456
#define XB_SPIN_CAP (1u << 18)
#define LAS __attribute__((address_space(3)))

__device__ __forceinline__ unsigned xb_ld(unsigned* p)              { return __hip_atomic_load(p, __ATOMIC_RELAXED, __HIP_MEMORY_SCOPE_AGENT); }
__device__ __forceinline__ unsigned xb_add(unsigned* p, unsigned v) { return __hip_atomic_fetch_add(p, v, __ATOMIC_RELAXED, __HIP_MEMORY_SCOPE_AGENT); }
__device__ __forceinline__ unsigned xb_xcc_id() { return (unsigned)__builtin_amdgcn_s_getreg((3 << 11) | 20) & 0xFu; }
#define XB_SPIN(cond, bar) do { unsigned _sp = 0; while (cond) { __builtin_amdgcn_s_sleep(1); \
    if ((++_sp & 255u) == 0u) { if (xb_ld(&(bar)[XB_TMO])) break; if (_sp > XB_SPIN_CAP) { atomicAdd(&(bar)[XB_TMO], 1u); break; } } } } while (0)

struct XcdBarrier {
    unsigned* bar; unsigned x;
    volatile LAS unsigned* st;
};

__device__ __forceinline__ XcdBarrier xcd_barrier_post(unsigned* bar, volatile LAS unsigned* st) {
    XcdBarrier b; b.bar = bar; b.x = xb_xcc_id(); b.st = st;
    if (threadIdx.x == 0) (void)xb_add(&bar[XB_XCNT(b.x)], 1u);
    return b;
}
__device__ __forceinline__ void xcd_barrier_complete(unsigned* bar, unsigned x, unsigned& nloc, unsigned& nx) {
    const unsigned G = gridDim.x * gridDim.y * gridDim.z;
    unsigned sum, cnt, mine, sp = 0u;
    for (;;) {
        sum = 0u; cnt = 0u; mine = 0u;
#pragma unroll
        for (unsigned j = 0; j < 16; ++j) { const unsigned c = xb_ld(&bar[XB_XCNT(j)]); sum += c; cnt += (c > 0u) ? 1u : 0u; mine = (j == x) ? c : mine; }
        if (sum == G) break;
        __builtin_amdgcn_s_sleep(1);
        if ((++sp & 255u) == 0u) { if (xb_ld(&bar[XB_TMO])) break; if (sp > XB_SPIN_CAP) { atomicAdd(&bar[XB_TMO], 1u); break; } }
    }
    nloc = mine > 0u ? mine : 1u; nx = cnt > 0u ? cnt : 1u;
}

__device__ __forceinline__ void xcd_barrier(const XcdBarrier& b) {
    asm volatile("s_waitcnt vmcnt(0)" ::: "memory");
    __syncthreads();
    if (threadIdx.x == 0) {
        unsigned* bar = b.bar;
        __builtin_amdgcn_s_waitcnt(0);
        unsigned nloc = b.st[0], nx = b.st[1];
        if (nloc == 0u) { xcd_barrier_complete(bar, b.x, nloc, nx); b.st[0] = nloc; b.st[1] = nx; }
        const unsigned old = xb_add(&bar[XB_XSUB(b.x)], 1u);
        const unsigned gen = old / nloc;
        if (old + 1u == (gen + 1u) * nloc) {
            __builtin_amdgcn_fence(__ATOMIC_RELEASE, "agent");
            asm volatile("s_waitcnt vmcnt(0)" ::: "memory");
            const unsigned og = xb_add(&bar[XB_TOP], 1u);
            const unsigned tg = og / nx;
            if (og + 1u == (tg + 1u) * nx) xb_add(&bar[XB_TOPGEN], 1u);
            else XB_SPIN(xb_ld(&bar[XB_TOPGEN]) == tg, bar);
            __builtin_amdgcn_fence(__ATOMIC_ACQUIRE, "agent");
            xb_add(&bar[XB_XGEN(b.x)], 1u);
            asm volatile("s_waitcnt vmcnt(0)" ::: "memory");
        } else {
            XB_SPIN(xb_ld(&bar[XB_XGEN(b.x)]) == gen, bar);
            __builtin_amdgcn_fence(__ATOMIC_ACQUIRE, "agent");
            asm volatile("s_waitcnt vmcnt(0)" ::: "memory");
        }
    }
    __syncthreads();
}

namespace pg8 {
using mk::cvt_pk_bf16;
constexpr int BM = 256, BK = 64, HALF = 128, HTB = HALF * BK * 2  , STAGE_BYTES = 8 * HTB;
__host__ __device__ __forceinline__ int lds_byte(int r, int c) { const int st = (r >> 4) * 2 + (c >> 5), rr = r & 15, cc = c & 31, ob = rr * 64 + cc * 2; return st * 1024 + (ob ^ (((ob >> 9) & 1) << 5)); }
__host__ __device__ __forceinline__ void stage_rc(int b, int& R, int& C) { const int st = b / 1024, sb = b % 1024, swz = sb ^ (((sb >> 9) & 1) << 5); R = (st >> 1) * 16 + swz / 64; C = (st & 1) * 32 + (swz % 64) / 2; }
__host__ __device__ __forceinline__ int perm32(int rho) { const int n = rho >> 4, i = rho & 15; return 8 * (i >> 2) + 4 * n + (i & 3); }

struct Unit { const char* A; const char* Bt; bf16_t* out; int pm, pn, x0, x1, ldo, kind; };

template <class Epi, class Sched>
__device__ __forceinline__ void gemm_phase(LAS unsigned char* lds, const int K, const Sched& S, const Epi& E) {
    const int tid = mk::otid(), wid = __builtin_amdgcn_readfirstlane(tid >> 6), lane = tid & 63, wr = wid >> 2, wc = wid & 3, fr = lane & 15, fq = lane >> 4;
    const int nt = K / BK;
    unsigned voffA[2], voffB[2];
#pragma unroll
    for (int i = 0; i < 2; ++i) { int R, C; stage_rc(tid * 16 + i * 8192, R, C); const int Rb = Epi::PERM ? ((R & ~31) + perm32(R & 31)) : R;
        voffA[i] = (unsigned)(R * K + C) * 2u; voffB[i] = (unsigned)(Rb * K + C) * 2u; }
    const size_t kstep = (size_t)(BK * 2);
    const size_t hstep = (size_t)HALF * K * 2;
    const unsigned ldsw = (unsigned)wid * 1024u;
    const int aoff = lds_byte(wr * 64 + fr, fq * 8), boff = lds_byte(wc * 32 + fr, fq * 8);
#define PG8_SA(b, h) (((b) * 2 + (h)) * HTB)
#define PG8_SB(b, h) ((4 + (b) * 2 + (h)) * HTB)
#define PG8_STAGE(bufoff, gbase, voff) do { _Pragma("unroll") for (int _i = 0; _i < 2; ++_i) \
        __builtin_amdgcn_global_load_lds((const unsigned*)((const char*)(gbase) + (voff)[_i]), (LAS unsigned*)(lds + (bufoff) + ldsw + _i * 8192), 16, 0, 0); } while (0)
#define PG8_LDA(dst, b, h) do { _Pragma("unroll") for (int m = 0; m < 4; ++m) _Pragma("unroll") for (int k = 0; k < 2; ++k) dst[m][k] = *(const LAS bf16x8*)(lds + PG8_SA(b, h) + aoff + m * 2048 + k * 1024); } while (0)
#define PG8_LDB(dst, b, h) do { _Pragma("unroll") for (int n = 0; n < 2; ++n) _Pragma("unroll") for (int k = 0; k < 2; ++k) dst[n][k] = *(const LAS bf16x8*)(lds + PG8_SB(b, h) + boff + n * 2048 + k * 1024); } while (0)
#define PG8_MMA(ai, bj, At, Bt) do { __builtin_amdgcn_s_setprio(1); _Pragma("unroll") for (int m = 0; m < 4; ++m) _Pragma("unroll") for (int n = 0; n < 2; ++n) _Pragma("unroll") for (int k = 0; k < 2; ++k) \
        acc[ai][bj][m][n] = __builtin_amdgcn_mfma_f32_16x16x32_bf16(Bt[n][k], At[m][k], acc[ai][bj][m][n], 0, 0, 0); __builtin_amdgcn_s_setprio(0); } while (0)
#define PG8_WAIT_V(n) asm volatile("s_waitcnt vmcnt(" #n ")" ::: "memory")
#define PG8_WAIT_L(n) asm volatile("s_waitcnt lgkmcnt(" #n ")" ::: "memory")
#define PG8_BAR __builtin_amdgcn_s_barrier()
#define PG8_SCHED __builtin_amdgcn_sched_barrier(0)
    Unit cur, nxt; int ui = 0;
    if (!S.next(0, cur)) return;
    f32x4 acc[2][2][4][2];
#pragma unroll
    for (int a = 0; a < 2; ++a)
#pragma unroll
        for (int b = 0; b < 2; ++b)
#pragma unroll
            for (int m = 0; m < 4; ++m)
#pragma unroll
                for (int n = 0; n < 2; ++n) acc[a][b][m][n] = (f32x4){0.f, 0.f, 0.f, 0.f};
    bf16x8 At[4][2], B0[2][2], B1[2][2];
    const char* cA = cur.A; const char* cB = cur.Bt;
    PG8_STAGE(PG8_SB(0, 0), cB, voffB); PG8_STAGE(PG8_SA(0, 0), cA, voffA); PG8_STAGE(PG8_SB(0, 1), cB + hstep, voffB); PG8_STAGE(PG8_SA(0, 1), cA + hstep, voffA);
    if (wr == 1) PG8_BAR;
    PG8_WAIT_V(4); PG8_BAR;
    PG8_STAGE(PG8_SB(1, 0), cB + kstep, voffB); PG8_STAGE(PG8_SA(1, 0), cA + kstep, voffA); PG8_STAGE(PG8_SB(1, 1), cB + hstep + kstep, voffB);
    PG8_WAIT_V(6); PG8_BAR;
    for (;;) {
        const bool has_next = S.next(ui + 1, nxt);
        const char* nA = has_next ? nxt.A : cA; const char* nB = has_next ? nxt.Bt : cB;
        for (int t = 0; t < nt; t += 2) {
            const bool last = (t == nt - 2);
            const char* a1 = cA + (size_t)(t + 1) * kstep;
            const char* a2 = last ? nA : cA + (size_t)(t + 2) * kstep; const char* b2 = last ? nB : cB + (size_t)(t + 2) * kstep;
            const char* a3 = a2 + kstep; const char* b3 = b2 + kstep;
            PG8_LDB(B0, 0, 0); PG8_SCHED; PG8_LDA(At, 0, 0); PG8_STAGE(PG8_SA(1, 1), a1 + hstep, voffA);
            PG8_WAIT_L(8); PG8_BAR; PG8_WAIT_L(0); PG8_MMA(0, 0, At, B0); PG8_BAR; PG8_SCHED;
            PG8_LDB(B1, 0, 1); PG8_STAGE(PG8_SB(0, 0), b2, voffB);
            PG8_BAR; PG8_WAIT_L(0); PG8_MMA(0, 1, At, B1); PG8_BAR;
            PG8_LDA(At, 0, 1); PG8_STAGE(PG8_SA(0, 0), a2, voffA);
            PG8_BAR; PG8_WAIT_L(0); PG8_MMA(1, 0, At, B0); PG8_BAR; PG8_SCHED;
            PG8_STAGE(PG8_SB(0, 1), b2 + hstep, voffB);
            PG8_WAIT_V(6); PG8_BAR; PG8_MMA(1, 1, At, B1); PG8_BAR;
            PG8_LDB(B0, 1, 0); PG8_SCHED; PG8_LDA(At, 1, 0); PG8_STAGE(PG8_SA(0, 1), a2 + hstep, voffA);
            PG8_WAIT_L(8); PG8_BAR; PG8_WAIT_L(0); PG8_MMA(0, 0, At, B0); PG8_BAR; PG8_SCHED;
            PG8_LDB(B1, 1, 1); PG8_STAGE(PG8_SB(1, 0), b3, voffB);
            PG8_BAR; PG8_WAIT_L(0); PG8_MMA(0, 1, At, B1); PG8_BAR;
            PG8_LDA(At, 1, 1); PG8_STAGE(PG8_SA(1, 0), a3, voffA);
            PG8_BAR; PG8_WAIT_L(0); PG8_MMA(1, 0, At, B0); PG8_BAR; PG8_SCHED;
            PG8_STAGE(PG8_SB(1, 1), b3 + hstep, voffB);
            PG8_WAIT_V(6); PG8_BAR; PG8_MMA(1, 1, At, B1); PG8_BAR;
        }
        E(acc, cur, wr, wc, fr, fq);
        if (!has_next) break;
#pragma unroll
        for (int a = 0; a < 2; ++a)
#pragma unroll
            for (int b = 0; b < 2; ++b)
#pragma unroll
                for (int m = 0; m < 4; ++m)
#pragma unroll
                    for (int n = 0; n < 2; ++n) acc[a][b][m][n] = (f32x4){0.f, 0.f, 0.f, 0.f};
        cur = nxt; cA = nA; cB = nB; ++ui;
    }
    PG8_WAIT_V(0);
    if (wr == 0) PG8_BAR;
    PG8_BAR;
#undef PG8_SA
#undef PG8_SB
#undef PG8_STAGE
#undef PG8_LDA
#undef PG8_LDB
#undef PG8_MMA
#undef PG8_WAIT_V
#undef PG8_WAIT_L
#undef PG8_BAR
#undef PG8_SCHED
}

struct EpiStoreBf16 {
    static constexpr bool PERM = true;
    __device__ __forceinline__ void operator()(const f32x4 (&acc)[2][2][4][2], const Unit& u, int wr, int wc, int fr, int fq) const {
        bf16_t* O = u.out; const int ldc = u.ldo;
        const int row0 = u.x0 + wr * 64 + fr, col0 = u.x1 + wc * 32 + 8 * fq;
#pragma unroll
        for (int ai = 0; ai < 2; ++ai)
#pragma unroll
            for (int m = 0; m < 4; ++m) { bf16_t* rowp = O + (size_t)(row0 + ai * HALF + m * 16) * ldc + col0;
#pragma unroll
                for (int bj = 0; bj < 2; ++bj) { const f32x4 v0 = acc[ai][bj][m][0], v1 = acc[ai][bj][m][1];
                    u32x4 w; w.x = cvt_pk_bf16(v0[0], v0[1]); w.y = cvt_pk_bf16(v0[2], v0[3]); w.z = cvt_pk_bf16(v1[0], v1[1]); w.w = cvt_pk_bf16(v1[2], v1[3]);
                    *(u32x4*)(rowp + bj * HALF) = w; } }
    }
};
}

namespace mk {
struct NMapId { int off; __device__ __forceinline__ int operator()(int n) const { return n + off; } };
struct NMapInterleave { int which; __device__ __forceinline__ int operator()(int n) const { return 2 * n + which; } };
struct NMapRope { __device__ __forceinline__ int operator()(int n) const { if (n >= 2048) return n; const int ch = n >> 6, c = n & 63, half = c >> 5, w = c & 31, z = w >> 4, i = w & 15; return ch * 64 + half * 32 + 2 * i + z; } };

template <class NMap>
__device__ __forceinline__ void cvt_tile(const float* __restrict__ src, int ldsrc, int K, bf16_t* __restrict__ dst, int k0, int n0, const NMap& nmap, LAS float* tile) {
  const int t = mk::otid();
  { const int k = t >> 3, c = (t & 7) * 8; const float* p = src + (size_t)(k0 + k) * ldsrc + n0 + c;
    const f32x4 a = *(const f32x4*)p, b = *(const f32x4*)(p + 4);
    LAS float* q = tile + k * 65 + c; q[0] = a[0]; q[1] = a[1]; q[2] = a[2]; q[3] = a[3]; q[4] = b[0]; q[5] = b[1]; q[6] = b[2]; q[7] = b[3]; }
  __syncthreads();
  { const int n = t >> 3, kc = (t & 7) * 8; const LAS float* q = tile + kc * 65 + n;
    u32x4 w; w.x = cvt_pk_bf16(q[0], q[65]); w.y = cvt_pk_bf16(q[130], q[195]); w.z = cvt_pk_bf16(q[260], q[325]); w.w = cvt_pk_bf16(q[390], q[455]);
    *(u32x4*)(dst + (size_t)nmap(n0 + n) * K + k0 + kc) = w; }
  __syncthreads();
}
template <class NMap>
__device__ __forceinline__ int cvt_matrix(const float* src, int ldsrc, int K, int N, bf16_t* dst, const NMap& nmap, LAS float* tile, int ubase, int bid, int nblk) {
  const int nkt = K / 64, nnt = N / 64, tot = nkt * nnt;
  int first = ubase + ((bid - ubase % nblk) + nblk) % nblk;
  for (int u = first; u < ubase + tot; u += nblk) { const int v = u - ubase; cvt_tile(src, ldsrc, K, dst, (v / nnt) * 64, (v % nnt) * 64, nmap, tile); }
  return tot;
}
}

namespace att {
using namespace mk;
constexpr int KB_BYTES = 64 * 128, VB_BYTES = 128 * 128, DA_LDS = 2 * KB_BYTES + 3 * VB_BYTES;
__device__ __forceinline__ int pi32(int r) { return (r & ~12) | ((r & 4) << 1) | ((r & 8) >> 1); }
__device__ __forceinline__ int swz(int row, int chunk) { return row * 128 + ((chunk ^ ((row >> 1) & 7)) << 4); }
__device__ __forceinline__ int crow(int r, int hi) { return (r & 3) + 8 * (r >> 2) + 4 * hi; }

__device__ __forceinline__ void diff_attn_unit(const bf16_t* __restrict__ Pqk, const bf16_t* __restrict__ Vt, bf16_t* __restrict__ O12, int hh, int q0, int klat0, int nlat, int kctx0, LAS unsigned char* lds) {
  const int tid = mk::otid(), wid = tid >> 6, lane = tid & 63, r = lane & 31, hi = lane >> 5;
  const int NT = (nlat + L) / 64, NTL = nlat / 64;
  constexpr float C = 0.125f * 1.4426950408889634f;
  constexpr float THR = 8.0f / 0.125f;
  const int srow = tid >> 3, sch = tid & 7;
  const bf16_t* kbase = Pqk + 1024 + hh * 64 + sch * 8;
  const bf16_t* vbase = Vt + (size_t)((hh >> 1) * 128 + srow) * NTOK + sch * 8;
  const int kdst = swz(srow, sch), vdst0 = swz(srow, sch), vdst1 = swz(srow + 64, sch);
  bf16x8 qf[4];
  { const bf16_t* qp = Pqk + (size_t)(q0 + wid * 32 + r) * 2048 + hh * 64 + hi * 8;
#pragma unroll
    for (int ks = 0; ks < 4; ++ks) qf[ks] = *(const bf16x8*)(qp + ks * 16); }
  int kaddr[2];
#pragma unroll
  for (int kb = 0; kb < 2; ++kb) kaddr[kb] = (kb * 32 + pi32(r)) * 128;
  const int kx = (pi32(r) >> 1) & 7;
  const int vx = (r >> 1) & 7;
  f32x16 o[4];
#pragma unroll
  for (int vb = 0; vb < 4; ++vb)
#pragma unroll
    for (int i = 0; i < 16; ++i) o[vb][i] = 0.f;
  float m_run = -1e30f, l_run = 0.f;
  u32x4 kreg, vreg0, vreg1;
  bf16x8 pf[2][2];
#pragma unroll
  for (int kb = 0; kb < 2; ++kb)
#pragma unroll
    for (int s = 0; s < 2; ++s) pf[kb][s] = (bf16x8){0, 0, 0, 0, 0, 0, 0, 0};
  f32x16 s0, s1;
#define DA_LOAD(t) do { const int tok = (t) < NTL ? klat0 + (t) * 64 : kctx0 + ((t) - NTL) * 64; \
    kreg = *(const u32x4*)(kbase + (size_t)(tok + srow) * 2048); vreg0 = *(const u32x4*)(vbase + tok); vreg1 = *(const u32x4*)(vbase + (size_t)64 * NTOK + tok); } while (0)
#define DA_WRITE(kbi, vbi) do { LAS unsigned char* kb_ = lds + (kbi) * KB_BYTES; LAS unsigned char* vb_ = lds + 2 * KB_BYTES + (vbi) * VB_BYTES; \
    *(LAS u32x4*)(kb_ + kdst) = kreg; *(LAS u32x4*)(vb_ + vdst0) = vreg0; *(LAS u32x4*)(vb_ + vdst1) = vreg1; } while (0)
#define DA_QK(tt) do { const LAS unsigned char* kb_ = lds + ((tt) & 1) * KB_BYTES; \
    _Pragma("unroll") for (int i = 0; i < 16; ++i) { s0[i] = 0.f; s1[i] = 0.f; } \
    _Pragma("unroll") for (int ks = 0; ks < 4; ++ks) { const int ch = ((ks * 2 + hi) ^ kx) << 4; \
      const bf16x8 a0 = *(const LAS bf16x8*)(kb_ + kaddr[0] + ch), a1 = *(const LAS bf16x8*)(kb_ + kaddr[1] + ch); \
      s0 = __builtin_amdgcn_mfma_f32_32x32x16_bf16(a0, qf[ks], s0, 0, 0, 0); s1 = __builtin_amdgcn_mfma_f32_32x32x16_bf16(a1, qf[ks], s1, 0, 0, 0); } } while (0)
#define DA_SM() do { float mx = fmaxf(s0[0], s1[0]); \
    _Pragma("unroll") for (int i = 1; i < 16; ++i) mx = fmaxf(mx, fmaxf(s0[i], s1[i])); \
    { const u32x2 sw = __builtin_amdgcn_permlane32_swap(__float_as_uint(mx), __float_as_uint(mx), false, false); mx = fmaxf(__uint_as_float(sw.x), __uint_as_float(sw.y)); } \
    float alpha = 1.0f; \
    if (!__all(mx - m_run <= THR)) { const float m_new = fmaxf(m_run, mx); alpha = __builtin_amdgcn_exp2f((m_run - m_new) * C); m_run = m_new; \
      _Pragma("unroll") for (int vb = 0; vb < 4; ++vb) _Pragma("unroll") for (int i = 0; i < 16; ++i) o[vb][i] *= alpha; } \
    const float mc = -m_run * C; float ps = 0.f; \
    _Pragma("unroll") for (int i = 0; i < 16; ++i) { s0[i] = __builtin_amdgcn_exp2f(fmaf(s0[i], C, mc)); ps += s0[i]; } \
    _Pragma("unroll") for (int i = 0; i < 16; ++i) { s1[i] = __builtin_amdgcn_exp2f(fmaf(s1[i], C, mc)); ps += s1[i]; } \
    l_run = l_run * alpha + ps; \
    _Pragma("unroll") for (int s = 0; s < 2; ++s) { u32x4 w0, w1; \
      w0.x = cvt_pk_bf16(s0[8 * s + 0], s0[8 * s + 1]); w0.y = cvt_pk_bf16(s0[8 * s + 2], s0[8 * s + 3]); w0.z = cvt_pk_bf16(s0[8 * s + 4], s0[8 * s + 5]); w0.w = cvt_pk_bf16(s0[8 * s + 6], s0[8 * s + 7]); \
      w1.x = cvt_pk_bf16(s1[8 * s + 0], s1[8 * s + 1]); w1.y = cvt_pk_bf16(s1[8 * s + 2], s1[8 * s + 3]); w1.z = cvt_pk_bf16(s1[8 * s + 4], s1[8 * s + 5]); w1.w = cvt_pk_bf16(s1[8 * s + 6], s1[8 * s + 7]); \
      pf[0][s] = __builtin_bit_cast(bf16x8, w0); pf[1][s] = __builtin_bit_cast(bf16x8, w1); } } while (0)
#define DA_PV(vbi) do { const LAS unsigned char* vb_ = lds + 2 * KB_BYTES + (vbi) * VB_BYTES; bf16x8 va[4][4]; \
    _Pragma("unroll") for (int vb = 0; vb < 4; ++vb) { const LAS unsigned char* vrow = vb_ + (vb * 32 + r) * 128; \
      _Pragma("unroll") for (int c4 = 0; c4 < 4; ++c4) va[vb][c4] = *(const LAS bf16x8*)(vrow + (((2 * c4 + hi) ^ vx) << 4)); } \
    _Pragma("unroll") for (int vb = 0; vb < 4; ++vb) _Pragma("unroll") for (int kb = 0; kb < 2; ++kb) _Pragma("unroll") for (int s = 0; s < 2; ++s) \
      o[vb] = __builtin_amdgcn_mfma_f32_32x32x16_bf16(va[vb][kb * 2 + s], pf[kb][s], o[vb], 0, 0, 0); } while (0)
  const bool lead = __builtin_amdgcn_readfirstlane(wid) < 4;
  DA_LOAD(0); DA_WRITE(0, 0); __syncthreads();
  if (lead) {
    int vc = 0;
    for (int t = 0; t < NT; ++t) {
      const bool more = t + 1 < NT; const int vn = vc == 2 ? 0 : vc + 1;
      if (more) DA_LOAD(t + 1);
      DA_QK(t); DA_SM(); DA_PV(vc);
      if (more) DA_WRITE((t + 1) & 1, vn);
      __syncthreads();
      vc = vn;
    }
  } else {
    int vc = 0, vp = 2;
    for (int t = 0; t < NT; ++t) {
      const bool more = t + 1 < NT; const int vn = vc == 2 ? 0 : vc + 1;
      if (more) DA_LOAD(t + 1);
      if (t > 0) DA_PV(vp);
      DA_QK(t); DA_SM();
      if (more) DA_WRITE((t + 1) & 1, vn);
      __syncthreads();
      vp = vc; vc = vn;
    }
    DA_PV(vp);
  }
  __syncthreads();
#undef DA_LOAD
#undef DA_WRITE
#undef DA_QK
#undef DA_SM
#undef DA_PV
  float l_tot; { const u32x2 sw = __builtin_amdgcn_permlane32_swap(__float_as_uint(l_run), __float_as_uint(l_run), false, false); l_tot = __uint_as_float(sw.x) + __uint_as_float(sw.y); }
  const float inv = 1.0f / l_tot;
  bf16_t* op = O12 + (size_t)(q0 + wid * 32 + r) * 2048 + hh * 128 + 4 * hi;
#pragma unroll
  for (int vb = 0; vb < 4; ++vb)
#pragma unroll
    for (int g = 0; g < 4; ++g) {
      u32x2 w; w.x = cvt_pk_bf16(o[vb][4 * g] * inv, o[vb][4 * g + 1] * inv); w.y = cvt_pk_bf16(o[vb][4 * g + 2] * inv, o[vb][4 * g + 3] * inv);
      *(u32x2*)(op + vb * 32 + 8 * g) = w;
    }
}

__device__ __forceinline__ void diff_combine_rows4(const bf16_t* __restrict__ O12, const float* __restrict__ subln_g, float lam, float oml, bf16_t* __restrict__ O, int row0, int h, int lane) {
  unsigned a[4], b[4];
#pragma unroll
  for (int i = 0; i < 4; ++i) { a[i] = *(const unsigned*)(O12 + (size_t)(row0 + i) * 2048 + (2 * h) * 128 + 2 * lane); b[i] = *(const unsigned*)(O12 + (size_t)(row0 + i) * 2048 + (2 * h + 1) * 128 + 2 * lane); }
  const float g0 = subln_g[2 * lane], g1 = subln_g[2 * lane + 1];
#pragma unroll
  for (int i = 0; i < 4; ++i) {
    const float x0 = bflo(a[i]) - lam * bflo(b[i]), x1 = bfhi(a[i]) - lam * bfhi(b[i]);
    const float ss = wave_sum_u(x0 * x0 + x1 * x1);
    const float rs = rsqrtf(ss * (1.0f / 128.0f) + 1e-5f) * oml;
    *(unsigned*)(O + (size_t)(row0 + i) * 1024 + h * 128 + 2 * lane) = cvt_pk_bf16(x0 * rs * g0, x1 * rs * g1);
  }
}
}

namespace natt {
using namespace mk;
using att::pi32; using att::swz;
constexpr int TB = 64 * 128;
constexpr int NA_LDS = 4 * TB + 2048;
__device__ __forceinline__ void na_attn_unit(const bf16_t* __restrict__ Pe, const bf16_t* __restrict__ Vte, const float* __restrict__ rpb_h, bf16_t* __restrict__ O, int b, int h, int rq, LAS unsigned char* lds) {
  const int tid = mk::otid(), wid = tid >> 6, lane = tid & 63, r = lane & 31, hi = lane >> 5;
  constexpr float LOG2E = 1.4426950408889634f;
  LAS float* sb = (LAS float*)(lds + 4 * TB);
  for (int i = tid; i < 465; i += NTHR) sb[i] = rpb_h[i];
  const bool is_ctx = rq < 0;
  int qrow = 0, qcol = 0, qtok, rs_q = 0, cs_q = 0, span0 = 0, wlo = 0, whi = -1, lo = 0, ntl = 0;
  if (!is_ctx) {
    const int r0 = rq * 4, ra = r0 + (wid >> 2) * 2;
    qrow = ra + (r >> 4); qcol = (wid & 3) * 16 + (r & 15); qtok = b * T + qrow * 64 + qcol;
    rs_q = min(max(qrow - 4, 0), 120); cs_q = min(max(qcol - 8, 0), 48);
    span0 = min(max((wid & 3) * 16 - 8, 0), 32);
    wlo = min(max(ra - 4, 0), 120); whi = min(max(ra - 3, 0), 120) + 7;
    lo = min(max(r0 - 4, 0), 120); const int hi_ = min(max(r0 - 1, 0), 120) + 7; ntl = hi_ - lo + 1;
  } else qtok = NLAT + b * L + wid * 32 + r;
  const int NT = ntl + 4;
  const int srow = tid >> 3, sch = tid & 7;
  const bf16_t* kbase = Pe + 512 + h * 64 + sch * 8;
  const bf16_t* vbase = Vte + (size_t)(h * 64 + srow) * NTOK + sch * 8;
  const int sdst = swz(srow, sch);
  bf16x8 qf[4];
  { const bf16_t* qp = Pe + (size_t)qtok * 1024 + h * 64 + hi * 8;
#pragma unroll
    for (int ks = 0; ks < 4; ++ks) qf[ks] = *(const bf16x8*)(qp + ks * 16); }
  const int kx = (pi32(r) >> 1) & 7, vx = (r >> 1) & 7;
  const int ka_loc = (span0 + pi32(r)) * 128; const int kx_loc = ((span0 + pi32(r)) >> 1) & 7;
  f32x16 o[2];
#pragma unroll
  for (int vb = 0; vb < 2; ++vb)
#pragma unroll
    for (int i = 0; i < 16; ++i) o[vb][i] = 0.f;
  float m_run = -1e30f, l_run = 0.f;
  u32x4 kreg, vreg;
#define NA_LOAD(t) do { const int tok = (t) < ntl ? b * T + (lo + (t)) * 64 : NLAT + b * L + ((t) - ntl) * 64; \
    kreg = *(const u32x4*)(kbase + (size_t)(tok + srow) * 1024); vreg = *(const u32x4*)(vbase + tok); } while (0)
#define NA_WRITE(bufi) do { *(LAS u32x4*)(lds + (bufi) * TB + sdst) = kreg; *(LAS u32x4*)(lds + 2 * TB + (bufi) * TB + sdst) = vreg; } while (0)
  NA_LOAD(0); NA_WRITE(0); __syncthreads();
  for (int t = 0; t < NT; ++t) {
    const bool more = t + 1 < NT;
    if (more) NA_LOAD(t + 1);
    const LAS unsigned char* kb_ = lds + (t & 1) * TB; const LAS unsigned char* vb_ = lds + 2 * TB + (t & 1) * TB;
    const bool local = t < ntl; const int kr = lo + t;
    const bool active = !local || (kr >= wlo && kr <= whi);
    if (active) {
      f32x16 s0, s1;
#pragma unroll
      for (int i = 0; i < 16; ++i) { s0[i] = 0.f; s1[i] = 0.f; }
      if (local) {
#pragma unroll
        for (int ks = 0; ks < 4; ++ks) {
          const bf16x8 a0 = *(const LAS bf16x8*)(kb_ + ka_loc + (((ks * 2 + hi) ^ kx_loc) << 4));
          s0 = __builtin_amdgcn_mfma_f32_32x32x16_bf16(a0, qf[ks], s0, 0, 0, 0);
        }
        const bool row_ok = kr >= rs_q && kr < rs_q + 8; const int dr31 = (kr - qrow + 7) * 31;
#pragma unroll
        for (int i = 0; i < 16; ++i) {
          const int kc = span0 + (i & 7) + 8 * hi + 16 * (i >> 3);
          const bool ok = row_ok && kc >= cs_q && kc < cs_q + 16;
          const int bi = ok ? dr31 + (kc - qcol + 15) : 0;
          const float bv = sb[bi];
          s0[i] = ok ? fmaf(s0[i], 0.125f, bv) : -1e30f; s1[i] = -1e30f;
        }
      } else {
#pragma unroll
        for (int ks = 0; ks < 4; ++ks) {
          const int ch = ((ks * 2 + hi) ^ kx) << 4;
          const bf16x8 a0 = *(const LAS bf16x8*)(kb_ + pi32(r) * 128 + ch), a1 = *(const LAS bf16x8*)(kb_ + (32 + pi32(r)) * 128 + ch);
          s0 = __builtin_amdgcn_mfma_f32_32x32x16_bf16(a0, qf[ks], s0, 0, 0, 0);
          s1 = __builtin_amdgcn_mfma_f32_32x32x16_bf16(a1, qf[ks], s1, 0, 0, 0);
        }
#pragma unroll
        for (int i = 0; i < 16; ++i) { s0[i] *= 0.125f; s1[i] *= 0.125f; }
      }
      float mx = s0[0];
#pragma unroll
      for (int i = 1; i < 16; ++i) mx = fmaxf(mx, s0[i]);
#pragma unroll
      for (int i = 0; i < 16; ++i) mx = fmaxf(mx, s1[i]);
      { const u32x2 sw = __builtin_amdgcn_permlane32_swap(__float_as_uint(mx), __float_as_uint(mx), false, false); mx = fmaxf(__uint_as_float(sw.x), __uint_as_float(sw.y)); }
      const float m_new = fmaxf(m_run, mx);
      const float alpha = __builtin_amdgcn_exp2f((m_run - m_new) * LOG2E);
      m_run = m_new;
      const float mc = -m_new * LOG2E;
      float ps = 0.f;
#pragma unroll
      for (int i = 0; i < 16; ++i) { const float p = s0[i] > -1e29f ? __builtin_amdgcn_exp2f(fmaf(s0[i], LOG2E, mc)) : 0.f; s0[i] = p; ps += p; }
#pragma unroll
      for (int i = 0; i < 16; ++i) { const float p = s1[i] > -1e29f ? __builtin_amdgcn_exp2f(fmaf(s1[i], LOG2E, mc)) : 0.f; s1[i] = p; ps += p; }
      l_run = l_run * alpha + ps;
      if (__any(alpha < 1.0f)) {
#pragma unroll
        for (int vb = 0; vb < 2; ++vb)
#pragma unroll
          for (int i = 0; i < 16; ++i) o[vb][i] *= alpha;
      }
      bf16x8 pf[2][2];
#pragma unroll
      for (int s = 0; s < 2; ++s) {
        u32x4 w0, w1;
        w0.x = cvt_pk_bf16(s0[8 * s + 0], s0[8 * s + 1]); w0.y = cvt_pk_bf16(s0[8 * s + 2], s0[8 * s + 3]); w0.z = cvt_pk_bf16(s0[8 * s + 4], s0[8 * s + 5]); w0.w = cvt_pk_bf16(s0[8 * s + 6], s0[8 * s + 7]);
        w1.x = cvt_pk_bf16(s1[8 * s + 0], s1[8 * s + 1]); w1.y = cvt_pk_bf16(s1[8 * s + 2], s1[8 * s + 3]); w1.z = cvt_pk_bf16(s1[8 * s + 4], s1[8 * s + 5]); w1.w = cvt_pk_bf16(s1[8 * s + 6], s1[8 * s + 7]);
        pf[0][s] = __builtin_bit_cast(bf16x8, w0); pf[1][s] = __builtin_bit_cast(bf16x8, w1);
      }
      const int cbase = local ? (span0 >> 3) : 0;
#pragma unroll
      for (int vb = 0; vb < 2; ++vb) {
        const LAS unsigned char* vrow = vb_ + (vb * 32 + r) * 128;
#pragma unroll
        for (int s = 0; s < 2; ++s) {
          const bf16x8 a = *(const LAS bf16x8*)(vrow + (((cbase + 2 * s + hi) ^ vx) << 4));
          o[vb] = __builtin_amdgcn_mfma_f32_32x32x16_bf16(a, pf[0][s], o[vb], 0, 0, 0);
        }
        if (!local) {
#pragma unroll
          for (int s = 0; s < 2; ++s) {
            const bf16x8 a = *(const LAS bf16x8*)(vrow + (((4 + 2 * s + hi) ^ vx) << 4));
            o[vb] = __builtin_amdgcn_mfma_f32_32x32x16_bf16(a, pf[1][s], o[vb], 0, 0, 0);
          }
        }
      }
    }
    if (more) NA_WRITE((t + 1) & 1);
    __syncthreads();
  }
#undef NA_LOAD
#undef NA_WRITE
  float l_tot; { const u32x2 sw = __builtin_amdgcn_permlane32_swap(__float_as_uint(l_run), __float_as_uint(l_run), false, false); l_tot = __uint_as_float(sw.x) + __uint_as_float(sw.y); }
  const float inv = 1.0f / l_tot;
  bf16_t* op = O + (size_t)qtok * 1024 + h * 64 + 4 * hi;
#pragma unroll
  for (int vb = 0; vb < 2; ++vb)
#pragma unroll
    for (int g = 0; g < 4; ++g) {
      u32x2 w; w.x = cvt_pk_bf16(o[vb][4 * g] * inv, o[vb][4 * g + 1] * inv); w.y = cvt_pk_bf16(o[vb][4 * g + 2] * inv, o[vb][4 * g + 3] * inv);
      *(u32x2*)(op + vb * 32 + 8 * g) = w;
    }
}
}

namespace rw {
using namespace mk;
constexpr int NSTEP = L + T, NCH = 32, CL = NSTEP / NCH;
constexpr int NCHAIN = 2 * B * 8;
constexpr float LOG2E = 1.4426950408889634f;
struct Bufs {
  u32x2* SH;
  unsigned* DR;
  bf16_t* G; int gstride;
  float* CS;
  float* PQ;
  float* SST;
  bf16_t* Y;
  bf16_t* Z;
};

__device__ __forceinline__ void prep_tile(const bf16_t* __restrict__ Prw, const float* __restrict__ cw, const float* __restrict__ w0, const float* __restrict__ w_up, const float* __restrict__ a0,
                                          const float* __restrict__ a_up, const float* __restrict__ g_up, const float* __restrict__ k_k, const float* __restrict__ k_a, const float* __restrict__ r_k,
                                          const Bufs& bf, int tile, LAS float* xs  ) {
  const int c = mk::otid(), lane = c & 63, h = c >> 6;
  const int row0 = tile * 16;
  int lo, hi;
  if (row0 < NLAT) { lo = (row0 / T) * T; hi = lo + T - 1; } else { lo = NLAT + ((row0 - NLAT) / L) * L; hi = lo + L - 1; }
#define RW_CONV(dst, col) do { const float c0 = cw[(col)], c1 = cw[RW_IN + (col)], c2 = cw[2 * RW_IN + (col)]; const bf16_t* p = Prw + (col); \
    bf16_t raw[18]; \
    _Pragma("unroll") for (int j = 0; j < 18; ++j) { int rr = row0 - 1 + j; rr = rr < lo ? lo : (rr > hi ? hi : rr); raw[j] = p[(size_t)rr * RW_IN]; } \
    float pm = row0 > lo ? bf2f(raw[0]) : 0.f, pc = bf2f(raw[1]); \
    _Pragma("unroll") for (int tt = 0; tt < 16; ++tt) { const float pn = (row0 + tt + 1 <= hi) ? bf2f(raw[tt + 2]) : 0.f; dst[tt] = pm * c0 + pc * c1 + pn * c2; pm = pc; pc = pn; } } while (0)
  if (c < 256) {
    float xv[16]; RW_CONV(xv, 1536 + c);
#pragma unroll
    for (int tt = 0; tt < 16; ++tt) { float v = xv[tt]; if (c < 64) v = tanhf(v); else if (c >= 128) v = sigmoidf_(v); xs[c * 16 + tt] = v; }
  }
  __syncthreads();
  const float w00 = w0[c], w01 = w0[512 + c], a00 = a0[c], a01 = a0[512 + c], kkc = k_k[c], kac = k_a[c], rkc = r_k[c];
  float e0[16], e1[16];
  {
    float aw0[16], aw1[16];
#pragma unroll
    for (int tt = 0; tt < 16; ++tt) { aw0[tt] = 0.f; aw1[tt] = 0.f; }
    float nw0[8], nw1[8];
#pragma unroll
    for (int u = 0; u < 8; ++u) { nw0[u] = w_up[(size_t)u * 512 + c]; nw1[u] = w_up[(size_t)(64 + u) * 512 + c]; }
    for (int m0 = 0; m0 < 64; m0 += 8) {
      float ww0[8], ww1[8];
      const int mn = m0 + 8 < 64 ? m0 + 8 : m0;
#pragma unroll
      for (int u = 0; u < 8; ++u) { ww0[u] = nw0[u]; ww1[u] = nw1[u]; nw0[u] = w_up[(size_t)(mn + u) * 512 + c]; nw1[u] = w_up[(size_t)(64 + mn + u) * 512 + c]; }
#pragma unroll
      for (int u = 0; u < 8; ++u) {
#pragma unroll
        for (int q = 0; q < 4; ++q) { const f32x4 xw = *(const LAS f32x4*)(xs + (m0 + u) * 16 + q * 4);
#pragma unroll
          for (int e = 0; e < 4; ++e) { aw0[q * 4 + e] += xw[e] * ww0[u]; aw1[q * 4 + e] += xw[e] * ww1[u]; } }
      }
    }
#pragma unroll
    for (int tt = 0; tt < 16; ++tt) {
      { const float z = -(w00 + aw0[tt]); const float sp = fmaxf(z, 0.f) + __logf(1.0f + __expf(-fabsf(z))); e0[tt] = __expf(-sp - 0.5f); }
      { const float z = -(w01 + aw1[tt]); const float sp = fmaxf(z, 0.f) + __logf(1.0f + __expf(-fabsf(z))); e1[tt] = __expf(-sp - 0.5f); }
    }
  }
  LAS float* asl = xs + 256 * 16;
  {
    float aa0[16], aa1[16];
#pragma unroll
    for (int tt = 0; tt < 16; ++tt) { aa0[tt] = 0.f; aa1[tt] = 0.f; }
    float na0[8], na1[8];
#pragma unroll
    for (int u = 0; u < 8; ++u) { na0[u] = a_up[(size_t)u * 512 + c]; na1[u] = a_up[(size_t)(64 + u) * 512 + c]; }
    for (int m0 = 0; m0 < 64; m0 += 8) {
      float av0[8], av1[8];
      const int mn = m0 + 8 < 64 ? m0 + 8 : m0;
#pragma unroll
      for (int u = 0; u < 8; ++u) { av0[u] = na0[u]; av1[u] = na1[u]; na0[u] = a_up[(size_t)(mn + u) * 512 + c]; na1[u] = a_up[(size_t)(64 + mn + u) * 512 + c]; }
#pragma unroll
      for (int u = 0; u < 8; ++u) {
#pragma unroll
        for (int q = 0; q < 4; ++q) { const f32x4 xa = *(const LAS f32x4*)(xs + (64 + m0 + u) * 16 + q * 4);
#pragma unroll
          for (int e = 0; e < 4; ++e) { aa0[q * 4 + e] += xa[e] * av0[u]; aa1[q * 4 + e] += xa[e] * av1[u]; } }
      }
    }
#pragma unroll
    for (int tt = 0; tt < 16; ++tt) { const unsigned d0 = cvt_pk_bf16(e0[tt], sigmoidf_(a00 + aa0[tt])), d1 = cvt_pk_bf16(e1[tt], sigmoidf_(a01 + aa1[tt]));
      bf.DR[((size_t)(row0 + tt)) * 512 + c] = d0; bf.DR[((size_t)NTOK + row0 + tt) * 512 + c] = d1; asl[tt * 512 + c] = bfhi(d0); asl[(16 + tt) * 512 + c] = bfhi(d1); }
  }
  {
    float ag[16];
#pragma unroll
    for (int tt = 0; tt < 16; ++tt) ag[tt] = 0.f;
    float ng[16];
#pragma unroll
    for (int u = 0; u < 16; ++u) ng[u] = g_up[(size_t)u * 512 + c];
    for (int m0 = 0; m0 < 128; m0 += 16) {
      float gg[16];
      const int mn = m0 + 16 < 128 ? m0 + 16 : m0;
#pragma unroll
      for (int u = 0; u < 16; ++u) { gg[u] = ng[u]; ng[u] = g_up[(size_t)(mn + u) * 512 + c]; }
#pragma unroll
      for (int u = 0; u < 16; ++u) {
#pragma unroll
        for (int q = 0; q < 4; ++q) { const f32x4 xg = *(const LAS f32x4*)(xs + (128 + m0 + u) * 16 + q * 4);
#pragma unroll
          for (int e = 0; e < 4; ++e) ag[q * 4 + e] += xg[e] * gg[u]; }
      }
    }
#pragma unroll
    for (int tt = 0; tt < 16; ++tt) bf.G[(size_t)(row0 + tt) * bf.gstride + c] = f2bf(ag[tt]);
  }
#undef RW_CONV
  const float cr0 = cw[c], cr1 = cw[RW_IN + c], cr2 = cw[2 * RW_IN + c], ck0 = cw[512 + c], ck1 = cw[RW_IN + 512 + c], ck2 = cw[2 * RW_IN + 512 + c], cv0 = cw[1024 + c], cv1 = cw[RW_IN + 1024 + c], cv2 = cw[2 * RW_IN + 1024 + c];
  const bf16_t* pr = Prw + (size_t)row0 * RW_IN + c;
  const bf16_t* prm = Prw + (size_t)(row0 > lo ? row0 - 1 : row0) * RW_IN + c;
  const bf16_t rm_ = prm[0], km_ = prm[512], vm_ = prm[1024];
  float rm = row0 > lo ? bf2f(rm_) : 0.f, km = row0 > lo ? bf2f(km_) : 0.f, vm = row0 > lo ? bf2f(vm_) : 0.f;
  float rc = bf2f(pr[0]), kc = bf2f(pr[512]), vc = bf2f(pr[1024]);
#pragma unroll 2
  for (int tt = 0; tt < 16; ++tt) {
    const int row = row0 + tt;
    const bool has_n = row + 1 <= hi; const bf16_t* pn = pr + (size_t)(has_n ? tt + 1 : tt) * RW_IN;
    const bf16_t rn_ = pn[0], kn_ = pn[512], vn_ = pn[1024];
    const float rn = has_n ? bf2f(rn_) : 0.f, kn = has_n ? bf2f(kn_) : 0.f, vn = has_n ? bf2f(vn_) : 0.f;
    const float rv = rm * cr0 + rc * cr1 + rn * cr2, kvv = km * ck0 + kc * ck1 + kn * ck2, vvv = vm * cv0 + vc * cv1 + vn * cv2;
    rm = rc; rc = rn; km = kc; kc = kn; vm = vc; vc = vn;
    float kk = kvv * kkc; const float nrm = sqrtf(wave_sum_u(kk * kk)); kk = kk * __builtin_amdgcn_rcpf(fmaxf(nrm, 1e-12f));
    u32x2 sh; sh.x = cvt_pk_bf16(rv, kvv); sh.y = cvt_pk_bf16(kk, vvv);
    bf.SH[(size_t)row * 512 + c] = sh;
    const float rq = bflo(sh.x), kq = bfhi(sh.x);
    const float cb0 = wave_sum_u(rq * kq * (1.0f + (asl[tt * 512 + c] - 1.0f) * kac) * rkc), cb1 = wave_sum_u(rq * kq * (1.0f + (asl[(16 + tt) * 512 + c] - 1.0f) * kac) * rkc);
    if (lane == 0) { bf.CS[(size_t)row * 16 + h] = cb0; bf.CS[(size_t)row * 16 + 8 + h] = cb1; }
  }
  __syncthreads();
}

struct StepRaw { u32x2 s; unsigned d; };
__device__ __forceinline__ int scan_row(int dir, int b, int p) {
  if (p < L) return NLAT + b * L + (dir ? (L - 1 - p) : p);
  const int q = p - L; return b * T + (dir ? (T - 1 - q) : q);
}
#define RW_RL(x, j) __int_as_float(__builtin_amdgcn_readlane(__float_as_int(x), (j)))
__device__ __forceinline__ void scan_unit(const Bufs& bf, const float* __restrict__ k_a, int chain, int chunk, LAS float* wl  ) {
  const int lane = mk::otid() & 63;
  const int dir = chain >> 5, b = (chain >> 3) & 3, h = chain & 7, ch = h * 64 + lane;
  const float kac = k_a[ch];
  float S[64], P[64];
#pragma unroll
  for (int j = 0; j < 64; ++j) { S[j] = 0.f; P[j] = (j == lane) ? 1.f : 0.f; }
  const int p0 = chunk * CL;
  StepRaw nx; { const int row = scan_row(dir, b, p0); nx.s = bf.SH[(size_t)row * 512 + ch]; nx.d = bf.DR[((size_t)dir * NTOK + row) * 512 + ch]; }
  for (int s = 0; s < CL; ++s) {
    const StepRaw cu = nx; const int row = scan_row(dir, b, p0 + s);
    if (s + 1 < CL) { const int rn = scan_row(dir, b, p0 + s + 1); nx.s = bf.SH[(size_t)rn * 512 + ch]; nx.d = bf.DR[((size_t)dir * NTOK + rn) * 512 + ch]; }
    const float r = bflo(cu.s.x), k = bfhi(cu.s.x), kk = bflo(cu.s.y), v = bfhi(cu.s.y), e = bflo(cu.d), asg = bfhi(cu.d);
    const float w = __builtin_amdgcn_exp2f(-e * LOG2E), a = -kk, bb = kk * asg, keff = k * (1.0f + (asg - 1.0f) * kac);
    wl[lane] = a; wl[64 + lane] = w; wl[128 + lane] = bb; wl[192 + lane] = keff; wl[256 + lane] = r;
    float sa = 0.f, sap = 0.f;
#pragma unroll
    for (int j4 = 0; j4 < 16; ++j4) { const f32x4 av = *(const LAS f32x4*)(wl + 4 * j4);
#pragma unroll
      for (int e2 = 0; e2 < 4; ++e2) { sa = fmaf(S[4 * j4 + e2], av[e2], sa); sap = fmaf(P[4 * j4 + e2], av[e2], sap); } }
    float y = 0.f, z = 0.f;
#pragma unroll
    for (int j4 = 0; j4 < 16; ++j4) {
      const f32x4 wv = *(const LAS f32x4*)(wl + 64 + 4 * j4), bv = *(const LAS f32x4*)(wl + 128 + 4 * j4), kv = *(const LAS f32x4*)(wl + 192 + 4 * j4), rv = *(const LAS f32x4*)(wl + 256 + 4 * j4);
#pragma unroll
      for (int e2 = 0; e2 < 4; ++e2) { const int j = 4 * j4 + e2;
        float t = v * kv[e2]; t = fmaf(sa, bv[e2], t); S[j] = fmaf(S[j], wv[e2], t);
        P[j] = fmaf(P[j], wv[e2], sap * bv[e2]);
        y = fmaf(S[j], rv[e2], y); z = fmaf(P[j], rv[e2], z); }
    }
    const size_t oi = ((size_t)dir * NTOK + row) * 512 + ch;
    bf.Y[oi] = f2bf(y); bf.Z[oi] = f2bf(z);
  }
  if (chunk < NCH - 1) {
    float* pq = bf.PQ + (((size_t)chain * (NCH - 1) + chunk) * 2) * 4096 + lane * 64;
#pragma unroll
    for (int q = 0; q < 16; ++q) { *(f32x4*)(pq + q * 4) = (f32x4){P[q * 4], P[q * 4 + 1], P[q * 4 + 2], P[q * 4 + 3]}; *(f32x4*)(pq + 4096 + q * 4) = (f32x4){S[q * 4], S[q * 4 + 1], S[q * 4 + 2], S[q * 4 + 3]}; }
  }
}

__device__ __forceinline__ void propagate_chain(const Bufs& bf, int chain, LAS float* lds) {
  LAS float* Sl = lds; LAS float* Pl = lds + 64 * 65;
  const int tid = mk::otid(), i = tid >> 3, jg = (tid & 7) * 8;
  float* sst = bf.SST + (size_t)chain * NCH * 4096;
#pragma unroll
  for (int e = 0; e < 8; ++e) Sl[i * 65 + jg + e] = 0.f;
  const float* pq0 = bf.PQ + ((size_t)chain * (NCH - 1) * 2) * 4096 + i * 64 + jg;
  f32x4 np0 = *(const f32x4*)pq0, np1 = *(const f32x4*)(pq0 + 4), nq0 = *(const f32x4*)(pq0 + 4096), nq1 = *(const f32x4*)(pq0 + 4096 + 4);
  for (int c = 0; c < NCH - 1; ++c) {
    const f32x4 p0 = np0, p1 = np1; f32x4 q0 = nq0, q1 = nq1;
    { const float* pqn = pq0 + (size_t)(c + 1 < NCH - 1 ? c + 1 : c) * 2 * 4096;
      np0 = *(const f32x4*)pqn; np1 = *(const f32x4*)(pqn + 4); nq0 = *(const f32x4*)(pqn + 4096); nq1 = *(const f32x4*)(pqn + 4096 + 4); }
    *(LAS f32x4*)(Pl + i * 64 + jg) = p0; *(LAS f32x4*)(Pl + i * 64 + jg + 4) = p1;
    __syncthreads();
#pragma unroll 8
    for (int k = 0; k < 64; ++k) { const float sv = Sl[i * 65 + k]; const f32x4 a = *(const LAS f32x4*)(Pl + k * 64 + jg), b2 = *(const LAS f32x4*)(Pl + k * 64 + jg + 4); q0 += sv * a; q1 += sv * b2; }
    __syncthreads();
    Sl[i * 65 + jg] = q0[0]; Sl[i * 65 + jg + 1] = q0[1]; Sl[i * 65 + jg + 2] = q0[2]; Sl[i * 65 + jg + 3] = q0[3]; Sl[i * 65 + jg + 4] = q1[0]; Sl[i * 65 + jg + 5] = q1[1]; Sl[i * 65 + jg + 6] = q1[2]; Sl[i * 65 + jg + 7] = q1[3];
    *(f32x4*)(sst + (size_t)(c + 1) * 4096 + i * 64 + jg) = q0; *(f32x4*)(sst + (size_t)(c + 1) * 4096 + i * 64 + jg + 4) = q1;
  }
  __syncthreads();
}

__device__ __forceinline__ void corr_unit(const Bufs& bf, int chain, int chunk) {
  const int lane = mk::otid() & 63, r = lane & 31, hi = lane >> 5;
  const int dir = chain >> 5, b = (chain >> 3) & 3, h = chain & 7;
  const float* ss = bf.SST + ((size_t)chain * NCH + chunk) * 4096;
  bf16x8 bfr[2][4];
#pragma unroll
  for (int nt = 0; nt < 2; ++nt)
#pragma unroll
    for (int ks = 0; ks < 4; ++ks) { const float* q = ss + (size_t)(nt * 32 + r) * 64 + ks * 16 + hi * 8; const f32x4 x0 = *(const f32x4*)q, x1 = *(const f32x4*)(q + 4);
      u32x4 w; w.x = cvt_pk_bf16(x0[0], x0[1]); w.y = cvt_pk_bf16(x0[2], x0[3]); w.z = cvt_pk_bf16(x1[0], x1[1]); w.w = cvt_pk_bf16(x1[2], x1[3]); bfr[nt][ks] = __builtin_bit_cast(bf16x8, w); }
  const int p0 = chunk * CL;
  const size_t dbase = (size_t)dir * NTOK;
  for (int mt = 0; mt < (CL + 31) / 32; ++mt) {
    const int sa_ = min(mt * 32 + r, CL - 1);
    const bf16_t* zp = bf.Z + (dbase + scan_row(dir, b, p0 + sa_)) * 512 + h * 64 + hi * 8;
    bf16x8 af[4];
#pragma unroll
    for (int ks = 0; ks < 4; ++ks) af[ks] = *(const bf16x8*)(zp + ks * 16);
    f32x16 acc[2];
#pragma unroll
    for (int nt = 0; nt < 2; ++nt) { acc[nt] = zero16();
#pragma unroll
      for (int ks = 0; ks < 4; ++ks) acc[nt] = __builtin_amdgcn_mfma_f32_32x32x16_bf16(af[ks], bfr[nt][ks], acc[nt], 0, 0, 0); }
#pragma unroll
    for (int i = 0; i < 16; ++i) { const int so = mt * 32 + (i & 3) + 8 * (i >> 2) + 4 * hi;
      if (so < CL) { bf16_t* yp = bf.Y + (dbase + scan_row(dir, b, p0 + so)) * 512 + h * 64 + r;
        yp[0] = f2bf(bf2f(yp[0]) + acc[0][i]); yp[32] = f2bf(bf2f(yp[32]) + acc[1][i]); } }
  }
}

template <int NR>
__device__ __forceinline__ void finish_rows(const Bufs& bf, const float* __restrict__ gn_g, const float* __restrict__ gn_b, bf16_t* __restrict__ O, int row0) {
  const int c = mk::otid(), h = c >> 6;
  float y[NR], v[NR], g[NR], cs[NR];
#pragma unroll
  for (int i = 0; i < NR; ++i) { const int row = row0 + i;
    y[i] = bf2f(bf.Y[(size_t)row * 512 + c]) + bf2f(bf.Y[((size_t)NTOK + row) * 512 + c]);
    v[i] = bfhi(bf.SH[(size_t)row * 512 + c].y); g[i] = bf2f(bf.G[(size_t)row * bf.gstride + c]);
    cs[i] = bf.CS[(size_t)row * 16 + h] + bf.CS[(size_t)row * 16 + 8 + h]; }
  const float gg = gn_g[c], gb = gn_b[c];
  float o[NR];
#pragma unroll
  for (int i = 0; i < NR; ++i) { const float mu = wave_sum_u(y[i]) * (1.0f / 64.0f); const float dv = y[i] - mu; const float var = wave_sum_u(dv * dv) * (1.0f / 64.0f);
    o[i] = (dv * rsqrtf(var + 64e-5f) * gg + gb + cs[i] * v[i]) * g[i]; }
#pragma unroll
  for (int i = 0; i < NR; ++i) O[(size_t)(row0 + i) * 1024 + 512 + c] = f2bf(o[i]);
}
}

namespace mk {
constexpr size_t al256(size_t x) { return (x + 255) / 256 * 256; }
constexpr size_t WS_BAR = 0;
constexpr size_t WS_BCNT = al256(WS_BAR + (size_t)XCD_BAR_WORDS * 4);
constexpr size_t WS_MOFF = al256(WS_BCNT + (size_t)4 * 256 * 64 * 4);
constexpr size_t WS_MOD = al256(WS_MOFF + 4 * 256);
constexpr size_t WS_ROPE = al256(WS_MOD + (size_t)4 * 5 * 6144 * 4);
constexpr size_t WS_HCTX = al256(WS_ROPE + 128 * 16 * 2 * 4);
constexpr size_t WS_EID = al256(WS_HCTX + (size_t)NCTX * D * 4);
constexpr size_t WS_GATE = al256(WS_EID + (size_t)NTOK * 2 * 4);
constexpr size_t WS_POS = al256(WS_GATE + (size_t)NTOK * 2 * 4);
constexpr size_t WS_WEIN = al256(WS_POS + (size_t)NTOK * 2 * 4);
constexpr size_t WS_WOIN = al256(WS_WEIN + (size_t)2 * EVEN_IN * D * 2);
constexpr size_t WS_WEOUT = al256(WS_WOIN + (size_t)2 * ODD_IN * D * 2);
constexpr size_t WS_WOOUT = al256(WS_WEOUT + (size_t)2 * D * D * 2);
constexpr size_t WS_WGU = al256(WS_WOOUT + (size_t)2 * D * D * 2);
constexpr size_t WS_WDN = al256(WS_WGU + (size_t)NE * 1024 * D * 2);
constexpr size_t WS_UO = al256(WS_WDN + (size_t)NE * D * DE * 2);
constexpr size_t WS_SCR = al256(WS_UO + (size_t)NTOK * D * 2);
constexpr size_t SE_PQK = 0;
constexpr size_t SE_VT = al256(SE_PQK + (size_t)NTOK * 1024 * 2);
constexpr size_t SE_PRW = al256(SE_VT + (size_t)512 * NTOK * 2);
constexpr size_t SE_PQ = 0;
constexpr size_t SE_SST = al256(SE_PQ + (size_t)rw::NCHAIN * (rw::NCH - 1) * 2 * 4096 * 4);
constexpr size_t SE_Y = al256(SE_SST + (size_t)rw::NCHAIN * rw::NCH * 4096 * 4);
constexpr size_t SE_Z = al256(SE_Y + (size_t)2 * NTOK * 512 * 2);
constexpr size_t SE_ZEND = al256(SE_Z + (size_t)2 * NTOK * 512 * 2);
constexpr size_t SE_PRWEND = al256(SE_PRW + (size_t)NTOK * RW_IN * 2);
constexpr size_t SE_SH = SE_PRWEND > SE_ZEND ? SE_PRWEND : SE_ZEND;
constexpr size_t SE_DR = al256(SE_SH + (size_t)NTOK * 512 * 8);
constexpr size_t SE_CS = al256(SE_DR + (size_t)2 * NTOK * 512 * 4);
constexpr size_t SE_END = al256(SE_CS + (size_t)2 * NTOK * 16 * 4);
constexpr size_t SE_YBUF = 0;
constexpr size_t SO_PQK = 0;
constexpr size_t SO_VT = al256(SO_PQK + (size_t)NTOK * 2048 * 2);
constexpr size_t SO_O12 = al256(SO_VT + (size_t)1024 * NTOK * 2);
constexpr size_t SO_END = al256(SO_O12 + (size_t)NTOK * 2048 * 2);
constexpr size_t SO_YBUF = 0;
constexpr size_t SM_XS = 0;
constexpr size_t SM_HE = al256(SM_XS + (size_t)MOE_ROWS * D * 2);
constexpr size_t SM_YS = al256(SM_HE + (size_t)MOE_ROWS * DE * 2);
constexpr size_t SM_END = al256(SM_YS + (size_t)MOE_ROWS * D * 2);
constexpr size_t SCR_BYTES = SE_END > SO_END ? (SE_END > SM_END ? SE_END : SM_END) : (SO_END > SM_END ? SO_END : SM_END);
constexpr size_t WS_END = WS_SCR + SCR_BYTES;
constexpr int LDS_BARW = 131072;
constexpr int LDS_MISC = 131072 + 64;

struct Params {
  const float *x, *c, *ctx, *c_ctx, *ada_w, *ada_b, *ln_g, *ln_b, *even_w_in, *even_w_out, *shift_w, *na_rpb, *rw_w0, *rw_w_up, *rw_a0, *rw_a_up, *rw_g_up, *rw_k_k, *rw_k_a, *rw_r_k,
      *rw_gn_g, *rw_gn_b, *odd_w_in, *odd_w_out, *da_lq1, *da_lk1, *da_lq2, *da_lk2, *da_subln_g, *router_w, *router_b, *exp_w_gate, *exp_w_up, *exp_w_down;
  float* out; unsigned char* ws; int ph_lo, ph_hi;
};
template <class Tp> __device__ __forceinline__ Tp* wsp(const Params& p, size_t off) { return (Tp*)(p.ws + off); }

__device__ __forceinline__ void ada_unit(const Params& p, int u, LAS float* lds) {
  LAS float* sc = lds; LAS float* red = lds + 5 * 1024;
  const int tid = mk::otid(), l = u / 96, n = (u % 96) * 64 + (tid & 63), kp = tid >> 6;
  for (int i = tid; i < 5 * 1024; i += NTHR) { const float v = i < 4096 ? p.c[i] : p.c_ctx[i - 4096]; sc[i] = siluf_(v); }
  __syncthreads();
  float a[5] = {0.f, 0.f, 0.f, 0.f, 0.f};
  const float* w = p.ada_w + ((size_t)l * D + kp * 128) * 6144 + n;
#pragma unroll 4
  for (int k = 0; k < 128; ++k) { const float wv = w[(size_t)k * 6144]; const int kk = kp * 128 + k;
#pragma unroll
    for (int r = 0; r < 5; ++r) a[r] = fmaf(sc[r * 1024 + kk], wv, a[r]); }
#pragma unroll
  for (int r = 0; r < 5; ++r) red[(kp * 5 + r) * 64 + (tid & 63)] = a[r];
  __syncthreads();
  if (tid < 320) { const int r = tid >> 6, nn = tid & 63; float s = 0.f;
#pragma unroll
    for (int q = 0; q < 8; ++q) s += red[(q * 5 + r) * 64 + nn];
    const int col = (u % 96) * 64 + nn;
    wsp<float>(p, WS_MOD)[((size_t)l * 5 + r) * 6144 + col] = s + p.ada_b[l * 6144 + col]; }
  __syncthreads();
}
__device__ __forceinline__ void phase_prologue(const Params& p, LAS unsigned char* lds) {
  const int bid = mk::obid(), nb = gridDim.x; LAS float* tile = (LAS float*)lds;
  int ub = 0;
  for (int i = 0; i < 2; ++i) ub += cvt_matrix(p.even_w_in + (size_t)i * D * EVEN_IN, EVEN_IN, D, EVEN_IN, wsp<bf16_t>(p, WS_WEIN) + (size_t)i * EVEN_IN * D, NMapId{0}, tile, ub, bid, nb);
  for (int i = 0; i < 2; ++i) ub += cvt_matrix(p.odd_w_in + (size_t)i * D * ODD_IN, ODD_IN, D, ODD_IN, wsp<bf16_t>(p, WS_WOIN) + (size_t)i * ODD_IN * D, NMapRope{}, tile, ub, bid, nb);
  for (int i = 0; i < 2; ++i) ub += cvt_matrix(p.even_w_out + (size_t)i * D * D, D, D, D, wsp<bf16_t>(p, WS_WEOUT) + (size_t)i * D * D, NMapId{0}, tile, ub, bid, nb);
  for (int i = 0; i < 2; ++i) ub += cvt_matrix(p.odd_w_out + (size_t)i * D * D, D, D, D, wsp<bf16_t>(p, WS_WOOUT) + (size_t)i * D * D, NMapId{0}, tile, ub, bid, nb);
  for (int u = (bid + nb - ub % nb) % nb; u < 384; u += nb) ada_unit(p, u, (LAS float*)lds);
  const int gt = bid * NTHR + mk::otid();
  if (gt < 128 * 16) { const int pos = gt >> 4, i = gt & 15; const float inv = exp2f(-(float)i * (13.287712379549449f / 16.0f)); float sn, cs; sincosf((float)pos * inv, &sn, &cs);
    wsp<float>(p, WS_ROPE)[gt * 2] = cs; wsp<float>(p, WS_ROPE)[gt * 2 + 1] = sn; }
}
__device__ __forceinline__ void cvt_experts(const Params& p, int l, LAS float* tile, int b0) {
  const int bid = mk::obid() - b0, nb = (int)gridDim.x - b0; int ub = 0;
  if (bid < 0) return;
  for (int e = 0; e < NE; ++e) {
    const size_t so = ((size_t)l * NE + e) * D * DE;
    ub += cvt_matrix(p.exp_w_gate + so, DE, D, DE, wsp<bf16_t>(p, WS_WGU) + (size_t)e * 1024 * D, NMapInterleave{0}, tile, ub, bid, nb);
    ub += cvt_matrix(p.exp_w_up + so, DE, D, DE, wsp<bf16_t>(p, WS_WGU) + (size_t)e * 1024 * D, NMapInterleave{1}, tile, ub, bid, nb);
    ub += cvt_matrix(p.exp_w_down + so, D, DE, D, wsp<bf16_t>(p, WS_WDN) + (size_t)e * D * DE, NMapId{0}, tile, ub, bid, nb);
  }
}

__device__ __forceinline__ const float* h_in_ptr(const Params& p, int l, int row) {
  if (l == 0) return row < NLAT ? p.x + (size_t)row * D : p.ctx + (size_t)(row - NLAT) * D;
  return row < NLAT ? p.out + (size_t)row * D : wsp<float>(p, WS_HCTX) + (size_t)(row - NLAT) * D;
}
__device__ __forceinline__ float* h_out_ptr(const Params& p, int row) { return row < NLAT ? p.out + (size_t)row * D : wsp<float>(p, WS_HCTX) + (size_t)(row - NLAT) * D; }
__device__ __forceinline__ void store_bf16x4(bf16_t* dst, f32x4 v) { u32x2 w; w.x = cvt_pk_bf16(v[0], v[1]); w.y = cvt_pk_bf16(v[2], v[3]); *(u32x2*)dst = w; }
__device__ __forceinline__ f32x4 load_bf16x4(const bf16_t* src) { const u32x2 w = *(const u32x2*)src; return (f32x4){bflo(w.x), bfhi(w.x), bflo(w.y), bfhi(w.y)}; }

__device__ __forceinline__ void phase_mod0(const Params& p) {
  const int lane = mk::otid() & 63, wid = mk::otid() >> 6;
  bf16_t* U = wsp<bf16_t>(p, WS_UO);
  for (int row = mk::obid() * 8 + wid; row < NTOK; row += gridDim.x * 8) {
    const float* h = h_in_ptr(p, 0, row); const float* modl = wsp<float>(p, WS_MOD) + (size_t)bidx_of_row(row) * 6144;
#pragma unroll
    for (int q = 0; q < 4; ++q) { const int col = q * 256 + lane * 4; const f32x4 hv = *(const f32x4*)(h + col), sh = *(const f32x4*)(modl + col), sc = *(const f32x4*)(modl + 1024 + col);
      store_bf16x4(U + (size_t)row * D + col, hv * (1.0f + sc) + sh); }
  }
}
__device__ __forceinline__ void ln_row(f32x4 (&v)[4], const float* __restrict__ g, const float* __restrict__ b, int lane) {
  float s = 0.f;
#pragma unroll
  for (int q = 0; q < 4; ++q) s += (v[q][0] + v[q][1]) + (v[q][2] + v[q][3]);
  const float mu = wave_sum_u(s) * (1.0f / D);
  float qq = 0.f;
#pragma unroll
  for (int q = 0; q < 4; ++q) { const f32x4 d = v[q] - mu; qq += (d[0] * d[0] + d[1] * d[1]) + (d[2] * d[2] + d[3] * d[3]); }
  const float rstd = rsqrtf(wave_sum_u(qq) * (1.0f / D) + LN_EPS);
#pragma unroll
  for (int q = 0; q < 4; ++q) { const int col = q * 256 + lane * 4; v[q] = (v[q] - mu) * rstd * *(const f32x4*)(g + col) + *(const f32x4*)(b + col); }
}
struct Ln1Raw { f32x4 h[4]; u32x2 y[4]; };
__device__ __forceinline__ void ln1_load(const Params& p, int l, const bf16_t* __restrict__ Ybuf, int row, int lane, Ln1Raw& r) {
  const float* h = h_in_ptr(p, l, row);
#pragma unroll
  for (int q = 0; q < 4; ++q) { const int col = q * 256 + lane * 4; r.h[q] = *(const f32x4*)(h + col); r.y[q] = *(const u32x2*)(Ybuf + (size_t)row * D + col); }
}
__device__ __forceinline__ void ln1_row(const Params& p, int l, int row, int lane, const Ln1Raw& raw, const LAS float* rwl, LAS int* lcnt, bool redir) {
  bf16_t* U2 = wsp<bf16_t>(p, WS_UO); int* eid = wsp<int>(p, WS_EID); float* gatev = wsp<float>(p, WS_GATE);
  const float* lg = p.ln_g + (size_t)(l * 2) * D; const float* lb = p.ln_b + (size_t)(l * 2) * D;
  float* ho = redir ? wsp<float>(p, WS_SCR + SM_YS) + (size_t)row * D : h_out_ptr(p, row); const float* modl = wsp<float>(p, WS_MOD) + ((size_t)l * 5 + bidx_of_row(row)) * 6144;
  f32x4 v[4];
#pragma unroll
  for (int q = 0; q < 4; ++q) { const int col = q * 256 + lane * 4; const f32x4 yv = (f32x4){bflo(raw.y[q].x), bfhi(raw.y[q].x), bflo(raw.y[q].y), bfhi(raw.y[q].y)};
    v[q] = ALPHA * raw.h[q] + *(const f32x4*)(modl + 2 * 1024 + col) * yv; }
  ln_row(v, lg, lb, lane);
  float acc[16];
#pragma unroll
  for (int e = 0; e < 16; ++e) acc[e] = 0.f;
#pragma unroll
  for (int q = 0; q < 4; ++q) { const int col = q * 256 + lane * 4;
    *(f32x4*)(ho + col) = v[q];
    const f32x4 u = v[q] * (1.0f + *(const f32x4*)(modl + 4 * 1024 + col)) + *(const f32x4*)(modl + 3 * 1024 + col);
    store_bf16x4(U2 + (size_t)row * D + col, u);
#pragma unroll
    for (int e = 0; e < 16; ++e) { const f32x4 w = *(const LAS f32x4*)(rwl + ((q * 16 + e) * 64 + lane) * 4); acc[e] += (u[0] * w[0] + u[1] * w[1]) + (u[2] * w[2] + u[3] * w[3]); }
  }
  float s[16], sel[16];
#pragma unroll
  for (int e = 0; e < 16; ++e) { s[e] = 1.0f / (1.0f + expf(-wave_sum_u(acc[e]))); sel[e] = s[e] + p.router_b[e]; }
  float best = -1e30f; int grp = 0;
#pragma unroll
  for (int gI = 0; gI < 4; ++gI) {
    const float a = sel[gI * 4], b2 = sel[gI * 4 + 1], c = sel[gI * 4 + 2], d = sel[gI * 4 + 3];
    const float lo1 = fminf(a, b2), hi1 = fmaxf(a, b2), lo2 = fminf(c, d), hi2 = fmaxf(c, d);
    const float gs = fmaxf(hi1, hi2) + fmaxf(fminf(hi1, hi2), fmaxf(lo1, lo2));
    if (gs > best) { best = gs; grp = gI; }
  }
  float v0 = 0, v1 = 0, v2 = 0, v3 = 0, s0 = 0, s1 = 0, s2 = 0, s3 = 0;
#pragma unroll
  for (int gI = 0; gI < 4; ++gI) if (gI == grp) { v0 = sel[gI * 4]; v1 = sel[gI * 4 + 1]; v2 = sel[gI * 4 + 2]; v3 = sel[gI * 4 + 3]; s0 = s[gI * 4]; s1 = s[gI * 4 + 1]; s2 = s[gI * 4 + 2]; s3 = s[gI * 4 + 3]; }
  int i1 = 0; float b1 = v0; if (v1 > b1) { b1 = v1; i1 = 1; } if (v2 > b1) { b1 = v2; i1 = 2; } if (v3 > b1) { b1 = v3; i1 = 3; }
  int i2 = -1; float bb = -1e30f;
  if (i1 != 0 && v0 > bb) { bb = v0; i2 = 0; } if (i1 != 1 && v1 > bb) { bb = v1; i2 = 1; } if (i1 != 2 && v2 > bb) { bb = v2; i2 = 2; } if (i1 != 3 && v3 > bb) { bb = v3; i2 = 3; }
  const float g1 = i1 == 0 ? s0 : i1 == 1 ? s1 : i1 == 2 ? s2 : s3; const float g2 = i2 == 0 ? s0 : i2 == 1 ? s1 : i2 == 2 ? s2 : s3;
  if (lane == 0) { const int e1 = grp * 4 + i1, e2 = grp * 4 + i2;
    eid[row * 2] = e1; eid[row * 2 + 1] = e2; gatev[row * 2] = g1 / (g1 + g2); gatev[row * 2 + 1] = g2 / (g1 + g2);
    __hip_atomic_fetch_add(lcnt + e1, 1, __ATOMIC_RELAXED, __HIP_MEMORY_SCOPE_WORKGROUP); __hip_atomic_fetch_add(lcnt + e2, 1, __ATOMIC_RELAXED, __HIP_MEMORY_SCOPE_WORKGROUP); }
}
__device__ __forceinline__ void phase_ln1(const Params& p, int l, const bf16_t* __restrict__ Ybuf, LAS unsigned char* lds, bool dry) {
  const int tid = mk::otid(), lane = tid & 63, wid = tid >> 6, bid = mk::obid();
  const bool last = l == DEPTH - 1; const int ntok = last ? NLAT : NTOK;
  LAS float* rwl = (LAS float*)lds; LAS int* lcnt = (LAS int*)(lds + 65536);
  { float rv[32];
#pragma unroll
    for (int i = 0; i < 32; ++i) rv[i] = p.router_w[tid + i * NTHR];
#pragma unroll
    for (int i = 0; i < 32; ++i) { const int idx = tid + i * NTHR, d = idx >> 4, e = idx & 15; rwl[(((d >> 8) * 16 + e) * 64 + ((d >> 2) & 63)) * 4 + (d & 3)] = rv[i]; } }
  if (tid < 16) lcnt[tid] = 0;
  __syncthreads();
  const int stride = gridDim.x * 8, row0 = bid * 8 + wid;
  if (row0 < ntok) {
    Ln1Raw cur, nxt; ln1_load(p, l, Ybuf, row0, lane, cur);
    for (int row = row0; row < ntok; row += stride) {
      const int rn = row + stride < ntok ? row + stride : row;
      ln1_load(p, l, Ybuf, rn, lane, nxt);
      ln1_row(p, l, row, lane, cur, rwl, lcnt, dry);
      cur = nxt;
    }
  }
  __syncthreads();
  if (tid < 16) wsp<int>(p, WS_BCNT)[((size_t)l * 256 + bid) * 64 + tid] = lcnt[tid];
  __syncthreads();
}
__device__ __forceinline__ void phase_scatter(const Params& p, int l, LAS unsigned char* lds) {
  const int tid = mk::otid(), lane = tid & 63, wid = tid >> 6, bid = mk::obid();
  const bool last = l == DEPTH - 1; const int ntok = last ? NLAT : NTOK;
  LAS int* tot = (LAS int*)lds; LAS int* pre = tot + 16; LAS int* base = tot + 32; LAS int* lcur = tot + 48;
  const int* bc = wsp<int>(p, WS_BCNT) + (size_t)l * 256 * 64;
  if (tid < 16) { int t = 0, pr = 0; for (int b2 = 0; b2 < (int)gridDim.x; ++b2) { const int v = bc[b2 * 64 + tid]; pr += b2 < bid ? v : 0; t += v; } tot[tid] = t; pre[tid] = pr; lcur[tid] = 0; }
  __syncthreads();
  if (tid == 0) { int o = 0; int* mo = wsp<int>(p, WS_MOFF) + l * 64; for (int e = 0; e < 16; ++e) { base[e] = o + pre[e]; if (bid == 0) mo[e] = o; o += (tot[e] + 255) / 256 * 256; } if (bid == 0) mo[16] = o; }
  __syncthreads();
  const bf16_t* U2 = wsp<bf16_t>(p, WS_UO); bf16_t* Xs = wsp<bf16_t>(p, WS_SCR + SM_XS); const int* eid = wsp<int>(p, WS_EID); int* pos = wsp<int>(p, WS_POS);
  for (int row = bid * 8 + wid; row < ntok; row += gridDim.x * 8) {
    int p1 = 0, p2 = 0;
    if (lane == 0) { const int e1 = eid[row * 2], e2 = eid[row * 2 + 1]; p1 = base[e1] + __hip_atomic_fetch_add(lcur + e1, 1, __ATOMIC_RELAXED, __HIP_MEMORY_SCOPE_WORKGROUP); p2 = base[e2] + __hip_atomic_fetch_add(lcur + e2, 1, __ATOMIC_RELAXED, __HIP_MEMORY_SCOPE_WORKGROUP); pos[row * 2] = p1; pos[row * 2 + 1] = p2; }
    p1 = __builtin_amdgcn_readfirstlane(p1); p2 = __builtin_amdgcn_readfirstlane(p2);
    const u32x4 a = *(const u32x4*)(U2 + (size_t)row * D + lane * 8), b2 = *(const u32x4*)(U2 + (size_t)row * D + 512 + lane * 8);
    *(u32x4*)(Xs + (size_t)p1 * D + lane * 8) = a; *(u32x4*)(Xs + (size_t)p1 * D + 512 + lane * 8) = b2;
    *(u32x4*)(Xs + (size_t)p2 * D + lane * 8) = a; *(u32x4*)(Xs + (size_t)p2 * D + 512 + lane * 8) = b2;
  }
}
struct Ln2Raw { f32x4 h[4]; u32x2 y1[4], y2[4]; };
__device__ __forceinline__ void ln2_load(const Params& p, int row, int lane, int p1, int p2, Ln2Raw& r) {
  const bf16_t* Ys = wsp<bf16_t>(p, WS_SCR + SM_YS); const float* ho = h_out_ptr(p, row);
#pragma unroll
  for (int q = 0; q < 4; ++q) { const int col = q * 256 + lane * 4; r.h[q] = *(const f32x4*)(ho + col); r.y1[q] = *(const u32x2*)(Ys + (size_t)p1 * D + col); r.y2[q] = *(const u32x2*)(Ys + (size_t)p2 * D + col); }
}
__device__ __forceinline__ void phase_ln2(const Params& p, int l, bool dry) {
  const int tid = mk::otid(), lane = tid & 63, wid = tid >> 6;
  const bool last = l == DEPTH - 1; const int ntok = last ? NLAT : NTOK;
  const int* pos = wsp<int>(p, WS_POS); const float* gatev = wsp<float>(p, WS_GATE); bf16_t* U = wsp<bf16_t>(p, WS_UO);
  const float* lg = p.ln_g + (size_t)(l * 2 + 1) * D; const float* lb = p.ln_b + (size_t)(l * 2 + 1) * D;
  const int stride = gridDim.x * 8, row0 = mk::obid() * 8 + wid;
  if (row0 >= ntok) return;
  auto clampr = [&](int r) { return r < ntok ? r : row0; };
  u32x2 pc = *(const u32x2*)(pos + 2 * row0); f32x2 gc = *(const f32x2*)(gatev + 2 * row0);
  Ln2Raw cur, nxt; ln2_load(p, row0, lane, (int)pc.x, (int)pc.y, cur);
  int r1 = clampr(row0 + stride);
  u32x2 pn = *(const u32x2*)(pos + 2 * r1); f32x2 gn = *(const f32x2*)(gatev + 2 * r1);
  for (int row = row0; row < ntok; row += stride) {
    ln2_load(p, r1, lane, (int)pn.x, (int)pn.y, nxt);
    const int r2 = clampr(row + 2 * stride);
    const u32x2 pn2 = *(const u32x2*)(pos + 2 * r2); const f32x2 gn2 = *(const f32x2*)(gatev + 2 * r2);
    float* ho = dry ? wsp<float>(p, WS_SCR + SM_XS) + (size_t)row * D : h_out_ptr(p, row); const int bi = bidx_of_row(row);
    const float* modl = wsp<float>(p, WS_MOD) + ((size_t)l * 5 + bi) * 6144;
    f32x4 v[4];
#pragma unroll
    for (int q = 0; q < 4; ++q) { const int col = q * 256 + lane * 4;
      const f32x4 a1 = (f32x4){bflo(cur.y1[q].x), bfhi(cur.y1[q].x), bflo(cur.y1[q].y), bfhi(cur.y1[q].y)}, a2 = (f32x4){bflo(cur.y2[q].x), bfhi(cur.y2[q].x), bflo(cur.y2[q].y), bfhi(cur.y2[q].y)};
      v[q] = ALPHA * cur.h[q] + *(const f32x4*)(modl + 5 * 1024 + col) * (gc[0] * a1 + gc[1] * a2); }
    ln_row(v, lg, lb, lane);
    const float* modn = wsp<float>(p, WS_MOD) + ((size_t)(last ? l : l + 1) * 5 + bi) * 6144;
#pragma unroll
    for (int q = 0; q < 4; ++q) { const int col = q * 256 + lane * 4; *(f32x4*)(ho + col) = v[q];
      if (!last) store_bf16x4(U + (size_t)row * D + col, v[q] * (1.0f + *(const f32x4*)(modn + 1024 + col)) + *(const f32x4*)(modn + col)); }
    cur = nxt; gc = gn; pn = pn2; gn = gn2; r1 = r2;
  }
}

struct SchedEvenIn { const bf16_t* U; const bf16_t* W; bf16_t* Pqk; bf16_t* Prw; bf16_t* Vt; int G, c;
  __device__ __forceinline__ bool next(int i, pg8::Unit& u) const { const int Lx = i * G + c; u.kind = 0;
    if (Lx < 1452) { const int grp = Lx / 44, rem = Lx % 44, pm = grp * 4 + (rem & 3), pi = rem >> 2; u.pm = pm; u.pn = pi;
      u.A = (const char*)(U + (size_t)pm * 256 * D); const int brow = pi < 4 ? pi * 256 : 1536 + (pi - 4) * 256; u.Bt = (const char*)(W + (size_t)brow * D);
      if (pi < 4) { u.out = Pqk; u.ldo = 1024; u.x1 = pi * 256; } else { u.out = Prw; u.ldo = RW_IN; u.x1 = (pi - 4) * 256; } u.x0 = pm * 256; return true; }
    if (Lx < 1452 + 264) { const int v = Lx - 1452, pmv = v & 1, pnv = v >> 1; u.pm = pmv; u.pn = pnv; u.A = (const char*)(W + (size_t)(1024 + pmv * 256) * D); u.Bt = (const char*)(U + (size_t)pnv * 256 * D);
      u.out = Vt; u.ldo = NTOK; u.x0 = pmv * 256; u.x1 = pnv * 256; return true; }
    return false; } };
struct SchedOddIn { const bf16_t* U; const bf16_t* W; bf16_t* Pqk; bf16_t* Vt; int G, c;
  __device__ __forceinline__ bool next(int i, pg8::Unit& u) const { const int Lx = i * G + c;
    if (Lx < 1056) { const int grp = Lx / 32, rem = Lx % 32, pm = grp * 4 + (rem & 3), pi = rem >> 2; u.pm = pm; u.pn = pi; u.kind = pm < 128 ? 1 : 0;
      u.A = (const char*)(U + (size_t)pm * 256 * D); u.Bt = (const char*)(W + (size_t)pi * 256 * D); u.out = Pqk; u.ldo = 2048; u.x0 = pm * 256; u.x1 = pi * 256; return true; }
    if (Lx < 1056 + 528) { const int v = Lx - 1056, pmv = v & 3, pnv = v >> 2; u.pm = pmv; u.pn = pnv; u.kind = 0; u.A = (const char*)(W + (size_t)(2048 + pmv * 256) * D); u.Bt = (const char*)(U + (size_t)pnv * 256 * D);
      u.out = Vt; u.ldo = NTOK; u.x0 = pmv * 256; u.x1 = pnv * 256; return true; }
    return false; } };
struct SchedOut { const bf16_t* O; const bf16_t* W; bf16_t* Y; int G, c;
  __device__ __forceinline__ bool next(int i, pg8::Unit& u) const { const int Lx = i * G + c; if (Lx >= 528) return false; const int pm = (Lx / 16) * 4 + (Lx & 3), pn = (Lx & 15) >> 2; u.pm = pm; u.pn = pn; u.kind = 0;
    u.A = (const char*)(O + (size_t)pm * 256 * D); u.Bt = (const char*)(W + (size_t)pn * 256 * D); u.out = Y; u.ldo = 1024; u.x0 = pm * 256; u.x1 = pn * 256; return true; } };
struct SchedMoe { const bf16_t* A; const bf16_t* W; bf16_t* out; const LAS int* moff; int Kd, ldo, ncol, G, c;
  __device__ __forceinline__ bool next(int i, pg8::Unit& u) const { const int Lx = i * G + c; const int ntile = moff[16] >> 8; if (Lx >= ntile * 4) return false;
    const int pm = Lx >> 2, pn = Lx & 3; int e = 0;
#pragma unroll
    for (int j = 1; j < 16; ++j) e += (pm * 256 >= moff[j]) ? 1 : 0;
    u.pm = pm; u.pn = pn; u.kind = 0; u.A = (const char*)(A + (size_t)pm * 256 * Kd); u.Bt = (const char*)(W + ((size_t)e * 1024 + pn * 256) * Kd); u.out = out; u.ldo = ldo; u.x0 = pm * 256; u.x1 = pn * ncol; return true; } };

struct EpiOddIn {
  static constexpr bool PERM = true; const float* rope;
  __device__ __forceinline__ void operator()(const f32x4 (&acc)[2][2][4][2], const pg8::Unit& u, int wr, int wc, int fr, int fq) const {
    if (u.kind == 0) { pg8::EpiStoreBf16{}(acc, u, wr, wc, fr, fq); return; }
    const int row0 = u.x0 + wr * 64 + fr, col0 = u.x1 + wc * 32 + 8 * fq; const int half = wc & 1;
#pragma unroll
    for (int ai = 0; ai < 2; ++ai)
#pragma unroll
      for (int m = 0; m < 4; ++m) { const int row = row0 + ai * 128 + m * 16; const int t = row & (T - 1); const int pos = half ? (t & 63) : (t >> 6);
        const f32x4 cs0 = *(const f32x4*)(rope + (pos * 16 + 4 * fq) * 2), cs1 = *(const f32x4*)(rope + (pos * 16 + 4 * fq + 2) * 2);
        bf16_t* rowp = u.out + (size_t)row * u.ldo + col0;
#pragma unroll
        for (int bj = 0; bj < 2; ++bj) { const f32x4 v0 = acc[ai][bj][m][0], v1 = acc[ai][bj][m][1];
          u32x4 w; w.x = cvt_pk_bf16(v0[0] * cs0[0] - v0[1] * cs0[1], v0[0] * cs0[1] + v0[1] * cs0[0]); w.y = cvt_pk_bf16(v0[2] * cs0[2] - v0[3] * cs0[3], v0[2] * cs0[3] + v0[3] * cs0[2]);
          w.z = cvt_pk_bf16(v1[0] * cs1[0] - v1[1] * cs1[1], v1[0] * cs1[1] + v1[1] * cs1[0]); w.w = cvt_pk_bf16(v1[2] * cs1[2] - v1[3] * cs1[3], v1[2] * cs1[3] + v1[3] * cs1[2]);
          *(u32x4*)(rowp + bj * 128) = w; } }
  }
};
struct EpiGateUp {
  static constexpr bool PERM = true;
  __device__ __forceinline__ void operator()(const f32x4 (&acc)[2][2][4][2], const pg8::Unit& u, int wr, int wc, int fr, int fq) const {
    const int row0 = u.x0 + wr * 64 + fr, col0 = u.x1 + wc * 16 + 4 * fq;
#pragma unroll
    for (int ai = 0; ai < 2; ++ai)
#pragma unroll
      for (int m = 0; m < 4; ++m) { bf16_t* rowp = u.out + (size_t)(row0 + ai * 128 + m * 16) * u.ldo + col0;
#pragma unroll
        for (int bj = 0; bj < 2; ++bj) { const f32x4 v0 = acc[ai][bj][m][0], v1 = acc[ai][bj][m][1];
          u32x2 w; w.x = cvt_pk_bf16(siluf_(v0[0]) * v0[1], siluf_(v0[2]) * v0[3]); w.y = cvt_pk_bf16(siluf_(v1[0]) * v1[1], siluf_(v1[2]) * v1[3]);
          *(u32x2*)(rowp + bj * 64) = w; } }
  }
};
}

namespace mk {
constexpr int N_PHASES = 2 + 2 * (12 + 9);
__global__ void __launch_bounds__(NTHR, 2) mega(Params p) {
  extern __shared__ __attribute__((aligned(16))) unsigned char shm[];
  LAS unsigned char* lds = (LAS unsigned char*)shm;
  const int nb = gridDim.x;
  if (threadIdx.x == 0) *(LAS u32x4*)(lds + LDS_BARW) = (u32x4){0u, 0u, 0u, 0u};
  __syncthreads();
  XcdBarrier bar = xcd_barrier_post(wsp<unsigned>(p, WS_BAR), (volatile LAS unsigned*)(lds + LDS_BARW));
  int ph = 0;
#ifndef MK_MASK
#define MK_MASK 0xFFFFFFFFu
#endif
#ifndef MK_REP
#define MK_REP 0u
#endif
#define PHASE_BEGIN_K(k) if ((((MK_MASK) >> (k)) & 1u) && ph >= p.ph_lo && ph < p.ph_hi) { const int bid = mk::obid(); const int nrep_ = ((((MK_REP) >> (k)) & 1u) ? 2 : 1); for (int rep_ = 0; rep_ < nrep_; ++rep_) { const bool dry = rep_ + 1 < nrep_; (void)dry;
#define PHASE_END   } if (ph + 1 < p.ph_hi) xcd_barrier(bar); } ++ph;
  bf16_t* UO = wsp<bf16_t>(p, WS_UO);
  unsigned char* scr = p.ws + WS_SCR;
  PHASE_BEGIN_K(0) phase_prologue(p, lds); PHASE_END
  PHASE_BEGIN_K(1) phase_mod0(p); PHASE_END
  for (int lp = 0; lp < 2; ++lp) {
    {
      const int l = 2 * lp;
      bf16_t* Pqk = (bf16_t*)(scr + SE_PQK); bf16_t* Vt = (bf16_t*)(scr + SE_VT); bf16_t* Prw = (bf16_t*)(scr + SE_PRW); bf16_t* Ybuf = (bf16_t*)(scr + SE_YBUF);
      rw::Bufs bf; bf.SH = (u32x2*)(scr + SE_SH); bf.DR = (unsigned*)(scr + SE_DR); bf.G = UO + 512; bf.gstride = 1024; bf.CS = (float*)(scr + SE_CS) + (size_t)lp * NTOK * 16; bf.PQ = (float*)(scr + SE_PQ); bf.SST = (float*)(scr + SE_SST); bf.Y = (bf16_t*)(scr + SE_Y); bf.Z = (bf16_t*)(scr + SE_Z);
      PHASE_BEGIN_K(2) { SchedEvenIn S{UO, wsp<bf16_t>(p, WS_WEIN) + (size_t)lp * EVEN_IN * D, Pqk, Prw, Vt, nb, bid}; pg8::gemm_phase(lds, D, S, pg8::EpiStoreBf16{}); } PHASE_END
      PHASE_BEGIN_K(3) { for (int u = bid; u < 1024 + 32; u += nb) { int b, h, rq; if (u < 1024) { b = u >> 8; h = (u >> 5) & 7; rq = u & 31; } else { const int v = u - 1024; b = v >> 3; h = v & 7; rq = -1; }
          natt::na_attn_unit(Pqk, Vt, p.na_rpb + ((size_t)lp * 8 + h) * 465, UO, b, h, rq, lds); }
        const int pb = (bid + nb / 2) % nb;
        for (int t = pb; t < NTOK / 16; t += nb) rw::prep_tile(Prw, p.shift_w + (size_t)lp * 3 * RW_IN, p.rw_w0 + lp * 1024, p.rw_w_up + (size_t)lp * 2 * 64 * 512, p.rw_a0 + lp * 1024,
            p.rw_a_up + (size_t)lp * 2 * 64 * 512, p.rw_g_up + (size_t)lp * 128 * 512, p.rw_k_k + lp * 512, p.rw_k_a + lp * 512, p.rw_r_k + lp * 512, bf, t, (LAS float*)lds); } PHASE_END
      PHASE_BEGIN_K(4) for (int u = bid * 8 + (mk::otid() >> 6); u < rw::NCHAIN * rw::NCH; u += nb * 8) rw::scan_unit(bf, p.rw_k_a + lp * 512, u / rw::NCH, u % rw::NCH, (LAS float*)lds + (mk::otid() >> 6) * 320); PHASE_END
      PHASE_BEGIN_K(5) for (int c = bid; c < rw::NCHAIN; c += nb) rw::propagate_chain(bf, c, (LAS float*)lds); PHASE_END
      PHASE_BEGIN_K(6) for (int u = bid * 8 + (mk::otid() >> 6); u < rw::NCHAIN * (rw::NCH - 1); u += nb * 8) rw::corr_unit(bf, u / (rw::NCH - 1), 1 + u % (rw::NCH - 1)); PHASE_END
      PHASE_BEGIN_K(7) for (int r = bid * 8; r < NTOK; r += nb * 8) rw::finish_rows<8>(bf, p.rw_gn_g + lp * 512, p.rw_gn_b + lp * 512, UO, r); PHASE_END
      PHASE_BEGIN_K(8) { SchedOut S{UO, wsp<bf16_t>(p, WS_WEOUT) + (size_t)lp * D * D, Ybuf, nb, bid}; pg8::gemm_phase(lds, D, S, pg8::EpiStoreBf16{}); __syncthreads(); cvt_experts(p, l, (LAS float*)lds, 528 - 2 * nb > 0 ? 528 - 2 * nb : 0); } PHASE_END
      PHASE_BEGIN_K(9) phase_ln1(p, l, Ybuf, lds, dry); PHASE_END
      PHASE_BEGIN_K(10) phase_scatter(p, l, lds); PHASE_END
      PHASE_BEGIN_K(11) { LAS int* mo = (LAS int*)(lds + LDS_MISC); { const int tq = mk::otid(); if (tq < 17) mo[tq] = wsp<int>(p, WS_MOFF)[l * 64 + tq]; } __syncthreads();
        SchedMoe S{(bf16_t*)(scr + SM_XS), wsp<bf16_t>(p, WS_WGU), (bf16_t*)(scr + SM_HE), mo, D, DE, 128, nb, bid}; pg8::gemm_phase(lds, D, S, EpiGateUp{}); } PHASE_END
      PHASE_BEGIN_K(12) { LAS int* mo = (LAS int*)(lds + LDS_MISC); { const int tq = mk::otid(); if (tq < 17) mo[tq] = wsp<int>(p, WS_MOFF)[l * 64 + tq]; } __syncthreads();
        SchedMoe S{(bf16_t*)(scr + SM_HE), wsp<bf16_t>(p, WS_WDN), (bf16_t*)(scr + SM_YS), mo, DE, D, 256, nb, bid}; pg8::gemm_phase(lds, DE, S, pg8::EpiStoreBf16{}); } PHASE_END
      PHASE_BEGIN_K(13) phase_ln2(p, l, dry); PHASE_END
    }
    {
      const int l = 2 * lp + 1; const bool last = l == DEPTH - 1;
      bf16_t* Pqk = (bf16_t*)(scr + SO_PQK); bf16_t* Vt = (bf16_t*)(scr + SO_VT); bf16_t* O12 = (bf16_t*)(scr + SO_O12); bf16_t* Ybuf = (bf16_t*)(scr + SO_YBUF);
      PHASE_BEGIN_K(14) { SchedOddIn S{UO, wsp<bf16_t>(p, WS_WOIN) + (size_t)lp * ODD_IN * D, Pqk, Vt, nb, bid}; pg8::gemm_phase(lds, D, S, EpiOddIn{wsp<float>(p, WS_ROPE)}); } PHASE_END
      PHASE_BEGIN_K(15) for (int u = bid; u < 2048 + (last ? 0 : 64); u += nb) { int b, hh, q0, nlat;
        if (u < 2048) { b = u >> 9; hh = (u >> 5) & 15; q0 = b * T + (u & 31) * 256; nlat = T; } else { const int v = u - 2048; b = v >> 4; hh = v & 15; q0 = NLAT + b * L; nlat = 0; }
        att::diff_attn_unit(Pqk, Vt, O12, hh, q0, b * T, nlat, NLAT + b * L, lds); } PHASE_END
      PHASE_BEGIN_K(16) { float d1 = 0.f, d2 = 0.f; for (int i = 0; i < 64; ++i) { d1 += p.da_lq1[lp * 64 + i] * p.da_lk1[lp * 64 + i]; d2 += p.da_lq2[lp * 64 + i] * p.da_lk2[lp * 64 + i]; }
        const float li = 0.8f - 0.6f * expf(-0.3f * (float)l), lam = expf(d1) - expf(d2) + li;
        const int tq = mk::otid(); for (int r4 = bid; r4 < (last ? NLAT : NTOK) / 4; r4 += nb) att::diff_combine_rows4(O12, p.da_subln_g + lp * 128, lam, 1.0f - li, UO, r4 * 4, tq >> 6, tq & 63); } PHASE_END
      PHASE_BEGIN_K(17) { SchedOut S{UO, wsp<bf16_t>(p, WS_WOOUT) + (size_t)lp * D * D, Ybuf, nb, bid}; pg8::gemm_phase(lds, D, S, pg8::EpiStoreBf16{}); __syncthreads(); cvt_experts(p, l, (LAS float*)lds, 528 - 2 * nb > 0 ? 528 - 2 * nb : 0); } PHASE_END
      PHASE_BEGIN_K(18) phase_ln1(p, l, Ybuf, lds, dry); PHASE_END
      PHASE_BEGIN_K(19) phase_scatter(p, l, lds); PHASE_END
      PHASE_BEGIN_K(20) { LAS int* mo = (LAS int*)(lds + LDS_MISC); { const int tq = mk::otid(); if (tq < 17) mo[tq] = wsp<int>(p, WS_MOFF)[l * 64 + tq]; } __syncthreads();
        SchedMoe S{(bf16_t*)(scr + SM_XS), wsp<bf16_t>(p, WS_WGU), (bf16_t*)(scr + SM_HE), mo, D, DE, 128, nb, bid}; pg8::gemm_phase(lds, D, S, EpiGateUp{}); } PHASE_END
      PHASE_BEGIN_K(21) { LAS int* mo = (LAS int*)(lds + LDS_MISC); { const int tq = mk::otid(); if (tq < 17) mo[tq] = wsp<int>(p, WS_MOFF)[l * 64 + tq]; } __syncthreads();
        SchedMoe S{(bf16_t*)(scr + SM_HE), wsp<bf16_t>(p, WS_WDN), (bf16_t*)(scr + SM_YS), mo, DE, D, 256, nb, bid}; pg8::gemm_phase(lds, DE, S, pg8::EpiStoreBf16{}); } PHASE_END
      PHASE_BEGIN_K(22) phase_ln2(p, l, dry); PHASE_END
    }
  }
#undef PHASE_BEGIN_K
#undef PHASE_END
}
}

#ifndef MK_SINGLE_LAUNCH
#define MK_SINGLE_LAUNCH 1
#endif
extern "C" void kernel_launch(void* const* d_in, const int* in_sizes, int n_in, void* d_out, int out_size, void* d_ws, size_t ws_size, hipStream_t stream) {
  using namespace mk;
  static int grid = 0;
  if (grid == 0) {
    if (n_in != 34 || out_size != NLAT * D || ws_size < WS_END) { fprintf(stderr, "kernel_launch: unexpected shapes (n_in %d out %d ws %zu need %zu)\n", n_in, out_size, ws_size, (size_t)WS_END); grid = -1; return; }
    if (hipFuncSetAttribute((const void*)mega, hipFuncAttributeMaxDynamicSharedMemorySize, LDS_BYTES) != hipSuccess) { grid = -1; return; }
    int dev = 0, cus = 0, per_cu = 0;
    if (hipGetDevice(&dev) != hipSuccess || hipDeviceGetAttribute(&cus, hipDeviceAttributeMultiprocessorCount, dev) != hipSuccess) { grid = -1; return; }
    if (hipOccupancyMaxActiveBlocksPerMultiprocessor(&per_cu, (const void*)mega, NTHR, LDS_BYTES) != hipSuccess || per_cu < 1) { fprintf(stderr, "kernel_launch: occupancy query says %d\n", per_cu); }
    (void)hipGetLastError();
    grid = cus;
  }
  if (grid < 0) return;
  (void)hipMemsetAsync((char*)d_ws + WS_BAR, 0, (size_t)XCD_BAR_WORDS * 4, stream);
  Params p{};
  const float** pp = (const float**)&p;
  for (int i = 0; i < 34; ++i) pp[i] = (const float*)d_in[i];
  p.out = (float*)d_out; p.ws = (unsigned char*)d_ws;
#if MK_SINGLE_LAUNCH
  p.ph_lo = 0; p.ph_hi = N_PHASES;
  hipLaunchKernelGGL(mega, dim3(grid), dim3(NTHR), LDS_BYTES, stream, p);
#else
  for (int ph = 0; ph < N_PHASES; ++ph) { p.ph_lo = ph; p.ph_hi = ph + 1; hipLaunchKernelGGL(mega, dim3(grid), dim3(NTHR), LDS_BYTES, stream, p); }
#endif
}
```

```cpp
#include <hip/hip_runtime.h>
#include <stdint.h>
#include <stdio.h>

typedef unsigned short bf16_t;
typedef short bf16x8 __attribute__((ext_vector_type(8)));
typedef float f32x4 __attribute__((ext_vector_type(4)));
typedef float f32x2 __attribute__((ext_vector_type(2)));
typedef float f32x16 __attribute__((ext_vector_type(16)));
typedef unsigned u32x4 __attribute__((ext_vector_type(4)));
typedef unsigned u32x2 __attribute__((ext_vector_type(2)));
#define LAS __attribute__((address_space(3)))

namespace mk {
constexpr int B = 4, T = 8192, L = 256, D = 1024, NLAT = B * T, NCTX = B * L, NTOK = NLAT + NCTX;
constexpr int DEPTH = 4, EVEN_IN = 3328, ODD_IN = 3072, RW_OFF = 1536, RW_IN = 1792, NE = 16, DE = 512;
constexpr float ALPHA = 1.681792830507429f, LN_EPS = 1e-5f;
constexpr int NTHR = 512, LDS_BYTES = 147456;
constexpr int MOE_TILES = 280, MOE_ROWS = MOE_TILES * 256;

__device__ __forceinline__ unsigned cvt_pk_bf16(float lo, float hi) { unsigned r; asm volatile("v_cvt_pk_bf16_f32 %0, %1, %2" : "=v"(r) : "v"(lo), "v"(hi)); return r; }
__device__ __forceinline__ float bf2f(bf16_t b) { return __uint_as_float(((unsigned)b) << 16); }
__device__ __forceinline__ float bflo(unsigned w) { return __uint_as_float(w << 16); }
__device__ __forceinline__ float bfhi(unsigned w) { return __uint_as_float(w & 0xffff0000u); }
__device__ __forceinline__ bf16_t f2bf(float f) { return (bf16_t)(cvt_pk_bf16(f, 0.f) & 0xffffu); }
__device__ __forceinline__ float sigmoidf_(float x) { return 1.0f / (1.0f + __expf(-x)); }
__device__ __forceinline__ float siluf_(float x) { return x / (1.0f + __expf(-x)); }
__device__ __forceinline__ float wave_sum(float v) {
#pragma unroll
  for (int o = 32; o > 0; o >>= 1) v += __shfl_xor(v, o);
  return v;
}
template <int CTRL, int RM, int BM> __device__ __forceinline__ float dpp_mov(float old, float v) { return __int_as_float(__builtin_amdgcn_update_dpp(__float_as_int(old), __float_as_int(v), CTRL, RM, BM, false)); }
__device__ __forceinline__ float wave_sum_u(float v) {
  v += dpp_mov<0xB1, 0xf, 0xf>(v, v);
  v += dpp_mov<0x4E, 0xf, 0xf>(v, v);
  v += dpp_mov<0x141, 0xf, 0xf>(v, v);
  v += dpp_mov<0x140, 0xf, 0xf>(v, v);
  v += dpp_mov<0x142, 0xa, 0xf>(0.f, v);
  v += dpp_mov<0x143, 0xc, 0xf>(0.f, v);
  return __int_as_float(__builtin_amdgcn_readlane(__float_as_int(v), 63));
}
__device__ __forceinline__ float wave_max_u(float v) {
  v = fmaxf(v, dpp_mov<0xB1, 0xf, 0xf>(v, v));
  v = fmaxf(v, dpp_mov<0x4E, 0xf, 0xf>(v, v));
  v = fmaxf(v, dpp_mov<0x141, 0xf, 0xf>(v, v));
  v = fmaxf(v, dpp_mov<0x140, 0xf, 0xf>(v, v));
  v = fmaxf(v, dpp_mov<0x142, 0xa, 0xf>(0.f, v));
  v = fmaxf(v, dpp_mov<0x143, 0xc, 0xf>(0.f, v));
  return __int_as_float(__builtin_amdgcn_readlane(__float_as_int(v), 63));
}
__device__ __forceinline__ f32x16 zero16() { float z = 0.f; asm volatile("" : "+v"(z)); f32x16 r;
#pragma unroll
  for (int i = 0; i < 16; ++i) r[i] = z;
  return r; }
__device__ __forceinline__ int otid() { int t = threadIdx.x; asm volatile("" : "+v"(t)); return t; }
__device__ __forceinline__ int obid() { int b = blockIdx.x; asm volatile("" : "+s"(b)); return b; }
__device__ __forceinline__ int bidx_of_row(int row) { return row < NLAT ? row / T : 4; }
}

#include <vector>

#define XB_TMO      128
#define XB_XCNT(j)  (256  + 64 * (j))
#define XB_XSUB(j)  (1280 + 64 * (j))
#define XB_XGEN(j)  (2304 + 64 * (j))
#define XB_TOP      3328
#define XB_TOPGEN   3392
#define XCD_BAR_WORDS 3456
#define XB_SPIN_CAP (1u << 18)
#define LAS __attribute__((address_space(3)))

__device__ __forceinline__ unsigned xb_ld(unsigned* p)              { return __hip_atomic_load(p, __ATOMIC_RELAXED, __HIP_MEMORY_SCOPE_AGENT); }
__device__ __forceinline__ unsigned xb_add(unsigned* p, unsigned v) { return __hip_atomic_fetch_add(p, v, __ATOMIC_RELAXED, __HIP_MEMORY_SCOPE_AGENT); }
__device__ __forceinline__ unsigned xb_xcc_id() { return (unsigned)__builtin_amdgcn_s_getreg((3 << 11) | 20) & 0xFu; }
#define XB_SPIN(cond, bar) do { unsigned _sp = 0; while (cond) { __builtin_amdgcn_s_sleep(1); \
    if ((++_sp & 255u) == 0u) { if (xb_ld(&(bar)[XB_TMO])) break; if (_sp > XB_SPIN_CAP) { atomicAdd(&(bar)[XB_TMO], 1u); break; } } } } while (0)

struct XcdBarrier {
    unsigned* bar; unsigned x;
    volatile LAS unsigned* st;
};

__device__ __forceinline__ XcdBarrier xcd_barrier_post(unsigned* bar, volatile LAS unsigned* st) {
    XcdBarrier b; b.bar = bar; b.x = xb_xcc_id(); b.st = st;
    if (threadIdx.x == 0) (void)xb_add(&bar[XB_XCNT(b.x)], 1u);
    return b;
}
__device__ __forceinline__ void xcd_barrier_complete(unsigned* bar, unsigned x, unsigned& nloc, unsigned& nx) {
    const unsigned G = gridDim.x * gridDim.y * gridDim.z;
    unsigned sum, cnt, mine, sp = 0u;
    for (;;) {
        sum = 0u; cnt = 0u; mine = 0u;
#pragma unroll
        for (unsigned j = 0; j < 16; ++j) { const unsigned c = xb_ld(&bar[XB_XCNT(j)]); sum += c; cnt += (c > 0u) ? 1u : 0u; mine = (j == x) ? c : mine; }
        if (sum == G) break;
        __builtin_amdgcn_s_sleep(1);
        if ((++sp & 255u) == 0u) { if (xb_ld(&bar[XB_TMO])) break; if (sp > XB_SPIN_CAP) { atomicAdd(&bar[XB_TMO], 1u); break; } }
    }
    nloc = mine > 0u ? mine : 1u; nx = cnt > 0u ? cnt : 1u;
}

__device__ __forceinline__ void xcd_barrier(const XcdBarrier& b) {
    asm volatile("s_waitcnt vmcnt(0)" ::: "memory");
    __syncthreads();
    if (threadIdx.x == 0) {
        unsigned* bar = b.bar;
        __builtin_amdgcn_s_waitcnt(0);
        unsigned nloc = b.st[0], nx = b.st[1];
        if (nloc == 0u) { xcd_barrier_complete(bar, b.x, nloc, nx); b.st[0] = nloc; b.st[1] = nx; }
        const unsigned old = xb_add(&bar[XB_XSUB(b.x)], 1u);
        const unsigned gen = old / nloc;
        if (old + 1u == (gen + 1u) * nloc) {
            __builtin_amdgcn_fence(__ATOMIC_RELEASE, "agent");
            asm volatile("s_waitcnt vmcnt(0)" ::: "memory");
            const unsigned og = xb_add(&bar[XB_TOP], 1u);
            const unsigned tg = og / nx;
            if (og + 1u == (tg + 1u) * nx) xb_add(&bar[XB_TOPGEN], 1u);
            else XB_SPIN(xb_ld(&bar[XB_TOPGEN]) == tg, bar);
            __builtin_amdgcn_fence(__ATOMIC_ACQUIRE, "agent");
            xb_add(&bar[XB_XGEN(b.x)], 1u);
            asm volatile("s_waitcnt vmcnt(0)" ::: "memory");
        } else {
            XB_SPIN(xb_ld(&bar[XB_XGEN(b.x)]) == gen, bar);
            __builtin_amdgcn_fence(__ATOMIC_ACQUIRE, "agent");
            asm volatile("s_waitcnt vmcnt(0)" ::: "memory");
        }
    }
    __syncthreads();
}

namespace pg8 {
using mk::cvt_pk_bf16;
constexpr int BM = 256, BK = 64, HALF = 128, HTB = HALF * BK * 2  , STAGE_BYTES = 8 * HTB;
__host__ __device__ __forceinline__ int lds_byte(int r, int c) { const int st = (r >> 4) * 2 + (c >> 5), rr = r & 15, cc = c & 31, ob = rr * 64 + cc * 2; return st * 1024 + (ob ^ (((ob >> 9) & 1) << 5)); }
__host__ __device__ __forceinline__ void stage_rc(int b, int& R, int& C) { const int st = b / 1024, sb = b % 1024, swz = sb ^ (((sb >> 9) & 1) << 5); R = (st >> 1) * 16 + swz / 64; C = (st & 1) * 32 + (swz % 64) / 2; }
__host__ __device__ __forceinline__ int perm32(int rho) { const int n = rho >> 4, i = rho & 15; return 8 * (i >> 2) + 4 * n + (i & 3); }

struct Unit { const char* A; const char* Bt; bf16_t* out; int pm, pn, x0, x1, ldo, kind; };

template <class Epi, class Sched>
__device__ __forceinline__ void gemm_phase(LAS unsigned char* lds, const int K, const Sched& S, const Epi& E) {
    const int tid = mk::otid(), wid = __builtin_amdgcn_readfirstlane(tid >> 6), lane = tid & 63, wr = wid >> 2, wc = wid & 3, fr = lane & 15, fq = lane >> 4;
    const int nt = K / BK;
    unsigned voffA[2], voffB[2];
#pragma unroll
    for (int i = 0; i < 2; ++i) { int R, C; stage_rc(tid * 16 + i * 8192, R, C); const int Rb = Epi::PERM ? ((R & ~31) + perm32(R & 31)) : R;
        voffA[i] = (unsigned)(R * K + C) * 2u; voffB[i] = (unsigned)(Rb * K + C) * 2u; }
    const size_t kstep = (size_t)(BK * 2);
    const size_t hstep = (size_t)HALF * K * 2;
    const unsigned ldsw = (unsigned)wid * 1024u;
    const int aoff = lds_byte(wr * 64 + fr, fq * 8), boff = lds_byte(wc * 32 + fr, fq * 8);
#define PG8_SA(b, h) (((b) * 2 + (h)) * HTB)
#define PG8_SB(b, h) ((4 + (b) * 2 + (h)) * HTB)
#define PG8_STAGE(bufoff, gbase, voff) do { _Pragma("unroll") for (int _i = 0; _i < 2; ++_i) \
        __builtin_amdgcn_global_load_lds((const unsigned*)((const char*)(gbase) + (voff)[_i]), (LAS unsigned*)(lds + (bufoff) + ldsw + _i * 8192), 16, 0, 0); } while (0)
#define PG8_LDA(dst, b, h) do { _Pragma("unroll") for (int m = 0; m < 4; ++m) _Pragma("unroll") for (int k = 0; k < 2; ++k) dst[m][k] = *(const LAS bf16x8*)(lds + PG8_SA(b, h) + aoff + m * 2048 + k * 1024); } while (0)
#define PG8_LDB(dst, b, h) do { _Pragma("unroll") for (int n = 0; n < 2; ++n) _Pragma("unroll") for (int k = 0; k < 2; ++k) dst[n][k] = *(const LAS bf16x8*)(lds + PG8_SB(b, h) + boff + n * 2048 + k * 1024); } while (0)
#define PG8_MMA(ai, bj, At, Bt) do { __builtin_amdgcn_s_setprio(1); _Pragma("unroll") for (int m = 0; m < 4; ++m) _Pragma("unroll") for (int n = 0; n < 2; ++n) _Pragma("unroll") for (int k = 0; k < 2; ++k) \
        acc[ai][bj][m][n] = __builtin_amdgcn_mfma_f32_16x16x32_bf16(Bt[n][k], At[m][k], acc[ai][bj][m][n], 0, 0, 0); __builtin_amdgcn_s_setprio(0); } while (0)
#define PG8_WAIT_V(n) asm volatile("s_waitcnt vmcnt(" #n ")" ::: "memory")
#define PG8_WAIT_L(n) asm volatile("s_waitcnt lgkmcnt(" #n ")" ::: "memory")
#define PG8_BAR __builtin_amdgcn_s_barrier()
#define PG8_SCHED __builtin_amdgcn_sched_barrier(0)
    Unit cur, nxt; int ui = 0;
    if (!S.next(0, cur)) return;
    f32x4 acc[2][2][4][2];
#pragma unroll
    for (int a = 0; a < 2; ++a)
#pragma unroll
        for (int b = 0; b < 2; ++b)
#pragma unroll
            for (int m = 0; m < 4; ++m)
#pragma unroll
                for (int n = 0; n < 2; ++n) acc[a][b][m][n] = (f32x4){0.f, 0.f, 0.f, 0.f};
    bf16x8 At[4][2], B0[2][2], B1[2][2];
    const char* cA = cur.A; const char* cB = cur.Bt;
    PG8_STAGE(PG8_SB(0, 0), cB, voffB); PG8_STAGE(PG8_SA(0, 0), cA, voffA); PG8_STAGE(PG8_SB(0, 1), cB + hstep, voffB); PG8_STAGE(PG8_SA(0, 1), cA + hstep, voffA);
    if (wr == 1) PG8_BAR;
    PG8_WAIT_V(4); PG8_BAR;
    PG8_STAGE(PG8_SB(1, 0), cB + kstep, voffB); PG8_STAGE(PG8_SA(1, 0), cA + kstep, voffA); PG8_STAGE(PG8_SB(1, 1), cB + hstep + kstep, voffB);
    PG8_WAIT_V(6); PG8_BAR;
    for (;;) {
        const bool has_next = S.next(ui + 1, nxt);
        const char* nA = has_next ? nxt.A : cA; const char* nB = has_next ? nxt.Bt : cB;
        for (int t = 0; t < nt; t += 2) {
            const bool last = (t == nt - 2);
            const char* a1 = cA + (size_t)(t + 1) * kstep;
            const char* a2 = last ? nA : cA + (size_t)(t + 2) * kstep; const char* b2 = last ? nB : cB + (size_t)(t + 2) * kstep;
            const char* a3 = a2 + kstep; const char* b3 = b2 + kstep;
            PG8_LDB(B0, 0, 0); PG8_SCHED; PG8_LDA(At, 0, 0); PG8_STAGE(PG8_SA(1, 1), a1 + hstep, voffA);
            PG8_WAIT_L(8); PG8_BAR; PG8_WAIT_L(0); PG8_MMA(0, 0, At, B0); PG8_BAR; PG8_SCHED;
            PG8_LDB(B1, 0, 1); PG8_STAGE(PG8_SB(0, 0), b2, voffB);
            PG8_BAR; PG8_WAIT_L(0); PG8_MMA(0, 1, At, B1); PG8_BAR;
            PG8_LDA(At, 0, 1); PG8_STAGE(PG8_SA(0, 0), a2, voffA);
            PG8_BAR; PG8_WAIT_L(0); PG8_MMA(1, 0, At, B0); PG8_BAR; PG8_SCHED;
            PG8_STAGE(PG8_SB(0, 1), b2 + hstep, voffB);
            PG8_WAIT_V(6); PG8_BAR; PG8_MMA(1, 1, At, B1); PG8_BAR;
            PG8_LDB(B0, 1, 0); PG8_SCHED; PG8_LDA(At, 1, 0); PG8_STAGE(PG8_SA(0, 1), a2 + hstep, voffA);
            PG8_WAIT_L(8); PG8_BAR; PG8_WAIT_L(0); PG8_MMA(0, 0, At, B0); PG8_BAR; PG8_SCHED;
            PG8_LDB(B1, 1, 1); PG8_STAGE(PG8_SB(1, 0), b3, voffB);
            PG8_BAR; PG8_WAIT_L(0); PG8_MMA(0, 1, At, B1); PG8_BAR;
            PG8_LDA(At, 1, 1); PG8_STAGE(PG8_SA(1, 0), a3, voffA);
            PG8_BAR; PG8_WAIT_L(0); PG8_MMA(1, 0, At, B0); PG8_BAR; PG8_SCHED;
            PG8_STAGE(PG8_SB(1, 1), b3 + hstep, voffB);
            PG8_WAIT_V(6); PG8_BAR; PG8_MMA(1, 1, At, B1); PG8_BAR;
        }
        E(acc, cur, wr, wc, fr, fq);
        if (!has_next) break;
#pragma unroll
        for (int a = 0; a < 2; ++a)
#pragma unroll
            for (int b = 0; b < 2; ++b)
#pragma unroll
                for (int m = 0; m < 4; ++m)
#pragma unroll
                    for (int n = 0; n < 2; ++n) acc[a][b][m][n] = (f32x4){0.f, 0.f, 0.f, 0.f};
        cur = nxt; cA = nA; cB = nB; ++ui;
    }
    PG8_WAIT_V(0);
    if (wr == 0) PG8_BAR;
    PG8_BAR;
#undef PG8_SA
#undef PG8_SB
#undef PG8_STAGE
#undef PG8_LDA
#undef PG8_LDB
#undef PG8_MMA
#undef PG8_WAIT_V
#undef PG8_WAIT_L
#undef PG8_BAR
#undef PG8_SCHED
}

struct EpiStoreBf16 {
    static constexpr bool PERM = true;
    __device__ __forceinline__ void operator()(const f32x4 (&acc)[2][2][4][2], const Unit& u, int wr, int wc, int fr, int fq) const {
        bf16_t* O = u.out; const int ldc = u.ldo;
        const int row0 = u.x0 + wr * 64 + fr, col0 = u.x1 + wc * 32 + 8 * fq;
#pragma unroll
        for (int ai = 0; ai < 2; ++ai)
#pragma unroll
            for (int m = 0; m < 4; ++m) { bf16_t* rowp = O + (size_t)(row0 + ai * HALF + m * 16) * ldc + col0;
#pragma unroll
                for (int bj = 0; bj < 2; ++bj) { const f32x4 v0 = acc[ai][bj][m][0], v1 = acc[ai][bj][m][1];
                    u32x4 w; w.x = cvt_pk_bf16(v0[0], v0[1]); w.y = cvt_pk_bf16(v0[2], v0[3]); w.z = cvt_pk_bf16(v1[0], v1[1]); w.w = cvt_pk_bf16(v1[2], v1[3]);
                    *(u32x4*)(rowp + bj * HALF) = w; } }
    }
};
}

namespace mk {
struct NMapId { int off; __device__ __forceinline__ int operator()(int n) const { return n + off; } __device__ __forceinline__ float scl(int) const { return 1.0f; } };
struct NMapInterleave { int which; __device__ __forceinline__ int operator()(int n) const { return 2 * n + which; } __device__ __forceinline__ float scl(int) const { return 1.0f; } };
struct NMapRope { __device__ __forceinline__ int operator()(int n) const { if (n >= 2048) return n; const int ch = n >> 6, c = n & 63, half = c >> 5, w = c & 31, z = w >> 4, i = w & 15; return ch * 64 + half * 32 + 2 * i + z; }
  __device__ __forceinline__ float scl(int n) const { return n < 1024 ? 0.125f * 1.4426950408889634f : 1.0f; } };

template <class NMap>
__device__ __forceinline__ void cvt_tile(const float* __restrict__ src, int ldsrc, int K, bf16_t* __restrict__ dst, int k0, int n0, const NMap& nmap, LAS float* tile) {
  const int t = mk::otid();
  { const int k = t >> 3, c = (t & 7) * 8; const float* p = src + (size_t)(k0 + k) * ldsrc + n0 + c;
    const f32x4 a = *(const f32x4*)p, b = *(const f32x4*)(p + 4);
    LAS float* q = tile + k * 65 + c; q[0] = a[0]; q[1] = a[1]; q[2] = a[2]; q[3] = a[3]; q[4] = b[0]; q[5] = b[1]; q[6] = b[2]; q[7] = b[3]; }
  __syncthreads();
  { const int n = t >> 3, kc = (t & 7) * 8; const LAS float* q = tile + kc * 65 + n; const float sc = nmap.scl(n0 + n);
    u32x4 w; w.x = cvt_pk_bf16(q[0] * sc, q[65] * sc); w.y = cvt_pk_bf16(q[130] * sc, q[195] * sc); w.z = cvt_pk_bf16(q[260] * sc, q[325] * sc); w.w = cvt_pk_bf16(q[390] * sc, q[455] * sc);
    *(u32x4*)(dst + (size_t)nmap(n0 + n) * K + k0 + kc) = w; }
  __syncthreads();
}
template <class NMap>
__device__ __forceinline__ int cvt_matrix(const float* src, int ldsrc, int K, int N, bf16_t* dst, const NMap& nmap, LAS float* tile, int ubase, int bid, int nblk) {
  const int nkt = K / 64, nnt = N / 64, tot = nkt * nnt;
  int first = ubase + ((bid - ubase % nblk) + nblk) % nblk;
  for (int u = first; u < ubase + tot; u += nblk) { const int v = u - ubase; cvt_tile(src, ldsrc, K, dst, (v / nnt) * 64, (v % nnt) * 64, nmap, tile); }
  return tot;
}
}

namespace att {
using namespace mk;
constexpr int KB_BYTES = 64 * 128, VB_BYTES = 128 * 128, DA_LDS = 2 * (KB_BYTES + VB_BYTES);
__device__ __forceinline__ int pi32(int r) { return (r & ~12) | ((r & 4) << 1) | ((r & 8) >> 1); }
__device__ __forceinline__ int swz(int row, int chunk) { return row * 128 + ((chunk ^ ((row >> 1) & 7)) << 4); }
__device__ __forceinline__ int crow(int r, int hi) { return (r & 3) + 8 * (r >> 2) + 4 * hi; }

__device__ __forceinline__ float sumsq8(u32x4 w) { return (bflo(w.x) * bflo(w.x) + bfhi(w.x) * bfhi(w.x)) + (bflo(w.y) * bflo(w.y) + bfhi(w.y) * bfhi(w.y)) + (bflo(w.z) * bflo(w.z) + bfhi(w.z) * bfhi(w.z)) + (bflo(w.w) * bflo(w.w) + bfhi(w.w) * bfhi(w.w)); }
__device__ __forceinline__ void knorm_group(const bf16_t* __restrict__ Pqk, float* __restrict__ KN, int g, LAS float* red) {
  const int tid = mk::otid(), wid = tid >> 6, lane = tid & 63;
  float mx = 0.f;
  for (int i0 = 0; i0 < 160; i0 += 32) {
    u32x4 a[4], b[4];
#pragma unroll
    for (int j = 0; j < 4; ++j) { int i = i0 + j * 8 + wid; i = i < 132 ? i : wid; const int row = i < 128 ? g * 128 + i : NLAT + g * 4 + (i - 128);
      const bf16_t* kp = Pqk + (size_t)row * 2048 + 1024 + lane * 16; a[j] = *(const u32x4*)kp; b[j] = *(const u32x4*)(kp + 8); }
#pragma unroll
    for (int j = 0; j < 4; ++j) { float s = sumsq8(a[j]) + sumsq8(b[j]); s += dpp_mov<0xB1, 0xf, 0xf>(s, s); s += dpp_mov<0x4E, 0xf, 0xf>(s, s); mx = fmaxf(mx, s); }
  }
  if ((lane & 3) == 0) red[wid * 16 + (lane >> 2)] = mx;
  __syncthreads();
  if (tid < 16) { float m = red[tid];
#pragma unroll
    for (int w = 1; w < 8; ++w) m = fmaxf(m, red[w * 16 + tid]);
    KN[g * 16 + tid] = m; }
  __syncthreads();
}
__device__ __forceinline__ float kmax2_of(const float* __restrict__ KN, int b, int hh) {
  return wave_max_u(KN[(b * 64 + (mk::otid() & 63)) * 16 + hh]);
}

__device__ __forceinline__ void diff_attn_unit(const bf16_t* __restrict__ Pqk, const bf16_t* __restrict__ Vt, bf16_t* __restrict__ O12, int hh, int q0, int klat0, int nlat, int kctx0, float kmax2, LAS unsigned char* lds) {
  const int tid = mk::otid(), wid = tid >> 6, lane = tid & 63, r = lane & 31, hi = lane >> 5;
  const int NT = (nlat + L) / 64, NTL = nlat / 64;
  const int srow = tid >> 3, sch = tid & 7;
  const bf16_t* kbase = Pqk + 1024 + hh * 64 + sch * 8;
  const bf16_t* vbase = Vt + (size_t)((hh >> 1) * 128 + srow) * NTOK + sch * 8;
  const int kdst = swz(srow, sch), vdst0 = swz(srow, sch), vdst1 = swz(srow + 64, sch);
  bf16x8 qf[4];
  { const bf16_t* qp = Pqk + (size_t)(q0 + wid * 32 + r) * 2048 + hh * 64 + hi * 8;
#pragma unroll
    for (int ks = 0; ks < 4; ++ks) qf[ks] = *(const bf16x8*)(qp + ks * 16); }
  int kaddr[2];
#pragma unroll
  for (int kb = 0; kb < 2; ++kb) kaddr[kb] = (kb * 32 + pi32(r)) * 128;
  const int kx = (pi32(r) >> 1) & 7;
  const int vx = (r >> 1) & 7;
  f32x16 o[4];
#pragma unroll
  for (int vb = 0; vb < 4; ++vb)
#pragma unroll
    for (int i = 0; i < 16; ++i) o[vb][i] = 0.f;
  float l_run = 0.f;
  u32x4 kreg, vreg0, vreg1;
#define DA_LOAD(t) do { const int tok = (t) < NTL ? klat0 + (t) * 64 : kctx0 + ((t) - NTL) * 64; \
    kreg = *(const u32x4*)(kbase + (size_t)(tok + srow) * 2048); vreg0 = *(const u32x4*)(vbase + tok); vreg1 = *(const u32x4*)(vbase + (size_t)64 * NTOK + tok); } while (0)
#define DA_WRITE(bufi) do { LAS unsigned char* kb_ = lds + (bufi) * KB_BYTES; LAS unsigned char* vb_ = lds + 2 * KB_BYTES + (bufi) * VB_BYTES; \
    *(LAS u32x4*)(kb_ + kdst) = kreg; *(LAS u32x4*)(vb_ + vdst0) = vreg0; *(LAS u32x4*)(vb_ + vdst1) = vreg1; } while (0)
  float qn2 = 0.f;
#pragma unroll
  for (int ks = 0; ks < 4; ++ks) { const u32x4 w = __builtin_bit_cast(u32x4, qf[ks]);
    qn2 += bflo(w.x) * bflo(w.x) + bfhi(w.x) * bfhi(w.x) + bflo(w.y) * bflo(w.y) + bfhi(w.y) * bfhi(w.y) + bflo(w.z) * bflo(w.z) + bfhi(w.z) * bfhi(w.z) + bflo(w.w) * bflo(w.w) + bfhi(w.w) * bfhi(w.w); }
  { const u32x2 sw = __builtin_amdgcn_permlane32_swap(__float_as_uint(qn2), __float_as_uint(qn2), false, false); qn2 = __uint_as_float(sw.x) + __uint_as_float(sw.y); }
  const float m_stat = sqrtf(qn2 * kmax2) * 1.0001f;
  const bool use_static = __all(m_stat <= 60.0f);
  DA_LOAD(0); DA_WRITE(0); __syncthreads();
#define DA_KFRAG(ks) const int ch = (((ks) * 2 + hi) ^ kx) << 4; const bf16x8 a0 = *(const LAS bf16x8*)(kb_ + kaddr[0] + ch), a1 = *(const LAS bf16x8*)(kb_ + kaddr[1] + ch)
#define DA_VFRAGS() bf16x8 va[4][4]; \
    _Pragma("unroll") for (int vb = 0; vb < 4; ++vb) { const LAS unsigned char* vrow = vb_ + (vb * 32 + r) * 128; \
      _Pragma("unroll") for (int c4 = 0; c4 < 4; ++c4) va[vb][c4] = *(const LAS bf16x8*)(vrow + (((2 * c4 + hi) ^ vx) << 4)); }
#define DA_PACK_PV() bf16x8 pf[2][2]; \
    _Pragma("unroll") for (int s = 0; s < 2; ++s) { u32x4 w0, w1; \
      w0.x = cvt_pk_bf16(s0[8 * s + 0], s0[8 * s + 1]); w0.y = cvt_pk_bf16(s0[8 * s + 2], s0[8 * s + 3]); w0.z = cvt_pk_bf16(s0[8 * s + 4], s0[8 * s + 5]); w0.w = cvt_pk_bf16(s0[8 * s + 6], s0[8 * s + 7]); \
      w1.x = cvt_pk_bf16(s1[8 * s + 0], s1[8 * s + 1]); w1.y = cvt_pk_bf16(s1[8 * s + 2], s1[8 * s + 3]); w1.z = cvt_pk_bf16(s1[8 * s + 4], s1[8 * s + 5]); w1.w = cvt_pk_bf16(s1[8 * s + 6], s1[8 * s + 7]); \
      pf[0][s] = __builtin_bit_cast(bf16x8, w0); pf[1][s] = __builtin_bit_cast(bf16x8, w1); } \
    _Pragma("unroll") for (int vb = 0; vb < 4; ++vb) _Pragma("unroll") for (int kb = 0; kb < 2; ++kb) _Pragma("unroll") for (int s = 0; s < 2; ++s) \
      o[vb] = __builtin_amdgcn_mfma_f32_32x32x16_bf16(va[vb][kb * 2 + s], pf[kb][s], o[vb], 0, 0, 0)
  if (use_static) {
    f32x16 negm;
#pragma unroll
    for (int i = 0; i < 16; ++i) negm[i] = -m_stat;
    for (int t = 0; t < NT; ++t) {
      const bool more = t + 1 < NT;
      if (more) DA_LOAD(t + 1);
      const LAS unsigned char* kb_ = lds + (t & 1) * KB_BYTES; const LAS unsigned char* vb_ = lds + 2 * KB_BYTES + (t & 1) * VB_BYTES;
      f32x16 s0, s1;
      { DA_KFRAG(0); s0 = __builtin_amdgcn_mfma_f32_32x32x16_bf16(a0, qf[0], negm, 0, 0, 0); s1 = __builtin_amdgcn_mfma_f32_32x32x16_bf16(a1, qf[0], negm, 0, 0, 0); }
#pragma unroll
      for (int ks = 1; ks < 4; ++ks) { DA_KFRAG(ks); s0 = __builtin_amdgcn_mfma_f32_32x32x16_bf16(a0, qf[ks], s0, 0, 0, 0); s1 = __builtin_amdgcn_mfma_f32_32x32x16_bf16(a1, qf[ks], s1, 0, 0, 0); }
      DA_VFRAGS();
      float ps = 0.f;
#pragma unroll
      for (int i = 0; i < 16; ++i) { s0[i] = __builtin_amdgcn_exp2f(s0[i]); ps += s0[i]; }
#pragma unroll
      for (int i = 0; i < 16; ++i) { s1[i] = __builtin_amdgcn_exp2f(s1[i]); ps += s1[i]; }
      l_run += ps;
      DA_PACK_PV();
      if (more) DA_WRITE((t + 1) & 1);
      __syncthreads();
    }
  } else {
    constexpr float THR = 8.0f * 1.4426950408889634f;
    float m_run = -1e30f;
    for (int t = 0; t < NT; ++t) {
      const bool more = t + 1 < NT;
      if (more) DA_LOAD(t + 1);
      const LAS unsigned char* kb_ = lds + (t & 1) * KB_BYTES; const LAS unsigned char* vb_ = lds + 2 * KB_BYTES + (t & 1) * VB_BYTES;
      f32x16 s0 = zero16(), s1 = zero16();
#pragma unroll
      for (int ks = 0; ks < 4; ++ks) { DA_KFRAG(ks); s0 = __builtin_amdgcn_mfma_f32_32x32x16_bf16(a0, qf[ks], s0, 0, 0, 0); s1 = __builtin_amdgcn_mfma_f32_32x32x16_bf16(a1, qf[ks], s1, 0, 0, 0); }
      DA_VFRAGS();
      float mx = fmaxf(s0[0], s1[0]);
#pragma unroll
      for (int i = 1; i < 16; ++i) mx = fmaxf(mx, fmaxf(s0[i], s1[i]));
      { const u32x2 sw = __builtin_amdgcn_permlane32_swap(__float_as_uint(mx), __float_as_uint(mx), false, false); mx = fmaxf(__uint_as_float(sw.x), __uint_as_float(sw.y)); }
      float alpha = 1.0f;
      if (!__all(mx - m_run <= THR)) {
        const float m_new = fmaxf(m_run, mx);
        alpha = __builtin_amdgcn_exp2f(m_run - m_new);
        m_run = m_new;
#pragma unroll
        for (int vb = 0; vb < 4; ++vb)
#pragma unroll
          for (int i = 0; i < 16; ++i) o[vb][i] *= alpha;
      }
      float ps = 0.f;
#pragma unroll
      for (int i = 0; i < 16; ++i) { s0[i] = __builtin_amdgcn_exp2f(s0[i] - m_run); ps += s0[i]; }
#pragma unroll
      for (int i = 0; i < 16; ++i) { s1[i] = __builtin_amdgcn_exp2f(s1[i] - m_run); ps += s1[i]; }
      l_run = l_run * alpha + ps;
      DA_PACK_PV();
      if (more) DA_WRITE((t + 1) & 1);
      __syncthreads();
    }
  }
#undef DA_KFRAG
#undef DA_VFRAGS
#undef DA_PACK_PV
#undef DA_LOAD
#undef DA_WRITE
  float l_tot; { const u32x2 sw = __builtin_amdgcn_permlane32_swap(__float_as_uint(l_run), __float_as_uint(l_run), false, false); l_tot = __uint_as_float(sw.x) + __uint_as_float(sw.y); }
  const float inv = 1.0f / l_tot;
  bf16_t* op = O12 + (size_t)(q0 + wid * 32 + r) * 2048 + hh * 128 + 4 * hi;
#pragma unroll
  for (int vb = 0; vb < 4; ++vb)
#pragma unroll
    for (int g = 0; g < 4; ++g) {
      u32x2 w; w.x = cvt_pk_bf16(o[vb][4 * g] * inv, o[vb][4 * g + 1] * inv); w.y = cvt_pk_bf16(o[vb][4 * g + 2] * inv, o[vb][4 * g + 3] * inv);
      *(u32x2*)(op + vb * 32 + 8 * g) = w;
    }
}

__device__ __forceinline__ void diff_combine_rows4(const bf16_t* __restrict__ O12, const float* __restrict__ subln_g, float lam, float oml, bf16_t* __restrict__ O, int row0, int h, int lane) {
  unsigned a[4], b[4];
#pragma unroll
  for (int i = 0; i < 4; ++i) { a[i] = *(const unsigned*)(O12 + (size_t)(row0 + i) * 2048 + (2 * h) * 128 + 2 * lane); b[i] = *(const unsigned*)(O12 + (size_t)(row0 + i) * 2048 + (2 * h + 1) * 128 + 2 * lane); }
  const float g0 = subln_g[2 * lane], g1 = subln_g[2 * lane + 1];
#pragma unroll
  for (int i = 0; i < 4; ++i) {
    const float x0 = bflo(a[i]) - lam * bflo(b[i]), x1 = bfhi(a[i]) - lam * bfhi(b[i]);
    const float ss = wave_sum_u(x0 * x0 + x1 * x1);
    const float rs = rsqrtf(ss * (1.0f / 128.0f) + 1e-5f) * oml;
    *(unsigned*)(O + (size_t)(row0 + i) * 1024 + h * 128 + 2 * lane) = cvt_pk_bf16(x0 * rs * g0, x1 * rs * g1);
  }
}
}

namespace natt {
using namespace mk;
using att::pi32; using att::swz;
constexpr int TB = 64 * 128;
constexpr int NA_LDS = 4 * TB + 2048;
__device__ __forceinline__ void na_attn_unit(const bf16_t* __restrict__ Pe, const bf16_t* __restrict__ Vte, const float* __restrict__ rpb_h, bf16_t* __restrict__ O, int b, int h, int rq, LAS unsigned char* lds) {
  const int tid = mk::otid(), wid = tid >> 6, lane = tid & 63, r = lane & 31, hi = lane >> 5;
  constexpr float LOG2E = 1.4426950408889634f;
  LAS float* sb = (LAS float*)(lds + 4 * TB);
  for (int i = tid; i < 465; i += NTHR) sb[i] = rpb_h[i];
  const bool is_ctx = rq < 0;
  int qrow = 0, qcol = 0, qtok, rs_q = 0, cs_q = 0, span0 = 0, wlo = 0, whi = -1, lo = 0, ntl = 0;
  if (!is_ctx) {
    const int r0 = rq * 4, ra = r0 + (wid >> 2) * 2;
    qrow = ra + (r >> 4); qcol = (wid & 3) * 16 + (r & 15); qtok = b * T + qrow * 64 + qcol;
    rs_q = min(max(qrow - 4, 0), 120); cs_q = min(max(qcol - 8, 0), 48);
    span0 = min(max((wid & 3) * 16 - 8, 0), 32);
    wlo = min(max(ra - 4, 0), 120); whi = min(max(ra - 3, 0), 120) + 7;
    lo = min(max(r0 - 4, 0), 120); const int hi_ = min(max(r0 - 1, 0), 120) + 7; ntl = hi_ - lo + 1;
  } else qtok = NLAT + b * L + wid * 32 + r;
  const int NT = ntl + 4;
  const int srow = tid >> 3, sch = tid & 7;
  const bf16_t* kbase = Pe + 512 + h * 64 + sch * 8;
  const bf16_t* vbase = Vte + (size_t)(h * 64 + srow) * NTOK + sch * 8;
  const int sdst = swz(srow, sch);
  bf16x8 qf[4];
  { const bf16_t* qp = Pe + (size_t)qtok * 1024 + h * 64 + hi * 8;
#pragma unroll
    for (int ks = 0; ks < 4; ++ks) qf[ks] = *(const bf16x8*)(qp + ks * 16); }
  const int kx = (pi32(r) >> 1) & 7, vx = (r >> 1) & 7;
  const int ka_loc = (span0 + pi32(r)) * 128; const int kx_loc = ((span0 + pi32(r)) >> 1) & 7;
  f32x16 o[2];
#pragma unroll
  for (int vb = 0; vb < 2; ++vb)
#pragma unroll
    for (int i = 0; i < 16; ++i) o[vb][i] = 0.f;
  float m_run = -1e30f, l_run = 0.f;
  u32x4 kreg, vreg;
#define NA_LOAD(t) do { const int tok = (t) < ntl ? b * T + (lo + (t)) * 64 : NLAT + b * L + ((t) - ntl) * 64; \
    kreg = *(const u32x4*)(kbase + (size_t)(tok + srow) * 1024); vreg = *(const u32x4*)(vbase + tok); } while (0)
#define NA_WRITE(bufi) do { *(LAS u32x4*)(lds + (bufi) * TB + sdst) = kreg; *(LAS u32x4*)(lds + 2 * TB + (bufi) * TB + sdst) = vreg; } while (0)
  NA_LOAD(0); NA_WRITE(0); __syncthreads();
  for (int t = 0; t < NT; ++t) {
    const bool more = t + 1 < NT;
    if (more) NA_LOAD(t + 1);
    const LAS unsigned char* kb_ = lds + (t & 1) * TB; const LAS unsigned char* vb_ = lds + 2 * TB + (t & 1) * TB;
    const bool local = t < ntl; const int kr = lo + t;
    const bool active = !local || (kr >= wlo && kr <= whi);
    if (active) {
      f32x16 s0, s1;
#pragma unroll
      for (int i = 0; i < 16; ++i) { s0[i] = 0.f; s1[i] = 0.f; }
      if (local) {
#pragma unroll
        for (int ks = 0; ks < 4; ++ks) {
          const bf16x8 a0 = *(const LAS bf16x8*)(kb_ + ka_loc + (((ks * 2 + hi) ^ kx_loc) << 4));
          s0 = __builtin_amdgcn_mfma_f32_32x32x16_bf16(a0, qf[ks], s0, 0, 0, 0);
        }
        const bool row_ok = kr >= rs_q && kr < rs_q + 8; const int dr31 = (kr - qrow + 7) * 31;
#pragma unroll
        for (int i = 0; i < 16; ++i) {
          const int kc = span0 + (i & 7) + 8 * hi + 16 * (i >> 3);
          const bool ok = row_ok && kc >= cs_q && kc < cs_q + 16;
          const int bi = ok ? dr31 + (kc - qcol + 15) : 0;
          const float bv = sb[bi];
          s0[i] = ok ? fmaf(s0[i], 0.125f, bv) : -1e30f; s1[i] = -1e30f;
        }
      } else {
#pragma unroll
        for (int ks = 0; ks < 4; ++ks) {
          const int ch = ((ks * 2 + hi) ^ kx) << 4;
          const bf16x8 a0 = *(const LAS bf16x8*)(kb_ + pi32(r) * 128 + ch), a1 = *(const LAS bf16x8*)(kb_ + (32 + pi32(r)) * 128 + ch);
          s0 = __builtin_amdgcn_mfma_f32_32x32x16_bf16(a0, qf[ks], s0, 0, 0, 0);
          s1 = __builtin_amdgcn_mfma_f32_32x32x16_bf16(a1, qf[ks], s1, 0, 0, 0);
        }
#pragma unroll
        for (int i = 0; i < 16; ++i) { s0[i] *= 0.125f; s1[i] *= 0.125f; }
      }
      float mx = s0[0];
#pragma unroll
      for (int i = 1; i < 16; ++i) mx = fmaxf(mx, s0[i]);
#pragma unroll
      for (int i = 0; i < 16; ++i) mx = fmaxf(mx, s1[i]);
      { const u32x2 sw = __builtin_amdgcn_permlane32_swap(__float_as_uint(mx), __float_as_uint(mx), false, false); mx = fmaxf(__uint_as_float(sw.x), __uint_as_float(sw.y)); }
      const float m_new = fmaxf(m_run, mx);
      const float alpha = __builtin_amdgcn_exp2f((m_run - m_new) * LOG2E);
      m_run = m_new;
      const float mc = -m_new * LOG2E;
      float ps = 0.f;
#pragma unroll
      for (int i = 0; i < 16; ++i) { const float p = s0[i] > -1e29f ? __builtin_amdgcn_exp2f(fmaf(s0[i], LOG2E, mc)) : 0.f; s0[i] = p; ps += p; }
#pragma unroll
      for (int i = 0; i < 16; ++i) { const float p = s1[i] > -1e29f ? __builtin_amdgcn_exp2f(fmaf(s1[i], LOG2E, mc)) : 0.f; s1[i] = p; ps += p; }
      l_run = l_run * alpha + ps;
      if (__any(alpha < 1.0f)) {
#pragma unroll
        for (int vb = 0; vb < 2; ++vb)
#pragma unroll
          for (int i = 0; i < 16; ++i) o[vb][i] *= alpha;
      }
      bf16x8 pf[2][2];
#pragma unroll
      for (int s = 0; s < 2; ++s) {
        u32x4 w0, w1;
        w0.x = cvt_pk_bf16(s0[8 * s + 0], s0[8 * s + 1]); w0.y = cvt_pk_bf16(s0[8 * s + 2], s0[8 * s + 3]); w0.z = cvt_pk_bf16(s0[8 * s + 4], s0[8 * s + 5]); w0.w = cvt_pk_bf16(s0[8 * s + 6], s0[8 * s + 7]);
        w1.x = cvt_pk_bf16(s1[8 * s + 0], s1[8 * s + 1]); w1.y = cvt_pk_bf16(s1[8 * s + 2], s1[8 * s + 3]); w1.z = cvt_pk_bf16(s1[8 * s + 4], s1[8 * s + 5]); w1.w = cvt_pk_bf16(s1[8 * s + 6], s1[8 * s + 7]);
        pf[0][s] = __builtin_bit_cast(bf16x8, w0); pf[1][s] = __builtin_bit_cast(bf16x8, w1);
      }
      const int cbase = local ? (span0 >> 3) : 0;
#pragma unroll
      for (int vb = 0; vb < 2; ++vb) {
        const LAS unsigned char* vrow = vb_ + (vb * 32 + r) * 128;
#pragma unroll
        for (int s = 0; s < 2; ++s) {
          const bf16x8 a = *(const LAS bf16x8*)(vrow + (((cbase + 2 * s + hi) ^ vx) << 4));
          o[vb] = __builtin_amdgcn_mfma_f32_32x32x16_bf16(a, pf[0][s], o[vb], 0, 0, 0);
        }
        if (!local) {
#pragma unroll
          for (int s = 0; s < 2; ++s) {
            const bf16x8 a = *(const LAS bf16x8*)(vrow + (((4 + 2 * s + hi) ^ vx) << 4));
            o[vb] = __builtin_amdgcn_mfma_f32_32x32x16_bf16(a, pf[1][s], o[vb], 0, 0, 0);
          }
        }
      }
    }
    if (more) NA_WRITE((t + 1) & 1);
    __syncthreads();
  }
#undef NA_LOAD
#undef NA_WRITE
  float l_tot; { const u32x2 sw = __builtin_amdgcn_permlane32_swap(__float_as_uint(l_run), __float_as_uint(l_run), false, false); l_tot = __uint_as_float(sw.x) + __uint_as_float(sw.y); }
  const float inv = 1.0f / l_tot;
  bf16_t* op = O + (size_t)qtok * 1024 + h * 64 + 4 * hi;
#pragma unroll
  for (int vb = 0; vb < 2; ++vb)
#pragma unroll
    for (int g = 0; g < 4; ++g) {
      u32x2 w; w.x = cvt_pk_bf16(o[vb][4 * g] * inv, o[vb][4 * g + 1] * inv); w.y = cvt_pk_bf16(o[vb][4 * g + 2] * inv, o[vb][4 * g + 3] * inv);
      *(u32x2*)(op + vb * 32 + 8 * g) = w;
    }
}
}

namespace rw {
using namespace mk;
constexpr int NSTEP = L + T, NCH = 32, CL = NSTEP / NCH;
constexpr int NCHAIN = 2 * B * 8;
constexpr float LOG2E = 1.4426950408889634f;
struct Bufs {
  u32x2* SH;
  unsigned* DR;
  bf16_t* G; int gstride;
  float* CS;
  float* PQ;
  float* SST;
  bf16_t* Y;
  bf16_t* Z;
};

__device__ __forceinline__ void prep_tile(const bf16_t* __restrict__ Prw, const float* __restrict__ cw, const float* __restrict__ w0, const float* __restrict__ w_up, const float* __restrict__ a0,
                                          const float* __restrict__ a_up, const float* __restrict__ g_up, const float* __restrict__ k_k, const float* __restrict__ k_a, const float* __restrict__ r_k,
                                          const Bufs& bf, int tile, LAS float* xs  ) {
  const int c = mk::otid(), lane = c & 63, h = c >> 6;
  const int row0 = tile * 16;
  int lo, hi;
  if (row0 < NLAT) { lo = (row0 / T) * T; hi = lo + T - 1; } else { lo = NLAT + ((row0 - NLAT) / L) * L; hi = lo + L - 1; }
#define RW_CONV(dst, col) do { const float c0 = cw[(col)], c1 = cw[RW_IN + (col)], c2 = cw[2 * RW_IN + (col)]; const bf16_t* p = Prw + (col); \
    bf16_t raw[18]; \
    _Pragma("unroll") for (int j = 0; j < 18; ++j) { int rr = row0 - 1 + j; rr = rr < lo ? lo : (rr > hi ? hi : rr); raw[j] = p[(size_t)rr * RW_IN]; } \
    float pm = row0 > lo ? bf2f(raw[0]) : 0.f, pc = bf2f(raw[1]); \
    _Pragma("unroll") for (int tt = 0; tt < 16; ++tt) { const float pn = (row0 + tt + 1 <= hi) ? bf2f(raw[tt + 2]) : 0.f; dst[tt] = pm * c0 + pc * c1 + pn * c2; pm = pc; pc = pn; } } while (0)
  if (c < 256) {
    float xv[16]; RW_CONV(xv, 1536 + c);
#pragma unroll
    for (int tt = 0; tt < 16; ++tt) { float v = xv[tt]; if (c < 64) v = tanhf(v); else if (c >= 128) v = sigmoidf_(v); xs[c * 16 + tt] = v; }
  }
  __syncthreads();
  const float w00 = w0[c], w01 = w0[512 + c], a00 = a0[c], a01 = a0[512 + c], kkc = k_k[c], kac = k_a[c], rkc = r_k[c];
  float e0[16], e1[16];
  {
    float aw0[16], aw1[16];
#pragma unroll
    for (int tt = 0; tt < 16; ++tt) { aw0[tt] = 0.f; aw1[tt] = 0.f; }
    float nw0[8], nw1[8];
#pragma unroll
    for (int u = 0; u < 8; ++u) { nw0[u] = w_up[(size_t)u * 512 + c]; nw1[u] = w_up[(size_t)(64 + u) * 512 + c]; }
    for (int m0 = 0; m0 < 64; m0 += 8) {
      float ww0[8], ww1[8];
      const int mn = m0 + 8 < 64 ? m0 + 8 : m0;
#pragma unroll
      for (int u = 0; u < 8; ++u) { ww0[u] = nw0[u]; ww1[u] = nw1[u]; nw0[u] = w_up[(size_t)(mn + u) * 512 + c]; nw1[u] = w_up[(size_t)(64 + mn + u) * 512 + c]; }
#pragma unroll
      for (int u = 0; u < 8; ++u) {
#pragma unroll
        for (int q = 0; q < 4; ++q) { const f32x4 xw = *(const LAS f32x4*)(xs + (m0 + u) * 16 + q * 4);
#pragma unroll
          for (int e = 0; e < 4; ++e) { aw0[q * 4 + e] += xw[e] * ww0[u]; aw1[q * 4 + e] += xw[e] * ww1[u]; } }
      }
    }
#pragma unroll
    for (int tt = 0; tt < 16; ++tt) {
      { const float z = -(w00 + aw0[tt]); const float sp = fmaxf(z, 0.f) + __logf(1.0f + __expf(-fabsf(z))); e0[tt] = __expf(-sp - 0.5f); }
      { const float z = -(w01 + aw1[tt]); const float sp = fmaxf(z, 0.f) + __logf(1.0f + __expf(-fabsf(z))); e1[tt] = __expf(-sp - 0.5f); }
    }
  }
  LAS float* asl = xs + 256 * 16;
  {
    float aa0[16], aa1[16];
#pragma unroll
    for (int tt = 0; tt < 16; ++tt) { aa0[tt] = 0.f; aa1[tt] = 0.f; }
    float na0[8], na1[8];
#pragma unroll
    for (int u = 0; u < 8; ++u) { na0[u] = a_up[(size_t)u * 512 + c]; na1[u] = a_up[(size_t)(64 + u) * 512 + c]; }
    for (int m0 = 0; m0 < 64; m0 += 8) {
      float av0[8], av1[8];
      const int mn = m0 + 8 < 64 ? m0 + 8 : m0;
#pragma unroll
      for (int u = 0; u < 8; ++u) { av0[u] = na0[u]; av1[u] = na1[u]; na0[u] = a_up[(size_t)(mn + u) * 512 + c]; na1[u] = a_up[(size_t)(64 + mn + u) * 512 + c]; }
#pragma unroll
      for (int u = 0; u < 8; ++u) {
#pragma unroll
        for (int q = 0; q < 4; ++q) { const f32x4 xa = *(const LAS f32x4*)(xs + (64 + m0 + u) * 16 + q * 4);
#pragma unroll
          for (int e = 0; e < 4; ++e) { aa0[q * 4 + e] += xa[e] * av0[u]; aa1[q * 4 + e] += xa[e] * av1[u]; } }
      }
    }
#pragma unroll
    for (int tt = 0; tt < 16; ++tt) { const unsigned d0 = cvt_pk_bf16(e0[tt], sigmoidf_(a00 + aa0[tt])), d1 = cvt_pk_bf16(e1[tt], sigmoidf_(a01 + aa1[tt]));
      bf.DR[((size_t)(row0 + tt)) * 512 + c] = d0; bf.DR[((size_t)NTOK + row0 + tt) * 512 + c] = d1; asl[tt * 512 + c] = bfhi(d0); asl[(16 + tt) * 512 + c] = bfhi(d1); }
  }
  {
    float ag[16];
#pragma unroll
    for (int tt = 0; tt < 16; ++tt) ag[tt] = 0.f;
    float ng[16];
#pragma unroll
    for (int u = 0; u < 16; ++u) ng[u] = g_up[(size_t)u * 512 + c];
    for (int m0 = 0; m0 < 128; m0 += 16) {
      float gg[16];
      const int mn = m0 + 16 < 128 ? m0 + 16 : m0;
#pragma unroll
      for (int u = 0; u < 16; ++u) { gg[u] = ng[u]; ng[u] = g_up[(size_t)(mn + u) * 512 + c]; }
#pragma unroll
      for (int u = 0; u < 16; ++u) {
#pragma unroll
        for (int q = 0; q < 4; ++q) { const f32x4 xg = *(const LAS f32x4*)(xs + (128 + m0 + u) * 16 + q * 4);
#pragma unroll
          for (int e = 0; e < 4; ++e) ag[q * 4 + e] += xg[e] * gg[u]; }
      }
    }
#pragma unroll
    for (int tt = 0; tt < 16; ++tt) bf.G[(size_t)(row0 + tt) * bf.gstride + c] = f2bf(ag[tt]);
  }
#undef RW_CONV
  const float cr0 = cw[c], cr1 = cw[RW_IN + c], cr2 = cw[2 * RW_IN + c], ck0 = cw[512 + c], ck1 = cw[RW_IN + 512 + c], ck2 = cw[2 * RW_IN + 512 + c], cv0 = cw[1024 + c], cv1 = cw[RW_IN + 1024 + c], cv2 = cw[2 * RW_IN + 1024 + c];
  const bf16_t* pr = Prw + (size_t)row0 * RW_IN + c;
  const bf16_t* prm = Prw + (size_t)(row0 > lo ? row0 - 1 : row0) * RW_IN + c;
  const bf16_t rm_ = prm[0], km_ = prm[512], vm_ = prm[1024];
  float rm = row0 > lo ? bf2f(rm_) : 0.f, km = row0 > lo ? bf2f(km_) : 0.f, vm = row0 > lo ? bf2f(vm_) : 0.f;
  float rc = bf2f(pr[0]), kc = bf2f(pr[512]), vc = bf2f(pr[1024]);
#pragma unroll 2
  for (int tt = 0; tt < 16; ++tt) {
    const int row = row0 + tt;
    const bool has_n = row + 1 <= hi; const bf16_t* pn = pr + (size_t)(has_n ? tt + 1 : tt) * RW_IN;
    const bf16_t rn_ = pn[0], kn_ = pn[512], vn_ = pn[1024];
    const float rn = has_n ? bf2f(rn_) : 0.f, kn = has_n ? bf2f(kn_) : 0.f, vn = has_n ? bf2f(vn_) : 0.f;
    const float rv = rm * cr0 + rc * cr1 + rn * cr2, kvv = km * ck0 + kc * ck1 + kn * ck2, vvv = vm * cv0 + vc * cv1 + vn * cv2;
    rm = rc; rc = rn; km = kc; kc = kn; vm = vc; vc = vn;
    float kk = kvv * kkc; const float nrm = sqrtf(wave_sum_u(kk * kk)); kk = kk * __builtin_amdgcn_rcpf(fmaxf(nrm, 1e-12f));
    u32x2 sh; sh.x = cvt_pk_bf16(rv, kvv); sh.y = cvt_pk_bf16(kk, vvv);
    bf.SH[(size_t)row * 512 + c] = sh;
    const float rq = bflo(sh.x), kq = bfhi(sh.x);
    const float cb0 = wave_sum_u(rq * kq * (1.0f + (asl[tt * 512 + c] - 1.0f) * kac) * rkc), cb1 = wave_sum_u(rq * kq * (1.0f + (asl[(16 + tt) * 512 + c] - 1.0f) * kac) * rkc);
    if (lane == 0) { bf.CS[(size_t)row * 16 + h] = cb0; bf.CS[(size_t)row * 16 + 8 + h] = cb1; }
  }
  __syncthreads();
}

struct StepRaw { u32x2 s; unsigned d; };
__device__ __forceinline__ int scan_row(int dir, int b, int p) {
  if (p < L) return NLAT + b * L + (dir ? (L - 1 - p) : p);
  const int q = p - L; return b * T + (dir ? (T - 1 - q) : q);
}
#define RW_RL(x, j) __int_as_float(__builtin_amdgcn_readlane(__float_as_int(x), (j)))
__device__ __forceinline__ void scan_unit(const Bufs& bf, const float* __restrict__ k_a, int chain, int chunk, LAS float* wl  ) {
  const int lane = mk::otid() & 63;
  const int dir = chain >> 5, b = (chain >> 3) & 3, h = chain & 7, ch = h * 64 + lane;
  const float kac = k_a[ch];
  float S[64], P[64];
#pragma unroll
  for (int j = 0; j < 64; ++j) { S[j] = 0.f; P[j] = (j == lane) ? 1.f : 0.f; }
  const int p0 = chunk * CL;
  StepRaw nx; { const int row = scan_row(dir, b, p0); nx.s = bf.SH[(size_t)row * 512 + ch]; nx.d = bf.DR[((size_t)dir * NTOK + row) * 512 + ch]; }
  for (int s = 0; s < CL; ++s) {
    const StepRaw cu = nx; const int row = scan_row(dir, b, p0 + s);
    if (s + 1 < CL) { const int rn = scan_row(dir, b, p0 + s + 1); nx.s = bf.SH[(size_t)rn * 512 + ch]; nx.d = bf.DR[((size_t)dir * NTOK + rn) * 512 + ch]; }
    const float r = bflo(cu.s.x), k = bfhi(cu.s.x), kk = bflo(cu.s.y), v = bfhi(cu.s.y), e = bflo(cu.d), asg = bfhi(cu.d);
    const float w = __builtin_amdgcn_exp2f(-e * LOG2E), a = -kk, bb = kk * asg, keff = k * (1.0f + (asg - 1.0f) * kac);
    wl[lane] = a; wl[64 + lane] = w; wl[128 + lane] = bb; wl[192 + lane] = keff; wl[256 + lane] = r;
    float sa = 0.f, sap = 0.f;
#pragma unroll
    for (int j4 = 0; j4 < 16; ++j4) { const f32x4 av = *(const LAS f32x4*)(wl + 4 * j4);
#pragma unroll
      for (int e2 = 0; e2 < 4; ++e2) { sa = fmaf(S[4 * j4 + e2], av[e2], sa); sap = fmaf(P[4 * j4 + e2], av[e2], sap); } }
    float y = 0.f, z = 0.f;
#pragma unroll
    for (int j4 = 0; j4 < 16; ++j4) {
      const f32x4 wv = *(const LAS f32x4*)(wl + 64 + 4 * j4), bv = *(const LAS f32x4*)(wl + 128 + 4 * j4), kv = *(const LAS f32x4*)(wl + 192 + 4 * j4), rv = *(const LAS f32x4*)(wl + 256 + 4 * j4);
#pragma unroll
      for (int e2 = 0; e2 < 4; ++e2) { const int j = 4 * j4 + e2;
        float t = v * kv[e2]; t = fmaf(sa, bv[e2], t); S[j] = fmaf(S[j], wv[e2], t);
        P[j] = fmaf(P[j], wv[e2], sap * bv[e2]);
        y = fmaf(S[j], rv[e2], y); z = fmaf(P[j], rv[e2], z); }
    }
    const size_t oi = ((size_t)dir * NTOK + row) * 512 + ch;
    bf.Y[oi] = f2bf(y); bf.Z[oi] = f2bf(z);
  }
  if (chunk < NCH - 1) {
    float* pq = bf.PQ + (((size_t)chain * (NCH - 1) + chunk) * 2) * 4096 + lane * 64;
#pragma unroll
    for (int q = 0; q < 16; ++q) { *(f32x4*)(pq + q * 4) = (f32x4){P[q * 4], P[q * 4 + 1], P[q * 4 + 2], P[q * 4 + 3]}; *(f32x4*)(pq + 4096 + q * 4) = (f32x4){S[q * 4], S[q * 4 + 1], S[q * 4 + 2], S[q * 4 + 3]}; }
  }
}

__device__ __forceinline__ void propagate_chain(const Bufs& bf, int chain, LAS float* lds) {
  LAS float* Sl = lds; LAS float* Pl = lds + 64 * 65;
  const int tid = mk::otid(), i = tid >> 3, jg = (tid & 7) * 8;
  float* sst = bf.SST + (size_t)chain * NCH * 4096;
#pragma unroll
  for (int e = 0; e < 8; ++e) Sl[i * 65 + jg + e] = 0.f;
  const float* pq0 = bf.PQ + ((size_t)chain * (NCH - 1) * 2) * 4096 + i * 64 + jg;
  f32x4 np0 = *(const f32x4*)pq0, np1 = *(const f32x4*)(pq0 + 4), nq0 = *(const f32x4*)(pq0 + 4096), nq1 = *(const f32x4*)(pq0 + 4096 + 4);
  for (int c = 0; c < NCH - 1; ++c) {
    const f32x4 p0 = np0, p1 = np1; f32x4 q0 = nq0, q1 = nq1;
    { const float* pqn = pq0 + (size_t)(c + 1 < NCH - 1 ? c + 1 : c) * 2 * 4096;
      np0 = *(const f32x4*)pqn; np1 = *(const f32x4*)(pqn + 4); nq0 = *(const f32x4*)(pqn + 4096); nq1 = *(const f32x4*)(pqn + 4096 + 4); }
    *(LAS f32x4*)(Pl + i * 64 + jg) = p0; *(LAS f32x4*)(Pl + i * 64 + jg + 4) = p1;
    __syncthreads();
#pragma unroll 8
    for (int k = 0; k < 64; ++k) { const float sv = Sl[i * 65 + k]; const f32x4 a = *(const LAS f32x4*)(Pl + k * 64 + jg), b2 = *(const LAS f32x4*)(Pl + k * 64 + jg + 4); q0 += sv * a; q1 += sv * b2; }
    __syncthreads();
    Sl[i * 65 + jg] = q0[0]; Sl[i * 65 + jg + 1] = q0[1]; Sl[i * 65 + jg + 2] = q0[2]; Sl[i * 65 + jg + 3] = q0[3]; Sl[i * 65 + jg + 4] = q1[0]; Sl[i * 65 + jg + 5] = q1[1]; Sl[i * 65 + jg + 6] = q1[2]; Sl[i * 65 + jg + 7] = q1[3];
    *(f32x4*)(sst + (size_t)(c + 1) * 4096 + i * 64 + jg) = q0; *(f32x4*)(sst + (size_t)(c + 1) * 4096 + i * 64 + jg + 4) = q1;
  }
  __syncthreads();
}

__device__ __forceinline__ void corr_unit(const Bufs& bf, int chain, int chunk) {
  const int lane = mk::otid() & 63, r = lane & 31, hi = lane >> 5;
  const int dir = chain >> 5, b = (chain >> 3) & 3, h = chain & 7;
  const float* ss = bf.SST + ((size_t)chain * NCH + chunk) * 4096;
  bf16x8 bfr[2][4];
#pragma unroll
  for (int nt = 0; nt < 2; ++nt)
#pragma unroll
    for (int ks = 0; ks < 4; ++ks) { const float* q = ss + (size_t)(nt * 32 + r) * 64 + ks * 16 + hi * 8; const f32x4 x0 = *(const f32x4*)q, x1 = *(const f32x4*)(q + 4);
      u32x4 w; w.x = cvt_pk_bf16(x0[0], x0[1]); w.y = cvt_pk_bf16(x0[2], x0[3]); w.z = cvt_pk_bf16(x1[0], x1[1]); w.w = cvt_pk_bf16(x1[2], x1[3]); bfr[nt][ks] = __builtin_bit_cast(bf16x8, w); }
  const int p0 = chunk * CL;
  const size_t dbase = (size_t)dir * NTOK;
  for (int mt = 0; mt < (CL + 31) / 32; ++mt) {
    const int sa_ = min(mt * 32 + r, CL - 1);
    const bf16_t* zp = bf.Z + (dbase + scan_row(dir, b, p0 + sa_)) * 512 + h * 64 + hi * 8;
    bf16x8 af[4];
#pragma unroll
    for (int ks = 0; ks < 4; ++ks) af[ks] = *(const bf16x8*)(zp + ks * 16);
    f32x16 acc[2];
#pragma unroll
    for (int nt = 0; nt < 2; ++nt) { acc[nt] = zero16();
#pragma unroll
      for (int ks = 0; ks < 4; ++ks) acc[nt] = __builtin_amdgcn_mfma_f32_32x32x16_bf16(af[ks], bfr[nt][ks], acc[nt], 0, 0, 0); }
#pragma unroll
    for (int i = 0; i < 16; ++i) { const int so = mt * 32 + (i & 3) + 8 * (i >> 2) + 4 * hi;
      if (so < CL) { bf16_t* yp = bf.Y + (dbase + scan_row(dir, b, p0 + so)) * 512 + h * 64 + r;
        yp[0] = f2bf(bf2f(yp[0]) + acc[0][i]); yp[32] = f2bf(bf2f(yp[32]) + acc[1][i]); } }
  }
}

template <int NR>
__device__ __forceinline__ void finish_rows(const Bufs& bf, const float* __restrict__ gn_g, const float* __restrict__ gn_b, bf16_t* __restrict__ O, int row0) {
  const int c = mk::otid(), h = c >> 6;
  float y[NR], v[NR], g[NR], cs[NR];
#pragma unroll
  for (int i = 0; i < NR; ++i) { const int row = row0 + i;
    y[i] = bf2f(bf.Y[(size_t)row * 512 + c]) + bf2f(bf.Y[((size_t)NTOK + row) * 512 + c]);
    v[i] = bfhi(bf.SH[(size_t)row * 512 + c].y); g[i] = bf2f(bf.G[(size_t)row * bf.gstride + c]);
    cs[i] = bf.CS[(size_t)row * 16 + h] + bf.CS[(size_t)row * 16 + 8 + h]; }
  const float gg = gn_g[c], gb = gn_b[c];
  float o[NR];
#pragma unroll
  for (int i = 0; i < NR; ++i) { const float mu = wave_sum_u(y[i]) * (1.0f / 64.0f); const float dv = y[i] - mu; const float var = wave_sum_u(dv * dv) * (1.0f / 64.0f);
    o[i] = (dv * rsqrtf(var + 64e-5f) * gg + gb + cs[i] * v[i]) * g[i]; }
#pragma unroll
  for (int i = 0; i < NR; ++i) O[(size_t)(row0 + i) * 1024 + 512 + c] = f2bf(o[i]);
}
}

namespace mk {
constexpr size_t al256(size_t x) { return (x + 255) / 256 * 256; }
constexpr size_t WS_BAR = 0;
constexpr size_t WS_BCNT = al256(WS_BAR + (size_t)XCD_BAR_WORDS * 4);
constexpr size_t WS_MOFF = al256(WS_BCNT + (size_t)4 * 256 * 64 * 4);
constexpr size_t WS_KN = al256(WS_MOFF + 4 * 256);
constexpr size_t WS_MOD = al256(WS_KN + (size_t)2 * 256 * 16 * 4);
constexpr size_t WS_ROPE = al256(WS_MOD + (size_t)4 * 5 * 6144 * 4);
constexpr size_t WS_HCTX = al256(WS_ROPE + 128 * 16 * 2 * 4);
constexpr size_t WS_EID = al256(WS_HCTX + (size_t)NCTX * D * 4);
constexpr size_t WS_GATE = al256(WS_EID + (size_t)NTOK * 2 * 4);
constexpr size_t WS_POS = al256(WS_GATE + (size_t)NTOK * 2 * 4);
constexpr size_t WS_WEIN = al256(WS_POS + (size_t)NTOK * 2 * 4);
constexpr size_t WS_WOIN = al256(WS_WEIN + (size_t)2 * EVEN_IN * D * 2);
constexpr size_t WS_WEOUT = al256(WS_WOIN + (size_t)2 * ODD_IN * D * 2);
constexpr size_t WS_WOOUT = al256(WS_WEOUT + (size_t)2 * D * D * 2);
constexpr size_t WS_WGU = al256(WS_WOOUT + (size_t)2 * D * D * 2);
constexpr size_t WS_WDN = al256(WS_WGU + (size_t)NE * 1024 * D * 2);
constexpr size_t WS_UO = al256(WS_WDN + (size_t)NE * D * DE * 2);
constexpr size_t WS_SCR = al256(WS_UO + (size_t)NTOK * D * 2);
constexpr size_t SE_PQK = 0;
constexpr size_t SE_VT = al256(SE_PQK + (size_t)NTOK * 1024 * 2);
constexpr size_t SE_PRW = al256(SE_VT + (size_t)512 * NTOK * 2);
constexpr size_t SE_PQ = 0;
constexpr size_t SE_SST = al256(SE_PQ + (size_t)rw::NCHAIN * (rw::NCH - 1) * 2 * 4096 * 4);
constexpr size_t SE_Y = al256(SE_SST + (size_t)rw::NCHAIN * rw::NCH * 4096 * 4);
constexpr size_t SE_Z = al256(SE_Y + (size_t)2 * NTOK * 512 * 2);
constexpr size_t SE_ZEND = al256(SE_Z + (size_t)2 * NTOK * 512 * 2);
constexpr size_t SE_PRWEND = al256(SE_PRW + (size_t)NTOK * RW_IN * 2);
constexpr size_t SE_SH = SE_PRWEND > SE_ZEND ? SE_PRWEND : SE_ZEND;
constexpr size_t SE_DR = al256(SE_SH + (size_t)NTOK * 512 * 8);
constexpr size_t SE_CS = al256(SE_DR + (size_t)2 * NTOK * 512 * 4);
constexpr size_t SE_END = al256(SE_CS + (size_t)2 * NTOK * 16 * 4);
constexpr size_t SE_YBUF = 0;
constexpr size_t SO_PQK = 0;
constexpr size_t SO_VT = al256(SO_PQK + (size_t)NTOK * 2048 * 2);
constexpr size_t SO_O12 = al256(SO_VT + (size_t)1024 * NTOK * 2);
constexpr size_t SO_END = al256(SO_O12 + (size_t)NTOK * 2048 * 2);
constexpr size_t SO_YBUF = 0;
constexpr size_t SM_XS = 0;
constexpr size_t SM_HE = al256(SM_XS + (size_t)MOE_ROWS * D * 2);
constexpr size_t SM_YS = al256(SM_HE + (size_t)MOE_ROWS * DE * 2);
constexpr size_t SM_END = al256(SM_YS + (size_t)MOE_ROWS * D * 2);
constexpr size_t SCR_BYTES = SE_END > SO_END ? (SE_END > SM_END ? SE_END : SM_END) : (SO_END > SM_END ? SO_END : SM_END);
constexpr size_t WS_END = WS_SCR + SCR_BYTES;
constexpr int LDS_BARW = 131072;
constexpr int LDS_MISC = 131072 + 64;

struct Params {
  const float *x, *c, *ctx, *c_ctx, *ada_w, *ada_b, *ln_g, *ln_b, *even_w_in, *even_w_out, *shift_w, *na_rpb, *rw_w0, *rw_w_up, *rw_a0, *rw_a_up, *rw_g_up, *rw_k_k, *rw_k_a, *rw_r_k,
      *rw_gn_g, *rw_gn_b, *odd_w_in, *odd_w_out, *da_lq1, *da_lk1, *da_lq2, *da_lk2, *da_subln_g, *router_w, *router_b, *exp_w_gate, *exp_w_up, *exp_w_down;
  float* out; unsigned char* ws; int ph_lo, ph_hi;
};
template <class Tp> __device__ __forceinline__ Tp* wsp(const Params& p, size_t off) { return (Tp*)(p.ws + off); }

__device__ __forceinline__ void ada_unit(const Params& p, int u, LAS float* lds) {
  LAS float* sc = lds; LAS float* red = lds + 5 * 1024;
  const int tid = mk::otid(), l = u / 96, n = (u % 96) * 64 + (tid & 63), kp = tid >> 6;
  for (int i = tid; i < 5 * 1024; i += NTHR) { const float v = i < 4096 ? p.c[i] : p.c_ctx[i - 4096]; sc[i] = siluf_(v); }
  __syncthreads();
  float a[5] = {0.f, 0.f, 0.f, 0.f, 0.f};
  const float* w = p.ada_w + ((size_t)l * D + kp * 128) * 6144 + n;
#pragma unroll 4
  for (int k = 0; k < 128; ++k) { const float wv = w[(size_t)k * 6144]; const int kk = kp * 128 + k;
#pragma unroll
    for (int r = 0; r < 5; ++r) a[r] = fmaf(sc[r * 1024 + kk], wv, a[r]); }
#pragma unroll
  for (int r = 0; r < 5; ++r) red[(kp * 5 + r) * 64 + (tid & 63)] = a[r];
  __syncthreads();
  if (tid < 320) { const int r = tid >> 6, nn = tid & 63; float s = 0.f;
#pragma unroll
    for (int q = 0; q < 8; ++q) s += red[(q * 5 + r) * 64 + nn];
    const int col = (u % 96) * 64 + nn;
    wsp<float>(p, WS_MOD)[((size_t)l * 5 + r) * 6144 + col] = s + p.ada_b[l * 6144 + col]; }
  __syncthreads();
}
__device__ __forceinline__ void phase_prologue(const Params& p, LAS unsigned char* lds) {
  const int bid = mk::obid(), nb = gridDim.x; LAS float* tile = (LAS float*)lds;
  int ub = 0;
  for (int i = 0; i < 2; ++i) ub += cvt_matrix(p.even_w_in + (size_t)i * D * EVEN_IN, EVEN_IN, D, EVEN_IN, wsp<bf16_t>(p, WS_WEIN) + (size_t)i * EVEN_IN * D, NMapId{0}, tile, ub, bid, nb);
  for (int i = 0; i < 2; ++i) ub += cvt_matrix(p.odd_w_in + (size_t)i * D * ODD_IN, ODD_IN, D, ODD_IN, wsp<bf16_t>(p, WS_WOIN) + (size_t)i * ODD_IN * D, NMapRope{}, tile, ub, bid, nb);
  for (int i = 0; i < 2; ++i) ub += cvt_matrix(p.even_w_out + (size_t)i * D * D, D, D, D, wsp<bf16_t>(p, WS_WEOUT) + (size_t)i * D * D, NMapId{0}, tile, ub, bid, nb);
  for (int i = 0; i < 2; ++i) ub += cvt_matrix(p.odd_w_out + (size_t)i * D * D, D, D, D, wsp<bf16_t>(p, WS_WOOUT) + (size_t)i * D * D, NMapId{0}, tile, ub, bid, nb);
  for (int u = (bid + nb - ub % nb) % nb; u < 384; u += nb) ada_unit(p, u, (LAS float*)lds);
  const int gt = bid * NTHR + mk::otid();
  if (gt < 128 * 16) { const int pos = gt >> 4, i = gt & 15; const float inv = exp2f(-(float)i * (13.287712379549449f / 16.0f)); float sn, cs; sincosf((float)pos * inv, &sn, &cs);
    wsp<float>(p, WS_ROPE)[gt * 2] = cs; wsp<float>(p, WS_ROPE)[gt * 2 + 1] = sn; }
}
__device__ __forceinline__ void cvt_experts(const Params& p, int l, LAS float* tile, int b0) {
  const int bid = mk::obid() - b0, nb = (int)gridDim.x - b0; int ub = 0;
  if (bid < 0) return;
  for (int e = 0; e < NE; ++e) {
    const size_t so = ((size_t)l * NE + e) * D * DE;
    ub += cvt_matrix(p.exp_w_gate + so, DE, D, DE, wsp<bf16_t>(p, WS_WGU) + (size_t)e * 1024 * D, NMapInterleave{0}, tile, ub, bid, nb);
    ub += cvt_matrix(p.exp_w_up + so, DE, D, DE, wsp<bf16_t>(p, WS_WGU) + (size_t)e * 1024 * D, NMapInterleave{1}, tile, ub, bid, nb);
    ub += cvt_matrix(p.exp_w_down + so, D, DE, D, wsp<bf16_t>(p, WS_WDN) + (size_t)e * D * DE, NMapId{0}, tile, ub, bid, nb);
  }
}

__device__ __forceinline__ const float* h_in_ptr(const Params& p, int l, int row) {
  if (l == 0) return row < NLAT ? p.x + (size_t)row * D : p.ctx + (size_t)(row - NLAT) * D;
  return row < NLAT ? p.out + (size_t)row * D : wsp<float>(p, WS_HCTX) + (size_t)(row - NLAT) * D;
}
__device__ __forceinline__ float* h_out_ptr(const Params& p, int row) { return row < NLAT ? p.out + (size_t)row * D : wsp<float>(p, WS_HCTX) + (size_t)(row - NLAT) * D; }
__device__ __forceinline__ void store_bf16x4(bf16_t* dst, f32x4 v) { u32x2 w; w.x = cvt_pk_bf16(v[0], v[1]); w.y = cvt_pk_bf16(v[2], v[3]); *(u32x2*)dst = w; }
__device__ __forceinline__ f32x4 load_bf16x4(const bf16_t* src) { const u32x2 w = *(const u32x2*)src; return (f32x4){bflo(w.x), bfhi(w.x), bflo(w.y), bfhi(w.y)}; }

__device__ __forceinline__ void phase_mod0(const Params& p) {
  const int lane = mk::otid() & 63, wid = mk::otid() >> 6;
  bf16_t* U = wsp<bf16_t>(p, WS_UO);
  for (int row = mk::obid() * 8 + wid; row < NTOK; row += gridDim.x * 8) {
    const float* h = h_in_ptr(p, 0, row); const float* modl = wsp<float>(p, WS_MOD) + (size_t)bidx_of_row(row) * 6144;
#pragma unroll
    for (int q = 0; q < 4; ++q) { const int col = q * 256 + lane * 4; const f32x4 hv = *(const f32x4*)(h + col), sh = *(const f32x4*)(modl + col), sc = *(const f32x4*)(modl + 1024 + col);
      store_bf16x4(U + (size_t)row * D + col, hv * (1.0f + sc) + sh); }
  }
}
__device__ __forceinline__ void ln_row(f32x4 (&v)[4], const float* __restrict__ g, const float* __restrict__ b, int lane) {
  float s = 0.f;
#pragma unroll
  for (int q = 0; q < 4; ++q) s += (v[q][0] + v[q][1]) + (v[q][2] + v[q][3]);
  const float mu = wave_sum_u(s) * (1.0f / D);
  float qq = 0.f;
#pragma unroll
  for (int q = 0; q < 4; ++q) { const f32x4 d = v[q] - mu; qq += (d[0] * d[0] + d[1] * d[1]) + (d[2] * d[2] + d[3] * d[3]); }
  const float rstd = rsqrtf(wave_sum_u(qq) * (1.0f / D) + LN_EPS);
#pragma unroll
  for (int q = 0; q < 4; ++q) { const int col = q * 256 + lane * 4; v[q] = (v[q] - mu) * rstd * *(const f32x4*)(g + col) + *(const f32x4*)(b + col); }
}
struct Ln1Raw { f32x4 h[4]; u32x2 y[4]; };
__device__ __forceinline__ void ln1_load(const Params& p, int l, const bf16_t* __restrict__ Ybuf, int row, int lane, Ln1Raw& r) {
  const float* h = h_in_ptr(p, l, row);
#pragma unroll
  for (int q = 0; q < 4; ++q) { const int col = q * 256 + lane * 4; r.h[q] = *(const f32x4*)(h + col); r.y[q] = *(const u32x2*)(Ybuf + (size_t)row * D + col); }
}
__device__ __forceinline__ void ln1_row(const Params& p, int l, int row, int lane, const Ln1Raw& raw, const LAS float* rwl, LAS int* lcnt, bool redir) {
  bf16_t* U2 = wsp<bf16_t>(p, WS_UO); int* eid = wsp<int>(p, WS_EID); float* gatev = wsp<float>(p, WS_GATE);
  const float* lg = p.ln_g + (size_t)(l * 2) * D; const float* lb = p.ln_b + (size_t)(l * 2) * D;
  float* ho = redir ? wsp<float>(p, WS_SCR + SM_YS) + (size_t)row * D : h_out_ptr(p, row); const float* modl = wsp<float>(p, WS_MOD) + ((size_t)l * 5 + bidx_of_row(row)) * 6144;
  f32x4 v[4];
#pragma unroll
  for (int q = 0; q < 4; ++q) { const int col = q * 256 + lane * 4; const f32x4 yv = (f32x4){bflo(raw.y[q].x), bfhi(raw.y[q].x), bflo(raw.y[q].y), bfhi(raw.y[q].y)};
    v[q] = ALPHA * raw.h[q] + *(const f32x4*)(modl + 2 * 1024 + col) * yv; }
  ln_row(v, lg, lb, lane);
  float acc[16];
#pragma unroll
  for (int e = 0; e < 16; ++e) acc[e] = 0.f;
#pragma unroll
  for (int q = 0; q < 4; ++q) { const int col = q * 256 + lane * 4;
    *(f32x4*)(ho + col) = v[q];
    const f32x4 u = v[q] * (1.0f + *(const f32x4*)(modl + 4 * 1024 + col)) + *(const f32x4*)(modl + 3 * 1024 + col);
    store_bf16x4(U2 + (size_t)row * D + col, u);
#pragma unroll
    for (int e = 0; e < 16; ++e) { const f32x4 w = *(const LAS f32x4*)(rwl + ((q * 16 + e) * 64 + lane) * 4); acc[e] += (u[0] * w[0] + u[1] * w[1]) + (u[2] * w[2] + u[3] * w[3]); }
  }
  float s[16], sel[16];
#pragma unroll
  for (int e = 0; e < 16; ++e) { s[e] = 1.0f / (1.0f + expf(-wave_sum_u(acc[e]))); sel[e] = s[e] + p.router_b[e]; }
  float best = -1e30f; int grp = 0;
#pragma unroll
  for (int gI = 0; gI < 4; ++gI) {
    const float a = sel[gI * 4], b2 = sel[gI * 4 + 1], c = sel[gI * 4 + 2], d = sel[gI * 4 + 3];
    const float lo1 = fminf(a, b2), hi1 = fmaxf(a, b2), lo2 = fminf(c, d), hi2 = fmaxf(c, d);
    const float gs = fmaxf(hi1, hi2) + fmaxf(fminf(hi1, hi2), fmaxf(lo1, lo2));
    if (gs > best) { best = gs; grp = gI; }
  }
  float v0 = 0, v1 = 0, v2 = 0, v3 = 0, s0 = 0, s1 = 0, s2 = 0, s3 = 0;
#pragma unroll
  for (int gI = 0; gI < 4; ++gI) if (gI == grp) { v0 = sel[gI * 4]; v1 = sel[gI * 4 + 1]; v2 = sel[gI * 4 + 2]; v3 = sel[gI * 4 + 3]; s0 = s[gI * 4]; s1 = s[gI * 4 + 1]; s2 = s[gI * 4 + 2]; s3 = s[gI * 4 + 3]; }
  int i1 = 0; float b1 = v0; if (v1 > b1) { b1 = v1; i1 = 1; } if (v2 > b1) { b1 = v2; i1 = 2; } if (v3 > b1) { b1 = v3; i1 = 3; }
  int i2 = -1; float bb = -1e30f;
  if (i1 != 0 && v0 > bb) { bb = v0; i2 = 0; } if (i1 != 1 && v1 > bb) { bb = v1; i2 = 1; } if (i1 != 2 && v2 > bb) { bb = v2; i2 = 2; } if (i1 != 3 && v3 > bb) { bb = v3; i2 = 3; }
  const float g1 = i1 == 0 ? s0 : i1 == 1 ? s1 : i1 == 2 ? s2 : s3; const float g2 = i2 == 0 ? s0 : i2 == 1 ? s1 : i2 == 2 ? s2 : s3;
  if (lane == 0) { const int e1 = grp * 4 + i1, e2 = grp * 4 + i2;
    eid[row * 2] = e1; eid[row * 2 + 1] = e2; gatev[row * 2] = g1 / (g1 + g2); gatev[row * 2 + 1] = g2 / (g1 + g2);
    __hip_atomic_fetch_add(lcnt + e1, 1, __ATOMIC_RELAXED, __HIP_MEMORY_SCOPE_WORKGROUP); __hip_atomic_fetch_add(lcnt + e2, 1, __ATOMIC_RELAXED, __HIP_MEMORY_SCOPE_WORKGROUP); }
}
__device__ __forceinline__ void phase_ln1(const Params& p, int l, const bf16_t* __restrict__ Ybuf, LAS unsigned char* lds, bool dry) {
  const int tid = mk::otid(), lane = tid & 63, wid = tid >> 6, bid = mk::obid();
  const bool last = l == DEPTH - 1; const int ntok = last ? NLAT : NTOK;
  LAS float* rwl = (LAS float*)lds; LAS int* lcnt = (LAS int*)(lds + 65536);
  { float rv[32];
#pragma unroll
    for (int i = 0; i < 32; ++i) rv[i] = p.router_w[tid + i * NTHR];
#pragma unroll
    for (int i = 0; i < 32; ++i) { const int idx = tid + i * NTHR, d = idx >> 4, e = idx & 15; rwl[(((d >> 8) * 16 + e) * 64 + ((d >> 2) & 63)) * 4 + (d & 3)] = rv[i]; } }
  if (tid < 16) lcnt[tid] = 0;
  __syncthreads();
  const int stride = gridDim.x * 8, row0 = bid * 8 + wid;
  if (row0 < ntok) {
    Ln1Raw cur, nxt; ln1_load(p, l, Ybuf, row0, lane, cur);
    for (int row = row0; row < ntok; row += stride) {
      const int rn = row + stride < ntok ? row + stride : row;
      ln1_load(p, l, Ybuf, rn, lane, nxt);
      ln1_row(p, l, row, lane, cur, rwl, lcnt, dry);
      cur = nxt;
    }
  }
  __syncthreads();
  if (tid < 16) wsp<int>(p, WS_BCNT)[((size_t)l * 256 + bid) * 64 + tid] = lcnt[tid];
  __syncthreads();
}
__device__ __forceinline__ void phase_scatter(const Params& p, int l, LAS unsigned char* lds) {
  const int tid = mk::otid(), lane = tid & 63, wid = tid >> 6, bid = mk::obid();
  const bool last = l == DEPTH - 1; const int ntok = last ? NLAT : NTOK;
  LAS int* tot = (LAS int*)lds; LAS int* pre = tot + 16; LAS int* base = tot + 32; LAS int* lcur = tot + 48;
  const int* bc = wsp<int>(p, WS_BCNT) + (size_t)l * 256 * 64;
  if (tid < 16) { int t = 0, pr = 0; for (int b2 = 0; b2 < (int)gridDim.x; ++b2) { const int v = bc[b2 * 64 + tid]; pr += b2 < bid ? v : 0; t += v; } tot[tid] = t; pre[tid] = pr; lcur[tid] = 0; }
  __syncthreads();
  if (tid == 0) { int o = 0; int* mo = wsp<int>(p, WS_MOFF) + l * 64; for (int e = 0; e < 16; ++e) { base[e] = o + pre[e]; if (bid == 0) mo[e] = o; o += (tot[e] + 255) / 256 * 256; } if (bid == 0) mo[16] = o; }
  __syncthreads();
  const bf16_t* U2 = wsp<bf16_t>(p, WS_UO); bf16_t* Xs = wsp<bf16_t>(p, WS_SCR + SM_XS); const int* eid = wsp<int>(p, WS_EID); int* pos = wsp<int>(p, WS_POS);
  for (int row = bid * 8 + wid; row < ntok; row += gridDim.x * 8) {
    int p1 = 0, p2 = 0;
    if (lane == 0) { const int e1 = eid[row * 2], e2 = eid[row * 2 + 1]; p1 = base[e1] + __hip_atomic_fetch_add(lcur + e1, 1, __ATOMIC_RELAXED, __HIP_MEMORY_SCOPE_WORKGROUP); p2 = base[e2] + __hip_atomic_fetch_add(lcur + e2, 1, __ATOMIC_RELAXED, __HIP_MEMORY_SCOPE_WORKGROUP); pos[row * 2] = p1; pos[row * 2 + 1] = p2; }
    p1 = __builtin_amdgcn_readfirstlane(p1); p2 = __builtin_amdgcn_readfirstlane(p2);
    const u32x4 a = *(const u32x4*)(U2 + (size_t)row * D + lane * 8), b2 = *(const u32x4*)(U2 + (size_t)row * D + 512 + lane * 8);
    *(u32x4*)(Xs + (size_t)p1 * D + lane * 8) = a; *(u32x4*)(Xs + (size_t)p1 * D + 512 + lane * 8) = b2;
    *(u32x4*)(Xs + (size_t)p2 * D + lane * 8) = a; *(u32x4*)(Xs + (size_t)p2 * D + 512 + lane * 8) = b2;
  }
}
struct Ln2Raw { f32x4 h[4]; u32x2 y1[4], y2[4]; };
__device__ __forceinline__ void ln2_load(const Params& p, int row, int lane, int p1, int p2, Ln2Raw& r) {
  const bf16_t* Ys = wsp<bf16_t>(p, WS_SCR + SM_YS); const float* ho = h_out_ptr(p, row);
#pragma unroll
  for (int q = 0; q < 4; ++q) { const int col = q * 256 + lane * 4; r.h[q] = *(const f32x4*)(ho + col); r.y1[q] = *(const u32x2*)(Ys + (size_t)p1 * D + col); r.y2[q] = *(const u32x2*)(Ys + (size_t)p2 * D + col); }
}
__device__ __forceinline__ void phase_ln2(const Params& p, int l, bool dry) {
  const int tid = mk::otid(), lane = tid & 63, wid = tid >> 6;
  const bool last = l == DEPTH - 1; const int ntok = last ? NLAT : NTOK;
  const int* pos = wsp<int>(p, WS_POS); const float* gatev = wsp<float>(p, WS_GATE); bf16_t* U = wsp<bf16_t>(p, WS_UO);
  const float* lg = p.ln_g + (size_t)(l * 2 + 1) * D; const float* lb = p.ln_b + (size_t)(l * 2 + 1) * D;
  const int stride = gridDim.x * 8, row0 = mk::obid() * 8 + wid;
  if (row0 >= ntok) return;
  auto clampr = [&](int r) { return r < ntok ? r : row0; };
  u32x2 pc = *(const u32x2*)(pos + 2 * row0); f32x2 gc = *(const f32x2*)(gatev + 2 * row0);
  Ln2Raw cur, nxt; ln2_load(p, row0, lane, (int)pc.x, (int)pc.y, cur);
  int r1 = clampr(row0 + stride);
  u32x2 pn = *(const u32x2*)(pos + 2 * r1); f32x2 gn = *(const f32x2*)(gatev + 2 * r1);
  for (int row = row0; row < ntok; row += stride) {
    ln2_load(p, r1, lane, (int)pn.x, (int)pn.y, nxt);
    const int r2 = clampr(row + 2 * stride);
    const u32x2 pn2 = *(const u32x2*)(pos + 2 * r2); const f32x2 gn2 = *(const f32x2*)(gatev + 2 * r2);
    float* ho = dry ? wsp<float>(p, WS_SCR + SM_XS) + (size_t)row * D : h_out_ptr(p, row); const int bi = bidx_of_row(row);
    const float* modl = wsp<float>(p, WS_MOD) + ((size_t)l * 5 + bi) * 6144;
    f32x4 v[4];
#pragma unroll
    for (int q = 0; q < 4; ++q) { const int col = q * 256 + lane * 4;
      const f32x4 a1 = (f32x4){bflo(cur.y1[q].x), bfhi(cur.y1[q].x), bflo(cur.y1[q].y), bfhi(cur.y1[q].y)}, a2 = (f32x4){bflo(cur.y2[q].x), bfhi(cur.y2[q].x), bflo(cur.y2[q].y), bfhi(cur.y2[q].y)};
      v[q] = ALPHA * cur.h[q] + *(const f32x4*)(modl + 5 * 1024 + col) * (gc[0] * a1 + gc[1] * a2); }
    ln_row(v, lg, lb, lane);
    const float* modn = wsp<float>(p, WS_MOD) + ((size_t)(last ? l : l + 1) * 5 + bi) * 6144;
#pragma unroll
    for (int q = 0; q < 4; ++q) { const int col = q * 256 + lane * 4; *(f32x4*)(ho + col) = v[q];
      if (!last) store_bf16x4(U + (size_t)row * D + col, v[q] * (1.0f + *(const f32x4*)(modn + 1024 + col)) + *(const f32x4*)(modn + col)); }
    cur = nxt; gc = gn; pn = pn2; gn = gn2; r1 = r2;
  }
}

struct SchedEvenIn { const bf16_t* U; const bf16_t* W; bf16_t* Pqk; bf16_t* Prw; bf16_t* Vt; int G, c;
  __device__ __forceinline__ bool next(int i, pg8::Unit& u) const { const int Lx = i * G + c; u.kind = 0;
    if (Lx < 1452) { const int grp = Lx / 44, rem = Lx % 44, pm = grp * 4 + (rem & 3), pi = rem >> 2; u.pm = pm; u.pn = pi;
      u.A = (const char*)(U + (size_t)pm * 256 * D); const int brow = pi < 4 ? pi * 256 : 1536 + (pi - 4) * 256; u.Bt = (const char*)(W + (size_t)brow * D);
      if (pi < 4) { u.out = Pqk; u.ldo = 1024; u.x1 = pi * 256; } else { u.out = Prw; u.ldo = RW_IN; u.x1 = (pi - 4) * 256; } u.x0 = pm * 256; return true; }
    if (Lx < 1452 + 264) { const int v = Lx - 1452, pmv = v & 1, pnv = v >> 1; u.pm = pmv; u.pn = pnv; u.A = (const char*)(W + (size_t)(1024 + pmv * 256) * D); u.Bt = (const char*)(U + (size_t)pnv * 256 * D);
      u.out = Vt; u.ldo = NTOK; u.x0 = pmv * 256; u.x1 = pnv * 256; return true; }
    return false; } };
struct SchedOddIn { const bf16_t* U; const bf16_t* W; bf16_t* Pqk; bf16_t* Vt; int G, c;
  __device__ __forceinline__ bool next(int i, pg8::Unit& u) const { const int Lx = i * G + c;
    if (Lx < 1056) { const int grp = Lx / 32, rem = Lx % 32, pm = grp * 4 + (rem & 3), pi = rem >> 2; u.pm = pm; u.pn = pi; u.kind = pm < 128 ? 1 : 0;
      u.A = (const char*)(U + (size_t)pm * 256 * D); u.Bt = (const char*)(W + (size_t)pi * 256 * D); u.out = Pqk; u.ldo = 2048; u.x0 = pm * 256; u.x1 = pi * 256; return true; }
    if (Lx < 1056 + 528) { const int v = Lx - 1056, pmv = v & 3, pnv = v >> 2; u.pm = pmv; u.pn = pnv; u.kind = 0; u.A = (const char*)(W + (size_t)(2048 + pmv * 256) * D); u.Bt = (const char*)(U + (size_t)pnv * 256 * D);
      u.out = Vt; u.ldo = NTOK; u.x0 = pmv * 256; u.x1 = pnv * 256; return true; }
    return false; } };
struct SchedOut { const bf16_t* O; const bf16_t* W; bf16_t* Y; int G, c;
  __device__ __forceinline__ bool next(int i, pg8::Unit& u) const { const int Lx = i * G + c; if (Lx >= 528) return false; const int pm = (Lx / 16) * 4 + (Lx & 3), pn = (Lx & 15) >> 2; u.pm = pm; u.pn = pn; u.kind = 0;
    u.A = (const char*)(O + (size_t)pm * 256 * D); u.Bt = (const char*)(W + (size_t)pn * 256 * D); u.out = Y; u.ldo = 1024; u.x0 = pm * 256; u.x1 = pn * 256; return true; } };
struct SchedMoe { const bf16_t* A; const bf16_t* W; bf16_t* out; const LAS int* moff; int Kd, ldo, ncol, G, c;
  __device__ __forceinline__ bool next(int i, pg8::Unit& u) const { const int Lx = i * G + c; const int ntile = moff[16] >> 8; if (Lx >= ntile * 4) return false;
    const int pm = Lx >> 2, pn = Lx & 3; int e = 0;
#pragma unroll
    for (int j = 1; j < 16; ++j) e += (pm * 256 >= moff[j]) ? 1 : 0;
    u.pm = pm; u.pn = pn; u.kind = 0; u.A = (const char*)(A + (size_t)pm * 256 * Kd); u.Bt = (const char*)(W + ((size_t)e * 1024 + pn * 256) * Kd); u.out = out; u.ldo = ldo; u.x0 = pm * 256; u.x1 = pn * ncol; return true; } };

struct EpiOddIn {
  static constexpr bool PERM = true; const float* rope;
  __device__ __forceinline__ void operator()(const f32x4 (&acc)[2][2][4][2], const pg8::Unit& u, int wr, int wc, int fr, int fq) const {
    if (u.kind == 0) { pg8::EpiStoreBf16{}(acc, u, wr, wc, fr, fq); return; }
    const int row0 = u.x0 + wr * 64 + fr, col0 = u.x1 + wc * 32 + 8 * fq; const int half = wc & 1;
#pragma unroll
    for (int ai = 0; ai < 2; ++ai)
#pragma unroll
      for (int m = 0; m < 4; ++m) { const int row = row0 + ai * 128 + m * 16; const int t = row & (T - 1); const int pos = half ? (t & 63) : (t >> 6);
        const f32x4 cs0 = *(const f32x4*)(rope + (pos * 16 + 4 * fq) * 2), cs1 = *(const f32x4*)(rope + (pos * 16 + 4 * fq + 2) * 2);
        bf16_t* rowp = u.out + (size_t)row * u.ldo + col0;
#pragma unroll
        for (int bj = 0; bj < 2; ++bj) { const f32x4 v0 = acc[ai][bj][m][0], v1 = acc[ai][bj][m][1];
          u32x4 w; w.x = cvt_pk_bf16(v0[0] * cs0[0] - v0[1] * cs0[1], v0[0] * cs0[1] + v0[1] * cs0[0]); w.y = cvt_pk_bf16(v0[2] * cs0[2] - v0[3] * cs0[3], v0[2] * cs0[3] + v0[3] * cs0[2]);
          w.z = cvt_pk_bf16(v1[0] * cs1[0] - v1[1] * cs1[1], v1[0] * cs1[1] + v1[1] * cs1[0]); w.w = cvt_pk_bf16(v1[2] * cs1[2] - v1[3] * cs1[3], v1[2] * cs1[3] + v1[3] * cs1[2]);
          *(u32x4*)(rowp + bj * 128) = w; } }
  }
};
struct EpiGateUp {
  static constexpr bool PERM = true;
  __device__ __forceinline__ void operator()(const f32x4 (&acc)[2][2][4][2], const pg8::Unit& u, int wr, int wc, int fr, int fq) const {
    const int row0 = u.x0 + wr * 64 + fr, col0 = u.x1 + wc * 16 + 4 * fq;
#pragma unroll
    for (int ai = 0; ai < 2; ++ai)
#pragma unroll
      for (int m = 0; m < 4; ++m) { bf16_t* rowp = u.out + (size_t)(row0 + ai * 128 + m * 16) * u.ldo + col0;
#pragma unroll
        for (int bj = 0; bj < 2; ++bj) { const f32x4 v0 = acc[ai][bj][m][0], v1 = acc[ai][bj][m][1];
          u32x2 w; w.x = cvt_pk_bf16(siluf_(v0[0]) * v0[1], siluf_(v0[2]) * v0[3]); w.y = cvt_pk_bf16(siluf_(v1[0]) * v1[1], siluf_(v1[2]) * v1[3]);
          *(u32x2*)(rowp + bj * 64) = w; } }
  }
};
}

namespace mk {
constexpr int N_PHASES = 2 + 2 * (12 + 10);
__global__ void __launch_bounds__(NTHR, 2) mega(Params p) {
  extern __shared__ __attribute__((aligned(16))) unsigned char shm[];
  LAS unsigned char* lds = (LAS unsigned char*)shm;
  const int nb = gridDim.x;
  if (threadIdx.x == 0) *(LAS u32x4*)(lds + LDS_BARW) = (u32x4){0u, 0u, 0u, 0u};
  __syncthreads();
  XcdBarrier bar = xcd_barrier_post(wsp<unsigned>(p, WS_BAR), (volatile LAS unsigned*)(lds + LDS_BARW));
  int ph = 0;
#ifndef MK_MASK
#define MK_MASK 0xFFFFFFFFu
#endif
#ifndef MK_REP
#define MK_REP 0u
#endif
#define PHASE_BEGIN_K(k) if ((((MK_MASK) >> (k)) & 1u) && ph >= p.ph_lo && ph < p.ph_hi) { const int bid = mk::obid(); const int nrep_ = ((((MK_REP) >> (k)) & 1u) ? 2 : 1); for (int rep_ = 0; rep_ < nrep_; ++rep_) { const bool dry = rep_ + 1 < nrep_; (void)dry;
#define PHASE_END   } if (ph + 1 < p.ph_hi) xcd_barrier(bar); } ++ph;
  bf16_t* UO = wsp<bf16_t>(p, WS_UO);
  unsigned char* scr = p.ws + WS_SCR;
  PHASE_BEGIN_K(0) phase_prologue(p, lds); PHASE_END
  PHASE_BEGIN_K(1) phase_mod0(p); PHASE_END
  for (int lp = 0; lp < 2; ++lp) {
    {
      const int l = 2 * lp;
      bf16_t* Pqk = (bf16_t*)(scr + SE_PQK); bf16_t* Vt = (bf16_t*)(scr + SE_VT); bf16_t* Prw = (bf16_t*)(scr + SE_PRW); bf16_t* Ybuf = (bf16_t*)(scr + SE_YBUF);
      rw::Bufs bf; bf.SH = (u32x2*)(scr + SE_SH); bf.DR = (unsigned*)(scr + SE_DR); bf.G = UO + 512; bf.gstride = 1024; bf.CS = (float*)(scr + SE_CS) + (size_t)lp * NTOK * 16; bf.PQ = (float*)(scr + SE_PQ); bf.SST = (float*)(scr + SE_SST); bf.Y = (bf16_t*)(scr + SE_Y); bf.Z = (bf16_t*)(scr + SE_Z);
      PHASE_BEGIN_K(2) { SchedEvenIn S{UO, wsp<bf16_t>(p, WS_WEIN) + (size_t)lp * EVEN_IN * D, Pqk, Prw, Vt, nb, bid}; pg8::gemm_phase(lds, D, S, pg8::EpiStoreBf16{}); } PHASE_END
      PHASE_BEGIN_K(3) { for (int u = bid; u < 1024 + 32; u += nb) { int b, h, rq; if (u < 1024) { b = u >> 8; h = (u >> 5) & 7; rq = u & 31; } else { const int v = u - 1024; b = v >> 3; h = v & 7; rq = -1; }
          natt::na_attn_unit(Pqk, Vt, p.na_rpb + ((size_t)lp * 8 + h) * 465, UO, b, h, rq, lds); }
        const int pb = (bid + nb / 2) % nb;
        for (int t = pb; t < NTOK / 16; t += nb) rw::prep_tile(Prw, p.shift_w + (size_t)lp * 3 * RW_IN, p.rw_w0 + lp * 1024, p.rw_w_up + (size_t)lp * 2 * 64 * 512, p.rw_a0 + lp * 1024,
            p.rw_a_up + (size_t)lp * 2 * 64 * 512, p.rw_g_up + (size_t)lp * 128 * 512, p.rw_k_k + lp * 512, p.rw_k_a + lp * 512, p.rw_r_k + lp * 512, bf, t, (LAS float*)lds); } PHASE_END
      PHASE_BEGIN_K(4) for (int u = bid * 8 + (mk::otid() >> 6); u < rw::NCHAIN * rw::NCH; u += nb * 8) rw::scan_unit(bf, p.rw_k_a + lp * 512, u / rw::NCH, u % rw::NCH, (LAS float*)lds + (mk::otid() >> 6) * 320); PHASE_END
      PHASE_BEGIN_K(5) for (int c = bid; c < rw::NCHAIN; c += nb) rw::propagate_chain(bf, c, (LAS float*)lds); PHASE_END
      PHASE_BEGIN_K(6) for (int u = bid * 8 + (mk::otid() >> 6); u < rw::NCHAIN * (rw::NCH - 1); u += nb * 8) rw::corr_unit(bf, u / (rw::NCH - 1), 1 + u % (rw::NCH - 1)); PHASE_END
      PHASE_BEGIN_K(7) for (int r = bid * 8; r < NTOK; r += nb * 8) rw::finish_rows<8>(bf, p.rw_gn_g + lp * 512, p.rw_gn_b + lp * 512, UO, r); PHASE_END
      PHASE_BEGIN_K(8) { SchedOut S{UO, wsp<bf16_t>(p, WS_WEOUT) + (size_t)lp * D * D, Ybuf, nb, bid}; pg8::gemm_phase(lds, D, S, pg8::EpiStoreBf16{}); __syncthreads(); cvt_experts(p, l, (LAS float*)lds, 528 - 2 * nb > 0 ? 528 - 2 * nb : 0); } PHASE_END
      PHASE_BEGIN_K(9) phase_ln1(p, l, Ybuf, lds, dry); PHASE_END
      PHASE_BEGIN_K(10) phase_scatter(p, l, lds); PHASE_END
      PHASE_BEGIN_K(11) { LAS int* mo = (LAS int*)(lds + LDS_MISC); { const int tq = mk::otid(); if (tq < 17) mo[tq] = wsp<int>(p, WS_MOFF)[l * 64 + tq]; } __syncthreads();
        SchedMoe S{(bf16_t*)(scr + SM_XS), wsp<bf16_t>(p, WS_WGU), (bf16_t*)(scr + SM_HE), mo, D, DE, 128, nb, bid}; pg8::gemm_phase(lds, D, S, EpiGateUp{}); } PHASE_END
      PHASE_BEGIN_K(12) { LAS int* mo = (LAS int*)(lds + LDS_MISC); { const int tq = mk::otid(); if (tq < 17) mo[tq] = wsp<int>(p, WS_MOFF)[l * 64 + tq]; } __syncthreads();
        SchedMoe S{(bf16_t*)(scr + SM_HE), wsp<bf16_t>(p, WS_WDN), (bf16_t*)(scr + SM_YS), mo, DE, D, 256, nb, bid}; pg8::gemm_phase(lds, DE, S, pg8::EpiStoreBf16{}); } PHASE_END
      PHASE_BEGIN_K(13) phase_ln2(p, l, dry); PHASE_END
    }
    {
      const int l = 2 * lp + 1; const bool last = l == DEPTH - 1;
      bf16_t* Pqk = (bf16_t*)(scr + SO_PQK); bf16_t* Vt = (bf16_t*)(scr + SO_VT); bf16_t* O12 = (bf16_t*)(scr + SO_O12); bf16_t* Ybuf = (bf16_t*)(scr + SO_YBUF);
      PHASE_BEGIN_K(14) { SchedOddIn S{UO, wsp<bf16_t>(p, WS_WOIN) + (size_t)lp * ODD_IN * D, Pqk, Vt, nb, bid}; pg8::gemm_phase(lds, D, S, EpiOddIn{wsp<float>(p, WS_ROPE)}); } PHASE_END
      float* KN = wsp<float>(p, WS_KN) + (size_t)lp * 256 * 16;
      PHASE_BEGIN_K(23) for (int g = bid; g < 256; g += nb) att::knorm_group(Pqk, KN, g, (LAS float*)lds); PHASE_END
      PHASE_BEGIN_K(15) for (int u = bid; u < 2048 + (last ? 0 : 64); u += nb) { int b, hh, q0, nlat;
        if (u < 2048) { b = u >> 9; hh = (u >> 5) & 15; q0 = b * T + (u & 31) * 256; nlat = T; } else { const int v = u - 2048; b = v >> 4; hh = v & 15; q0 = NLAT + b * L; nlat = 0; }
        att::diff_attn_unit(Pqk, Vt, O12, hh, q0, b * T, nlat, NLAT + b * L, att::kmax2_of(KN, b, hh), lds); } PHASE_END
      PHASE_BEGIN_K(16) { float d1 = 0.f, d2 = 0.f; for (int i = 0; i < 64; ++i) { d1 += p.da_lq1[lp * 64 + i] * p.da_lk1[lp * 64 + i]; d2 += p.da_lq2[lp * 64 + i] * p.da_lk2[lp * 64 + i]; }
        const float li = 0.8f - 0.6f * expf(-0.3f * (float)l), lam = expf(d1) - expf(d2) + li;
        const int tq = mk::otid(); for (int r4 = bid; r4 < (last ? NLAT : NTOK) / 4; r4 += nb) att::diff_combine_rows4(O12, p.da_subln_g + lp * 128, lam, 1.0f - li, UO, r4 * 4, tq >> 6, tq & 63); } PHASE_END
      PHASE_BEGIN_K(17) { SchedOut S{UO, wsp<bf16_t>(p, WS_WOOUT) + (size_t)lp * D * D, Ybuf, nb, bid}; pg8::gemm_phase(lds, D, S, pg8::EpiStoreBf16{}); __syncthreads(); cvt_experts(p, l, (LAS float*)lds, 528 - 2 * nb > 0 ? 528 - 2 * nb : 0); } PHASE_END
      PHASE_BEGIN_K(18) phase_ln1(p, l, Ybuf, lds, dry); PHASE_END
      PHASE_BEGIN_K(19) phase_scatter(p, l, lds); PHASE_END
      PHASE_BEGIN_K(20) { LAS int* mo = (LAS int*)(lds + LDS_MISC); { const int tq = mk::otid(); if (tq < 17) mo[tq] = wsp<int>(p, WS_MOFF)[l * 64 + tq]; } __syncthreads();
        SchedMoe S{(bf16_t*)(scr + SM_XS), wsp<bf16_t>(p, WS_WGU), (bf16_t*)(scr + SM_HE), mo, D, DE, 128, nb, bid}; pg8::gemm_phase(lds, D, S, EpiGateUp{}); } PHASE_END
      PHASE_BEGIN_K(21) { LAS int* mo = (LAS int*)(lds + LDS_MISC); { const int tq = mk::otid(); if (tq < 17) mo[tq] = wsp<int>(p, WS_MOFF)[l * 64 + tq]; } __syncthreads();
        SchedMoe S{(bf16_t*)(scr + SM_HE), wsp<bf16_t>(p, WS_WDN), (bf16_t*)(scr + SM_YS), mo, DE, D, 256, nb, bid}; pg8::gemm_phase(lds, DE, S, pg8::EpiStoreBf16{}); } PHASE_END
      PHASE_BEGIN_K(22) phase_ln2(p, l, dry); PHASE_END
    }
  }
#undef PHASE_BEGIN_K
#undef PHASE_END
}
}

#ifndef MK_SINGLE_LAUNCH
#define MK_SINGLE_LAUNCH 1
#endif
extern "C" void kernel_launch(void* const* d_in, const int* in_sizes, int n_in, void* d_out, int out_size, void* d_ws, size_t ws_size, hipStream_t stream) {
  using namespace mk;
  static int grid = 0;
  if (grid == 0) {
    if (n_in != 34 || out_size != NLAT * D || ws_size < WS_END) { fprintf(stderr, "kernel_launch: unexpected shapes (n_in %d out %d ws %zu need %zu)\n", n_in, out_size, ws_size, (size_t)WS_END); grid = -1; return; }
    if (hipFuncSetAttribute((const void*)mega, hipFuncAttributeMaxDynamicSharedMemorySize, LDS_BYTES) != hipSuccess) { grid = -1; return; }
    int dev = 0, cus = 0, per_cu = 0;
    if (hipGetDevice(&dev) != hipSuccess || hipDeviceGetAttribute(&cus, hipDeviceAttributeMultiprocessorCount, dev) != hipSuccess) { grid = -1; return; }
    if (hipOccupancyMaxActiveBlocksPerMultiprocessor(&per_cu, (const void*)mega, NTHR, LDS_BYTES) != hipSuccess || per_cu < 1) { fprintf(stderr, "kernel_launch: occupancy query says %d\n", per_cu); }
    (void)hipGetLastError();
    grid = cus;
  }
  if (grid < 0) return;
  (void)hipMemsetAsync((char*)d_ws + WS_BAR, 0, (size_t)XCD_BAR_WORDS * 4, stream);
  Params p{};
  const float** pp = (const float**)&p;
  for (int i = 0; i < 34; ++i) pp[i] = (const float*)d_in[i];
  p.out = (float*)d_out; p.ws = (unsigned char*)d_ws;
#if MK_SINGLE_LAUNCH
  p.ph_lo = 0; p.ph_hi = N_PHASES;
  hipLaunchKernelGGL(mega, dim3(grid), dim3(NTHR), LDS_BYTES, stream, p);
#else
  for (int ph = 0; ph < N_PHASES; ++ph) { p.ph_lo = ph; p.ph_hi = ph + 1; hipLaunchKernelGGL(mega, dim3(grid), dim3(NTHR), LDS_BYTES, stream, p); }
#endif
}
```

```cpp
#include <hip/hip_runtime.h>
#include <stdint.h>
#include <stdio.h>

typedef unsigned short bf16_t;
typedef short bf16x8 __attribute__((ext_vector_type(8)));
typedef float f32x4 __attribute__((ext_vector_type(4)));
typedef float f32x2 __attribute__((ext_vector_type(2)));
typedef float f32x16 __attribute__((ext_vector_type(16)));
typedef unsigned u32x4 __attribute__((ext_vector_type(4)));
typedef unsigned u32x2 __attribute__((ext_vector_type(2)));
#define LAS __attribute__((address_space(3)))

namespace mk {
constexpr int B = 4, T = 8192, L = 256, D = 1024, NLAT = B * T, NCTX = B * L, NTOK = NLAT + NCTX;
constexpr int DEPTH = 4, EVEN_IN = 3328, ODD_IN = 3072, RW_OFF = 1536, RW_IN = 1792, NE = 16, DE = 512;
constexpr float ALPHA = 1.681792830507429f, LN_EPS = 1e-5f;
constexpr int NTHR = 512, LDS_BYTES = 147456;
constexpr int MOE_TILES = 280, MOE_ROWS = MOE_TILES * 256;

__device__ __forceinline__ unsigned cvt_pk_bf16(float lo, float hi) { unsigned r; asm volatile("v_cvt_pk_bf16_f32 %0, %1, %2" : "=v"(r) : "v"(lo), "v"(hi)); return r; }
__device__ __forceinline__ float bf2f(bf16_t b) { return __uint_as_float(((unsigned)b) << 16); }
__device__ __forceinline__ float bflo(unsigned w) { return __uint_as_float(w << 16); }
__device__ __forceinline__ float bfhi(unsigned w) { return __uint_as_float(w & 0xffff0000u); }
__device__ __forceinline__ bf16_t f2bf(float f) { return (bf16_t)(cvt_pk_bf16(f, 0.f) & 0xffffu); }
__device__ __forceinline__ float sigmoidf_(float x) { return 1.0f / (1.0f + __expf(-x)); }
__device__ __forceinline__ float siluf_(float x) { return x / (1.0f + __expf(-x)); }
__device__ __forceinline__ float wave_sum(float v) {
#pragma unroll
  for (int o = 32; o > 0; o >>= 1) v += __shfl_xor(v, o);
  return v;
}
template <int CTRL, int RM, int BM> __device__ __forceinline__ float dpp_mov(float old, float v) { return __int_as_float(__builtin_amdgcn_update_dpp(__float_as_int(old), __float_as_int(v), CTRL, RM, BM, false)); }
__device__ __forceinline__ float wave_sum_u(float v) {
  v += dpp_mov<0xB1, 0xf, 0xf>(v, v);
  v += dpp_mov<0x4E, 0xf, 0xf>(v, v);
  v += dpp_mov<0x141, 0xf, 0xf>(v, v);
  v += dpp_mov<0x140, 0xf, 0xf>(v, v);
  v += dpp_mov<0x142, 0xa, 0xf>(0.f, v);
  v += dpp_mov<0x143, 0xc, 0xf>(0.f, v);
  return __int_as_float(__builtin_amdgcn_readlane(__float_as_int(v), 63));
}
__device__ __forceinline__ float wave_max_u(float v) {
  v = fmaxf(v, dpp_mov<0xB1, 0xf, 0xf>(v, v));
  v = fmaxf(v, dpp_mov<0x4E, 0xf, 0xf>(v, v));
  v = fmaxf(v, dpp_mov<0x141, 0xf, 0xf>(v, v));
  v = fmaxf(v, dpp_mov<0x140, 0xf, 0xf>(v, v));
  v = fmaxf(v, dpp_mov<0x142, 0xa, 0xf>(0.f, v));
  v = fmaxf(v, dpp_mov<0x143, 0xc, 0xf>(0.f, v));
  return __int_as_float(__builtin_amdgcn_readlane(__float_as_int(v), 63));
}
__device__ __forceinline__ f32x16 zero16() { float z = 0.f; asm volatile("" : "+v"(z)); f32x16 r;
#pragma unroll
  for (int i = 0; i < 16; ++i) r[i] = z;
  return r; }
__device__ __forceinline__ int otid() { int t = threadIdx.x; asm volatile("" : "+v"(t)); return t; }
__device__ __forceinline__ int obid() { int b = blockIdx.x; asm volatile("" : "+s"(b)); return b; }
__device__ __forceinline__ int bidx_of_row(int row) { return row < NLAT ? row / T : 4; }
}

#include <vector>

#define XB_TMO      128
#define XB_XCNT(j)  (256  + 64 * (j))
#define XB_XSUB(j)  (1280 + 64 * (j))
#define XB_XGEN(j)  (2304 + 64 * (j))
#define XB_TOP      3328
#define XB_TOPGEN   3392
#define XCD_BAR_WORDS 3456
#define XB_SPIN_CAP (1u << 18)
#define LAS __attribute__((address_space(3)))

__device__ __forceinline__ unsigned xb_ld(unsigned* p)              { return __hip_atomic_load(p, __ATOMIC_RELAXED, __HIP_MEMORY_SCOPE_AGENT); }
__device__ __forceinline__ unsigned xb_add(unsigned* p, unsigned v) { return __hip_atomic_fetch_add(p, v, __ATOMIC_RELAXED, __HIP_MEMORY_SCOPE_AGENT); }
__device__ __forceinline__ unsigned xb_xcc_id() { return (unsigned)__builtin_amdgcn_s_getreg((3 << 11) | 20) & 0xFu; }
#define XB_SPIN(cond, bar) do { unsigned _sp = 0; while (cond) { __builtin_amdgcn_s_sleep(1); \
    if ((++_sp & 255u) == 0u) { if (xb_ld(&(bar)[XB_TMO])) break; if (_sp > XB_SPIN_CAP) { atomicAdd(&(bar)[XB_TMO], 1u); break; } } } } while (0)

struct XcdBarrier {
    unsigned* bar; unsigned x;
    volatile LAS unsigned* st;
};

__device__ __forceinline__ XcdBarrier xcd_barrier_post(unsigned* bar, volatile LAS unsigned* st) {
    XcdBarrier b; b.bar = bar; b.x = xb_xcc_id(); b.st = st;
    if (threadIdx.x == 0) (void)xb_add(&bar[XB_XCNT(b.x)], 1u);
    return b;
}
__device__ __forceinline__ void xcd_barrier_complete(unsigned* bar, unsigned x, unsigned& nloc, unsigned& nx) {
    const unsigned G = gridDim.x * gridDim.y * gridDim.z;
    unsigned sum, cnt, mine, sp = 0u;
    for (;;) {
        sum = 0u; cnt = 0u; mine = 0u;
#pragma unroll
        for (unsigned j = 0; j < 16; ++j) { const unsigned c = xb_ld(&bar[XB_XCNT(j)]); sum += c; cnt += (c > 0u) ? 1u : 0u; mine = (j == x) ? c : mine; }
        if (sum == G) break;
        __builtin_amdgcn_s_sleep(1);
        if ((++sp & 255u) == 0u) { if (xb_ld(&bar[XB_TMO])) break; if (sp > XB_SPIN_CAP) { atomicAdd(&bar[XB_TMO], 1u); break; } }
    }
    nloc = mine > 0u ? mine : 1u; nx = cnt > 0u ? cnt : 1u;
}

__device__ __forceinline__ void xcd_barrier(const XcdBarrier& b) {
    asm volatile("s_waitcnt vmcnt(0)" ::: "memory");
    __syncthreads();
    if (threadIdx.x == 0) {
        unsigned* bar = b.bar;
        __builtin_amdgcn_s_waitcnt(0);
        unsigned nloc = b.st[0], nx = b.st[1];
        if (nloc == 0u) { xcd_barrier_complete(bar, b.x, nloc, nx); b.st[0] = nloc; b.st[1] = nx; }
        const unsigned old = xb_add(&bar[XB_XSUB(b.x)], 1u);
        const unsigned gen = old / nloc;
        if (old + 1u == (gen + 1u) * nloc) {
            __builtin_amdgcn_fence(__ATOMIC_RELEASE, "agent");
            asm volatile("s_waitcnt vmcnt(0)" ::: "memory");
            const unsigned og = xb_add(&bar[XB_TOP], 1u);
            const unsigned tg = og / nx;
            if (og + 1u == (tg + 1u) * nx) xb_add(&bar[XB_TOPGEN], 1u);
            else XB_SPIN(xb_ld(&bar[XB_TOPGEN]) == tg, bar);
            __builtin_amdgcn_fence(__ATOMIC_ACQUIRE, "agent");
            xb_add(&bar[XB_XGEN(b.x)], 1u);
            asm volatile("s_waitcnt vmcnt(0)" ::: "memory");
        } else {
            XB_SPIN(xb_ld(&bar[XB_XGEN(b.x)]) == gen, bar);
            __builtin_amdgcn_fence(__ATOMIC_ACQUIRE, "agent");
            asm volatile("s_waitcnt vmcnt(0)" ::: "memory");
        }
    }
    __syncthreads();
}

namespace pg8 {
using mk::cvt_pk_bf16;
constexpr int BM = 256, BK = 64, HALF = 128, HTB = HALF * BK * 2  , STAGE_BYTES = 8 * HTB;
__host__ __device__ __forceinline__ int lds_byte(int r, int c) { const int st = (r >> 4) * 2 + (c >> 5), rr = r & 15, cc = c & 31, ob = rr * 64 + cc * 2; return st * 1024 + (ob ^ (((ob >> 9) & 1) << 5)); }
__host__ __device__ __forceinline__ void stage_rc(int b, int& R, int& C) { const int st = b / 1024, sb = b % 1024, swz = sb ^ (((sb >> 9) & 1) << 5); R = (st >> 1) * 16 + swz / 64; C = (st & 1) * 32 + (swz % 64) / 2; }
__host__ __device__ __forceinline__ int perm32(int rho) { const int n = rho >> 4, i = rho & 15; return 8 * (i >> 2) + 4 * n + (i & 3); }

struct Unit { const char* A; const char* Bt; bf16_t* out; int pm, pn, x0, x1, ldo, kind; };

template <class Epi, class Sched>
__device__ __forceinline__ void gemm_phase(LAS unsigned char* lds, const int K, const Sched& S, const Epi& E) {
    const int tid = mk::otid(), wid = __builtin_amdgcn_readfirstlane(tid >> 6), lane = tid & 63, wr = wid >> 2, wc = wid & 3, fr = lane & 15, fq = lane >> 4;
    const int nt = K / BK;
    unsigned voffA[2], voffB[2];
#pragma unroll
    for (int i = 0; i < 2; ++i) { int R, C; stage_rc(tid * 16 + i * 8192, R, C); const int Rb = Epi::PERM ? ((R & ~31) + perm32(R & 31)) : R;
        voffA[i] = (unsigned)(R * K + C) * 2u; voffB[i] = (unsigned)(Rb * K + C) * 2u; }
    const size_t kstep = (size_t)(BK * 2);
    const size_t hstep = (size_t)HALF * K * 2;
    const unsigned ldsw = (unsigned)wid * 1024u;
    const int aoff = lds_byte(wr * 64 + fr, fq * 8), boff = lds_byte(wc * 32 + fr, fq * 8);
#define PG8_SA(b, h) (((b) * 2 + (h)) * HTB)
#define PG8_SB(b, h) ((4 + (b) * 2 + (h)) * HTB)
#define PG8_STAGE(bufoff, gbase, voff) do { _Pragma("unroll") for (int _i = 0; _i < 2; ++_i) \
        __builtin_amdgcn_global_load_lds((const unsigned*)((const char*)(gbase) + (voff)[_i]), (LAS unsigned*)(lds + (bufoff) + ldsw + _i * 8192), 16, 0, 0); } while (0)
#define PG8_LDA(dst, b, h) do { _Pragma("unroll") for (int m = 0; m < 4; ++m) _Pragma("unroll") for (int k = 0; k < 2; ++k) dst[m][k] = *(const LAS bf16x8*)(lds + PG8_SA(b, h) + aoff + m * 2048 + k * 1024); } while (0)
#define PG8_LDB(dst, b, h) do { _Pragma("unroll") for (int n = 0; n < 2; ++n) _Pragma("unroll") for (int k = 0; k < 2; ++k) dst[n][k] = *(const LAS bf16x8*)(lds + PG8_SB(b, h) + boff + n * 2048 + k * 1024); } while (0)
#define PG8_MMA(ai, bj, At, Bt) do { __builtin_amdgcn_s_setprio(1); _Pragma("unroll") for (int m = 0; m < 4; ++m) _Pragma("unroll") for (int n = 0; n < 2; ++n) _Pragma("unroll") for (int k = 0; k < 2; ++k) \
        acc[ai][bj][m][n] = __builtin_amdgcn_mfma_f32_16x16x32_bf16(Bt[n][k], At[m][k], acc[ai][bj][m][n], 0, 0, 0); __builtin_amdgcn_s_setprio(0); } while (0)
#define PG8_WAIT_V(n) asm volatile("s_waitcnt vmcnt(" #n ")" ::: "memory")
#define PG8_WAIT_L(n) asm volatile("s_waitcnt lgkmcnt(" #n ")" ::: "memory")
#define PG8_BAR __builtin_amdgcn_s_barrier()
#define PG8_SCHED __builtin_amdgcn_sched_barrier(0)
    Unit cur, nxt; int ui = 0;
    if (!S.next(0, cur)) return;
    f32x4 acc[2][2][4][2];
#pragma unroll
    for (int a = 0; a < 2; ++a)
#pragma unroll
        for (int b = 0; b < 2; ++b)
#pragma unroll
            for (int m = 0; m < 4; ++m)
#pragma unroll
                for (int n = 0; n < 2; ++n) acc[a][b][m][n] = (f32x4){0.f, 0.f, 0.f, 0.f};
    bf16x8 At[4][2], B0[2][2], B1[2][2];
    const char* cA = cur.A; const char* cB = cur.Bt;
    PG8_STAGE(PG8_SB(0, 0), cB, voffB); PG8_STAGE(PG8_SA(0, 0), cA, voffA); PG8_STAGE(PG8_SB(0, 1), cB + hstep, voffB); PG8_STAGE(PG8_SA(0, 1), cA + hstep, voffA);
    if (wr == 1) PG8_BAR;
    PG8_WAIT_V(4); PG8_BAR;
    PG8_STAGE(PG8_SB(1, 0), cB + kstep, voffB); PG8_STAGE(PG8_SA(1, 0), cA + kstep, voffA); PG8_STAGE(PG8_SB(1, 1), cB + hstep + kstep, voffB);
    PG8_WAIT_V(6); PG8_BAR;
    for (;;) {
        const bool has_next = S.next(ui + 1, nxt);
        const char* nA = has_next ? nxt.A : cA; const char* nB = has_next ? nxt.Bt : cB;
        for (int t = 0; t < nt; t += 2) {
            const bool last = (t == nt - 2);
            const char* a1 = cA + (size_t)(t + 1) * kstep;
            const char* a2 = last ? nA : cA + (size_t)(t + 2) * kstep; const char* b2 = last ? nB : cB + (size_t)(t + 2) * kstep;
            const char* a3 = a2 + kstep; const char* b3 = b2 + kstep;
            PG8_LDB(B0, 0, 0); PG8_SCHED; PG8_LDA(At, 0, 0); PG8_STAGE(PG8_SA(1, 1), a1 + hstep, voffA);
            PG8_WAIT_L(8); PG8_BAR; PG8_WAIT_L(0); PG8_MMA(0, 0, At, B0); PG8_BAR; PG8_SCHED;
            PG8_LDB(B1, 0, 1); PG8_STAGE(PG8_SB(0, 0), b2, voffB);
            PG8_BAR; PG8_WAIT_L(0); PG8_MMA(0, 1, At, B1); PG8_BAR;
            PG8_LDA(At, 0, 1); PG8_STAGE(PG8_SA(0, 0), a2, voffA);
            PG8_BAR; PG8_WAIT_L(0); PG8_MMA(1, 0, At, B0); PG8_BAR; PG8_SCHED;
            PG8_STAGE(PG8_SB(0, 1), b2 + hstep, voffB);
            PG8_WAIT_V(6); PG8_BAR; PG8_MMA(1, 1, At, B1); PG8_BAR;
            PG8_LDB(B0, 1, 0); PG8_SCHED; PG8_LDA(At, 1, 0); PG8_STAGE(PG8_SA(0, 1), a2 + hstep, voffA);
            PG8_WAIT_L(8); PG8_BAR; PG8_WAIT_L(0); PG8_MMA(0, 0, At, B0); PG8_BAR; PG8_SCHED;
            PG8_LDB(B1, 1, 1); PG8_STAGE(PG8_SB(1, 0), b3, voffB);
            PG8_BAR; PG8_WAIT_L(0); PG8_MMA(0, 1, At, B1); PG8_BAR;
            PG8_LDA(At, 1, 1); PG8_STAGE(PG8_SA(1, 0), a3, voffA);
            PG8_BAR; PG8_WAIT_L(0); PG8_MMA(1, 0, At, B0); PG8_BAR; PG8_SCHED;
            PG8_STAGE(PG8_SB(1, 1), b3 + hstep, voffB);
            PG8_WAIT_V(6); PG8_BAR; PG8_MMA(1, 1, At, B1); PG8_BAR;
        }
        E(acc, cur, wr, wc, fr, fq);
        if (!has_next) break;
#pragma unroll
        for (int a = 0; a < 2; ++a)
#pragma unroll
            for (int b = 0; b < 2; ++b)
#pragma unroll
                for (int m = 0; m < 4; ++m)
#pragma unroll
                    for (int n = 0; n < 2; ++n) acc[a][b][m][n] = (f32x4){0.f, 0.f, 0.f, 0.f};
        cur = nxt; cA = nA; cB = nB; ++ui;
    }
    PG8_WAIT_V(0);
    if (wr == 0) PG8_BAR;
    PG8_BAR;
#undef PG8_SA
#undef PG8_SB
#undef PG8_STAGE
#undef PG8_LDA
#undef PG8_LDB
#undef PG8_MMA
#undef PG8_WAIT_V
#undef PG8_WAIT_L
#undef PG8_BAR
#undef PG8_SCHED
}

struct EpiStoreBf16 {
    static constexpr bool PERM = true;
    __device__ __forceinline__ void operator()(const f32x4 (&acc)[2][2][4][2], const Unit& u, int wr, int wc, int fr, int fq) const {
        bf16_t* O = u.out; const int ldc = u.ldo;
        const int row0 = u.x0 + wr * 64 + fr, col0 = u.x1 + wc * 32 + 8 * fq;
#pragma unroll
        for (int ai = 0; ai < 2; ++ai)
#pragma unroll
            for (int m = 0; m < 4; ++m) { bf16_t* rowp = O + (size_t)(row0 + ai * HALF + m * 16) * ldc + col0;
#pragma unroll
                for (int bj = 0; bj < 2; ++bj) { const f32x4 v0 = acc[ai][bj][m][0], v1 = acc[ai][bj][m][1];
                    u32x4 w; w.x = cvt_pk_bf16(v0[0], v0[1]); w.y = cvt_pk_bf16(v0[2], v0[3]); w.z = cvt_pk_bf16(v1[0], v1[1]); w.w = cvt_pk_bf16(v1[2], v1[3]);
                    *(u32x4*)(rowp + bj * HALF) = w; } }
    }
};
}

namespace mk {
struct NMapId { int off; __device__ __forceinline__ int operator()(int n) const { return n + off; } __device__ __forceinline__ float scl(int) const { return 1.0f; } };
struct NMapInterleave { int which; __device__ __forceinline__ int operator()(int n) const { return 2 * n + which; } __device__ __forceinline__ float scl(int) const { return 1.0f; } };
struct NMapRope { __device__ __forceinline__ int operator()(int n) const { if (n >= 2048) return n; const int ch = n >> 6, c = n & 63, half = c >> 5, w = c & 31, z = w >> 4, i = w & 15; return ch * 64 + half * 32 + 2 * i + z; }
  __device__ __forceinline__ float scl(int n) const { return n < 1024 ? 0.125f * 1.4426950408889634f : 1.0f; } };

template <class NMap>
__device__ __forceinline__ void cvt_tile(const float* __restrict__ src, int ldsrc, int K, bf16_t* __restrict__ dst, int k0, int n0, const NMap& nmap, LAS float* tile) {
  const int t = mk::otid();
  { const int k = t >> 3, c = (t & 7) * 8; const float* p = src + (size_t)(k0 + k) * ldsrc + n0 + c;
    const f32x4 a = *(const f32x4*)p, b = *(const f32x4*)(p + 4);
    LAS float* q = tile + k * 65 + c; q[0] = a[0]; q[1] = a[1]; q[2] = a[2]; q[3] = a[3]; q[4] = b[0]; q[5] = b[1]; q[6] = b[2]; q[7] = b[3]; }
  __syncthreads();
  { const int n = t >> 3, kc = (t & 7) * 8; const LAS float* q = tile + kc * 65 + n; const float sc = nmap.scl(n0 + n);
    u32x4 w; w.x = cvt_pk_bf16(q[0] * sc, q[65] * sc); w.y = cvt_pk_bf16(q[130] * sc, q[195] * sc); w.z = cvt_pk_bf16(q[260] * sc, q[325] * sc); w.w = cvt_pk_bf16(q[390] * sc, q[455] * sc);
    *(u32x4*)(dst + (size_t)nmap(n0 + n) * K + k0 + kc) = w; }
  __syncthreads();
}
template <class NMap>
__device__ __forceinline__ int cvt_matrix(const float* src, int ldsrc, int K, int N, bf16_t* dst, const NMap& nmap, LAS float* tile, int ubase, int bid, int nblk) {
  const int nkt = K / 64, nnt = N / 64, tot = nkt * nnt;
  int first = ubase + ((bid - ubase % nblk) + nblk) % nblk;
  for (int u = first; u < ubase + tot; u += nblk) { const int v = u - ubase; cvt_tile(src, ldsrc, K, dst, (v / nnt) * 64, (v % nnt) * 64, nmap, tile); }
  return tot;
}
}

namespace att {
using namespace mk;
constexpr int KB_BYTES = 64 * 128, VB_BYTES = 128 * 128, TILE_BYTES = KB_BYTES + VB_BYTES, DA_RING = 4, DA_LDS = DA_RING * TILE_BYTES;
__device__ __forceinline__ int pi32(int r) { return (r & ~12) | ((r & 4) << 1) | ((r & 8) >> 1); }
__device__ __forceinline__ int swz(int row, int chunk) { return row * 128 + ((chunk ^ ((row >> 1) & 7)) << 4); }
__device__ __forceinline__ int crow(int r, int hi) { return (r & 3) + 8 * (r >> 2) + 4 * hi; }

__device__ __forceinline__ float sumsq8(u32x4 w) { return (bflo(w.x) * bflo(w.x) + bfhi(w.x) * bfhi(w.x)) + (bflo(w.y) * bflo(w.y) + bfhi(w.y) * bfhi(w.y)) + (bflo(w.z) * bflo(w.z) + bfhi(w.z) * bfhi(w.z)) + (bflo(w.w) * bflo(w.w) + bfhi(w.w) * bfhi(w.w)); }
__device__ __forceinline__ void knorm_group(const bf16_t* __restrict__ Pqk, float* __restrict__ KN, int g, LAS float* red) {
  const int tid = mk::otid(), wid = tid >> 6, lane = tid & 63;
  float mx = 0.f;
  for (int i0 = 0; i0 < 160; i0 += 32) {
    u32x4 a[4], b[4];
#pragma unroll
    for (int j = 0; j < 4; ++j) { int i = i0 + j * 8 + wid; i = i < 132 ? i : wid; const int row = i < 128 ? g * 128 + i : NLAT + g * 4 + (i - 128);
      const bf16_t* kp = Pqk + (size_t)row * 2048 + 1024 + lane * 16; a[j] = *(const u32x4*)kp; b[j] = *(const u32x4*)(kp + 8); }
#pragma unroll
    for (int j = 0; j < 4; ++j) { float s = sumsq8(a[j]) + sumsq8(b[j]); s += dpp_mov<0xB1, 0xf, 0xf>(s, s); s += dpp_mov<0x4E, 0xf, 0xf>(s, s); mx = fmaxf(mx, s); }
  }
  if ((lane & 3) == 0) red[wid * 16 + (lane >> 2)] = mx;
  __syncthreads();
  if (tid < 16) { float m = red[tid];
#pragma unroll
    for (int w = 1; w < 8; ++w) m = fmaxf(m, red[w * 16 + tid]);
    KN[g * 16 + tid] = m; }
  __syncthreads();
}
__device__ __forceinline__ float kmax2_of(const float* __restrict__ KN, int b, int hh) {
  return wave_max_u(KN[(b * 64 + (mk::otid() & 63)) * 16 + hh]);
}

template <int ABL = 0>
__device__ __forceinline__ void diff_attn_unit(const bf16_t* __restrict__ Pqk, const bf16_t* __restrict__ Vt, bf16_t* __restrict__ O12, int hh, int q0, int klat0, int nlat, int kctx0, float kmax2, LAS unsigned char* lds) {
  const int tid = mk::otid(), wid = tid >> 6, lane = tid & 63, r = lane & 31, hi = lane >> 5;
  const int NT = (nlat + L) / 64, NTL = nlat / 64;
  const int wv = __builtin_amdgcn_readfirstlane(wid);
  const int drow = wv * 8 + (lane >> 3), dch = (lane & 7) ^ ((drow >> 1) & 7);
  const bf16_t* kbase = Pqk + 1024 + hh * 64 + dch * 8;
  const bf16_t* vbase = Vt + (size_t)((hh >> 1) * 128 + drow) * NTOK + dch * 8;
  bf16x8 qf[4];
  { const bf16_t* qp = Pqk + (size_t)(q0 + wid * 32 + r) * 2048 + hh * 64 + hi * 8;
#pragma unroll
    for (int ks = 0; ks < 4; ++ks) qf[ks] = *(const bf16x8*)(qp + ks * 16); }
  int kaddr[2];
#pragma unroll
  for (int kb = 0; kb < 2; ++kb) kaddr[kb] = (kb * 32 + pi32(r)) * 128;
  const int kx = (pi32(r) >> 1) & 7;
  const int vx = (r >> 1) & 7;
  f32x16 o[4];
#pragma unroll
  for (int vb = 0; vb < 4; ++vb)
#pragma unroll
    for (int i = 0; i < 16; ++i) o[vb][i] = 0.f;
  float l_run = 0.f;
#define DA_DMA(t) do { const int tok = (t) < NTL ? klat0 + (t) * 64 : kctx0 + ((t) - NTL) * 64; LAS unsigned char* b_ = lds + ((t) & 3) * TILE_BYTES + wv * 1024; \
    __builtin_amdgcn_global_load_lds((const unsigned*)(kbase + (size_t)(tok + drow) * 2048), (LAS unsigned*)b_, 16, 0, 0); \
    __builtin_amdgcn_global_load_lds((const unsigned*)(vbase + tok), (LAS unsigned*)(b_ + KB_BYTES), 16, 0, 0); \
    __builtin_amdgcn_global_load_lds((const unsigned*)(vbase + (size_t)64 * NTOK + tok), (LAS unsigned*)(b_ + KB_BYTES + 8192), 16, 0, 0); } while (0)
#define DA_WAITV(n) asm volatile("s_waitcnt vmcnt(" #n ")" ::: "memory")
#define DA_TILE_BEGIN(t) if (!(ABL & 8) && (t) + 3 < NT) DA_DMA((t) + 3); const LAS unsigned char* kb_ = lds + ((t) & 3) * TILE_BYTES; const LAS unsigned char* vb_ = kb_ + KB_BYTES
#define DA_TILE_END(t) do { if ((t) + 3 < NT) DA_WAITV(3); else DA_WAITV(0); asm volatile("s_waitcnt lgkmcnt(0)" ::: "memory"); if (!(ABL & 16)) __builtin_amdgcn_s_barrier(); } while (0)
  DA_DMA(0); DA_DMA(1); DA_DMA(2);
  float qn2 = 0.f;
#pragma unroll
  for (int ks = 0; ks < 4; ++ks) { const u32x4 w = __builtin_bit_cast(u32x4, qf[ks]);
    qn2 += bflo(w.x) * bflo(w.x) + bfhi(w.x) * bfhi(w.x) + bflo(w.y) * bflo(w.y) + bfhi(w.y) * bfhi(w.y) + bflo(w.z) * bflo(w.z) + bfhi(w.z) * bfhi(w.z) + bflo(w.w) * bflo(w.w) + bfhi(w.w) * bfhi(w.w); }
  { const u32x2 sw = __builtin_amdgcn_permlane32_swap(__float_as_uint(qn2), __float_as_uint(qn2), false, false); qn2 = __uint_as_float(sw.x) + __uint_as_float(sw.y); }
  const float m_stat = sqrtf(qn2 * kmax2) * 1.0001f;
  const bool use_static = __all(m_stat <= 60.0f);
  DA_WAITV(3); __builtin_amdgcn_s_barrier();
#define DA_KFRAG(ks) const int ch = (((ks) * 2 + hi) ^ kx) << 4; const bf16x8 a0 = (ABL & 2) ? qf[ks] : *(const LAS bf16x8*)(kb_ + kaddr[0] + ch), a1 = (ABL & 2) ? qf[(ks) ^ 1] : *(const LAS bf16x8*)(kb_ + kaddr[1] + ch)
#define DA_VFRAGS() bf16x8 va[4][4]; \
    _Pragma("unroll") for (int vb = 0; vb < 4; ++vb) { const LAS unsigned char* vrow = vb_ + (vb * 32 + r) * 128; \
      _Pragma("unroll") for (int c4 = 0; c4 < 4; ++c4) va[vb][c4] = (ABL & 1) ? qf[c4 ^ (vb & 3)] : *(const LAS bf16x8*)(vrow + (((2 * c4 + hi) ^ vx) << 4)); }
#define DA_PACK_PV() bf16x8 pf[2][2]; \
    _Pragma("unroll") for (int s = 0; s < 2; ++s) { u32x4 w0, w1; \
      w0.x = cvt_pk_bf16(s0[8 * s + 0], s0[8 * s + 1]); w0.y = cvt_pk_bf16(s0[8 * s + 2], s0[8 * s + 3]); w0.z = cvt_pk_bf16(s0[8 * s + 4], s0[8 * s + 5]); w0.w = cvt_pk_bf16(s0[8 * s + 6], s0[8 * s + 7]); \
      w1.x = cvt_pk_bf16(s1[8 * s + 0], s1[8 * s + 1]); w1.y = cvt_pk_bf16(s1[8 * s + 2], s1[8 * s + 3]); w1.z = cvt_pk_bf16(s1[8 * s + 4], s1[8 * s + 5]); w1.w = cvt_pk_bf16(s1[8 * s + 6], s1[8 * s + 7]); \
      pf[0][s] = __builtin_bit_cast(bf16x8, w0); pf[1][s] = __builtin_bit_cast(bf16x8, w1); } \
    _Pragma("unroll") for (int vb = 0; vb < 4; ++vb) _Pragma("unroll") for (int kb = 0; kb < 2; ++kb) _Pragma("unroll") for (int s = 0; s < 2; ++s) \
      o[vb] = __builtin_amdgcn_mfma_f32_32x32x16_bf16(va[vb][kb * 2 + s], pf[kb][s], o[vb], 0, 0, 0)
  if (use_static) {
    bf16x8 kf[2][4];
#define DA_READK(slot) do { const LAS unsigned char* kq_ = lds + (slot) * TILE_BYTES; \
      _Pragma("unroll") for (int ks = 0; ks < 4; ++ks) { const int ch = ((ks * 2 + hi) ^ kx) << 4; \
        kf[0][ks] = (ABL & 2) ? qf[ks] : *(const LAS bf16x8*)(kq_ + kaddr[0] + ch); kf[1][ks] = (ABL & 2) ? qf[ks ^ 1] : *(const LAS bf16x8*)(kq_ + kaddr[1] + ch); } } while (0)
    DA_READK(0);
    for (int t = 0; t < NT; ++t) {
      DA_TILE_BEGIN(t); (void)kb_;
      f32x16 s0, s1;
#pragma unroll
      for (int i = 0; i < 16; ++i) { s0[i] = 0.f; s1[i] = 0.f; }
#pragma unroll
      for (int ks = 0; ks < 4; ++ks) { s0 = __builtin_amdgcn_mfma_f32_32x32x16_bf16(kf[0][ks], qf[ks], s0, 0, 0, 0); s1 = __builtin_amdgcn_mfma_f32_32x32x16_bf16(kf[1][ks], qf[ks], s1, 0, 0, 0); }
      DA_VFRAGS();
      DA_READK(t + 1 < NT ? (t + 1) & 3 : t & 3);
      if constexpr ((ABL & 32) != 0) {
        l_run += s0[0] + s1[0];
#pragma unroll
        for (int vb = 0; vb < 4; ++vb)
#pragma unroll
          for (int c4 = 0; c4 < 4; ++c4) o[vb] = __builtin_amdgcn_mfma_f32_32x32x16_bf16(va[vb][c4], qf[c4], o[vb], 0, 0, 0);
      } else {
      float ps = 0.f;
#pragma unroll
      for (int i = 0; i < 16; ++i) { s0[i] = (ABL & 4) ? s0[i] : __builtin_amdgcn_exp2f(s0[i]); ps += s0[i]; }
#pragma unroll
      for (int i = 0; i < 16; ++i) { s1[i] = (ABL & 4) ? s1[i] : __builtin_amdgcn_exp2f(s1[i]); ps += s1[i]; }
      l_run += ps;
      DA_PACK_PV();
      }
      DA_TILE_END(t);
    }
#undef DA_READK
  } else {
    constexpr float THR = 8.0f * 1.4426950408889634f;
    float m_run = -1e30f;
    for (int t = 0; t < NT; ++t) {
      DA_TILE_BEGIN(t);
      f32x16 s0 = zero16(), s1 = zero16();
#pragma unroll
      for (int ks = 0; ks < 4; ++ks) { DA_KFRAG(ks); s0 = __builtin_amdgcn_mfma_f32_32x32x16_bf16(a0, qf[ks], s0, 0, 0, 0); s1 = __builtin_amdgcn_mfma_f32_32x32x16_bf16(a1, qf[ks], s1, 0, 0, 0); }
      DA_VFRAGS();
      float mx = fmaxf(s0[0], s1[0]);
#pragma unroll
      for (int i = 1; i < 16; ++i) mx = fmaxf(mx, fmaxf(s0[i], s1[i]));
      { const u32x2 sw = __builtin_amdgcn_permlane32_swap(__float_as_uint(mx), __float_as_uint(mx), false, false); mx = fmaxf(__uint_as_float(sw.x), __uint_as_float(sw.y)); }
      float alpha = 1.0f;
      if (!__all(mx - m_run <= THR)) {
        const float m_new = fmaxf(m_run, mx);
        alpha = __builtin_amdgcn_exp2f(m_run - m_new);
        m_run = m_new;
#pragma unroll
        for (int vb = 0; vb < 4; ++vb)
#pragma unroll
          for (int i = 0; i < 16; ++i) o[vb][i] *= alpha;
      }
      float ps = 0.f;
#pragma unroll
      for (int i = 0; i < 16; ++i) { s0[i] = __builtin_amdgcn_exp2f(s0[i] - m_run); ps += s0[i]; }
#pragma unroll
      for (int i = 0; i < 16; ++i) { s1[i] = __builtin_amdgcn_exp2f(s1[i] - m_run); ps += s1[i]; }
      l_run = l_run * alpha + ps;
      DA_PACK_PV();
      DA_TILE_END(t);
    }
  }
#undef DA_KFRAG
#undef DA_VFRAGS
#undef DA_PACK_PV
#undef DA_DMA
#undef DA_WAITV
#undef DA_TILE_BEGIN
#undef DA_TILE_END
  float l_tot; { const u32x2 sw = __builtin_amdgcn_permlane32_swap(__float_as_uint(l_run), __float_as_uint(l_run), false, false); l_tot = __uint_as_float(sw.x) + __uint_as_float(sw.y); }
  const float inv = 1.0f / l_tot;
  bf16_t* op = O12 + (size_t)(q0 + wid * 32 + r) * 2048 + hh * 128 + 4 * hi;
#pragma unroll
  for (int vb = 0; vb < 4; ++vb)
#pragma unroll
    for (int g = 0; g < 4; ++g) {
      u32x2 w; w.x = cvt_pk_bf16(o[vb][4 * g] * inv, o[vb][4 * g + 1] * inv); w.y = cvt_pk_bf16(o[vb][4 * g + 2] * inv, o[vb][4 * g + 3] * inv);
      *(u32x2*)(op + vb * 32 + 8 * g) = w;
    }
}

__device__ __forceinline__ void diff_combine_rows4(const bf16_t* __restrict__ O12, const float* __restrict__ subln_g, float lam, float oml, bf16_t* __restrict__ O, int row0, int h, int lane) {
  unsigned a[4], b[4];
#pragma unroll
  for (int i = 0; i < 4; ++i) { a[i] = *(const unsigned*)(O12 + (size_t)(row0 + i) * 2048 + (2 * h) * 128 + 2 * lane); b[i] = *(const unsigned*)(O12 + (size_t)(row0 + i) * 2048 + (2 * h + 1) * 128 + 2 * lane); }
  const float g0 = subln_g[2 * lane], g1 = subln_g[2 * lane + 1];
#pragma unroll
  for (int i = 0; i < 4; ++i) {
    const float x0 = bflo(a[i]) - lam * bflo(b[i]), x1 = bfhi(a[i]) - lam * bfhi(b[i]);
    const float ss = wave_sum_u(x0 * x0 + x1 * x1);
    const float rs = rsqrtf(ss * (1.0f / 128.0f) + 1e-5f) * oml;
    *(unsigned*)(O + (size_t)(row0 + i) * 1024 + h * 128 + 2 * lane) = cvt_pk_bf16(x0 * rs * g0, x1 * rs * g1);
  }
}
}

namespace natt {
using namespace mk;
using att::pi32; using att::swz;
constexpr int TB = 64 * 128;
constexpr int NA_LDS = 4 * TB + 2048;
__device__ __forceinline__ void na_attn_unit(const bf16_t* __restrict__ Pe, const bf16_t* __restrict__ Vte, const float* __restrict__ rpb_h, bf16_t* __restrict__ O, int b, int h, int rq, LAS unsigned char* lds) {
  const int tid = mk::otid(), wid = tid >> 6, lane = tid & 63, r = lane & 31, hi = lane >> 5;
  constexpr float LOG2E = 1.4426950408889634f;
  LAS float* sb = (LAS float*)(lds + 4 * TB);
  for (int i = tid; i < 465; i += NTHR) sb[i] = rpb_h[i];
  const bool is_ctx = rq < 0;
  int qrow = 0, qcol = 0, qtok, rs_q = 0, cs_q = 0, span0 = 0, wlo = 0, whi = -1, lo = 0, ntl = 0;
  if (!is_ctx) {
    const int r0 = rq * 4, ra = r0 + (wid >> 2) * 2;
    qrow = ra + (r >> 4); qcol = (wid & 3) * 16 + (r & 15); qtok = b * T + qrow * 64 + qcol;
    rs_q = min(max(qrow - 4, 0), 120); cs_q = min(max(qcol - 8, 0), 48);
    span0 = min(max((wid & 3) * 16 - 8, 0), 32);
    wlo = min(max(ra - 4, 0), 120); whi = min(max(ra - 3, 0), 120) + 7;
    lo = min(max(r0 - 4, 0), 120); const int hi_ = min(max(r0 - 1, 0), 120) + 7; ntl = hi_ - lo + 1;
  } else qtok = NLAT + b * L + wid * 32 + r;
  const int NT = ntl + 4;
  const int srow = tid >> 3, sch = tid & 7;
  const bf16_t* kbase = Pe + 512 + h * 64 + sch * 8;
  const bf16_t* vbase = Vte + (size_t)(h * 64 + srow) * NTOK + sch * 8;
  const int sdst = swz(srow, sch);
  bf16x8 qf[4];
  { const bf16_t* qp = Pe + (size_t)qtok * 1024 + h * 64 + hi * 8;
#pragma unroll
    for (int ks = 0; ks < 4; ++ks) qf[ks] = *(const bf16x8*)(qp + ks * 16); }
  const int kx = (pi32(r) >> 1) & 7, vx = (r >> 1) & 7;
  const int ka_loc = (span0 + pi32(r)) * 128; const int kx_loc = ((span0 + pi32(r)) >> 1) & 7;
  f32x16 o[2];
#pragma unroll
  for (int vb = 0; vb < 2; ++vb)
#pragma unroll
    for (int i = 0; i < 16; ++i) o[vb][i] = 0.f;
  float m_run = -1e30f, l_run = 0.f;
  u32x4 kreg, vreg;
#define NA_LOAD(t) do { const int tok = (t) < ntl ? b * T + (lo + (t)) * 64 : NLAT + b * L + ((t) - ntl) * 64; \
    kreg = *(const u32x4*)(kbase + (size_t)(tok + srow) * 1024); vreg = *(const u32x4*)(vbase + tok); } while (0)
#define NA_WRITE(bufi) do { *(LAS u32x4*)(lds + (bufi) * TB + sdst) = kreg; *(LAS u32x4*)(lds + 2 * TB + (bufi) * TB + sdst) = vreg; } while (0)
  NA_LOAD(0); NA_WRITE(0); __syncthreads();
  for (int t = 0; t < NT; ++t) {
    const bool more = t + 1 < NT;
    if (more) NA_LOAD(t + 1);
    const LAS unsigned char* kb_ = lds + (t & 1) * TB; const LAS unsigned char* vb_ = lds + 2 * TB + (t & 1) * TB;
    const bool local = t < ntl; const int kr = lo + t;
    const bool active = !local || (kr >= wlo && kr <= whi);
    if (active) {
      f32x16 s0, s1;
#pragma unroll
      for (int i = 0; i < 16; ++i) { s0[i] = 0.f; s1[i] = 0.f; }
      if (local) {
#pragma unroll
        for (int ks = 0; ks < 4; ++ks) {
          const bf16x8 a0 = *(const LAS bf16x8*)(kb_ + ka_loc + (((ks * 2 + hi) ^ kx_loc) << 4));
          s0 = __builtin_amdgcn_mfma_f32_32x32x16_bf16(a0, qf[ks], s0, 0, 0, 0);
        }
        const bool row_ok = kr >= rs_q && kr < rs_q + 8; const int dr31 = (kr - qrow + 7) * 31;
#pragma unroll
        for (int i = 0; i < 16; ++i) {
          const int kc = span0 + (i & 7) + 8 * hi + 16 * (i >> 3);
          const bool ok = row_ok && kc >= cs_q && kc < cs_q + 16;
          const int bi = ok ? dr31 + (kc - qcol + 15) : 0;
          const float bv = sb[bi];
          s0[i] = ok ? fmaf(s0[i], 0.125f, bv) : -1e30f; s1[i] = -1e30f;
        }
      } else {
#pragma unroll
        for (int ks = 0; ks < 4; ++ks) {
          const int ch = ((ks * 2 + hi) ^ kx) << 4;
          const bf16x8 a0 = *(const LAS bf16x8*)(kb_ + pi32(r) * 128 + ch), a1 = *(const LAS bf16x8*)(kb_ + (32 + pi32(r)) * 128 + ch);
          s0 = __builtin_amdgcn_mfma_f32_32x32x16_bf16(a0, qf[ks], s0, 0, 0, 0);
          s1 = __builtin_amdgcn_mfma_f32_32x32x16_bf16(a1, qf[ks], s1, 0, 0, 0);
        }
#pragma unroll
        for (int i = 0; i < 16; ++i) { s0[i] *= 0.125f; s1[i] *= 0.125f; }
      }
      float mx = s0[0];
#pragma unroll
      for (int i = 1; i < 16; ++i) mx = fmaxf(mx, s0[i]);
#pragma unroll
      for (int i = 0; i < 16; ++i) mx = fmaxf(mx, s1[i]);
      { const u32x2 sw = __builtin_amdgcn_permlane32_swap(__float_as_uint(mx), __float_as_uint(mx), false, false); mx = fmaxf(__uint_as_float(sw.x), __uint_as_float(sw.y)); }
      const float m_new = fmaxf(m_run, mx);
      const float alpha = __builtin_amdgcn_exp2f((m_run - m_new) * LOG2E);
      m_run = m_new;
      const float mc = -m_new * LOG2E;
      float ps = 0.f;
#pragma unroll
      for (int i = 0; i < 16; ++i) { const float p = s0[i] > -1e29f ? __builtin_amdgcn_exp2f(fmaf(s0[i], LOG2E, mc)) : 0.f; s0[i] = p; ps += p; }
#pragma unroll
      for (int i = 0; i < 16; ++i) { const float p = s1[i] > -1e29f ? __builtin_amdgcn_exp2f(fmaf(s1[i], LOG2E, mc)) : 0.f; s1[i] = p; ps += p; }
      l_run = l_run * alpha + ps;
      if (__any(alpha < 1.0f)) {
#pragma unroll
        for (int vb = 0; vb < 2; ++vb)
#pragma unroll
          for (int i = 0; i < 16; ++i) o[vb][i] *= alpha;
      }
      bf16x8 pf[2][2];
#pragma unroll
      for (int s = 0; s < 2; ++s) {
        u32x4 w0, w1;
        w0.x = cvt_pk_bf16(s0[8 * s + 0], s0[8 * s + 1]); w0.y = cvt_pk_bf16(s0[8 * s + 2], s0[8 * s + 3]); w0.z = cvt_pk_bf16(s0[8 * s + 4], s0[8 * s + 5]); w0.w = cvt_pk_bf16(s0[8 * s + 6], s0[8 * s + 7]);
        w1.x = cvt_pk_bf16(s1[8 * s + 0], s1[8 * s + 1]); w1.y = cvt_pk_bf16(s1[8 * s + 2], s1[8 * s + 3]); w1.z = cvt_pk_bf16(s1[8 * s + 4], s1[8 * s + 5]); w1.w = cvt_pk_bf16(s1[8 * s + 6], s1[8 * s + 7]);
        pf[0][s] = __builtin_bit_cast(bf16x8, w0); pf[1][s] = __builtin_bit_cast(bf16x8, w1);
      }
      const int cbase = local ? (span0 >> 3) : 0;
#pragma unroll
      for (int vb = 0; vb < 2; ++vb) {
        const LAS unsigned char* vrow = vb_ + (vb * 32 + r) * 128;
#pragma unroll
        for (int s = 0; s < 2; ++s) {
          const bf16x8 a = *(const LAS bf16x8*)(vrow + (((cbase + 2 * s + hi) ^ vx) << 4));
          o[vb] = __builtin_amdgcn_mfma_f32_32x32x16_bf16(a, pf[0][s], o[vb], 0, 0, 0);
        }
        if (!local) {
#pragma unroll
          for (int s = 0; s < 2; ++s) {
            const bf16x8 a = *(const LAS bf16x8*)(vrow + (((4 + 2 * s + hi) ^ vx) << 4));
            o[vb] = __builtin_amdgcn_mfma_f32_32x32x16_bf16(a, pf[1][s], o[vb], 0, 0, 0);
          }
        }
      }
    }
    if (more) NA_WRITE((t + 1) & 1);
    __syncthreads();
  }
#undef NA_LOAD
#undef NA_WRITE
  float l_tot; { const u32x2 sw = __builtin_amdgcn_permlane32_swap(__float_as_uint(l_run), __float_as_uint(l_run), false, false); l_tot = __uint_as_float(sw.x) + __uint_as_float(sw.y); }
  const float inv = 1.0f / l_tot;
  bf16_t* op = O + (size_t)qtok * 1024 + h * 64 + 4 * hi;
#pragma unroll
  for (int vb = 0; vb < 2; ++vb)
#pragma unroll
    for (int g = 0; g < 4; ++g) {
      u32x2 w; w.x = cvt_pk_bf16(o[vb][4 * g] * inv, o[vb][4 * g + 1] * inv); w.y = cvt_pk_bf16(o[vb][4 * g + 2] * inv, o[vb][4 * g + 3] * inv);
      *(u32x2*)(op + vb * 32 + 8 * g) = w;
    }
}
}

namespace rw {
using namespace mk;
constexpr int NSTEP = L + T, NCH = 32, CL = NSTEP / NCH;
constexpr int NCHAIN = 2 * B * 8;
constexpr float LOG2E = 1.4426950408889634f;
struct Bufs {
  u32x2* SH;
  unsigned* DR;
  bf16_t* G; int gstride;
  float* CS;
  float* PQ;
  float* SST;
  bf16_t* Y;
  bf16_t* Z;
};

constexpr int XPITCH = 528;
__device__ __forceinline__ void lora_mfma(const LAS unsigned char* xb, int xcol0, const bf16_t* __restrict__ W, int K, int h, int lane, LAS float* tw, float (&out)[16]) {
  const int fr = lane & 15, fq = lane >> 4;
  f32x4 acc[4];
#pragma unroll
  for (int nb = 0; nb < 4; ++nb) { float z = 0.f; asm volatile("" : "+v"(z)); acc[nb] = (f32x4){z, z, z, z}; }
  for (int ks = 0; ks < K / 32; ++ks) {
    const bf16x8 xf = *(const LAS bf16x8*)(xb + fr * XPITCH + (xcol0 + ks * 32 + fq * 8) * 2);
    bf16x8 wf[4];
#pragma unroll
    for (int nb = 0; nb < 4; ++nb) wf[nb] = *(const bf16x8*)(W + (size_t)(h * 64 + nb * 16 + fr) * K + ks * 32 + fq * 8);
#pragma unroll
    for (int nb = 0; nb < 4; ++nb) acc[nb] = __builtin_amdgcn_mfma_f32_16x16x32_bf16(xf, wf[nb], acc[nb], 0, 0, 0);
  }
#pragma unroll
  for (int nb = 0; nb < 4; ++nb) *(LAS f32x4*)(tw + (nb * 16 + fr) * 16 + fq * 4) = acc[nb];
  __builtin_amdgcn_wave_barrier(); asm volatile("s_waitcnt lgkmcnt(0)" ::: "memory"); __builtin_amdgcn_wave_barrier();
#pragma unroll
  for (int q = 0; q < 4; ++q) { const f32x4 v = *(const LAS f32x4*)(tw + lane * 16 + q * 4); out[q * 4] = v[0]; out[q * 4 + 1] = v[1]; out[q * 4 + 2] = v[2]; out[q * 4 + 3] = v[3]; }
  __builtin_amdgcn_wave_barrier(); asm volatile("s_waitcnt lgkmcnt(0)" ::: "memory"); __builtin_amdgcn_wave_barrier();
}
__device__ __forceinline__ void prep_tile(const bf16_t* __restrict__ Prw, const float* __restrict__ cw, const float* __restrict__ w0, const bf16_t* __restrict__ WLT, const float* __restrict__ a0,
                                          const float* __restrict__ k_k, const float* __restrict__ k_a, const float* __restrict__ r_k,
                                          const Bufs& bf, int tile, LAS float* xs  ) {
  const int c = mk::otid(), lane = c & 63, h = c >> 6;
  const int row0 = tile * 16;
  int lo, hi;
  if (row0 < NLAT) { lo = (row0 / T) * T; hi = lo + T - 1; } else { lo = NLAT + ((row0 - NLAT) / L) * L; hi = lo + L - 1; }
#define RW_CONV(dst, col) do { const float c0 = cw[(col)], c1 = cw[RW_IN + (col)], c2 = cw[2 * RW_IN + (col)]; const bf16_t* p = Prw + (col); \
    bf16_t raw[18]; \
    _Pragma("unroll") for (int j = 0; j < 18; ++j) { int rr = row0 - 1 + j; rr = rr < lo ? lo : (rr > hi ? hi : rr); raw[j] = p[(size_t)rr * RW_IN]; } \
    float pm = row0 > lo ? bf2f(raw[0]) : 0.f, pc = bf2f(raw[1]); \
    _Pragma("unroll") for (int tt = 0; tt < 16; ++tt) { const float pn = (row0 + tt + 1 <= hi) ? bf2f(raw[tt + 2]) : 0.f; dst[tt] = pm * c0 + pc * c1 + pn * c2; pm = pc; pc = pn; } } while (0)
  if (c < 256) {
    float xv[16]; RW_CONV(xv, 1536 + c);
#pragma unroll
    for (int tt = 0; tt < 16; ++tt) { float v = xv[tt]; if (c < 64) v = tanhf(v); else if (c >= 128) v = sigmoidf_(v); *(LAS bf16_t*)((LAS unsigned char*)xs + tt * XPITCH + c * 2) = f2bf(v); }
  }
  __syncthreads();
  const LAS unsigned char* xb = (const LAS unsigned char*)xs; LAS float* tw = xs + 20480 + h * 1024;
  const float w00 = w0[c], w01 = w0[512 + c], a00 = a0[c], a01 = a0[512 + c], kkc = k_k[c], kac = k_a[c], rkc = r_k[c];
  float e0[16], e1[16];
  {
    float aw0[16], aw1[16];
    lora_mfma(xb, 0, WLT, 64, h, lane, tw, aw0); lora_mfma(xb, 0, WLT + 32768, 64, h, lane, tw, aw1);
#pragma unroll
    for (int tt = 0; tt < 16; ++tt) {
      { const float z = -(w00 + aw0[tt]); const float sp = fmaxf(z, 0.f) + __logf(1.0f + __expf(-fabsf(z))); e0[tt] = __expf(-sp - 0.5f); }
      { const float z = -(w01 + aw1[tt]); const float sp = fmaxf(z, 0.f) + __logf(1.0f + __expf(-fabsf(z))); e1[tt] = __expf(-sp - 0.5f); }
    }
  }
  LAS float* asl = xs + 256 * 16;
  {
    float aa0[16], aa1[16];
    lora_mfma(xb, 64, WLT + 2 * 32768, 64, h, lane, tw, aa0); lora_mfma(xb, 64, WLT + 3 * 32768, 64, h, lane, tw, aa1);
#pragma unroll
    for (int tt = 0; tt < 16; ++tt) { const unsigned d0 = cvt_pk_bf16(e0[tt], sigmoidf_(a00 + aa0[tt])), d1 = cvt_pk_bf16(e1[tt], sigmoidf_(a01 + aa1[tt]));
      bf.DR[((size_t)(row0 + tt)) * 512 + c] = d0; bf.DR[((size_t)NTOK + row0 + tt) * 512 + c] = d1; asl[tt * 512 + c] = bfhi(d0); asl[(16 + tt) * 512 + c] = bfhi(d1); }
  }
  {
    float ag[16];
    lora_mfma(xb, 128, WLT + 4 * 32768, 128, h, lane, tw, ag);
#pragma unroll
    for (int tt = 0; tt < 16; ++tt) bf.G[(size_t)(row0 + tt) * bf.gstride + c] = f2bf(ag[tt]);
  }
#undef RW_CONV
  const float cr0 = cw[c], cr1 = cw[RW_IN + c], cr2 = cw[2 * RW_IN + c], ck0 = cw[512 + c], ck1 = cw[RW_IN + 512 + c], ck2 = cw[2 * RW_IN + 512 + c], cv0 = cw[1024 + c], cv1 = cw[RW_IN + 1024 + c], cv2 = cw[2 * RW_IN + 1024 + c];
  const bf16_t* pr = Prw + (size_t)row0 * RW_IN + c;
  const bf16_t* prm = Prw + (size_t)(row0 > lo ? row0 - 1 : row0) * RW_IN + c;
  const bf16_t rm_ = prm[0], km_ = prm[512], vm_ = prm[1024];
  float rm = row0 > lo ? bf2f(rm_) : 0.f, km = row0 > lo ? bf2f(km_) : 0.f, vm = row0 > lo ? bf2f(vm_) : 0.f;
  float rc = bf2f(pr[0]), kc = bf2f(pr[512]), vc = bf2f(pr[1024]);
#pragma unroll 2
  for (int tt = 0; tt < 16; ++tt) {
    const int row = row0 + tt;
    const bool has_n = row + 1 <= hi; const bf16_t* pn = pr + (size_t)(has_n ? tt + 1 : tt) * RW_IN;
    const bf16_t rn_ = pn[0], kn_ = pn[512], vn_ = pn[1024];
    const float rn = has_n ? bf2f(rn_) : 0.f, kn = has_n ? bf2f(kn_) : 0.f, vn = has_n ? bf2f(vn_) : 0.f;
    const float rv = rm * cr0 + rc * cr1 + rn * cr2, kvv = km * ck0 + kc * ck1 + kn * ck2, vvv = vm * cv0 + vc * cv1 + vn * cv2;
    rm = rc; rc = rn; km = kc; kc = kn; vm = vc; vc = vn;
    float kk = kvv * kkc; const float nrm = sqrtf(wave_sum_u(kk * kk)); kk = kk * __builtin_amdgcn_rcpf(fmaxf(nrm, 1e-12f));
    u32x2 sh; sh.x = cvt_pk_bf16(rv, kvv); sh.y = cvt_pk_bf16(kk, vvv);
    bf.SH[(size_t)row * 512 + c] = sh;
    const float rq = bflo(sh.x), kq = bfhi(sh.x);
    const float cb0 = wave_sum_u(rq * kq * (1.0f + (asl[tt * 512 + c] - 1.0f) * kac) * rkc), cb1 = wave_sum_u(rq * kq * (1.0f + (asl[(16 + tt) * 512 + c] - 1.0f) * kac) * rkc);
    if (lane == 0) { bf.CS[(size_t)row * 16 + h] = cb0; bf.CS[(size_t)row * 16 + 8 + h] = cb1; }
  }
  __syncthreads();
}

struct StepRaw { u32x2 s; unsigned d; };
__device__ __forceinline__ int scan_row(int dir, int b, int p) {
  if (p < L) return NLAT + b * L + (dir ? (L - 1 - p) : p);
  const int q = p - L; return b * T + (dir ? (T - 1 - q) : q);
}
#define RW_RL(x, j) __int_as_float(__builtin_amdgcn_readlane(__float_as_int(x), (j)))
__device__ __forceinline__ void scan_unit(const Bufs& bf, const float* __restrict__ k_a, int chain, int chunk, LAS float* wl  ) {
  const int lane = mk::otid() & 63;
  const int dir = chain >> 5, b = (chain >> 3) & 3, h = chain & 7, ch = h * 64 + lane;
  const float kac = k_a[ch];
  float S[64], P[64];
#pragma unroll
  for (int j = 0; j < 64; ++j) { S[j] = 0.f; P[j] = (j == lane) ? 1.f : 0.f; }
  const int p0 = chunk * CL;
  StepRaw nx; { const int row = scan_row(dir, b, p0); nx.s = bf.SH[(size_t)row * 512 + ch]; nx.d = bf.DR[((size_t)dir * NTOK + row) * 512 + ch]; }
  for (int s = 0; s < CL; ++s) {
    const StepRaw cu = nx; const int row = scan_row(dir, b, p0 + s);
    if (s + 1 < CL) { const int rn = scan_row(dir, b, p0 + s + 1); nx.s = bf.SH[(size_t)rn * 512 + ch]; nx.d = bf.DR[((size_t)dir * NTOK + rn) * 512 + ch]; }
    const float r = bflo(cu.s.x), k = bfhi(cu.s.x), kk = bflo(cu.s.y), v = bfhi(cu.s.y), e = bflo(cu.d), asg = bfhi(cu.d);
    const float w = __builtin_amdgcn_exp2f(-e * LOG2E), a = -kk, bb = kk * asg, keff = k * (1.0f + (asg - 1.0f) * kac);
    wl[lane] = a; wl[64 + lane] = w; wl[128 + lane] = bb; wl[192 + lane] = keff; wl[256 + lane] = r;
    float sa = 0.f, sap = 0.f;
#pragma unroll
    for (int j4 = 0; j4 < 16; ++j4) { const f32x4 av = *(const LAS f32x4*)(wl + 4 * j4);
#pragma unroll
      for (int e2 = 0; e2 < 4; ++e2) { sa = fmaf(S[4 * j4 + e2], av[e2], sa); sap = fmaf(P[4 * j4 + e2], av[e2], sap); } }
    float y = 0.f, z = 0.f;
#pragma unroll
    for (int j4 = 0; j4 < 16; ++j4) {
      const f32x4 wv = *(const LAS f32x4*)(wl + 64 + 4 * j4), bv = *(const LAS f32x4*)(wl + 128 + 4 * j4), kv = *(const LAS f32x4*)(wl + 192 + 4 * j4), rv = *(const LAS f32x4*)(wl + 256 + 4 * j4);
#pragma unroll
      for (int e2 = 0; e2 < 4; ++e2) { const int j = 4 * j4 + e2;
        float t = v * kv[e2]; t = fmaf(sa, bv[e2], t); S[j] = fmaf(S[j], wv[e2], t);
        P[j] = fmaf(P[j], wv[e2], sap * bv[e2]);
        y = fmaf(S[j], rv[e2], y); z = fmaf(P[j], rv[e2], z); }
    }
    const size_t oi = ((size_t)dir * NTOK + row) * 512 + ch;
    bf.Y[oi] = f2bf(y); bf.Z[oi] = f2bf(z);
  }
  if (chunk < NCH - 1) {
    float* pq = bf.PQ + (((size_t)chain * (NCH - 1) + chunk) * 2) * 4096 + lane * 64;
#pragma unroll
    for (int q = 0; q < 16; ++q) { *(f32x4*)(pq + q * 4) = (f32x4){P[q * 4], P[q * 4 + 1], P[q * 4 + 2], P[q * 4 + 3]}; *(f32x4*)(pq + 4096 + q * 4) = (f32x4){S[q * 4], S[q * 4 + 1], S[q * 4 + 2], S[q * 4 + 3]}; }
  }
}

__device__ __forceinline__ void propagate_chain(const Bufs& bf, int chain, LAS float* lds) {
  LAS float* Sl = lds; LAS float* Pl = lds + 64 * 65;
  const int tid = mk::otid(), i = tid >> 3, jg = (tid & 7) * 8;
  float* sst = bf.SST + (size_t)chain * NCH * 4096;
#pragma unroll
  for (int e = 0; e < 8; ++e) Sl[i * 65 + jg + e] = 0.f;
  const float* pq0 = bf.PQ + ((size_t)chain * (NCH - 1) * 2) * 4096 + i * 64 + jg;
  f32x4 np0 = *(const f32x4*)pq0, np1 = *(const f32x4*)(pq0 + 4), nq0 = *(const f32x4*)(pq0 + 4096), nq1 = *(const f32x4*)(pq0 + 4096 + 4);
  for (int c = 0; c < NCH - 1; ++c) {
    const f32x4 p0 = np0, p1 = np1; f32x4 q0 = nq0, q1 = nq1;
    { const float* pqn = pq0 + (size_t)(c + 1 < NCH - 1 ? c + 1 : c) * 2 * 4096;
      np0 = *(const f32x4*)pqn; np1 = *(const f32x4*)(pqn + 4); nq0 = *(const f32x4*)(pqn + 4096); nq1 = *(const f32x4*)(pqn + 4096 + 4); }
    *(LAS f32x4*)(Pl + i * 64 + jg) = p0; *(LAS f32x4*)(Pl + i * 64 + jg + 4) = p1;
    __syncthreads();
#pragma unroll 8
    for (int k = 0; k < 64; ++k) { const float sv = Sl[i * 65 + k]; const f32x4 a = *(const LAS f32x4*)(Pl + k * 64 + jg), b2 = *(const LAS f32x4*)(Pl + k * 64 + jg + 4); q0 += sv * a; q1 += sv * b2; }
    __syncthreads();
    Sl[i * 65 + jg] = q0[0]; Sl[i * 65 + jg + 1] = q0[1]; Sl[i * 65 + jg + 2] = q0[2]; Sl[i * 65 + jg + 3] = q0[3]; Sl[i * 65 + jg + 4] = q1[0]; Sl[i * 65 + jg + 5] = q1[1]; Sl[i * 65 + jg + 6] = q1[2]; Sl[i * 65 + jg + 7] = q1[3];
    *(f32x4*)(sst + (size_t)(c + 1) * 4096 + i * 64 + jg) = q0; *(f32x4*)(sst + (size_t)(c + 1) * 4096 + i * 64 + jg + 4) = q1;
  }
  __syncthreads();
}

__device__ __forceinline__ void corr_unit(const Bufs& bf, int chain, int chunk) {
  const int lane = mk::otid() & 63, r = lane & 31, hi = lane >> 5;
  const int dir = chain >> 5, b = (chain >> 3) & 3, h = chain & 7;
  const float* ss = bf.SST + ((size_t)chain * NCH + chunk) * 4096;
  bf16x8 bfr[2][4];
#pragma unroll
  for (int nt = 0; nt < 2; ++nt)
#pragma unroll
    for (int ks = 0; ks < 4; ++ks) { const float* q = ss + (size_t)(nt * 32 + r) * 64 + ks * 16 + hi * 8; const f32x4 x0 = *(const f32x4*)q, x1 = *(const f32x4*)(q + 4);
      u32x4 w; w.x = cvt_pk_bf16(x0[0], x0[1]); w.y = cvt_pk_bf16(x0[2], x0[3]); w.z = cvt_pk_bf16(x1[0], x1[1]); w.w = cvt_pk_bf16(x1[2], x1[3]); bfr[nt][ks] = __builtin_bit_cast(bf16x8, w); }
  const int p0 = chunk * CL;
  const size_t dbase = (size_t)dir * NTOK;
  for (int mt = 0; mt < (CL + 31) / 32; ++mt) {
    const int sa_ = min(mt * 32 + r, CL - 1);
    const bf16_t* zp = bf.Z + (dbase + scan_row(dir, b, p0 + sa_)) * 512 + h * 64 + hi * 8;
    bf16x8 af[4];
#pragma unroll
    for (int ks = 0; ks < 4; ++ks) af[ks] = *(const bf16x8*)(zp + ks * 16);
    f32x16 acc[2];
#pragma unroll
    for (int nt = 0; nt < 2; ++nt) { acc[nt] = zero16();
#pragma unroll
      for (int ks = 0; ks < 4; ++ks) acc[nt] = __builtin_amdgcn_mfma_f32_32x32x16_bf16(af[ks], bfr[nt][ks], acc[nt], 0, 0, 0); }
#pragma unroll
    for (int i = 0; i < 16; ++i) { const int so = mt * 32 + (i & 3) + 8 * (i >> 2) + 4 * hi;
      if (so < CL) { bf16_t* yp = bf.Y + (dbase + scan_row(dir, b, p0 + so)) * 512 + h * 64 + r;
        yp[0] = f2bf(bf2f(yp[0]) + acc[0][i]); yp[32] = f2bf(bf2f(yp[32]) + acc[1][i]); } }
  }
}

template <int NR>
__device__ __forceinline__ void finish_rows(const Bufs& bf, const float* __restrict__ gn_g, const float* __restrict__ gn_b, bf16_t* __restrict__ O, int row0) {
  const int c = mk::otid(), h = c >> 6;
  float y[NR], v[NR], g[NR], cs[NR];
#pragma unroll
  for (int i = 0; i < NR; ++i) { const int row = row0 + i;
    y[i] = bf2f(bf.Y[(size_t)row * 512 + c]) + bf2f(bf.Y[((size_t)NTOK + row) * 512 + c]);
    v[i] = bfhi(bf.SH[(size_t)row * 512 + c].y); g[i] = bf2f(bf.G[(size_t)row * bf.gstride + c]);
    cs[i] = bf.CS[(size_t)row * 16 + h] + bf.CS[(size_t)row * 16 + 8 + h]; }
  const float gg = gn_g[c], gb = gn_b[c];
  float o[NR];
#pragma unroll
  for (int i = 0; i < NR; ++i) { const float mu = wave_sum_u(y[i]) * (1.0f / 64.0f); const float dv = y[i] - mu; const float var = wave_sum_u(dv * dv) * (1.0f / 64.0f);
    o[i] = (dv * rsqrtf(var + 64e-5f) * gg + gb + cs[i] * v[i]) * g[i]; }
#pragma unroll
  for (int i = 0; i < NR; ++i) O[(size_t)(row0 + i) * 1024 + 512 + c] = f2bf(o[i]);
}
}

namespace mk {
constexpr size_t al256(size_t x) { return (x + 255) / 256 * 256; }
constexpr size_t WS_BAR = 0;
constexpr size_t WS_BCNT = al256(WS_BAR + (size_t)XCD_BAR_WORDS * 4);
constexpr size_t WS_MOFF = al256(WS_BCNT + (size_t)4 * 256 * 64 * 4);
constexpr size_t WS_KN = al256(WS_MOFF + 4 * 256);
constexpr size_t WS_MOD = al256(WS_KN + (size_t)2 * 256 * 16 * 4);
constexpr size_t WS_ROPE = al256(WS_MOD + (size_t)4 * 5 * 6144 * 4);
constexpr size_t WS_HBC = al256(WS_ROPE + 128 * 16 * 2 * 4);
constexpr size_t WS_EID = al256(WS_HBC + (size_t)NCTX * D * 2);
constexpr size_t WS_GATE = al256(WS_EID + (size_t)NTOK * 2 * 4);
constexpr size_t WS_POS = al256(WS_GATE + (size_t)NTOK * 2 * 4);
constexpr size_t WS_WEIN = al256(WS_POS + (size_t)NTOK * 2 * 4);
constexpr size_t WS_WOIN = al256(WS_WEIN + (size_t)2 * EVEN_IN * D * 2);
constexpr size_t WS_WEOUT = al256(WS_WOIN + (size_t)2 * ODD_IN * D * 2);
constexpr size_t WS_WOOUT = al256(WS_WEOUT + (size_t)2 * D * D * 2);
constexpr size_t WS_WGU = al256(WS_WOOUT + (size_t)2 * D * D * 2);
constexpr size_t WS_WDN = al256(WS_WGU + (size_t)NE * 1024 * D * 2);
constexpr size_t WS_WLT = al256(WS_WDN + (size_t)NE * D * DE * 2);
constexpr size_t WS_UO = al256(WS_WLT + (size_t)2 * 196608 * 2);
constexpr size_t WS_SCR = al256(WS_UO + (size_t)NTOK * D * 2);
constexpr size_t SE_PQK = 0;
constexpr size_t SE_VT = al256(SE_PQK + (size_t)NTOK * 1024 * 2);
constexpr size_t SE_PRW = al256(SE_VT + (size_t)512 * NTOK * 2);
constexpr size_t SE_PQ = 0;
constexpr size_t SE_SST = al256(SE_PQ + (size_t)rw::NCHAIN * (rw::NCH - 1) * 2 * 4096 * 4);
constexpr size_t SE_Y = al256(SE_SST + (size_t)rw::NCHAIN * rw::NCH * 4096 * 4);
constexpr size_t SE_Z = al256(SE_Y + (size_t)2 * NTOK * 512 * 2);
constexpr size_t SE_ZEND = al256(SE_Z + (size_t)2 * NTOK * 512 * 2);
constexpr size_t SE_PRWEND = al256(SE_PRW + (size_t)NTOK * RW_IN * 2);
constexpr size_t SE_SH = SE_PRWEND > SE_ZEND ? SE_PRWEND : SE_ZEND;
constexpr size_t SE_DR = al256(SE_SH + (size_t)NTOK * 512 * 8);
constexpr size_t SE_CS = al256(SE_DR + (size_t)2 * NTOK * 512 * 4);
constexpr size_t SE_END = al256(SE_CS + (size_t)2 * NTOK * 16 * 4);
constexpr size_t SE_YBUF = 0;
constexpr size_t SO_PQK = 0;
constexpr size_t SO_VT = al256(SO_PQK + (size_t)NTOK * 2048 * 2);
constexpr size_t SO_O12 = al256(SO_VT + (size_t)1024 * NTOK * 2);
constexpr size_t SO_END = al256(SO_O12 + (size_t)NTOK * 2048 * 2);
constexpr size_t SO_YBUF = 0;
constexpr size_t SM_XS = 0;
constexpr size_t SM_HE = al256(SM_XS + (size_t)MOE_ROWS * D * 2);
constexpr size_t SM_YS = al256(SM_HE + (size_t)MOE_ROWS * DE * 2);
constexpr size_t SM_END = al256(SM_YS + (size_t)MOE_ROWS * D * 2);
constexpr size_t SCR_BYTES = SE_END > SO_END ? (SE_END > SM_END ? SE_END : SM_END) : (SO_END > SM_END ? SO_END : SM_END);
constexpr size_t WS_END = WS_SCR + SCR_BYTES;
constexpr int LDS_BARW = 131072;
constexpr int LDS_MISC = 131072 + 64;

struct Params {
  const float *x, *c, *ctx, *c_ctx, *ada_w, *ada_b, *ln_g, *ln_b, *even_w_in, *even_w_out, *shift_w, *na_rpb, *rw_w0, *rw_w_up, *rw_a0, *rw_a_up, *rw_g_up, *rw_k_k, *rw_k_a, *rw_r_k,
      *rw_gn_g, *rw_gn_b, *odd_w_in, *odd_w_out, *da_lq1, *da_lk1, *da_lq2, *da_lk2, *da_subln_g, *router_w, *router_b, *exp_w_gate, *exp_w_up, *exp_w_down;
  float* out; unsigned char* ws; int ph_lo, ph_hi;
};
template <class Tp> __device__ __forceinline__ Tp* wsp(const Params& p, size_t off) { return (Tp*)(p.ws + off); }

__device__ __forceinline__ void ada_unit(const Params& p, int u, LAS float* lds) {
  LAS float* sc = lds; LAS float* red = lds + 5 * 1024;
  const int tid = mk::otid(), l = u / 96, n = (u % 96) * 64 + (tid & 63), kp = tid >> 6;
  for (int i = tid; i < 5 * 1024; i += NTHR) { const float v = i < 4096 ? p.c[i] : p.c_ctx[i - 4096]; sc[i] = siluf_(v); }
  __syncthreads();
  float a[5] = {0.f, 0.f, 0.f, 0.f, 0.f};
  const float* w = p.ada_w + ((size_t)l * D + kp * 128) * 6144 + n;
#pragma unroll 4
  for (int k = 0; k < 128; ++k) { const float wv = w[(size_t)k * 6144]; const int kk = kp * 128 + k;
#pragma unroll
    for (int r = 0; r < 5; ++r) a[r] = fmaf(sc[r * 1024 + kk], wv, a[r]); }
#pragma unroll
  for (int r = 0; r < 5; ++r) red[(kp * 5 + r) * 64 + (tid & 63)] = a[r];
  __syncthreads();
  if (tid < 320) { const int r = tid >> 6, nn = tid & 63; float s = 0.f;
#pragma unroll
    for (int q = 0; q < 8; ++q) s += red[(q * 5 + r) * 64 + nn];
    const int col = (u % 96) * 64 + nn;
    wsp<float>(p, WS_MOD)[((size_t)l * 5 + r) * 6144 + col] = s + p.ada_b[l * 6144 + col]; }
  __syncthreads();
}
__device__ __forceinline__ void phase_prologue(const Params& p, LAS unsigned char* lds) {
  const int bid = mk::obid(), nb = gridDim.x; LAS float* tile = (LAS float*)lds;
  int ub = 0;
  for (int i = 0; i < 2; ++i) ub += cvt_matrix(p.even_w_in + (size_t)i * D * EVEN_IN, EVEN_IN, D, EVEN_IN, wsp<bf16_t>(p, WS_WEIN) + (size_t)i * EVEN_IN * D, NMapId{0}, tile, ub, bid, nb);
  for (int i = 0; i < 2; ++i) ub += cvt_matrix(p.odd_w_in + (size_t)i * D * ODD_IN, ODD_IN, D, ODD_IN, wsp<bf16_t>(p, WS_WOIN) + (size_t)i * ODD_IN * D, NMapRope{}, tile, ub, bid, nb);
  for (int i = 0; i < 2; ++i) ub += cvt_matrix(p.even_w_out + (size_t)i * D * D, D, D, D, wsp<bf16_t>(p, WS_WEOUT) + (size_t)i * D * D, NMapId{0}, tile, ub, bid, nb);
  for (int i = 0; i < 2; ++i) ub += cvt_matrix(p.odd_w_out + (size_t)i * D * D, D, D, D, wsp<bf16_t>(p, WS_WOOUT) + (size_t)i * D * D, NMapId{0}, tile, ub, bid, nb);
  for (int i = 0; i < 2; ++i) { bf16_t* wl = wsp<bf16_t>(p, WS_WLT) + (size_t)i * 196608;
    for (int d = 0; d < 2; ++d) { ub += cvt_matrix(p.rw_w_up + (size_t)(i * 2 + d) * 64 * 512, 512, 64, 512, wl + (size_t)d * 32768, NMapId{0}, tile, ub, bid, nb);
      ub += cvt_matrix(p.rw_a_up + (size_t)(i * 2 + d) * 64 * 512, 512, 64, 512, wl + (size_t)(2 + d) * 32768, NMapId{0}, tile, ub, bid, nb); }
    ub += cvt_matrix(p.rw_g_up + (size_t)i * 128 * 512, 512, 128, 512, wl + (size_t)4 * 32768, NMapId{0}, tile, ub, bid, nb); }
  for (int u = (bid + nb - ub % nb) % nb; u < 384; u += nb) ada_unit(p, u, (LAS float*)lds);
  const int gt = bid * NTHR + mk::otid();
  if (gt < 128 * 16) { const int pos = gt >> 4, i = gt & 15; const float inv = exp2f(-(float)i * (13.287712379549449f / 16.0f)); float sn, cs; sincosf((float)pos * inv, &sn, &cs);
    wsp<float>(p, WS_ROPE)[gt * 2] = cs; wsp<float>(p, WS_ROPE)[gt * 2 + 1] = sn; }
}
__device__ __forceinline__ void cvt_experts(const Params& p, int l, LAS float* tile, int b0) {
  const int bid = mk::obid() - b0, nb = (int)gridDim.x - b0; int ub = 0;
  if (bid < 0) return;
  for (int e = 0; e < NE; ++e) {
    const size_t so = ((size_t)l * NE + e) * D * DE;
    ub += cvt_matrix(p.exp_w_gate + so, DE, D, DE, wsp<bf16_t>(p, WS_WGU) + (size_t)e * 1024 * D, NMapInterleave{0}, tile, ub, bid, nb);
    ub += cvt_matrix(p.exp_w_up + so, DE, D, DE, wsp<bf16_t>(p, WS_WGU) + (size_t)e * 1024 * D, NMapInterleave{1}, tile, ub, bid, nb);
    ub += cvt_matrix(p.exp_w_down + so, D, DE, D, wsp<bf16_t>(p, WS_WDN) + (size_t)e * D * DE, NMapId{0}, tile, ub, bid, nb);
  }
}

__device__ __forceinline__ bf16_t* hb_ptr(const Params& p, int row, bool alt) {
  if (alt) return wsp<bf16_t>(p, WS_SCR + SM_END) + (size_t)row * D;
  return row < NLAT ? (bf16_t*)p.out + (size_t)row * D : wsp<bf16_t>(p, WS_HBC) + (size_t)(row - NLAT) * D;
}
__device__ __forceinline__ const float* h0_ptr(const Params& p, int row) { return row < NLAT ? p.x + (size_t)row * D : p.ctx + (size_t)(row - NLAT) * D; }
__device__ __forceinline__ void store_bf16x4(bf16_t* dst, f32x4 v) { u32x2 w; w.x = cvt_pk_bf16(v[0], v[1]); w.y = cvt_pk_bf16(v[2], v[3]); *(u32x2*)dst = w; }
__device__ __forceinline__ f32x4 load_bf16x4(const bf16_t* src) { const u32x2 w = *(const u32x2*)src; return (f32x4){bflo(w.x), bfhi(w.x), bflo(w.y), bfhi(w.y)}; }

__device__ __forceinline__ void phase_mod0(const Params& p) {
  const int lane = mk::otid() & 63, wid = mk::otid() >> 6;
  bf16_t* U = wsp<bf16_t>(p, WS_UO);
  for (int row = mk::obid() * 8 + wid; row < NTOK; row += gridDim.x * 8) {
    const float* h = h0_ptr(p, row); const float* modl = wsp<float>(p, WS_MOD) + (size_t)bidx_of_row(row) * 6144;
#pragma unroll
    for (int q = 0; q < 4; ++q) { const int col = q * 256 + lane * 4; const f32x4 hv = *(const f32x4*)(h + col), sh = *(const f32x4*)(modl + col), sc = *(const f32x4*)(modl + 1024 + col);
      store_bf16x4(U + (size_t)row * D + col, hv * (1.0f + sc) + sh); }
  }
}
__device__ __forceinline__ void ln_row(f32x4 (&v)[4], const float* __restrict__ g, const float* __restrict__ b, int lane) {
  float s = 0.f;
#pragma unroll
  for (int q = 0; q < 4; ++q) s += (v[q][0] + v[q][1]) + (v[q][2] + v[q][3]);
  const float mu = wave_sum_u(s) * (1.0f / D);
  float qq = 0.f;
#pragma unroll
  for (int q = 0; q < 4; ++q) { const f32x4 d = v[q] - mu; qq += (d[0] * d[0] + d[1] * d[1]) + (d[2] * d[2] + d[3] * d[3]); }
  const float rstd = rsqrtf(wave_sum_u(qq) * (1.0f / D) + LN_EPS);
#pragma unroll
  for (int q = 0; q < 4; ++q) { const int col = q * 256 + lane * 4; v[q] = (v[q] - mu) * rstd * *(const f32x4*)(g + col) + *(const f32x4*)(b + col); }
}
template <bool F32IN> struct Ln1Raw;
template <> struct Ln1Raw<true> { f32x4 h[4]; u32x2 y[4]; };
template <> struct Ln1Raw<false> { u32x2 h[4]; u32x2 y[4]; };
__device__ __forceinline__ f32x4 h_as_f32(f32x4 v) { return v; }
__device__ __forceinline__ f32x4 h_as_f32(u32x2 w) { return (f32x4){bflo(w.x), bfhi(w.x), bflo(w.y), bfhi(w.y)}; }
template <bool F32IN>
__device__ __forceinline__ void ln1_load(const Params& p, const bf16_t* __restrict__ Ybuf, int row, int lane, Ln1Raw<F32IN>& r) {
#pragma unroll
  for (int q = 0; q < 4; ++q) { const int col = q * 256 + lane * 4;
    if constexpr (F32IN) r.h[q] = *(const f32x4*)(h0_ptr(p, row) + col); else r.h[q] = *(const u32x2*)(hb_ptr(p, row, false) + col);
    r.y[q] = *(const u32x2*)(Ybuf + (size_t)row * D + col); }
}
template <bool F32IN>
__device__ __forceinline__ void ln1_row(const Params& p, int l, int row, int lane, const Ln1Raw<F32IN>& raw, const LAS float* rwl, LAS int* lcnt, bool redir) {
  bf16_t* U2 = wsp<bf16_t>(p, WS_UO); int* eid = wsp<int>(p, WS_EID); float* gatev = wsp<float>(p, WS_GATE);
  const float* lg = p.ln_g + (size_t)(l * 2) * D; const float* lb = p.ln_b + (size_t)(l * 2) * D;
  bf16_t* ho = redir ? wsp<bf16_t>(p, WS_SCR + SM_YS) + (size_t)row * D : hb_ptr(p, row, l == DEPTH - 1); const float* modl = wsp<float>(p, WS_MOD) + ((size_t)l * 5 + bidx_of_row(row)) * 6144;
  f32x4 v[4];
#pragma unroll
  for (int q = 0; q < 4; ++q) { const int col = q * 256 + lane * 4; const f32x4 yv = (f32x4){bflo(raw.y[q].x), bfhi(raw.y[q].x), bflo(raw.y[q].y), bfhi(raw.y[q].y)};
    v[q] = ALPHA * h_as_f32(raw.h[q]) + *(const f32x4*)(modl + 2 * 1024 + col) * yv; }
  ln_row(v, lg, lb, lane);
  float acc[16];
#pragma unroll
  for (int e = 0; e < 16; ++e) acc[e] = 0.f;
#pragma unroll
  for (int q = 0; q < 4; ++q) { const int col = q * 256 + lane * 4;
    store_bf16x4(ho + col, v[q]);
    const f32x4 u = v[q] * (1.0f + *(const f32x4*)(modl + 4 * 1024 + col)) + *(const f32x4*)(modl + 3 * 1024 + col);
    store_bf16x4(U2 + (size_t)row * D + col, u);
#pragma unroll
    for (int e = 0; e < 16; ++e) { const f32x4 w = *(const LAS f32x4*)(rwl + ((q * 16 + e) * 64 + lane) * 4); acc[e] += (u[0] * w[0] + u[1] * w[1]) + (u[2] * w[2] + u[3] * w[3]); }
  }
  float s[16], sel[16];
#pragma unroll
  for (int e = 0; e < 16; ++e) { s[e] = 1.0f / (1.0f + expf(-wave_sum_u(acc[e]))); sel[e] = s[e] + p.router_b[e]; }
  float best = -1e30f; int grp = 0;
#pragma unroll
  for (int gI = 0; gI < 4; ++gI) {
    const float a = sel[gI * 4], b2 = sel[gI * 4 + 1], c = sel[gI * 4 + 2], d = sel[gI * 4 + 3];
    const float lo1 = fminf(a, b2), hi1 = fmaxf(a, b2), lo2 = fminf(c, d), hi2 = fmaxf(c, d);
    const float gs = fmaxf(hi1, hi2) + fmaxf(fminf(hi1, hi2), fmaxf(lo1, lo2));
    if (gs > best) { best = gs; grp = gI; }
  }
  float v0 = 0, v1 = 0, v2 = 0, v3 = 0, s0 = 0, s1 = 0, s2 = 0, s3 = 0;
#pragma unroll
  for (int gI = 0; gI < 4; ++gI) if (gI == grp) { v0 = sel[gI * 4]; v1 = sel[gI * 4 + 1]; v2 = sel[gI * 4 + 2]; v3 = sel[gI * 4 + 3]; s0 = s[gI * 4]; s1 = s[gI * 4 + 1]; s2 = s[gI * 4 + 2]; s3 = s[gI * 4 + 3]; }
  int i1 = 0; float b1 = v0; if (v1 > b1) { b1 = v1; i1 = 1; } if (v2 > b1) { b1 = v2; i1 = 2; } if (v3 > b1) { b1 = v3; i1 = 3; }
  int i2 = -1; float bb = -1e30f;
  if (i1 != 0 && v0 > bb) { bb = v0; i2 = 0; } if (i1 != 1 && v1 > bb) { bb = v1; i2 = 1; } if (i1 != 2 && v2 > bb) { bb = v2; i2 = 2; } if (i1 != 3 && v3 > bb) { bb = v3; i2 = 3; }
  const float g1 = i1 == 0 ? s0 : i1 == 1 ? s1 : i1 == 2 ? s2 : s3; const float g2 = i2 == 0 ? s0 : i2 == 1 ? s1 : i2 == 2 ? s2 : s3;
  if (lane == 0) { const int e1 = grp * 4 + i1, e2 = grp * 4 + i2;
    eid[row * 2] = e1; eid[row * 2 + 1] = e2; gatev[row * 2] = g1 / (g1 + g2); gatev[row * 2 + 1] = g2 / (g1 + g2);
    __hip_atomic_fetch_add(lcnt + e1, 1, __ATOMIC_RELAXED, __HIP_MEMORY_SCOPE_WORKGROUP); __hip_atomic_fetch_add(lcnt + e2, 1, __ATOMIC_RELAXED, __HIP_MEMORY_SCOPE_WORKGROUP); }
}
template <bool F32IN>
__device__ __forceinline__ void phase_ln1(const Params& p, int l, const bf16_t* __restrict__ Ybuf, LAS unsigned char* lds, bool dry) {
  const int tid = mk::otid(), lane = tid & 63, wid = tid >> 6, bid = mk::obid();
  const bool last = l == DEPTH - 1; const int ntok = last ? NLAT : NTOK;
  LAS float* rwl = (LAS float*)lds; LAS int* lcnt = (LAS int*)(lds + 65536);
  { float rv[32];
#pragma unroll
    for (int i = 0; i < 32; ++i) rv[i] = p.router_w[tid + i * NTHR];
#pragma unroll
    for (int i = 0; i < 32; ++i) { const int idx = tid + i * NTHR, d = idx >> 4, e = idx & 15; rwl[(((d >> 8) * 16 + e) * 64 + ((d >> 2) & 63)) * 4 + (d & 3)] = rv[i]; } }
  if (tid < 16) lcnt[tid] = 0;
  __syncthreads();
  const int stride = gridDim.x * 8, row0 = bid * 8 + wid;
  if (row0 < ntok) {
    Ln1Raw<F32IN> cur, nxt; ln1_load<F32IN>(p, Ybuf, row0, lane, cur);
    for (int row = row0; row < ntok; row += stride) {
      const int rn = row + stride < ntok ? row + stride : row;
      ln1_load<F32IN>(p, Ybuf, rn, lane, nxt);
      ln1_row<F32IN>(p, l, row, lane, cur, rwl, lcnt, dry);
      cur = nxt;
    }
  }
  __syncthreads();
  if (tid < 16) wsp<int>(p, WS_BCNT)[((size_t)l * 256 + bid) * 64 + tid] = lcnt[tid];
  __syncthreads();
}
__device__ __forceinline__ void phase_scatter(const Params& p, int l, LAS unsigned char* lds) {
  const int tid = mk::otid(), lane = tid & 63, wid = tid >> 6, bid = mk::obid();
  const bool last = l == DEPTH - 1; const int ntok = last ? NLAT : NTOK;
  LAS int* tot = (LAS int*)lds; LAS int* pre = tot + 16; LAS int* base = tot + 32; LAS int* lcur = tot + 48;
  const int* bc = wsp<int>(p, WS_BCNT) + (size_t)l * 256 * 64;
  if (tid < 16) { int t = 0, pr = 0; for (int b2 = 0; b2 < (int)gridDim.x; ++b2) { const int v = bc[b2 * 64 + tid]; pr += b2 < bid ? v : 0; t += v; } tot[tid] = t; pre[tid] = pr; lcur[tid] = 0; }
  __syncthreads();
  if (tid == 0) { int o = 0; int* mo = wsp<int>(p, WS_MOFF) + l * 64; for (int e = 0; e < 16; ++e) { base[e] = o + pre[e]; if (bid == 0) mo[e] = o; o += (tot[e] + 255) / 256 * 256; } if (bid == 0) mo[16] = o; }
  __syncthreads();
  const bf16_t* U2 = wsp<bf16_t>(p, WS_UO); bf16_t* Xs = wsp<bf16_t>(p, WS_SCR + SM_XS); const int* eid = wsp<int>(p, WS_EID); int* pos = wsp<int>(p, WS_POS);
  for (int row = bid * 8 + wid; row < ntok; row += gridDim.x * 8) {
    int p1 = 0, p2 = 0;
    if (lane == 0) { const int e1 = eid[row * 2], e2 = eid[row * 2 + 1]; p1 = base[e1] + __hip_atomic_fetch_add(lcur + e1, 1, __ATOMIC_RELAXED, __HIP_MEMORY_SCOPE_WORKGROUP); p2 = base[e2] + __hip_atomic_fetch_add(lcur + e2, 1, __ATOMIC_RELAXED, __HIP_MEMORY_SCOPE_WORKGROUP); pos[row * 2] = p1; pos[row * 2 + 1] = p2; }
    p1 = __builtin_amdgcn_readfirstlane(p1); p2 = __builtin_amdgcn_readfirstlane(p2);
    const u32x4 a = *(const u32x4*)(U2 + (size_t)row * D + lane * 8), b2 = *(const u32x4*)(U2 + (size_t)row * D + 512 + lane * 8);
    *(u32x4*)(Xs + (size_t)p1 * D + lane * 8) = a; *(u32x4*)(Xs + (size_t)p1 * D + 512 + lane * 8) = b2;
    *(u32x4*)(Xs + (size_t)p2 * D + lane * 8) = a; *(u32x4*)(Xs + (size_t)p2 * D + 512 + lane * 8) = b2;
  }
}
struct Ln2Raw { u32x2 h[4]; u32x2 y1[4], y2[4]; };
__device__ __forceinline__ void ln2_load(const Params& p, bool last, int row, int lane, int p1, int p2, Ln2Raw& r) {
  const bf16_t* Ys = wsp<bf16_t>(p, WS_SCR + SM_YS); const bf16_t* ho = hb_ptr(p, row, last);
#pragma unroll
  for (int q = 0; q < 4; ++q) { const int col = q * 256 + lane * 4; r.h[q] = *(const u32x2*)(ho + col); r.y1[q] = *(const u32x2*)(Ys + (size_t)p1 * D + col); r.y2[q] = *(const u32x2*)(Ys + (size_t)p2 * D + col); }
}
__device__ __forceinline__ void phase_ln2(const Params& p, int l, bool dry) {
  const int tid = mk::otid(), lane = tid & 63, wid = tid >> 6;
  const bool last = l == DEPTH - 1; const int ntok = last ? NLAT : NTOK;
  const int* pos = wsp<int>(p, WS_POS); const float* gatev = wsp<float>(p, WS_GATE); bf16_t* U = wsp<bf16_t>(p, WS_UO);
  const float* lg = p.ln_g + (size_t)(l * 2 + 1) * D; const float* lb = p.ln_b + (size_t)(l * 2 + 1) * D;
  const int stride = gridDim.x * 8, row0 = mk::obid() * 8 + wid;
  if (row0 >= ntok) return;
  auto clampr = [&](int r) { return r < ntok ? r : row0; };
  u32x2 pc = *(const u32x2*)(pos + 2 * row0); f32x2 gc = *(const f32x2*)(gatev + 2 * row0);
  Ln2Raw cur, nxt; ln2_load(p, last, row0, lane, (int)pc.x, (int)pc.y, cur);
  int r1 = clampr(row0 + stride);
  u32x2 pn = *(const u32x2*)(pos + 2 * r1); f32x2 gn = *(const f32x2*)(gatev + 2 * r1);
  for (int row = row0; row < ntok; row += stride) {
    ln2_load(p, last, r1, lane, (int)pn.x, (int)pn.y, nxt);
    const int r2 = clampr(row + 2 * stride);
    const u32x2 pn2 = *(const u32x2*)(pos + 2 * r2); const f32x2 gn2 = *(const f32x2*)(gatev + 2 * r2);
    bf16_t* hb = dry ? wsp<bf16_t>(p, WS_SCR + SM_XS) + (size_t)row * D : hb_ptr(p, row, false); float* hf = (dry ? wsp<float>(p, WS_SCR + SM_XS) : p.out) + (size_t)row * D; const int bi = bidx_of_row(row);
    const float* modl = wsp<float>(p, WS_MOD) + ((size_t)l * 5 + bi) * 6144;
    f32x4 v[4];
#pragma unroll
    for (int q = 0; q < 4; ++q) { const int col = q * 256 + lane * 4;
      const f32x4 a1 = (f32x4){bflo(cur.y1[q].x), bfhi(cur.y1[q].x), bflo(cur.y1[q].y), bfhi(cur.y1[q].y)}, a2 = (f32x4){bflo(cur.y2[q].x), bfhi(cur.y2[q].x), bflo(cur.y2[q].y), bfhi(cur.y2[q].y)};
      v[q] = ALPHA * h_as_f32(cur.h[q]) + *(const f32x4*)(modl + 5 * 1024 + col) * (gc[0] * a1 + gc[1] * a2); }
    ln_row(v, lg, lb, lane);
    const float* modn = wsp<float>(p, WS_MOD) + ((size_t)(last ? l : l + 1) * 5 + bi) * 6144;
#pragma unroll
    for (int q = 0; q < 4; ++q) { const int col = q * 256 + lane * 4; if (last) *(f32x4*)(hf + col) = v[q]; else store_bf16x4(hb + col, v[q]);
      if (!last) store_bf16x4(U + (size_t)row * D + col, v[q] * (1.0f + *(const f32x4*)(modn + 1024 + col)) + *(const f32x4*)(modn + col)); }
    cur = nxt; gc = gn; pn = pn2; gn = gn2; r1 = r2;
  }
}

struct SchedEvenIn { const bf16_t* U; const bf16_t* W; bf16_t* Pqk; bf16_t* Prw; bf16_t* Vt; int G, c;
  __device__ __forceinline__ bool next(int i, pg8::Unit& u) const { const int Lx = i * G + c; u.kind = 0;
    if (Lx < 1452) { const int grp = Lx / 44, rem = Lx % 44, pm = grp * 4 + (rem & 3), pi = rem >> 2; u.pm = pm; u.pn = pi;
      u.A = (const char*)(U + (size_t)pm * 256 * D); const int brow = pi < 4 ? pi * 256 : 1536 + (pi - 4) * 256; u.Bt = (const char*)(W + (size_t)brow * D);
      if (pi < 4) { u.out = Pqk; u.ldo = 1024; u.x1 = pi * 256; } else { u.out = Prw; u.ldo = RW_IN; u.x1 = (pi - 4) * 256; } u.x0 = pm * 256; return true; }
    if (Lx < 1452 + 264) { const int v = Lx - 1452, pmv = v & 1, pnv = v >> 1; u.pm = pmv; u.pn = pnv; u.A = (const char*)(W + (size_t)(1024 + pmv * 256) * D); u.Bt = (const char*)(U + (size_t)pnv * 256 * D);
      u.out = Vt; u.ldo = NTOK; u.x0 = pmv * 256; u.x1 = pnv * 256; return true; }
    return false; } };
struct SchedOddIn { const bf16_t* U; const bf16_t* W; bf16_t* Pqk; bf16_t* Vt; int G, c;
  __device__ __forceinline__ bool next(int i, pg8::Unit& u) const { const int Lx = i * G + c;
    if (Lx < 1056) { const int grp = Lx / 32, rem = Lx % 32, pm = grp * 4 + (rem & 3), pi = rem >> 2; u.pm = pm; u.pn = pi; u.kind = pm < 128 ? 1 : 0;
      u.A = (const char*)(U + (size_t)pm * 256 * D); u.Bt = (const char*)(W + (size_t)pi * 256 * D); u.out = Pqk; u.ldo = 2048; u.x0 = pm * 256; u.x1 = pi * 256; return true; }
    if (Lx < 1056 + 528) { const int v = Lx - 1056, pmv = v & 3, pnv = v >> 2; u.pm = pmv; u.pn = pnv; u.kind = 0; u.A = (const char*)(W + (size_t)(2048 + pmv * 256) * D); u.Bt = (const char*)(U + (size_t)pnv * 256 * D);
      u.out = Vt; u.ldo = NTOK; u.x0 = pmv * 256; u.x1 = pnv * 256; return true; }
    return false; } };
struct SchedOut { const bf16_t* O; const bf16_t* W; bf16_t* Y; int G, c;
  __device__ __forceinline__ bool next(int i, pg8::Unit& u) const { const int Lx = i * G + c; if (Lx >= 528) return false; const int pm = (Lx / 16) * 4 + (Lx & 3), pn = (Lx & 15) >> 2; u.pm = pm; u.pn = pn; u.kind = 0;
    u.A = (const char*)(O + (size_t)pm * 256 * D); u.Bt = (const char*)(W + (size_t)pn * 256 * D); u.out = Y; u.ldo = 1024; u.x0 = pm * 256; u.x1 = pn * 256; return true; } };
struct SchedMoe { const bf16_t* A; const bf16_t* W; bf16_t* out; const LAS int* moff; int Kd, ldo, ncol, G, c;
  __device__ __forceinline__ bool next(int i, pg8::Unit& u) const { const int Lx = i * G + c; const int ntile = moff[16] >> 8; if (Lx >= ntile * 4) return false;
    const int pm = Lx >> 2, pn = Lx & 3; int e = 0;
#pragma unroll
    for (int j = 1; j < 16; ++j) e += (pm * 256 >= moff[j]) ? 1 : 0;
    u.pm = pm; u.pn = pn; u.kind = 0; u.A = (const char*)(A + (size_t)pm * 256 * Kd); u.Bt = (const char*)(W + ((size_t)e * 1024 + pn * 256) * Kd); u.out = out; u.ldo = ldo; u.x0 = pm * 256; u.x1 = pn * ncol; return true; } };

struct EpiOddIn {
  static constexpr bool PERM = true; const float* rope;
  __device__ __forceinline__ void operator()(const f32x4 (&acc)[2][2][4][2], const pg8::Unit& u, int wr, int wc, int fr, int fq) const {
    if (u.kind == 0) { pg8::EpiStoreBf16{}(acc, u, wr, wc, fr, fq); return; }
    const int row0 = u.x0 + wr * 64 + fr, col0 = u.x1 + wc * 32 + 8 * fq; const int half = wc & 1;
#pragma unroll
    for (int ai = 0; ai < 2; ++ai)
#pragma unroll
      for (int m = 0; m < 4; ++m) { const int row = row0 + ai * 128 + m * 16; const int t = row & (T - 1); const int pos = half ? (t & 63) : (t >> 6);
        const f32x4 cs0 = *(const f32x4*)(rope + (pos * 16 + 4 * fq) * 2), cs1 = *(const f32x4*)(rope + (pos * 16 + 4 * fq + 2) * 2);
        bf16_t* rowp = u.out + (size_t)row * u.ldo + col0;
#pragma unroll
        for (int bj = 0; bj < 2; ++bj) { const f32x4 v0 = acc[ai][bj][m][0], v1 = acc[ai][bj][m][1];
          u32x4 w; w.x = cvt_pk_bf16(v0[0] * cs0[0] - v0[1] * cs0[1], v0[0] * cs0[1] + v0[1] * cs0[0]); w.y = cvt_pk_bf16(v0[2] * cs0[2] - v0[3] * cs0[3], v0[2] * cs0[3] + v0[3] * cs0[2]);
          w.z = cvt_pk_bf16(v1[0] * cs1[0] - v1[1] * cs1[1], v1[0] * cs1[1] + v1[1] * cs1[0]); w.w = cvt_pk_bf16(v1[2] * cs1[2] - v1[3] * cs1[3], v1[2] * cs1[3] + v1[3] * cs1[2]);
          *(u32x4*)(rowp + bj * 128) = w; } }
  }
};
struct EpiGateUp {
  static constexpr bool PERM = true;
  __device__ __forceinline__ void operator()(const f32x4 (&acc)[2][2][4][2], const pg8::Unit& u, int wr, int wc, int fr, int fq) const {
    const int row0 = u.x0 + wr * 64 + fr, col0 = u.x1 + wc * 16 + 4 * fq;
#pragma unroll
    for (int ai = 0; ai < 2; ++ai)
#pragma unroll
      for (int m = 0; m < 4; ++m) { bf16_t* rowp = u.out + (size_t)(row0 + ai * 128 + m * 16) * u.ldo + col0;
#pragma unroll
        for (int bj = 0; bj < 2; ++bj) { const f32x4 v0 = acc[ai][bj][m][0], v1 = acc[ai][bj][m][1];
          u32x2 w; w.x = cvt_pk_bf16(siluf_(v0[0]) * v0[1], siluf_(v0[2]) * v0[3]); w.y = cvt_pk_bf16(siluf_(v1[0]) * v1[1], siluf_(v1[2]) * v1[3]);
          *(u32x2*)(rowp + bj * 64) = w; } }
  }
};
}

namespace mk {
constexpr int N_PHASES = 2 + 2 * (12 + 10);
__global__ void __launch_bounds__(NTHR, 2) mega(Params p) {
  extern __shared__ __attribute__((aligned(16))) unsigned char shm[];
  LAS unsigned char* lds = (LAS unsigned char*)shm;
  const int nb = gridDim.x;
  if (threadIdx.x == 0) *(LAS u32x4*)(lds + LDS_BARW) = (u32x4){0u, 0u, 0u, 0u};
  __syncthreads();
  XcdBarrier bar = xcd_barrier_post(wsp<unsigned>(p, WS_BAR), (volatile LAS unsigned*)(lds + LDS_BARW));
  int ph = 0;
#ifndef MK_MASK
#define MK_MASK 0xFFFFFFFFu
#endif
#ifndef MK_REP
#define MK_REP 0u
#endif
#define PHASE_BEGIN_K(k) if ((((MK_MASK) >> (k)) & 1u) && ph >= p.ph_lo && ph < p.ph_hi) { const int bid = mk::obid(); const int nrep_ = ((((MK_REP) >> (k)) & 1u) ? 2 : 1); for (int rep_ = 0; rep_ < nrep_; ++rep_) { const bool dry = rep_ + 1 < nrep_; (void)dry;
#define PHASE_END   } if (ph + 1 < p.ph_hi) xcd_barrier(bar); } ++ph;
  bf16_t* UO = wsp<bf16_t>(p, WS_UO);
  unsigned char* scr = p.ws + WS_SCR;
  PHASE_BEGIN_K(0) phase_prologue(p, lds); PHASE_END
  PHASE_BEGIN_K(1) phase_mod0(p); PHASE_END
  for (int lp = 0; lp < 2; ++lp) {
    {
      const int l = 2 * lp;
      bf16_t* Pqk = (bf16_t*)(scr + SE_PQK); bf16_t* Vt = (bf16_t*)(scr + SE_VT); bf16_t* Prw = (bf16_t*)(scr + SE_PRW); bf16_t* Ybuf = (bf16_t*)(scr + SE_YBUF);
      rw::Bufs bf; bf.SH = (u32x2*)(scr + SE_SH); bf.DR = (unsigned*)(scr + SE_DR); bf.G = UO + 512; bf.gstride = 1024; bf.CS = (float*)(scr + SE_CS) + (size_t)lp * NTOK * 16; bf.PQ = (float*)(scr + SE_PQ); bf.SST = (float*)(scr + SE_SST); bf.Y = (bf16_t*)(scr + SE_Y); bf.Z = (bf16_t*)(scr + SE_Z);
      PHASE_BEGIN_K(2) { SchedEvenIn S{UO, wsp<bf16_t>(p, WS_WEIN) + (size_t)lp * EVEN_IN * D, Pqk, Prw, Vt, nb, bid}; pg8::gemm_phase(lds, D, S, pg8::EpiStoreBf16{}); } PHASE_END
      PHASE_BEGIN_K(3) { for (int u = bid; u < 1024 + 32; u += nb) { int b, h, rq; if (u < 1024) { b = u >> 8; h = (u >> 5) & 7; rq = u & 31; } else { const int v = u - 1024; b = v >> 3; h = v & 7; rq = -1; }
          natt::na_attn_unit(Pqk, Vt, p.na_rpb + ((size_t)lp * 8 + h) * 465, UO, b, h, rq, lds); }
        const int pb = (bid + nb / 2) % nb;
        for (int t = pb; t < NTOK / 16; t += nb) rw::prep_tile(Prw, p.shift_w + (size_t)lp * 3 * RW_IN, p.rw_w0 + lp * 1024, wsp<bf16_t>(p, WS_WLT) + (size_t)lp * 196608, p.rw_a0 + lp * 1024, p.rw_k_k + lp * 512, p.rw_k_a + lp * 512, p.rw_r_k + lp * 512, bf, t, (LAS float*)lds); } PHASE_END
      PHASE_BEGIN_K(4) for (int u = bid * 8 + (mk::otid() >> 6); u < rw::NCHAIN * rw::NCH; u += nb * 8) rw::scan_unit(bf, p.rw_k_a + lp * 512, u / rw::NCH, u % rw::NCH, (LAS float*)lds + (mk::otid() >> 6) * 320); PHASE_END
      PHASE_BEGIN_K(5) for (int c = bid; c < rw::NCHAIN; c += nb) rw::propagate_chain(bf, c, (LAS float*)lds); PHASE_END
      PHASE_BEGIN_K(6) for (int u = bid * 8 + (mk::otid() >> 6); u < rw::NCHAIN * (rw::NCH - 1); u += nb * 8) rw::corr_unit(bf, u / (rw::NCH - 1), 1 + u % (rw::NCH - 1)); PHASE_END
      PHASE_BEGIN_K(7) for (int r = bid * 8; r < NTOK; r += nb * 8) rw::finish_rows<8>(bf, p.rw_gn_g + lp * 512, p.rw_gn_b + lp * 512, UO, r); PHASE_END
      PHASE_BEGIN_K(8) { SchedOut S{UO, wsp<bf16_t>(p, WS_WEOUT) + (size_t)lp * D * D, Ybuf, nb, bid}; pg8::gemm_phase(lds, D, S, pg8::EpiStoreBf16{}); __syncthreads(); cvt_experts(p, l, (LAS float*)lds, 528 - 2 * nb > 0 ? 528 - 2 * nb : 0); } PHASE_END
      PHASE_BEGIN_K(9) if (l == 0) phase_ln1<true>(p, l, Ybuf, lds, dry); else phase_ln1<false>(p, l, Ybuf, lds, dry); PHASE_END
      PHASE_BEGIN_K(10) phase_scatter(p, l, lds); PHASE_END
      PHASE_BEGIN_K(11) { LAS int* mo = (LAS int*)(lds + LDS_MISC); { const int tq = mk::otid(); if (tq < 17) mo[tq] = wsp<int>(p, WS_MOFF)[l * 64 + tq]; } __syncthreads();
        SchedMoe S{(bf16_t*)(scr + SM_XS), wsp<bf16_t>(p, WS_WGU), (bf16_t*)(scr + SM_HE), mo, D, DE, 128, nb, bid}; pg8::gemm_phase(lds, D, S, EpiGateUp{}); } PHASE_END
      PHASE_BEGIN_K(12) { LAS int* mo = (LAS int*)(lds + LDS_MISC); { const int tq = mk::otid(); if (tq < 17) mo[tq] = wsp<int>(p, WS_MOFF)[l * 64 + tq]; } __syncthreads();
        SchedMoe S{(bf16_t*)(scr + SM_HE), wsp<bf16_t>(p, WS_WDN), (bf16_t*)(scr + SM_YS), mo, DE, D, 256, nb, bid}; pg8::gemm_phase(lds, DE, S, pg8::EpiStoreBf16{}); } PHASE_END
      PHASE_BEGIN_K(13) phase_ln2(p, l, dry); PHASE_END
    }
    {
      const int l = 2 * lp + 1; const bool last = l == DEPTH - 1;
      bf16_t* Pqk = (bf16_t*)(scr + SO_PQK); bf16_t* Vt = (bf16_t*)(scr + SO_VT); bf16_t* O12 = (bf16_t*)(scr + SO_O12); bf16_t* Ybuf = (bf16_t*)(scr + SO_YBUF);
      PHASE_BEGIN_K(14) { SchedOddIn S{UO, wsp<bf16_t>(p, WS_WOIN) + (size_t)lp * ODD_IN * D, Pqk, Vt, nb, bid}; pg8::gemm_phase(lds, D, S, EpiOddIn{wsp<float>(p, WS_ROPE)}); } PHASE_END
      float* KN = wsp<float>(p, WS_KN) + (size_t)lp * 256 * 16;
      PHASE_BEGIN_K(23) for (int g = bid; g < 256; g += nb) att::knorm_group(Pqk, KN, g, (LAS float*)lds); PHASE_END
      PHASE_BEGIN_K(15) for (int ui = bid; ui < 2048 + (last ? 0 : 64); ui += nb) { int b, hh, q0, nlat; const int u = (nb == 256 && ui < 2048) ? ((((ui >> 8) * 8 + (bid & 7)) << 5) | (bid >> 3)) : ui;
        if (u < 2048) { b = u >> 9; hh = (u >> 5) & 15; q0 = b * T + (u & 31) * 256; nlat = T; } else { const int v = u - 2048; b = v >> 4; hh = v & 15; q0 = NLAT + b * L; nlat = 0; }
#ifdef MK_ABL
        if (dry) att::diff_attn_unit<MK_ABL>(Pqk, Vt, O12, hh, q0, b * T, nlat, NLAT + b * L, att::kmax2_of(KN, b, hh), lds); else
#endif
        att::diff_attn_unit(Pqk, Vt, O12, hh, q0, b * T, nlat, NLAT + b * L, att::kmax2_of(KN, b, hh), lds); } PHASE_END
      PHASE_BEGIN_K(16) { float d1 = 0.f, d2 = 0.f; for (int i = 0; i < 64; ++i) { d1 += p.da_lq1[lp * 64 + i] * p.da_lk1[lp * 64 + i]; d2 += p.da_lq2[lp * 64 + i] * p.da_lk2[lp * 64 + i]; }
        const float li = 0.8f - 0.6f * expf(-0.3f * (float)l), lam = expf(d1) - expf(d2) + li;
        const int tq = mk::otid(); for (int r4 = bid; r4 < (last ? NLAT : NTOK) / 4; r4 += nb) att::diff_combine_rows4(O12, p.da_subln_g + lp * 128, lam, 1.0f - li, UO, r4 * 4, tq >> 6, tq & 63); } PHASE_END
      PHASE_BEGIN_K(17) { SchedOut S{UO, wsp<bf16_t>(p, WS_WOOUT) + (size_t)lp * D * D, Ybuf, nb, bid}; pg8::gemm_phase(lds, D, S, pg8::EpiStoreBf16{}); __syncthreads(); cvt_experts(p, l, (LAS float*)lds, 528 - 2 * nb > 0 ? 528 - 2 * nb : 0); } PHASE_END
      PHASE_BEGIN_K(18) phase_ln1<false>(p, l, Ybuf, lds, dry); PHASE_END
      PHASE_BEGIN_K(19) phase_scatter(p, l, lds); PHASE_END
      PHASE_BEGIN_K(20) { LAS int* mo = (LAS int*)(lds + LDS_MISC); { const int tq = mk::otid(); if (tq < 17) mo[tq] = wsp<int>(p, WS_MOFF)[l * 64 + tq]; } __syncthreads();
        SchedMoe S{(bf16_t*)(scr + SM_XS), wsp<bf16_t>(p, WS_WGU), (bf16_t*)(scr + SM_HE), mo, D, DE, 128, nb, bid}; pg8::gemm_phase(lds, D, S, EpiGateUp{}); } PHASE_END
      PHASE_BEGIN_K(21) { LAS int* mo = (LAS int*)(lds + LDS_MISC); { const int tq = mk::otid(); if (tq < 17) mo[tq] = wsp<int>(p, WS_MOFF)[l * 64 + tq]; } __syncthreads();
        SchedMoe S{(bf16_t*)(scr + SM_HE), wsp<bf16_t>(p, WS_WDN), (bf16_t*)(scr + SM_YS), mo, DE, D, 256, nb, bid}; pg8::gemm_phase(lds, DE, S, pg8::EpiStoreBf16{}); } PHASE_END
      PHASE_BEGIN_K(22) phase_ln2(p, l, dry); PHASE_END
    }
  }
#undef PHASE_BEGIN_K
#undef PHASE_END
}
}

#ifndef MK_SINGLE_LAUNCH
#define MK_SINGLE_LAUNCH 1
#endif
extern "C" void kernel_launch(void* const* d_in, const int* in_sizes, int n_in, void* d_out, int out_size, void* d_ws, size_t ws_size, hipStream_t stream) {
  using namespace mk;
  static int grid = 0;
  if (grid == 0) {
    if (n_in != 34 || out_size != NLAT * D || ws_size < WS_END) { fprintf(stderr, "kernel_launch: unexpected shapes (n_in %d out %d ws %zu need %zu)\n", n_in, out_size, ws_size, (size_t)WS_END); grid = -1; return; }
    if (hipFuncSetAttribute((const void*)mega, hipFuncAttributeMaxDynamicSharedMemorySize, LDS_BYTES) != hipSuccess) { grid = -1; return; }
    int dev = 0, cus = 0, per_cu = 0;
    if (hipGetDevice(&dev) != hipSuccess || hipDeviceGetAttribute(&cus, hipDeviceAttributeMultiprocessorCount, dev) != hipSuccess) { grid = -1; return; }
    if (hipOccupancyMaxActiveBlocksPerMultiprocessor(&per_cu, (const void*)mega, NTHR, LDS_BYTES) != hipSuccess || per_cu < 1) { fprintf(stderr, "kernel_launch: occupancy query says %d\n", per_cu); }
    (void)hipGetLastError();
    grid = cus;
  }
  if (grid < 0) return;
  (void)hipMemsetAsync((char*)d_ws + WS_BAR, 0, (size_t)XCD_BAR_WORDS * 4, stream);
  Params p{};
  const float** pp = (const float**)&p;
  for (int i = 0; i < 34; ++i) pp[i] = (const float*)d_in[i];
  p.out = (float*)d_out; p.ws = (unsigned char*)d_ws;
#if MK_SINGLE_LAUNCH
  p.ph_lo = 0; p.ph_hi = N_PHASES;
  hipLaunchKernelGGL(mega, dim3(grid), dim3(NTHR), LDS_BYTES, stream, p);
#else
  for (int ph = 0; ph < N_PHASES; ++ph) { p.ph_lo = ph; p.ph_hi = ph + 1; hipLaunchKernelGGL(mega, dim3(grid), dim3(NTHR), LDS_BYTES, stream, p); }
#endif
}
```

```cpp
#include <hip/hip_runtime.h>
#include <stdint.h>
#include <stdio.h>

typedef unsigned short bf16_t;
typedef short bf16x8 __attribute__((ext_vector_type(8)));
typedef float f32x4 __attribute__((ext_vector_type(4)));
typedef float f32x2 __attribute__((ext_vector_type(2)));
typedef float f32x16 __attribute__((ext_vector_type(16)));
typedef unsigned u32x4 __attribute__((ext_vector_type(4)));
typedef unsigned u32x2 __attribute__((ext_vector_type(2)));
#define LAS __attribute__((address_space(3)))

namespace mk {
constexpr int B = 4, T = 8192, L = 256, D = 1024, NLAT = B * T, NCTX = B * L, NTOK = NLAT + NCTX;
constexpr int DEPTH = 4, EVEN_IN = 3328, ODD_IN = 3072, RW_OFF = 1536, RW_IN = 1792, NE = 16, DE = 512;
constexpr float ALPHA = 1.681792830507429f, LN_EPS = 1e-5f;
constexpr int NTHR = 512, LDS_BYTES = 147456;
constexpr int MOE_TILES = 280, MOE_ROWS = MOE_TILES * 256;

__device__ __forceinline__ unsigned cvt_pk_bf16(float lo, float hi) { unsigned r; asm volatile("v_cvt_pk_bf16_f32 %0, %1, %2" : "=v"(r) : "v"(lo), "v"(hi)); return r; }
__device__ __forceinline__ float bf2f(bf16_t b) { return __uint_as_float(((unsigned)b) << 16); }
__device__ __forceinline__ float bflo(unsigned w) { return __uint_as_float(w << 16); }
__device__ __forceinline__ float bfhi(unsigned w) { return __uint_as_float(w & 0xffff0000u); }
__device__ __forceinline__ bf16_t f2bf(float f) { return (bf16_t)(cvt_pk_bf16(f, 0.f) & 0xffffu); }
__device__ __forceinline__ float sigmoidf_(float x) { return 1.0f / (1.0f + __expf(-x)); }
__device__ __forceinline__ float siluf_(float x) { return x / (1.0f + __expf(-x)); }
__device__ __forceinline__ float wave_sum(float v) {
#pragma unroll
  for (int o = 32; o > 0; o >>= 1) v += __shfl_xor(v, o);
  return v;
}
template <int CTRL, int RM, int BM> __device__ __forceinline__ float dpp_mov(float old, float v) { return __int_as_float(__builtin_amdgcn_update_dpp(__float_as_int(old), __float_as_int(v), CTRL, RM, BM, false)); }
__device__ __forceinline__ float wave_sum_u(float v) {
  v += dpp_mov<0xB1, 0xf, 0xf>(v, v);
  v += dpp_mov<0x4E, 0xf, 0xf>(v, v);
  v += dpp_mov<0x141, 0xf, 0xf>(v, v);
  v += dpp_mov<0x140, 0xf, 0xf>(v, v);
  v += dpp_mov<0x142, 0xa, 0xf>(0.f, v);
  v += dpp_mov<0x143, 0xc, 0xf>(0.f, v);
  return __int_as_float(__builtin_amdgcn_readlane(__float_as_int(v), 63));
}
__device__ __forceinline__ float wave_max_u(float v) {
  v = fmaxf(v, dpp_mov<0xB1, 0xf, 0xf>(v, v));
  v = fmaxf(v, dpp_mov<0x4E, 0xf, 0xf>(v, v));
  v = fmaxf(v, dpp_mov<0x141, 0xf, 0xf>(v, v));
  v = fmaxf(v, dpp_mov<0x140, 0xf, 0xf>(v, v));
  v = fmaxf(v, dpp_mov<0x142, 0xa, 0xf>(0.f, v));
  v = fmaxf(v, dpp_mov<0x143, 0xc, 0xf>(0.f, v));
  return __int_as_float(__builtin_amdgcn_readlane(__float_as_int(v), 63));
}
__device__ __forceinline__ f32x16 zero16() { float z = 0.f; asm volatile("" : "+v"(z)); f32x16 r;
#pragma unroll
  for (int i = 0; i < 16; ++i) r[i] = z;
  return r; }
__device__ __forceinline__ int otid() { int t = threadIdx.x; asm volatile("" : "+v"(t)); return t; }
__device__ __forceinline__ int obid() { int b = blockIdx.x; asm volatile("" : "+s"(b)); return b; }
__device__ __forceinline__ int bidx_of_row(int row) { return row < NLAT ? row / T : 4; }
}

#include <vector>

#define XB_TMO      128
#define XB_XCNT(j)  (256  + 64 * (j))
#define XB_XSUB(j)  (1280 + 64 * (j))
#define XB_XGEN(j)  (2304 + 64 * (j))
#define XB_TOP      3328
#define XB_TOPGEN   3392
#define XCD_BAR_WORDS 3456
#define XB_SPIN_CAP (1u << 18)
#define LAS __attribute__((address_space(3)))

__device__ __forceinline__ unsigned xb_ld(unsigned* p)              { return __hip_atomic_load(p, __ATOMIC_RELAXED, __HIP_MEMORY_SCOPE_AGENT); }
__device__ __forceinline__ unsigned xb_add(unsigned* p, unsigned v) { return __hip_atomic_fetch_add(p, v, __ATOMIC_RELAXED, __HIP_MEMORY_SCOPE_AGENT); }
__device__ __forceinline__ unsigned xb_xcc_id() { return (unsigned)__builtin_amdgcn_s_getreg((3 << 11) | 20) & 0xFu; }
#define XB_SPIN(cond, bar) do { unsigned _sp = 0; while (cond) { __builtin_amdgcn_s_sleep(1); \
    if ((++_sp & 255u) == 0u) { if (xb_ld(&(bar)[XB_TMO])) break; if (_sp > XB_SPIN_CAP) { atomicAdd(&(bar)[XB_TMO], 1u); break; } } } } while (0)

struct XcdBarrier {
    unsigned* bar; unsigned x;
    volatile LAS unsigned* st;
};

__device__ __forceinline__ XcdBarrier xcd_barrier_post(unsigned* bar, volatile LAS unsigned* st) {
    XcdBarrier b; b.bar = bar; b.x = xb_xcc_id(); b.st = st;
    if (threadIdx.x == 0) (void)xb_add(&bar[XB_XCNT(b.x)], 1u);
    return b;
}
__device__ __forceinline__ void xcd_barrier_complete(unsigned* bar, unsigned x, unsigned& nloc, unsigned& nx) {
    const unsigned G = gridDim.x * gridDim.y * gridDim.z;
    unsigned sum, cnt, mine, sp = 0u;
    for (;;) {
        sum = 0u; cnt = 0u; mine = 0u;
#pragma unroll
        for (unsigned j = 0; j < 16; ++j) { const unsigned c = xb_ld(&bar[XB_XCNT(j)]); sum += c; cnt += (c > 0u) ? 1u : 0u; mine = (j == x) ? c : mine; }
        if (sum == G) break;
        __builtin_amdgcn_s_sleep(1);
        if ((++sp & 255u) == 0u) { if (xb_ld(&bar[XB_TMO])) break; if (sp > XB_SPIN_CAP) { atomicAdd(&bar[XB_TMO], 1u); break; } }
    }
    nloc = mine > 0u ? mine : 1u; nx = cnt > 0u ? cnt : 1u;
}

__device__ __forceinline__ void xcd_barrier(const XcdBarrier& b) {
    asm volatile("s_waitcnt vmcnt(0)" ::: "memory");
    __syncthreads();
    if (threadIdx.x == 0) {
        unsigned* bar = b.bar;
        __builtin_amdgcn_s_waitcnt(0);
        unsigned nloc = b.st[0], nx = b.st[1];
        if (nloc == 0u) { xcd_barrier_complete(bar, b.x, nloc, nx); b.st[0] = nloc; b.st[1] = nx; }
        const unsigned old = xb_add(&bar[XB_XSUB(b.x)], 1u);
        const unsigned gen = old / nloc;
        if (old + 1u == (gen + 1u) * nloc) {
            __builtin_amdgcn_fence(__ATOMIC_RELEASE, "agent");
            asm volatile("s_waitcnt vmcnt(0)" ::: "memory");
            const unsigned og = xb_add(&bar[XB_TOP], 1u);
            const unsigned tg = og / nx;
            if (og + 1u == (tg + 1u) * nx) xb_add(&bar[XB_TOPGEN], 1u);
            else XB_SPIN(xb_ld(&bar[XB_TOPGEN]) == tg, bar);
            __builtin_amdgcn_fence(__ATOMIC_ACQUIRE, "agent");
            xb_add(&bar[XB_XGEN(b.x)], 1u);
            asm volatile("s_waitcnt vmcnt(0)" ::: "memory");
        } else {
            XB_SPIN(xb_ld(&bar[XB_XGEN(b.x)]) == gen, bar);
            __builtin_amdgcn_fence(__ATOMIC_ACQUIRE, "agent");
            asm volatile("s_waitcnt vmcnt(0)" ::: "memory");
        }
    }
    __syncthreads();
}

namespace pg8 {
using mk::cvt_pk_bf16;
constexpr int BM = 256, BK = 64, HALF = 128, HTB = HALF * BK * 2  , STAGE_BYTES = 8 * HTB;
__host__ __device__ __forceinline__ int lds_byte(int r, int c) { const int st = (r >> 4) * 2 + (c >> 5), rr = r & 15, cc = c & 31, ob = rr * 64 + cc * 2; return st * 1024 + (ob ^ (((ob >> 9) & 1) << 5)); }
__host__ __device__ __forceinline__ void stage_rc(int b, int& R, int& C) { const int st = b / 1024, sb = b % 1024, swz = sb ^ (((sb >> 9) & 1) << 5); R = (st >> 1) * 16 + swz / 64; C = (st & 1) * 32 + (swz % 64) / 2; }
__host__ __device__ __forceinline__ int perm32(int rho) { const int n = rho >> 4, i = rho & 15; return 8 * (i >> 2) + 4 * n + (i & 3); }

struct Unit { const char* A; const char* Bt; bf16_t* out; const int* rl; int pm, pn, x0, x1, ldo, kind; };

template <class Epi, class Sched>
__device__ __forceinline__ void gemm_phase(LAS unsigned char* lds, const int K, const Sched& S, const Epi& E) {
    const int tid = mk::otid(), wid = __builtin_amdgcn_readfirstlane(tid >> 6), lane = tid & 63, wr = wid >> 2, wc = wid & 3, fr = lane & 15, fq = lane >> 4;
    const int nt = K / BK;
    constexpr bool GATH = Sched::GATHER;
    unsigned voffA[2], voffB[2]; int Rl[2], Cl[2];
#pragma unroll
    for (int i = 0; i < 2; ++i) { int R, C; stage_rc(tid * 16 + i * 8192, R, C); const int Rb = Epi::PERM ? ((R & ~31) + perm32(R & 31)) : R; Rl[i] = R; Cl[i] = C;
        voffA[i] = (unsigned)(R * K + C) * 2u; voffB[i] = (unsigned)(Rb * K + C) * 2u; }
    unsigned roC[2][2], roN[2][2];
    (void)Rl; (void)Cl;
    const size_t kstep = (size_t)(BK * 2);
    const size_t hstep = (size_t)HALF * K * 2;
    const unsigned ldsw = (unsigned)wid * 1024u;
    const int aoff = lds_byte(wr * 64 + fr, fq * 8), boff = lds_byte(wc * 32 + fr, fq * 8);
#define PG8_SA(b, h) (((b) * 2 + (h)) * HTB)
#define PG8_SB(b, h) ((4 + (b) * 2 + (h)) * HTB)
#define PG8_STAGE(bufoff, gbase, voff) do { _Pragma("unroll") for (int _i = 0; _i < 2; ++_i) \
        __builtin_amdgcn_global_load_lds((const unsigned*)((const char*)(gbase) + (voff)[_i]), (LAS unsigned*)(lds + (bufoff) + ldsw + _i * 8192), 16, 0, 0); } while (0)
#define PG8_STAGE_A(bufoff, gbase, h, ro) do { if constexpr (GATH) { _Pragma("unroll") for (int _i = 0; _i < 2; ++_i) \
        __builtin_amdgcn_global_load_lds((const unsigned*)((const char*)(gbase) + (ro)[h][_i]), (LAS unsigned*)(lds + (bufoff) + ldsw + _i * 8192), 16, 0, 0); } \
      else { PG8_STAGE(bufoff, (const char*)(gbase) + (h) * hstep, voffA); } } while (0)
#define PG8_LOAD_RO(u, ro) do { _Pragma("unroll") for (int _h = 0; _h < 2; ++_h) _Pragma("unroll") for (int _i = 0; _i < 2; ++_i) \
        (ro)[_h][_i] = (unsigned)(u).rl[Rl[_i] + _h * 128] * (unsigned)(K * 2) + (unsigned)(Cl[_i] * 2); } while (0)
#define PG8_LDA(dst, b, h) do { _Pragma("unroll") for (int m = 0; m < 4; ++m) _Pragma("unroll") for (int k = 0; k < 2; ++k) dst[m][k] = *(const LAS bf16x8*)(lds + PG8_SA(b, h) + aoff + m * 2048 + k * 1024); } while (0)
#define PG8_LDB(dst, b, h) do { _Pragma("unroll") for (int n = 0; n < 2; ++n) _Pragma("unroll") for (int k = 0; k < 2; ++k) dst[n][k] = *(const LAS bf16x8*)(lds + PG8_SB(b, h) + boff + n * 2048 + k * 1024); } while (0)
#define PG8_MMA(ai, bj, At, Bt) do { __builtin_amdgcn_s_setprio(1); _Pragma("unroll") for (int m = 0; m < 4; ++m) _Pragma("unroll") for (int n = 0; n < 2; ++n) _Pragma("unroll") for (int k = 0; k < 2; ++k) \
        acc[ai][bj][m][n] = __builtin_amdgcn_mfma_f32_16x16x32_bf16(Bt[n][k], At[m][k], acc[ai][bj][m][n], 0, 0, 0); __builtin_amdgcn_s_setprio(0); } while (0)
#define PG8_WAIT_V(n) asm volatile("s_waitcnt vmcnt(" #n ")" ::: "memory")
#define PG8_WAIT_L(n) asm volatile("s_waitcnt lgkmcnt(" #n ")" ::: "memory")
#define PG8_BAR __builtin_amdgcn_s_barrier()
#define PG8_SCHED __builtin_amdgcn_sched_barrier(0)
    Unit cur, nxt; int ui = 0;
    if (!S.next(0, cur)) return;
    f32x4 acc[2][2][4][2];
#pragma unroll
    for (int a = 0; a < 2; ++a)
#pragma unroll
        for (int b = 0; b < 2; ++b)
#pragma unroll
            for (int m = 0; m < 4; ++m)
#pragma unroll
                for (int n = 0; n < 2; ++n) acc[a][b][m][n] = (f32x4){0.f, 0.f, 0.f, 0.f};
    bf16x8 At[4][2], B0[2][2], B1[2][2];
    const char* cA = cur.A; const char* cB = cur.Bt;
    if constexpr (GATH) { PG8_LOAD_RO(cur, roC); }
    PG8_STAGE(PG8_SB(0, 0), cB, voffB); PG8_STAGE_A(PG8_SA(0, 0), cA, 0, roC); PG8_STAGE(PG8_SB(0, 1), cB + hstep, voffB); PG8_STAGE_A(PG8_SA(0, 1), cA, 1, roC);
    if (wr == 1) PG8_BAR;
    PG8_WAIT_V(4); PG8_BAR;
    PG8_STAGE(PG8_SB(1, 0), cB + kstep, voffB); PG8_STAGE_A(PG8_SA(1, 0), cA + kstep, 0, roC); PG8_STAGE(PG8_SB(1, 1), cB + hstep + kstep, voffB);
    PG8_WAIT_V(6); PG8_BAR;
    for (;;) {
        const bool has_next = S.next(ui + 1, nxt);
        const char* nA = has_next ? nxt.A : cA; const char* nB = has_next ? nxt.Bt : cB;
        if constexpr (GATH) { if (has_next) { PG8_LOAD_RO(nxt, roN); } else { _Pragma("unroll") for (int _h = 0; _h < 2; ++_h) _Pragma("unroll") for (int _i = 0; _i < 2; ++_i) roN[_h][_i] = roC[_h][_i]; } }
        for (int t = 0; t < nt; t += 2) {
            const bool last = (t == nt - 2);
            const char* a1 = cA + (size_t)(t + 1) * kstep;
            const char* a2 = last ? nA : cA + (size_t)(t + 2) * kstep; const char* b2 = last ? nB : cB + (size_t)(t + 2) * kstep;
            const char* a3 = a2 + kstep; const char* b3 = b2 + kstep;
            unsigned ro2[2][2];
            if constexpr (GATH) { _Pragma("unroll") for (int _h = 0; _h < 2; ++_h) _Pragma("unroll") for (int _i = 0; _i < 2; ++_i) ro2[_h][_i] = last ? roN[_h][_i] : roC[_h][_i]; }
            (void)ro2;
            PG8_LDB(B0, 0, 0); PG8_SCHED; PG8_LDA(At, 0, 0); PG8_STAGE_A(PG8_SA(1, 1), a1, 1, roC);
            PG8_WAIT_L(8); PG8_BAR; PG8_WAIT_L(0); PG8_MMA(0, 0, At, B0); PG8_BAR; PG8_SCHED;
            PG8_LDB(B1, 0, 1); PG8_STAGE(PG8_SB(0, 0), b2, voffB);
            PG8_BAR; PG8_WAIT_L(0); PG8_MMA(0, 1, At, B1); PG8_BAR;
            PG8_LDA(At, 0, 1); PG8_STAGE_A(PG8_SA(0, 0), a2, 0, ro2);
            PG8_BAR; PG8_WAIT_L(0); PG8_MMA(1, 0, At, B0); PG8_BAR; PG8_SCHED;
            PG8_STAGE(PG8_SB(0, 1), b2 + hstep, voffB);
            PG8_WAIT_V(6); PG8_BAR; PG8_MMA(1, 1, At, B1); PG8_BAR;
            PG8_LDB(B0, 1, 0); PG8_SCHED; PG8_LDA(At, 1, 0); PG8_STAGE_A(PG8_SA(0, 1), a2, 1, ro2);
            PG8_WAIT_L(8); PG8_BAR; PG8_WAIT_L(0); PG8_MMA(0, 0, At, B0); PG8_BAR; PG8_SCHED;
            PG8_LDB(B1, 1, 1); PG8_STAGE(PG8_SB(1, 0), b3, voffB);
            PG8_BAR; PG8_WAIT_L(0); PG8_MMA(0, 1, At, B1); PG8_BAR;
            PG8_LDA(At, 1, 1); PG8_STAGE_A(PG8_SA(1, 0), a3, 0, ro2);
            PG8_BAR; PG8_WAIT_L(0); PG8_MMA(1, 0, At, B0); PG8_BAR; PG8_SCHED;
            PG8_STAGE(PG8_SB(1, 1), b3 + hstep, voffB);
            PG8_WAIT_V(6); PG8_BAR; PG8_MMA(1, 1, At, B1); PG8_BAR;
        }
        E(acc, cur, wr, wc, fr, fq);
        if (!has_next) break;
#pragma unroll
        for (int a = 0; a < 2; ++a)
#pragma unroll
            for (int b = 0; b < 2; ++b)
#pragma unroll
                for (int m = 0; m < 4; ++m)
#pragma unroll
                    for (int n = 0; n < 2; ++n) acc[a][b][m][n] = (f32x4){0.f, 0.f, 0.f, 0.f};
        cur = nxt; cA = nA; cB = nB; ++ui;
        if constexpr (GATH) { _Pragma("unroll") for (int _h = 0; _h < 2; ++_h) _Pragma("unroll") for (int _i = 0; _i < 2; ++_i) roC[_h][_i] = roN[_h][_i]; }
    }
    PG8_WAIT_V(0);
    if (wr == 0) PG8_BAR;
    PG8_BAR;
#undef PG8_SA
#undef PG8_SB
#undef PG8_STAGE
#undef PG8_STAGE_A
#undef PG8_LOAD_RO
#undef PG8_LDA
#undef PG8_LDB
#undef PG8_MMA
#undef PG8_WAIT_V
#undef PG8_WAIT_L
#undef PG8_BAR
#undef PG8_SCHED
}

struct EpiStoreBf16 {
    static constexpr bool PERM = true;
    __device__ __forceinline__ void operator()(const f32x4 (&acc)[2][2][4][2], const Unit& u, int wr, int wc, int fr, int fq) const {
        bf16_t* O = u.out; const int ldc = u.ldo;
        const int row0 = u.x0 + wr * 64 + fr, col0 = u.x1 + wc * 32 + 8 * fq;
#pragma unroll
        for (int ai = 0; ai < 2; ++ai)
#pragma unroll
            for (int m = 0; m < 4; ++m) { bf16_t* rowp = O + (size_t)(row0 + ai * HALF + m * 16) * ldc + col0;
#pragma unroll
                for (int bj = 0; bj < 2; ++bj) { const f32x4 v0 = acc[ai][bj][m][0], v1 = acc[ai][bj][m][1];
                    u32x4 w; w.x = cvt_pk_bf16(v0[0], v0[1]); w.y = cvt_pk_bf16(v0[2], v0[3]); w.z = cvt_pk_bf16(v1[0], v1[1]); w.w = cvt_pk_bf16(v1[2], v1[3]);
                    *(u32x4*)(rowp + bj * HALF) = w; } }
    }
};
}

namespace mk {
struct NMapId { int off; __device__ __forceinline__ int operator()(int n) const { return n + off; } __device__ __forceinline__ float scl(int) const { return 1.0f; } };
struct NMapInterleave { int which; __device__ __forceinline__ int operator()(int n) const { return 2 * n + which; } __device__ __forceinline__ float scl(int) const { return 1.0f; } };
struct NMapRope { __device__ __forceinline__ int operator()(int n) const { if (n >= 2048) return n; const int ch = n >> 6, c = n & 63, half = c >> 5, w = c & 31, z = w >> 4, i = w & 15; return ch * 64 + half * 32 + 2 * i + z; }
  __device__ __forceinline__ float scl(int n) const { return n < 1024 ? 0.125f * 1.4426950408889634f : 1.0f; } };

template <class NMap>
__device__ __forceinline__ void cvt_tile(const float* __restrict__ src, int ldsrc, int K, bf16_t* __restrict__ dst, int k0, int n0, const NMap& nmap, LAS float* tile) {
  const int t = mk::otid();
  { const int k = t >> 3, c = (t & 7) * 8; const float* p = src + (size_t)(k0 + k) * ldsrc + n0 + c;
    const f32x4 a = *(const f32x4*)p, b = *(const f32x4*)(p + 4);
    LAS float* q = tile + k * 65 + c; q[0] = a[0]; q[1] = a[1]; q[2] = a[2]; q[3] = a[3]; q[4] = b[0]; q[5] = b[1]; q[6] = b[2]; q[7] = b[3]; }
  __syncthreads();
  { const int n = t >> 3, kc = (t & 7) * 8; const LAS float* q = tile + kc * 65 + n; const float sc = nmap.scl(n0 + n);
    u32x4 w; w.x = cvt_pk_bf16(q[0] * sc, q[65] * sc); w.y = cvt_pk_bf16(q[130] * sc, q[195] * sc); w.z = cvt_pk_bf16(q[260] * sc, q[325] * sc); w.w = cvt_pk_bf16(q[390] * sc, q[455] * sc);
    *(u32x4*)(dst + (size_t)nmap(n0 + n) * K + k0 + kc) = w; }
  __syncthreads();
}
template <class NMap>
__device__ __forceinline__ int cvt_matrix(const float* src, int ldsrc, int K, int N, bf16_t* dst, const NMap& nmap, LAS float* tile, int ubase, int bid, int nblk) {
  const int nkt = K / 64, nnt = N / 64, tot = nkt * nnt;
  int first = ubase + ((bid - ubase % nblk) + nblk) % nblk;
  for (int u = first; u < ubase + tot; u += nblk) { const int v = u - ubase; cvt_tile(src, ldsrc, K, dst, (v / nnt) * 64, (v % nnt) * 64, nmap, tile); }
  return tot;
}
}

namespace att {
using namespace mk;
constexpr int KB_BYTES = 64 * 128, VB_BYTES = 128 * 128, TILE_BYTES = KB_BYTES + VB_BYTES, DA_RING = 4, DA_LDS = DA_RING * TILE_BYTES;
__device__ __forceinline__ int pi32(int r) { return (r & ~12) | ((r & 4) << 1) | ((r & 8) >> 1); }
__device__ __forceinline__ int swz(int row, int chunk) { return row * 128 + ((chunk ^ ((row >> 1) & 7)) << 4); }
__device__ __forceinline__ int crow(int r, int hi) { return (r & 3) + 8 * (r >> 2) + 4 * hi; }

__device__ __forceinline__ float sumsq8(u32x4 w) { return (bflo(w.x) * bflo(w.x) + bfhi(w.x) * bfhi(w.x)) + (bflo(w.y) * bflo(w.y) + bfhi(w.y) * bfhi(w.y)) + (bflo(w.z) * bflo(w.z) + bfhi(w.z) * bfhi(w.z)) + (bflo(w.w) * bflo(w.w) + bfhi(w.w) * bfhi(w.w)); }
__device__ __forceinline__ void knorm_group(const bf16_t* __restrict__ Pqk, float* __restrict__ KN, int g, LAS float* red) {
  const int tid = mk::otid(), wid = tid >> 6, lane = tid & 63;
  float mx = 0.f;
  for (int i0 = 0; i0 < 160; i0 += 32) {
    u32x4 a[4], b[4];
#pragma unroll
    for (int j = 0; j < 4; ++j) { int i = i0 + j * 8 + wid; i = i < 132 ? i : wid; const int row = i < 128 ? g * 128 + i : NLAT + g * 4 + (i - 128);
      const bf16_t* kp = Pqk + (size_t)row * 2048 + 1024 + lane * 16; a[j] = *(const u32x4*)kp; b[j] = *(const u32x4*)(kp + 8); }
#pragma unroll
    for (int j = 0; j < 4; ++j) { float s = sumsq8(a[j]) + sumsq8(b[j]); s += dpp_mov<0xB1, 0xf, 0xf>(s, s); s += dpp_mov<0x4E, 0xf, 0xf>(s, s); mx = fmaxf(mx, s); }
  }
  if ((lane & 3) == 0) red[wid * 16 + (lane >> 2)] = mx;
  __syncthreads();
  if (tid < 16) { float m = red[tid];
#pragma unroll
    for (int w = 1; w < 8; ++w) m = fmaxf(m, red[w * 16 + tid]);
    KN[g * 16 + tid] = m; }
  __syncthreads();
}
__device__ __forceinline__ float kmax2_of(const float* __restrict__ KN, int b, int hh) {
  return wave_max_u(KN[(b * 64 + (mk::otid() & 63)) * 16 + hh]);
}

template <int ABL = 0>
__device__ __forceinline__ void diff_attn_unit(const bf16_t* __restrict__ Pqk, const bf16_t* __restrict__ Vt, bf16_t* __restrict__ O12, int hh, int q0, int klat0, int nlat, int kctx0, float kmax2, LAS unsigned char* lds) {
  const int tid = mk::otid(), wid = tid >> 6, lane = tid & 63, r = lane & 31, hi = lane >> 5;
  const int NT = (nlat + L) / 64, NTL = nlat / 64;
  const int wv = __builtin_amdgcn_readfirstlane(wid);
  const int drow = wv * 8 + (lane >> 3), dch = (lane & 7) ^ ((drow >> 1) & 7);
  const unsigned koff = (unsigned)(drow * 2048 + 1024 + hh * 64 + dch * 8) * 2u;
  const unsigned voff = (unsigned)(((hh >> 1) * 128 + drow) * NTOK + dch * 8) * 2u;
  bf16x8 qf[4];
  { const bf16_t* qp = Pqk + (size_t)(q0 + wid * 32 + r) * 2048 + hh * 64 + hi * 8;
#pragma unroll
    for (int ks = 0; ks < 4; ++ks) qf[ks] = *(const bf16x8*)(qp + ks * 16); }
  int kaddr[2];
#pragma unroll
  for (int kb = 0; kb < 2; ++kb) kaddr[kb] = (kb * 32 + pi32(r)) * 128;
  const int kx = (pi32(r) >> 1) & 7;
  const int vx = (r >> 1) & 7;
  f32x16 o[4];
#pragma unroll
  for (int vb = 0; vb < 4; ++vb)
#pragma unroll
    for (int i = 0; i < 16; ++i) o[vb][i] = 0.f;
  float l_run = 0.f;
#define DA_DMA(t) do { const int tok = (t) < NTL ? klat0 + (t) * 64 : kctx0 + ((t) - NTL) * 64; LAS unsigned char* b_ = lds + ((t) & 3) * TILE_BYTES + wv * 1024; \
    const char* kt_ = (const char*)Pqk + (size_t)tok * 4096; const char* vt_ = (const char*)Vt + (size_t)tok * 2; \
    __builtin_amdgcn_global_load_lds((const unsigned*)(kt_ + koff), (LAS unsigned*)b_, 16, 0, 0); \
    __builtin_amdgcn_global_load_lds((const unsigned*)(vt_ + voff), (LAS unsigned*)(b_ + KB_BYTES), 16, 0, 0); \
    __builtin_amdgcn_global_load_lds((const unsigned*)(vt_ + (size_t)64 * NTOK * 2 + voff), (LAS unsigned*)(b_ + KB_BYTES + 8192), 16, 0, 0); } while (0)
#define DA_WAITV(n) asm volatile("s_waitcnt vmcnt(" #n ")" ::: "memory")
#define DA_PAIR_BEGIN(t) if (!(ABL & 8) && (t) + 2 < NT) { DA_DMA((t) + 2); DA_DMA((t) + 3); }
#define DA_SLOT(tt) const LAS unsigned char* kb_ = lds + ((tt) & 3) * TILE_BYTES; const LAS unsigned char* vb_ = kb_ + KB_BYTES
#define DA_PAIR_END() do { DA_WAITV(0); asm volatile("s_waitcnt lgkmcnt(0)" ::: "memory"); if (!(ABL & 16)) __builtin_amdgcn_s_barrier(); } while (0)
  DA_DMA(0); DA_DMA(1);
  float qn2 = 0.f;
#pragma unroll
  for (int ks = 0; ks < 4; ++ks) { const u32x4 w = __builtin_bit_cast(u32x4, qf[ks]);
    qn2 += bflo(w.x) * bflo(w.x) + bfhi(w.x) * bfhi(w.x) + bflo(w.y) * bflo(w.y) + bfhi(w.y) * bfhi(w.y) + bflo(w.z) * bflo(w.z) + bfhi(w.z) * bfhi(w.z) + bflo(w.w) * bflo(w.w) + bfhi(w.w) * bfhi(w.w); }
  { const u32x2 sw = __builtin_amdgcn_permlane32_swap(__float_as_uint(qn2), __float_as_uint(qn2), false, false); qn2 = __uint_as_float(sw.x) + __uint_as_float(sw.y); }
  const float m_stat = sqrtf(qn2 * kmax2) * 1.0001f;
  const bool use_static = __all(m_stat <= 60.0f);
  DA_WAITV(0); __builtin_amdgcn_s_barrier();
#define DA_KFRAG(ks) const int ch = (((ks) * 2 + hi) ^ kx) << 4; const bf16x8 a0 = (ABL & 2) ? qf[ks] : *(const LAS bf16x8*)(kb_ + kaddr[0] + ch), a1 = (ABL & 2) ? qf[(ks) ^ 1] : *(const LAS bf16x8*)(kb_ + kaddr[1] + ch)
#define DA_VFRAGS() bf16x8 va[4][4]; \
    _Pragma("unroll") for (int vb = 0; vb < 4; ++vb) { const LAS unsigned char* vrow = vb_ + (vb * 32 + r) * 128; \
      _Pragma("unroll") for (int c4 = 0; c4 < 4; ++c4) va[vb][c4] = (ABL & 1) ? qf[c4 ^ (vb & 3)] : *(const LAS bf16x8*)(vrow + (((2 * c4 + hi) ^ vx) << 4)); }
#define DA_PACK_PV() bf16x8 pf[2][2]; \
    _Pragma("unroll") for (int s = 0; s < 2; ++s) { u32x4 w0, w1; \
      w0.x = cvt_pk_bf16(s0[8 * s + 0], s0[8 * s + 1]); w0.y = cvt_pk_bf16(s0[8 * s + 2], s0[8 * s + 3]); w0.z = cvt_pk_bf16(s0[8 * s + 4], s0[8 * s + 5]); w0.w = cvt_pk_bf16(s0[8 * s + 6], s0[8 * s + 7]); \
      w1.x = cvt_pk_bf16(s1[8 * s + 0], s1[8 * s + 1]); w1.y = cvt_pk_bf16(s1[8 * s + 2], s1[8 * s + 3]); w1.z = cvt_pk_bf16(s1[8 * s + 4], s1[8 * s + 5]); w1.w = cvt_pk_bf16(s1[8 * s + 6], s1[8 * s + 7]); \
      pf[0][s] = __builtin_bit_cast(bf16x8, w0); pf[1][s] = __builtin_bit_cast(bf16x8, w1); } \
    _Pragma("unroll") for (int vb = 0; vb < 4; ++vb) _Pragma("unroll") for (int kb = 0; kb < 2; ++kb) _Pragma("unroll") for (int s = 0; s < 2; ++s) \
      o[vb] = __builtin_amdgcn_mfma_f32_32x32x16_bf16(va[vb][kb * 2 + s], pf[kb][s], o[vb], 0, 0, 0)
  if (use_static) {
    for (int t = 0; t < NT; t += 2) {
      DA_PAIR_BEGIN(t);
#pragma unroll
      for (int u = 0; u < 2; ++u) {
        DA_SLOT(t + u);
        f32x16 s0, s1;
#pragma unroll
        for (int i = 0; i < 16; ++i) { s0[i] = 0.f; s1[i] = 0.f; }
#pragma unroll
        for (int ks = 0; ks < 4; ++ks) { DA_KFRAG(ks); s0 = __builtin_amdgcn_mfma_f32_32x32x16_bf16(a0, qf[ks], s0, 0, 0, 0); s1 = __builtin_amdgcn_mfma_f32_32x32x16_bf16(a1, qf[ks], s1, 0, 0, 0); }
        DA_VFRAGS();
        if constexpr ((ABL & 32) != 0) {
          l_run += s0[0] + s1[0];
#pragma unroll
          for (int vb = 0; vb < 4; ++vb)
#pragma unroll
            for (int c4 = 0; c4 < 4; ++c4) o[vb] = __builtin_amdgcn_mfma_f32_32x32x16_bf16(va[vb][c4], qf[c4], o[vb], 0, 0, 0);
        } else {
          float ps = 0.f;
#pragma unroll
          for (int i = 0; i < 16; ++i) { s0[i] = (ABL & 4) ? s0[i] : __builtin_amdgcn_exp2f(s0[i]); ps += s0[i]; }
#pragma unroll
          for (int i = 0; i < 16; ++i) { s1[i] = (ABL & 4) ? s1[i] : __builtin_amdgcn_exp2f(s1[i]); ps += s1[i]; }
          l_run += ps;
          DA_PACK_PV();
        }
        if (u == 0) __builtin_amdgcn_sched_barrier(0);
      }
      DA_PAIR_END();
    }
  } else {
    constexpr float THR = 8.0f * 1.4426950408889634f;
    float m_run = -1e30f;
    for (int t = 0; t < NT; ++t) {
      if (!(t & 1)) DA_PAIR_BEGIN(t);
      DA_SLOT(t);
      f32x16 s0 = zero16(), s1 = zero16();
#pragma unroll
      for (int ks = 0; ks < 4; ++ks) { DA_KFRAG(ks); s0 = __builtin_amdgcn_mfma_f32_32x32x16_bf16(a0, qf[ks], s0, 0, 0, 0); s1 = __builtin_amdgcn_mfma_f32_32x32x16_bf16(a1, qf[ks], s1, 0, 0, 0); }
      float mx = fmaxf(s0[0], s1[0]);
#pragma unroll
      for (int i = 1; i < 16; ++i) mx = fmaxf(mx, fmaxf(s0[i], s1[i]));
      { const u32x2 sw = __builtin_amdgcn_permlane32_swap(__float_as_uint(mx), __float_as_uint(mx), false, false); mx = fmaxf(__uint_as_float(sw.x), __uint_as_float(sw.y)); }
      float alpha = 1.0f;
      if (!__all(mx - m_run <= THR)) {
        const float m_new = fmaxf(m_run, mx);
        alpha = __builtin_amdgcn_exp2f(m_run - m_new);
        m_run = m_new;
#pragma unroll
        for (int vb = 0; vb < 4; ++vb)
#pragma unroll
          for (int i = 0; i < 16; ++i) o[vb][i] *= alpha;
      }
      float ps = 0.f;
#pragma unroll
      for (int i = 0; i < 16; ++i) { s0[i] = __builtin_amdgcn_exp2f(s0[i] - m_run); ps += s0[i]; }
#pragma unroll
      for (int i = 0; i < 16; ++i) { s1[i] = __builtin_amdgcn_exp2f(s1[i] - m_run); ps += s1[i]; }
      l_run = l_run * alpha + ps;
      __builtin_amdgcn_sched_barrier(0);
      DA_VFRAGS();
      DA_PACK_PV();
      if (t & 1) DA_PAIR_END();
    }
  }
#undef DA_KFRAG
#undef DA_VFRAGS
#undef DA_PACK_PV
#undef DA_DMA
#undef DA_WAITV
#undef DA_PAIR_BEGIN
#undef DA_PAIR_END
#undef DA_SLOT
  float l_tot; { const u32x2 sw = __builtin_amdgcn_permlane32_swap(__float_as_uint(l_run), __float_as_uint(l_run), false, false); l_tot = __uint_as_float(sw.x) + __uint_as_float(sw.y); }
  const float inv = 1.0f / l_tot;
  const int te = mk::otid();
  bf16_t* op = O12 + (size_t)(q0 + (te >> 6) * 32 + (te & 31)) * 2048 + hh * 128 + 4 * ((te >> 5) & 1);
#pragma unroll
  for (int vb = 0; vb < 4; ++vb)
#pragma unroll
    for (int g = 0; g < 4; ++g) {
      u32x2 w; w.x = cvt_pk_bf16(o[vb][4 * g] * inv, o[vb][4 * g + 1] * inv); w.y = cvt_pk_bf16(o[vb][4 * g + 2] * inv, o[vb][4 * g + 3] * inv);
      *(u32x2*)(op + vb * 32 + 8 * g) = w;
    }
}

__device__ __forceinline__ void diff_combine_rows4(const bf16_t* __restrict__ O12, const float* __restrict__ subln_g, float lam, float oml, bf16_t* __restrict__ O, int row0, int h, int lane) {
  unsigned a[4], b[4];
#pragma unroll
  for (int i = 0; i < 4; ++i) { a[i] = *(const unsigned*)(O12 + (size_t)(row0 + i) * 2048 + (2 * h) * 128 + 2 * lane); b[i] = *(const unsigned*)(O12 + (size_t)(row0 + i) * 2048 + (2 * h + 1) * 128 + 2 * lane); }
  const float g0 = subln_g[2 * lane], g1 = subln_g[2 * lane + 1];
#pragma unroll
  for (int i = 0; i < 4; ++i) {
    const float x0 = bflo(a[i]) - lam * bflo(b[i]), x1 = bfhi(a[i]) - lam * bfhi(b[i]);
    const float ss = wave_sum_u(x0 * x0 + x1 * x1);
    const float rs = rsqrtf(ss * (1.0f / 128.0f) + 1e-5f) * oml;
    *(unsigned*)(O + (size_t)(row0 + i) * 1024 + h * 128 + 2 * lane) = cvt_pk_bf16(x0 * rs * g0, x1 * rs * g1);
  }
}
}

namespace natt {
using namespace mk;
using att::pi32; using att::swz;
constexpr int TB = 64 * 128;
constexpr int NA_LDS = 4 * TB + 2048;
__device__ __forceinline__ void na_attn_unit(const bf16_t* __restrict__ Pe, const bf16_t* __restrict__ Vte, const float* __restrict__ rpb_h, bf16_t* __restrict__ O, int b, int h, int rq, LAS unsigned char* lds) {
  const int tid = mk::otid(), wid = tid >> 6, lane = tid & 63, r = lane & 31, hi = lane >> 5;
  constexpr float LOG2E = 1.4426950408889634f;
  LAS float* sb = (LAS float*)(lds + 4 * TB);
  for (int i = tid; i < 465; i += NTHR) sb[i] = rpb_h[i];
  const bool is_ctx = rq < 0;
  int qrow = 0, qcol = 0, qtok, rs_q = 0, cs_q = 0, span0 = 0, wlo = 0, whi = -1, lo = 0, ntl = 0;
  if (!is_ctx) {
    const int r0 = rq * 4, ra = r0 + (wid >> 2) * 2;
    qrow = ra + (r >> 4); qcol = (wid & 3) * 16 + (r & 15); qtok = b * T + qrow * 64 + qcol;
    rs_q = min(max(qrow - 4, 0), 120); cs_q = min(max(qcol - 8, 0), 48);
    span0 = min(max((wid & 3) * 16 - 8, 0), 32);
    wlo = min(max(ra - 4, 0), 120); whi = min(max(ra - 3, 0), 120) + 7;
    lo = min(max(r0 - 4, 0), 120); const int hi_ = min(max(r0 - 1, 0), 120) + 7; ntl = hi_ - lo + 1;
  } else qtok = NLAT + b * L + wid * 32 + r;
  const int NT = ntl + 4;
  const int srow = tid >> 3, sch = tid & 7;
  const bf16_t* kbase = Pe + 512 + h * 64 + sch * 8;
  const bf16_t* vbase = Vte + (size_t)(h * 64 + srow) * NTOK + sch * 8;
  const int sdst = swz(srow, sch);
  bf16x8 qf[4];
  { const bf16_t* qp = Pe + (size_t)qtok * 1024 + h * 64 + hi * 8;
#pragma unroll
    for (int ks = 0; ks < 4; ++ks) qf[ks] = *(const bf16x8*)(qp + ks * 16); }
  const int kx = (pi32(r) >> 1) & 7, vx = (r >> 1) & 7;
  const int ka_loc = (span0 + pi32(r)) * 128; const int kx_loc = ((span0 + pi32(r)) >> 1) & 7;
  f32x16 o[2];
#pragma unroll
  for (int vb = 0; vb < 2; ++vb)
#pragma unroll
    for (int i = 0; i < 16; ++i) o[vb][i] = 0.f;
  float m_run = -1e30f, l_run = 0.f;
  u32x4 kreg, vreg;
#define NA_LOAD(t) do { const int tok = (t) < ntl ? b * T + (lo + (t)) * 64 : NLAT + b * L + ((t) - ntl) * 64; \
    kreg = *(const u32x4*)(kbase + (size_t)(tok + srow) * 1024); vreg = *(const u32x4*)(vbase + tok); } while (0)
#define NA_WRITE(bufi) do { *(LAS u32x4*)(lds + (bufi) * TB + sdst) = kreg; *(LAS u32x4*)(lds + 2 * TB + (bufi) * TB + sdst) = vreg; } while (0)
  NA_LOAD(0); NA_WRITE(0); __syncthreads();
  for (int t = 0; t < NT; ++t) {
    const bool more = t + 1 < NT;
    if (more) NA_LOAD(t + 1);
    const LAS unsigned char* kb_ = lds + (t & 1) * TB; const LAS unsigned char* vb_ = lds + 2 * TB + (t & 1) * TB;
    const bool local = t < ntl; const int kr = lo + t;
    const bool active = !local || (kr >= wlo && kr <= whi);
    if (active) {
      f32x16 s0, s1;
#pragma unroll
      for (int i = 0; i < 16; ++i) { s0[i] = 0.f; s1[i] = 0.f; }
      if (local) {
#pragma unroll
        for (int ks = 0; ks < 4; ++ks) {
          const bf16x8 a0 = *(const LAS bf16x8*)(kb_ + ka_loc + (((ks * 2 + hi) ^ kx_loc) << 4));
          s0 = __builtin_amdgcn_mfma_f32_32x32x16_bf16(a0, qf[ks], s0, 0, 0, 0);
        }
        const bool row_ok = kr >= rs_q && kr < rs_q + 8; const int dr31 = (kr - qrow + 7) * 31;
#pragma unroll
        for (int i = 0; i < 16; ++i) {
          const int kc = span0 + (i & 7) + 8 * hi + 16 * (i >> 3);
          const bool ok = row_ok && kc >= cs_q && kc < cs_q + 16;
          const int bi = ok ? dr31 + (kc - qcol + 15) : 0;
          const float bv = sb[bi];
          s0[i] = ok ? fmaf(s0[i], 0.125f, bv) : -1e30f; s1[i] = -1e30f;
        }
      } else {
#pragma unroll
        for (int ks = 0; ks < 4; ++ks) {
          const int ch = ((ks * 2 + hi) ^ kx) << 4;
          const bf16x8 a0 = *(const LAS bf16x8*)(kb_ + pi32(r) * 128 + ch), a1 = *(const LAS bf16x8*)(kb_ + (32 + pi32(r)) * 128 + ch);
          s0 = __builtin_amdgcn_mfma_f32_32x32x16_bf16(a0, qf[ks], s0, 0, 0, 0);
          s1 = __builtin_amdgcn_mfma_f32_32x32x16_bf16(a1, qf[ks], s1, 0, 0, 0);
        }
#pragma unroll
        for (int i = 0; i < 16; ++i) { s0[i] *= 0.125f; s1[i] *= 0.125f; }
      }
      float mx = s0[0];
#pragma unroll
      for (int i = 1; i < 16; ++i) mx = fmaxf(mx, s0[i]);
#pragma unroll
      for (int i = 0; i < 16; ++i) mx = fmaxf(mx, s1[i]);
      { const u32x2 sw = __builtin_amdgcn_permlane32_swap(__float_as_uint(mx), __float_as_uint(mx), false, false); mx = fmaxf(__uint_as_float(sw.x), __uint_as_float(sw.y)); }
      const float m_new = fmaxf(m_run, mx);
      const float alpha = __builtin_amdgcn_exp2f((m_run - m_new) * LOG2E);
      m_run = m_new;
      const float mc = -m_new * LOG2E;
      float ps = 0.f;
#pragma unroll
      for (int i = 0; i < 16; ++i) { const float p = s0[i] > -1e29f ? __builtin_amdgcn_exp2f(fmaf(s0[i], LOG2E, mc)) : 0.f; s0[i] = p; ps += p; }
#pragma unroll
      for (int i = 0; i < 16; ++i) { const float p = s1[i] > -1e29f ? __builtin_amdgcn_exp2f(fmaf(s1[i], LOG2E, mc)) : 0.f; s1[i] = p; ps += p; }
      l_run = l_run * alpha + ps;
      if (__any(alpha < 1.0f)) {
#pragma unroll
        for (int vb = 0; vb < 2; ++vb)
#pragma unroll
          for (int i = 0; i < 16; ++i) o[vb][i] *= alpha;
      }
      bf16x8 pf[2][2];
#pragma unroll
      for (int s = 0; s < 2; ++s) {
        u32x4 w0, w1;
        w0.x = cvt_pk_bf16(s0[8 * s + 0], s0[8 * s + 1]); w0.y = cvt_pk_bf16(s0[8 * s + 2], s0[8 * s + 3]); w0.z = cvt_pk_bf16(s0[8 * s + 4], s0[8 * s + 5]); w0.w = cvt_pk_bf16(s0[8 * s + 6], s0[8 * s + 7]);
        w1.x = cvt_pk_bf16(s1[8 * s + 0], s1[8 * s + 1]); w1.y = cvt_pk_bf16(s1[8 * s + 2], s1[8 * s + 3]); w1.z = cvt_pk_bf16(s1[8 * s + 4], s1[8 * s + 5]); w1.w = cvt_pk_bf16(s1[8 * s + 6], s1[8 * s + 7]);
        pf[0][s] = __builtin_bit_cast(bf16x8, w0); pf[1][s] = __builtin_bit_cast(bf16x8, w1);
      }
      const int cbase = local ? (span0 >> 3) : 0;
#pragma unroll
      for (int vb = 0; vb < 2; ++vb) {
        const LAS unsigned char* vrow = vb_ + (vb * 32 + r) * 128;
#pragma unroll
        for (int s = 0; s < 2; ++s) {
          const bf16x8 a = *(const LAS bf16x8*)(vrow + (((cbase + 2 * s + hi) ^ vx) << 4));
          o[vb] = __builtin_amdgcn_mfma_f32_32x32x16_bf16(a, pf[0][s], o[vb], 0, 0, 0);
        }
        if (!local) {
#pragma unroll
          for (int s = 0; s < 2; ++s) {
            const bf16x8 a = *(const LAS bf16x8*)(vrow + (((4 + 2 * s + hi) ^ vx) << 4));
            o[vb] = __builtin_amdgcn_mfma_f32_32x32x16_bf16(a, pf[1][s], o[vb], 0, 0, 0);
          }
        }
      }
    }
    if (more) NA_WRITE((t + 1) & 1);
    __syncthreads();
  }
#undef NA_LOAD
#undef NA_WRITE
  float l_tot; { const u32x2 sw = __builtin_amdgcn_permlane32_swap(__float_as_uint(l_run), __float_as_uint(l_run), false, false); l_tot = __uint_as_float(sw.x) + __uint_as_float(sw.y); }
  const float inv = 1.0f / l_tot;
  bf16_t* op = O + (size_t)qtok * 1024 + h * 64 + 4 * hi;
#pragma unroll
  for (int vb = 0; vb < 2; ++vb)
#pragma unroll
    for (int g = 0; g < 4; ++g) {
      u32x2 w; w.x = cvt_pk_bf16(o[vb][4 * g] * inv, o[vb][4 * g + 1] * inv); w.y = cvt_pk_bf16(o[vb][4 * g + 2] * inv, o[vb][4 * g + 3] * inv);
      *(u32x2*)(op + vb * 32 + 8 * g) = w;
    }
}
}

namespace rw {
using namespace mk;
constexpr int NSTEP = L + T, NCH = 32, CL = NSTEP / NCH;
constexpr int NCHAIN = 2 * B * 8;
constexpr float LOG2E = 1.4426950408889634f;
struct Bufs {
  u32x2* SH;
  unsigned* DR;
  bf16_t* G; int gstride;
  float* CS;
  float* PQ;
  float* SST;
  bf16_t* Y;
  bf16_t* Z;
};

constexpr int XPITCH = 528;
__device__ __forceinline__ void lora_mfma(const LAS unsigned char* xb, int xcol0, const bf16_t* __restrict__ W, int K, int h, int lane, LAS float* tw, float (&out)[16]) {
  const int fr = lane & 15, fq = lane >> 4;
  f32x4 acc[4];
#pragma unroll
  for (int nb = 0; nb < 4; ++nb) { float z = 0.f; asm volatile("" : "+v"(z)); acc[nb] = (f32x4){z, z, z, z}; }
  for (int ks = 0; ks < K / 32; ++ks) {
    const bf16x8 xf = *(const LAS bf16x8*)(xb + fr * XPITCH + (xcol0 + ks * 32 + fq * 8) * 2);
    bf16x8 wf[4];
#pragma unroll
    for (int nb = 0; nb < 4; ++nb) wf[nb] = *(const bf16x8*)(W + (size_t)(h * 64 + nb * 16 + fr) * K + ks * 32 + fq * 8);
#pragma unroll
    for (int nb = 0; nb < 4; ++nb) acc[nb] = __builtin_amdgcn_mfma_f32_16x16x32_bf16(xf, wf[nb], acc[nb], 0, 0, 0);
  }
#pragma unroll
  for (int nb = 0; nb < 4; ++nb) *(LAS f32x4*)(tw + (nb * 16 + fr) * 16 + fq * 4) = acc[nb];
  __builtin_amdgcn_wave_barrier(); asm volatile("s_waitcnt lgkmcnt(0)" ::: "memory"); __builtin_amdgcn_wave_barrier();
#pragma unroll
  for (int q = 0; q < 4; ++q) { const f32x4 v = *(const LAS f32x4*)(tw + lane * 16 + q * 4); out[q * 4] = v[0]; out[q * 4 + 1] = v[1]; out[q * 4 + 2] = v[2]; out[q * 4 + 3] = v[3]; }
  __builtin_amdgcn_wave_barrier(); asm volatile("s_waitcnt lgkmcnt(0)" ::: "memory"); __builtin_amdgcn_wave_barrier();
}
__device__ __forceinline__ void prep_tile(const bf16_t* __restrict__ Prw, const float* __restrict__ cw, const float* __restrict__ w0, const bf16_t* __restrict__ WLT, const float* __restrict__ a0,
                                          const float* __restrict__ k_k, const float* __restrict__ k_a, const float* __restrict__ r_k,
                                          const Bufs& bf, int tile, LAS float* xs  ) {
  const int c = mk::otid(), lane = c & 63, h = c >> 6;
  const int row0 = tile * 16;
  int lo, hi;
  if (row0 < NLAT) { lo = (row0 / T) * T; hi = lo + T - 1; } else { lo = NLAT + ((row0 - NLAT) / L) * L; hi = lo + L - 1; }
#define RW_CONV(dst, col) do { const float c0 = cw[(col)], c1 = cw[RW_IN + (col)], c2 = cw[2 * RW_IN + (col)]; const bf16_t* p = Prw + (col); \
    bf16_t raw[18]; \
    _Pragma("unroll") for (int j = 0; j < 18; ++j) { int rr = row0 - 1 + j; rr = rr < lo ? lo : (rr > hi ? hi : rr); raw[j] = p[(size_t)rr * RW_IN]; } \
    float pm = row0 > lo ? bf2f(raw[0]) : 0.f, pc = bf2f(raw[1]); \
    _Pragma("unroll") for (int tt = 0; tt < 16; ++tt) { const float pn = (row0 + tt + 1 <= hi) ? bf2f(raw[tt + 2]) : 0.f; dst[tt] = pm * c0 + pc * c1 + pn * c2; pm = pc; pc = pn; } } while (0)
  if (c < 256) {
    float xv[16]; RW_CONV(xv, 1536 + c);
#pragma unroll
    for (int tt = 0; tt < 16; ++tt) { float v = xv[tt]; if (c < 64) v = tanhf(v); else if (c >= 128) v = sigmoidf_(v); *(LAS bf16_t*)((LAS unsigned char*)xs + tt * XPITCH + c * 2) = f2bf(v); }
  }
  __syncthreads();
  const LAS unsigned char* xb = (const LAS unsigned char*)xs; LAS float* tw = xs + 20480 + h * 1024;
  const float w00 = w0[c], w01 = w0[512 + c], a00 = a0[c], a01 = a0[512 + c], kkc = k_k[c], kac = k_a[c], rkc = r_k[c];
  float e0[16], e1[16];
  {
    float aw0[16], aw1[16];
    lora_mfma(xb, 0, WLT, 64, h, lane, tw, aw0); lora_mfma(xb, 0, WLT + 32768, 64, h, lane, tw, aw1);
#pragma unroll
    for (int tt = 0; tt < 16; ++tt) {
      { const float z = -(w00 + aw0[tt]); const float sp = fmaxf(z, 0.f) + __logf(1.0f + __expf(-fabsf(z))); e0[tt] = __expf(-sp - 0.5f); }
      { const float z = -(w01 + aw1[tt]); const float sp = fmaxf(z, 0.f) + __logf(1.0f + __expf(-fabsf(z))); e1[tt] = __expf(-sp - 0.5f); }
    }
  }
  LAS float* asl = xs + 256 * 16;
  {
    float aa0[16], aa1[16];
    lora_mfma(xb, 64, WLT + 2 * 32768, 64, h, lane, tw, aa0); lora_mfma(xb, 64, WLT + 3 * 32768, 64, h, lane, tw, aa1);
#pragma unroll
    for (int tt = 0; tt < 16; ++tt) { const unsigned d0 = cvt_pk_bf16(e0[tt], sigmoidf_(a00 + aa0[tt])), d1 = cvt_pk_bf16(e1[tt], sigmoidf_(a01 + aa1[tt]));
      bf.DR[((size_t)(row0 + tt)) * 512 + c] = d0; bf.DR[((size_t)NTOK + row0 + tt) * 512 + c] = d1; asl[tt * 512 + c] = bfhi(d0); asl[(16 + tt) * 512 + c] = bfhi(d1); }
  }
  {
    float ag[16];
    lora_mfma(xb, 128, WLT + 4 * 32768, 128, h, lane, tw, ag);
#pragma unroll
    for (int tt = 0; tt < 16; ++tt) bf.G[(size_t)(row0 + tt) * bf.gstride + c] = f2bf(ag[tt]);
  }
#undef RW_CONV
  const float cr0 = cw[c], cr1 = cw[RW_IN + c], cr2 = cw[2 * RW_IN + c], ck0 = cw[512 + c], ck1 = cw[RW_IN + 512 + c], ck2 = cw[2 * RW_IN + 512 + c], cv0 = cw[1024 + c], cv1 = cw[RW_IN + 1024 + c], cv2 = cw[2 * RW_IN + 1024 + c];
  const bf16_t* pr = Prw + (size_t)row0 * RW_IN + c;
  const bf16_t* prm = Prw + (size_t)(row0 > lo ? row0 - 1 : row0) * RW_IN + c;
  const bf16_t rm_ = prm[0], km_ = prm[512], vm_ = prm[1024];
  float rm = row0 > lo ? bf2f(rm_) : 0.f, km = row0 > lo ? bf2f(km_) : 0.f, vm = row0 > lo ? bf2f(vm_) : 0.f;
  float rc = bf2f(pr[0]), kc = bf2f(pr[512]), vc = bf2f(pr[1024]);
#pragma unroll 2
  for (int tt = 0; tt < 16; ++tt) {
    const int row = row0 + tt;
    const bool has_n = row + 1 <= hi; const bf16_t* pn = pr + (size_t)(has_n ? tt + 1 : tt) * RW_IN;
    const bf16_t rn_ = pn[0], kn_ = pn[512], vn_ = pn[1024];
    const float rn = has_n ? bf2f(rn_) : 0.f, kn = has_n ? bf2f(kn_) : 0.f, vn = has_n ? bf2f(vn_) : 0.f;
    const float rv = rm * cr0 + rc * cr1 + rn * cr2, kvv = km * ck0 + kc * ck1 + kn * ck2, vvv = vm * cv0 + vc * cv1 + vn * cv2;
    rm = rc; rc = rn; km = kc; kc = kn; vm = vc; vc = vn;
    float kk = kvv * kkc; const float nrm = sqrtf(wave_sum_u(kk * kk)); kk = kk * __builtin_amdgcn_rcpf(fmaxf(nrm, 1e-12f));
    u32x2 sh; sh.x = cvt_pk_bf16(rv, kvv); sh.y = cvt_pk_bf16(kk, vvv);
    bf.SH[(size_t)row * 512 + c] = sh;
    const float rq = bflo(sh.x), kq = bfhi(sh.x);
    const float cb0 = wave_sum_u(rq * kq * (1.0f + (asl[tt * 512 + c] - 1.0f) * kac) * rkc), cb1 = wave_sum_u(rq * kq * (1.0f + (asl[(16 + tt) * 512 + c] - 1.0f) * kac) * rkc);
    if (lane == 0) { bf.CS[(size_t)row * 16 + h] = cb0; bf.CS[(size_t)row * 16 + 8 + h] = cb1; }
  }
  __syncthreads();
}

struct StepRaw { u32x2 s; unsigned d; };
__device__ __forceinline__ int scan_row(int dir, int b, int p) {
  if (p < L) return NLAT + b * L + (dir ? (L - 1 - p) : p);
  const int q = p - L; return b * T + (dir ? (T - 1 - q) : q);
}
#define RW_RL(x, j) __int_as_float(__builtin_amdgcn_readlane(__float_as_int(x), (j)))
__device__ __forceinline__ void scan_unit(const Bufs& bf, const float* __restrict__ k_a, int chain, int chunk, LAS float* wl  ) {
  const int lane = mk::otid() & 63;
  const int dir = chain >> 5, b = (chain >> 3) & 3, h = chain & 7, ch = h * 64 + lane;
  const float kac = k_a[ch];
  float S[64], P[64];
#pragma unroll
  for (int j = 0; j < 64; ++j) { S[j] = 0.f; P[j] = (j == lane) ? 1.f : 0.f; }
  const int p0 = chunk * CL;
  StepRaw nx; { const int row = scan_row(dir, b, p0); nx.s = bf.SH[(size_t)row * 512 + ch]; nx.d = bf.DR[((size_t)dir * NTOK + row) * 512 + ch]; }
  for (int s = 0; s < CL; ++s) {
    const StepRaw cu = nx; const int row = scan_row(dir, b, p0 + s);
    if (s + 1 < CL) { const int rn = scan_row(dir, b, p0 + s + 1); nx.s = bf.SH[(size_t)rn * 512 + ch]; nx.d = bf.DR[((size_t)dir * NTOK + rn) * 512 + ch]; }
    const float r = bflo(cu.s.x), k = bfhi(cu.s.x), kk = bflo(cu.s.y), v = bfhi(cu.s.y), e = bflo(cu.d), asg = bfhi(cu.d);
    const float w = __builtin_amdgcn_exp2f(-e * LOG2E), a = -kk, bb = kk * asg, keff = k * (1.0f + (asg - 1.0f) * kac);
    wl[lane] = a; wl[64 + lane] = w; wl[128 + lane] = bb; wl[192 + lane] = keff; wl[256 + lane] = r;
    float sa = 0.f, sap = 0.f;
#pragma unroll
    for (int j4 = 0; j4 < 16; ++j4) { const f32x4 av = *(const LAS f32x4*)(wl + 4 * j4);
#pragma unroll
      for (int e2 = 0; e2 < 4; ++e2) { sa = fmaf(S[4 * j4 + e2], av[e2], sa); sap = fmaf(P[4 * j4 + e2], av[e2], sap); } }
    float y = 0.f, z = 0.f;
#pragma unroll
    for (int j4 = 0; j4 < 16; ++j4) {
      const f32x4 wv = *(const LAS f32x4*)(wl + 64 + 4 * j4), bv = *(const LAS f32x4*)(wl + 128 + 4 * j4), kv = *(const LAS f32x4*)(wl + 192 + 4 * j4), rv = *(const LAS f32x4*)(wl + 256 + 4 * j4);
#pragma unroll
      for (int e2 = 0; e2 < 4; ++e2) { const int j = 4 * j4 + e2;
        float t = v * kv[e2]; t = fmaf(sa, bv[e2], t); S[j] = fmaf(S[j], wv[e2], t);
        P[j] = fmaf(P[j], wv[e2], sap * bv[e2]);
        y = fmaf(S[j], rv[e2], y); z = fmaf(P[j], rv[e2], z); }
    }
    const size_t oi = ((size_t)dir * NTOK + row) * 512 + ch;
    bf.Y[oi] = f2bf(y); bf.Z[oi] = f2bf(z);
  }
  if (chunk < NCH - 1) {
    float* pq = bf.PQ + (((size_t)chain * (NCH - 1) + chunk) * 2) * 4096 + lane * 64;
#pragma unroll
    for (int q = 0; q < 16; ++q) { *(f32x4*)(pq + q * 4) = (f32x4){P[q * 4], P[q * 4 + 1], P[q * 4 + 2], P[q * 4 + 3]}; *(f32x4*)(pq + 4096 + q * 4) = (f32x4){S[q * 4], S[q * 4 + 1], S[q * 4 + 2], S[q * 4 + 3]}; }
  }
}

__device__ __forceinline__ void propagate_chain(const Bufs& bf, int chain, int rq, LAS float* lds) {
  LAS float* Sl = lds; LAS float* Pl = lds + 16 * 65 + 15;
  Pl = lds + 1056;
  const int tid = mk::otid(), i = tid >> 5, jc = (tid & 31) * 2, row = rq * 16 + i, pi = tid >> 3, pj = (tid & 7) * 8;
  float* sst = bf.SST + (size_t)chain * NCH * 4096;
  Sl[i * 65 + jc] = 0.f; Sl[i * 65 + jc + 1] = 0.f;
  const float* pb = bf.PQ + ((size_t)chain * (NCH - 1) * 2) * 4096;
  f32x4 np0 = *(const f32x4*)(pb + pi * 64 + pj), np1 = *(const f32x4*)(pb + pi * 64 + pj + 4); f32x2 nq = *(const f32x2*)(pb + 4096 + row * 64 + jc);
  for (int c = 0; c < NCH - 1; ++c) {
    const f32x4 p0 = np0, p1 = np1; f32x2 q = nq;
    { const float* pn = pb + (size_t)(c + 1 < NCH - 1 ? c + 1 : c) * 2 * 4096;
      np0 = *(const f32x4*)(pn + pi * 64 + pj); np1 = *(const f32x4*)(pn + pi * 64 + pj + 4); nq = *(const f32x2*)(pn + 4096 + row * 64 + jc); }
    *(LAS f32x4*)(Pl + pi * 64 + pj) = p0; *(LAS f32x4*)(Pl + pi * 64 + pj + 4) = p1;
    __syncthreads();
#pragma unroll 16
    for (int k = 0; k < 64; ++k) { const float sv = Sl[i * 65 + k]; const f32x2 a = *(const LAS f32x2*)(Pl + k * 64 + jc); q += sv * a; }
    __syncthreads();
    Sl[i * 65 + jc] = q[0]; Sl[i * 65 + jc + 1] = q[1];
    *(f32x2*)(sst + (size_t)(c + 1) * 4096 + row * 64 + jc) = q;
  }
  __syncthreads();
}

__device__ __forceinline__ void corr_unit(const Bufs& bf, int chain, int chunk) {
  const int lane = mk::otid() & 63, r = lane & 31, hi = lane >> 5;
  const int dir = chain >> 5, b = (chain >> 3) & 3, h = chain & 7;
  const float* ss = bf.SST + ((size_t)chain * NCH + chunk) * 4096;
  bf16x8 bfr[2][4];
#pragma unroll
  for (int nt = 0; nt < 2; ++nt)
#pragma unroll
    for (int ks = 0; ks < 4; ++ks) { const float* q = ss + (size_t)(nt * 32 + r) * 64 + ks * 16 + hi * 8; const f32x4 x0 = *(const f32x4*)q, x1 = *(const f32x4*)(q + 4);
      u32x4 w; w.x = cvt_pk_bf16(x0[0], x0[1]); w.y = cvt_pk_bf16(x0[2], x0[3]); w.z = cvt_pk_bf16(x1[0], x1[1]); w.w = cvt_pk_bf16(x1[2], x1[3]); bfr[nt][ks] = __builtin_bit_cast(bf16x8, w); }
  const int p0 = chunk * CL;
  const size_t dbase = (size_t)dir * NTOK;
  for (int mt = 0; mt < (CL + 31) / 32; ++mt) {
    const int sa_ = min(mt * 32 + r, CL - 1);
    const bf16_t* zp = bf.Z + (dbase + scan_row(dir, b, p0 + sa_)) * 512 + h * 64 + hi * 8;
    bf16x8 af[4];
#pragma unroll
    for (int ks = 0; ks < 4; ++ks) af[ks] = *(const bf16x8*)(zp + ks * 16);
    f32x16 acc[2];
#pragma unroll
    for (int nt = 0; nt < 2; ++nt) { acc[nt] = zero16();
#pragma unroll
      for (int ks = 0; ks < 4; ++ks) acc[nt] = __builtin_amdgcn_mfma_f32_32x32x16_bf16(af[ks], bfr[nt][ks], acc[nt], 0, 0, 0); }
#pragma unroll
    for (int i = 0; i < 16; ++i) { const int so = mt * 32 + (i & 3) + 8 * (i >> 2) + 4 * hi;
      if (so < CL) { bf16_t* yp = bf.Y + (dbase + scan_row(dir, b, p0 + so)) * 512 + h * 64 + r;
        yp[0] = f2bf(bf2f(yp[0]) + acc[0][i]); yp[32] = f2bf(bf2f(yp[32]) + acc[1][i]); } }
  }
}

template <int NR>
__device__ __forceinline__ void finish_rows(const Bufs& bf, const float* __restrict__ gn_g, const float* __restrict__ gn_b, bf16_t* __restrict__ O, int row0) {
  const int c = mk::otid(), h = c >> 6;
  float y[NR], v[NR], g[NR], cs[NR];
#pragma unroll
  for (int i = 0; i < NR; ++i) { const int row = row0 + i;
    y[i] = bf2f(bf.Y[(size_t)row * 512 + c]) + bf2f(bf.Y[((size_t)NTOK + row) * 512 + c]);
    v[i] = bfhi(bf.SH[(size_t)row * 512 + c].y); g[i] = bf2f(bf.G[(size_t)row * bf.gstride + c]);
    cs[i] = bf.CS[(size_t)row * 16 + h] + bf.CS[(size_t)row * 16 + 8 + h]; }
  const float gg = gn_g[c], gb = gn_b[c];
  float o[NR];
#pragma unroll
  for (int i = 0; i < NR; ++i) { const float mu = wave_sum_u(y[i]) * (1.0f / 64.0f); const float dv = y[i] - mu; const float var = wave_sum_u(dv * dv) * (1.0f / 64.0f);
    o[i] = (dv * rsqrtf(var + 64e-5f) * gg + gb + cs[i] * v[i]) * g[i]; }
#pragma unroll
  for (int i = 0; i < NR; ++i) O[(size_t)(row0 + i) * 1024 + 512 + c] = f2bf(o[i]);
}
}

namespace mk {
constexpr size_t al256(size_t x) { return (x + 255) / 256 * 256; }
constexpr size_t WS_BAR = 0;
constexpr size_t WS_BCNT = al256(WS_BAR + (size_t)XCD_BAR_WORDS * 4);
constexpr size_t WS_MOFF = al256(WS_BCNT + (size_t)4 * 256 * 64 * 4);
constexpr size_t WS_KN = al256(WS_MOFF + 4 * 256);
constexpr size_t WS_MOD = al256(WS_KN + (size_t)2 * 256 * 16 * 4);
constexpr size_t WS_ROPE = al256(WS_MOD + (size_t)4 * 5 * 6144 * 4);
constexpr size_t WS_HBC = al256(WS_ROPE + 128 * 16 * 2 * 4);
constexpr size_t WS_EID = al256(WS_HBC + (size_t)NCTX * D * 2);
constexpr size_t WS_GATE = al256(WS_EID + (size_t)NTOK * 2 * 4);
constexpr size_t WS_POS = al256(WS_GATE + (size_t)NTOK * 2 * 4);
constexpr size_t WS_RL = al256(WS_POS + (size_t)NTOK * 2 * 4);
constexpr size_t WS_WEIN = al256(WS_RL + (size_t)MOE_ROWS * 4);
constexpr size_t WS_WOIN = al256(WS_WEIN + (size_t)2 * EVEN_IN * D * 2);
constexpr size_t WS_WEOUT = al256(WS_WOIN + (size_t)2 * ODD_IN * D * 2);
constexpr size_t WS_WOOUT = al256(WS_WEOUT + (size_t)2 * D * D * 2);
constexpr size_t WS_WGU = al256(WS_WOOUT + (size_t)2 * D * D * 2);
constexpr size_t WS_WDN = al256(WS_WGU + (size_t)NE * 1024 * D * 2);
constexpr size_t WS_WLT = al256(WS_WDN + (size_t)NE * D * DE * 2);
constexpr size_t WS_UO = al256(WS_WLT + (size_t)2 * 196608 * 2);
constexpr size_t WS_SCR = al256(WS_UO + (size_t)NTOK * D * 2);
constexpr size_t SE_PQK = 0;
constexpr size_t SE_VT = al256(SE_PQK + (size_t)NTOK * 1024 * 2);
constexpr size_t SE_PRW = al256(SE_VT + (size_t)512 * NTOK * 2);
constexpr size_t SE_PQ = 0;
constexpr size_t SE_SST = al256(SE_PQ + (size_t)rw::NCHAIN * (rw::NCH - 1) * 2 * 4096 * 4);
constexpr size_t SE_Y = al256(SE_SST + (size_t)rw::NCHAIN * rw::NCH * 4096 * 4);
constexpr size_t SE_Z = al256(SE_Y + (size_t)2 * NTOK * 512 * 2);
constexpr size_t SE_ZEND = al256(SE_Z + (size_t)2 * NTOK * 512 * 2);
constexpr size_t SE_PRWEND = al256(SE_PRW + (size_t)NTOK * RW_IN * 2);
constexpr size_t SE_SH = SE_PRWEND > SE_ZEND ? SE_PRWEND : SE_ZEND;
constexpr size_t SE_DR = al256(SE_SH + (size_t)NTOK * 512 * 8);
constexpr size_t SE_CS = al256(SE_DR + (size_t)2 * NTOK * 512 * 4);
constexpr size_t SE_END = al256(SE_CS + (size_t)2 * NTOK * 16 * 4);
constexpr size_t SE_YBUF = 0;
constexpr size_t SO_PQK = 0;
constexpr size_t SO_VT = al256(SO_PQK + (size_t)NTOK * 2048 * 2);
constexpr size_t SO_O12 = al256(SO_VT + (size_t)1024 * NTOK * 2);
constexpr size_t SO_END = al256(SO_O12 + (size_t)NTOK * 2048 * 2);
constexpr size_t SO_YBUF = 0;
constexpr size_t SM_XS = 0;
constexpr size_t SM_HE = al256(SM_XS + (size_t)MOE_ROWS * D * 2);
constexpr size_t SM_YS = al256(SM_HE + (size_t)MOE_ROWS * DE * 2);
constexpr size_t SM_END = al256(SM_YS + (size_t)MOE_ROWS * D * 2);
constexpr size_t SCR_BYTES = SE_END > SO_END ? (SE_END > SM_END ? SE_END : SM_END) : (SO_END > SM_END ? SO_END : SM_END);
constexpr size_t WS_END = WS_SCR + SCR_BYTES;
constexpr int LDS_BARW = 131072;
constexpr int LDS_MISC = 131072 + 64;

struct Params {
  const float *x, *c, *ctx, *c_ctx, *ada_w, *ada_b, *ln_g, *ln_b, *even_w_in, *even_w_out, *shift_w, *na_rpb, *rw_w0, *rw_w_up, *rw_a0, *rw_a_up, *rw_g_up, *rw_k_k, *rw_k_a, *rw_r_k,
      *rw_gn_g, *rw_gn_b, *odd_w_in, *odd_w_out, *da_lq1, *da_lk1, *da_lq2, *da_lk2, *da_subln_g, *router_w, *router_b, *exp_w_gate, *exp_w_up, *exp_w_down;
  float* out; unsigned char* ws; int ph_lo, ph_hi;
};
template <class Tp> __device__ __forceinline__ Tp* wsp(const Params& p, size_t off) { return (Tp*)(p.ws + off); }

__device__ __forceinline__ void ada_unit(const Params& p, int u, LAS float* lds) {
  LAS float* sc = lds; LAS float* red = lds + 5 * 1024;
  const int tid = mk::otid(), l = u / 96, n = (u % 96) * 64 + (tid & 63), kp = tid >> 6;
  for (int i = tid; i < 5 * 1024; i += NTHR) { const float v = i < 4096 ? p.c[i] : p.c_ctx[i - 4096]; sc[i] = siluf_(v); }
  __syncthreads();
  float a[5] = {0.f, 0.f, 0.f, 0.f, 0.f};
  const float* w = p.ada_w + ((size_t)l * D + kp * 128) * 6144 + n;
#pragma unroll 4
  for (int k = 0; k < 128; ++k) { const float wv = w[(size_t)k * 6144]; const int kk = kp * 128 + k;
#pragma unroll
    for (int r = 0; r < 5; ++r) a[r] = fmaf(sc[r * 1024 + kk], wv, a[r]); }
#pragma unroll
  for (int r = 0; r < 5; ++r) red[(kp * 5 + r) * 64 + (tid & 63)] = a[r];
  __syncthreads();
  if (tid < 320) { const int r = tid >> 6, nn = tid & 63; float s = 0.f;
#pragma unroll
    for (int q = 0; q < 8; ++q) s += red[(q * 5 + r) * 64 + nn];
    const int col = (u % 96) * 64 + nn;
    wsp<float>(p, WS_MOD)[((size_t)l * 5 + r) * 6144 + col] = s + p.ada_b[l * 6144 + col]; }
  __syncthreads();
}
__device__ __forceinline__ void phase_prologue(const Params& p, LAS unsigned char* lds) {
  const int bid = mk::obid(), nb = gridDim.x; LAS float* tile = (LAS float*)lds;
  int ub = 0;
  for (int i = 0; i < 2; ++i) ub += cvt_matrix(p.even_w_in + (size_t)i * D * EVEN_IN, EVEN_IN, D, EVEN_IN, wsp<bf16_t>(p, WS_WEIN) + (size_t)i * EVEN_IN * D, NMapId{0}, tile, ub, bid, nb);
  for (int i = 0; i < 2; ++i) ub += cvt_matrix(p.odd_w_in + (size_t)i * D * ODD_IN, ODD_IN, D, ODD_IN, wsp<bf16_t>(p, WS_WOIN) + (size_t)i * ODD_IN * D, NMapRope{}, tile, ub, bid, nb);
  for (int i = 0; i < 2; ++i) ub += cvt_matrix(p.even_w_out + (size_t)i * D * D, D, D, D, wsp<bf16_t>(p, WS_WEOUT) + (size_t)i * D * D, NMapId{0}, tile, ub, bid, nb);
  for (int i = 0; i < 2; ++i) ub += cvt_matrix(p.odd_w_out + (size_t)i * D * D, D, D, D, wsp<bf16_t>(p, WS_WOOUT) + (size_t)i * D * D, NMapId{0}, tile, ub, bid, nb);
  for (int i = 0; i < 2; ++i) { bf16_t* wl = wsp<bf16_t>(p, WS_WLT) + (size_t)i * 196608;
    for (int d = 0; d < 2; ++d) { ub += cvt_matrix(p.rw_w_up + (size_t)(i * 2 + d) * 64 * 512, 512, 64, 512, wl + (size_t)d * 32768, NMapId{0}, tile, ub, bid, nb);
      ub += cvt_matrix(p.rw_a_up + (size_t)(i * 2 + d) * 64 * 512, 512, 64, 512, wl + (size_t)(2 + d) * 32768, NMapId{0}, tile, ub, bid, nb); }
    ub += cvt_matrix(p.rw_g_up + (size_t)i * 128 * 512, 512, 128, 512, wl + (size_t)4 * 32768, NMapId{0}, tile, ub, bid, nb); }
  for (int u = (bid + nb - ub % nb) % nb; u < 384; u += nb) ada_unit(p, u, (LAS float*)lds);
  const int gt = bid * NTHR + mk::otid();
  if (gt < 128 * 16) { const int pos = gt >> 4, i = gt & 15; const float inv = exp2f(-(float)i * (13.287712379549449f / 16.0f)); float sn, cs; sincosf((float)pos * inv, &sn, &cs);
    wsp<float>(p, WS_ROPE)[gt * 2] = cs; wsp<float>(p, WS_ROPE)[gt * 2 + 1] = sn; }
}
__device__ __forceinline__ void cvt_experts(const Params& p, int l, LAS float* tile, int b0) {
  const int bid = mk::obid() - b0, nb = (int)gridDim.x - b0; int ub = 0;
  if (bid < 0) return;
  for (int e = 0; e < NE; ++e) {
    const size_t so = ((size_t)l * NE + e) * D * DE;
    ub += cvt_matrix(p.exp_w_gate + so, DE, D, DE, wsp<bf16_t>(p, WS_WGU) + (size_t)e * 1024 * D, NMapInterleave{0}, tile, ub, bid, nb);
    ub += cvt_matrix(p.exp_w_up + so, DE, D, DE, wsp<bf16_t>(p, WS_WGU) + (size_t)e * 1024 * D, NMapInterleave{1}, tile, ub, bid, nb);
    ub += cvt_matrix(p.exp_w_down + so, D, DE, D, wsp<bf16_t>(p, WS_WDN) + (size_t)e * D * DE, NMapId{0}, tile, ub, bid, nb);
  }
}

__device__ __forceinline__ bf16_t* hb_ptr(const Params& p, int row, bool alt) {
  if (alt) return wsp<bf16_t>(p, WS_SCR + SM_END) + (size_t)row * D;
  return row < NLAT ? (bf16_t*)p.out + (size_t)row * D : wsp<bf16_t>(p, WS_HBC) + (size_t)(row - NLAT) * D;
}
__device__ __forceinline__ const float* h0_ptr(const Params& p, int row) { return row < NLAT ? p.x + (size_t)row * D : p.ctx + (size_t)(row - NLAT) * D; }
__device__ __forceinline__ void store_bf16x4(bf16_t* dst, f32x4 v) { u32x2 w; w.x = cvt_pk_bf16(v[0], v[1]); w.y = cvt_pk_bf16(v[2], v[3]); *(u32x2*)dst = w; }
__device__ __forceinline__ f32x4 load_bf16x4(const bf16_t* src) { const u32x2 w = *(const u32x2*)src; return (f32x4){bflo(w.x), bfhi(w.x), bflo(w.y), bfhi(w.y)}; }

__device__ __forceinline__ void phase_mod0(const Params& p) {
  const int lane = mk::otid() & 63, wid = mk::otid() >> 6;
  bf16_t* U = wsp<bf16_t>(p, WS_UO);
  for (int row = mk::obid() * 8 + wid; row < NTOK; row += gridDim.x * 8) {
    const float* h = h0_ptr(p, row); const float* modl = wsp<float>(p, WS_MOD) + (size_t)bidx_of_row(row) * 6144;
#pragma unroll
    for (int q = 0; q < 4; ++q) { const int col = q * 256 + lane * 4; const f32x4 hv = *(const f32x4*)(h + col), sh = *(const f32x4*)(modl + col), sc = *(const f32x4*)(modl + 1024 + col);
      store_bf16x4(U + (size_t)row * D + col, hv * (1.0f + sc) + sh); }
  }
}
__device__ __forceinline__ void ln_row(f32x4 (&v)[4], const float* __restrict__ g, const float* __restrict__ b, int lane) {
  float s = 0.f;
#pragma unroll
  for (int q = 0; q < 4; ++q) s += (v[q][0] + v[q][1]) + (v[q][2] + v[q][3]);
  const float mu = wave_sum_u(s) * (1.0f / D);
  float qq = 0.f;
#pragma unroll
  for (int q = 0; q < 4; ++q) { const f32x4 d = v[q] - mu; qq += (d[0] * d[0] + d[1] * d[1]) + (d[2] * d[2] + d[3] * d[3]); }
  const float rstd = rsqrtf(wave_sum_u(qq) * (1.0f / D) + LN_EPS);
#pragma unroll
  for (int q = 0; q < 4; ++q) { const int col = q * 256 + lane * 4; v[q] = (v[q] - mu) * rstd * *(const f32x4*)(g + col) + *(const f32x4*)(b + col); }
}
template <bool F32IN> struct Ln1Raw;
template <> struct Ln1Raw<true> { f32x4 h[4]; u32x2 y[4]; };
template <> struct Ln1Raw<false> { u32x2 h[4]; u32x2 y[4]; };
__device__ __forceinline__ f32x4 h_as_f32(f32x4 v) { return v; }
__device__ __forceinline__ f32x4 h_as_f32(u32x2 w) { return (f32x4){bflo(w.x), bfhi(w.x), bflo(w.y), bfhi(w.y)}; }
template <bool F32IN>
__device__ __forceinline__ void ln1_load(const Params& p, const bf16_t* __restrict__ Ybuf, int row, int lane, Ln1Raw<F32IN>& r) {
#pragma unroll
  for (int q = 0; q < 4; ++q) { const int col = q * 256 + lane * 4;
    if constexpr (F32IN) r.h[q] = *(const f32x4*)(h0_ptr(p, row) + col); else r.h[q] = *(const u32x2*)(hb_ptr(p, row, false) + col);
    r.y[q] = *(const u32x2*)(Ybuf + (size_t)row * D + col); }
}
template <bool F32IN>
__device__ __forceinline__ void ln1_row(const Params& p, int l, int row, int lane, const Ln1Raw<F32IN>& raw, const LAS float* rwl, LAS int* lcnt, bool redir) {
  bf16_t* U2 = wsp<bf16_t>(p, WS_UO); int* eid = wsp<int>(p, WS_EID); float* gatev = wsp<float>(p, WS_GATE);
  const float* lg = p.ln_g + (size_t)(l * 2) * D; const float* lb = p.ln_b + (size_t)(l * 2) * D;
  bf16_t* ho = redir ? wsp<bf16_t>(p, WS_SCR + SM_YS) + (size_t)row * D : hb_ptr(p, row, l == DEPTH - 1); const float* modl = wsp<float>(p, WS_MOD) + ((size_t)l * 5 + bidx_of_row(row)) * 6144;
  f32x4 v[4];
#pragma unroll
  for (int q = 0; q < 4; ++q) { const int col = q * 256 + lane * 4; const f32x4 yv = (f32x4){bflo(raw.y[q].x), bfhi(raw.y[q].x), bflo(raw.y[q].y), bfhi(raw.y[q].y)};
    v[q] = ALPHA * h_as_f32(raw.h[q]) + *(const f32x4*)(modl + 2 * 1024 + col) * yv; }
  ln_row(v, lg, lb, lane);
  float acc[16];
#pragma unroll
  for (int e = 0; e < 16; ++e) acc[e] = 0.f;
#pragma unroll
  for (int q = 0; q < 4; ++q) { const int col = q * 256 + lane * 4;
    store_bf16x4(ho + col, v[q]);
    const f32x4 u = v[q] * (1.0f + *(const f32x4*)(modl + 4 * 1024 + col)) + *(const f32x4*)(modl + 3 * 1024 + col);
    store_bf16x4(U2 + (size_t)row * D + col, u);
#pragma unroll
    for (int e = 0; e < 16; ++e) { const f32x4 w = *(const LAS f32x4*)(rwl + ((q * 16 + e) * 64 + lane) * 4); acc[e] += (u[0] * w[0] + u[1] * w[1]) + (u[2] * w[2] + u[3] * w[3]); }
  }
  float s[16], sel[16];
#pragma unroll
  for (int e = 0; e < 16; ++e) { s[e] = 1.0f / (1.0f + expf(-wave_sum_u(acc[e]))); sel[e] = s[e] + p.router_b[e]; }
  float best = -1e30f; int grp = 0;
#pragma unroll
  for (int gI = 0; gI < 4; ++gI) {
    const float a = sel[gI * 4], b2 = sel[gI * 4 + 1], c = sel[gI * 4 + 2], d = sel[gI * 4 + 3];
    const float lo1 = fminf(a, b2), hi1 = fmaxf(a, b2), lo2 = fminf(c, d), hi2 = fmaxf(c, d);
    const float gs = fmaxf(hi1, hi2) + fmaxf(fminf(hi1, hi2), fmaxf(lo1, lo2));
    if (gs > best) { best = gs; grp = gI; }
  }
  float v0 = 0, v1 = 0, v2 = 0, v3 = 0, s0 = 0, s1 = 0, s2 = 0, s3 = 0;
#pragma unroll
  for (int gI = 0; gI < 4; ++gI) if (gI == grp) { v0 = sel[gI * 4]; v1 = sel[gI * 4 + 1]; v2 = sel[gI * 4 + 2]; v3 = sel[gI * 4 + 3]; s0 = s[gI * 4]; s1 = s[gI * 4 + 1]; s2 = s[gI * 4 + 2]; s3 = s[gI * 4 + 3]; }
  int i1 = 0; float b1 = v0; if (v1 > b1) { b1 = v1; i1 = 1; } if (v2 > b1) { b1 = v2; i1 = 2; } if (v3 > b1) { b1 = v3; i1 = 3; }
  int i2 = -1; float bb = -1e30f;
  if (i1 != 0 && v0 > bb) { bb = v0; i2 = 0; } if (i1 != 1 && v1 > bb) { bb = v1; i2 = 1; } if (i1 != 2 && v2 > bb) { bb = v2; i2 = 2; } if (i1 != 3 && v3 > bb) { bb = v3; i2 = 3; }
  const float g1 = i1 == 0 ? s0 : i1 == 1 ? s1 : i1 == 2 ? s2 : s3; const float g2 = i2 == 0 ? s0 : i2 == 1 ? s1 : i2 == 2 ? s2 : s3;
  if (lane == 0) { const int e1 = grp * 4 + i1, e2 = grp * 4 + i2;
    eid[row * 2] = e1; eid[row * 2 + 1] = e2; gatev[row * 2] = g1 / (g1 + g2); gatev[row * 2 + 1] = g2 / (g1 + g2);
    __hip_atomic_fetch_add(lcnt + e1, 1, __ATOMIC_RELAXED, __HIP_MEMORY_SCOPE_WORKGROUP); __hip_atomic_fetch_add(lcnt + e2, 1, __ATOMIC_RELAXED, __HIP_MEMORY_SCOPE_WORKGROUP); }
}
template <bool F32IN>
__device__ __forceinline__ void phase_ln1(const Params& p, int l, const bf16_t* __restrict__ Ybuf, LAS unsigned char* lds, bool dry) {
  const int tid = mk::otid(), lane = tid & 63, wid = tid >> 6, bid = mk::obid();
  const bool last = l == DEPTH - 1; const int ntok = last ? NLAT : NTOK;
  LAS float* rwl = (LAS float*)lds; LAS int* lcnt = (LAS int*)(lds + 65536);
  { float rv[32];
#pragma unroll
    for (int i = 0; i < 32; ++i) rv[i] = p.router_w[tid + i * NTHR];
#pragma unroll
    for (int i = 0; i < 32; ++i) { const int idx = tid + i * NTHR, d = idx >> 4, e = idx & 15; rwl[(((d >> 8) * 16 + e) * 64 + ((d >> 2) & 63)) * 4 + (d & 3)] = rv[i]; } }
  if (tid < 16) lcnt[tid] = 0;
  __syncthreads();
  const int stride = gridDim.x * 8, row0 = bid * 8 + wid;
  if (row0 < ntok) {
    Ln1Raw<F32IN> cur, nxt; ln1_load<F32IN>(p, Ybuf, row0, lane, cur);
    for (int row = row0; row < ntok; row += stride) {
      const int rn = row + stride < ntok ? row + stride : row;
      ln1_load<F32IN>(p, Ybuf, rn, lane, nxt);
      ln1_row<F32IN>(p, l, row, lane, cur, rwl, lcnt, dry);
      cur = nxt;
    }
  }
  __syncthreads();
  if (tid < 16) wsp<int>(p, WS_BCNT)[((size_t)l * 256 + bid) * 64 + tid] = lcnt[tid];
  __syncthreads();
}
__device__ __forceinline__ void phase_scatter(const Params& p, int l, LAS unsigned char* lds) {
  const int tid = mk::otid(), bid = mk::obid(), nb = gridDim.x;
  const bool last = l == DEPTH - 1; const int ntok = last ? NLAT : NTOK;
  LAS int* tot = (LAS int*)lds; LAS int* pre = tot + 16; LAS int* base = tot + 32; LAS int* lcur = tot + 48; LAS int* offs = tot + 64; LAS int* cnts = tot + 128;
  const int* bc = wsp<int>(p, WS_BCNT) + (size_t)l * 256 * 64;
  for (int b2 = tid; b2 < nb; b2 += NTHR) { const u32x4 c0 = *(const u32x4*)(bc + b2 * 64), c1 = *(const u32x4*)(bc + b2 * 64 + 4), c2 = *(const u32x4*)(bc + b2 * 64 + 8), c3 = *(const u32x4*)(bc + b2 * 64 + 12);
    *(LAS u32x4*)(cnts + b2 * 16) = c0; *(LAS u32x4*)(cnts + b2 * 16 + 4) = c1; *(LAS u32x4*)(cnts + b2 * 16 + 8) = c2; *(LAS u32x4*)(cnts + b2 * 16 + 12) = c3; }
  __syncthreads();
  if (tid < 16) { int t = 0, pr = 0; for (int b2 = 0; b2 < nb; ++b2) { const int v = cnts[b2 * 16 + tid]; pr += b2 < bid ? v : 0; t += v; } tot[tid] = t; pre[tid] = pr; lcur[tid] = 0; }
  __syncthreads();
  if (tid == 0) { int o = 0; int* mo = wsp<int>(p, WS_MOFF) + l * 64; for (int e = 0; e < 16; ++e) { offs[e] = o; base[e] = o + pre[e]; if (bid == 0) mo[e] = o; o += (tot[e] + 255) / 256 * 256; } offs[16] = o; if (bid == 0) mo[16] = o; }
  __syncthreads();
  const int* eid = wsp<int>(p, WS_EID); int* pos = wsp<int>(p, WS_POS); int* rl = wsp<int>(p, WS_RL);
  for (int n = tid; ; n += NTHR) { const int row = bid * 8 + (n & 7) + (n >> 3) * nb * 8; if (row >= ntok) break;
    const int e1 = eid[row * 2], e2 = eid[row * 2 + 1];
    const int p1 = base[e1] + __hip_atomic_fetch_add(lcur + e1, 1, __ATOMIC_RELAXED, __HIP_MEMORY_SCOPE_WORKGROUP), p2 = base[e2] + __hip_atomic_fetch_add(lcur + e2, 1, __ATOMIC_RELAXED, __HIP_MEMORY_SCOPE_WORKGROUP);
    pos[row * 2] = p1; pos[row * 2 + 1] = p2; rl[p1] = row; rl[p2] = row; }
  if (bid == 0) for (int e = 0; e < 16; ++e) for (int q = offs[e] + tot[e] + tid; q < offs[e + 1]; q += NTHR) rl[q] = 0;
}
struct Ln2Raw { u32x2 h[4]; u32x2 y1[4], y2[4]; };
__device__ __forceinline__ void ln2_load(const Params& p, bool last, int row, int lane, int p1, int p2, Ln2Raw& r) {
  const bf16_t* Ys = wsp<bf16_t>(p, WS_SCR + SM_YS); const bf16_t* ho = hb_ptr(p, row, last);
#pragma unroll
  for (int q = 0; q < 4; ++q) { const int col = q * 256 + lane * 4; r.h[q] = *(const u32x2*)(ho + col); r.y1[q] = *(const u32x2*)(Ys + (size_t)p1 * D + col); r.y2[q] = *(const u32x2*)(Ys + (size_t)p2 * D + col); }
}
__device__ __forceinline__ void phase_ln2(const Params& p, int l, bool dry) {
  const int tid = mk::otid(), lane = tid & 63, wid = tid >> 6;
  const bool last = l == DEPTH - 1; const int ntok = last ? NLAT : NTOK;
  const int* pos = wsp<int>(p, WS_POS); const float* gatev = wsp<float>(p, WS_GATE); bf16_t* U = wsp<bf16_t>(p, WS_UO);
  const float* lg = p.ln_g + (size_t)(l * 2 + 1) * D; const float* lb = p.ln_b + (size_t)(l * 2 + 1) * D;
  const int stride = gridDim.x * 8, row0 = mk::obid() * 8 + wid;
  if (row0 >= ntok) return;
  auto clampr = [&](int r) { return r < ntok ? r : row0; };
  u32x2 pc = *(const u32x2*)(pos + 2 * row0); f32x2 gc = *(const f32x2*)(gatev + 2 * row0);
  Ln2Raw cur, nxt; ln2_load(p, last, row0, lane, (int)pc.x, (int)pc.y, cur);
  int r1 = clampr(row0 + stride);
  u32x2 pn = *(const u32x2*)(pos + 2 * r1); f32x2 gn = *(const f32x2*)(gatev + 2 * r1);
  for (int row = row0; row < ntok; row += stride) {
    ln2_load(p, last, r1, lane, (int)pn.x, (int)pn.y, nxt);
    const int r2 = clampr(row + 2 * stride);
    const u32x2 pn2 = *(const u32x2*)(pos + 2 * r2); const f32x2 gn2 = *(const f32x2*)(gatev + 2 * r2);
    bf16_t* hb = dry ? wsp<bf16_t>(p, WS_SCR + SM_XS) + (size_t)row * D : hb_ptr(p, row, false); float* hf = (dry ? wsp<float>(p, WS_SCR + SM_XS) : p.out) + (size_t)row * D; const int bi = bidx_of_row(row);
    const float* modl = wsp<float>(p, WS_MOD) + ((size_t)l * 5 + bi) * 6144;
    f32x4 v[4];
#pragma unroll
    for (int q = 0; q < 4; ++q) { const int col = q * 256 + lane * 4;
      const f32x4 a1 = (f32x4){bflo(cur.y1[q].x), bfhi(cur.y1[q].x), bflo(cur.y1[q].y), bfhi(cur.y1[q].y)}, a2 = (f32x4){bflo(cur.y2[q].x), bfhi(cur.y2[q].x), bflo(cur.y2[q].y), bfhi(cur.y2[q].y)};
      v[q] = ALPHA * h_as_f32(cur.h[q]) + *(const f32x4*)(modl + 5 * 1024 + col) * (gc[0] * a1 + gc[1] * a2); }
    ln_row(v, lg, lb, lane);
    const float* modn = wsp<float>(p, WS_MOD) + ((size_t)(last ? l : l + 1) * 5 + bi) * 6144;
#pragma unroll
    for (int q = 0; q < 4; ++q) { const int col = q * 256 + lane * 4; if (last) *(f32x4*)(hf + col) = v[q]; else store_bf16x4(hb + col, v[q]);
      if (!last) store_bf16x4(U + (size_t)row * D + col, v[q] * (1.0f + *(const f32x4*)(modn + 1024 + col)) + *(const f32x4*)(modn + col)); }
    cur = nxt; gc = gn; pn = pn2; gn = gn2; r1 = r2;
  }
}

struct SchedEvenIn { static constexpr bool GATHER = false; const bf16_t* U; const bf16_t* W; bf16_t* Pqk; bf16_t* Prw; bf16_t* Vt; int G, c;
  __device__ __forceinline__ bool next(int i, pg8::Unit& u) const { const int Lx = i * G + c; u.kind = 0;
    if (Lx < 1452) { const int grp = Lx / 44, rem = Lx % 44, pm = grp * 4 + (rem & 3), pi = rem >> 2; u.pm = pm; u.pn = pi;
      u.A = (const char*)(U + (size_t)pm * 256 * D); const int brow = pi < 4 ? pi * 256 : 1536 + (pi - 4) * 256; u.Bt = (const char*)(W + (size_t)brow * D);
      if (pi < 4) { u.out = Pqk; u.ldo = 1024; u.x1 = pi * 256; } else { u.out = Prw; u.ldo = RW_IN; u.x1 = (pi - 4) * 256; } u.x0 = pm * 256; return true; }
    if (Lx < 1452 + 264) { const int v = Lx - 1452, pmv = v & 1, pnv = v >> 1; u.pm = pmv; u.pn = pnv; u.A = (const char*)(W + (size_t)(1024 + pmv * 256) * D); u.Bt = (const char*)(U + (size_t)pnv * 256 * D);
      u.out = Vt; u.ldo = NTOK; u.x0 = pmv * 256; u.x1 = pnv * 256; return true; }
    return false; } };
struct SchedOddIn { static constexpr bool GATHER = false; const bf16_t* U; const bf16_t* W; bf16_t* Pqk; bf16_t* Vt; int G, c;
  __device__ __forceinline__ bool next(int i, pg8::Unit& u) const { const int Lx = i * G + c;
    if (Lx < 1056) { const int grp = Lx / 32, rem = Lx % 32, pm = grp * 4 + (rem & 3), pi = rem >> 2; u.pm = pm; u.pn = pi; u.kind = pm < 128 ? 1 : 0;
      u.A = (const char*)(U + (size_t)pm * 256 * D); u.Bt = (const char*)(W + (size_t)pi * 256 * D); u.out = Pqk; u.ldo = 2048; u.x0 = pm * 256; u.x1 = pi * 256; return true; }
    if (Lx < 1056 + 528) { const int v = Lx - 1056, pmv = v & 3, pnv = v >> 2; u.pm = pmv; u.pn = pnv; u.kind = 0; u.A = (const char*)(W + (size_t)(2048 + pmv * 256) * D); u.Bt = (const char*)(U + (size_t)pnv * 256 * D);
      u.out = Vt; u.ldo = NTOK; u.x0 = pmv * 256; u.x1 = pnv * 256; return true; }
    return false; } };
struct SchedOut { static constexpr bool GATHER = false; const bf16_t* O; const bf16_t* W; bf16_t* Y; int G, c;
  __device__ __forceinline__ bool next(int i, pg8::Unit& u) const { const int Lx = i * G + c; if (Lx >= 528) return false; const int pm = (Lx / 16) * 4 + (Lx & 3), pn = (Lx & 15) >> 2; u.pm = pm; u.pn = pn; u.kind = 0;
    u.A = (const char*)(O + (size_t)pm * 256 * D); u.Bt = (const char*)(W + (size_t)pn * 256 * D); u.out = Y; u.ldo = 1024; u.x0 = pm * 256; u.x1 = pn * 256; return true; } };
template <bool GATH>
struct SchedMoe { static constexpr bool GATHER = GATH; const bf16_t* A; const bf16_t* W; bf16_t* out; const LAS int* moff; const int* rl; int Kd, ldo, ncol, G, c;
  __device__ __forceinline__ bool next(int i, pg8::Unit& u) const { const int Lx = i * G + c; const int ntile = moff[16] >> 8; if (Lx >= ntile * 4) return false;
    const int pm = Lx >> 2, pn = Lx & 3; int e = 0;
#pragma unroll
    for (int j = 1; j < 16; ++j) e += (pm * 256 >= moff[j]) ? 1 : 0;
    u.pm = pm; u.pn = pn; u.kind = 0; u.A = GATH ? (const char*)A : (const char*)(A + (size_t)pm * 256 * Kd); u.rl = rl + pm * 256; u.Bt = (const char*)(W + ((size_t)e * 1024 + pn * 256) * Kd); u.out = out; u.ldo = ldo; u.x0 = pm * 256; u.x1 = pn * ncol; return true; } };

struct EpiOddIn {
  static constexpr bool PERM = true; const float* rope;
  __device__ __forceinline__ void operator()(const f32x4 (&acc)[2][2][4][2], const pg8::Unit& u, int wr, int wc, int fr, int fq) const {
    if (u.kind == 0) { pg8::EpiStoreBf16{}(acc, u, wr, wc, fr, fq); return; }
    const int row0 = u.x0 + wr * 64 + fr, col0 = u.x1 + wc * 32 + 8 * fq; const int half = wc & 1;
#pragma unroll
    for (int ai = 0; ai < 2; ++ai)
#pragma unroll
      for (int m = 0; m < 4; ++m) { const int row = row0 + ai * 128 + m * 16; const int t = row & (T - 1); const int pos = half ? (t & 63) : (t >> 6);
        const f32x4 cs0 = *(const f32x4*)(rope + (pos * 16 + 4 * fq) * 2), cs1 = *(const f32x4*)(rope + (pos * 16 + 4 * fq + 2) * 2);
        bf16_t* rowp = u.out + (size_t)row * u.ldo + col0;
#pragma unroll
        for (int bj = 0; bj < 2; ++bj) { const f32x4 v0 = acc[ai][bj][m][0], v1 = acc[ai][bj][m][1];
          u32x4 w; w.x = cvt_pk_bf16(v0[0] * cs0[0] - v0[1] * cs0[1], v0[0] * cs0[1] + v0[1] * cs0[0]); w.y = cvt_pk_bf16(v0[2] * cs0[2] - v0[3] * cs0[3], v0[2] * cs0[3] + v0[3] * cs0[2]);
          w.z = cvt_pk_bf16(v1[0] * cs1[0] - v1[1] * cs1[1], v1[0] * cs1[1] + v1[1] * cs1[0]); w.w = cvt_pk_bf16(v1[2] * cs1[2] - v1[3] * cs1[3], v1[2] * cs1[3] + v1[3] * cs1[2]);
          *(u32x4*)(rowp + bj * 128) = w; } }
  }
};
struct EpiGateUp {
  static constexpr bool PERM = true;
  __device__ __forceinline__ void operator()(const f32x4 (&acc)[2][2][4][2], const pg8::Unit& u, int wr, int wc, int fr, int fq) const {
    const int row0 = u.x0 + wr * 64 + fr, col0 = u.x1 + wc * 16 + 4 * fq;
#pragma unroll
    for (int ai = 0; ai < 2; ++ai)
#pragma unroll
      for (int m = 0; m < 4; ++m) { bf16_t* rowp = u.out + (size_t)(row0 + ai * 128 + m * 16) * u.ldo + col0;
#pragma unroll
        for (int bj = 0; bj < 2; ++bj) { const f32x4 v0 = acc[ai][bj][m][0], v1 = acc[ai][bj][m][1];
          u32x2 w; w.x = cvt_pk_bf16(siluf_(v0[0]) * v0[1], siluf_(v0[2]) * v0[3]); w.y = cvt_pk_bf16(siluf_(v1[0]) * v1[1], siluf_(v1[2]) * v1[3]);
          *(u32x2*)(rowp + bj * 64) = w; } }
  }
};
}

namespace mk {
constexpr int N_PHASES = 2 + 2 * (12 + 10);
__global__ void __launch_bounds__(NTHR, 2) mega(Params p) {
  extern __shared__ __attribute__((aligned(16))) unsigned char shm[];
  LAS unsigned char* lds = (LAS unsigned char*)shm;
  const int nb = gridDim.x;
  if (threadIdx.x == 0) *(LAS u32x4*)(lds + LDS_BARW) = (u32x4){0u, 0u, 0u, 0u};
  __syncthreads();
  XcdBarrier bar = xcd_barrier_post(wsp<unsigned>(p, WS_BAR), (volatile LAS unsigned*)(lds + LDS_BARW));
  int ph = 0;
#ifndef MK_MASK
#define MK_MASK 0xFFFFFFFFu
#endif
#ifndef MK_REP
#define MK_REP 0u
#endif
#define PHASE_BEGIN_K(k) if ((((MK_MASK) >> (k)) & 1u) && ph >= p.ph_lo && ph < p.ph_hi) { const int bid = mk::obid(); const int nrep_ = ((((MK_REP) >> (k)) & 1u) ? 2 : 1); for (int rep_ = 0; rep_ < nrep_; ++rep_) { const bool dry = rep_ + 1 < nrep_; (void)dry;
#define PHASE_END   } if (ph + 1 < p.ph_hi) xcd_barrier(bar); } ++ph;
  bf16_t* UO = wsp<bf16_t>(p, WS_UO);
  unsigned char* scr = p.ws + WS_SCR;
  PHASE_BEGIN_K(0) phase_prologue(p, lds); PHASE_END
  PHASE_BEGIN_K(1) phase_mod0(p); PHASE_END
  for (int lp = 0; lp < 2; ++lp) {
    {
      const int l = 2 * lp;
      bf16_t* Pqk = (bf16_t*)(scr + SE_PQK); bf16_t* Vt = (bf16_t*)(scr + SE_VT); bf16_t* Prw = (bf16_t*)(scr + SE_PRW); bf16_t* Ybuf = (bf16_t*)(scr + SE_YBUF);
      rw::Bufs bf; bf.SH = (u32x2*)(scr + SE_SH); bf.DR = (unsigned*)(scr + SE_DR); bf.G = UO + 512; bf.gstride = 1024; bf.CS = (float*)(scr + SE_CS) + (size_t)lp * NTOK * 16; bf.PQ = (float*)(scr + SE_PQ); bf.SST = (float*)(scr + SE_SST); bf.Y = (bf16_t*)(scr + SE_Y); bf.Z = (bf16_t*)(scr + SE_Z);
      PHASE_BEGIN_K(2) { SchedEvenIn S{UO, wsp<bf16_t>(p, WS_WEIN) + (size_t)lp * EVEN_IN * D, Pqk, Prw, Vt, nb, bid}; pg8::gemm_phase(lds, D, S, pg8::EpiStoreBf16{}); } PHASE_END
      PHASE_BEGIN_K(3) { for (int u = bid; u < 1024 + 32; u += nb) { int b, h, rq; if (u < 1024) { b = u >> 8; h = (u >> 5) & 7; rq = u & 31; } else { const int v = u - 1024; b = v >> 3; h = v & 7; rq = -1; }
          natt::na_attn_unit(Pqk, Vt, p.na_rpb + ((size_t)lp * 8 + h) * 465, UO, b, h, rq, lds); }
        const int pb = (bid + nb / 2) % nb;
        for (int t = pb; t < NTOK / 16; t += nb) rw::prep_tile(Prw, p.shift_w + (size_t)lp * 3 * RW_IN, p.rw_w0 + lp * 1024, wsp<bf16_t>(p, WS_WLT) + (size_t)lp * 196608, p.rw_a0 + lp * 1024, p.rw_k_k + lp * 512, p.rw_k_a + lp * 512, p.rw_r_k + lp * 512, bf, t, (LAS float*)lds); } PHASE_END
      PHASE_BEGIN_K(4) for (int u = bid * 8 + (mk::otid() >> 6); u < rw::NCHAIN * rw::NCH; u += nb * 8) rw::scan_unit(bf, p.rw_k_a + lp * 512, u / rw::NCH, u % rw::NCH, (LAS float*)lds + (mk::otid() >> 6) * 320); PHASE_END
      PHASE_BEGIN_K(5) for (int c = bid; c < rw::NCHAIN * 4; c += nb) rw::propagate_chain(bf, c >> 2, c & 3, (LAS float*)lds); PHASE_END
      PHASE_BEGIN_K(6) for (int u = bid * 8 + (mk::otid() >> 6); u < rw::NCHAIN * (rw::NCH - 1); u += nb * 8) rw::corr_unit(bf, u / (rw::NCH - 1), 1 + u % (rw::NCH - 1)); PHASE_END
      PHASE_BEGIN_K(7) for (int r = bid * 8; r < NTOK; r += nb * 8) rw::finish_rows<8>(bf, p.rw_gn_g + lp * 512, p.rw_gn_b + lp * 512, UO, r); PHASE_END
      PHASE_BEGIN_K(8) { SchedOut S{UO, wsp<bf16_t>(p, WS_WEOUT) + (size_t)lp * D * D, Ybuf, nb, bid}; pg8::gemm_phase(lds, D, S, pg8::EpiStoreBf16{}); __syncthreads(); cvt_experts(p, l, (LAS float*)lds, 528 - 2 * nb > 0 ? 528 - 2 * nb : 0); } PHASE_END
      PHASE_BEGIN_K(9) if (l == 0) phase_ln1<true>(p, l, Ybuf, lds, dry); else phase_ln1<false>(p, l, Ybuf, lds, dry); PHASE_END
      PHASE_BEGIN_K(10) phase_scatter(p, l, lds); PHASE_END
      PHASE_BEGIN_K(11) { LAS int* mo = (LAS int*)(lds + LDS_MISC); { const int tq = mk::otid(); if (tq < 17) mo[tq] = wsp<int>(p, WS_MOFF)[l * 64 + tq]; } __syncthreads();
        SchedMoe<true> S{UO, wsp<bf16_t>(p, WS_WGU), (bf16_t*)(scr + SM_HE), mo, wsp<int>(p, WS_RL), D, DE, 128, nb, bid}; pg8::gemm_phase(lds, D, S, EpiGateUp{}); } PHASE_END
      PHASE_BEGIN_K(12) { LAS int* mo = (LAS int*)(lds + LDS_MISC); { const int tq = mk::otid(); if (tq < 17) mo[tq] = wsp<int>(p, WS_MOFF)[l * 64 + tq]; } __syncthreads();
        SchedMoe<false> S{(bf16_t*)(scr + SM_HE), wsp<bf16_t>(p, WS_WDN), (bf16_t*)(scr + SM_YS), mo, nullptr, DE, D, 256, nb, bid}; pg8::gemm_phase(lds, DE, S, pg8::EpiStoreBf16{}); } PHASE_END
      PHASE_BEGIN_K(13) phase_ln2(p, l, dry); PHASE_END
    }
    {
      const int l = 2 * lp + 1; const bool last = l == DEPTH - 1;
      bf16_t* Pqk = (bf16_t*)(scr + SO_PQK); bf16_t* Vt = (bf16_t*)(scr + SO_VT); bf16_t* O12 = (bf16_t*)(scr + SO_O12); bf16_t* Ybuf = (bf16_t*)(scr + SO_YBUF);
      PHASE_BEGIN_K(14) { SchedOddIn S{UO, wsp<bf16_t>(p, WS_WOIN) + (size_t)lp * ODD_IN * D, Pqk, Vt, nb, bid}; pg8::gemm_phase(lds, D, S, EpiOddIn{wsp<float>(p, WS_ROPE)}); } PHASE_END
      float* KN = wsp<float>(p, WS_KN) + (size_t)lp * 256 * 16;
      PHASE_BEGIN_K(23) for (int g = bid; g < 256; g += nb) att::knorm_group(Pqk, KN, g, (LAS float*)lds); PHASE_END
      PHASE_BEGIN_K(15) for (int ui = bid; ui < 2048 + (last ? 0 : 64); ui += nb) { int b, hh, q0, nlat; const int u = (nb == 256 && ui < 2048) ? ((((ui >> 8) * 8 + (bid & 7)) << 5) | (bid >> 3)) : ui;
        if (u < 2048) { b = u >> 9; hh = (u >> 5) & 15; q0 = b * T + (u & 31) * 256; nlat = T; } else { const int v = u - 2048; b = v >> 4; hh = v & 15; q0 = NLAT + b * L; nlat = 0; }
#ifdef MK_ABL
        if (dry) att::diff_attn_unit<MK_ABL>(Pqk, Vt, O12, hh, q0, b * T, nlat, NLAT + b * L, att::kmax2_of(KN, b, hh), lds); else
#endif
        att::diff_attn_unit(Pqk, Vt, O12, hh, q0, b * T, nlat, NLAT + b * L, att::kmax2_of(KN, b, hh), lds); } PHASE_END
      PHASE_BEGIN_K(16) { float d1 = 0.f, d2 = 0.f; for (int i = 0; i < 64; ++i) { d1 += p.da_lq1[lp * 64 + i] * p.da_lk1[lp * 64 + i]; d2 += p.da_lq2[lp * 64 + i] * p.da_lk2[lp * 64 + i]; }
        const float li = 0.8f - 0.6f * expf(-0.3f * (float)l), lam = expf(d1) - expf(d2) + li;
        const int tq = mk::otid(); for (int r4 = bid; r4 < (last ? NLAT : NTOK) / 4; r4 += nb) att::diff_combine_rows4(O12, p.da_subln_g + lp * 128, lam, 1.0f - li, UO, r4 * 4, tq >> 6, tq & 63); } PHASE_END
      PHASE_BEGIN_K(17) { SchedOut S{UO, wsp<bf16_t>(p, WS_WOOUT) + (size_t)lp * D * D, Ybuf, nb, bid}; pg8::gemm_phase(lds, D, S, pg8::EpiStoreBf16{}); __syncthreads(); cvt_experts(p, l, (LAS float*)lds, 528 - 2 * nb > 0 ? 528 - 2 * nb : 0); } PHASE_END
      PHASE_BEGIN_K(18) phase_ln1<false>(p, l, Ybuf, lds, dry); PHASE_END
      PHASE_BEGIN_K(19) phase_scatter(p, l, lds); PHASE_END
      PHASE_BEGIN_K(20) { LAS int* mo = (LAS int*)(lds + LDS_MISC); { const int tq = mk::otid(); if (tq < 17) mo[tq] = wsp<int>(p, WS_MOFF)[l * 64 + tq]; } __syncthreads();
        SchedMoe<true> S{UO, wsp<bf16_t>(p, WS_WGU), (bf16_t*)(scr + SM_HE), mo, wsp<int>(p, WS_RL), D, DE, 128, nb, bid}; pg8::gemm_phase(lds, D, S, EpiGateUp{}); } PHASE_END
      PHASE_BEGIN_K(21) { LAS int* mo = (LAS int*)(lds + LDS_MISC); { const int tq = mk::otid(); if (tq < 17) mo[tq] = wsp<int>(p, WS_MOFF)[l * 64 + tq]; } __syncthreads();
        SchedMoe<false> S{(bf16_t*)(scr + SM_HE), wsp<bf16_t>(p, WS_WDN), (bf16_t*)(scr + SM_YS), mo, nullptr, DE, D, 256, nb, bid}; pg8::gemm_phase(lds, DE, S, pg8::EpiStoreBf16{}); } PHASE_END
      PHASE_BEGIN_K(22) phase_ln2(p, l, dry); PHASE_END
    }
  }
#undef PHASE_BEGIN_K
#undef PHASE_END
}
}

#ifndef MK_SINGLE_LAUNCH
#define MK_SINGLE_LAUNCH 1
#endif
extern "C" void kernel_launch(void* const* d_in, const int* in_sizes, int n_in, void* d_out, int out_size, void* d_ws, size_t ws_size, hipStream_t stream) {
  using namespace mk;
  static int grid = 0;
  if (grid == 0) {
    if (n_in != 34 || out_size != NLAT * D || ws_size < WS_END) { fprintf(stderr, "kernel_launch: unexpected shapes (n_in %d out %d ws %zu need %zu)\n", n_in, out_size, ws_size, (size_t)WS_END); grid = -1; return; }
    if (hipFuncSetAttribute((const void*)mega, hipFuncAttributeMaxDynamicSharedMemorySize, LDS_BYTES) != hipSuccess) { grid = -1; return; }
    int dev = 0, cus = 0, per_cu = 0;
    if (hipGetDevice(&dev) != hipSuccess || hipDeviceGetAttribute(&cus, hipDeviceAttributeMultiprocessorCount, dev) != hipSuccess) { grid = -1; return; }
    if (hipOccupancyMaxActiveBlocksPerMultiprocessor(&per_cu, (const void*)mega, NTHR, LDS_BYTES) != hipSuccess || per_cu < 1) { fprintf(stderr, "kernel_launch: occupancy query says %d\n", per_cu); }
    (void)hipGetLastError();
    grid = cus;
  }
  if (grid < 0) return;
  (void)hipMemsetAsync((char*)d_ws + WS_BAR, 0, (size_t)XCD_BAR_WORDS * 4, stream);
  Params p{};
  const float** pp = (const float**)&p;
  for (int i = 0; i < 34; ++i) pp[i] = (const float*)d_in[i];
  p.out = (float*)d_out; p.ws = (unsigned char*)d_ws;
#if MK_SINGLE_LAUNCH
  p.ph_lo = 0; p.ph_hi = N_PHASES;
  hipLaunchKernelGGL(mega, dim3(grid), dim3(NTHR), LDS_BYTES, stream, p);
#else
  for (int ph = 0; ph < N_PHASES; ++ph) { p.ph_lo = ph; p.ph_hi = ph + 1; hipLaunchKernelGGL(mega, dim3(grid), dim3(NTHR), LDS_BYTES, stream, p); }
#endif
}
```

```cpp
#include <hip/hip_runtime.h>
#include <stdint.h>
#include <stdio.h>

typedef unsigned short bf16_t;
typedef short bf16x8 __attribute__((ext_vector_type(8)));
typedef float f32x4 __attribute__((ext_vector_type(4)));
typedef float f32x2 __attribute__((ext_vector_type(2)));
typedef float f32x16 __attribute__((ext_vector_type(16)));
typedef unsigned u32x4 __attribute__((ext_vector_type(4)));
typedef unsigned u32x2 __attribute__((ext_vector_type(2)));
#define LAS __attribute__((address_space(3)))

namespace mk {
constexpr int B = 4, T = 8192, L = 256, D = 1024, NLAT = B * T, NCTX = B * L, NTOK = NLAT + NCTX;
constexpr int DEPTH = 4, EVEN_IN = 3328, ODD_IN = 3072, RW_OFF = 1536, RW_IN = 1792, NE = 16, DE = 512;
constexpr float ALPHA = 1.681792830507429f, LN_EPS = 1e-5f;
constexpr int NTHR = 512, LDS_BYTES = 147456;
constexpr int MOE_TILES = 280, MOE_ROWS = MOE_TILES * 256;

__device__ __forceinline__ unsigned cvt_pk_bf16(float lo, float hi) { unsigned r; asm volatile("v_cvt_pk_bf16_f32 %0, %1, %2" : "=v"(r) : "v"(lo), "v"(hi)); return r; }
__device__ __forceinline__ float bf2f(bf16_t b) { return __uint_as_float(((unsigned)b) << 16); }
__device__ __forceinline__ float bflo(unsigned w) { return __uint_as_float(w << 16); }
__device__ __forceinline__ float bfhi(unsigned w) { return __uint_as_float(w & 0xffff0000u); }
__device__ __forceinline__ bf16_t f2bf(float f) { return (bf16_t)(cvt_pk_bf16(f, 0.f) & 0xffffu); }
__device__ __forceinline__ float sigmoidf_(float x) { return 1.0f / (1.0f + __expf(-x)); }
__device__ __forceinline__ float siluf_(float x) { return x / (1.0f + __expf(-x)); }
__device__ __forceinline__ float wave_sum(float v) {
#pragma unroll
  for (int o = 32; o > 0; o >>= 1) v += __shfl_xor(v, o);
  return v;
}
template <int CTRL, int RM, int BM> __device__ __forceinline__ float dpp_mov(float old, float v) { return __int_as_float(__builtin_amdgcn_update_dpp(__float_as_int(old), __float_as_int(v), CTRL, RM, BM, false)); }
__device__ __forceinline__ float wave_sum_u(float v) {
  v += dpp_mov<0xB1, 0xf, 0xf>(v, v);
  v += dpp_mov<0x4E, 0xf, 0xf>(v, v);
  v += dpp_mov<0x141, 0xf, 0xf>(v, v);
  v += dpp_mov<0x140, 0xf, 0xf>(v, v);
  v += dpp_mov<0x142, 0xa, 0xf>(0.f, v);
  v += dpp_mov<0x143, 0xc, 0xf>(0.f, v);
  return __int_as_float(__builtin_amdgcn_readlane(__float_as_int(v), 63));
}
__device__ __forceinline__ float wave_max_u(float v) {
  v = fmaxf(v, dpp_mov<0xB1, 0xf, 0xf>(v, v));
  v = fmaxf(v, dpp_mov<0x4E, 0xf, 0xf>(v, v));
  v = fmaxf(v, dpp_mov<0x141, 0xf, 0xf>(v, v));
  v = fmaxf(v, dpp_mov<0x140, 0xf, 0xf>(v, v));
  v = fmaxf(v, dpp_mov<0x142, 0xa, 0xf>(0.f, v));
  v = fmaxf(v, dpp_mov<0x143, 0xc, 0xf>(0.f, v));
  return __int_as_float(__builtin_amdgcn_readlane(__float_as_int(v), 63));
}
__device__ __forceinline__ f32x16 zero16() { float z = 0.f; asm volatile("" : "+v"(z)); f32x16 r;
#pragma unroll
  for (int i = 0; i < 16; ++i) r[i] = z;
  return r; }
__device__ __forceinline__ int otid() { int t = threadIdx.x; asm volatile("" : "+v"(t)); return t; }
__device__ __forceinline__ int obid() { int b = blockIdx.x; asm volatile("" : "+s"(b)); return b; }
__device__ __forceinline__ int bidx_of_row(int row) { return row < NLAT ? row / T : 4; }
}

#include <vector>

#define XB_TMO      128
#define XB_XCNT(j)  (256  + 64 * (j))
#define XB_XSUB(j)  (1280 + 64 * (j))
#define XB_XGEN(j)  (2304 + 64 * (j))
#define XB_TOP      3328
#define XB_TOPGEN   3392
#define XCD_BAR_WORDS 3456
#define XB_SPIN_CAP (1u << 18)
#define LAS __attribute__((address_space(3)))

__device__ __forceinline__ unsigned xb_ld(unsigned* p)              { return __hip_atomic_load(p, __ATOMIC_RELAXED, __HIP_MEMORY_SCOPE_AGENT); }
__device__ __forceinline__ unsigned xb_add(unsigned* p, unsigned v) { return __hip_atomic_fetch_add(p, v, __ATOMIC_RELAXED, __HIP_MEMORY_SCOPE_AGENT); }
__device__ __forceinline__ unsigned xb_xcc_id() { return (unsigned)__builtin_amdgcn_s_getreg((3 << 11) | 20) & 0xFu; }
#define XB_SPIN(cond, bar) do { unsigned _sp = 0; while (cond) { __builtin_amdgcn_s_sleep(1); \
    if ((++_sp & 255u) == 0u) { if (xb_ld(&(bar)[XB_TMO])) break; if (_sp > XB_SPIN_CAP) { atomicAdd(&(bar)[XB_TMO], 1u); break; } } } } while (0)

struct XcdBarrier {
    unsigned* bar; unsigned x;
    volatile LAS unsigned* st;
};

__device__ __forceinline__ XcdBarrier xcd_barrier_post(unsigned* bar, volatile LAS unsigned* st) {
    XcdBarrier b; b.bar = bar; b.x = xb_xcc_id(); b.st = st;
    if (threadIdx.x == 0) (void)xb_add(&bar[XB_XCNT(b.x)], 1u);
    return b;
}
__device__ __forceinline__ void xcd_barrier_complete(unsigned* bar, unsigned x, unsigned& nloc, unsigned& nx) {
    const unsigned G = gridDim.x * gridDim.y * gridDim.z;
    unsigned sum, cnt, mine, sp = 0u;
    for (;;) {
        sum = 0u; cnt = 0u; mine = 0u;
#pragma unroll
        for (unsigned j = 0; j < 16; ++j) { const unsigned c = xb_ld(&bar[XB_XCNT(j)]); sum += c; cnt += (c > 0u) ? 1u : 0u; mine = (j == x) ? c : mine; }
        if (sum == G) break;
        __builtin_amdgcn_s_sleep(1);
        if ((++sp & 255u) == 0u) { if (xb_ld(&bar[XB_TMO])) break; if (sp > XB_SPIN_CAP) { atomicAdd(&bar[XB_TMO], 1u); break; } }
    }
    nloc = mine > 0u ? mine : 1u; nx = cnt > 0u ? cnt : 1u;
}

__device__ __forceinline__ void xcd_barrier(const XcdBarrier& b) {
    asm volatile("s_waitcnt vmcnt(0)" ::: "memory");
    __syncthreads();
    if (threadIdx.x == 0) {
        unsigned* bar = b.bar;
        __builtin_amdgcn_s_waitcnt(0);
        unsigned nloc = b.st[0], nx = b.st[1];
        if (nloc == 0u) { xcd_barrier_complete(bar, b.x, nloc, nx); b.st[0] = nloc; b.st[1] = nx; }
        const unsigned old = xb_add(&bar[XB_XSUB(b.x)], 1u);
        const unsigned gen = old / nloc;
        if (old + 1u == (gen + 1u) * nloc) {
            __builtin_amdgcn_fence(__ATOMIC_RELEASE, "agent");
            asm volatile("s_waitcnt vmcnt(0)" ::: "memory");
            const unsigned og = xb_add(&bar[XB_TOP], 1u);
            const unsigned tg = og / nx;
            if (og + 1u == (tg + 1u) * nx) xb_add(&bar[XB_TOPGEN], 1u);
            else XB_SPIN(xb_ld(&bar[XB_TOPGEN]) == tg, bar);
            __builtin_amdgcn_fence(__ATOMIC_ACQUIRE, "agent");
            xb_add(&bar[XB_XGEN(b.x)], 1u);
            asm volatile("s_waitcnt vmcnt(0)" ::: "memory");
        } else {
            XB_SPIN(xb_ld(&bar[XB_XGEN(b.x)]) == gen, bar);
            __builtin_amdgcn_fence(__ATOMIC_ACQUIRE, "agent");
            asm volatile("s_waitcnt vmcnt(0)" ::: "memory");
        }
    }
    __syncthreads();
}

namespace pg8 {
using mk::cvt_pk_bf16;
constexpr int BM = 256, BK = 64, HALF = 128, HTB = HALF * BK * 2  , STAGE_BYTES = 8 * HTB;
__host__ __device__ __forceinline__ int lds_byte(int r, int c) { const int st = (r >> 4) * 2 + (c >> 5), rr = r & 15, cc = c & 31, ob = rr * 64 + cc * 2; return st * 1024 + (ob ^ (((ob >> 9) & 1) << 5)); }
__host__ __device__ __forceinline__ void stage_rc(int b, int& R, int& C) { const int st = b / 1024, sb = b % 1024, swz = sb ^ (((sb >> 9) & 1) << 5); R = (st >> 1) * 16 + swz / 64; C = (st & 1) * 32 + (swz % 64) / 2; }
__host__ __device__ __forceinline__ int perm32(int rho) { const int n = rho >> 4, i = rho & 15; return 8 * (i >> 2) + 4 * n + (i & 3); }

struct Unit { const char* A; const char* Bt; bf16_t* out; const int* rl; int pm, pn, x0, x1, ldo, kind; };

template <class Epi, class Sched>
__device__ __forceinline__ void gemm_phase(LAS unsigned char* lds, const int K, const Sched& S, const Epi& E) {
    const int tid = mk::otid(), wid = __builtin_amdgcn_readfirstlane(tid >> 6), lane = tid & 63, wr = wid >> 2, wc = wid & 3, fr = lane & 15, fq = lane >> 4;
    const int nt = K / BK;
    constexpr bool GATH = Sched::GATHER;
    unsigned voffA[2], voffB[2]; int Rl[2], Cl[2];
#pragma unroll
    for (int i = 0; i < 2; ++i) { int R, C; stage_rc(tid * 16 + i * 8192, R, C); const int Rb = Epi::PERM ? ((R & ~31) + perm32(R & 31)) : R; Rl[i] = R; Cl[i] = C;
        voffA[i] = (unsigned)(R * K + C) * 2u; voffB[i] = (unsigned)(Rb * K + C) * 2u; }
    unsigned roC[2][2], roN[2][2];
    (void)Rl; (void)Cl;
    const size_t kstep = (size_t)(BK * 2);
    const size_t hstep = (size_t)HALF * K * 2;
    const unsigned ldsw = (unsigned)wid * 1024u;
    const int aoff = lds_byte(wr * 64 + fr, fq * 8), boff = lds_byte(wc * 32 + fr, fq * 8);
#define PG8_SA(b, h) (((b) * 2 + (h)) * HTB)
#define PG8_SB(b, h) ((4 + (b) * 2 + (h)) * HTB)
#define PG8_STAGE(bufoff, gbase, voff) do { _Pragma("unroll") for (int _i = 0; _i < 2; ++_i) \
        __builtin_amdgcn_global_load_lds((const unsigned*)((const char*)(gbase) + (voff)[_i]), (LAS unsigned*)(lds + (bufoff) + ldsw + _i * 8192), 16, 0, 0); } while (0)
#define PG8_STAGE_A(bufoff, gbase, h, ro) do { if constexpr (GATH) { _Pragma("unroll") for (int _i = 0; _i < 2; ++_i) \
        __builtin_amdgcn_global_load_lds((const unsigned*)((const char*)(gbase) + (ro)[h][_i]), (LAS unsigned*)(lds + (bufoff) + ldsw + _i * 8192), 16, 0, 0); } \
      else { PG8_STAGE(bufoff, (const char*)(gbase) + (h) * hstep, voffA); } } while (0)
#define PG8_LOAD_RO(u, ro) do { _Pragma("unroll") for (int _h = 0; _h < 2; ++_h) _Pragma("unroll") for (int _i = 0; _i < 2; ++_i) \
        (ro)[_h][_i] = (unsigned)(u).rl[Rl[_i] + _h * 128] * (unsigned)(K * 2) + (unsigned)(Cl[_i] * 2); } while (0)
#define PG8_LDA(dst, b, h) do { _Pragma("unroll") for (int m = 0; m < 4; ++m) _Pragma("unroll") for (int k = 0; k < 2; ++k) dst[m][k] = *(const LAS bf16x8*)(lds + PG8_SA(b, h) + aoff + m * 2048 + k * 1024); } while (0)
#define PG8_LDB(dst, b, h) do { _Pragma("unroll") for (int n = 0; n < 2; ++n) _Pragma("unroll") for (int k = 0; k < 2; ++k) dst[n][k] = *(const LAS bf16x8*)(lds + PG8_SB(b, h) + boff + n * 2048 + k * 1024); } while (0)
#define PG8_MMA(ai, bj, At, Bt) do { __builtin_amdgcn_s_setprio(1); _Pragma("unroll") for (int m = 0; m < 4; ++m) _Pragma("unroll") for (int n = 0; n < 2; ++n) _Pragma("unroll") for (int k = 0; k < 2; ++k) \
        acc[ai][bj][m][n] = __builtin_amdgcn_mfma_f32_16x16x32_bf16(Bt[n][k], At[m][k], acc[ai][bj][m][n], 0, 0, 0); __builtin_amdgcn_s_setprio(0); } while (0)
#define PG8_WAIT_V(n) asm volatile("s_waitcnt vmcnt(" #n ")" ::: "memory")
#define PG8_WAIT_L(n) asm volatile("s_waitcnt lgkmcnt(" #n ")" ::: "memory")
#define PG8_BAR __builtin_amdgcn_s_barrier()
#define PG8_SCHED __builtin_amdgcn_sched_barrier(0)
    Unit cur, nxt; int ui = 0;
    if (!S.next(0, cur)) return;
    f32x4 acc[2][2][4][2];
#pragma unroll
    for (int a = 0; a < 2; ++a)
#pragma unroll
        for (int b = 0; b < 2; ++b)
#pragma unroll
            for (int m = 0; m < 4; ++m)
#pragma unroll
                for (int n = 0; n < 2; ++n) acc[a][b][m][n] = (f32x4){0.f, 0.f, 0.f, 0.f};
    bf16x8 At[4][2], B0[2][2], B1[2][2];
    const char* cA = cur.A; const char* cB = cur.Bt;
    if constexpr (GATH) { PG8_LOAD_RO(cur, roC); }
    PG8_STAGE(PG8_SB(0, 0), cB, voffB); PG8_STAGE_A(PG8_SA(0, 0), cA, 0, roC); PG8_STAGE(PG8_SB(0, 1), cB + hstep, voffB); PG8_STAGE_A(PG8_SA(0, 1), cA, 1, roC);
    if (wr == 1) PG8_BAR;
    PG8_WAIT_V(4); PG8_BAR;
    PG8_STAGE(PG8_SB(1, 0), cB + kstep, voffB); PG8_STAGE_A(PG8_SA(1, 0), cA + kstep, 0, roC); PG8_STAGE(PG8_SB(1, 1), cB + hstep + kstep, voffB);
    PG8_WAIT_V(6); PG8_BAR;
    for (;;) {
        const bool has_next = S.next(ui + 1, nxt);
        const char* nA = has_next ? nxt.A : cA; const char* nB = has_next ? nxt.Bt : cB;
        if constexpr (GATH) { if (has_next) { PG8_LOAD_RO(nxt, roN); } else { _Pragma("unroll") for (int _h = 0; _h < 2; ++_h) _Pragma("unroll") for (int _i = 0; _i < 2; ++_i) roN[_h][_i] = roC[_h][_i]; } }
        for (int t = 0; t < nt; t += 2) {
            const bool last = (t == nt - 2);
            const char* a1 = cA + (size_t)(t + 1) * kstep;
            const char* a2 = last ? nA : cA + (size_t)(t + 2) * kstep; const char* b2 = last ? nB : cB + (size_t)(t + 2) * kstep;
            const char* a3 = a2 + kstep; const char* b3 = b2 + kstep;
            unsigned ro2[2][2];
            if constexpr (GATH) { _Pragma("unroll") for (int _h = 0; _h < 2; ++_h) _Pragma("unroll") for (int _i = 0; _i < 2; ++_i) ro2[_h][_i] = last ? roN[_h][_i] : roC[_h][_i]; }
            (void)ro2;
            PG8_LDB(B0, 0, 0); PG8_SCHED; PG8_LDA(At, 0, 0); PG8_STAGE_A(PG8_SA(1, 1), a1, 1, roC);
            PG8_WAIT_L(8); PG8_BAR; PG8_WAIT_L(0); PG8_MMA(0, 0, At, B0); PG8_BAR; PG8_SCHED;
            PG8_LDB(B1, 0, 1); PG8_STAGE(PG8_SB(0, 0), b2, voffB);
            PG8_BAR; PG8_WAIT_L(0); PG8_MMA(0, 1, At, B1); PG8_BAR;
            PG8_LDA(At, 0, 1); PG8_STAGE_A(PG8_SA(0, 0), a2, 0, ro2);
            PG8_BAR; PG8_WAIT_L(0); PG8_MMA(1, 0, At, B0); PG8_BAR; PG8_SCHED;
            PG8_STAGE(PG8_SB(0, 1), b2 + hstep, voffB);
            PG8_WAIT_V(6); PG8_BAR; PG8_MMA(1, 1, At, B1); PG8_BAR;
            PG8_LDB(B0, 1, 0); PG8_SCHED; PG8_LDA(At, 1, 0); PG8_STAGE_A(PG8_SA(0, 1), a2, 1, ro2);
            PG8_WAIT_L(8); PG8_BAR; PG8_WAIT_L(0); PG8_MMA(0, 0, At, B0); PG8_BAR; PG8_SCHED;
            PG8_LDB(B1, 1, 1); PG8_STAGE(PG8_SB(1, 0), b3, voffB);
            PG8_BAR; PG8_WAIT_L(0); PG8_MMA(0, 1, At, B1); PG8_BAR;
            PG8_LDA(At, 1, 1); PG8_STAGE_A(PG8_SA(1, 0), a3, 0, ro2);
            PG8_BAR; PG8_WAIT_L(0); PG8_MMA(1, 0, At, B0); PG8_BAR; PG8_SCHED;
            PG8_STAGE(PG8_SB(1, 1), b3 + hstep, voffB);
            PG8_WAIT_V(6); PG8_BAR; PG8_MMA(1, 1, At, B1); PG8_BAR;
        }
        E(acc, cur, wr, wc, fr, fq);
        if (!has_next) break;
#pragma unroll
        for (int a = 0; a < 2; ++a)
#pragma unroll
            for (int b = 0; b < 2; ++b)
#pragma unroll
                for (int m = 0; m < 4; ++m)
#pragma unroll
                    for (int n = 0; n < 2; ++n) acc[a][b][m][n] = (f32x4){0.f, 0.f, 0.f, 0.f};
        cur = nxt; cA = nA; cB = nB; ++ui;
        if constexpr (GATH) { _Pragma("unroll") for (int _h = 0; _h < 2; ++_h) _Pragma("unroll") for (int _i = 0; _i < 2; ++_i) roC[_h][_i] = roN[_h][_i]; }
    }
    PG8_WAIT_V(0);
    if (wr == 0) PG8_BAR;
    PG8_BAR;
#undef PG8_SA
#undef PG8_SB
#undef PG8_STAGE
#undef PG8_STAGE_A
#undef PG8_LOAD_RO
#undef PG8_LDA
#undef PG8_LDB
#undef PG8_MMA
#undef PG8_WAIT_V
#undef PG8_WAIT_L
#undef PG8_BAR
#undef PG8_SCHED
}

struct EpiStoreBf16 {
    static constexpr bool PERM = true;
    __device__ __forceinline__ void operator()(const f32x4 (&acc)[2][2][4][2], const Unit& u, int wr, int wc, int fr, int fq) const {
        bf16_t* O = u.out; const int ldc = u.ldo;
        const int row0 = u.x0 + wr * 64 + fr, col0 = u.x1 + wc * 32 + 8 * fq;
#pragma unroll
        for (int ai = 0; ai < 2; ++ai)
#pragma unroll
            for (int m = 0; m < 4; ++m) { bf16_t* rowp = O + (size_t)(row0 + ai * HALF + m * 16) * ldc + col0;
#pragma unroll
                for (int bj = 0; bj < 2; ++bj) { const f32x4 v0 = acc[ai][bj][m][0], v1 = acc[ai][bj][m][1];
                    u32x4 w; w.x = cvt_pk_bf16(v0[0], v0[1]); w.y = cvt_pk_bf16(v0[2], v0[3]); w.z = cvt_pk_bf16(v1[0], v1[1]); w.w = cvt_pk_bf16(v1[2], v1[3]);
                    *(u32x4*)(rowp + bj * HALF) = w; } }
    }
};
}

namespace mk {
struct NMapId { int off; __device__ __forceinline__ int operator()(int n) const { return n + off; } __device__ __forceinline__ float scl(int) const { return 1.0f; } };
struct NMapInterleave { int which; __device__ __forceinline__ int operator()(int n) const { return 2 * n + which; } __device__ __forceinline__ float scl(int) const { return 1.0f; } };
struct NMapRope { __device__ __forceinline__ int operator()(int n) const { if (n >= 2048) return n; const int ch = n >> 6, c = n & 63, half = c >> 5, w = c & 31, z = w >> 4, i = w & 15; return ch * 64 + half * 32 + 2 * i + z; }
  __device__ __forceinline__ float scl(int n) const { return n < 1024 ? 0.125f * 1.4426950408889634f : 1.0f; } };

template <class NMap>
__device__ __forceinline__ void cvt_tile(const float* __restrict__ src, int ldsrc, int K, bf16_t* __restrict__ dst, int k0, int n0, const NMap& nmap, LAS float* tile) {
  const int t = mk::otid();
  { const int k = t >> 3, c = (t & 7) * 8; const float* p = src + (size_t)(k0 + k) * ldsrc + n0 + c;
    const f32x4 a = *(const f32x4*)p, b = *(const f32x4*)(p + 4);
    LAS float* q = tile + k * 65 + c; q[0] = a[0]; q[1] = a[1]; q[2] = a[2]; q[3] = a[3]; q[4] = b[0]; q[5] = b[1]; q[6] = b[2]; q[7] = b[3]; }
  __syncthreads();
  { const int n = t >> 3, kc = (t & 7) * 8; const LAS float* q = tile + kc * 65 + n; const float sc = nmap.scl(n0 + n);
    u32x4 w; w.x = cvt_pk_bf16(q[0] * sc, q[65] * sc); w.y = cvt_pk_bf16(q[130] * sc, q[195] * sc); w.z = cvt_pk_bf16(q[260] * sc, q[325] * sc); w.w = cvt_pk_bf16(q[390] * sc, q[455] * sc);
    *(u32x4*)(dst + (size_t)nmap(n0 + n) * K + k0 + kc) = w; }
  __syncthreads();
}
template <class NMap>
__device__ __forceinline__ int cvt_matrix(const float* src, int ldsrc, int K, int N, bf16_t* dst, const NMap& nmap, LAS float* tile, int ubase, int bid, int nblk) {
  const int nkt = K / 64, nnt = N / 64, tot = nkt * nnt;
  int first = ubase + ((bid - ubase % nblk) + nblk) % nblk;
  for (int u = first; u < ubase + tot; u += nblk) { const int v = u - ubase; cvt_tile(src, ldsrc, K, dst, (v / nnt) * 64, (v % nnt) * 64, nmap, tile); }
  return tot;
}
}

namespace att {
using namespace mk;
constexpr int KB_BYTES = 64 * 128, VB_BYTES = 128 * 128, TILE_BYTES = KB_BYTES + VB_BYTES, DA_RING = 4, DA_LDS = DA_RING * TILE_BYTES;
__device__ __forceinline__ int pi32(int r) { return (r & ~12) | ((r & 4) << 1) | ((r & 8) >> 1); }
__device__ __forceinline__ int swz(int row, int chunk) { return row * 128 + ((chunk ^ ((row >> 1) & 7)) << 4); }
__device__ __forceinline__ int crow(int r, int hi) { return (r & 3) + 8 * (r >> 2) + 4 * hi; }

__device__ __forceinline__ float sumsq8(u32x4 w) { return (bflo(w.x) * bflo(w.x) + bfhi(w.x) * bfhi(w.x)) + (bflo(w.y) * bflo(w.y) + bfhi(w.y) * bfhi(w.y)) + (bflo(w.z) * bflo(w.z) + bfhi(w.z) * bfhi(w.z)) + (bflo(w.w) * bflo(w.w) + bfhi(w.w) * bfhi(w.w)); }
__device__ __forceinline__ void knorm_group(const bf16_t* __restrict__ Pqk, float* __restrict__ KN, int g, LAS float* red) {
  const int tid = mk::otid(), wid = tid >> 6, lane = tid & 63;
  float mx = 0.f;
  for (int i0 = 0; i0 < 160; i0 += 32) {
    u32x4 a[4], b[4];
#pragma unroll
    for (int j = 0; j < 4; ++j) { int i = i0 + j * 8 + wid; i = i < 132 ? i : wid; const int row = i < 128 ? g * 128 + i : NLAT + g * 4 + (i - 128);
      const bf16_t* kp = Pqk + (size_t)row * 2048 + 1024 + lane * 16; a[j] = *(const u32x4*)kp; b[j] = *(const u32x4*)(kp + 8); }
#pragma unroll
    for (int j = 0; j < 4; ++j) { float s = sumsq8(a[j]) + sumsq8(b[j]); s += dpp_mov<0xB1, 0xf, 0xf>(s, s); s += dpp_mov<0x4E, 0xf, 0xf>(s, s); mx = fmaxf(mx, s); }
  }
  if ((lane & 3) == 0) red[wid * 16 + (lane >> 2)] = mx;
  __syncthreads();
  if (tid < 16) { float m = red[tid];
#pragma unroll
    for (int w = 1; w < 8; ++w) m = fmaxf(m, red[w * 16 + tid]);
    KN[g * 16 + tid] = m; }
  __syncthreads();
}
__device__ __forceinline__ float kmax2_of(const float* __restrict__ KN, int b, int hh) {
  return wave_max_u(KN[(b * 64 + (mk::otid() & 63)) * 16 + hh]);
}

template <int ABL = 0>
__device__ __forceinline__ void diff_attn_unit(const bf16_t* __restrict__ Pqk, const bf16_t* __restrict__ Vt, bf16_t* __restrict__ O12, int hh, int q0, int klat0, int nlat, int kctx0, float kmax2, LAS unsigned char* lds) {
  const int tid = mk::otid(), wid = tid >> 6, lane = tid & 63, r = lane & 31, hi = lane >> 5;
  const int NT = (nlat + L) / 64, NTL = nlat / 64;
  const int wv = __builtin_amdgcn_readfirstlane(wid);
  const int drow = wv * 8 + (lane >> 3), dch = (lane & 7) ^ ((drow >> 1) & 7);
  const unsigned koff = (unsigned)(drow * 2048 + 1024 + hh * 64 + dch * 8) * 2u;
  const unsigned voff = (unsigned)(((hh >> 1) * 128 + drow) * NTOK + dch * 8) * 2u;
  bf16x8 qf[4];
  { const bf16_t* qp = Pqk + (size_t)(q0 + wid * 32 + r) * 2048 + hh * 64 + hi * 8;
#pragma unroll
    for (int ks = 0; ks < 4; ++ks) qf[ks] = *(const bf16x8*)(qp + ks * 16); }
  const unsigned kaddr0 = (unsigned)(pi32(r) * 128 + ((hi ^ ((pi32(r) >> 1) & 7)) << 4));
  const unsigned vaddr0 = (unsigned)(r * 128 + ((hi ^ ((r >> 1) & 7)) << 4)) + KB_BYTES;
  f32x16 o[4];
#pragma unroll
  for (int vb = 0; vb < 4; ++vb)
#pragma unroll
    for (int i = 0; i < 16; ++i) o[vb][i] = 0.f;
  float l_run = 0.f;
#define DA_DMA(t) do { const int tok = (t) < NTL ? klat0 + (t) * 64 : kctx0 + ((t) - NTL) * 64; LAS unsigned char* b_ = lds + ((t) & 3) * TILE_BYTES + wv * 1024; \
    const char* kt_ = (const char*)Pqk + (size_t)tok * 4096; const char* vt_ = (const char*)Vt + (size_t)tok * 2; \
    __builtin_amdgcn_global_load_lds((const unsigned*)(kt_ + koff), (LAS unsigned*)b_, 16, 0, 0); \
    __builtin_amdgcn_global_load_lds((const unsigned*)(vt_ + voff), (LAS unsigned*)(b_ + KB_BYTES), 16, 0, 0); \
    __builtin_amdgcn_global_load_lds((const unsigned*)(vt_ + (size_t)64 * NTOK * 2 + voff), (LAS unsigned*)(b_ + KB_BYTES + 8192), 16, 0, 0); } while (0)
#define DA_WAITV(n) asm volatile("s_waitcnt vmcnt(" #n ")" ::: "memory")
#define DA_PAIR_BEGIN(t) if (!(ABL & 8) && (t) + 2 < NT) { DA_DMA((t) + 2); DA_DMA((t) + 3); }
#define DA_SLOT(tt) const unsigned sb_ = (unsigned)(((tt) & 3) * TILE_BYTES); const LAS unsigned char* kb_ = lds + (kaddr0 + sb_); const LAS unsigned char* vb_ = lds + (vaddr0 + sb_)
#define DA_PAIR_END() do { DA_WAITV(0); asm volatile("s_waitcnt lgkmcnt(0)" ::: "memory"); if (!(ABL & 16)) __builtin_amdgcn_s_barrier(); } while (0)
  DA_DMA(0); DA_DMA(1);
  float qn2 = 0.f;
#pragma unroll
  for (int ks = 0; ks < 4; ++ks) { const u32x4 w = __builtin_bit_cast(u32x4, qf[ks]);
    qn2 += bflo(w.x) * bflo(w.x) + bfhi(w.x) * bfhi(w.x) + bflo(w.y) * bflo(w.y) + bfhi(w.y) * bfhi(w.y) + bflo(w.z) * bflo(w.z) + bfhi(w.z) * bfhi(w.z) + bflo(w.w) * bflo(w.w) + bfhi(w.w) * bfhi(w.w); }
  { const u32x2 sw = __builtin_amdgcn_permlane32_swap(__float_as_uint(qn2), __float_as_uint(qn2), false, false); qn2 = __uint_as_float(sw.x) + __uint_as_float(sw.y); }
  const float m_stat = sqrtf(qn2 * kmax2) * 1.0001f;
  const bool use_static = __all(m_stat <= 60.0f);
  DA_WAITV(0); __builtin_amdgcn_s_barrier();
#define DA_XOR(ptr, x) ((const LAS unsigned char*)((unsigned)(size_t)(ptr) ^ (unsigned)(x)))
#define DA_KFRAG(ks) const LAS unsigned char* kp_ = DA_XOR(kb_, (ks) << 5); const bf16x8 a0 = (ABL & 2) ? qf[ks] : *(const LAS bf16x8*)kp_, a1 = (ABL & 2) ? qf[(ks) ^ 1] : *(const LAS bf16x8*)(kp_ + 4096)
#define DA_VFRAGS() bf16x8 va[4][4]; \
    _Pragma("unroll") for (int c4 = 0; c4 < 4; ++c4) { const LAS unsigned char* vp_ = DA_XOR(vb_, c4 << 5); \
      _Pragma("unroll") for (int vb = 0; vb < 4; ++vb) va[vb][c4] = (ABL & 1) ? qf[c4 ^ (vb & 3)] : *(const LAS bf16x8*)(vp_ + vb * 4096); }
#define DA_PACK_PV() bf16x8 pf[2][2]; \
    _Pragma("unroll") for (int s = 0; s < 2; ++s) { u32x4 w0, w1; \
      w0.x = cvt_pk_bf16(s0[8 * s + 0], s0[8 * s + 1]); w0.y = cvt_pk_bf16(s0[8 * s + 2], s0[8 * s + 3]); w0.z = cvt_pk_bf16(s0[8 * s + 4], s0[8 * s + 5]); w0.w = cvt_pk_bf16(s0[8 * s + 6], s0[8 * s + 7]); \
      w1.x = cvt_pk_bf16(s1[8 * s + 0], s1[8 * s + 1]); w1.y = cvt_pk_bf16(s1[8 * s + 2], s1[8 * s + 3]); w1.z = cvt_pk_bf16(s1[8 * s + 4], s1[8 * s + 5]); w1.w = cvt_pk_bf16(s1[8 * s + 6], s1[8 * s + 7]); \
      pf[0][s] = __builtin_bit_cast(bf16x8, w0); pf[1][s] = __builtin_bit_cast(bf16x8, w1); } \
    _Pragma("unroll") for (int vb = 0; vb < 4; ++vb) _Pragma("unroll") for (int kb = 0; kb < 2; ++kb) _Pragma("unroll") for (int s = 0; s < 2; ++s) \
      o[vb] = __builtin_amdgcn_mfma_f32_32x32x16_bf16(va[vb][kb * 2 + s], pf[kb][s], o[vb], 0, 0, 0)
  if (use_static) {
    for (int t = 0; t < NT; t += 2) {
      DA_PAIR_BEGIN(t);
#pragma unroll
      for (int u = 0; u < 2; ++u) {
        DA_SLOT(t + u);
        f32x16 s0, s1;
#pragma unroll
        for (int i = 0; i < 16; ++i) { s0[i] = 0.f; s1[i] = 0.f; }
#pragma unroll
        for (int ks = 0; ks < 4; ++ks) { DA_KFRAG(ks); s0 = __builtin_amdgcn_mfma_f32_32x32x16_bf16(a0, qf[ks], s0, 0, 0, 0); s1 = __builtin_amdgcn_mfma_f32_32x32x16_bf16(a1, qf[ks], s1, 0, 0, 0); }
        DA_VFRAGS();
        if constexpr ((ABL & 32) != 0) {
          l_run += s0[0] + s1[0];
#pragma unroll
          for (int vb = 0; vb < 4; ++vb)
#pragma unroll
            for (int c4 = 0; c4 < 4; ++c4) o[vb] = __builtin_amdgcn_mfma_f32_32x32x16_bf16(va[vb][c4], qf[c4], o[vb], 0, 0, 0);
        } else {
          float ps = 0.f;
#pragma unroll
          for (int i = 0; i < 16; ++i) { s0[i] = (ABL & 4) ? s0[i] : __builtin_amdgcn_exp2f(s0[i]); ps += s0[i]; }
#pragma unroll
          for (int i = 0; i < 16; ++i) { s1[i] = (ABL & 4) ? s1[i] : __builtin_amdgcn_exp2f(s1[i]); ps += s1[i]; }
          l_run += ps;
          DA_PACK_PV();
        }
        if (u == 0) __builtin_amdgcn_sched_barrier(0);
      }
      DA_PAIR_END();
    }
  } else {
    constexpr float THR = 8.0f * 1.4426950408889634f;
    float m_run = -1e30f;
    for (int t = 0; t < NT; ++t) {
      if (!(t & 1)) DA_PAIR_BEGIN(t);
      DA_SLOT(t);
      f32x16 s0 = zero16(), s1 = zero16();
#pragma unroll
      for (int ks = 0; ks < 4; ++ks) { DA_KFRAG(ks); s0 = __builtin_amdgcn_mfma_f32_32x32x16_bf16(a0, qf[ks], s0, 0, 0, 0); s1 = __builtin_amdgcn_mfma_f32_32x32x16_bf16(a1, qf[ks], s1, 0, 0, 0); }
      float mx = fmaxf(s0[0], s1[0]);
#pragma unroll
      for (int i = 1; i < 16; ++i) mx = fmaxf(mx, fmaxf(s0[i], s1[i]));
      { const u32x2 sw = __builtin_amdgcn_permlane32_swap(__float_as_uint(mx), __float_as_uint(mx), false, false); mx = fmaxf(__uint_as_float(sw.x), __uint_as_float(sw.y)); }
      float alpha = 1.0f;
      if (!__all(mx - m_run <= THR)) {
        const float m_new = fmaxf(m_run, mx);
        alpha = __builtin_amdgcn_exp2f(m_run - m_new);
        m_run = m_new;
#pragma unroll
        for (int vb = 0; vb < 4; ++vb)
#pragma unroll
          for (int i = 0; i < 16; ++i) o[vb][i] *= alpha;
      }
      float ps = 0.f;
#pragma unroll
      for (int i = 0; i < 16; ++i) { s0[i] = __builtin_amdgcn_exp2f(s0[i] - m_run); ps += s0[i]; }
#pragma unroll
      for (int i = 0; i < 16; ++i) { s1[i] = __builtin_amdgcn_exp2f(s1[i] - m_run); ps += s1[i]; }
      l_run = l_run * alpha + ps;
      __builtin_amdgcn_sched_barrier(0);
      DA_VFRAGS();
      DA_PACK_PV();
      if (t & 1) DA_PAIR_END();
    }
  }
#undef DA_KFRAG
#undef DA_XOR
#undef DA_VFRAGS
#undef DA_PACK_PV
#undef DA_DMA
#undef DA_WAITV
#undef DA_PAIR_BEGIN
#undef DA_PAIR_END
#undef DA_SLOT
  float l_tot; { const u32x2 sw = __builtin_amdgcn_permlane32_swap(__float_as_uint(l_run), __float_as_uint(l_run), false, false); l_tot = __uint_as_float(sw.x) + __uint_as_float(sw.y); }
  const float inv = 1.0f / l_tot;
  const int te = mk::otid();
  bf16_t* op = O12 + (size_t)(q0 + (te >> 6) * 32 + (te & 31)) * 2048 + hh * 128 + 4 * ((te >> 5) & 1);
#pragma unroll
  for (int vb = 0; vb < 4; ++vb)
#pragma unroll
    for (int g = 0; g < 4; ++g) {
      u32x2 w; w.x = cvt_pk_bf16(o[vb][4 * g] * inv, o[vb][4 * g + 1] * inv); w.y = cvt_pk_bf16(o[vb][4 * g + 2] * inv, o[vb][4 * g + 3] * inv);
      *(u32x2*)(op + vb * 32 + 8 * g) = w;
    }
}

__device__ __forceinline__ void diff_combine_rows4(const bf16_t* __restrict__ O12, const float* __restrict__ subln_g, float lam, float oml, bf16_t* __restrict__ O, int row0, int h, int lane) {
  unsigned a[4], b[4];
#pragma unroll
  for (int i = 0; i < 4; ++i) { a[i] = *(const unsigned*)(O12 + (size_t)(row0 + i) * 2048 + (2 * h) * 128 + 2 * lane); b[i] = *(const unsigned*)(O12 + (size_t)(row0 + i) * 2048 + (2 * h + 1) * 128 + 2 * lane); }
  const float g0 = subln_g[2 * lane], g1 = subln_g[2 * lane + 1];
#pragma unroll
  for (int i = 0; i < 4; ++i) {
    const float x0 = bflo(a[i]) - lam * bflo(b[i]), x1 = bfhi(a[i]) - lam * bfhi(b[i]);
    const float ss = wave_sum_u(x0 * x0 + x1 * x1);
    const float rs = rsqrtf(ss * (1.0f / 128.0f) + 1e-5f) * oml;
    *(unsigned*)(O + (size_t)(row0 + i) * 1024 + h * 128 + 2 * lane) = cvt_pk_bf16(x0 * rs * g0, x1 * rs * g1);
  }
}
}

namespace natt {
using namespace mk;
using att::pi32; using att::swz;
constexpr int TB = 64 * 128;
constexpr int NA_LDS = 4 * TB + 2048;
__device__ __forceinline__ void na_attn_unit(const bf16_t* __restrict__ Pe, const bf16_t* __restrict__ Vte, const float* __restrict__ rpb_h, bf16_t* __restrict__ O, int b, int h, int rq, LAS unsigned char* lds) {
  const int tid = mk::otid(), wid = tid >> 6, lane = tid & 63, r = lane & 31, hi = lane >> 5;
  constexpr float LOG2E = 1.4426950408889634f;
  LAS float* sb = (LAS float*)(lds + 4 * TB);
  for (int i = tid; i < 465; i += NTHR) sb[i] = rpb_h[i];
  const bool is_ctx = rq < 0;
  int qrow = 0, qcol = 0, qtok, rs_q = 0, cs_q = 0, span0 = 0, wlo = 0, whi = -1, lo = 0, ntl = 0;
  if (!is_ctx) {
    const int r0 = rq * 4, ra = r0 + (wid >> 2) * 2;
    qrow = ra + (r >> 4); qcol = (wid & 3) * 16 + (r & 15); qtok = b * T + qrow * 64 + qcol;
    rs_q = min(max(qrow - 4, 0), 120); cs_q = min(max(qcol - 8, 0), 48);
    span0 = min(max((wid & 3) * 16 - 8, 0), 32);
    wlo = min(max(ra - 4, 0), 120); whi = min(max(ra - 3, 0), 120) + 7;
    lo = min(max(r0 - 4, 0), 120); const int hi_ = min(max(r0 - 1, 0), 120) + 7; ntl = hi_ - lo + 1;
  } else qtok = NLAT + b * L + wid * 32 + r;
  const int NT = ntl + 4;
  const int srow = tid >> 3, sch = tid & 7;
  const bf16_t* kbase = Pe + 512 + h * 64 + sch * 8;
  const bf16_t* vbase = Vte + (size_t)(h * 64 + srow) * NTOK + sch * 8;
  const int sdst = swz(srow, sch);
  bf16x8 qf[4];
  { const bf16_t* qp = Pe + (size_t)qtok * 1024 + h * 64 + hi * 8;
#pragma unroll
    for (int ks = 0; ks < 4; ++ks) qf[ks] = *(const bf16x8*)(qp + ks * 16); }
  const int kx = (pi32(r) >> 1) & 7, vx = (r >> 1) & 7;
  const int ka_loc = (span0 + pi32(r)) * 128; const int kx_loc = ((span0 + pi32(r)) >> 1) & 7;
  f32x16 o[2];
#pragma unroll
  for (int vb = 0; vb < 2; ++vb)
#pragma unroll
    for (int i = 0; i < 16; ++i) o[vb][i] = 0.f;
  float m_run = -1e30f, l_run = 0.f;
  u32x4 kreg, vreg;
#define NA_LOAD(t) do { const int tok = (t) < ntl ? b * T + (lo + (t)) * 64 : NLAT + b * L + ((t) - ntl) * 64; \
    kreg = *(const u32x4*)(kbase + (size_t)(tok + srow) * 1024); vreg = *(const u32x4*)(vbase + tok); } while (0)
#define NA_WRITE(bufi) do { *(LAS u32x4*)(lds + (bufi) * TB + sdst) = kreg; *(LAS u32x4*)(lds + 2 * TB + (bufi) * TB + sdst) = vreg; } while (0)
  NA_LOAD(0); NA_WRITE(0); __syncthreads();
  for (int t = 0; t < NT; ++t) {
    const bool more = t + 1 < NT;
    if (more) NA_LOAD(t + 1);
    const LAS unsigned char* kb_ = lds + (t & 1) * TB; const LAS unsigned char* vb_ = lds + 2 * TB + (t & 1) * TB;
    const bool local = t < ntl; const int kr = lo + t;
    const bool active = !local || (kr >= wlo && kr <= whi);
    if (active) {
      f32x16 s0, s1;
#pragma unroll
      for (int i = 0; i < 16; ++i) { s0[i] = 0.f; s1[i] = 0.f; }
      if (local) {
#pragma unroll
        for (int ks = 0; ks < 4; ++ks) {
          const bf16x8 a0 = *(const LAS bf16x8*)(kb_ + ka_loc + (((ks * 2 + hi) ^ kx_loc) << 4));
          s0 = __builtin_amdgcn_mfma_f32_32x32x16_bf16(a0, qf[ks], s0, 0, 0, 0);
        }
        const bool row_ok = kr >= rs_q && kr < rs_q + 8; const int dr31 = (kr - qrow + 7) * 31;
#pragma unroll
        for (int i = 0; i < 16; ++i) {
          const int kc = span0 + (i & 7) + 8 * hi + 16 * (i >> 3);
          const bool ok = row_ok && kc >= cs_q && kc < cs_q + 16;
          const int bi = ok ? dr31 + (kc - qcol + 15) : 0;
          const float bv = sb[bi];
          s0[i] = ok ? fmaf(s0[i], 0.125f, bv) : -1e30f; s1[i] = -1e30f;
        }
      } else {
#pragma unroll
        for (int ks = 0; ks < 4; ++ks) {
          const int ch = ((ks * 2 + hi) ^ kx) << 4;
          const bf16x8 a0 = *(const LAS bf16x8*)(kb_ + pi32(r) * 128 + ch), a1 = *(const LAS bf16x8*)(kb_ + (32 + pi32(r)) * 128 + ch);
          s0 = __builtin_amdgcn_mfma_f32_32x32x16_bf16(a0, qf[ks], s0, 0, 0, 0);
          s1 = __builtin_amdgcn_mfma_f32_32x32x16_bf16(a1, qf[ks], s1, 0, 0, 0);
        }
#pragma unroll
        for (int i = 0; i < 16; ++i) { s0[i] *= 0.125f; s1[i] *= 0.125f; }
      }
      float mx = s0[0];
#pragma unroll
      for (int i = 1; i < 16; ++i) mx = fmaxf(mx, s0[i]);
#pragma unroll
      for (int i = 0; i < 16; ++i) mx = fmaxf(mx, s1[i]);
      { const u32x2 sw = __builtin_amdgcn_permlane32_swap(__float_as_uint(mx), __float_as_uint(mx), false, false); mx = fmaxf(__uint_as_float(sw.x), __uint_as_float(sw.y)); }
      const float m_new = fmaxf(m_run, mx);
      const float alpha = __builtin_amdgcn_exp2f((m_run - m_new) * LOG2E);
      m_run = m_new;
      const float mc = -m_new * LOG2E;
      float ps = 0.f;
#pragma unroll
      for (int i = 0; i < 16; ++i) { const float p = s0[i] > -1e29f ? __builtin_amdgcn_exp2f(fmaf(s0[i], LOG2E, mc)) : 0.f; s0[i] = p; ps += p; }
#pragma unroll
      for (int i = 0; i < 16; ++i) { const float p = s1[i] > -1e29f ? __builtin_amdgcn_exp2f(fmaf(s1[i], LOG2E, mc)) : 0.f; s1[i] = p; ps += p; }
      l_run = l_run * alpha + ps;
      if (__any(alpha < 1.0f)) {
#pragma unroll
        for (int vb = 0; vb < 2; ++vb)
#pragma unroll
          for (int i = 0; i < 16; ++i) o[vb][i] *= alpha;
      }
      bf16x8 pf[2][2];
#pragma unroll
      for (int s = 0; s < 2; ++s) {
        u32x4 w0, w1;
        w0.x = cvt_pk_bf16(s0[8 * s + 0], s0[8 * s + 1]); w0.y = cvt_pk_bf16(s0[8 * s + 2], s0[8 * s + 3]); w0.z = cvt_pk_bf16(s0[8 * s + 4], s0[8 * s + 5]); w0.w = cvt_pk_bf16(s0[8 * s + 6], s0[8 * s + 7]);
        w1.x = cvt_pk_bf16(s1[8 * s + 0], s1[8 * s + 1]); w1.y = cvt_pk_bf16(s1[8 * s + 2], s1[8 * s + 3]); w1.z = cvt_pk_bf16(s1[8 * s + 4], s1[8 * s + 5]); w1.w = cvt_pk_bf16(s1[8 * s + 6], s1[8 * s + 7]);
        pf[0][s] = __builtin_bit_cast(bf16x8, w0); pf[1][s] = __builtin_bit_cast(bf16x8, w1);
      }
      const int cbase = local ? (span0 >> 3) : 0;
#pragma unroll
      for (int vb = 0; vb < 2; ++vb) {
        const LAS unsigned char* vrow = vb_ + (vb * 32 + r) * 128;
#pragma unroll
        for (int s = 0; s < 2; ++s) {
          const bf16x8 a = *(const LAS bf16x8*)(vrow + (((cbase + 2 * s + hi) ^ vx) << 4));
          o[vb] = __builtin_amdgcn_mfma_f32_32x32x16_bf16(a, pf[0][s], o[vb], 0, 0, 0);
        }
        if (!local) {
#pragma unroll
          for (int s = 0; s < 2; ++s) {
            const bf16x8 a = *(const LAS bf16x8*)(vrow + (((4 + 2 * s + hi) ^ vx) << 4));
            o[vb] = __builtin_amdgcn_mfma_f32_32x32x16_bf16(a, pf[1][s], o[vb], 0, 0, 0);
          }
        }
      }
    }
    if (more) NA_WRITE((t + 1) & 1);
    __syncthreads();
  }
#undef NA_LOAD
#undef NA_WRITE
  float l_tot; { const u32x2 sw = __builtin_amdgcn_permlane32_swap(__float_as_uint(l_run), __float_as_uint(l_run), false, false); l_tot = __uint_as_float(sw.x) + __uint_as_float(sw.y); }
  const float inv = 1.0f / l_tot;
  bf16_t* op = O + (size_t)qtok * 1024 + h * 64 + 4 * hi;
#pragma unroll
  for (int vb = 0; vb < 2; ++vb)
#pragma unroll
    for (int g = 0; g < 4; ++g) {
      u32x2 w; w.x = cvt_pk_bf16(o[vb][4 * g] * inv, o[vb][4 * g + 1] * inv); w.y = cvt_pk_bf16(o[vb][4 * g + 2] * inv, o[vb][4 * g + 3] * inv);
      *(u32x2*)(op + vb * 32 + 8 * g) = w;
    }
}
}

namespace rw {
using namespace mk;
constexpr int NSTEP = L + T, NCH = 32, CL = NSTEP / NCH;
constexpr int NCHAIN = 2 * B * 8;
constexpr float LOG2E = 1.4426950408889634f;
struct Bufs {
  u32x2* SH;
  unsigned* DR;
  bf16_t* G; int gstride;
  float* CS;
  float* PQ;
  float* SST;
  bf16_t* Y;
  bf16_t* Z;
};

constexpr int XPITCH = 528;
__device__ __forceinline__ void lora_mfma(const LAS unsigned char* xb, int xcol0, const bf16_t* __restrict__ W, int K, int h, int lane, LAS float* tw, float (&out)[16]) {
  const int fr = lane & 15, fq = lane >> 4;
  f32x4 acc[4];
#pragma unroll
  for (int nb = 0; nb < 4; ++nb) { float z = 0.f; asm volatile("" : "+v"(z)); acc[nb] = (f32x4){z, z, z, z}; }
  for (int ks = 0; ks < K / 32; ++ks) {
    const bf16x8 xf = *(const LAS bf16x8*)(xb + fr * XPITCH + (xcol0 + ks * 32 + fq * 8) * 2);
    bf16x8 wf[4];
#pragma unroll
    for (int nb = 0; nb < 4; ++nb) wf[nb] = *(const bf16x8*)(W + (size_t)(h * 64 + nb * 16 + fr) * K + ks * 32 + fq * 8);
#pragma unroll
    for (int nb = 0; nb < 4; ++nb) acc[nb] = __builtin_amdgcn_mfma_f32_16x16x32_bf16(xf, wf[nb], acc[nb], 0, 0, 0);
  }
#pragma unroll
  for (int nb = 0; nb < 4; ++nb) *(LAS f32x4*)(tw + (nb * 16 + fr) * 16 + fq * 4) = acc[nb];
  __builtin_amdgcn_wave_barrier(); asm volatile("s_waitcnt lgkmcnt(0)" ::: "memory"); __builtin_amdgcn_wave_barrier();
#pragma unroll
  for (int q = 0; q < 4; ++q) { const f32x4 v = *(const LAS f32x4*)(tw + lane * 16 + q * 4); out[q * 4] = v[0]; out[q * 4 + 1] = v[1]; out[q * 4 + 2] = v[2]; out[q * 4 + 3] = v[3]; }
  __builtin_amdgcn_wave_barrier(); asm volatile("s_waitcnt lgkmcnt(0)" ::: "memory"); __builtin_amdgcn_wave_barrier();
}
__device__ __forceinline__ void prep_tile(const bf16_t* __restrict__ Prw, const float* __restrict__ cw, const float* __restrict__ w0, const bf16_t* __restrict__ WLT, const float* __restrict__ a0,
                                          const float* __restrict__ k_k, const float* __restrict__ k_a, const float* __restrict__ r_k,
                                          const Bufs& bf, int tile, LAS float* xs  ) {
  const int c = mk::otid(), lane = c & 63, h = c >> 6;
  const int row0 = tile * 16;
  int lo, hi;
  if (row0 < NLAT) { lo = (row0 / T) * T; hi = lo + T - 1; } else { lo = NLAT + ((row0 - NLAT) / L) * L; hi = lo + L - 1; }
#define RW_CONV(dst, col) do { const float c0 = cw[(col)], c1 = cw[RW_IN + (col)], c2 = cw[2 * RW_IN + (col)]; const bf16_t* p = Prw + (col); \
    bf16_t raw[18]; \
    _Pragma("unroll") for (int j = 0; j < 18; ++j) { int rr = row0 - 1 + j; rr = rr < lo ? lo : (rr > hi ? hi : rr); raw[j] = p[(size_t)rr * RW_IN]; } \
    float pm = row0 > lo ? bf2f(raw[0]) : 0.f, pc = bf2f(raw[1]); \
    _Pragma("unroll") for (int tt = 0; tt < 16; ++tt) { const float pn = (row0 + tt + 1 <= hi) ? bf2f(raw[tt + 2]) : 0.f; dst[tt] = pm * c0 + pc * c1 + pn * c2; pm = pc; pc = pn; } } while (0)
  if (c < 256) {
    float xv[16]; RW_CONV(xv, 1536 + c);
#pragma unroll
    for (int tt = 0; tt < 16; ++tt) { float v = xv[tt]; if (c < 64) v = tanhf(v); else if (c >= 128) v = sigmoidf_(v); *(LAS bf16_t*)((LAS unsigned char*)xs + tt * XPITCH + c * 2) = f2bf(v); }
  }
  __syncthreads();
  const LAS unsigned char* xb = (const LAS unsigned char*)xs; LAS float* tw = xs + 20480 + h * 1024;
  const float w00 = w0[c], w01 = w0[512 + c], a00 = a0[c], a01 = a0[512 + c], kkc = k_k[c], kac = k_a[c], rkc = r_k[c];
  float e0[16], e1[16];
  {
    float aw0[16], aw1[16];
    lora_mfma(xb, 0, WLT, 64, h, lane, tw, aw0); lora_mfma(xb, 0, WLT + 32768, 64, h, lane, tw, aw1);
#pragma unroll
    for (int tt = 0; tt < 16; ++tt) {
      e0[tt] = 0.6065306597126334f * __builtin_amdgcn_rcpf(1.0f + __expf(-(w00 + aw0[tt])));
      e1[tt] = 0.6065306597126334f * __builtin_amdgcn_rcpf(1.0f + __expf(-(w01 + aw1[tt])));
    }
  }
  LAS float* asl = xs + 256 * 16;
  {
    float aa0[16], aa1[16];
    lora_mfma(xb, 64, WLT + 2 * 32768, 64, h, lane, tw, aa0); lora_mfma(xb, 64, WLT + 3 * 32768, 64, h, lane, tw, aa1);
#pragma unroll
    for (int tt = 0; tt < 16; ++tt) { const unsigned d0 = cvt_pk_bf16(e0[tt], sigmoidf_(a00 + aa0[tt])), d1 = cvt_pk_bf16(e1[tt], sigmoidf_(a01 + aa1[tt]));
      bf.DR[((size_t)(row0 + tt)) * 512 + c] = d0; bf.DR[((size_t)NTOK + row0 + tt) * 512 + c] = d1; asl[tt * 512 + c] = bfhi(d0); asl[(16 + tt) * 512 + c] = bfhi(d1); }
  }
  {
    float ag[16];
    lora_mfma(xb, 128, WLT + 4 * 32768, 128, h, lane, tw, ag);
#pragma unroll
    for (int tt = 0; tt < 16; ++tt) bf.G[(size_t)(row0 + tt) * bf.gstride + c] = f2bf(ag[tt]);
  }
#undef RW_CONV
  const float cr0 = cw[c], cr1 = cw[RW_IN + c], cr2 = cw[2 * RW_IN + c], ck0 = cw[512 + c], ck1 = cw[RW_IN + 512 + c], ck2 = cw[2 * RW_IN + 512 + c], cv0 = cw[1024 + c], cv1 = cw[RW_IN + 1024 + c], cv2 = cw[2 * RW_IN + 1024 + c];
  const bf16_t* pr = Prw + (size_t)row0 * RW_IN + c;
  const bf16_t* prm = Prw + (size_t)(row0 > lo ? row0 - 1 : row0) * RW_IN + c;
  const bf16_t rm_ = prm[0], km_ = prm[512], vm_ = prm[1024];
  float rm = row0 > lo ? bf2f(rm_) : 0.f, km = row0 > lo ? bf2f(km_) : 0.f, vm = row0 > lo ? bf2f(vm_) : 0.f;
  float rc = bf2f(pr[0]), kc = bf2f(pr[512]), vc = bf2f(pr[1024]);
#pragma unroll 2
  for (int tt = 0; tt < 16; ++tt) {
    const int row = row0 + tt;
    const bool has_n = row + 1 <= hi; const bf16_t* pn = pr + (size_t)(has_n ? tt + 1 : tt) * RW_IN;
    const bf16_t rn_ = pn[0], kn_ = pn[512], vn_ = pn[1024];
    const float rn = has_n ? bf2f(rn_) : 0.f, kn = has_n ? bf2f(kn_) : 0.f, vn = has_n ? bf2f(vn_) : 0.f;
    const float rv = rm * cr0 + rc * cr1 + rn * cr2, kvv = km * ck0 + kc * ck1 + kn * ck2, vvv = vm * cv0 + vc * cv1 + vn * cv2;
    rm = rc; rc = rn; km = kc; kc = kn; vm = vc; vc = vn;
    float kk = kvv * kkc; const float nrm = sqrtf(wave_sum_u(kk * kk)); kk = kk * __builtin_amdgcn_rcpf(fmaxf(nrm, 1e-12f));
    u32x2 sh; sh.x = cvt_pk_bf16(rv, kvv); sh.y = cvt_pk_bf16(kk, vvv);
    bf.SH[(size_t)row * 512 + c] = sh;
    const float rq = bflo(sh.x), kq = bfhi(sh.x);
    const float cb0 = wave_sum_u(rq * kq * (1.0f + (asl[tt * 512 + c] - 1.0f) * kac) * rkc), cb1 = wave_sum_u(rq * kq * (1.0f + (asl[(16 + tt) * 512 + c] - 1.0f) * kac) * rkc);
    if (lane == 0) { bf.CS[(size_t)row * 16 + h] = cb0; bf.CS[(size_t)row * 16 + 8 + h] = cb1; }
  }
  __syncthreads();
}

struct StepRaw { u32x2 s; unsigned d; };
__device__ __forceinline__ int scan_row(int dir, int b, int p) {
  if (p < L) return NLAT + b * L + (dir ? (L - 1 - p) : p);
  const int q = p - L; return b * T + (dir ? (T - 1 - q) : q);
}
#define RW_RL(x, j) __int_as_float(__builtin_amdgcn_readlane(__float_as_int(x), (j)))
__device__ __forceinline__ void scan_unit(const Bufs& bf, const float* __restrict__ k_a, int chain, int chunk, LAS float* wl  ) {
  const int lane = mk::otid() & 63;
  const int dir = chain >> 5, b = (chain >> 3) & 3, h = chain & 7, ch = h * 64 + lane;
  const float kac = k_a[ch];
  float S[64], P[64];
#pragma unroll
  for (int j = 0; j < 64; ++j) { S[j] = 0.f; P[j] = (j == lane) ? 1.f : 0.f; }
  const int p0 = chunk * CL;
  StepRaw nx; { const int row = scan_row(dir, b, p0); nx.s = bf.SH[(size_t)row * 512 + ch]; nx.d = bf.DR[((size_t)dir * NTOK + row) * 512 + ch]; }
  for (int s = 0; s < CL; ++s) {
    const StepRaw cu = nx; const int row = scan_row(dir, b, p0 + s);
    if (s + 1 < CL) { const int rn = scan_row(dir, b, p0 + s + 1); nx.s = bf.SH[(size_t)rn * 512 + ch]; nx.d = bf.DR[((size_t)dir * NTOK + rn) * 512 + ch]; }
    const float r = bflo(cu.s.x), k = bfhi(cu.s.x), kk = bflo(cu.s.y), v = bfhi(cu.s.y), e = bflo(cu.d), asg = bfhi(cu.d);
    const float w = __builtin_amdgcn_exp2f(-e * LOG2E), a = -kk, bb = kk * asg, keff = k * (1.0f + (asg - 1.0f) * kac);
    wl[lane] = a; wl[64 + lane] = w; wl[128 + lane] = bb; wl[192 + lane] = keff; wl[256 + lane] = r;
    float sa = 0.f, sap = 0.f;
#pragma unroll
    for (int j4 = 0; j4 < 16; ++j4) { const f32x4 av = *(const LAS f32x4*)(wl + 4 * j4);
#pragma unroll
      for (int e2 = 0; e2 < 4; ++e2) { sa = fmaf(S[4 * j4 + e2], av[e2], sa); sap = fmaf(P[4 * j4 + e2], av[e2], sap); } }
    float y = 0.f, z = 0.f;
#pragma unroll
    for (int j4 = 0; j4 < 16; ++j4) {
      const f32x4 wv = *(const LAS f32x4*)(wl + 64 + 4 * j4), bv = *(const LAS f32x4*)(wl + 128 + 4 * j4), kv = *(const LAS f32x4*)(wl + 192 + 4 * j4), rv = *(const LAS f32x4*)(wl + 256 + 4 * j4);
#pragma unroll
      for (int e2 = 0; e2 < 4; ++e2) { const int j = 4 * j4 + e2;
        float t = v * kv[e2]; t = fmaf(sa, bv[e2], t); S[j] = fmaf(S[j], wv[e2], t);
        P[j] = fmaf(P[j], wv[e2], sap * bv[e2]);
        y = fmaf(S[j], rv[e2], y); z = fmaf(P[j], rv[e2], z); }
    }
    const size_t oi = ((size_t)dir * NTOK + row) * 512 + ch;
    bf.Y[oi] = f2bf(y); bf.Z[oi] = f2bf(z);
  }
  if (chunk < NCH - 1) {
    float* pq = bf.PQ + (((size_t)chain * (NCH - 1) + chunk) * 2) * 4096 + lane * 64;
#pragma unroll
    for (int q = 0; q < 16; ++q) { *(f32x4*)(pq + q * 4) = (f32x4){P[q * 4], P[q * 4 + 1], P[q * 4 + 2], P[q * 4 + 3]}; *(f32x4*)(pq + 4096 + q * 4) = (f32x4){S[q * 4], S[q * 4 + 1], S[q * 4 + 2], S[q * 4 + 3]}; }
  }
}

__device__ __forceinline__ void propagate_chain(const Bufs& bf, int chain, int rq, LAS float* lds) {
  LAS float* Sl = lds; LAS float* Pl = lds + 16 * 65 + 15;
  Pl = lds + 1056;
  const int tid = mk::otid(), i = tid >> 5, jc = (tid & 31) * 2, row = rq * 16 + i, pi = tid >> 3, pj = (tid & 7) * 8;
  float* sst = bf.SST + (size_t)chain * NCH * 4096;
  Sl[i * 65 + jc] = 0.f; Sl[i * 65 + jc + 1] = 0.f;
  const float* pb = bf.PQ + ((size_t)chain * (NCH - 1) * 2) * 4096;
  f32x4 np0 = *(const f32x4*)(pb + pi * 64 + pj), np1 = *(const f32x4*)(pb + pi * 64 + pj + 4); f32x2 nq = *(const f32x2*)(pb + 4096 + row * 64 + jc);
  for (int c = 0; c < NCH - 1; ++c) {
    const f32x4 p0 = np0, p1 = np1; f32x2 q = nq;
    { const float* pn = pb + (size_t)(c + 1 < NCH - 1 ? c + 1 : c) * 2 * 4096;
      np0 = *(const f32x4*)(pn + pi * 64 + pj); np1 = *(const f32x4*)(pn + pi * 64 + pj + 4); nq = *(const f32x2*)(pn + 4096 + row * 64 + jc); }
    *(LAS f32x4*)(Pl + pi * 64 + pj) = p0; *(LAS f32x4*)(Pl + pi * 64 + pj + 4) = p1;
    __syncthreads();
#pragma unroll 16
    for (int k = 0; k < 64; ++k) { const float sv = Sl[i * 65 + k]; const f32x2 a = *(const LAS f32x2*)(Pl + k * 64 + jc); q += sv * a; }
    __syncthreads();
    Sl[i * 65 + jc] = q[0]; Sl[i * 65 + jc + 1] = q[1];
    *(f32x2*)(sst + (size_t)(c + 1) * 4096 + row * 64 + jc) = q;
  }
  __syncthreads();
}

__device__ __forceinline__ void corr_unit(const Bufs& bf, int chain, int chunk) {
  const int lane = mk::otid() & 63, r = lane & 31, hi = lane >> 5;
  const int dir = chain >> 5, b = (chain >> 3) & 3, h = chain & 7;
  const float* ss = bf.SST + ((size_t)chain * NCH + chunk) * 4096;
  bf16x8 bfr[2][4];
#pragma unroll
  for (int nt = 0; nt < 2; ++nt)
#pragma unroll
    for (int ks = 0; ks < 4; ++ks) { const float* q = ss + (size_t)(nt * 32 + r) * 64 + ks * 16 + hi * 8; const f32x4 x0 = *(const f32x4*)q, x1 = *(const f32x4*)(q + 4);
      u32x4 w; w.x = cvt_pk_bf16(x0[0], x0[1]); w.y = cvt_pk_bf16(x0[2], x0[3]); w.z = cvt_pk_bf16(x1[0], x1[1]); w.w = cvt_pk_bf16(x1[2], x1[3]); bfr[nt][ks] = __builtin_bit_cast(bf16x8, w); }
  const int p0 = chunk * CL;
  const size_t dbase = (size_t)dir * NTOK;
  for (int mt = 0; mt < (CL + 31) / 32; ++mt) {
    const int sa_ = min(mt * 32 + r, CL - 1);
    const bf16_t* zp = bf.Z + (dbase + scan_row(dir, b, p0 + sa_)) * 512 + h * 64 + hi * 8;
    bf16x8 af[4];
#pragma unroll
    for (int ks = 0; ks < 4; ++ks) af[ks] = *(const bf16x8*)(zp + ks * 16);
    f32x16 acc[2];
#pragma unroll
    for (int nt = 0; nt < 2; ++nt) { acc[nt] = zero16();
#pragma unroll
      for (int ks = 0; ks < 4; ++ks) acc[nt] = __builtin_amdgcn_mfma_f32_32x32x16_bf16(af[ks], bfr[nt][ks], acc[nt], 0, 0, 0); }
#pragma unroll
    for (int i = 0; i < 16; ++i) { const int so = mt * 32 + (i & 3) + 8 * (i >> 2) + 4 * hi;
      if (so < CL) { bf16_t* yp = bf.Y + (dbase + scan_row(dir, b, p0 + so)) * 512 + h * 64 + r;
        yp[0] = f2bf(bf2f(yp[0]) + acc[0][i]); yp[32] = f2bf(bf2f(yp[32]) + acc[1][i]); } }
  }
}

template <int NR>
__device__ __forceinline__ void finish_rows(const Bufs& bf, const float* __restrict__ gn_g, const float* __restrict__ gn_b, bf16_t* __restrict__ O, int row0) {
  const int c = mk::otid(), h = c >> 6;
  float y[NR], v[NR], g[NR], cs[NR];
#pragma unroll
  for (int i = 0; i < NR; ++i) { const int row = row0 + i;
    y[i] = bf2f(bf.Y[(size_t)row * 512 + c]) + bf2f(bf.Y[((size_t)NTOK + row) * 512 + c]);
    v[i] = bfhi(bf.SH[(size_t)row * 512 + c].y); g[i] = bf2f(bf.G[(size_t)row * bf.gstride + c]);
    cs[i] = bf.CS[(size_t)row * 16 + h] + bf.CS[(size_t)row * 16 + 8 + h]; }
  const float gg = gn_g[c], gb = gn_b[c];
  float o[NR];
#pragma unroll
  for (int i = 0; i < NR; ++i) { const float mu = wave_sum_u(y[i]) * (1.0f / 64.0f); const float dv = y[i] - mu; const float var = wave_sum_u(dv * dv) * (1.0f / 64.0f);
    o[i] = (dv * rsqrtf(var + 64e-5f) * gg + gb + cs[i] * v[i]) * g[i]; }
#pragma unroll
  for (int i = 0; i < NR; ++i) O[(size_t)(row0 + i) * 1024 + 512 + c] = f2bf(o[i]);
}
}

namespace mk {
constexpr size_t al256(size_t x) { return (x + 255) / 256 * 256; }
constexpr size_t WS_BAR = 0;
constexpr size_t WS_BCNT = al256(WS_BAR + (size_t)XCD_BAR_WORDS * 4);
constexpr size_t WS_MOFF = al256(WS_BCNT + (size_t)4 * 256 * 64 * 4);
constexpr size_t WS_KN = al256(WS_MOFF + 4 * 256);
constexpr size_t WS_MOD = al256(WS_KN + (size_t)2 * 256 * 16 * 4);
constexpr size_t WS_ROPE = al256(WS_MOD + (size_t)4 * 5 * 6144 * 4);
constexpr size_t WS_HBC = al256(WS_ROPE + 128 * 16 * 2 * 4);
constexpr size_t WS_EID = al256(WS_HBC + (size_t)NCTX * D * 2);
constexpr size_t WS_GATE = al256(WS_EID + (size_t)NTOK * 2 * 4);
constexpr size_t WS_POS = al256(WS_GATE + (size_t)NTOK * 2 * 4);
constexpr size_t WS_RL = al256(WS_POS + (size_t)NTOK * 2 * 4);
constexpr size_t WS_WEIN = al256(WS_RL + (size_t)MOE_ROWS * 4);
constexpr size_t WS_WOIN = al256(WS_WEIN + (size_t)2 * EVEN_IN * D * 2);
constexpr size_t WS_WEOUT = al256(WS_WOIN + (size_t)2 * ODD_IN * D * 2);
constexpr size_t WS_WOOUT = al256(WS_WEOUT + (size_t)2 * D * D * 2);
constexpr size_t WS_WGU = al256(WS_WOOUT + (size_t)2 * D * D * 2);
constexpr size_t WS_WDN = al256(WS_WGU + (size_t)NE * 1024 * D * 2);
constexpr size_t WS_WLT = al256(WS_WDN + (size_t)NE * D * DE * 2);
constexpr size_t WS_UO = al256(WS_WLT + (size_t)2 * 196608 * 2);
constexpr size_t WS_SCR = al256(WS_UO + (size_t)NTOK * D * 2);
constexpr size_t SE_PQK = 0;
constexpr size_t SE_VT = al256(SE_PQK + (size_t)NTOK * 1024 * 2);
constexpr size_t SE_PRW = al256(SE_VT + (size_t)512 * NTOK * 2);
constexpr size_t SE_PQ = 0;
constexpr size_t SE_SST = al256(SE_PQ + (size_t)rw::NCHAIN * (rw::NCH - 1) * 2 * 4096 * 4);
constexpr size_t SE_Y = al256(SE_SST + (size_t)rw::NCHAIN * rw::NCH * 4096 * 4);
constexpr size_t SE_Z = al256(SE_Y + (size_t)2 * NTOK * 512 * 2);
constexpr size_t SE_ZEND = al256(SE_Z + (size_t)2 * NTOK * 512 * 2);
constexpr size_t SE_PRWEND = al256(SE_PRW + (size_t)NTOK * RW_IN * 2);
constexpr size_t SE_SH = SE_PRWEND > SE_ZEND ? SE_PRWEND : SE_ZEND;
constexpr size_t SE_DR = al256(SE_SH + (size_t)NTOK * 512 * 8);
constexpr size_t SE_CS = al256(SE_DR + (size_t)2 * NTOK * 512 * 4);
constexpr size_t SE_END = al256(SE_CS + (size_t)2 * NTOK * 16 * 4);
constexpr size_t SE_YBUF = 0;
constexpr size_t SO_PQK = 0;
constexpr size_t SO_VT = al256(SO_PQK + (size_t)NTOK * 2048 * 2);
constexpr size_t SO_O12 = al256(SO_VT + (size_t)1024 * NTOK * 2);
constexpr size_t SO_END = al256(SO_O12 + (size_t)NTOK * 2048 * 2);
constexpr size_t SO_YBUF = 0;
constexpr size_t SM_XS = 0;
constexpr size_t SM_HE = al256(SM_XS + (size_t)MOE_ROWS * D * 2);
constexpr size_t SM_YS = al256(SM_HE + (size_t)MOE_ROWS * DE * 2);
constexpr size_t SM_END = al256(SM_YS + (size_t)MOE_ROWS * D * 2);
constexpr size_t SCR_BYTES = SE_END > SO_END ? (SE_END > SM_END ? SE_END : SM_END) : (SO_END > SM_END ? SO_END : SM_END);
constexpr size_t WS_END = WS_SCR + SCR_BYTES;
constexpr int LDS_BARW = 131072;
constexpr int LDS_MISC = 131072 + 64;

struct Params {
  const float *x, *c, *ctx, *c_ctx, *ada_w, *ada_b, *ln_g, *ln_b, *even_w_in, *even_w_out, *shift_w, *na_rpb, *rw_w0, *rw_w_up, *rw_a0, *rw_a_up, *rw_g_up, *rw_k_k, *rw_k_a, *rw_r_k,
      *rw_gn_g, *rw_gn_b, *odd_w_in, *odd_w_out, *da_lq1, *da_lk1, *da_lq2, *da_lk2, *da_subln_g, *router_w, *router_b, *exp_w_gate, *exp_w_up, *exp_w_down;
  float* out; unsigned char* ws; int ph_lo, ph_hi;
};
template <class Tp> __device__ __forceinline__ Tp* wsp(const Params& p, size_t off) { return (Tp*)(p.ws + off); }

__device__ __forceinline__ void ada_unit(const Params& p, int u, LAS float* lds) {
  LAS float* sc = lds; LAS float* red = lds + 5 * 1024;
  const int tid = mk::otid(), l = u / 96, n = (u % 96) * 64 + (tid & 63), kp = tid >> 6;
  for (int i = tid; i < 5 * 1024; i += NTHR) { const float v = i < 4096 ? p.c[i] : p.c_ctx[i - 4096]; sc[i] = siluf_(v); }
  __syncthreads();
  float a[5] = {0.f, 0.f, 0.f, 0.f, 0.f};
  const float* w = p.ada_w + ((size_t)l * D + kp * 128) * 6144 + n;
#pragma unroll 4
  for (int k = 0; k < 128; ++k) { const float wv = w[(size_t)k * 6144]; const int kk = kp * 128 + k;
#pragma unroll
    for (int r = 0; r < 5; ++r) a[r] = fmaf(sc[r * 1024 + kk], wv, a[r]); }
#pragma unroll
  for (int r = 0; r < 5; ++r) red[(kp * 5 + r) * 64 + (tid & 63)] = a[r];
  __syncthreads();
  if (tid < 320) { const int r = tid >> 6, nn = tid & 63; float s = 0.f;
#pragma unroll
    for (int q = 0; q < 8; ++q) s += red[(q * 5 + r) * 64 + nn];
    const int col = (u % 96) * 64 + nn;
    wsp<float>(p, WS_MOD)[((size_t)l * 5 + r) * 6144 + col] = s + p.ada_b[l * 6144 + col]; }
  __syncthreads();
}
__device__ __forceinline__ void phase_prologue(const Params& p, LAS unsigned char* lds) {
  const int bid = mk::obid(), nb = gridDim.x; LAS float* tile = (LAS float*)lds;
  int ub = 0;
  for (int i = 0; i < 2; ++i) ub += cvt_matrix(p.even_w_in + (size_t)i * D * EVEN_IN, EVEN_IN, D, EVEN_IN, wsp<bf16_t>(p, WS_WEIN) + (size_t)i * EVEN_IN * D, NMapId{0}, tile, ub, bid, nb);
  for (int i = 0; i < 2; ++i) ub += cvt_matrix(p.odd_w_in + (size_t)i * D * ODD_IN, ODD_IN, D, ODD_IN, wsp<bf16_t>(p, WS_WOIN) + (size_t)i * ODD_IN * D, NMapRope{}, tile, ub, bid, nb);
  for (int i = 0; i < 2; ++i) ub += cvt_matrix(p.even_w_out + (size_t)i * D * D, D, D, D, wsp<bf16_t>(p, WS_WEOUT) + (size_t)i * D * D, NMapId{0}, tile, ub, bid, nb);
  for (int i = 0; i < 2; ++i) ub += cvt_matrix(p.odd_w_out + (size_t)i * D * D, D, D, D, wsp<bf16_t>(p, WS_WOOUT) + (size_t)i * D * D, NMapId{0}, tile, ub, bid, nb);
  for (int i = 0; i < 2; ++i) { bf16_t* wl = wsp<bf16_t>(p, WS_WLT) + (size_t)i * 196608;
    for (int d = 0; d < 2; ++d) { ub += cvt_matrix(p.rw_w_up + (size_t)(i * 2 + d) * 64 * 512, 512, 64, 512, wl + (size_t)d * 32768, NMapId{0}, tile, ub, bid, nb);
      ub += cvt_matrix(p.rw_a_up + (size_t)(i * 2 + d) * 64 * 512, 512, 64, 512, wl + (size_t)(2 + d) * 32768, NMapId{0}, tile, ub, bid, nb); }
    ub += cvt_matrix(p.rw_g_up + (size_t)i * 128 * 512, 512, 128, 512, wl + (size_t)4 * 32768, NMapId{0}, tile, ub, bid, nb); }
  for (int u = (bid + nb - ub % nb) % nb; u < 384; u += nb) ada_unit(p, u, (LAS float*)lds);
  const int gt = bid * NTHR + mk::otid();
  if (gt < 128 * 16) { const int pos = gt >> 4, i = gt & 15; const float inv = exp2f(-(float)i * (13.287712379549449f / 16.0f)); float sn, cs; sincosf((float)pos * inv, &sn, &cs);
    wsp<float>(p, WS_ROPE)[gt * 2] = cs; wsp<float>(p, WS_ROPE)[gt * 2 + 1] = sn; }
}
__device__ __forceinline__ void cvt_experts(const Params& p, int l, LAS float* tile, int b0) {
  const int bid = mk::obid() - b0, nb = (int)gridDim.x - b0; int ub = 0;
  if (bid < 0) return;
  for (int e = 0; e < NE; ++e) {
    const size_t so = ((size_t)l * NE + e) * D * DE;
    ub += cvt_matrix(p.exp_w_gate + so, DE, D, DE, wsp<bf16_t>(p, WS_WGU) + (size_t)e * 1024 * D, NMapInterleave{0}, tile, ub, bid, nb);
    ub += cvt_matrix(p.exp_w_up + so, DE, D, DE, wsp<bf16_t>(p, WS_WGU) + (size_t)e * 1024 * D, NMapInterleave{1}, tile, ub, bid, nb);
    ub += cvt_matrix(p.exp_w_down + so, D, DE, D, wsp<bf16_t>(p, WS_WDN) + (size_t)e * D * DE, NMapId{0}, tile, ub, bid, nb);
  }
}

__device__ __forceinline__ bf16_t* hb_ptr(const Params& p, int row, bool alt) {
  if (alt) return wsp<bf16_t>(p, WS_SCR + SM_END) + (size_t)row * D;
  return row < NLAT ? (bf16_t*)p.out + (size_t)row * D : wsp<bf16_t>(p, WS_HBC) + (size_t)(row - NLAT) * D;
}
__device__ __forceinline__ const float* h0_ptr(const Params& p, int row) { return row < NLAT ? p.x + (size_t)row * D : p.ctx + (size_t)(row - NLAT) * D; }
__device__ __forceinline__ void store_bf16x4(bf16_t* dst, f32x4 v) { u32x2 w; w.x = cvt_pk_bf16(v[0], v[1]); w.y = cvt_pk_bf16(v[2], v[3]); *(u32x2*)dst = w; }
__device__ __forceinline__ f32x4 load_bf16x4(const bf16_t* src) { const u32x2 w = *(const u32x2*)src; return (f32x4){bflo(w.x), bfhi(w.x), bflo(w.y), bfhi(w.y)}; }

__device__ __forceinline__ void phase_mod0(const Params& p) {
  const int lane = mk::otid() & 63, wid = mk::otid() >> 6;
  bf16_t* U = wsp<bf16_t>(p, WS_UO);
  for (int row = mk::obid() * 8 + wid; row < NTOK; row += gridDim.x * 8) {
    const float* h = h0_ptr(p, row); const float* modl = wsp<float>(p, WS_MOD) + (size_t)bidx_of_row(row) * 6144;
#pragma unroll
    for (int q = 0; q < 4; ++q) { const int col = q * 256 + lane * 4; const f32x4 hv = *(const f32x4*)(h + col), sh = *(const f32x4*)(modl + col), sc = *(const f32x4*)(modl + 1024 + col);
      store_bf16x4(U + (size_t)row * D + col, hv * (1.0f + sc) + sh); }
  }
}
__device__ __forceinline__ void ln_row(f32x4 (&v)[4], const float* __restrict__ g, const float* __restrict__ b, int lane) {
  float s = 0.f;
#pragma unroll
  for (int q = 0; q < 4; ++q) s += (v[q][0] + v[q][1]) + (v[q][2] + v[q][3]);
  const float mu = wave_sum_u(s) * (1.0f / D);
  float qq = 0.f;
#pragma unroll
  for (int q = 0; q < 4; ++q) { const f32x4 d = v[q] - mu; qq += (d[0] * d[0] + d[1] * d[1]) + (d[2] * d[2] + d[3] * d[3]); }
  const float rstd = rsqrtf(wave_sum_u(qq) * (1.0f / D) + LN_EPS);
#pragma unroll
  for (int q = 0; q < 4; ++q) { const int col = q * 256 + lane * 4; v[q] = (v[q] - mu) * rstd * *(const f32x4*)(g + col) + *(const f32x4*)(b + col); }
}
template <bool F32IN> struct Ln1Raw;
template <> struct Ln1Raw<true> { f32x4 h[4]; u32x2 y[4]; };
template <> struct Ln1Raw<false> { u32x2 h[4]; u32x2 y[4]; };
__device__ __forceinline__ f32x4 h_as_f32(f32x4 v) { return v; }
__device__ __forceinline__ f32x4 h_as_f32(u32x2 w) { return (f32x4){bflo(w.x), bfhi(w.x), bflo(w.y), bfhi(w.y)}; }
template <bool F32IN>
__device__ __forceinline__ void ln1_load(const Params& p, const bf16_t* __restrict__ Ybuf, int row, int lane, Ln1Raw<F32IN>& r) {
#pragma unroll
  for (int q = 0; q < 4; ++q) { const int col = q * 256 + lane * 4;
    if constexpr (F32IN) r.h[q] = *(const f32x4*)(h0_ptr(p, row) + col); else r.h[q] = *(const u32x2*)(hb_ptr(p, row, false) + col);
    r.y[q] = *(const u32x2*)(Ybuf + (size_t)row * D + col); }
}
template <bool F32IN>
__device__ __forceinline__ void ln1_row(const Params& p, int l, int row, int lane, const Ln1Raw<F32IN>& raw, const LAS float* rwl, LAS int* lcnt, float rbias  , bool redir) {
  bf16_t* U2 = wsp<bf16_t>(p, WS_UO); int* eid = wsp<int>(p, WS_EID); float* gatev = wsp<float>(p, WS_GATE);
  const float* lg = p.ln_g + (size_t)(l * 2) * D; const float* lb = p.ln_b + (size_t)(l * 2) * D;
  bf16_t* ho = redir ? wsp<bf16_t>(p, WS_SCR + SM_YS) + (size_t)row * D : hb_ptr(p, row, l == DEPTH - 1); const float* modl = wsp<float>(p, WS_MOD) + ((size_t)l * 5 + bidx_of_row(row)) * 6144;
  f32x4 v[4];
#pragma unroll
  for (int q = 0; q < 4; ++q) { const int col = q * 256 + lane * 4; const f32x4 yv = (f32x4){bflo(raw.y[q].x), bfhi(raw.y[q].x), bflo(raw.y[q].y), bfhi(raw.y[q].y)};
    v[q] = ALPHA * h_as_f32(raw.h[q]) + *(const f32x4*)(modl + 2 * 1024 + col) * yv; }
  ln_row(v, lg, lb, lane);
  float acc[16];
#pragma unroll
  for (int e = 0; e < 16; ++e) acc[e] = 0.f;
#pragma unroll
  for (int q = 0; q < 4; ++q) { const int col = q * 256 + lane * 4;
    store_bf16x4(ho + col, v[q]);
    const f32x4 u = v[q] * (1.0f + *(const f32x4*)(modl + 4 * 1024 + col)) + *(const f32x4*)(modl + 3 * 1024 + col);
    store_bf16x4(U2 + (size_t)row * D + col, u);
#pragma unroll
    for (int e = 0; e < 16; ++e) { const f32x4 w = *(const LAS f32x4*)(rwl + ((q * 16 + e) * 64 + lane) * 4); acc[e] += (u[0] * w[0] + u[1] * w[1]) + (u[2] * w[2] + u[3] * w[3]); }
  }
  float t8[8], t4[4], t2[2];
#pragma unroll
  for (int i = 0; i < 8; ++i) { const u32x2 sw = __builtin_amdgcn_permlane32_swap(__float_as_uint(acc[i]), __float_as_uint(acc[8 + i]), false, false); t8[i] = __uint_as_float(sw.x) + __uint_as_float(sw.y); }
#pragma unroll
  for (int i = 0; i < 4; ++i) { const u32x2 sw = __builtin_amdgcn_permlane16_swap(__float_as_uint(t8[i]), __float_as_uint(t8[4 + i]), false, false); t4[i] = __uint_as_float(sw.x) + __uint_as_float(sw.y); }
  const bool b3 = (lane & 8) != 0, b2_ = (lane & 4) != 0;
#pragma unroll
  for (int i = 0; i < 2; ++i) { const float keep = b3 ? t4[2 + i] : t4[i], send = b3 ? t4[i] : t4[2 + i]; t2[i] = keep + dpp_mov<0x128, 0xf, 0xf>(send, send); }
  float logit;
  { const float keep = b2_ ? t2[1] : t2[0], send = b2_ ? t2[0] : t2[1];
    float recv = dpp_mov<0x104, 0xf, 0x5>(send, send);
    recv = dpp_mov<0x114, 0xf, 0xa>(recv, send);
    logit = keep + recv; }
  logit += dpp_mov<0xB1, 0xf, 0xf>(logit, logit); logit += dpp_mov<0x4E, 0xf, 0xf>(logit, logit);
  const float sg = 1.0f / (1.0f + expf(-logit)), sl = sg + rbias;
  float gs;
  { const float a = sl, b2 = dpp_mov<0x124, 0xf, 0xf>(sl, sl), c = dpp_mov<0x128, 0xf, 0xf>(sl, sl), d = dpp_mov<0x12C, 0xf, 0xf>(sl, sl);
    const float lo1 = fminf(a, b2), hi1 = fmaxf(a, b2), lo2 = fminf(c, d), hi2 = fmaxf(c, d);
    gs = fmaxf(hi1, hi2) + fmaxf(fminf(hi1, hi2), fmaxf(lo1, lo2)); }
  float best = -1e30f; int grp = 0;
#pragma unroll
  for (int gI = 0; gI < 4; ++gI) { const float g = __uint_as_float(__builtin_amdgcn_readlane(__float_as_uint(gs), gI * 16)); if (g > best) { best = g; grp = gI; } }
  grp = __builtin_amdgcn_readfirstlane(grp);
  const float v0 = __uint_as_float(__builtin_amdgcn_readlane(__float_as_uint(sl), grp * 16)), v1 = __uint_as_float(__builtin_amdgcn_readlane(__float_as_uint(sl), grp * 16 + 4)),
              v2 = __uint_as_float(__builtin_amdgcn_readlane(__float_as_uint(sl), grp * 16 + 8)), v3 = __uint_as_float(__builtin_amdgcn_readlane(__float_as_uint(sl), grp * 16 + 12));
  const float s0 = __uint_as_float(__builtin_amdgcn_readlane(__float_as_uint(sg), grp * 16)), s1 = __uint_as_float(__builtin_amdgcn_readlane(__float_as_uint(sg), grp * 16 + 4)),
              s2 = __uint_as_float(__builtin_amdgcn_readlane(__float_as_uint(sg), grp * 16 + 8)), s3 = __uint_as_float(__builtin_amdgcn_readlane(__float_as_uint(sg), grp * 16 + 12));
  int i1 = 0; float b1 = v0; if (v1 > b1) { b1 = v1; i1 = 1; } if (v2 > b1) { b1 = v2; i1 = 2; } if (v3 > b1) { b1 = v3; i1 = 3; }
  int i2 = -1; float bb = -1e30f;
  if (i1 != 0 && v0 > bb) { bb = v0; i2 = 0; } if (i1 != 1 && v1 > bb) { bb = v1; i2 = 1; } if (i1 != 2 && v2 > bb) { bb = v2; i2 = 2; } if (i1 != 3 && v3 > bb) { bb = v3; i2 = 3; }
  const float g1 = i1 == 0 ? s0 : i1 == 1 ? s1 : i1 == 2 ? s2 : s3; const float g2 = i2 == 0 ? s0 : i2 == 1 ? s1 : i2 == 2 ? s2 : s3;
  if (lane == 0) { const int e1 = grp * 4 + i1, e2 = grp * 4 + i2;
    eid[row * 2] = e1; eid[row * 2 + 1] = e2; gatev[row * 2] = g1 / (g1 + g2); gatev[row * 2 + 1] = g2 / (g1 + g2);
    __hip_atomic_fetch_add(lcnt + e1, 1, __ATOMIC_RELAXED, __HIP_MEMORY_SCOPE_WORKGROUP); __hip_atomic_fetch_add(lcnt + e2, 1, __ATOMIC_RELAXED, __HIP_MEMORY_SCOPE_WORKGROUP); }
}
template <bool F32IN>
__device__ __forceinline__ void phase_ln1(const Params& p, int l, const bf16_t* __restrict__ Ybuf, LAS unsigned char* lds, bool dry) {
  const int tid = mk::otid(), lane = tid & 63, wid = tid >> 6, bid = mk::obid();
  const bool last = l == DEPTH - 1; const int ntok = last ? NLAT : NTOK;
  LAS float* rwl = (LAS float*)lds; LAS int* lcnt = (LAS int*)(lds + 65536);
  { float rv[32];
#pragma unroll
    for (int i = 0; i < 32; ++i) rv[i] = p.router_w[tid + i * NTHR];
#pragma unroll
    for (int i = 0; i < 32; ++i) { const int idx = tid + i * NTHR, d = idx >> 4, e = idx & 15; rwl[(((d >> 8) * 16 + e) * 64 + ((d >> 2) & 63)) * 4 + (d & 3)] = rv[i]; } }
  if (tid < 16) lcnt[tid] = 0;
  __syncthreads();
  const int stride = gridDim.x * 8, row0 = bid * 8 + wid;
  const float rbias = p.router_b[lane >> 2];
  if (row0 < ntok) {
    Ln1Raw<F32IN> cur, nxt; ln1_load<F32IN>(p, Ybuf, row0, lane, cur);
    for (int row = row0; row < ntok; row += stride) {
      const int rn = row + stride < ntok ? row + stride : row;
      ln1_load<F32IN>(p, Ybuf, rn, lane, nxt);
      ln1_row<F32IN>(p, l, row, lane, cur, rwl, lcnt, rbias, dry);
      cur = nxt;
    }
  }
  __syncthreads();
  if (tid < 16) wsp<int>(p, WS_BCNT)[((size_t)l * 256 + bid) * 64 + tid] = lcnt[tid];
  __syncthreads();
}
__device__ __forceinline__ void phase_scatter(const Params& p, int l, LAS unsigned char* lds) {
  const int tid = mk::otid(), bid = mk::obid(), nb = gridDim.x;
  const bool last = l == DEPTH - 1; const int ntok = last ? NLAT : NTOK;
  LAS int* tot = (LAS int*)lds; LAS int* pre = tot + 16; LAS int* base = tot + 32; LAS int* lcur = tot + 48; LAS int* offs = tot + 64; LAS int* cnts = tot + 128;
  const int* bc = wsp<int>(p, WS_BCNT) + (size_t)l * 256 * 64;
  for (int b2 = tid; b2 < nb; b2 += NTHR) { const u32x4 c0 = *(const u32x4*)(bc + b2 * 64), c1 = *(const u32x4*)(bc + b2 * 64 + 4), c2 = *(const u32x4*)(bc + b2 * 64 + 8), c3 = *(const u32x4*)(bc + b2 * 64 + 12);
    *(LAS u32x4*)(cnts + b2 * 16) = c0; *(LAS u32x4*)(cnts + b2 * 16 + 4) = c1; *(LAS u32x4*)(cnts + b2 * 16 + 8) = c2; *(LAS u32x4*)(cnts + b2 * 16 + 12) = c3; }
  __syncthreads();
  if (tid < 16) { int t = 0, pr = 0; for (int b2 = 0; b2 < nb; ++b2) { const int v = cnts[b2 * 16 + tid]; pr += b2 < bid ? v : 0; t += v; } tot[tid] = t; pre[tid] = pr; lcur[tid] = 0; }
  __syncthreads();
  if (tid == 0) { int o = 0; int* mo = wsp<int>(p, WS_MOFF) + l * 64; for (int e = 0; e < 16; ++e) { offs[e] = o; base[e] = o + pre[e]; if (bid == 0) mo[e] = o; o += (tot[e] + 255) / 256 * 256; } offs[16] = o; if (bid == 0) mo[16] = o; }
  __syncthreads();
  const int* eid = wsp<int>(p, WS_EID); int* pos = wsp<int>(p, WS_POS); int* rl = wsp<int>(p, WS_RL);
  for (int n = tid; ; n += NTHR) { const int row = bid * 8 + (n & 7) + (n >> 3) * nb * 8; if (row >= ntok) break;
    const int e1 = eid[row * 2], e2 = eid[row * 2 + 1];
    const int p1 = base[e1] + __hip_atomic_fetch_add(lcur + e1, 1, __ATOMIC_RELAXED, __HIP_MEMORY_SCOPE_WORKGROUP), p2 = base[e2] + __hip_atomic_fetch_add(lcur + e2, 1, __ATOMIC_RELAXED, __HIP_MEMORY_SCOPE_WORKGROUP);
    pos[row * 2] = p1; pos[row * 2 + 1] = p2; rl[p1] = row; rl[p2] = row; }
  if (bid == 0) for (int e = 0; e < 16; ++e) for (int q = offs[e] + tot[e] + tid; q < offs[e + 1]; q += NTHR) rl[q] = 0;
}
struct Ln2Raw { u32x2 h[4]; u32x2 y1[4], y2[4]; };
__device__ __forceinline__ void ln2_load(const Params& p, bool last, int row, int lane, int p1, int p2, Ln2Raw& r) {
  const bf16_t* Ys = wsp<bf16_t>(p, WS_SCR + SM_YS); const bf16_t* ho = hb_ptr(p, row, last);
#pragma unroll
  for (int q = 0; q < 4; ++q) { const int col = q * 256 + lane * 4; r.h[q] = *(const u32x2*)(ho + col); r.y1[q] = *(const u32x2*)(Ys + (size_t)p1 * D + col); r.y2[q] = *(const u32x2*)(Ys + (size_t)p2 * D + col); }
}
__device__ __forceinline__ void phase_ln2(const Params& p, int l, bool dry) {
  const int tid = mk::otid(), lane = tid & 63, wid = tid >> 6;
  const bool last = l == DEPTH - 1; const int ntok = last ? NLAT : NTOK;
  const int* pos = wsp<int>(p, WS_POS); const float* gatev = wsp<float>(p, WS_GATE); bf16_t* U = wsp<bf16_t>(p, WS_UO);
  const float* lg = p.ln_g + (size_t)(l * 2 + 1) * D; const float* lb = p.ln_b + (size_t)(l * 2 + 1) * D;
  const int stride = gridDim.x * 8, row0 = mk::obid() * 8 + wid;
  if (row0 >= ntok) return;
  auto clampr = [&](int r) { return r < ntok ? r : row0; };
  u32x2 pc = *(const u32x2*)(pos + 2 * row0); f32x2 gc = *(const f32x2*)(gatev + 2 * row0);
  Ln2Raw cur, nxt; ln2_load(p, last, row0, lane, (int)pc.x, (int)pc.y, cur);
  int r1 = clampr(row0 + stride);
  u32x2 pn = *(const u32x2*)(pos + 2 * r1); f32x2 gn = *(const f32x2*)(gatev + 2 * r1);
  for (int row = row0; row < ntok; row += stride) {
    ln2_load(p, last, r1, lane, (int)pn.x, (int)pn.y, nxt);
    const int r2 = clampr(row + 2 * stride);
    const u32x2 pn2 = *(const u32x2*)(pos + 2 * r2); const f32x2 gn2 = *(const f32x2*)(gatev + 2 * r2);
    bf16_t* hb = dry ? wsp<bf16_t>(p, WS_SCR + SM_XS) + (size_t)row * D : hb_ptr(p, row, false); float* hf = (dry ? wsp<float>(p, WS_SCR + SM_XS) : p.out) + (size_t)row * D; const int bi = bidx_of_row(row);
    const float* modl = wsp<float>(p, WS_MOD) + ((size_t)l * 5 + bi) * 6144;
    f32x4 v[4];
#pragma unroll
    for (int q = 0; q < 4; ++q) { const int col = q * 256 + lane * 4;
      const f32x4 a1 = (f32x4){bflo(cur.y1[q].x), bfhi(cur.y1[q].x), bflo(cur.y1[q].y), bfhi(cur.y1[q].y)}, a2 = (f32x4){bflo(cur.y2[q].x), bfhi(cur.y2[q].x), bflo(cur.y2[q].y), bfhi(cur.y2[q].y)};
      v[q] = ALPHA * h_as_f32(cur.h[q]) + *(const f32x4*)(modl + 5 * 1024 + col) * (gc[0] * a1 + gc[1] * a2); }
    ln_row(v, lg, lb, lane);
    const float* modn = wsp<float>(p, WS_MOD) + ((size_t)(last ? l : l + 1) * 5 + bi) * 6144;
#pragma unroll
    for (int q = 0; q < 4; ++q) { const int col = q * 256 + lane * 4; if (last) *(f32x4*)(hf + col) = v[q]; else store_bf16x4(hb + col, v[q]);
      if (!last) store_bf16x4(U + (size_t)row * D + col, v[q] * (1.0f + *(const f32x4*)(modn + 1024 + col)) + *(const f32x4*)(modn + col)); }
    cur = nxt; gc = gn; pn = pn2; gn = gn2; r1 = r2;
  }
}

struct SchedEvenIn { static constexpr bool GATHER = false; const bf16_t* U; const bf16_t* W; bf16_t* Pqk; bf16_t* Prw; bf16_t* Vt; int G, c;
  __device__ __forceinline__ bool next(int i, pg8::Unit& u) const { const int Lx = i * G + c; u.kind = 0;
    if (Lx < 1452) { const int grp = Lx / 44, rem = Lx % 44, pm = grp * 4 + (rem & 3), pi = rem >> 2; u.pm = pm; u.pn = pi;
      u.A = (const char*)(U + (size_t)pm * 256 * D); const int brow = pi < 4 ? pi * 256 : 1536 + (pi - 4) * 256; u.Bt = (const char*)(W + (size_t)brow * D);
      if (pi < 4) { u.out = Pqk; u.ldo = 1024; u.x1 = pi * 256; } else { u.out = Prw; u.ldo = RW_IN; u.x1 = (pi - 4) * 256; } u.x0 = pm * 256; return true; }
    if (Lx < 1452 + 264) { const int v = Lx - 1452, pmv = v & 1, pnv = v >> 1; u.pm = pmv; u.pn = pnv; u.A = (const char*)(W + (size_t)(1024 + pmv * 256) * D); u.Bt = (const char*)(U + (size_t)pnv * 256 * D);
      u.out = Vt; u.ldo = NTOK; u.x0 = pmv * 256; u.x1 = pnv * 256; return true; }
    return false; } };
struct SchedOddIn { static constexpr bool GATHER = false; const bf16_t* U; const bf16_t* W; bf16_t* Pqk; bf16_t* Vt; int G, c;
  __device__ __forceinline__ bool next(int i, pg8::Unit& u) const { const int Lx = i * G + c;
    if (Lx < 1056) { const int grp = Lx / 32, rem = Lx % 32, pm = grp * 4 + (rem & 3), pi = rem >> 2; u.pm = pm; u.pn = pi; u.kind = pm < 128 ? 1 : 0;
      u.A = (const char*)(U + (size_t)pm * 256 * D); u.Bt = (const char*)(W + (size_t)pi * 256 * D); u.out = Pqk; u.ldo = 2048; u.x0 = pm * 256; u.x1 = pi * 256; return true; }
    if (Lx < 1056 + 528) { const int v = Lx - 1056, pmv = v & 3, pnv = v >> 2; u.pm = pmv; u.pn = pnv; u.kind = 0; u.A = (const char*)(W + (size_t)(2048 + pmv * 256) * D); u.Bt = (const char*)(U + (size_t)pnv * 256 * D);
      u.out = Vt; u.ldo = NTOK; u.x0 = pmv * 256; u.x1 = pnv * 256; return true; }
    return false; } };
struct SchedOut { static constexpr bool GATHER = false; const bf16_t* O; const bf16_t* W; bf16_t* Y; int G, c;
  __device__ __forceinline__ bool next(int i, pg8::Unit& u) const { const int Lx = i * G + c; if (Lx >= 528) return false; const int pm = (Lx / 16) * 4 + (Lx & 3), pn = (Lx & 15) >> 2; u.pm = pm; u.pn = pn; u.kind = 0;
    u.A = (const char*)(O + (size_t)pm * 256 * D); u.Bt = (const char*)(W + (size_t)pn * 256 * D); u.out = Y; u.ldo = 1024; u.x0 = pm * 256; u.x1 = pn * 256; return true; } };
template <bool GATH>
struct SchedMoe { static constexpr bool GATHER = GATH; const bf16_t* A; const bf16_t* W; bf16_t* out; const LAS int* moff; const int* rl; int Kd, ldo, ncol, G, c;
  __device__ __forceinline__ bool next(int i, pg8::Unit& u) const { const int Lx = i * G + c; const int ntile = moff[16] >> 8; if (Lx >= ntile * 4) return false;
    const int pm = Lx >> 2, pn = Lx & 3; int e = 0;
#pragma unroll
    for (int j = 1; j < 16; ++j) e += (pm * 256 >= moff[j]) ? 1 : 0;
    u.pm = pm; u.pn = pn; u.kind = 0; u.A = GATH ? (const char*)A : (const char*)(A + (size_t)pm * 256 * Kd); u.rl = rl + pm * 256; u.Bt = (const char*)(W + ((size_t)e * 1024 + pn * 256) * Kd); u.out = out; u.ldo = ldo; u.x0 = pm * 256; u.x1 = pn * ncol; return true; } };

struct EpiOddIn {
  static constexpr bool PERM = true; const float* rope;
  __device__ __forceinline__ void operator()(const f32x4 (&acc)[2][2][4][2], const pg8::Unit& u, int wr, int wc, int fr, int fq) const {
    if (u.kind == 0) { pg8::EpiStoreBf16{}(acc, u, wr, wc, fr, fq); return; }
    const int row0 = u.x0 + wr * 64 + fr, col0 = u.x1 + wc * 32 + 8 * fq; const int half = wc & 1;
#pragma unroll
    for (int ai = 0; ai < 2; ++ai)
#pragma unroll
      for (int m = 0; m < 4; ++m) { const int row = row0 + ai * 128 + m * 16; const int t = row & (T - 1); const int pos = half ? (t & 63) : (t >> 6);
        const f32x4 cs0 = *(const f32x4*)(rope + (pos * 16 + 4 * fq) * 2), cs1 = *(const f32x4*)(rope + (pos * 16 + 4 * fq + 2) * 2);
        bf16_t* rowp = u.out + (size_t)row * u.ldo + col0;
#pragma unroll
        for (int bj = 0; bj < 2; ++bj) { const f32x4 v0 = acc[ai][bj][m][0], v1 = acc[ai][bj][m][1];
          u32x4 w; w.x = cvt_pk_bf16(v0[0] * cs0[0] - v0[1] * cs0[1], v0[0] * cs0[1] + v0[1] * cs0[0]); w.y = cvt_pk_bf16(v0[2] * cs0[2] - v0[3] * cs0[3], v0[2] * cs0[3] + v0[3] * cs0[2]);
          w.z = cvt_pk_bf16(v1[0] * cs1[0] - v1[1] * cs1[1], v1[0] * cs1[1] + v1[1] * cs1[0]); w.w = cvt_pk_bf16(v1[2] * cs1[2] - v1[3] * cs1[3], v1[2] * cs1[3] + v1[3] * cs1[2]);
          *(u32x4*)(rowp + bj * 128) = w; } }
  }
};
struct EpiGateUp {
  static constexpr bool PERM = true;
  __device__ __forceinline__ void operator()(const f32x4 (&acc)[2][2][4][2], const pg8::Unit& u, int wr, int wc, int fr, int fq) const {
    const int row0 = u.x0 + wr * 64 + fr, col0 = u.x1 + wc * 16 + 4 * fq;
#pragma unroll
    for (int ai = 0; ai < 2; ++ai)
#pragma unroll
      for (int m = 0; m < 4; ++m) { bf16_t* rowp = u.out + (size_t)(row0 + ai * 128 + m * 16) * u.ldo + col0;
#pragma unroll
        for (int bj = 0; bj < 2; ++bj) { const f32x4 v0 = acc[ai][bj][m][0], v1 = acc[ai][bj][m][1];
          u32x2 w; w.x = cvt_pk_bf16(siluf_(v0[0]) * v0[1], siluf_(v0[2]) * v0[3]); w.y = cvt_pk_bf16(siluf_(v1[0]) * v1[1], siluf_(v1[2]) * v1[3]);
          *(u32x2*)(rowp + bj * 64) = w; } }
  }
};
}

namespace mk {
constexpr int N_PHASES = 2 + 2 * (12 + 10);
__global__ void __launch_bounds__(NTHR, 2) mega(Params p) {
  extern __shared__ __attribute__((aligned(16))) unsigned char shm[];
  LAS unsigned char* lds = (LAS unsigned char*)shm;
  const int nb = gridDim.x;
  if (threadIdx.x == 0) *(LAS u32x4*)(lds + LDS_BARW) = (u32x4){0u, 0u, 0u, 0u};
  __syncthreads();
  XcdBarrier bar = xcd_barrier_post(wsp<unsigned>(p, WS_BAR), (volatile LAS unsigned*)(lds + LDS_BARW));
  int ph = 0;
#ifndef MK_MASK
#define MK_MASK 0xFFFFFFFFu
#endif
#ifndef MK_REP
#define MK_REP 0u
#endif
#define PHASE_BEGIN_K(k) if ((((MK_MASK) >> (k)) & 1u) && ph >= p.ph_lo && ph < p.ph_hi) { const int bid = mk::obid(); const int nrep_ = ((((MK_REP) >> (k)) & 1u) ? 2 : 1); for (int rep_ = 0; rep_ < nrep_; ++rep_) { const bool dry = rep_ + 1 < nrep_; (void)dry;
#define PHASE_END   } if (ph + 1 < p.ph_hi) xcd_barrier(bar); } ++ph;
  bf16_t* UO = wsp<bf16_t>(p, WS_UO);
  unsigned char* scr = p.ws + WS_SCR;
  PHASE_BEGIN_K(0) phase_prologue(p, lds); PHASE_END
  PHASE_BEGIN_K(1) phase_mod0(p); PHASE_END
  for (int lp = 0; lp < 2; ++lp) {
    {
      const int l = 2 * lp;
      bf16_t* Pqk = (bf16_t*)(scr + SE_PQK); bf16_t* Vt = (bf16_t*)(scr + SE_VT); bf16_t* Prw = (bf16_t*)(scr + SE_PRW); bf16_t* Ybuf = (bf16_t*)(scr + SE_YBUF);
      rw::Bufs bf; bf.SH = (u32x2*)(scr + SE_SH); bf.DR = (unsigned*)(scr + SE_DR); bf.G = UO + 512; bf.gstride = 1024; bf.CS = (float*)(scr + SE_CS) + (size_t)lp * NTOK * 16; bf.PQ = (float*)(scr + SE_PQ); bf.SST = (float*)(scr + SE_SST); bf.Y = (bf16_t*)(scr + SE_Y); bf.Z = (bf16_t*)(scr + SE_Z);
      PHASE_BEGIN_K(2) { SchedEvenIn S{UO, wsp<bf16_t>(p, WS_WEIN) + (size_t)lp * EVEN_IN * D, Pqk, Prw, Vt, nb, bid}; pg8::gemm_phase(lds, D, S, pg8::EpiStoreBf16{}); } PHASE_END
      PHASE_BEGIN_K(3) { for (int u = bid; u < 1024 + 32; u += nb) { int b, h, rq; if (u < 1024) { b = u >> 8; h = (u >> 5) & 7; rq = u & 31; } else { const int v = u - 1024; b = v >> 3; h = v & 7; rq = -1; }
          natt::na_attn_unit(Pqk, Vt, p.na_rpb + ((size_t)lp * 8 + h) * 465, UO, b, h, rq, lds); }
        const int pb = (bid + nb / 2) % nb;
        for (int t = pb; t < NTOK / 16; t += nb) rw::prep_tile(Prw, p.shift_w + (size_t)lp * 3 * RW_IN, p.rw_w0 + lp * 1024, wsp<bf16_t>(p, WS_WLT) + (size_t)lp * 196608, p.rw_a0 + lp * 1024, p.rw_k_k + lp * 512, p.rw_k_a + lp * 512, p.rw_r_k + lp * 512, bf, t, (LAS float*)lds); } PHASE_END
      PHASE_BEGIN_K(4) for (int u = bid * 8 + (mk::otid() >> 6); u < rw::NCHAIN * rw::NCH; u += nb * 8) rw::scan_unit(bf, p.rw_k_a + lp * 512, u / rw::NCH, u % rw::NCH, (LAS float*)lds + (mk::otid() >> 6) * 320); PHASE_END
      PHASE_BEGIN_K(5) for (int c = bid; c < rw::NCHAIN * 4; c += nb) rw::propagate_chain(bf, c >> 2, c & 3, (LAS float*)lds); PHASE_END
      PHASE_BEGIN_K(6) for (int u = bid * 8 + (mk::otid() >> 6); u < rw::NCHAIN * (rw::NCH - 1); u += nb * 8) rw::corr_unit(bf, u / (rw::NCH - 1), 1 + u % (rw::NCH - 1)); PHASE_END
      PHASE_BEGIN_K(7) for (int r = bid * 8; r < NTOK; r += nb * 8) rw::finish_rows<8>(bf, p.rw_gn_g + lp * 512, p.rw_gn_b + lp * 512, UO, r); PHASE_END
      PHASE_BEGIN_K(8) { SchedOut S{UO, wsp<bf16_t>(p, WS_WEOUT) + (size_t)lp * D * D, Ybuf, nb, bid}; pg8::gemm_phase(lds, D, S, pg8::EpiStoreBf16{}); __syncthreads(); cvt_experts(p, l, (LAS float*)lds, 528 - 2 * nb > 0 ? 528 - 2 * nb : 0); } PHASE_END
      PHASE_BEGIN_K(9) if (l == 0) phase_ln1<true>(p, l, Ybuf, lds, dry); else phase_ln1<false>(p, l, Ybuf, lds, dry); PHASE_END
      PHASE_BEGIN_K(10) phase_scatter(p, l, lds); PHASE_END
      PHASE_BEGIN_K(11) { LAS int* mo = (LAS int*)(lds + LDS_MISC); { const int tq = mk::otid(); if (tq < 17) mo[tq] = wsp<int>(p, WS_MOFF)[l * 64 + tq]; } __syncthreads();
        SchedMoe<true> S{UO, wsp<bf16_t>(p, WS_WGU), (bf16_t*)(scr + SM_HE), mo, wsp<int>(p, WS_RL), D, DE, 128, nb, bid}; pg8::gemm_phase(lds, D, S, EpiGateUp{}); } PHASE_END
      PHASE_BEGIN_K(12) { LAS int* mo = (LAS int*)(lds + LDS_MISC); { const int tq = mk::otid(); if (tq < 17) mo[tq] = wsp<int>(p, WS_MOFF)[l * 64 + tq]; } __syncthreads();
        SchedMoe<false> S{(bf16_t*)(scr + SM_HE), wsp<bf16_t>(p, WS_WDN), (bf16_t*)(scr + SM_YS), mo, nullptr, DE, D, 256, nb, bid}; pg8::gemm_phase(lds, DE, S, pg8::EpiStoreBf16{}); } PHASE_END
      PHASE_BEGIN_K(13) phase_ln2(p, l, dry); PHASE_END
    }
    {
      const int l = 2 * lp + 1; const bool last = l == DEPTH - 1;
      bf16_t* Pqk = (bf16_t*)(scr + SO_PQK); bf16_t* Vt = (bf16_t*)(scr + SO_VT); bf16_t* O12 = (bf16_t*)(scr + SO_O12); bf16_t* Ybuf = (bf16_t*)(scr + SO_YBUF);
      PHASE_BEGIN_K(14) { SchedOddIn S{UO, wsp<bf16_t>(p, WS_WOIN) + (size_t)lp * ODD_IN * D, Pqk, Vt, nb, bid}; pg8::gemm_phase(lds, D, S, EpiOddIn{wsp<float>(p, WS_ROPE)}); } PHASE_END
      float* KN = wsp<float>(p, WS_KN) + (size_t)lp * 256 * 16;
      PHASE_BEGIN_K(23) for (int g = bid; g < 256; g += nb) att::knorm_group(Pqk, KN, g, (LAS float*)lds); PHASE_END
      PHASE_BEGIN_K(15) for (int ui = bid; ui < 2048 + (last ? 0 : 64); ui += nb) { int b, hh, q0, nlat; const int u = (nb == 256 && ui < 2048) ? ((((ui >> 8) * 8 + (bid & 7)) << 5) | (bid >> 3)) : ui;
        if (u < 2048) { b = u >> 9; hh = (u >> 5) & 15; q0 = b * T + (u & 31) * 256; nlat = T; } else { const int v = u - 2048; b = v >> 4; hh = v & 15; q0 = NLAT + b * L; nlat = 0; }
#ifdef MK_ABL
        if (dry) att::diff_attn_unit<MK_ABL>(Pqk, Vt, O12, hh, q0, b * T, nlat, NLAT + b * L, att::kmax2_of(KN, b, hh), lds); else
#endif
        att::diff_attn_unit(Pqk, Vt, O12, hh, q0, b * T, nlat, NLAT + b * L, att::kmax2_of(KN, b, hh), lds); } PHASE_END
      PHASE_BEGIN_K(16) { float d1 = 0.f, d2 = 0.f; for (int i = 0; i < 64; ++i) { d1 += p.da_lq1[lp * 64 + i] * p.da_lk1[lp * 64 + i]; d2 += p.da_lq2[lp * 64 + i] * p.da_lk2[lp * 64 + i]; }
        const float li = 0.8f - 0.6f * expf(-0.3f * (float)l), lam = expf(d1) - expf(d2) + li;
        const int tq = mk::otid(); for (int r4 = bid; r4 < (last ? NLAT : NTOK) / 4; r4 += nb) att::diff_combine_rows4(O12, p.da_subln_g + lp * 128, lam, 1.0f - li, UO, r4 * 4, tq >> 6, tq & 63); } PHASE_END
      PHASE_BEGIN_K(17) { SchedOut S{UO, wsp<bf16_t>(p, WS_WOOUT) + (size_t)lp * D * D, Ybuf, nb, bid}; pg8::gemm_phase(lds, D, S, pg8::EpiStoreBf16{}); __syncthreads(); cvt_experts(p, l, (LAS float*)lds, 528 - 2 * nb > 0 ? 528 - 2 * nb : 0); } PHASE_END
      PHASE_BEGIN_K(18) phase_ln1<false>(p, l, Ybuf, lds, dry); PHASE_END
      PHASE_BEGIN_K(19) phase_scatter(p, l, lds); PHASE_END
      PHASE_BEGIN_K(20) { LAS int* mo = (LAS int*)(lds + LDS_MISC); { const int tq = mk::otid(); if (tq < 17) mo[tq] = wsp<int>(p, WS_MOFF)[l * 64 + tq]; } __syncthreads();
        SchedMoe<true> S{UO, wsp<bf16_t>(p, WS_WGU), (bf16_t*)(scr + SM_HE), mo, wsp<int>(p, WS_RL), D, DE, 128, nb, bid}; pg8::gemm_phase(lds, D, S, EpiGateUp{}); } PHASE_END
      PHASE_BEGIN_K(21) { LAS int* mo = (LAS int*)(lds + LDS_MISC); { const int tq = mk::otid(); if (tq < 17) mo[tq] = wsp<int>(p, WS_MOFF)[l * 64 + tq]; } __syncthreads();
        SchedMoe<false> S{(bf16_t*)(scr + SM_HE), wsp<bf16_t>(p, WS_WDN), (bf16_t*)(scr + SM_YS), mo, nullptr, DE, D, 256, nb, bid}; pg8::gemm_phase(lds, DE, S, pg8::EpiStoreBf16{}); } PHASE_END
      PHASE_BEGIN_K(22) phase_ln2(p, l, dry); PHASE_END
    }
  }
#undef PHASE_BEGIN_K
#undef PHASE_END
}
}

#ifndef MK_SINGLE_LAUNCH
#define MK_SINGLE_LAUNCH 1
#endif
extern "C" void kernel_launch(void* const* d_in, const int* in_sizes, int n_in, void* d_out, int out_size, void* d_ws, size_t ws_size, hipStream_t stream) {
  using namespace mk;
  static int grid = 0;
  if (grid == 0) {
    if (n_in != 34 || out_size != NLAT * D || ws_size < WS_END) { fprintf(stderr, "kernel_launch: unexpected shapes (n_in %d out %d ws %zu need %zu)\n", n_in, out_size, ws_size, (size_t)WS_END); grid = -1; return; }
    if (hipFuncSetAttribute((const void*)mega, hipFuncAttributeMaxDynamicSharedMemorySize, LDS_BYTES) != hipSuccess) { grid = -1; return; }
    int dev = 0, cus = 0, per_cu = 0;
    if (hipGetDevice(&dev) != hipSuccess || hipDeviceGetAttribute(&cus, hipDeviceAttributeMultiprocessorCount, dev) != hipSuccess) { grid = -1; return; }
    if (hipOccupancyMaxActiveBlocksPerMultiprocessor(&per_cu, (const void*)mega, NTHR, LDS_BYTES) != hipSuccess || per_cu < 1) { fprintf(stderr, "kernel_launch: occupancy query says %d\n", per_cu); }
    (void)hipGetLastError();
    grid = cus;
  }
  if (grid < 0) return;
  (void)hipMemsetAsync((char*)d_ws + WS_BAR, 0, (size_t)XCD_BAR_WORDS * 4, stream);
  Params p{};
  const float** pp = (const float**)&p;
  for (int i = 0; i < 34; ++i) pp[i] = (const float*)d_in[i];
  p.out = (float*)d_out; p.ws = (unsigned char*)d_ws;
#if MK_SINGLE_LAUNCH
  p.ph_lo = 0; p.ph_hi = N_PHASES;
  hipLaunchKernelGGL(mega, dim3(grid), dim3(NTHR), LDS_BYTES, stream, p);
#else
  for (int ph = 0; ph < N_PHASES; ++ph) { p.ph_lo = ph; p.ph_hi = ph + 1; hipLaunchKernelGGL(mega, dim3(grid), dim3(NTHR), LDS_BYTES, stream, p); }
#endif
}
```

```cpp
#include <hip/hip_runtime.h>
#include <stdint.h>
#include <stdio.h>

typedef unsigned short bf16_t;
typedef short bf16x8 __attribute__((ext_vector_type(8)));
typedef float f32x4 __attribute__((ext_vector_type(4)));
typedef float f32x2 __attribute__((ext_vector_type(2)));
typedef float f32x16 __attribute__((ext_vector_type(16)));
typedef unsigned u32x4 __attribute__((ext_vector_type(4)));
typedef unsigned u32x2 __attribute__((ext_vector_type(2)));
#define LAS __attribute__((address_space(3)))

namespace mk {
constexpr int B = 4, T = 8192, L = 256, D = 1024, NLAT = B * T, NCTX = B * L, NTOK = NLAT + NCTX;
constexpr int DEPTH = 4, EVEN_IN = 3328, ODD_IN = 3072, RW_OFF = 1536, RW_IN = 1792, NE = 16, DE = 512;
constexpr float ALPHA = 1.681792830507429f, LN_EPS = 1e-5f;
constexpr int NTHR = 512, LDS_BYTES = 147456;
constexpr int MOE_TILES = 280, MOE_ROWS = MOE_TILES * 256;

__device__ __forceinline__ unsigned cvt_pk_bf16(float lo, float hi) { unsigned r; asm volatile("v_cvt_pk_bf16_f32 %0, %1, %2" : "=v"(r) : "v"(lo), "v"(hi)); return r; }
typedef __bf16 bf16x2v __attribute__((ext_vector_type(2)));
__device__ __forceinline__ unsigned cvt_pk_bf16_v(float lo, float hi) { const f32x2 v = {lo, hi}; return __builtin_bit_cast(unsigned, __builtin_convertvector(v, bf16x2v)); }
__device__ __forceinline__ float bf2f(bf16_t b) { return __uint_as_float(((unsigned)b) << 16); }
__device__ __forceinline__ float bflo(unsigned w) { return __uint_as_float(w << 16); }
__device__ __forceinline__ float bfhi(unsigned w) { return __uint_as_float(w & 0xffff0000u); }
__device__ __forceinline__ bf16_t f2bf(float f) { return (bf16_t)(cvt_pk_bf16(f, 0.f) & 0xffffu); }
__device__ __forceinline__ float sigmoidf_(float x) { return 1.0f / (1.0f + __expf(-x)); }
__device__ __forceinline__ float siluf_(float x) { return x / (1.0f + __expf(-x)); }
__device__ __forceinline__ float wave_sum(float v) {
#pragma unroll
  for (int o = 32; o > 0; o >>= 1) v += __shfl_xor(v, o);
  return v;
}
template <int CTRL, int RM, int BM> __device__ __forceinline__ float dpp_mov(float old, float v) { return __int_as_float(__builtin_amdgcn_update_dpp(__float_as_int(old), __float_as_int(v), CTRL, RM, BM, false)); }
__device__ __forceinline__ float wave_sum_u(float v) {
  v += dpp_mov<0xB1, 0xf, 0xf>(v, v);
  v += dpp_mov<0x4E, 0xf, 0xf>(v, v);
  v += dpp_mov<0x141, 0xf, 0xf>(v, v);
  v += dpp_mov<0x140, 0xf, 0xf>(v, v);
  v += dpp_mov<0x142, 0xa, 0xf>(0.f, v);
  v += dpp_mov<0x143, 0xc, 0xf>(0.f, v);
  return __int_as_float(__builtin_amdgcn_readlane(__float_as_int(v), 63));
}
__device__ __forceinline__ float wave_max_u(float v) {
  v = fmaxf(v, dpp_mov<0xB1, 0xf, 0xf>(v, v));
  v = fmaxf(v, dpp_mov<0x4E, 0xf, 0xf>(v, v));
  v = fmaxf(v, dpp_mov<0x141, 0xf, 0xf>(v, v));
  v = fmaxf(v, dpp_mov<0x140, 0xf, 0xf>(v, v));
  v = fmaxf(v, dpp_mov<0x142, 0xa, 0xf>(0.f, v));
  v = fmaxf(v, dpp_mov<0x143, 0xc, 0xf>(0.f, v));
  return __int_as_float(__builtin_amdgcn_readlane(__float_as_int(v), 63));
}
__device__ __forceinline__ f32x16 zero16() { float z = 0.f; asm volatile("" : "+v"(z)); f32x16 r;
#pragma unroll
  for (int i = 0; i < 16; ++i) r[i] = z;
  return r; }
__device__ __forceinline__ int otid() { int t = threadIdx.x; asm volatile("" : "+v"(t)); return t; }
__device__ __forceinline__ int obid() { int b = blockIdx.x; asm volatile("" : "+s"(b)); return b; }
__device__ __forceinline__ int bidx_of_row(int row) { return row < NLAT ? row / T : 4; }
}

#include <vector>

#define XB_TMO      128
#define XB_XCNT(j)  (256  + 64 * (j))
#define XB_XSUB(j)  (1280 + 64 * (j))
#define XB_XGEN(j)  (2304 + 64 * (j))
#define XB_TOP      3328
#define XB_TOPGEN   3392
#define XCD_BAR_WORDS 3456
#define XB_SPIN_CAP (1u << 18)
#define LAS __attribute__((address_space(3)))

__device__ __forceinline__ unsigned xb_ld(unsigned* p)              { return __hip_atomic_load(p, __ATOMIC_RELAXED, __HIP_MEMORY_SCOPE_AGENT); }
__device__ __forceinline__ unsigned xb_add(unsigned* p, unsigned v) { return __hip_atomic_fetch_add(p, v, __ATOMIC_RELAXED, __HIP_MEMORY_SCOPE_AGENT); }
__device__ __forceinline__ unsigned xb_xcc_id() { return (unsigned)__builtin_amdgcn_s_getreg((3 << 11) | 20) & 0xFu; }
#define XB_SPIN(cond, bar) do { unsigned _sp = 0; while (cond) { __builtin_amdgcn_s_sleep(1); \
    if ((++_sp & 255u) == 0u) { if (xb_ld(&(bar)[XB_TMO])) break; if (_sp > XB_SPIN_CAP) { atomicAdd(&(bar)[XB_TMO], 1u); break; } } } } while (0)

struct XcdBarrier {
    unsigned* bar; unsigned x;
    volatile LAS unsigned* st;
};

__device__ __forceinline__ XcdBarrier xcd_barrier_post(unsigned* bar, volatile LAS unsigned* st) {
    XcdBarrier b; b.bar = bar; b.x = xb_xcc_id(); b.st = st;
    if (threadIdx.x == 0) (void)xb_add(&bar[XB_XCNT(b.x)], 1u);
    return b;
}
__device__ __forceinline__ void xcd_barrier_complete(unsigned* bar, unsigned x, unsigned& nloc, unsigned& nx) {
    const unsigned G = gridDim.x * gridDim.y * gridDim.z;
    unsigned sum, cnt, mine, sp = 0u;
    for (;;) {
        sum = 0u; cnt = 0u; mine = 0u;
#pragma unroll
        for (unsigned j = 0; j < 16; ++j) { const unsigned c = xb_ld(&bar[XB_XCNT(j)]); sum += c; cnt += (c > 0u) ? 1u : 0u; mine = (j == x) ? c : mine; }
        if (sum == G) break;
        __builtin_amdgcn_s_sleep(1);
        if ((++sp & 255u) == 0u) { if (xb_ld(&bar[XB_TMO])) break; if (sp > XB_SPIN_CAP) { atomicAdd(&bar[XB_TMO], 1u); break; } }
    }
    nloc = mine > 0u ? mine : 1u; nx = cnt > 0u ? cnt : 1u;
}

__device__ __forceinline__ void xcd_barrier(const XcdBarrier& b) {
    asm volatile("s_waitcnt vmcnt(0)" ::: "memory");
    __syncthreads();
    if (threadIdx.x == 0) {
        unsigned* bar = b.bar;
        __builtin_amdgcn_s_waitcnt(0);
        unsigned nloc = b.st[0], nx = b.st[1];
        if (nloc == 0u) { xcd_barrier_complete(bar, b.x, nloc, nx); b.st[0] = nloc; b.st[1] = nx; }
        const unsigned old = xb_add(&bar[XB_XSUB(b.x)], 1u);
        const unsigned gen = old / nloc;
        if (old + 1u == (gen + 1u) * nloc) {
            __builtin_amdgcn_fence(__ATOMIC_RELEASE, "agent");
            asm volatile("s_waitcnt vmcnt(0)" ::: "memory");
            const unsigned og = xb_add(&bar[XB_TOP], 1u);
            const unsigned tg = og / nx;
            if (og + 1u == (tg + 1u) * nx) xb_add(&bar[XB_TOPGEN], 1u);
            else XB_SPIN(xb_ld(&bar[XB_TOPGEN]) == tg, bar);
            __builtin_amdgcn_fence(__ATOMIC_ACQUIRE, "agent");
            xb_add(&bar[XB_XGEN(b.x)], 1u);
            asm volatile("s_waitcnt vmcnt(0)" ::: "memory");
        } else {
            XB_SPIN(xb_ld(&bar[XB_XGEN(b.x)]) == gen, bar);
            __builtin_amdgcn_fence(__ATOMIC_ACQUIRE, "agent");
            asm volatile("s_waitcnt vmcnt(0)" ::: "memory");
        }
    }
    __syncthreads();
}

namespace pg8 {
using mk::cvt_pk_bf16;
constexpr int BM = 256, BK = 64, HALF = 128, HTB = HALF * BK * 2  , STAGE_BYTES = 8 * HTB;
__host__ __device__ __forceinline__ int lds_byte(int r, int c) { const int st = (r >> 4) * 2 + (c >> 5), rr = r & 15, cc = c & 31, ob = rr * 64 + cc * 2; return st * 1024 + (ob ^ (((ob >> 9) & 1) << 5)); }
__host__ __device__ __forceinline__ void stage_rc(int b, int& R, int& C) { const int st = b / 1024, sb = b % 1024, swz = sb ^ (((sb >> 9) & 1) << 5); R = (st >> 1) * 16 + swz / 64; C = (st & 1) * 32 + (swz % 64) / 2; }
__host__ __device__ __forceinline__ int perm32(int rho) { const int n = rho >> 4, i = rho & 15; return 8 * (i >> 2) + 4 * n + (i & 3); }

struct Unit { const char* A; const char* Bt; bf16_t* out; const int* rl; int pm, pn, x0, x1, ldo, kind; };

template <class Epi, class Sched>
__device__ __forceinline__ void gemm_phase(LAS unsigned char* lds, const int K, const Sched& S, const Epi& E) {
    const int tid = mk::otid(), wid = __builtin_amdgcn_readfirstlane(tid >> 6), lane = tid & 63, wr = wid >> 2, wc = wid & 3, fr = lane & 15, fq = lane >> 4;
    const int nt = K / BK;
    constexpr bool GATH = Sched::GATHER;
    unsigned voffA[2], voffB[2]; int Rl[2], Cl[2];
#pragma unroll
    for (int i = 0; i < 2; ++i) { int R, C; stage_rc(tid * 16 + i * 8192, R, C); const int Rb = Epi::PERM ? ((R & ~31) + perm32(R & 31)) : R; Rl[i] = R; Cl[i] = C;
        voffA[i] = (unsigned)(R * K + C) * 2u; voffB[i] = (unsigned)(Rb * K + C) * 2u; }
    unsigned roC[2][2], roN[2][2];
    (void)Rl; (void)Cl;
    const size_t kstep = (size_t)(BK * 2);
    const size_t hstep = (size_t)HALF * K * 2;
    const unsigned ldsw = (unsigned)wid * 1024u;
    const int aoff = lds_byte(wr * 64 + fr, fq * 8), boff = lds_byte(wc * 32 + fr, fq * 8);
#define PG8_SA(b, h) (((b) * 2 + (h)) * HTB)
#define PG8_SB(b, h) ((4 + (b) * 2 + (h)) * HTB)
#define PG8_STAGE(bufoff, gbase, voff) do { _Pragma("unroll") for (int _i = 0; _i < 2; ++_i) \
        __builtin_amdgcn_global_load_lds((const unsigned*)((const char*)(gbase) + (voff)[_i]), (LAS unsigned*)(lds + (bufoff) + ldsw + _i * 8192), 16, 0, 0); } while (0)
#define PG8_STAGE_A(bufoff, gbase, h, ro) do { if constexpr (GATH) { _Pragma("unroll") for (int _i = 0; _i < 2; ++_i) \
        __builtin_amdgcn_global_load_lds((const unsigned*)((const char*)(gbase) + (ro)[h][_i]), (LAS unsigned*)(lds + (bufoff) + ldsw + _i * 8192), 16, 0, 0); } \
      else { PG8_STAGE(bufoff, (const char*)(gbase) + (h) * hstep, voffA); } } while (0)
#define PG8_LOAD_RO(u, ro) do { _Pragma("unroll") for (int _h = 0; _h < 2; ++_h) _Pragma("unroll") for (int _i = 0; _i < 2; ++_i) \
        (ro)[_h][_i] = (unsigned)(u).rl[Rl[_i] + _h * 128] * (unsigned)(K * 2) + (unsigned)(Cl[_i] * 2); } while (0)
#define PG8_LDA(dst, b, h) do { _Pragma("unroll") for (int m = 0; m < 4; ++m) _Pragma("unroll") for (int k = 0; k < 2; ++k) dst[m][k] = *(const LAS bf16x8*)(lds + PG8_SA(b, h) + aoff + m * 2048 + k * 1024); } while (0)
#define PG8_LDB(dst, b, h) do { _Pragma("unroll") for (int n = 0; n < 2; ++n) _Pragma("unroll") for (int k = 0; k < 2; ++k) dst[n][k] = *(const LAS bf16x8*)(lds + PG8_SB(b, h) + boff + n * 2048 + k * 1024); } while (0)
#define PG8_MMA(ai, bj, At, Bt) do { __builtin_amdgcn_s_setprio(1); _Pragma("unroll") for (int m = 0; m < 4; ++m) _Pragma("unroll") for (int n = 0; n < 2; ++n) _Pragma("unroll") for (int k = 0; k < 2; ++k) \
        acc[ai][bj][m][n] = __builtin_amdgcn_mfma_f32_16x16x32_bf16(Bt[n][k], At[m][k], acc[ai][bj][m][n], 0, 0, 0); __builtin_amdgcn_s_setprio(0); } while (0)
#define PG8_WAIT_V(n) asm volatile("s_waitcnt vmcnt(" #n ")" ::: "memory")
#define PG8_WAIT_L(n) asm volatile("s_waitcnt lgkmcnt(" #n ")" ::: "memory")
#define PG8_BAR __builtin_amdgcn_s_barrier()
#define PG8_SCHED __builtin_amdgcn_sched_barrier(0)
    Unit cur, nxt; int ui = 0;
    if (!S.next(0, cur)) return;
    f32x4 acc[2][2][4][2];
#pragma unroll
    for (int a = 0; a < 2; ++a)
#pragma unroll
        for (int b = 0; b < 2; ++b)
#pragma unroll
            for (int m = 0; m < 4; ++m)
#pragma unroll
                for (int n = 0; n < 2; ++n) acc[a][b][m][n] = (f32x4){0.f, 0.f, 0.f, 0.f};
    bf16x8 At[4][2], B0[2][2], B1[2][2];
    const char* cA = cur.A; const char* cB = cur.Bt;
    if constexpr (GATH) { PG8_LOAD_RO(cur, roC); }
    PG8_STAGE(PG8_SB(0, 0), cB, voffB); PG8_STAGE_A(PG8_SA(0, 0), cA, 0, roC); PG8_STAGE(PG8_SB(0, 1), cB + hstep, voffB); PG8_STAGE_A(PG8_SA(0, 1), cA, 1, roC);
    if (wr == 1) PG8_BAR;
    PG8_WAIT_V(4); PG8_BAR;
    PG8_STAGE(PG8_SB(1, 0), cB + kstep, voffB); PG8_STAGE_A(PG8_SA(1, 0), cA + kstep, 0, roC); PG8_STAGE(PG8_SB(1, 1), cB + hstep + kstep, voffB);
    PG8_WAIT_V(6); PG8_BAR;
    for (;;) {
        const bool has_next = S.next(ui + 1, nxt);
        const char* nA = has_next ? nxt.A : cA; const char* nB = has_next ? nxt.Bt : cB;
        if constexpr (GATH) { if (has_next) { PG8_LOAD_RO(nxt, roN); } else { _Pragma("unroll") for (int _h = 0; _h < 2; ++_h) _Pragma("unroll") for (int _i = 0; _i < 2; ++_i) roN[_h][_i] = roC[_h][_i]; } }
        for (int t = 0; t < nt; t += 2) {
            const bool last = (t == nt - 2);
            const char* a1 = cA + (size_t)(t + 1) * kstep;
            const char* a2 = last ? nA : cA + (size_t)(t + 2) * kstep; const char* b2 = last ? nB : cB + (size_t)(t + 2) * kstep;
            const char* a3 = a2 + kstep; const char* b3 = b2 + kstep;
            unsigned ro2[2][2];
            if constexpr (GATH) { _Pragma("unroll") for (int _h = 0; _h < 2; ++_h) _Pragma("unroll") for (int _i = 0; _i < 2; ++_i) ro2[_h][_i] = last ? roN[_h][_i] : roC[_h][_i]; }
            (void)ro2;
            PG8_LDB(B0, 0, 0); PG8_SCHED; PG8_LDA(At, 0, 0); PG8_STAGE_A(PG8_SA(1, 1), a1, 1, roC);
            PG8_WAIT_L(8); PG8_BAR; PG8_WAIT_L(0); PG8_MMA(0, 0, At, B0); PG8_BAR; PG8_SCHED;
            PG8_LDB(B1, 0, 1); PG8_STAGE(PG8_SB(0, 0), b2, voffB);
            PG8_BAR; PG8_WAIT_L(0); PG8_MMA(0, 1, At, B1); PG8_BAR;
            PG8_LDA(At, 0, 1); PG8_STAGE_A(PG8_SA(0, 0), a2, 0, ro2);
            PG8_BAR; PG8_WAIT_L(0); PG8_MMA(1, 0, At, B0); PG8_BAR; PG8_SCHED;
            PG8_STAGE(PG8_SB(0, 1), b2 + hstep, voffB);
            PG8_WAIT_V(6); PG8_BAR; PG8_MMA(1, 1, At, B1); PG8_BAR;
            PG8_LDB(B0, 1, 0); PG8_SCHED; PG8_LDA(At, 1, 0); PG8_STAGE_A(PG8_SA(0, 1), a2, 1, ro2);
            PG8_WAIT_L(8); PG8_BAR; PG8_WAIT_L(0); PG8_MMA(0, 0, At, B0); PG8_BAR; PG8_SCHED;
            PG8_LDB(B1, 1, 1); PG8_STAGE(PG8_SB(1, 0), b3, voffB);
            PG8_BAR; PG8_WAIT_L(0); PG8_MMA(0, 1, At, B1); PG8_BAR;
            PG8_LDA(At, 1, 1); PG8_STAGE_A(PG8_SA(1, 0), a3, 0, ro2);
            PG8_BAR; PG8_WAIT_L(0); PG8_MMA(1, 0, At, B0); PG8_BAR; PG8_SCHED;
            PG8_STAGE(PG8_SB(1, 1), b3 + hstep, voffB);
            PG8_WAIT_V(6); PG8_BAR; PG8_MMA(1, 1, At, B1); PG8_BAR;
        }
        E(acc, cur, wr, wc, fr, fq);
        if (!has_next) break;
#pragma unroll
        for (int a = 0; a < 2; ++a)
#pragma unroll
            for (int b = 0; b < 2; ++b)
#pragma unroll
                for (int m = 0; m < 4; ++m)
#pragma unroll
                    for (int n = 0; n < 2; ++n) acc[a][b][m][n] = (f32x4){0.f, 0.f, 0.f, 0.f};
        cur = nxt; cA = nA; cB = nB; ++ui;
        if constexpr (GATH) { _Pragma("unroll") for (int _h = 0; _h < 2; ++_h) _Pragma("unroll") for (int _i = 0; _i < 2; ++_i) roC[_h][_i] = roN[_h][_i]; }
    }
    PG8_WAIT_V(0);
    if (wr == 0) PG8_BAR;
    PG8_BAR;
#undef PG8_SA
#undef PG8_SB
#undef PG8_STAGE
#undef PG8_STAGE_A
#undef PG8_LOAD_RO
#undef PG8_LDA
#undef PG8_LDB
#undef PG8_MMA
#undef PG8_WAIT_V
#undef PG8_WAIT_L
#undef PG8_BAR
#undef PG8_SCHED
}

struct EpiStoreBf16 {
    static constexpr bool PERM = true;
    __device__ __forceinline__ void operator()(const f32x4 (&acc)[2][2][4][2], const Unit& u, int wr, int wc, int fr, int fq) const {
        bf16_t* O = u.out; const int ldc = u.ldo;
        const int row0 = u.x0 + wr * 64 + fr, col0 = u.x1 + wc * 32 + 8 * fq;
#pragma unroll
        for (int ai = 0; ai < 2; ++ai)
#pragma unroll
            for (int m = 0; m < 4; ++m) { bf16_t* rowp = O + (size_t)(row0 + ai * HALF + m * 16) * ldc + col0;
#pragma unroll
                for (int bj = 0; bj < 2; ++bj) { const f32x4 v0 = acc[ai][bj][m][0], v1 = acc[ai][bj][m][1];
                    u32x4 w; w.x = cvt_pk_bf16(v0[0], v0[1]); w.y = cvt_pk_bf16(v0[2], v0[3]); w.z = cvt_pk_bf16(v1[0], v1[1]); w.w = cvt_pk_bf16(v1[2], v1[3]);
                    *(u32x4*)(rowp + bj * HALF) = w; } }
    }
};
}

namespace mk {
struct NMapId { int off; __device__ __forceinline__ int operator()(int n) const { return n + off; } __device__ __forceinline__ float scl(int) const { return 1.0f; } };
struct NMapInterleave { int which; __device__ __forceinline__ int operator()(int n) const { return 2 * n + which; } __device__ __forceinline__ float scl(int) const { return 1.0f; } };
struct NMapRope { __device__ __forceinline__ int operator()(int n) const { if (n >= 2048) return n; const int ch = n >> 6, c = n & 63, half = c >> 5, w = c & 31, z = w >> 4, i = w & 15; return ch * 64 + half * 32 + 2 * i + z; }
  __device__ __forceinline__ float scl(int n) const { return n < 1024 ? 0.125f * 1.4426950408889634f : 1.0f; } };

template <class NMap>
__device__ __forceinline__ void cvt_tile(const float* __restrict__ src, int ldsrc, int K, bf16_t* __restrict__ dst, int k0, int n0, const NMap& nmap, LAS float* tile) {
  const int t = mk::otid();
  { const int k = t >> 3, c = (t & 7) * 8; const float* p = src + (size_t)(k0 + k) * ldsrc + n0 + c;
    const f32x4 a = *(const f32x4*)p, b = *(const f32x4*)(p + 4);
    LAS float* q = tile + k * 65 + c; q[0] = a[0]; q[1] = a[1]; q[2] = a[2]; q[3] = a[3]; q[4] = b[0]; q[5] = b[1]; q[6] = b[2]; q[7] = b[3]; }
  __syncthreads();
  { const int n = t >> 3, kc = (t & 7) * 8; const LAS float* q = tile + kc * 65 + n; const float sc = nmap.scl(n0 + n);
    u32x4 w; w.x = cvt_pk_bf16(q[0] * sc, q[65] * sc); w.y = cvt_pk_bf16(q[130] * sc, q[195] * sc); w.z = cvt_pk_bf16(q[260] * sc, q[325] * sc); w.w = cvt_pk_bf16(q[390] * sc, q[455] * sc);
    *(u32x4*)(dst + (size_t)nmap(n0 + n) * K + k0 + kc) = w; }
  __syncthreads();
}
template <class NMap>
__device__ __forceinline__ int cvt_matrix(const float* src, int ldsrc, int K, int N, bf16_t* dst, const NMap& nmap, LAS float* tile, int ubase, int bid, int nblk) {
  const int nkt = K / 64, nnt = N / 64, tot = nkt * nnt;
  int first = ubase + ((bid - ubase % nblk) + nblk) % nblk;
  for (int u = first; u < ubase + tot; u += nblk) { const int v = u - ubase; cvt_tile(src, ldsrc, K, dst, (v / nnt) * 64, (v % nnt) * 64, nmap, tile); }
  return tot;
}
}

namespace att {
using namespace mk;
constexpr int KB_BYTES = 64 * 128, VB_BYTES = 128 * 128, TILE_BYTES = KB_BYTES + VB_BYTES, DA_RING = 4, DA_LDS = DA_RING * TILE_BYTES;
__device__ __forceinline__ int pi32(int r) { return (r & ~12) | ((r & 4) << 1) | ((r & 8) >> 1); }
__device__ __forceinline__ int swz(int row, int chunk) { return row * 128 + ((chunk ^ ((row >> 1) & 7)) << 4); }
__device__ __forceinline__ int crow(int r, int hi) { return (r & 3) + 8 * (r >> 2) + 4 * hi; }

__device__ __forceinline__ float sumsq8(u32x4 w) { return (bflo(w.x) * bflo(w.x) + bfhi(w.x) * bfhi(w.x)) + (bflo(w.y) * bflo(w.y) + bfhi(w.y) * bfhi(w.y)) + (bflo(w.z) * bflo(w.z) + bfhi(w.z) * bfhi(w.z)) + (bflo(w.w) * bflo(w.w) + bfhi(w.w) * bfhi(w.w)); }
__device__ __forceinline__ void knorm_group(const bf16_t* __restrict__ Pqk, float* __restrict__ KN, int g, LAS float* red) {
  const int tid = mk::otid(), wid = tid >> 6, lane = tid & 63;
  float mx = 0.f, mq = 0.f;
  for (int i0 = 0; i0 < 160; i0 += 32) {
    u32x4 a[4], b[4], c[4], d[4];
#pragma unroll
    for (int j = 0; j < 4; ++j) { int i = i0 + j * 8 + wid; i = i < 132 ? i : wid; const int row = i < 128 ? g * 128 + i : NLAT + g * 4 + (i - 128);
      const bf16_t* kp = Pqk + (size_t)row * 2048 + 1024 + lane * 16; a[j] = *(const u32x4*)kp; b[j] = *(const u32x4*)(kp + 8); c[j] = *(const u32x4*)(kp - 1024); d[j] = *(const u32x4*)(kp - 1024 + 8); }
#pragma unroll
    for (int j = 0; j < 4; ++j) { float s = sumsq8(a[j]) + sumsq8(b[j]); s += dpp_mov<0xB1, 0xf, 0xf>(s, s); s += dpp_mov<0x4E, 0xf, 0xf>(s, s); mx = fmaxf(mx, s);
      float q = sumsq8(c[j]) + sumsq8(d[j]); q += dpp_mov<0xB1, 0xf, 0xf>(q, q); q += dpp_mov<0x4E, 0xf, 0xf>(q, q); mq = fmaxf(mq, q); }
  }
  if ((lane & 3) == 0) { red[wid * 32 + (lane >> 2)] = mx; red[wid * 32 + 16 + (lane >> 2)] = mq; }
  __syncthreads();
  if (tid < 32) { float m = red[tid];
#pragma unroll
    for (int w = 1; w < 8; ++w) m = fmaxf(m, red[w * 32 + tid]);
    KN[g * 32 + tid] = m; }
  __syncthreads();
}
__device__ __forceinline__ float nmax2_of(const float* __restrict__ KN, int b, int hh, int which) {
  return wave_max_u(KN[(b * 64 + (mk::otid() & 63)) * 32 + which * 16 + hh]);
}

template <bool STATIC, int ABL = 0>
__device__ __forceinline__ void diff_attn_unit(const bf16_t* __restrict__ Pqk, const bf16_t* __restrict__ Vt, bf16_t* __restrict__ O12, int hh, int q0, int klat0, int nlat, int kctx0, LAS unsigned char* lds) {
  const int tid = mk::otid(), wid = tid >> 6, lane = tid & 63, r = lane & 31, hi = lane >> 5;
  const int NT = (nlat + L) / 64, NTL = nlat / 64;
  const int wv = __builtin_amdgcn_readfirstlane(wid);
  const int drow = wv * 8 + (lane >> 3), dch = (lane & 7) ^ ((drow >> 1) & 7);
  const unsigned koff = (unsigned)(drow * 2048 + 1024 + hh * 64 + dch * 8) * 2u;
  const unsigned voff = (unsigned)(((hh >> 1) * 128 + drow) * NTOK + dch * 8) * 2u;
  bf16x8 qf[4];
  { const bf16_t* qp = Pqk + (size_t)(q0 + wid * 32 + r) * 2048 + hh * 64 + hi * 8;
#pragma unroll
    for (int ks = 0; ks < 4; ++ks) qf[ks] = *(const bf16x8*)(qp + ks * 16); }
  const unsigned kaddr0 = (unsigned)(pi32(r) * 128 + ((hi ^ ((pi32(r) >> 1) & 7)) << 4));
  const unsigned vaddr0 = (unsigned)(r * 128 + ((hi ^ ((r >> 1) & 7)) << 4)) + KB_BYTES;
  f32x16 o[4];
#pragma unroll
  for (int vb = 0; vb < 4; ++vb)
#pragma unroll
    for (int i = 0; i < 16; ++i) o[vb][i] = 0.f;
  float l_run = 0.f;
#define DA_DMA(t) do { const int tok = (t) < NTL ? klat0 + (t) * 64 : kctx0 + ((t) - NTL) * 64; LAS unsigned char* b_ = lds + ((t) & 3) * TILE_BYTES + wv * 1024; \
    const char* kt_ = (const char*)Pqk + (size_t)tok * 4096; const char* vt_ = (const char*)Vt + (size_t)tok * 2; \
    __builtin_amdgcn_global_load_lds((const unsigned*)(kt_ + koff), (LAS unsigned*)b_, 16, 0, 0); \
    __builtin_amdgcn_global_load_lds((const unsigned*)(vt_ + voff), (LAS unsigned*)(b_ + KB_BYTES), 16, 0, 0); \
    __builtin_amdgcn_global_load_lds((const unsigned*)(vt_ + (size_t)64 * NTOK * 2 + voff), (LAS unsigned*)(b_ + KB_BYTES + 8192), 16, 0, 0); } while (0)
#define DA_WAITV(n) asm volatile("s_waitcnt vmcnt(" #n ")" ::: "memory")
#define DA_PAIR_BEGIN(t) if (!(ABL & 8) && (t) + 2 < NT) { DA_DMA((t) + 2); DA_DMA((t) + 3); }
#define DA_SLOT(tt) const unsigned sb_ = (unsigned)(((tt) & 3) * TILE_BYTES); const LAS unsigned char* kb_ = lds + (kaddr0 + sb_); const LAS unsigned char* vb_ = lds + (vaddr0 + sb_)
#define DA_PAIR_END() do { DA_WAITV(0); asm volatile("s_waitcnt lgkmcnt(0)" ::: "memory"); if (!(ABL & 16)) __builtin_amdgcn_s_barrier(); } while (0)
  DA_DMA(0); DA_DMA(1);
  DA_WAITV(0); __builtin_amdgcn_s_barrier();
#define DA_XOR(ptr, x) ((const LAS unsigned char*)((unsigned)(size_t)(ptr) ^ (unsigned)(x)))
#define DA_KFRAG(ks) const LAS unsigned char* kp_ = DA_XOR(kb_, (ks) << 5); const bf16x8 a0 = (ABL & 2) ? qf[ks] : *(const LAS bf16x8*)kp_, a1 = (ABL & 2) ? qf[(ks) ^ 1] : *(const LAS bf16x8*)(kp_ + 4096)
#define DA_VFRAGS() bf16x8 va[4][4]; \
    _Pragma("unroll") for (int c4 = 0; c4 < 4; ++c4) { const LAS unsigned char* vp_ = DA_XOR(vb_, c4 << 5); \
      _Pragma("unroll") for (int vb = 0; vb < 4; ++vb) va[vb][c4] = (ABL & 1) ? qf[c4 ^ (vb & 3)] : *(const LAS bf16x8*)(vp_ + vb * 4096); }
#define DA_PACK_PV() bf16x8 pf[2][2]; \
    _Pragma("unroll") for (int s = 0; s < 2; ++s) { u32x4 w0, w1; \
      w0.x = cvt_pk_bf16(s0[8 * s + 0], s0[8 * s + 1]); w0.y = cvt_pk_bf16(s0[8 * s + 2], s0[8 * s + 3]); w0.z = cvt_pk_bf16(s0[8 * s + 4], s0[8 * s + 5]); w0.w = cvt_pk_bf16(s0[8 * s + 6], s0[8 * s + 7]); \
      w1.x = cvt_pk_bf16(s1[8 * s + 0], s1[8 * s + 1]); w1.y = cvt_pk_bf16(s1[8 * s + 2], s1[8 * s + 3]); w1.z = cvt_pk_bf16(s1[8 * s + 4], s1[8 * s + 5]); w1.w = cvt_pk_bf16(s1[8 * s + 6], s1[8 * s + 7]); \
      pf[0][s] = __builtin_bit_cast(bf16x8, w0); pf[1][s] = __builtin_bit_cast(bf16x8, w1); } \
    _Pragma("unroll") for (int vb = 0; vb < 4; ++vb) _Pragma("unroll") for (int kb = 0; kb < 2; ++kb) _Pragma("unroll") for (int s = 0; s < 2; ++s) \
      o[vb] = __builtin_amdgcn_mfma_f32_32x32x16_bf16(va[vb][kb * 2 + s], pf[kb][s], o[vb], 0, 0, 0)
  if constexpr (STATIC) {
    for (int t = 0; t < NT; t += 2) {
      DA_PAIR_BEGIN(t);
#pragma unroll
      for (int u = 0; u < 2; ++u) {
        DA_SLOT(t + u);
        f32x16 s0, s1;
#pragma unroll
        for (int i = 0; i < 16; ++i) { s0[i] = 0.f; s1[i] = 0.f; }
#pragma unroll
        for (int ks = 0; ks < 4; ++ks) { DA_KFRAG(ks); s0 = __builtin_amdgcn_mfma_f32_32x32x16_bf16(a0, qf[ks], s0, 0, 0, 0); s1 = __builtin_amdgcn_mfma_f32_32x32x16_bf16(a1, qf[ks], s1, 0, 0, 0); }
        DA_VFRAGS();
        if constexpr ((ABL & 32) != 0) {
          l_run += s0[0] + s1[0];
#pragma unroll
          for (int vb = 0; vb < 4; ++vb)
#pragma unroll
            for (int c4 = 0; c4 < 4; ++c4) o[vb] = __builtin_amdgcn_mfma_f32_32x32x16_bf16(va[vb][c4], qf[c4], o[vb], 0, 0, 0);
        } else {
          float ps = 0.f;
#pragma unroll
          for (int i = 0; i < 16; ++i) { s0[i] = (ABL & 4) ? s0[i] : __builtin_amdgcn_exp2f(s0[i]); ps += s0[i]; }
#pragma unroll
          for (int i = 0; i < 16; ++i) { s1[i] = (ABL & 4) ? s1[i] : __builtin_amdgcn_exp2f(s1[i]); ps += s1[i]; }
          l_run += ps;
          DA_PACK_PV();
        }
        if (u == 0) __builtin_amdgcn_sched_barrier(0);
      }
      DA_PAIR_END();
    }
  } else {
    constexpr float THR = 8.0f * 1.4426950408889634f;
    float m_run = -1e30f;
    for (int t = 0; t < NT; ++t) {
      if (!(t & 1)) DA_PAIR_BEGIN(t);
      DA_SLOT(t);
      f32x16 s0 = zero16(), s1 = zero16();
#pragma unroll
      for (int ks = 0; ks < 4; ++ks) { DA_KFRAG(ks); s0 = __builtin_amdgcn_mfma_f32_32x32x16_bf16(a0, qf[ks], s0, 0, 0, 0); s1 = __builtin_amdgcn_mfma_f32_32x32x16_bf16(a1, qf[ks], s1, 0, 0, 0); }
      float mx = fmaxf(s0[0], s1[0]);
#pragma unroll
      for (int i = 1; i < 16; ++i) mx = fmaxf(mx, fmaxf(s0[i], s1[i]));
      { const u32x2 sw = __builtin_amdgcn_permlane32_swap(__float_as_uint(mx), __float_as_uint(mx), false, false); mx = fmaxf(__uint_as_float(sw.x), __uint_as_float(sw.y)); }
      float alpha = 1.0f;
      if (!__all(mx - m_run <= THR)) {
        const float m_new = fmaxf(m_run, mx);
        alpha = __builtin_amdgcn_exp2f(m_run - m_new);
        m_run = m_new;
#pragma unroll
        for (int vb = 0; vb < 4; ++vb)
#pragma unroll
          for (int i = 0; i < 16; ++i) o[vb][i] *= alpha;
      }
      float ps = 0.f;
#pragma unroll
      for (int i = 0; i < 16; ++i) { s0[i] = __builtin_amdgcn_exp2f(s0[i] - m_run); ps += s0[i]; }
#pragma unroll
      for (int i = 0; i < 16; ++i) { s1[i] = __builtin_amdgcn_exp2f(s1[i] - m_run); ps += s1[i]; }
      l_run = l_run * alpha + ps;
      __builtin_amdgcn_sched_barrier(0);
      DA_VFRAGS();
      DA_PACK_PV();
      if (t & 1) DA_PAIR_END();
    }
  }
#undef DA_KFRAG
#undef DA_XOR
#undef DA_VFRAGS
#undef DA_PACK_PV
#undef DA_DMA
#undef DA_WAITV
#undef DA_PAIR_BEGIN
#undef DA_PAIR_END
#undef DA_SLOT
  float l_tot; { const u32x2 sw = __builtin_amdgcn_permlane32_swap(__float_as_uint(l_run), __float_as_uint(l_run), false, false); l_tot = __uint_as_float(sw.x) + __uint_as_float(sw.y); }
  const float inv = 1.0f / l_tot;
  const int te = mk::otid();
  bf16_t* op = O12 + (size_t)(q0 + (te >> 6) * 32 + (te & 31)) * 2048 + hh * 128 + 4 * ((te >> 5) & 1);
#pragma unroll
  for (int vb = 0; vb < 4; ++vb)
#pragma unroll
    for (int g = 0; g < 4; ++g) {
      u32x2 w; w.x = cvt_pk_bf16(o[vb][4 * g] * inv, o[vb][4 * g + 1] * inv); w.y = cvt_pk_bf16(o[vb][4 * g + 2] * inv, o[vb][4 * g + 3] * inv);
      *(u32x2*)(op + vb * 32 + 8 * g) = w;
    }
}

__device__ __forceinline__ void diff_combine_rows4(const bf16_t* __restrict__ O12, const float* __restrict__ subln_g, float lam, float oml, bf16_t* __restrict__ O, int row0, int h, int lane) {
  unsigned a[4], b[4];
#pragma unroll
  for (int i = 0; i < 4; ++i) { a[i] = *(const unsigned*)(O12 + (size_t)(row0 + i) * 2048 + (2 * h) * 128 + 2 * lane); b[i] = *(const unsigned*)(O12 + (size_t)(row0 + i) * 2048 + (2 * h + 1) * 128 + 2 * lane); }
  const float g0 = subln_g[2 * lane], g1 = subln_g[2 * lane + 1];
#pragma unroll
  for (int i = 0; i < 4; ++i) {
    const float x0 = bflo(a[i]) - lam * bflo(b[i]), x1 = bfhi(a[i]) - lam * bfhi(b[i]);
    const float ss = wave_sum_u(x0 * x0 + x1 * x1);
    const float rs = rsqrtf(ss * (1.0f / 128.0f) + 1e-5f) * oml;
    *(unsigned*)(O + (size_t)(row0 + i) * 1024 + h * 128 + 2 * lane) = cvt_pk_bf16(x0 * rs * g0, x1 * rs * g1);
  }
}
}

namespace natt {
using namespace mk;
using att::pi32; using att::swz;
constexpr int TB = 64 * 128;
constexpr int NA_LDS = 4 * TB + 2048;
__device__ __forceinline__ void na_attn_unit(const bf16_t* __restrict__ Pe, const bf16_t* __restrict__ Vte, const float* __restrict__ rpb_h, bf16_t* __restrict__ O, int b, int h, int rq, LAS unsigned char* lds) {
  const int tid = mk::otid(), wid = tid >> 6, lane = tid & 63, r = lane & 31, hi = lane >> 5;
  constexpr float LOG2E = 1.4426950408889634f;
  LAS float* sb = (LAS float*)(lds + 4 * TB);
  for (int i = tid; i < 465; i += NTHR) sb[i] = rpb_h[i];
  const bool is_ctx = rq < 0;
  int qrow = 0, qcol = 0, qtok, rs_q = 0, cs_q = 0, span0 = 0, wlo = 0, whi = -1, lo = 0, ntl = 0;
  if (!is_ctx) {
    const int r0 = rq * 4, ra = r0 + (wid >> 2) * 2;
    qrow = ra + (r >> 4); qcol = (wid & 3) * 16 + (r & 15); qtok = b * T + qrow * 64 + qcol;
    rs_q = min(max(qrow - 4, 0), 120); cs_q = min(max(qcol - 8, 0), 48);
    span0 = min(max((wid & 3) * 16 - 8, 0), 32);
    wlo = min(max(ra - 4, 0), 120); whi = min(max(ra - 3, 0), 120) + 7;
    lo = min(max(r0 - 4, 0), 120); const int hi_ = min(max(r0 - 1, 0), 120) + 7; ntl = hi_ - lo + 1;
  } else qtok = NLAT + b * L + wid * 32 + r;
  const int NT = ntl + 4;
  const int srow = tid >> 3, sch = tid & 7;
  const bf16_t* kbase = Pe + 512 + h * 64 + sch * 8;
  const bf16_t* vbase = Vte + (size_t)(h * 64 + srow) * NTOK + sch * 8;
  const int sdst = swz(srow, sch);
  bf16x8 qf[4];
  { const bf16_t* qp = Pe + (size_t)qtok * 1024 + h * 64 + hi * 8;
#pragma unroll
    for (int ks = 0; ks < 4; ++ks) qf[ks] = *(const bf16x8*)(qp + ks * 16); }
  const int kx = (pi32(r) >> 1) & 7, vx = (r >> 1) & 7;
  const int ka_loc = (span0 + pi32(r)) * 128; const int kx_loc = ((span0 + pi32(r)) >> 1) & 7;
  f32x16 o[2];
#pragma unroll
  for (int vb = 0; vb < 2; ++vb)
#pragma unroll
    for (int i = 0; i < 16; ++i) o[vb][i] = 0.f;
  float m_run = -1e30f, l_run = 0.f;
  u32x4 kreg, vreg;
#define NA_LOAD(t) do { const int tok = (t) < ntl ? b * T + (lo + (t)) * 64 : NLAT + b * L + ((t) - ntl) * 64; \
    kreg = *(const u32x4*)(kbase + (size_t)(tok + srow) * 1024); vreg = *(const u32x4*)(vbase + tok); } while (0)
#define NA_WRITE(bufi) do { *(LAS u32x4*)(lds + (bufi) * TB + sdst) = kreg; *(LAS u32x4*)(lds + 2 * TB + (bufi) * TB + sdst) = vreg; } while (0)
  NA_LOAD(0); NA_WRITE(0); __syncthreads();
  for (int t = 0; t < NT; ++t) {
    const bool more = t + 1 < NT;
    if (more) NA_LOAD(t + 1);
    const LAS unsigned char* kb_ = lds + (t & 1) * TB; const LAS unsigned char* vb_ = lds + 2 * TB + (t & 1) * TB;
    const bool local = t < ntl; const int kr = lo + t;
    const bool active = !local || (kr >= wlo && kr <= whi);
    if (active) {
      f32x16 s0, s1;
#pragma unroll
      for (int i = 0; i < 16; ++i) { s0[i] = 0.f; s1[i] = 0.f; }
      if (local) {
#pragma unroll
        for (int ks = 0; ks < 4; ++ks) {
          const bf16x8 a0 = *(const LAS bf16x8*)(kb_ + ka_loc + (((ks * 2 + hi) ^ kx_loc) << 4));
          s0 = __builtin_amdgcn_mfma_f32_32x32x16_bf16(a0, qf[ks], s0, 0, 0, 0);
        }
        const bool row_ok = kr >= rs_q && kr < rs_q + 8; const int dr31 = (kr - qrow + 7) * 31;
#pragma unroll
        for (int i = 0; i < 16; ++i) {
          const int kc = span0 + (i & 7) + 8 * hi + 16 * (i >> 3);
          const bool ok = row_ok && kc >= cs_q && kc < cs_q + 16;
          const int bi = ok ? dr31 + (kc - qcol + 15) : 0;
          const float bv = sb[bi];
          s0[i] = ok ? fmaf(s0[i], 0.125f, bv) : -1e30f; s1[i] = -1e30f;
        }
      } else {
#pragma unroll
        for (int ks = 0; ks < 4; ++ks) {
          const int ch = ((ks * 2 + hi) ^ kx) << 4;
          const bf16x8 a0 = *(const LAS bf16x8*)(kb_ + pi32(r) * 128 + ch), a1 = *(const LAS bf16x8*)(kb_ + (32 + pi32(r)) * 128 + ch);
          s0 = __builtin_amdgcn_mfma_f32_32x32x16_bf16(a0, qf[ks], s0, 0, 0, 0);
          s1 = __builtin_amdgcn_mfma_f32_32x32x16_bf16(a1, qf[ks], s1, 0, 0, 0);
        }
#pragma unroll
        for (int i = 0; i < 16; ++i) { s0[i] *= 0.125f; s1[i] *= 0.125f; }
      }
      float mx = s0[0];
#pragma unroll
      for (int i = 1; i < 16; ++i) mx = fmaxf(mx, s0[i]);
#pragma unroll
      for (int i = 0; i < 16; ++i) mx = fmaxf(mx, s1[i]);
      { const u32x2 sw = __builtin_amdgcn_permlane32_swap(__float_as_uint(mx), __float_as_uint(mx), false, false); mx = fmaxf(__uint_as_float(sw.x), __uint_as_float(sw.y)); }
      const float m_new = fmaxf(m_run, mx);
      const float alpha = __builtin_amdgcn_exp2f((m_run - m_new) * LOG2E);
      m_run = m_new;
      const float mc = -m_new * LOG2E;
      float ps = 0.f;
#pragma unroll
      for (int i = 0; i < 16; ++i) { const float p = s0[i] > -1e29f ? __builtin_amdgcn_exp2f(fmaf(s0[i], LOG2E, mc)) : 0.f; s0[i] = p; ps += p; }
#pragma unroll
      for (int i = 0; i < 16; ++i) { const float p = s1[i] > -1e29f ? __builtin_amdgcn_exp2f(fmaf(s1[i], LOG2E, mc)) : 0.f; s1[i] = p; ps += p; }
      l_run = l_run * alpha + ps;
      if (__any(alpha < 1.0f)) {
#pragma unroll
        for (int vb = 0; vb < 2; ++vb)
#pragma unroll
          for (int i = 0; i < 16; ++i) o[vb][i] *= alpha;
      }
      bf16x8 pf[2][2];
#pragma unroll
      for (int s = 0; s < 2; ++s) {
        u32x4 w0, w1;
        w0.x = cvt_pk_bf16(s0[8 * s + 0], s0[8 * s + 1]); w0.y = cvt_pk_bf16(s0[8 * s + 2], s0[8 * s + 3]); w0.z = cvt_pk_bf16(s0[8 * s + 4], s0[8 * s + 5]); w0.w = cvt_pk_bf16(s0[8 * s + 6], s0[8 * s + 7]);
        w1.x = cvt_pk_bf16(s1[8 * s + 0], s1[8 * s + 1]); w1.y = cvt_pk_bf16(s1[8 * s + 2], s1[8 * s + 3]); w1.z = cvt_pk_bf16(s1[8 * s + 4], s1[8 * s + 5]); w1.w = cvt_pk_bf16(s1[8 * s + 6], s1[8 * s + 7]);
        pf[0][s] = __builtin_bit_cast(bf16x8, w0); pf[1][s] = __builtin_bit_cast(bf16x8, w1);
      }
      const int cbase = local ? (span0 >> 3) : 0;
#pragma unroll
      for (int vb = 0; vb < 2; ++vb) {
        const LAS unsigned char* vrow = vb_ + (vb * 32 + r) * 128;
#pragma unroll
        for (int s = 0; s < 2; ++s) {
          const bf16x8 a = *(const LAS bf16x8*)(vrow + (((cbase + 2 * s + hi) ^ vx) << 4));
          o[vb] = __builtin_amdgcn_mfma_f32_32x32x16_bf16(a, pf[0][s], o[vb], 0, 0, 0);
        }
        if (!local) {
#pragma unroll
          for (int s = 0; s < 2; ++s) {
            const bf16x8 a = *(const LAS bf16x8*)(vrow + (((4 + 2 * s + hi) ^ vx) << 4));
            o[vb] = __builtin_amdgcn_mfma_f32_32x32x16_bf16(a, pf[1][s], o[vb], 0, 0, 0);
          }
        }
      }
    }
    if (more) NA_WRITE((t + 1) & 1);
    __syncthreads();
  }
#undef NA_LOAD
#undef NA_WRITE
  float l_tot; { const u32x2 sw = __builtin_amdgcn_permlane32_swap(__float_as_uint(l_run), __float_as_uint(l_run), false, false); l_tot = __uint_as_float(sw.x) + __uint_as_float(sw.y); }
  const float inv = 1.0f / l_tot;
  bf16_t* op = O + (size_t)qtok * 1024 + h * 64 + 4 * hi;
#pragma unroll
  for (int vb = 0; vb < 2; ++vb)
#pragma unroll
    for (int g = 0; g < 4; ++g) {
      u32x2 w; w.x = cvt_pk_bf16(o[vb][4 * g] * inv, o[vb][4 * g + 1] * inv); w.y = cvt_pk_bf16(o[vb][4 * g + 2] * inv, o[vb][4 * g + 3] * inv);
      *(u32x2*)(op + vb * 32 + 8 * g) = w;
    }
}
}

namespace rw {
using namespace mk;
constexpr int NSTEP = L + T, NCH = 32, CL = NSTEP / NCH;
constexpr int NCHAIN = 2 * B * 8;
constexpr float LOG2E = 1.4426950408889634f;
struct Bufs {
  u32x2* SH;
  unsigned* DR;
  bf16_t* G; int gstride;
  float* CS;
  float* PQ;
  float* SST;
  bf16_t* Y;
  bf16_t* Z;
};

constexpr int XPITCH = 528;
__device__ __forceinline__ void lora_mfma(const LAS unsigned char* xb, int xcol0, const bf16_t* __restrict__ W, int K, int h, int lane, LAS float* tw, float (&out)[16]) {
  const int fr = lane & 15, fq = lane >> 4;
  f32x4 acc[4];
#pragma unroll
  for (int nb = 0; nb < 4; ++nb) { float z = 0.f; asm volatile("" : "+v"(z)); acc[nb] = (f32x4){z, z, z, z}; }
  for (int ks = 0; ks < K / 32; ++ks) {
    const bf16x8 xf = *(const LAS bf16x8*)(xb + fr * XPITCH + (xcol0 + ks * 32 + fq * 8) * 2);
    bf16x8 wf[4];
#pragma unroll
    for (int nb = 0; nb < 4; ++nb) wf[nb] = *(const bf16x8*)(W + (size_t)(h * 64 + nb * 16 + fr) * K + ks * 32 + fq * 8);
#pragma unroll
    for (int nb = 0; nb < 4; ++nb) acc[nb] = __builtin_amdgcn_mfma_f32_16x16x32_bf16(xf, wf[nb], acc[nb], 0, 0, 0);
  }
#pragma unroll
  for (int nb = 0; nb < 4; ++nb) *(LAS f32x4*)(tw + (nb * 16 + fr) * 16 + fq * 4) = acc[nb];
  __builtin_amdgcn_wave_barrier(); asm volatile("s_waitcnt lgkmcnt(0)" ::: "memory"); __builtin_amdgcn_wave_barrier();
#pragma unroll
  for (int q = 0; q < 4; ++q) { const f32x4 v = *(const LAS f32x4*)(tw + lane * 16 + q * 4); out[q * 4] = v[0]; out[q * 4 + 1] = v[1]; out[q * 4 + 2] = v[2]; out[q * 4 + 3] = v[3]; }
  __builtin_amdgcn_wave_barrier(); asm volatile("s_waitcnt lgkmcnt(0)" ::: "memory"); __builtin_amdgcn_wave_barrier();
}
__device__ __forceinline__ void prep_tile(const bf16_t* __restrict__ Prw, const float* __restrict__ cw, const float* __restrict__ w0, const bf16_t* __restrict__ WLT, const float* __restrict__ a0,
                                          const float* __restrict__ k_k, const float* __restrict__ k_a, const float* __restrict__ r_k,
                                          const Bufs& bf, int tile, LAS float* xs  ) {
  const int c = mk::otid(), lane = c & 63, h = c >> 6;
  const int row0 = tile * 16;
  int lo, hi;
  if (row0 < NLAT) { lo = (row0 / T) * T; hi = lo + T - 1; } else { lo = NLAT + ((row0 - NLAT) / L) * L; hi = lo + L - 1; }
#define RW_CONV(dst, col) do { const float c0 = cw[(col)], c1 = cw[RW_IN + (col)], c2 = cw[2 * RW_IN + (col)]; const bf16_t* p = Prw + (col); \
    bf16_t raw[18]; \
    _Pragma("unroll") for (int j = 0; j < 18; ++j) { int rr = row0 - 1 + j; rr = rr < lo ? lo : (rr > hi ? hi : rr); raw[j] = p[(size_t)rr * RW_IN]; } \
    float pm = row0 > lo ? bf2f(raw[0]) : 0.f, pc = bf2f(raw[1]); \
    _Pragma("unroll") for (int tt = 0; tt < 16; ++tt) { const float pn = (row0 + tt + 1 <= hi) ? bf2f(raw[tt + 2]) : 0.f; dst[tt] = pm * c0 + pc * c1 + pn * c2; pm = pc; pc = pn; } } while (0)
  if (c < 256) {
    float xv[16]; RW_CONV(xv, 1536 + c);
#pragma unroll
    for (int tt = 0; tt < 16; ++tt) { float v = xv[tt]; if (c < 64) v = tanhf(v); else if (c >= 128) v = sigmoidf_(v); *(LAS bf16_t*)((LAS unsigned char*)xs + tt * XPITCH + c * 2) = f2bf(v); }
  }
  __syncthreads();
  const LAS unsigned char* xb = (const LAS unsigned char*)xs; LAS float* tw = xs + 20480 + h * 1024;
  const float w00 = w0[c], w01 = w0[512 + c], a00 = a0[c], a01 = a0[512 + c], kkc = k_k[c], kac = k_a[c], rkc = r_k[c];
  float e0[16], e1[16];
  {
    float aw0[16], aw1[16];
    lora_mfma(xb, 0, WLT, 64, h, lane, tw, aw0); lora_mfma(xb, 0, WLT + 32768, 64, h, lane, tw, aw1);
#pragma unroll
    for (int tt = 0; tt < 16; ++tt) {
      e0[tt] = 0.6065306597126334f * __builtin_amdgcn_rcpf(1.0f + __expf(-(w00 + aw0[tt])));
      e1[tt] = 0.6065306597126334f * __builtin_amdgcn_rcpf(1.0f + __expf(-(w01 + aw1[tt])));
    }
  }
  LAS float* asl = xs + 256 * 16;
  {
    float aa0[16], aa1[16];
    lora_mfma(xb, 64, WLT + 2 * 32768, 64, h, lane, tw, aa0); lora_mfma(xb, 64, WLT + 3 * 32768, 64, h, lane, tw, aa1);
#pragma unroll
    for (int tt = 0; tt < 16; ++tt) { const unsigned d0 = cvt_pk_bf16(e0[tt], sigmoidf_(a00 + aa0[tt])), d1 = cvt_pk_bf16(e1[tt], sigmoidf_(a01 + aa1[tt]));
      bf.DR[((size_t)(row0 + tt)) * 512 + c] = d0; bf.DR[((size_t)NTOK + row0 + tt) * 512 + c] = d1; asl[tt * 512 + c] = bfhi(d0); asl[(16 + tt) * 512 + c] = bfhi(d1); }
  }
  {
    float ag[16];
    lora_mfma(xb, 128, WLT + 4 * 32768, 128, h, lane, tw, ag);
#pragma unroll
    for (int tt = 0; tt < 16; ++tt) bf.G[(size_t)(row0 + tt) * bf.gstride + c] = f2bf(ag[tt]);
  }
#undef RW_CONV
  const float cr0 = cw[c], cr1 = cw[RW_IN + c], cr2 = cw[2 * RW_IN + c], ck0 = cw[512 + c], ck1 = cw[RW_IN + 512 + c], ck2 = cw[2 * RW_IN + 512 + c], cv0 = cw[1024 + c], cv1 = cw[RW_IN + 1024 + c], cv2 = cw[2 * RW_IN + 1024 + c];
  const bf16_t* pr = Prw + (size_t)row0 * RW_IN + c;
  const bf16_t* prm = Prw + (size_t)(row0 > lo ? row0 - 1 : row0) * RW_IN + c;
  const bf16_t rm_ = prm[0], km_ = prm[512], vm_ = prm[1024];
  float rm = row0 > lo ? bf2f(rm_) : 0.f, km = row0 > lo ? bf2f(km_) : 0.f, vm = row0 > lo ? bf2f(vm_) : 0.f;
  float rc = bf2f(pr[0]), kc = bf2f(pr[512]), vc = bf2f(pr[1024]);
#pragma unroll 2
  for (int tt = 0; tt < 16; ++tt) {
    const int row = row0 + tt;
    const bool has_n = row + 1 <= hi; const bf16_t* pn = pr + (size_t)(has_n ? tt + 1 : tt) * RW_IN;
    const bf16_t rn_ = pn[0], kn_ = pn[512], vn_ = pn[1024];
    const float rn = has_n ? bf2f(rn_) : 0.f, kn = has_n ? bf2f(kn_) : 0.f, vn = has_n ? bf2f(vn_) : 0.f;
    const float rv = rm * cr0 + rc * cr1 + rn * cr2, kvv = km * ck0 + kc * ck1 + kn * ck2, vvv = vm * cv0 + vc * cv1 + vn * cv2;
    rm = rc; rc = rn; km = kc; kc = kn; vm = vc; vc = vn;
    float kk = kvv * kkc; const float nrm = sqrtf(wave_sum_u(kk * kk)); kk = kk * __builtin_amdgcn_rcpf(fmaxf(nrm, 1e-12f));
    u32x2 sh; sh.x = cvt_pk_bf16(rv, kvv); sh.y = cvt_pk_bf16(kk, vvv);
    bf.SH[(size_t)row * 512 + c] = sh;
    const float rq = bflo(sh.x), kq = bfhi(sh.x);
    const float cb0 = wave_sum_u(rq * kq * (1.0f + (asl[tt * 512 + c] - 1.0f) * kac) * rkc), cb1 = wave_sum_u(rq * kq * (1.0f + (asl[(16 + tt) * 512 + c] - 1.0f) * kac) * rkc);
    if (lane == 0) { bf.CS[(size_t)row * 16 + h] = cb0; bf.CS[(size_t)row * 16 + 8 + h] = cb1; }
  }
  __syncthreads();
}

struct StepRaw { u32x2 s; unsigned d; };
__device__ __forceinline__ int scan_row(int dir, int b, int p) {
  if (p < L) return NLAT + b * L + (dir ? (L - 1 - p) : p);
  const int q = p - L; return b * T + (dir ? (T - 1 - q) : q);
}
__device__ __forceinline__ void scan_unit(const Bufs& bf, const float* __restrict__ k_a, int chain, int chunk, LAS float* wl) {
  const int lane = mk::otid() & 63, r = lane & 31, hi = lane >> 5;
  const int dir = chain >> 5, b = (chain >> 3) & 3, h = chain & 7, ch = h * 64 + lane;
  const float kac = k_a[ch];
  f32x16 TS[2][2], TP[2][2];
#pragma unroll
  for (int rb = 0; rb < 2; ++rb)
#pragma unroll
    for (int cb = 0; cb < 2; ++cb)
#pragma unroll
      for (int q = 0; q < 16; ++q) { TS[rb][cb][q] = 0.f; TP[rb][cb][q] = (32 * rb + (q & 3) + 8 * (q >> 2) + 4 * hi == 32 * cb + r) ? 1.f : 0.f; }
  LAS unsigned char* wb = (LAS unsigned char*)wl;
  const LAS unsigned char* avec = wb + (r == 1 ? 128 : 0) + 8 * hi;
  const int p0 = chunk * CL;
  const u32x4 zero4 = (u32x4){0u, 0u, 0u, 0u};
  StepRaw nx; { const int row = scan_row(dir, b, p0); nx.s = bf.SH[(size_t)row * 512 + ch]; nx.d = bf.DR[((size_t)dir * NTOK + row) * 512 + ch]; }
  float r_prev = 0.f; int row_prev = 0;
#define RW_DOTS(T, o) do { _Pragma("unroll") for (int cb = 0; cb < 2; ++cb) _Pragma("unroll") for (int q = 0; q < 16; ++q) o[cb][q] = 0.f; \
    _Pragma("unroll") for (int rb = 0; rb < 2; ++rb) _Pragma("unroll") for (int s2 = 0; s2 < 2; ++s2) _Pragma("unroll") for (int cb = 0; cb < 2; ++cb) { u32x4 w_; \
      w_.x = cvt_pk_bf16_v(T[rb][cb][8 * s2 + 0], T[rb][cb][8 * s2 + 1]); w_.y = cvt_pk_bf16_v(T[rb][cb][8 * s2 + 2], T[rb][cb][8 * s2 + 3]); \
      w_.z = cvt_pk_bf16_v(T[rb][cb][8 * s2 + 4], T[rb][cb][8 * s2 + 5]); w_.w = cvt_pk_bf16_v(T[rb][cb][8 * s2 + 6], T[rb][cb][8 * s2 + 7]); \
      o[cb] = __builtin_amdgcn_mfma_f32_32x32x16_bf16(afr[rb][s2], __builtin_bit_cast(bf16x8, w_), o[cb], 0, 0, 0); \
      asm volatile("" : "+v"(o[cb]) : "v"(w_), "v"(afr[rb][s2]));   } } while (0)
#define RW_AFRAGS() do { _Pragma("unroll") for (int rb = 0; rb < 2; ++rb) _Pragma("unroll") for (int s2 = 0; s2 < 2; ++s2) { \
      const u32x2 lo_ = *(const LAS u32x2*)(avec + (32 * rb + 16 * s2) * 2), hi_ = *(const LAS u32x2*)(avec + (32 * rb + 16 * s2 + 8) * 2); \
      afr[rb][s2] = __builtin_bit_cast(bf16x8, (u32x4){lo_.x, lo_.y, hi_.x, hi_.y}); } } while (0)
  bf16x8 afr[2][2]; f32x16 oS[2], oP[2];
  for (int s = 0; s < CL; ++s) {
    const StepRaw cu = nx; const int row = scan_row(dir, b, p0 + s);
    if (s + 1 < CL) { const int rn = scan_row(dir, b, p0 + s + 1); nx.s = bf.SH[(size_t)rn * 512 + ch]; nx.d = bf.DR[((size_t)dir * NTOK + rn) * 512 + ch]; }
    const float rr = bflo(cu.s.x), k = bfhi(cu.s.x), kk = bflo(cu.s.y), v = bfhi(cu.s.y), e = bflo(cu.d), asg = bfhi(cu.d);
    const float w = __builtin_amdgcn_exp2f(-e * LOG2E), a = -kk, bb = kk * asg, keff = k * (1.0f + (asg - 1.0f) * kac);
    ((LAS bf16_t*)wb)[lane] = f2bf(a); ((LAS bf16_t*)wb)[64 + lane] = f2bf(r_prev); wl[64 + lane] = w;
    __builtin_amdgcn_wave_barrier();
    RW_AFRAGS();
    RW_DOTS(TS, oS); RW_DOTS(TP, oP);
#pragma unroll
    for (int rb = 0; rb < 2; ++rb)
#pragma unroll
      for (int g = 0; g < 4; ++g) { const f32x4 w4 = *(const LAS f32x4*)(wl + 64 + 32 * rb + 8 * g + 4 * hi);
#pragma unroll
        for (int cb = 0; cb < 2; ++cb)
#pragma unroll
          for (int u = 0; u < 4; ++u) { TS[rb][cb][4 * g + u] *= w4[u]; TP[rb][cb][4 * g + u] *= w4[u]; } }
    __builtin_amdgcn_wave_barrier();
    const u32x2 sb = __builtin_amdgcn_permlane32_swap(__float_as_uint(bb), __float_as_uint(bb), false, false), sk = __builtin_amdgcn_permlane32_swap(__float_as_uint(keff), __float_as_uint(keff), false, false),
                sv = __builtin_amdgcn_permlane32_swap(__float_as_uint(v), __float_as_uint(v), false, false);
    bf16x8 au[2], buS[2], buP[2];
#pragma unroll
    for (int q = 0; q < 2; ++q) { const float bq = __uint_as_float(q ? sb.y : sb.x), kq = __uint_as_float(q ? sk.y : sk.x), vq = __uint_as_float(q ? sv.y : sv.x);
      u32x4 x = zero4, y = zero4, z = zero4;
      if (!hi) { x.x = cvt_pk_bf16_v(bq, kq); y.x = cvt_pk_bf16_v(oS[q][0], vq); z.x = cvt_pk_bf16_v(oP[q][0], 0.f); }
      au[q] = __builtin_bit_cast(bf16x8, x); buS[q] = __builtin_bit_cast(bf16x8, y); buP[q] = __builtin_bit_cast(bf16x8, z); }
#pragma unroll
    for (int rb = 0; rb < 2; ++rb)
#pragma unroll
      for (int cb = 0; cb < 2; ++cb) { TS[rb][cb] = __builtin_amdgcn_mfma_f32_32x32x16_bf16(au[rb], buS[cb], TS[rb][cb], 0, 0, 0); TP[rb][cb] = __builtin_amdgcn_mfma_f32_32x32x16_bf16(au[rb], buP[cb], TP[rb][cb], 0, 0, 0); }
    if (s > 0 && !hi) { const size_t oi = ((size_t)dir * NTOK + row_prev) * 512 + h * 64 + r;
      bf.Y[oi] = (bf16_t)(cvt_pk_bf16_v(oS[0][1], 0.f) & 0xffffu); bf.Y[oi + 32] = (bf16_t)(cvt_pk_bf16_v(oS[1][1], 0.f) & 0xffffu); bf.Z[oi] = (bf16_t)(cvt_pk_bf16_v(oP[0][1], 0.f) & 0xffffu); bf.Z[oi + 32] = (bf16_t)(cvt_pk_bf16_v(oP[1][1], 0.f) & 0xffffu); }
    r_prev = rr; row_prev = row;
  }
  ((LAS bf16_t*)wb)[64 + lane] = f2bf(r_prev);
  __builtin_amdgcn_wave_barrier();
  RW_AFRAGS();
  RW_DOTS(TS, oS); RW_DOTS(TP, oP);
  if (!hi) { const size_t oi = ((size_t)dir * NTOK + row_prev) * 512 + h * 64 + r;
    bf.Y[oi] = (bf16_t)(cvt_pk_bf16_v(oS[0][1], 0.f) & 0xffffu); bf.Y[oi + 32] = (bf16_t)(cvt_pk_bf16_v(oS[1][1], 0.f) & 0xffffu); bf.Z[oi] = (bf16_t)(cvt_pk_bf16_v(oP[0][1], 0.f) & 0xffffu); bf.Z[oi + 32] = (bf16_t)(cvt_pk_bf16_v(oP[1][1], 0.f) & 0xffffu); }
  __builtin_amdgcn_wave_barrier();
#undef RW_DOTS
#undef RW_AFRAGS
  if (chunk < NCH - 1) {
    float* pq = bf.PQ + (((size_t)chain * (NCH - 1) + chunk) * 2) * 4096;
#pragma unroll
    for (int rb = 0; rb < 2; ++rb)
#pragma unroll
      for (int cb = 0; cb < 2; ++cb)
#pragma unroll
        for (int g = 0; g < 4; ++g) { float* q = pq + (size_t)(32 * cb + r) * 64 + 32 * rb + 8 * g + 4 * hi;
          *(f32x4*)q = (f32x4){TP[rb][cb][4 * g], TP[rb][cb][4 * g + 1], TP[rb][cb][4 * g + 2], TP[rb][cb][4 * g + 3]};
          *(f32x4*)(q + 4096) = (f32x4){TS[rb][cb][4 * g], TS[rb][cb][4 * g + 1], TS[rb][cb][4 * g + 2], TS[rb][cb][4 * g + 3]}; }
  }
}

__device__ __forceinline__ void propagate_chain(const Bufs& bf, int chain, int rq, LAS float* lds) {
  LAS float* Sl = lds; LAS float* Pl = lds + 16 * 65 + 15;
  Pl = lds + 1056;
  const int tid = mk::otid(), i = tid >> 5, jc = (tid & 31) * 2, row = rq * 16 + i, pi = tid >> 3, pj = (tid & 7) * 8;
  float* sst = bf.SST + (size_t)chain * NCH * 4096;
  Sl[i * 65 + jc] = 0.f; Sl[i * 65 + jc + 1] = 0.f;
  const float* pb = bf.PQ + ((size_t)chain * (NCH - 1) * 2) * 4096;
  f32x4 np0 = *(const f32x4*)(pb + pi * 64 + pj), np1 = *(const f32x4*)(pb + pi * 64 + pj + 4); f32x2 nq = *(const f32x2*)(pb + 4096 + row * 64 + jc);
  for (int c = 0; c < NCH - 1; ++c) {
    const f32x4 p0 = np0, p1 = np1; f32x2 q = nq;
    { const float* pn = pb + (size_t)(c + 1 < NCH - 1 ? c + 1 : c) * 2 * 4096;
      np0 = *(const f32x4*)(pn + pi * 64 + pj); np1 = *(const f32x4*)(pn + pi * 64 + pj + 4); nq = *(const f32x2*)(pn + 4096 + row * 64 + jc); }
    *(LAS f32x4*)(Pl + pi * 64 + pj) = p0; *(LAS f32x4*)(Pl + pi * 64 + pj + 4) = p1;
    __syncthreads();
#pragma unroll 16
    for (int k = 0; k < 64; ++k) { const float sv = Sl[i * 65 + k]; const f32x2 a = *(const LAS f32x2*)(Pl + k * 64 + jc); q += sv * a; }
    __syncthreads();
    Sl[i * 65 + jc] = q[0]; Sl[i * 65 + jc + 1] = q[1];
    *(f32x2*)(sst + (size_t)(c + 1) * 4096 + row * 64 + jc) = q;
  }
  __syncthreads();
}

__device__ __forceinline__ void corr_unit(const Bufs& bf, int chain, int chunk) {
  const int lane = mk::otid() & 63, r = lane & 31, hi = lane >> 5;
  const int dir = chain >> 5, b = (chain >> 3) & 3, h = chain & 7;
  const float* ss = bf.SST + ((size_t)chain * NCH + chunk) * 4096;
  bf16x8 bfr[2][4];
#pragma unroll
  for (int nt = 0; nt < 2; ++nt)
#pragma unroll
    for (int ks = 0; ks < 4; ++ks) { const float* q = ss + (size_t)(nt * 32 + r) * 64 + ks * 16 + hi * 8; const f32x4 x0 = *(const f32x4*)q, x1 = *(const f32x4*)(q + 4);
      u32x4 w; w.x = cvt_pk_bf16(x0[0], x0[1]); w.y = cvt_pk_bf16(x0[2], x0[3]); w.z = cvt_pk_bf16(x1[0], x1[1]); w.w = cvt_pk_bf16(x1[2], x1[3]); bfr[nt][ks] = __builtin_bit_cast(bf16x8, w); }
  const int p0 = chunk * CL;
  const size_t dbase = (size_t)dir * NTOK;
  for (int mt = 0; mt < (CL + 31) / 32; ++mt) {
    const int sa_ = min(mt * 32 + r, CL - 1);
    const bf16_t* zp = bf.Z + (dbase + scan_row(dir, b, p0 + sa_)) * 512 + h * 64 + hi * 8;
    bf16x8 af[4];
#pragma unroll
    for (int ks = 0; ks < 4; ++ks) af[ks] = *(const bf16x8*)(zp + ks * 16);
    f32x16 acc[2];
#pragma unroll
    for (int nt = 0; nt < 2; ++nt) { acc[nt] = zero16();
#pragma unroll
      for (int ks = 0; ks < 4; ++ks) acc[nt] = __builtin_amdgcn_mfma_f32_32x32x16_bf16(af[ks], bfr[nt][ks], acc[nt], 0, 0, 0); }
#pragma unroll
    for (int i = 0; i < 16; ++i) { const int so = mt * 32 + (i & 3) + 8 * (i >> 2) + 4 * hi;
      if (so < CL) { bf16_t* yp = bf.Y + (dbase + scan_row(dir, b, p0 + so)) * 512 + h * 64 + r;
        yp[0] = f2bf(bf2f(yp[0]) + acc[0][i]); yp[32] = f2bf(bf2f(yp[32]) + acc[1][i]); } }
  }
}

template <int NR>
__device__ __forceinline__ void finish_rows(const Bufs& bf, const float* __restrict__ gn_g, const float* __restrict__ gn_b, bf16_t* __restrict__ O, int row0) {
  const int c = mk::otid(), h = c >> 6;
  float y[NR], v[NR], g[NR], cs[NR];
#pragma unroll
  for (int i = 0; i < NR; ++i) { const int row = row0 + i;
    y[i] = bf2f(bf.Y[(size_t)row * 512 + c]) + bf2f(bf.Y[((size_t)NTOK + row) * 512 + c]);
    v[i] = bfhi(bf.SH[(size_t)row * 512 + c].y); g[i] = bf2f(bf.G[(size_t)row * bf.gstride + c]);
    cs[i] = bf.CS[(size_t)row * 16 + h] + bf.CS[(size_t)row * 16 + 8 + h]; }
  const float gg = gn_g[c], gb = gn_b[c];
  float o[NR];
#pragma unroll
  for (int i = 0; i < NR; ++i) { const float mu = wave_sum_u(y[i]) * (1.0f / 64.0f); const float dv = y[i] - mu; const float var = wave_sum_u(dv * dv) * (1.0f / 64.0f);
    o[i] = (dv * rsqrtf(var + 64e-5f) * gg + gb + cs[i] * v[i]) * g[i]; }
#pragma unroll
  for (int i = 0; i < NR; ++i) O[(size_t)(row0 + i) * 1024 + 512 + c] = f2bf(o[i]);
}
}

namespace mk {
constexpr size_t al256(size_t x) { return (x + 255) / 256 * 256; }
constexpr size_t WS_BAR = 0;
constexpr size_t WS_BCNT = al256(WS_BAR + (size_t)XCD_BAR_WORDS * 4);
constexpr size_t WS_MOFF = al256(WS_BCNT + (size_t)4 * 256 * 64 * 4);
constexpr size_t WS_KN = al256(WS_MOFF + 4 * 256);
constexpr size_t WS_MOD = al256(WS_KN + (size_t)2 * 256 * 32 * 4);
constexpr size_t WS_ROPE = al256(WS_MOD + (size_t)4 * 5 * 6144 * 4);
constexpr size_t WS_HBC = al256(WS_ROPE + 128 * 16 * 2 * 4);
constexpr size_t WS_EID = al256(WS_HBC + (size_t)NCTX * D * 2);
constexpr size_t WS_GATE = al256(WS_EID + (size_t)NTOK * 2 * 4);
constexpr size_t WS_POS = al256(WS_GATE + (size_t)NTOK * 2 * 4);
constexpr size_t WS_RL = al256(WS_POS + (size_t)NTOK * 2 * 4);
constexpr size_t WS_WEIN = al256(WS_RL + (size_t)MOE_ROWS * 4);
constexpr size_t WS_WOIN = al256(WS_WEIN + (size_t)2 * EVEN_IN * D * 2);
constexpr size_t WS_WEOUT = al256(WS_WOIN + (size_t)2 * ODD_IN * D * 2);
constexpr size_t WS_WOOUT = al256(WS_WEOUT + (size_t)2 * D * D * 2);
constexpr size_t WS_WGU = al256(WS_WOOUT + (size_t)2 * D * D * 2);
constexpr size_t WS_WDN = al256(WS_WGU + (size_t)NE * 1024 * D * 2);
constexpr size_t WS_WLT = al256(WS_WDN + (size_t)NE * D * DE * 2);
constexpr size_t WS_UO = al256(WS_WLT + (size_t)2 * 196608 * 2);
constexpr size_t WS_SCR = al256(WS_UO + (size_t)NTOK * D * 2);
constexpr size_t SE_PQK = 0;
constexpr size_t SE_VT = al256(SE_PQK + (size_t)NTOK * 1024 * 2);
constexpr size_t SE_PRW = al256(SE_VT + (size_t)512 * NTOK * 2);
constexpr size_t SE_PQ = 0;
constexpr size_t SE_SST = al256(SE_PQ + (size_t)rw::NCHAIN * (rw::NCH - 1) * 2 * 4096 * 4);
constexpr size_t SE_Y = al256(SE_SST + (size_t)rw::NCHAIN * rw::NCH * 4096 * 4);
constexpr size_t SE_Z = al256(SE_Y + (size_t)2 * NTOK * 512 * 2);
constexpr size_t SE_ZEND = al256(SE_Z + (size_t)2 * NTOK * 512 * 2);
constexpr size_t SE_PRWEND = al256(SE_PRW + (size_t)NTOK * RW_IN * 2);
constexpr size_t SE_SH = SE_PRWEND > SE_ZEND ? SE_PRWEND : SE_ZEND;
constexpr size_t SE_DR = al256(SE_SH + (size_t)NTOK * 512 * 8);
constexpr size_t SE_CS = al256(SE_DR + (size_t)2 * NTOK * 512 * 4);
constexpr size_t SE_END = al256(SE_CS + (size_t)2 * NTOK * 16 * 4);
constexpr size_t SE_YBUF = 0;
constexpr size_t SO_PQK = 0;
constexpr size_t SO_VT = al256(SO_PQK + (size_t)NTOK * 2048 * 2);
constexpr size_t SO_O12 = al256(SO_VT + (size_t)1024 * NTOK * 2);
constexpr size_t SO_END = al256(SO_O12 + (size_t)NTOK * 2048 * 2);
constexpr size_t SO_YBUF = 0;
constexpr size_t SM_XS = 0;
constexpr size_t SM_HE = al256(SM_XS + (size_t)MOE_ROWS * D * 2);
constexpr size_t SM_YS = al256(SM_HE + (size_t)MOE_ROWS * DE * 2);
constexpr size_t SM_END = al256(SM_YS + (size_t)MOE_ROWS * D * 2);
constexpr size_t SCR_BYTES = SE_END > SO_END ? (SE_END > SM_END ? SE_END : SM_END) : (SO_END > SM_END ? SO_END : SM_END);
constexpr size_t WS_END = WS_SCR + SCR_BYTES;
constexpr int LDS_BARW = 131072;
constexpr int LDS_MISC = 131072 + 64;

struct Params {
  const float *x, *c, *ctx, *c_ctx, *ada_w, *ada_b, *ln_g, *ln_b, *even_w_in, *even_w_out, *shift_w, *na_rpb, *rw_w0, *rw_w_up, *rw_a0, *rw_a_up, *rw_g_up, *rw_k_k, *rw_k_a, *rw_r_k,
      *rw_gn_g, *rw_gn_b, *odd_w_in, *odd_w_out, *da_lq1, *da_lk1, *da_lq2, *da_lk2, *da_subln_g, *router_w, *router_b, *exp_w_gate, *exp_w_up, *exp_w_down;
  float* out; unsigned char* ws; int ph_lo, ph_hi;
};
template <class Tp> __device__ __forceinline__ Tp* wsp(const Params& p, size_t off) { return (Tp*)(p.ws + off); }

__device__ __forceinline__ void ada_unit(const Params& p, int u, LAS float* lds) {
  LAS float* sc = lds; LAS float* red = lds + 5 * 1024;
  const int tid = mk::otid(), l = u / 96, n = (u % 96) * 64 + (tid & 63), kp = tid >> 6;
  for (int i = tid; i < 5 * 1024; i += NTHR) { const float v = i < 4096 ? p.c[i] : p.c_ctx[i - 4096]; sc[i] = siluf_(v); }
  __syncthreads();
  float a[5] = {0.f, 0.f, 0.f, 0.f, 0.f};
  const float* w = p.ada_w + ((size_t)l * D + kp * 128) * 6144 + n;
#pragma unroll 4
  for (int k = 0; k < 128; ++k) { const float wv = w[(size_t)k * 6144]; const int kk = kp * 128 + k;
#pragma unroll
    for (int r = 0; r < 5; ++r) a[r] = fmaf(sc[r * 1024 + kk], wv, a[r]); }
#pragma unroll
  for (int r = 0; r < 5; ++r) red[(kp * 5 + r) * 64 + (tid & 63)] = a[r];
  __syncthreads();
  if (tid < 320) { const int r = tid >> 6, nn = tid & 63; float s = 0.f;
#pragma unroll
    for (int q = 0; q < 8; ++q) s += red[(q * 5 + r) * 64 + nn];
    const int col = (u % 96) * 64 + nn;
    wsp<float>(p, WS_MOD)[((size_t)l * 5 + r) * 6144 + col] = s + p.ada_b[l * 6144 + col]; }
  __syncthreads();
}
__device__ __forceinline__ void phase_prologue(const Params& p, LAS unsigned char* lds) {
  const int bid = mk::obid(), nb = gridDim.x; LAS float* tile = (LAS float*)lds;
  int ub = 0;
  for (int i = 0; i < 2; ++i) ub += cvt_matrix(p.even_w_in + (size_t)i * D * EVEN_IN, EVEN_IN, D, EVEN_IN, wsp<bf16_t>(p, WS_WEIN) + (size_t)i * EVEN_IN * D, NMapId{0}, tile, ub, bid, nb);
  for (int i = 0; i < 2; ++i) ub += cvt_matrix(p.odd_w_in + (size_t)i * D * ODD_IN, ODD_IN, D, ODD_IN, wsp<bf16_t>(p, WS_WOIN) + (size_t)i * ODD_IN * D, NMapRope{}, tile, ub, bid, nb);
  for (int i = 0; i < 2; ++i) ub += cvt_matrix(p.even_w_out + (size_t)i * D * D, D, D, D, wsp<bf16_t>(p, WS_WEOUT) + (size_t)i * D * D, NMapId{0}, tile, ub, bid, nb);
  for (int i = 0; i < 2; ++i) ub += cvt_matrix(p.odd_w_out + (size_t)i * D * D, D, D, D, wsp<bf16_t>(p, WS_WOOUT) + (size_t)i * D * D, NMapId{0}, tile, ub, bid, nb);
  for (int i = 0; i < 2; ++i) { bf16_t* wl = wsp<bf16_t>(p, WS_WLT) + (size_t)i * 196608;
    for (int d = 0; d < 2; ++d) { ub += cvt_matrix(p.rw_w_up + (size_t)(i * 2 + d) * 64 * 512, 512, 64, 512, wl + (size_t)d * 32768, NMapId{0}, tile, ub, bid, nb);
      ub += cvt_matrix(p.rw_a_up + (size_t)(i * 2 + d) * 64 * 512, 512, 64, 512, wl + (size_t)(2 + d) * 32768, NMapId{0}, tile, ub, bid, nb); }
    ub += cvt_matrix(p.rw_g_up + (size_t)i * 128 * 512, 512, 128, 512, wl + (size_t)4 * 32768, NMapId{0}, tile, ub, bid, nb); }
  for (int u = (bid + nb - ub % nb) % nb; u < 384; u += nb) ada_unit(p, u, (LAS float*)lds);
  const int gt = bid * NTHR + mk::otid();
  if (gt < 128 * 16) { const int pos = gt >> 4, i = gt & 15; const float inv = exp2f(-(float)i * (13.287712379549449f / 16.0f)); float sn, cs; sincosf((float)pos * inv, &sn, &cs);
    wsp<float>(p, WS_ROPE)[gt * 2] = cs; wsp<float>(p, WS_ROPE)[gt * 2 + 1] = sn; }
}
__device__ __forceinline__ void cvt_experts(const Params& p, int l, LAS float* tile, int b0) {
  const int bid = mk::obid() - b0, nb = (int)gridDim.x - b0; int ub = 0;
  if (bid < 0) return;
  for (int e = 0; e < NE; ++e) {
    const size_t so = ((size_t)l * NE + e) * D * DE;
    ub += cvt_matrix(p.exp_w_gate + so, DE, D, DE, wsp<bf16_t>(p, WS_WGU) + (size_t)e * 1024 * D, NMapInterleave{0}, tile, ub, bid, nb);
    ub += cvt_matrix(p.exp_w_up + so, DE, D, DE, wsp<bf16_t>(p, WS_WGU) + (size_t)e * 1024 * D, NMapInterleave{1}, tile, ub, bid, nb);
    ub += cvt_matrix(p.exp_w_down + so, D, DE, D, wsp<bf16_t>(p, WS_WDN) + (size_t)e * D * DE, NMapId{0}, tile, ub, bid, nb);
  }
}

__device__ __forceinline__ bf16_t* hb_ptr(const Params& p, int row, bool alt) {
  if (alt) return wsp<bf16_t>(p, WS_SCR + SM_END) + (size_t)row * D;
  return row < NLAT ? (bf16_t*)p.out + (size_t)row * D : wsp<bf16_t>(p, WS_HBC) + (size_t)(row - NLAT) * D;
}
__device__ __forceinline__ const float* h0_ptr(const Params& p, int row) { return row < NLAT ? p.x + (size_t)row * D : p.ctx + (size_t)(row - NLAT) * D; }
__device__ __forceinline__ void store_bf16x4(bf16_t* dst, f32x4 v) { u32x2 w; w.x = cvt_pk_bf16(v[0], v[1]); w.y = cvt_pk_bf16(v[2], v[3]); *(u32x2*)dst = w; }
__device__ __forceinline__ f32x4 load_bf16x4(const bf16_t* src) { const u32x2 w = *(const u32x2*)src; return (f32x4){bflo(w.x), bfhi(w.x), bflo(w.y), bfhi(w.y)}; }

__device__ __forceinline__ void phase_mod0(const Params& p) {
  const int lane = mk::otid() & 63, wid = mk::otid() >> 6;
  bf16_t* U = wsp<bf16_t>(p, WS_UO);
  for (int row = mk::obid() * 8 + wid; row < NTOK; row += gridDim.x * 8) {
    const float* h = h0_ptr(p, row); const float* modl = wsp<float>(p, WS_MOD) + (size_t)bidx_of_row(row) * 6144;
#pragma unroll
    for (int q = 0; q < 4; ++q) { const int col = q * 256 + lane * 4; const f32x4 hv = *(const f32x4*)(h + col), sh = *(const f32x4*)(modl + col), sc = *(const f32x4*)(modl + 1024 + col);
      store_bf16x4(U + (size_t)row * D + col, hv * (1.0f + sc) + sh); }
  }
}
__device__ __forceinline__ void ln_row(f32x4 (&v)[4], const float* __restrict__ g, const float* __restrict__ b, int lane) {
  float s = 0.f;
#pragma unroll
  for (int q = 0; q < 4; ++q) s += (v[q][0] + v[q][1]) + (v[q][2] + v[q][3]);
  const float mu = wave_sum_u(s) * (1.0f / D);
  float qq = 0.f;
#pragma unroll
  for (int q = 0; q < 4; ++q) { const f32x4 d = v[q] - mu; qq += (d[0] * d[0] + d[1] * d[1]) + (d[2] * d[2] + d[3] * d[3]); }
  const float rstd = rsqrtf(wave_sum_u(qq) * (1.0f / D) + LN_EPS);
#pragma unroll
  for (int q = 0; q < 4; ++q) { const int col = q * 256 + lane * 4; v[q] = (v[q] - mu) * rstd * *(const f32x4*)(g + col) + *(const f32x4*)(b + col); }
}
template <bool F32IN> struct Ln1Raw;
template <> struct Ln1Raw<true> { f32x4 h[4]; u32x2 y[4]; };
template <> struct Ln1Raw<false> { u32x2 h[4]; u32x2 y[4]; };
__device__ __forceinline__ f32x4 h_as_f32(f32x4 v) { return v; }
__device__ __forceinline__ f32x4 h_as_f32(u32x2 w) { return (f32x4){bflo(w.x), bfhi(w.x), bflo(w.y), bfhi(w.y)}; }
template <bool F32IN>
__device__ __forceinline__ void ln1_load(const Params& p, const bf16_t* __restrict__ Ybuf, int row, int lane, Ln1Raw<F32IN>& r) {
#pragma unroll
  for (int q = 0; q < 4; ++q) { const int col = q * 256 + lane * 4;
    if constexpr (F32IN) r.h[q] = *(const f32x4*)(h0_ptr(p, row) + col); else r.h[q] = *(const u32x2*)(hb_ptr(p, row, false) + col);
    r.y[q] = *(const u32x2*)(Ybuf + (size_t)row * D + col); }
}
template <bool F32IN>
__device__ __forceinline__ void ln1_row(const Params& p, int l, int row, int lane, const Ln1Raw<F32IN>& raw, const LAS float* rwl, LAS int* lcnt, float rbias  , bool redir) {
  bf16_t* U2 = wsp<bf16_t>(p, WS_UO); int* eid = wsp<int>(p, WS_EID); float* gatev = wsp<float>(p, WS_GATE);
  const float* lg = p.ln_g + (size_t)(l * 2) * D; const float* lb = p.ln_b + (size_t)(l * 2) * D;
  bf16_t* ho = redir ? wsp<bf16_t>(p, WS_SCR + SM_YS) + (size_t)row * D : hb_ptr(p, row, l == DEPTH - 1); const float* modl = wsp<float>(p, WS_MOD) + ((size_t)l * 5 + bidx_of_row(row)) * 6144;
  f32x4 v[4];
#pragma unroll
  for (int q = 0; q < 4; ++q) { const int col = q * 256 + lane * 4; const f32x4 yv = (f32x4){bflo(raw.y[q].x), bfhi(raw.y[q].x), bflo(raw.y[q].y), bfhi(raw.y[q].y)};
    v[q] = ALPHA * h_as_f32(raw.h[q]) + *(const f32x4*)(modl + 2 * 1024 + col) * yv; }
  ln_row(v, lg, lb, lane);
  float acc[16];
#pragma unroll
  for (int e = 0; e < 16; ++e) acc[e] = 0.f;
#pragma unroll
  for (int q = 0; q < 4; ++q) { const int col = q * 256 + lane * 4;
    store_bf16x4(ho + col, v[q]);
    const f32x4 u = v[q] * (1.0f + *(const f32x4*)(modl + 4 * 1024 + col)) + *(const f32x4*)(modl + 3 * 1024 + col);
    store_bf16x4(U2 + (size_t)row * D + col, u);
#pragma unroll
    for (int e = 0; e < 16; ++e) { const f32x4 w = *(const LAS f32x4*)(rwl + ((q * 16 + e) * 64 + lane) * 4); acc[e] += (u[0] * w[0] + u[1] * w[1]) + (u[2] * w[2] + u[3] * w[3]); }
  }
  float t8[8], t4[4], t2[2];
#pragma unroll
  for (int i = 0; i < 8; ++i) { const u32x2 sw = __builtin_amdgcn_permlane32_swap(__float_as_uint(acc[i]), __float_as_uint(acc[8 + i]), false, false); t8[i] = __uint_as_float(sw.x) + __uint_as_float(sw.y); }
#pragma unroll
  for (int i = 0; i < 4; ++i) { const u32x2 sw = __builtin_amdgcn_permlane16_swap(__float_as_uint(t8[i]), __float_as_uint(t8[4 + i]), false, false); t4[i] = __uint_as_float(sw.x) + __uint_as_float(sw.y); }
  const bool b3 = (lane & 8) != 0, b2_ = (lane & 4) != 0;
#pragma unroll
  for (int i = 0; i < 2; ++i) { const float keep = b3 ? t4[2 + i] : t4[i], send = b3 ? t4[i] : t4[2 + i]; t2[i] = keep + dpp_mov<0x128, 0xf, 0xf>(send, send); }
  float logit;
  { const float keep = b2_ ? t2[1] : t2[0], send = b2_ ? t2[0] : t2[1];
    float recv = dpp_mov<0x104, 0xf, 0x5>(send, send);
    recv = dpp_mov<0x114, 0xf, 0xa>(recv, send);
    logit = keep + recv; }
  logit += dpp_mov<0xB1, 0xf, 0xf>(logit, logit); logit += dpp_mov<0x4E, 0xf, 0xf>(logit, logit);
  const float sg = 1.0f / (1.0f + expf(-logit)), sl = sg + rbias;
  float gs;
  { const float a = sl, b2 = dpp_mov<0x124, 0xf, 0xf>(sl, sl), c = dpp_mov<0x128, 0xf, 0xf>(sl, sl), d = dpp_mov<0x12C, 0xf, 0xf>(sl, sl);
    const float lo1 = fminf(a, b2), hi1 = fmaxf(a, b2), lo2 = fminf(c, d), hi2 = fmaxf(c, d);
    gs = fmaxf(hi1, hi2) + fmaxf(fminf(hi1, hi2), fmaxf(lo1, lo2)); }
  float best = -1e30f; int grp = 0;
#pragma unroll
  for (int gI = 0; gI < 4; ++gI) { const float g = __uint_as_float(__builtin_amdgcn_readlane(__float_as_uint(gs), gI * 16)); if (g > best) { best = g; grp = gI; } }
  grp = __builtin_amdgcn_readfirstlane(grp);
  const float v0 = __uint_as_float(__builtin_amdgcn_readlane(__float_as_uint(sl), grp * 16)), v1 = __uint_as_float(__builtin_amdgcn_readlane(__float_as_uint(sl), grp * 16 + 4)),
              v2 = __uint_as_float(__builtin_amdgcn_readlane(__float_as_uint(sl), grp * 16 + 8)), v3 = __uint_as_float(__builtin_amdgcn_readlane(__float_as_uint(sl), grp * 16 + 12));
  const float s0 = __uint_as_float(__builtin_amdgcn_readlane(__float_as_uint(sg), grp * 16)), s1 = __uint_as_float(__builtin_amdgcn_readlane(__float_as_uint(sg), grp * 16 + 4)),
              s2 = __uint_as_float(__builtin_amdgcn_readlane(__float_as_uint(sg), grp * 16 + 8)), s3 = __uint_as_float(__builtin_amdgcn_readlane(__float_as_uint(sg), grp * 16 + 12));
  int i1 = 0; float b1 = v0; if (v1 > b1) { b1 = v1; i1 = 1; } if (v2 > b1) { b1 = v2; i1 = 2; } if (v3 > b1) { b1 = v3; i1 = 3; }
  int i2 = -1; float bb = -1e30f;
  if (i1 != 0 && v0 > bb) { bb = v0; i2 = 0; } if (i1 != 1 && v1 > bb) { bb = v1; i2 = 1; } if (i1 != 2 && v2 > bb) { bb = v2; i2 = 2; } if (i1 != 3 && v3 > bb) { bb = v3; i2 = 3; }
  const float g1 = i1 == 0 ? s0 : i1 == 1 ? s1 : i1 == 2 ? s2 : s3; const float g2 = i2 == 0 ? s0 : i2 == 1 ? s1 : i2 == 2 ? s2 : s3;
  if (lane == 0) { const int e1 = grp * 4 + i1, e2 = grp * 4 + i2;
    eid[row * 2] = e1; eid[row * 2 + 1] = e2; gatev[row * 2] = g1 / (g1 + g2); gatev[row * 2 + 1] = g2 / (g1 + g2);
    __hip_atomic_fetch_add(lcnt + e1, 1, __ATOMIC_RELAXED, __HIP_MEMORY_SCOPE_WORKGROUP); __hip_atomic_fetch_add(lcnt + e2, 1, __ATOMIC_RELAXED, __HIP_MEMORY_SCOPE_WORKGROUP); }
}
template <bool F32IN>
__device__ __forceinline__ void phase_ln1(const Params& p, int l, const bf16_t* __restrict__ Ybuf, LAS unsigned char* lds, bool dry) {
  const int tid = mk::otid(), lane = tid & 63, wid = tid >> 6, bid = mk::obid();
  const bool last = l == DEPTH - 1; const int ntok = last ? NLAT : NTOK;
  LAS float* rwl = (LAS float*)lds; LAS int* lcnt = (LAS int*)(lds + 65536);
  { float rv[32];
#pragma unroll
    for (int i = 0; i < 32; ++i) rv[i] = p.router_w[tid + i * NTHR];
#pragma unroll
    for (int i = 0; i < 32; ++i) { const int idx = tid + i * NTHR, d = idx >> 4, e = idx & 15; rwl[(((d >> 8) * 16 + e) * 64 + ((d >> 2) & 63)) * 4 + (d & 3)] = rv[i]; } }
  if (tid < 16) lcnt[tid] = 0;
  __syncthreads();
  const int stride = gridDim.x * 8, row0 = bid * 8 + wid;
  const float rbias = p.router_b[lane >> 2];
  if (row0 < ntok) {
    Ln1Raw<F32IN> cur, nxt; ln1_load<F32IN>(p, Ybuf, row0, lane, cur);
    for (int row = row0; row < ntok; row += stride) {
      const int rn = row + stride < ntok ? row + stride : row;
      ln1_load<F32IN>(p, Ybuf, rn, lane, nxt);
      ln1_row<F32IN>(p, l, row, lane, cur, rwl, lcnt, rbias, dry);
      cur = nxt;
    }
  }
  __syncthreads();
  if (tid < 16) wsp<int>(p, WS_BCNT)[((size_t)l * 256 + bid) * 64 + tid] = lcnt[tid];
  __syncthreads();
}
__device__ __forceinline__ void phase_scatter(const Params& p, int l, LAS unsigned char* lds) {
  const int tid = mk::otid(), bid = mk::obid(), nb = gridDim.x;
  const bool last = l == DEPTH - 1; const int ntok = last ? NLAT : NTOK;
  LAS int* tot = (LAS int*)lds; LAS int* pre = tot + 16; LAS int* base = tot + 32; LAS int* lcur = tot + 48; LAS int* offs = tot + 64; LAS int* cnts = tot + 128;
  const int* bc = wsp<int>(p, WS_BCNT) + (size_t)l * 256 * 64;
  for (int b2 = tid; b2 < nb; b2 += NTHR) { const u32x4 c0 = *(const u32x4*)(bc + b2 * 64), c1 = *(const u32x4*)(bc + b2 * 64 + 4), c2 = *(const u32x4*)(bc + b2 * 64 + 8), c3 = *(const u32x4*)(bc + b2 * 64 + 12);
    *(LAS u32x4*)(cnts + b2 * 16) = c0; *(LAS u32x4*)(cnts + b2 * 16 + 4) = c1; *(LAS u32x4*)(cnts + b2 * 16 + 8) = c2; *(LAS u32x4*)(cnts + b2 * 16 + 12) = c3; }
  __syncthreads();
  if (tid < 16) { int t = 0, pr = 0; for (int b2 = 0; b2 < nb; ++b2) { const int v = cnts[b2 * 16 + tid]; pr += b2 < bid ? v : 0; t += v; } tot[tid] = t; pre[tid] = pr; lcur[tid] = 0; }
  __syncthreads();
  if (tid == 0) { int o = 0; int* mo = wsp<int>(p, WS_MOFF) + l * 64; for (int e = 0; e < 16; ++e) { offs[e] = o; base[e] = o + pre[e]; if (bid == 0) mo[e] = o; o += (tot[e] + 255) / 256 * 256; } offs[16] = o; if (bid == 0) mo[16] = o; }
  __syncthreads();
  const int* eid = wsp<int>(p, WS_EID); int* pos = wsp<int>(p, WS_POS); int* rl = wsp<int>(p, WS_RL);
  for (int n = tid; ; n += NTHR) { const int row = bid * 8 + (n & 7) + (n >> 3) * nb * 8; if (row >= ntok) break;
    const int e1 = eid[row * 2], e2 = eid[row * 2 + 1];
    const int p1 = base[e1] + __hip_atomic_fetch_add(lcur + e1, 1, __ATOMIC_RELAXED, __HIP_MEMORY_SCOPE_WORKGROUP), p2 = base[e2] + __hip_atomic_fetch_add(lcur + e2, 1, __ATOMIC_RELAXED, __HIP_MEMORY_SCOPE_WORKGROUP);
    pos[row * 2] = p1; pos[row * 2 + 1] = p2; rl[p1] = row; rl[p2] = row; }
  if (bid == 0) for (int e = 0; e < 16; ++e) for (int q = offs[e] + tot[e] + tid; q < offs[e + 1]; q += NTHR) rl[q] = 0;
}
struct Ln2Raw { u32x2 h[4]; u32x2 y1[4], y2[4]; };
__device__ __forceinline__ void ln2_load(const Params& p, bool last, int row, int lane, int p1, int p2, Ln2Raw& r) {
  const bf16_t* Ys = wsp<bf16_t>(p, WS_SCR + SM_YS); const bf16_t* ho = hb_ptr(p, row, last);
#pragma unroll
  for (int q = 0; q < 4; ++q) { const int col = q * 256 + lane * 4; r.h[q] = *(const u32x2*)(ho + col); r.y1[q] = *(const u32x2*)(Ys + (size_t)p1 * D + col); r.y2[q] = *(const u32x2*)(Ys + (size_t)p2 * D + col); }
}
__device__ __forceinline__ void phase_ln2(const Params& p, int l, bool dry) {
  const int tid = mk::otid(), lane = tid & 63, wid = tid >> 6;
  const bool last = l == DEPTH - 1; const int ntok = last ? NLAT : NTOK;
  const int* pos = wsp<int>(p, WS_POS); const float* gatev = wsp<float>(p, WS_GATE); bf16_t* U = wsp<bf16_t>(p, WS_UO);
  const float* lg = p.ln_g + (size_t)(l * 2 + 1) * D; const float* lb = p.ln_b + (size_t)(l * 2 + 1) * D;
  const int stride = gridDim.x * 8, row0 = mk::obid() * 8 + wid;
  if (row0 >= ntok) return;
  auto clampr = [&](int r) { return r < ntok ? r : row0; };
  u32x2 pc = *(const u32x2*)(pos + 2 * row0); f32x2 gc = *(const f32x2*)(gatev + 2 * row0);
  Ln2Raw cur, nxt; ln2_load(p, last, row0, lane, (int)pc.x, (int)pc.y, cur);
  int r1 = clampr(row0 + stride);
  u32x2 pn = *(const u32x2*)(pos + 2 * r1); f32x2 gn = *(const f32x2*)(gatev + 2 * r1);
  for (int row = row0; row < ntok; row += stride) {
    ln2_load(p, last, r1, lane, (int)pn.x, (int)pn.y, nxt);
    const int r2 = clampr(row + 2 * stride);
    const u32x2 pn2 = *(const u32x2*)(pos + 2 * r2); const f32x2 gn2 = *(const f32x2*)(gatev + 2 * r2);
    bf16_t* hb = dry ? wsp<bf16_t>(p, WS_SCR + SM_XS) + (size_t)row * D : hb_ptr(p, row, false); float* hf = (dry ? wsp<float>(p, WS_SCR + SM_XS) : p.out) + (size_t)row * D; const int bi = bidx_of_row(row);
    const float* modl = wsp<float>(p, WS_MOD) + ((size_t)l * 5 + bi) * 6144;
    f32x4 v[4];
#pragma unroll
    for (int q = 0; q < 4; ++q) { const int col = q * 256 + lane * 4;
      const f32x4 a1 = (f32x4){bflo(cur.y1[q].x), bfhi(cur.y1[q].x), bflo(cur.y1[q].y), bfhi(cur.y1[q].y)}, a2 = (f32x4){bflo(cur.y2[q].x), bfhi(cur.y2[q].x), bflo(cur.y2[q].y), bfhi(cur.y2[q].y)};
      v[q] = ALPHA * h_as_f32(cur.h[q]) + *(const f32x4*)(modl + 5 * 1024 + col) * (gc[0] * a1 + gc[1] * a2); }
    ln_row(v, lg, lb, lane);
    const float* modn = wsp<float>(p, WS_MOD) + ((size_t)(last ? l : l + 1) * 5 + bi) * 6144;
#pragma unroll
    for (int q = 0; q < 4; ++q) { const int col = q * 256 + lane * 4; if (last) *(f32x4*)(hf + col) = v[q]; else store_bf16x4(hb + col, v[q]);
      if (!last) store_bf16x4(U + (size_t)row * D + col, v[q] * (1.0f + *(const f32x4*)(modn + 1024 + col)) + *(const f32x4*)(modn + col)); }
    cur = nxt; gc = gn; pn = pn2; gn = gn2; r1 = r2;
  }
}

struct SchedEvenIn { static constexpr bool GATHER = false; const bf16_t* U; const bf16_t* W; bf16_t* Pqk; bf16_t* Prw; bf16_t* Vt; int G, c;
  __device__ __forceinline__ bool next(int i, pg8::Unit& u) const { const int Lx = i * G + c; u.kind = 0;
    if (Lx < 1452) { const int grp = Lx / 44, rem = Lx % 44, pm = grp * 4 + (rem & 3), pi = rem >> 2; u.pm = pm; u.pn = pi;
      u.A = (const char*)(U + (size_t)pm * 256 * D); const int brow = pi < 4 ? pi * 256 : 1536 + (pi - 4) * 256; u.Bt = (const char*)(W + (size_t)brow * D);
      if (pi < 4) { u.out = Pqk; u.ldo = 1024; u.x1 = pi * 256; } else { u.out = Prw; u.ldo = RW_IN; u.x1 = (pi - 4) * 256; } u.x0 = pm * 256; return true; }
    if (Lx < 1452 + 264) { const int v = Lx - 1452, pmv = v & 1, pnv = v >> 1; u.pm = pmv; u.pn = pnv; u.A = (const char*)(W + (size_t)(1024 + pmv * 256) * D); u.Bt = (const char*)(U + (size_t)pnv * 256 * D);
      u.out = Vt; u.ldo = NTOK; u.x0 = pmv * 256; u.x1 = pnv * 256; return true; }
    return false; } };
struct SchedOddIn { static constexpr bool GATHER = false; const bf16_t* U; const bf16_t* W; bf16_t* Pqk; bf16_t* Vt; int G, c;
  __device__ __forceinline__ bool next(int i, pg8::Unit& u) const { const int Lx = i * G + c;
    if (Lx < 1056) { const int grp = Lx / 32, rem = Lx % 32, pm = grp * 4 + (rem & 3), pi = rem >> 2; u.pm = pm; u.pn = pi; u.kind = pm < 128 ? 1 : 0;
      u.A = (const char*)(U + (size_t)pm * 256 * D); u.Bt = (const char*)(W + (size_t)pi * 256 * D); u.out = Pqk; u.ldo = 2048; u.x0 = pm * 256; u.x1 = pi * 256; return true; }
    if (Lx < 1056 + 528) { const int v = Lx - 1056, pmv = v & 3, pnv = v >> 2; u.pm = pmv; u.pn = pnv; u.kind = 0; u.A = (const char*)(W + (size_t)(2048 + pmv * 256) * D); u.Bt = (const char*)(U + (size_t)pnv * 256 * D);
      u.out = Vt; u.ldo = NTOK; u.x0 = pmv * 256; u.x1 = pnv * 256; return true; }
    return false; } };
struct SchedOut { static constexpr bool GATHER = false; const bf16_t* O; const bf16_t* W; bf16_t* Y; int G, c;
  __device__ __forceinline__ bool next(int i, pg8::Unit& u) const { const int Lx = i * G + c; if (Lx >= 528) return false; const int pm = (Lx / 16) * 4 + (Lx & 3), pn = (Lx & 15) >> 2; u.pm = pm; u.pn = pn; u.kind = 0;
    u.A = (const char*)(O + (size_t)pm * 256 * D); u.Bt = (const char*)(W + (size_t)pn * 256 * D); u.out = Y; u.ldo = 1024; u.x0 = pm * 256; u.x1 = pn * 256; return true; } };
template <bool GATH>
struct SchedMoe { static constexpr bool GATHER = GATH; const bf16_t* A; const bf16_t* W; bf16_t* out; const LAS int* moff; const int* rl; int Kd, ldo, ncol, G, c;
  __device__ __forceinline__ bool next(int i, pg8::Unit& u) const { const int Lx = i * G + c; const int ntile = moff[16] >> 8; if (Lx >= ntile * 4) return false;
    const int pm = Lx >> 2, pn = Lx & 3; int e = 0;
#pragma unroll
    for (int j = 1; j < 16; ++j) e += (pm * 256 >= moff[j]) ? 1 : 0;
    u.pm = pm; u.pn = pn; u.kind = 0; u.A = GATH ? (const char*)A : (const char*)(A + (size_t)pm * 256 * Kd); u.rl = rl + pm * 256; u.Bt = (const char*)(W + ((size_t)e * 1024 + pn * 256) * Kd); u.out = out; u.ldo = ldo; u.x0 = pm * 256; u.x1 = pn * ncol; return true; } };

struct EpiOddIn {
  static constexpr bool PERM = true; const float* rope;
  __device__ __forceinline__ void operator()(const f32x4 (&acc)[2][2][4][2], const pg8::Unit& u, int wr, int wc, int fr, int fq) const {
    if (u.kind == 0) { pg8::EpiStoreBf16{}(acc, u, wr, wc, fr, fq); return; }
    const int row0 = u.x0 + wr * 64 + fr, col0 = u.x1 + wc * 32 + 8 * fq; const int half = wc & 1;
#pragma unroll
    for (int ai = 0; ai < 2; ++ai)
#pragma unroll
      for (int m = 0; m < 4; ++m) { const int row = row0 + ai * 128 + m * 16; const int t = row & (T - 1); const int pos = half ? (t & 63) : (t >> 6);
        const f32x4 cs0 = *(const f32x4*)(rope + (pos * 16 + 4 * fq) * 2), cs1 = *(const f32x4*)(rope + (pos * 16 + 4 * fq + 2) * 2);
        bf16_t* rowp = u.out + (size_t)row * u.ldo + col0;
#pragma unroll
        for (int bj = 0; bj < 2; ++bj) { const f32x4 v0 = acc[ai][bj][m][0], v1 = acc[ai][bj][m][1];
          u32x4 w; w.x = cvt_pk_bf16(v0[0] * cs0[0] - v0[1] * cs0[1], v0[0] * cs0[1] + v0[1] * cs0[0]); w.y = cvt_pk_bf16(v0[2] * cs0[2] - v0[3] * cs0[3], v0[2] * cs0[3] + v0[3] * cs0[2]);
          w.z = cvt_pk_bf16(v1[0] * cs1[0] - v1[1] * cs1[1], v1[0] * cs1[1] + v1[1] * cs1[0]); w.w = cvt_pk_bf16(v1[2] * cs1[2] - v1[3] * cs1[3], v1[2] * cs1[3] + v1[3] * cs1[2]);
          *(u32x4*)(rowp + bj * 128) = w; } }
  }
};
struct EpiGateUp {
  static constexpr bool PERM = true;
  __device__ __forceinline__ void operator()(const f32x4 (&acc)[2][2][4][2], const pg8::Unit& u, int wr, int wc, int fr, int fq) const {
    const int row0 = u.x0 + wr * 64 + fr, col0 = u.x1 + wc * 16 + 4 * fq;
#pragma unroll
    for (int ai = 0; ai < 2; ++ai)
#pragma unroll
      for (int m = 0; m < 4; ++m) { bf16_t* rowp = u.out + (size_t)(row0 + ai * 128 + m * 16) * u.ldo + col0;
#pragma unroll
        for (int bj = 0; bj < 2; ++bj) { const f32x4 v0 = acc[ai][bj][m][0], v1 = acc[ai][bj][m][1];
          u32x2 w; w.x = cvt_pk_bf16(siluf_(v0[0]) * v0[1], siluf_(v0[2]) * v0[3]); w.y = cvt_pk_bf16(siluf_(v1[0]) * v1[1], siluf_(v1[2]) * v1[3]);
          *(u32x2*)(rowp + bj * 64) = w; } }
  }
};
}

namespace mk {
constexpr int N_PHASES = 2 + 2 * (12 + 10);
__global__ void __launch_bounds__(NTHR, 2) mega(Params p) {
  extern __shared__ __attribute__((aligned(16))) unsigned char shm[];
  LAS unsigned char* lds = (LAS unsigned char*)shm;
  const int nb = gridDim.x;
  if (threadIdx.x == 0) *(LAS u32x4*)(lds + LDS_BARW) = (u32x4){0u, 0u, 0u, 0u};
  __syncthreads();
  XcdBarrier bar = xcd_barrier_post(wsp<unsigned>(p, WS_BAR), (volatile LAS unsigned*)(lds + LDS_BARW));
  int ph = 0;
#ifndef MK_MASK
#define MK_MASK 0xFFFFFFFFu
#endif
#ifndef MK_REP
#define MK_REP 0u
#endif
#define PHASE_BEGIN_K(k) if ((((MK_MASK) >> (k)) & 1u) && ph >= p.ph_lo && ph < p.ph_hi) { const int bid = mk::obid(); const int nrep_ = ((((MK_REP) >> (k)) & 1u) ? 2 : 1); for (int rep_ = 0; rep_ < nrep_; ++rep_) { const bool dry = rep_ + 1 < nrep_; (void)dry;
#define PHASE_END   } if (ph + 1 < p.ph_hi) xcd_barrier(bar); } ++ph;
  bf16_t* UO = wsp<bf16_t>(p, WS_UO);
  unsigned char* scr = p.ws + WS_SCR;
  PHASE_BEGIN_K(0) phase_prologue(p, lds); PHASE_END
  PHASE_BEGIN_K(1) phase_mod0(p); PHASE_END
  for (int lp = 0; lp < 2; ++lp) {
    {
      const int l = 2 * lp;
      bf16_t* Pqk = (bf16_t*)(scr + SE_PQK); bf16_t* Vt = (bf16_t*)(scr + SE_VT); bf16_t* Prw = (bf16_t*)(scr + SE_PRW); bf16_t* Ybuf = (bf16_t*)(scr + SE_YBUF);
      rw::Bufs bf; bf.SH = (u32x2*)(scr + SE_SH); bf.DR = (unsigned*)(scr + SE_DR); bf.G = UO + 512; bf.gstride = 1024; bf.CS = (float*)(scr + SE_CS) + (size_t)lp * NTOK * 16; bf.PQ = (float*)(scr + SE_PQ); bf.SST = (float*)(scr + SE_SST); bf.Y = (bf16_t*)(scr + SE_Y); bf.Z = (bf16_t*)(scr + SE_Z);
      PHASE_BEGIN_K(2) { SchedEvenIn S{UO, wsp<bf16_t>(p, WS_WEIN) + (size_t)lp * EVEN_IN * D, Pqk, Prw, Vt, nb, bid}; pg8::gemm_phase(lds, D, S, pg8::EpiStoreBf16{}); } PHASE_END
      PHASE_BEGIN_K(3) { for (int u = bid; u < 1024 + 32; u += nb) { int b, h, rq; if (u < 1024) { b = u >> 8; h = (u >> 5) & 7; rq = u & 31; } else { const int v = u - 1024; b = v >> 3; h = v & 7; rq = -1; }
          natt::na_attn_unit(Pqk, Vt, p.na_rpb + ((size_t)lp * 8 + h) * 465, UO, b, h, rq, lds); }
        const int pb = (bid + nb / 2) % nb;
        for (int t = pb; t < NTOK / 16; t += nb) rw::prep_tile(Prw, p.shift_w + (size_t)lp * 3 * RW_IN, p.rw_w0 + lp * 1024, wsp<bf16_t>(p, WS_WLT) + (size_t)lp * 196608, p.rw_a0 + lp * 1024, p.rw_k_k + lp * 512, p.rw_k_a + lp * 512, p.rw_r_k + lp * 512, bf, t, (LAS float*)lds); } PHASE_END
      PHASE_BEGIN_K(4) for (int u = bid * 8 + (mk::otid() >> 6); u < rw::NCHAIN * rw::NCH; u += nb * 8) rw::scan_unit(bf, p.rw_k_a + lp * 512, u / rw::NCH, u % rw::NCH, (LAS float*)lds + (mk::otid() >> 6) * 320); PHASE_END
      PHASE_BEGIN_K(5) for (int c = bid; c < rw::NCHAIN * 4; c += nb) rw::propagate_chain(bf, c >> 2, c & 3, (LAS float*)lds); PHASE_END
      PHASE_BEGIN_K(6) for (int u = bid * 8 + (mk::otid() >> 6); u < rw::NCHAIN * (rw::NCH - 1); u += nb * 8) rw::corr_unit(bf, u / (rw::NCH - 1), 1 + u % (rw::NCH - 1)); PHASE_END
      PHASE_BEGIN_K(7) for (int r = bid * 8; r < NTOK; r += nb * 8) rw::finish_rows<8>(bf, p.rw_gn_g + lp * 512, p.rw_gn_b + lp * 512, UO, r); PHASE_END
      PHASE_BEGIN_K(8) { SchedOut S{UO, wsp<bf16_t>(p, WS_WEOUT) + (size_t)lp * D * D, Ybuf, nb, bid}; pg8::gemm_phase(lds, D, S, pg8::EpiStoreBf16{}); __syncthreads(); cvt_experts(p, l, (LAS float*)lds, 528 - 2 * nb > 0 ? 528 - 2 * nb : 0); } PHASE_END
      PHASE_BEGIN_K(9) if (l == 0) phase_ln1<true>(p, l, Ybuf, lds, dry); else phase_ln1<false>(p, l, Ybuf, lds, dry); PHASE_END
      PHASE_BEGIN_K(10) phase_scatter(p, l, lds); PHASE_END
      PHASE_BEGIN_K(11) { LAS int* mo = (LAS int*)(lds + LDS_MISC); { const int tq = mk::otid(); if (tq < 17) mo[tq] = wsp<int>(p, WS_MOFF)[l * 64 + tq]; } __syncthreads();
        SchedMoe<true> S{UO, wsp<bf16_t>(p, WS_WGU), (bf16_t*)(scr + SM_HE), mo, wsp<int>(p, WS_RL), D, DE, 128, nb, bid}; pg8::gemm_phase(lds, D, S, EpiGateUp{}); } PHASE_END
      PHASE_BEGIN_K(12) { LAS int* mo = (LAS int*)(lds + LDS_MISC); { const int tq = mk::otid(); if (tq < 17) mo[tq] = wsp<int>(p, WS_MOFF)[l * 64 + tq]; } __syncthreads();
        SchedMoe<false> S{(bf16_t*)(scr + SM_HE), wsp<bf16_t>(p, WS_WDN), (bf16_t*)(scr + SM_YS), mo, nullptr, DE, D, 256, nb, bid}; pg8::gemm_phase(lds, DE, S, pg8::EpiStoreBf16{}); } PHASE_END
      PHASE_BEGIN_K(13) phase_ln2(p, l, dry); PHASE_END
    }
    {
      const int l = 2 * lp + 1; const bool last = l == DEPTH - 1;
      bf16_t* Pqk = (bf16_t*)(scr + SO_PQK); bf16_t* Vt = (bf16_t*)(scr + SO_VT); bf16_t* O12 = (bf16_t*)(scr + SO_O12); bf16_t* Ybuf = (bf16_t*)(scr + SO_YBUF);
      PHASE_BEGIN_K(14) { SchedOddIn S{UO, wsp<bf16_t>(p, WS_WOIN) + (size_t)lp * ODD_IN * D, Pqk, Vt, nb, bid}; pg8::gemm_phase(lds, D, S, EpiOddIn{wsp<float>(p, WS_ROPE)}); } PHASE_END
      float* KN = wsp<float>(p, WS_KN) + (size_t)lp * 256 * 32;
      PHASE_BEGIN_K(23) for (int g = bid; g < 256; g += nb) att::knorm_group(Pqk, KN, g, (LAS float*)lds); PHASE_END
      PHASE_BEGIN_K(15) for (int ui = bid; ui < 2048 + (last ? 0 : 64); ui += nb) { int b, hh, q0, nlat; const int u = (nb == 256 && ui < 2048) ? ((((ui >> 8) * 8 + (bid & 7)) << 5) | (bid >> 3)) : ui;
        if (u < 2048) { b = u >> 9; hh = (u >> 5) & 15; q0 = b * T + (u & 31) * 256; nlat = T; } else { const int v = u - 2048; b = v >> 4; hh = v & 15; q0 = NLAT + b * L; nlat = 0; }
        const bool st = __builtin_amdgcn_sqrtf(att::nmax2_of(KN, b, hh, 0) * att::nmax2_of(KN, b, hh, 1)) * 1.001f <= 60.0f;
#ifdef MK_ABL
        if (dry) att::diff_attn_unit<true, MK_ABL>(Pqk, Vt, O12, hh, q0, b * T, nlat, NLAT + b * L, lds); else
#endif
        if (st) att::diff_attn_unit<true>(Pqk, Vt, O12, hh, q0, b * T, nlat, NLAT + b * L, lds); else att::diff_attn_unit<false>(Pqk, Vt, O12, hh, q0, b * T, nlat, NLAT + b * L, lds); } PHASE_END
      PHASE_BEGIN_K(16) { float d1 = 0.f, d2 = 0.f; for (int i = 0; i < 64; ++i) { d1 += p.da_lq1[lp * 64 + i] * p.da_lk1[lp * 64 + i]; d2 += p.da_lq2[lp * 64 + i] * p.da_lk2[lp * 64 + i]; }
        const float li = 0.8f - 0.6f * expf(-0.3f * (float)l), lam = expf(d1) - expf(d2) + li;
        const int tq = mk::otid(); for (int r4 = bid; r4 < (last ? NLAT : NTOK) / 4; r4 += nb) att::diff_combine_rows4(O12, p.da_subln_g + lp * 128, lam, 1.0f - li, UO, r4 * 4, tq >> 6, tq & 63); } PHASE_END
      PHASE_BEGIN_K(17) { SchedOut S{UO, wsp<bf16_t>(p, WS_WOOUT) + (size_t)lp * D * D, Ybuf, nb, bid}; pg8::gemm_phase(lds, D, S, pg8::EpiStoreBf16{}); __syncthreads(); cvt_experts(p, l, (LAS float*)lds, 528 - 2 * nb > 0 ? 528 - 2 * nb : 0); } PHASE_END
      PHASE_BEGIN_K(18) phase_ln1<false>(p, l, Ybuf, lds, dry); PHASE_END
      PHASE_BEGIN_K(19) phase_scatter(p, l, lds); PHASE_END
      PHASE_BEGIN_K(20) { LAS int* mo = (LAS int*)(lds + LDS_MISC); { const int tq = mk::otid(); if (tq < 17) mo[tq] = wsp<int>(p, WS_MOFF)[l * 64 + tq]; } __syncthreads();
        SchedMoe<true> S{UO, wsp<bf16_t>(p, WS_WGU), (bf16_t*)(scr + SM_HE), mo, wsp<int>(p, WS_RL), D, DE, 128, nb, bid}; pg8::gemm_phase(lds, D, S, EpiGateUp{}); } PHASE_END
      PHASE_BEGIN_K(21) { LAS int* mo = (LAS int*)(lds + LDS_MISC); { const int tq = mk::otid(); if (tq < 17) mo[tq] = wsp<int>(p, WS_MOFF)[l * 64 + tq]; } __syncthreads();
        SchedMoe<false> S{(bf16_t*)(scr + SM_HE), wsp<bf16_t>(p, WS_WDN), (bf16_t*)(scr + SM_YS), mo, nullptr, DE, D, 256, nb, bid}; pg8::gemm_phase(lds, DE, S, pg8::EpiStoreBf16{}); } PHASE_END
      PHASE_BEGIN_K(22) phase_ln2(p, l, dry); PHASE_END
    }
  }
#undef PHASE_BEGIN_K
#undef PHASE_END
}
}

#ifndef MK_SINGLE_LAUNCH
#define MK_SINGLE_LAUNCH 1
#endif
extern "C" void kernel_launch(void* const* d_in, const int* in_sizes, int n_in, void* d_out, int out_size, void* d_ws, size_t ws_size, hipStream_t stream) {
  using namespace mk;
  static int grid = 0;
  if (grid == 0) {
    if (n_in != 34 || out_size != NLAT * D || ws_size < WS_END) { fprintf(stderr, "kernel_launch: unexpected shapes (n_in %d out %d ws %zu need %zu)\n", n_in, out_size, ws_size, (size_t)WS_END); grid = -1; return; }
    if (hipFuncSetAttribute((const void*)mega, hipFuncAttributeMaxDynamicSharedMemorySize, LDS_BYTES) != hipSuccess) { grid = -1; return; }
    int dev = 0, cus = 0, per_cu = 0;
    if (hipGetDevice(&dev) != hipSuccess || hipDeviceGetAttribute(&cus, hipDeviceAttributeMultiprocessorCount, dev) != hipSuccess) { grid = -1; return; }
    if (hipOccupancyMaxActiveBlocksPerMultiprocessor(&per_cu, (const void*)mega, NTHR, LDS_BYTES) != hipSuccess || per_cu < 1) { fprintf(stderr, "kernel_launch: occupancy query says %d\n", per_cu); }
    (void)hipGetLastError();
    grid = cus;
  }
  if (grid < 0) return;
  (void)hipMemsetAsync((char*)d_ws + WS_BAR, 0, (size_t)XCD_BAR_WORDS * 4, stream);
  Params p{};
  const float** pp = (const float**)&p;
  for (int i = 0; i < 34; ++i) pp[i] = (const float*)d_in[i];
  p.out = (float*)d_out; p.ws = (unsigned char*)d_ws;
#if MK_SINGLE_LAUNCH
  p.ph_lo = 0; p.ph_hi = N_PHASES;
  hipLaunchKernelGGL(mega, dim3(grid), dim3(NTHR), LDS_BYTES, stream, p);
#else
  for (int ph = 0; ph < N_PHASES; ++ph) { p.ph_lo = ph; p.ph_hi = ph + 1; hipLaunchKernelGGL(mega, dim3(grid), dim3(NTHR), LDS_BYTES, stream, p); }
#endif
}
```

```cpp
#include <hip/hip_runtime.h>
#include <stdint.h>
#include <stdio.h>

typedef unsigned short bf16_t;
typedef short bf16x8 __attribute__((ext_vector_type(8)));
typedef float f32x4 __attribute__((ext_vector_type(4)));
typedef float f32x2 __attribute__((ext_vector_type(2)));
typedef float f32x16 __attribute__((ext_vector_type(16)));
typedef unsigned u32x4 __attribute__((ext_vector_type(4)));
typedef unsigned u32x2 __attribute__((ext_vector_type(2)));
#define LAS __attribute__((address_space(3)))

namespace mk {
constexpr int B = 4, T = 8192, L = 256, D = 1024, NLAT = B * T, NCTX = B * L, NTOK = NLAT + NCTX;
constexpr int DEPTH = 4, EVEN_IN = 3328, ODD_IN = 3072, RW_OFF = 1536, RW_IN = 1792, NE = 16, DE = 512;
constexpr float ALPHA = 1.681792830507429f, LN_EPS = 1e-5f;
constexpr int NTHR = 512, LDS_BYTES = 147456;
constexpr int MOE_TILES = 280, MOE_ROWS = MOE_TILES * 256;

typedef __bf16 bf16x2v __attribute__((ext_vector_type(2)));
__device__ __forceinline__ unsigned cvt_pk_bf16(float lo, float hi) { const f32x2 v = {lo, hi}; return __builtin_bit_cast(unsigned, __builtin_convertvector(v, bf16x2v)); }
__device__ __forceinline__ unsigned cvt_pk_bf16_v(float lo, float hi) { return cvt_pk_bf16(lo, hi); }
__device__ __forceinline__ float bf2f(bf16_t b) { return __uint_as_float(((unsigned)b) << 16); }
__device__ __forceinline__ float bflo(unsigned w) { return __uint_as_float(w << 16); }
__device__ __forceinline__ float bfhi(unsigned w) { return __uint_as_float(w & 0xffff0000u); }
__device__ __forceinline__ bf16_t f2bf(float f) { return (bf16_t)(cvt_pk_bf16(f, 0.f) & 0xffffu); }
__device__ __forceinline__ float sigmoidf_(float x) { return 1.0f / (1.0f + __expf(-x)); }
__device__ __forceinline__ float siluf_(float x) { return x / (1.0f + __expf(-x)); }
__device__ __forceinline__ float wave_sum(float v) {
#pragma unroll
  for (int o = 32; o > 0; o >>= 1) v += __shfl_xor(v, o);
  return v;
}
template <int CTRL, int RM, int BM> __device__ __forceinline__ float dpp_mov(float old, float v) { return __int_as_float(__builtin_amdgcn_update_dpp(__float_as_int(old), __float_as_int(v), CTRL, RM, BM, false)); }
__device__ __forceinline__ float wave_sum_u(float v) {
  v += dpp_mov<0xB1, 0xf, 0xf>(v, v);
  v += dpp_mov<0x4E, 0xf, 0xf>(v, v);
  v += dpp_mov<0x141, 0xf, 0xf>(v, v);
  v += dpp_mov<0x140, 0xf, 0xf>(v, v);
  v += dpp_mov<0x142, 0xa, 0xf>(0.f, v);
  v += dpp_mov<0x143, 0xc, 0xf>(0.f, v);
  return __int_as_float(__builtin_amdgcn_readlane(__float_as_int(v), 63));
}
__device__ __forceinline__ float wave_max_u(float v) {
  v = fmaxf(v, dpp_mov<0xB1, 0xf, 0xf>(v, v));
  v = fmaxf(v, dpp_mov<0x4E, 0xf, 0xf>(v, v));
  v = fmaxf(v, dpp_mov<0x141, 0xf, 0xf>(v, v));
  v = fmaxf(v, dpp_mov<0x140, 0xf, 0xf>(v, v));
  v = fmaxf(v, dpp_mov<0x142, 0xa, 0xf>(0.f, v));
  v = fmaxf(v, dpp_mov<0x143, 0xc, 0xf>(0.f, v));
  return __int_as_float(__builtin_amdgcn_readlane(__float_as_int(v), 63));
}
__device__ __forceinline__ f32x16 zero16() { float z = 0.f; asm volatile("" : "+v"(z)); f32x16 r;
#pragma unroll
  for (int i = 0; i < 16; ++i) r[i] = z;
  return r; }
__device__ __forceinline__ int otid() { int t = threadIdx.x; asm volatile("" : "+v"(t)); return t; }
__device__ __forceinline__ int obid() { int b = blockIdx.x; asm volatile("" : "+s"(b)); return b; }
__device__ __forceinline__ int bidx_of_row(int row) { return row < NLAT ? row / T : 4; }
}

#include <vector>

#define XB_TMO      128
#define XB_XCNT(j)  (256  + 64 * (j))
#define XB_XSUB(j)  (1280 + 64 * (j))
#define XB_XGEN(j)  (2304 + 64 * (j))
#define XB_TOP      3328
#define XB_TOPGEN   3392
#define XCD_BAR_WORDS 3456
#define XB_SPIN_CAP (1u << 18)
#define LAS __attribute__((address_space(3)))

__device__ __forceinline__ unsigned xb_ld(unsigned* p)              { return __hip_atomic_load(p, __ATOMIC_RELAXED, __HIP_MEMORY_SCOPE_AGENT); }
__device__ __forceinline__ unsigned xb_add(unsigned* p, unsigned v) { return __hip_atomic_fetch_add(p, v, __ATOMIC_RELAXED, __HIP_MEMORY_SCOPE_AGENT); }
__device__ __forceinline__ unsigned xb_xcc_id() { return (unsigned)__builtin_amdgcn_s_getreg((3 << 11) | 20) & 0xFu; }
#define XB_SPIN(cond, bar) do { unsigned _sp = 0; while (cond) { __builtin_amdgcn_s_sleep(1); \
    if ((++_sp & 255u) == 0u) { if (xb_ld(&(bar)[XB_TMO])) break; if (_sp > XB_SPIN_CAP) { atomicAdd(&(bar)[XB_TMO], 1u); break; } } } } while (0)

struct XcdBarrier {
    unsigned* bar; unsigned x;
    volatile LAS unsigned* st;
};

__device__ __forceinline__ XcdBarrier xcd_barrier_post(unsigned* bar, volatile LAS unsigned* st) {
    XcdBarrier b; b.bar = bar; b.x = xb_xcc_id(); b.st = st;
    if (threadIdx.x == 0) (void)xb_add(&bar[XB_XCNT(b.x)], 1u);
    return b;
}
__device__ __forceinline__ void xcd_barrier_complete(unsigned* bar, unsigned x, unsigned& nloc, unsigned& nx) {
    const unsigned G = gridDim.x * gridDim.y * gridDim.z;
    unsigned sum, cnt, mine, sp = 0u;
    for (;;) {
        sum = 0u; cnt = 0u; mine = 0u;
#pragma unroll
        for (unsigned j = 0; j < 16; ++j) { const unsigned c = xb_ld(&bar[XB_XCNT(j)]); sum += c; cnt += (c > 0u) ? 1u : 0u; mine = (j == x) ? c : mine; }
        if (sum == G) break;
        __builtin_amdgcn_s_sleep(1);
        if ((++sp & 255u) == 0u) { if (xb_ld(&bar[XB_TMO])) break; if (sp > XB_SPIN_CAP) { atomicAdd(&bar[XB_TMO], 1u); break; } }
    }
    nloc = mine > 0u ? mine : 1u; nx = cnt > 0u ? cnt : 1u;
}

__device__ __forceinline__ void xcd_barrier(const XcdBarrier& b) {
    asm volatile("s_waitcnt vmcnt(0)" ::: "memory");
    __syncthreads();
    if (threadIdx.x == 0) {
        unsigned* bar = b.bar;
        __builtin_amdgcn_s_waitcnt(0);
        unsigned nloc = b.st[0], nx = b.st[1];
        if (nloc == 0u) { xcd_barrier_complete(bar, b.x, nloc, nx); b.st[0] = nloc; b.st[1] = nx; }
        const unsigned old = xb_add(&bar[XB_XSUB(b.x)], 1u);
        const unsigned gen = old / nloc;
        if (old + 1u == (gen + 1u) * nloc) {
            __builtin_amdgcn_fence(__ATOMIC_RELEASE, "agent");
            asm volatile("s_waitcnt vmcnt(0)" ::: "memory");
            const unsigned og = xb_add(&bar[XB_TOP], 1u);
            const unsigned tg = og / nx;
            if (og + 1u == (tg + 1u) * nx) xb_add(&bar[XB_TOPGEN], 1u);
            else XB_SPIN(xb_ld(&bar[XB_TOPGEN]) == tg, bar);
            __builtin_amdgcn_fence(__ATOMIC_ACQUIRE, "agent");
            xb_add(&bar[XB_XGEN(b.x)], 1u);
            asm volatile("s_waitcnt vmcnt(0)" ::: "memory");
        } else {
            XB_SPIN(xb_ld(&bar[XB_XGEN(b.x)]) == gen, bar);
            __builtin_amdgcn_fence(__ATOMIC_ACQUIRE, "agent");
            asm volatile("s_waitcnt vmcnt(0)" ::: "memory");
        }
    }
    __syncthreads();
}

namespace pg8 {
using mk::cvt_pk_bf16;
constexpr int BM = 256, BK = 64, HALF = 128, HTB = HALF * BK * 2  , STAGE_BYTES = 8 * HTB;
__host__ __device__ __forceinline__ int lds_byte(int r, int c) { const int st = (r >> 4) * 2 + (c >> 5), rr = r & 15, cc = c & 31, ob = rr * 64 + cc * 2; return st * 1024 + (ob ^ (((ob >> 9) & 1) << 5)); }
__host__ __device__ __forceinline__ void stage_rc(int b, int& R, int& C) { const int st = b / 1024, sb = b % 1024, swz = sb ^ (((sb >> 9) & 1) << 5); R = (st >> 1) * 16 + swz / 64; C = (st & 1) * 32 + (swz % 64) / 2; }
__host__ __device__ __forceinline__ int perm32(int rho) { const int n = rho >> 4, i = rho & 15; return 8 * (i >> 2) + 4 * n + (i & 3); }

struct Unit { const char* A; const char* Bt; bf16_t* out; const int* rl; int pm, pn, x0, x1, ldo, kind; };

template <class Epi, class Sched>
__device__ __forceinline__ void gemm_phase(LAS unsigned char* lds, const int K, const Sched& S, const Epi& E) {
    const int tid = mk::otid(), wid = __builtin_amdgcn_readfirstlane(tid >> 6), lane = tid & 63, wr = wid >> 2, wc = wid & 3, fr = lane & 15, fq = lane >> 4;
    const int nt = K / BK;
    constexpr bool GATH = Sched::GATHER;
    unsigned voffA[2], voffB[2]; int Rl[2], Cl[2];
#pragma unroll
    for (int i = 0; i < 2; ++i) { int R, C; stage_rc(tid * 16 + i * 8192, R, C); const int Rb = Epi::PERM ? ((R & ~31) + perm32(R & 31)) : R; Rl[i] = R; Cl[i] = C;
        voffA[i] = (unsigned)(R * K + C) * 2u; voffB[i] = (unsigned)(Rb * K + C) * 2u; }
    unsigned roC[2][2], roN[2][2];
    (void)Rl; (void)Cl;
    const size_t kstep = (size_t)(BK * 2);
    const size_t hstep = (size_t)HALF * K * 2;
    const unsigned ldsw = (unsigned)wid * 1024u;
    const int aoff = lds_byte(wr * 64 + fr, fq * 8), boff = lds_byte(wc * 32 + fr, fq * 8);
#define PG8_SA(b, h) (((b) * 2 + (h)) * HTB)
#define PG8_SB(b, h) ((4 + (b) * 2 + (h)) * HTB)
#define PG8_STAGE(bufoff, gbase, voff) do { _Pragma("unroll") for (int _i = 0; _i < 2; ++_i) \
        __builtin_amdgcn_global_load_lds((const unsigned*)((const char*)(gbase) + (voff)[_i]), (LAS unsigned*)(lds + (bufoff) + ldsw + _i * 8192), 16, 0, 0); } while (0)
#define PG8_STAGE_A(bufoff, gbase, h, ro) do { if constexpr (GATH) { _Pragma("unroll") for (int _i = 0; _i < 2; ++_i) \
        __builtin_amdgcn_global_load_lds((const unsigned*)((const char*)(gbase) + (ro)[h][_i]), (LAS unsigned*)(lds + (bufoff) + ldsw + _i * 8192), 16, 0, 0); } \
      else { PG8_STAGE(bufoff, (const char*)(gbase) + (h) * hstep, voffA); } } while (0)
#define PG8_LOAD_RO(u, ro) do { _Pragma("unroll") for (int _h = 0; _h < 2; ++_h) _Pragma("unroll") for (int _i = 0; _i < 2; ++_i) \
        (ro)[_h][_i] = (unsigned)(u).rl[Rl[_i] + _h * 128] * (unsigned)(K * 2) + (unsigned)(Cl[_i] * 2); } while (0)
#define PG8_LDA(dst, b, h) do { _Pragma("unroll") for (int m = 0; m < 4; ++m) _Pragma("unroll") for (int k = 0; k < 2; ++k) dst[m][k] = *(const LAS bf16x8*)(lds + PG8_SA(b, h) + aoff + m * 2048 + k * 1024); } while (0)
#define PG8_LDB(dst, b, h) do { _Pragma("unroll") for (int n = 0; n < 2; ++n) _Pragma("unroll") for (int k = 0; k < 2; ++k) dst[n][k] = *(const LAS bf16x8*)(lds + PG8_SB(b, h) + boff + n * 2048 + k * 1024); } while (0)
#define PG8_MMA(ai, bj, At, Bt) do { __builtin_amdgcn_s_setprio(1); _Pragma("unroll") for (int m = 0; m < 4; ++m) _Pragma("unroll") for (int n = 0; n < 2; ++n) _Pragma("unroll") for (int k = 0; k < 2; ++k) \
        acc[ai][bj][m][n] = __builtin_amdgcn_mfma_f32_16x16x32_bf16(Bt[n][k], At[m][k], acc[ai][bj][m][n], 0, 0, 0); __builtin_amdgcn_s_setprio(0); } while (0)
#define PG8_WAIT_V(n) asm volatile("s_waitcnt vmcnt(" #n ")" ::: "memory")
#define PG8_WAIT_L(n) asm volatile("s_waitcnt lgkmcnt(" #n ")" ::: "memory")
#define PG8_BAR __builtin_amdgcn_s_barrier()
#define PG8_SCHED __builtin_amdgcn_sched_barrier(0)
    Unit cur, nxt; int ui = 0;
    if (!S.next(0, cur)) return;
    f32x4 acc[2][2][4][2];
#pragma unroll
    for (int a = 0; a < 2; ++a)
#pragma unroll
        for (int b = 0; b < 2; ++b)
#pragma unroll
            for (int m = 0; m < 4; ++m)
#pragma unroll
                for (int n = 0; n < 2; ++n) acc[a][b][m][n] = (f32x4){0.f, 0.f, 0.f, 0.f};
    bf16x8 At[4][2], B0[2][2], B1[2][2];
    const char* cA = cur.A; const char* cB = cur.Bt;
    if constexpr (GATH) { PG8_LOAD_RO(cur, roC); }
    PG8_STAGE(PG8_SB(0, 0), cB, voffB); PG8_STAGE_A(PG8_SA(0, 0), cA, 0, roC); PG8_STAGE(PG8_SB(0, 1), cB + hstep, voffB); PG8_STAGE_A(PG8_SA(0, 1), cA, 1, roC);
    if (wr == 1) PG8_BAR;
    PG8_WAIT_V(4); PG8_BAR;
    PG8_STAGE(PG8_SB(1, 0), cB + kstep, voffB); PG8_STAGE_A(PG8_SA(1, 0), cA + kstep, 0, roC); PG8_STAGE(PG8_SB(1, 1), cB + hstep + kstep, voffB);
    PG8_WAIT_V(6); PG8_BAR;
    for (;;) {
        const bool has_next = S.next(ui + 1, nxt);
        const char* nA = has_next ? nxt.A : cA; const char* nB = has_next ? nxt.Bt : cB;
        if constexpr (GATH) { if (has_next) { PG8_LOAD_RO(nxt, roN); } else { _Pragma("unroll") for (int _h = 0; _h < 2; ++_h) _Pragma("unroll") for (int _i = 0; _i < 2; ++_i) roN[_h][_i] = roC[_h][_i]; } }
        for (int t = 0; t < nt; t += 2) {
            const bool last = (t == nt - 2);
            const char* a1 = cA + (size_t)(t + 1) * kstep;
            const char* a2 = last ? nA : cA + (size_t)(t + 2) * kstep; const char* b2 = last ? nB : cB + (size_t)(t + 2) * kstep;
            const char* a3 = a2 + kstep; const char* b3 = b2 + kstep;
            unsigned ro2[2][2];
            if constexpr (GATH) { _Pragma("unroll") for (int _h = 0; _h < 2; ++_h) _Pragma("unroll") for (int _i = 0; _i < 2; ++_i) ro2[_h][_i] = last ? roN[_h][_i] : roC[_h][_i]; }
            (void)ro2;
            PG8_LDB(B0, 0, 0); PG8_SCHED; PG8_LDA(At, 0, 0); PG8_STAGE_A(PG8_SA(1, 1), a1, 1, roC);
            PG8_WAIT_L(8); PG8_BAR; PG8_WAIT_L(0); PG8_MMA(0, 0, At, B0); PG8_BAR; PG8_SCHED;
            PG8_LDB(B1, 0, 1); PG8_STAGE(PG8_SB(0, 0), b2, voffB);
            PG8_BAR; PG8_WAIT_L(0); PG8_MMA(0, 1, At, B1); PG8_BAR;
            PG8_LDA(At, 0, 1); PG8_STAGE_A(PG8_SA(0, 0), a2, 0, ro2);
            PG8_BAR; PG8_WAIT_L(0); PG8_MMA(1, 0, At, B0); PG8_BAR; PG8_SCHED;
            PG8_STAGE(PG8_SB(0, 1), b2 + hstep, voffB);
            PG8_WAIT_V(6); PG8_BAR; PG8_MMA(1, 1, At, B1); PG8_BAR;
            PG8_LDB(B0, 1, 0); PG8_SCHED; PG8_LDA(At, 1, 0); PG8_STAGE_A(PG8_SA(0, 1), a2, 1, ro2);
            PG8_WAIT_L(8); PG8_BAR; PG8_WAIT_L(0); PG8_MMA(0, 0, At, B0); PG8_BAR; PG8_SCHED;
            PG8_LDB(B1, 1, 1); PG8_STAGE(PG8_SB(1, 0), b3, voffB);
            PG8_BAR; PG8_WAIT_L(0); PG8_MMA(0, 1, At, B1); PG8_BAR;
            PG8_LDA(At, 1, 1); PG8_STAGE_A(PG8_SA(1, 0), a3, 0, ro2);
            PG8_BAR; PG8_WAIT_L(0); PG8_MMA(1, 0, At, B0); PG8_BAR; PG8_SCHED;
            PG8_STAGE(PG8_SB(1, 1), b3 + hstep, voffB);
            PG8_WAIT_V(6); PG8_BAR; PG8_MMA(1, 1, At, B1); PG8_BAR;
        }
        E(acc, cur, wr, wc, fr, fq);
        if (!has_next) break;
#pragma unroll
        for (int a = 0; a < 2; ++a)
#pragma unroll
            for (int b = 0; b < 2; ++b)
#pragma unroll
                for (int m = 0; m < 4; ++m)
#pragma unroll
                    for (int n = 0; n < 2; ++n) acc[a][b][m][n] = (f32x4){0.f, 0.f, 0.f, 0.f};
        cur = nxt; cA = nA; cB = nB; ++ui;
        if constexpr (GATH) { _Pragma("unroll") for (int _h = 0; _h < 2; ++_h) _Pragma("unroll") for (int _i = 0; _i < 2; ++_i) roC[_h][_i] = roN[_h][_i]; }
    }
    PG8_WAIT_V(0);
    if (wr == 0) PG8_BAR;
    PG8_BAR;
#undef PG8_SA
#undef PG8_SB
#undef PG8_STAGE
#undef PG8_STAGE_A
#undef PG8_LOAD_RO
#undef PG8_LDA
#undef PG8_LDB
#undef PG8_MMA
#undef PG8_WAIT_V
#undef PG8_WAIT_L
#undef PG8_BAR
#undef PG8_SCHED
}

struct EpiStoreBf16 {
    static constexpr bool PERM = true;
    __device__ __forceinline__ void operator()(const f32x4 (&acc)[2][2][4][2], const Unit& u, int wr, int wc, int fr, int fq) const {
        bf16_t* O = u.out; const int ldc = u.ldo;
        const int row0 = u.x0 + wr * 64 + fr, col0 = u.x1 + wc * 32 + 8 * fq;
#pragma unroll
        for (int ai = 0; ai < 2; ++ai)
#pragma unroll
            for (int m = 0; m < 4; ++m) { bf16_t* rowp = O + (size_t)(row0 + ai * HALF + m * 16) * ldc + col0;
#pragma unroll
                for (int bj = 0; bj < 2; ++bj) { const f32x4 v0 = acc[ai][bj][m][0], v1 = acc[ai][bj][m][1];
                    u32x4 w; w.x = cvt_pk_bf16(v0[0], v0[1]); w.y = cvt_pk_bf16(v0[2], v0[3]); w.z = cvt_pk_bf16(v1[0], v1[1]); w.w = cvt_pk_bf16(v1[2], v1[3]);
                    *(u32x4*)(rowp + bj * HALF) = w; } }
    }
};
}

namespace mk {
struct NMapId { int off; __device__ __forceinline__ int operator()(int n) const { return n + off; } __device__ __forceinline__ float scl(int) const { return 1.0f; } };
struct NMapInterleave { int which; __device__ __forceinline__ int operator()(int n) const { return 2 * n + which; } __device__ __forceinline__ float scl(int) const { return 1.0f; } };
struct NMapRope { __device__ __forceinline__ int operator()(int n) const { if (n >= 2048) return n; const int ch = n >> 6, c = n & 63, half = c >> 5, w = c & 31, z = w >> 4, i = w & 15; return ch * 64 + half * 32 + 2 * i + z; }
  __device__ __forceinline__ float scl(int n) const { return n < 1024 ? 0.125f * 1.4426950408889634f : 1.0f; } };

template <class NMap>
__device__ __forceinline__ void cvt_tile(const float* __restrict__ src, int ldsrc, int K, bf16_t* __restrict__ dst, int k0, int n0, const NMap& nmap, LAS float* tile) {
  const int t = mk::otid();
  { const int k = t >> 3, c = (t & 7) * 8; const float* p = src + (size_t)(k0 + k) * ldsrc + n0 + c;
    const f32x4 a = *(const f32x4*)p, b = *(const f32x4*)(p + 4);
    LAS float* q = tile + k * 65 + c; q[0] = a[0]; q[1] = a[1]; q[2] = a[2]; q[3] = a[3]; q[4] = b[0]; q[5] = b[1]; q[6] = b[2]; q[7] = b[3]; }
  __syncthreads();
  { const int n = t >> 3, kc = (t & 7) * 8; const LAS float* q = tile + kc * 65 + n; const float sc = nmap.scl(n0 + n);
    u32x4 w; w.x = cvt_pk_bf16(q[0] * sc, q[65] * sc); w.y = cvt_pk_bf16(q[130] * sc, q[195] * sc); w.z = cvt_pk_bf16(q[260] * sc, q[325] * sc); w.w = cvt_pk_bf16(q[390] * sc, q[455] * sc);
    *(u32x4*)(dst + (size_t)nmap(n0 + n) * K + k0 + kc) = w; }
  __syncthreads();
}
template <class NMap>
__device__ __forceinline__ int cvt_matrix(const float* src, int ldsrc, int K, int N, bf16_t* dst, const NMap& nmap, LAS float* tile, int ubase, int bid, int nblk) {
  const int nkt = K / 64, nnt = N / 64, tot = nkt * nnt;
  int first = ubase + ((bid - ubase % nblk) + nblk) % nblk;
  for (int u = first; u < ubase + tot; u += nblk) { const int v = u - ubase; cvt_tile(src, ldsrc, K, dst, (v / nnt) * 64, (v % nnt) * 64, nmap, tile); }
  return tot;
}
}

namespace att {
using namespace mk;
constexpr int KB_BYTES = 64 * 128, VB_BYTES = 128 * 128, TILE_BYTES = KB_BYTES + VB_BYTES, DA_RING = 4, DA_LDS = DA_RING * TILE_BYTES;
__device__ __forceinline__ int pi32(int r) { return (r & ~12) | ((r & 4) << 1) | ((r & 8) >> 1); }
__device__ __forceinline__ int swz(int row, int chunk) { return row * 128 + ((chunk ^ ((row >> 1) & 7)) << 4); }
__device__ __forceinline__ int crow(int r, int hi) { return (r & 3) + 8 * (r >> 2) + 4 * hi; }

__device__ __forceinline__ float sumsq8(u32x4 w) { return (bflo(w.x) * bflo(w.x) + bfhi(w.x) * bfhi(w.x)) + (bflo(w.y) * bflo(w.y) + bfhi(w.y) * bfhi(w.y)) + (bflo(w.z) * bflo(w.z) + bfhi(w.z) * bfhi(w.z)) + (bflo(w.w) * bflo(w.w) + bfhi(w.w) * bfhi(w.w)); }
__device__ __forceinline__ void knorm_group(const bf16_t* __restrict__ Pqk, float* __restrict__ KN, int g, LAS float* red) {
  const int tid = mk::otid(), wid = tid >> 6, lane = tid & 63;
  float mx = 0.f, mq = 0.f;
  for (int i0 = 0; i0 < 160; i0 += 32) {
    u32x4 a[4], b[4], c[4], d[4];
#pragma unroll
    for (int j = 0; j < 4; ++j) { int i = i0 + j * 8 + wid; i = i < 132 ? i : wid; const int row = i < 128 ? g * 128 + i : NLAT + g * 4 + (i - 128);
      const bf16_t* kp = Pqk + (size_t)row * 2048 + 1024 + lane * 16; a[j] = *(const u32x4*)kp; b[j] = *(const u32x4*)(kp + 8); c[j] = *(const u32x4*)(kp - 1024); d[j] = *(const u32x4*)(kp - 1024 + 8); }
#pragma unroll
    for (int j = 0; j < 4; ++j) { float s = sumsq8(a[j]) + sumsq8(b[j]); s += dpp_mov<0xB1, 0xf, 0xf>(s, s); s += dpp_mov<0x4E, 0xf, 0xf>(s, s); mx = fmaxf(mx, s);
      float q = sumsq8(c[j]) + sumsq8(d[j]); q += dpp_mov<0xB1, 0xf, 0xf>(q, q); q += dpp_mov<0x4E, 0xf, 0xf>(q, q); mq = fmaxf(mq, q); }
  }
  if ((lane & 3) == 0) { red[wid * 32 + (lane >> 2)] = mx; red[wid * 32 + 16 + (lane >> 2)] = mq; }
  __syncthreads();
  if (tid < 32) { float m = red[tid];
#pragma unroll
    for (int w = 1; w < 8; ++w) m = fmaxf(m, red[w * 32 + tid]);
    KN[g * 32 + tid] = m; }
  __syncthreads();
}
__device__ __forceinline__ float nmax2_of(const float* __restrict__ KN, int b, int hh, int which) {
  return wave_max_u(KN[(b * 64 + (mk::otid() & 63)) * 32 + which * 16 + hh]);
}

template <bool STATIC, int ABL = 0>
__device__ __forceinline__ void diff_attn_unit(const bf16_t* __restrict__ Pqk, const bf16_t* __restrict__ Vt, bf16_t* __restrict__ O12, int hh, int q0, int klat0, int nlat, int kctx0, LAS unsigned char* lds) {
  const int tid = mk::otid(), wid = tid >> 6, lane = tid & 63, r = lane & 31, hi = lane >> 5;
  const int NT = (nlat + L) / 64, NTL = nlat / 64;
  const int wv = __builtin_amdgcn_readfirstlane(wid);
  const int drow = wv * 8 + (lane >> 3), dch = (lane & 7) ^ ((drow >> 1) & 7);
  const unsigned koff = (unsigned)(drow * 2048 + 1024 + hh * 64 + dch * 8) * 2u;
  const unsigned voff = (unsigned)(((hh >> 1) * 128 + drow) * NTOK + dch * 8) * 2u;
  bf16x8 qf[4];
  { const bf16_t* qp = Pqk + (size_t)(q0 + wid * 32 + r) * 2048 + hh * 64 + hi * 8;
#pragma unroll
    for (int ks = 0; ks < 4; ++ks) qf[ks] = *(const bf16x8*)(qp + ks * 16); }
  const unsigned kaddr0 = (unsigned)(pi32(r) * 128 + ((hi ^ ((pi32(r) >> 1) & 7)) << 4));
  const unsigned vaddr0 = (unsigned)(r * 128 + ((hi ^ ((r >> 1) & 7)) << 4)) + KB_BYTES;
  f32x16 o[4];
#pragma unroll
  for (int vb = 0; vb < 4; ++vb)
#pragma unroll
    for (int i = 0; i < 16; ++i) o[vb][i] = 0.f;
  float l_run = 0.f;
#define DA_DMA(t) do { const int tok = (t) < NTL ? klat0 + (t) * 64 : kctx0 + ((t) - NTL) * 64; LAS unsigned char* b_ = lds + ((t) & 3) * TILE_BYTES + wv * 1024; \
    const char* kt_ = (const char*)Pqk + (size_t)tok * 4096; const char* vt_ = (const char*)Vt + (size_t)tok * 2; \
    __builtin_amdgcn_global_load_lds((const unsigned*)(kt_ + koff), (LAS unsigned*)b_, 16, 0, 0); \
    __builtin_amdgcn_global_load_lds((const unsigned*)(vt_ + voff), (LAS unsigned*)(b_ + KB_BYTES), 16, 0, 0); \
    __builtin_amdgcn_global_load_lds((const unsigned*)(vt_ + (size_t)64 * NTOK * 2 + voff), (LAS unsigned*)(b_ + KB_BYTES + 8192), 16, 0, 0); } while (0)
#define DA_WAITV(n) asm volatile("s_waitcnt vmcnt(" #n ")" ::: "memory")
#define DA_PAIR_BEGIN(t) if (!(ABL & 8) && (t) + 2 < NT) { DA_DMA((t) + 2); DA_DMA((t) + 3); }
#define DA_SLOT(tt) const unsigned sb_ = (unsigned)(((tt) & 3) * TILE_BYTES); const LAS unsigned char* kb_ = lds + (kaddr0 + sb_); const LAS unsigned char* vb_ = lds + (vaddr0 + sb_)
#define DA_PAIR_END() do { DA_WAITV(0); asm volatile("s_waitcnt lgkmcnt(0)" ::: "memory"); if (!(ABL & 16)) __builtin_amdgcn_s_barrier(); } while (0)
  DA_DMA(0); DA_DMA(1);
  DA_WAITV(0); __builtin_amdgcn_s_barrier();
#define DA_XOR(ptr, x) ((const LAS unsigned char*)((unsigned)(size_t)(ptr) ^ (unsigned)(x)))
#define DA_KFRAG(ks) const LAS unsigned char* kp_ = DA_XOR(kb_, (ks) << 5); const bf16x8 a0 = (ABL & 2) ? qf[ks] : *(const LAS bf16x8*)kp_, a1 = (ABL & 2) ? qf[(ks) ^ 1] : *(const LAS bf16x8*)(kp_ + 4096)
#define DA_VFRAGS() bf16x8 va[4][4]; \
    _Pragma("unroll") for (int c4 = 0; c4 < 4; ++c4) { const LAS unsigned char* vp_ = DA_XOR(vb_, c4 << 5); \
      _Pragma("unroll") for (int vb = 0; vb < 4; ++vb) va[vb][c4] = (ABL & 1) ? qf[c4 ^ (vb & 3)] : *(const LAS bf16x8*)(vp_ + vb * 4096); }
#define DA_PACK_PV() bf16x8 pf[2][2]; \
    _Pragma("unroll") for (int s = 0; s < 2; ++s) { u32x4 w0, w1; \
      w0.x = cvt_pk_bf16(s0[8 * s + 0], s0[8 * s + 1]); w0.y = cvt_pk_bf16(s0[8 * s + 2], s0[8 * s + 3]); w0.z = cvt_pk_bf16(s0[8 * s + 4], s0[8 * s + 5]); w0.w = cvt_pk_bf16(s0[8 * s + 6], s0[8 * s + 7]); \
      w1.x = cvt_pk_bf16(s1[8 * s + 0], s1[8 * s + 1]); w1.y = cvt_pk_bf16(s1[8 * s + 2], s1[8 * s + 3]); w1.z = cvt_pk_bf16(s1[8 * s + 4], s1[8 * s + 5]); w1.w = cvt_pk_bf16(s1[8 * s + 6], s1[8 * s + 7]); \
      pf[0][s] = __builtin_bit_cast(bf16x8, w0); pf[1][s] = __builtin_bit_cast(bf16x8, w1); } \
    _Pragma("unroll") for (int vb = 0; vb < 4; ++vb) _Pragma("unroll") for (int kb = 0; kb < 2; ++kb) _Pragma("unroll") for (int s = 0; s < 2; ++s) \
      o[vb] = __builtin_amdgcn_mfma_f32_32x32x16_bf16(va[vb][kb * 2 + s], pf[kb][s], o[vb], 0, 0, 0)
  if constexpr (STATIC) {
    for (int t = 0; t < NT; t += 2) {
      DA_PAIR_BEGIN(t);
#pragma unroll
      for (int u = 0; u < 2; ++u) {
        DA_SLOT(t + u);
        f32x16 s0, s1;
#pragma unroll
        for (int i = 0; i < 16; ++i) { s0[i] = 0.f; s1[i] = 0.f; }
#pragma unroll
        for (int ks = 0; ks < 4; ++ks) { DA_KFRAG(ks); s0 = __builtin_amdgcn_mfma_f32_32x32x16_bf16(a0, qf[ks], s0, 0, 0, 0); s1 = __builtin_amdgcn_mfma_f32_32x32x16_bf16(a1, qf[ks], s1, 0, 0, 0); }
        DA_VFRAGS();
        if constexpr ((ABL & 32) != 0) {
          l_run += s0[0] + s1[0];
#pragma unroll
          for (int vb = 0; vb < 4; ++vb)
#pragma unroll
            for (int c4 = 0; c4 < 4; ++c4) o[vb] = __builtin_amdgcn_mfma_f32_32x32x16_bf16(va[vb][c4], qf[c4], o[vb], 0, 0, 0);
        } else {
          float ps = 0.f;
#pragma unroll
          for (int i = 0; i < 16; ++i) { s0[i] = (ABL & 4) ? s0[i] : __builtin_amdgcn_exp2f(s0[i]); ps += s0[i]; }
#pragma unroll
          for (int i = 0; i < 16; ++i) { s1[i] = (ABL & 4) ? s1[i] : __builtin_amdgcn_exp2f(s1[i]); ps += s1[i]; }
          l_run += ps;
          DA_PACK_PV();
        }
        if (u == 0) __builtin_amdgcn_sched_barrier(0);
      }
      DA_PAIR_END();
    }
  } else {
    constexpr float THR = 8.0f * 1.4426950408889634f;
    float m_run = -1e30f;
    for (int t = 0; t < NT; ++t) {
      if (!(t & 1)) DA_PAIR_BEGIN(t);
      DA_SLOT(t);
      f32x16 s0 = zero16(), s1 = zero16();
#pragma unroll
      for (int ks = 0; ks < 4; ++ks) { DA_KFRAG(ks); s0 = __builtin_amdgcn_mfma_f32_32x32x16_bf16(a0, qf[ks], s0, 0, 0, 0); s1 = __builtin_amdgcn_mfma_f32_32x32x16_bf16(a1, qf[ks], s1, 0, 0, 0); }
      float mx = fmaxf(s0[0], s1[0]);
#pragma unroll
      for (int i = 1; i < 16; ++i) mx = fmaxf(mx, fmaxf(s0[i], s1[i]));
      { const u32x2 sw = __builtin_amdgcn_permlane32_swap(__float_as_uint(mx), __float_as_uint(mx), false, false); mx = fmaxf(__uint_as_float(sw.x), __uint_as_float(sw.y)); }
      float alpha = 1.0f;
      if (!__all(mx - m_run <= THR)) {
        const float m_new = fmaxf(m_run, mx);
        alpha = __builtin_amdgcn_exp2f(m_run - m_new);
        m_run = m_new;
#pragma unroll
        for (int vb = 0; vb < 4; ++vb)
#pragma unroll
          for (int i = 0; i < 16; ++i) o[vb][i] *= alpha;
      }
      float ps = 0.f;
#pragma unroll
      for (int i = 0; i < 16; ++i) { s0[i] = __builtin_amdgcn_exp2f(s0[i] - m_run); ps += s0[i]; }
#pragma unroll
      for (int i = 0; i < 16; ++i) { s1[i] = __builtin_amdgcn_exp2f(s1[i] - m_run); ps += s1[i]; }
      l_run = l_run * alpha + ps;
      __builtin_amdgcn_sched_barrier(0);
      DA_VFRAGS();
      DA_PACK_PV();
      if (t & 1) DA_PAIR_END();
    }
  }
#undef DA_KFRAG
#undef DA_XOR
#undef DA_VFRAGS
#undef DA_PACK_PV
#undef DA_DMA
#undef DA_WAITV
#undef DA_PAIR_BEGIN
#undef DA_PAIR_END
#undef DA_SLOT
  float l_tot; { const u32x2 sw = __builtin_amdgcn_permlane32_swap(__float_as_uint(l_run), __float_as_uint(l_run), false, false); l_tot = __uint_as_float(sw.x) + __uint_as_float(sw.y); }
  const float inv = 1.0f / l_tot;
  const int te = mk::otid();
  bf16_t* op = O12 + (size_t)(q0 + (te >> 6) * 32 + (te & 31)) * 2048 + hh * 128 + 4 * ((te >> 5) & 1);
#pragma unroll
  for (int vb = 0; vb < 4; ++vb)
#pragma unroll
    for (int g = 0; g < 4; ++g) {
      u32x2 w; w.x = cvt_pk_bf16(o[vb][4 * g] * inv, o[vb][4 * g + 1] * inv); w.y = cvt_pk_bf16(o[vb][4 * g + 2] * inv, o[vb][4 * g + 3] * inv);
      *(u32x2*)(op + vb * 32 + 8 * g) = w;
    }
}

__device__ __forceinline__ void diff_combine_rows4(const bf16_t* __restrict__ O12, const float* __restrict__ subln_g, float lam, float oml, bf16_t* __restrict__ O, int row0, int h, int lane) {
  unsigned a[4], b[4];
#pragma unroll
  for (int i = 0; i < 4; ++i) { a[i] = *(const unsigned*)(O12 + (size_t)(row0 + i) * 2048 + (2 * h) * 128 + 2 * lane); b[i] = *(const unsigned*)(O12 + (size_t)(row0 + i) * 2048 + (2 * h + 1) * 128 + 2 * lane); }
  const float g0 = subln_g[2 * lane], g1 = subln_g[2 * lane + 1];
#pragma unroll
  for (int i = 0; i < 4; ++i) {
    const float x0 = bflo(a[i]) - lam * bflo(b[i]), x1 = bfhi(a[i]) - lam * bfhi(b[i]);
    const float ss = wave_sum_u(x0 * x0 + x1 * x1);
    const float rs = rsqrtf(ss * (1.0f / 128.0f) + 1e-5f) * oml;
    *(unsigned*)(O + (size_t)(row0 + i) * 1024 + h * 128 + 2 * lane) = cvt_pk_bf16(x0 * rs * g0, x1 * rs * g1);
  }
}
}

namespace natt {
using namespace mk;
using att::pi32; using att::swz;
constexpr int TB = 64 * 128;
constexpr int NA_LDS = 4 * TB + 2048;
__device__ __forceinline__ void na_attn_unit(const bf16_t* __restrict__ Pe, const bf16_t* __restrict__ Vte, const float* __restrict__ rpb_h, bf16_t* __restrict__ O, int b, int h, int rq, LAS unsigned char* lds) {
  const int tid = mk::otid(), wid = tid >> 6, lane = tid & 63, r = lane & 31, hi = lane >> 5;
  constexpr float LOG2E = 1.4426950408889634f;
  LAS float* sb = (LAS float*)(lds + 4 * TB);
  for (int i = tid; i < 465; i += NTHR) sb[i] = rpb_h[i];
  const bool is_ctx = rq < 0;
  int qrow = 0, qcol = 0, qtok, rs_q = 0, cs_q = 0, span0 = 0, wlo = 0, whi = -1, lo = 0, ntl = 0;
  if (!is_ctx) {
    const int r0 = rq * 4, ra = r0 + (wid >> 2) * 2;
    qrow = ra + (r >> 4); qcol = (wid & 3) * 16 + (r & 15); qtok = b * T + qrow * 64 + qcol;
    rs_q = min(max(qrow - 4, 0), 120); cs_q = min(max(qcol - 8, 0), 48);
    span0 = min(max((wid & 3) * 16 - 8, 0), 32);
    wlo = min(max(ra - 4, 0), 120); whi = min(max(ra - 3, 0), 120) + 7;
    lo = min(max(r0 - 4, 0), 120); const int hi_ = min(max(r0 - 1, 0), 120) + 7; ntl = hi_ - lo + 1;
  } else qtok = NLAT + b * L + wid * 32 + r;
  const int NT = ntl + 4;
  const int srow = tid >> 3, sch = tid & 7;
  const bf16_t* kbase = Pe + 512 + h * 64 + sch * 8;
  const bf16_t* vbase = Vte + (size_t)(h * 64 + srow) * NTOK + sch * 8;
  const int sdst = swz(srow, sch);
  bf16x8 qf[4];
  { const bf16_t* qp = Pe + (size_t)qtok * 1024 + h * 64 + hi * 8;
#pragma unroll
    for (int ks = 0; ks < 4; ++ks) qf[ks] = *(const bf16x8*)(qp + ks * 16); }
  const int kx = (pi32(r) >> 1) & 7, vx = (r >> 1) & 7;
  const int ka_loc = (span0 + pi32(r)) * 128; const int kx_loc = ((span0 + pi32(r)) >> 1) & 7;
  f32x16 o[2];
#pragma unroll
  for (int vb = 0; vb < 2; ++vb)
#pragma unroll
    for (int i = 0; i < 16; ++i) o[vb][i] = 0.f;
  float m_run = -1e30f, l_run = 0.f;
  u32x4 kreg, vreg;
#define NA_LOAD(t) do { const int tok = (t) < ntl ? b * T + (lo + (t)) * 64 : NLAT + b * L + ((t) - ntl) * 64; \
    kreg = *(const u32x4*)(kbase + (size_t)(tok + srow) * 1024); vreg = *(const u32x4*)(vbase + tok); } while (0)
#define NA_WRITE(bufi) do { *(LAS u32x4*)(lds + (bufi) * TB + sdst) = kreg; *(LAS u32x4*)(lds + 2 * TB + (bufi) * TB + sdst) = vreg; } while (0)
  NA_LOAD(0); NA_WRITE(0); __syncthreads();
  for (int t = 0; t < NT; ++t) {
    const bool more = t + 1 < NT;
    if (more) NA_LOAD(t + 1);
    const LAS unsigned char* kb_ = lds + (t & 1) * TB; const LAS unsigned char* vb_ = lds + 2 * TB + (t & 1) * TB;
    const bool local = t < ntl; const int kr = lo + t;
    const bool active = !local || (kr >= wlo && kr <= whi);
    if (active) {
      f32x16 s0, s1;
#pragma unroll
      for (int i = 0; i < 16; ++i) { s0[i] = 0.f; s1[i] = 0.f; }
      if (local) {
#pragma unroll
        for (int ks = 0; ks < 4; ++ks) {
          const bf16x8 a0 = *(const LAS bf16x8*)(kb_ + ka_loc + (((ks * 2 + hi) ^ kx_loc) << 4));
          s0 = __builtin_amdgcn_mfma_f32_32x32x16_bf16(a0, qf[ks], s0, 0, 0, 0);
        }
        const bool row_ok = kr >= rs_q && kr < rs_q + 8; const int dr31 = (kr - qrow + 7) * 31;
#pragma unroll
        for (int i = 0; i < 16; ++i) {
          const int kc = span0 + (i & 7) + 8 * hi + 16 * (i >> 3);
          const bool ok = row_ok && kc >= cs_q && kc < cs_q + 16;
          const int bi = ok ? dr31 + (kc - qcol + 15) : 0;
          const float bv = sb[bi];
          s0[i] = ok ? fmaf(s0[i], 0.125f, bv) : -1e30f; s1[i] = -1e30f;
        }
      } else {
#pragma unroll
        for (int ks = 0; ks < 4; ++ks) {
          const int ch = ((ks * 2 + hi) ^ kx) << 4;
          const bf16x8 a0 = *(const LAS bf16x8*)(kb_ + pi32(r) * 128 + ch), a1 = *(const LAS bf16x8*)(kb_ + (32 + pi32(r)) * 128 + ch);
          s0 = __builtin_amdgcn_mfma_f32_32x32x16_bf16(a0, qf[ks], s0, 0, 0, 0);
          s1 = __builtin_amdgcn_mfma_f32_32x32x16_bf16(a1, qf[ks], s1, 0, 0, 0);
        }
#pragma unroll
        for (int i = 0; i < 16; ++i) { s0[i] *= 0.125f; s1[i] *= 0.125f; }
      }
      float mx = s0[0];
#pragma unroll
      for (int i = 1; i < 16; ++i) mx = fmaxf(mx, s0[i]);
#pragma unroll
      for (int i = 0; i < 16; ++i) mx = fmaxf(mx, s1[i]);
      { const u32x2 sw = __builtin_amdgcn_permlane32_swap(__float_as_uint(mx), __float_as_uint(mx), false, false); mx = fmaxf(__uint_as_float(sw.x), __uint_as_float(sw.y)); }
      const float m_new = fmaxf(m_run, mx);
      const float alpha = __builtin_amdgcn_exp2f((m_run - m_new) * LOG2E);
      m_run = m_new;
      const float mc = -m_new * LOG2E;
      float ps = 0.f;
#pragma unroll
      for (int i = 0; i < 16; ++i) { const float p = s0[i] > -1e29f ? __builtin_amdgcn_exp2f(fmaf(s0[i], LOG2E, mc)) : 0.f; s0[i] = p; ps += p; }
#pragma unroll
      for (int i = 0; i < 16; ++i) { const float p = s1[i] > -1e29f ? __builtin_amdgcn_exp2f(fmaf(s1[i], LOG2E, mc)) : 0.f; s1[i] = p; ps += p; }
      l_run = l_run * alpha + ps;
      if (__any(alpha < 1.0f)) {
#pragma unroll
        for (int vb = 0; vb < 2; ++vb)
#pragma unroll
          for (int i = 0; i < 16; ++i) o[vb][i] *= alpha;
      }
      bf16x8 pf[2][2];
#pragma unroll
      for (int s = 0; s < 2; ++s) {
        u32x4 w0, w1;
        w0.x = cvt_pk_bf16(s0[8 * s + 0], s0[8 * s + 1]); w0.y = cvt_pk_bf16(s0[8 * s + 2], s0[8 * s + 3]); w0.z = cvt_pk_bf16(s0[8 * s + 4], s0[8 * s + 5]); w0.w = cvt_pk_bf16(s0[8 * s + 6], s0[8 * s + 7]);
        w1.x = cvt_pk_bf16(s1[8 * s + 0], s1[8 * s + 1]); w1.y = cvt_pk_bf16(s1[8 * s + 2], s1[8 * s + 3]); w1.z = cvt_pk_bf16(s1[8 * s + 4], s1[8 * s + 5]); w1.w = cvt_pk_bf16(s1[8 * s + 6], s1[8 * s + 7]);
        pf[0][s] = __builtin_bit_cast(bf16x8, w0); pf[1][s] = __builtin_bit_cast(bf16x8, w1);
      }
      const int cbase = local ? (span0 >> 3) : 0;
#pragma unroll
      for (int vb = 0; vb < 2; ++vb) {
        const LAS unsigned char* vrow = vb_ + (vb * 32 + r) * 128;
#pragma unroll
        for (int s = 0; s < 2; ++s) {
          const bf16x8 a = *(const LAS bf16x8*)(vrow + (((cbase + 2 * s + hi) ^ vx) << 4));
          o[vb] = __builtin_amdgcn_mfma_f32_32x32x16_bf16(a, pf[0][s], o[vb], 0, 0, 0);
        }
        if (!local) {
#pragma unroll
          for (int s = 0; s < 2; ++s) {
            const bf16x8 a = *(const LAS bf16x8*)(vrow + (((4 + 2 * s + hi) ^ vx) << 4));
            o[vb] = __builtin_amdgcn_mfma_f32_32x32x16_bf16(a, pf[1][s], o[vb], 0, 0, 0);
          }
        }
      }
    }
    if (more) NA_WRITE((t + 1) & 1);
    __syncthreads();
  }
#undef NA_LOAD
#undef NA_WRITE
  float l_tot; { const u32x2 sw = __builtin_amdgcn_permlane32_swap(__float_as_uint(l_run), __float_as_uint(l_run), false, false); l_tot = __uint_as_float(sw.x) + __uint_as_float(sw.y); }
  const float inv = 1.0f / l_tot;
  bf16_t* op = O + (size_t)qtok * 1024 + h * 64 + 4 * hi;
#pragma unroll
  for (int vb = 0; vb < 2; ++vb)
#pragma unroll
    for (int g = 0; g < 4; ++g) {
      u32x2 w; w.x = cvt_pk_bf16(o[vb][4 * g] * inv, o[vb][4 * g + 1] * inv); w.y = cvt_pk_bf16(o[vb][4 * g + 2] * inv, o[vb][4 * g + 3] * inv);
      *(u32x2*)(op + vb * 32 + 8 * g) = w;
    }
}
}

namespace rw {
using namespace mk;
constexpr int NSTEP = L + T, NCH = 32, CL = NSTEP / NCH;
constexpr int NCHAIN = 2 * B * 8;
constexpr float LOG2E = 1.4426950408889634f;
struct Bufs {
  u32x2* SH;
  unsigned* DR;
  bf16_t* G; int gstride;
  float* CS;
  float* PQ;
  float* SST;
  bf16_t* Y;
  bf16_t* Z;
};

constexpr int XPITCH = 528;
__device__ __forceinline__ void lora_mfma(const LAS unsigned char* xb, int xcol0, const bf16_t* __restrict__ W, int K, int h, int lane, LAS float* tw, float (&out)[16]) {
  const int fr = lane & 15, fq = lane >> 4;
  f32x4 acc[4];
#pragma unroll
  for (int nb = 0; nb < 4; ++nb) { float z = 0.f; asm volatile("" : "+v"(z)); acc[nb] = (f32x4){z, z, z, z}; }
  for (int ks = 0; ks < K / 32; ++ks) {
    const bf16x8 xf = *(const LAS bf16x8*)(xb + fr * XPITCH + (xcol0 + ks * 32 + fq * 8) * 2);
    bf16x8 wf[4];
#pragma unroll
    for (int nb = 0; nb < 4; ++nb) wf[nb] = *(const bf16x8*)(W + (size_t)(h * 64 + nb * 16 + fr) * K + ks * 32 + fq * 8);
#pragma unroll
    for (int nb = 0; nb < 4; ++nb) acc[nb] = __builtin_amdgcn_mfma_f32_16x16x32_bf16(xf, wf[nb], acc[nb], 0, 0, 0);
  }
#pragma unroll
  for (int nb = 0; nb < 4; ++nb) *(LAS f32x4*)(tw + (nb * 16 + fr) * 16 + fq * 4) = acc[nb];
  __builtin_amdgcn_wave_barrier(); asm volatile("s_waitcnt lgkmcnt(0)" ::: "memory"); __builtin_amdgcn_wave_barrier();
#pragma unroll
  for (int q = 0; q < 4; ++q) { const f32x4 v = *(const LAS f32x4*)(tw + lane * 16 + q * 4); out[q * 4] = v[0]; out[q * 4 + 1] = v[1]; out[q * 4 + 2] = v[2]; out[q * 4 + 3] = v[3]; }
  __builtin_amdgcn_wave_barrier(); asm volatile("s_waitcnt lgkmcnt(0)" ::: "memory"); __builtin_amdgcn_wave_barrier();
}
__device__ __forceinline__ void prep_tile(const bf16_t* __restrict__ Prw, const float* __restrict__ cw, const float* __restrict__ w0, const bf16_t* __restrict__ WLT, const float* __restrict__ a0,
                                          const float* __restrict__ k_k, const float* __restrict__ k_a, const float* __restrict__ r_k,
                                          const Bufs& bf, int tile, LAS float* xs  ) {
  const int c = mk::otid(), lane = c & 63, h = c >> 6;
  const int row0 = tile * 16;
  int lo, hi;
  if (row0 < NLAT) { lo = (row0 / T) * T; hi = lo + T - 1; } else { lo = NLAT + ((row0 - NLAT) / L) * L; hi = lo + L - 1; }
#define RW_CONV(dst, col) do { const float c0 = cw[(col)], c1 = cw[RW_IN + (col)], c2 = cw[2 * RW_IN + (col)]; const bf16_t* p = Prw + (col); \
    bf16_t raw[18]; \
    _Pragma("unroll") for (int j = 0; j < 18; ++j) { int rr = row0 - 1 + j; rr = rr < lo ? lo : (rr > hi ? hi : rr); raw[j] = p[(size_t)rr * RW_IN]; } \
    float pm = row0 > lo ? bf2f(raw[0]) : 0.f, pc = bf2f(raw[1]); \
    _Pragma("unroll") for (int tt = 0; tt < 16; ++tt) { const float pn = (row0 + tt + 1 <= hi) ? bf2f(raw[tt + 2]) : 0.f; dst[tt] = pm * c0 + pc * c1 + pn * c2; pm = pc; pc = pn; } } while (0)
  if (c < 256) {
    float xv[16]; RW_CONV(xv, 1536 + c);
#pragma unroll
    for (int tt = 0; tt < 16; ++tt) { float v = xv[tt]; if (c < 64) v = tanhf(v); else if (c >= 128) v = sigmoidf_(v); *(LAS bf16_t*)((LAS unsigned char*)xs + tt * XPITCH + c * 2) = f2bf(v); }
  }
  __syncthreads();
  const LAS unsigned char* xb = (const LAS unsigned char*)xs; LAS float* tw = xs + 20480 + h * 1024;
  const float w00 = w0[c], w01 = w0[512 + c], a00 = a0[c], a01 = a0[512 + c], kkc = k_k[c], kac = k_a[c], rkc = r_k[c];
  float e0[16], e1[16];
  {
    float aw0[16], aw1[16];
    lora_mfma(xb, 0, WLT, 64, h, lane, tw, aw0); lora_mfma(xb, 0, WLT + 32768, 64, h, lane, tw, aw1);
#pragma unroll
    for (int tt = 0; tt < 16; ++tt) {
      e0[tt] = 0.6065306597126334f * __builtin_amdgcn_rcpf(1.0f + __expf(-(w00 + aw0[tt])));
      e1[tt] = 0.6065306597126334f * __builtin_amdgcn_rcpf(1.0f + __expf(-(w01 + aw1[tt])));
    }
  }
  LAS float* asl = xs + 256 * 16;
  {
    float aa0[16], aa1[16];
    lora_mfma(xb, 64, WLT + 2 * 32768, 64, h, lane, tw, aa0); lora_mfma(xb, 64, WLT + 3 * 32768, 64, h, lane, tw, aa1);
#pragma unroll
    for (int tt = 0; tt < 16; ++tt) { const unsigned d0 = cvt_pk_bf16(e0[tt], sigmoidf_(a00 + aa0[tt])), d1 = cvt_pk_bf16(e1[tt], sigmoidf_(a01 + aa1[tt]));
      bf.DR[((size_t)(row0 + tt)) * 512 + c] = d0; bf.DR[((size_t)NTOK + row0 + tt) * 512 + c] = d1; asl[tt * 512 + c] = bfhi(d0); asl[(16 + tt) * 512 + c] = bfhi(d1); }
  }
  {
    float ag[16];
    lora_mfma(xb, 128, WLT + 4 * 32768, 128, h, lane, tw, ag);
#pragma unroll
    for (int tt = 0; tt < 16; ++tt) bf.G[(size_t)(row0 + tt) * bf.gstride + c] = f2bf(ag[tt]);
  }
#undef RW_CONV
  const float cr0 = cw[c], cr1 = cw[RW_IN + c], cr2 = cw[2 * RW_IN + c], ck0 = cw[512 + c], ck1 = cw[RW_IN + 512 + c], ck2 = cw[2 * RW_IN + 512 + c], cv0 = cw[1024 + c], cv1 = cw[RW_IN + 1024 + c], cv2 = cw[2 * RW_IN + 1024 + c];
  const bf16_t* pr = Prw + (size_t)row0 * RW_IN + c;
  const bf16_t* prm = Prw + (size_t)(row0 > lo ? row0 - 1 : row0) * RW_IN + c;
  const bf16_t rm_ = prm[0], km_ = prm[512], vm_ = prm[1024];
  float rm = row0 > lo ? bf2f(rm_) : 0.f, km = row0 > lo ? bf2f(km_) : 0.f, vm = row0 > lo ? bf2f(vm_) : 0.f;
  float rc = bf2f(pr[0]), kc = bf2f(pr[512]), vc = bf2f(pr[1024]);
#pragma unroll 2
  for (int tt = 0; tt < 16; ++tt) {
    const int row = row0 + tt;
    const bool has_n = row + 1 <= hi; const bf16_t* pn = pr + (size_t)(has_n ? tt + 1 : tt) * RW_IN;
    const bf16_t rn_ = pn[0], kn_ = pn[512], vn_ = pn[1024];
    const float rn = has_n ? bf2f(rn_) : 0.f, kn = has_n ? bf2f(kn_) : 0.f, vn = has_n ? bf2f(vn_) : 0.f;
    const float rv = rm * cr0 + rc * cr1 + rn * cr2, kvv = km * ck0 + kc * ck1 + kn * ck2, vvv = vm * cv0 + vc * cv1 + vn * cv2;
    rm = rc; rc = rn; km = kc; kc = kn; vm = vc; vc = vn;
    float kk = kvv * kkc; const float nrm = sqrtf(wave_sum_u(kk * kk)); kk = kk * __builtin_amdgcn_rcpf(fmaxf(nrm, 1e-12f));
    u32x2 sh; sh.x = cvt_pk_bf16(rv, kvv); sh.y = cvt_pk_bf16(kk, vvv);
    bf.SH[(size_t)row * 512 + c] = sh;
    const float rq = bflo(sh.x), kq = bfhi(sh.x);
    const float cb0 = wave_sum_u(rq * kq * (1.0f + (asl[tt * 512 + c] - 1.0f) * kac) * rkc), cb1 = wave_sum_u(rq * kq * (1.0f + (asl[(16 + tt) * 512 + c] - 1.0f) * kac) * rkc);
    if (lane == 0) { bf.CS[(size_t)row * 16 + h] = cb0; bf.CS[(size_t)row * 16 + 8 + h] = cb1; }
  }
  __syncthreads();
}

struct StepRaw { u32x2 s; unsigned d; };
__device__ __forceinline__ int scan_row(int dir, int b, int p) {
  if (p < L) return NLAT + b * L + (dir ? (L - 1 - p) : p);
  const int q = p - L; return b * T + (dir ? (T - 1 - q) : q);
}
__device__ __forceinline__ void scan_unit(const Bufs& bf, const float* __restrict__ k_a, int chain, int chunk, LAS float* wl) {
  const int lane = mk::otid() & 63, r = lane & 31, hi = lane >> 5;
  const int dir = chain >> 5, b = (chain >> 3) & 3, h = chain & 7, ch = h * 64 + lane;
  const float kac = k_a[ch];
  f32x16 TS[2][2], TP[2][2];
#pragma unroll
  for (int rb = 0; rb < 2; ++rb)
#pragma unroll
    for (int cb = 0; cb < 2; ++cb)
#pragma unroll
      for (int q = 0; q < 16; ++q) { TS[rb][cb][q] = 0.f; TP[rb][cb][q] = (32 * rb + (q & 3) + 8 * (q >> 2) + 4 * hi == 32 * cb + r) ? 1.f : 0.f; }
  LAS unsigned char* wb = (LAS unsigned char*)wl;
  const LAS unsigned char* xrow = wb + (lane & 15) * 128 + 8 * hi;
  LAS float* Gl = wl + 1024;
  const int p0 = chunk * CL;
  float Dl = 1.f;
#define RW_FRAG(base, rb, s2) ([&]() { const u32x2 lo_ = *(const LAS u32x2*)((base) + (32 * (rb) + 16 * (s2)) * 2), hi_ = *(const LAS u32x2*)((base) + (32 * (rb) + 16 * (s2) + 8) * 2); \
      return __builtin_bit_cast(bf16x8, (u32x4){lo_.x, lo_.y, hi_.x, hi_.y}); }())
#define RW_DOTS(T, o) do { _Pragma("unroll") for (int cb = 0; cb < 2; ++cb) _Pragma("unroll") for (int q = 0; q < 16; ++q) o[cb][q] = 0.f; \
    _Pragma("unroll") for (int rb = 0; rb < 2; ++rb) _Pragma("unroll") for (int s2 = 0; s2 < 2; ++s2) _Pragma("unroll") for (int cb = 0; cb < 2; ++cb) { u32x4 w_; \
      w_.x = cvt_pk_bf16(T[rb][cb][8 * s2 + 0], T[rb][cb][8 * s2 + 1]); w_.y = cvt_pk_bf16(T[rb][cb][8 * s2 + 2], T[rb][cb][8 * s2 + 3]); \
      w_.z = cvt_pk_bf16(T[rb][cb][8 * s2 + 4], T[rb][cb][8 * s2 + 5]); w_.w = cvt_pk_bf16(T[rb][cb][8 * s2 + 6], T[rb][cb][8 * s2 + 7]); \
      o[cb] = __builtin_amdgcn_mfma_f32_32x32x16_bf16(xf[rb][s2], __builtin_bit_cast(bf16x8, w_), o[cb], 0, 0, 0); \
      asm volatile("" : "+v"(o[cb]) : "v"(w_), "v"(xf[rb][s2]));   } } while (0)
#define RW_RENORM() do { wl[1280 + lane] = Dl; __builtin_amdgcn_wave_barrier(); \
    _Pragma("unroll") for (int rb = 0; rb < 2; ++rb) _Pragma("unroll") for (int g = 0; g < 4; ++g) { const f32x4 w4 = *(const LAS f32x4*)(wl + 1280 + 32 * rb + 8 * g + 4 * hi); \
      _Pragma("unroll") for (int cb = 0; cb < 2; ++cb) _Pragma("unroll") for (int u = 0; u < 4; ++u) { TS[rb][cb][4 * g + u] *= w4[u]; TP[rb][cb][4 * g + u] *= w4[u]; } } \
    __builtin_amdgcn_wave_barrier(); Dl = 1.f; } while (0)
  const int wvs = __builtin_amdgcn_readfirstlane((int)((size_t)wl));
#define RW_FETCH(tb) do { _Pragma("unroll") for (int u = 0; u < 8; ++u) { const int pn = (tb) + u < CL ? (tb) + u : CL - 1; const int row = scan_row(dir, b, p0 + pn); \
      const unsigned* gs = (const unsigned*)(bf.SH + (size_t)row * 512 + ch); const unsigned* gd = bf.DR + ((size_t)dir * NTOK + row) * 512 + ch; LAS unsigned* ld = (LAS unsigned*)(size_t)(wvs + 8192 + u * 768); \
      __builtin_amdgcn_global_load_lds(gs, ld, 4, 0, 0); __builtin_amdgcn_global_load_lds(gs + 1, ld + 64, 4, 0, 0); __builtin_amdgcn_global_load_lds(gd, ld + 128, 4, 0, 0); } } while (0)
  RW_FETCH(0);
  for (int t0 = 0; t0 < CL; t0 += 8) {
    asm volatile("s_waitcnt vmcnt(0)" ::: "memory");
    __builtin_amdgcn_wave_barrier();
#pragma unroll
    for (int u = 0; u < 8; ++u) {
      const LAS unsigned* ld = (const LAS unsigned*)(wb + 8192 + u * 768) + lane; const unsigned sx = ld[0], sy = ld[64], dd = ld[128];
      const float rr = bflo(sx), k = bfhi(sx), kk = bflo(sy), e = bflo(dd), asg = bfhi(dd);
      const float w = __builtin_amdgcn_exp2f(-e * LOG2E), keff = k * (1.0f + (asg - 1.0f) * kac);
      ((LAS bf16_t*)wb)[u * 64 + lane] = f2bf(-kk * Dl);
      Dl *= w; const float dinv = __builtin_amdgcn_rcpf(Dl);
      ((LAS bf16_t*)wb)[(8 + u) * 64 + lane] = f2bf(rr * Dl);
      ((LAS bf16_t*)wb)[1024 + u * 64 + lane] = f2bf(kk * asg * dinv); ((LAS bf16_t*)wb)[1024 + (8 + u) * 64 + lane] = f2bf(keff * dinv);
      ((LAS bf16_t*)wb)[3072 + u * 64 + lane] = (bf16_t)(sy >> 16);
    }
    asm volatile("s_waitcnt lgkmcnt(0)" ::: "memory");
    __builtin_amdgcn_wave_barrier();
    RW_FETCH(t0 + 8);
    __builtin_amdgcn_wave_barrier();
    bf16x8 xf[2][2];
#pragma unroll
    for (int rb = 0; rb < 2; ++rb)
#pragma unroll
      for (int s2 = 0; s2 < 2; ++s2) xf[rb][s2] = RW_FRAG(xrow, rb, s2);
    { f32x16 gm;
#pragma unroll
      for (int q = 0; q < 16; ++q) gm[q] = 0.f;
#pragma unroll
      for (int rb = 0; rb < 2; ++rb)
#pragma unroll
        for (int s2 = 0; s2 < 2; ++s2) { const bf16x8 yf = RW_FRAG(xrow + 2048, rb, s2); gm = __builtin_amdgcn_mfma_f32_32x32x16_bf16(xf[rb][s2], yf, gm, 0, 0, 0); asm volatile("" : "+v"(gm) : "v"(yf), "v"(xf[rb][s2])); }
      if (r < 16) {
#pragma unroll
        for (int q = 0; q < 8; ++q) Gl[((q & 3) + 8 * (q >> 2) + 4 * hi) * 16 + r] = gm[q]; }
    }
    float sa[2][8], yy[2][8];
    { f32x16 oS[2], oP[2];
      RW_DOTS(TS, oS); RW_DOTS(TP, oP);
#pragma unroll
      for (int cb = 0; cb < 2; ++cb)
#pragma unroll
        for (int q = 0; q < 4; ++q) {
          { const u32x2 sw = __builtin_amdgcn_permlane32_swap(__float_as_uint(oS[cb][q]), __float_as_uint(oP[cb][q]), false, false); sa[cb][q] = __uint_as_float(sw.x); sa[cb][4 + q] = __uint_as_float(sw.y); }
          { const u32x2 sw = __builtin_amdgcn_permlane32_swap(__float_as_uint(oS[cb][4 + q]), __float_as_uint(oP[cb][4 + q]), false, false); yy[cb][q] = __uint_as_float(sw.x); yy[cb][4 + q] = __uint_as_float(sw.y); } }
    }
    __builtin_amdgcn_wave_barrier();
    float vm[2][8];
#pragma unroll
    for (int u = 0; u < 8; ++u) { const LAS bf16_t* vr = (const LAS bf16_t*)wb + 3072 + u * 64 + r; vm[0][u] = hi ? 0.f : bf2f(vr[0]); vm[1][u] = hi ? 0.f : bf2f(vr[32]); }
#pragma unroll
    for (int s = 0; s < 8; ++s) {
      const f32x4 ga0 = *(const LAS f32x4*)(Gl + s * 16), ga1 = *(const LAS f32x4*)(Gl + s * 16 + 4), ga2 = *(const LAS f32x4*)(Gl + s * 16 + 8), ga3 = *(const LAS f32x4*)(Gl + s * 16 + 12);
      const f32x4 gr0 = *(const LAS f32x4*)(Gl + (8 + s) * 16), gr1 = *(const LAS f32x4*)(Gl + (8 + s) * 16 + 4), gr2 = *(const LAS f32x4*)(Gl + (8 + s) * 16 + 8), gr3 = *(const LAS f32x4*)(Gl + (8 + s) * 16 + 12);
      const float gab[8] = {ga0[0], ga0[1], ga0[2], ga0[3], ga1[0], ga1[1], ga1[2], ga1[3]}, gak[8] = {ga2[0], ga2[1], ga2[2], ga2[3], ga3[0], ga3[1], ga3[2], ga3[3]};
      const float grb[8] = {gr0[0], gr0[1], gr0[2], gr0[3], gr1[0], gr1[1], gr1[2], gr1[3]}, grk[8] = {gr2[0], gr2[1], gr2[2], gr2[3], gr3[0], gr3[1], gr3[2], gr3[3]};
#pragma unroll
      for (int cb = 0; cb < 2; ++cb) {
        float x = sa[cb][s], y = yy[cb][s];
#pragma unroll
        for (int u = 0; u < 8; ++u) { if (u < s) { x = fmaf(gab[u], sa[cb][u], x); x = fmaf(gak[u], vm[cb][u], x); } }
        sa[cb][s] = x;
#pragma unroll
        for (int u = 0; u < 8; ++u) { if (u <= s) { y = fmaf(grb[u], sa[cb][u], y); y = fmaf(grk[u], vm[cb][u], y); } }
        yy[cb][s] = y;
      }
    }
    { bf16_t* yz = hi ? bf.Z : bf.Y;
#pragma unroll
      for (int s = 0; s < 8; ++s) { const size_t oi = ((size_t)dir * NTOK + scan_row(dir, b, p0 + t0 + s)) * 512 + h * 64 + r; yz[oi] = f2bf(yy[0][s]); yz[oi + 32] = f2bf(yy[1][s]); } }
    { bf16x8 au[2], buS[2], buP[2];
      u32x4 a0, a1, s0, s1, p0_, p1_;
#pragma unroll
      for (int q = 0; q < 4; ++q) {
        const int u = 4 * hi + q;
        const LAS bf16_t* yb = (const LAS bf16_t*)wb + 1024 + u * 64 + r; const LAS bf16_t* vr = (const LAS bf16_t*)wb + 3072 + u * 64 + r;
        a0[q] = (unsigned)yb[0] | ((unsigned)yb[512] << 16); a1[q] = (unsigned)yb[32] | ((unsigned)yb[512 + 32] << 16);
        const u32x2 sw0 = __builtin_amdgcn_permlane32_swap(__float_as_uint(sa[0][q]), __float_as_uint(sa[0][4 + q]), false, false), sw1 = __builtin_amdgcn_permlane32_swap(__float_as_uint(sa[1][q]), __float_as_uint(sa[1][4 + q]), false, false);
        s0[q] = (cvt_pk_bf16(__uint_as_float(sw0.x), 0.f) & 0xffffu) | ((unsigned)vr[0] << 16); s1[q] = (cvt_pk_bf16(__uint_as_float(sw1.x), 0.f) & 0xffffu) | ((unsigned)vr[32] << 16);
        p0_[q] = cvt_pk_bf16(__uint_as_float(sw0.y), 0.f); p1_[q] = cvt_pk_bf16(__uint_as_float(sw1.y), 0.f); }
      au[0] = __builtin_bit_cast(bf16x8, a0); au[1] = __builtin_bit_cast(bf16x8, a1); buS[0] = __builtin_bit_cast(bf16x8, s0); buS[1] = __builtin_bit_cast(bf16x8, s1); buP[0] = __builtin_bit_cast(bf16x8, p0_); buP[1] = __builtin_bit_cast(bf16x8, p1_);
#pragma unroll
      for (int rb = 0; rb < 2; ++rb)
#pragma unroll
        for (int cb = 0; cb < 2; ++cb) { TS[rb][cb] = __builtin_amdgcn_mfma_f32_32x32x16_bf16(au[rb], buS[cb], TS[rb][cb], 0, 0, 0); TP[rb][cb] = __builtin_amdgcn_mfma_f32_32x32x16_bf16(au[rb], buP[cb], TP[rb][cb], 0, 0, 0); }
    }
    __builtin_amdgcn_wave_barrier();
    if ((t0 & 31) == 24) RW_RENORM();
  }
  RW_RENORM();
#undef RW_DOTS
#undef RW_FRAG
#undef RW_RENORM
#undef RW_FETCH
  asm volatile("s_waitcnt vmcnt(0)" ::: "memory");
  if (chunk < NCH - 1) {
    float* pq = bf.PQ + (((size_t)chain * (NCH - 1) + chunk) * 2) * 4096;
#pragma unroll
    for (int rb = 0; rb < 2; ++rb)
#pragma unroll
      for (int cb = 0; cb < 2; ++cb)
#pragma unroll
        for (int g = 0; g < 4; ++g) { float* q = pq + (size_t)(32 * cb + r) * 64 + 32 * rb + 8 * g + 4 * hi;
          *(f32x4*)q = (f32x4){TP[rb][cb][4 * g], TP[rb][cb][4 * g + 1], TP[rb][cb][4 * g + 2], TP[rb][cb][4 * g + 3]};
          *(f32x4*)(q + 4096) = (f32x4){TS[rb][cb][4 * g], TS[rb][cb][4 * g + 1], TS[rb][cb][4 * g + 2], TS[rb][cb][4 * g + 3]}; }
  }
}

__device__ __forceinline__ void propagate_chain(const Bufs& bf, int chain, int rq, LAS float* lds) {
  LAS float* Sl = lds; LAS float* Pl = lds + 16 * 65 + 15;
  Pl = lds + 1056;
  const int tid = mk::otid(), i = tid >> 5, jc = (tid & 31) * 2, row = rq * 16 + i, pi = tid >> 3, pj = (tid & 7) * 8;
  float* sst = bf.SST + (size_t)chain * NCH * 4096;
  Sl[i * 65 + jc] = 0.f; Sl[i * 65 + jc + 1] = 0.f;
  const float* pb = bf.PQ + ((size_t)chain * (NCH - 1) * 2) * 4096;
  f32x4 np0 = *(const f32x4*)(pb + pi * 64 + pj), np1 = *(const f32x4*)(pb + pi * 64 + pj + 4); f32x2 nq = *(const f32x2*)(pb + 4096 + row * 64 + jc);
  for (int c = 0; c < NCH - 1; ++c) {
    const f32x4 p0 = np0, p1 = np1; f32x2 q = nq;
    { const float* pn = pb + (size_t)(c + 1 < NCH - 1 ? c + 1 : c) * 2 * 4096;
      np0 = *(const f32x4*)(pn + pi * 64 + pj); np1 = *(const f32x4*)(pn + pi * 64 + pj + 4); nq = *(const f32x2*)(pn + 4096 + row * 64 + jc); }
    *(LAS f32x4*)(Pl + pi * 64 + pj) = p0; *(LAS f32x4*)(Pl + pi * 64 + pj + 4) = p1;
    __syncthreads();
#pragma unroll 16
    for (int k = 0; k < 64; ++k) { const float sv = Sl[i * 65 + k]; const f32x2 a = *(const LAS f32x2*)(Pl + k * 64 + jc); q += sv * a; }
    __syncthreads();
    Sl[i * 65 + jc] = q[0]; Sl[i * 65 + jc + 1] = q[1];
    *(f32x2*)(sst + (size_t)(c + 1) * 4096 + row * 64 + jc) = q;
  }
  __syncthreads();
}

__device__ __forceinline__ void corr_unit(const Bufs& bf, int chain, int chunk) {
  const int lane = mk::otid() & 63, r = lane & 31, hi = lane >> 5;
  const int dir = chain >> 5, b = (chain >> 3) & 3, h = chain & 7;
  const float* ss = bf.SST + ((size_t)chain * NCH + chunk) * 4096;
  bf16x8 bfr[2][4];
#pragma unroll
  for (int nt = 0; nt < 2; ++nt)
#pragma unroll
    for (int ks = 0; ks < 4; ++ks) { const float* q = ss + (size_t)(nt * 32 + r) * 64 + ks * 16 + hi * 8; const f32x4 x0 = *(const f32x4*)q, x1 = *(const f32x4*)(q + 4);
      u32x4 w; w.x = cvt_pk_bf16(x0[0], x0[1]); w.y = cvt_pk_bf16(x0[2], x0[3]); w.z = cvt_pk_bf16(x1[0], x1[1]); w.w = cvt_pk_bf16(x1[2], x1[3]); bfr[nt][ks] = __builtin_bit_cast(bf16x8, w); }
  const int p0 = chunk * CL;
  const size_t dbase = (size_t)dir * NTOK;
  for (int mt = 0; mt < (CL + 31) / 32; ++mt) {
    const int sa_ = min(mt * 32 + r, CL - 1);
    const bf16_t* zp = bf.Z + (dbase + scan_row(dir, b, p0 + sa_)) * 512 + h * 64 + hi * 8;
    bf16x8 af[4];
#pragma unroll
    for (int ks = 0; ks < 4; ++ks) af[ks] = *(const bf16x8*)(zp + ks * 16);
    f32x16 acc[2];
#pragma unroll
    for (int nt = 0; nt < 2; ++nt) { acc[nt] = zero16();
#pragma unroll
      for (int ks = 0; ks < 4; ++ks) acc[nt] = __builtin_amdgcn_mfma_f32_32x32x16_bf16(af[ks], bfr[nt][ks], acc[nt], 0, 0, 0); }
#pragma unroll
    for (int i = 0; i < 16; ++i) { const int so = mt * 32 + (i & 3) + 8 * (i >> 2) + 4 * hi;
      if (so < CL) { bf16_t* yp = bf.Y + (dbase + scan_row(dir, b, p0 + so)) * 512 + h * 64 + r;
        yp[0] = f2bf(bf2f(yp[0]) + acc[0][i]); yp[32] = f2bf(bf2f(yp[32]) + acc[1][i]); } }
  }
}

template <int NR>
__device__ __forceinline__ void finish_rows(const Bufs& bf, const float* __restrict__ gn_g, const float* __restrict__ gn_b, bf16_t* __restrict__ O, int row0) {
  const int c = mk::otid(), h = c >> 6;
  float y[NR], v[NR], g[NR], cs[NR];
#pragma unroll
  for (int i = 0; i < NR; ++i) { const int row = row0 + i;
    y[i] = bf2f(bf.Y[(size_t)row * 512 + c]) + bf2f(bf.Y[((size_t)NTOK + row) * 512 + c]);
    v[i] = bfhi(bf.SH[(size_t)row * 512 + c].y); g[i] = bf2f(bf.G[(size_t)row * bf.gstride + c]);
    cs[i] = bf.CS[(size_t)row * 16 + h] + bf.CS[(size_t)row * 16 + 8 + h]; }
  const float gg = gn_g[c], gb = gn_b[c];
  float o[NR];
#pragma unroll
  for (int i = 0; i < NR; ++i) { const float mu = wave_sum_u(y[i]) * (1.0f / 64.0f); const float dv = y[i] - mu; const float var = wave_sum_u(dv * dv) * (1.0f / 64.0f);
    o[i] = (dv * rsqrtf(var + 64e-5f) * gg + gb + cs[i] * v[i]) * g[i]; }
#pragma unroll
  for (int i = 0; i < NR; ++i) O[(size_t)(row0 + i) * 1024 + 512 + c] = f2bf(o[i]);
}
}

namespace mk {
constexpr size_t al256(size_t x) { return (x + 255) / 256 * 256; }
constexpr size_t WS_BAR = 0;
constexpr size_t WS_BCNT = al256(WS_BAR + (size_t)XCD_BAR_WORDS * 4);
constexpr size_t WS_MOFF = al256(WS_BCNT + (size_t)4 * 256 * 64 * 4);
constexpr size_t WS_KN = al256(WS_MOFF + 4 * 256);
constexpr size_t WS_MOD = al256(WS_KN + (size_t)2 * 256 * 32 * 4);
constexpr size_t WS_ROPE = al256(WS_MOD + (size_t)4 * 5 * 6144 * 4);
constexpr size_t WS_HBC = al256(WS_ROPE + 128 * 16 * 2 * 4);
constexpr size_t WS_EID = al256(WS_HBC + (size_t)NCTX * D * 2);
constexpr size_t WS_GATE = al256(WS_EID + (size_t)NTOK * 2 * 4);
constexpr size_t WS_POS = al256(WS_GATE + (size_t)NTOK * 2 * 4);
constexpr size_t WS_RL = al256(WS_POS + (size_t)NTOK * 2 * 4);
constexpr size_t WS_WEIN = al256(WS_RL + (size_t)MOE_ROWS * 4);
constexpr size_t WS_WOIN = al256(WS_WEIN + (size_t)2 * EVEN_IN * D * 2);
constexpr size_t WS_WEOUT = al256(WS_WOIN + (size_t)2 * ODD_IN * D * 2);
constexpr size_t WS_WOOUT = al256(WS_WEOUT + (size_t)2 * D * D * 2);
constexpr size_t WS_WGU = al256(WS_WOOUT + (size_t)2 * D * D * 2);
constexpr size_t WS_WDN = al256(WS_WGU + (size_t)NE * 1024 * D * 2);
constexpr size_t WS_WLT = al256(WS_WDN + (size_t)NE * D * DE * 2);
constexpr size_t WS_UO = al256(WS_WLT + (size_t)2 * 196608 * 2);
constexpr size_t WS_SCR = al256(WS_UO + (size_t)NTOK * D * 2);
constexpr size_t SE_PQK = 0;
constexpr size_t SE_VT = al256(SE_PQK + (size_t)NTOK * 1024 * 2);
constexpr size_t SE_PRW = al256(SE_VT + (size_t)512 * NTOK * 2);
constexpr size_t SE_PQ = 0;
constexpr size_t SE_SST = al256(SE_PQ + (size_t)rw::NCHAIN * (rw::NCH - 1) * 2 * 4096 * 4);
constexpr size_t SE_Y = al256(SE_SST + (size_t)rw::NCHAIN * rw::NCH * 4096 * 4);
constexpr size_t SE_Z = al256(SE_Y + (size_t)2 * NTOK * 512 * 2);
constexpr size_t SE_ZEND = al256(SE_Z + (size_t)2 * NTOK * 512 * 2);
constexpr size_t SE_PRWEND = al256(SE_PRW + (size_t)NTOK * RW_IN * 2);
constexpr size_t SE_SH = SE_PRWEND > SE_ZEND ? SE_PRWEND : SE_ZEND;
constexpr size_t SE_DR = al256(SE_SH + (size_t)NTOK * 512 * 8);
constexpr size_t SE_CS = al256(SE_DR + (size_t)2 * NTOK * 512 * 4);
constexpr size_t SE_END = al256(SE_CS + (size_t)2 * NTOK * 16 * 4);
constexpr size_t SE_YBUF = 0;
constexpr size_t SO_PQK = 0;
constexpr size_t SO_VT = al256(SO_PQK + (size_t)NTOK * 2048 * 2);
constexpr size_t SO_O12 = al256(SO_VT + (size_t)1024 * NTOK * 2);
constexpr size_t SO_END = al256(SO_O12 + (size_t)NTOK * 2048 * 2);
constexpr size_t SO_YBUF = 0;
constexpr size_t SM_XS = 0;
constexpr size_t SM_HE = al256(SM_XS + (size_t)MOE_ROWS * D * 2);
constexpr size_t SM_YS = al256(SM_HE + (size_t)MOE_ROWS * DE * 2);
constexpr size_t SM_END = al256(SM_YS + (size_t)MOE_ROWS * D * 2);
constexpr size_t SCR_BYTES = SE_END > SO_END ? (SE_END > SM_END ? SE_END : SM_END) : (SO_END > SM_END ? SO_END : SM_END);
constexpr size_t WS_END = WS_SCR + SCR_BYTES;
constexpr int LDS_BARW = 131072;
constexpr int LDS_MISC = 131072 + 64;

struct Params {
  const float *x, *c, *ctx, *c_ctx, *ada_w, *ada_b, *ln_g, *ln_b, *even_w_in, *even_w_out, *shift_w, *na_rpb, *rw_w0, *rw_w_up, *rw_a0, *rw_a_up, *rw_g_up, *rw_k_k, *rw_k_a, *rw_r_k,
      *rw_gn_g, *rw_gn_b, *odd_w_in, *odd_w_out, *da_lq1, *da_lk1, *da_lq2, *da_lk2, *da_subln_g, *router_w, *router_b, *exp_w_gate, *exp_w_up, *exp_w_down;
  float* out; unsigned char* ws; int ph_lo, ph_hi;
};
template <class Tp> __device__ __forceinline__ Tp* wsp(const Params& p, size_t off) { return (Tp*)(p.ws + off); }

__device__ __forceinline__ void ada_unit(const Params& p, int u, LAS float* lds) {
  LAS float* sc = lds; LAS float* red = lds + 5 * 1024;
  const int tid = mk::otid(), l = u / 96, n = (u % 96) * 64 + (tid & 63), kp = tid >> 6;
  for (int i = tid; i < 5 * 1024; i += NTHR) { const float v = i < 4096 ? p.c[i] : p.c_ctx[i - 4096]; sc[i] = siluf_(v); }
  __syncthreads();
  float a[5] = {0.f, 0.f, 0.f, 0.f, 0.f};
  const float* w = p.ada_w + ((size_t)l * D + kp * 128) * 6144 + n;
#pragma unroll 4
  for (int k = 0; k < 128; ++k) { const float wv = w[(size_t)k * 6144]; const int kk = kp * 128 + k;
#pragma unroll
    for (int r = 0; r < 5; ++r) a[r] = fmaf(sc[r * 1024 + kk], wv, a[r]); }
#pragma unroll
  for (int r = 0; r < 5; ++r) red[(kp * 5 + r) * 64 + (tid & 63)] = a[r];
  __syncthreads();
  if (tid < 320) { const int r = tid >> 6, nn = tid & 63; float s = 0.f;
#pragma unroll
    for (int q = 0; q < 8; ++q) s += red[(q * 5 + r) * 64 + nn];
    const int col = (u % 96) * 64 + nn;
    wsp<float>(p, WS_MOD)[((size_t)l * 5 + r) * 6144 + col] = s + p.ada_b[l * 6144 + col]; }
  __syncthreads();
}
__device__ __forceinline__ void phase_prologue(const Params& p, LAS unsigned char* lds) {
  const int bid = mk::obid(), nb = gridDim.x; LAS float* tile = (LAS float*)lds;
  int ub = 0;
  for (int i = 0; i < 2; ++i) ub += cvt_matrix(p.even_w_in + (size_t)i * D * EVEN_IN, EVEN_IN, D, EVEN_IN, wsp<bf16_t>(p, WS_WEIN) + (size_t)i * EVEN_IN * D, NMapId{0}, tile, ub, bid, nb);
  for (int i = 0; i < 2; ++i) ub += cvt_matrix(p.odd_w_in + (size_t)i * D * ODD_IN, ODD_IN, D, ODD_IN, wsp<bf16_t>(p, WS_WOIN) + (size_t)i * ODD_IN * D, NMapRope{}, tile, ub, bid, nb);
  for (int i = 0; i < 2; ++i) ub += cvt_matrix(p.even_w_out + (size_t)i * D * D, D, D, D, wsp<bf16_t>(p, WS_WEOUT) + (size_t)i * D * D, NMapId{0}, tile, ub, bid, nb);
  for (int i = 0; i < 2; ++i) ub += cvt_matrix(p.odd_w_out + (size_t)i * D * D, D, D, D, wsp<bf16_t>(p, WS_WOOUT) + (size_t)i * D * D, NMapId{0}, tile, ub, bid, nb);
  for (int i = 0; i < 2; ++i) { bf16_t* wl = wsp<bf16_t>(p, WS_WLT) + (size_t)i * 196608;
    for (int d = 0; d < 2; ++d) { ub += cvt_matrix(p.rw_w_up + (size_t)(i * 2 + d) * 64 * 512, 512, 64, 512, wl + (size_t)d * 32768, NMapId{0}, tile, ub, bid, nb);
      ub += cvt_matrix(p.rw_a_up + (size_t)(i * 2 + d) * 64 * 512, 512, 64, 512, wl + (size_t)(2 + d) * 32768, NMapId{0}, tile, ub, bid, nb); }
    ub += cvt_matrix(p.rw_g_up + (size_t)i * 128 * 512, 512, 128, 512, wl + (size_t)4 * 32768, NMapId{0}, tile, ub, bid, nb); }
  for (int u = (bid + nb - ub % nb) % nb; u < 384; u += nb) ada_unit(p, u, (LAS float*)lds);
  const int gt = bid * NTHR + mk::otid();
  if (gt < 128 * 16) { const int pos = gt >> 4, i = gt & 15; const float inv = exp2f(-(float)i * (13.287712379549449f / 16.0f)); float sn, cs; sincosf((float)pos * inv, &sn, &cs);
    wsp<float>(p, WS_ROPE)[gt * 2] = cs; wsp<float>(p, WS_ROPE)[gt * 2 + 1] = sn; }
}
__device__ __forceinline__ void cvt_experts(const Params& p, int l, LAS float* tile, int b0) {
  const int bid = mk::obid() - b0, nb = (int)gridDim.x - b0; int ub = 0;
  if (bid < 0) return;
  for (int e = 0; e < NE; ++e) {
    const size_t so = ((size_t)l * NE + e) * D * DE;
    ub += cvt_matrix(p.exp_w_gate + so, DE, D, DE, wsp<bf16_t>(p, WS_WGU) + (size_t)e * 1024 * D, NMapInterleave{0}, tile, ub, bid, nb);
    ub += cvt_matrix(p.exp_w_up + so, DE, D, DE, wsp<bf16_t>(p, WS_WGU) + (size_t)e * 1024 * D, NMapInterleave{1}, tile, ub, bid, nb);
    ub += cvt_matrix(p.exp_w_down + so, D, DE, D, wsp<bf16_t>(p, WS_WDN) + (size_t)e * D * DE, NMapId{0}, tile, ub, bid, nb);
  }
}

__device__ __forceinline__ bf16_t* hb_ptr(const Params& p, int row, bool alt) {
  if (alt) return wsp<bf16_t>(p, WS_SCR + SM_END) + (size_t)row * D;
  return row < NLAT ? (bf16_t*)p.out + (size_t)row * D : wsp<bf16_t>(p, WS_HBC) + (size_t)(row - NLAT) * D;
}
__device__ __forceinline__ const float* h0_ptr(const Params& p, int row) { return row < NLAT ? p.x + (size_t)row * D : p.ctx + (size_t)(row - NLAT) * D; }
__device__ __forceinline__ void store_bf16x4(bf16_t* dst, f32x4 v) { u32x2 w; w.x = cvt_pk_bf16(v[0], v[1]); w.y = cvt_pk_bf16(v[2], v[3]); *(u32x2*)dst = w; }
__device__ __forceinline__ f32x4 load_bf16x4(const bf16_t* src) { const u32x2 w = *(const u32x2*)src; return (f32x4){bflo(w.x), bfhi(w.x), bflo(w.y), bfhi(w.y)}; }

__device__ __forceinline__ void phase_mod0(const Params& p) {
  const int lane = mk::otid() & 63, wid = mk::otid() >> 6;
  bf16_t* U = wsp<bf16_t>(p, WS_UO);
  for (int row = mk::obid() * 8 + wid; row < NTOK; row += gridDim.x * 8) {
    const float* h = h0_ptr(p, row); const float* modl = wsp<float>(p, WS_MOD) + (size_t)bidx_of_row(row) * 6144;
#pragma unroll
    for (int q = 0; q < 4; ++q) { const int col = q * 256 + lane * 4; const f32x4 hv = *(const f32x4*)(h + col), sh = *(const f32x4*)(modl + col), sc = *(const f32x4*)(modl + 1024 + col);
      store_bf16x4(U + (size_t)row * D + col, hv * (1.0f + sc) + sh); }
  }
}
__device__ __forceinline__ void ln_row(f32x4 (&v)[4], const float* __restrict__ g, const float* __restrict__ b, int lane) {
  float s = 0.f;
#pragma unroll
  for (int q = 0; q < 4; ++q) s += (v[q][0] + v[q][1]) + (v[q][2] + v[q][3]);
  const float mu = wave_sum_u(s) * (1.0f / D);
  float qq = 0.f;
#pragma unroll
  for (int q = 0; q < 4; ++q) { const f32x4 d = v[q] - mu; qq += (d[0] * d[0] + d[1] * d[1]) + (d[2] * d[2] + d[3] * d[3]); }
  const float rstd = rsqrtf(wave_sum_u(qq) * (1.0f / D) + LN_EPS);
#pragma unroll
  for (int q = 0; q < 4; ++q) { const int col = q * 256 + lane * 4; v[q] = (v[q] - mu) * rstd * *(const f32x4*)(g + col) + *(const f32x4*)(b + col); }
}
template <bool F32IN> struct Ln1Raw;
template <> struct Ln1Raw<true> { f32x4 h[4]; u32x2 y[4]; };
template <> struct Ln1Raw<false> { u32x2 h[4]; u32x2 y[4]; };
__device__ __forceinline__ f32x4 h_as_f32(f32x4 v) { return v; }
__device__ __forceinline__ f32x4 h_as_f32(u32x2 w) { return (f32x4){bflo(w.x), bfhi(w.x), bflo(w.y), bfhi(w.y)}; }
template <bool F32IN>
__device__ __forceinline__ void ln1_load(const Params& p, const bf16_t* __restrict__ Ybuf, int row, int lane, Ln1Raw<F32IN>& r) {
#pragma unroll
  for (int q = 0; q < 4; ++q) { const int col = q * 256 + lane * 4;
    if constexpr (F32IN) r.h[q] = *(const f32x4*)(h0_ptr(p, row) + col); else r.h[q] = *(const u32x2*)(hb_ptr(p, row, false) + col);
    r.y[q] = *(const u32x2*)(Ybuf + (size_t)row * D + col); }
}
template <bool F32IN>
__device__ __forceinline__ void ln1_row(const Params& p, int l, int row, int lane, const Ln1Raw<F32IN>& raw, const LAS float* rwl, LAS int* lcnt, float rbias  , bool redir) {
  bf16_t* U2 = wsp<bf16_t>(p, WS_UO); int* eid = wsp<int>(p, WS_EID); float* gatev = wsp<float>(p, WS_GATE);
  const float* lg = p.ln_g + (size_t)(l * 2) * D; const float* lb = p.ln_b + (size_t)(l * 2) * D;
  bf16_t* ho = redir ? wsp<bf16_t>(p, WS_SCR + SM_YS) + (size_t)row * D : hb_ptr(p, row, l == DEPTH - 1); const float* modl = wsp<float>(p, WS_MOD) + ((size_t)l * 5 + bidx_of_row(row)) * 6144;
  f32x4 v[4];
#pragma unroll
  for (int q = 0; q < 4; ++q) { const int col = q * 256 + lane * 4; const f32x4 yv = (f32x4){bflo(raw.y[q].x), bfhi(raw.y[q].x), bflo(raw.y[q].y), bfhi(raw.y[q].y)};
    v[q] = ALPHA * h_as_f32(raw.h[q]) + *(const f32x4*)(modl + 2 * 1024 + col) * yv; }
  ln_row(v, lg, lb, lane);
  float acc[16];
#pragma unroll
  for (int e = 0; e < 16; ++e) acc[e] = 0.f;
#pragma unroll
  for (int q = 0; q < 4; ++q) { const int col = q * 256 + lane * 4;
    store_bf16x4(ho + col, v[q]);
    const f32x4 u = v[q] * (1.0f + *(const f32x4*)(modl + 4 * 1024 + col)) + *(const f32x4*)(modl + 3 * 1024 + col);
    store_bf16x4(U2 + (size_t)row * D + col, u);
#pragma unroll
    for (int e = 0; e < 16; ++e) { const f32x4 w = *(const LAS f32x4*)(rwl + ((q * 16 + e) * 64 + lane) * 4); acc[e] += (u[0] * w[0] + u[1] * w[1]) + (u[2] * w[2] + u[3] * w[3]); }
  }
  float t8[8], t4[4], t2[2];
#pragma unroll
  for (int i = 0; i < 8; ++i) { const u32x2 sw = __builtin_amdgcn_permlane32_swap(__float_as_uint(acc[i]), __float_as_uint(acc[8 + i]), false, false); t8[i] = __uint_as_float(sw.x) + __uint_as_float(sw.y); }
#pragma unroll
  for (int i = 0; i < 4; ++i) { const u32x2 sw = __builtin_amdgcn_permlane16_swap(__float_as_uint(t8[i]), __float_as_uint(t8[4 + i]), false, false); t4[i] = __uint_as_float(sw.x) + __uint_as_float(sw.y); }
  const bool b3 = (lane & 8) != 0, b2_ = (lane & 4) != 0;
#pragma unroll
  for (int i = 0; i < 2; ++i) { const float keep = b3 ? t4[2 + i] : t4[i], send = b3 ? t4[i] : t4[2 + i]; t2[i] = keep + dpp_mov<0x128, 0xf, 0xf>(send, send); }
  float logit;
  { const float keep = b2_ ? t2[1] : t2[0], send = b2_ ? t2[0] : t2[1];
    float recv = dpp_mov<0x104, 0xf, 0x5>(send, send);
    recv = dpp_mov<0x114, 0xf, 0xa>(recv, send);
    logit = keep + recv; }
  logit += dpp_mov<0xB1, 0xf, 0xf>(logit, logit); logit += dpp_mov<0x4E, 0xf, 0xf>(logit, logit);
  const float sg = 1.0f / (1.0f + expf(-logit)), sl = sg + rbias;
  float gs;
  { const float a = sl, b2 = dpp_mov<0x124, 0xf, 0xf>(sl, sl), c = dpp_mov<0x128, 0xf, 0xf>(sl, sl), d = dpp_mov<0x12C, 0xf, 0xf>(sl, sl);
    const float lo1 = fminf(a, b2), hi1 = fmaxf(a, b2), lo2 = fminf(c, d), hi2 = fmaxf(c, d);
    gs = fmaxf(hi1, hi2) + fmaxf(fminf(hi1, hi2), fmaxf(lo1, lo2)); }
  float best = -1e30f; int grp = 0;
#pragma unroll
  for (int gI = 0; gI < 4; ++gI) { const float g = __uint_as_float(__builtin_amdgcn_readlane(__float_as_uint(gs), gI * 16)); if (g > best) { best = g; grp = gI; } }
  grp = __builtin_amdgcn_readfirstlane(grp);
  const float v0 = __uint_as_float(__builtin_amdgcn_readlane(__float_as_uint(sl), grp * 16)), v1 = __uint_as_float(__builtin_amdgcn_readlane(__float_as_uint(sl), grp * 16 + 4)),
              v2 = __uint_as_float(__builtin_amdgcn_readlane(__float_as_uint(sl), grp * 16 + 8)), v3 = __uint_as_float(__builtin_amdgcn_readlane(__float_as_uint(sl), grp * 16 + 12));
  const float s0 = __uint_as_float(__builtin_amdgcn_readlane(__float_as_uint(sg), grp * 16)), s1 = __uint_as_float(__builtin_amdgcn_readlane(__float_as_uint(sg), grp * 16 + 4)),
              s2 = __uint_as_float(__builtin_amdgcn_readlane(__float_as_uint(sg), grp * 16 + 8)), s3 = __uint_as_float(__builtin_amdgcn_readlane(__float_as_uint(sg), grp * 16 + 12));
  int i1 = 0; float b1 = v0; if (v1 > b1) { b1 = v1; i1 = 1; } if (v2 > b1) { b1 = v2; i1 = 2; } if (v3 > b1) { b1 = v3; i1 = 3; }
  int i2 = -1; float bb = -1e30f;
  if (i1 != 0 && v0 > bb) { bb = v0; i2 = 0; } if (i1 != 1 && v1 > bb) { bb = v1; i2 = 1; } if (i1 != 2 && v2 > bb) { bb = v2; i2 = 2; } if (i1 != 3 && v3 > bb) { bb = v3; i2 = 3; }
  const float g1 = i1 == 0 ? s0 : i1 == 1 ? s1 : i1 == 2 ? s2 : s3; const float g2 = i2 == 0 ? s0 : i2 == 1 ? s1 : i2 == 2 ? s2 : s3;
  if (lane == 0) { const int e1 = grp * 4 + i1, e2 = grp * 4 + i2;
    eid[row * 2] = e1; eid[row * 2 + 1] = e2; gatev[row * 2] = g1 / (g1 + g2); gatev[row * 2 + 1] = g2 / (g1 + g2);
    __hip_atomic_fetch_add(lcnt + e1, 1, __ATOMIC_RELAXED, __HIP_MEMORY_SCOPE_WORKGROUP); __hip_atomic_fetch_add(lcnt + e2, 1, __ATOMIC_RELAXED, __HIP_MEMORY_SCOPE_WORKGROUP); }
}
template <bool F32IN>
__device__ __forceinline__ void phase_ln1(const Params& p, int l, const bf16_t* __restrict__ Ybuf, LAS unsigned char* lds, bool dry) {
  const int tid = mk::otid(), lane = tid & 63, wid = tid >> 6, bid = mk::obid();
  const bool last = l == DEPTH - 1; const int ntok = last ? NLAT : NTOK;
  LAS float* rwl = (LAS float*)lds; LAS int* lcnt = (LAS int*)(lds + 65536);
  { float rv[32];
#pragma unroll
    for (int i = 0; i < 32; ++i) rv[i] = p.router_w[tid + i * NTHR];
#pragma unroll
    for (int i = 0; i < 32; ++i) { const int idx = tid + i * NTHR, d = idx >> 4, e = idx & 15; rwl[(((d >> 8) * 16 + e) * 64 + ((d >> 2) & 63)) * 4 + (d & 3)] = rv[i]; } }
  if (tid < 16) lcnt[tid] = 0;
  __syncthreads();
  const int stride = gridDim.x * 8, row0 = bid * 8 + wid;
  const float rbias = p.router_b[lane >> 2];
  if (row0 < ntok) {
    Ln1Raw<F32IN> cur, nxt; ln1_load<F32IN>(p, Ybuf, row0, lane, cur);
    for (int row = row0; row < ntok; row += stride) {
      const int rn = row + stride < ntok ? row + stride : row;
      ln1_load<F32IN>(p, Ybuf, rn, lane, nxt);
      ln1_row<F32IN>(p, l, row, lane, cur, rwl, lcnt, rbias, dry);
      cur = nxt;
    }
  }
  __syncthreads();
  if (tid < 16) wsp<int>(p, WS_BCNT)[((size_t)l * 256 + bid) * 64 + tid] = lcnt[tid];
  __syncthreads();
}
__device__ __forceinline__ void phase_scatter(const Params& p, int l, LAS unsigned char* lds) {
  const int tid = mk::otid(), bid = mk::obid(), nb = gridDim.x;
  const bool last = l == DEPTH - 1; const int ntok = last ? NLAT : NTOK;
  LAS int* tot = (LAS int*)lds; LAS int* pre = tot + 16; LAS int* base = tot + 32; LAS int* lcur = tot + 48; LAS int* offs = tot + 64; LAS int* cnts = tot + 128;
  const int* bc = wsp<int>(p, WS_BCNT) + (size_t)l * 256 * 64;
  for (int b2 = tid; b2 < nb; b2 += NTHR) { const u32x4 c0 = *(const u32x4*)(bc + b2 * 64), c1 = *(const u32x4*)(bc + b2 * 64 + 4), c2 = *(const u32x4*)(bc + b2 * 64 + 8), c3 = *(const u32x4*)(bc + b2 * 64 + 12);
    *(LAS u32x4*)(cnts + b2 * 16) = c0; *(LAS u32x4*)(cnts + b2 * 16 + 4) = c1; *(LAS u32x4*)(cnts + b2 * 16 + 8) = c2; *(LAS u32x4*)(cnts + b2 * 16 + 12) = c3; }
  __syncthreads();
  if (tid < 16) { int t = 0, pr = 0; for (int b2 = 0; b2 < nb; ++b2) { const int v = cnts[b2 * 16 + tid]; pr += b2 < bid ? v : 0; t += v; } tot[tid] = t; pre[tid] = pr; lcur[tid] = 0; }
  __syncthreads();
  if (tid == 0) { int o = 0; int* mo = wsp<int>(p, WS_MOFF) + l * 64; for (int e = 0; e < 16; ++e) { offs[e] = o; base[e] = o + pre[e]; if (bid == 0) mo[e] = o; o += (tot[e] + 255) / 256 * 256; } offs[16] = o; if (bid == 0) mo[16] = o; }
  __syncthreads();
  const int* eid = wsp<int>(p, WS_EID); int* pos = wsp<int>(p, WS_POS); int* rl = wsp<int>(p, WS_RL);
  for (int n = tid; ; n += NTHR) { const int row = bid * 8 + (n & 7) + (n >> 3) * nb * 8; if (row >= ntok) break;
    const int e1 = eid[row * 2], e2 = eid[row * 2 + 1];
    const int p1 = base[e1] + __hip_atomic_fetch_add(lcur + e1, 1, __ATOMIC_RELAXED, __HIP_MEMORY_SCOPE_WORKGROUP), p2 = base[e2] + __hip_atomic_fetch_add(lcur + e2, 1, __ATOMIC_RELAXED, __HIP_MEMORY_SCOPE_WORKGROUP);
    pos[row * 2] = p1; pos[row * 2 + 1] = p2; rl[p1] = row; rl[p2] = row; }
  if (bid == 0) for (int e = 0; e < 16; ++e) for (int q = offs[e] + tot[e] + tid; q < offs[e + 1]; q += NTHR) rl[q] = 0;
}
struct Ln2Raw { u32x2 h[4]; u32x2 y1[4], y2[4]; };
__device__ __forceinline__ void ln2_load(const Params& p, bool last, int row, int lane, int p1, int p2, Ln2Raw& r) {
  const bf16_t* Ys = wsp<bf16_t>(p, WS_SCR + SM_YS); const bf16_t* ho = hb_ptr(p, row, last);
#pragma unroll
  for (int q = 0; q < 4; ++q) { const int col = q * 256 + lane * 4; r.h[q] = *(const u32x2*)(ho + col); r.y1[q] = *(const u32x2*)(Ys + (size_t)p1 * D + col); r.y2[q] = *(const u32x2*)(Ys + (size_t)p2 * D + col); }
}
__device__ __forceinline__ void phase_ln2(const Params& p, int l, bool dry) {
  const int tid = mk::otid(), lane = tid & 63, wid = tid >> 6;
  const bool last = l == DEPTH - 1; const int ntok = last ? NLAT : NTOK;
  const int* pos = wsp<int>(p, WS_POS); const float* gatev = wsp<float>(p, WS_GATE); bf16_t* U = wsp<bf16_t>(p, WS_UO);
  const float* lg = p.ln_g + (size_t)(l * 2 + 1) * D; const float* lb = p.ln_b + (size_t)(l * 2 + 1) * D;
  const int stride = gridDim.x * 8, row0 = mk::obid() * 8 + wid;
  if (row0 >= ntok) return;
  auto clampr = [&](int r) { return r < ntok ? r : row0; };
  u32x2 pc = *(const u32x2*)(pos + 2 * row0); f32x2 gc = *(const f32x2*)(gatev + 2 * row0);
  Ln2Raw cur, nxt; ln2_load(p, last, row0, lane, (int)pc.x, (int)pc.y, cur);
  int r1 = clampr(row0 + stride);
  u32x2 pn = *(const u32x2*)(pos + 2 * r1); f32x2 gn = *(const f32x2*)(gatev + 2 * r1);
  for (int row = row0; row < ntok; row += stride) {
    ln2_load(p, last, r1, lane, (int)pn.x, (int)pn.y, nxt);
    const int r2 = clampr(row + 2 * stride);
    const u32x2 pn2 = *(const u32x2*)(pos + 2 * r2); const f32x2 gn2 = *(const f32x2*)(gatev + 2 * r2);
    bf16_t* hb = dry ? wsp<bf16_t>(p, WS_SCR + SM_XS) + (size_t)row * D : hb_ptr(p, row, false); float* hf = (dry ? wsp<float>(p, WS_SCR + SM_XS) : p.out) + (size_t)row * D; const int bi = bidx_of_row(row);
    const float* modl = wsp<float>(p, WS_MOD) + ((size_t)l * 5 + bi) * 6144;
    f32x4 v[4];
#pragma unroll
    for (int q = 0; q < 4; ++q) { const int col = q * 256 + lane * 4;
      const f32x4 a1 = (f32x4){bflo(cur.y1[q].x), bfhi(cur.y1[q].x), bflo(cur.y1[q].y), bfhi(cur.y1[q].y)}, a2 = (f32x4){bflo(cur.y2[q].x), bfhi(cur.y2[q].x), bflo(cur.y2[q].y), bfhi(cur.y2[q].y)};
      v[q] = ALPHA * h_as_f32(cur.h[q]) + *(const f32x4*)(modl + 5 * 1024 + col) * (gc[0] * a1 + gc[1] * a2); }
    ln_row(v, lg, lb, lane);
    const float* modn = wsp<float>(p, WS_MOD) + ((size_t)(last ? l : l + 1) * 5 + bi) * 6144;
#pragma unroll
    for (int q = 0; q < 4; ++q) { const int col = q * 256 + lane * 4; if (last) *(f32x4*)(hf + col) = v[q]; else store_bf16x4(hb + col, v[q]);
      if (!last) store_bf16x4(U + (size_t)row * D + col, v[q] * (1.0f + *(const f32x4*)(modn + 1024 + col)) + *(const f32x4*)(modn + col)); }
    cur = nxt; gc = gn; pn = pn2; gn = gn2; r1 = r2;
  }
}

struct SchedEvenIn { static constexpr bool GATHER = false; const bf16_t* U; const bf16_t* W; bf16_t* Pqk; bf16_t* Prw; bf16_t* Vt; int G, c;
  __device__ __forceinline__ bool next(int i, pg8::Unit& u) const { const int Lx = i * G + c; u.kind = 0;
    if (Lx < 1452) { const int grp = Lx / 44, rem = Lx % 44, pm = grp * 4 + (rem & 3), pi = rem >> 2; u.pm = pm; u.pn = pi;
      u.A = (const char*)(U + (size_t)pm * 256 * D); const int brow = pi < 4 ? pi * 256 : 1536 + (pi - 4) * 256; u.Bt = (const char*)(W + (size_t)brow * D);
      if (pi < 4) { u.out = Pqk; u.ldo = 1024; u.x1 = pi * 256; } else { u.out = Prw; u.ldo = RW_IN; u.x1 = (pi - 4) * 256; } u.x0 = pm * 256; return true; }
    if (Lx < 1452 + 264) { const int v = Lx - 1452, pmv = v & 1, pnv = v >> 1; u.pm = pmv; u.pn = pnv; u.A = (const char*)(W + (size_t)(1024 + pmv * 256) * D); u.Bt = (const char*)(U + (size_t)pnv * 256 * D);
      u.out = Vt; u.ldo = NTOK; u.x0 = pmv * 256; u.x1 = pnv * 256; return true; }
    return false; } };
struct SchedOddIn { static constexpr bool GATHER = false; const bf16_t* U; const bf16_t* W; bf16_t* Pqk; bf16_t* Vt; int G, c;
  __device__ __forceinline__ bool next(int i, pg8::Unit& u) const { const int Lx = i * G + c;
    if (Lx < 1056) { const int grp = Lx / 32, rem = Lx % 32, pm = grp * 4 + (rem & 3), pi = rem >> 2; u.pm = pm; u.pn = pi; u.kind = pm < 128 ? 1 : 0;
      u.A = (const char*)(U + (size_t)pm * 256 * D); u.Bt = (const char*)(W + (size_t)pi * 256 * D); u.out = Pqk; u.ldo = 2048; u.x0 = pm * 256; u.x1 = pi * 256; return true; }
    if (Lx < 1056 + 528) { const int v = Lx - 1056, pmv = v & 3, pnv = v >> 2; u.pm = pmv; u.pn = pnv; u.kind = 0; u.A = (const char*)(W + (size_t)(2048 + pmv * 256) * D); u.Bt = (const char*)(U + (size_t)pnv * 256 * D);
      u.out = Vt; u.ldo = NTOK; u.x0 = pmv * 256; u.x1 = pnv * 256; return true; }
    return false; } };
struct SchedOut { static constexpr bool GATHER = false; const bf16_t* O; const bf16_t* W; bf16_t* Y; int G, c;
  __device__ __forceinline__ bool next(int i, pg8::Unit& u) const { const int Lx = i * G + c; if (Lx >= 528) return false; const int pm = (Lx / 16) * 4 + (Lx & 3), pn = (Lx & 15) >> 2; u.pm = pm; u.pn = pn; u.kind = 0;
    u.A = (const char*)(O + (size_t)pm * 256 * D); u.Bt = (const char*)(W + (size_t)pn * 256 * D); u.out = Y; u.ldo = 1024; u.x0 = pm * 256; u.x1 = pn * 256; return true; } };
template <bool GATH>
struct SchedMoe { static constexpr bool GATHER = GATH; const bf16_t* A; const bf16_t* W; bf16_t* out; const LAS int* moff; const int* rl; int Kd, ldo, ncol, G, c;
  __device__ __forceinline__ bool next(int i, pg8::Unit& u) const { const int Lx = i * G + c; const int ntile = moff[16] >> 8; if (Lx >= ntile * 4) return false;
    const int pm = Lx >> 2, pn = Lx & 3; int e = 0;
#pragma unroll
    for (int j = 1; j < 16; ++j) e += (pm * 256 >= moff[j]) ? 1 : 0;
    u.pm = pm; u.pn = pn; u.kind = 0; u.A = GATH ? (const char*)A : (const char*)(A + (size_t)pm * 256 * Kd); u.rl = rl + pm * 256; u.Bt = (const char*)(W + ((size_t)e * 1024 + pn * 256) * Kd); u.out = out; u.ldo = ldo; u.x0 = pm * 256; u.x1 = pn * ncol; return true; } };

struct EpiOddIn {
  static constexpr bool PERM = true; const float* rope;
  __device__ __forceinline__ void operator()(const f32x4 (&acc)[2][2][4][2], const pg8::Unit& u, int wr, int wc, int fr, int fq) const {
    if (u.kind == 0) { pg8::EpiStoreBf16{}(acc, u, wr, wc, fr, fq); return; }
    const int row0 = u.x0 + wr * 64 + fr, col0 = u.x1 + wc * 32 + 8 * fq; const int half = wc & 1;
#pragma unroll
    for (int ai = 0; ai < 2; ++ai)
#pragma unroll
      for (int m = 0; m < 4; ++m) { const int row = row0 + ai * 128 + m * 16; const int t = row & (T - 1); const int pos = half ? (t & 63) : (t >> 6);
        const f32x4 cs0 = *(const f32x4*)(rope + (pos * 16 + 4 * fq) * 2), cs1 = *(const f32x4*)(rope + (pos * 16 + 4 * fq + 2) * 2);
        bf16_t* rowp = u.out + (size_t)row * u.ldo + col0;
#pragma unroll
        for (int bj = 0; bj < 2; ++bj) { const f32x4 v0 = acc[ai][bj][m][0], v1 = acc[ai][bj][m][1];
          u32x4 w; w.x = cvt_pk_bf16(v0[0] * cs0[0] - v0[1] * cs0[1], v0[0] * cs0[1] + v0[1] * cs0[0]); w.y = cvt_pk_bf16(v0[2] * cs0[2] - v0[3] * cs0[3], v0[2] * cs0[3] + v0[3] * cs0[2]);
          w.z = cvt_pk_bf16(v1[0] * cs1[0] - v1[1] * cs1[1], v1[0] * cs1[1] + v1[1] * cs1[0]); w.w = cvt_pk_bf16(v1[2] * cs1[2] - v1[3] * cs1[3], v1[2] * cs1[3] + v1[3] * cs1[2]);
          *(u32x4*)(rowp + bj * 128) = w; } }
  }
};
struct EpiGateUp {
  static constexpr bool PERM = true;
  __device__ __forceinline__ void operator()(const f32x4 (&acc)[2][2][4][2], const pg8::Unit& u, int wr, int wc, int fr, int fq) const {
    const int row0 = u.x0 + wr * 64 + fr, col0 = u.x1 + wc * 16 + 4 * fq;
#pragma unroll
    for (int ai = 0; ai < 2; ++ai)
#pragma unroll
      for (int m = 0; m < 4; ++m) { bf16_t* rowp = u.out + (size_t)(row0 + ai * 128 + m * 16) * u.ldo + col0;
#pragma unroll
        for (int bj = 0; bj < 2; ++bj) { const f32x4 v0 = acc[ai][bj][m][0], v1 = acc[ai][bj][m][1];
          u32x2 w; w.x = cvt_pk_bf16(siluf_(v0[0]) * v0[1], siluf_(v0[2]) * v0[3]); w.y = cvt_pk_bf16(siluf_(v1[0]) * v1[1], siluf_(v1[2]) * v1[3]);
          *(u32x2*)(rowp + bj * 64) = w; } }
  }
};
}

namespace mk {
constexpr int N_PHASES = 2 + 2 * (12 + 10);
__global__ void __launch_bounds__(NTHR, 2) mega(Params p) {
  extern __shared__ __attribute__((aligned(16))) unsigned char shm[];
  LAS unsigned char* lds = (LAS unsigned char*)shm;
  const int nb = gridDim.x;
  if (threadIdx.x == 0) *(LAS u32x4*)(lds + LDS_BARW) = (u32x4){0u, 0u, 0u, 0u};
  __syncthreads();
  XcdBarrier bar = xcd_barrier_post(wsp<unsigned>(p, WS_BAR), (volatile LAS unsigned*)(lds + LDS_BARW));
  int ph = 0;
#ifndef MK_MASK
#define MK_MASK 0xFFFFFFFFu
#endif
#ifndef MK_REP
#define MK_REP 0u
#endif
#define PHASE_BEGIN_K(k) if ((((MK_MASK) >> (k)) & 1u) && ph >= p.ph_lo && ph < p.ph_hi) { const int bid = mk::obid(); const int nrep_ = ((((MK_REP) >> (k)) & 1u) ? 2 : 1); for (int rep_ = 0; rep_ < nrep_; ++rep_) { const bool dry = rep_ + 1 < nrep_; (void)dry;
#define PHASE_END   } if (ph + 1 < p.ph_hi) xcd_barrier(bar); } ++ph;
  bf16_t* UO = wsp<bf16_t>(p, WS_UO);
  unsigned char* scr = p.ws + WS_SCR;
  PHASE_BEGIN_K(0) phase_prologue(p, lds); PHASE_END
  PHASE_BEGIN_K(1) phase_mod0(p); PHASE_END
  for (int lp = 0; lp < 2; ++lp) {
    {
      const int l = 2 * lp;
      bf16_t* Pqk = (bf16_t*)(scr + SE_PQK); bf16_t* Vt = (bf16_t*)(scr + SE_VT); bf16_t* Prw = (bf16_t*)(scr + SE_PRW); bf16_t* Ybuf = (bf16_t*)(scr + SE_YBUF);
      rw::Bufs bf; bf.SH = (u32x2*)(scr + SE_SH); bf.DR = (unsigned*)(scr + SE_DR); bf.G = UO + 512; bf.gstride = 1024; bf.CS = (float*)(scr + SE_CS) + (size_t)lp * NTOK * 16; bf.PQ = (float*)(scr + SE_PQ); bf.SST = (float*)(scr + SE_SST); bf.Y = (bf16_t*)(scr + SE_Y); bf.Z = (bf16_t*)(scr + SE_Z);
      PHASE_BEGIN_K(2) { SchedEvenIn S{UO, wsp<bf16_t>(p, WS_WEIN) + (size_t)lp * EVEN_IN * D, Pqk, Prw, Vt, nb, bid}; pg8::gemm_phase(lds, D, S, pg8::EpiStoreBf16{}); } PHASE_END
      PHASE_BEGIN_K(3) { for (int u = bid; u < 1024 + 32; u += nb) { int b, h, rq; if (u < 1024) { b = u >> 8; h = (u >> 5) & 7; rq = u & 31; } else { const int v = u - 1024; b = v >> 3; h = v & 7; rq = -1; }
          natt::na_attn_unit(Pqk, Vt, p.na_rpb + ((size_t)lp * 8 + h) * 465, UO, b, h, rq, lds); }
        const int pb = (bid + nb / 2) % nb;
        for (int t = pb; t < NTOK / 16; t += nb) rw::prep_tile(Prw, p.shift_w + (size_t)lp * 3 * RW_IN, p.rw_w0 + lp * 1024, wsp<bf16_t>(p, WS_WLT) + (size_t)lp * 196608, p.rw_a0 + lp * 1024, p.rw_k_k + lp * 512, p.rw_k_a + lp * 512, p.rw_r_k + lp * 512, bf, t, (LAS float*)lds); } PHASE_END
      PHASE_BEGIN_K(4) for (int u = bid * 8 + (mk::otid() >> 6); u < rw::NCHAIN * rw::NCH; u += nb * 8) rw::scan_unit(bf, p.rw_k_a + lp * 512, u / rw::NCH, u % rw::NCH, (LAS float*)lds + (mk::otid() >> 6) * 4096); PHASE_END
      PHASE_BEGIN_K(5) for (int c = bid; c < rw::NCHAIN * 4; c += nb) rw::propagate_chain(bf, c >> 2, c & 3, (LAS float*)lds); PHASE_END
      PHASE_BEGIN_K(6) for (int u = bid * 8 + (mk::otid() >> 6); u < rw::NCHAIN * (rw::NCH - 1); u += nb * 8) rw::corr_unit(bf, u / (rw::NCH - 1), 1 + u % (rw::NCH - 1)); PHASE_END
      PHASE_BEGIN_K(7) for (int r = bid * 8; r < NTOK; r += nb * 8) rw::finish_rows<8>(bf, p.rw_gn_g + lp * 512, p.rw_gn_b + lp * 512, UO, r); PHASE_END
      PHASE_BEGIN_K(8) { SchedOut S{UO, wsp<bf16_t>(p, WS_WEOUT) + (size_t)lp * D * D, Ybuf, nb, bid}; pg8::gemm_phase(lds, D, S, pg8::EpiStoreBf16{}); __syncthreads(); cvt_experts(p, l, (LAS float*)lds, 528 - 2 * nb > 0 ? 528 - 2 * nb : 0); } PHASE_END
      PHASE_BEGIN_K(9) if (l == 0) phase_ln1<true>(p, l, Ybuf, lds, dry); else phase_ln1<false>(p, l, Ybuf, lds, dry); PHASE_END
      PHASE_BEGIN_K(10) phase_scatter(p, l, lds); PHASE_END
      PHASE_BEGIN_K(11) { LAS int* mo = (LAS int*)(lds + LDS_MISC); { const int tq = mk::otid(); if (tq < 17) mo[tq] = wsp<int>(p, WS_MOFF)[l * 64 + tq]; } __syncthreads();
        SchedMoe<true> S{UO, wsp<bf16_t>(p, WS_WGU), (bf16_t*)(scr + SM_HE), mo, wsp<int>(p, WS_RL), D, DE, 128, nb, bid}; pg8::gemm_phase(lds, D, S, EpiGateUp{}); } PHASE_END
      PHASE_BEGIN_K(12) { LAS int* mo = (LAS int*)(lds + LDS_MISC); { const int tq = mk::otid(); if (tq < 17) mo[tq] = wsp<int>(p, WS_MOFF)[l * 64 + tq]; } __syncthreads();
        SchedMoe<false> S{(bf16_t*)(scr + SM_HE), wsp<bf16_t>(p, WS_WDN), (bf16_t*)(scr + SM_YS), mo, nullptr, DE, D, 256, nb, bid}; pg8::gemm_phase(lds, DE, S, pg8::EpiStoreBf16{}); } PHASE_END
      PHASE_BEGIN_K(13) phase_ln2(p, l, dry); PHASE_END
    }
    {
      const int l = 2 * lp + 1; const bool last = l == DEPTH - 1;
      bf16_t* Pqk = (bf16_t*)(scr + SO_PQK); bf16_t* Vt = (bf16_t*)(scr + SO_VT); bf16_t* O12 = (bf16_t*)(scr + SO_O12); bf16_t* Ybuf = (bf16_t*)(scr + SO_YBUF);
      PHASE_BEGIN_K(14) { SchedOddIn S{UO, wsp<bf16_t>(p, WS_WOIN) + (size_t)lp * ODD_IN * D, Pqk, Vt, nb, bid}; pg8::gemm_phase(lds, D, S, EpiOddIn{wsp<float>(p, WS_ROPE)}); } PHASE_END
      float* KN = wsp<float>(p, WS_KN) + (size_t)lp * 256 * 32;
      PHASE_BEGIN_K(23) for (int g = bid; g < 256; g += nb) att::knorm_group(Pqk, KN, g, (LAS float*)lds); PHASE_END
      PHASE_BEGIN_K(15) for (int ui = bid; ui < 2048 + (last ? 0 : 64); ui += nb) { int b, hh, q0, nlat; const int u = (nb == 256 && ui < 2048) ? ((((ui >> 8) * 8 + (bid & 7)) << 5) | (bid >> 3)) : ui;
        if (u < 2048) { b = u >> 9; hh = (u >> 5) & 15; q0 = b * T + (u & 31) * 256; nlat = T; } else { const int v = u - 2048; b = v >> 4; hh = v & 15; q0 = NLAT + b * L; nlat = 0; }
        const bool st = __builtin_amdgcn_sqrtf(att::nmax2_of(KN, b, hh, 0) * att::nmax2_of(KN, b, hh, 1)) * 1.001f <= 60.0f;
#ifdef MK_ABL
        if (dry) att::diff_attn_unit<true, MK_ABL>(Pqk, Vt, O12, hh, q0, b * T, nlat, NLAT + b * L, lds); else
#endif
        if (st) att::diff_attn_unit<true>(Pqk, Vt, O12, hh, q0, b * T, nlat, NLAT + b * L, lds); else att::diff_attn_unit<false>(Pqk, Vt, O12, hh, q0, b * T, nlat, NLAT + b * L, lds); } PHASE_END
      PHASE_BEGIN_K(16) { float d1 = 0.f, d2 = 0.f; for (int i = 0; i < 64; ++i) { d1 += p.da_lq1[lp * 64 + i] * p.da_lk1[lp * 64 + i]; d2 += p.da_lq2[lp * 64 + i] * p.da_lk2[lp * 64 + i]; }
        const float li = 0.8f - 0.6f * expf(-0.3f * (float)l), lam = expf(d1) - expf(d2) + li;
        const int tq = mk::otid(); for (int r4 = bid; r4 < (last ? NLAT : NTOK) / 4; r4 += nb) att::diff_combine_rows4(O12, p.da_subln_g + lp * 128, lam, 1.0f - li, UO, r4 * 4, tq >> 6, tq & 63); } PHASE_END
      PHASE_BEGIN_K(17) { SchedOut S{UO, wsp<bf16_t>(p, WS_WOOUT) + (size_t)lp * D * D, Ybuf, nb, bid}; pg8::gemm_phase(lds, D, S, pg8::EpiStoreBf16{}); __syncthreads(); cvt_experts(p, l, (LAS float*)lds, 528 - 2 * nb > 0 ? 528 - 2 * nb : 0); } PHASE_END
      PHASE_BEGIN_K(18) phase_ln1<false>(p, l, Ybuf, lds, dry); PHASE_END
      PHASE_BEGIN_K(19) phase_scatter(p, l, lds); PHASE_END
      PHASE_BEGIN_K(20) { LAS int* mo = (LAS int*)(lds + LDS_MISC); { const int tq = mk::otid(); if (tq < 17) mo[tq] = wsp<int>(p, WS_MOFF)[l * 64 + tq]; } __syncthreads();
        SchedMoe<true> S{UO, wsp<bf16_t>(p, WS_WGU), (bf16_t*)(scr + SM_HE), mo, wsp<int>(p, WS_RL), D, DE, 128, nb, bid}; pg8::gemm_phase(lds, D, S, EpiGateUp{}); } PHASE_END
      PHASE_BEGIN_K(21) { LAS int* mo = (LAS int*)(lds + LDS_MISC); { const int tq = mk::otid(); if (tq < 17) mo[tq] = wsp<int>(p, WS_MOFF)[l * 64 + tq]; } __syncthreads();
        SchedMoe<false> S{(bf16_t*)(scr + SM_HE), wsp<bf16_t>(p, WS_WDN), (bf16_t*)(scr + SM_YS), mo, nullptr, DE, D, 256, nb, bid}; pg8::gemm_phase(lds, DE, S, pg8::EpiStoreBf16{}); } PHASE_END
      PHASE_BEGIN_K(22) phase_ln2(p, l, dry); PHASE_END
    }
  }
#undef PHASE_BEGIN_K
#undef PHASE_END
}
}

#ifndef MK_SINGLE_LAUNCH
#define MK_SINGLE_LAUNCH 1
#endif
extern "C" void kernel_launch(void* const* d_in, const int* in_sizes, int n_in, void* d_out, int out_size, void* d_ws, size_t ws_size, hipStream_t stream) {
  using namespace mk;
  static int grid = 0;
  if (grid == 0) {
    if (n_in != 34 || out_size != NLAT * D || ws_size < WS_END) { fprintf(stderr, "kernel_launch: unexpected shapes (n_in %d out %d ws %zu need %zu)\n", n_in, out_size, ws_size, (size_t)WS_END); grid = -1; return; }
    if (hipFuncSetAttribute((const void*)mega, hipFuncAttributeMaxDynamicSharedMemorySize, LDS_BYTES) != hipSuccess) { grid = -1; return; }
    int dev = 0, cus = 0, per_cu = 0;
    if (hipGetDevice(&dev) != hipSuccess || hipDeviceGetAttribute(&cus, hipDeviceAttributeMultiprocessorCount, dev) != hipSuccess) { grid = -1; return; }
    if (hipOccupancyMaxActiveBlocksPerMultiprocessor(&per_cu, (const void*)mega, NTHR, LDS_BYTES) != hipSuccess || per_cu < 1) { fprintf(stderr, "kernel_launch: occupancy query says %d\n", per_cu); }
    (void)hipGetLastError();
    grid = cus;
  }
  if (grid < 0) return;
  (void)hipMemsetAsync((char*)d_ws + WS_BAR, 0, (size_t)XCD_BAR_WORDS * 4, stream);
  Params p{};
  const float** pp = (const float**)&p;
  for (int i = 0; i < 34; ++i) pp[i] = (const float*)d_in[i];
  p.out = (float*)d_out; p.ws = (unsigned char*)d_ws;
#if MK_SINGLE_LAUNCH
  p.ph_lo = 0; p.ph_hi = N_PHASES;
  hipLaunchKernelGGL(mega, dim3(grid), dim3(NTHR), LDS_BYTES, stream, p);
#else
  for (int ph = 0; ph < N_PHASES; ++ph) { p.ph_lo = ph; p.ph_hi = ph + 1; hipLaunchKernelGGL(mega, dim3(grid), dim3(NTHR), LDS_BYTES, stream, p); }
#endif
}
```

```cpp
#include <hip/hip_runtime.h>
#include <stdint.h>
#include <stdio.h>

typedef unsigned short bf16_t;
typedef short bf16x8 __attribute__((ext_vector_type(8)));
typedef float f32x4 __attribute__((ext_vector_type(4)));
typedef float f32x2 __attribute__((ext_vector_type(2)));
typedef float f32x16 __attribute__((ext_vector_type(16)));
typedef unsigned u32x4 __attribute__((ext_vector_type(4)));
typedef unsigned u32x2 __attribute__((ext_vector_type(2)));
#define LAS __attribute__((address_space(3)))

namespace mk {
constexpr int B = 4, T = 8192, L = 256, D = 1024, NLAT = B * T, NCTX = B * L, NTOK = NLAT + NCTX;
constexpr int DEPTH = 4, EVEN_IN = 3328, ODD_IN = 3072, RW_OFF = 1536, RW_IN = 1792, NE = 16, DE = 512;
constexpr float ALPHA = 1.681792830507429f, LN_EPS = 1e-5f;
constexpr int NTHR = 512, LDS_BYTES = 147456;
constexpr int MOE_TILES = 280, MOE_ROWS = MOE_TILES * 256;

typedef __bf16 bf16x2v __attribute__((ext_vector_type(2)));
__device__ __forceinline__ unsigned cvt_pk_bf16(float lo, float hi) { const f32x2 v = {lo, hi}; return __builtin_bit_cast(unsigned, __builtin_convertvector(v, bf16x2v)); }
__device__ __forceinline__ unsigned cvt_pk_bf16_v(float lo, float hi) { return cvt_pk_bf16(lo, hi); }
template <int V> struct IntC { static constexpr int value = V; };
__device__ __forceinline__ float bf2f(bf16_t b) { return __uint_as_float(((unsigned)b) << 16); }
__device__ __forceinline__ float bflo(unsigned w) { return __uint_as_float(w << 16); }
__device__ __forceinline__ float bfhi(unsigned w) { return __uint_as_float(w & 0xffff0000u); }
__device__ __forceinline__ bf16_t f2bf(float f) { return (bf16_t)(cvt_pk_bf16(f, 0.f) & 0xffffu); }
__device__ __forceinline__ float sigmoidf_(float x) { return 1.0f / (1.0f + __expf(-x)); }
__device__ __forceinline__ float siluf_(float x) { return x / (1.0f + __expf(-x)); }
__device__ __forceinline__ float wave_sum(float v) {
#pragma unroll
  for (int o = 32; o > 0; o >>= 1) v += __shfl_xor(v, o);
  return v;
}
template <int CTRL, int RM, int BM> __device__ __forceinline__ float dpp_mov(float old, float v) { return __int_as_float(__builtin_amdgcn_update_dpp(__float_as_int(old), __float_as_int(v), CTRL, RM, BM, false)); }
__device__ __forceinline__ float wave_sum_u(float v) {
  v += dpp_mov<0xB1, 0xf, 0xf>(v, v);
  v += dpp_mov<0x4E, 0xf, 0xf>(v, v);
  v += dpp_mov<0x141, 0xf, 0xf>(v, v);
  v += dpp_mov<0x140, 0xf, 0xf>(v, v);
  v += dpp_mov<0x142, 0xa, 0xf>(0.f, v);
  v += dpp_mov<0x143, 0xc, 0xf>(0.f, v);
  return __int_as_float(__builtin_amdgcn_readlane(__float_as_int(v), 63));
}
__device__ __forceinline__ float wave_max_u(float v) {
  v = fmaxf(v, dpp_mov<0xB1, 0xf, 0xf>(v, v));
  v = fmaxf(v, dpp_mov<0x4E, 0xf, 0xf>(v, v));
  v = fmaxf(v, dpp_mov<0x141, 0xf, 0xf>(v, v));
  v = fmaxf(v, dpp_mov<0x140, 0xf, 0xf>(v, v));
  v = fmaxf(v, dpp_mov<0x142, 0xa, 0xf>(0.f, v));
  v = fmaxf(v, dpp_mov<0x143, 0xc, 0xf>(0.f, v));
  return __int_as_float(__builtin_amdgcn_readlane(__float_as_int(v), 63));
}
__device__ __forceinline__ f32x16 zero16() { float z = 0.f; asm volatile("" : "+v"(z)); f32x16 r;
#pragma unroll
  for (int i = 0; i < 16; ++i) r[i] = z;
  return r; }
__device__ __forceinline__ int otid() { int t = threadIdx.x; asm volatile("" : "+v"(t)); return t; }
__device__ __forceinline__ int obid() { int b = blockIdx.x; asm volatile("" : "+s"(b)); return b; }
__device__ __forceinline__ int bidx_of_row(int row) { return row < NLAT ? row / T : 4; }
}

#include <vector>

#define XB_TMO      128
#define XB_XCNT(j)  (256  + 64 * (j))
#define XB_XSUB(j)  (1280 + 64 * (j))
#define XB_XGEN(j)  (2304 + 64 * (j))
#define XB_TOP      3328
#define XB_TOPGEN   3392
#define XCD_BAR_WORDS 3456
#define XB_SPIN_CAP (1u << 18)
#define LAS __attribute__((address_space(3)))

__device__ __forceinline__ unsigned xb_ld(unsigned* p)              { return __hip_atomic_load(p, __ATOMIC_RELAXED, __HIP_MEMORY_SCOPE_AGENT); }
__device__ __forceinline__ unsigned xb_add(unsigned* p, unsigned v) { return __hip_atomic_fetch_add(p, v, __ATOMIC_RELAXED, __HIP_MEMORY_SCOPE_AGENT); }
__device__ __forceinline__ unsigned xb_xcc_id() { return (unsigned)__builtin_amdgcn_s_getreg((3 << 11) | 20) & 0xFu; }
#define XB_SPIN(cond, bar) do { unsigned _sp = 0; while (cond) { __builtin_amdgcn_s_sleep(1); \
    if ((++_sp & 255u) == 0u) { if (xb_ld(&(bar)[XB_TMO])) break; if (_sp > XB_SPIN_CAP) { atomicAdd(&(bar)[XB_TMO], 1u); break; } } } } while (0)

struct XcdBarrier {
    unsigned* bar; unsigned x;
    volatile LAS unsigned* st;
};

__device__ __forceinline__ XcdBarrier xcd_barrier_post(unsigned* bar, volatile LAS unsigned* st) {
    XcdBarrier b; b.bar = bar; b.x = xb_xcc_id(); b.st = st;
    if (threadIdx.x == 0) (void)xb_add(&bar[XB_XCNT(b.x)], 1u);
    return b;
}
__device__ __forceinline__ void xcd_barrier_complete(unsigned* bar, unsigned x, unsigned& nloc, unsigned& nx) {
    const unsigned G = gridDim.x * gridDim.y * gridDim.z;
    unsigned sum, cnt, mine, sp = 0u;
    for (;;) {
        sum = 0u; cnt = 0u; mine = 0u;
#pragma unroll
        for (unsigned j = 0; j < 16; ++j) { const unsigned c = xb_ld(&bar[XB_XCNT(j)]); sum += c; cnt += (c > 0u) ? 1u : 0u; mine = (j == x) ? c : mine; }
        if (sum == G) break;
        __builtin_amdgcn_s_sleep(1);
        if ((++sp & 255u) == 0u) { if (xb_ld(&bar[XB_TMO])) break; if (sp > XB_SPIN_CAP) { atomicAdd(&bar[XB_TMO], 1u); break; } }
    }
    nloc = mine > 0u ? mine : 1u; nx = cnt > 0u ? cnt : 1u;
}

__device__ __forceinline__ void xcd_barrier(const XcdBarrier& b) {
    asm volatile("s_waitcnt vmcnt(0)" ::: "memory");
    __syncthreads();
    if (threadIdx.x == 0) {
        unsigned* bar = b.bar;
        __builtin_amdgcn_s_waitcnt(0);
        unsigned nloc = b.st[0], nx = b.st[1];
        if (nloc == 0u) { xcd_barrier_complete(bar, b.x, nloc, nx); b.st[0] = nloc; b.st[1] = nx; }
        const unsigned old = xb_add(&bar[XB_XSUB(b.x)], 1u);
        const unsigned gen = old / nloc;
        if (old + 1u == (gen + 1u) * nloc) {
            __builtin_amdgcn_fence(__ATOMIC_RELEASE, "agent");
            asm volatile("s_waitcnt vmcnt(0)" ::: "memory");
            const unsigned og = xb_add(&bar[XB_TOP], 1u);
            const unsigned tg = og / nx;
            if (og + 1u == (tg + 1u) * nx) xb_add(&bar[XB_TOPGEN], 1u);
            else XB_SPIN(xb_ld(&bar[XB_TOPGEN]) == tg, bar);
            __builtin_amdgcn_fence(__ATOMIC_ACQUIRE, "agent");
            xb_add(&bar[XB_XGEN(b.x)], 1u);
            asm volatile("s_waitcnt vmcnt(0)" ::: "memory");
        } else {
            XB_SPIN(xb_ld(&bar[XB_XGEN(b.x)]) == gen, bar);
            __builtin_amdgcn_fence(__ATOMIC_ACQUIRE, "agent");
            asm volatile("s_waitcnt vmcnt(0)" ::: "memory");
        }
    }
    __syncthreads();
}

namespace pg8 {
using mk::cvt_pk_bf16;
constexpr int BM = 256, BK = 64, HALF = 128, HTB = HALF * BK * 2  , STAGE_BYTES = 8 * HTB;
__host__ __device__ __forceinline__ int lds_byte(int r, int c) { const int st = (r >> 4) * 2 + (c >> 5), rr = r & 15, cc = c & 31, ob = rr * 64 + cc * 2; return st * 1024 + (ob ^ (((ob >> 9) & 1) << 5)); }
__host__ __device__ __forceinline__ void stage_rc(int b, int& R, int& C) { const int st = b / 1024, sb = b % 1024, swz = sb ^ (((sb >> 9) & 1) << 5); R = (st >> 1) * 16 + swz / 64; C = (st & 1) * 32 + (swz % 64) / 2; }
__host__ __device__ __forceinline__ int perm32(int rho) { const int n = rho >> 4, i = rho & 15; return 8 * (i >> 2) + 4 * n + (i & 3); }

struct Unit { const char* A; const char* Bt; bf16_t* out; const int* rl; int pm, pn, x0, x1, ldo, kind; };

template <class Epi, class Sched>
__device__ __forceinline__ void gemm_phase(LAS unsigned char* lds, const int K, const Sched& S, const Epi& E) {
    const int tid = mk::otid(), wid = __builtin_amdgcn_readfirstlane(tid >> 6), lane = tid & 63, wr = wid >> 2, wc = wid & 3, fr = lane & 15, fq = lane >> 4;
    const int nt = K / BK;
    constexpr bool GATH = Sched::GATHER;
    unsigned voffA[2], voffB[2]; int Rl[2], Cl[2];
#pragma unroll
    for (int i = 0; i < 2; ++i) { int R, C; stage_rc(tid * 16 + i * 8192, R, C); const int Rb = Epi::PERM ? ((R & ~31) + perm32(R & 31)) : R; Rl[i] = R; Cl[i] = C;
        voffA[i] = (unsigned)(R * K + C) * 2u; voffB[i] = (unsigned)(Rb * K + C) * 2u; }
    unsigned roC[2][2], roN[2][2];
    (void)Rl; (void)Cl;
    const size_t kstep = (size_t)(BK * 2);
    const size_t hstep = (size_t)HALF * K * 2;
    const unsigned ldsw = (unsigned)wid * 1024u;
    const int aoff = lds_byte(wr * 64 + fr, fq * 8), boff = lds_byte(wc * 32 + fr, fq * 8);
#define PG8_SA(b, h) (((b) * 2 + (h)) * HTB)
#define PG8_SB(b, h) ((4 + (b) * 2 + (h)) * HTB)
#define PG8_STAGE(bufoff, gbase, voff) do { _Pragma("unroll") for (int _i = 0; _i < 2; ++_i) \
        __builtin_amdgcn_global_load_lds((const unsigned*)((const char*)(gbase) + (voff)[_i]), (LAS unsigned*)(lds + (bufoff) + ldsw + _i * 8192), 16, 0, 0); } while (0)
#define PG8_STAGE_A(bufoff, gbase, h, ro) do { if constexpr (GATH) { _Pragma("unroll") for (int _i = 0; _i < 2; ++_i) \
        __builtin_amdgcn_global_load_lds((const unsigned*)((const char*)(gbase) + (ro)[h][_i]), (LAS unsigned*)(lds + (bufoff) + ldsw + _i * 8192), 16, 0, 0); } \
      else { PG8_STAGE(bufoff, (const char*)(gbase) + (h) * hstep, voffA); } } while (0)
#define PG8_LOAD_RO(u, ro) do { _Pragma("unroll") for (int _h = 0; _h < 2; ++_h) _Pragma("unroll") for (int _i = 0; _i < 2; ++_i) \
        (ro)[_h][_i] = (unsigned)(u).rl[Rl[_i] + _h * 128] * (unsigned)(K * 2) + (unsigned)(Cl[_i] * 2); } while (0)
#define PG8_LDA(dst, b, h) do { _Pragma("unroll") for (int m = 0; m < 4; ++m) _Pragma("unroll") for (int k = 0; k < 2; ++k) dst[m][k] = *(const LAS bf16x8*)(lds + PG8_SA(b, h) + aoff + m * 2048 + k * 1024); } while (0)
#define PG8_LDB(dst, b, h) do { _Pragma("unroll") for (int n = 0; n < 2; ++n) _Pragma("unroll") for (int k = 0; k < 2; ++k) dst[n][k] = *(const LAS bf16x8*)(lds + PG8_SB(b, h) + boff + n * 2048 + k * 1024); } while (0)
#define PG8_MMA(ai, bj, At, Bt) do { __builtin_amdgcn_s_setprio(1); _Pragma("unroll") for (int m = 0; m < 4; ++m) _Pragma("unroll") for (int n = 0; n < 2; ++n) _Pragma("unroll") for (int k = 0; k < 2; ++k) \
        acc[ai][bj][m][n] = __builtin_amdgcn_mfma_f32_16x16x32_bf16(Bt[n][k], At[m][k], acc[ai][bj][m][n], 0, 0, 0); __builtin_amdgcn_s_setprio(0); } while (0)
#define PG8_WAIT_V(n) asm volatile("s_waitcnt vmcnt(" #n ")" ::: "memory")
#define PG8_WAIT_L(n) asm volatile("s_waitcnt lgkmcnt(" #n ")" ::: "memory")
#define PG8_BAR __builtin_amdgcn_s_barrier()
#define PG8_SCHED __builtin_amdgcn_sched_barrier(0)
    Unit cur, nxt; int ui = 0;
    if (!S.next(0, cur)) return;
    f32x4 acc[2][2][4][2];
#pragma unroll
    for (int a = 0; a < 2; ++a)
#pragma unroll
        for (int b = 0; b < 2; ++b)
#pragma unroll
            for (int m = 0; m < 4; ++m)
#pragma unroll
                for (int n = 0; n < 2; ++n) acc[a][b][m][n] = (f32x4){0.f, 0.f, 0.f, 0.f};
    bf16x8 At[4][2], B0[2][2], B1[2][2];
    const char* cA = cur.A; const char* cB = cur.Bt;
    if constexpr (GATH) { PG8_LOAD_RO(cur, roC); }
    PG8_STAGE(PG8_SB(0, 0), cB, voffB); PG8_STAGE_A(PG8_SA(0, 0), cA, 0, roC); PG8_STAGE(PG8_SB(0, 1), cB + hstep, voffB); PG8_STAGE_A(PG8_SA(0, 1), cA, 1, roC);
    if (wr == 1) PG8_BAR;
    PG8_WAIT_V(4); PG8_BAR;
    PG8_STAGE(PG8_SB(1, 0), cB + kstep, voffB); PG8_STAGE_A(PG8_SA(1, 0), cA + kstep, 0, roC); PG8_STAGE(PG8_SB(1, 1), cB + hstep + kstep, voffB);
    PG8_WAIT_V(6); PG8_BAR;
    for (;;) {
        const bool has_next = S.next(ui + 1, nxt);
        const char* nA = has_next ? nxt.A : cA; const char* nB = has_next ? nxt.Bt : cB;
        if constexpr (GATH) { if (has_next) { PG8_LOAD_RO(nxt, roN); } else { _Pragma("unroll") for (int _h = 0; _h < 2; ++_h) _Pragma("unroll") for (int _i = 0; _i < 2; ++_i) roN[_h][_i] = roC[_h][_i]; } }
        for (int t = 0; t < nt; t += 2) {
            const bool last = (t == nt - 2);
            const char* a1 = cA + (size_t)(t + 1) * kstep;
            const char* a2 = last ? nA : cA + (size_t)(t + 2) * kstep; const char* b2 = last ? nB : cB + (size_t)(t + 2) * kstep;
            const char* a3 = a2 + kstep; const char* b3 = b2 + kstep;
            unsigned ro2[2][2];
            if constexpr (GATH) { _Pragma("unroll") for (int _h = 0; _h < 2; ++_h) _Pragma("unroll") for (int _i = 0; _i < 2; ++_i) ro2[_h][_i] = last ? roN[_h][_i] : roC[_h][_i]; }
            (void)ro2;
            PG8_LDB(B0, 0, 0); PG8_SCHED; PG8_LDA(At, 0, 0); PG8_STAGE_A(PG8_SA(1, 1), a1, 1, roC);
            PG8_WAIT_L(8); PG8_BAR; PG8_WAIT_L(0); PG8_MMA(0, 0, At, B0); PG8_BAR; PG8_SCHED;
            PG8_LDB(B1, 0, 1); PG8_STAGE(PG8_SB(0, 0), b2, voffB);
            PG8_BAR; PG8_WAIT_L(0); PG8_MMA(0, 1, At, B1); PG8_BAR;
            PG8_LDA(At, 0, 1); PG8_STAGE_A(PG8_SA(0, 0), a2, 0, ro2);
            PG8_BAR; PG8_WAIT_L(0); PG8_MMA(1, 0, At, B0); PG8_BAR; PG8_SCHED;
            PG8_STAGE(PG8_SB(0, 1), b2 + hstep, voffB);
            PG8_WAIT_V(6); PG8_BAR; PG8_MMA(1, 1, At, B1); PG8_BAR;
            PG8_LDB(B0, 1, 0); PG8_SCHED; PG8_LDA(At, 1, 0); PG8_STAGE_A(PG8_SA(0, 1), a2, 1, ro2);
            PG8_WAIT_L(8); PG8_BAR; PG8_WAIT_L(0); PG8_MMA(0, 0, At, B0); PG8_BAR; PG8_SCHED;
            PG8_LDB(B1, 1, 1); PG8_STAGE(PG8_SB(1, 0), b3, voffB);
            PG8_BAR; PG8_WAIT_L(0); PG8_MMA(0, 1, At, B1); PG8_BAR;
            PG8_LDA(At, 1, 1); PG8_STAGE_A(PG8_SA(1, 0), a3, 0, ro2);
            PG8_BAR; PG8_WAIT_L(0); PG8_MMA(1, 0, At, B0); PG8_BAR; PG8_SCHED;
            PG8_STAGE(PG8_SB(1, 1), b3 + hstep, voffB);
            PG8_WAIT_V(6); PG8_BAR; PG8_MMA(1, 1, At, B1); PG8_BAR;
        }
        E(acc, cur, wr, wc, fr, fq);
        if (!has_next) break;
#pragma unroll
        for (int a = 0; a < 2; ++a)
#pragma unroll
            for (int b = 0; b < 2; ++b)
#pragma unroll
                for (int m = 0; m < 4; ++m)
#pragma unroll
                    for (int n = 0; n < 2; ++n) acc[a][b][m][n] = (f32x4){0.f, 0.f, 0.f, 0.f};
        cur = nxt; cA = nA; cB = nB; ++ui;
        if constexpr (GATH) { _Pragma("unroll") for (int _h = 0; _h < 2; ++_h) _Pragma("unroll") for (int _i = 0; _i < 2; ++_i) roC[_h][_i] = roN[_h][_i]; }
    }
    PG8_WAIT_V(0);
    if (wr == 0) PG8_BAR;
    PG8_BAR;
#undef PG8_SA
#undef PG8_SB
#undef PG8_STAGE
#undef PG8_STAGE_A
#undef PG8_LOAD_RO
#undef PG8_LDA
#undef PG8_LDB
#undef PG8_MMA
#undef PG8_WAIT_V
#undef PG8_WAIT_L
#undef PG8_BAR
#undef PG8_SCHED
}

struct EpiStoreBf16 {
    static constexpr bool PERM = true;
    __device__ __forceinline__ void operator()(const f32x4 (&acc)[2][2][4][2], const Unit& u, int wr, int wc, int fr, int fq) const {
        bf16_t* O = u.out; const int ldc = u.ldo;
        const int row0 = u.x0 + wr * 64 + fr, col0 = u.x1 + wc * 32 + 8 * fq;
#pragma unroll
        for (int ai = 0; ai < 2; ++ai)
#pragma unroll
            for (int m = 0; m < 4; ++m) { bf16_t* rowp = O + (size_t)(row0 + ai * HALF + m * 16) * ldc + col0;
#pragma unroll
                for (int bj = 0; bj < 2; ++bj) { const f32x4 v0 = acc[ai][bj][m][0], v1 = acc[ai][bj][m][1];
                    u32x4 w; w.x = cvt_pk_bf16(v0[0], v0[1]); w.y = cvt_pk_bf16(v0[2], v0[3]); w.z = cvt_pk_bf16(v1[0], v1[1]); w.w = cvt_pk_bf16(v1[2], v1[3]);
                    *(u32x4*)(rowp + bj * HALF) = w; } }
    }
};
}

namespace mk {
struct NMapId { int off; __device__ __forceinline__ int operator()(int n) const { return n + off; } __device__ __forceinline__ float scl(int) const { return 1.0f; } };
struct NMapInterleave { int which; __device__ __forceinline__ int operator()(int n) const { return 2 * n + which; } __device__ __forceinline__ float scl(int) const { return 1.0f; } };
struct NMapRope { __device__ __forceinline__ int operator()(int n) const { if (n >= 2048) return n; const int ch = n >> 6, c = n & 63, half = c >> 5, w = c & 31, z = w >> 4, i = w & 15; return ch * 64 + half * 32 + 2 * i + z; }
  __device__ __forceinline__ float scl(int n) const { return n < 1024 ? 0.125f * 1.4426950408889634f : 1.0f; } };

template <class NMap>
__device__ __forceinline__ void cvt_tile(const float* __restrict__ src, int ldsrc, int K, bf16_t* __restrict__ dst, int k0, int n0, const NMap& nmap, LAS float* tile) {
  const int t = mk::otid();
  { const int k = t >> 3, c = (t & 7) * 8; const float* p = src + (size_t)(k0 + k) * ldsrc + n0 + c;
    const f32x4 a = *(const f32x4*)p, b = *(const f32x4*)(p + 4);
    LAS float* q = tile + k * 65 + c; q[0] = a[0]; q[1] = a[1]; q[2] = a[2]; q[3] = a[3]; q[4] = b[0]; q[5] = b[1]; q[6] = b[2]; q[7] = b[3]; }
  __syncthreads();
  { const int n = t >> 3, kc = (t & 7) * 8; const LAS float* q = tile + kc * 65 + n; const float sc = nmap.scl(n0 + n);
    u32x4 w; w.x = cvt_pk_bf16(q[0] * sc, q[65] * sc); w.y = cvt_pk_bf16(q[130] * sc, q[195] * sc); w.z = cvt_pk_bf16(q[260] * sc, q[325] * sc); w.w = cvt_pk_bf16(q[390] * sc, q[455] * sc);
    *(u32x4*)(dst + (size_t)nmap(n0 + n) * K + k0 + kc) = w; }
  __syncthreads();
}
template <class NMap>
__device__ __forceinline__ int cvt_matrix(const float* src, int ldsrc, int K, int N, bf16_t* dst, const NMap& nmap, LAS float* tile, int ubase, int bid, int nblk) {
  const int nkt = K / 64, nnt = N / 64, tot = nkt * nnt;
  int first = ubase + ((bid - ubase % nblk) + nblk) % nblk;
  for (int u = first; u < ubase + tot; u += nblk) { const int v = u - ubase; cvt_tile(src, ldsrc, K, dst, (v / nnt) * 64, (v % nnt) * 64, nmap, tile); }
  return tot;
}
}

namespace att {
using namespace mk;
constexpr int KB_BYTES = 64 * 128, VB_BYTES = 128 * 128, TILE_BYTES = KB_BYTES + VB_BYTES, DA_RING = 4, DA_LDS = DA_RING * TILE_BYTES;
__device__ __forceinline__ int pi32(int r) { return (r & ~12) | ((r & 4) << 1) | ((r & 8) >> 1); }
__device__ __forceinline__ int swz(int row, int chunk) { return row * 128 + ((chunk ^ ((row >> 1) & 7)) << 4); }
__device__ __forceinline__ int crow(int r, int hi) { return (r & 3) + 8 * (r >> 2) + 4 * hi; }

__device__ __forceinline__ float sumsq8(u32x4 w) { return (bflo(w.x) * bflo(w.x) + bfhi(w.x) * bfhi(w.x)) + (bflo(w.y) * bflo(w.y) + bfhi(w.y) * bfhi(w.y)) + (bflo(w.z) * bflo(w.z) + bfhi(w.z) * bfhi(w.z)) + (bflo(w.w) * bflo(w.w) + bfhi(w.w) * bfhi(w.w)); }
__device__ __forceinline__ void knorm_group(const bf16_t* __restrict__ Pqk, float* __restrict__ KN, int g, LAS float* red) {
  const int tid = mk::otid(), wid = tid >> 6, lane = tid & 63;
  float mx = 0.f, mq = 0.f;
  for (int i0 = 0; i0 < 160; i0 += 32) {
    u32x4 a[4], b[4], c[4], d[4];
#pragma unroll
    for (int j = 0; j < 4; ++j) { int i = i0 + j * 8 + wid; i = i < 132 ? i : wid; const int row = i < 128 ? g * 128 + i : NLAT + g * 4 + (i - 128);
      const bf16_t* kp = Pqk + (size_t)row * 2048 + 1024 + lane * 16; a[j] = *(const u32x4*)kp; b[j] = *(const u32x4*)(kp + 8); c[j] = *(const u32x4*)(kp - 1024); d[j] = *(const u32x4*)(kp - 1024 + 8); }
#pragma unroll
    for (int j = 0; j < 4; ++j) { float s = sumsq8(a[j]) + sumsq8(b[j]); s += dpp_mov<0xB1, 0xf, 0xf>(s, s); s += dpp_mov<0x4E, 0xf, 0xf>(s, s); mx = fmaxf(mx, s);
      float q = sumsq8(c[j]) + sumsq8(d[j]); q += dpp_mov<0xB1, 0xf, 0xf>(q, q); q += dpp_mov<0x4E, 0xf, 0xf>(q, q); mq = fmaxf(mq, q); }
  }
  if ((lane & 3) == 0) { red[wid * 32 + (lane >> 2)] = mx; red[wid * 32 + 16 + (lane >> 2)] = mq; }
  __syncthreads();
  if (tid < 32) { float m = red[tid];
#pragma unroll
    for (int w = 1; w < 8; ++w) m = fmaxf(m, red[w * 32 + tid]);
    KN[g * 32 + tid] = m; }
  __syncthreads();
}
__device__ __forceinline__ float nmax2_of(const float* __restrict__ KN, int b, int hh, int which) {
  return wave_max_u(KN[(b * 64 + (mk::otid() & 63)) * 32 + which * 16 + hh]);
}

template <bool STATIC, int ABL = 0>
__device__ __forceinline__ void diff_attn_unit(const bf16_t* __restrict__ Pqk, const bf16_t* __restrict__ Vt, bf16_t* __restrict__ O12, int hh, int q0, int klat0, int nlat, int kctx0, LAS unsigned char* lds) {
  const int tid = mk::otid(), wid = tid >> 6, lane = tid & 63, r = lane & 31, hi = lane >> 5;
  const int NT = (nlat + L) / 64, NTL = nlat / 64;
  const int wv = __builtin_amdgcn_readfirstlane(wid);
  const int drow = wv * 8 + (lane >> 3), dch = (lane & 7) ^ ((drow >> 1) & 7);
  const unsigned koff = (unsigned)(drow * 2048 + 1024 + hh * 64 + dch * 8) * 2u;
  const unsigned voff = (unsigned)(((hh >> 1) * 128 + drow) * NTOK + dch * 8) * 2u;
  bf16x8 qf[4];
  { const bf16_t* qp = Pqk + (size_t)(q0 + wid * 32 + r) * 2048 + hh * 64 + hi * 8;
#pragma unroll
    for (int ks = 0; ks < 4; ++ks) qf[ks] = *(const bf16x8*)(qp + ks * 16); }
  const unsigned kaddr0 = (unsigned)(pi32(r) * 128 + ((hi ^ ((pi32(r) >> 1) & 7)) << 4));
  const unsigned vaddr0 = (unsigned)(r * 128 + ((hi ^ ((r >> 1) & 7)) << 4)) + KB_BYTES;
  f32x16 o[4];
#pragma unroll
  for (int vb = 0; vb < 4; ++vb)
#pragma unroll
    for (int i = 0; i < 16; ++i) o[vb][i] = 0.f;
  float l_run = 0.f;
#define DA_DMA(t) do { const int tok = (t) < NTL ? klat0 + (t) * 64 : kctx0 + ((t) - NTL) * 64; LAS unsigned char* b_ = lds + ((t) & 3) * TILE_BYTES + wv * 1024; \
    const char* kt_ = (const char*)Pqk + (size_t)tok * 4096; const char* vt_ = (const char*)Vt + (size_t)tok * 2; \
    __builtin_amdgcn_global_load_lds((const unsigned*)(kt_ + koff), (LAS unsigned*)b_, 16, 0, 0); \
    __builtin_amdgcn_global_load_lds((const unsigned*)(vt_ + voff), (LAS unsigned*)(b_ + KB_BYTES), 16, 0, 0); \
    __builtin_amdgcn_global_load_lds((const unsigned*)(vt_ + (size_t)64 * NTOK * 2 + voff), (LAS unsigned*)(b_ + KB_BYTES + 8192), 16, 0, 0); } while (0)
#define DA_WAITV(n) asm volatile("s_waitcnt vmcnt(" #n ")" ::: "memory")
#define DA_PAIR_BEGIN(t) if (!(ABL & 8) && (t) + 2 < NT) { DA_DMA((t) + 2); DA_DMA((t) + 3); }
#define DA_SLOT(tt) const unsigned sb_ = (unsigned)(((tt) & 3) * TILE_BYTES); const LAS unsigned char* kb_ = lds + (kaddr0 + sb_); const LAS unsigned char* vb_ = lds + (vaddr0 + sb_)
#define DA_PAIR_END() do { DA_WAITV(0); asm volatile("s_waitcnt lgkmcnt(0)" ::: "memory"); if (!(ABL & 16)) __builtin_amdgcn_s_barrier(); } while (0)
  DA_DMA(0); DA_DMA(1);
  DA_WAITV(0); __builtin_amdgcn_s_barrier();
#define DA_XOR(ptr, x) ((const LAS unsigned char*)((unsigned)(size_t)(ptr) ^ (unsigned)(x)))
#define DA_KFRAG(ks) const LAS unsigned char* kp_ = DA_XOR(kb_, (ks) << 5); const bf16x8 a0 = (ABL & 2) ? qf[ks] : *(const LAS bf16x8*)kp_, a1 = (ABL & 2) ? qf[(ks) ^ 1] : *(const LAS bf16x8*)(kp_ + 4096)
#define DA_VFRAGS() bf16x8 va[4][4]; \
    _Pragma("unroll") for (int c4 = 0; c4 < 4; ++c4) { const LAS unsigned char* vp_ = DA_XOR(vb_, c4 << 5); \
      _Pragma("unroll") for (int vb = 0; vb < 4; ++vb) va[vb][c4] = (ABL & 1) ? qf[c4 ^ (vb & 3)] : *(const LAS bf16x8*)(vp_ + vb * 4096); }
#define DA_PACK_PV() bf16x8 pf[2][2]; \
    _Pragma("unroll") for (int s = 0; s < 2; ++s) { u32x4 w0, w1; \
      w0.x = cvt_pk_bf16(s0[8 * s + 0], s0[8 * s + 1]); w0.y = cvt_pk_bf16(s0[8 * s + 2], s0[8 * s + 3]); w0.z = cvt_pk_bf16(s0[8 * s + 4], s0[8 * s + 5]); w0.w = cvt_pk_bf16(s0[8 * s + 6], s0[8 * s + 7]); \
      w1.x = cvt_pk_bf16(s1[8 * s + 0], s1[8 * s + 1]); w1.y = cvt_pk_bf16(s1[8 * s + 2], s1[8 * s + 3]); w1.z = cvt_pk_bf16(s1[8 * s + 4], s1[8 * s + 5]); w1.w = cvt_pk_bf16(s1[8 * s + 6], s1[8 * s + 7]); \
      pf[0][s] = __builtin_bit_cast(bf16x8, w0); pf[1][s] = __builtin_bit_cast(bf16x8, w1); } \
    _Pragma("unroll") for (int vb = 0; vb < 4; ++vb) _Pragma("unroll") for (int kb = 0; kb < 2; ++kb) _Pragma("unroll") for (int s = 0; s < 2; ++s) \
      o[vb] = __builtin_amdgcn_mfma_f32_32x32x16_bf16(va[vb][kb * 2 + s], pf[kb][s], o[vb], 0, 0, 0)
  if constexpr (STATIC) {
    for (int t = 0; t < NT; t += 2) {
      DA_PAIR_BEGIN(t);
#pragma unroll
      for (int u = 0; u < 2; ++u) {
        DA_SLOT(t + u);
        f32x16 s0, s1;
#pragma unroll
        for (int i = 0; i < 16; ++i) { s0[i] = 0.f; s1[i] = 0.f; }
#pragma unroll
        for (int ks = 0; ks < 4; ++ks) { DA_KFRAG(ks); s0 = __builtin_amdgcn_mfma_f32_32x32x16_bf16(a0, qf[ks], s0, 0, 0, 0); s1 = __builtin_amdgcn_mfma_f32_32x32x16_bf16(a1, qf[ks], s1, 0, 0, 0); }
        DA_VFRAGS();
        if constexpr ((ABL & 32) != 0) {
          l_run += s0[0] + s1[0];
#pragma unroll
          for (int vb = 0; vb < 4; ++vb)
#pragma unroll
            for (int c4 = 0; c4 < 4; ++c4) o[vb] = __builtin_amdgcn_mfma_f32_32x32x16_bf16(va[vb][c4], qf[c4], o[vb], 0, 0, 0);
        } else {
          float ps = 0.f;
#pragma unroll
          for (int i = 0; i < 16; ++i) { s0[i] = (ABL & 4) ? s0[i] : __builtin_amdgcn_exp2f(s0[i]); ps += s0[i]; }
#pragma unroll
          for (int i = 0; i < 16; ++i) { s1[i] = (ABL & 4) ? s1[i] : __builtin_amdgcn_exp2f(s1[i]); ps += s1[i]; }
          l_run += ps;
          DA_PACK_PV();
        }
        if (u == 0) __builtin_amdgcn_sched_barrier(0);
      }
      DA_PAIR_END();
    }
  } else {
    constexpr float THR = 8.0f * 1.4426950408889634f;
    float m_run = -1e30f;
    for (int t = 0; t < NT; ++t) {
      if (!(t & 1)) DA_PAIR_BEGIN(t);
      DA_SLOT(t);
      f32x16 s0 = zero16(), s1 = zero16();
#pragma unroll
      for (int ks = 0; ks < 4; ++ks) { DA_KFRAG(ks); s0 = __builtin_amdgcn_mfma_f32_32x32x16_bf16(a0, qf[ks], s0, 0, 0, 0); s1 = __builtin_amdgcn_mfma_f32_32x32x16_bf16(a1, qf[ks], s1, 0, 0, 0); }
      float mx = fmaxf(s0[0], s1[0]);
#pragma unroll
      for (int i = 1; i < 16; ++i) mx = fmaxf(mx, fmaxf(s0[i], s1[i]));
      { const u32x2 sw = __builtin_amdgcn_permlane32_swap(__float_as_uint(mx), __float_as_uint(mx), false, false); mx = fmaxf(__uint_as_float(sw.x), __uint_as_float(sw.y)); }
      float alpha = 1.0f;
      if (!__all(mx - m_run <= THR)) {
        const float m_new = fmaxf(m_run, mx);
        alpha = __builtin_amdgcn_exp2f(m_run - m_new);
        m_run = m_new;
#pragma unroll
        for (int vb = 0; vb < 4; ++vb)
#pragma unroll
          for (int i = 0; i < 16; ++i) o[vb][i] *= alpha;
      }
      float ps = 0.f;
#pragma unroll
      for (int i = 0; i < 16; ++i) { s0[i] = __builtin_amdgcn_exp2f(s0[i] - m_run); ps += s0[i]; }
#pragma unroll
      for (int i = 0; i < 16; ++i) { s1[i] = __builtin_amdgcn_exp2f(s1[i] - m_run); ps += s1[i]; }
      l_run = l_run * alpha + ps;
      __builtin_amdgcn_sched_barrier(0);
      DA_VFRAGS();
      DA_PACK_PV();
      if (t & 1) DA_PAIR_END();
    }
  }
#undef DA_KFRAG
#undef DA_XOR
#undef DA_VFRAGS
#undef DA_PACK_PV
#undef DA_DMA
#undef DA_WAITV
#undef DA_PAIR_BEGIN
#undef DA_PAIR_END
#undef DA_SLOT
  float l_tot; { const u32x2 sw = __builtin_amdgcn_permlane32_swap(__float_as_uint(l_run), __float_as_uint(l_run), false, false); l_tot = __uint_as_float(sw.x) + __uint_as_float(sw.y); }
  const float inv = 1.0f / l_tot;
  const int te = mk::otid();
  bf16_t* op = O12 + (size_t)(q0 + (te >> 6) * 32 + (te & 31)) * 2048 + hh * 128 + 4 * ((te >> 5) & 1);
#pragma unroll
  for (int vb = 0; vb < 4; ++vb)
#pragma unroll
    for (int g = 0; g < 4; ++g) {
      u32x2 w; w.x = cvt_pk_bf16(o[vb][4 * g] * inv, o[vb][4 * g + 1] * inv); w.y = cvt_pk_bf16(o[vb][4 * g + 2] * inv, o[vb][4 * g + 3] * inv);
      *(u32x2*)(op + vb * 32 + 8 * g) = w;
    }
}

__device__ __forceinline__ void diff_combine_rows4(const bf16_t* __restrict__ O12, const float* __restrict__ subln_g, float lam, float oml, bf16_t* __restrict__ O, int row0, int h, int lane) {
  unsigned a[4], b[4];
#pragma unroll
  for (int i = 0; i < 4; ++i) { a[i] = *(const unsigned*)(O12 + (size_t)(row0 + i) * 2048 + (2 * h) * 128 + 2 * lane); b[i] = *(const unsigned*)(O12 + (size_t)(row0 + i) * 2048 + (2 * h + 1) * 128 + 2 * lane); }
  const float g0 = subln_g[2 * lane], g1 = subln_g[2 * lane + 1];
#pragma unroll
  for (int i = 0; i < 4; ++i) {
    const float x0 = bflo(a[i]) - lam * bflo(b[i]), x1 = bfhi(a[i]) - lam * bfhi(b[i]);
    const float ss = wave_sum_u(x0 * x0 + x1 * x1);
    const float rs = rsqrtf(ss * (1.0f / 128.0f) + 1e-5f) * oml;
    *(unsigned*)(O + (size_t)(row0 + i) * 1024 + h * 128 + 2 * lane) = cvt_pk_bf16(x0 * rs * g0, x1 * rs * g1);
  }
}
}

namespace natt {
using namespace mk;
using att::pi32; using att::swz;
constexpr int TB = 64 * 128;
constexpr int NA_LDS = 4 * TB + 2048;
__device__ __forceinline__ void na_attn_unit(const bf16_t* __restrict__ Pe, const bf16_t* __restrict__ Vte, const float* __restrict__ rpb_h, bf16_t* __restrict__ O, int b, int h, int rq, LAS unsigned char* lds) {
  const int tid = mk::otid(), wid = tid >> 6, lane = tid & 63, r = lane & 31, hi = lane >> 5;
  constexpr float LOG2E = 1.4426950408889634f;
  LAS float* sb = (LAS float*)(lds + 4 * TB);
  for (int i = tid; i < 465; i += NTHR) sb[i] = rpb_h[i];
  const bool is_ctx = rq < 0;
  int qrow = 0, qcol = 0, qtok, rs_q = 0, cs_q = 0, span0 = 0, wlo = 0, whi = -1, lo = 0, ntl = 0;
  if (!is_ctx) {
    const int r0 = rq * 4, ra = r0 + (wid >> 2) * 2;
    qrow = ra + (r >> 4); qcol = (wid & 3) * 16 + (r & 15); qtok = b * T + qrow * 64 + qcol;
    rs_q = min(max(qrow - 4, 0), 120); cs_q = min(max(qcol - 8, 0), 48);
    span0 = min(max((wid & 3) * 16 - 8, 0), 32);
    wlo = min(max(ra - 4, 0), 120); whi = min(max(ra - 3, 0), 120) + 7;
    lo = min(max(r0 - 4, 0), 120); const int hi_ = min(max(r0 - 1, 0), 120) + 7; ntl = hi_ - lo + 1;
  } else qtok = NLAT + b * L + wid * 32 + r;
  const int NT = ntl + 4;
  const int srow = tid >> 3, sch = tid & 7;
  const bf16_t* kbase = Pe + 512 + h * 64 + sch * 8;
  const bf16_t* vbase = Vte + (size_t)(h * 64 + srow) * NTOK + sch * 8;
  const int sdst = swz(srow, sch);
  bf16x8 qf[4];
  { const bf16_t* qp = Pe + (size_t)qtok * 1024 + h * 64 + hi * 8;
#pragma unroll
    for (int ks = 0; ks < 4; ++ks) qf[ks] = *(const bf16x8*)(qp + ks * 16); }
  const int kx = (pi32(r) >> 1) & 7, vx = (r >> 1) & 7;
  const int ka_loc = (span0 + pi32(r)) * 128; const int kx_loc = ((span0 + pi32(r)) >> 1) & 7;
  f32x16 o[2];
#pragma unroll
  for (int vb = 0; vb < 2; ++vb)
#pragma unroll
    for (int i = 0; i < 16; ++i) o[vb][i] = 0.f;
  float m_run = -1e30f, l_run = 0.f;
  u32x4 kreg, vreg;
#define NA_LOAD(t) do { const int tok = (t) < ntl ? b * T + (lo + (t)) * 64 : NLAT + b * L + ((t) - ntl) * 64; \
    kreg = *(const u32x4*)(kbase + (size_t)(tok + srow) * 1024); vreg = *(const u32x4*)(vbase + tok); } while (0)
#define NA_WRITE(bufi) do { *(LAS u32x4*)(lds + (bufi) * TB + sdst) = kreg; *(LAS u32x4*)(lds + 2 * TB + (bufi) * TB + sdst) = vreg; } while (0)
  NA_LOAD(0); NA_WRITE(0); __syncthreads();
  for (int t = 0; t < NT; ++t) {
    const bool more = t + 1 < NT;
    if (more) NA_LOAD(t + 1);
    const LAS unsigned char* kb_ = lds + (t & 1) * TB; const LAS unsigned char* vb_ = lds + 2 * TB + (t & 1) * TB;
    const bool local = t < ntl; const int kr = lo + t;
    const bool active = !local || (kr >= wlo && kr <= whi);
    if (active) {
      f32x16 s0, s1;
#pragma unroll
      for (int i = 0; i < 16; ++i) { s0[i] = 0.f; s1[i] = 0.f; }
      if (local) {
#pragma unroll
        for (int ks = 0; ks < 4; ++ks) {
          const bf16x8 a0 = *(const LAS bf16x8*)(kb_ + ka_loc + (((ks * 2 + hi) ^ kx_loc) << 4));
          s0 = __builtin_amdgcn_mfma_f32_32x32x16_bf16(a0, qf[ks], s0, 0, 0, 0);
        }
        const bool row_ok = kr >= rs_q && kr < rs_q + 8; const int dr31 = (kr - qrow + 7) * 31;
#pragma unroll
        for (int i = 0; i < 16; ++i) {
          const int kc = span0 + (i & 7) + 8 * hi + 16 * (i >> 3);
          const bool ok = row_ok && kc >= cs_q && kc < cs_q + 16;
          const int bi = ok ? dr31 + (kc - qcol + 15) : 0;
          const float bv = sb[bi];
          s0[i] = ok ? fmaf(s0[i], 0.125f, bv) : -1e30f; s1[i] = -1e30f;
        }
      } else {
#pragma unroll
        for (int ks = 0; ks < 4; ++ks) {
          const int ch = ((ks * 2 + hi) ^ kx) << 4;
          const bf16x8 a0 = *(const LAS bf16x8*)(kb_ + pi32(r) * 128 + ch), a1 = *(const LAS bf16x8*)(kb_ + (32 + pi32(r)) * 128 + ch);
          s0 = __builtin_amdgcn_mfma_f32_32x32x16_bf16(a0, qf[ks], s0, 0, 0, 0);
          s1 = __builtin_amdgcn_mfma_f32_32x32x16_bf16(a1, qf[ks], s1, 0, 0, 0);
        }
#pragma unroll
        for (int i = 0; i < 16; ++i) { s0[i] *= 0.125f; s1[i] *= 0.125f; }
      }
      float mx = s0[0];
#pragma unroll
      for (int i = 1; i < 16; ++i) mx = fmaxf(mx, s0[i]);
#pragma unroll
      for (int i = 0; i < 16; ++i) mx = fmaxf(mx, s1[i]);
      { const u32x2 sw = __builtin_amdgcn_permlane32_swap(__float_as_uint(mx), __float_as_uint(mx), false, false); mx = fmaxf(__uint_as_float(sw.x), __uint_as_float(sw.y)); }
      const float m_new = fmaxf(m_run, mx);
      const float alpha = __builtin_amdgcn_exp2f((m_run - m_new) * LOG2E);
      m_run = m_new;
      const float mc = -m_new * LOG2E;
      float ps = 0.f;
#pragma unroll
      for (int i = 0; i < 16; ++i) { const float p = s0[i] > -1e29f ? __builtin_amdgcn_exp2f(fmaf(s0[i], LOG2E, mc)) : 0.f; s0[i] = p; ps += p; }
#pragma unroll
      for (int i = 0; i < 16; ++i) { const float p = s1[i] > -1e29f ? __builtin_amdgcn_exp2f(fmaf(s1[i], LOG2E, mc)) : 0.f; s1[i] = p; ps += p; }
      l_run = l_run * alpha + ps;
      if (__any(alpha < 1.0f)) {
#pragma unroll
        for (int vb = 0; vb < 2; ++vb)
#pragma unroll
          for (int i = 0; i < 16; ++i) o[vb][i] *= alpha;
      }
      bf16x8 pf[2][2];
#pragma unroll
      for (int s = 0; s < 2; ++s) {
        u32x4 w0, w1;
        w0.x = cvt_pk_bf16(s0[8 * s + 0], s0[8 * s + 1]); w0.y = cvt_pk_bf16(s0[8 * s + 2], s0[8 * s + 3]); w0.z = cvt_pk_bf16(s0[8 * s + 4], s0[8 * s + 5]); w0.w = cvt_pk_bf16(s0[8 * s + 6], s0[8 * s + 7]);
        w1.x = cvt_pk_bf16(s1[8 * s + 0], s1[8 * s + 1]); w1.y = cvt_pk_bf16(s1[8 * s + 2], s1[8 * s + 3]); w1.z = cvt_pk_bf16(s1[8 * s + 4], s1[8 * s + 5]); w1.w = cvt_pk_bf16(s1[8 * s + 6], s1[8 * s + 7]);
        pf[0][s] = __builtin_bit_cast(bf16x8, w0); pf[1][s] = __builtin_bit_cast(bf16x8, w1);
      }
      const int cbase = local ? (span0 >> 3) : 0;
#pragma unroll
      for (int vb = 0; vb < 2; ++vb) {
        const LAS unsigned char* vrow = vb_ + (vb * 32 + r) * 128;
#pragma unroll
        for (int s = 0; s < 2; ++s) {
          const bf16x8 a = *(const LAS bf16x8*)(vrow + (((cbase + 2 * s + hi) ^ vx) << 4));
          o[vb] = __builtin_amdgcn_mfma_f32_32x32x16_bf16(a, pf[0][s], o[vb], 0, 0, 0);
        }
        if (!local) {
#pragma unroll
          for (int s = 0; s < 2; ++s) {
            const bf16x8 a = *(const LAS bf16x8*)(vrow + (((4 + 2 * s + hi) ^ vx) << 4));
            o[vb] = __builtin_amdgcn_mfma_f32_32x32x16_bf16(a, pf[1][s], o[vb], 0, 0, 0);
          }
        }
      }
    }
    if (more) NA_WRITE((t + 1) & 1);
    __syncthreads();
  }
#undef NA_LOAD
#undef NA_WRITE
  float l_tot; { const u32x2 sw = __builtin_amdgcn_permlane32_swap(__float_as_uint(l_run), __float_as_uint(l_run), false, false); l_tot = __uint_as_float(sw.x) + __uint_as_float(sw.y); }
  const float inv = 1.0f / l_tot;
  bf16_t* op = O + (size_t)qtok * 1024 + h * 64 + 4 * hi;
#pragma unroll
  for (int vb = 0; vb < 2; ++vb)
#pragma unroll
    for (int g = 0; g < 4; ++g) {
      u32x2 w; w.x = cvt_pk_bf16(o[vb][4 * g] * inv, o[vb][4 * g + 1] * inv); w.y = cvt_pk_bf16(o[vb][4 * g + 2] * inv, o[vb][4 * g + 3] * inv);
      *(u32x2*)(op + vb * 32 + 8 * g) = w;
    }
}
}

namespace rw {
using namespace mk;
constexpr int NSTEP = L + T, NCH = 32, CL = NSTEP / NCH;
constexpr int NCHAIN = 2 * B * 8;
constexpr float LOG2E = 1.4426950408889634f;
struct Bufs {
  u32x2* SH;
  unsigned* DR;
  bf16_t* G; int gstride;
  float* CS;
  float* PQ;
  float* SST;
  bf16_t* Y;
  bf16_t* Z;
};

constexpr int XPITCH = 528;
template <int KS> struct LoraW { bf16x8 w[KS][4]; };
template <int KS>
__device__ __forceinline__ void lora_load(const bf16_t* __restrict__ W, int h, int lane, LoraW<KS>& f) {
  const int fr = lane & 15, fq = lane >> 4;
#pragma unroll
  for (int ks = 0; ks < KS; ++ks)
#pragma unroll
    for (int nb = 0; nb < 4; ++nb) f.w[ks][nb] = *(const bf16x8*)(W + (size_t)(h * 64 + nb * 16 + fr) * (KS * 32) + ks * 32 + fq * 8);
}
template <int KS>
__device__ __forceinline__ void lora_mma(const LAS unsigned char* xb, int xcol0, const LoraW<KS>& f, int lane, LAS float* tw, float (&out)[16]) {
  const int fr = lane & 15, fq = lane >> 4;
  f32x4 acc[4];
#pragma unroll
  for (int nb = 0; nb < 4; ++nb) { float z = 0.f; asm volatile("" : "+v"(z)); acc[nb] = (f32x4){z, z, z, z}; }
#pragma unroll
  for (int ks = 0; ks < KS; ++ks) {
    const bf16x8 xf = *(const LAS bf16x8*)(xb + fr * XPITCH + (xcol0 + ks * 32 + fq * 8) * 2);
#pragma unroll
    for (int nb = 0; nb < 4; ++nb) acc[nb] = __builtin_amdgcn_mfma_f32_16x16x32_bf16(xf, f.w[ks][nb], acc[nb], 0, 0, 0);
  }
#pragma unroll
  for (int nb = 0; nb < 4; ++nb) *(LAS f32x4*)(tw + (nb * 16 + fr) * 16 + fq * 4) = acc[nb];
  __builtin_amdgcn_wave_barrier(); asm volatile("s_waitcnt lgkmcnt(0)" ::: "memory"); __builtin_amdgcn_wave_barrier();
#pragma unroll
  for (int q = 0; q < 4; ++q) { const f32x4 v = *(const LAS f32x4*)(tw + lane * 16 + q * 4); out[q * 4] = v[0]; out[q * 4 + 1] = v[1]; out[q * 4 + 2] = v[2]; out[q * 4 + 3] = v[3]; }
  __builtin_amdgcn_wave_barrier(); asm volatile("s_waitcnt lgkmcnt(0)" ::: "memory"); __builtin_amdgcn_wave_barrier();
}
__device__ __forceinline__ void prep_tile(const bf16_t* __restrict__ Prw, const float* __restrict__ cw, const float* __restrict__ w0, const bf16_t* __restrict__ WLT, const float* __restrict__ a0,
                                          const float* __restrict__ k_k, const float* __restrict__ k_a, const float* __restrict__ r_k,
                                          const Bufs& bf, int tile, LAS float* xs  ) {
  const int c = mk::otid(), lane = c & 63, h = c >> 6;
  const int row0 = tile * 16;
  int lo, hi;
  if (row0 < NLAT) { lo = (row0 / T) * T; hi = lo + T - 1; } else { lo = NLAT + ((row0 - NLAT) / L) * L; hi = lo + L - 1; }
  bf16_t rraw[18], kraw[18], vraw[18];
#pragma unroll
  for (int j = 0; j < 18; ++j) { int rr_ = row0 - 1 + j; rr_ = rr_ < lo ? lo : (rr_ > hi ? hi : rr_); const bf16_t* q = Prw + (size_t)rr_ * RW_IN + c; rraw[j] = q[0]; kraw[j] = q[512]; vraw[j] = q[1024]; }
  LoraW<2> wd0, wd1; LoraW<4> wg;
  lora_load<2>(WLT, h, lane, wd0); lora_load<2>(WLT + 32768, h, lane, wd1);
#define RW_CONV(dst, col) do { const float c0 = cw[(col)], c1 = cw[RW_IN + (col)], c2 = cw[2 * RW_IN + (col)]; const bf16_t* p = Prw + (col); \
    bf16_t raw[18]; \
    _Pragma("unroll") for (int j = 0; j < 18; ++j) { int rr = row0 - 1 + j; rr = rr < lo ? lo : (rr > hi ? hi : rr); raw[j] = p[(size_t)rr * RW_IN]; } \
    float pm = row0 > lo ? bf2f(raw[0]) : 0.f, pc = bf2f(raw[1]); \
    _Pragma("unroll") for (int tt = 0; tt < 16; ++tt) { const float pn = (row0 + tt + 1 <= hi) ? bf2f(raw[tt + 2]) : 0.f; dst[tt] = pm * c0 + pc * c1 + pn * c2; pm = pc; pc = pn; } } while (0)
  if (c < 256) {
    float xv[16]; RW_CONV(xv, 1536 + c);
#pragma unroll
    for (int tt = 0; tt < 16; ++tt) { float v = xv[tt]; if (c < 64) v = tanhf(v); else if (c >= 128) v = sigmoidf_(v); *(LAS bf16_t*)((LAS unsigned char*)xs + tt * XPITCH + c * 2) = f2bf(v); }
  }
  __syncthreads();
  const LAS unsigned char* xb = (const LAS unsigned char*)xs; LAS float* tw = xs + 20480 + h * 1024;
  const float w00 = w0[c], w01 = w0[512 + c], a00 = a0[c], a01 = a0[512 + c], kkc = k_k[c], kac = k_a[c], rkc = r_k[c];
  float e0[16], e1[16];
  {
    float aw0[16], aw1[16];
    lora_mma<2>(xb, 0, wd0, lane, tw, aw0); lora_mma<2>(xb, 0, wd1, lane, tw, aw1);
    lora_load<2>(WLT + 2 * 32768, h, lane, wd0); lora_load<2>(WLT + 3 * 32768, h, lane, wd1);
#pragma unroll
    for (int tt = 0; tt < 16; ++tt) {
      e0[tt] = 0.6065306597126334f * __builtin_amdgcn_rcpf(1.0f + __expf(-(w00 + aw0[tt])));
      e1[tt] = 0.6065306597126334f * __builtin_amdgcn_rcpf(1.0f + __expf(-(w01 + aw1[tt])));
    }
  }
  LAS float* asl = xs + 256 * 16;
  {
    float aa0[16], aa1[16];
    lora_mma<2>(xb, 64, wd0, lane, tw, aa0); lora_mma<2>(xb, 64, wd1, lane, tw, aa1);
    lora_load<4>(WLT + 4 * 32768, h, lane, wg);
#pragma unroll
    for (int tt = 0; tt < 16; ++tt) { const unsigned d0 = cvt_pk_bf16(e0[tt], sigmoidf_(a00 + aa0[tt])), d1 = cvt_pk_bf16(e1[tt], sigmoidf_(a01 + aa1[tt]));
      bf.DR[((size_t)(row0 + tt)) * 512 + c] = d0; bf.DR[((size_t)NTOK + row0 + tt) * 512 + c] = d1; asl[tt * 512 + c] = bfhi(d0); asl[(16 + tt) * 512 + c] = bfhi(d1); }
  }
  {
    float ag[16];
    lora_mma<4>(xb, 128, wg, lane, tw, ag);
#pragma unroll
    for (int tt = 0; tt < 16; ++tt) bf.G[(size_t)(row0 + tt) * bf.gstride + c] = f2bf(ag[tt]);
  }
#undef RW_CONV
  const float cr0 = cw[c], cr1 = cw[RW_IN + c], cr2 = cw[2 * RW_IN + c], ck0 = cw[512 + c], ck1 = cw[RW_IN + 512 + c], ck2 = cw[2 * RW_IN + 512 + c], cv0 = cw[1024 + c], cv1 = cw[RW_IN + 1024 + c], cv2 = cw[2 * RW_IN + 1024 + c];
  float rm = row0 > lo ? bf2f(rraw[0]) : 0.f, km = row0 > lo ? bf2f(kraw[0]) : 0.f, vm = row0 > lo ? bf2f(vraw[0]) : 0.f;
  float rc = bf2f(rraw[1]), kc = bf2f(kraw[1]), vc = bf2f(vraw[1]);
#pragma unroll
  for (int tt = 0; tt < 16; ++tt) {
    const int row = row0 + tt;
    const bool has_n = row + 1 <= hi;
    const float rn = has_n ? bf2f(rraw[tt + 2]) : 0.f, kn = has_n ? bf2f(kraw[tt + 2]) : 0.f, vn = has_n ? bf2f(vraw[tt + 2]) : 0.f;
    const float rv = rm * cr0 + rc * cr1 + rn * cr2, kvv = km * ck0 + kc * ck1 + kn * ck2, vvv = vm * cv0 + vc * cv1 + vn * cv2;
    rm = rc; rc = rn; km = kc; kc = kn; vm = vc; vc = vn;
    float kk = kvv * kkc; const float nrm = sqrtf(wave_sum_u(kk * kk)); kk = kk * __builtin_amdgcn_rcpf(fmaxf(nrm, 1e-12f));
    u32x2 sh; sh.x = cvt_pk_bf16(rv, kvv); sh.y = cvt_pk_bf16(kk, vvv);
    bf.SH[(size_t)row * 512 + c] = sh;
    const float rq = bflo(sh.x), kq = bfhi(sh.x);
    const float cb0 = wave_sum_u(rq * kq * (1.0f + (asl[tt * 512 + c] - 1.0f) * kac) * rkc), cb1 = wave_sum_u(rq * kq * (1.0f + (asl[(16 + tt) * 512 + c] - 1.0f) * kac) * rkc);
    if (lane == 0) { bf.CS[(size_t)row * 16 + h] = cb0; bf.CS[(size_t)row * 16 + 8 + h] = cb1; }
  }
  __syncthreads();
}

struct StepRaw { u32x2 s; unsigned d; };
__device__ __forceinline__ int scan_row(int dir, int b, int p) {
  if (p < L) return NLAT + b * L + (dir ? (L - 1 - p) : p);
  const int q = p - L; return b * T + (dir ? (T - 1 - q) : q);
}
__device__ __forceinline__ void scan_unit(const Bufs& bf, const float* __restrict__ k_a, int chain, int chunk, LAS float* wl) {
  const int lane = mk::otid() & 63, r = lane & 31, hi = lane >> 5;
  const int dir = chain >> 5, b = (chain >> 3) & 3, h = chain & 7, ch = h * 64 + lane;
  const float kac = k_a[ch];
  f32x16 TS[2][2], TP[2][2];
#pragma unroll
  for (int rb = 0; rb < 2; ++rb)
#pragma unroll
    for (int cb = 0; cb < 2; ++cb)
#pragma unroll
      for (int q = 0; q < 16; ++q) { TS[rb][cb][q] = 0.f; TP[rb][cb][q] = (32 * rb + (q & 3) + 8 * (q >> 2) + 4 * hi == 32 * cb + r) ? 1.f : 0.f; }
  LAS unsigned char* wb = (LAS unsigned char*)wl;
  const LAS unsigned char* xrow = wb + (lane & 15) * 128 + 8 * hi;
  LAS float* Gl = wl + 1024;
  const int p0 = chunk * CL;
  float Dl = 1.f;
#define RW_FRAG(base, rb, s2) ([&]() { const u32x2 lo_ = *(const LAS u32x2*)((base) + (32 * (rb) + 16 * (s2)) * 2), hi_ = *(const LAS u32x2*)((base) + (32 * (rb) + 16 * (s2) + 8) * 2); \
      return __builtin_bit_cast(bf16x8, (u32x4){lo_.x, lo_.y, hi_.x, hi_.y}); }())
#define RW_DOTS(T, o) do { _Pragma("unroll") for (int cb = 0; cb < 2; ++cb) _Pragma("unroll") for (int q = 0; q < 16; ++q) o[cb][q] = 0.f; \
    _Pragma("unroll") for (int rb = 0; rb < 2; ++rb) _Pragma("unroll") for (int s2 = 0; s2 < 2; ++s2) _Pragma("unroll") for (int cb = 0; cb < 2; ++cb) { u32x4 w_; \
      w_.x = cvt_pk_bf16(T[rb][cb][8 * s2 + 0], T[rb][cb][8 * s2 + 1]); w_.y = cvt_pk_bf16(T[rb][cb][8 * s2 + 2], T[rb][cb][8 * s2 + 3]); \
      w_.z = cvt_pk_bf16(T[rb][cb][8 * s2 + 4], T[rb][cb][8 * s2 + 5]); w_.w = cvt_pk_bf16(T[rb][cb][8 * s2 + 6], T[rb][cb][8 * s2 + 7]); \
      o[cb] = __builtin_amdgcn_mfma_f32_32x32x16_bf16(xf[rb][s2], __builtin_bit_cast(bf16x8, w_), o[cb], 0, 0, 0); \
      asm volatile("" : "+v"(o[cb]) : "v"(w_), "v"(xf[rb][s2]));   } } while (0)
#define RW_RENORM() do { wl[1280 + lane] = Dl; __builtin_amdgcn_wave_barrier(); \
    _Pragma("unroll") for (int rb = 0; rb < 2; ++rb) _Pragma("unroll") for (int g = 0; g < 4; ++g) { const f32x4 w4 = *(const LAS f32x4*)(wl + 1280 + 32 * rb + 8 * g + 4 * hi); \
      _Pragma("unroll") for (int cb = 0; cb < 2; ++cb) _Pragma("unroll") for (int u = 0; u < 4; ++u) { TS[rb][cb][4 * g + u] *= w4[u]; TP[rb][cb][4 * g + u] *= w4[u]; } } \
    __builtin_amdgcn_wave_barrier(); Dl = 1.f; } while (0)
  const int wvs = __builtin_amdgcn_readfirstlane((int)((size_t)wl));
#define RW_FETCH(tb) do { _Pragma("unroll") for (int u = 0; u < 8; ++u) { const int pn = (tb) + u < CL ? (tb) + u : CL - 1; const int row = scan_row(dir, b, p0 + pn); \
      const unsigned* gs = (const unsigned*)(bf.SH + (size_t)row * 512 + ch); const unsigned* gd = bf.DR + ((size_t)dir * NTOK + row) * 512 + ch; LAS unsigned* ld = (LAS unsigned*)(size_t)(wvs + 8192 + u * 768); \
      __builtin_amdgcn_global_load_lds(gs, ld, 4, 0, 0); __builtin_amdgcn_global_load_lds(gs + 1, ld + 64, 4, 0, 0); __builtin_amdgcn_global_load_lds(gd, ld + 128, 4, 0, 0); } } while (0)
  RW_FETCH(0);
  for (int t0 = 0; t0 < CL; t0 += 8) {
    asm volatile("s_waitcnt vmcnt(0)" ::: "memory");
    __builtin_amdgcn_wave_barrier();
#pragma unroll
    for (int u = 0; u < 8; ++u) {
      const LAS unsigned* ld = (const LAS unsigned*)(wb + 8192 + u * 768) + lane; const unsigned sx = ld[0], sy = ld[64], dd = ld[128];
      const float rr = bflo(sx), k = bfhi(sx), kk = bflo(sy), e = bflo(dd), asg = bfhi(dd);
      const float w = __builtin_amdgcn_exp2f(-e * LOG2E), keff = k * (1.0f + (asg - 1.0f) * kac);
      ((LAS bf16_t*)wb)[u * 64 + lane] = f2bf(-kk * Dl);
      Dl *= w; const float dinv = __builtin_amdgcn_rcpf(Dl);
      ((LAS bf16_t*)wb)[(8 + u) * 64 + lane] = f2bf(rr * Dl);
      ((LAS bf16_t*)wb)[1024 + u * 64 + lane] = f2bf(kk * asg * dinv); ((LAS bf16_t*)wb)[1024 + (8 + u) * 64 + lane] = f2bf(keff * dinv);
      ((LAS bf16_t*)wb)[3072 + u * 64 + lane] = (bf16_t)(sy >> 16);
    }
    asm volatile("s_waitcnt lgkmcnt(0)" ::: "memory");
    __builtin_amdgcn_wave_barrier();
    RW_FETCH(t0 + 8);
    __builtin_amdgcn_wave_barrier();
    bf16x8 xf[2][2];
#pragma unroll
    for (int rb = 0; rb < 2; ++rb)
#pragma unroll
      for (int s2 = 0; s2 < 2; ++s2) xf[rb][s2] = RW_FRAG(xrow, rb, s2);
    { f32x16 gm;
#pragma unroll
      for (int q = 0; q < 16; ++q) gm[q] = 0.f;
#pragma unroll
      for (int rb = 0; rb < 2; ++rb)
#pragma unroll
        for (int s2 = 0; s2 < 2; ++s2) { const bf16x8 yf = RW_FRAG(xrow + 2048, rb, s2); gm = __builtin_amdgcn_mfma_f32_32x32x16_bf16(xf[rb][s2], yf, gm, 0, 0, 0); asm volatile("" : "+v"(gm) : "v"(yf), "v"(xf[rb][s2])); }
      if (r < 16) {
#pragma unroll
        for (int q = 0; q < 8; ++q) Gl[((q & 3) + 8 * (q >> 2) + 4 * hi) * 16 + r] = gm[q]; }
    }
    float sa[2][8], yy[2][8];
    { f32x16 oS[2], oP[2];
      RW_DOTS(TS, oS); RW_DOTS(TP, oP);
#pragma unroll
      for (int cb = 0; cb < 2; ++cb)
#pragma unroll
        for (int q = 0; q < 4; ++q) {
          { const u32x2 sw = __builtin_amdgcn_permlane32_swap(__float_as_uint(oS[cb][q]), __float_as_uint(oP[cb][q]), false, false); sa[cb][q] = __uint_as_float(sw.x); sa[cb][4 + q] = __uint_as_float(sw.y); }
          { const u32x2 sw = __builtin_amdgcn_permlane32_swap(__float_as_uint(oS[cb][4 + q]), __float_as_uint(oP[cb][4 + q]), false, false); yy[cb][q] = __uint_as_float(sw.x); yy[cb][4 + q] = __uint_as_float(sw.y); } }
    }
    __builtin_amdgcn_wave_barrier();
    float vm[2][8];
#pragma unroll
    for (int u = 0; u < 8; ++u) { const LAS bf16_t* vr = (const LAS bf16_t*)wb + 3072 + u * 64 + r; vm[0][u] = hi ? 0.f : bf2f(vr[0]); vm[1][u] = hi ? 0.f : bf2f(vr[32]); }
#pragma unroll
    for (int s = 0; s < 8; ++s) {
      const f32x4 ga0 = *(const LAS f32x4*)(Gl + s * 16), ga1 = *(const LAS f32x4*)(Gl + s * 16 + 4), ga2 = *(const LAS f32x4*)(Gl + s * 16 + 8), ga3 = *(const LAS f32x4*)(Gl + s * 16 + 12);
      const f32x4 gr0 = *(const LAS f32x4*)(Gl + (8 + s) * 16), gr1 = *(const LAS f32x4*)(Gl + (8 + s) * 16 + 4), gr2 = *(const LAS f32x4*)(Gl + (8 + s) * 16 + 8), gr3 = *(const LAS f32x4*)(Gl + (8 + s) * 16 + 12);
      const float gab[8] = {ga0[0], ga0[1], ga0[2], ga0[3], ga1[0], ga1[1], ga1[2], ga1[3]}, gak[8] = {ga2[0], ga2[1], ga2[2], ga2[3], ga3[0], ga3[1], ga3[2], ga3[3]};
      const float grb[8] = {gr0[0], gr0[1], gr0[2], gr0[3], gr1[0], gr1[1], gr1[2], gr1[3]}, grk[8] = {gr2[0], gr2[1], gr2[2], gr2[3], gr3[0], gr3[1], gr3[2], gr3[3]};
#pragma unroll
      for (int cb = 0; cb < 2; ++cb) {
        float x = sa[cb][s], y = yy[cb][s];
#pragma unroll
        for (int u = 0; u < 8; ++u) { if (u < s) { x = fmaf(gab[u], sa[cb][u], x); x = fmaf(gak[u], vm[cb][u], x); } }
        sa[cb][s] = x;
#pragma unroll
        for (int u = 0; u < 8; ++u) { if (u <= s) { y = fmaf(grb[u], sa[cb][u], y); y = fmaf(grk[u], vm[cb][u], y); } }
        yy[cb][s] = y;
      }
    }
    { bf16_t* yz = hi ? bf.Z : bf.Y;
#pragma unroll
      for (int s = 0; s < 8; ++s) { const size_t oi = ((size_t)dir * NTOK + scan_row(dir, b, p0 + t0 + s)) * 512 + h * 64 + r; yz[oi] = f2bf(yy[0][s]); yz[oi + 32] = f2bf(yy[1][s]); } }
    { bf16x8 au[2], buS[2], buP[2];
      u32x4 a0, a1, s0, s1, p0_, p1_;
#pragma unroll
      for (int q = 0; q < 4; ++q) {
        const int u = 4 * hi + q;
        const LAS bf16_t* yb = (const LAS bf16_t*)wb + 1024 + u * 64 + r; const LAS bf16_t* vr = (const LAS bf16_t*)wb + 3072 + u * 64 + r;
        a0[q] = (unsigned)yb[0] | ((unsigned)yb[512] << 16); a1[q] = (unsigned)yb[32] | ((unsigned)yb[512 + 32] << 16);
        const u32x2 sw0 = __builtin_amdgcn_permlane32_swap(__float_as_uint(sa[0][q]), __float_as_uint(sa[0][4 + q]), false, false), sw1 = __builtin_amdgcn_permlane32_swap(__float_as_uint(sa[1][q]), __float_as_uint(sa[1][4 + q]), false, false);
        s0[q] = (cvt_pk_bf16(__uint_as_float(sw0.x), 0.f) & 0xffffu) | ((unsigned)vr[0] << 16); s1[q] = (cvt_pk_bf16(__uint_as_float(sw1.x), 0.f) & 0xffffu) | ((unsigned)vr[32] << 16);
        p0_[q] = cvt_pk_bf16(__uint_as_float(sw0.y), 0.f); p1_[q] = cvt_pk_bf16(__uint_as_float(sw1.y), 0.f); }
      au[0] = __builtin_bit_cast(bf16x8, a0); au[1] = __builtin_bit_cast(bf16x8, a1); buS[0] = __builtin_bit_cast(bf16x8, s0); buS[1] = __builtin_bit_cast(bf16x8, s1); buP[0] = __builtin_bit_cast(bf16x8, p0_); buP[1] = __builtin_bit_cast(bf16x8, p1_);
#pragma unroll
      for (int rb = 0; rb < 2; ++rb)
#pragma unroll
        for (int cb = 0; cb < 2; ++cb) { TS[rb][cb] = __builtin_amdgcn_mfma_f32_32x32x16_bf16(au[rb], buS[cb], TS[rb][cb], 0, 0, 0); TP[rb][cb] = __builtin_amdgcn_mfma_f32_32x32x16_bf16(au[rb], buP[cb], TP[rb][cb], 0, 0, 0); }
    }
    __builtin_amdgcn_wave_barrier();
    if ((t0 & 31) == 24) RW_RENORM();
  }
  RW_RENORM();
#undef RW_DOTS
#undef RW_FRAG
#undef RW_RENORM
#undef RW_FETCH
  asm volatile("s_waitcnt vmcnt(0)" ::: "memory");
  if (chunk < NCH - 1) {
    float* pq = bf.PQ + (((size_t)chain * (NCH - 1) + chunk) * 2) * 4096;
#pragma unroll
    for (int rb = 0; rb < 2; ++rb)
#pragma unroll
      for (int cb = 0; cb < 2; ++cb)
#pragma unroll
        for (int g = 0; g < 4; ++g) { float* q = pq + (size_t)(32 * cb + r) * 64 + 32 * rb + 8 * g + 4 * hi;
          *(f32x4*)q = (f32x4){TP[rb][cb][4 * g], TP[rb][cb][4 * g + 1], TP[rb][cb][4 * g + 2], TP[rb][cb][4 * g + 3]};
          *(f32x4*)(q + 4096) = (f32x4){TS[rb][cb][4 * g], TS[rb][cb][4 * g + 1], TS[rb][cb][4 * g + 2], TS[rb][cb][4 * g + 3]}; }
  }
}

__device__ __forceinline__ void propagate_chain(const Bufs& bf, int chain, int rq, LAS float* lds) {
  LAS float* Sl = lds; LAS float* Pl = lds + 16 * 65 + 15;
  Pl = lds + 1056;
  const int tid = mk::otid(), i = tid >> 5, jc = (tid & 31) * 2, row = rq * 16 + i, pi = tid >> 3, pj = (tid & 7) * 8;
  float* sst = bf.SST + (size_t)chain * NCH * 4096;
  Sl[i * 65 + jc] = 0.f; Sl[i * 65 + jc + 1] = 0.f;
  const float* pb = bf.PQ + ((size_t)chain * (NCH - 1) * 2) * 4096;
  f32x4 np0 = *(const f32x4*)(pb + pi * 64 + pj), np1 = *(const f32x4*)(pb + pi * 64 + pj + 4); f32x2 nq = *(const f32x2*)(pb + 4096 + row * 64 + jc);
  for (int c = 0; c < NCH - 1; ++c) {
    const f32x4 p0 = np0, p1 = np1; f32x2 q = nq;
    { const float* pn = pb + (size_t)(c + 1 < NCH - 1 ? c + 1 : c) * 2 * 4096;
      np0 = *(const f32x4*)(pn + pi * 64 + pj); np1 = *(const f32x4*)(pn + pi * 64 + pj + 4); nq = *(const f32x2*)(pn + 4096 + row * 64 + jc); }
    *(LAS f32x4*)(Pl + pi * 64 + pj) = p0; *(LAS f32x4*)(Pl + pi * 64 + pj + 4) = p1;
    __syncthreads();
#pragma unroll 16
    for (int k = 0; k < 64; ++k) { const float sv = Sl[i * 65 + k]; const f32x2 a = *(const LAS f32x2*)(Pl + k * 64 + jc); q += sv * a; }
    __syncthreads();
    Sl[i * 65 + jc] = q[0]; Sl[i * 65 + jc + 1] = q[1];
    *(f32x2*)(sst + (size_t)(c + 1) * 4096 + row * 64 + jc) = q;
  }
  __syncthreads();
}

__device__ __forceinline__ void corr_unit(const Bufs& bf, int chain, int chunk) {
  const int lane = mk::otid() & 63, r = lane & 31, hi = lane >> 5;
  const int dir = chain >> 5, b = (chain >> 3) & 3, h = chain & 7;
  const float* ss = bf.SST + ((size_t)chain * NCH + chunk) * 4096;
  bf16x8 bfr[2][4];
#pragma unroll
  for (int nt = 0; nt < 2; ++nt)
#pragma unroll
    for (int ks = 0; ks < 4; ++ks) { const float* q = ss + (size_t)(nt * 32 + r) * 64 + ks * 16 + hi * 8; const f32x4 x0 = *(const f32x4*)q, x1 = *(const f32x4*)(q + 4);
      u32x4 w; w.x = cvt_pk_bf16(x0[0], x0[1]); w.y = cvt_pk_bf16(x0[2], x0[3]); w.z = cvt_pk_bf16(x1[0], x1[1]); w.w = cvt_pk_bf16(x1[2], x1[3]); bfr[nt][ks] = __builtin_bit_cast(bf16x8, w); }
  const int p0 = chunk * CL;
  const size_t dbase = (size_t)dir * NTOK;
  for (int mt = 0; mt < (CL + 31) / 32; ++mt) {
    const int sa_ = min(mt * 32 + r, CL - 1);
    const bf16_t* zp = bf.Z + (dbase + scan_row(dir, b, p0 + sa_)) * 512 + h * 64 + hi * 8;
    bf16x8 af[4];
#pragma unroll
    for (int ks = 0; ks < 4; ++ks) af[ks] = *(const bf16x8*)(zp + ks * 16);
    f32x16 acc[2];
#pragma unroll
    for (int nt = 0; nt < 2; ++nt) { acc[nt] = zero16();
#pragma unroll
      for (int ks = 0; ks < 4; ++ks) acc[nt] = __builtin_amdgcn_mfma_f32_32x32x16_bf16(af[ks], bfr[nt][ks], acc[nt], 0, 0, 0); }
#pragma unroll
    for (int i = 0; i < 16; ++i) { const int so = mt * 32 + (i & 3) + 8 * (i >> 2) + 4 * hi;
      if (so < CL) { bf16_t* yp = bf.Y + (dbase + scan_row(dir, b, p0 + so)) * 512 + h * 64 + r;
        yp[0] = f2bf(bf2f(yp[0]) + acc[0][i]); yp[32] = f2bf(bf2f(yp[32]) + acc[1][i]); } }
  }
}

template <int NR> struct FinRaw { bf16_t y0[NR], y1[NR], g[NR]; unsigned v[NR]; float c0[NR], c1[NR]; };
template <int NR>
__device__ __forceinline__ void finish_load(const Bufs& bf, int row0, int c, int h, FinRaw<NR>& q) {
#pragma unroll
  for (int i = 0; i < NR; ++i) { const int row = row0 + i;
    q.y0[i] = bf.Y[(size_t)row * 512 + c]; q.y1[i] = bf.Y[((size_t)NTOK + row) * 512 + c];
    q.v[i] = bf.SH[(size_t)row * 512 + c].y; q.g[i] = bf.G[(size_t)row * bf.gstride + c];
    q.c0[i] = bf.CS[(size_t)row * 16 + h]; q.c1[i] = bf.CS[(size_t)row * 16 + 8 + h]; }
}
template <int NR>
__device__ __forceinline__ void finish_phase(const Bufs& bf, const float* __restrict__ gn_g, const float* __restrict__ gn_b, bf16_t* __restrict__ O) {
  const int c = mk::otid(), h = c >> 6, stride = gridDim.x * NR;
  const float gg = gn_g[c], gb = gn_b[c];
  int row0 = mk::obid() * NR;
  if (row0 >= NTOK) return;
  FinRaw<NR> cur, nxt; finish_load<NR>(bf, row0, c, h, cur);
  for (; row0 < NTOK; row0 += stride) {
    const int rn = row0 + stride < NTOK ? row0 + stride : row0;
    finish_load<NR>(bf, rn, c, h, nxt);
    float o[NR];
#pragma unroll
    for (int i = 0; i < NR; ++i) { const float y = bf2f(cur.y0[i]) + bf2f(cur.y1[i]);
      const float mu = wave_sum_u(y) * (1.0f / 64.0f); const float dv = y - mu; const float var = wave_sum_u(dv * dv) * (1.0f / 64.0f);
      o[i] = (dv * rsqrtf(var + 64e-5f) * gg + gb + (cur.c0[i] + cur.c1[i]) * bfhi(cur.v[i])) * bf2f(cur.g[i]); }
#pragma unroll
    for (int i = 0; i < NR; ++i) O[(size_t)(row0 + i) * 1024 + 512 + c] = f2bf(o[i]);
    cur = nxt;
  }
}
}

namespace mk {
constexpr size_t al256(size_t x) { return (x + 255) / 256 * 256; }
constexpr size_t WS_BAR = 0;
constexpr size_t WS_BCNT = al256(WS_BAR + (size_t)XCD_BAR_WORDS * 4);
constexpr size_t WS_MOFF = al256(WS_BCNT + (size_t)4 * 256 * 64 * 4);
constexpr size_t WS_KN = al256(WS_MOFF + 4 * 256);
constexpr size_t WS_MOD = al256(WS_KN + (size_t)2 * 256 * 32 * 4);
constexpr size_t WS_ROPE = al256(WS_MOD + (size_t)4 * 5 * 6144 * 4);
constexpr size_t WS_HBC = al256(WS_ROPE + 128 * 16 * 2 * 4);
constexpr size_t WS_EID = al256(WS_HBC + (size_t)NCTX * D * 2);
constexpr size_t WS_GATE = al256(WS_EID + (size_t)NTOK * 2 * 4);
constexpr size_t WS_POS = al256(WS_GATE + (size_t)NTOK * 2 * 4);
constexpr size_t WS_RL = al256(WS_POS + (size_t)NTOK * 2 * 4);
constexpr size_t WS_WEIN = al256(WS_RL + (size_t)MOE_ROWS * 4);
constexpr size_t WS_WOIN = al256(WS_WEIN + (size_t)2 * EVEN_IN * D * 2);
constexpr size_t WS_WEOUT = al256(WS_WOIN + (size_t)2 * ODD_IN * D * 2);
constexpr size_t WS_WOOUT = al256(WS_WEOUT + (size_t)2 * D * D * 2);
constexpr size_t WS_WGU = al256(WS_WOOUT + (size_t)2 * D * D * 2);
constexpr size_t WS_WDN = al256(WS_WGU + (size_t)NE * 1024 * D * 2);
constexpr size_t WS_WLT = al256(WS_WDN + (size_t)NE * D * DE * 2);
constexpr size_t WS_UO = al256(WS_WLT + (size_t)2 * 196608 * 2);
constexpr size_t WS_SCR = al256(WS_UO + (size_t)NTOK * D * 2);
constexpr size_t SE_PQK = 0;
constexpr size_t SE_VT = al256(SE_PQK + (size_t)NTOK * 1024 * 2);
constexpr size_t SE_PRW = al256(SE_VT + (size_t)512 * NTOK * 2);
constexpr size_t SE_PQ = 0;
constexpr size_t SE_SST = al256(SE_PQ + (size_t)rw::NCHAIN * (rw::NCH - 1) * 2 * 4096 * 4);
constexpr size_t SE_Y = al256(SE_SST + (size_t)rw::NCHAIN * rw::NCH * 4096 * 4);
constexpr size_t SE_Z = al256(SE_Y + (size_t)2 * NTOK * 512 * 2);
constexpr size_t SE_ZEND = al256(SE_Z + (size_t)2 * NTOK * 512 * 2);
constexpr size_t SE_PRWEND = al256(SE_PRW + (size_t)NTOK * RW_IN * 2);
constexpr size_t SE_SH = SE_PRWEND > SE_ZEND ? SE_PRWEND : SE_ZEND;
constexpr size_t SE_DR = al256(SE_SH + (size_t)NTOK * 512 * 8);
constexpr size_t SE_CS = al256(SE_DR + (size_t)2 * NTOK * 512 * 4);
constexpr size_t SE_END = al256(SE_CS + (size_t)2 * NTOK * 16 * 4);
constexpr size_t SE_YBUF = 0;
constexpr size_t SO_PQK = 0;
constexpr size_t SO_VT = al256(SO_PQK + (size_t)NTOK * 2048 * 2);
constexpr size_t SO_O12 = al256(SO_VT + (size_t)1024 * NTOK * 2);
constexpr size_t SO_END = al256(SO_O12 + (size_t)NTOK * 2048 * 2);
constexpr size_t SO_YBUF = 0;
constexpr size_t SM_XS = 0;
constexpr size_t SM_HE = al256(SM_XS + (size_t)MOE_ROWS * D * 2);
constexpr size_t SM_YS = al256(SM_HE + (size_t)MOE_ROWS * DE * 2);
constexpr size_t SM_END = al256(SM_YS + (size_t)MOE_ROWS * D * 2);
constexpr size_t SCR_BYTES = SE_END > SO_END ? (SE_END > SM_END ? SE_END : SM_END) : (SO_END > SM_END ? SO_END : SM_END);
constexpr size_t WS_END = WS_SCR + SCR_BYTES;
constexpr int LDS_BARW = 131072;
constexpr int LDS_MISC = 131072 + 64;

struct Params {
  const float *x, *c, *ctx, *c_ctx, *ada_w, *ada_b, *ln_g, *ln_b, *even_w_in, *even_w_out, *shift_w, *na_rpb, *rw_w0, *rw_w_up, *rw_a0, *rw_a_up, *rw_g_up, *rw_k_k, *rw_k_a, *rw_r_k,
      *rw_gn_g, *rw_gn_b, *odd_w_in, *odd_w_out, *da_lq1, *da_lk1, *da_lq2, *da_lk2, *da_subln_g, *router_w, *router_b, *exp_w_gate, *exp_w_up, *exp_w_down;
  float* out; unsigned char* ws; int ph_lo, ph_hi;
};
template <class Tp> __device__ __forceinline__ Tp* wsp(const Params& p, size_t off) { return (Tp*)(p.ws + off); }

__device__ __forceinline__ void ada_unit(const Params& p, int u, LAS float* lds) {
  LAS float* sc = lds; LAS float* red = lds + 5 * 1024;
  const int tid = mk::otid(), l = u / 96, n = (u % 96) * 64 + (tid & 63), kp = tid >> 6;
  for (int i = tid; i < 5 * 1024; i += NTHR) { const float v = i < 4096 ? p.c[i] : p.c_ctx[i - 4096]; sc[i] = siluf_(v); }
  __syncthreads();
  float a[5] = {0.f, 0.f, 0.f, 0.f, 0.f};
  const float* w = p.ada_w + ((size_t)l * D + kp * 128) * 6144 + n;
#pragma unroll 4
  for (int k = 0; k < 128; ++k) { const float wv = w[(size_t)k * 6144]; const int kk = kp * 128 + k;
#pragma unroll
    for (int r = 0; r < 5; ++r) a[r] = fmaf(sc[r * 1024 + kk], wv, a[r]); }
#pragma unroll
  for (int r = 0; r < 5; ++r) red[(kp * 5 + r) * 64 + (tid & 63)] = a[r];
  __syncthreads();
  if (tid < 320) { const int r = tid >> 6, nn = tid & 63; float s = 0.f;
#pragma unroll
    for (int q = 0; q < 8; ++q) s += red[(q * 5 + r) * 64 + nn];
    const int col = (u % 96) * 64 + nn;
    wsp<float>(p, WS_MOD)[((size_t)l * 5 + r) * 6144 + col] = s + p.ada_b[l * 6144 + col]; }
  __syncthreads();
}
__device__ __forceinline__ void phase_prologue(const Params& p, LAS unsigned char* lds) {
  const int bid = mk::obid(), nb = gridDim.x; LAS float* tile = (LAS float*)lds;
  int ub = 0;
  for (int i = 0; i < 2; ++i) ub += cvt_matrix(p.even_w_in + (size_t)i * D * EVEN_IN, EVEN_IN, D, EVEN_IN, wsp<bf16_t>(p, WS_WEIN) + (size_t)i * EVEN_IN * D, NMapId{0}, tile, ub, bid, nb);
  for (int i = 0; i < 2; ++i) ub += cvt_matrix(p.odd_w_in + (size_t)i * D * ODD_IN, ODD_IN, D, ODD_IN, wsp<bf16_t>(p, WS_WOIN) + (size_t)i * ODD_IN * D, NMapRope{}, tile, ub, bid, nb);
  for (int i = 0; i < 2; ++i) ub += cvt_matrix(p.even_w_out + (size_t)i * D * D, D, D, D, wsp<bf16_t>(p, WS_WEOUT) + (size_t)i * D * D, NMapId{0}, tile, ub, bid, nb);
  for (int i = 0; i < 2; ++i) ub += cvt_matrix(p.odd_w_out + (size_t)i * D * D, D, D, D, wsp<bf16_t>(p, WS_WOOUT) + (size_t)i * D * D, NMapId{0}, tile, ub, bid, nb);
  for (int i = 0; i < 2; ++i) { bf16_t* wl = wsp<bf16_t>(p, WS_WLT) + (size_t)i * 196608;
    for (int d = 0; d < 2; ++d) { ub += cvt_matrix(p.rw_w_up + (size_t)(i * 2 + d) * 64 * 512, 512, 64, 512, wl + (size_t)d * 32768, NMapId{0}, tile, ub, bid, nb);
      ub += cvt_matrix(p.rw_a_up + (size_t)(i * 2 + d) * 64 * 512, 512, 64, 512, wl + (size_t)(2 + d) * 32768, NMapId{0}, tile, ub, bid, nb); }
    ub += cvt_matrix(p.rw_g_up + (size_t)i * 128 * 512, 512, 128, 512, wl + (size_t)4 * 32768, NMapId{0}, tile, ub, bid, nb); }
  for (int u = (bid + nb - ub % nb) % nb; u < 384; u += nb) ada_unit(p, u, (LAS float*)lds);
  const int gt = bid * NTHR + mk::otid();
  if (gt < 128 * 16) { const int pos = gt >> 4, i = gt & 15; const float inv = exp2f(-(float)i * (13.287712379549449f / 16.0f)); float sn, cs; sincosf((float)pos * inv, &sn, &cs);
    wsp<float>(p, WS_ROPE)[gt * 2] = cs; wsp<float>(p, WS_ROPE)[gt * 2 + 1] = sn; }
}
#define CVT_JOB(u_, src_, dst_, ld_, K_, k0_, n0_, mode_) do { const int e_ = (u_) / 384, rem_ = (u_) % 384, v_ = rem_ & 127; mode_ = rem_ >> 7; const size_t so_ = ((size_t)l * NE + e_) * D * DE; \
    const bool dn_ = mode_ == 2; src_ = (dn_ ? wd_ : (mode_ == 0 ? wg_ : wu_)) + so_; ld_ = dn_ ? D : DE; K_ = dn_ ? DE : D; \
    k0_ = (dn_ ? (v_ >> 4) : (v_ >> 3)) * 64; n0_ = (dn_ ? (v_ & 15) : (v_ & 7)) * 64; dst_ = dn_ ? wsp<bf16_t>(p, WS_WDN) + (size_t)e_ * D * DE : wsp<bf16_t>(p, WS_WGU) + (size_t)e_ * 1024 * D; } while (0)
__device__ __forceinline__ void cvt_experts(const Params& p, int l, LAS float* tile, int b0) {
  const int bid = mk::obid() - b0, nb = (int)gridDim.x - b0, t = mk::otid();
  if (bid < 0) return;
  const float* wg_ = p.exp_w_gate; const float* wu_ = p.exp_w_up; const float* wd_ = p.exp_w_down; asm volatile("" : "+s"(wg_), "+s"(wu_), "+s"(wd_));
  constexpr int NJ = NE * 384;
  int u = bid;
  if (u >= NJ) return;
  const float* csrc; bf16_t* cdst; int cld, cK, ck0, cn0, cmode;
  CVT_JOB(u, csrc, cdst, cld, cK, ck0, cn0, cmode);
  const int lk = t >> 3, lc = (t & 7) * 8;
  f32x4 ra, rb; { const float* q = csrc + (size_t)(ck0 + lk) * cld + cn0 + lc; ra = *(const f32x4*)q; rb = *(const f32x4*)(q + 4); }
  for (; u < NJ; u += nb) {
    const int un = u + nb < NJ ? u + nb : u;
    const float* nsrc; bf16_t* ndst; int nld, nK, nk0, nn0, nmode;
    CVT_JOB(un, nsrc, ndst, nld, nK, nk0, nn0, nmode);
    f32x4 na, nbv; { const float* q = nsrc + (size_t)(nk0 + lk) * nld + nn0 + lc; na = *(const f32x4*)q; nbv = *(const f32x4*)(q + 4); }
    { LAS float* q = tile + lk * 65 + lc; q[0] = ra[0]; q[1] = ra[1]; q[2] = ra[2]; q[3] = ra[3]; q[4] = rb[0]; q[5] = rb[1]; q[6] = rb[2]; q[7] = rb[3]; }
    __syncthreads();
    { const int n = t >> 3, kc = (t & 7) * 8; const LAS float* q = tile + kc * 65 + n;
      u32x4 w; w.x = cvt_pk_bf16(q[0], q[65]); w.y = cvt_pk_bf16(q[130], q[195]); w.z = cvt_pk_bf16(q[260], q[325]); w.w = cvt_pk_bf16(q[390], q[455]);
      const int drow = cmode == 2 ? cn0 + n : 2 * (cn0 + n) + cmode;
      *(u32x4*)(cdst + (size_t)drow * cK + ck0 + kc) = w; }
    __syncthreads();
    csrc = nsrc; cdst = ndst; cld = nld; cK = nK; ck0 = nk0; cn0 = nn0; cmode = nmode; ra = na; rb = nbv;
  }
}
#undef CVT_JOB

__device__ __forceinline__ bf16_t* hb_ptr(const Params& p, int row, bool alt) {
  if (alt) return wsp<bf16_t>(p, WS_SCR + SM_END) + (size_t)row * D;
  return row < NLAT ? (bf16_t*)p.out + (size_t)row * D : wsp<bf16_t>(p, WS_HBC) + (size_t)(row - NLAT) * D;
}
__device__ __forceinline__ const float* h0_ptr(const Params& p, int row) { return row < NLAT ? p.x + (size_t)row * D : p.ctx + (size_t)(row - NLAT) * D; }
__device__ __forceinline__ void store_bf16x4(bf16_t* dst, f32x4 v) { u32x2 w; w.x = cvt_pk_bf16(v[0], v[1]); w.y = cvt_pk_bf16(v[2], v[3]); *(u32x2*)dst = w; }
__device__ __forceinline__ f32x4 load_bf16x4(const bf16_t* src) { const u32x2 w = *(const u32x2*)src; return (f32x4){bflo(w.x), bfhi(w.x), bflo(w.y), bfhi(w.y)}; }

__device__ __forceinline__ void phase_mod0(const Params& p) {
  const int lane = mk::otid() & 63, wid = mk::otid() >> 6;
  bf16_t* U = wsp<bf16_t>(p, WS_UO);
  for (int row = mk::obid() * 8 + wid; row < NTOK; row += gridDim.x * 8) {
    const float* h = h0_ptr(p, row); const float* modl = wsp<float>(p, WS_MOD) + (size_t)bidx_of_row(row) * 6144;
#pragma unroll
    for (int q = 0; q < 4; ++q) { const int col = q * 256 + lane * 4; const f32x4 hv = *(const f32x4*)(h + col), sh = *(const f32x4*)(modl + col), sc = *(const f32x4*)(modl + 1024 + col);
      store_bf16x4(U + (size_t)row * D + col, hv * (1.0f + sc) + sh); }
  }
}
__device__ __forceinline__ void ln_row(f32x4 (&v)[4], const float* __restrict__ g, const float* __restrict__ b, int lane) {
  float s = 0.f;
#pragma unroll
  for (int q = 0; q < 4; ++q) s += (v[q][0] + v[q][1]) + (v[q][2] + v[q][3]);
  const float mu = wave_sum_u(s) * (1.0f / D);
  float qq = 0.f;
#pragma unroll
  for (int q = 0; q < 4; ++q) { const f32x4 d = v[q] - mu; qq += (d[0] * d[0] + d[1] * d[1]) + (d[2] * d[2] + d[3] * d[3]); }
  const float rstd = rsqrtf(wave_sum_u(qq) * (1.0f / D) + LN_EPS);
#pragma unroll
  for (int q = 0; q < 4; ++q) { const int col = q * 256 + lane * 4; v[q] = (v[q] - mu) * rstd * *(const f32x4*)(g + col) + *(const f32x4*)(b + col); }
}
template <bool F32IN> struct Ln1Raw;
template <> struct Ln1Raw<true> { f32x4 h[4]; u32x2 y[4]; };
template <> struct Ln1Raw<false> { u32x2 h[4]; u32x2 y[4]; };
__device__ __forceinline__ f32x4 h_as_f32(f32x4 v) { return v; }
__device__ __forceinline__ f32x4 h_as_f32(u32x2 w) { return (f32x4){bflo(w.x), bfhi(w.x), bflo(w.y), bfhi(w.y)}; }
template <bool F32IN>
__device__ __forceinline__ void ln1_load(const Params& p, const bf16_t* __restrict__ Ybuf, int row, int lane, Ln1Raw<F32IN>& r) {
#pragma unroll
  for (int q = 0; q < 4; ++q) { const int col = q * 256 + lane * 4;
    if constexpr (F32IN) r.h[q] = *(const f32x4*)(h0_ptr(p, row) + col); else r.h[q] = *(const u32x2*)(hb_ptr(p, row, false) + col);
    r.y[q] = *(const u32x2*)(Ybuf + (size_t)row * D + col); }
}
template <bool F32IN>
__device__ __forceinline__ void ln1_row(const Params& p, int l, int row, int lane, const Ln1Raw<F32IN>& raw, const LAS float* rwl, LAS int* lcnt, float rbias  , bool redir) {
  bf16_t* U2 = wsp<bf16_t>(p, WS_UO); int* eid = wsp<int>(p, WS_EID); float* gatev = wsp<float>(p, WS_GATE);
  const float* lg = p.ln_g + (size_t)(l * 2) * D; const float* lb = p.ln_b + (size_t)(l * 2) * D;
  bf16_t* ho = redir ? wsp<bf16_t>(p, WS_SCR + SM_YS) + (size_t)row * D : hb_ptr(p, row, l == DEPTH - 1); const float* modl = wsp<float>(p, WS_MOD) + ((size_t)l * 5 + bidx_of_row(row)) * 6144;
  f32x4 v[4];
#pragma unroll
  for (int q = 0; q < 4; ++q) { const int col = q * 256 + lane * 4; const f32x4 yv = (f32x4){bflo(raw.y[q].x), bfhi(raw.y[q].x), bflo(raw.y[q].y), bfhi(raw.y[q].y)};
    v[q] = ALPHA * h_as_f32(raw.h[q]) + *(const f32x4*)(modl + 2 * 1024 + col) * yv; }
  ln_row(v, lg, lb, lane);
  float acc[16];
#pragma unroll
  for (int e = 0; e < 16; ++e) acc[e] = 0.f;
#pragma unroll
  for (int q = 0; q < 4; ++q) { const int col = q * 256 + lane * 4;
    store_bf16x4(ho + col, v[q]);
    const f32x4 u = v[q] * (1.0f + *(const f32x4*)(modl + 4 * 1024 + col)) + *(const f32x4*)(modl + 3 * 1024 + col);
    store_bf16x4(U2 + (size_t)row * D + col, u);
#pragma unroll
    for (int e = 0; e < 16; ++e) { const f32x4 w = *(const LAS f32x4*)(rwl + ((q * 16 + e) * 64 + lane) * 4); acc[e] += (u[0] * w[0] + u[1] * w[1]) + (u[2] * w[2] + u[3] * w[3]); }
  }
  float t8[8], t4[4], t2[2];
#pragma unroll
  for (int i = 0; i < 8; ++i) { const u32x2 sw = __builtin_amdgcn_permlane32_swap(__float_as_uint(acc[i]), __float_as_uint(acc[8 + i]), false, false); t8[i] = __uint_as_float(sw.x) + __uint_as_float(sw.y); }
#pragma unroll
  for (int i = 0; i < 4; ++i) { const u32x2 sw = __builtin_amdgcn_permlane16_swap(__float_as_uint(t8[i]), __float_as_uint(t8[4 + i]), false, false); t4[i] = __uint_as_float(sw.x) + __uint_as_float(sw.y); }
  const bool b3 = (lane & 8) != 0, b2_ = (lane & 4) != 0;
#pragma unroll
  for (int i = 0; i < 2; ++i) { const float keep = b3 ? t4[2 + i] : t4[i], send = b3 ? t4[i] : t4[2 + i]; t2[i] = keep + dpp_mov<0x128, 0xf, 0xf>(send, send); }
  float logit;
  { const float keep = b2_ ? t2[1] : t2[0], send = b2_ ? t2[0] : t2[1];
    float recv = dpp_mov<0x104, 0xf, 0x5>(send, send);
    recv = dpp_mov<0x114, 0xf, 0xa>(recv, send);
    logit = keep + recv; }
  logit += dpp_mov<0xB1, 0xf, 0xf>(logit, logit); logit += dpp_mov<0x4E, 0xf, 0xf>(logit, logit);
  const float sg = 1.0f / (1.0f + expf(-logit)), sl = sg + rbias;
  float gs;
  { const float a = sl, b2 = dpp_mov<0x124, 0xf, 0xf>(sl, sl), c = dpp_mov<0x128, 0xf, 0xf>(sl, sl), d = dpp_mov<0x12C, 0xf, 0xf>(sl, sl);
    const float lo1 = fminf(a, b2), hi1 = fmaxf(a, b2), lo2 = fminf(c, d), hi2 = fmaxf(c, d);
    gs = fmaxf(hi1, hi2) + fmaxf(fminf(hi1, hi2), fmaxf(lo1, lo2)); }
  float best = -1e30f; int grp = 0;
#pragma unroll
  for (int gI = 0; gI < 4; ++gI) { const float g = __uint_as_float(__builtin_amdgcn_readlane(__float_as_uint(gs), gI * 16)); if (g > best) { best = g; grp = gI; } }
  grp = __builtin_amdgcn_readfirstlane(grp);
  const float v0 = __uint_as_float(__builtin_amdgcn_readlane(__float_as_uint(sl), grp * 16)), v1 = __uint_as_float(__builtin_amdgcn_readlane(__float_as_uint(sl), grp * 16 + 4)),
              v2 = __uint_as_float(__builtin_amdgcn_readlane(__float_as_uint(sl), grp * 16 + 8)), v3 = __uint_as_float(__builtin_amdgcn_readlane(__float_as_uint(sl), grp * 16 + 12));
  const float s0 = __uint_as_float(__builtin_amdgcn_readlane(__float_as_uint(sg), grp * 16)), s1 = __uint_as_float(__builtin_amdgcn_readlane(__float_as_uint(sg), grp * 16 + 4)),
              s2 = __uint_as_float(__builtin_amdgcn_readlane(__float_as_uint(sg), grp * 16 + 8)), s3 = __uint_as_float(__builtin_amdgcn_readlane(__float_as_uint(sg), grp * 16 + 12));
  int i1 = 0; float b1 = v0; if (v1 > b1) { b1 = v1; i1 = 1; } if (v2 > b1) { b1 = v2; i1 = 2; } if (v3 > b1) { b1 = v3; i1 = 3; }
  int i2 = -1; float bb = -1e30f;
  if (i1 != 0 && v0 > bb) { bb = v0; i2 = 0; } if (i1 != 1 && v1 > bb) { bb = v1; i2 = 1; } if (i1 != 2 && v2 > bb) { bb = v2; i2 = 2; } if (i1 != 3 && v3 > bb) { bb = v3; i2 = 3; }
  const float g1 = i1 == 0 ? s0 : i1 == 1 ? s1 : i1 == 2 ? s2 : s3; const float g2 = i2 == 0 ? s0 : i2 == 1 ? s1 : i2 == 2 ? s2 : s3;
  if (lane == 0) { const int e1 = grp * 4 + i1, e2 = grp * 4 + i2;
    eid[row * 2] = e1; eid[row * 2 + 1] = e2; gatev[row * 2] = g1 / (g1 + g2); gatev[row * 2 + 1] = g2 / (g1 + g2);
    __hip_atomic_fetch_add(lcnt + e1, 1, __ATOMIC_RELAXED, __HIP_MEMORY_SCOPE_WORKGROUP); __hip_atomic_fetch_add(lcnt + e2, 1, __ATOMIC_RELAXED, __HIP_MEMORY_SCOPE_WORKGROUP); }
}
template <bool F32IN>
__device__ __forceinline__ void phase_ln1(const Params& p, int l, const bf16_t* __restrict__ Ybuf, LAS unsigned char* lds, bool dry) {
  const int tid = mk::otid(), lane = tid & 63, wid = tid >> 6, bid = mk::obid();
  const bool last = l == DEPTH - 1; const int ntok = last ? NLAT : NTOK;
  LAS float* rwl = (LAS float*)lds; LAS int* lcnt = (LAS int*)(lds + 65536);
  { float rv[32];
#pragma unroll
    for (int i = 0; i < 32; ++i) rv[i] = p.router_w[tid + i * NTHR];
#pragma unroll
    for (int i = 0; i < 32; ++i) { const int idx = tid + i * NTHR, d = idx >> 4, e = idx & 15; rwl[(((d >> 8) * 16 + e) * 64 + ((d >> 2) & 63)) * 4 + (d & 3)] = rv[i]; } }
  if (tid < 16) lcnt[tid] = 0;
  __syncthreads();
  const int stride = gridDim.x * 8, row0 = bid * 8 + wid;
  const float rbias = p.router_b[lane >> 2];
  if (row0 < ntok) {
    Ln1Raw<F32IN> cur, nxt; ln1_load<F32IN>(p, Ybuf, row0, lane, cur);
    for (int row = row0; row < ntok; row += stride) {
      const int rn = row + stride < ntok ? row + stride : row;
      ln1_load<F32IN>(p, Ybuf, rn, lane, nxt);
      ln1_row<F32IN>(p, l, row, lane, cur, rwl, lcnt, rbias, dry);
      cur = nxt;
    }
  }
  __syncthreads();
  if (tid < 16) wsp<int>(p, WS_BCNT)[((size_t)l * 256 + bid) * 64 + tid] = lcnt[tid];
  __syncthreads();
}
__device__ __forceinline__ void phase_scatter(const Params& p, int l, LAS unsigned char* lds) {
  const int tid = mk::otid(), bid = mk::obid(), nb = gridDim.x;
  const bool last = l == DEPTH - 1; const int ntok = last ? NLAT : NTOK;
  LAS int* tot = (LAS int*)lds; LAS int* pre = tot + 16; LAS int* base = tot + 32; LAS int* lcur = tot + 48; LAS int* offs = tot + 64; LAS int* cnts = tot + 128;
  const int* bc = wsp<int>(p, WS_BCNT) + (size_t)l * 256 * 64;
  for (int b2 = tid; b2 < nb; b2 += NTHR) { const u32x4 c0 = *(const u32x4*)(bc + b2 * 64), c1 = *(const u32x4*)(bc + b2 * 64 + 4), c2 = *(const u32x4*)(bc + b2 * 64 + 8), c3 = *(const u32x4*)(bc + b2 * 64 + 12);
    *(LAS u32x4*)(cnts + b2 * 16) = c0; *(LAS u32x4*)(cnts + b2 * 16 + 4) = c1; *(LAS u32x4*)(cnts + b2 * 16 + 8) = c2; *(LAS u32x4*)(cnts + b2 * 16 + 12) = c3; }
  __syncthreads();
  if (tid < 16) { int t = 0, pr = 0; for (int b2 = 0; b2 < nb; ++b2) { const int v = cnts[b2 * 16 + tid]; pr += b2 < bid ? v : 0; t += v; } tot[tid] = t; pre[tid] = pr; lcur[tid] = 0; }
  __syncthreads();
  if (tid == 0) { int o = 0; int* mo = wsp<int>(p, WS_MOFF) + l * 64; for (int e = 0; e < 16; ++e) { offs[e] = o; base[e] = o + pre[e]; if (bid == 0) mo[e] = o; o += (tot[e] + 255) / 256 * 256; } offs[16] = o; if (bid == 0) mo[16] = o; }
  __syncthreads();
  const int* eid = wsp<int>(p, WS_EID); int* pos = wsp<int>(p, WS_POS); int* rl = wsp<int>(p, WS_RL);
  for (int n = tid; ; n += NTHR) { const int row = bid * 8 + (n & 7) + (n >> 3) * nb * 8; if (row >= ntok) break;
    const int e1 = eid[row * 2], e2 = eid[row * 2 + 1];
    const int p1 = base[e1] + __hip_atomic_fetch_add(lcur + e1, 1, __ATOMIC_RELAXED, __HIP_MEMORY_SCOPE_WORKGROUP), p2 = base[e2] + __hip_atomic_fetch_add(lcur + e2, 1, __ATOMIC_RELAXED, __HIP_MEMORY_SCOPE_WORKGROUP);
    pos[row * 2] = p1; pos[row * 2 + 1] = p2; rl[p1] = row; rl[p2] = row; }
  if (bid == 0) for (int e = 0; e < 16; ++e) for (int q = offs[e] + tot[e] + tid; q < offs[e + 1]; q += NTHR) rl[q] = 0;
}
struct Ln2Raw { u32x2 h[4]; u32x2 y1[4], y2[4]; };
__device__ __forceinline__ void ln2_load(const Params& p, bool last, int row, int lane, int p1, int p2, Ln2Raw& r) {
  const bf16_t* Ys = wsp<bf16_t>(p, WS_SCR + SM_YS); const bf16_t* ho = hb_ptr(p, row, last);
#pragma unroll
  for (int q = 0; q < 4; ++q) { const int col = q * 256 + lane * 4; r.h[q] = *(const u32x2*)(ho + col); r.y1[q] = *(const u32x2*)(Ys + (size_t)p1 * D + col); r.y2[q] = *(const u32x2*)(Ys + (size_t)p2 * D + col); }
}
__device__ __forceinline__ void phase_ln2(const Params& p, int l, bool dry) {
  const int tid = mk::otid(), lane = tid & 63, wid = tid >> 6;
  const bool last = l == DEPTH - 1; const int ntok = last ? NLAT : NTOK;
  const int* pos = wsp<int>(p, WS_POS); const float* gatev = wsp<float>(p, WS_GATE); bf16_t* U = wsp<bf16_t>(p, WS_UO);
  const float* lg = p.ln_g + (size_t)(l * 2 + 1) * D; const float* lb = p.ln_b + (size_t)(l * 2 + 1) * D;
  const int stride = gridDim.x * 8, row0 = mk::obid() * 8 + wid;
  if (row0 >= ntok) return;
  auto clampr = [&](int r) { return r < ntok ? r : row0; };
  u32x2 pc = *(const u32x2*)(pos + 2 * row0); f32x2 gc = *(const f32x2*)(gatev + 2 * row0);
  Ln2Raw cur, nxt; ln2_load(p, last, row0, lane, (int)pc.x, (int)pc.y, cur);
  int r1 = clampr(row0 + stride);
  u32x2 pn = *(const u32x2*)(pos + 2 * r1); f32x2 gn = *(const f32x2*)(gatev + 2 * r1);
  for (int row = row0; row < ntok; row += stride) {
    ln2_load(p, last, r1, lane, (int)pn.x, (int)pn.y, nxt);
    const int r2 = clampr(row + 2 * stride);
    const u32x2 pn2 = *(const u32x2*)(pos + 2 * r2); const f32x2 gn2 = *(const f32x2*)(gatev + 2 * r2);
    bf16_t* hb = dry ? wsp<bf16_t>(p, WS_SCR + SM_XS) + (size_t)row * D : hb_ptr(p, row, false); float* hf = (dry ? wsp<float>(p, WS_SCR + SM_XS) : p.out) + (size_t)row * D; const int bi = bidx_of_row(row);
    const float* modl = wsp<float>(p, WS_MOD) + ((size_t)l * 5 + bi) * 6144;
    f32x4 v[4];
#pragma unroll
    for (int q = 0; q < 4; ++q) { const int col = q * 256 + lane * 4;
      const f32x4 a1 = (f32x4){bflo(cur.y1[q].x), bfhi(cur.y1[q].x), bflo(cur.y1[q].y), bfhi(cur.y1[q].y)}, a2 = (f32x4){bflo(cur.y2[q].x), bfhi(cur.y2[q].x), bflo(cur.y2[q].y), bfhi(cur.y2[q].y)};
      v[q] = ALPHA * h_as_f32(cur.h[q]) + *(const f32x4*)(modl + 5 * 1024 + col) * (gc[0] * a1 + gc[1] * a2); }
    ln_row(v, lg, lb, lane);
    const float* modn = wsp<float>(p, WS_MOD) + ((size_t)(last ? l : l + 1) * 5 + bi) * 6144;
#pragma unroll
    for (int q = 0; q < 4; ++q) { const int col = q * 256 + lane * 4; if (last) *(f32x4*)(hf + col) = v[q]; else store_bf16x4(hb + col, v[q]);
      if (!last) store_bf16x4(U + (size_t)row * D + col, v[q] * (1.0f + *(const f32x4*)(modn + 1024 + col)) + *(const f32x4*)(modn + col)); }
    cur = nxt; gc = gn; pn = pn2; gn = gn2; r1 = r2;
  }
}

struct SchedEvenIn { static constexpr bool GATHER = false; const bf16_t* U; const bf16_t* W; bf16_t* Pqk; bf16_t* Prw; bf16_t* Vt; int G, c;
  __device__ __forceinline__ bool next(int i, pg8::Unit& u) const { const int Lx = i * G + c; u.kind = 0;
    if (Lx < 1452) { const int grp = Lx / 44, rem = Lx % 44, pm = grp * 4 + (rem & 3), pi = rem >> 2; u.pm = pm; u.pn = pi;
      u.A = (const char*)(U + (size_t)pm * 256 * D); const int brow = pi < 4 ? pi * 256 : 1536 + (pi - 4) * 256; u.Bt = (const char*)(W + (size_t)brow * D);
      if (pi < 4) { u.out = Pqk; u.ldo = 1024; u.x1 = pi * 256; } else { u.out = Prw; u.ldo = RW_IN; u.x1 = (pi - 4) * 256; } u.x0 = pm * 256; return true; }
    if (Lx < 1452 + 264) { const int v = Lx - 1452, pmv = v & 1, pnv = v >> 1; u.pm = pmv; u.pn = pnv; u.A = (const char*)(W + (size_t)(1024 + pmv * 256) * D); u.Bt = (const char*)(U + (size_t)pnv * 256 * D);
      u.out = Vt; u.ldo = NTOK; u.x0 = pmv * 256; u.x1 = pnv * 256; return true; }
    return false; } };
struct SchedOddIn { static constexpr bool GATHER = false; const bf16_t* U; const bf16_t* W; bf16_t* Pqk; bf16_t* Vt; int G, c;
  __device__ __forceinline__ bool next(int i, pg8::Unit& u) const { const int Lx = i * G + c;
    if (Lx < 1056) { const int grp = Lx / 32, rem = Lx % 32, pm = grp * 4 + (rem & 3), pi = rem >> 2; u.pm = pm; u.pn = pi; u.kind = pm < 128 ? 1 : 0;
      u.A = (const char*)(U + (size_t)pm * 256 * D); u.Bt = (const char*)(W + (size_t)pi * 256 * D); u.out = Pqk; u.ldo = 2048; u.x0 = pm * 256; u.x1 = pi * 256; return true; }
    if (Lx < 1056 + 528) { const int v = Lx - 1056, pmv = v & 3, pnv = v >> 2; u.pm = pmv; u.pn = pnv; u.kind = 0; u.A = (const char*)(W + (size_t)(2048 + pmv * 256) * D); u.Bt = (const char*)(U + (size_t)pnv * 256 * D);
      u.out = Vt; u.ldo = NTOK; u.x0 = pmv * 256; u.x1 = pnv * 256; return true; }
    return false; } };
struct SchedOut { static constexpr bool GATHER = false; const bf16_t* O; const bf16_t* W; bf16_t* Y; int G, c;
  __device__ __forceinline__ bool next(int i, pg8::Unit& u) const { const int Lx = i * G + c; if (Lx >= 528) return false; const int pm = (Lx / 16) * 4 + (Lx & 3), pn = (Lx & 15) >> 2; u.pm = pm; u.pn = pn; u.kind = 0;
    u.A = (const char*)(O + (size_t)pm * 256 * D); u.Bt = (const char*)(W + (size_t)pn * 256 * D); u.out = Y; u.ldo = 1024; u.x0 = pm * 256; u.x1 = pn * 256; return true; } };
template <bool GATH>
struct SchedMoe { static constexpr bool GATHER = GATH; const bf16_t* A; const bf16_t* W; bf16_t* out; const LAS int* moff; const int* rl; int Kd, ldo, ncol, G, c;
  __device__ __forceinline__ bool next(int i, pg8::Unit& u) const { const int Lx = i * G + c; const int ntile = moff[16] >> 8; if (Lx >= ntile * 4) return false;
    const int pm = Lx >> 2, pn = Lx & 3; int e = 0;
#pragma unroll
    for (int j = 1; j < 16; ++j) e += (pm * 256 >= moff[j]) ? 1 : 0;
    u.pm = pm; u.pn = pn; u.kind = 0; u.A = GATH ? (const char*)A : (const char*)(A + (size_t)pm * 256 * Kd); u.rl = rl + pm * 256; u.Bt = (const char*)(W + ((size_t)e * 1024 + pn * 256) * Kd); u.out = out; u.ldo = ldo; u.x0 = pm * 256; u.x1 = pn * ncol; return true; } };

struct EpiOddIn {
  static constexpr bool PERM = true; const float* rope;
  __device__ __forceinline__ void operator()(const f32x4 (&acc)[2][2][4][2], const pg8::Unit& u, int wr, int wc, int fr, int fq) const {
    if (u.kind == 0) { pg8::EpiStoreBf16{}(acc, u, wr, wc, fr, fq); return; }
    const int row0 = u.x0 + wr * 64 + fr, col0 = u.x1 + wc * 32 + 8 * fq; const int half = wc & 1;
#pragma unroll
    for (int ai = 0; ai < 2; ++ai)
#pragma unroll
      for (int m = 0; m < 4; ++m) { const int row = row0 + ai * 128 + m * 16; const int t = row & (T - 1); const int pos = half ? (t & 63) : (t >> 6);
        const f32x4 cs0 = *(const f32x4*)(rope + (pos * 16 + 4 * fq) * 2), cs1 = *(const f32x4*)(rope + (pos * 16 + 4 * fq + 2) * 2);
        bf16_t* rowp = u.out + (size_t)row * u.ldo + col0;
#pragma unroll
        for (int bj = 0; bj < 2; ++bj) { const f32x4 v0 = acc[ai][bj][m][0], v1 = acc[ai][bj][m][1];
          u32x4 w; w.x = cvt_pk_bf16(v0[0] * cs0[0] - v0[1] * cs0[1], v0[0] * cs0[1] + v0[1] * cs0[0]); w.y = cvt_pk_bf16(v0[2] * cs0[2] - v0[3] * cs0[3], v0[2] * cs0[3] + v0[3] * cs0[2]);
          w.z = cvt_pk_bf16(v1[0] * cs1[0] - v1[1] * cs1[1], v1[0] * cs1[1] + v1[1] * cs1[0]); w.w = cvt_pk_bf16(v1[2] * cs1[2] - v1[3] * cs1[3], v1[2] * cs1[3] + v1[3] * cs1[2]);
          *(u32x4*)(rowp + bj * 128) = w; } }
  }
};
struct EpiGateUp {
  static constexpr bool PERM = true;
  __device__ __forceinline__ void operator()(const f32x4 (&acc)[2][2][4][2], const pg8::Unit& u, int wr, int wc, int fr, int fq) const {
    const int row0 = u.x0 + wr * 64 + fr, col0 = u.x1 + wc * 16 + 4 * fq;
#pragma unroll
    for (int ai = 0; ai < 2; ++ai)
#pragma unroll
      for (int m = 0; m < 4; ++m) { bf16_t* rowp = u.out + (size_t)(row0 + ai * 128 + m * 16) * u.ldo + col0;
#pragma unroll
        for (int bj = 0; bj < 2; ++bj) { const f32x4 v0 = acc[ai][bj][m][0], v1 = acc[ai][bj][m][1];
          u32x2 w; w.x = cvt_pk_bf16(siluf_(v0[0]) * v0[1], siluf_(v0[2]) * v0[3]); w.y = cvt_pk_bf16(siluf_(v1[0]) * v1[1], siluf_(v1[2]) * v1[3]);
          *(u32x2*)(rowp + bj * 64) = w; } }
  }
};
}

namespace mk {
constexpr int N_PHASES = 2 + 2 * (12 + 10);
__global__ void __launch_bounds__(NTHR, 2) mega(Params p_) {
  const Params& p = p_;
  extern __shared__ __attribute__((aligned(16))) unsigned char shm[];
  LAS unsigned char* lds = (LAS unsigned char*)shm;
  const int nb = gridDim.x;
  if (threadIdx.x == 0) *(LAS u32x4*)(lds + LDS_BARW) = (u32x4){0u, 0u, 0u, 0u};
  __syncthreads();
  XcdBarrier bar = xcd_barrier_post(wsp<unsigned>(p, WS_BAR), (volatile LAS unsigned*)(lds + LDS_BARW));
  int ph = 0;
#ifndef MK_MASK
#define MK_MASK 0xFFFFFFFFu
#endif
#ifndef MK_REP
#define MK_REP 0u
#endif
#define PHASE_BEGIN_K(k) if (((MK_MASK) >> (k)) & 1u) { Params pl_ = p_; asm volatile("" : "+s"(pl_.ws)); const Params& p = pl_; bf16_t* UO = wsp<bf16_t>(p, WS_UO); unsigned char* scr = p.ws + WS_SCR; (void)UO; (void)scr; \
    const int bid = mk::obid(); const int nrep_ = ((((MK_REP) >> (k)) & 1u) ? 2 : 1); for (int rep_ = 0; rep_ < nrep_; ++rep_) { const bool dry = rep_ + 1 < nrep_; (void)dry;
#define PHASE_END   } if (ph + 1 < N_PHASES) { XcdBarrier b_ = bar; asm volatile("" : "+s"(b_.bar), "+s"(b_.x)); xcd_barrier(b_); } } ++ph;
  bf16_t* UO = wsp<bf16_t>(p, WS_UO);
  unsigned char* scr = p.ws + WS_SCR;
  PHASE_BEGIN_K(0) phase_prologue(p, lds); PHASE_END
  PHASE_BEGIN_K(1) phase_mod0(p); PHASE_END
  for (int lp = 0; lp < 2; ++lp) {
    {
      const int l = 2 * lp;
      bf16_t* Pqk = (bf16_t*)(scr + SE_PQK); bf16_t* Vt = (bf16_t*)(scr + SE_VT); bf16_t* Prw = (bf16_t*)(scr + SE_PRW); bf16_t* Ybuf = (bf16_t*)(scr + SE_YBUF);
      rw::Bufs bf; bf.SH = (u32x2*)(scr + SE_SH); bf.DR = (unsigned*)(scr + SE_DR); bf.G = UO + 512; bf.gstride = 1024; bf.CS = (float*)(scr + SE_CS) + (size_t)lp * NTOK * 16; bf.PQ = (float*)(scr + SE_PQ); bf.SST = (float*)(scr + SE_SST); bf.Y = (bf16_t*)(scr + SE_Y); bf.Z = (bf16_t*)(scr + SE_Z);
      PHASE_BEGIN_K(2) { SchedEvenIn S{UO, wsp<bf16_t>(p, WS_WEIN) + (size_t)lp * EVEN_IN * D, Pqk, Prw, Vt, nb, bid}; pg8::gemm_phase(lds, D, S, pg8::EpiStoreBf16{}); } PHASE_END
      PHASE_BEGIN_K(3) {
#ifdef MK_P3
        if (!(dry && MK_P3 == 2))
#endif
        for (int u = bid; u < 1024 + 32; u += nb) { int b, h, rq; if (u < 1024) { b = u >> 8; h = (u >> 5) & 7; rq = u & 31; } else { const int v = u - 1024; b = v >> 3; h = v & 7; rq = -1; }
          natt::na_attn_unit(Pqk, Vt, p.na_rpb + ((size_t)lp * 8 + h) * 465, UO, b, h, rq, lds); }
        const int pb = (bid + nb / 2) % nb;
#ifdef MK_P3
        if (!(dry && MK_P3 == 1))
#endif
        for (int t = pb; t < NTOK / 16; t += nb) rw::prep_tile(Prw, p.shift_w + (size_t)lp * 3 * RW_IN, p.rw_w0 + lp * 1024, wsp<bf16_t>(p, WS_WLT) + (size_t)lp * 196608, p.rw_a0 + lp * 1024, p.rw_k_k + lp * 512, p.rw_k_a + lp * 512, p.rw_r_k + lp * 512, bf, t, (LAS float*)lds); } PHASE_END
      PHASE_BEGIN_K(4) for (int u = bid * 8 + (mk::otid() >> 6); u < rw::NCHAIN * rw::NCH; u += nb * 8) rw::scan_unit(bf, p.rw_k_a + lp * 512, u / rw::NCH, u % rw::NCH, (LAS float*)lds + (mk::otid() >> 6) * 4096); PHASE_END
      PHASE_BEGIN_K(5) for (int c = bid; c < rw::NCHAIN * 4; c += nb) rw::propagate_chain(bf, c >> 2, c & 3, (LAS float*)lds); PHASE_END
      PHASE_BEGIN_K(6) for (int u = bid * 8 + (mk::otid() >> 6); u < rw::NCHAIN * (rw::NCH - 1); u += nb * 8) rw::corr_unit(bf, u / (rw::NCH - 1), 1 + u % (rw::NCH - 1)); PHASE_END
      PHASE_BEGIN_K(7) rw::finish_phase<8>(bf, p.rw_gn_g + lp * 512, p.rw_gn_b + lp * 512, UO); PHASE_END
      PHASE_BEGIN_K(8) { SchedOut S{UO, wsp<bf16_t>(p, WS_WEOUT) + (size_t)lp * D * D, Ybuf, nb, bid}; pg8::gemm_phase(lds, D, S, pg8::EpiStoreBf16{}); __syncthreads(); cvt_experts(p, l, (LAS float*)lds, 528 - 2 * nb > 0 ? 528 - 2 * nb : 0); } PHASE_END
      PHASE_BEGIN_K(9) if (l == 0) phase_ln1<true>(p, l, Ybuf, lds, dry); else phase_ln1<false>(p, l, Ybuf, lds, dry); PHASE_END
      PHASE_BEGIN_K(10) phase_scatter(p, l, lds); PHASE_END
      PHASE_BEGIN_K(11) { LAS int* mo = (LAS int*)(lds + LDS_MISC); { const int tq = mk::otid(); if (tq < 17) mo[tq] = wsp<int>(p, WS_MOFF)[l * 64 + tq]; } __syncthreads();
        SchedMoe<true> S{UO, wsp<bf16_t>(p, WS_WGU), (bf16_t*)(scr + SM_HE), mo, wsp<int>(p, WS_RL), D, DE, 128, nb, bid}; pg8::gemm_phase(lds, D, S, EpiGateUp{}); } PHASE_END
      PHASE_BEGIN_K(12) { LAS int* mo = (LAS int*)(lds + LDS_MISC); { const int tq = mk::otid(); if (tq < 17) mo[tq] = wsp<int>(p, WS_MOFF)[l * 64 + tq]; } __syncthreads();
        SchedMoe<false> S{(bf16_t*)(scr + SM_HE), wsp<bf16_t>(p, WS_WDN), (bf16_t*)(scr + SM_YS), mo, nullptr, DE, D, 256, nb, bid}; pg8::gemm_phase(lds, DE, S, pg8::EpiStoreBf16{}); } PHASE_END
      PHASE_BEGIN_K(13) phase_ln2(p, l, dry); PHASE_END
    }
    {
      const int l = 2 * lp + 1; const bool last = l == DEPTH - 1;
      bf16_t* Pqk = (bf16_t*)(scr + SO_PQK); bf16_t* Vt = (bf16_t*)(scr + SO_VT); bf16_t* O12 = (bf16_t*)(scr + SO_O12); bf16_t* Ybuf = (bf16_t*)(scr + SO_YBUF);
      PHASE_BEGIN_K(14) { SchedOddIn S{UO, wsp<bf16_t>(p, WS_WOIN) + (size_t)lp * ODD_IN * D, Pqk, Vt, nb, bid}; pg8::gemm_phase(lds, D, S, EpiOddIn{wsp<float>(p, WS_ROPE)}); } PHASE_END
      float* KN = wsp<float>(p, WS_KN) + (size_t)lp * 256 * 32;
      PHASE_BEGIN_K(23) for (int g = bid; g < 256; g += nb) att::knorm_group(Pqk, KN, g, (LAS float*)lds); PHASE_END
      PHASE_BEGIN_K(15) for (int ui = bid; ui < 2048 + (last ? 0 : 64); ui += nb) { int b, hh, q0, nlat; const int u = (nb == 256 && ui < 2048) ? ((((ui >> 8) * 8 + (bid & 7)) << 5) | (bid >> 3)) : ui;
        if (u < 2048) { b = u >> 9; hh = (u >> 5) & 15; q0 = b * T + (u & 31) * 256; nlat = T; } else { const int v = u - 2048; b = v >> 4; hh = v & 15; q0 = NLAT + b * L; nlat = 0; }
        const bool st = __builtin_amdgcn_sqrtf(att::nmax2_of(KN, b, hh, 0) * att::nmax2_of(KN, b, hh, 1)) * 1.001f <= 60.0f;
#ifdef MK_ABL
        if (dry) att::diff_attn_unit<true, MK_ABL>(Pqk, Vt, O12, hh, q0, b * T, nlat, NLAT + b * L, lds); else
#endif
        if (st) att::diff_attn_unit<true>(Pqk, Vt, O12, hh, q0, b * T, nlat, NLAT + b * L, lds); else att::diff_attn_unit<false>(Pqk, Vt, O12, hh, q0, b * T, nlat, NLAT + b * L, lds); } PHASE_END
      PHASE_BEGIN_K(16) { float d1 = 0.f, d2 = 0.f; for (int i = 0; i < 64; ++i) { d1 += p.da_lq1[lp * 64 + i] * p.da_lk1[lp * 64 + i]; d2 += p.da_lq2[lp * 64 + i] * p.da_lk2[lp * 64 + i]; }
        const float li = 0.8f - 0.6f * expf(-0.3f * (float)l), lam = expf(d1) - expf(d2) + li;
        const int tq = mk::otid(); for (int r4 = bid; r4 < (last ? NLAT : NTOK) / 4; r4 += nb) att::diff_combine_rows4(O12, p.da_subln_g + lp * 128, lam, 1.0f - li, UO, r4 * 4, tq >> 6, tq & 63); } PHASE_END
      PHASE_BEGIN_K(17) { SchedOut S{UO, wsp<bf16_t>(p, WS_WOOUT) + (size_t)lp * D * D, Ybuf, nb, bid}; pg8::gemm_phase(lds, D, S, pg8::EpiStoreBf16{}); __syncthreads(); cvt_experts(p, l, (LAS float*)lds, 528 - 2 * nb > 0 ? 528 - 2 * nb : 0); } PHASE_END
      PHASE_BEGIN_K(18) phase_ln1<false>(p, l, Ybuf, lds, dry); PHASE_END
      PHASE_BEGIN_K(19) phase_scatter(p, l, lds); PHASE_END
      PHASE_BEGIN_K(20) { LAS int* mo = (LAS int*)(lds + LDS_MISC); { const int tq = mk::otid(); if (tq < 17) mo[tq] = wsp<int>(p, WS_MOFF)[l * 64 + tq]; } __syncthreads();
        SchedMoe<true> S{UO, wsp<bf16_t>(p, WS_WGU), (bf16_t*)(scr + SM_HE), mo, wsp<int>(p, WS_RL), D, DE, 128, nb, bid}; pg8::gemm_phase(lds, D, S, EpiGateUp{}); } PHASE_END
      PHASE_BEGIN_K(21) { LAS int* mo = (LAS int*)(lds + LDS_MISC); { const int tq = mk::otid(); if (tq < 17) mo[tq] = wsp<int>(p, WS_MOFF)[l * 64 + tq]; } __syncthreads();
        SchedMoe<false> S{(bf16_t*)(scr + SM_HE), wsp<bf16_t>(p, WS_WDN), (bf16_t*)(scr + SM_YS), mo, nullptr, DE, D, 256, nb, bid}; pg8::gemm_phase(lds, DE, S, pg8::EpiStoreBf16{}); } PHASE_END
      PHASE_BEGIN_K(22) phase_ln2(p, l, dry); PHASE_END
    }
  }
#undef PHASE_BEGIN_K
#undef PHASE_END
}
}

#ifndef MK_SINGLE_LAUNCH
#define MK_SINGLE_LAUNCH 1
#endif
extern "C" void kernel_launch(void* const* d_in, const int* in_sizes, int n_in, void* d_out, int out_size, void* d_ws, size_t ws_size, hipStream_t stream) {
  using namespace mk;
  static int grid = 0;
  if (grid == 0) {
    if (n_in != 34 || out_size != NLAT * D || ws_size < WS_END) { fprintf(stderr, "kernel_launch: unexpected shapes (n_in %d out %d ws %zu need %zu)\n", n_in, out_size, ws_size, (size_t)WS_END); grid = -1; return; }
    if (hipFuncSetAttribute((const void*)mega, hipFuncAttributeMaxDynamicSharedMemorySize, LDS_BYTES) != hipSuccess) { grid = -1; return; }
    int dev = 0, cus = 0, per_cu = 0;
    if (hipGetDevice(&dev) != hipSuccess || hipDeviceGetAttribute(&cus, hipDeviceAttributeMultiprocessorCount, dev) != hipSuccess) { grid = -1; return; }
    if (hipOccupancyMaxActiveBlocksPerMultiprocessor(&per_cu, (const void*)mega, NTHR, LDS_BYTES) != hipSuccess || per_cu < 1) { fprintf(stderr, "kernel_launch: occupancy query says %d\n", per_cu); }
    (void)hipGetLastError();
    grid = cus;
  }
  if (grid < 0) return;
  (void)hipMemsetAsync((char*)d_ws + WS_BAR, 0, (size_t)XCD_BAR_WORDS * 4, stream);
  Params p{};
  const float** pp = (const float**)&p;
  for (int i = 0; i < 34; ++i) pp[i] = (const float*)d_in[i];
  p.out = (float*)d_out; p.ws = (unsigned char*)d_ws;
#if MK_SINGLE_LAUNCH
  p.ph_lo = 0; p.ph_hi = N_PHASES;
  hipLaunchKernelGGL(mega, dim3(grid), dim3(NTHR), LDS_BYTES, stream, p);
#else
  for (int ph = 0; ph < N_PHASES; ++ph) { p.ph_lo = ph; p.ph_hi = ph + 1; hipLaunchKernelGGL(mega, dim3(grid), dim3(NTHR), LDS_BYTES, stream, p); }
#endif
}
```

```cpp
#include <hip/hip_runtime.h>
#include <stdint.h>
#include <stdio.h>

typedef unsigned short bf16_t;
typedef short bf16x8 __attribute__((ext_vector_type(8)));
typedef float f32x4 __attribute__((ext_vector_type(4)));
typedef float f32x2 __attribute__((ext_vector_type(2)));
typedef float f32x16 __attribute__((ext_vector_type(16)));
typedef unsigned u32x4 __attribute__((ext_vector_type(4)));
typedef unsigned u32x2 __attribute__((ext_vector_type(2)));
#define LAS __attribute__((address_space(3)))

namespace mk {
constexpr int B = 4, T = 8192, L = 256, D = 1024, NLAT = B * T, NCTX = B * L, NTOK = NLAT + NCTX;
constexpr int DEPTH = 4, EVEN_IN = 3328, ODD_IN = 3072, RW_OFF = 1536, RW_IN = 1792, NE = 16, DE = 512;
constexpr float ALPHA = 1.681792830507429f, LN_EPS = 1e-5f;
constexpr int NTHR = 512, LDS_BYTES = 147456;
constexpr int MOE_TILES = 280, MOE_ROWS = MOE_TILES * 256;

typedef __bf16 bf16x2v __attribute__((ext_vector_type(2)));
__device__ __forceinline__ unsigned cvt_pk_bf16(float lo, float hi) { const f32x2 v = {lo, hi}; return __builtin_bit_cast(unsigned, __builtin_convertvector(v, bf16x2v)); }
__device__ __forceinline__ unsigned cvt_pk_bf16_v(float lo, float hi) { return cvt_pk_bf16(lo, hi); }
template <int V> struct IntC { static constexpr int value = V; };
__device__ __forceinline__ float bf2f(bf16_t b) { return __uint_as_float(((unsigned)b) << 16); }
__device__ __forceinline__ float bflo(unsigned w) { return __uint_as_float(w << 16); }
__device__ __forceinline__ float bfhi(unsigned w) { return __uint_as_float(w & 0xffff0000u); }
__device__ __forceinline__ bf16_t f2bf(float f) { return (bf16_t)(cvt_pk_bf16(f, 0.f) & 0xffffu); }
__device__ __forceinline__ float sigmoidf_(float x) { return 1.0f / (1.0f + __expf(-x)); }
__device__ __forceinline__ float siluf_(float x) { return x / (1.0f + __expf(-x)); }
__device__ __forceinline__ float wave_sum(float v) {
#pragma unroll
  for (int o = 32; o > 0; o >>= 1) v += __shfl_xor(v, o);
  return v;
}
template <int CTRL, int RM, int BM> __device__ __forceinline__ float dpp_mov(float old, float v) { return __int_as_float(__builtin_amdgcn_update_dpp(__float_as_int(old), __float_as_int(v), CTRL, RM, BM, false)); }
__device__ __forceinline__ float wave_sum_u(float v) {
  v += dpp_mov<0xB1, 0xf, 0xf>(v, v);
  v += dpp_mov<0x4E, 0xf, 0xf>(v, v);
  v += dpp_mov<0x141, 0xf, 0xf>(v, v);
  v += dpp_mov<0x140, 0xf, 0xf>(v, v);
  v += dpp_mov<0x142, 0xa, 0xf>(0.f, v);
  v += dpp_mov<0x143, 0xc, 0xf>(0.f, v);
  return __int_as_float(__builtin_amdgcn_readlane(__float_as_int(v), 63));
}
__device__ __forceinline__ float wave_max_u(float v) {
  v = fmaxf(v, dpp_mov<0xB1, 0xf, 0xf>(v, v));
  v = fmaxf(v, dpp_mov<0x4E, 0xf, 0xf>(v, v));
  v = fmaxf(v, dpp_mov<0x141, 0xf, 0xf>(v, v));
  v = fmaxf(v, dpp_mov<0x140, 0xf, 0xf>(v, v));
  v = fmaxf(v, dpp_mov<0x142, 0xa, 0xf>(0.f, v));
  v = fmaxf(v, dpp_mov<0x143, 0xc, 0xf>(0.f, v));
  return __int_as_float(__builtin_amdgcn_readlane(__float_as_int(v), 63));
}
__device__ __forceinline__ f32x16 zero16() { float z = 0.f; asm volatile("" : "+v"(z)); f32x16 r;
#pragma unroll
  for (int i = 0; i < 16; ++i) r[i] = z;
  return r; }
__device__ __forceinline__ int otid() { int t = threadIdx.x; asm volatile("" : "+v"(t)); return t; }
__device__ __forceinline__ int obid() { int b = blockIdx.x; asm volatile("" : "+s"(b)); return b; }
__device__ __forceinline__ int bidx_of_row(int row) { return row < NLAT ? row / T : 4; }
}

#include <vector>

#define XB_TMO      128
#define XB_XCNT(j)  (256  + 64 * (j))
#define XB_XSUB(j)  (1280 + 64 * (j))
#define XB_XGEN(j)  (2304 + 64 * (j))
#define XB_TOP      3328
#define XB_TOPGEN   3392
#define XCD_BAR_WORDS 3456
#define XB_SPIN_CAP (1u << 18)
#define LAS __attribute__((address_space(3)))

__device__ __forceinline__ unsigned xb_ld(unsigned* p)              { return __hip_atomic_load(p, __ATOMIC_RELAXED, __HIP_MEMORY_SCOPE_AGENT); }
__device__ __forceinline__ unsigned xb_add(unsigned* p, unsigned v) { return __hip_atomic_fetch_add(p, v, __ATOMIC_RELAXED, __HIP_MEMORY_SCOPE_AGENT); }
__device__ __forceinline__ unsigned xb_xcc_id() { return (unsigned)__builtin_amdgcn_s_getreg((3 << 11) | 20) & 0xFu; }
#define XB_SPIN(cond, bar) do { unsigned _sp = 0; while (cond) { __builtin_amdgcn_s_sleep(1); \
    if ((++_sp & 255u) == 0u) { if (xb_ld(&(bar)[XB_TMO])) break; if (_sp > XB_SPIN_CAP) { atomicAdd(&(bar)[XB_TMO], 1u); break; } } } } while (0)

struct XcdBarrier {
    unsigned* bar; unsigned x;
    volatile LAS unsigned* st;
};

__device__ __forceinline__ XcdBarrier xcd_barrier_post(unsigned* bar, volatile LAS unsigned* st) {
    XcdBarrier b; b.bar = bar; b.x = xb_xcc_id(); b.st = st;
    if (threadIdx.x == 0) (void)xb_add(&bar[XB_XCNT(b.x)], 1u);
    return b;
}
__device__ __forceinline__ void xcd_barrier_complete(unsigned* bar, unsigned x, unsigned& nloc, unsigned& nx) {
    const unsigned G = gridDim.x * gridDim.y * gridDim.z;
    unsigned sum, cnt, mine, sp = 0u;
    for (;;) {
        sum = 0u; cnt = 0u; mine = 0u;
#pragma unroll
        for (unsigned j = 0; j < 16; ++j) { const unsigned c = xb_ld(&bar[XB_XCNT(j)]); sum += c; cnt += (c > 0u) ? 1u : 0u; mine = (j == x) ? c : mine; }
        if (sum == G) break;
        __builtin_amdgcn_s_sleep(1);
        if ((++sp & 255u) == 0u) { if (xb_ld(&bar[XB_TMO])) break; if (sp > XB_SPIN_CAP) { atomicAdd(&bar[XB_TMO], 1u); break; } }
    }
    nloc = mine > 0u ? mine : 1u; nx = cnt > 0u ? cnt : 1u;
}

__device__ __forceinline__ void xcd_barrier(const XcdBarrier& b) {
    asm volatile("s_waitcnt vmcnt(0)" ::: "memory");
    __syncthreads();
    if (threadIdx.x == 0) {
        unsigned* bar = b.bar;
        __builtin_amdgcn_s_waitcnt(0);
        unsigned nloc = b.st[0], nx = b.st[1];
        if (nloc == 0u) { xcd_barrier_complete(bar, b.x, nloc, nx); b.st[0] = nloc; b.st[1] = nx; }
        const unsigned old = xb_add(&bar[XB_XSUB(b.x)], 1u);
        const unsigned gen = old / nloc;
        if (old + 1u == (gen + 1u) * nloc) {
            __builtin_amdgcn_fence(__ATOMIC_RELEASE, "agent");
            asm volatile("s_waitcnt vmcnt(0)" ::: "memory");
            const unsigned og = xb_add(&bar[XB_TOP], 1u);
            const unsigned tg = og / nx;
            if (og + 1u == (tg + 1u) * nx) xb_add(&bar[XB_TOPGEN], 1u);
            else XB_SPIN(xb_ld(&bar[XB_TOPGEN]) == tg, bar);
            __builtin_amdgcn_fence(__ATOMIC_ACQUIRE, "agent");
            xb_add(&bar[XB_XGEN(b.x)], 1u);
            asm volatile("s_waitcnt vmcnt(0)" ::: "memory");
        } else {
            XB_SPIN(xb_ld(&bar[XB_XGEN(b.x)]) == gen, bar);
            __builtin_amdgcn_fence(__ATOMIC_ACQUIRE, "agent");
            asm volatile("s_waitcnt vmcnt(0)" ::: "memory");
        }
    }
    __syncthreads();
}

namespace pg8 {
using mk::cvt_pk_bf16;
constexpr int BM = 256, BK = 64, HALF = 128, HTB = HALF * BK * 2  , STAGE_BYTES = 8 * HTB;
__host__ __device__ __forceinline__ int lds_byte(int r, int c) { const int st = (r >> 4) * 2 + (c >> 5), rr = r & 15, cc = c & 31, ob = rr * 64 + cc * 2; return st * 1024 + (ob ^ (((ob >> 9) & 1) << 5)); }
__host__ __device__ __forceinline__ void stage_rc(int b, int& R, int& C) { const int st = b / 1024, sb = b % 1024, swz = sb ^ (((sb >> 9) & 1) << 5); R = (st >> 1) * 16 + swz / 64; C = (st & 1) * 32 + (swz % 64) / 2; }
__host__ __device__ __forceinline__ int perm32(int rho) { const int n = rho >> 4, i = rho & 15; return 8 * (i >> 2) + 4 * n + (i & 3); }

struct Unit { const char* A; const char* Bt; bf16_t* out; const int* rl; int pm, pn, x0, x1, ldo, kind; };

template <class Epi, class Sched>
__device__ __forceinline__ void gemm_phase(LAS unsigned char* lds, const int K, const Sched& S, const Epi& E) {
    const int tid = mk::otid(), wid = __builtin_amdgcn_readfirstlane(tid >> 6), lane = tid & 63, wr = wid >> 2, wc = wid & 3, fr = lane & 15, fq = lane >> 4;
    const int nt = K / BK;
    constexpr bool GATH = Sched::GATHER;
    unsigned voffA[2], voffB[2]; int Rl[2], Cl[2];
#pragma unroll
    for (int i = 0; i < 2; ++i) { int R, C; stage_rc(tid * 16 + i * 8192, R, C); const int Rb = Epi::PERM ? ((R & ~31) + perm32(R & 31)) : R; Rl[i] = R; Cl[i] = C;
        voffA[i] = (unsigned)(R * K + C) * 2u; voffB[i] = (unsigned)(Rb * K + C) * 2u; }
    unsigned roC[2][2], roN[2][2];
    (void)Rl; (void)Cl;
    const size_t kstep = (size_t)(BK * 2);
    const size_t hstep = (size_t)HALF * K * 2;
    const unsigned ldsw = (unsigned)wid * 1024u;
    const int aoff = lds_byte(wr * 64 + fr, fq * 8), boff = lds_byte(wc * 32 + fr, fq * 8);
#define PG8_SA(b, h) (((b) * 2 + (h)) * HTB)
#define PG8_SB(b, h) ((4 + (b) * 2 + (h)) * HTB)
#define PG8_STAGE(bufoff, gbase, voff) do { _Pragma("unroll") for (int _i = 0; _i < 2; ++_i) \
        __builtin_amdgcn_global_load_lds((const unsigned*)((const char*)(gbase) + (voff)[_i]), (LAS unsigned*)(lds + (bufoff) + ldsw + _i * 8192), 16, 0, 0); } while (0)
#define PG8_STAGE_A(bufoff, gbase, h, ro) do { if constexpr (GATH) { _Pragma("unroll") for (int _i = 0; _i < 2; ++_i) \
        __builtin_amdgcn_global_load_lds((const unsigned*)((const char*)(gbase) + (ro)[h][_i]), (LAS unsigned*)(lds + (bufoff) + ldsw + _i * 8192), 16, 0, 0); } \
      else { PG8_STAGE(bufoff, (const char*)(gbase) + (h) * hstep, voffA); } } while (0)
#define PG8_LOAD_RO(u, ro) do { _Pragma("unroll") for (int _h = 0; _h < 2; ++_h) _Pragma("unroll") for (int _i = 0; _i < 2; ++_i) \
        (ro)[_h][_i] = (unsigned)(u).rl[Rl[_i] + _h * 128] * (unsigned)(K * 2) + (unsigned)(Cl[_i] * 2); } while (0)
#define PG8_LDA(dst, b, h) do { _Pragma("unroll") for (int m = 0; m < 4; ++m) _Pragma("unroll") for (int k = 0; k < 2; ++k) dst[m][k] = *(const LAS bf16x8*)(lds + PG8_SA(b, h) + aoff + m * 2048 + k * 1024); } while (0)
#define PG8_LDB(dst, b, h) do { _Pragma("unroll") for (int n = 0; n < 2; ++n) _Pragma("unroll") for (int k = 0; k < 2; ++k) dst[n][k] = *(const LAS bf16x8*)(lds + PG8_SB(b, h) + boff + n * 2048 + k * 1024); } while (0)
#define PG8_MMA(ai, bj, At, Bt) do { __builtin_amdgcn_s_setprio(1); _Pragma("unroll") for (int m = 0; m < 4; ++m) _Pragma("unroll") for (int n = 0; n < 2; ++n) _Pragma("unroll") for (int k = 0; k < 2; ++k) \
        acc[ai][bj][m][n] = __builtin_amdgcn_mfma_f32_16x16x32_bf16(Bt[n][k], At[m][k], acc[ai][bj][m][n], 0, 0, 0); __builtin_amdgcn_s_setprio(0); } while (0)
#define PG8_WAIT_V(n) asm volatile("s_waitcnt vmcnt(" #n ")" ::: "memory")
#define PG8_WAIT_L(n) asm volatile("s_waitcnt lgkmcnt(" #n ")" ::: "memory")
#define PG8_BAR __builtin_amdgcn_s_barrier()
#define PG8_SCHED __builtin_amdgcn_sched_barrier(0)
    Unit cur, nxt; int ui = 0;
    if (!S.next(0, cur)) return;
    f32x4 acc[2][2][4][2];
#pragma unroll
    for (int a = 0; a < 2; ++a)
#pragma unroll
        for (int b = 0; b < 2; ++b)
#pragma unroll
            for (int m = 0; m < 4; ++m)
#pragma unroll
                for (int n = 0; n < 2; ++n) acc[a][b][m][n] = (f32x4){0.f, 0.f, 0.f, 0.f};
    bf16x8 At[4][2], B0[2][2], B1[2][2];
    const char* cA = cur.A; const char* cB = cur.Bt;
    if constexpr (GATH) { PG8_LOAD_RO(cur, roC); }
    PG8_STAGE(PG8_SB(0, 0), cB, voffB); PG8_STAGE_A(PG8_SA(0, 0), cA, 0, roC); PG8_STAGE(PG8_SB(0, 1), cB + hstep, voffB); PG8_STAGE_A(PG8_SA(0, 1), cA, 1, roC);
    if (wr == 1) PG8_BAR;
    PG8_WAIT_V(4); PG8_BAR;
    PG8_STAGE(PG8_SB(1, 0), cB + kstep, voffB); PG8_STAGE_A(PG8_SA(1, 0), cA + kstep, 0, roC); PG8_STAGE(PG8_SB(1, 1), cB + hstep + kstep, voffB);
    PG8_WAIT_V(6); PG8_BAR;
    for (;;) {
        const bool has_next = S.next(ui + 1, nxt);
        const char* nA = has_next ? nxt.A : cA; const char* nB = has_next ? nxt.Bt : cB;
        if constexpr (GATH) { if (has_next) { PG8_LOAD_RO(nxt, roN); } else { _Pragma("unroll") for (int _h = 0; _h < 2; ++_h) _Pragma("unroll") for (int _i = 0; _i < 2; ++_i) roN[_h][_i] = roC[_h][_i]; } }
        for (int t = 0; t < nt; t += 2) {
            const bool last = (t == nt - 2);
            const char* a1 = cA + (size_t)(t + 1) * kstep;
            const char* a2 = last ? nA : cA + (size_t)(t + 2) * kstep; const char* b2 = last ? nB : cB + (size_t)(t + 2) * kstep;
            const char* a3 = a2 + kstep; const char* b3 = b2 + kstep;
            unsigned ro2[2][2];
            if constexpr (GATH) { _Pragma("unroll") for (int _h = 0; _h < 2; ++_h) _Pragma("unroll") for (int _i = 0; _i < 2; ++_i) ro2[_h][_i] = last ? roN[_h][_i] : roC[_h][_i]; }
            (void)ro2;
            PG8_LDB(B0, 0, 0); PG8_SCHED; PG8_LDA(At, 0, 0); PG8_STAGE_A(PG8_SA(1, 1), a1, 1, roC);
            PG8_WAIT_L(8); PG8_BAR; PG8_WAIT_L(0); PG8_MMA(0, 0, At, B0); PG8_BAR; PG8_SCHED;
            PG8_LDB(B1, 0, 1); PG8_STAGE(PG8_SB(0, 0), b2, voffB);
            PG8_BAR; PG8_WAIT_L(0); PG8_MMA(0, 1, At, B1); PG8_BAR;
            PG8_LDA(At, 0, 1); PG8_STAGE_A(PG8_SA(0, 0), a2, 0, ro2);
            PG8_BAR; PG8_WAIT_L(0); PG8_MMA(1, 0, At, B0); PG8_BAR; PG8_SCHED;
            PG8_STAGE(PG8_SB(0, 1), b2 + hstep, voffB);
            PG8_WAIT_V(6); PG8_BAR; PG8_MMA(1, 1, At, B1); PG8_BAR;
            PG8_LDB(B0, 1, 0); PG8_SCHED; PG8_LDA(At, 1, 0); PG8_STAGE_A(PG8_SA(0, 1), a2, 1, ro2);
            PG8_WAIT_L(8); PG8_BAR; PG8_WAIT_L(0); PG8_MMA(0, 0, At, B0); PG8_BAR; PG8_SCHED;
            PG8_LDB(B1, 1, 1); PG8_STAGE(PG8_SB(1, 0), b3, voffB);
            PG8_BAR; PG8_WAIT_L(0); PG8_MMA(0, 1, At, B1); PG8_BAR;
            PG8_LDA(At, 1, 1); PG8_STAGE_A(PG8_SA(1, 0), a3, 0, ro2);
            PG8_BAR; PG8_WAIT_L(0); PG8_MMA(1, 0, At, B0); PG8_BAR; PG8_SCHED;
            PG8_STAGE(PG8_SB(1, 1), b3 + hstep, voffB);
            PG8_WAIT_V(6); PG8_BAR; PG8_MMA(1, 1, At, B1); PG8_BAR;
        }
        E(acc, cur, wr, wc, fr, fq);
        if (!has_next) break;
#pragma unroll
        for (int a = 0; a < 2; ++a)
#pragma unroll
            for (int b = 0; b < 2; ++b)
#pragma unroll
                for (int m = 0; m < 4; ++m)
#pragma unroll
                    for (int n = 0; n < 2; ++n) acc[a][b][m][n] = (f32x4){0.f, 0.f, 0.f, 0.f};
        cur = nxt; cA = nA; cB = nB; ++ui;
        if constexpr (GATH) { _Pragma("unroll") for (int _h = 0; _h < 2; ++_h) _Pragma("unroll") for (int _i = 0; _i < 2; ++_i) roC[_h][_i] = roN[_h][_i]; }
    }
    PG8_WAIT_V(0);
    if (wr == 0) PG8_BAR;
    PG8_BAR;
#undef PG8_SA
#undef PG8_SB
#undef PG8_STAGE
#undef PG8_STAGE_A
#undef PG8_LOAD_RO
#undef PG8_LDA
#undef PG8_LDB
#undef PG8_MMA
#undef PG8_WAIT_V
#undef PG8_WAIT_L
#undef PG8_BAR
#undef PG8_SCHED
}

struct EpiStoreBf16 {
    static constexpr bool PERM = true;
    __device__ __forceinline__ void operator()(const f32x4 (&acc)[2][2][4][2], const Unit& u, int wr, int wc, int fr, int fq) const {
        bf16_t* O = u.out; const int ldc = u.ldo;
        const int row0 = u.x0 + wr * 64 + fr, col0 = u.x1 + wc * 32 + 8 * fq;
#pragma unroll
        for (int ai = 0; ai < 2; ++ai)
#pragma unroll
            for (int m = 0; m < 4; ++m) { bf16_t* rowp = O + (size_t)(row0 + ai * HALF + m * 16) * ldc + col0;
#pragma unroll
                for (int bj = 0; bj < 2; ++bj) { const f32x4 v0 = acc[ai][bj][m][0], v1 = acc[ai][bj][m][1];
                    u32x4 w; w.x = cvt_pk_bf16(v0[0], v0[1]); w.y = cvt_pk_bf16(v0[2], v0[3]); w.z = cvt_pk_bf16(v1[0], v1[1]); w.w = cvt_pk_bf16(v1[2], v1[3]);
                    *(u32x4*)(rowp + bj * HALF) = w; } }
    }
};
}

namespace mk {
struct NMapId { int off; __device__ __forceinline__ int operator()(int n) const { return n + off; } __device__ __forceinline__ float scl(int) const { return 1.0f; } };
struct NMapInterleave { int which; __device__ __forceinline__ int operator()(int n) const { return 2 * n + which; } __device__ __forceinline__ float scl(int) const { return 1.0f; } };
struct NMapRope { __device__ __forceinline__ int operator()(int n) const { if (n >= 2048) return n; const int ch = n >> 6, c = n & 63, half = c >> 5, w = c & 31, z = w >> 4, i = w & 15; return ch * 64 + half * 32 + 2 * i + z; }
  __device__ __forceinline__ float scl(int n) const { return n < 1024 ? 0.125f * 1.4426950408889634f : 1.0f; } };

template <class NMap>
__device__ __forceinline__ void cvt_tile(const float* __restrict__ src, int ldsrc, int K, bf16_t* __restrict__ dst, int k0, int n0, const NMap& nmap, LAS float* tile) {
  const int t = mk::otid();
  { const int k = t >> 3, c = (t & 7) * 8; const float* p = src + (size_t)(k0 + k) * ldsrc + n0 + c;
    const f32x4 a = *(const f32x4*)p, b = *(const f32x4*)(p + 4);
    LAS float* q = tile + k * 65 + c; q[0] = a[0]; q[1] = a[1]; q[2] = a[2]; q[3] = a[3]; q[4] = b[0]; q[5] = b[1]; q[6] = b[2]; q[7] = b[3]; }
  __syncthreads();
  { const int n = t >> 3, kc = (t & 7) * 8; const LAS float* q = tile + kc * 65 + n; const float sc = nmap.scl(n0 + n);
    u32x4 w; w.x = cvt_pk_bf16(q[0] * sc, q[65] * sc); w.y = cvt_pk_bf16(q[130] * sc, q[195] * sc); w.z = cvt_pk_bf16(q[260] * sc, q[325] * sc); w.w = cvt_pk_bf16(q[390] * sc, q[455] * sc);
    *(u32x4*)(dst + (size_t)nmap(n0 + n) * K + k0 + kc) = w; }
  __syncthreads();
}
template <class NMap>
__device__ __forceinline__ int cvt_matrix(const float* src, int ldsrc, int K, int N, bf16_t* dst, const NMap& nmap, LAS float* tile, int ubase, int bid, int nblk) {
  const int nkt = K / 64, nnt = N / 64, tot = nkt * nnt;
  int first = ubase + ((bid - ubase % nblk) + nblk) % nblk;
  for (int u = first; u < ubase + tot; u += nblk) { const int v = u - ubase; cvt_tile(src, ldsrc, K, dst, (v / nnt) * 64, (v % nnt) * 64, nmap, tile); }
  return tot;
}
}

namespace att {
using namespace mk;
constexpr int KB_BYTES = 64 * 128, VB_BYTES = 128 * 128, TILE_BYTES = KB_BYTES + VB_BYTES, DA_RING = 4, DA_LDS = DA_RING * TILE_BYTES;
__device__ __forceinline__ int pi32(int r) { return (r & ~12) | ((r & 4) << 1) | ((r & 8) >> 1); }
__device__ __forceinline__ int swz(int row, int chunk) { return row * 128 + ((chunk ^ ((row >> 1) & 7)) << 4); }
__device__ __forceinline__ int crow(int r, int hi) { return (r & 3) + 8 * (r >> 2) + 4 * hi; }

__device__ __forceinline__ float sumsq8(u32x4 w) { return (bflo(w.x) * bflo(w.x) + bfhi(w.x) * bfhi(w.x)) + (bflo(w.y) * bflo(w.y) + bfhi(w.y) * bfhi(w.y)) + (bflo(w.z) * bflo(w.z) + bfhi(w.z) * bfhi(w.z)) + (bflo(w.w) * bflo(w.w) + bfhi(w.w) * bfhi(w.w)); }
__device__ __forceinline__ void knorm_group(const bf16_t* __restrict__ Pqk, float* __restrict__ KN, int g, LAS float* red) {
  const int tid = mk::otid(), wid = tid >> 6, lane = tid & 63;
  float mx = 0.f, mq = 0.f;
  for (int i0 = 0; i0 < 160; i0 += 32) {
    u32x4 a[4], b[4], c[4], d[4];
#pragma unroll
    for (int j = 0; j < 4; ++j) { int i = i0 + j * 8 + wid; i = i < 132 ? i : wid; const int row = i < 128 ? g * 128 + i : NLAT + g * 4 + (i - 128);
      const bf16_t* kp = Pqk + (size_t)row * 2048 + 1024 + lane * 16; a[j] = *(const u32x4*)kp; b[j] = *(const u32x4*)(kp + 8); c[j] = *(const u32x4*)(kp - 1024); d[j] = *(const u32x4*)(kp - 1024 + 8); }
#pragma unroll
    for (int j = 0; j < 4; ++j) { float s = sumsq8(a[j]) + sumsq8(b[j]); s += dpp_mov<0xB1, 0xf, 0xf>(s, s); s += dpp_mov<0x4E, 0xf, 0xf>(s, s); mx = fmaxf(mx, s);
      float q = sumsq8(c[j]) + sumsq8(d[j]); q += dpp_mov<0xB1, 0xf, 0xf>(q, q); q += dpp_mov<0x4E, 0xf, 0xf>(q, q); mq = fmaxf(mq, q); }
  }
  if ((lane & 3) == 0) { red[wid * 32 + (lane >> 2)] = mx; red[wid * 32 + 16 + (lane >> 2)] = mq; }
  __syncthreads();
  if (tid < 32) { float m = red[tid];
#pragma unroll
    for (int w = 1; w < 8; ++w) m = fmaxf(m, red[w * 32 + tid]);
    KN[g * 32 + tid] = m; }
  __syncthreads();
}
__device__ __forceinline__ float nmax2_of(const float* __restrict__ KN, int b, int hh, int which) {
  return wave_max_u(KN[(b * 64 + (mk::otid() & 63)) * 32 + which * 16 + hh]);
}

template <bool STATIC, int ABL = 0>
__device__ __forceinline__ void diff_attn_unit(const bf16_t* __restrict__ Pqk, const bf16_t* __restrict__ Vt, bf16_t* __restrict__ O12, int hh, int q0, int klat0, int nlat, int kctx0, LAS unsigned char* lds) {
  const int tid = mk::otid(), wid = tid >> 6, lane = tid & 63, r = lane & 31, hi = lane >> 5;
  const int NT = (nlat + L) / 64, NTL = nlat / 64;
  const int wv = __builtin_amdgcn_readfirstlane(wid);
  const int drow = wv * 8 + (lane >> 3), dch = (lane & 7) ^ ((drow >> 1) & 7);
  const unsigned koff = (unsigned)(drow * 2048 + 1024 + hh * 64 + dch * 8) * 2u;
  const unsigned voff = (unsigned)(((hh >> 1) * 128 + drow) * NTOK + dch * 8) * 2u;
  bf16x8 qf[4];
  { const bf16_t* qp = Pqk + (size_t)(q0 + wid * 32 + r) * 2048 + hh * 64 + hi * 8;
#pragma unroll
    for (int ks = 0; ks < 4; ++ks) qf[ks] = *(const bf16x8*)(qp + ks * 16); }
  const unsigned kaddr0 = (unsigned)(pi32(r) * 128 + ((hi ^ ((pi32(r) >> 1) & 7)) << 4));
  const unsigned vaddr0 = (unsigned)(r * 128 + ((hi ^ ((r >> 1) & 7)) << 4)) + KB_BYTES;
  f32x16 o[4];
#pragma unroll
  for (int vb = 0; vb < 4; ++vb)
#pragma unroll
    for (int i = 0; i < 16; ++i) o[vb][i] = 0.f;
  float l_run = 0.f;
#define DA_DMA(t) do { const int tok = (t) < NTL ? klat0 + (t) * 64 : kctx0 + ((t) - NTL) * 64; LAS unsigned char* b_ = lds + ((t) & 3) * TILE_BYTES + wv * 1024; \
    const char* kt_ = (const char*)Pqk + (size_t)tok * 4096; const char* vt_ = (const char*)Vt + (size_t)tok * 2; \
    __builtin_amdgcn_global_load_lds((const unsigned*)(kt_ + koff), (LAS unsigned*)b_, 16, 0, 0); \
    __builtin_amdgcn_global_load_lds((const unsigned*)(vt_ + voff), (LAS unsigned*)(b_ + KB_BYTES), 16, 0, 0); \
    __builtin_amdgcn_global_load_lds((const unsigned*)(vt_ + (size_t)64 * NTOK * 2 + voff), (LAS unsigned*)(b_ + KB_BYTES + 8192), 16, 0, 0); } while (0)
#define DA_WAITV(n) asm volatile("s_waitcnt vmcnt(" #n ")" ::: "memory")
#define DA_PAIR_BEGIN(t) if (!(ABL & 8) && (t) + 2 < NT) { DA_DMA((t) + 2); DA_DMA((t) + 3); }
#define DA_SLOT(tt) const unsigned sb_ = (unsigned)(((tt) & 3) * TILE_BYTES); const LAS unsigned char* kb_ = lds + (kaddr0 + sb_); const LAS unsigned char* vb_ = lds + (vaddr0 + sb_)
#define DA_PAIR_END() do { DA_WAITV(0); asm volatile("s_waitcnt lgkmcnt(0)" ::: "memory"); if (!(ABL & 16)) __builtin_amdgcn_s_barrier(); } while (0)
  DA_DMA(0); DA_DMA(1);
  DA_WAITV(0); __builtin_amdgcn_s_barrier();
#define DA_XOR(ptr, x) ((const LAS unsigned char*)((unsigned)(size_t)(ptr) ^ (unsigned)(x)))
#define DA_KFRAG(ks) const LAS unsigned char* kp_ = DA_XOR(kb_, (ks) << 5); const bf16x8 a0 = (ABL & 2) ? qf[ks] : *(const LAS bf16x8*)kp_, a1 = (ABL & 2) ? qf[(ks) ^ 1] : *(const LAS bf16x8*)(kp_ + 4096)
#define DA_VFRAGS() bf16x8 va[4][4]; \
    _Pragma("unroll") for (int c4 = 0; c4 < 4; ++c4) { const LAS unsigned char* vp_ = DA_XOR(vb_, c4 << 5); \
      _Pragma("unroll") for (int vb = 0; vb < 4; ++vb) va[vb][c4] = (ABL & 1) ? qf[c4 ^ (vb & 3)] : *(const LAS bf16x8*)(vp_ + vb * 4096); }
#define DA_PACK_PV() bf16x8 pf[2][2]; \
    _Pragma("unroll") for (int s = 0; s < 2; ++s) { u32x4 w0, w1; \
      w0.x = cvt_pk_bf16(s0[8 * s + 0], s0[8 * s + 1]); w0.y = cvt_pk_bf16(s0[8 * s + 2], s0[8 * s + 3]); w0.z = cvt_pk_bf16(s0[8 * s + 4], s0[8 * s + 5]); w0.w = cvt_pk_bf16(s0[8 * s + 6], s0[8 * s + 7]); \
      w1.x = cvt_pk_bf16(s1[8 * s + 0], s1[8 * s + 1]); w1.y = cvt_pk_bf16(s1[8 * s + 2], s1[8 * s + 3]); w1.z = cvt_pk_bf16(s1[8 * s + 4], s1[8 * s + 5]); w1.w = cvt_pk_bf16(s1[8 * s + 6], s1[8 * s + 7]); \
      pf[0][s] = __builtin_bit_cast(bf16x8, w0); pf[1][s] = __builtin_bit_cast(bf16x8, w1); } \
    _Pragma("unroll") for (int vb = 0; vb < 4; ++vb) _Pragma("unroll") for (int kb = 0; kb < 2; ++kb) _Pragma("unroll") for (int s = 0; s < 2; ++s) \
      o[vb] = __builtin_amdgcn_mfma_f32_32x32x16_bf16(va[vb][kb * 2 + s], pf[kb][s], o[vb], 0, 0, 0)
  if constexpr (STATIC) {
    for (int t = 0; t < NT; t += 2) {
      DA_PAIR_BEGIN(t);
#pragma unroll
      for (int u = 0; u < 2; ++u) {
        DA_SLOT(t + u);
        f32x16 s0, s1;
#pragma unroll
        for (int i = 0; i < 16; ++i) { s0[i] = 0.f; s1[i] = 0.f; }
#pragma unroll
        for (int ks = 0; ks < 4; ++ks) { DA_KFRAG(ks); s0 = __builtin_amdgcn_mfma_f32_32x32x16_bf16(a0, qf[ks], s0, 0, 0, 0); s1 = __builtin_amdgcn_mfma_f32_32x32x16_bf16(a1, qf[ks], s1, 0, 0, 0); }
        DA_VFRAGS();
        if constexpr ((ABL & 32) != 0) {
          l_run += s0[0] + s1[0];
#pragma unroll
          for (int vb = 0; vb < 4; ++vb)
#pragma unroll
            for (int c4 = 0; c4 < 4; ++c4) o[vb] = __builtin_amdgcn_mfma_f32_32x32x16_bf16(va[vb][c4], qf[c4], o[vb], 0, 0, 0);
        } else {
          float ps = 0.f;
#pragma unroll
          for (int i = 0; i < 16; ++i) { s0[i] = (ABL & 4) ? s0[i] : __builtin_amdgcn_exp2f(s0[i]); ps += s0[i]; }
#pragma unroll
          for (int i = 0; i < 16; ++i) { s1[i] = (ABL & 4) ? s1[i] : __builtin_amdgcn_exp2f(s1[i]); ps += s1[i]; }
          l_run += ps;
          DA_PACK_PV();
        }
      }
      DA_PAIR_END();
    }
  } else {
    constexpr float THR = 8.0f * 1.4426950408889634f;
    float m_run = -1e30f;
    for (int t = 0; t < NT; ++t) {
      if (!(t & 1)) DA_PAIR_BEGIN(t);
      DA_SLOT(t);
      f32x16 s0 = zero16(), s1 = zero16();
#pragma unroll
      for (int ks = 0; ks < 4; ++ks) { DA_KFRAG(ks); s0 = __builtin_amdgcn_mfma_f32_32x32x16_bf16(a0, qf[ks], s0, 0, 0, 0); s1 = __builtin_amdgcn_mfma_f32_32x32x16_bf16(a1, qf[ks], s1, 0, 0, 0); }
      float mx = fmaxf(s0[0], s1[0]);
#pragma unroll
      for (int i = 1; i < 16; ++i) mx = fmaxf(mx, fmaxf(s0[i], s1[i]));
      { const u32x2 sw = __builtin_amdgcn_permlane32_swap(__float_as_uint(mx), __float_as_uint(mx), false, false); mx = fmaxf(__uint_as_float(sw.x), __uint_as_float(sw.y)); }
      float alpha = 1.0f;
      if (!__all(mx - m_run <= THR)) {
        const float m_new = fmaxf(m_run, mx);
        alpha = __builtin_amdgcn_exp2f(m_run - m_new);
        m_run = m_new;
#pragma unroll
        for (int vb = 0; vb < 4; ++vb)
#pragma unroll
          for (int i = 0; i < 16; ++i) o[vb][i] *= alpha;
      }
      float ps = 0.f;
#pragma unroll
      for (int i = 0; i < 16; ++i) { s0[i] = __builtin_amdgcn_exp2f(s0[i] - m_run); ps += s0[i]; }
#pragma unroll
      for (int i = 0; i < 16; ++i) { s1[i] = __builtin_amdgcn_exp2f(s1[i] - m_run); ps += s1[i]; }
      l_run = l_run * alpha + ps;
      __builtin_amdgcn_sched_barrier(0);
      DA_VFRAGS();
      DA_PACK_PV();
      if (t & 1) DA_PAIR_END();
    }
  }
#undef DA_KFRAG
#undef DA_XOR
#undef DA_VFRAGS
#undef DA_PACK_PV
#undef DA_DMA
#undef DA_WAITV
#undef DA_PAIR_BEGIN
#undef DA_PAIR_END
#undef DA_SLOT
  float l_tot; { const u32x2 sw = __builtin_amdgcn_permlane32_swap(__float_as_uint(l_run), __float_as_uint(l_run), false, false); l_tot = __uint_as_float(sw.x) + __uint_as_float(sw.y); }
  const float inv = 1.0f / l_tot;
  const int te = mk::otid();
  bf16_t* op = O12 + (size_t)(q0 + (te >> 6) * 32 + (te & 31)) * 2048 + hh * 128 + 4 * ((te >> 5) & 1);
#pragma unroll
  for (int vb = 0; vb < 4; ++vb)
#pragma unroll
    for (int g = 0; g < 4; ++g) {
      u32x2 w; w.x = cvt_pk_bf16(o[vb][4 * g] * inv, o[vb][4 * g + 1] * inv); w.y = cvt_pk_bf16(o[vb][4 * g + 2] * inv, o[vb][4 * g + 3] * inv);
      *(u32x2*)(op + vb * 32 + 8 * g) = w;
    }
}

__device__ __forceinline__ void diff_combine_rows4(const bf16_t* __restrict__ O12, const float* __restrict__ subln_g, float lam, float oml, bf16_t* __restrict__ O, int row0, int h, int lane) {
  unsigned a[4], b[4];
#pragma unroll
  for (int i = 0; i < 4; ++i) { a[i] = *(const unsigned*)(O12 + (size_t)(row0 + i) * 2048 + (2 * h) * 128 + 2 * lane); b[i] = *(const unsigned*)(O12 + (size_t)(row0 + i) * 2048 + (2 * h + 1) * 128 + 2 * lane); }
  const float g0 = subln_g[2 * lane], g1 = subln_g[2 * lane + 1];
#pragma unroll
  for (int i = 0; i < 4; ++i) {
    const float x0 = bflo(a[i]) - lam * bflo(b[i]), x1 = bfhi(a[i]) - lam * bfhi(b[i]);
    const float ss = wave_sum_u(x0 * x0 + x1 * x1);
    const float rs = rsqrtf(ss * (1.0f / 128.0f) + 1e-5f) * oml;
    *(unsigned*)(O + (size_t)(row0 + i) * 1024 + h * 128 + 2 * lane) = cvt_pk_bf16(x0 * rs * g0, x1 * rs * g1);
  }
}
}

namespace natt {
using namespace mk;
using att::pi32; using att::swz;
constexpr int TB = 64 * 128;
constexpr int NA_LDS = 4 * TB + 2048;
__device__ __forceinline__ void na_attn_unit(const bf16_t* __restrict__ Pe, const bf16_t* __restrict__ Vte, const float* __restrict__ rpb_h, bf16_t* __restrict__ O, int b, int h, int rq, LAS unsigned char* lds) {
  const int tid = mk::otid(), wid = tid >> 6, lane = tid & 63, r = lane & 31, hi = lane >> 5;
  constexpr float LOG2E = 1.4426950408889634f;
  LAS float* sb = (LAS float*)(lds + 4 * TB);
  for (int i = tid; i < 465; i += NTHR) sb[i] = rpb_h[i];
  const bool is_ctx = rq < 0;
  int qrow = 0, qcol = 0, qtok, rs_q = 0, cs_q = 0, span0 = 0, wlo = 0, whi = -1, lo = 0, ntl = 0;
  if (!is_ctx) {
    const int r0 = rq * 4, ra = r0 + (wid >> 2) * 2;
    qrow = ra + (r >> 4); qcol = (wid & 3) * 16 + (r & 15); qtok = b * T + qrow * 64 + qcol;
    rs_q = min(max(qrow - 4, 0), 120); cs_q = min(max(qcol - 8, 0), 48);
    span0 = min(max((wid & 3) * 16 - 8, 0), 32);
    wlo = min(max(ra - 4, 0), 120); whi = min(max(ra - 3, 0), 120) + 7;
    lo = min(max(r0 - 4, 0), 120); const int hi_ = min(max(r0 - 1, 0), 120) + 7; ntl = hi_ - lo + 1;
  } else qtok = NLAT + b * L + wid * 32 + r;
  const int NT = ntl + 4;
  const int srow = tid >> 3, sch = tid & 7;
  const bf16_t* kbase = Pe + 512 + h * 64 + sch * 8;
  const bf16_t* vbase = Vte + (size_t)(h * 64 + srow) * NTOK + sch * 8;
  const int sdst = swz(srow, sch);
  bf16x8 qf[4];
  { const bf16_t* qp = Pe + (size_t)qtok * 1024 + h * 64 + hi * 8;
#pragma unroll
    for (int ks = 0; ks < 4; ++ks) qf[ks] = *(const bf16x8*)(qp + ks * 16); }
  const int kx = (pi32(r) >> 1) & 7, vx = (r >> 1) & 7;
  const int ka_loc = (span0 + pi32(r)) * 128; const int kx_loc = ((span0 + pi32(r)) >> 1) & 7;
  f32x16 o[2];
#pragma unroll
  for (int vb = 0; vb < 2; ++vb)
#pragma unroll
    for (int i = 0; i < 16; ++i) o[vb][i] = 0.f;
  float m_run = -1e30f, l_run = 0.f;
  u32x4 kreg, vreg;
#define NA_LOAD(t) do { const int tok = (t) < ntl ? b * T + (lo + (t)) * 64 : NLAT + b * L + ((t) - ntl) * 64; \
    kreg = *(const u32x4*)(kbase + (size_t)(tok + srow) * 1024); vreg = *(const u32x4*)(vbase + tok); } while (0)
#define NA_WRITE(bufi) do { *(LAS u32x4*)(lds + (bufi) * TB + sdst) = kreg; *(LAS u32x4*)(lds + 2 * TB + (bufi) * TB + sdst) = vreg; } while (0)
  NA_LOAD(0); NA_WRITE(0); __syncthreads();
  for (int t = 0; t < NT; ++t) {
    const bool more = t + 1 < NT;
    if (more) NA_LOAD(t + 1);
    const LAS unsigned char* kb_ = lds + (t & 1) * TB; const LAS unsigned char* vb_ = lds + 2 * TB + (t & 1) * TB;
    const bool local = t < ntl; const int kr = lo + t;
    const bool active = !local || (kr >= wlo && kr <= whi);
    if (active) {
      f32x16 s0, s1;
#pragma unroll
      for (int i = 0; i < 16; ++i) { s0[i] = 0.f; s1[i] = 0.f; }
      if (local) {
#pragma unroll
        for (int ks = 0; ks < 4; ++ks) {
          const bf16x8 a0 = *(const LAS bf16x8*)(kb_ + ka_loc + (((ks * 2 + hi) ^ kx_loc) << 4));
          s0 = __builtin_amdgcn_mfma_f32_32x32x16_bf16(a0, qf[ks], s0, 0, 0, 0);
        }
        const bool row_ok = kr >= rs_q && kr < rs_q + 8; const int dr31 = (kr - qrow + 7) * 31;
#pragma unroll
        for (int i = 0; i < 16; ++i) {
          const int kc = span0 + (i & 7) + 8 * hi + 16 * (i >> 3);
          const bool ok = row_ok && kc >= cs_q && kc < cs_q + 16;
          const int bi = ok ? dr31 + (kc - qcol + 15) : 0;
          const float bv = sb[bi];
          s0[i] = ok ? fmaf(s0[i], 0.125f, bv) : -1e30f; s1[i] = -1e30f;
        }
      } else {
#pragma unroll
        for (int ks = 0; ks < 4; ++ks) {
          const int ch = ((ks * 2 + hi) ^ kx) << 4;
          const bf16x8 a0 = *(const LAS bf16x8*)(kb_ + pi32(r) * 128 + ch), a1 = *(const LAS bf16x8*)(kb_ + (32 + pi32(r)) * 128 + ch);
          s0 = __builtin_amdgcn_mfma_f32_32x32x16_bf16(a0, qf[ks], s0, 0, 0, 0);
          s1 = __builtin_amdgcn_mfma_f32_32x32x16_bf16(a1, qf[ks], s1, 0, 0, 0);
        }
#pragma unroll
        for (int i = 0; i < 16; ++i) { s0[i] *= 0.125f; s1[i] *= 0.125f; }
      }
      float mx = s0[0];
#pragma unroll
      for (int i = 1; i < 16; ++i) mx = fmaxf(mx, s0[i]);
#pragma unroll
      for (int i = 0; i < 16; ++i) mx = fmaxf(mx, s1[i]);
      { const u32x2 sw = __builtin_amdgcn_permlane32_swap(__float_as_uint(mx), __float_as_uint(mx), false, false); mx = fmaxf(__uint_as_float(sw.x), __uint_as_float(sw.y)); }
      const float m_new = fmaxf(m_run, mx);
      const float alpha = __builtin_amdgcn_exp2f((m_run - m_new) * LOG2E);
      m_run = m_new;
      const float mc = -m_new * LOG2E;
      float ps = 0.f;
#pragma unroll
      for (int i = 0; i < 16; ++i) { const float p = s0[i] > -1e29f ? __builtin_amdgcn_exp2f(fmaf(s0[i], LOG2E, mc)) : 0.f; s0[i] = p; ps += p; }
#pragma unroll
      for (int i = 0; i < 16; ++i) { const float p = s1[i] > -1e29f ? __builtin_amdgcn_exp2f(fmaf(s1[i], LOG2E, mc)) : 0.f; s1[i] = p; ps += p; }
      l_run = l_run * alpha + ps;
      if (__any(alpha < 1.0f)) {
#pragma unroll
        for (int vb = 0; vb < 2; ++vb)
#pragma unroll
          for (int i = 0; i < 16; ++i) o[vb][i] *= alpha;
      }
      bf16x8 pf[2][2];
#pragma unroll
      for (int s = 0; s < 2; ++s) {
        u32x4 w0, w1;
        w0.x = cvt_pk_bf16(s0[8 * s + 0], s0[8 * s + 1]); w0.y = cvt_pk_bf16(s0[8 * s + 2], s0[8 * s + 3]); w0.z = cvt_pk_bf16(s0[8 * s + 4], s0[8 * s + 5]); w0.w = cvt_pk_bf16(s0[8 * s + 6], s0[8 * s + 7]);
        w1.x = cvt_pk_bf16(s1[8 * s + 0], s1[8 * s + 1]); w1.y = cvt_pk_bf16(s1[8 * s + 2], s1[8 * s + 3]); w1.z = cvt_pk_bf16(s1[8 * s + 4], s1[8 * s + 5]); w1.w = cvt_pk_bf16(s1[8 * s + 6], s1[8 * s + 7]);
        pf[0][s] = __builtin_bit_cast(bf16x8, w0); pf[1][s] = __builtin_bit_cast(bf16x8, w1);
      }
      const int cbase = local ? (span0 >> 3) : 0;
#pragma unroll
      for (int vb = 0; vb < 2; ++vb) {
        const LAS unsigned char* vrow = vb_ + (vb * 32 + r) * 128;
#pragma unroll
        for (int s = 0; s < 2; ++s) {
          const bf16x8 a = *(const LAS bf16x8*)(vrow + (((cbase + 2 * s + hi) ^ vx) << 4));
          o[vb] = __builtin_amdgcn_mfma_f32_32x32x16_bf16(a, pf[0][s], o[vb], 0, 0, 0);
        }
        if (!local) {
#pragma unroll
          for (int s = 0; s < 2; ++s) {
            const bf16x8 a = *(const LAS bf16x8*)(vrow + (((4 + 2 * s + hi) ^ vx) << 4));
            o[vb] = __builtin_amdgcn_mfma_f32_32x32x16_bf16(a, pf[1][s], o[vb], 0, 0, 0);
          }
        }
      }
    }
    if (more) NA_WRITE((t + 1) & 1);
    __syncthreads();
  }
#undef NA_LOAD
#undef NA_WRITE
  float l_tot; { const u32x2 sw = __builtin_amdgcn_permlane32_swap(__float_as_uint(l_run), __float_as_uint(l_run), false, false); l_tot = __uint_as_float(sw.x) + __uint_as_float(sw.y); }
  const float inv = 1.0f / l_tot;
  bf16_t* op = O + (size_t)qtok * 1024 + h * 64 + 4 * hi;
#pragma unroll
  for (int vb = 0; vb < 2; ++vb)
#pragma unroll
    for (int g = 0; g < 4; ++g) {
      u32x2 w; w.x = cvt_pk_bf16(o[vb][4 * g] * inv, o[vb][4 * g + 1] * inv); w.y = cvt_pk_bf16(o[vb][4 * g + 2] * inv, o[vb][4 * g + 3] * inv);
      *(u32x2*)(op + vb * 32 + 8 * g) = w;
    }
}
}

namespace rw {
using namespace mk;
constexpr int NSTEP = L + T, NCH = 32, CL = NSTEP / NCH;
constexpr int NCHAIN = 2 * B * 8;
constexpr float LOG2E = 1.4426950408889634f;
struct Bufs {
  u32x2* SH;
  unsigned* DR;
  bf16_t* G; int gstride;
  float* CS;
  float* PQ;
  float* SST;
  bf16_t* Y;
  bf16_t* Z;
};

constexpr int XPITCH = 528;
template <int KS> struct LoraW { bf16x8 w[KS][4]; };
template <int KS>
__device__ __forceinline__ void lora_load(const bf16_t* __restrict__ W, int h, int lane, LoraW<KS>& f) {
  const int fr = lane & 15, fq = lane >> 4;
#pragma unroll
  for (int ks = 0; ks < KS; ++ks)
#pragma unroll
    for (int nb = 0; nb < 4; ++nb) f.w[ks][nb] = *(const bf16x8*)(W + (size_t)(h * 64 + nb * 16 + fr) * (KS * 32) + ks * 32 + fq * 8);
}
template <int KS>
__device__ __forceinline__ void lora_mma(const LAS unsigned char* xb, int xcol0, const LoraW<KS>& f, int lane, LAS float* tw, float (&out)[16]) {
  const int fr = lane & 15, fq = lane >> 4;
  f32x4 acc[4];
#pragma unroll
  for (int nb = 0; nb < 4; ++nb) { float z = 0.f; asm volatile("" : "+v"(z)); acc[nb] = (f32x4){z, z, z, z}; }
#pragma unroll
  for (int ks = 0; ks < KS; ++ks) {
    const bf16x8 xf = *(const LAS bf16x8*)(xb + fr * XPITCH + (xcol0 + ks * 32 + fq * 8) * 2);
#pragma unroll
    for (int nb = 0; nb < 4; ++nb) acc[nb] = __builtin_amdgcn_mfma_f32_16x16x32_bf16(xf, f.w[ks][nb], acc[nb], 0, 0, 0);
  }
#pragma unroll
  for (int nb = 0; nb < 4; ++nb) *(LAS f32x4*)(tw + (nb * 16 + fr) * 16 + fq * 4) = acc[nb];
  __builtin_amdgcn_wave_barrier(); asm volatile("s_waitcnt lgkmcnt(0)" ::: "memory"); __builtin_amdgcn_wave_barrier();
#pragma unroll
  for (int q = 0; q < 4; ++q) { const f32x4 v = *(const LAS f32x4*)(tw + lane * 16 + q * 4); out[q * 4] = v[0]; out[q * 4 + 1] = v[1]; out[q * 4 + 2] = v[2]; out[q * 4 + 3] = v[3]; }
  __builtin_amdgcn_wave_barrier(); asm volatile("s_waitcnt lgkmcnt(0)" ::: "memory"); __builtin_amdgcn_wave_barrier();
}
__device__ __forceinline__ void prep_tile(const bf16_t* __restrict__ Prw, const float* __restrict__ cw, const float* __restrict__ w0, const bf16_t* __restrict__ WLT, const float* __restrict__ a0,
                                          const float* __restrict__ k_k, const float* __restrict__ k_a, const float* __restrict__ r_k,
                                          const Bufs& bf, int tile, LAS float* xs  ) {
  const int c = mk::otid(), lane = c & 63, h = c >> 6;
  const int row0 = tile * 16;
  int lo, hi;
  if (row0 < NLAT) { lo = (row0 / T) * T; hi = lo + T - 1; } else { lo = NLAT + ((row0 - NLAT) / L) * L; hi = lo + L - 1; }
  bf16_t rraw[18], kraw[18], vraw[18];
#pragma unroll
  for (int j = 0; j < 18; ++j) { int rr_ = row0 - 1 + j; rr_ = rr_ < lo ? lo : (rr_ > hi ? hi : rr_); const bf16_t* q = Prw + (size_t)rr_ * RW_IN + c; rraw[j] = q[0]; kraw[j] = q[512]; vraw[j] = q[1024]; }
  LoraW<2> wd0, wd1; LoraW<4> wg;
  lora_load<2>(WLT, h, lane, wd0); lora_load<2>(WLT + 32768, h, lane, wd1);
#define RW_CONV(dst, col) do { const float c0 = cw[(col)], c1 = cw[RW_IN + (col)], c2 = cw[2 * RW_IN + (col)]; const bf16_t* p = Prw + (col); \
    bf16_t raw[18]; \
    _Pragma("unroll") for (int j = 0; j < 18; ++j) { int rr = row0 - 1 + j; rr = rr < lo ? lo : (rr > hi ? hi : rr); raw[j] = p[(size_t)rr * RW_IN]; } \
    float pm = row0 > lo ? bf2f(raw[0]) : 0.f, pc = bf2f(raw[1]); \
    _Pragma("unroll") for (int tt = 0; tt < 16; ++tt) { const float pn = (row0 + tt + 1 <= hi) ? bf2f(raw[tt + 2]) : 0.f; dst[tt] = pm * c0 + pc * c1 + pn * c2; pm = pc; pc = pn; } } while (0)
  if (c < 256) {
    float xv[16]; RW_CONV(xv, 1536 + c);
#pragma unroll
    for (int tt = 0; tt < 16; ++tt) { float v = xv[tt]; if (c < 64) v = tanhf(v); else if (c >= 128) v = sigmoidf_(v); *(LAS bf16_t*)((LAS unsigned char*)xs + tt * XPITCH + c * 2) = f2bf(v); }
  }
  __syncthreads();
  const LAS unsigned char* xb = (const LAS unsigned char*)xs; LAS float* tw = xs + 20480 + h * 1024;
  const float w00 = w0[c], w01 = w0[512 + c], a00 = a0[c], a01 = a0[512 + c], kkc = k_k[c], kac = k_a[c], rkc = r_k[c];
  float e0[16], e1[16];
  {
    float aw0[16], aw1[16];
    lora_mma<2>(xb, 0, wd0, lane, tw, aw0); lora_mma<2>(xb, 0, wd1, lane, tw, aw1);
    lora_load<2>(WLT + 2 * 32768, h, lane, wd0); lora_load<2>(WLT + 3 * 32768, h, lane, wd1);
#pragma unroll
    for (int tt = 0; tt < 16; ++tt) {
      e0[tt] = 0.6065306597126334f * __builtin_amdgcn_rcpf(1.0f + __expf(-(w00 + aw0[tt])));
      e1[tt] = 0.6065306597126334f * __builtin_amdgcn_rcpf(1.0f + __expf(-(w01 + aw1[tt])));
    }
  }
  LAS float* asl = xs + 256 * 16;
  {
    float aa0[16], aa1[16];
    lora_mma<2>(xb, 64, wd0, lane, tw, aa0); lora_mma<2>(xb, 64, wd1, lane, tw, aa1);
    lora_load<4>(WLT + 4 * 32768, h, lane, wg);
#pragma unroll
    for (int tt = 0; tt < 16; ++tt) { const unsigned d0 = cvt_pk_bf16(e0[tt], sigmoidf_(a00 + aa0[tt])), d1 = cvt_pk_bf16(e1[tt], sigmoidf_(a01 + aa1[tt]));
      bf.DR[((size_t)(row0 + tt)) * 512 + c] = d0; bf.DR[((size_t)NTOK + row0 + tt) * 512 + c] = d1; asl[tt * 512 + c] = bfhi(d0); asl[(16 + tt) * 512 + c] = bfhi(d1); }
  }
  {
    float ag[16];
    lora_mma<4>(xb, 128, wg, lane, tw, ag);
#pragma unroll
    for (int tt = 0; tt < 16; ++tt) bf.G[(size_t)(row0 + tt) * bf.gstride + c] = f2bf(ag[tt]);
  }
#undef RW_CONV
  const float cr0 = cw[c], cr1 = cw[RW_IN + c], cr2 = cw[2 * RW_IN + c], ck0 = cw[512 + c], ck1 = cw[RW_IN + 512 + c], ck2 = cw[2 * RW_IN + 512 + c], cv0 = cw[1024 + c], cv1 = cw[RW_IN + 1024 + c], cv2 = cw[2 * RW_IN + 1024 + c];
  float rm = row0 > lo ? bf2f(rraw[0]) : 0.f, km = row0 > lo ? bf2f(kraw[0]) : 0.f, vm = row0 > lo ? bf2f(vraw[0]) : 0.f;
  float rc = bf2f(rraw[1]), kc = bf2f(kraw[1]), vc = bf2f(vraw[1]);
#pragma unroll
  for (int tt = 0; tt < 16; ++tt) {
    const int row = row0 + tt;
    const bool has_n = row + 1 <= hi;
    const float rn = has_n ? bf2f(rraw[tt + 2]) : 0.f, kn = has_n ? bf2f(kraw[tt + 2]) : 0.f, vn = has_n ? bf2f(vraw[tt + 2]) : 0.f;
    const float rv = rm * cr0 + rc * cr1 + rn * cr2, kvv = km * ck0 + kc * ck1 + kn * ck2, vvv = vm * cv0 + vc * cv1 + vn * cv2;
    rm = rc; rc = rn; km = kc; kc = kn; vm = vc; vc = vn;
    float kk = kvv * kkc; const float nrm = sqrtf(wave_sum_u(kk * kk)); kk = kk * __builtin_amdgcn_rcpf(fmaxf(nrm, 1e-12f));
    u32x2 sh; sh.x = cvt_pk_bf16(rv, kvv); sh.y = cvt_pk_bf16(kk, vvv);
    bf.SH[(size_t)row * 512 + c] = sh;
    const float rq = bflo(sh.x), kq = bfhi(sh.x);
    const float cb0 = wave_sum_u(rq * kq * (1.0f + (asl[tt * 512 + c] - 1.0f) * kac) * rkc), cb1 = wave_sum_u(rq * kq * (1.0f + (asl[(16 + tt) * 512 + c] - 1.0f) * kac) * rkc);
    if (lane == 0) { bf.CS[(size_t)row * 16 + h] = cb0; bf.CS[(size_t)row * 16 + 8 + h] = cb1; }
  }
  __syncthreads();
}

struct StepRaw { u32x2 s; unsigned d; };
__device__ __forceinline__ int scan_row(int dir, int b, int p) {
  if (p < L) return NLAT + b * L + (dir ? (L - 1 - p) : p);
  const int q = p - L; return b * T + (dir ? (T - 1 - q) : q);
}
__device__ __forceinline__ void scan_unit(const Bufs& bf, const float* __restrict__ k_a, int chain, int chunk, LAS float* wl) {
  const int lane = mk::otid() & 63, r = lane & 31, hi = lane >> 5;
  const int dir = chain >> 5, b = (chain >> 3) & 3, h = chain & 7, ch = h * 64 + lane;
  const float kac = k_a[ch];
  f32x16 TS[2][2], TP[2][2];
#pragma unroll
  for (int rb = 0; rb < 2; ++rb)
#pragma unroll
    for (int cb = 0; cb < 2; ++cb)
#pragma unroll
      for (int q = 0; q < 16; ++q) { TS[rb][cb][q] = 0.f; TP[rb][cb][q] = (32 * rb + (q & 3) + 8 * (q >> 2) + 4 * hi == 32 * cb + r) ? 1.f : 0.f; }
  LAS unsigned char* wb = (LAS unsigned char*)wl;
  const LAS unsigned char* xrow = wb + (lane & 15) * 128 + 8 * hi;
  LAS float* Gl = wl + 1024;
  const int p0 = chunk * CL;
  float Dl = 1.f;
#define RW_FRAG(base, rb, s2) ([&]() { const u32x2 lo_ = *(const LAS u32x2*)((base) + (32 * (rb) + 16 * (s2)) * 2), hi_ = *(const LAS u32x2*)((base) + (32 * (rb) + 16 * (s2) + 8) * 2); \
      return __builtin_bit_cast(bf16x8, (u32x4){lo_.x, lo_.y, hi_.x, hi_.y}); }())
#define RW_DOTS(T, o) do { _Pragma("unroll") for (int cb = 0; cb < 2; ++cb) _Pragma("unroll") for (int q = 0; q < 16; ++q) o[cb][q] = 0.f; \
    _Pragma("unroll") for (int rb = 0; rb < 2; ++rb) _Pragma("unroll") for (int s2 = 0; s2 < 2; ++s2) _Pragma("unroll") for (int cb = 0; cb < 2; ++cb) { u32x4 w_; \
      w_.x = cvt_pk_bf16(T[rb][cb][8 * s2 + 0], T[rb][cb][8 * s2 + 1]); w_.y = cvt_pk_bf16(T[rb][cb][8 * s2 + 2], T[rb][cb][8 * s2 + 3]); \
      w_.z = cvt_pk_bf16(T[rb][cb][8 * s2 + 4], T[rb][cb][8 * s2 + 5]); w_.w = cvt_pk_bf16(T[rb][cb][8 * s2 + 6], T[rb][cb][8 * s2 + 7]); \
      o[cb] = __builtin_amdgcn_mfma_f32_32x32x16_bf16(xf[rb][s2], __builtin_bit_cast(bf16x8, w_), o[cb], 0, 0, 0); \
      asm volatile("" : "+v"(o[cb]) : "v"(w_), "v"(xf[rb][s2]));   } } while (0)
#define RW_RENORM() do { wl[1280 + lane] = Dl; __builtin_amdgcn_wave_barrier(); \
    _Pragma("unroll") for (int rb = 0; rb < 2; ++rb) _Pragma("unroll") for (int g = 0; g < 4; ++g) { const f32x4 w4 = *(const LAS f32x4*)(wl + 1280 + 32 * rb + 8 * g + 4 * hi); \
      _Pragma("unroll") for (int cb = 0; cb < 2; ++cb) _Pragma("unroll") for (int u = 0; u < 4; ++u) { TS[rb][cb][4 * g + u] *= w4[u]; TP[rb][cb][4 * g + u] *= w4[u]; } } \
    __builtin_amdgcn_wave_barrier(); Dl = 1.f; } while (0)
  const int wvs = __builtin_amdgcn_readfirstlane((int)((size_t)wl));
#define RW_FETCH(tb) do { _Pragma("unroll") for (int u = 0; u < 8; ++u) { const int pn = (tb) + u < CL ? (tb) + u : CL - 1; const int row = scan_row(dir, b, p0 + pn); \
      const unsigned* gs = (const unsigned*)(bf.SH + (size_t)row * 512 + ch); const unsigned* gd = bf.DR + ((size_t)dir * NTOK + row) * 512 + ch; LAS unsigned* ld = (LAS unsigned*)(size_t)(wvs + 8192 + u * 768); \
      __builtin_amdgcn_global_load_lds(gs, ld, 4, 0, 0); __builtin_amdgcn_global_load_lds(gs + 1, ld + 64, 4, 0, 0); __builtin_amdgcn_global_load_lds(gd, ld + 128, 4, 0, 0); } } while (0)
  RW_FETCH(0);
  for (int t0 = 0; t0 < CL; t0 += 8) {
    asm volatile("s_waitcnt vmcnt(0)" ::: "memory");
    __builtin_amdgcn_wave_barrier();
#pragma unroll
    for (int u = 0; u < 8; ++u) {
      const LAS unsigned* ld = (const LAS unsigned*)(wb + 8192 + u * 768) + lane; const unsigned sx = ld[0], sy = ld[64], dd = ld[128];
      const float rr = bflo(sx), k = bfhi(sx), kk = bflo(sy), e = bflo(dd), asg = bfhi(dd);
      const float w = __builtin_amdgcn_exp2f(-e * LOG2E), keff = k * (1.0f + (asg - 1.0f) * kac);
      ((LAS bf16_t*)wb)[u * 64 + lane] = f2bf(-kk * Dl);
      Dl *= w; const float dinv = __builtin_amdgcn_rcpf(Dl);
      ((LAS bf16_t*)wb)[(8 + u) * 64 + lane] = f2bf(rr * Dl);
      ((LAS bf16_t*)wb)[1024 + u * 64 + lane] = f2bf(kk * asg * dinv); ((LAS bf16_t*)wb)[1024 + (8 + u) * 64 + lane] = f2bf(keff * dinv);
      ((LAS bf16_t*)wb)[3072 + u * 64 + lane] = (bf16_t)(sy >> 16);
    }
    asm volatile("s_waitcnt lgkmcnt(0)" ::: "memory");
    __builtin_amdgcn_wave_barrier();
    RW_FETCH(t0 + 8);
    __builtin_amdgcn_wave_barrier();
    bf16x8 xf[2][2];
#pragma unroll
    for (int rb = 0; rb < 2; ++rb)
#pragma unroll
      for (int s2 = 0; s2 < 2; ++s2) xf[rb][s2] = RW_FRAG(xrow, rb, s2);
    { f32x16 gm;
#pragma unroll
      for (int q = 0; q < 16; ++q) gm[q] = 0.f;
#pragma unroll
      for (int rb = 0; rb < 2; ++rb)
#pragma unroll
        for (int s2 = 0; s2 < 2; ++s2) { const bf16x8 yf = RW_FRAG(xrow + 2048, rb, s2); gm = __builtin_amdgcn_mfma_f32_32x32x16_bf16(xf[rb][s2], yf, gm, 0, 0, 0); asm volatile("" : "+v"(gm) : "v"(yf), "v"(xf[rb][s2])); }
      if (r < 16) {
#pragma unroll
        for (int q = 0; q < 8; ++q) Gl[((q & 3) + 8 * (q >> 2) + 4 * hi) * 16 + r] = gm[q]; }
    }
    float sa[2][8], yy[2][8];
    { f32x16 oS[2], oP[2];
      RW_DOTS(TS, oS); RW_DOTS(TP, oP);
#pragma unroll
      for (int cb = 0; cb < 2; ++cb)
#pragma unroll
        for (int q = 0; q < 4; ++q) {
          { const u32x2 sw = __builtin_amdgcn_permlane32_swap(__float_as_uint(oS[cb][q]), __float_as_uint(oP[cb][q]), false, false); sa[cb][q] = __uint_as_float(sw.x); sa[cb][4 + q] = __uint_as_float(sw.y); }
          { const u32x2 sw = __builtin_amdgcn_permlane32_swap(__float_as_uint(oS[cb][4 + q]), __float_as_uint(oP[cb][4 + q]), false, false); yy[cb][q] = __uint_as_float(sw.x); yy[cb][4 + q] = __uint_as_float(sw.y); } }
    }
    __builtin_amdgcn_wave_barrier();
    float vm[2][8];
#pragma unroll
    for (int u = 0; u < 8; ++u) { const LAS bf16_t* vr = (const LAS bf16_t*)wb + 3072 + u * 64 + r; vm[0][u] = hi ? 0.f : bf2f(vr[0]); vm[1][u] = hi ? 0.f : bf2f(vr[32]); }
#pragma unroll
    for (int s = 0; s < 8; ++s) {
      const f32x4 ga0 = *(const LAS f32x4*)(Gl + s * 16), ga1 = *(const LAS f32x4*)(Gl + s * 16 + 4), ga2 = *(const LAS f32x4*)(Gl + s * 16 + 8), ga3 = *(const LAS f32x4*)(Gl + s * 16 + 12);
      const f32x4 gr0 = *(const LAS f32x4*)(Gl + (8 + s) * 16), gr1 = *(const LAS f32x4*)(Gl + (8 + s) * 16 + 4), gr2 = *(const LAS f32x4*)(Gl + (8 + s) * 16 + 8), gr3 = *(const LAS f32x4*)(Gl + (8 + s) * 16 + 12);
      const float gab[8] = {ga0[0], ga0[1], ga0[2], ga0[3], ga1[0], ga1[1], ga1[2], ga1[3]}, gak[8] = {ga2[0], ga2[1], ga2[2], ga2[3], ga3[0], ga3[1], ga3[2], ga3[3]};
      const float grb[8] = {gr0[0], gr0[1], gr0[2], gr0[3], gr1[0], gr1[1], gr1[2], gr1[3]}, grk[8] = {gr2[0], gr2[1], gr2[2], gr2[3], gr3[0], gr3[1], gr3[2], gr3[3]};
#pragma unroll
      for (int cb = 0; cb < 2; ++cb) {
        float x = sa[cb][s], y = yy[cb][s];
#pragma unroll
        for (int u = 0; u < 8; ++u) { if (u < s) { x = fmaf(gab[u], sa[cb][u], x); x = fmaf(gak[u], vm[cb][u], x); } }
        sa[cb][s] = x;
#pragma unroll
        for (int u = 0; u < 8; ++u) { if (u <= s) { y = fmaf(grb[u], sa[cb][u], y); y = fmaf(grk[u], vm[cb][u], y); } }
        yy[cb][s] = y;
      }
    }
    { bf16_t* yz = hi ? bf.Z : bf.Y;
#pragma unroll
      for (int s = 0; s < 8; ++s) { const size_t oi = ((size_t)dir * NTOK + scan_row(dir, b, p0 + t0 + s)) * 512 + h * 64 + r; yz[oi] = f2bf(yy[0][s]); yz[oi + 32] = f2bf(yy[1][s]); } }
    { bf16x8 au[2], buS[2], buP[2];
      u32x4 a0, a1, s0, s1, p0_, p1_;
#pragma unroll
      for (int q = 0; q < 4; ++q) {
        const int u = 4 * hi + q;
        const LAS bf16_t* yb = (const LAS bf16_t*)wb + 1024 + u * 64 + r; const LAS bf16_t* vr = (const LAS bf16_t*)wb + 3072 + u * 64 + r;
        a0[q] = (unsigned)yb[0] | ((unsigned)yb[512] << 16); a1[q] = (unsigned)yb[32] | ((unsigned)yb[512 + 32] << 16);
        const u32x2 sw0 = __builtin_amdgcn_permlane32_swap(__float_as_uint(sa[0][q]), __float_as_uint(sa[0][4 + q]), false, false), sw1 = __builtin_amdgcn_permlane32_swap(__float_as_uint(sa[1][q]), __float_as_uint(sa[1][4 + q]), false, false);
        s0[q] = (cvt_pk_bf16(__uint_as_float(sw0.x), 0.f) & 0xffffu) | ((unsigned)vr[0] << 16); s1[q] = (cvt_pk_bf16(__uint_as_float(sw1.x), 0.f) & 0xffffu) | ((unsigned)vr[32] << 16);
        p0_[q] = cvt_pk_bf16(__uint_as_float(sw0.y), 0.f); p1_[q] = cvt_pk_bf16(__uint_as_float(sw1.y), 0.f); }
      au[0] = __builtin_bit_cast(bf16x8, a0); au[1] = __builtin_bit_cast(bf16x8, a1); buS[0] = __builtin_bit_cast(bf16x8, s0); buS[1] = __builtin_bit_cast(bf16x8, s1); buP[0] = __builtin_bit_cast(bf16x8, p0_); buP[1] = __builtin_bit_cast(bf16x8, p1_);
#pragma unroll
      for (int rb = 0; rb < 2; ++rb)
#pragma unroll
        for (int cb = 0; cb < 2; ++cb) { TS[rb][cb] = __builtin_amdgcn_mfma_f32_32x32x16_bf16(au[rb], buS[cb], TS[rb][cb], 0, 0, 0); TP[rb][cb] = __builtin_amdgcn_mfma_f32_32x32x16_bf16(au[rb], buP[cb], TP[rb][cb], 0, 0, 0); }
    }
    __builtin_amdgcn_wave_barrier();
    if ((t0 & 31) == 24) RW_RENORM();
  }
  RW_RENORM();
#undef RW_DOTS
#undef RW_FRAG
#undef RW_RENORM
#undef RW_FETCH
  asm volatile("s_waitcnt vmcnt(0)" ::: "memory");
  if (chunk < NCH - 1) {
    float* pq = bf.PQ + (((size_t)chain * (NCH - 1) + chunk) * 2) * 4096;
#pragma unroll
    for (int rb = 0; rb < 2; ++rb)
#pragma unroll
      for (int cb = 0; cb < 2; ++cb)
#pragma unroll
        for (int g = 0; g < 4; ++g) { float* q = pq + (size_t)(32 * cb + r) * 64 + 32 * rb + 8 * g + 4 * hi;
          *(f32x4*)q = (f32x4){TP[rb][cb][4 * g], TP[rb][cb][4 * g + 1], TP[rb][cb][4 * g + 2], TP[rb][cb][4 * g + 3]};
          *(f32x4*)(q + 4096) = (f32x4){TS[rb][cb][4 * g], TS[rb][cb][4 * g + 1], TS[rb][cb][4 * g + 2], TS[rb][cb][4 * g + 3]}; }
  }
}

__device__ __forceinline__ void propagate_chain(const Bufs& bf, int chain, int rq, LAS float* lds) {
  LAS float* Sl = lds; LAS float* Pl = lds + 16 * 65 + 15;
  Pl = lds + 1056;
  const int tid = mk::otid(), i = tid >> 5, jc = (tid & 31) * 2, row = rq * 16 + i, pi = tid >> 3, pj = (tid & 7) * 8;
  float* sst = bf.SST + (size_t)chain * NCH * 4096;
  Sl[i * 65 + jc] = 0.f; Sl[i * 65 + jc + 1] = 0.f;
  const float* pb = bf.PQ + ((size_t)chain * (NCH - 1) * 2) * 4096;
  f32x4 np0 = *(const f32x4*)(pb + pi * 64 + pj), np1 = *(const f32x4*)(pb + pi * 64 + pj + 4); f32x2 nq = *(const f32x2*)(pb + 4096 + row * 64 + jc);
  for (int c = 0; c < NCH - 1; ++c) {
    const f32x4 p0 = np0, p1 = np1; f32x2 q = nq;
    { const float* pn = pb + (size_t)(c + 1 < NCH - 1 ? c + 1 : c) * 2 * 4096;
      np0 = *(const f32x4*)(pn + pi * 64 + pj); np1 = *(const f32x4*)(pn + pi * 64 + pj + 4); nq = *(const f32x2*)(pn + 4096 + row * 64 + jc); }
    *(LAS f32x4*)(Pl + pi * 64 + pj) = p0; *(LAS f32x4*)(Pl + pi * 64 + pj + 4) = p1;
    __syncthreads();
#pragma unroll 16
    for (int k = 0; k < 64; ++k) { const float sv = Sl[i * 65 + k]; const f32x2 a = *(const LAS f32x2*)(Pl + k * 64 + jc); q += sv * a; }
    __syncthreads();
    Sl[i * 65 + jc] = q[0]; Sl[i * 65 + jc + 1] = q[1];
    *(f32x2*)(sst + (size_t)(c + 1) * 4096 + row * 64 + jc) = q;
  }
  __syncthreads();
}

__device__ __forceinline__ void corr_unit(const Bufs& bf, int chain, int chunk) {
  const int lane = mk::otid() & 63, r = lane & 31, hi = lane >> 5;
  const int dir = chain >> 5, b = (chain >> 3) & 3, h = chain & 7;
  const float* ss = bf.SST + ((size_t)chain * NCH + chunk) * 4096;
  bf16x8 bfr[2][4];
#pragma unroll
  for (int nt = 0; nt < 2; ++nt)
#pragma unroll
    for (int ks = 0; ks < 4; ++ks) { const float* q = ss + (size_t)(nt * 32 + r) * 64 + ks * 16 + hi * 8; const f32x4 x0 = *(const f32x4*)q, x1 = *(const f32x4*)(q + 4);
      u32x4 w; w.x = cvt_pk_bf16(x0[0], x0[1]); w.y = cvt_pk_bf16(x0[2], x0[3]); w.z = cvt_pk_bf16(x1[0], x1[1]); w.w = cvt_pk_bf16(x1[2], x1[3]); bfr[nt][ks] = __builtin_bit_cast(bf16x8, w); }
  const int p0 = chunk * CL;
  const size_t dbase = (size_t)dir * NTOK;
  for (int mt = 0; mt < (CL + 31) / 32; ++mt) {
    const int sa_ = min(mt * 32 + r, CL - 1);
    const bf16_t* zp = bf.Z + (dbase + scan_row(dir, b, p0 + sa_)) * 512 + h * 64 + hi * 8;
    bf16x8 af[4];
#pragma unroll
    for (int ks = 0; ks < 4; ++ks) af[ks] = *(const bf16x8*)(zp + ks * 16);
    f32x16 acc[2];
#pragma unroll
    for (int nt = 0; nt < 2; ++nt) { acc[nt] = zero16();
#pragma unroll
      for (int ks = 0; ks < 4; ++ks) acc[nt] = __builtin_amdgcn_mfma_f32_32x32x16_bf16(af[ks], bfr[nt][ks], acc[nt], 0, 0, 0); }
#pragma unroll
    for (int i = 0; i < 16; ++i) { const int so = mt * 32 + (i & 3) + 8 * (i >> 2) + 4 * hi;
      if (so < CL) { bf16_t* yp = bf.Y + (dbase + scan_row(dir, b, p0 + so)) * 512 + h * 64 + r;
        yp[0] = f2bf(bf2f(yp[0]) + acc[0][i]); yp[32] = f2bf(bf2f(yp[32]) + acc[1][i]); } }
  }
}

template <int NR> struct FinRaw { bf16_t y0[NR], y1[NR], g[NR]; unsigned v[NR]; float c0[NR], c1[NR]; };
template <int NR>
__device__ __forceinline__ void finish_load(const Bufs& bf, int row0, int c, int h, FinRaw<NR>& q) {
#pragma unroll
  for (int i = 0; i < NR; ++i) { const int row = row0 + i;
    q.y0[i] = bf.Y[(size_t)row * 512 + c]; q.y1[i] = bf.Y[((size_t)NTOK + row) * 512 + c];
    q.v[i] = bf.SH[(size_t)row * 512 + c].y; q.g[i] = bf.G[(size_t)row * bf.gstride + c];
    q.c0[i] = bf.CS[(size_t)row * 16 + h]; q.c1[i] = bf.CS[(size_t)row * 16 + 8 + h]; }
}
template <int NR>
__device__ __forceinline__ void finish_phase(const Bufs& bf, const float* __restrict__ gn_g, const float* __restrict__ gn_b, bf16_t* __restrict__ O) {
  const int c = mk::otid(), h = c >> 6, stride = gridDim.x * NR;
  const float gg = gn_g[c], gb = gn_b[c];
  int row0 = mk::obid() * NR;
  if (row0 >= NTOK) return;
  FinRaw<NR> cur, nxt; finish_load<NR>(bf, row0, c, h, cur);
  for (; row0 < NTOK; row0 += stride) {
    const int rn = row0 + stride < NTOK ? row0 + stride : row0;
    finish_load<NR>(bf, rn, c, h, nxt);
    float o[NR];
#pragma unroll
    for (int i = 0; i < NR; ++i) { const float y = bf2f(cur.y0[i]) + bf2f(cur.y1[i]);
      const float mu = wave_sum_u(y) * (1.0f / 64.0f); const float dv = y - mu; const float var = wave_sum_u(dv * dv) * (1.0f / 64.0f);
      o[i] = (dv * rsqrtf(var + 64e-5f) * gg + gb + (cur.c0[i] + cur.c1[i]) * bfhi(cur.v[i])) * bf2f(cur.g[i]); }
#pragma unroll
    for (int i = 0; i < NR; ++i) O[(size_t)(row0 + i) * 1024 + 512 + c] = f2bf(o[i]);
    cur = nxt;
  }
}
}

namespace mk {
constexpr size_t al256(size_t x) { return (x + 255) / 256 * 256; }
constexpr size_t WS_BAR = 0;
constexpr size_t WS_BCNT = al256(WS_BAR + (size_t)XCD_BAR_WORDS * 4);
constexpr size_t WS_MOFF = al256(WS_BCNT + (size_t)4 * 256 * 64 * 4);
constexpr size_t WS_KN = al256(WS_MOFF + 4 * 256);
constexpr size_t WS_MOD = al256(WS_KN + (size_t)2 * 256 * 32 * 4);
constexpr size_t WS_ROPE = al256(WS_MOD + (size_t)4 * 5 * 6144 * 4);
constexpr size_t WS_HBC = al256(WS_ROPE + 128 * 16 * 2 * 4);
constexpr size_t WS_EID = al256(WS_HBC + (size_t)NCTX * D * 2);
constexpr size_t WS_GATE = al256(WS_EID + (size_t)NTOK * 2 * 4);
constexpr size_t WS_POS = al256(WS_GATE + (size_t)NTOK * 2 * 4);
constexpr size_t WS_RL = al256(WS_POS + (size_t)NTOK * 2 * 4);
constexpr size_t WS_WEIN = al256(WS_RL + (size_t)MOE_ROWS * 4);
constexpr size_t WS_WOIN = al256(WS_WEIN + (size_t)2 * EVEN_IN * D * 2);
constexpr size_t WS_WEOUT = al256(WS_WOIN + (size_t)2 * ODD_IN * D * 2);
constexpr size_t WS_WOOUT = al256(WS_WEOUT + (size_t)2 * D * D * 2);
constexpr size_t WS_WGU = al256(WS_WOOUT + (size_t)2 * D * D * 2);
constexpr size_t WS_WDN = al256(WS_WGU + (size_t)NE * 1024 * D * 2);
constexpr size_t WS_WLT = al256(WS_WDN + (size_t)NE * D * DE * 2);
constexpr size_t WS_UO = al256(WS_WLT + (size_t)2 * 196608 * 2);
constexpr size_t WS_SCR = al256(WS_UO + (size_t)NTOK * D * 2);
constexpr size_t SE_PQK = 0;
constexpr size_t SE_VT = al256(SE_PQK + (size_t)NTOK * 1024 * 2);
constexpr size_t SE_PRW = al256(SE_VT + (size_t)512 * NTOK * 2);
constexpr size_t SE_PQ = 0;
constexpr size_t SE_SST = al256(SE_PQ + (size_t)rw::NCHAIN * (rw::NCH - 1) * 2 * 4096 * 4);
constexpr size_t SE_Y = al256(SE_SST + (size_t)rw::NCHAIN * rw::NCH * 4096 * 4);
constexpr size_t SE_Z = al256(SE_Y + (size_t)2 * NTOK * 512 * 2);
constexpr size_t SE_ZEND = al256(SE_Z + (size_t)2 * NTOK * 512 * 2);
constexpr size_t SE_PRWEND = al256(SE_PRW + (size_t)NTOK * RW_IN * 2);
constexpr size_t SE_SH = SE_PRWEND > SE_ZEND ? SE_PRWEND : SE_ZEND;
constexpr size_t SE_DR = al256(SE_SH + (size_t)NTOK * 512 * 8);
constexpr size_t SE_CS = al256(SE_DR + (size_t)2 * NTOK * 512 * 4);
constexpr size_t SE_END = al256(SE_CS + (size_t)2 * NTOK * 16 * 4);
constexpr size_t SE_YBUF = 0;
constexpr size_t SO_PQK = 0;
constexpr size_t SO_VT = al256(SO_PQK + (size_t)NTOK * 2048 * 2);
constexpr size_t SO_O12 = al256(SO_VT + (size_t)1024 * NTOK * 2);
constexpr size_t SO_END = al256(SO_O12 + (size_t)NTOK * 2048 * 2);
constexpr size_t SO_YBUF = 0;
constexpr size_t SM_XS = 0;
constexpr size_t SM_HE = al256(SM_XS + (size_t)MOE_ROWS * D * 2);
constexpr size_t SM_YS = al256(SM_HE + (size_t)MOE_ROWS * DE * 2);
constexpr size_t SM_END = al256(SM_YS + (size_t)MOE_ROWS * D * 2);
constexpr size_t SCR_BYTES = SE_END > SO_END ? (SE_END > SM_END ? SE_END : SM_END) : (SO_END > SM_END ? SO_END : SM_END);
constexpr size_t WS_END = WS_SCR + SCR_BYTES;
constexpr int LDS_BARW = 131072;
constexpr int LDS_MISC = 131072 + 64;

struct Params {
  const float *x, *c, *ctx, *c_ctx, *ada_w, *ada_b, *ln_g, *ln_b, *even_w_in, *even_w_out, *shift_w, *na_rpb, *rw_w0, *rw_w_up, *rw_a0, *rw_a_up, *rw_g_up, *rw_k_k, *rw_k_a, *rw_r_k,
      *rw_gn_g, *rw_gn_b, *odd_w_in, *odd_w_out, *da_lq1, *da_lk1, *da_lq2, *da_lk2, *da_subln_g, *router_w, *router_b, *exp_w_gate, *exp_w_up, *exp_w_down;
  float* out; unsigned char* ws; int ph_lo, ph_hi;
};
template <class Tp> __device__ __forceinline__ Tp* wsp(const Params& p, size_t off) { return (Tp*)(p.ws + off); }

__device__ __forceinline__ void ada_unit(const Params& p, int u, LAS float* lds) {
  LAS float* sc = lds; LAS float* red = lds + 5 * 1024;
  const int tid = mk::otid(), l = u / 96, n = (u % 96) * 64 + (tid & 63), kp = tid >> 6;
  for (int i = tid; i < 5 * 1024; i += NTHR) { const float v = i < 4096 ? p.c[i] : p.c_ctx[i - 4096]; sc[i] = siluf_(v); }
  __syncthreads();
  float a[5] = {0.f, 0.f, 0.f, 0.f, 0.f};
  const float* w = p.ada_w + ((size_t)l * D + kp * 128) * 6144 + n;
#pragma unroll 4
  for (int k = 0; k < 128; ++k) { const float wv = w[(size_t)k * 6144]; const int kk = kp * 128 + k;
#pragma unroll
    for (int r = 0; r < 5; ++r) a[r] = fmaf(sc[r * 1024 + kk], wv, a[r]); }
#pragma unroll
  for (int r = 0; r < 5; ++r) red[(kp * 5 + r) * 64 + (tid & 63)] = a[r];
  __syncthreads();
  if (tid < 320) { const int r = tid >> 6, nn = tid & 63; float s = 0.f;
#pragma unroll
    for (int q = 0; q < 8; ++q) s += red[(q * 5 + r) * 64 + nn];
    const int col = (u % 96) * 64 + nn;
    wsp<float>(p, WS_MOD)[((size_t)l * 5 + r) * 6144 + col] = s + p.ada_b[l * 6144 + col]; }
  __syncthreads();
}
__device__ __forceinline__ void phase_prologue(const Params& p, LAS unsigned char* lds) {
  const int bid = mk::obid(), nb = gridDim.x; LAS float* tile = (LAS float*)lds;
  int ub = 0;
  for (int i = 0; i < 2; ++i) ub += cvt_matrix(p.even_w_in + (size_t)i * D * EVEN_IN, EVEN_IN, D, EVEN_IN, wsp<bf16_t>(p, WS_WEIN) + (size_t)i * EVEN_IN * D, NMapId{0}, tile, ub, bid, nb);
  for (int i = 0; i < 2; ++i) ub += cvt_matrix(p.odd_w_in + (size_t)i * D * ODD_IN, ODD_IN, D, ODD_IN, wsp<bf16_t>(p, WS_WOIN) + (size_t)i * ODD_IN * D, NMapRope{}, tile, ub, bid, nb);
  for (int i = 0; i < 2; ++i) ub += cvt_matrix(p.even_w_out + (size_t)i * D * D, D, D, D, wsp<bf16_t>(p, WS_WEOUT) + (size_t)i * D * D, NMapId{0}, tile, ub, bid, nb);
  for (int i = 0; i < 2; ++i) ub += cvt_matrix(p.odd_w_out + (size_t)i * D * D, D, D, D, wsp<bf16_t>(p, WS_WOOUT) + (size_t)i * D * D, NMapId{0}, tile, ub, bid, nb);
  for (int i = 0; i < 2; ++i) { bf16_t* wl = wsp<bf16_t>(p, WS_WLT) + (size_t)i * 196608;
    for (int d = 0; d < 2; ++d) { ub += cvt_matrix(p.rw_w_up + (size_t)(i * 2 + d) * 64 * 512, 512, 64, 512, wl + (size_t)d * 32768, NMapId{0}, tile, ub, bid, nb);
      ub += cvt_matrix(p.rw_a_up + (size_t)(i * 2 + d) * 64 * 512, 512, 64, 512, wl + (size_t)(2 + d) * 32768, NMapId{0}, tile, ub, bid, nb); }
    ub += cvt_matrix(p.rw_g_up + (size_t)i * 128 * 512, 512, 128, 512, wl + (size_t)4 * 32768, NMapId{0}, tile, ub, bid, nb); }
  for (int u = (bid + nb - ub % nb) % nb; u < 384; u += nb) ada_unit(p, u, (LAS float*)lds);
  const int gt = bid * NTHR + mk::otid();
  if (gt < 128 * 16) { const int pos = gt >> 4, i = gt & 15; const float inv = exp2f(-(float)i * (13.287712379549449f / 16.0f)); float sn, cs; sincosf((float)pos * inv, &sn, &cs);
    wsp<float>(p, WS_ROPE)[gt * 2] = cs; wsp<float>(p, WS_ROPE)[gt * 2 + 1] = sn; }
}
#define CVT_JOB(u_, src_, dst_, ld_, K_, k0_, n0_, mode_) do { const int e_ = (u_) / 384, rem_ = (u_) % 384, v_ = rem_ & 127; mode_ = rem_ >> 7; const size_t so_ = ((size_t)l * NE + e_) * D * DE; \
    const bool dn_ = mode_ == 2; src_ = (dn_ ? wd_ : (mode_ == 0 ? wg_ : wu_)) + so_; ld_ = dn_ ? D : DE; K_ = dn_ ? DE : D; \
    k0_ = (dn_ ? (v_ >> 4) : (v_ >> 3)) * 64; n0_ = (dn_ ? (v_ & 15) : (v_ & 7)) * 64; dst_ = dn_ ? wsp<bf16_t>(p, WS_WDN) + (size_t)e_ * D * DE : wsp<bf16_t>(p, WS_WGU) + (size_t)e_ * 1024 * D; } while (0)
__device__ __forceinline__ void cvt_experts(const Params& p, int l, LAS float* tile, int b0) {
  const int bid = mk::obid() - b0, nb = (int)gridDim.x - b0, t = mk::otid();
  if (bid < 0) return;
  const float* wg_ = p.exp_w_gate; const float* wu_ = p.exp_w_up; const float* wd_ = p.exp_w_down; asm volatile("" : "+s"(wg_), "+s"(wu_), "+s"(wd_));
  constexpr int NJ = NE * 384;
  int u = bid;
  if (u >= NJ) return;
  const float* csrc; bf16_t* cdst; int cld, cK, ck0, cn0, cmode;
  CVT_JOB(u, csrc, cdst, cld, cK, ck0, cn0, cmode);
  const int lk = t >> 3, lc = (t & 7) * 8;
  f32x4 ra, rb; { const float* q = csrc + (size_t)(ck0 + lk) * cld + cn0 + lc; ra = *(const f32x4*)q; rb = *(const f32x4*)(q + 4); }
  for (; u < NJ; u += nb) {
    const int un = u + nb < NJ ? u + nb : u;
    const float* nsrc; bf16_t* ndst; int nld, nK, nk0, nn0, nmode;
    CVT_JOB(un, nsrc, ndst, nld, nK, nk0, nn0, nmode);
    f32x4 na, nbv; { const float* q = nsrc + (size_t)(nk0 + lk) * nld + nn0 + lc; na = *(const f32x4*)q; nbv = *(const f32x4*)(q + 4); }
    { LAS float* q = tile + lk * 65 + lc; q[0] = ra[0]; q[1] = ra[1]; q[2] = ra[2]; q[3] = ra[3]; q[4] = rb[0]; q[5] = rb[1]; q[6] = rb[2]; q[7] = rb[3]; }
    __syncthreads();
    { const int n = t >> 3, kc = (t & 7) * 8; const LAS float* q = tile + kc * 65 + n;
      u32x4 w; w.x = cvt_pk_bf16(q[0], q[65]); w.y = cvt_pk_bf16(q[130], q[195]); w.z = cvt_pk_bf16(q[260], q[325]); w.w = cvt_pk_bf16(q[390], q[455]);
      const int drow = cmode == 2 ? cn0 + n : 2 * (cn0 + n) + cmode;
      *(u32x4*)(cdst + (size_t)drow * cK + ck0 + kc) = w; }
    __syncthreads();
    csrc = nsrc; cdst = ndst; cld = nld; cK = nK; ck0 = nk0; cn0 = nn0; cmode = nmode; ra = na; rb = nbv;
  }
}
#undef CVT_JOB

__device__ __forceinline__ bf16_t* hb_ptr(const Params& p, int row, bool alt) {
  if (alt) return wsp<bf16_t>(p, WS_SCR + SM_END) + (size_t)row * D;
  return row < NLAT ? (bf16_t*)p.out + (size_t)row * D : wsp<bf16_t>(p, WS_HBC) + (size_t)(row - NLAT) * D;
}
__device__ __forceinline__ const float* h0_ptr(const Params& p, int row) { return row < NLAT ? p.x + (size_t)row * D : p.ctx + (size_t)(row - NLAT) * D; }
__device__ __forceinline__ void store_bf16x4(bf16_t* dst, f32x4 v) { u32x2 w; w.x = cvt_pk_bf16(v[0], v[1]); w.y = cvt_pk_bf16(v[2], v[3]); *(u32x2*)dst = w; }
__device__ __forceinline__ f32x4 load_bf16x4(const bf16_t* src) { const u32x2 w = *(const u32x2*)src; return (f32x4){bflo(w.x), bfhi(w.x), bflo(w.y), bfhi(w.y)}; }

__device__ __forceinline__ void phase_mod0(const Params& p) {
  const int lane = mk::otid() & 63, wid = mk::otid() >> 6;
  bf16_t* U = wsp<bf16_t>(p, WS_UO);
  for (int row = mk::obid() * 8 + wid; row < NTOK; row += gridDim.x * 8) {
    const float* h = h0_ptr(p, row); const float* modl = wsp<float>(p, WS_MOD) + (size_t)bidx_of_row(row) * 6144;
#pragma unroll
    for (int q = 0; q < 4; ++q) { const int col = q * 256 + lane * 4; const f32x4 hv = *(const f32x4*)(h + col), sh = *(const f32x4*)(modl + col), sc = *(const f32x4*)(modl + 1024 + col);
      store_bf16x4(U + (size_t)row * D + col, hv * (1.0f + sc) + sh); }
  }
}
__device__ __forceinline__ void ln_row(f32x4 (&v)[4], const float* __restrict__ g, const float* __restrict__ b, int lane) {
  float s = 0.f;
#pragma unroll
  for (int q = 0; q < 4; ++q) s += (v[q][0] + v[q][1]) + (v[q][2] + v[q][3]);
  const float mu = wave_sum_u(s) * (1.0f / D);
  float qq = 0.f;
#pragma unroll
  for (int q = 0; q < 4; ++q) { const f32x4 d = v[q] - mu; qq += (d[0] * d[0] + d[1] * d[1]) + (d[2] * d[2] + d[3] * d[3]); }
  const float rstd = rsqrtf(wave_sum_u(qq) * (1.0f / D) + LN_EPS);
#pragma unroll
  for (int q = 0; q < 4; ++q) { const int col = q * 256 + lane * 4; v[q] = (v[q] - mu) * rstd * *(const f32x4*)(g + col) + *(const f32x4*)(b + col); }
}
template <bool F32IN> struct Ln1Raw;
template <> struct Ln1Raw<true> { f32x4 h[4]; u32x2 y[4]; };
template <> struct Ln1Raw<false> { u32x2 h[4]; u32x2 y[4]; };
__device__ __forceinline__ f32x4 h_as_f32(f32x4 v) { return v; }
__device__ __forceinline__ f32x4 h_as_f32(u32x2 w) { return (f32x4){bflo(w.x), bfhi(w.x), bflo(w.y), bfhi(w.y)}; }
template <bool F32IN>
__device__ __forceinline__ void ln1_load(const Params& p, const bf16_t* __restrict__ Ybuf, int row, int lane, Ln1Raw<F32IN>& r) {
#pragma unroll
  for (int q = 0; q < 4; ++q) { const int col = q * 256 + lane * 4;
    if constexpr (F32IN) r.h[q] = *(const f32x4*)(h0_ptr(p, row) + col); else r.h[q] = *(const u32x2*)(hb_ptr(p, row, false) + col);
    r.y[q] = *(const u32x2*)(Ybuf + (size_t)row * D + col); }
}
template <bool F32IN>
__device__ __forceinline__ void ln1_row(const Params& p, int l, int row, int lane, const Ln1Raw<F32IN>& raw, const LAS float* rwl, LAS int* lcnt, float rbias  , bool redir) {
  bf16_t* U2 = wsp<bf16_t>(p, WS_UO); int* eid = wsp<int>(p, WS_EID); float* gatev = wsp<float>(p, WS_GATE);
  const float* lg = p.ln_g + (size_t)(l * 2) * D; const float* lb = p.ln_b + (size_t)(l * 2) * D;
  bf16_t* ho = redir ? wsp<bf16_t>(p, WS_SCR + SM_YS) + (size_t)row * D : hb_ptr(p, row, l == DEPTH - 1); const float* modl = wsp<float>(p, WS_MOD) + ((size_t)l * 5 + bidx_of_row(row)) * 6144;
  f32x4 v[4];
#pragma unroll
  for (int q = 0; q < 4; ++q) { const int col = q * 256 + lane * 4; const f32x4 yv = (f32x4){bflo(raw.y[q].x), bfhi(raw.y[q].x), bflo(raw.y[q].y), bfhi(raw.y[q].y)};
    v[q] = ALPHA * h_as_f32(raw.h[q]) + *(const f32x4*)(modl + 2 * 1024 + col) * yv; }
  ln_row(v, lg, lb, lane);
  float acc[16];
#pragma unroll
  for (int e = 0; e < 16; ++e) acc[e] = 0.f;
#pragma unroll
  for (int q = 0; q < 4; ++q) { const int col = q * 256 + lane * 4;
    store_bf16x4(ho + col, v[q]);
    const f32x4 u = v[q] * (1.0f + *(const f32x4*)(modl + 4 * 1024 + col)) + *(const f32x4*)(modl + 3 * 1024 + col);
    store_bf16x4(U2 + (size_t)row * D + col, u);
#pragma unroll
    for (int e = 0; e < 16; ++e) { const f32x4 w = *(const LAS f32x4*)(rwl + ((q * 16 + e) * 64 + lane) * 4); acc[e] += (u[0] * w[0] + u[1] * w[1]) + (u[2] * w[2] + u[3] * w[3]); }
  }
  float t8[8], t4[4], t2[2];
#pragma unroll
  for (int i = 0; i < 8; ++i) { const u32x2 sw = __builtin_amdgcn_permlane32_swap(__float_as_uint(acc[i]), __float_as_uint(acc[8 + i]), false, false); t8[i] = __uint_as_float(sw.x) + __uint_as_float(sw.y); }
#pragma unroll
  for (int i = 0; i < 4; ++i) { const u32x2 sw = __builtin_amdgcn_permlane16_swap(__float_as_uint(t8[i]), __float_as_uint(t8[4 + i]), false, false); t4[i] = __uint_as_float(sw.x) + __uint_as_float(sw.y); }
  const bool b3 = (lane & 8) != 0, b2_ = (lane & 4) != 0;
#pragma unroll
  for (int i = 0; i < 2; ++i) { const float keep = b3 ? t4[2 + i] : t4[i], send = b3 ? t4[i] : t4[2 + i]; t2[i] = keep + dpp_mov<0x128, 0xf, 0xf>(send, send); }
  float logit;
  { const float keep = b2_ ? t2[1] : t2[0], send = b2_ ? t2[0] : t2[1];
    float recv = dpp_mov<0x104, 0xf, 0x5>(send, send);
    recv = dpp_mov<0x114, 0xf, 0xa>(recv, send);
    logit = keep + recv; }
  logit += dpp_mov<0xB1, 0xf, 0xf>(logit, logit); logit += dpp_mov<0x4E, 0xf, 0xf>(logit, logit);
  const float sg = 1.0f / (1.0f + expf(-logit)), sl = sg + rbias;
  float gs;
  { const float a = sl, b2 = dpp_mov<0x124, 0xf, 0xf>(sl, sl), c = dpp_mov<0x128, 0xf, 0xf>(sl, sl), d = dpp_mov<0x12C, 0xf, 0xf>(sl, sl);
    const float lo1 = fminf(a, b2), hi1 = fmaxf(a, b2), lo2 = fminf(c, d), hi2 = fmaxf(c, d);
    gs = fmaxf(hi1, hi2) + fmaxf(fminf(hi1, hi2), fmaxf(lo1, lo2)); }
  float best = -1e30f; int grp = 0;
#pragma unroll
  for (int gI = 0; gI < 4; ++gI) { const float g = __uint_as_float(__builtin_amdgcn_readlane(__float_as_uint(gs), gI * 16)); if (g > best) { best = g; grp = gI; } }
  grp = __builtin_amdgcn_readfirstlane(grp);
  const float v0 = __uint_as_float(__builtin_amdgcn_readlane(__float_as_uint(sl), grp * 16)), v1 = __uint_as_float(__builtin_amdgcn_readlane(__float_as_uint(sl), grp * 16 + 4)),
              v2 = __uint_as_float(__builtin_amdgcn_readlane(__float_as_uint(sl), grp * 16 + 8)), v3 = __uint_as_float(__builtin_amdgcn_readlane(__float_as_uint(sl), grp * 16 + 12));
  const float s0 = __uint_as_float(__builtin_amdgcn_readlane(__float_as_uint(sg), grp * 16)), s1 = __uint_as_float(__builtin_amdgcn_readlane(__float_as_uint(sg), grp * 16 + 4)),
              s2 = __uint_as_float(__builtin_amdgcn_readlane(__float_as_uint(sg), grp * 16 + 8)), s3 = __uint_as_float(__builtin_amdgcn_readlane(__float_as_uint(sg), grp * 16 + 12));
  int i1 = 0; float b1 = v0; if (v1 > b1) { b1 = v1; i1 = 1; } if (v2 > b1) { b1 = v2; i1 = 2; } if (v3 > b1) { b1 = v3; i1 = 3; }
  int i2 = -1; float bb = -1e30f;
  if (i1 != 0 && v0 > bb) { bb = v0; i2 = 0; } if (i1 != 1 && v1 > bb) { bb = v1; i2 = 1; } if (i1 != 2 && v2 > bb) { bb = v2; i2 = 2; } if (i1 != 3 && v3 > bb) { bb = v3; i2 = 3; }
  const float g1 = i1 == 0 ? s0 : i1 == 1 ? s1 : i1 == 2 ? s2 : s3; const float g2 = i2 == 0 ? s0 : i2 == 1 ? s1 : i2 == 2 ? s2 : s3;
  if (lane == 0) { const int e1 = grp * 4 + i1, e2 = grp * 4 + i2;
    eid[row * 2] = e1; eid[row * 2 + 1] = e2; gatev[row * 2] = g1 / (g1 + g2); gatev[row * 2 + 1] = g2 / (g1 + g2);
    __hip_atomic_fetch_add(lcnt + e1, 1, __ATOMIC_RELAXED, __HIP_MEMORY_SCOPE_WORKGROUP); __hip_atomic_fetch_add(lcnt + e2, 1, __ATOMIC_RELAXED, __HIP_MEMORY_SCOPE_WORKGROUP); }
}
template <bool F32IN>
__device__ __forceinline__ void phase_ln1(const Params& p, int l, const bf16_t* __restrict__ Ybuf, LAS unsigned char* lds, bool dry) {
  const int tid = mk::otid(), lane = tid & 63, wid = tid >> 6, bid = mk::obid();
  const bool last = l == DEPTH - 1; const int ntok = last ? NLAT : NTOK;
  LAS float* rwl = (LAS float*)lds; LAS int* lcnt = (LAS int*)(lds + 65536);
  { float rv[32];
#pragma unroll
    for (int i = 0; i < 32; ++i) rv[i] = p.router_w[tid + i * NTHR];
#pragma unroll
    for (int i = 0; i < 32; ++i) { const int idx = tid + i * NTHR, d = idx >> 4, e = idx & 15; rwl[(((d >> 8) * 16 + e) * 64 + ((d >> 2) & 63)) * 4 + (d & 3)] = rv[i]; } }
  if (tid < 16) lcnt[tid] = 0;
  __syncthreads();
  const int stride = gridDim.x * 8, row0 = bid * 8 + wid;
  const float rbias = p.router_b[lane >> 2];
  if (row0 < ntok) {
    Ln1Raw<F32IN> cur, nxt; ln1_load<F32IN>(p, Ybuf, row0, lane, cur);
    for (int row = row0; row < ntok; row += stride) {
      const int rn = row + stride < ntok ? row + stride : row;
      ln1_load<F32IN>(p, Ybuf, rn, lane, nxt);
      ln1_row<F32IN>(p, l, row, lane, cur, rwl, lcnt, rbias, dry);
      cur = nxt;
    }
  }
  __syncthreads();
  if (tid < 16) wsp<int>(p, WS_BCNT)[((size_t)l * 256 + bid) * 64 + tid] = lcnt[tid];
  __syncthreads();
}
__device__ __forceinline__ void phase_scatter(const Params& p, int l, LAS unsigned char* lds) {
  const int tid = mk::otid(), bid = mk::obid(), nb = gridDim.x;
  const bool last = l == DEPTH - 1; const int ntok = last ? NLAT : NTOK;
  LAS int* tot = (LAS int*)lds; LAS int* pre = tot + 16; LAS int* base = tot + 32; LAS int* lcur = tot + 48; LAS int* offs = tot + 64; LAS int* cnts = tot + 128;
  const int* bc = wsp<int>(p, WS_BCNT) + (size_t)l * 256 * 64;
  for (int b2 = tid; b2 < nb; b2 += NTHR) { const u32x4 c0 = *(const u32x4*)(bc + b2 * 64), c1 = *(const u32x4*)(bc + b2 * 64 + 4), c2 = *(const u32x4*)(bc + b2 * 64 + 8), c3 = *(const u32x4*)(bc + b2 * 64 + 12);
    *(LAS u32x4*)(cnts + b2 * 16) = c0; *(LAS u32x4*)(cnts + b2 * 16 + 4) = c1; *(LAS u32x4*)(cnts + b2 * 16 + 8) = c2; *(LAS u32x4*)(cnts + b2 * 16 + 12) = c3; }
  __syncthreads();
  if (tid < 16) { int t = 0, pr = 0; for (int b2 = 0; b2 < nb; ++b2) { const int v = cnts[b2 * 16 + tid]; pr += b2 < bid ? v : 0; t += v; } tot[tid] = t; pre[tid] = pr; lcur[tid] = 0; }
  __syncthreads();
  if (tid == 0) { int o = 0; int* mo = wsp<int>(p, WS_MOFF) + l * 64; for (int e = 0; e < 16; ++e) { offs[e] = o; base[e] = o + pre[e]; if (bid == 0) mo[e] = o; o += (tot[e] + 255) / 256 * 256; } offs[16] = o; if (bid == 0) mo[16] = o; }
  __syncthreads();
  const int* eid = wsp<int>(p, WS_EID); int* pos = wsp<int>(p, WS_POS); int* rl = wsp<int>(p, WS_RL);
  for (int n = tid; ; n += NTHR) { const int row = bid * 8 + (n & 7) + (n >> 3) * nb * 8; if (row >= ntok) break;
    const int e1 = eid[row * 2], e2 = eid[row * 2 + 1];
    const int p1 = base[e1] + __hip_atomic_fetch_add(lcur + e1, 1, __ATOMIC_RELAXED, __HIP_MEMORY_SCOPE_WORKGROUP), p2 = base[e2] + __hip_atomic_fetch_add(lcur + e2, 1, __ATOMIC_RELAXED, __HIP_MEMORY_SCOPE_WORKGROUP);
    pos[row * 2] = p1; pos[row * 2 + 1] = p2; rl[p1] = row; rl[p2] = row; }
  if (bid == 0) for (int e = 0; e < 16; ++e) for (int q = offs[e] + tot[e] + tid; q < offs[e + 1]; q += NTHR) rl[q] = 0;
}
struct Ln2Raw { u32x4 h[2], y1[2], y2[2]; };
__device__ __forceinline__ void ln2_load(const Params& p, bool last, int row, int lane, int p1, int p2, Ln2Raw& r) {
  const bf16_t* Ys = wsp<bf16_t>(p, WS_SCR + SM_YS); const bf16_t* ho = hb_ptr(p, row, last);
#pragma unroll
  for (int q = 0; q < 2; ++q) { const int col = q * 512 + lane * 8; r.h[q] = *(const u32x4*)(ho + col); r.y1[q] = *(const u32x4*)(Ys + (size_t)p1 * D + col); r.y2[q] = *(const u32x4*)(Ys + (size_t)p2 * D + col); }
}
__device__ __forceinline__ void unpack8(const u32x4 w, float (&o)[8]) { o[0] = bflo(w.x); o[1] = bfhi(w.x); o[2] = bflo(w.y); o[3] = bfhi(w.y); o[4] = bflo(w.z); o[5] = bfhi(w.z); o[6] = bflo(w.w); o[7] = bfhi(w.w); }
__device__ __forceinline__ void load8f(const float* q, float (&o)[8]) { const f32x4 a = *(const f32x4*)q, b = *(const f32x4*)(q + 4); o[0] = a[0]; o[1] = a[1]; o[2] = a[2]; o[3] = a[3]; o[4] = b[0]; o[5] = b[1]; o[6] = b[2]; o[7] = b[3]; }
__device__ __forceinline__ u32x4 pack8(const float (&v)[8]) { u32x4 w; w.x = cvt_pk_bf16(v[0], v[1]); w.y = cvt_pk_bf16(v[2], v[3]); w.z = cvt_pk_bf16(v[4], v[5]); w.w = cvt_pk_bf16(v[6], v[7]); return w; }
__device__ __forceinline__ void phase_ln2(const Params& p, int l, bool dry) {
  const int tid = mk::otid(), lane = tid & 63, wid = tid >> 6;
  const bool last = l == DEPTH - 1; const int ntok = last ? NLAT : NTOK;
  const int* pos = wsp<int>(p, WS_POS); const float* gatev = wsp<float>(p, WS_GATE); bf16_t* U = wsp<bf16_t>(p, WS_UO);
  const float* lg = p.ln_g + (size_t)(l * 2 + 1) * D; const float* lb = p.ln_b + (size_t)(l * 2 + 1) * D;
  const int stride = gridDim.x * 8, row0 = mk::obid() * 8 + wid;
  if (row0 >= ntok) return;
  auto clampr = [&](int r) { return r < ntok ? r : row0; };
  u32x2 pc = *(const u32x2*)(pos + 2 * row0); f32x2 gc = *(const f32x2*)(gatev + 2 * row0);
  Ln2Raw cur, nxt; ln2_load(p, last, row0, lane, (int)pc.x, (int)pc.y, cur);
  int r1 = clampr(row0 + stride);
  u32x2 pn = *(const u32x2*)(pos + 2 * r1); f32x2 gn = *(const f32x2*)(gatev + 2 * r1);
  for (int row = row0; row < ntok; row += stride) {
    ln2_load(p, last, r1, lane, (int)pn.x, (int)pn.y, nxt);
    const int r2 = clampr(row + 2 * stride);
    const u32x2 pn2 = *(const u32x2*)(pos + 2 * r2); const f32x2 gn2 = *(const f32x2*)(gatev + 2 * r2);
    bf16_t* hb = dry ? wsp<bf16_t>(p, WS_SCR + SM_XS) + (size_t)row * D : hb_ptr(p, row, false); float* hf = (dry ? wsp<float>(p, WS_SCR + SM_XS) : p.out) + (size_t)row * D; const int bi = bidx_of_row(row);
    const float* modl = wsp<float>(p, WS_MOD) + ((size_t)l * 5 + bi) * 6144;
    float v[2][8]; float s1 = 0.f;
#pragma unroll
    for (int q = 0; q < 2; ++q) { const int col = q * 512 + lane * 8; float hh[8], a1[8], a2[8], g2[8];
      unpack8(cur.h[q], hh); unpack8(cur.y1[q], a1); unpack8(cur.y2[q], a2); load8f(modl + 5 * 1024 + col, g2);
#pragma unroll
      for (int e = 0; e < 8; ++e) { v[q][e] = ALPHA * hh[e] + g2[e] * (gc[0] * a1[e] + gc[1] * a2[e]); s1 += v[q][e]; } }
    const float mu = wave_sum_u(s1) * (1.0f / D);
    float s2 = 0.f;
#pragma unroll
    for (int q = 0; q < 2; ++q)
#pragma unroll
      for (int e = 0; e < 8; ++e) { const float d = v[q][e] - mu; s2 += d * d; }
    const float rstd = rsqrtf(wave_sum_u(s2) * (1.0f / D) + LN_EPS);
    const float* modn = wsp<float>(p, WS_MOD) + ((size_t)(last ? l : l + 1) * 5 + bi) * 6144;
#pragma unroll
    for (int q = 0; q < 2; ++q) { const int col = q * 512 + lane * 8; float gg[8], bb[8];
      load8f(lg + col, gg); load8f(lb + col, bb);
#pragma unroll
      for (int e = 0; e < 8; ++e) v[q][e] = (v[q][e] - mu) * rstd * gg[e] + bb[e];
      if (last) { *(f32x4*)(hf + col) = (f32x4){v[q][0], v[q][1], v[q][2], v[q][3]}; *(f32x4*)(hf + col + 4) = (f32x4){v[q][4], v[q][5], v[q][6], v[q][7]}; }
      else { *(u32x4*)(hb + col) = pack8(v[q]); float sc[8], sh[8], u[8]; load8f(modn + 1024 + col, sc); load8f(modn + col, sh);
#pragma unroll
        for (int e = 0; e < 8; ++e) u[e] = v[q][e] * (1.0f + sc[e]) + sh[e];
        *(u32x4*)(U + (size_t)row * D + col) = pack8(u); } }
    cur = nxt; gc = gn; pn = pn2; gn = gn2; r1 = r2;
  }
}

struct SchedEvenIn { static constexpr bool GATHER = false; const bf16_t* U; const bf16_t* W; bf16_t* Pqk; bf16_t* Prw; bf16_t* Vt; int G, c;
  __device__ __forceinline__ bool next(int i, pg8::Unit& u) const { const int Lx = i * G + c; u.kind = 0;
    if (Lx < 1452) { const int grp = Lx / 44, rem = Lx % 44, pm = grp * 4 + (rem & 3), pi = rem >> 2; u.pm = pm; u.pn = pi;
      u.A = (const char*)(U + (size_t)pm * 256 * D); const int brow = pi < 4 ? pi * 256 : 1536 + (pi - 4) * 256; u.Bt = (const char*)(W + (size_t)brow * D);
      if (pi < 4) { u.out = Pqk; u.ldo = 1024; u.x1 = pi * 256; } else { u.out = Prw; u.ldo = RW_IN; u.x1 = (pi - 4) * 256; } u.x0 = pm * 256; return true; }
    if (Lx < 1452 + 264) { const int v = Lx - 1452, pmv = v & 1, pnv = v >> 1; u.pm = pmv; u.pn = pnv; u.A = (const char*)(W + (size_t)(1024 + pmv * 256) * D); u.Bt = (const char*)(U + (size_t)pnv * 256 * D);
      u.out = Vt; u.ldo = NTOK; u.x0 = pmv * 256; u.x1 = pnv * 256; return true; }
    return false; } };
struct SchedOddIn { static constexpr bool GATHER = false; const bf16_t* U; const bf16_t* W; bf16_t* Pqk; bf16_t* Vt; int G, c;
  __device__ __forceinline__ bool next(int i, pg8::Unit& u) const { const int Lx = i * G + c;
    if (Lx < 1056) { const int grp = Lx / 32, rem = Lx % 32, pm = grp * 4 + (rem & 3), pi = rem >> 2; u.pm = pm; u.pn = pi; u.kind = pm < 128 ? 1 : 0;
      u.A = (const char*)(U + (size_t)pm * 256 * D); u.Bt = (const char*)(W + (size_t)pi * 256 * D); u.out = Pqk; u.ldo = 2048; u.x0 = pm * 256; u.x1 = pi * 256; return true; }
    if (Lx < 1056 + 528) { const int v = Lx - 1056, pmv = v & 3, pnv = v >> 2; u.pm = pmv; u.pn = pnv; u.kind = 0; u.A = (const char*)(W + (size_t)(2048 + pmv * 256) * D); u.Bt = (const char*)(U + (size_t)pnv * 256 * D);
      u.out = Vt; u.ldo = NTOK; u.x0 = pmv * 256; u.x1 = pnv * 256; return true; }
    return false; } };
struct SchedOut { static constexpr bool GATHER = false; const bf16_t* O; const bf16_t* W; bf16_t* Y; int G, c;
  __device__ __forceinline__ bool next(int i, pg8::Unit& u) const { const int Lx = i * G + c; if (Lx >= 528) return false; const int pm = (Lx / 16) * 4 + (Lx & 3), pn = (Lx & 15) >> 2; u.pm = pm; u.pn = pn; u.kind = 0;
    u.A = (const char*)(O + (size_t)pm * 256 * D); u.Bt = (const char*)(W + (size_t)pn * 256 * D); u.out = Y; u.ldo = 1024; u.x0 = pm * 256; u.x1 = pn * 256; return true; } };
template <bool GATH>
struct SchedMoe { static constexpr bool GATHER = GATH; const bf16_t* A; const bf16_t* W; bf16_t* out; const LAS int* moff; const int* rl; int Kd, ldo, ncol, G, c;
  __device__ __forceinline__ bool next(int i, pg8::Unit& u) const { const int Lx = i * G + c; const int ntile = moff[16] >> 8; if (Lx >= ntile * 4) return false;
    const int pm = Lx >> 2, pn = Lx & 3; int e = 0;
#pragma unroll
    for (int j = 1; j < 16; ++j) e += (pm * 256 >= moff[j]) ? 1 : 0;
    u.pm = pm; u.pn = pn; u.kind = 0; u.A = GATH ? (const char*)A : (const char*)(A + (size_t)pm * 256 * Kd); u.rl = rl + pm * 256; u.Bt = (const char*)(W + ((size_t)e * 1024 + pn * 256) * Kd); u.out = out; u.ldo = ldo; u.x0 = pm * 256; u.x1 = pn * ncol; return true; } };

struct EpiOddIn {
  static constexpr bool PERM = true; const float* rope;
  __device__ __forceinline__ void operator()(const f32x4 (&acc)[2][2][4][2], const pg8::Unit& u, int wr, int wc, int fr, int fq) const {
    if (u.kind == 0) { pg8::EpiStoreBf16{}(acc, u, wr, wc, fr, fq); return; }
    const int row0 = u.x0 + wr * 64 + fr, col0 = u.x1 + wc * 32 + 8 * fq; const int half = wc & 1;
#pragma unroll
    for (int ai = 0; ai < 2; ++ai)
#pragma unroll
      for (int m = 0; m < 4; ++m) { const int row = row0 + ai * 128 + m * 16; const int t = row & (T - 1); const int pos = half ? (t & 63) : (t >> 6);
        const f32x4 cs0 = *(const f32x4*)(rope + (pos * 16 + 4 * fq) * 2), cs1 = *(const f32x4*)(rope + (pos * 16 + 4 * fq + 2) * 2);
        bf16_t* rowp = u.out + (size_t)row * u.ldo + col0;
#pragma unroll
        for (int bj = 0; bj < 2; ++bj) { const f32x4 v0 = acc[ai][bj][m][0], v1 = acc[ai][bj][m][1];
          u32x4 w; w.x = cvt_pk_bf16(v0[0] * cs0[0] - v0[1] * cs0[1], v0[0] * cs0[1] + v0[1] * cs0[0]); w.y = cvt_pk_bf16(v0[2] * cs0[2] - v0[3] * cs0[3], v0[2] * cs0[3] + v0[3] * cs0[2]);
          w.z = cvt_pk_bf16(v1[0] * cs1[0] - v1[1] * cs1[1], v1[0] * cs1[1] + v1[1] * cs1[0]); w.w = cvt_pk_bf16(v1[2] * cs1[2] - v1[3] * cs1[3], v1[2] * cs1[3] + v1[3] * cs1[2]);
          *(u32x4*)(rowp + bj * 128) = w; } }
  }
};
struct EpiGateUp {
  static constexpr bool PERM = true;
  __device__ __forceinline__ void operator()(const f32x4 (&acc)[2][2][4][2], const pg8::Unit& u, int wr, int wc, int fr, int fq) const {
    const int row0 = u.x0 + wr * 64 + fr, col0 = u.x1 + wc * 16 + 4 * fq;
#pragma unroll
    for (int ai = 0; ai < 2; ++ai)
#pragma unroll
      for (int m = 0; m < 4; ++m) { bf16_t* rowp = u.out + (size_t)(row0 + ai * 128 + m * 16) * u.ldo + col0;
#pragma unroll
        for (int bj = 0; bj < 2; ++bj) { const f32x4 v0 = acc[ai][bj][m][0], v1 = acc[ai][bj][m][1];
          u32x2 w; w.x = cvt_pk_bf16(siluf_(v0[0]) * v0[1], siluf_(v0[2]) * v0[3]); w.y = cvt_pk_bf16(siluf_(v1[0]) * v1[1], siluf_(v1[2]) * v1[3]);
          *(u32x2*)(rowp + bj * 64) = w; } }
  }
};
}

namespace mk {
constexpr int N_PHASES = 2 + 2 * (12 + 10);
__global__ void __launch_bounds__(NTHR, 2) mega(Params p_) {
  const Params& p = p_;
  extern __shared__ __attribute__((aligned(16))) unsigned char shm[];
  LAS unsigned char* lds = (LAS unsigned char*)shm;
  const int nb = gridDim.x;
  if (threadIdx.x == 0) *(LAS u32x4*)(lds + LDS_BARW) = (u32x4){0u, 0u, 0u, 0u};
  __syncthreads();
  XcdBarrier bar = xcd_barrier_post(wsp<unsigned>(p, WS_BAR), (volatile LAS unsigned*)(lds + LDS_BARW));
  int ph = 0;
#ifndef MK_MASK
#define MK_MASK 0xFFFFFFFFu
#endif
#ifndef MK_REP
#define MK_REP 0u
#endif
#define PHASE_BEGIN_K(k) if (((MK_MASK) >> (k)) & 1u) { Params pl_ = p_; asm volatile("" : "+s"(pl_.ws)); const Params& p = pl_; bf16_t* UO = wsp<bf16_t>(p, WS_UO); unsigned char* scr = p.ws + WS_SCR; (void)UO; (void)scr; \
    const int bid = mk::obid(); const int nrep_ = ((((MK_REP) >> (k)) & 1u) ? 2 : 1); for (int rep_ = 0; rep_ < nrep_; ++rep_) { const bool dry = rep_ + 1 < nrep_; (void)dry;
#define PHASE_END   } if (ph + 1 < N_PHASES) { XcdBarrier b_ = bar; asm volatile("" : "+s"(b_.bar), "+s"(b_.x)); xcd_barrier(b_); } } ++ph;
  bf16_t* UO = wsp<bf16_t>(p, WS_UO);
  unsigned char* scr = p.ws + WS_SCR;
  PHASE_BEGIN_K(0) phase_prologue(p, lds); PHASE_END
  PHASE_BEGIN_K(1) phase_mod0(p); PHASE_END
  for (int lp = 0; lp < 2; ++lp) {
    {
      const int l = 2 * lp;
      bf16_t* Pqk = (bf16_t*)(scr + SE_PQK); bf16_t* Vt = (bf16_t*)(scr + SE_VT); bf16_t* Prw = (bf16_t*)(scr + SE_PRW); bf16_t* Ybuf = (bf16_t*)(scr + SE_YBUF);
      rw::Bufs bf; bf.SH = (u32x2*)(scr + SE_SH); bf.DR = (unsigned*)(scr + SE_DR); bf.G = UO + 512; bf.gstride = 1024; bf.CS = (float*)(scr + SE_CS) + (size_t)lp * NTOK * 16; bf.PQ = (float*)(scr + SE_PQ); bf.SST = (float*)(scr + SE_SST); bf.Y = (bf16_t*)(scr + SE_Y); bf.Z = (bf16_t*)(scr + SE_Z);
      PHASE_BEGIN_K(2) { SchedEvenIn S{UO, wsp<bf16_t>(p, WS_WEIN) + (size_t)lp * EVEN_IN * D, Pqk, Prw, Vt, nb, bid}; pg8::gemm_phase(lds, D, S, pg8::EpiStoreBf16{}); } PHASE_END
      PHASE_BEGIN_K(3) {
#ifdef MK_P3
        if (!(dry && MK_P3 == 2))
#endif
        for (int u = bid; u < 1024 + 32; u += nb) { int b, h, rq; if (u < 1024) { b = u >> 8; h = (u >> 5) & 7; rq = u & 31; } else { const int v = u - 1024; b = v >> 3; h = v & 7; rq = -1; }
          natt::na_attn_unit(Pqk, Vt, p.na_rpb + ((size_t)lp * 8 + h) * 465, UO, b, h, rq, lds); }
        const int pb = (bid + nb / 2) % nb;
#ifdef MK_P3
        if (!(dry && MK_P3 == 1))
#endif
        for (int t = pb; t < NTOK / 16; t += nb) rw::prep_tile(Prw, p.shift_w + (size_t)lp * 3 * RW_IN, p.rw_w0 + lp * 1024, wsp<bf16_t>(p, WS_WLT) + (size_t)lp * 196608, p.rw_a0 + lp * 1024, p.rw_k_k + lp * 512, p.rw_k_a + lp * 512, p.rw_r_k + lp * 512, bf, t, (LAS float*)lds); } PHASE_END
      PHASE_BEGIN_K(4) for (int u = bid * 8 + (mk::otid() >> 6); u < rw::NCHAIN * rw::NCH; u += nb * 8) rw::scan_unit(bf, p.rw_k_a + lp * 512, u / rw::NCH, u % rw::NCH, (LAS float*)lds + (mk::otid() >> 6) * 4096); PHASE_END
      PHASE_BEGIN_K(5) for (int c = bid; c < rw::NCHAIN * 4; c += nb) rw::propagate_chain(bf, c >> 2, c & 3, (LAS float*)lds); PHASE_END
      PHASE_BEGIN_K(6) for (int u = bid * 8 + (mk::otid() >> 6); u < rw::NCHAIN * (rw::NCH - 1); u += nb * 8) rw::corr_unit(bf, u / (rw::NCH - 1), 1 + u % (rw::NCH - 1)); PHASE_END
      PHASE_BEGIN_K(7) rw::finish_phase<8>(bf, p.rw_gn_g + lp * 512, p.rw_gn_b + lp * 512, UO); PHASE_END
      PHASE_BEGIN_K(8) { SchedOut S{UO, wsp<bf16_t>(p, WS_WEOUT) + (size_t)lp * D * D, Ybuf, nb, bid}; pg8::gemm_phase(lds, D, S, pg8::EpiStoreBf16{}); __syncthreads(); cvt_experts(p, l, (LAS float*)lds, 528 - 2 * nb > 0 ? 528 - 2 * nb : 0); } PHASE_END
      PHASE_BEGIN_K(9) if (l == 0) phase_ln1<true>(p, l, Ybuf, lds, dry); else phase_ln1<false>(p, l, Ybuf, lds, dry); PHASE_END
      PHASE_BEGIN_K(10) phase_scatter(p, l, lds); PHASE_END
      PHASE_BEGIN_K(11) { LAS int* mo = (LAS int*)(lds + LDS_MISC); { const int tq = mk::otid(); if (tq < 17) mo[tq] = wsp<int>(p, WS_MOFF)[l * 64 + tq]; } __syncthreads();
        SchedMoe<true> S{UO, wsp<bf16_t>(p, WS_WGU), (bf16_t*)(scr + SM_HE), mo, wsp<int>(p, WS_RL), D, DE, 128, nb, bid}; pg8::gemm_phase(lds, D, S, EpiGateUp{}); } PHASE_END
      PHASE_BEGIN_K(12) { LAS int* mo = (LAS int*)(lds + LDS_MISC); { const int tq = mk::otid(); if (tq < 17) mo[tq] = wsp<int>(p, WS_MOFF)[l * 64 + tq]; } __syncthreads();
        SchedMoe<false> S{(bf16_t*)(scr + SM_HE), wsp<bf16_t>(p, WS_WDN), (bf16_t*)(scr + SM_YS), mo, nullptr, DE, D, 256, nb, bid}; pg8::gemm_phase(lds, DE, S, pg8::EpiStoreBf16{}); } PHASE_END
      PHASE_BEGIN_K(13) phase_ln2(p, l, dry); PHASE_END
    }
    {
      const int l = 2 * lp + 1; const bool last = l == DEPTH - 1;
      bf16_t* Pqk = (bf16_t*)(scr + SO_PQK); bf16_t* Vt = (bf16_t*)(scr + SO_VT); bf16_t* O12 = (bf16_t*)(scr + SO_O12); bf16_t* Ybuf = (bf16_t*)(scr + SO_YBUF);
      PHASE_BEGIN_K(14) { SchedOddIn S{UO, wsp<bf16_t>(p, WS_WOIN) + (size_t)lp * ODD_IN * D, Pqk, Vt, nb, bid}; pg8::gemm_phase(lds, D, S, EpiOddIn{wsp<float>(p, WS_ROPE)}); } PHASE_END
      float* KN = wsp<float>(p, WS_KN) + (size_t)lp * 256 * 32;
      PHASE_BEGIN_K(23) for (int g = bid; g < 256; g += nb) att::knorm_group(Pqk, KN, g, (LAS float*)lds); PHASE_END
      PHASE_BEGIN_K(15) for (int ui = bid; ui < 2048 + (last ? 0 : 64); ui += nb) { int b, hh, q0, nlat; const int u = (nb == 256 && ui < 2048) ? ((((ui >> 8) * 8 + (bid & 7)) << 5) | (bid >> 3)) : ui;
        if (u < 2048) { b = u >> 9; hh = (u >> 5) & 15; q0 = b * T + (u & 31) * 256; nlat = T; } else { const int v = u - 2048; b = v >> 4; hh = v & 15; q0 = NLAT + b * L; nlat = 0; }
        const bool st = __builtin_amdgcn_sqrtf(att::nmax2_of(KN, b, hh, 0) * att::nmax2_of(KN, b, hh, 1)) * 1.001f <= 60.0f;
#ifdef MK_ABL
        if (dry) att::diff_attn_unit<true, MK_ABL>(Pqk, Vt, O12, hh, q0, b * T, nlat, NLAT + b * L, lds); else
#endif
        if (st) att::diff_attn_unit<true>(Pqk, Vt, O12, hh, q0, b * T, nlat, NLAT + b * L, lds); else att::diff_attn_unit<false>(Pqk, Vt, O12, hh, q0, b * T, nlat, NLAT + b * L, lds); } PHASE_END
      PHASE_BEGIN_K(16) { float d1 = 0.f, d2 = 0.f; for (int i = 0; i < 64; ++i) { d1 += p.da_lq1[lp * 64 + i] * p.da_lk1[lp * 64 + i]; d2 += p.da_lq2[lp * 64 + i] * p.da_lk2[lp * 64 + i]; }
        const float li = 0.8f - 0.6f * expf(-0.3f * (float)l), lam = expf(d1) - expf(d2) + li;
        const int tq = mk::otid(); for (int r4 = bid; r4 < (last ? NLAT : NTOK) / 4; r4 += nb) att::diff_combine_rows4(O12, p.da_subln_g + lp * 128, lam, 1.0f - li, UO, r4 * 4, tq >> 6, tq & 63); } PHASE_END
      PHASE_BEGIN_K(17) { SchedOut S{UO, wsp<bf16_t>(p, WS_WOOUT) + (size_t)lp * D * D, Ybuf, nb, bid}; pg8::gemm_phase(lds, D, S, pg8::EpiStoreBf16{}); __syncthreads(); cvt_experts(p, l, (LAS float*)lds, 528 - 2 * nb > 0 ? 528 - 2 * nb : 0); } PHASE_END
      PHASE_BEGIN_K(18) phase_ln1<false>(p, l, Ybuf, lds, dry); PHASE_END
      PHASE_BEGIN_K(19) phase_scatter(p, l, lds); PHASE_END
      PHASE_BEGIN_K(20) { LAS int* mo = (LAS int*)(lds + LDS_MISC); { const int tq = mk::otid(); if (tq < 17) mo[tq] = wsp<int>(p, WS_MOFF)[l * 64 + tq]; } __syncthreads();
        SchedMoe<true> S{UO, wsp<bf16_t>(p, WS_WGU), (bf16_t*)(scr + SM_HE), mo, wsp<int>(p, WS_RL), D, DE, 128, nb, bid}; pg8::gemm_phase(lds, D, S, EpiGateUp{}); } PHASE_END
      PHASE_BEGIN_K(21) { LAS int* mo = (LAS int*)(lds + LDS_MISC); { const int tq = mk::otid(); if (tq < 17) mo[tq] = wsp<int>(p, WS_MOFF)[l * 64 + tq]; } __syncthreads();
        SchedMoe<false> S{(bf16_t*)(scr + SM_HE), wsp<bf16_t>(p, WS_WDN), (bf16_t*)(scr + SM_YS), mo, nullptr, DE, D, 256, nb, bid}; pg8::gemm_phase(lds, DE, S, pg8::EpiStoreBf16{}); } PHASE_END
      PHASE_BEGIN_K(22) phase_ln2(p, l, dry); PHASE_END
    }
  }
#undef PHASE_BEGIN_K
#undef PHASE_END
}
}

#ifndef MK_SINGLE_LAUNCH
#define MK_SINGLE_LAUNCH 1
#endif
extern "C" void kernel_launch(void* const* d_in, const int* in_sizes, int n_in, void* d_out, int out_size, void* d_ws, size_t ws_size, hipStream_t stream) {
  using namespace mk;
  static int grid = 0;
  if (grid == 0) {
    if (n_in != 34 || out_size != NLAT * D || ws_size < WS_END) { fprintf(stderr, "kernel_launch: unexpected shapes (n_in %d out %d ws %zu need %zu)\n", n_in, out_size, ws_size, (size_t)WS_END); grid = -1; return; }
    if (hipFuncSetAttribute((const void*)mega, hipFuncAttributeMaxDynamicSharedMemorySize, LDS_BYTES) != hipSuccess) { grid = -1; return; }
    int dev = 0, cus = 0, per_cu = 0;
    if (hipGetDevice(&dev) != hipSuccess || hipDeviceGetAttribute(&cus, hipDeviceAttributeMultiprocessorCount, dev) != hipSuccess) { grid = -1; return; }
    if (hipOccupancyMaxActiveBlocksPerMultiprocessor(&per_cu, (const void*)mega, NTHR, LDS_BYTES) != hipSuccess || per_cu < 1) { fprintf(stderr, "kernel_launch: occupancy query says %d\n", per_cu); }
    (void)hipGetLastError();
    grid = cus;
  }
  if (grid < 0) return;
  (void)hipMemsetAsync((char*)d_ws + WS_BAR, 0, (size_t)XCD_BAR_WORDS * 4, stream);
  Params p{};
  const float** pp = (const float**)&p;
  for (int i = 0; i < 34; ++i) pp[i] = (const float*)d_in[i];
  p.out = (float*)d_out; p.ws = (unsigned char*)d_ws;
#if MK_SINGLE_LAUNCH
  p.ph_lo = 0; p.ph_hi = N_PHASES;
  hipLaunchKernelGGL(mega, dim3(grid), dim3(NTHR), LDS_BYTES, stream, p);
#else
  for (int ph = 0; ph < N_PHASES; ++ph) { p.ph_lo = ph; p.ph_hi = ph + 1; hipLaunchKernelGGL(mega, dim3(grid), dim3(NTHR), LDS_BYTES, stream, p); }
#endif
}
```

```cpp
#include <hip/hip_runtime.h>
#include <stdint.h>
#include <stdio.h>

typedef unsigned short bf16_t;
typedef short bf16x8 __attribute__((ext_vector_type(8)));
typedef float f32x4 __attribute__((ext_vector_type(4)));
typedef float f32x2 __attribute__((ext_vector_type(2)));
typedef float f32x16 __attribute__((ext_vector_type(16)));
typedef unsigned u32x4 __attribute__((ext_vector_type(4)));
typedef unsigned u32x2 __attribute__((ext_vector_type(2)));
#define LAS __attribute__((address_space(3)))

namespace mk {
constexpr int B = 4, T = 8192, L = 256, D = 1024, NLAT = B * T, NCTX = B * L, NTOK = NLAT + NCTX;
constexpr int DEPTH = 4, EVEN_IN = 3328, ODD_IN = 3072, RW_OFF = 1536, RW_IN = 1792, NE = 16, DE = 512;
constexpr float ALPHA = 1.681792830507429f, LN_EPS = 1e-5f;
constexpr int NTHR = 512, LDS_BYTES = 147456;
constexpr int MOE_TILES = 280, MOE_ROWS = MOE_TILES * 256;

typedef __bf16 bf16x2v __attribute__((ext_vector_type(2)));
__device__ __forceinline__ unsigned cvt_pk_bf16(float lo, float hi) { const f32x2 v = {lo, hi}; return __builtin_bit_cast(unsigned, __builtin_convertvector(v, bf16x2v)); }
__device__ __forceinline__ unsigned cvt_pk_bf16_v(float lo, float hi) { return cvt_pk_bf16(lo, hi); }
template <int V> struct IntC { static constexpr int value = V; };
__device__ __forceinline__ float bf2f(bf16_t b) { return __uint_as_float(((unsigned)b) << 16); }
__device__ __forceinline__ float bflo(unsigned w) { return __uint_as_float(w << 16); }
__device__ __forceinline__ float bfhi(unsigned w) { return __uint_as_float(w & 0xffff0000u); }
__device__ __forceinline__ bf16_t f2bf(float f) { return (bf16_t)(cvt_pk_bf16(f, 0.f) & 0xffffu); }
__device__ __forceinline__ float sigmoidf_(float x) { return 1.0f / (1.0f + __expf(-x)); }
__device__ __forceinline__ float siluf_(float x) { return x / (1.0f + __expf(-x)); }
__device__ __forceinline__ float wave_sum(float v) {
#pragma unroll
  for (int o = 32; o > 0; o >>= 1) v += __shfl_xor(v, o);
  return v;
}
template <int CTRL, int RM, int BM> __device__ __forceinline__ float dpp_mov(float old, float v) { return __int_as_float(__builtin_amdgcn_update_dpp(__float_as_int(old), __float_as_int(v), CTRL, RM, BM, false)); }
__device__ __forceinline__ float wave_sum_u(float v) {
  v += dpp_mov<0xB1, 0xf, 0xf>(v, v);
  v += dpp_mov<0x4E, 0xf, 0xf>(v, v);
  v += dpp_mov<0x141, 0xf, 0xf>(v, v);
  v += dpp_mov<0x140, 0xf, 0xf>(v, v);
  v += dpp_mov<0x142, 0xa, 0xf>(0.f, v);
  v += dpp_mov<0x143, 0xc, 0xf>(0.f, v);
  return __int_as_float(__builtin_amdgcn_readlane(__float_as_int(v), 63));
}
__device__ __forceinline__ float wave_max_u(float v) {
  v = fmaxf(v, dpp_mov<0xB1, 0xf, 0xf>(v, v));
  v = fmaxf(v, dpp_mov<0x4E, 0xf, 0xf>(v, v));
  v = fmaxf(v, dpp_mov<0x141, 0xf, 0xf>(v, v));
  v = fmaxf(v, dpp_mov<0x140, 0xf, 0xf>(v, v));
  v = fmaxf(v, dpp_mov<0x142, 0xa, 0xf>(0.f, v));
  v = fmaxf(v, dpp_mov<0x143, 0xc, 0xf>(0.f, v));
  return __int_as_float(__builtin_amdgcn_readlane(__float_as_int(v), 63));
}
__device__ __forceinline__ f32x16 zero16() { float z = 0.f; asm volatile("" : "+v"(z)); f32x16 r;
#pragma unroll
  for (int i = 0; i < 16; ++i) r[i] = z;
  return r; }
__device__ __forceinline__ int otid() { int t = threadIdx.x; asm volatile("" : "+v"(t)); return t; }
__device__ __forceinline__ int obid() { int b = blockIdx.x; asm volatile("" : "+s"(b)); return b; }
__device__ __forceinline__ int bidx_of_row(int row) { return row < NLAT ? row / T : 4; }
}

#include <vector>

#define XB_TMO      128
#define XB_XCNT(j)  (256  + 64 * (j))
#define XB_XSUB(j)  (1280 + 64 * (j))
#define XB_XGEN(j)  (2304 + 64 * (j))
#define XB_TOP      3328
#define XB_TOPGEN   3392
#define XCD_BAR_WORDS 3456
#define XB_SPIN_CAP (1u << 18)
#define LAS __attribute__((address_space(3)))

__device__ __forceinline__ unsigned xb_ld(unsigned* p)              { return __hip_atomic_load(p, __ATOMIC_RELAXED, __HIP_MEMORY_SCOPE_AGENT); }
__device__ __forceinline__ unsigned xb_add(unsigned* p, unsigned v) { return __hip_atomic_fetch_add(p, v, __ATOMIC_RELAXED, __HIP_MEMORY_SCOPE_AGENT); }
__device__ __forceinline__ unsigned xb_xcc_id() { return (unsigned)__builtin_amdgcn_s_getreg((3 << 11) | 20) & 0xFu; }
#define XB_SPIN(cond, bar) do { unsigned _sp = 0; while (cond) { __builtin_amdgcn_s_sleep(1); \
    if ((++_sp & 255u) == 0u) { if (xb_ld(&(bar)[XB_TMO])) break; if (_sp > XB_SPIN_CAP) { atomicAdd(&(bar)[XB_TMO], 1u); break; } } } } while (0)

struct XcdBarrier {
    unsigned* bar; unsigned x;
    volatile LAS unsigned* st;
};

__device__ __forceinline__ XcdBarrier xcd_barrier_post(unsigned* bar, volatile LAS unsigned* st) {
    XcdBarrier b; b.bar = bar; b.x = xb_xcc_id(); b.st = st;
    if (threadIdx.x == 0) (void)xb_add(&bar[XB_XCNT(b.x)], 1u);
    return b;
}
__device__ __forceinline__ void xcd_barrier_complete(unsigned* bar, unsigned x, unsigned& nloc, unsigned& nx) {
    const unsigned G = gridDim.x * gridDim.y * gridDim.z;
    unsigned sum, cnt, mine, sp = 0u;
    for (;;) {
        sum = 0u; cnt = 0u; mine = 0u;
#pragma unroll
        for (unsigned j = 0; j < 16; ++j) { const unsigned c = xb_ld(&bar[XB_XCNT(j)]); sum += c; cnt += (c > 0u) ? 1u : 0u; mine = (j == x) ? c : mine; }
        if (sum == G) break;
        __builtin_amdgcn_s_sleep(1);
        if ((++sp & 255u) == 0u) { if (xb_ld(&bar[XB_TMO])) break; if (sp > XB_SPIN_CAP) { atomicAdd(&bar[XB_TMO], 1u); break; } }
    }
    nloc = mine > 0u ? mine : 1u; nx = cnt > 0u ? cnt : 1u;
}

__device__ __forceinline__ void xcd_barrier(const XcdBarrier& b) {
    asm volatile("s_waitcnt vmcnt(0)" ::: "memory");
    __syncthreads();
    if (threadIdx.x == 0) {
        unsigned* bar = b.bar;
        __builtin_amdgcn_s_waitcnt(0);
        unsigned nloc = b.st[0], nx = b.st[1];
        if (nloc == 0u) { xcd_barrier_complete(bar, b.x, nloc, nx); b.st[0] = nloc; b.st[1] = nx; }
        const unsigned old = xb_add(&bar[XB_XSUB(b.x)], 1u);
        const unsigned gen = old / nloc;
        if (old + 1u == (gen + 1u) * nloc) {
            __builtin_amdgcn_fence(__ATOMIC_RELEASE, "agent");
            asm volatile("s_waitcnt vmcnt(0)" ::: "memory");
            const unsigned og = xb_add(&bar[XB_TOP], 1u);
            const unsigned tg = og / nx;
            if (og + 1u == (tg + 1u) * nx) xb_add(&bar[XB_TOPGEN], 1u);
            else XB_SPIN(xb_ld(&bar[XB_TOPGEN]) == tg, bar);
            __builtin_amdgcn_fence(__ATOMIC_ACQUIRE, "agent");
            xb_add(&bar[XB_XGEN(b.x)], 1u);
            asm volatile("s_waitcnt vmcnt(0)" ::: "memory");
        } else {
            XB_SPIN(xb_ld(&bar[XB_XGEN(b.x)]) == gen, bar);
            __builtin_amdgcn_fence(__ATOMIC_ACQUIRE, "agent");
            asm volatile("s_waitcnt vmcnt(0)" ::: "memory");
        }
    }
    __syncthreads();
}

namespace pg8 {
using mk::cvt_pk_bf16;
constexpr int BM = 256, BK = 64, HALF = 128, HTB = HALF * BK * 2  , STAGE_BYTES = 8 * HTB;
__host__ __device__ __forceinline__ int lds_byte(int r, int c) { const int st = (r >> 4) * 2 + (c >> 5), rr = r & 15, cc = c & 31, ob = rr * 64 + cc * 2; return st * 1024 + (ob ^ (((ob >> 9) & 1) << 5)); }
__host__ __device__ __forceinline__ void stage_rc(int b, int& R, int& C) { const int st = b / 1024, sb = b % 1024, swz = sb ^ (((sb >> 9) & 1) << 5); R = (st >> 1) * 16 + swz / 64; C = (st & 1) * 32 + (swz % 64) / 2; }
__host__ __device__ __forceinline__ int perm32(int rho) { const int n = rho >> 4, i = rho & 15; return 8 * (i >> 2) + 4 * n + (i & 3); }

struct Unit { const char* A; const char* Bt; bf16_t* out; const int* rl; int pm, pn, x0, x1, ldo, kind; };

template <class Epi, class Sched>
__device__ __forceinline__ void gemm_phase(LAS unsigned char* lds, const int K, const Sched& S, const Epi& E) {
    const int tid = mk::otid(), wid = __builtin_amdgcn_readfirstlane(tid >> 6), lane = tid & 63, wr = wid >> 2, wc = wid & 3, fr = lane & 15, fq = lane >> 4;
    const int nt = K / BK;
    constexpr bool GATH = Sched::GATHER;
    unsigned voffA[2], voffB[2]; int Rl[2], Cl[2];
#pragma unroll
    for (int i = 0; i < 2; ++i) { int R, C; stage_rc(tid * 16 + i * 8192, R, C); const int Rb = Epi::PERM ? ((R & ~31) + perm32(R & 31)) : R; Rl[i] = R; Cl[i] = C;
        voffA[i] = (unsigned)(R * K + C) * 2u; voffB[i] = (unsigned)(Rb * K + C) * 2u; }
    unsigned roC[2][2], roN[2][2];
    (void)Rl; (void)Cl;
    const size_t kstep = (size_t)(BK * 2);
    const size_t hstep = (size_t)HALF * K * 2;
    const unsigned ldsw = (unsigned)wid * 1024u;
    const int aoff = lds_byte(wr * 64 + fr, fq * 8), boff = lds_byte(wc * 32 + fr, fq * 8);
#define PG8_SA(b, h) (((b) * 2 + (h)) * HTB)
#define PG8_SB(b, h) ((4 + (b) * 2 + (h)) * HTB)
#define PG8_STAGE(bufoff, gbase, voff) do { _Pragma("unroll") for (int _i = 0; _i < 2; ++_i) \
        __builtin_amdgcn_global_load_lds((const unsigned*)((const char*)(gbase) + (voff)[_i]), (LAS unsigned*)(lds + (bufoff) + ldsw + _i * 8192), 16, 0, 0); } while (0)
#define PG8_STAGE_A(bufoff, gbase, h, ro) do { if constexpr (GATH) { _Pragma("unroll") for (int _i = 0; _i < 2; ++_i) \
        __builtin_amdgcn_global_load_lds((const unsigned*)((const char*)(gbase) + (ro)[h][_i]), (LAS unsigned*)(lds + (bufoff) + ldsw + _i * 8192), 16, 0, 0); } \
      else { PG8_STAGE(bufoff, (const char*)(gbase) + (h) * hstep, voffA); } } while (0)
#define PG8_LOAD_RO(u, ro) do { _Pragma("unroll") for (int _h = 0; _h < 2; ++_h) _Pragma("unroll") for (int _i = 0; _i < 2; ++_i) \
        (ro)[_h][_i] = (unsigned)(u).rl[Rl[_i] + _h * 128] * (unsigned)(K * 2) + (unsigned)(Cl[_i] * 2); } while (0)
#define PG8_LDA(dst, b, h) do { _Pragma("unroll") for (int m = 0; m < 4; ++m) _Pragma("unroll") for (int k = 0; k < 2; ++k) dst[m][k] = *(const LAS bf16x8*)(lds + PG8_SA(b, h) + aoff + m * 2048 + k * 1024); } while (0)
#define PG8_LDB(dst, b, h) do { _Pragma("unroll") for (int n = 0; n < 2; ++n) _Pragma("unroll") for (int k = 0; k < 2; ++k) dst[n][k] = *(const LAS bf16x8*)(lds + PG8_SB(b, h) + boff + n * 2048 + k * 1024); } while (0)
#define PG8_MMA(ai, bj, At, Bt) do { __builtin_amdgcn_s_setprio(1); _Pragma("unroll") for (int m = 0; m < 4; ++m) _Pragma("unroll") for (int n = 0; n < 2; ++n) _Pragma("unroll") for (int k = 0; k < 2; ++k) \
        acc[ai][bj][m][n] = __builtin_amdgcn_mfma_f32_16x16x32_bf16(Bt[n][k], At[m][k], acc[ai][bj][m][n], 0, 0, 0); __builtin_amdgcn_s_setprio(0); } while (0)
#define PG8_WAIT_V(n) asm volatile("s_waitcnt vmcnt(" #n ")" ::: "memory")
#define PG8_WAIT_L(n) asm volatile("s_waitcnt lgkmcnt(" #n ")" ::: "memory")
#define PG8_BAR __builtin_amdgcn_s_barrier()
#define PG8_SCHED __builtin_amdgcn_sched_barrier(0)
    Unit cur, nxt; int ui = 0;
    if (!S.next(0, cur)) return;
    f32x4 acc[2][2][4][2];
#pragma unroll
    for (int a = 0; a < 2; ++a)
#pragma unroll
        for (int b = 0; b < 2; ++b)
#pragma unroll
            for (int m = 0; m < 4; ++m)
#pragma unroll
                for (int n = 0; n < 2; ++n) acc[a][b][m][n] = (f32x4){0.f, 0.f, 0.f, 0.f};
    bf16x8 At[4][2], B0[2][2], B1[2][2];
    const char* cA = cur.A; const char* cB = cur.Bt;
    if constexpr (GATH) { PG8_LOAD_RO(cur, roC); }
    PG8_STAGE(PG8_SB(0, 0), cB, voffB); PG8_STAGE_A(PG8_SA(0, 0), cA, 0, roC); PG8_STAGE(PG8_SB(0, 1), cB + hstep, voffB); PG8_STAGE_A(PG8_SA(0, 1), cA, 1, roC);
    if (wr == 1) PG8_BAR;
    PG8_WAIT_V(4); PG8_BAR;
    PG8_STAGE(PG8_SB(1, 0), cB + kstep, voffB); PG8_STAGE_A(PG8_SA(1, 0), cA + kstep, 0, roC); PG8_STAGE(PG8_SB(1, 1), cB + hstep + kstep, voffB);
    PG8_WAIT_V(6); PG8_BAR;
    for (;;) {
        const bool has_next = S.next(ui + 1, nxt);
        const char* nA = has_next ? nxt.A : cA; const char* nB = has_next ? nxt.Bt : cB;
        if constexpr (GATH) { if (has_next) { PG8_LOAD_RO(nxt, roN); } else { _Pragma("unroll") for (int _h = 0; _h < 2; ++_h) _Pragma("unroll") for (int _i = 0; _i < 2; ++_i) roN[_h][_i] = roC[_h][_i]; } }
        for (int t = 0; t < nt; t += 2) {
            const bool last = (t == nt - 2);
            const char* a1 = cA + (size_t)(t + 1) * kstep;
            const char* a2 = last ? nA : cA + (size_t)(t + 2) * kstep; const char* b2 = last ? nB : cB + (size_t)(t + 2) * kstep;
            const char* a3 = a2 + kstep; const char* b3 = b2 + kstep;
            unsigned ro2[2][2];
            if constexpr (GATH) { _Pragma("unroll") for (int _h = 0; _h < 2; ++_h) _Pragma("unroll") for (int _i = 0; _i < 2; ++_i) ro2[_h][_i] = last ? roN[_h][_i] : roC[_h][_i]; }
            (void)ro2;
            PG8_LDB(B0, 0, 0); PG8_SCHED; PG8_LDA(At, 0, 0); PG8_STAGE_A(PG8_SA(1, 1), a1, 1, roC);
            PG8_WAIT_L(8); PG8_BAR; PG8_WAIT_L(0); PG8_MMA(0, 0, At, B0); PG8_BAR; PG8_SCHED;
            PG8_LDB(B1, 0, 1); PG8_STAGE(PG8_SB(0, 0), b2, voffB);
            PG8_BAR; PG8_WAIT_L(0); PG8_MMA(0, 1, At, B1); PG8_BAR;
            PG8_LDA(At, 0, 1); PG8_STAGE_A(PG8_SA(0, 0), a2, 0, ro2);
            PG8_BAR; PG8_WAIT_L(0); PG8_MMA(1, 0, At, B0); PG8_BAR; PG8_SCHED;
            PG8_STAGE(PG8_SB(0, 1), b2 + hstep, voffB);
            PG8_WAIT_V(6); PG8_BAR; PG8_MMA(1, 1, At, B1); PG8_BAR;
            PG8_LDB(B0, 1, 0); PG8_SCHED; PG8_LDA(At, 1, 0); PG8_STAGE_A(PG8_SA(0, 1), a2, 1, ro2);
            PG8_WAIT_L(8); PG8_BAR; PG8_WAIT_L(0); PG8_MMA(0, 0, At, B0); PG8_BAR; PG8_SCHED;
            PG8_LDB(B1, 1, 1); PG8_STAGE(PG8_SB(1, 0), b3, voffB);
            PG8_BAR; PG8_WAIT_L(0); PG8_MMA(0, 1, At, B1); PG8_BAR;
            PG8_LDA(At, 1, 1); PG8_STAGE_A(PG8_SA(1, 0), a3, 0, ro2);
            PG8_BAR; PG8_WAIT_L(0); PG8_MMA(1, 0, At, B0); PG8_BAR; PG8_SCHED;
            PG8_STAGE(PG8_SB(1, 1), b3 + hstep, voffB);
            PG8_WAIT_V(6); PG8_BAR; PG8_MMA(1, 1, At, B1); PG8_BAR;
        }
        E(acc, cur, wr, wc, fr, fq);
        if (!has_next) break;
#pragma unroll
        for (int a = 0; a < 2; ++a)
#pragma unroll
            for (int b = 0; b < 2; ++b)
#pragma unroll
                for (int m = 0; m < 4; ++m)
#pragma unroll
                    for (int n = 0; n < 2; ++n) acc[a][b][m][n] = (f32x4){0.f, 0.f, 0.f, 0.f};
        cur = nxt; cA = nA; cB = nB; ++ui;
        if constexpr (GATH) { _Pragma("unroll") for (int _h = 0; _h < 2; ++_h) _Pragma("unroll") for (int _i = 0; _i < 2; ++_i) roC[_h][_i] = roN[_h][_i]; }
    }
    PG8_WAIT_V(0);
    if (wr == 0) PG8_BAR;
    PG8_BAR;
#undef PG8_SA
#undef PG8_SB
#undef PG8_STAGE
#undef PG8_STAGE_A
#undef PG8_LOAD_RO
#undef PG8_LDA
#undef PG8_LDB
#undef PG8_MMA
#undef PG8_WAIT_V
#undef PG8_WAIT_L
#undef PG8_BAR
#undef PG8_SCHED
}

struct EpiStoreBf16 {
    static constexpr bool PERM = true;
    __device__ __forceinline__ void operator()(const f32x4 (&acc)[2][2][4][2], const Unit& u, int wr, int wc, int fr, int fq) const {
        bf16_t* O = u.out; const int ldc = u.ldo;
        const int row0 = u.x0 + wr * 64 + fr, col0 = u.x1 + wc * 32 + 8 * fq;
#pragma unroll
        for (int ai = 0; ai < 2; ++ai)
#pragma unroll
            for (int m = 0; m < 4; ++m) { bf16_t* rowp = O + (size_t)(row0 + ai * HALF + m * 16) * ldc + col0;
#pragma unroll
                for (int bj = 0; bj < 2; ++bj) { const f32x4 v0 = acc[ai][bj][m][0], v1 = acc[ai][bj][m][1];
                    u32x4 w; w.x = cvt_pk_bf16(v0[0], v0[1]); w.y = cvt_pk_bf16(v0[2], v0[3]); w.z = cvt_pk_bf16(v1[0], v1[1]); w.w = cvt_pk_bf16(v1[2], v1[3]);
                    *(u32x4*)(rowp + bj * HALF) = w; } }
    }
};
}

namespace mk {
struct NMapId { int off; __device__ __forceinline__ int operator()(int n) const { return n + off; } __device__ __forceinline__ float scl(int) const { return 1.0f; } };
struct NMapInterleave { int which; __device__ __forceinline__ int operator()(int n) const { return 2 * n + which; } __device__ __forceinline__ float scl(int) const { return 1.0f; } };
struct NMapRope { __device__ __forceinline__ int operator()(int n) const { if (n >= 2048) return n; const int ch = n >> 6, c = n & 63, half = c >> 5, w = c & 31, z = w >> 4, i = w & 15; return ch * 64 + half * 32 + 2 * i + z; }
  __device__ __forceinline__ float scl(int n) const { return n < 1024 ? 0.125f * 1.4426950408889634f : 1.0f; } };

template <class NMap>
__device__ __forceinline__ void cvt_tile(const float* __restrict__ src, int ldsrc, int K, bf16_t* __restrict__ dst, int k0, int n0, const NMap& nmap, LAS float* tile) {
  const int t = mk::otid();
  { const int k = t >> 3, c = (t & 7) * 8; const float* p = src + (size_t)(k0 + k) * ldsrc + n0 + c;
    const f32x4 a = *(const f32x4*)p, b = *(const f32x4*)(p + 4);
    LAS float* q = tile + k * 65 + c; q[0] = a[0]; q[1] = a[1]; q[2] = a[2]; q[3] = a[3]; q[4] = b[0]; q[5] = b[1]; q[6] = b[2]; q[7] = b[3]; }
  __syncthreads();
  { const int n = t >> 3, kc = (t & 7) * 8; const LAS float* q = tile + kc * 65 + n; const float sc = nmap.scl(n0 + n);
    u32x4 w; w.x = cvt_pk_bf16(q[0] * sc, q[65] * sc); w.y = cvt_pk_bf16(q[130] * sc, q[195] * sc); w.z = cvt_pk_bf16(q[260] * sc, q[325] * sc); w.w = cvt_pk_bf16(q[390] * sc, q[455] * sc);
    *(u32x4*)(dst + (size_t)nmap(n0 + n) * K + k0 + kc) = w; }
  __syncthreads();
}
template <class NMap>
__device__ __forceinline__ int cvt_matrix(const float* src, int ldsrc, int K, int N, bf16_t* dst, const NMap& nmap, LAS float* tile, int ubase, int bid, int nblk) {
  const int nkt = K / 64, nnt = N / 64, tot = nkt * nnt;
  int first = ubase + ((bid - ubase % nblk) + nblk) % nblk;
  for (int u = first; u < ubase + tot; u += nblk) { const int v = u - ubase; cvt_tile(src, ldsrc, K, dst, (v / nnt) * 64, (v % nnt) * 64, nmap, tile); }
  return tot;
}
}

namespace att {
using namespace mk;
constexpr int KB_BYTES = 64 * 128, VB_BYTES = 128 * 128, TILE_BYTES = KB_BYTES + VB_BYTES, DA_RING = 4, DA_LDS = DA_RING * TILE_BYTES;
__device__ __forceinline__ int pi32(int r) { return (r & ~12) | ((r & 4) << 1) | ((r & 8) >> 1); }
__device__ __forceinline__ int swz(int row, int chunk) { return row * 128 + ((chunk ^ ((row >> 1) & 7)) << 4); }
__device__ __forceinline__ int crow(int r, int hi) { return (r & 3) + 8 * (r >> 2) + 4 * hi; }

__device__ __forceinline__ float sumsq8(u32x4 w) { return (bflo(w.x) * bflo(w.x) + bfhi(w.x) * bfhi(w.x)) + (bflo(w.y) * bflo(w.y) + bfhi(w.y) * bfhi(w.y)) + (bflo(w.z) * bflo(w.z) + bfhi(w.z) * bfhi(w.z)) + (bflo(w.w) * bflo(w.w) + bfhi(w.w) * bfhi(w.w)); }
__device__ __forceinline__ void knorm_group(const bf16_t* __restrict__ Pqk, float* __restrict__ KN, int g, LAS float* red) {
  const int tid = mk::otid(), wid = tid >> 6, lane = tid & 63;
  float mx = 0.f, mq = 0.f;
  for (int i0 = 0; i0 < 160; i0 += 32) {
    u32x4 a[4], b[4], c[4], d[4];
#pragma unroll
    for (int j = 0; j < 4; ++j) { int i = i0 + j * 8 + wid; i = i < 132 ? i : wid; const int row = i < 128 ? g * 128 + i : NLAT + g * 4 + (i - 128);
      const bf16_t* kp = Pqk + (size_t)row * 2048 + 1024 + lane * 16; a[j] = *(const u32x4*)kp; b[j] = *(const u32x4*)(kp + 8); c[j] = *(const u32x4*)(kp - 1024); d[j] = *(const u32x4*)(kp - 1024 + 8); }
#pragma unroll
    for (int j = 0; j < 4; ++j) { float s = sumsq8(a[j]) + sumsq8(b[j]); s += dpp_mov<0xB1, 0xf, 0xf>(s, s); s += dpp_mov<0x4E, 0xf, 0xf>(s, s); mx = fmaxf(mx, s);
      float q = sumsq8(c[j]) + sumsq8(d[j]); q += dpp_mov<0xB1, 0xf, 0xf>(q, q); q += dpp_mov<0x4E, 0xf, 0xf>(q, q); mq = fmaxf(mq, q); }
  }
  if ((lane & 3) == 0) { red[wid * 32 + (lane >> 2)] = mx; red[wid * 32 + 16 + (lane >> 2)] = mq; }
  __syncthreads();
  if (tid < 32) { float m = red[tid];
#pragma unroll
    for (int w = 1; w < 8; ++w) m = fmaxf(m, red[w * 32 + tid]);
    KN[g * 32 + tid] = m; }
  __syncthreads();
}
__device__ __forceinline__ float nmax2_of(const float* __restrict__ KN, int b, int hh, int which) {
  return wave_max_u(KN[(b * 64 + (mk::otid() & 63)) * 32 + which * 16 + hh]);
}

template <bool STATIC, int ABL = 0>
__device__ __forceinline__ void diff_attn_unit(const bf16_t* __restrict__ Pqk, const bf16_t* __restrict__ Vt, bf16_t* __restrict__ O12, int hh, int q0, int klat0, int nlat, int kctx0, LAS unsigned char* lds) {
  const int tid = mk::otid(), wid = tid >> 6, lane = tid & 63, r = lane & 31, hi = lane >> 5;
  const int NT = (nlat + L) / 64, NTL = nlat / 64;
  const int wv = __builtin_amdgcn_readfirstlane(wid);
  const int drow = wv * 8 + (lane >> 3), dch = (lane & 7) ^ ((drow >> 1) & 7);
  const unsigned koff = (unsigned)(drow * 2048 + 1024 + hh * 64 + dch * 8) * 2u;
  const unsigned voff = (unsigned)(((hh >> 1) * 128 + drow) * NTOK + dch * 8) * 2u;
  bf16x8 qf[4];
  { const bf16_t* qp = Pqk + (size_t)(q0 + wid * 32 + r) * 2048 + hh * 64 + hi * 8;
#pragma unroll
    for (int ks = 0; ks < 4; ++ks) qf[ks] = *(const bf16x8*)(qp + ks * 16); }
  const unsigned kaddr0 = (unsigned)(pi32(r) * 128 + ((hi ^ ((pi32(r) >> 1) & 7)) << 4));
  const unsigned vaddr0 = (unsigned)(r * 128 + ((hi ^ ((r >> 1) & 7)) << 4)) + KB_BYTES;
  f32x16 o[4];
#pragma unroll
  for (int vb = 0; vb < 4; ++vb)
#pragma unroll
    for (int i = 0; i < 16; ++i) o[vb][i] = 0.f;
  float l_run = 0.f;
#define DA_DMA(t) do { const int tok = (t) < NTL ? klat0 + (t) * 64 : kctx0 + ((t) - NTL) * 64; LAS unsigned char* b_ = lds + ((t) & 3) * TILE_BYTES + wv * 1024; \
    const char* kt_ = (const char*)Pqk + (size_t)tok * 4096; const char* vt_ = (const char*)Vt + (size_t)tok * 2; \
    __builtin_amdgcn_global_load_lds((const unsigned*)(kt_ + koff), (LAS unsigned*)b_, 16, 0, 0); \
    __builtin_amdgcn_global_load_lds((const unsigned*)(vt_ + voff), (LAS unsigned*)(b_ + KB_BYTES), 16, 0, 0); \
    __builtin_amdgcn_global_load_lds((const unsigned*)(vt_ + (size_t)64 * NTOK * 2 + voff), (LAS unsigned*)(b_ + KB_BYTES + 8192), 16, 0, 0); } while (0)
#define DA_WAITV(n) asm volatile("s_waitcnt vmcnt(" #n ")" ::: "memory")
#define DA_PAIR_BEGIN(t) if (!(ABL & 8) && (t) + 2 < NT) { DA_DMA((t) + 2); DA_DMA((t) + 3); }
#define DA_SLOT(tt) const unsigned sb_ = (unsigned)(((tt) & 3) * TILE_BYTES); const LAS unsigned char* kb_ = lds + (kaddr0 + sb_); const LAS unsigned char* vb_ = lds + (vaddr0 + sb_)
#define DA_PAIR_END() do { DA_WAITV(0); asm volatile("s_waitcnt lgkmcnt(0)" ::: "memory"); if (!(ABL & 16)) __builtin_amdgcn_s_barrier(); } while (0)
  DA_DMA(0); DA_DMA(1);
  DA_WAITV(0); __builtin_amdgcn_s_barrier();
#define DA_XOR(ptr, x) ((const LAS unsigned char*)((unsigned)(size_t)(ptr) ^ (unsigned)(x)))
#define DA_KFRAG(ks) const LAS unsigned char* kp_ = DA_XOR(kb_, (ks) << 5); const bf16x8 a0 = (ABL & 2) ? qf[ks] : *(const LAS bf16x8*)kp_, a1 = (ABL & 2) ? qf[(ks) ^ 1] : *(const LAS bf16x8*)(kp_ + 4096)
#define DA_VFRAGS() bf16x8 va[4][4]; \
    _Pragma("unroll") for (int c4 = 0; c4 < 4; ++c4) { const LAS unsigned char* vp_ = DA_XOR(vb_, c4 << 5); \
      _Pragma("unroll") for (int vb = 0; vb < 4; ++vb) va[vb][c4] = (ABL & 1) ? qf[c4 ^ (vb & 3)] : *(const LAS bf16x8*)(vp_ + vb * 4096); }
#define DA_PACK_PV() bf16x8 pf[2][2]; \
    _Pragma("unroll") for (int s = 0; s < 2; ++s) { u32x4 w0, w1; \
      w0.x = cvt_pk_bf16(s0[8 * s + 0], s0[8 * s + 1]); w0.y = cvt_pk_bf16(s0[8 * s + 2], s0[8 * s + 3]); w0.z = cvt_pk_bf16(s0[8 * s + 4], s0[8 * s + 5]); w0.w = cvt_pk_bf16(s0[8 * s + 6], s0[8 * s + 7]); \
      w1.x = cvt_pk_bf16(s1[8 * s + 0], s1[8 * s + 1]); w1.y = cvt_pk_bf16(s1[8 * s + 2], s1[8 * s + 3]); w1.z = cvt_pk_bf16(s1[8 * s + 4], s1[8 * s + 5]); w1.w = cvt_pk_bf16(s1[8 * s + 6], s1[8 * s + 7]); \
      pf[0][s] = __builtin_bit_cast(bf16x8, w0); pf[1][s] = __builtin_bit_cast(bf16x8, w1); } \
    _Pragma("unroll") for (int vb = 0; vb < 4; ++vb) _Pragma("unroll") for (int kb = 0; kb < 2; ++kb) _Pragma("unroll") for (int s = 0; s < 2; ++s) \
      o[vb] = __builtin_amdgcn_mfma_f32_32x32x16_bf16(va[vb][kb * 2 + s], pf[kb][s], o[vb], 0, 0, 0)
  if constexpr (STATIC) {
    for (int t = 0; t < NT; t += 2) {
      DA_PAIR_BEGIN(t);
#pragma unroll
      for (int u = 0; u < 2; ++u) {
        DA_SLOT(t + u);
        f32x16 s0, s1;
#pragma unroll
        for (int i = 0; i < 16; ++i) { s0[i] = 0.f; s1[i] = 0.f; }
#pragma unroll
        for (int ks = 0; ks < 4; ++ks) { DA_KFRAG(ks); s0 = __builtin_amdgcn_mfma_f32_32x32x16_bf16(a0, qf[ks], s0, 0, 0, 0); s1 = __builtin_amdgcn_mfma_f32_32x32x16_bf16(a1, qf[ks], s1, 0, 0, 0); }
        DA_VFRAGS();
        if constexpr ((ABL & 32) != 0) {
          l_run += s0[0] + s1[0];
#pragma unroll
          for (int vb = 0; vb < 4; ++vb)
#pragma unroll
            for (int c4 = 0; c4 < 4; ++c4) o[vb] = __builtin_amdgcn_mfma_f32_32x32x16_bf16(va[vb][c4], qf[c4], o[vb], 0, 0, 0);
        } else {
          float ps = 0.f;
#pragma unroll
          for (int i = 0; i < 16; ++i) { s0[i] = (ABL & 4) ? s0[i] : __builtin_amdgcn_exp2f(s0[i]); ps += s0[i]; }
#pragma unroll
          for (int i = 0; i < 16; ++i) { s1[i] = (ABL & 4) ? s1[i] : __builtin_amdgcn_exp2f(s1[i]); ps += s1[i]; }
          l_run += ps;
          DA_PACK_PV();
        }
      }
      DA_PAIR_END();
    }
  } else {
    constexpr float THR = 8.0f * 1.4426950408889634f;
    float m_run = -1e30f;
    for (int t = 0; t < NT; ++t) {
      if (!(t & 1)) DA_PAIR_BEGIN(t);
      DA_SLOT(t);
      f32x16 s0 = zero16(), s1 = zero16();
#pragma unroll
      for (int ks = 0; ks < 4; ++ks) { DA_KFRAG(ks); s0 = __builtin_amdgcn_mfma_f32_32x32x16_bf16(a0, qf[ks], s0, 0, 0, 0); s1 = __builtin_amdgcn_mfma_f32_32x32x16_bf16(a1, qf[ks], s1, 0, 0, 0); }
      float mx = fmaxf(s0[0], s1[0]);
#pragma unroll
      for (int i = 1; i < 16; ++i) mx = fmaxf(mx, fmaxf(s0[i], s1[i]));
      { const u32x2 sw = __builtin_amdgcn_permlane32_swap(__float_as_uint(mx), __float_as_uint(mx), false, false); mx = fmaxf(__uint_as_float(sw.x), __uint_as_float(sw.y)); }
      float alpha = 1.0f;
      if (!__all(mx - m_run <= THR)) {
        const float m_new = fmaxf(m_run, mx);
        alpha = __builtin_amdgcn_exp2f(m_run - m_new);
        m_run = m_new;
#pragma unroll
        for (int vb = 0; vb < 4; ++vb)
#pragma unroll
          for (int i = 0; i < 16; ++i) o[vb][i] *= alpha;
      }
      float ps = 0.f;
#pragma unroll
      for (int i = 0; i < 16; ++i) { s0[i] = __builtin_amdgcn_exp2f(s0[i] - m_run); ps += s0[i]; }
#pragma unroll
      for (int i = 0; i < 16; ++i) { s1[i] = __builtin_amdgcn_exp2f(s1[i] - m_run); ps += s1[i]; }
      l_run = l_run * alpha + ps;
      __builtin_amdgcn_sched_barrier(0);
      DA_VFRAGS();
      DA_PACK_PV();
      if (t & 1) DA_PAIR_END();
    }
  }
#undef DA_KFRAG
#undef DA_XOR
#undef DA_VFRAGS
#undef DA_PACK_PV
#undef DA_DMA
#undef DA_WAITV
#undef DA_PAIR_BEGIN
#undef DA_PAIR_END
#undef DA_SLOT
  float l_tot; { const u32x2 sw = __builtin_amdgcn_permlane32_swap(__float_as_uint(l_run), __float_as_uint(l_run), false, false); l_tot = __uint_as_float(sw.x) + __uint_as_float(sw.y); }
  const float inv = 1.0f / l_tot;
  const int te = mk::otid();
  bf16_t* op = O12 + (size_t)(q0 + (te >> 6) * 32 + (te & 31)) * 2048 + hh * 128 + 4 * ((te >> 5) & 1);
#pragma unroll
  for (int vb = 0; vb < 4; ++vb)
#pragma unroll
    for (int g = 0; g < 4; ++g) {
      u32x2 w; w.x = cvt_pk_bf16(o[vb][4 * g] * inv, o[vb][4 * g + 1] * inv); w.y = cvt_pk_bf16(o[vb][4 * g + 2] * inv, o[vb][4 * g + 3] * inv);
      *(u32x2*)(op + vb * 32 + 8 * g) = w;
    }
}

__device__ __forceinline__ void diff_combine_rows4(const bf16_t* __restrict__ O12, const float* __restrict__ subln_g, float lam, float oml, bf16_t* __restrict__ O, int row0, int h, int lane) {
  unsigned a[4], b[4];
#pragma unroll
  for (int i = 0; i < 4; ++i) { a[i] = *(const unsigned*)(O12 + (size_t)(row0 + i) * 2048 + (2 * h) * 128 + 2 * lane); b[i] = *(const unsigned*)(O12 + (size_t)(row0 + i) * 2048 + (2 * h + 1) * 128 + 2 * lane); }
  const float g0 = subln_g[2 * lane], g1 = subln_g[2 * lane + 1];
#pragma unroll
  for (int i = 0; i < 4; ++i) {
    const float x0 = bflo(a[i]) - lam * bflo(b[i]), x1 = bfhi(a[i]) - lam * bfhi(b[i]);
    const float ss = wave_sum_u(x0 * x0 + x1 * x1);
    const float rs = rsqrtf(ss * (1.0f / 128.0f) + 1e-5f) * oml;
    *(unsigned*)(O + (size_t)(row0 + i) * 1024 + h * 128 + 2 * lane) = cvt_pk_bf16(x0 * rs * g0, x1 * rs * g1);
  }
}
}

namespace natt {
using namespace mk;
using att::pi32; using att::swz;
constexpr int TB = 64 * 128;
constexpr int NA_LDS = 4 * TB + 2048;
__device__ __forceinline__ void na_attn_unit(const bf16_t* __restrict__ Pe, const bf16_t* __restrict__ Vte, const float* __restrict__ rpb_h, bf16_t* __restrict__ O, int b, int h, int rq, LAS unsigned char* lds) {
  const int tid = mk::otid(), wid = tid >> 6, lane = tid & 63, r = lane & 31, hi = lane >> 5;
  constexpr float LOG2E = 1.4426950408889634f;
  LAS float* sb = (LAS float*)(lds + 4 * TB);
  for (int i = tid; i < 465; i += NTHR) sb[i] = rpb_h[i];
  const bool is_ctx = rq < 0;
  int qrow = 0, qcol = 0, qtok, rs_q = 0, cs_q = 0, span0 = 0, wlo = 0, whi = -1, lo = 0, ntl = 0;
  if (!is_ctx) {
    const int r0 = rq * 4, ra = r0 + (wid >> 2) * 2;
    qrow = ra + (r >> 4); qcol = (wid & 3) * 16 + (r & 15); qtok = b * T + qrow * 64 + qcol;
    rs_q = min(max(qrow - 4, 0), 120); cs_q = min(max(qcol - 8, 0), 48);
    span0 = min(max((wid & 3) * 16 - 8, 0), 32);
    wlo = min(max(ra - 4, 0), 120); whi = min(max(ra - 3, 0), 120) + 7;
    lo = min(max(r0 - 4, 0), 120); const int hi_ = min(max(r0 - 1, 0), 120) + 7; ntl = hi_ - lo + 1;
  } else qtok = NLAT + b * L + wid * 32 + r;
  const int NT = ntl + 4;
  const int srow = tid >> 3, sch = tid & 7;
  const bf16_t* kbase = Pe + 512 + h * 64 + sch * 8;
  const bf16_t* vbase = Vte + (size_t)(h * 64 + srow) * NTOK + sch * 8;
  const int sdst = swz(srow, sch);
  bf16x8 qf[4];
  { const bf16_t* qp = Pe + (size_t)qtok * 1024 + h * 64 + hi * 8;
#pragma unroll
    for (int ks = 0; ks < 4; ++ks) qf[ks] = *(const bf16x8*)(qp + ks * 16); }
  const int kx = (pi32(r) >> 1) & 7, vx = (r >> 1) & 7;
  const int ka_loc = (span0 + pi32(r)) * 128; const int kx_loc = ((span0 + pi32(r)) >> 1) & 7;
  f32x16 o[2];
#pragma unroll
  for (int vb = 0; vb < 2; ++vb)
#pragma unroll
    for (int i = 0; i < 16; ++i) o[vb][i] = 0.f;
  float m_run = -1e30f, l_run = 0.f;
  u32x4 kreg, vreg;
#define NA_LOAD(t) do { const int tok = (t) < ntl ? b * T + (lo + (t)) * 64 : NLAT + b * L + ((t) - ntl) * 64; \
    kreg = *(const u32x4*)(kbase + (size_t)(tok + srow) * 1024); vreg = *(const u32x4*)(vbase + tok); } while (0)
#define NA_WRITE(bufi) do { *(LAS u32x4*)(lds + (bufi) * TB + sdst) = kreg; *(LAS u32x4*)(lds + 2 * TB + (bufi) * TB + sdst) = vreg; } while (0)
  NA_LOAD(0); NA_WRITE(0); __syncthreads();
  for (int t = 0; t < NT; ++t) {
    const bool more = t + 1 < NT;
    if (more) NA_LOAD(t + 1);
    const LAS unsigned char* kb_ = lds + (t & 1) * TB; const LAS unsigned char* vb_ = lds + 2 * TB + (t & 1) * TB;
    const bool local = t < ntl; const int kr = lo + t;
    const bool active = !local || (kr >= wlo && kr <= whi);
    if (active) {
      f32x16 s0, s1;
#pragma unroll
      for (int i = 0; i < 16; ++i) { s0[i] = 0.f; s1[i] = 0.f; }
      if (local) {
#pragma unroll
        for (int ks = 0; ks < 4; ++ks) {
          const bf16x8 a0 = *(const LAS bf16x8*)(kb_ + ka_loc + (((ks * 2 + hi) ^ kx_loc) << 4));
          s0 = __builtin_amdgcn_mfma_f32_32x32x16_bf16(a0, qf[ks], s0, 0, 0, 0);
        }
        const bool row_ok = kr >= rs_q && kr < rs_q + 8; const int dr31 = (kr - qrow + 7) * 31;
#pragma unroll
        for (int i = 0; i < 16; ++i) {
          const int kc = span0 + (i & 7) + 8 * hi + 16 * (i >> 3);
          const bool ok = row_ok && kc >= cs_q && kc < cs_q + 16;
          const int bi = ok ? dr31 + (kc - qcol + 15) : 0;
          const float bv = sb[bi];
          s0[i] = ok ? fmaf(s0[i], 0.125f, bv) : -1e30f; s1[i] = -1e30f;
        }
      } else {
#pragma unroll
        for (int ks = 0; ks < 4; ++ks) {
          const int ch = ((ks * 2 + hi) ^ kx) << 4;
          const bf16x8 a0 = *(const LAS bf16x8*)(kb_ + pi32(r) * 128 + ch), a1 = *(const LAS bf16x8*)(kb_ + (32 + pi32(r)) * 128 + ch);
          s0 = __builtin_amdgcn_mfma_f32_32x32x16_bf16(a0, qf[ks], s0, 0, 0, 0);
          s1 = __builtin_amdgcn_mfma_f32_32x32x16_bf16(a1, qf[ks], s1, 0, 0, 0);
        }
#pragma unroll
        for (int i = 0; i < 16; ++i) { s0[i] *= 0.125f; s1[i] *= 0.125f; }
      }
      float mx = s0[0];
#pragma unroll
      for (int i = 1; i < 16; ++i) mx = fmaxf(mx, s0[i]);
#pragma unroll
      for (int i = 0; i < 16; ++i) mx = fmaxf(mx, s1[i]);
      { const u32x2 sw = __builtin_amdgcn_permlane32_swap(__float_as_uint(mx), __float_as_uint(mx), false, false); mx = fmaxf(__uint_as_float(sw.x), __uint_as_float(sw.y)); }
      const float m_new = fmaxf(m_run, mx);
      const float alpha = __builtin_amdgcn_exp2f((m_run - m_new) * LOG2E);
      m_run = m_new;
      const float mc = -m_new * LOG2E;
      float ps = 0.f;
#pragma unroll
      for (int i = 0; i < 16; ++i) { const float p = s0[i] > -1e29f ? __builtin_amdgcn_exp2f(fmaf(s0[i], LOG2E, mc)) : 0.f; s0[i] = p; ps += p; }
#pragma unroll
      for (int i = 0; i < 16; ++i) { const float p = s1[i] > -1e29f ? __builtin_amdgcn_exp2f(fmaf(s1[i], LOG2E, mc)) : 0.f; s1[i] = p; ps += p; }
      l_run = l_run * alpha + ps;
      if (__any(alpha < 1.0f)) {
#pragma unroll
        for (int vb = 0; vb < 2; ++vb)
#pragma unroll
          for (int i = 0; i < 16; ++i) o[vb][i] *= alpha;
      }
      bf16x8 pf[2][2];
#pragma unroll
      for (int s = 0; s < 2; ++s) {
        u32x4 w0, w1;
        w0.x = cvt_pk_bf16(s0[8 * s + 0], s0[8 * s + 1]); w0.y = cvt_pk_bf16(s0[8 * s + 2], s0[8 * s + 3]); w0.z = cvt_pk_bf16(s0[8 * s + 4], s0[8 * s + 5]); w0.w = cvt_pk_bf16(s0[8 * s + 6], s0[8 * s + 7]);
        w1.x = cvt_pk_bf16(s1[8 * s + 0], s1[8 * s + 1]); w1.y = cvt_pk_bf16(s1[8 * s + 2], s1[8 * s + 3]); w1.z = cvt_pk_bf16(s1[8 * s + 4], s1[8 * s + 5]); w1.w = cvt_pk_bf16(s1[8 * s + 6], s1[8 * s + 7]);
        pf[0][s] = __builtin_bit_cast(bf16x8, w0); pf[1][s] = __builtin_bit_cast(bf16x8, w1);
      }
      const int cbase = local ? (span0 >> 3) : 0;
#pragma unroll
      for (int vb = 0; vb < 2; ++vb) {
        const LAS unsigned char* vrow = vb_ + (vb * 32 + r) * 128;
#pragma unroll
        for (int s = 0; s < 2; ++s) {
          const bf16x8 a = *(const LAS bf16x8*)(vrow + (((cbase + 2 * s + hi) ^ vx) << 4));
          o[vb] = __builtin_amdgcn_mfma_f32_32x32x16_bf16(a, pf[0][s], o[vb], 0, 0, 0);
        }
        if (!local) {
#pragma unroll
          for (int s = 0; s < 2; ++s) {
            const bf16x8 a = *(const LAS bf16x8*)(vrow + (((4 + 2 * s + hi) ^ vx) << 4));
            o[vb] = __builtin_amdgcn_mfma_f32_32x32x16_bf16(a, pf[1][s], o[vb], 0, 0, 0);
          }
        }
      }
    }
    if (more) NA_WRITE((t + 1) & 1);
    __syncthreads();
  }
#undef NA_LOAD
#undef NA_WRITE
  float l_tot; { const u32x2 sw = __builtin_amdgcn_permlane32_swap(__float_as_uint(l_run), __float_as_uint(l_run), false, false); l_tot = __uint_as_float(sw.x) + __uint_as_float(sw.y); }
  const float inv = 1.0f / l_tot;
  bf16_t* op = O + (size_t)qtok * 1024 + h * 64 + 4 * hi;
#pragma unroll
  for (int vb = 0; vb < 2; ++vb)
#pragma unroll
    for (int g = 0; g < 4; ++g) {
      u32x2 w; w.x = cvt_pk_bf16(o[vb][4 * g] * inv, o[vb][4 * g + 1] * inv); w.y = cvt_pk_bf16(o[vb][4 * g + 2] * inv, o[vb][4 * g + 3] * inv);
      *(u32x2*)(op + vb * 32 + 8 * g) = w;
    }
}
}

namespace rw {
using namespace mk;
constexpr int NSTEP = L + T, NCH = 32, CL = NSTEP / NCH;
constexpr int NCHAIN = 2 * B * 8;
constexpr float LOG2E = 1.4426950408889634f;
struct Bufs {
  u32x2* SH;
  unsigned* DR;
  bf16_t* G; int gstride;
  float* CS;
  float* PQ;
  float* SST;
  bf16_t* Y;
  bf16_t* Z;
};

constexpr int XPITCH = 528;
template <int KS> struct LoraW { bf16x8 w[KS][4]; };
template <int KS>
__device__ __forceinline__ void lora_load(const bf16_t* __restrict__ W, int h, int lane, LoraW<KS>& f) {
  const int fr = lane & 15, fq = lane >> 4;
#pragma unroll
  for (int ks = 0; ks < KS; ++ks)
#pragma unroll
    for (int nb = 0; nb < 4; ++nb) f.w[ks][nb] = *(const bf16x8*)(W + (size_t)(h * 64 + nb * 16 + fr) * (KS * 32) + ks * 32 + fq * 8);
}
template <int KS>
__device__ __forceinline__ void lora_mma(const LAS unsigned char* xb, int xcol0, const LoraW<KS>& f, int lane, LAS float* tw, float (&out)[16]) {
  const int fr = lane & 15, fq = lane >> 4;
  f32x4 acc[4];
#pragma unroll
  for (int nb = 0; nb < 4; ++nb) { float z = 0.f; asm volatile("" : "+v"(z)); acc[nb] = (f32x4){z, z, z, z}; }
#pragma unroll
  for (int ks = 0; ks < KS; ++ks) {
    const bf16x8 xf = *(const LAS bf16x8*)(xb + fr * XPITCH + (xcol0 + ks * 32 + fq * 8) * 2);
#pragma unroll
    for (int nb = 0; nb < 4; ++nb) acc[nb] = __builtin_amdgcn_mfma_f32_16x16x32_bf16(xf, f.w[ks][nb], acc[nb], 0, 0, 0);
  }
#pragma unroll
  for (int nb = 0; nb < 4; ++nb) *(LAS f32x4*)(tw + (nb * 16 + fr) * 16 + fq * 4) = acc[nb];
  __builtin_amdgcn_wave_barrier(); asm volatile("s_waitcnt lgkmcnt(0)" ::: "memory"); __builtin_amdgcn_wave_barrier();
#pragma unroll
  for (int q = 0; q < 4; ++q) { const f32x4 v = *(const LAS f32x4*)(tw + lane * 16 + q * 4); out[q * 4] = v[0]; out[q * 4 + 1] = v[1]; out[q * 4 + 2] = v[2]; out[q * 4 + 3] = v[3]; }
  __builtin_amdgcn_wave_barrier(); asm volatile("s_waitcnt lgkmcnt(0)" ::: "memory"); __builtin_amdgcn_wave_barrier();
}
__device__ __forceinline__ void prep_tile(const bf16_t* __restrict__ Prw, const float* __restrict__ cw, const float* __restrict__ w0, const bf16_t* __restrict__ WLT, const float* __restrict__ a0,
                                          const float* __restrict__ k_k, const float* __restrict__ k_a, const float* __restrict__ r_k,
                                          const Bufs& bf, int tile, LAS float* xs  ) {
  const int c = mk::otid(), lane = c & 63, h = c >> 6;
  const int row0 = tile * 16;
  int lo, hi;
  if (row0 < NLAT) { lo = (row0 / T) * T; hi = lo + T - 1; } else { lo = NLAT + ((row0 - NLAT) / L) * L; hi = lo + L - 1; }
  bf16_t rraw[18], kraw[18], vraw[18];
#pragma unroll
  for (int j = 0; j < 18; ++j) { int rr_ = row0 - 1 + j; rr_ = rr_ < lo ? lo : (rr_ > hi ? hi : rr_); const bf16_t* q = Prw + (size_t)rr_ * RW_IN + c; rraw[j] = q[0]; kraw[j] = q[512]; vraw[j] = q[1024]; }
  LoraW<2> wd0, wd1; LoraW<4> wg;
  lora_load<2>(WLT, h, lane, wd0); lora_load<2>(WLT + 32768, h, lane, wd1);
#define RW_CONV(dst, col) do { const float c0 = cw[(col)], c1 = cw[RW_IN + (col)], c2 = cw[2 * RW_IN + (col)]; const bf16_t* p = Prw + (col); \
    bf16_t raw[18]; \
    _Pragma("unroll") for (int j = 0; j < 18; ++j) { int rr = row0 - 1 + j; rr = rr < lo ? lo : (rr > hi ? hi : rr); raw[j] = p[(size_t)rr * RW_IN]; } \
    float pm = row0 > lo ? bf2f(raw[0]) : 0.f, pc = bf2f(raw[1]); \
    _Pragma("unroll") for (int tt = 0; tt < 16; ++tt) { const float pn = (row0 + tt + 1 <= hi) ? bf2f(raw[tt + 2]) : 0.f; dst[tt] = pm * c0 + pc * c1 + pn * c2; pm = pc; pc = pn; } } while (0)
  if (c < 256) {
    float xv[16]; RW_CONV(xv, 1536 + c);
#pragma unroll
    for (int tt = 0; tt < 16; ++tt) { float v = xv[tt]; if (c < 64) v = tanhf(v); else if (c >= 128) v = sigmoidf_(v); *(LAS bf16_t*)((LAS unsigned char*)xs + tt * XPITCH + c * 2) = f2bf(v); }
  }
  __syncthreads();
  const LAS unsigned char* xb = (const LAS unsigned char*)xs; LAS float* tw = xs + 20480 + h * 1024;
  const float w00 = w0[c], w01 = w0[512 + c], a00 = a0[c], a01 = a0[512 + c], kkc = k_k[c], kac = k_a[c], rkc = r_k[c];
  float e0[16], e1[16];
  {
    float aw0[16], aw1[16];
    lora_mma<2>(xb, 0, wd0, lane, tw, aw0); lora_mma<2>(xb, 0, wd1, lane, tw, aw1);
    lora_load<2>(WLT + 2 * 32768, h, lane, wd0); lora_load<2>(WLT + 3 * 32768, h, lane, wd1);
#pragma unroll
    for (int tt = 0; tt < 16; ++tt) {
      e0[tt] = 0.6065306597126334f * __builtin_amdgcn_rcpf(1.0f + __expf(-(w00 + aw0[tt])));
      e1[tt] = 0.6065306597126334f * __builtin_amdgcn_rcpf(1.0f + __expf(-(w01 + aw1[tt])));
    }
  }
  LAS float* asl = xs + 256 * 16;
  {
    float aa0[16], aa1[16];
    lora_mma<2>(xb, 64, wd0, lane, tw, aa0); lora_mma<2>(xb, 64, wd1, lane, tw, aa1);
    lora_load<4>(WLT + 4 * 32768, h, lane, wg);
#pragma unroll
    for (int tt = 0; tt < 16; ++tt) { const unsigned d0 = cvt_pk_bf16(e0[tt], sigmoidf_(a00 + aa0[tt])), d1 = cvt_pk_bf16(e1[tt], sigmoidf_(a01 + aa1[tt]));
      bf.DR[((size_t)(row0 + tt)) * 512 + c] = d0; bf.DR[((size_t)NTOK + row0 + tt) * 512 + c] = d1; asl[tt * 512 + c] = bfhi(d0); asl[(16 + tt) * 512 + c] = bfhi(d1); }
  }
  {
    float ag[16];
    lora_mma<4>(xb, 128, wg, lane, tw, ag);
#pragma unroll
    for (int tt = 0; tt < 16; ++tt) bf.G[(size_t)(row0 + tt) * bf.gstride + c] = f2bf(ag[tt]);
  }
#undef RW_CONV
  const float cr0 = cw[c], cr1 = cw[RW_IN + c], cr2 = cw[2 * RW_IN + c], ck0 = cw[512 + c], ck1 = cw[RW_IN + 512 + c], ck2 = cw[2 * RW_IN + 512 + c], cv0 = cw[1024 + c], cv1 = cw[RW_IN + 1024 + c], cv2 = cw[2 * RW_IN + 1024 + c];
  float rm = row0 > lo ? bf2f(rraw[0]) : 0.f, km = row0 > lo ? bf2f(kraw[0]) : 0.f, vm = row0 > lo ? bf2f(vraw[0]) : 0.f;
  float rc = bf2f(rraw[1]), kc = bf2f(kraw[1]), vc = bf2f(vraw[1]);
#pragma unroll
  for (int tt = 0; tt < 16; ++tt) {
    const int row = row0 + tt;
    const bool has_n = row + 1 <= hi;
    const float rn = has_n ? bf2f(rraw[tt + 2]) : 0.f, kn = has_n ? bf2f(kraw[tt + 2]) : 0.f, vn = has_n ? bf2f(vraw[tt + 2]) : 0.f;
    const float rv = rm * cr0 + rc * cr1 + rn * cr2, kvv = km * ck0 + kc * ck1 + kn * ck2, vvv = vm * cv0 + vc * cv1 + vn * cv2;
    rm = rc; rc = rn; km = kc; kc = kn; vm = vc; vc = vn;
    float kk = kvv * kkc; const float nrm = sqrtf(wave_sum_u(kk * kk)); kk = kk * __builtin_amdgcn_rcpf(fmaxf(nrm, 1e-12f));
    u32x2 sh; sh.x = cvt_pk_bf16(rv, kvv); sh.y = cvt_pk_bf16(kk, vvv);
    bf.SH[(size_t)row * 512 + c] = sh;
    const float rq = bflo(sh.x), kq = bfhi(sh.x);
    const float cb0 = wave_sum_u(rq * kq * (1.0f + (asl[tt * 512 + c] - 1.0f) * kac) * rkc), cb1 = wave_sum_u(rq * kq * (1.0f + (asl[(16 + tt) * 512 + c] - 1.0f) * kac) * rkc);
    if (lane == 0) { bf.CS[(size_t)row * 16 + h] = cb0; bf.CS[(size_t)row * 16 + 8 + h] = cb1; }
  }
  __syncthreads();
}

struct StepRaw { u32x2 s; unsigned d; };
__device__ __forceinline__ int scan_row(int dir, int b, int p) {
  if (p < L) return NLAT + b * L + (dir ? (L - 1 - p) : p);
  const int q = p - L; return b * T + (dir ? (T - 1 - q) : q);
}
__device__ __forceinline__ void scan_unit(const Bufs& bf, const float* __restrict__ k_a, int chain, int chunk, LAS float* wl) {
  const int lane = mk::otid() & 63, r = lane & 31, hi = lane >> 5;
  const int dir = chain >> 5, b = (chain >> 3) & 3, h = chain & 7, ch = h * 64 + lane;
  const float kac = k_a[ch];
  f32x16 TS[2][2], TP[2][2];
#pragma unroll
  for (int rb = 0; rb < 2; ++rb)
#pragma unroll
    for (int cb = 0; cb < 2; ++cb)
#pragma unroll
      for (int q = 0; q < 16; ++q) { TS[rb][cb][q] = 0.f; TP[rb][cb][q] = (32 * rb + (q & 3) + 8 * (q >> 2) + 4 * hi == 32 * cb + r) ? 1.f : 0.f; }
  LAS unsigned char* wb = (LAS unsigned char*)wl;
  const LAS unsigned char* xrow = wb + (lane & 15) * 128 + 8 * hi;
  LAS float* Gl = wl + 1024;
  const int p0 = chunk * CL;
  float Dl = 1.f;
#define RW_FRAG(base, rb, s2) ([&]() { const u32x2 lo_ = *(const LAS u32x2*)((base) + (32 * (rb) + 16 * (s2)) * 2), hi_ = *(const LAS u32x2*)((base) + (32 * (rb) + 16 * (s2) + 8) * 2); \
      return __builtin_bit_cast(bf16x8, (u32x4){lo_.x, lo_.y, hi_.x, hi_.y}); }())
#define RW_DOTS(T, o) do { _Pragma("unroll") for (int cb = 0; cb < 2; ++cb) _Pragma("unroll") for (int q = 0; q < 16; ++q) o[cb][q] = 0.f; \
    _Pragma("unroll") for (int rb = 0; rb < 2; ++rb) _Pragma("unroll") for (int s2 = 0; s2 < 2; ++s2) _Pragma("unroll") for (int cb = 0; cb < 2; ++cb) { u32x4 w_; \
      w_.x = cvt_pk_bf16(T[rb][cb][8 * s2 + 0], T[rb][cb][8 * s2 + 1]); w_.y = cvt_pk_bf16(T[rb][cb][8 * s2 + 2], T[rb][cb][8 * s2 + 3]); \
      w_.z = cvt_pk_bf16(T[rb][cb][8 * s2 + 4], T[rb][cb][8 * s2 + 5]); w_.w = cvt_pk_bf16(T[rb][cb][8 * s2 + 6], T[rb][cb][8 * s2 + 7]); \
      o[cb] = __builtin_amdgcn_mfma_f32_32x32x16_bf16(xf[rb][s2], __builtin_bit_cast(bf16x8, w_), o[cb], 0, 0, 0); \
      asm volatile("" : "+v"(o[cb]) : "v"(w_), "v"(xf[rb][s2]));   } } while (0)
#define RW_RENORM() do { wl[1280 + lane] = Dl; __builtin_amdgcn_wave_barrier(); \
    _Pragma("unroll") for (int rb = 0; rb < 2; ++rb) _Pragma("unroll") for (int g = 0; g < 4; ++g) { const f32x4 w4 = *(const LAS f32x4*)(wl + 1280 + 32 * rb + 8 * g + 4 * hi); \
      _Pragma("unroll") for (int cb = 0; cb < 2; ++cb) _Pragma("unroll") for (int u = 0; u < 4; ++u) { TS[rb][cb][4 * g + u] *= w4[u]; TP[rb][cb][4 * g + u] *= w4[u]; } } \
    __builtin_amdgcn_wave_barrier(); Dl = 1.f; } while (0)
  const int wvs = __builtin_amdgcn_readfirstlane((int)((size_t)wl));
#define RW_FETCH(tb) do { _Pragma("unroll") for (int u = 0; u < 8; ++u) { const int pn = (tb) + u < CL ? (tb) + u : CL - 1; const int row = scan_row(dir, b, p0 + pn); \
      const unsigned* gs = (const unsigned*)(bf.SH + (size_t)row * 512 + ch); const unsigned* gd = bf.DR + ((size_t)dir * NTOK + row) * 512 + ch; LAS unsigned* ld = (LAS unsigned*)(size_t)(wvs + 8192 + u * 768); \
      __builtin_amdgcn_global_load_lds(gs, ld, 4, 0, 0); __builtin_amdgcn_global_load_lds(gs + 1, ld + 64, 4, 0, 0); __builtin_amdgcn_global_load_lds(gd, ld + 128, 4, 0, 0); } } while (0)
  RW_FETCH(0);
  for (int t0 = 0; t0 < CL; t0 += 8) {
    asm volatile("s_waitcnt vmcnt(0)" ::: "memory");
    __builtin_amdgcn_wave_barrier();
#pragma unroll
    for (int u = 0; u < 8; ++u) {
      const LAS unsigned* ld = (const LAS unsigned*)(wb + 8192 + u * 768) + lane; const unsigned sx = ld[0], sy = ld[64], dd = ld[128];
      const float rr = bflo(sx), k = bfhi(sx), kk = bflo(sy), e = bflo(dd), asg = bfhi(dd);
      const float w = __builtin_amdgcn_exp2f(-e * LOG2E), keff = k * (1.0f + (asg - 1.0f) * kac);
      ((LAS bf16_t*)wb)[u * 64 + lane] = f2bf(-kk * Dl);
      Dl *= w; const float dinv = __builtin_amdgcn_rcpf(Dl);
      ((LAS bf16_t*)wb)[(8 + u) * 64 + lane] = f2bf(rr * Dl);
      ((LAS bf16_t*)wb)[1024 + u * 64 + lane] = f2bf(kk * asg * dinv); ((LAS bf16_t*)wb)[1024 + (8 + u) * 64 + lane] = f2bf(keff * dinv);
      ((LAS bf16_t*)wb)[3072 + u * 64 + lane] = (bf16_t)(sy >> 16);
    }
    asm volatile("s_waitcnt lgkmcnt(0)" ::: "memory");
    __builtin_amdgcn_wave_barrier();
    RW_FETCH(t0 + 8);
    __builtin_amdgcn_wave_barrier();
    bf16x8 xf[2][2];
#pragma unroll
    for (int rb = 0; rb < 2; ++rb)
#pragma unroll
      for (int s2 = 0; s2 < 2; ++s2) xf[rb][s2] = RW_FRAG(xrow, rb, s2);
    { f32x16 gm;
#pragma unroll
      for (int q = 0; q < 16; ++q) gm[q] = 0.f;
#pragma unroll
      for (int rb = 0; rb < 2; ++rb)
#pragma unroll
        for (int s2 = 0; s2 < 2; ++s2) { const bf16x8 yf = RW_FRAG(xrow + 2048, rb, s2); gm = __builtin_amdgcn_mfma_f32_32x32x16_bf16(xf[rb][s2], yf, gm, 0, 0, 0); asm volatile("" : "+v"(gm) : "v"(yf), "v"(xf[rb][s2])); }
      if (r < 16) {
#pragma unroll
        for (int q = 0; q < 8; ++q) Gl[((q & 3) + 8 * (q >> 2) + 4 * hi) * 16 + r] = gm[q]; }
    }
    float sa[2][8], yy[2][8];
    { f32x16 oS[2], oP[2];
      RW_DOTS(TS, oS); RW_DOTS(TP, oP);
#pragma unroll
      for (int cb = 0; cb < 2; ++cb)
#pragma unroll
        for (int q = 0; q < 4; ++q) {
          { const u32x2 sw = __builtin_amdgcn_permlane32_swap(__float_as_uint(oS[cb][q]), __float_as_uint(oP[cb][q]), false, false); sa[cb][q] = __uint_as_float(sw.x); sa[cb][4 + q] = __uint_as_float(sw.y); }
          { const u32x2 sw = __builtin_amdgcn_permlane32_swap(__float_as_uint(oS[cb][4 + q]), __float_as_uint(oP[cb][4 + q]), false, false); yy[cb][q] = __uint_as_float(sw.x); yy[cb][4 + q] = __uint_as_float(sw.y); } }
    }
    __builtin_amdgcn_wave_barrier();
    float vm[2][8];
#pragma unroll
    for (int u = 0; u < 8; ++u) { const LAS bf16_t* vr = (const LAS bf16_t*)wb + 3072 + u * 64 + r; vm[0][u] = hi ? 0.f : bf2f(vr[0]); vm[1][u] = hi ? 0.f : bf2f(vr[32]); }
#pragma unroll
    for (int s = 0; s < 8; ++s) {
      const f32x4 ga0 = *(const LAS f32x4*)(Gl + s * 16), ga1 = *(const LAS f32x4*)(Gl + s * 16 + 4), ga2 = *(const LAS f32x4*)(Gl + s * 16 + 8), ga3 = *(const LAS f32x4*)(Gl + s * 16 + 12);
      const f32x4 gr0 = *(const LAS f32x4*)(Gl + (8 + s) * 16), gr1 = *(const LAS f32x4*)(Gl + (8 + s) * 16 + 4), gr2 = *(const LAS f32x4*)(Gl + (8 + s) * 16 + 8), gr3 = *(const LAS f32x4*)(Gl + (8 + s) * 16 + 12);
      const float gab[8] = {ga0[0], ga0[1], ga0[2], ga0[3], ga1[0], ga1[1], ga1[2], ga1[3]}, gak[8] = {ga2[0], ga2[1], ga2[2], ga2[3], ga3[0], ga3[1], ga3[2], ga3[3]};
      const float grb[8] = {gr0[0], gr0[1], gr0[2], gr0[3], gr1[0], gr1[1], gr1[2], gr1[3]}, grk[8] = {gr2[0], gr2[1], gr2[2], gr2[3], gr3[0], gr3[1], gr3[2], gr3[3]};
#pragma unroll
      for (int cb = 0; cb < 2; ++cb) {
        float x = sa[cb][s], y = yy[cb][s];
#pragma unroll
        for (int u = 0; u < 8; ++u) { if (u < s) { x = fmaf(gab[u], sa[cb][u], x); x = fmaf(gak[u], vm[cb][u], x); } }
        sa[cb][s] = x;
#pragma unroll
        for (int u = 0; u < 8; ++u) { if (u <= s) { y = fmaf(grb[u], sa[cb][u], y); y = fmaf(grk[u], vm[cb][u], y); } }
        yy[cb][s] = y;
      }
    }
    { bf16_t* yz = hi ? bf.Z : bf.Y;
#pragma unroll
      for (int s = 0; s < 8; ++s) { const size_t oi = ((size_t)dir * NTOK + scan_row(dir, b, p0 + t0 + s)) * 512 + h * 64 + r; yz[oi] = f2bf(yy[0][s]); yz[oi + 32] = f2bf(yy[1][s]); } }
    { bf16x8 au[2], buS[2], buP[2];
      u32x4 a0, a1, s0, s1, p0_, p1_;
#pragma unroll
      for (int q = 0; q < 4; ++q) {
        const int u = 4 * hi + q;
        const LAS bf16_t* yb = (const LAS bf16_t*)wb + 1024 + u * 64 + r; const LAS bf16_t* vr = (const LAS bf16_t*)wb + 3072 + u * 64 + r;
        a0[q] = (unsigned)yb[0] | ((unsigned)yb[512] << 16); a1[q] = (unsigned)yb[32] | ((unsigned)yb[512 + 32] << 16);
        const u32x2 sw0 = __builtin_amdgcn_permlane32_swap(__float_as_uint(sa[0][q]), __float_as_uint(sa[0][4 + q]), false, false), sw1 = __builtin_amdgcn_permlane32_swap(__float_as_uint(sa[1][q]), __float_as_uint(sa[1][4 + q]), false, false);
        s0[q] = (cvt_pk_bf16(__uint_as_float(sw0.x), 0.f) & 0xffffu) | ((unsigned)vr[0] << 16); s1[q] = (cvt_pk_bf16(__uint_as_float(sw1.x), 0.f) & 0xffffu) | ((unsigned)vr[32] << 16);
        p0_[q] = cvt_pk_bf16(__uint_as_float(sw0.y), 0.f); p1_[q] = cvt_pk_bf16(__uint_as_float(sw1.y), 0.f); }
      au[0] = __builtin_bit_cast(bf16x8, a0); au[1] = __builtin_bit_cast(bf16x8, a1); buS[0] = __builtin_bit_cast(bf16x8, s0); buS[1] = __builtin_bit_cast(bf16x8, s1); buP[0] = __builtin_bit_cast(bf16x8, p0_); buP[1] = __builtin_bit_cast(bf16x8, p1_);
#pragma unroll
      for (int rb = 0; rb < 2; ++rb)
#pragma unroll
        for (int cb = 0; cb < 2; ++cb) { TS[rb][cb] = __builtin_amdgcn_mfma_f32_32x32x16_bf16(au[rb], buS[cb], TS[rb][cb], 0, 0, 0); TP[rb][cb] = __builtin_amdgcn_mfma_f32_32x32x16_bf16(au[rb], buP[cb], TP[rb][cb], 0, 0, 0); }
    }
    __builtin_amdgcn_wave_barrier();
    if ((t0 & 31) == 24) RW_RENORM();
  }
  RW_RENORM();
#undef RW_DOTS
#undef RW_FRAG
#undef RW_RENORM
#undef RW_FETCH
  asm volatile("s_waitcnt vmcnt(0)" ::: "memory");
  if (chunk < NCH - 1) {
    float* pq = bf.PQ + (((size_t)chain * (NCH - 1) + chunk) * 2) * 4096;
#pragma unroll
    for (int rb = 0; rb < 2; ++rb)
#pragma unroll
      for (int cb = 0; cb < 2; ++cb)
#pragma unroll
        for (int g = 0; g < 4; ++g) { float* q = pq + (size_t)(32 * cb + r) * 64 + 32 * rb + 8 * g + 4 * hi;
          *(f32x4*)q = (f32x4){TP[rb][cb][4 * g], TP[rb][cb][4 * g + 1], TP[rb][cb][4 * g + 2], TP[rb][cb][4 * g + 3]};
          *(f32x4*)(q + 4096) = (f32x4){TS[rb][cb][4 * g], TS[rb][cb][4 * g + 1], TS[rb][cb][4 * g + 2], TS[rb][cb][4 * g + 3]}; }
  }
}

__device__ __forceinline__ void propagate_chain(const Bufs& bf, int chain, int rq, LAS float* lds) {
  LAS float* Sl = lds; LAS float* Pl = lds + 16 * 65 + 15;
  Pl = lds + 1056;
  const int tid = mk::otid(), i = tid >> 5, jc = (tid & 31) * 2, row = rq * 16 + i, pi = tid >> 3, pj = (tid & 7) * 8;
  float* sst = bf.SST + (size_t)chain * NCH * 4096;
  Sl[i * 65 + jc] = 0.f; Sl[i * 65 + jc + 1] = 0.f;
  const float* pb = bf.PQ + ((size_t)chain * (NCH - 1) * 2) * 4096;
  f32x4 np0 = *(const f32x4*)(pb + pi * 64 + pj), np1 = *(const f32x4*)(pb + pi * 64 + pj + 4); f32x2 nq = *(const f32x2*)(pb + 4096 + row * 64 + jc);
  for (int c = 0; c < NCH - 1; ++c) {
    const f32x4 p0 = np0, p1 = np1; f32x2 q = nq;
    { const float* pn = pb + (size_t)(c + 1 < NCH - 1 ? c + 1 : c) * 2 * 4096;
      np0 = *(const f32x4*)(pn + pi * 64 + pj); np1 = *(const f32x4*)(pn + pi * 64 + pj + 4); nq = *(const f32x2*)(pn + 4096 + row * 64 + jc); }
    *(LAS f32x4*)(Pl + pi * 64 + pj) = p0; *(LAS f32x4*)(Pl + pi * 64 + pj + 4) = p1;
    __syncthreads();
#pragma unroll 16
    for (int k = 0; k < 64; ++k) { const float sv = Sl[i * 65 + k]; const f32x2 a = *(const LAS f32x2*)(Pl + k * 64 + jc); q += sv * a; }
    __syncthreads();
    Sl[i * 65 + jc] = q[0]; Sl[i * 65 + jc + 1] = q[1];
    *(f32x2*)(sst + (size_t)(c + 1) * 4096 + row * 64 + jc) = q;
  }
  __syncthreads();
}

__device__ __forceinline__ void corr_unit(const Bufs& bf, int chain, int chunk) {
  const int lane = mk::otid() & 63, r = lane & 31, hi = lane >> 5;
  const int dir = chain >> 5, b = (chain >> 3) & 3, h = chain & 7;
  const float* ss = bf.SST + ((size_t)chain * NCH + chunk) * 4096;
  bf16x8 bfr[2][4];
#pragma unroll
  for (int nt = 0; nt < 2; ++nt)
#pragma unroll
    for (int ks = 0; ks < 4; ++ks) { const float* q = ss + (size_t)(nt * 32 + r) * 64 + ks * 16 + hi * 8; const f32x4 x0 = *(const f32x4*)q, x1 = *(const f32x4*)(q + 4);
      u32x4 w; w.x = cvt_pk_bf16(x0[0], x0[1]); w.y = cvt_pk_bf16(x0[2], x0[3]); w.z = cvt_pk_bf16(x1[0], x1[1]); w.w = cvt_pk_bf16(x1[2], x1[3]); bfr[nt][ks] = __builtin_bit_cast(bf16x8, w); }
  const int p0 = chunk * CL;
  const size_t dbase = (size_t)dir * NTOK;
  for (int mt = 0; mt < (CL + 31) / 32; ++mt) {
    const int sa_ = min(mt * 32 + r, CL - 1);
    const bf16_t* zp = bf.Z + (dbase + scan_row(dir, b, p0 + sa_)) * 512 + h * 64 + hi * 8;
    bf16x8 af[4];
#pragma unroll
    for (int ks = 0; ks < 4; ++ks) af[ks] = *(const bf16x8*)(zp + ks * 16);
    bf16_t yo0[16], yo1[16];
#pragma unroll
    for (int i = 0; i < 16; ++i) { const int so = min(mt * 32 + (i & 3) + 8 * (i >> 2) + 4 * hi, CL - 1); const bf16_t* yp = bf.Y + (dbase + scan_row(dir, b, p0 + so)) * 512 + h * 64 + r; yo0[i] = yp[0]; yo1[i] = yp[32]; }
    f32x16 acc[2];
#pragma unroll
    for (int nt = 0; nt < 2; ++nt) { acc[nt] = zero16();
#pragma unroll
      for (int ks = 0; ks < 4; ++ks) acc[nt] = __builtin_amdgcn_mfma_f32_32x32x16_bf16(af[ks], bfr[nt][ks], acc[nt], 0, 0, 0); }
#pragma unroll
    for (int i = 0; i < 16; ++i) { const int so = mt * 32 + (i & 3) + 8 * (i >> 2) + 4 * hi;
      if (so < CL) { bf16_t* yp = bf.Y + (dbase + scan_row(dir, b, p0 + so)) * 512 + h * 64 + r;
        yp[0] = f2bf(bf2f(yo0[i]) + acc[0][i]); yp[32] = f2bf(bf2f(yo1[i]) + acc[1][i]); } }
  }
}

template <int NR> struct FinRaw { bf16_t y0[NR], y1[NR], g[NR]; unsigned v[NR]; float c0[NR], c1[NR]; };
template <int NR>
__device__ __forceinline__ void finish_load(const Bufs& bf, int row0, int c, int h, FinRaw<NR>& q) {
#pragma unroll
  for (int i = 0; i < NR; ++i) { const int row = row0 + i;
    q.y0[i] = bf.Y[(size_t)row * 512 + c]; q.y1[i] = bf.Y[((size_t)NTOK + row) * 512 + c];
    q.v[i] = bf.SH[(size_t)row * 512 + c].y; q.g[i] = bf.G[(size_t)row * bf.gstride + c];
    q.c0[i] = bf.CS[(size_t)row * 16 + h]; q.c1[i] = bf.CS[(size_t)row * 16 + 8 + h]; }
}
template <int NR>
__device__ __forceinline__ void finish_phase(const Bufs& bf, const float* __restrict__ gn_g, const float* __restrict__ gn_b, bf16_t* __restrict__ O) {
  const int c = mk::otid(), h = c >> 6, stride = gridDim.x * NR;
  const float gg = gn_g[c], gb = gn_b[c];
  int row0 = mk::obid() * NR;
  if (row0 >= NTOK) return;
  FinRaw<NR> cur, nxt; finish_load<NR>(bf, row0, c, h, cur);
  for (; row0 < NTOK; row0 += stride) {
    const int rn = row0 + stride < NTOK ? row0 + stride : row0;
    finish_load<NR>(bf, rn, c, h, nxt);
    float o[NR];
#pragma unroll
    for (int i = 0; i < NR; ++i) { const float y = bf2f(cur.y0[i]) + bf2f(cur.y1[i]);
      const float mu = wave_sum_u(y) * (1.0f / 64.0f); const float dv = y - mu; const float var = wave_sum_u(dv * dv) * (1.0f / 64.0f);
      o[i] = (dv * rsqrtf(var + 64e-5f) * gg + gb + (cur.c0[i] + cur.c1[i]) * bfhi(cur.v[i])) * bf2f(cur.g[i]); }
#pragma unroll
    for (int i = 0; i < NR; ++i) O[(size_t)(row0 + i) * 1024 + 512 + c] = f2bf(o[i]);
    cur = nxt;
  }
}
}

namespace mk {
constexpr size_t al256(size_t x) { return (x + 255) / 256 * 256; }
constexpr size_t WS_BAR = 0;
constexpr size_t WS_BCNT = al256(WS_BAR + (size_t)XCD_BAR_WORDS * 4);
constexpr size_t WS_MOFF = al256(WS_BCNT + (size_t)4 * 256 * 64 * 4);
constexpr size_t WS_KN = al256(WS_MOFF + 4 * 256);
constexpr size_t WS_MOD = al256(WS_KN + (size_t)2 * 256 * 32 * 4);
constexpr size_t WS_ROPE = al256(WS_MOD + (size_t)4 * 5 * 6144 * 4);
constexpr size_t WS_HBC = al256(WS_ROPE + 128 * 16 * 2 * 4);
constexpr size_t WS_EID = al256(WS_HBC + (size_t)NCTX * D * 2);
constexpr size_t WS_GATE = al256(WS_EID + (size_t)NTOK * 2 * 4);
constexpr size_t WS_POS = al256(WS_GATE + (size_t)NTOK * 2 * 4);
constexpr size_t WS_RL = al256(WS_POS + (size_t)NTOK * 2 * 4);
constexpr size_t WS_WEIN = al256(WS_RL + (size_t)MOE_ROWS * 4);
constexpr size_t WS_WOIN = al256(WS_WEIN + (size_t)2 * EVEN_IN * D * 2);
constexpr size_t WS_WEOUT = al256(WS_WOIN + (size_t)2 * ODD_IN * D * 2);
constexpr size_t WS_WOOUT = al256(WS_WEOUT + (size_t)2 * D * D * 2);
constexpr size_t WS_WGU = al256(WS_WOOUT + (size_t)2 * D * D * 2);
constexpr size_t WS_WDN = al256(WS_WGU + (size_t)NE * 1024 * D * 2);
constexpr size_t WS_WLT = al256(WS_WDN + (size_t)NE * D * DE * 2);
constexpr size_t WS_UO = al256(WS_WLT + (size_t)2 * 196608 * 2);
constexpr size_t WS_SCR = al256(WS_UO + (size_t)NTOK * D * 2);
constexpr size_t SE_PQK = 0;
constexpr size_t SE_VT = al256(SE_PQK + (size_t)NTOK * 1024 * 2);
constexpr size_t SE_PRW = al256(SE_VT + (size_t)512 * NTOK * 2);
constexpr size_t SE_PQ = 0;
constexpr size_t SE_SST = al256(SE_PQ + (size_t)rw::NCHAIN * (rw::NCH - 1) * 2 * 4096 * 4);
constexpr size_t SE_Y = al256(SE_SST + (size_t)rw::NCHAIN * rw::NCH * 4096 * 4);
constexpr size_t SE_Z = al256(SE_Y + (size_t)2 * NTOK * 512 * 2);
constexpr size_t SE_ZEND = al256(SE_Z + (size_t)2 * NTOK * 512 * 2);
constexpr size_t SE_PRWEND = al256(SE_PRW + (size_t)NTOK * RW_IN * 2);
constexpr size_t SE_SH = SE_PRWEND > SE_ZEND ? SE_PRWEND : SE_ZEND;
constexpr size_t SE_DR = al256(SE_SH + (size_t)NTOK * 512 * 8);
constexpr size_t SE_CS = al256(SE_DR + (size_t)2 * NTOK * 512 * 4);
constexpr size_t SE_END = al256(SE_CS + (size_t)2 * NTOK * 16 * 4);
constexpr size_t SE_YBUF = 0;
constexpr size_t SO_PQK = 0;
constexpr size_t SO_VT = al256(SO_PQK + (size_t)NTOK * 2048 * 2);
constexpr size_t SO_O12 = al256(SO_VT + (size_t)1024 * NTOK * 2);
constexpr size_t SO_END = al256(SO_O12 + (size_t)NTOK * 2048 * 2);
constexpr size_t SO_YBUF = 0;
constexpr size_t SM_XS = 0;
constexpr size_t SM_HE = al256(SM_XS + (size_t)MOE_ROWS * D * 2);
constexpr size_t SM_YS = al256(SM_HE + (size_t)MOE_ROWS * DE * 2);
constexpr size_t SM_END = al256(SM_YS + (size_t)MOE_ROWS * D * 2);
constexpr size_t SCR_BYTES = SE_END > SO_END ? (SE_END > SM_END ? SE_END : SM_END) : (SO_END > SM_END ? SO_END : SM_END);
constexpr size_t WS_END = WS_SCR + SCR_BYTES;
constexpr int LDS_BARW = 131072;
constexpr int LDS_MISC = 131072 + 64;

struct Params {
  const float *x, *c, *ctx, *c_ctx, *ada_w, *ada_b, *ln_g, *ln_b, *even_w_in, *even_w_out, *shift_w, *na_rpb, *rw_w0, *rw_w_up, *rw_a0, *rw_a_up, *rw_g_up, *rw_k_k, *rw_k_a, *rw_r_k,
      *rw_gn_g, *rw_gn_b, *odd_w_in, *odd_w_out, *da_lq1, *da_lk1, *da_lq2, *da_lk2, *da_subln_g, *router_w, *router_b, *exp_w_gate, *exp_w_up, *exp_w_down;
  float* out; unsigned char* ws; int ph_lo, ph_hi;
};
template <class Tp> __device__ __forceinline__ Tp* wsp(const Params& p, size_t off) { return (Tp*)(p.ws + off); }

__device__ __forceinline__ void ada_unit(const Params& p, int u, LAS float* lds) {
  LAS float* sc = lds; LAS float* red = lds + 5 * 1024;
  const int tid = mk::otid(), l = u / 96, n = (u % 96) * 64 + (tid & 63), kp = tid >> 6;
  for (int i = tid; i < 5 * 1024; i += NTHR) { const float v = i < 4096 ? p.c[i] : p.c_ctx[i - 4096]; sc[i] = siluf_(v); }
  __syncthreads();
  float a[5] = {0.f, 0.f, 0.f, 0.f, 0.f};
  const float* w = p.ada_w + ((size_t)l * D + kp * 128) * 6144 + n;
#pragma unroll 4
  for (int k = 0; k < 128; ++k) { const float wv = w[(size_t)k * 6144]; const int kk = kp * 128 + k;
#pragma unroll
    for (int r = 0; r < 5; ++r) a[r] = fmaf(sc[r * 1024 + kk], wv, a[r]); }
#pragma unroll
  for (int r = 0; r < 5; ++r) red[(kp * 5 + r) * 64 + (tid & 63)] = a[r];
  __syncthreads();
  if (tid < 320) { const int r = tid >> 6, nn = tid & 63; float s = 0.f;
#pragma unroll
    for (int q = 0; q < 8; ++q) s += red[(q * 5 + r) * 64 + nn];
    const int col = (u % 96) * 64 + nn;
    wsp<float>(p, WS_MOD)[((size_t)l * 5 + r) * 6144 + col] = s + p.ada_b[l * 6144 + col]; }
  __syncthreads();
}
__device__ __forceinline__ void phase_prologue(const Params& p, LAS unsigned char* lds) {
  const int bid = mk::obid(), nb = gridDim.x; LAS float* tile = (LAS float*)lds;
  int ub = 0;
  for (int i = 0; i < 2; ++i) ub += cvt_matrix(p.even_w_in + (size_t)i * D * EVEN_IN, EVEN_IN, D, EVEN_IN, wsp<bf16_t>(p, WS_WEIN) + (size_t)i * EVEN_IN * D, NMapId{0}, tile, ub, bid, nb);
  for (int i = 0; i < 2; ++i) ub += cvt_matrix(p.odd_w_in + (size_t)i * D * ODD_IN, ODD_IN, D, ODD_IN, wsp<bf16_t>(p, WS_WOIN) + (size_t)i * ODD_IN * D, NMapRope{}, tile, ub, bid, nb);
  for (int i = 0; i < 2; ++i) ub += cvt_matrix(p.even_w_out + (size_t)i * D * D, D, D, D, wsp<bf16_t>(p, WS_WEOUT) + (size_t)i * D * D, NMapId{0}, tile, ub, bid, nb);
  for (int i = 0; i < 2; ++i) ub += cvt_matrix(p.odd_w_out + (size_t)i * D * D, D, D, D, wsp<bf16_t>(p, WS_WOOUT) + (size_t)i * D * D, NMapId{0}, tile, ub, bid, nb);
  for (int i = 0; i < 2; ++i) { bf16_t* wl = wsp<bf16_t>(p, WS_WLT) + (size_t)i * 196608;
    for (int d = 0; d < 2; ++d) { ub += cvt_matrix(p.rw_w_up + (size_t)(i * 2 + d) * 64 * 512, 512, 64, 512, wl + (size_t)d * 32768, NMapId{0}, tile, ub, bid, nb);
      ub += cvt_matrix(p.rw_a_up + (size_t)(i * 2 + d) * 64 * 512, 512, 64, 512, wl + (size_t)(2 + d) * 32768, NMapId{0}, tile, ub, bid, nb); }
    ub += cvt_matrix(p.rw_g_up + (size_t)i * 128 * 512, 512, 128, 512, wl + (size_t)4 * 32768, NMapId{0}, tile, ub, bid, nb); }
  for (int u = (bid + nb - ub % nb) % nb; u < 384; u += nb) ada_unit(p, u, (LAS float*)lds);
  const int gt = bid * NTHR + mk::otid();
  if (gt < 128 * 16) { const int pos = gt >> 4, i = gt & 15; const float inv = exp2f(-(float)i * (13.287712379549449f / 16.0f)); float sn, cs; sincosf((float)pos * inv, &sn, &cs);
    wsp<float>(p, WS_ROPE)[gt * 2] = cs; wsp<float>(p, WS_ROPE)[gt * 2 + 1] = sn; }
}
#define CVT_JOB(u_, src_, dst_, ld_, K_, k0_, n0_, mode_) do { const int e_ = (u_) / 384, rem_ = (u_) % 384, v_ = rem_ & 127; mode_ = rem_ >> 7; const size_t so_ = ((size_t)l * NE + e_) * D * DE; \
    const bool dn_ = mode_ == 2; src_ = (dn_ ? wd_ : (mode_ == 0 ? wg_ : wu_)) + so_; ld_ = dn_ ? D : DE; K_ = dn_ ? DE : D; \
    k0_ = (dn_ ? (v_ >> 4) : (v_ >> 3)) * 64; n0_ = (dn_ ? (v_ & 15) : (v_ & 7)) * 64; dst_ = dn_ ? wsp<bf16_t>(p, WS_WDN) + (size_t)e_ * D * DE : wsp<bf16_t>(p, WS_WGU) + (size_t)e_ * 1024 * D; } while (0)
__device__ __forceinline__ void cvt_experts(const Params& p, int l, LAS float* tile, int b0) {
  const int bid = mk::obid() - b0, nb = (int)gridDim.x - b0, t = mk::otid();
  if (bid < 0) return;
  const float* wg_ = p.exp_w_gate; const float* wu_ = p.exp_w_up; const float* wd_ = p.exp_w_down; asm volatile("" : "+s"(wg_), "+s"(wu_), "+s"(wd_));
  constexpr int NJ = NE * 384;
  int u = bid;
  if (u >= NJ) return;
  const float* csrc; bf16_t* cdst; int cld, cK, ck0, cn0, cmode;
  CVT_JOB(u, csrc, cdst, cld, cK, ck0, cn0, cmode);
  const int lk = t >> 3, lc = (t & 7) * 8;
  f32x4 ra, rb; { const float* q = csrc + (size_t)(ck0 + lk) * cld + cn0 + lc; ra = *(const f32x4*)q; rb = *(const f32x4*)(q + 4); }
  for (; u < NJ; u += nb) {
    const int un = u + nb < NJ ? u + nb : u;
    const float* nsrc; bf16_t* ndst; int nld, nK, nk0, nn0, nmode;
    CVT_JOB(un, nsrc, ndst, nld, nK, nk0, nn0, nmode);
    f32x4 na, nbv; { const float* q = nsrc + (size_t)(nk0 + lk) * nld + nn0 + lc; na = *(const f32x4*)q; nbv = *(const f32x4*)(q + 4); }
    { LAS float* q = tile + lk * 65 + lc; q[0] = ra[0]; q[1] = ra[1]; q[2] = ra[2]; q[3] = ra[3]; q[4] = rb[0]; q[5] = rb[1]; q[6] = rb[2]; q[7] = rb[3]; }
    __syncthreads();
    { const int n = t >> 3, kc = (t & 7) * 8; const LAS float* q = tile + kc * 65 + n;
      u32x4 w; w.x = cvt_pk_bf16(q[0], q[65]); w.y = cvt_pk_bf16(q[130], q[195]); w.z = cvt_pk_bf16(q[260], q[325]); w.w = cvt_pk_bf16(q[390], q[455]);
      const int drow = cmode == 2 ? cn0 + n : 2 * (cn0 + n) + cmode;
      *(u32x4*)(cdst + (size_t)drow * cK + ck0 + kc) = w; }
    __syncthreads();
    csrc = nsrc; cdst = ndst; cld = nld; cK = nK; ck0 = nk0; cn0 = nn0; cmode = nmode; ra = na; rb = nbv;
  }
}
#undef CVT_JOB

__device__ __forceinline__ bf16_t* hb_ptr(const Params& p, int row, bool alt) {
  if (alt) return wsp<bf16_t>(p, WS_SCR + SM_END) + (size_t)row * D;
  return row < NLAT ? (bf16_t*)p.out + (size_t)row * D : wsp<bf16_t>(p, WS_HBC) + (size_t)(row - NLAT) * D;
}
__device__ __forceinline__ const float* h0_ptr(const Params& p, int row) { return row < NLAT ? p.x + (size_t)row * D : p.ctx + (size_t)(row - NLAT) * D; }
__device__ __forceinline__ void store_bf16x4(bf16_t* dst, f32x4 v) { u32x2 w; w.x = cvt_pk_bf16(v[0], v[1]); w.y = cvt_pk_bf16(v[2], v[3]); *(u32x2*)dst = w; }
__device__ __forceinline__ f32x4 load_bf16x4(const bf16_t* src) { const u32x2 w = *(const u32x2*)src; return (f32x4){bflo(w.x), bfhi(w.x), bflo(w.y), bfhi(w.y)}; }

__device__ __forceinline__ void phase_mod0(const Params& p) {
  const int lane = mk::otid() & 63, wid = mk::otid() >> 6;
  bf16_t* U = wsp<bf16_t>(p, WS_UO);
  for (int row = mk::obid() * 8 + wid; row < NTOK; row += gridDim.x * 8) {
    const float* h = h0_ptr(p, row); const float* modl = wsp<float>(p, WS_MOD) + (size_t)bidx_of_row(row) * 6144;
#pragma unroll
    for (int q = 0; q < 4; ++q) { const int col = q * 256 + lane * 4; const f32x4 hv = *(const f32x4*)(h + col), sh = *(const f32x4*)(modl + col), sc = *(const f32x4*)(modl + 1024 + col);
      store_bf16x4(U + (size_t)row * D + col, hv * (1.0f + sc) + sh); }
  }
}
__device__ __forceinline__ void ln_row(f32x4 (&v)[4], const float* __restrict__ g, const float* __restrict__ b, int lane) {
  float s = 0.f;
#pragma unroll
  for (int q = 0; q < 4; ++q) s += (v[q][0] + v[q][1]) + (v[q][2] + v[q][3]);
  const float mu = wave_sum_u(s) * (1.0f / D);
  float qq = 0.f;
#pragma unroll
  for (int q = 0; q < 4; ++q) { const f32x4 d = v[q] - mu; qq += (d[0] * d[0] + d[1] * d[1]) + (d[2] * d[2] + d[3] * d[3]); }
  const float rstd = rsqrtf(wave_sum_u(qq) * (1.0f / D) + LN_EPS);
#pragma unroll
  for (int q = 0; q < 4; ++q) { const int col = q * 256 + lane * 4; v[q] = (v[q] - mu) * rstd * *(const f32x4*)(g + col) + *(const f32x4*)(b + col); }
}
template <bool F32IN> struct Ln1Raw;
template <> struct Ln1Raw<true> { f32x4 h[4]; u32x2 y[4]; };
template <> struct Ln1Raw<false> { u32x2 h[4]; u32x2 y[4]; };
__device__ __forceinline__ f32x4 h_as_f32(f32x4 v) { return v; }
__device__ __forceinline__ f32x4 h_as_f32(u32x2 w) { return (f32x4){bflo(w.x), bfhi(w.x), bflo(w.y), bfhi(w.y)}; }
template <bool F32IN>
__device__ __forceinline__ void ln1_load(const Params& p, const bf16_t* __restrict__ Ybuf, int row, int lane, Ln1Raw<F32IN>& r) {
#pragma unroll
  for (int q = 0; q < 4; ++q) { const int col = q * 256 + lane * 4;
    if constexpr (F32IN) r.h[q] = *(const f32x4*)(h0_ptr(p, row) + col); else r.h[q] = *(const u32x2*)(hb_ptr(p, row, false) + col);
    r.y[q] = *(const u32x2*)(Ybuf + (size_t)row * D + col); }
}
template <bool F32IN>
__device__ __forceinline__ void ln1_row(const Params& p, int l, int row, int lane, const Ln1Raw<F32IN>& raw, const LAS float* rwl, LAS int* lcnt, float rbias  , bool redir) {
  bf16_t* U2 = wsp<bf16_t>(p, WS_UO); int* eid = wsp<int>(p, WS_EID); float* gatev = wsp<float>(p, WS_GATE);
  const float* lg = p.ln_g + (size_t)(l * 2) * D; const float* lb = p.ln_b + (size_t)(l * 2) * D;
  bf16_t* ho = redir ? wsp<bf16_t>(p, WS_SCR + SM_YS) + (size_t)row * D : hb_ptr(p, row, l == DEPTH - 1); const float* modl = wsp<float>(p, WS_MOD) + ((size_t)l * 5 + bidx_of_row(row)) * 6144;
  f32x4 v[4];
#pragma unroll
  for (int q = 0; q < 4; ++q) { const int col = q * 256 + lane * 4; const f32x4 yv = (f32x4){bflo(raw.y[q].x), bfhi(raw.y[q].x), bflo(raw.y[q].y), bfhi(raw.y[q].y)};
    v[q] = ALPHA * h_as_f32(raw.h[q]) + *(const f32x4*)(modl + 2 * 1024 + col) * yv; }
  ln_row(v, lg, lb, lane);
  float acc[16];
#pragma unroll
  for (int e = 0; e < 16; ++e) acc[e] = 0.f;
#pragma unroll
  for (int q = 0; q < 4; ++q) { const int col = q * 256 + lane * 4;
    store_bf16x4(ho + col, v[q]);
    const f32x4 u = v[q] * (1.0f + *(const f32x4*)(modl + 4 * 1024 + col)) + *(const f32x4*)(modl + 3 * 1024 + col);
    store_bf16x4(U2 + (size_t)row * D + col, u);
#pragma unroll
    for (int e = 0; e < 16; ++e) { const f32x4 w = *(const LAS f32x4*)(rwl + ((q * 16 + e) * 64 + lane) * 4); acc[e] += (u[0] * w[0] + u[1] * w[1]) + (u[2] * w[2] + u[3] * w[3]); }
  }
  float t8[8], t4[4], t2[2];
#pragma unroll
  for (int i = 0; i < 8; ++i) { const u32x2 sw = __builtin_amdgcn_permlane32_swap(__float_as_uint(acc[i]), __float_as_uint(acc[8 + i]), false, false); t8[i] = __uint_as_float(sw.x) + __uint_as_float(sw.y); }
#pragma unroll
  for (int i = 0; i < 4; ++i) { const u32x2 sw = __builtin_amdgcn_permlane16_swap(__float_as_uint(t8[i]), __float_as_uint(t8[4 + i]), false, false); t4[i] = __uint_as_float(sw.x) + __uint_as_float(sw.y); }
  const bool b3 = (lane & 8) != 0, b2_ = (lane & 4) != 0;
#pragma unroll
  for (int i = 0; i < 2; ++i) { const float keep = b3 ? t4[2 + i] : t4[i], send = b3 ? t4[i] : t4[2 + i]; t2[i] = keep + dpp_mov<0x128, 0xf, 0xf>(send, send); }
  float logit;
  { const float keep = b2_ ? t2[1] : t2[0], send = b2_ ? t2[0] : t2[1];
    float recv = dpp_mov<0x104, 0xf, 0x5>(send, send);
    recv = dpp_mov<0x114, 0xf, 0xa>(recv, send);
    logit = keep + recv; }
  logit += dpp_mov<0xB1, 0xf, 0xf>(logit, logit); logit += dpp_mov<0x4E, 0xf, 0xf>(logit, logit);
  const float sg = 1.0f / (1.0f + expf(-logit)), sl = sg + rbias;
  float gs;
  { const float a = sl, b2 = dpp_mov<0x124, 0xf, 0xf>(sl, sl), c = dpp_mov<0x128, 0xf, 0xf>(sl, sl), d = dpp_mov<0x12C, 0xf, 0xf>(sl, sl);
    const float lo1 = fminf(a, b2), hi1 = fmaxf(a, b2), lo2 = fminf(c, d), hi2 = fmaxf(c, d);
    gs = fmaxf(hi1, hi2) + fmaxf(fminf(hi1, hi2), fmaxf(lo1, lo2)); }
  float best = -1e30f; int grp = 0;
#pragma unroll
  for (int gI = 0; gI < 4; ++gI) { const float g = __uint_as_float(__builtin_amdgcn_readlane(__float_as_uint(gs), gI * 16)); if (g > best) { best = g; grp = gI; } }
  grp = __builtin_amdgcn_readfirstlane(grp);
  const float v0 = __uint_as_float(__builtin_amdgcn_readlane(__float_as_uint(sl), grp * 16)), v1 = __uint_as_float(__builtin_amdgcn_readlane(__float_as_uint(sl), grp * 16 + 4)),
              v2 = __uint_as_float(__builtin_amdgcn_readlane(__float_as_uint(sl), grp * 16 + 8)), v3 = __uint_as_float(__builtin_amdgcn_readlane(__float_as_uint(sl), grp * 16 + 12));
  const float s0 = __uint_as_float(__builtin_amdgcn_readlane(__float_as_uint(sg), grp * 16)), s1 = __uint_as_float(__builtin_amdgcn_readlane(__float_as_uint(sg), grp * 16 + 4)),
              s2 = __uint_as_float(__builtin_amdgcn_readlane(__float_as_uint(sg), grp * 16 + 8)), s3 = __uint_as_float(__builtin_amdgcn_readlane(__float_as_uint(sg), grp * 16 + 12));
  int i1 = 0; float b1 = v0; if (v1 > b1) { b1 = v1; i1 = 1; } if (v2 > b1) { b1 = v2; i1 = 2; } if (v3 > b1) { b1 = v3; i1 = 3; }
  int i2 = -1; float bb = -1e30f;
  if (i1 != 0 && v0 > bb) { bb = v0; i2 = 0; } if (i1 != 1 && v1 > bb) { bb = v1; i2 = 1; } if (i1 != 2 && v2 > bb) { bb = v2; i2 = 2; } if (i1 != 3 && v3 > bb) { bb = v3; i2 = 3; }
  const float g1 = i1 == 0 ? s0 : i1 == 1 ? s1 : i1 == 2 ? s2 : s3; const float g2 = i2 == 0 ? s0 : i2 == 1 ? s1 : i2 == 2 ? s2 : s3;
  if (lane == 0) { const int e1 = grp * 4 + i1, e2 = grp * 4 + i2;
    eid[row * 2] = e1; eid[row * 2 + 1] = e2; gatev[row * 2] = g1 / (g1 + g2); gatev[row * 2 + 1] = g2 / (g1 + g2);
    __hip_atomic_fetch_add(lcnt + e1, 1, __ATOMIC_RELAXED, __HIP_MEMORY_SCOPE_WORKGROUP); __hip_atomic_fetch_add(lcnt + e2, 1, __ATOMIC_RELAXED, __HIP_MEMORY_SCOPE_WORKGROUP); }
}
template <bool F32IN>
__device__ __forceinline__ void phase_ln1(const Params& p, int l, const bf16_t* __restrict__ Ybuf, LAS unsigned char* lds, bool dry) {
  const int tid = mk::otid(), lane = tid & 63, wid = tid >> 6, bid = mk::obid();
  const bool last = l == DEPTH - 1; const int ntok = last ? NLAT : NTOK;
  LAS float* rwl = (LAS float*)lds; LAS int* lcnt = (LAS int*)(lds + 65536);
  { float rv[32];
#pragma unroll
    for (int i = 0; i < 32; ++i) rv[i] = p.router_w[tid + i * NTHR];
#pragma unroll
    for (int i = 0; i < 32; ++i) { const int idx = tid + i * NTHR, d = idx >> 4, e = idx & 15; rwl[(((d >> 8) * 16 + e) * 64 + ((d >> 2) & 63)) * 4 + (d & 3)] = rv[i]; } }
  if (tid < 16) lcnt[tid] = 0;
  __syncthreads();
  const int stride = gridDim.x * 8, row0 = bid * 8 + wid;
  const float rbias = p.router_b[lane >> 2];
  if (row0 < ntok) {
    Ln1Raw<F32IN> cur, nxt; ln1_load<F32IN>(p, Ybuf, row0, lane, cur);
    for (int row = row0; row < ntok; row += stride) {
      const int rn = row + stride < ntok ? row + stride : row;
      ln1_load<F32IN>(p, Ybuf, rn, lane, nxt);
      ln1_row<F32IN>(p, l, row, lane, cur, rwl, lcnt, rbias, dry);
      cur = nxt;
    }
  }
  __syncthreads();
  if (tid < 16) wsp<int>(p, WS_BCNT)[((size_t)l * 256 + bid) * 64 + tid] = lcnt[tid];
  __syncthreads();
}
__device__ __forceinline__ void phase_scatter(const Params& p, int l, LAS unsigned char* lds) {
  const int tid = mk::otid(), bid = mk::obid(), nb = gridDim.x;
  const bool last = l == DEPTH - 1; const int ntok = last ? NLAT : NTOK;
  LAS int* tot = (LAS int*)lds; LAS int* pre = tot + 16; LAS int* base = tot + 32; LAS int* lcur = tot + 48; LAS int* offs = tot + 64; LAS int* cnts = tot + 128;
  const int* bc = wsp<int>(p, WS_BCNT) + (size_t)l * 256 * 64;
  for (int b2 = tid; b2 < nb; b2 += NTHR) { const u32x4 c0 = *(const u32x4*)(bc + b2 * 64), c1 = *(const u32x4*)(bc + b2 * 64 + 4), c2 = *(const u32x4*)(bc + b2 * 64 + 8), c3 = *(const u32x4*)(bc + b2 * 64 + 12);
    *(LAS u32x4*)(cnts + b2 * 16) = c0; *(LAS u32x4*)(cnts + b2 * 16 + 4) = c1; *(LAS u32x4*)(cnts + b2 * 16 + 8) = c2; *(LAS u32x4*)(cnts + b2 * 16 + 12) = c3; }
  __syncthreads();
  if (tid < 16) { int t = 0, pr = 0; for (int b2 = 0; b2 < nb; ++b2) { const int v = cnts[b2 * 16 + tid]; pr += b2 < bid ? v : 0; t += v; } tot[tid] = t; pre[tid] = pr; lcur[tid] = 0; }
  __syncthreads();
  if (tid == 0) { int o = 0; int* mo = wsp<int>(p, WS_MOFF) + l * 64; for (int e = 0; e < 16; ++e) { offs[e] = o; base[e] = o + pre[e]; if (bid == 0) mo[e] = o; o += (tot[e] + 255) / 256 * 256; } offs[16] = o; if (bid == 0) mo[16] = o; }
  __syncthreads();
  const int* eid = wsp<int>(p, WS_EID); int* pos = wsp<int>(p, WS_POS); int* rl = wsp<int>(p, WS_RL);
  for (int n = tid; ; n += NTHR) { const int row = bid * 8 + (n & 7) + (n >> 3) * nb * 8; if (row >= ntok) break;
    const int e1 = eid[row * 2], e2 = eid[row * 2 + 1];
    const int p1 = base[e1] + __hip_atomic_fetch_add(lcur + e1, 1, __ATOMIC_RELAXED, __HIP_MEMORY_SCOPE_WORKGROUP), p2 = base[e2] + __hip_atomic_fetch_add(lcur + e2, 1, __ATOMIC_RELAXED, __HIP_MEMORY_SCOPE_WORKGROUP);
    pos[row * 2] = p1; pos[row * 2 + 1] = p2; rl[p1] = row; rl[p2] = row; }
  if (bid == 0) for (int e = 0; e < 16; ++e) for (int q = offs[e] + tot[e] + tid; q < offs[e + 1]; q += NTHR) rl[q] = 0;
}
struct Ln2Raw { u32x4 h[2], y1[2], y2[2]; };
__device__ __forceinline__ void ln2_load(const Params& p, bool last, int row, int lane, int p1, int p2, Ln2Raw& r) {
  const bf16_t* Ys = wsp<bf16_t>(p, WS_SCR + SM_YS); const bf16_t* ho = hb_ptr(p, row, last);
#pragma unroll
  for (int q = 0; q < 2; ++q) { const int col = q * 512 + lane * 8; r.h[q] = *(const u32x4*)(ho + col); r.y1[q] = *(const u32x4*)(Ys + (size_t)p1 * D + col); r.y2[q] = *(const u32x4*)(Ys + (size_t)p2 * D + col); }
}
__device__ __forceinline__ void unpack8(const u32x4 w, float (&o)[8]) { o[0] = bflo(w.x); o[1] = bfhi(w.x); o[2] = bflo(w.y); o[3] = bfhi(w.y); o[4] = bflo(w.z); o[5] = bfhi(w.z); o[6] = bflo(w.w); o[7] = bfhi(w.w); }
__device__ __forceinline__ void load8f(const float* q, float (&o)[8]) { const f32x4 a = *(const f32x4*)q, b = *(const f32x4*)(q + 4); o[0] = a[0]; o[1] = a[1]; o[2] = a[2]; o[3] = a[3]; o[4] = b[0]; o[5] = b[1]; o[6] = b[2]; o[7] = b[3]; }
__device__ __forceinline__ u32x4 pack8(const float (&v)[8]) { u32x4 w; w.x = cvt_pk_bf16(v[0], v[1]); w.y = cvt_pk_bf16(v[2], v[3]); w.z = cvt_pk_bf16(v[4], v[5]); w.w = cvt_pk_bf16(v[6], v[7]); return w; }
__device__ __forceinline__ void phase_ln2(const Params& p, int l, bool dry) {
  const int tid = mk::otid(), lane = tid & 63, wid = tid >> 6;
  const bool last = l == DEPTH - 1; const int ntok = last ? NLAT : NTOK;
  const int* pos = wsp<int>(p, WS_POS); const float* gatev = wsp<float>(p, WS_GATE); bf16_t* U = wsp<bf16_t>(p, WS_UO);
  const float* lg = p.ln_g + (size_t)(l * 2 + 1) * D; const float* lb = p.ln_b + (size_t)(l * 2 + 1) * D;
  const int stride = gridDim.x * 8, row0 = mk::obid() * 8 + wid;
  if (row0 >= ntok) return;
  auto clampr = [&](int r) { return r < ntok ? r : row0; };
  u32x2 pc = *(const u32x2*)(pos + 2 * row0); f32x2 gc = *(const f32x2*)(gatev + 2 * row0);
  Ln2Raw cur, nxt; ln2_load(p, last, row0, lane, (int)pc.x, (int)pc.y, cur);
  int r1 = clampr(row0 + stride);
  u32x2 pn = *(const u32x2*)(pos + 2 * r1); f32x2 gn = *(const f32x2*)(gatev + 2 * r1);
  for (int row = row0; row < ntok; row += stride) {
    ln2_load(p, last, r1, lane, (int)pn.x, (int)pn.y, nxt);
    const int r2 = clampr(row + 2 * stride);
    const u32x2 pn2 = *(const u32x2*)(pos + 2 * r2); const f32x2 gn2 = *(const f32x2*)(gatev + 2 * r2);
    bf16_t* hb = dry ? wsp<bf16_t>(p, WS_SCR + SM_XS) + (size_t)row * D : hb_ptr(p, row, false); float* hf = (dry ? wsp<float>(p, WS_SCR + SM_XS) : p.out) + (size_t)row * D; const int bi = bidx_of_row(row);
    const float* modl = wsp<float>(p, WS_MOD) + ((size_t)l * 5 + bi) * 6144;
    float v[2][8]; float s1 = 0.f;
#pragma unroll
    for (int q = 0; q < 2; ++q) { const int col = q * 512 + lane * 8; float hh[8], a1[8], a2[8], g2[8];
      unpack8(cur.h[q], hh); unpack8(cur.y1[q], a1); unpack8(cur.y2[q], a2); load8f(modl + 5 * 1024 + col, g2);
#pragma unroll
      for (int e = 0; e < 8; ++e) { v[q][e] = ALPHA * hh[e] + g2[e] * (gc[0] * a1[e] + gc[1] * a2[e]); s1 += v[q][e]; } }
    const float mu = wave_sum_u(s1) * (1.0f / D);
    float s2 = 0.f;
#pragma unroll
    for (int q = 0; q < 2; ++q)
#pragma unroll
      for (int e = 0; e < 8; ++e) { const float d = v[q][e] - mu; s2 += d * d; }
    const float rstd = rsqrtf(wave_sum_u(s2) * (1.0f / D) + LN_EPS);
    const float* modn = wsp<float>(p, WS_MOD) + ((size_t)(last ? l : l + 1) * 5 + bi) * 6144;
#pragma unroll
    for (int q = 0; q < 2; ++q) { const int col = q * 512 + lane * 8; float gg[8], bb[8];
      load8f(lg + col, gg); load8f(lb + col, bb);
#pragma unroll
      for (int e = 0; e < 8; ++e) v[q][e] = (v[q][e] - mu) * rstd * gg[e] + bb[e];
      if (last) { *(f32x4*)(hf + col) = (f32x4){v[q][0], v[q][1], v[q][2], v[q][3]}; *(f32x4*)(hf + col + 4) = (f32x4){v[q][4], v[q][5], v[q][6], v[q][7]}; }
      else { *(u32x4*)(hb + col) = pack8(v[q]); float sc[8], sh[8], u[8]; load8f(modn + 1024 + col, sc); load8f(modn + col, sh);
#pragma unroll
        for (int e = 0; e < 8; ++e) u[e] = v[q][e] * (1.0f + sc[e]) + sh[e];
        *(u32x4*)(U + (size_t)row * D + col) = pack8(u); } }
    cur = nxt; gc = gn; pn = pn2; gn = gn2; r1 = r2;
  }
}

struct SchedEvenIn { static constexpr bool GATHER = false; const bf16_t* U; const bf16_t* W; bf16_t* Pqk; bf16_t* Prw; bf16_t* Vt; int G, c;
  __device__ __forceinline__ bool next(int i, pg8::Unit& u) const { const int Lx = i * G + c; u.kind = 0;
    if (Lx < 1452) { const int grp = Lx / 44, rem = Lx % 44, pm = grp * 4 + (rem & 3), pi = rem >> 2; u.pm = pm; u.pn = pi;
      u.A = (const char*)(U + (size_t)pm * 256 * D); const int brow = pi < 4 ? pi * 256 : 1536 + (pi - 4) * 256; u.Bt = (const char*)(W + (size_t)brow * D);
      if (pi < 4) { u.out = Pqk; u.ldo = 1024; u.x1 = pi * 256; } else { u.out = Prw; u.ldo = RW_IN; u.x1 = (pi - 4) * 256; } u.x0 = pm * 256; return true; }
    if (Lx < 1452 + 264) { const int v = Lx - 1452, pmv = v & 1, pnv = v >> 1; u.pm = pmv; u.pn = pnv; u.A = (const char*)(W + (size_t)(1024 + pmv * 256) * D); u.Bt = (const char*)(U + (size_t)pnv * 256 * D);
      u.out = Vt; u.ldo = NTOK; u.x0 = pmv * 256; u.x1 = pnv * 256; return true; }
    return false; } };
struct SchedOddIn { static constexpr bool GATHER = false; const bf16_t* U; const bf16_t* W; bf16_t* Pqk; bf16_t* Vt; int G, c;
  __device__ __forceinline__ bool next(int i, pg8::Unit& u) const { const int Lx = i * G + c;
    if (Lx < 1056) { const int grp = Lx / 32, rem = Lx % 32, pm = grp * 4 + (rem & 3), pi = rem >> 2; u.pm = pm; u.pn = pi; u.kind = pm < 128 ? 1 : 0;
      u.A = (const char*)(U + (size_t)pm * 256 * D); u.Bt = (const char*)(W + (size_t)pi * 256 * D); u.out = Pqk; u.ldo = 2048; u.x0 = pm * 256; u.x1 = pi * 256; return true; }
    if (Lx < 1056 + 528) { const int v = Lx - 1056, pmv = v & 3, pnv = v >> 2; u.pm = pmv; u.pn = pnv; u.kind = 0; u.A = (const char*)(W + (size_t)(2048 + pmv * 256) * D); u.Bt = (const char*)(U + (size_t)pnv * 256 * D);
      u.out = Vt; u.ldo = NTOK; u.x0 = pmv * 256; u.x1 = pnv * 256; return true; }
    return false; } };
struct SchedOut { static constexpr bool GATHER = false; const bf16_t* O; const bf16_t* W; bf16_t* Y; int G, c;
  __device__ __forceinline__ bool next(int i, pg8::Unit& u) const { const int Lx = i * G + c; if (Lx >= 528) return false; const int pm = (Lx / 16) * 4 + (Lx & 3), pn = (Lx & 15) >> 2; u.pm = pm; u.pn = pn; u.kind = 0;
    u.A = (const char*)(O + (size_t)pm * 256 * D); u.Bt = (const char*)(W + (size_t)pn * 256 * D); u.out = Y; u.ldo = 1024; u.x0 = pm * 256; u.x1 = pn * 256; return true; } };
template <bool GATH>
struct SchedMoe { static constexpr bool GATHER = GATH; const bf16_t* A; const bf16_t* W; bf16_t* out; const LAS int* moff; const int* rl; int Kd, ldo, ncol, G, c;
  __device__ __forceinline__ bool next(int i, pg8::Unit& u) const { const int Lx = i * G + c; const int ntile = moff[16] >> 8; if (Lx >= ntile * 4) return false;
    const int pm = Lx >> 2, pn = Lx & 3; int e = 0;
#pragma unroll
    for (int j = 1; j < 16; ++j) e += (pm * 256 >= moff[j]) ? 1 : 0;
    u.pm = pm; u.pn = pn; u.kind = 0; u.A = GATH ? (const char*)A : (const char*)(A + (size_t)pm * 256 * Kd); u.rl = rl + pm * 256; u.Bt = (const char*)(W + ((size_t)e * 1024 + pn * 256) * Kd); u.out = out; u.ldo = ldo; u.x0 = pm * 256; u.x1 = pn * ncol; return true; } };

struct EpiOddIn {
  static constexpr bool PERM = true; const float* rope;
  __device__ __forceinline__ void operator()(const f32x4 (&acc)[2][2][4][2], const pg8::Unit& u, int wr, int wc, int fr, int fq) const {
    if (u.kind == 0) { pg8::EpiStoreBf16{}(acc, u, wr, wc, fr, fq); return; }
    const int row0 = u.x0 + wr * 64 + fr, col0 = u.x1 + wc * 32 + 8 * fq; const int half = wc & 1;
#pragma unroll
    for (int ai = 0; ai < 2; ++ai)
#pragma unroll
      for (int m = 0; m < 4; ++m) { const int row = row0 + ai * 128 + m * 16; const int t = row & (T - 1); const int pos = half ? (t & 63) : (t >> 6);
        const f32x4 cs0 = *(const f32x4*)(rope + (pos * 16 + 4 * fq) * 2), cs1 = *(const f32x4*)(rope + (pos * 16 + 4 * fq + 2) * 2);
        bf16_t* rowp = u.out + (size_t)row * u.ldo + col0;
#pragma unroll
        for (int bj = 0; bj < 2; ++bj) { const f32x4 v0 = acc[ai][bj][m][0], v1 = acc[ai][bj][m][1];
          u32x4 w; w.x = cvt_pk_bf16(v0[0] * cs0[0] - v0[1] * cs0[1], v0[0] * cs0[1] + v0[1] * cs0[0]); w.y = cvt_pk_bf16(v0[2] * cs0[2] - v0[3] * cs0[3], v0[2] * cs0[3] + v0[3] * cs0[2]);
          w.z = cvt_pk_bf16(v1[0] * cs1[0] - v1[1] * cs1[1], v1[0] * cs1[1] + v1[1] * cs1[0]); w.w = cvt_pk_bf16(v1[2] * cs1[2] - v1[3] * cs1[3], v1[2] * cs1[3] + v1[3] * cs1[2]);
          *(u32x4*)(rowp + bj * 128) = w; } }
  }
};
struct EpiGateUp {
  static constexpr bool PERM = true;
  __device__ __forceinline__ void operator()(const f32x4 (&acc)[2][2][4][2], const pg8::Unit& u, int wr, int wc, int fr, int fq) const {
    const int row0 = u.x0 + wr * 64 + fr, col0 = u.x1 + wc * 16 + 4 * fq;
#pragma unroll
    for (int ai = 0; ai < 2; ++ai)
#pragma unroll
      for (int m = 0; m < 4; ++m) { bf16_t* rowp = u.out + (size_t)(row0 + ai * 128 + m * 16) * u.ldo + col0;
#pragma unroll
        for (int bj = 0; bj < 2; ++bj) { const f32x4 v0 = acc[ai][bj][m][0], v1 = acc[ai][bj][m][1];
          u32x2 w; w.x = cvt_pk_bf16(siluf_(v0[0]) * v0[1], siluf_(v0[2]) * v0[3]); w.y = cvt_pk_bf16(siluf_(v1[0]) * v1[1], siluf_(v1[2]) * v1[3]);
          *(u32x2*)(rowp + bj * 64) = w; } }
  }
};
}

namespace mk {
constexpr int N_PHASES = 2 + 2 * (12 + 10);
__global__ void __launch_bounds__(NTHR, 2) mega(Params p_) {
  const Params& p = p_;
  extern __shared__ __attribute__((aligned(16))) unsigned char shm[];
  LAS unsigned char* lds = (LAS unsigned char*)shm;
  const int nb = gridDim.x;
  if (threadIdx.x == 0) *(LAS u32x4*)(lds + LDS_BARW) = (u32x4){0u, 0u, 0u, 0u};
  __syncthreads();
  XcdBarrier bar = xcd_barrier_post(wsp<unsigned>(p, WS_BAR), (volatile LAS unsigned*)(lds + LDS_BARW));
  int ph = 0;
#ifndef MK_MASK
#define MK_MASK 0xFFFFFFFFu
#endif
#ifndef MK_REP
#define MK_REP 0u
#endif
#define PHASE_BEGIN_K(k) if (((MK_MASK) >> (k)) & 1u) { Params pl_ = p_; asm volatile("" : "+s"(pl_.ws)); const Params& p = pl_; bf16_t* UO = wsp<bf16_t>(p, WS_UO); unsigned char* scr = p.ws + WS_SCR; (void)UO; (void)scr; \
    const int bid = mk::obid(); const int nrep_ = ((((MK_REP) >> (k)) & 1u) ? 2 : 1); for (int rep_ = 0; rep_ < nrep_; ++rep_) { const bool dry = rep_ + 1 < nrep_; (void)dry;
#define PHASE_END   } if (ph + 1 < N_PHASES) { XcdBarrier b_ = bar; asm volatile("" : "+s"(b_.bar), "+s"(b_.x)); xcd_barrier(b_); } } ++ph;
  bf16_t* UO = wsp<bf16_t>(p, WS_UO);
  unsigned char* scr = p.ws + WS_SCR;
  PHASE_BEGIN_K(0) phase_prologue(p, lds); PHASE_END
  PHASE_BEGIN_K(1) phase_mod0(p); PHASE_END
  for (int lp = 0; lp < 2; ++lp) {
    {
      const int l = 2 * lp;
      bf16_t* Pqk = (bf16_t*)(scr + SE_PQK); bf16_t* Vt = (bf16_t*)(scr + SE_VT); bf16_t* Prw = (bf16_t*)(scr + SE_PRW); bf16_t* Ybuf = (bf16_t*)(scr + SE_YBUF);
      rw::Bufs bf; bf.SH = (u32x2*)(scr + SE_SH); bf.DR = (unsigned*)(scr + SE_DR); bf.G = UO + 512; bf.gstride = 1024; bf.CS = (float*)(scr + SE_CS) + (size_t)lp * NTOK * 16; bf.PQ = (float*)(scr + SE_PQ); bf.SST = (float*)(scr + SE_SST); bf.Y = (bf16_t*)(scr + SE_Y); bf.Z = (bf16_t*)(scr + SE_Z);
      PHASE_BEGIN_K(2) { SchedEvenIn S{UO, wsp<bf16_t>(p, WS_WEIN) + (size_t)lp * EVEN_IN * D, Pqk, Prw, Vt, nb, bid}; pg8::gemm_phase(lds, D, S, pg8::EpiStoreBf16{}); } PHASE_END
      PHASE_BEGIN_K(3) {
#ifdef MK_P3
        if (!(dry && MK_P3 == 2))
#endif
        for (int u = bid; u < 1024 + 32; u += nb) { int b, h, rq; if (u < 1024) { b = u >> 8; h = (u >> 5) & 7; rq = u & 31; } else { const int v = u - 1024; b = v >> 3; h = v & 7; rq = -1; }
          natt::na_attn_unit(Pqk, Vt, p.na_rpb + ((size_t)lp * 8 + h) * 465, UO, b, h, rq, lds); }
        const int pb = (bid + nb / 2) % nb;
#ifdef MK_P3
        if (!(dry && MK_P3 == 1))
#endif
        for (int t = pb; t < NTOK / 16; t += nb) rw::prep_tile(Prw, p.shift_w + (size_t)lp * 3 * RW_IN, p.rw_w0 + lp * 1024, wsp<bf16_t>(p, WS_WLT) + (size_t)lp * 196608, p.rw_a0 + lp * 1024, p.rw_k_k + lp * 512, p.rw_k_a + lp * 512, p.rw_r_k + lp * 512, bf, t, (LAS float*)lds); } PHASE_END
      PHASE_BEGIN_K(4) for (int u = bid * 8 + (mk::otid() >> 6); u < rw::NCHAIN * rw::NCH; u += nb * 8) rw::scan_unit(bf, p.rw_k_a + lp * 512, u / rw::NCH, u % rw::NCH, (LAS float*)lds + (mk::otid() >> 6) * 4096); PHASE_END
      PHASE_BEGIN_K(5) for (int c = bid; c < rw::NCHAIN * 4; c += nb) rw::propagate_chain(bf, c >> 2, c & 3, (LAS float*)lds); PHASE_END
      PHASE_BEGIN_K(6) for (int u = bid * 8 + (mk::otid() >> 6); u < rw::NCHAIN * (rw::NCH - 1); u += nb * 8) rw::corr_unit(bf, u / (rw::NCH - 1), 1 + u % (rw::NCH - 1)); PHASE_END
      PHASE_BEGIN_K(7) rw::finish_phase<8>(bf, p.rw_gn_g + lp * 512, p.rw_gn_b + lp * 512, UO); PHASE_END
      PHASE_BEGIN_K(8) { SchedOut S{UO, wsp<bf16_t>(p, WS_WEOUT) + (size_t)lp * D * D, Ybuf, nb, bid}; pg8::gemm_phase(lds, D, S, pg8::EpiStoreBf16{}); __syncthreads(); cvt_experts(p, l, (LAS float*)lds, 528 - 2 * nb > 0 ? 528 - 2 * nb : 0); } PHASE_END
      PHASE_BEGIN_K(9) if (l == 0) phase_ln1<true>(p, l, Ybuf, lds, dry); else phase_ln1<false>(p, l, Ybuf, lds, dry); PHASE_END
      PHASE_BEGIN_K(10) phase_scatter(p, l, lds); PHASE_END
      PHASE_BEGIN_K(11) { LAS int* mo = (LAS int*)(lds + LDS_MISC); { const int tq = mk::otid(); if (tq < 17) mo[tq] = wsp<int>(p, WS_MOFF)[l * 64 + tq]; } __syncthreads();
        SchedMoe<true> S{UO, wsp<bf16_t>(p, WS_WGU), (bf16_t*)(scr + SM_HE), mo, wsp<int>(p, WS_RL), D, DE, 128, nb, bid}; pg8::gemm_phase(lds, D, S, EpiGateUp{}); } PHASE_END
      PHASE_BEGIN_K(12) { LAS int* mo = (LAS int*)(lds + LDS_MISC); { const int tq = mk::otid(); if (tq < 17) mo[tq] = wsp<int>(p, WS_MOFF)[l * 64 + tq]; } __syncthreads();
        SchedMoe<false> S{(bf16_t*)(scr + SM_HE), wsp<bf16_t>(p, WS_WDN), (bf16_t*)(scr + SM_YS), mo, nullptr, DE, D, 256, nb, bid}; pg8::gemm_phase(lds, DE, S, pg8::EpiStoreBf16{}); } PHASE_END
      PHASE_BEGIN_K(13) phase_ln2(p, l, dry); PHASE_END
    }
    {
      const int l = 2 * lp + 1; const bool last = l == DEPTH - 1;
      bf16_t* Pqk = (bf16_t*)(scr + SO_PQK); bf16_t* Vt = (bf16_t*)(scr + SO_VT); bf16_t* O12 = (bf16_t*)(scr + SO_O12); bf16_t* Ybuf = (bf16_t*)(scr + SO_YBUF);
      PHASE_BEGIN_K(14) { SchedOddIn S{UO, wsp<bf16_t>(p, WS_WOIN) + (size_t)lp * ODD_IN * D, Pqk, Vt, nb, bid}; pg8::gemm_phase(lds, D, S, EpiOddIn{wsp<float>(p, WS_ROPE)}); } PHASE_END
      float* KN = wsp<float>(p, WS_KN) + (size_t)lp * 256 * 32;
      PHASE_BEGIN_K(23) for (int g = bid; g < 256; g += nb) att::knorm_group(Pqk, KN, g, (LAS float*)lds); PHASE_END
      PHASE_BEGIN_K(15) for (int ui = bid; ui < 2048 + (last ? 0 : 64); ui += nb) { int b, hh, q0, nlat; const int u = (nb == 256 && ui < 2048) ? ((((ui >> 8) * 8 + (bid & 7)) << 5) | (bid >> 3)) : ui;
        if (u < 2048) { b = u >> 9; hh = (u >> 5) & 15; q0 = b * T + (u & 31) * 256; nlat = T; } else { const int v = u - 2048; b = v >> 4; hh = v & 15; q0 = NLAT + b * L; nlat = 0; }
        const bool st = __builtin_amdgcn_sqrtf(att::nmax2_of(KN, b, hh, 0) * att::nmax2_of(KN, b, hh, 1)) * 1.001f <= 60.0f;
#ifdef MK_ABL
        if (dry) att::diff_attn_unit<true, MK_ABL>(Pqk, Vt, O12, hh, q0, b * T, nlat, NLAT + b * L, lds); else
#endif
        if (st) att::diff_attn_unit<true>(Pqk, Vt, O12, hh, q0, b * T, nlat, NLAT + b * L, lds); else att::diff_attn_unit<false>(Pqk, Vt, O12, hh, q0, b * T, nlat, NLAT + b * L, lds); } PHASE_END
      PHASE_BEGIN_K(16) { float d1 = 0.f, d2 = 0.f; for (int i = 0; i < 64; ++i) { d1 += p.da_lq1[lp * 64 + i] * p.da_lk1[lp * 64 + i]; d2 += p.da_lq2[lp * 64 + i] * p.da_lk2[lp * 64 + i]; }
        const float li = 0.8f - 0.6f * expf(-0.3f * (float)l), lam = expf(d1) - expf(d2) + li;
        const int tq = mk::otid(); for (int r4 = bid; r4 < (last ? NLAT : NTOK) / 4; r4 += nb) att::diff_combine_rows4(O12, p.da_subln_g + lp * 128, lam, 1.0f - li, UO, r4 * 4, tq >> 6, tq & 63); } PHASE_END
      PHASE_BEGIN_K(17) { SchedOut S{UO, wsp<bf16_t>(p, WS_WOOUT) + (size_t)lp * D * D, Ybuf, nb, bid}; pg8::gemm_phase(lds, D, S, pg8::EpiStoreBf16{}); __syncthreads(); cvt_experts(p, l, (LAS float*)lds, 528 - 2 * nb > 0 ? 528 - 2 * nb : 0); } PHASE_END
      PHASE_BEGIN_K(18) phase_ln1<false>(p, l, Ybuf, lds, dry); PHASE_END
      PHASE_BEGIN_K(19) phase_scatter(p, l, lds); PHASE_END
      PHASE_BEGIN_K(20) { LAS int* mo = (LAS int*)(lds + LDS_MISC); { const int tq = mk::otid(); if (tq < 17) mo[tq] = wsp<int>(p, WS_MOFF)[l * 64 + tq]; } __syncthreads();
        SchedMoe<true> S{UO, wsp<bf16_t>(p, WS_WGU), (bf16_t*)(scr + SM_HE), mo, wsp<int>(p, WS_RL), D, DE, 128, nb, bid}; pg8::gemm_phase(lds, D, S, EpiGateUp{}); } PHASE_END
      PHASE_BEGIN_K(21) { LAS int* mo = (LAS int*)(lds + LDS_MISC); { const int tq = mk::otid(); if (tq < 17) mo[tq] = wsp<int>(p, WS_MOFF)[l * 64 + tq]; } __syncthreads();
        SchedMoe<false> S{(bf16_t*)(scr + SM_HE), wsp<bf16_t>(p, WS_WDN), (bf16_t*)(scr + SM_YS), mo, nullptr, DE, D, 256, nb, bid}; pg8::gemm_phase(lds, DE, S, pg8::EpiStoreBf16{}); } PHASE_END
      PHASE_BEGIN_K(22) phase_ln2(p, l, dry); PHASE_END
    }
  }
#undef PHASE_BEGIN_K
#undef PHASE_END
}
}

#ifndef MK_SINGLE_LAUNCH
#define MK_SINGLE_LAUNCH 1
#endif
extern "C" void kernel_launch(void* const* d_in, const int* in_sizes, int n_in, void* d_out, int out_size, void* d_ws, size_t ws_size, hipStream_t stream) {
  using namespace mk;
  static int grid = 0;
  if (grid == 0) {
    if (n_in != 34 || out_size != NLAT * D || ws_size < WS_END) { fprintf(stderr, "kernel_launch: unexpected shapes (n_in %d out %d ws %zu need %zu)\n", n_in, out_size, ws_size, (size_t)WS_END); grid = -1; return; }
    if (hipFuncSetAttribute((const void*)mega, hipFuncAttributeMaxDynamicSharedMemorySize, LDS_BYTES) != hipSuccess) { grid = -1; return; }
    int dev = 0, cus = 0, per_cu = 0;
    if (hipGetDevice(&dev) != hipSuccess || hipDeviceGetAttribute(&cus, hipDeviceAttributeMultiprocessorCount, dev) != hipSuccess) { grid = -1; return; }
    if (hipOccupancyMaxActiveBlocksPerMultiprocessor(&per_cu, (const void*)mega, NTHR, LDS_BYTES) != hipSuccess || per_cu < 1) { fprintf(stderr, "kernel_launch: occupancy query says %d\n", per_cu); }
    (void)hipGetLastError();
    grid = cus;
  }
  if (grid < 0) return;
  (void)hipMemsetAsync((char*)d_ws + WS_BAR, 0, (size_t)XCD_BAR_WORDS * 4, stream);
  Params p{};
  const float** pp = (const float**)&p;
  for (int i = 0; i < 34; ++i) pp[i] = (const float*)d_in[i];
  p.out = (float*)d_out; p.ws = (unsigned char*)d_ws;
#if MK_SINGLE_LAUNCH
  p.ph_lo = 0; p.ph_hi = N_PHASES;
  hipLaunchKernelGGL(mega, dim3(grid), dim3(NTHR), LDS_BYTES, stream, p);
#else
  for (int ph = 0; ph < N_PHASES; ++ph) { p.ph_lo = ph; p.ph_hi = ph + 1; hipLaunchKernelGGL(mega, dim3(grid), dim3(NTHR), LDS_BYTES, stream, p); }
#endif
}
```

```cpp
#include <hip/hip_runtime.h>
#include <stdint.h>
#include <stdio.h>

typedef unsigned short bf16_t;
typedef short bf16x8 __attribute__((ext_vector_type(8)));
typedef float f32x4 __attribute__((ext_vector_type(4)));
typedef float f32x2 __attribute__((ext_vector_type(2)));
typedef float f32x16 __attribute__((ext_vector_type(16)));
typedef unsigned u32x4 __attribute__((ext_vector_type(4)));
typedef unsigned u32x2 __attribute__((ext_vector_type(2)));
#define LAS __attribute__((address_space(3)))

namespace mk {
constexpr int B = 4, T = 8192, L = 256, D = 1024, NLAT = B * T, NCTX = B * L, NTOK = NLAT + NCTX;
constexpr int DEPTH = 4, EVEN_IN = 3328, ODD_IN = 3072, RW_OFF = 1536, RW_IN = 1792, NE = 16, DE = 512;
constexpr float ALPHA = 1.681792830507429f, LN_EPS = 1e-5f;
constexpr int NTHR = 512, LDS_BYTES = 147456;
constexpr int MOE_TILES = 280, MOE_ROWS = MOE_TILES * 256;

typedef __bf16 bf16x2v __attribute__((ext_vector_type(2)));
__device__ __forceinline__ unsigned cvt_pk_bf16(float lo, float hi) { const f32x2 v = {lo, hi}; return __builtin_bit_cast(unsigned, __builtin_convertvector(v, bf16x2v)); }
__device__ __forceinline__ unsigned cvt_pk_bf16_v(float lo, float hi) { return cvt_pk_bf16(lo, hi); }
template <int V> struct IntC { static constexpr int value = V; };
__device__ __forceinline__ float bf2f(bf16_t b) { return __uint_as_float(((unsigned)b) << 16); }
__device__ __forceinline__ float bflo(unsigned w) { return __uint_as_float(w << 16); }
__device__ __forceinline__ float bfhi(unsigned w) { return __uint_as_float(w & 0xffff0000u); }
__device__ __forceinline__ bf16_t f2bf(float f) { return (bf16_t)(cvt_pk_bf16(f, 0.f) & 0xffffu); }
__device__ __forceinline__ float sigmoidf_(float x) { return 1.0f / (1.0f + __expf(-x)); }
__device__ __forceinline__ float siluf_(float x) { return x / (1.0f + __expf(-x)); }
__device__ __forceinline__ float sigmoid_r(float x) { return __builtin_amdgcn_rcpf(1.0f + __expf(-x)); }
__device__ __forceinline__ float silu_r(float x) { return x * __builtin_amdgcn_rcpf(1.0f + __expf(-x)); }
__device__ __forceinline__ float wave_sum(float v) {
#pragma unroll
  for (int o = 32; o > 0; o >>= 1) v += __shfl_xor(v, o);
  return v;
}
template <int CTRL, int RM, int BM> __device__ __forceinline__ float dpp_mov(float old, float v) { return __int_as_float(__builtin_amdgcn_update_dpp(__float_as_int(old), __float_as_int(v), CTRL, RM, BM, false)); }
__device__ __forceinline__ float wave_sum_u(float v) {
  v += dpp_mov<0xB1, 0xf, 0xf>(v, v);
  v += dpp_mov<0x4E, 0xf, 0xf>(v, v);
  v += dpp_mov<0x141, 0xf, 0xf>(v, v);
  v += dpp_mov<0x140, 0xf, 0xf>(v, v);
  v += dpp_mov<0x142, 0xa, 0xf>(0.f, v);
  v += dpp_mov<0x143, 0xc, 0xf>(0.f, v);
  return __int_as_float(__builtin_amdgcn_readlane(__float_as_int(v), 63));
}
__device__ __forceinline__ float wave_max_u(float v) {
  v = fmaxf(v, dpp_mov<0xB1, 0xf, 0xf>(v, v));
  v = fmaxf(v, dpp_mov<0x4E, 0xf, 0xf>(v, v));
  v = fmaxf(v, dpp_mov<0x141, 0xf, 0xf>(v, v));
  v = fmaxf(v, dpp_mov<0x140, 0xf, 0xf>(v, v));
  v = fmaxf(v, dpp_mov<0x142, 0xa, 0xf>(0.f, v));
  v = fmaxf(v, dpp_mov<0x143, 0xc, 0xf>(0.f, v));
  return __int_as_float(__builtin_amdgcn_readlane(__float_as_int(v), 63));
}
__device__ __forceinline__ f32x16 zero16() { float z = 0.f; asm volatile("" : "+v"(z)); f32x16 r;
#pragma unroll
  for (int i = 0; i < 16; ++i) r[i] = z;
  return r; }
__device__ __forceinline__ int otid() { int t = threadIdx.x; asm volatile("" : "+v"(t)); return t; }
__device__ __forceinline__ int obid() { int b = blockIdx.x; asm volatile("" : "+s"(b)); return b; }
__device__ __forceinline__ int bidx_of_row(int row) { return row < NLAT ? row / T : 4; }
}

#include <vector>

#define XB_TMO      128
#define XB_XCNT(j)  (256  + 64 * (j))
#define XB_XSUB(j)  (1280 + 64 * (j))
#define XB_XGEN(j)  (2304 + 64 * (j))
#define XB_TOP      3328
#define XB_TOPGEN   3392
#define XCD_BAR_WORDS 3456
#define XB_SPIN_CAP (1u << 18)
#define LAS __attribute__((address_space(3)))

__device__ __forceinline__ unsigned xb_ld(unsigned* p)              { return __hip_atomic_load(p, __ATOMIC_RELAXED, __HIP_MEMORY_SCOPE_AGENT); }
__device__ __forceinline__ unsigned xb_add(unsigned* p, unsigned v) { return __hip_atomic_fetch_add(p, v, __ATOMIC_RELAXED, __HIP_MEMORY_SCOPE_AGENT); }
__device__ __forceinline__ unsigned xb_xcc_id() { return (unsigned)__builtin_amdgcn_s_getreg((3 << 11) | 20) & 0xFu; }
#define XB_SPIN(cond, bar) do { unsigned _sp = 0; while (cond) { __builtin_amdgcn_s_sleep(1); \
    if ((++_sp & 255u) == 0u) { if (xb_ld(&(bar)[XB_TMO])) break; if (_sp > XB_SPIN_CAP) { atomicAdd(&(bar)[XB_TMO], 1u); break; } } } } while (0)

struct XcdBarrier {
    unsigned* bar; unsigned x;
    volatile LAS unsigned* st;
};

__device__ __forceinline__ XcdBarrier xcd_barrier_post(unsigned* bar, volatile LAS unsigned* st) {
    XcdBarrier b; b.bar = bar; b.x = xb_xcc_id(); b.st = st;
    if (threadIdx.x == 0) (void)xb_add(&bar[XB_XCNT(b.x)], 1u);
    return b;
}
__device__ __forceinline__ void xcd_barrier_complete(unsigned* bar, unsigned x, unsigned& nloc, unsigned& nx) {
    const unsigned G = gridDim.x * gridDim.y * gridDim.z;
    unsigned sum, cnt, mine, sp = 0u;
    for (;;) {
        sum = 0u; cnt = 0u; mine = 0u;
#pragma unroll
        for (unsigned j = 0; j < 16; ++j) { const unsigned c = xb_ld(&bar[XB_XCNT(j)]); sum += c; cnt += (c > 0u) ? 1u : 0u; mine = (j == x) ? c : mine; }
        if (sum == G) break;
        __builtin_amdgcn_s_sleep(1);
        if ((++sp & 255u) == 0u) { if (xb_ld(&bar[XB_TMO])) break; if (sp > XB_SPIN_CAP) { atomicAdd(&bar[XB_TMO], 1u); break; } }
    }
    nloc = mine > 0u ? mine : 1u; nx = cnt > 0u ? cnt : 1u;
}

__device__ __forceinline__ void xcd_barrier(const XcdBarrier& b) {
    asm volatile("s_waitcnt vmcnt(0)" ::: "memory");
    __syncthreads();
    if (threadIdx.x == 0) {
        unsigned* bar = b.bar;
        __builtin_amdgcn_s_waitcnt(0);
        unsigned nloc = b.st[0], nx = b.st[1];
        if (nloc == 0u) { xcd_barrier_complete(bar, b.x, nloc, nx); b.st[0] = nloc; b.st[1] = nx; }
        const unsigned old = xb_add(&bar[XB_XSUB(b.x)], 1u);
        const unsigned gen = old / nloc;
        if (old + 1u == (gen + 1u) * nloc) {
            __builtin_amdgcn_fence(__ATOMIC_RELEASE, "agent");
            asm volatile("s_waitcnt vmcnt(0)" ::: "memory");
            const unsigned og = xb_add(&bar[XB_TOP], 1u);
            const unsigned tg = og / nx;
            if (og + 1u == (tg + 1u) * nx) xb_add(&bar[XB_TOPGEN], 1u);
            else XB_SPIN(xb_ld(&bar[XB_TOPGEN]) == tg, bar);
            __builtin_amdgcn_fence(__ATOMIC_ACQUIRE, "agent");
            xb_add(&bar[XB_XGEN(b.x)], 1u);
            asm volatile("s_waitcnt vmcnt(0)" ::: "memory");
        } else {
            XB_SPIN(xb_ld(&bar[XB_XGEN(b.x)]) == gen, bar);
            __builtin_amdgcn_fence(__ATOMIC_ACQUIRE, "agent");
            asm volatile("s_waitcnt vmcnt(0)" ::: "memory");
        }
    }
    __syncthreads();
}

namespace pg8 {
using mk::cvt_pk_bf16;
constexpr int BM = 256, BK = 64, HALF = 128, HTB = HALF * BK * 2  , STAGE_BYTES = 8 * HTB;
__host__ __device__ __forceinline__ int lds_byte(int r, int c) { const int st = (r >> 4) * 2 + (c >> 5), rr = r & 15, cc = c & 31, ob = rr * 64 + cc * 2; return st * 1024 + (ob ^ (((ob >> 9) & 1) << 5)); }
__host__ __device__ __forceinline__ void stage_rc(int b, int& R, int& C) { const int st = b / 1024, sb = b % 1024, swz = sb ^ (((sb >> 9) & 1) << 5); R = (st >> 1) * 16 + swz / 64; C = (st & 1) * 32 + (swz % 64) / 2; }
__host__ __device__ __forceinline__ int perm32(int rho) { const int n = rho >> 4, i = rho & 15; return 8 * (i >> 2) + 4 * n + (i & 3); }

struct Unit { const char* A; const char* Bt; bf16_t* out; const int* rl; int pm, pn, x0, x1, ldo, kind; };

template <class Epi, class Sched>
__device__ __forceinline__ void gemm_phase(LAS unsigned char* lds, const int K, const Sched& S, const Epi& E) {
    const int tid = mk::otid(), wid = __builtin_amdgcn_readfirstlane(tid >> 6), lane = tid & 63, wr = wid >> 2, wc = wid & 3, fr = lane & 15, fq = lane >> 4;
    const int nt = K / BK;
    constexpr bool GATH = Sched::GATHER;
    unsigned voffA[2], voffB[2]; int Rl[2], Cl[2];
#pragma unroll
    for (int i = 0; i < 2; ++i) { int R, C; stage_rc(tid * 16 + i * 8192, R, C); const int Rb = Epi::PERM ? ((R & ~31) + perm32(R & 31)) : R; Rl[i] = R; Cl[i] = C;
        voffA[i] = (unsigned)(R * K + C) * 2u; voffB[i] = (unsigned)(Rb * K + C) * 2u; }
    unsigned roC[2][2], roN[2][2];
    (void)Rl; (void)Cl;
    const size_t kstep = (size_t)(BK * 2);
    const size_t hstep = (size_t)HALF * K * 2;
    const unsigned ldsw = (unsigned)wid * 1024u;
    const int aoff = lds_byte(wr * 64 + fr, fq * 8), boff = lds_byte(wc * 32 + fr, fq * 8);
#define PG8_SA(b, h) (((b) * 2 + (h)) * HTB)
#define PG8_SB(b, h) ((4 + (b) * 2 + (h)) * HTB)
#define PG8_STAGE(bufoff, gbase, voff) do { _Pragma("unroll") for (int _i = 0; _i < 2; ++_i) \
        __builtin_amdgcn_global_load_lds((const unsigned*)((const char*)(gbase) + (voff)[_i]), (LAS unsigned*)(lds + (bufoff) + ldsw + _i * 8192), 16, 0, 0); } while (0)
#define PG8_STAGE_A(bufoff, gbase, h, ro) do { if constexpr (GATH) { _Pragma("unroll") for (int _i = 0; _i < 2; ++_i) \
        __builtin_amdgcn_global_load_lds((const unsigned*)((const char*)(gbase) + (ro)[h][_i]), (LAS unsigned*)(lds + (bufoff) + ldsw + _i * 8192), 16, 0, 0); } \
      else { PG8_STAGE(bufoff, (const char*)(gbase) + (h) * hstep, voffA); } } while (0)
#define PG8_LOAD_RO(u, ro) do { _Pragma("unroll") for (int _h = 0; _h < 2; ++_h) _Pragma("unroll") for (int _i = 0; _i < 2; ++_i) \
        (ro)[_h][_i] = (unsigned)(u).rl[Rl[_i] + _h * 128] * (unsigned)(K * 2) + (unsigned)(Cl[_i] * 2); } while (0)
#define PG8_LDA(dst, b, h) do { _Pragma("unroll") for (int m = 0; m < 4; ++m) _Pragma("unroll") for (int k = 0; k < 2; ++k) dst[m][k] = *(const LAS bf16x8*)(lds + PG8_SA(b, h) + aoff + m * 2048 + k * 1024); } while (0)
#define PG8_LDB(dst, b, h) do { _Pragma("unroll") for (int n = 0; n < 2; ++n) _Pragma("unroll") for (int k = 0; k < 2; ++k) dst[n][k] = *(const LAS bf16x8*)(lds + PG8_SB(b, h) + boff + n * 2048 + k * 1024); } while (0)
#define PG8_MMA(ai, bj, At, Bt) do { __builtin_amdgcn_s_setprio(1); _Pragma("unroll") for (int m = 0; m < 4; ++m) _Pragma("unroll") for (int n = 0; n < 2; ++n) _Pragma("unroll") for (int k = 0; k < 2; ++k) \
        acc[ai][bj][m][n] = __builtin_amdgcn_mfma_f32_16x16x32_bf16(Bt[n][k], At[m][k], acc[ai][bj][m][n], 0, 0, 0); __builtin_amdgcn_s_setprio(0); } while (0)
#define PG8_WAIT_V(n) asm volatile("s_waitcnt vmcnt(" #n ")" ::: "memory")
#define PG8_WAIT_L(n) asm volatile("s_waitcnt lgkmcnt(" #n ")" ::: "memory")
#define PG8_BAR __builtin_amdgcn_s_barrier()
#define PG8_SCHED __builtin_amdgcn_sched_barrier(0)
    Unit cur, nxt; int ui = 0;
    if (!S.next(0, cur)) return;
    f32x4 acc[2][2][4][2];
#pragma unroll
    for (int a = 0; a < 2; ++a)
#pragma unroll
        for (int b = 0; b < 2; ++b)
#pragma unroll
            for (int m = 0; m < 4; ++m)
#pragma unroll
                for (int n = 0; n < 2; ++n) acc[a][b][m][n] = (f32x4){0.f, 0.f, 0.f, 0.f};
    bf16x8 At[4][2], B0[2][2], B1[2][2];
    const char* cA = cur.A; const char* cB = cur.Bt;
    if constexpr (GATH) { PG8_LOAD_RO(cur, roC); }
    PG8_STAGE(PG8_SB(0, 0), cB, voffB); PG8_STAGE_A(PG8_SA(0, 0), cA, 0, roC); PG8_STAGE(PG8_SB(0, 1), cB + hstep, voffB); PG8_STAGE_A(PG8_SA(0, 1), cA, 1, roC);
    if (wr == 1) PG8_BAR;
    PG8_WAIT_V(4); PG8_BAR;
    PG8_STAGE(PG8_SB(1, 0), cB + kstep, voffB); PG8_STAGE_A(PG8_SA(1, 0), cA + kstep, 0, roC); PG8_STAGE(PG8_SB(1, 1), cB + hstep + kstep, voffB);
    PG8_WAIT_V(6); PG8_BAR;
    for (;;) {
        const bool has_next = S.next(ui + 1, nxt);
        const char* nA = has_next ? nxt.A : cA; const char* nB = has_next ? nxt.Bt : cB;
        if constexpr (GATH) { if (has_next) { PG8_LOAD_RO(nxt, roN); } else { _Pragma("unroll") for (int _h = 0; _h < 2; ++_h) _Pragma("unroll") for (int _i = 0; _i < 2; ++_i) roN[_h][_i] = roC[_h][_i]; } }
        for (int t = 0; t < nt; t += 2) {
            const bool last = (t == nt - 2);
            const char* a1 = cA + (size_t)(t + 1) * kstep;
            const char* a2 = last ? nA : cA + (size_t)(t + 2) * kstep; const char* b2 = last ? nB : cB + (size_t)(t + 2) * kstep;
            const char* a3 = a2 + kstep; const char* b3 = b2 + kstep;
            unsigned ro2[2][2];
            if constexpr (GATH) { _Pragma("unroll") for (int _h = 0; _h < 2; ++_h) _Pragma("unroll") for (int _i = 0; _i < 2; ++_i) ro2[_h][_i] = last ? roN[_h][_i] : roC[_h][_i]; }
            (void)ro2;
            PG8_LDB(B0, 0, 0); PG8_SCHED; PG8_LDA(At, 0, 0); PG8_STAGE_A(PG8_SA(1, 1), a1, 1, roC);
            PG8_WAIT_L(8); PG8_BAR; PG8_WAIT_L(0); PG8_MMA(0, 0, At, B0); PG8_BAR; PG8_SCHED;
            PG8_LDB(B1, 0, 1); PG8_STAGE(PG8_SB(0, 0), b2, voffB);
            PG8_BAR; PG8_WAIT_L(0); PG8_MMA(0, 1, At, B1); PG8_BAR;
            PG8_LDA(At, 0, 1); PG8_STAGE_A(PG8_SA(0, 0), a2, 0, ro2);
            PG8_BAR; PG8_WAIT_L(0); PG8_MMA(1, 0, At, B0); PG8_BAR; PG8_SCHED;
            PG8_STAGE(PG8_SB(0, 1), b2 + hstep, voffB);
            PG8_WAIT_V(6); PG8_BAR; PG8_MMA(1, 1, At, B1); PG8_BAR;
            PG8_LDB(B0, 1, 0); PG8_SCHED; PG8_LDA(At, 1, 0); PG8_STAGE_A(PG8_SA(0, 1), a2, 1, ro2);
            PG8_WAIT_L(8); PG8_BAR; PG8_WAIT_L(0); PG8_MMA(0, 0, At, B0); PG8_BAR; PG8_SCHED;
            PG8_LDB(B1, 1, 1); PG8_STAGE(PG8_SB(1, 0), b3, voffB);
            PG8_BAR; PG8_WAIT_L(0); PG8_MMA(0, 1, At, B1); PG8_BAR;
            PG8_LDA(At, 1, 1); PG8_STAGE_A(PG8_SA(1, 0), a3, 0, ro2);
            PG8_BAR; PG8_WAIT_L(0); PG8_MMA(1, 0, At, B0); PG8_BAR; PG8_SCHED;
            PG8_STAGE(PG8_SB(1, 1), b3 + hstep, voffB);
            PG8_WAIT_V(6); PG8_BAR; PG8_MMA(1, 1, At, B1); PG8_BAR;
        }
        E(acc, cur, wr, wc, fr, fq);
        if (!has_next) break;
#pragma unroll
        for (int a = 0; a < 2; ++a)
#pragma unroll
            for (int b = 0; b < 2; ++b)
#pragma unroll
                for (int m = 0; m < 4; ++m)
#pragma unroll
                    for (int n = 0; n < 2; ++n) acc[a][b][m][n] = (f32x4){0.f, 0.f, 0.f, 0.f};
        cur = nxt; cA = nA; cB = nB; ++ui;
        if constexpr (GATH) { _Pragma("unroll") for (int _h = 0; _h < 2; ++_h) _Pragma("unroll") for (int _i = 0; _i < 2; ++_i) roC[_h][_i] = roN[_h][_i]; }
    }
    PG8_WAIT_V(0);
    if (wr == 0) PG8_BAR;
    PG8_BAR;
#undef PG8_SA
#undef PG8_SB
#undef PG8_STAGE
#undef PG8_STAGE_A
#undef PG8_LOAD_RO
#undef PG8_LDA
#undef PG8_LDB
#undef PG8_MMA
#undef PG8_WAIT_V
#undef PG8_WAIT_L
#undef PG8_BAR
#undef PG8_SCHED
}

struct EpiStoreBf16 {
    static constexpr bool PERM = true;
    __device__ __forceinline__ void operator()(const f32x4 (&acc)[2][2][4][2], const Unit& u, int wr, int wc, int fr, int fq) const {
        bf16_t* O = u.out; const int ldc = u.ldo;
        const int row0 = u.x0 + wr * 64 + fr, col0 = u.x1 + wc * 32 + 8 * fq;
#pragma unroll
        for (int ai = 0; ai < 2; ++ai)
#pragma unroll
            for (int m = 0; m < 4; ++m) { bf16_t* rowp = O + (size_t)(row0 + ai * HALF + m * 16) * ldc + col0;
#pragma unroll
                for (int bj = 0; bj < 2; ++bj) { const f32x4 v0 = acc[ai][bj][m][0], v1 = acc[ai][bj][m][1];
                    u32x4 w; w.x = cvt_pk_bf16(v0[0], v0[1]); w.y = cvt_pk_bf16(v0[2], v0[3]); w.z = cvt_pk_bf16(v1[0], v1[1]); w.w = cvt_pk_bf16(v1[2], v1[3]);
                    *(u32x4*)(rowp + bj * HALF) = w; } }
    }
};
}

namespace mk {
struct NMapId { int off; __device__ __forceinline__ int operator()(int n) const { return n + off; } __device__ __forceinline__ float scl(int) const { return 1.0f; } };
struct NMapInterleave { int which; __device__ __forceinline__ int operator()(int n) const { return 2 * n + which; } __device__ __forceinline__ float scl(int) const { return 1.0f; } };
struct NMapRope { __device__ __forceinline__ int operator()(int n) const { if (n >= 2048) return n; const int ch = n >> 6, c = n & 63, half = c >> 5, w = c & 31, z = w >> 4, i = w & 15; return ch * 64 + half * 32 + 2 * i + z; }
  __device__ __forceinline__ float scl(int n) const { return n < 1024 ? 0.125f * 1.4426950408889634f : 1.0f; } };

template <class NMap>
__device__ __forceinline__ void cvt_tile(const float* __restrict__ src, int ldsrc, int K, bf16_t* __restrict__ dst, int k0, int n0, const NMap& nmap, LAS float* tile) {
  const int t = mk::otid();
  { const int k = t >> 3, c = (t & 7) * 8; const float* p = src + (size_t)(k0 + k) * ldsrc + n0 + c;
    const f32x4 a = *(const f32x4*)p, b = *(const f32x4*)(p + 4);
    LAS float* q = tile + k * 65 + c; q[0] = a[0]; q[1] = a[1]; q[2] = a[2]; q[3] = a[3]; q[4] = b[0]; q[5] = b[1]; q[6] = b[2]; q[7] = b[3]; }
  __syncthreads();
  { const int n = t >> 3, kc = (t & 7) * 8; const LAS float* q = tile + kc * 65 + n; const float sc = nmap.scl(n0 + n);
    u32x4 w; w.x = cvt_pk_bf16(q[0] * sc, q[65] * sc); w.y = cvt_pk_bf16(q[130] * sc, q[195] * sc); w.z = cvt_pk_bf16(q[260] * sc, q[325] * sc); w.w = cvt_pk_bf16(q[390] * sc, q[455] * sc);
    *(u32x4*)(dst + (size_t)nmap(n0 + n) * K + k0 + kc) = w; }
  __syncthreads();
}
template <class NMap>
__device__ __forceinline__ int cvt_matrix(const float* src, int ldsrc, int K, int N, bf16_t* dst, const NMap& nmap, LAS float* tile, int ubase, int bid, int nblk) {
  const int nkt = K / 64, nnt = N / 64, tot = nkt * nnt;
  int first = ubase + ((bid - ubase % nblk) + nblk) % nblk;
  for (int u = first; u < ubase + tot; u += nblk) { const int v = u - ubase; cvt_tile(src, ldsrc, K, dst, (v / nnt) * 64, (v % nnt) * 64, nmap, tile); }
  return tot;
}
}

namespace att {
using namespace mk;
constexpr int KB_BYTES = 64 * 128, VB_BYTES = 128 * 128, TILE_BYTES = KB_BYTES + VB_BYTES, DA_RING = 4, DA_LDS = DA_RING * TILE_BYTES;
__device__ __forceinline__ int pi32(int r) { return (r & ~12) | ((r & 4) << 1) | ((r & 8) >> 1); }
__device__ __forceinline__ int swz(int row, int chunk) { return row * 128 + ((chunk ^ ((row >> 1) & 7)) << 4); }
__device__ __forceinline__ int crow(int r, int hi) { return (r & 3) + 8 * (r >> 2) + 4 * hi; }

__device__ __forceinline__ float sumsq8(u32x4 w) { return (bflo(w.x) * bflo(w.x) + bfhi(w.x) * bfhi(w.x)) + (bflo(w.y) * bflo(w.y) + bfhi(w.y) * bfhi(w.y)) + (bflo(w.z) * bflo(w.z) + bfhi(w.z) * bfhi(w.z)) + (bflo(w.w) * bflo(w.w) + bfhi(w.w) * bfhi(w.w)); }
__device__ __forceinline__ void knorm_group(const bf16_t* __restrict__ Pqk, float* __restrict__ KN, int g, LAS float* red) {
  const int tid = mk::otid(), wid = tid >> 6, lane = tid & 63;
  float mx = 0.f, mq = 0.f;
  for (int i0 = 0; i0 < 160; i0 += 32) {
    u32x4 a[4], b[4], c[4], d[4];
#pragma unroll
    for (int j = 0; j < 4; ++j) { int i = i0 + j * 8 + wid; i = i < 132 ? i : wid; const int row = i < 128 ? g * 128 + i : NLAT + g * 4 + (i - 128);
      const bf16_t* kp = Pqk + (size_t)row * 2048 + 1024 + lane * 16; a[j] = *(const u32x4*)kp; b[j] = *(const u32x4*)(kp + 8); c[j] = *(const u32x4*)(kp - 1024); d[j] = *(const u32x4*)(kp - 1024 + 8); }
#pragma unroll
    for (int j = 0; j < 4; ++j) { float s = sumsq8(a[j]) + sumsq8(b[j]); s += dpp_mov<0xB1, 0xf, 0xf>(s, s); s += dpp_mov<0x4E, 0xf, 0xf>(s, s); mx = fmaxf(mx, s);
      float q = sumsq8(c[j]) + sumsq8(d[j]); q += dpp_mov<0xB1, 0xf, 0xf>(q, q); q += dpp_mov<0x4E, 0xf, 0xf>(q, q); mq = fmaxf(mq, q); }
  }
  if ((lane & 3) == 0) { red[wid * 32 + (lane >> 2)] = mx; red[wid * 32 + 16 + (lane >> 2)] = mq; }
  __syncthreads();
  if (tid < 32) { float m = red[tid];
#pragma unroll
    for (int w = 1; w < 8; ++w) m = fmaxf(m, red[w * 32 + tid]);
    KN[g * 32 + tid] = m; }
  __syncthreads();
}
__device__ __forceinline__ float nmax2_of(const float* __restrict__ KN, int b, int hh, int which) {
  return wave_max_u(KN[(b * 64 + (mk::otid() & 63)) * 32 + which * 16 + hh]);
}

template <bool STATIC, int ABL = 0>
__device__ __forceinline__ void diff_attn_unit(const bf16_t* __restrict__ Pqk, const bf16_t* __restrict__ Vt, bf16_t* __restrict__ O12, int hh, int q0, int klat0, int nlat, int kctx0, LAS unsigned char* lds) {
  const int tid = mk::otid(), wid = tid >> 6, lane = tid & 63, r = lane & 31, hi = lane >> 5;
  const int NT = (nlat + L) / 64, NTL = nlat / 64;
  const int wv = __builtin_amdgcn_readfirstlane(wid);
  const int drow = wv * 8 + (lane >> 3), dch = (lane & 7) ^ ((drow >> 1) & 7);
  const unsigned koff = (unsigned)(drow * 2048 + 1024 + hh * 64 + dch * 8) * 2u;
  const unsigned voff = (unsigned)(((hh >> 1) * 128 + drow) * NTOK + dch * 8) * 2u;
  bf16x8 qf[4];
  { const bf16_t* qp = Pqk + (size_t)(q0 + wid * 32 + r) * 2048 + hh * 64 + hi * 8;
#pragma unroll
    for (int ks = 0; ks < 4; ++ks) qf[ks] = *(const bf16x8*)(qp + ks * 16); }
  const unsigned kaddr0 = (unsigned)(pi32(r) * 128 + ((hi ^ ((pi32(r) >> 1) & 7)) << 4));
  const unsigned vaddr0 = (unsigned)(r * 128 + ((hi ^ ((r >> 1) & 7)) << 4)) + KB_BYTES;
  f32x16 o[4];
#pragma unroll
  for (int vb = 0; vb < 4; ++vb)
#pragma unroll
    for (int i = 0; i < 16; ++i) o[vb][i] = 0.f;
  float l_run = 0.f;
#define DA_DMA(t) do { const int tok = (t) < NTL ? klat0 + (t) * 64 : kctx0 + ((t) - NTL) * 64; LAS unsigned char* b_ = lds + ((t) & 3) * TILE_BYTES + wv * 1024; \
    const char* kt_ = (const char*)Pqk + (size_t)tok * 4096; const char* vt_ = (const char*)Vt + (size_t)tok * 2; \
    __builtin_amdgcn_global_load_lds((const unsigned*)(kt_ + koff), (LAS unsigned*)b_, 16, 0, 0); \
    __builtin_amdgcn_global_load_lds((const unsigned*)(vt_ + voff), (LAS unsigned*)(b_ + KB_BYTES), 16, 0, 0); \
    __builtin_amdgcn_global_load_lds((const unsigned*)(vt_ + (size_t)64 * NTOK * 2 + voff), (LAS unsigned*)(b_ + KB_BYTES + 8192), 16, 0, 0); } while (0)
#define DA_WAITV(n) asm volatile("s_waitcnt vmcnt(" #n ")" ::: "memory")
#define DA_PAIR_BEGIN(t) if (!(ABL & 8) && (t) + 2 < NT) { DA_DMA((t) + 2); DA_DMA((t) + 3); }
#define DA_SLOT(tt) const unsigned sb_ = (unsigned)(((tt) & 3) * TILE_BYTES); const LAS unsigned char* kb_ = lds + (kaddr0 + sb_); const LAS unsigned char* vb_ = lds + (vaddr0 + sb_)
#define DA_PAIR_END() do { DA_WAITV(0); asm volatile("s_waitcnt lgkmcnt(0)" ::: "memory"); if (!(ABL & 16)) __builtin_amdgcn_s_barrier(); } while (0)
  DA_DMA(0); DA_DMA(1);
  DA_WAITV(0); __builtin_amdgcn_s_barrier();
#define DA_XOR(ptr, x) ((const LAS unsigned char*)((unsigned)(size_t)(ptr) ^ (unsigned)(x)))
#define DA_KFRAG(ks) const LAS unsigned char* kp_ = DA_XOR(kb_, (ks) << 5); const bf16x8 a0 = (ABL & 2) ? qf[ks] : *(const LAS bf16x8*)kp_, a1 = (ABL & 2) ? qf[(ks) ^ 1] : *(const LAS bf16x8*)(kp_ + 4096)
#define DA_VFRAGS() bf16x8 va[4][4]; \
    _Pragma("unroll") for (int c4 = 0; c4 < 4; ++c4) { const LAS unsigned char* vp_ = DA_XOR(vb_, c4 << 5); \
      _Pragma("unroll") for (int vb = 0; vb < 4; ++vb) va[vb][c4] = (ABL & 1) ? qf[c4 ^ (vb & 3)] : *(const LAS bf16x8*)(vp_ + vb * 4096); }
#define DA_PACK_PV() bf16x8 pf[2][2]; \
    _Pragma("unroll") for (int s = 0; s < 2; ++s) { u32x4 w0, w1; \
      w0.x = cvt_pk_bf16(s0[8 * s + 0], s0[8 * s + 1]); w0.y = cvt_pk_bf16(s0[8 * s + 2], s0[8 * s + 3]); w0.z = cvt_pk_bf16(s0[8 * s + 4], s0[8 * s + 5]); w0.w = cvt_pk_bf16(s0[8 * s + 6], s0[8 * s + 7]); \
      w1.x = cvt_pk_bf16(s1[8 * s + 0], s1[8 * s + 1]); w1.y = cvt_pk_bf16(s1[8 * s + 2], s1[8 * s + 3]); w1.z = cvt_pk_bf16(s1[8 * s + 4], s1[8 * s + 5]); w1.w = cvt_pk_bf16(s1[8 * s + 6], s1[8 * s + 7]); \
      pf[0][s] = __builtin_bit_cast(bf16x8, w0); pf[1][s] = __builtin_bit_cast(bf16x8, w1); } \
    _Pragma("unroll") for (int vb = 0; vb < 4; ++vb) _Pragma("unroll") for (int kb = 0; kb < 2; ++kb) _Pragma("unroll") for (int s = 0; s < 2; ++s) \
      o[vb] = __builtin_amdgcn_mfma_f32_32x32x16_bf16(va[vb][kb * 2 + s], pf[kb][s], o[vb], 0, 0, 0)
  if constexpr (STATIC) {
    for (int t = 0; t < NT; t += 2) {
      DA_PAIR_BEGIN(t);
#pragma unroll
      for (int u = 0; u < 2; ++u) {
        DA_SLOT(t + u);
        f32x16 s0, s1;
#pragma unroll
        for (int i = 0; i < 16; ++i) { s0[i] = 0.f; s1[i] = 0.f; }
#pragma unroll
        for (int ks = 0; ks < 4; ++ks) { DA_KFRAG(ks); s0 = __builtin_amdgcn_mfma_f32_32x32x16_bf16(a0, qf[ks], s0, 0, 0, 0); s1 = __builtin_amdgcn_mfma_f32_32x32x16_bf16(a1, qf[ks], s1, 0, 0, 0); }
        DA_VFRAGS();
        if constexpr ((ABL & 32) != 0) {
          l_run += s0[0] + s1[0];
#pragma unroll
          for (int vb = 0; vb < 4; ++vb)
#pragma unroll
            for (int c4 = 0; c4 < 4; ++c4) o[vb] = __builtin_amdgcn_mfma_f32_32x32x16_bf16(va[vb][c4], qf[c4], o[vb], 0, 0, 0);
        } else {
          float ps = 0.f;
#pragma unroll
          for (int i = 0; i < 16; ++i) { s0[i] = (ABL & 4) ? s0[i] : __builtin_amdgcn_exp2f(s0[i]); ps += s0[i]; }
#pragma unroll
          for (int i = 0; i < 16; ++i) { s1[i] = (ABL & 4) ? s1[i] : __builtin_amdgcn_exp2f(s1[i]); ps += s1[i]; }
          l_run += ps;
          DA_PACK_PV();
        }
      }
      DA_PAIR_END();
    }
  } else {
    constexpr float THR = 8.0f * 1.4426950408889634f;
    float m_run = -1e30f;
    for (int t = 0; t < NT; ++t) {
      if (!(t & 1)) DA_PAIR_BEGIN(t);
      DA_SLOT(t);
      f32x16 s0 = zero16(), s1 = zero16();
#pragma unroll
      for (int ks = 0; ks < 4; ++ks) { DA_KFRAG(ks); s0 = __builtin_amdgcn_mfma_f32_32x32x16_bf16(a0, qf[ks], s0, 0, 0, 0); s1 = __builtin_amdgcn_mfma_f32_32x32x16_bf16(a1, qf[ks], s1, 0, 0, 0); }
      float mx = fmaxf(s0[0], s1[0]);
#pragma unroll
      for (int i = 1; i < 16; ++i) mx = fmaxf(mx, fmaxf(s0[i], s1[i]));
      { const u32x2 sw = __builtin_amdgcn_permlane32_swap(__float_as_uint(mx), __float_as_uint(mx), false, false); mx = fmaxf(__uint_as_float(sw.x), __uint_as_float(sw.y)); }
      float alpha = 1.0f;
      if (!__all(mx - m_run <= THR)) {
        const float m_new = fmaxf(m_run, mx);
        alpha = __builtin_amdgcn_exp2f(m_run - m_new);
        m_run = m_new;
#pragma unroll
        for (int vb = 0; vb < 4; ++vb)
#pragma unroll
          for (int i = 0; i < 16; ++i) o[vb][i] *= alpha;
      }
      float ps = 0.f;
#pragma unroll
      for (int i = 0; i < 16; ++i) { s0[i] = __builtin_amdgcn_exp2f(s0[i] - m_run); ps += s0[i]; }
#pragma unroll
      for (int i = 0; i < 16; ++i) { s1[i] = __builtin_amdgcn_exp2f(s1[i] - m_run); ps += s1[i]; }
      l_run = l_run * alpha + ps;
      __builtin_amdgcn_sched_barrier(0);
      DA_VFRAGS();
      DA_PACK_PV();
      if (t & 1) DA_PAIR_END();
    }
  }
#undef DA_KFRAG
#undef DA_XOR
#undef DA_VFRAGS
#undef DA_PACK_PV
#undef DA_DMA
#undef DA_WAITV
#undef DA_PAIR_BEGIN
#undef DA_PAIR_END
#undef DA_SLOT
  float l_tot; { const u32x2 sw = __builtin_amdgcn_permlane32_swap(__float_as_uint(l_run), __float_as_uint(l_run), false, false); l_tot = __uint_as_float(sw.x) + __uint_as_float(sw.y); }
  const float inv = 1.0f / l_tot;
  const int te = mk::otid();
  bf16_t* op = O12 + (size_t)(q0 + (te >> 6) * 32 + (te & 31)) * 2048 + hh * 128 + 4 * ((te >> 5) & 1);
#pragma unroll
  for (int vb = 0; vb < 4; ++vb)
#pragma unroll
    for (int g = 0; g < 4; ++g) {
      u32x2 w; w.x = cvt_pk_bf16(o[vb][4 * g] * inv, o[vb][4 * g + 1] * inv); w.y = cvt_pk_bf16(o[vb][4 * g + 2] * inv, o[vb][4 * g + 3] * inv);
      *(u32x2*)(op + vb * 32 + 8 * g) = w;
    }
}

__device__ __forceinline__ void diff_combine_rows4(const bf16_t* __restrict__ O12, const float* __restrict__ subln_g, float lam, float oml, bf16_t* __restrict__ O, int row0, int h, int lane) {
  unsigned a[4], b[4];
#pragma unroll
  for (int i = 0; i < 4; ++i) { a[i] = *(const unsigned*)(O12 + (size_t)(row0 + i) * 2048 + (2 * h) * 128 + 2 * lane); b[i] = *(const unsigned*)(O12 + (size_t)(row0 + i) * 2048 + (2 * h + 1) * 128 + 2 * lane); }
  const float g0 = subln_g[2 * lane], g1 = subln_g[2 * lane + 1];
#pragma unroll
  for (int i = 0; i < 4; ++i) {
    const float x0 = bflo(a[i]) - lam * bflo(b[i]), x1 = bfhi(a[i]) - lam * bfhi(b[i]);
    const float ss = wave_sum_u(x0 * x0 + x1 * x1);
    const float rs = rsqrtf(ss * (1.0f / 128.0f) + 1e-5f) * oml;
    *(unsigned*)(O + (size_t)(row0 + i) * 1024 + h * 128 + 2 * lane) = cvt_pk_bf16(x0 * rs * g0, x1 * rs * g1);
  }
}
}

namespace natt {
using namespace mk;
using att::pi32; using att::swz;
constexpr int TB = 64 * 128;
constexpr int NA_LDS = 4 * TB + 2048;
__device__ __forceinline__ void na_attn_unit(const bf16_t* __restrict__ Pe, const bf16_t* __restrict__ Vte, const float* __restrict__ rpb_h, bf16_t* __restrict__ O, int b, int h, int rq, LAS unsigned char* lds) {
  const int tid = mk::otid(), wid = tid >> 6, lane = tid & 63, r = lane & 31, hi = lane >> 5;
  constexpr float LOG2E = 1.4426950408889634f;
  LAS float* sb = (LAS float*)(lds + 4 * TB);
  for (int i = tid; i < 465; i += NTHR) sb[i] = rpb_h[i];
  const bool is_ctx = rq < 0;
  int qrow = 0, qcol = 0, qtok, rs_q = 0, cs_q = 0, span0 = 0, wlo = 0, whi = -1, lo = 0, ntl = 0;
  if (!is_ctx) {
    const int r0 = rq * 4, ra = r0 + (wid >> 2) * 2;
    qrow = ra + (r >> 4); qcol = (wid & 3) * 16 + (r & 15); qtok = b * T + qrow * 64 + qcol;
    rs_q = min(max(qrow - 4, 0), 120); cs_q = min(max(qcol - 8, 0), 48);
    span0 = min(max((wid & 3) * 16 - 8, 0), 32);
    wlo = min(max(ra - 4, 0), 120); whi = min(max(ra - 3, 0), 120) + 7;
    lo = min(max(r0 - 4, 0), 120); const int hi_ = min(max(r0 - 1, 0), 120) + 7; ntl = hi_ - lo + 1;
  } else qtok = NLAT + b * L + wid * 32 + r;
  const int NT = ntl + 4;
  const int srow = tid >> 3, sch = tid & 7;
  const bf16_t* kbase = Pe + 512 + h * 64 + sch * 8;
  const bf16_t* vbase = Vte + (size_t)(h * 64 + srow) * NTOK + sch * 8;
  const int sdst = swz(srow, sch);
  bf16x8 qf[4];
  { const bf16_t* qp = Pe + (size_t)qtok * 1024 + h * 64 + hi * 8;
#pragma unroll
    for (int ks = 0; ks < 4; ++ks) qf[ks] = *(const bf16x8*)(qp + ks * 16); }
  const int kx = (pi32(r) >> 1) & 7, vx = (r >> 1) & 7;
  const int ka_loc = (span0 + pi32(r)) * 128; const int kx_loc = ((span0 + pi32(r)) >> 1) & 7;
  f32x16 o[2];
#pragma unroll
  for (int vb = 0; vb < 2; ++vb)
#pragma unroll
    for (int i = 0; i < 16; ++i) o[vb][i] = 0.f;
  float m_run = -1e30f, l_run = 0.f;
  u32x4 kreg, vreg;
#define NA_LOAD(t) do { const int tok = (t) < ntl ? b * T + (lo + (t)) * 64 : NLAT + b * L + ((t) - ntl) * 64; \
    kreg = *(const u32x4*)(kbase + (size_t)(tok + srow) * 1024); vreg = *(const u32x4*)(vbase + tok); } while (0)
#define NA_WRITE(bufi) do { *(LAS u32x4*)(lds + (bufi) * TB + sdst) = kreg; *(LAS u32x4*)(lds + 2 * TB + (bufi) * TB + sdst) = vreg; } while (0)
  NA_LOAD(0); NA_WRITE(0); __syncthreads();
  for (int t = 0; t < NT; ++t) {
    const bool more = t + 1 < NT;
    if (more) NA_LOAD(t + 1);
    const LAS unsigned char* kb_ = lds + (t & 1) * TB; const LAS unsigned char* vb_ = lds + 2 * TB + (t & 1) * TB;
    const bool local = t < ntl; const int kr = lo + t;
    const bool active = !local || (kr >= wlo && kr <= whi);
    if (active) {
      f32x16 s0, s1;
#pragma unroll
      for (int i = 0; i < 16; ++i) { s0[i] = 0.f; s1[i] = 0.f; }
      if (local) {
#pragma unroll
        for (int ks = 0; ks < 4; ++ks) {
          const bf16x8 a0 = *(const LAS bf16x8*)(kb_ + ka_loc + (((ks * 2 + hi) ^ kx_loc) << 4));
          s0 = __builtin_amdgcn_mfma_f32_32x32x16_bf16(a0, qf[ks], s0, 0, 0, 0);
        }
        const bool row_ok = kr >= rs_q && kr < rs_q + 8; const int dr31 = (kr - qrow + 7) * 31;
#pragma unroll
        for (int i = 0; i < 16; ++i) {
          const int kc = span0 + (i & 7) + 8 * hi + 16 * (i >> 3);
          const bool ok = row_ok && kc >= cs_q && kc < cs_q + 16;
          const int bi = ok ? dr31 + (kc - qcol + 15) : 0;
          const float bv = sb[bi];
          s0[i] = ok ? fmaf(s0[i], 0.125f, bv) : -1e30f; s1[i] = -1e30f;
        }
      } else {
#pragma unroll
        for (int ks = 0; ks < 4; ++ks) {
          const int ch = ((ks * 2 + hi) ^ kx) << 4;
          const bf16x8 a0 = *(const LAS bf16x8*)(kb_ + pi32(r) * 128 + ch), a1 = *(const LAS bf16x8*)(kb_ + (32 + pi32(r)) * 128 + ch);
          s0 = __builtin_amdgcn_mfma_f32_32x32x16_bf16(a0, qf[ks], s0, 0, 0, 0);
          s1 = __builtin_amdgcn_mfma_f32_32x32x16_bf16(a1, qf[ks], s1, 0, 0, 0);
        }
#pragma unroll
        for (int i = 0; i < 16; ++i) { s0[i] *= 0.125f; s1[i] *= 0.125f; }
      }
      float mx = s0[0];
#pragma unroll
      for (int i = 1; i < 16; ++i) mx = fmaxf(mx, s0[i]);
#pragma unroll
      for (int i = 0; i < 16; ++i) mx = fmaxf(mx, s1[i]);
      { const u32x2 sw = __builtin_amdgcn_permlane32_swap(__float_as_uint(mx), __float_as_uint(mx), false, false); mx = fmaxf(__uint_as_float(sw.x), __uint_as_float(sw.y)); }
      const float m_new = fmaxf(m_run, mx);
      const float alpha = __builtin_amdgcn_exp2f((m_run - m_new) * LOG2E);
      m_run = m_new;
      const float mc = -m_new * LOG2E;
      float ps = 0.f;
#pragma unroll
      for (int i = 0; i < 16; ++i) { const float p = s0[i] > -1e29f ? __builtin_amdgcn_exp2f(fmaf(s0[i], LOG2E, mc)) : 0.f; s0[i] = p; ps += p; }
#pragma unroll
      for (int i = 0; i < 16; ++i) { const float p = s1[i] > -1e29f ? __builtin_amdgcn_exp2f(fmaf(s1[i], LOG2E, mc)) : 0.f; s1[i] = p; ps += p; }
      l_run = l_run * alpha + ps;
      if (__any(alpha < 1.0f)) {
#pragma unroll
        for (int vb = 0; vb < 2; ++vb)
#pragma unroll
          for (int i = 0; i < 16; ++i) o[vb][i] *= alpha;
      }
      bf16x8 pf[2][2];
#pragma unroll
      for (int s = 0; s < 2; ++s) {
        u32x4 w0, w1;
        w0.x = cvt_pk_bf16(s0[8 * s + 0], s0[8 * s + 1]); w0.y = cvt_pk_bf16(s0[8 * s + 2], s0[8 * s + 3]); w0.z = cvt_pk_bf16(s0[8 * s + 4], s0[8 * s + 5]); w0.w = cvt_pk_bf16(s0[8 * s + 6], s0[8 * s + 7]);
        w1.x = cvt_pk_bf16(s1[8 * s + 0], s1[8 * s + 1]); w1.y = cvt_pk_bf16(s1[8 * s + 2], s1[8 * s + 3]); w1.z = cvt_pk_bf16(s1[8 * s + 4], s1[8 * s + 5]); w1.w = cvt_pk_bf16(s1[8 * s + 6], s1[8 * s + 7]);
        pf[0][s] = __builtin_bit_cast(bf16x8, w0); pf[1][s] = __builtin_bit_cast(bf16x8, w1);
      }
      const int cbase = local ? (span0 >> 3) : 0;
#pragma unroll
      for (int vb = 0; vb < 2; ++vb) {
        const LAS unsigned char* vrow = vb_ + (vb * 32 + r) * 128;
#pragma unroll
        for (int s = 0; s < 2; ++s) {
          const bf16x8 a = *(const LAS bf16x8*)(vrow + (((cbase + 2 * s + hi) ^ vx) << 4));
          o[vb] = __builtin_amdgcn_mfma_f32_32x32x16_bf16(a, pf[0][s], o[vb], 0, 0, 0);
        }
        if (!local) {
#pragma unroll
          for (int s = 0; s < 2; ++s) {
            const bf16x8 a = *(const LAS bf16x8*)(vrow + (((4 + 2 * s + hi) ^ vx) << 4));
            o[vb] = __builtin_amdgcn_mfma_f32_32x32x16_bf16(a, pf[1][s], o[vb], 0, 0, 0);
          }
        }
      }
    }
    if (more) NA_WRITE((t + 1) & 1);
    __syncthreads();
  }
#undef NA_LOAD
#undef NA_WRITE
  float l_tot; { const u32x2 sw = __builtin_amdgcn_permlane32_swap(__float_as_uint(l_run), __float_as_uint(l_run), false, false); l_tot = __uint_as_float(sw.x) + __uint_as_float(sw.y); }
  const float inv = 1.0f / l_tot;
  bf16_t* op = O + (size_t)qtok * 1024 + h * 64 + 4 * hi;
#pragma unroll
  for (int vb = 0; vb < 2; ++vb)
#pragma unroll
    for (int g = 0; g < 4; ++g) {
      u32x2 w; w.x = cvt_pk_bf16(o[vb][4 * g] * inv, o[vb][4 * g + 1] * inv); w.y = cvt_pk_bf16(o[vb][4 * g + 2] * inv, o[vb][4 * g + 3] * inv);
      *(u32x2*)(op + vb * 32 + 8 * g) = w;
    }
}
}

namespace rw {
using namespace mk;
constexpr int NSTEP = L + T, NCH = 32, CL = NSTEP / NCH;
constexpr int NCHAIN = 2 * B * 8;
constexpr float LOG2E = 1.4426950408889634f;
struct Bufs {
  u32x2* SH;
  unsigned* DR;
  bf16_t* G; int gstride;
  float* CS;
  float* PQ;
  float* SST;
  bf16_t* Y;
  bf16_t* Z;
};

constexpr int XPITCH = 528;
template <int KS> struct LoraW { bf16x8 w[KS][4]; };
template <int KS>
__device__ __forceinline__ void lora_load(const bf16_t* __restrict__ W, int h, int lane, LoraW<KS>& f) {
  const int fr = lane & 15, fq = lane >> 4;
#pragma unroll
  for (int ks = 0; ks < KS; ++ks)
#pragma unroll
    for (int nb = 0; nb < 4; ++nb) f.w[ks][nb] = *(const bf16x8*)(W + (size_t)(h * 64 + nb * 16 + fr) * (KS * 32) + ks * 32 + fq * 8);
}
template <int KS>
__device__ __forceinline__ void lora_mma(const LAS unsigned char* xb, int xcol0, const LoraW<KS>& f, int lane, LAS float* tw, float (&out)[16]) {
  const int fr = lane & 15, fq = lane >> 4;
  f32x4 acc[4];
#pragma unroll
  for (int nb = 0; nb < 4; ++nb) { float z = 0.f; asm volatile("" : "+v"(z)); acc[nb] = (f32x4){z, z, z, z}; }
#pragma unroll
  for (int ks = 0; ks < KS; ++ks) {
    const bf16x8 xf = *(const LAS bf16x8*)(xb + fr * XPITCH + (xcol0 + ks * 32 + fq * 8) * 2);
#pragma unroll
    for (int nb = 0; nb < 4; ++nb) acc[nb] = __builtin_amdgcn_mfma_f32_16x16x32_bf16(xf, f.w[ks][nb], acc[nb], 0, 0, 0);
  }
#pragma unroll
  for (int nb = 0; nb < 4; ++nb) *(LAS f32x4*)(tw + (nb * 16 + fr) * 16 + fq * 4) = acc[nb];
  __builtin_amdgcn_wave_barrier(); asm volatile("s_waitcnt lgkmcnt(0)" ::: "memory"); __builtin_amdgcn_wave_barrier();
#pragma unroll
  for (int q = 0; q < 4; ++q) { const f32x4 v = *(const LAS f32x4*)(tw + lane * 16 + q * 4); out[q * 4] = v[0]; out[q * 4 + 1] = v[1]; out[q * 4 + 2] = v[2]; out[q * 4 + 3] = v[3]; }
  __builtin_amdgcn_wave_barrier(); asm volatile("s_waitcnt lgkmcnt(0)" ::: "memory"); __builtin_amdgcn_wave_barrier();
}
__device__ __forceinline__ void prep_tile(const bf16_t* __restrict__ Prw, const float* __restrict__ cw, const float* __restrict__ w0, const bf16_t* __restrict__ WLT, const float* __restrict__ a0,
                                          const float* __restrict__ k_k, const float* __restrict__ k_a, const float* __restrict__ r_k,
                                          const Bufs& bf, int tile, LAS float* xs  ) {
  const int c = mk::otid(), lane = c & 63, h = c >> 6;
  const int row0 = tile * 16;
  int lo, hi;
  if (row0 < NLAT) { lo = (row0 / T) * T; hi = lo + T - 1; } else { lo = NLAT + ((row0 - NLAT) / L) * L; hi = lo + L - 1; }
  bf16_t rraw[18], kraw[18], vraw[18];
#pragma unroll
  for (int j = 0; j < 18; ++j) { int rr_ = row0 - 1 + j; rr_ = rr_ < lo ? lo : (rr_ > hi ? hi : rr_); const bf16_t* q = Prw + (size_t)rr_ * RW_IN + c; rraw[j] = q[0]; kraw[j] = q[512]; vraw[j] = q[1024]; }
  LoraW<2> wd0, wd1; LoraW<4> wg;
  lora_load<2>(WLT, h, lane, wd0); lora_load<2>(WLT + 32768, h, lane, wd1);
#define RW_CONV(dst, col) do { const float c0 = cw[(col)], c1 = cw[RW_IN + (col)], c2 = cw[2 * RW_IN + (col)]; const bf16_t* p = Prw + (col); \
    bf16_t raw[18]; \
    _Pragma("unroll") for (int j = 0; j < 18; ++j) { int rr = row0 - 1 + j; rr = rr < lo ? lo : (rr > hi ? hi : rr); raw[j] = p[(size_t)rr * RW_IN]; } \
    float pm = row0 > lo ? bf2f(raw[0]) : 0.f, pc = bf2f(raw[1]); \
    _Pragma("unroll") for (int tt = 0; tt < 16; ++tt) { const float pn = (row0 + tt + 1 <= hi) ? bf2f(raw[tt + 2]) : 0.f; dst[tt] = pm * c0 + pc * c1 + pn * c2; pm = pc; pc = pn; } } while (0)
  if (c < 256) {
    float xv[16]; RW_CONV(xv, 1536 + c);
#pragma unroll
    for (int tt = 0; tt < 16; ++tt) { float v = xv[tt]; if (c < 64) v = 2.0f * sigmoid_r(2.0f * v) - 1.0f; else if (c >= 128) v = sigmoid_r(v);     *(LAS bf16_t*)((LAS unsigned char*)xs + tt * XPITCH + c * 2) = f2bf(v); }
  }
  __syncthreads();
  const LAS unsigned char* xb = (const LAS unsigned char*)xs; LAS float* tw = xs + 20480 + h * 1024;
  const float w00 = w0[c], w01 = w0[512 + c], a00 = a0[c], a01 = a0[512 + c], kkc = k_k[c], kac = k_a[c], rkc = r_k[c];
  float e0[16], e1[16];
  {
    float aw0[16], aw1[16];
    lora_mma<2>(xb, 0, wd0, lane, tw, aw0); lora_mma<2>(xb, 0, wd1, lane, tw, aw1);
    lora_load<2>(WLT + 2 * 32768, h, lane, wd0); lora_load<2>(WLT + 3 * 32768, h, lane, wd1);
#pragma unroll
    for (int tt = 0; tt < 16; ++tt) {
      e0[tt] = 0.6065306597126334f * __builtin_amdgcn_rcpf(1.0f + __expf(-(w00 + aw0[tt])));
      e1[tt] = 0.6065306597126334f * __builtin_amdgcn_rcpf(1.0f + __expf(-(w01 + aw1[tt])));
    }
  }
  LAS float* asl = xs + 256 * 16;
  {
    float aa0[16], aa1[16];
    lora_mma<2>(xb, 64, wd0, lane, tw, aa0); lora_mma<2>(xb, 64, wd1, lane, tw, aa1);
    lora_load<4>(WLT + 4 * 32768, h, lane, wg);
#pragma unroll
    for (int tt = 0; tt < 16; ++tt) { const unsigned d0 = cvt_pk_bf16(e0[tt], sigmoid_r(a00 + aa0[tt])), d1 = cvt_pk_bf16(e1[tt], sigmoid_r(a01 + aa1[tt]));
      bf.DR[((size_t)(row0 + tt)) * 512 + c] = d0; bf.DR[((size_t)NTOK + row0 + tt) * 512 + c] = d1; asl[tt * 512 + c] = bfhi(d0); asl[(16 + tt) * 512 + c] = bfhi(d1); }
  }
  {
    float ag[16];
    lora_mma<4>(xb, 128, wg, lane, tw, ag);
#pragma unroll
    for (int tt = 0; tt < 16; ++tt) bf.G[(size_t)(row0 + tt) * bf.gstride + c] = f2bf(ag[tt]);
  }
#undef RW_CONV
  const float cr0 = cw[c], cr1 = cw[RW_IN + c], cr2 = cw[2 * RW_IN + c], ck0 = cw[512 + c], ck1 = cw[RW_IN + 512 + c], ck2 = cw[2 * RW_IN + 512 + c], cv0 = cw[1024 + c], cv1 = cw[RW_IN + 1024 + c], cv2 = cw[2 * RW_IN + 1024 + c];
  float rm = row0 > lo ? bf2f(rraw[0]) : 0.f, km = row0 > lo ? bf2f(kraw[0]) : 0.f, vm = row0 > lo ? bf2f(vraw[0]) : 0.f;
  float rc = bf2f(rraw[1]), kc = bf2f(kraw[1]), vc = bf2f(vraw[1]);
#pragma unroll
  for (int tt = 0; tt < 16; ++tt) {
    const int row = row0 + tt;
    const bool has_n = row + 1 <= hi;
    const float rn = has_n ? bf2f(rraw[tt + 2]) : 0.f, kn = has_n ? bf2f(kraw[tt + 2]) : 0.f, vn = has_n ? bf2f(vraw[tt + 2]) : 0.f;
    const float rv = rm * cr0 + rc * cr1 + rn * cr2, kvv = km * ck0 + kc * ck1 + kn * ck2, vvv = vm * cv0 + vc * cv1 + vn * cv2;
    rm = rc; rc = rn; km = kc; kc = kn; vm = vc; vc = vn;
    float kk = kvv * kkc; const float nrm = sqrtf(wave_sum_u(kk * kk)); kk = kk * __builtin_amdgcn_rcpf(fmaxf(nrm, 1e-12f));
    u32x2 sh; sh.x = cvt_pk_bf16(rv, kvv); sh.y = cvt_pk_bf16(kk, vvv);
    bf.SH[(size_t)row * 512 + c] = sh;
    const float rq = bflo(sh.x), kq = bfhi(sh.x);
    const float cb0 = wave_sum_u(rq * kq * (1.0f + (asl[tt * 512 + c] - 1.0f) * kac) * rkc), cb1 = wave_sum_u(rq * kq * (1.0f + (asl[(16 + tt) * 512 + c] - 1.0f) * kac) * rkc);
    if (lane == 0) { bf.CS[(size_t)row * 16 + h] = cb0; bf.CS[(size_t)row * 16 + 8 + h] = cb1; }
  }
  __syncthreads();
}

struct StepRaw { u32x2 s; unsigned d; };
__device__ __forceinline__ int scan_row(int dir, int b, int p) {
  if (p < L) return NLAT + b * L + (dir ? (L - 1 - p) : p);
  const int q = p - L; return b * T + (dir ? (T - 1 - q) : q);
}
__device__ __forceinline__ void scan_unit(const Bufs& bf, const float* __restrict__ k_a, int chain, int chunk, LAS float* wl) {
  const int lane = mk::otid() & 63, r = lane & 31, hi = lane >> 5;
  const int dir = chain >> 5, b = (chain >> 3) & 3, h = chain & 7, ch = h * 64 + lane;
  const float kac = k_a[ch];
  f32x16 TS[2][2], TP[2][2];
#pragma unroll
  for (int rb = 0; rb < 2; ++rb)
#pragma unroll
    for (int cb = 0; cb < 2; ++cb)
#pragma unroll
      for (int q = 0; q < 16; ++q) { TS[rb][cb][q] = 0.f; TP[rb][cb][q] = (32 * rb + (q & 3) + 8 * (q >> 2) + 4 * hi == 32 * cb + r) ? 1.f : 0.f; }
  LAS unsigned char* wb = (LAS unsigned char*)wl;
  const LAS unsigned char* xrow = wb + (lane & 15) * 128 + 8 * hi;
  LAS float* Gl = wl + 1024;
  const int p0 = chunk * CL;
  float Dl = 1.f;
#define RW_FRAG(base, rb, s2) ([&]() { const u32x2 lo_ = *(const LAS u32x2*)((base) + (32 * (rb) + 16 * (s2)) * 2), hi_ = *(const LAS u32x2*)((base) + (32 * (rb) + 16 * (s2) + 8) * 2); \
      return __builtin_bit_cast(bf16x8, (u32x4){lo_.x, lo_.y, hi_.x, hi_.y}); }())
#define RW_DOTS(T, o) do { _Pragma("unroll") for (int cb = 0; cb < 2; ++cb) _Pragma("unroll") for (int q = 0; q < 16; ++q) o[cb][q] = 0.f; \
    _Pragma("unroll") for (int rb = 0; rb < 2; ++rb) _Pragma("unroll") for (int s2 = 0; s2 < 2; ++s2) _Pragma("unroll") for (int cb = 0; cb < 2; ++cb) { u32x4 w_; \
      w_.x = cvt_pk_bf16(T[rb][cb][8 * s2 + 0], T[rb][cb][8 * s2 + 1]); w_.y = cvt_pk_bf16(T[rb][cb][8 * s2 + 2], T[rb][cb][8 * s2 + 3]); \
      w_.z = cvt_pk_bf16(T[rb][cb][8 * s2 + 4], T[rb][cb][8 * s2 + 5]); w_.w = cvt_pk_bf16(T[rb][cb][8 * s2 + 6], T[rb][cb][8 * s2 + 7]); \
      o[cb] = __builtin_amdgcn_mfma_f32_32x32x16_bf16(xf[rb][s2], __builtin_bit_cast(bf16x8, w_), o[cb], 0, 0, 0); \
      asm volatile("" : "+v"(o[cb]) : "v"(w_), "v"(xf[rb][s2]));   } } while (0)
#define RW_RENORM() do { wl[1280 + lane] = Dl; __builtin_amdgcn_wave_barrier(); \
    _Pragma("unroll") for (int rb = 0; rb < 2; ++rb) _Pragma("unroll") for (int g = 0; g < 4; ++g) { const f32x4 w4 = *(const LAS f32x4*)(wl + 1280 + 32 * rb + 8 * g + 4 * hi); \
      _Pragma("unroll") for (int cb = 0; cb < 2; ++cb) _Pragma("unroll") for (int u = 0; u < 4; ++u) { TS[rb][cb][4 * g + u] *= w4[u]; TP[rb][cb][4 * g + u] *= w4[u]; } } \
    __builtin_amdgcn_wave_barrier(); Dl = 1.f; } while (0)
  const int wvs = __builtin_amdgcn_readfirstlane((int)((size_t)wl));
#define RW_FETCH(tb) do { _Pragma("unroll") for (int u = 0; u < 8; ++u) { const int pn = (tb) + u < CL ? (tb) + u : CL - 1; const int row = scan_row(dir, b, p0 + pn); \
      const unsigned* gs = (const unsigned*)(bf.SH + (size_t)row * 512 + ch); const unsigned* gd = bf.DR + ((size_t)dir * NTOK + row) * 512 + ch; LAS unsigned* ld = (LAS unsigned*)(size_t)(wvs + 8192 + u * 768); \
      __builtin_amdgcn_global_load_lds(gs, ld, 4, 0, 0); __builtin_amdgcn_global_load_lds(gs + 1, ld + 64, 4, 0, 0); __builtin_amdgcn_global_load_lds(gd, ld + 128, 4, 0, 0); } } while (0)
  RW_FETCH(0);
  for (int t0 = 0; t0 < CL; t0 += 8) {
    asm volatile("s_waitcnt vmcnt(0)" ::: "memory");
    __builtin_amdgcn_wave_barrier();
#pragma unroll
    for (int u = 0; u < 8; ++u) {
      const LAS unsigned* ld = (const LAS unsigned*)(wb + 8192 + u * 768) + lane; const unsigned sx = ld[0], sy = ld[64], dd = ld[128];
      const float rr = bflo(sx), k = bfhi(sx), kk = bflo(sy), e = bflo(dd), asg = bfhi(dd);
      const float w = __builtin_amdgcn_exp2f(-e * LOG2E), keff = k * (1.0f + (asg - 1.0f) * kac);
      ((LAS bf16_t*)wb)[u * 64 + lane] = f2bf(-kk * Dl);
      Dl *= w; const float dinv = __builtin_amdgcn_rcpf(Dl);
      ((LAS bf16_t*)wb)[(8 + u) * 64 + lane] = f2bf(rr * Dl);
      ((LAS bf16_t*)wb)[1024 + u * 64 + lane] = f2bf(kk * asg * dinv); ((LAS bf16_t*)wb)[1024 + (8 + u) * 64 + lane] = f2bf(keff * dinv);
      ((LAS bf16_t*)wb)[3072 + u * 64 + lane] = (bf16_t)(sy >> 16);
    }
    asm volatile("s_waitcnt lgkmcnt(0)" ::: "memory");
    __builtin_amdgcn_wave_barrier();
    RW_FETCH(t0 + 8);
    __builtin_amdgcn_wave_barrier();
    bf16x8 xf[2][2];
#pragma unroll
    for (int rb = 0; rb < 2; ++rb)
#pragma unroll
      for (int s2 = 0; s2 < 2; ++s2) xf[rb][s2] = RW_FRAG(xrow, rb, s2);
    { f32x16 gm;
#pragma unroll
      for (int q = 0; q < 16; ++q) gm[q] = 0.f;
#pragma unroll
      for (int rb = 0; rb < 2; ++rb)
#pragma unroll
        for (int s2 = 0; s2 < 2; ++s2) { const bf16x8 yf = RW_FRAG(xrow + 2048, rb, s2); gm = __builtin_amdgcn_mfma_f32_32x32x16_bf16(xf[rb][s2], yf, gm, 0, 0, 0); asm volatile("" : "+v"(gm) : "v"(yf), "v"(xf[rb][s2])); }
      if (r < 16) {
#pragma unroll
        for (int q = 0; q < 8; ++q) Gl[((q & 3) + 8 * (q >> 2) + 4 * hi) * 16 + r] = gm[q]; }
    }
    float sa[2][8], yy[2][8];
    { f32x16 oS[2], oP[2];
      RW_DOTS(TS, oS); RW_DOTS(TP, oP);
#pragma unroll
      for (int cb = 0; cb < 2; ++cb)
#pragma unroll
        for (int q = 0; q < 4; ++q) {
          { const u32x2 sw = __builtin_amdgcn_permlane32_swap(__float_as_uint(oS[cb][q]), __float_as_uint(oP[cb][q]), false, false); sa[cb][q] = __uint_as_float(sw.x); sa[cb][4 + q] = __uint_as_float(sw.y); }
          { const u32x2 sw = __builtin_amdgcn_permlane32_swap(__float_as_uint(oS[cb][4 + q]), __float_as_uint(oP[cb][4 + q]), false, false); yy[cb][q] = __uint_as_float(sw.x); yy[cb][4 + q] = __uint_as_float(sw.y); } }
    }
    __builtin_amdgcn_wave_barrier();
    float vm[2][8];
#pragma unroll
    for (int u = 0; u < 8; ++u) { const LAS bf16_t* vr = (const LAS bf16_t*)wb + 3072 + u * 64 + r; vm[0][u] = hi ? 0.f : bf2f(vr[0]); vm[1][u] = hi ? 0.f : bf2f(vr[32]); }
#pragma unroll
    for (int s = 0; s < 8; ++s) {
      const f32x4 ga0 = *(const LAS f32x4*)(Gl + s * 16), ga1 = *(const LAS f32x4*)(Gl + s * 16 + 4), ga2 = *(const LAS f32x4*)(Gl + s * 16 + 8), ga3 = *(const LAS f32x4*)(Gl + s * 16 + 12);
      const f32x4 gr0 = *(const LAS f32x4*)(Gl + (8 + s) * 16), gr1 = *(const LAS f32x4*)(Gl + (8 + s) * 16 + 4), gr2 = *(const LAS f32x4*)(Gl + (8 + s) * 16 + 8), gr3 = *(const LAS f32x4*)(Gl + (8 + s) * 16 + 12);
      const float gab[8] = {ga0[0], ga0[1], ga0[2], ga0[3], ga1[0], ga1[1], ga1[2], ga1[3]}, gak[8] = {ga2[0], ga2[1], ga2[2], ga2[3], ga3[0], ga3[1], ga3[2], ga3[3]};
      const float grb[8] = {gr0[0], gr0[1], gr0[2], gr0[3], gr1[0], gr1[1], gr1[2], gr1[3]}, grk[8] = {gr2[0], gr2[1], gr2[2], gr2[3], gr3[0], gr3[1], gr3[2], gr3[3]};
#pragma unroll
      for (int cb = 0; cb < 2; ++cb) {
        float x = sa[cb][s], y = yy[cb][s];
#pragma unroll
        for (int u = 0; u < 8; ++u) { if (u < s) { x = fmaf(gab[u], sa[cb][u], x); x = fmaf(gak[u], vm[cb][u], x); } }
        sa[cb][s] = x;
#pragma unroll
        for (int u = 0; u < 8; ++u) { if (u <= s) { y = fmaf(grb[u], sa[cb][u], y); y = fmaf(grk[u], vm[cb][u], y); } }
        yy[cb][s] = y;
      }
    }
    { bf16_t* yz = hi ? bf.Z : bf.Y;
#pragma unroll
      for (int s = 0; s < 8; ++s) { const size_t oi = ((size_t)dir * NTOK + scan_row(dir, b, p0 + t0 + s)) * 512 + h * 64 + r; yz[oi] = f2bf(yy[0][s]); yz[oi + 32] = f2bf(yy[1][s]); } }
    { bf16x8 au[2], buS[2], buP[2];
      u32x4 a0, a1, s0, s1, p0_, p1_;
#pragma unroll
      for (int q = 0; q < 4; ++q) {
        const int u = 4 * hi + q;
        const LAS bf16_t* yb = (const LAS bf16_t*)wb + 1024 + u * 64 + r; const LAS bf16_t* vr = (const LAS bf16_t*)wb + 3072 + u * 64 + r;
        a0[q] = (unsigned)yb[0] | ((unsigned)yb[512] << 16); a1[q] = (unsigned)yb[32] | ((unsigned)yb[512 + 32] << 16);
        const u32x2 sw0 = __builtin_amdgcn_permlane32_swap(__float_as_uint(sa[0][q]), __float_as_uint(sa[0][4 + q]), false, false), sw1 = __builtin_amdgcn_permlane32_swap(__float_as_uint(sa[1][q]), __float_as_uint(sa[1][4 + q]), false, false);
        s0[q] = (cvt_pk_bf16(__uint_as_float(sw0.x), 0.f) & 0xffffu) | ((unsigned)vr[0] << 16); s1[q] = (cvt_pk_bf16(__uint_as_float(sw1.x), 0.f) & 0xffffu) | ((unsigned)vr[32] << 16);
        p0_[q] = cvt_pk_bf16(__uint_as_float(sw0.y), 0.f); p1_[q] = cvt_pk_bf16(__uint_as_float(sw1.y), 0.f); }
      au[0] = __builtin_bit_cast(bf16x8, a0); au[1] = __builtin_bit_cast(bf16x8, a1); buS[0] = __builtin_bit_cast(bf16x8, s0); buS[1] = __builtin_bit_cast(bf16x8, s1); buP[0] = __builtin_bit_cast(bf16x8, p0_); buP[1] = __builtin_bit_cast(bf16x8, p1_);
#pragma unroll
      for (int rb = 0; rb < 2; ++rb)
#pragma unroll
        for (int cb = 0; cb < 2; ++cb) { TS[rb][cb] = __builtin_amdgcn_mfma_f32_32x32x16_bf16(au[rb], buS[cb], TS[rb][cb], 0, 0, 0); TP[rb][cb] = __builtin_amdgcn_mfma_f32_32x32x16_bf16(au[rb], buP[cb], TP[rb][cb], 0, 0, 0); }
    }
    __builtin_amdgcn_wave_barrier();
    if ((t0 & 31) == 24) RW_RENORM();
  }
  RW_RENORM();
#undef RW_DOTS
#undef RW_FRAG
#undef RW_RENORM
#undef RW_FETCH
  asm volatile("s_waitcnt vmcnt(0)" ::: "memory");
  if (chunk < NCH - 1) {
    float* pq = bf.PQ + (((size_t)chain * (NCH - 1) + chunk) * 2) * 4096;
#pragma unroll
    for (int rb = 0; rb < 2; ++rb)
#pragma unroll
      for (int cb = 0; cb < 2; ++cb)
#pragma unroll
        for (int g = 0; g < 4; ++g) { float* q = pq + (size_t)(32 * cb + r) * 64 + 32 * rb + 8 * g + 4 * hi;
          *(f32x4*)q = (f32x4){TP[rb][cb][4 * g], TP[rb][cb][4 * g + 1], TP[rb][cb][4 * g + 2], TP[rb][cb][4 * g + 3]};
          *(f32x4*)(q + 4096) = (f32x4){TS[rb][cb][4 * g], TS[rb][cb][4 * g + 1], TS[rb][cb][4 * g + 2], TS[rb][cb][4 * g + 3]}; }
  }
}

__device__ __forceinline__ void propagate_chain(const Bufs& bf, int chain, int rq, LAS float* lds) {
  LAS float* Sl = lds; LAS float* Pl = lds + 16 * 65 + 15;
  Pl = lds + 1056;
  const int tid = mk::otid(), i = tid >> 5, jc = (tid & 31) * 2, row = rq * 16 + i, pi = tid >> 3, pj = (tid & 7) * 8;
  float* sst = bf.SST + (size_t)chain * NCH * 4096;
  Sl[i * 65 + jc] = 0.f; Sl[i * 65 + jc + 1] = 0.f;
  const float* pb = bf.PQ + ((size_t)chain * (NCH - 1) * 2) * 4096;
  f32x4 np0 = *(const f32x4*)(pb + pi * 64 + pj), np1 = *(const f32x4*)(pb + pi * 64 + pj + 4); f32x2 nq = *(const f32x2*)(pb + 4096 + row * 64 + jc);
  for (int c = 0; c < NCH - 1; ++c) {
    const f32x4 p0 = np0, p1 = np1; f32x2 q = nq;
    { const float* pn = pb + (size_t)(c + 1 < NCH - 1 ? c + 1 : c) * 2 * 4096;
      np0 = *(const f32x4*)(pn + pi * 64 + pj); np1 = *(const f32x4*)(pn + pi * 64 + pj + 4); nq = *(const f32x2*)(pn + 4096 + row * 64 + jc); }
    *(LAS f32x4*)(Pl + pi * 64 + pj) = p0; *(LAS f32x4*)(Pl + pi * 64 + pj + 4) = p1;
    __syncthreads();
#pragma unroll 16
    for (int k = 0; k < 64; ++k) { const float sv = Sl[i * 65 + k]; const f32x2 a = *(const LAS f32x2*)(Pl + k * 64 + jc); q += sv * a; }
    __syncthreads();
    Sl[i * 65 + jc] = q[0]; Sl[i * 65 + jc + 1] = q[1];
    *(f32x2*)(sst + (size_t)(c + 1) * 4096 + row * 64 + jc) = q;
  }
  __syncthreads();
}

__device__ __forceinline__ void corr_unit(const Bufs& bf, int chain, int chunk) {
  const int lane = mk::otid() & 63, r = lane & 31, hi = lane >> 5;
  const int dir = chain >> 5, b = (chain >> 3) & 3, h = chain & 7;
  const float* ss = bf.SST + ((size_t)chain * NCH + chunk) * 4096;
  bf16x8 bfr[2][4];
#pragma unroll
  for (int nt = 0; nt < 2; ++nt)
#pragma unroll
    for (int ks = 0; ks < 4; ++ks) { const float* q = ss + (size_t)(nt * 32 + r) * 64 + ks * 16 + hi * 8; const f32x4 x0 = *(const f32x4*)q, x1 = *(const f32x4*)(q + 4);
      u32x4 w; w.x = cvt_pk_bf16(x0[0], x0[1]); w.y = cvt_pk_bf16(x0[2], x0[3]); w.z = cvt_pk_bf16(x1[0], x1[1]); w.w = cvt_pk_bf16(x1[2], x1[3]); bfr[nt][ks] = __builtin_bit_cast(bf16x8, w); }
  const int p0 = chunk * CL;
  const size_t dbase = (size_t)dir * NTOK;
  for (int mt = 0; mt < (CL + 31) / 32; ++mt) {
    const int sa_ = min(mt * 32 + r, CL - 1);
    const bf16_t* zp = bf.Z + (dbase + scan_row(dir, b, p0 + sa_)) * 512 + h * 64 + hi * 8;
    bf16x8 af[4];
#pragma unroll
    for (int ks = 0; ks < 4; ++ks) af[ks] = *(const bf16x8*)(zp + ks * 16);
    bf16_t yo0[16], yo1[16];
#pragma unroll
    for (int i = 0; i < 16; ++i) { const int so = min(mt * 32 + (i & 3) + 8 * (i >> 2) + 4 * hi, CL - 1); const bf16_t* yp = bf.Y + (dbase + scan_row(dir, b, p0 + so)) * 512 + h * 64 + r; yo0[i] = yp[0]; yo1[i] = yp[32]; }
    f32x16 acc[2];
#pragma unroll
    for (int nt = 0; nt < 2; ++nt) { acc[nt] = zero16();
#pragma unroll
      for (int ks = 0; ks < 4; ++ks) acc[nt] = __builtin_amdgcn_mfma_f32_32x32x16_bf16(af[ks], bfr[nt][ks], acc[nt], 0, 0, 0); }
#pragma unroll
    for (int i = 0; i < 16; ++i) { const int so = mt * 32 + (i & 3) + 8 * (i >> 2) + 4 * hi;
      if (so < CL) { bf16_t* yp = bf.Y + (dbase + scan_row(dir, b, p0 + so)) * 512 + h * 64 + r;
        yp[0] = f2bf(bf2f(yo0[i]) + acc[0][i]); yp[32] = f2bf(bf2f(yo1[i]) + acc[1][i]); } }
  }
}

template <int NR> struct FinRaw { bf16_t y0[NR], y1[NR], g[NR]; unsigned v[NR]; float c0[NR], c1[NR]; };
template <int NR>
__device__ __forceinline__ void finish_load(const Bufs& bf, int row0, int c, int h, FinRaw<NR>& q) {
#pragma unroll
  for (int i = 0; i < NR; ++i) { const int row = row0 + i;
    q.y0[i] = bf.Y[(size_t)row * 512 + c]; q.y1[i] = bf.Y[((size_t)NTOK + row) * 512 + c];
    q.v[i] = bf.SH[(size_t)row * 512 + c].y; q.g[i] = bf.G[(size_t)row * bf.gstride + c];
    q.c0[i] = bf.CS[(size_t)row * 16 + h]; q.c1[i] = bf.CS[(size_t)row * 16 + 8 + h]; }
}
template <int NR>
__device__ __forceinline__ void finish_phase(const Bufs& bf, const float* __restrict__ gn_g, const float* __restrict__ gn_b, bf16_t* __restrict__ O) {
  const int c = mk::otid(), h = c >> 6, stride = gridDim.x * NR;
  const float gg = gn_g[c], gb = gn_b[c];
  int row0 = mk::obid() * NR;
  if (row0 >= NTOK) return;
  FinRaw<NR> cur, nxt; finish_load<NR>(bf, row0, c, h, cur);
  for (; row0 < NTOK; row0 += stride) {
    const int rn = row0 + stride < NTOK ? row0 + stride : row0;
    finish_load<NR>(bf, rn, c, h, nxt);
    float o[NR];
#pragma unroll
    for (int i = 0; i < NR; ++i) { const float y = bf2f(cur.y0[i]) + bf2f(cur.y1[i]);
      const float mu = wave_sum_u(y) * (1.0f / 64.0f); const float dv = y - mu; const float var = wave_sum_u(dv * dv) * (1.0f / 64.0f);
      o[i] = (dv * rsqrtf(var + 64e-5f) * gg + gb + (cur.c0[i] + cur.c1[i]) * bfhi(cur.v[i])) * bf2f(cur.g[i]); }
#pragma unroll
    for (int i = 0; i < NR; ++i) O[(size_t)(row0 + i) * 1024 + 512 + c] = f2bf(o[i]);
    cur = nxt;
  }
}
}

namespace mk {
constexpr size_t al256(size_t x) { return (x + 255) / 256 * 256; }
constexpr size_t WS_BAR = 0;
constexpr size_t WS_BCNT = al256(WS_BAR + (size_t)XCD_BAR_WORDS * 4);
constexpr size_t WS_MOFF = al256(WS_BCNT + (size_t)4 * 256 * 64 * 4);
constexpr size_t WS_KN = al256(WS_MOFF + 4 * 256);
constexpr size_t WS_MOD = al256(WS_KN + (size_t)2 * 256 * 32 * 4);
constexpr size_t WS_ROPE = al256(WS_MOD + (size_t)4 * 5 * 6144 * 4);
constexpr size_t WS_HBC = al256(WS_ROPE + 128 * 16 * 2 * 4);
constexpr size_t WS_EID = al256(WS_HBC + (size_t)NCTX * D * 2);
constexpr size_t WS_GATE = al256(WS_EID + (size_t)NTOK * 2 * 4);
constexpr size_t WS_POS = al256(WS_GATE + (size_t)NTOK * 2 * 4);
constexpr size_t WS_RL = al256(WS_POS + (size_t)NTOK * 2 * 4);
constexpr size_t WS_WEIN = al256(WS_RL + (size_t)MOE_ROWS * 4);
constexpr size_t WS_WOIN = al256(WS_WEIN + (size_t)2 * EVEN_IN * D * 2);
constexpr size_t WS_WEOUT = al256(WS_WOIN + (size_t)2 * ODD_IN * D * 2);
constexpr size_t WS_WOOUT = al256(WS_WEOUT + (size_t)2 * D * D * 2);
constexpr size_t WS_WGU = al256(WS_WOOUT + (size_t)2 * D * D * 2);
constexpr size_t WS_WDN = al256(WS_WGU + (size_t)NE * 1024 * D * 2);
constexpr size_t WS_WLT = al256(WS_WDN + (size_t)NE * D * DE * 2);
constexpr size_t WS_UO = al256(WS_WLT + (size_t)2 * 196608 * 2);
constexpr size_t WS_SCR = al256(WS_UO + (size_t)NTOK * D * 2);
constexpr size_t SE_PQK = 0;
constexpr size_t SE_VT = al256(SE_PQK + (size_t)NTOK * 1024 * 2);
constexpr size_t SE_PRW = al256(SE_VT + (size_t)512 * NTOK * 2);
constexpr size_t SE_PQ = 0;
constexpr size_t SE_SST = al256(SE_PQ + (size_t)rw::NCHAIN * (rw::NCH - 1) * 2 * 4096 * 4);
constexpr size_t SE_Y = al256(SE_SST + (size_t)rw::NCHAIN * rw::NCH * 4096 * 4);
constexpr size_t SE_Z = al256(SE_Y + (size_t)2 * NTOK * 512 * 2);
constexpr size_t SE_ZEND = al256(SE_Z + (size_t)2 * NTOK * 512 * 2);
constexpr size_t SE_PRWEND = al256(SE_PRW + (size_t)NTOK * RW_IN * 2);
constexpr size_t SE_SH = SE_PRWEND > SE_ZEND ? SE_PRWEND : SE_ZEND;
constexpr size_t SE_DR = al256(SE_SH + (size_t)NTOK * 512 * 8);
constexpr size_t SE_CS = al256(SE_DR + (size_t)2 * NTOK * 512 * 4);
constexpr size_t SE_END = al256(SE_CS + (size_t)2 * NTOK * 16 * 4);
constexpr size_t SE_YBUF = 0;
constexpr size_t SO_PQK = 0;
constexpr size_t SO_VT = al256(SO_PQK + (size_t)NTOK * 2048 * 2);
constexpr size_t SO_O12 = al256(SO_VT + (size_t)1024 * NTOK * 2);
constexpr size_t SO_END = al256(SO_O12 + (size_t)NTOK * 2048 * 2);
constexpr size_t SO_YBUF = 0;
constexpr size_t SM_XS = 0;
constexpr size_t SM_HE = al256(SM_XS + (size_t)MOE_ROWS * D * 2);
constexpr size_t SM_YS = al256(SM_HE + (size_t)MOE_ROWS * DE * 2);
constexpr size_t SM_END = al256(SM_YS + (size_t)MOE_ROWS * D * 2);
constexpr size_t SCR_BYTES = SE_END > SO_END ? (SE_END > SM_END ? SE_END : SM_END) : (SO_END > SM_END ? SO_END : SM_END);
constexpr size_t WS_END = WS_SCR + SCR_BYTES;
constexpr int LDS_BARW = 131072;
constexpr int LDS_MISC = 131072 + 64;

struct Params {
  const float *x, *c, *ctx, *c_ctx, *ada_w, *ada_b, *ln_g, *ln_b, *even_w_in, *even_w_out, *shift_w, *na_rpb, *rw_w0, *rw_w_up, *rw_a0, *rw_a_up, *rw_g_up, *rw_k_k, *rw_k_a, *rw_r_k,
      *rw_gn_g, *rw_gn_b, *odd_w_in, *odd_w_out, *da_lq1, *da_lk1, *da_lq2, *da_lk2, *da_subln_g, *router_w, *router_b, *exp_w_gate, *exp_w_up, *exp_w_down;
  float* out; unsigned char* ws; int ph_lo, ph_hi;
};
template <class Tp> __device__ __forceinline__ Tp* wsp(const Params& p, size_t off) { return (Tp*)(p.ws + off); }

__device__ __forceinline__ void ada_unit(const Params& p, int u, LAS float* lds) {
  LAS float* sc = lds; LAS float* red = lds + 5 * 1024;
  const int tid = mk::otid(), l = u / 96, n = (u % 96) * 64 + (tid & 63), kp = tid >> 6;
  for (int i = tid; i < 5 * 1024; i += NTHR) { const float v = i < 4096 ? p.c[i] : p.c_ctx[i - 4096]; sc[i] = siluf_(v); }
  __syncthreads();
  float a[5] = {0.f, 0.f, 0.f, 0.f, 0.f};
  const float* w = p.ada_w + ((size_t)l * D + kp * 128) * 6144 + n;
#pragma unroll 4
  for (int k = 0; k < 128; ++k) { const float wv = w[(size_t)k * 6144]; const int kk = kp * 128 + k;
#pragma unroll
    for (int r = 0; r < 5; ++r) a[r] = fmaf(sc[r * 1024 + kk], wv, a[r]); }
#pragma unroll
  for (int r = 0; r < 5; ++r) red[(kp * 5 + r) * 64 + (tid & 63)] = a[r];
  __syncthreads();
  if (tid < 320) { const int r = tid >> 6, nn = tid & 63; float s = 0.f;
#pragma unroll
    for (int q = 0; q < 8; ++q) s += red[(q * 5 + r) * 64 + nn];
    const int col = (u % 96) * 64 + nn;
    wsp<float>(p, WS_MOD)[((size_t)l * 5 + r) * 6144 + col] = s + p.ada_b[l * 6144 + col]; }
  __syncthreads();
}
__device__ __forceinline__ void phase_prologue(const Params& p, LAS unsigned char* lds) {
  const int bid = mk::obid(), nb = gridDim.x; LAS float* tile = (LAS float*)lds;
  int ub = 0;
  for (int i = 0; i < 2; ++i) ub += cvt_matrix(p.even_w_in + (size_t)i * D * EVEN_IN, EVEN_IN, D, EVEN_IN, wsp<bf16_t>(p, WS_WEIN) + (size_t)i * EVEN_IN * D, NMapId{0}, tile, ub, bid, nb);
  for (int i = 0; i < 2; ++i) ub += cvt_matrix(p.odd_w_in + (size_t)i * D * ODD_IN, ODD_IN, D, ODD_IN, wsp<bf16_t>(p, WS_WOIN) + (size_t)i * ODD_IN * D, NMapRope{}, tile, ub, bid, nb);
  for (int i = 0; i < 2; ++i) ub += cvt_matrix(p.even_w_out + (size_t)i * D * D, D, D, D, wsp<bf16_t>(p, WS_WEOUT) + (size_t)i * D * D, NMapId{0}, tile, ub, bid, nb);
  for (int i = 0; i < 2; ++i) ub += cvt_matrix(p.odd_w_out + (size_t)i * D * D, D, D, D, wsp<bf16_t>(p, WS_WOOUT) + (size_t)i * D * D, NMapId{0}, tile, ub, bid, nb);
  for (int i = 0; i < 2; ++i) { bf16_t* wl = wsp<bf16_t>(p, WS_WLT) + (size_t)i * 196608;
    for (int d = 0; d < 2; ++d) { ub += cvt_matrix(p.rw_w_up + (size_t)(i * 2 + d) * 64 * 512, 512, 64, 512, wl + (size_t)d * 32768, NMapId{0}, tile, ub, bid, nb);
      ub += cvt_matrix(p.rw_a_up + (size_t)(i * 2 + d) * 64 * 512, 512, 64, 512, wl + (size_t)(2 + d) * 32768, NMapId{0}, tile, ub, bid, nb); }
    ub += cvt_matrix(p.rw_g_up + (size_t)i * 128 * 512, 512, 128, 512, wl + (size_t)4 * 32768, NMapId{0}, tile, ub, bid, nb); }
  for (int u = (bid + nb - ub % nb) % nb; u < 384; u += nb) ada_unit(p, u, (LAS float*)lds);
  const int gt = bid * NTHR + mk::otid();
  if (gt < 128 * 16) { const int pos = gt >> 4, i = gt & 15; const float inv = exp2f(-(float)i * (13.287712379549449f / 16.0f)); float sn, cs; sincosf((float)pos * inv, &sn, &cs);
    wsp<float>(p, WS_ROPE)[gt * 2] = cs; wsp<float>(p, WS_ROPE)[gt * 2 + 1] = sn; }
}
#define CVT_JOB(u_, src_, dst_, ld_, K_, k0_, n0_, mode_) do { const int e_ = (u_) / 384, rem_ = (u_) % 384, v_ = rem_ & 127; mode_ = rem_ >> 7; const size_t so_ = ((size_t)l * NE + e_) * D * DE; \
    const bool dn_ = mode_ == 2; src_ = (dn_ ? wd_ : (mode_ == 0 ? wg_ : wu_)) + so_; ld_ = dn_ ? D : DE; K_ = dn_ ? DE : D; \
    k0_ = (dn_ ? (v_ >> 4) : (v_ >> 3)) * 64; n0_ = (dn_ ? (v_ & 15) : (v_ & 7)) * 64; dst_ = dn_ ? wsp<bf16_t>(p, WS_WDN) + (size_t)e_ * D * DE : wsp<bf16_t>(p, WS_WGU) + (size_t)e_ * 1024 * D; } while (0)
__device__ __forceinline__ void cvt_experts(const Params& p, int l, LAS float* tile, int b0) {
  const int bid = mk::obid() - b0, nb = (int)gridDim.x - b0, t = mk::otid();
  if (bid < 0) return;
  const float* wg_ = p.exp_w_gate; const float* wu_ = p.exp_w_up; const float* wd_ = p.exp_w_down; asm volatile("" : "+s"(wg_), "+s"(wu_), "+s"(wd_));
  constexpr int NJ = NE * 384;
  int u = bid;
  if (u >= NJ) return;
  const float* csrc; bf16_t* cdst; int cld, cK, ck0, cn0, cmode;
  CVT_JOB(u, csrc, cdst, cld, cK, ck0, cn0, cmode);
  const int lk = t >> 3, lc = (t & 7) * 8;
  f32x4 ra, rb; { const float* q = csrc + (size_t)(ck0 + lk) * cld + cn0 + lc; ra = *(const f32x4*)q; rb = *(const f32x4*)(q + 4); }
  for (; u < NJ; u += nb) {
    const int un = u + nb < NJ ? u + nb : u;
    const float* nsrc; bf16_t* ndst; int nld, nK, nk0, nn0, nmode;
    CVT_JOB(un, nsrc, ndst, nld, nK, nk0, nn0, nmode);
    f32x4 na, nbv; { const float* q = nsrc + (size_t)(nk0 + lk) * nld + nn0 + lc; na = *(const f32x4*)q; nbv = *(const f32x4*)(q + 4); }
    { LAS float* q = tile + lk * 65 + lc; q[0] = ra[0]; q[1] = ra[1]; q[2] = ra[2]; q[3] = ra[3]; q[4] = rb[0]; q[5] = rb[1]; q[6] = rb[2]; q[7] = rb[3]; }
    __syncthreads();
    { const int n = t >> 3, kc = (t & 7) * 8; const LAS float* q = tile + kc * 65 + n;
      u32x4 w; w.x = cvt_pk_bf16(q[0], q[65]); w.y = cvt_pk_bf16(q[130], q[195]); w.z = cvt_pk_bf16(q[260], q[325]); w.w = cvt_pk_bf16(q[390], q[455]);
      const int drow = cmode == 2 ? cn0 + n : 2 * (cn0 + n) + cmode;
      *(u32x4*)(cdst + (size_t)drow * cK + ck0 + kc) = w; }
    __syncthreads();
    csrc = nsrc; cdst = ndst; cld = nld; cK = nK; ck0 = nk0; cn0 = nn0; cmode = nmode; ra = na; rb = nbv;
  }
}
#undef CVT_JOB

__device__ __forceinline__ bf16_t* hb_ptr(const Params& p, int row, bool alt) {
  if (alt) return wsp<bf16_t>(p, WS_SCR + SM_END) + (size_t)row * D;
  return row < NLAT ? (bf16_t*)p.out + (size_t)row * D : wsp<bf16_t>(p, WS_HBC) + (size_t)(row - NLAT) * D;
}
__device__ __forceinline__ const float* h0_ptr(const Params& p, int row) { return row < NLAT ? p.x + (size_t)row * D : p.ctx + (size_t)(row - NLAT) * D; }
__device__ __forceinline__ void store_bf16x4(bf16_t* dst, f32x4 v) { u32x2 w; w.x = cvt_pk_bf16(v[0], v[1]); w.y = cvt_pk_bf16(v[2], v[3]); *(u32x2*)dst = w; }
__device__ __forceinline__ f32x4 load_bf16x4(const bf16_t* src) { const u32x2 w = *(const u32x2*)src; return (f32x4){bflo(w.x), bfhi(w.x), bflo(w.y), bfhi(w.y)}; }

__device__ __forceinline__ void phase_mod0(const Params& p) {
  const int lane = mk::otid() & 63, wid = mk::otid() >> 6;
  bf16_t* U = wsp<bf16_t>(p, WS_UO);
  for (int row = mk::obid() * 8 + wid; row < NTOK; row += gridDim.x * 8) {
    const float* h = h0_ptr(p, row); const float* modl = wsp<float>(p, WS_MOD) + (size_t)bidx_of_row(row) * 6144;
#pragma unroll
    for (int q = 0; q < 4; ++q) { const int col = q * 256 + lane * 4; const f32x4 hv = *(const f32x4*)(h + col), sh = *(const f32x4*)(modl + col), sc = *(const f32x4*)(modl + 1024 + col);
      store_bf16x4(U + (size_t)row * D + col, hv * (1.0f + sc) + sh); }
  }
}
__device__ __forceinline__ void ln_row(f32x4 (&v)[4], const float* __restrict__ g, const float* __restrict__ b, int lane) {
  float s = 0.f;
#pragma unroll
  for (int q = 0; q < 4; ++q) s += (v[q][0] + v[q][1]) + (v[q][2] + v[q][3]);
  const float mu = wave_sum_u(s) * (1.0f / D);
  float qq = 0.f;
#pragma unroll
  for (int q = 0; q < 4; ++q) { const f32x4 d = v[q] - mu; qq += (d[0] * d[0] + d[1] * d[1]) + (d[2] * d[2] + d[3] * d[3]); }
  const float rstd = rsqrtf(wave_sum_u(qq) * (1.0f / D) + LN_EPS);
#pragma unroll
  for (int q = 0; q < 4; ++q) { const int col = q * 256 + lane * 4; v[q] = (v[q] - mu) * rstd * *(const f32x4*)(g + col) + *(const f32x4*)(b + col); }
}
template <bool F32IN> struct Ln1Raw;
template <> struct Ln1Raw<true> { f32x4 h[4]; u32x2 y[4]; };
template <> struct Ln1Raw<false> { u32x2 h[4]; u32x2 y[4]; };
__device__ __forceinline__ f32x4 h_as_f32(f32x4 v) { return v; }
__device__ __forceinline__ f32x4 h_as_f32(u32x2 w) { return (f32x4){bflo(w.x), bfhi(w.x), bflo(w.y), bfhi(w.y)}; }
template <bool F32IN>
__device__ __forceinline__ void ln1_load(const Params& p, const bf16_t* __restrict__ Ybuf, int row, int lane, Ln1Raw<F32IN>& r) {
#pragma unroll
  for (int q = 0; q < 4; ++q) { const int col = q * 256 + lane * 4;
    if constexpr (F32IN) r.h[q] = *(const f32x4*)(h0_ptr(p, row) + col); else r.h[q] = *(const u32x2*)(hb_ptr(p, row, false) + col);
    r.y[q] = *(const u32x2*)(Ybuf + (size_t)row * D + col); }
}
template <bool F32IN>
__device__ __forceinline__ void ln1_row(const Params& p, int l, int row, int lane, const Ln1Raw<F32IN>& raw, const LAS float* rwl, LAS int* lcnt, float rbias  , bool redir) {
  bf16_t* U2 = wsp<bf16_t>(p, WS_UO); int* eid = wsp<int>(p, WS_EID); float* gatev = wsp<float>(p, WS_GATE);
  const float* lg = p.ln_g + (size_t)(l * 2) * D; const float* lb = p.ln_b + (size_t)(l * 2) * D;
  bf16_t* ho = redir ? wsp<bf16_t>(p, WS_SCR + SM_YS) + (size_t)row * D : hb_ptr(p, row, l == DEPTH - 1); const float* modl = wsp<float>(p, WS_MOD) + ((size_t)l * 5 + bidx_of_row(row)) * 6144;
  f32x4 v[4];
#pragma unroll
  for (int q = 0; q < 4; ++q) { const int col = q * 256 + lane * 4; const f32x4 yv = (f32x4){bflo(raw.y[q].x), bfhi(raw.y[q].x), bflo(raw.y[q].y), bfhi(raw.y[q].y)};
    v[q] = ALPHA * h_as_f32(raw.h[q]) + *(const f32x4*)(modl + 2 * 1024 + col) * yv; }
  ln_row(v, lg, lb, lane);
  float acc[16];
#pragma unroll
  for (int e = 0; e < 16; ++e) acc[e] = 0.f;
#pragma unroll
  for (int q = 0; q < 4; ++q) { const int col = q * 256 + lane * 4;
    store_bf16x4(ho + col, v[q]);
    const f32x4 u = v[q] * (1.0f + *(const f32x4*)(modl + 4 * 1024 + col)) + *(const f32x4*)(modl + 3 * 1024 + col);
    store_bf16x4(U2 + (size_t)row * D + col, u);
#pragma unroll
    for (int e = 0; e < 16; ++e) { const f32x4 w = *(const LAS f32x4*)(rwl + ((q * 16 + e) * 64 + lane) * 4); acc[e] += (u[0] * w[0] + u[1] * w[1]) + (u[2] * w[2] + u[3] * w[3]); }
  }
  float t8[8], t4[4], t2[2];
#pragma unroll
  for (int i = 0; i < 8; ++i) { const u32x2 sw = __builtin_amdgcn_permlane32_swap(__float_as_uint(acc[i]), __float_as_uint(acc[8 + i]), false, false); t8[i] = __uint_as_float(sw.x) + __uint_as_float(sw.y); }
#pragma unroll
  for (int i = 0; i < 4; ++i) { const u32x2 sw = __builtin_amdgcn_permlane16_swap(__float_as_uint(t8[i]), __float_as_uint(t8[4 + i]), false, false); t4[i] = __uint_as_float(sw.x) + __uint_as_float(sw.y); }
  const bool b3 = (lane & 8) != 0, b2_ = (lane & 4) != 0;
#pragma unroll
  for (int i = 0; i < 2; ++i) { const float keep = b3 ? t4[2 + i] : t4[i], send = b3 ? t4[i] : t4[2 + i]; t2[i] = keep + dpp_mov<0x128, 0xf, 0xf>(send, send); }
  float logit;
  { const float keep = b2_ ? t2[1] : t2[0], send = b2_ ? t2[0] : t2[1];
    float recv = dpp_mov<0x104, 0xf, 0x5>(send, send);
    recv = dpp_mov<0x114, 0xf, 0xa>(recv, send);
    logit = keep + recv; }
  logit += dpp_mov<0xB1, 0xf, 0xf>(logit, logit); logit += dpp_mov<0x4E, 0xf, 0xf>(logit, logit);
  const float sg = 1.0f / (1.0f + expf(-logit)), sl = sg + rbias;
  float gs;
  { const float a = sl, b2 = dpp_mov<0x124, 0xf, 0xf>(sl, sl), c = dpp_mov<0x128, 0xf, 0xf>(sl, sl), d = dpp_mov<0x12C, 0xf, 0xf>(sl, sl);
    const float lo1 = fminf(a, b2), hi1 = fmaxf(a, b2), lo2 = fminf(c, d), hi2 = fmaxf(c, d);
    gs = fmaxf(hi1, hi2) + fmaxf(fminf(hi1, hi2), fmaxf(lo1, lo2)); }
  float best = -1e30f; int grp = 0;
#pragma unroll
  for (int gI = 0; gI < 4; ++gI) { const float g = __uint_as_float(__builtin_amdgcn_readlane(__float_as_uint(gs), gI * 16)); if (g > best) { best = g; grp = gI; } }
  grp = __builtin_amdgcn_readfirstlane(grp);
  const float v0 = __uint_as_float(__builtin_amdgcn_readlane(__float_as_uint(sl), grp * 16)), v1 = __uint_as_float(__builtin_amdgcn_readlane(__float_as_uint(sl), grp * 16 + 4)),
              v2 = __uint_as_float(__builtin_amdgcn_readlane(__float_as_uint(sl), grp * 16 + 8)), v3 = __uint_as_float(__builtin_amdgcn_readlane(__float_as_uint(sl), grp * 16 + 12));
  const float s0 = __uint_as_float(__builtin_amdgcn_readlane(__float_as_uint(sg), grp * 16)), s1 = __uint_as_float(__builtin_amdgcn_readlane(__float_as_uint(sg), grp * 16 + 4)),
              s2 = __uint_as_float(__builtin_amdgcn_readlane(__float_as_uint(sg), grp * 16 + 8)), s3 = __uint_as_float(__builtin_amdgcn_readlane(__float_as_uint(sg), grp * 16 + 12));
  int i1 = 0; float b1 = v0; if (v1 > b1) { b1 = v1; i1 = 1; } if (v2 > b1) { b1 = v2; i1 = 2; } if (v3 > b1) { b1 = v3; i1 = 3; }
  int i2 = -1; float bb = -1e30f;
  if (i1 != 0 && v0 > bb) { bb = v0; i2 = 0; } if (i1 != 1 && v1 > bb) { bb = v1; i2 = 1; } if (i1 != 2 && v2 > bb) { bb = v2; i2 = 2; } if (i1 != 3 && v3 > bb) { bb = v3; i2 = 3; }
  const float g1 = i1 == 0 ? s0 : i1 == 1 ? s1 : i1 == 2 ? s2 : s3; const float g2 = i2 == 0 ? s0 : i2 == 1 ? s1 : i2 == 2 ? s2 : s3;
  if (lane == 0) { const int e1 = grp * 4 + i1, e2 = grp * 4 + i2;
    eid[row * 2] = e1; eid[row * 2 + 1] = e2; gatev[row * 2] = g1 / (g1 + g2); gatev[row * 2 + 1] = g2 / (g1 + g2);
    __hip_atomic_fetch_add(lcnt + e1, 1, __ATOMIC_RELAXED, __HIP_MEMORY_SCOPE_WORKGROUP); __hip_atomic_fetch_add(lcnt + e2, 1, __ATOMIC_RELAXED, __HIP_MEMORY_SCOPE_WORKGROUP); }
}
template <bool F32IN>
__device__ __forceinline__ void phase_ln1(const Params& p, int l, const bf16_t* __restrict__ Ybuf, LAS unsigned char* lds, bool dry) {
  const int tid = mk::otid(), lane = tid & 63, wid = tid >> 6, bid = mk::obid();
  const bool last = l == DEPTH - 1; const int ntok = last ? NLAT : NTOK;
  LAS float* rwl = (LAS float*)lds; LAS int* lcnt = (LAS int*)(lds + 65536);
  { float rv[32];
#pragma unroll
    for (int i = 0; i < 32; ++i) rv[i] = p.router_w[tid + i * NTHR];
#pragma unroll
    for (int i = 0; i < 32; ++i) { const int idx = tid + i * NTHR, d = idx >> 4, e = idx & 15; rwl[(((d >> 8) * 16 + e) * 64 + ((d >> 2) & 63)) * 4 + (d & 3)] = rv[i]; } }
  if (tid < 16) lcnt[tid] = 0;
  __syncthreads();
  const int stride = gridDim.x * 8, row0 = bid * 8 + wid;
  const float rbias = p.router_b[lane >> 2];
  if (row0 < ntok) {
    Ln1Raw<F32IN> cur, nxt; ln1_load<F32IN>(p, Ybuf, row0, lane, cur);
    for (int row = row0; row < ntok; row += stride) {
      const int rn = row + stride < ntok ? row + stride : row;
      ln1_load<F32IN>(p, Ybuf, rn, lane, nxt);
      ln1_row<F32IN>(p, l, row, lane, cur, rwl, lcnt, rbias, dry);
      cur = nxt;
    }
  }
  __syncthreads();
  if (tid < 16) wsp<int>(p, WS_BCNT)[((size_t)l * 256 + bid) * 64 + tid] = lcnt[tid];
  __syncthreads();
}
__device__ __forceinline__ void phase_scatter(const Params& p, int l, LAS unsigned char* lds) {
  const int tid = mk::otid(), bid = mk::obid(), nb = gridDim.x;
  const bool last = l == DEPTH - 1; const int ntok = last ? NLAT : NTOK;
  LAS int* tot = (LAS int*)lds; LAS int* pre = tot + 16; LAS int* base = tot + 32; LAS int* lcur = tot + 48; LAS int* offs = tot + 64; LAS int* cnts = tot + 128;
  const int* bc = wsp<int>(p, WS_BCNT) + (size_t)l * 256 * 64;
  for (int b2 = tid; b2 < nb; b2 += NTHR) { const u32x4 c0 = *(const u32x4*)(bc + b2 * 64), c1 = *(const u32x4*)(bc + b2 * 64 + 4), c2 = *(const u32x4*)(bc + b2 * 64 + 8), c3 = *(const u32x4*)(bc + b2 * 64 + 12);
    *(LAS u32x4*)(cnts + b2 * 16) = c0; *(LAS u32x4*)(cnts + b2 * 16 + 4) = c1; *(LAS u32x4*)(cnts + b2 * 16 + 8) = c2; *(LAS u32x4*)(cnts + b2 * 16 + 12) = c3; }
  __syncthreads();
  if (tid < 16) { int t = 0, pr = 0; for (int b2 = 0; b2 < nb; ++b2) { const int v = cnts[b2 * 16 + tid]; pr += b2 < bid ? v : 0; t += v; } tot[tid] = t; pre[tid] = pr; lcur[tid] = 0; }
  __syncthreads();
  if (tid == 0) { int o = 0; int* mo = wsp<int>(p, WS_MOFF) + l * 64; for (int e = 0; e < 16; ++e) { offs[e] = o; base[e] = o + pre[e]; if (bid == 0) mo[e] = o; o += (tot[e] + 255) / 256 * 256; } offs[16] = o; if (bid == 0) mo[16] = o; }
  __syncthreads();
  const int* eid = wsp<int>(p, WS_EID); int* pos = wsp<int>(p, WS_POS); int* rl = wsp<int>(p, WS_RL);
  for (int n = tid; ; n += NTHR) { const int row = bid * 8 + (n & 7) + (n >> 3) * nb * 8; if (row >= ntok) break;
    const int e1 = eid[row * 2], e2 = eid[row * 2 + 1];
    const int p1 = base[e1] + __hip_atomic_fetch_add(lcur + e1, 1, __ATOMIC_RELAXED, __HIP_MEMORY_SCOPE_WORKGROUP), p2 = base[e2] + __hip_atomic_fetch_add(lcur + e2, 1, __ATOMIC_RELAXED, __HIP_MEMORY_SCOPE_WORKGROUP);
    pos[row * 2] = p1; pos[row * 2 + 1] = p2; rl[p1] = row; rl[p2] = row; }
  if (bid == 0) for (int e = 0; e < 16; ++e) for (int q = offs[e] + tot[e] + tid; q < offs[e + 1]; q += NTHR) rl[q] = 0;
}
struct Ln2Raw { u32x4 h[2], y1[2], y2[2]; };
__device__ __forceinline__ void ln2_load(const Params& p, bool last, int row, int lane, int p1, int p2, Ln2Raw& r) {
  const bf16_t* Ys = wsp<bf16_t>(p, WS_SCR + SM_YS); const bf16_t* ho = hb_ptr(p, row, last);
#pragma unroll
  for (int q = 0; q < 2; ++q) { const int col = q * 512 + lane * 8; r.h[q] = *(const u32x4*)(ho + col); r.y1[q] = *(const u32x4*)(Ys + (size_t)p1 * D + col); r.y2[q] = *(const u32x4*)(Ys + (size_t)p2 * D + col); }
}
__device__ __forceinline__ void unpack8(const u32x4 w, float (&o)[8]) { o[0] = bflo(w.x); o[1] = bfhi(w.x); o[2] = bflo(w.y); o[3] = bfhi(w.y); o[4] = bflo(w.z); o[5] = bfhi(w.z); o[6] = bflo(w.w); o[7] = bfhi(w.w); }
__device__ __forceinline__ void load8f(const float* q, float (&o)[8]) { const f32x4 a = *(const f32x4*)q, b = *(const f32x4*)(q + 4); o[0] = a[0]; o[1] = a[1]; o[2] = a[2]; o[3] = a[3]; o[4] = b[0]; o[5] = b[1]; o[6] = b[2]; o[7] = b[3]; }
__device__ __forceinline__ u32x4 pack8(const float (&v)[8]) { u32x4 w; w.x = cvt_pk_bf16(v[0], v[1]); w.y = cvt_pk_bf16(v[2], v[3]); w.z = cvt_pk_bf16(v[4], v[5]); w.w = cvt_pk_bf16(v[6], v[7]); return w; }
__device__ __forceinline__ void phase_ln2(const Params& p, int l, bool dry) {
  const int tid = mk::otid(), lane = tid & 63, wid = tid >> 6;
  const bool last = l == DEPTH - 1; const int ntok = last ? NLAT : NTOK;
  const int* pos = wsp<int>(p, WS_POS); const float* gatev = wsp<float>(p, WS_GATE); bf16_t* U = wsp<bf16_t>(p, WS_UO);
  const float* lg = p.ln_g + (size_t)(l * 2 + 1) * D; const float* lb = p.ln_b + (size_t)(l * 2 + 1) * D;
  const int stride = gridDim.x * 8, row0 = mk::obid() * 8 + wid;
  if (row0 >= ntok) return;
  auto clampr = [&](int r) { return r < ntok ? r : row0; };
  u32x2 pc = *(const u32x2*)(pos + 2 * row0); f32x2 gc = *(const f32x2*)(gatev + 2 * row0);
  Ln2Raw cur, nxt; ln2_load(p, last, row0, lane, (int)pc.x, (int)pc.y, cur);
  int r1 = clampr(row0 + stride);
  u32x2 pn = *(const u32x2*)(pos + 2 * r1); f32x2 gn = *(const f32x2*)(gatev + 2 * r1);
  for (int row = row0; row < ntok; row += stride) {
    ln2_load(p, last, r1, lane, (int)pn.x, (int)pn.y, nxt);
    const int r2 = clampr(row + 2 * stride);
    const u32x2 pn2 = *(const u32x2*)(pos + 2 * r2); const f32x2 gn2 = *(const f32x2*)(gatev + 2 * r2);
    bf16_t* hb = dry ? wsp<bf16_t>(p, WS_SCR + SM_XS) + (size_t)row * D : hb_ptr(p, row, false); float* hf = (dry ? wsp<float>(p, WS_SCR + SM_XS) : p.out) + (size_t)row * D; const int bi = bidx_of_row(row);
    const float* modl = wsp<float>(p, WS_MOD) + ((size_t)l * 5 + bi) * 6144;
    float v[2][8]; float s1 = 0.f;
#pragma unroll
    for (int q = 0; q < 2; ++q) { const int col = q * 512 + lane * 8; float hh[8], a1[8], a2[8], g2[8];
      unpack8(cur.h[q], hh); unpack8(cur.y1[q], a1); unpack8(cur.y2[q], a2); load8f(modl + 5 * 1024 + col, g2);
#pragma unroll
      for (int e = 0; e < 8; ++e) { v[q][e] = ALPHA * hh[e] + g2[e] * (gc[0] * a1[e] + gc[1] * a2[e]); s1 += v[q][e]; } }
    const float mu = wave_sum_u(s1) * (1.0f / D);
    float s2 = 0.f;
#pragma unroll
    for (int q = 0; q < 2; ++q)
#pragma unroll
      for (int e = 0; e < 8; ++e) { const float d = v[q][e] - mu; s2 += d * d; }
    const float rstd = rsqrtf(wave_sum_u(s2) * (1.0f / D) + LN_EPS);
    const float* modn = wsp<float>(p, WS_MOD) + ((size_t)(last ? l : l + 1) * 5 + bi) * 6144;
#pragma unroll
    for (int q = 0; q < 2; ++q) { const int col = q * 512 + lane * 8; float gg[8], bb[8];
      load8f(lg + col, gg); load8f(lb + col, bb);
#pragma unroll
      for (int e = 0; e < 8; ++e) v[q][e] = (v[q][e] - mu) * rstd * gg[e] + bb[e];
      if (last) { *(f32x4*)(hf + col) = (f32x4){v[q][0], v[q][1], v[q][2], v[q][3]}; *(f32x4*)(hf + col + 4) = (f32x4){v[q][4], v[q][5], v[q][6], v[q][7]}; }
      else { *(u32x4*)(hb + col) = pack8(v[q]); float sc[8], sh[8], u[8]; load8f(modn + 1024 + col, sc); load8f(modn + col, sh);
#pragma unroll
        for (int e = 0; e < 8; ++e) u[e] = v[q][e] * (1.0f + sc[e]) + sh[e];
        *(u32x4*)(U + (size_t)row * D + col) = pack8(u); } }
    cur = nxt; gc = gn; pn = pn2; gn = gn2; r1 = r2;
  }
}

struct SchedEvenIn { static constexpr bool GATHER = false; const bf16_t* U; const bf16_t* W; bf16_t* Pqk; bf16_t* Prw; bf16_t* Vt; int G, c;
  __device__ __forceinline__ bool next(int i, pg8::Unit& u) const { const int Lx = i * G + c; u.kind = 0;
    if (Lx < 1452) { const int grp = Lx / 44, rem = Lx % 44, pm = grp * 4 + (rem & 3), pi = rem >> 2; u.pm = pm; u.pn = pi;
      u.A = (const char*)(U + (size_t)pm * 256 * D); const int brow = pi < 4 ? pi * 256 : 1536 + (pi - 4) * 256; u.Bt = (const char*)(W + (size_t)brow * D);
      if (pi < 4) { u.out = Pqk; u.ldo = 1024; u.x1 = pi * 256; } else { u.out = Prw; u.ldo = RW_IN; u.x1 = (pi - 4) * 256; } u.x0 = pm * 256; return true; }
    if (Lx < 1452 + 264) { const int v = Lx - 1452, pmv = v & 1, pnv = v >> 1; u.pm = pmv; u.pn = pnv; u.A = (const char*)(W + (size_t)(1024 + pmv * 256) * D); u.Bt = (const char*)(U + (size_t)pnv * 256 * D);
      u.out = Vt; u.ldo = NTOK; u.x0 = pmv * 256; u.x1 = pnv * 256; return true; }
    return false; } };
struct SchedOddIn { static constexpr bool GATHER = false; const bf16_t* U; const bf16_t* W; bf16_t* Pqk; bf16_t* Vt; int G, c;
  __device__ __forceinline__ bool next(int i, pg8::Unit& u) const { const int Lx = i * G + c;
    if (Lx < 1056) { const int grp = Lx / 32, rem = Lx % 32, pm = grp * 4 + (rem & 3), pi = rem >> 2; u.pm = pm; u.pn = pi; u.kind = pm < 128 ? 1 : 0;
      u.A = (const char*)(U + (size_t)pm * 256 * D); u.Bt = (const char*)(W + (size_t)pi * 256 * D); u.out = Pqk; u.ldo = 2048; u.x0 = pm * 256; u.x1 = pi * 256; return true; }
    if (Lx < 1056 + 528) { const int v = Lx - 1056, pmv = v & 3, pnv = v >> 2; u.pm = pmv; u.pn = pnv; u.kind = 0; u.A = (const char*)(W + (size_t)(2048 + pmv * 256) * D); u.Bt = (const char*)(U + (size_t)pnv * 256 * D);
      u.out = Vt; u.ldo = NTOK; u.x0 = pmv * 256; u.x1 = pnv * 256; return true; }
    return false; } };
struct SchedOut { static constexpr bool GATHER = false; const bf16_t* O; const bf16_t* W; bf16_t* Y; int G, c;
  __device__ __forceinline__ bool next(int i, pg8::Unit& u) const { const int Lx = i * G + c; if (Lx >= 528) return false; const int pm = (Lx / 16) * 4 + (Lx & 3), pn = (Lx & 15) >> 2; u.pm = pm; u.pn = pn; u.kind = 0;
    u.A = (const char*)(O + (size_t)pm * 256 * D); u.Bt = (const char*)(W + (size_t)pn * 256 * D); u.out = Y; u.ldo = 1024; u.x0 = pm * 256; u.x1 = pn * 256; return true; } };
template <bool GATH>
struct SchedMoe { static constexpr bool GATHER = GATH; const bf16_t* A; const bf16_t* W; bf16_t* out; const LAS int* moff; const int* rl; int Kd, ldo, ncol, G, c;
  __device__ __forceinline__ bool next(int i, pg8::Unit& u) const { const int Lx = i * G + c; const int ntile = moff[16] >> 8; if (Lx >= ntile * 4) return false;
    const int pm = Lx >> 2, pn = Lx & 3; int e = 0;
#pragma unroll
    for (int j = 1; j < 16; ++j) e += (pm * 256 >= moff[j]) ? 1 : 0;
    u.pm = pm; u.pn = pn; u.kind = 0; u.A = GATH ? (const char*)A : (const char*)(A + (size_t)pm * 256 * Kd); u.rl = rl + pm * 256; u.Bt = (const char*)(W + ((size_t)e * 1024 + pn * 256) * Kd); u.out = out; u.ldo = ldo; u.x0 = pm * 256; u.x1 = pn * ncol; return true; } };

struct EpiOddIn {
  static constexpr bool PERM = true; const float* rope;
  __device__ __forceinline__ void operator()(const f32x4 (&acc)[2][2][4][2], const pg8::Unit& u, int wr, int wc, int fr, int fq) const {
    if (u.kind == 0) { pg8::EpiStoreBf16{}(acc, u, wr, wc, fr, fq); return; }
    const int row0 = u.x0 + wr * 64 + fr, col0 = u.x1 + wc * 32 + 8 * fq; const int half = wc & 1;
#pragma unroll
    for (int ai = 0; ai < 2; ++ai)
#pragma unroll
      for (int m = 0; m < 4; ++m) { const int row = row0 + ai * 128 + m * 16; const int t = row & (T - 1); const int pos = half ? (t & 63) : (t >> 6);
        const f32x4 cs0 = *(const f32x4*)(rope + (pos * 16 + 4 * fq) * 2), cs1 = *(const f32x4*)(rope + (pos * 16 + 4 * fq + 2) * 2);
        bf16_t* rowp = u.out + (size_t)row * u.ldo + col0;
#pragma unroll
        for (int bj = 0; bj < 2; ++bj) { const f32x4 v0 = acc[ai][bj][m][0], v1 = acc[ai][bj][m][1];
          u32x4 w; w.x = cvt_pk_bf16(v0[0] * cs0[0] - v0[1] * cs0[1], v0[0] * cs0[1] + v0[1] * cs0[0]); w.y = cvt_pk_bf16(v0[2] * cs0[2] - v0[3] * cs0[3], v0[2] * cs0[3] + v0[3] * cs0[2]);
          w.z = cvt_pk_bf16(v1[0] * cs1[0] - v1[1] * cs1[1], v1[0] * cs1[1] + v1[1] * cs1[0]); w.w = cvt_pk_bf16(v1[2] * cs1[2] - v1[3] * cs1[3], v1[2] * cs1[3] + v1[3] * cs1[2]);
          *(u32x4*)(rowp + bj * 128) = w; } }
  }
};
struct EpiGateUp {
  static constexpr bool PERM = true;
  __device__ __forceinline__ void operator()(const f32x4 (&acc)[2][2][4][2], const pg8::Unit& u, int wr, int wc, int fr, int fq) const {
    const int row0 = u.x0 + wr * 64 + fr, col0 = u.x1 + wc * 16 + 4 * fq;
#pragma unroll
    for (int ai = 0; ai < 2; ++ai)
#pragma unroll
      for (int m = 0; m < 4; ++m) { bf16_t* rowp = u.out + (size_t)(row0 + ai * 128 + m * 16) * u.ldo + col0;
#pragma unroll
        for (int bj = 0; bj < 2; ++bj) { const f32x4 v0 = acc[ai][bj][m][0], v1 = acc[ai][bj][m][1];
          u32x2 w; w.x = cvt_pk_bf16(silu_r(v0[0]) * v0[1], silu_r(v0[2]) * v0[3]); w.y = cvt_pk_bf16(silu_r(v1[0]) * v1[1], silu_r(v1[2]) * v1[3]);
          *(u32x2*)(rowp + bj * 64) = w; } }
  }
};
}

namespace mk {
constexpr int N_PHASES = 2 + 2 * (12 + 10);
__global__ void __launch_bounds__(NTHR, 2) mega(Params p_) {
  const Params& p = p_;
  extern __shared__ __attribute__((aligned(16))) unsigned char shm[];
  LAS unsigned char* lds = (LAS unsigned char*)shm;
  const int nb = gridDim.x;
  if (threadIdx.x == 0) *(LAS u32x4*)(lds + LDS_BARW) = (u32x4){0u, 0u, 0u, 0u};
  __syncthreads();
  XcdBarrier bar = xcd_barrier_post(wsp<unsigned>(p, WS_BAR), (volatile LAS unsigned*)(lds + LDS_BARW));
  int ph = 0;
#ifndef MK_MASK
#define MK_MASK 0xFFFFFFFFu
#endif
#ifndef MK_REP
#define MK_REP 0u
#endif
#define PHASE_BEGIN_K(k) if (((MK_MASK) >> (k)) & 1u) { Params pl_ = p_; asm volatile("" : "+s"(pl_.ws)); const Params& p = pl_; bf16_t* UO = wsp<bf16_t>(p, WS_UO); unsigned char* scr = p.ws + WS_SCR; (void)UO; (void)scr; \
    const int bid = mk::obid(); const int nrep_ = ((((MK_REP) >> (k)) & 1u) ? 2 : 1); for (int rep_ = 0; rep_ < nrep_; ++rep_) { const bool dry = rep_ + 1 < nrep_; (void)dry;
#define PHASE_END   } if (ph + 1 < N_PHASES) { XcdBarrier b_ = bar; asm volatile("" : "+s"(b_.bar), "+s"(b_.x)); xcd_barrier(b_); } } ++ph;
  bf16_t* UO = wsp<bf16_t>(p, WS_UO);
  unsigned char* scr = p.ws + WS_SCR;
  PHASE_BEGIN_K(0) phase_prologue(p, lds); PHASE_END
  PHASE_BEGIN_K(1) phase_mod0(p); PHASE_END
  for (int lp = 0; lp < 2; ++lp) {
    {
      const int l = 2 * lp;
      bf16_t* Pqk = (bf16_t*)(scr + SE_PQK); bf16_t* Vt = (bf16_t*)(scr + SE_VT); bf16_t* Prw = (bf16_t*)(scr + SE_PRW); bf16_t* Ybuf = (bf16_t*)(scr + SE_YBUF);
      rw::Bufs bf; bf.SH = (u32x2*)(scr + SE_SH); bf.DR = (unsigned*)(scr + SE_DR); bf.G = UO + 512; bf.gstride = 1024; bf.CS = (float*)(scr + SE_CS) + (size_t)lp * NTOK * 16; bf.PQ = (float*)(scr + SE_PQ); bf.SST = (float*)(scr + SE_SST); bf.Y = (bf16_t*)(scr + SE_Y); bf.Z = (bf16_t*)(scr + SE_Z);
      PHASE_BEGIN_K(2) { SchedEvenIn S{UO, wsp<bf16_t>(p, WS_WEIN) + (size_t)lp * EVEN_IN * D, Pqk, Prw, Vt, nb, bid}; pg8::gemm_phase(lds, D, S, pg8::EpiStoreBf16{}); } PHASE_END
      PHASE_BEGIN_K(3) {
#ifdef MK_P3
        if (!(dry && MK_P3 == 2))
#endif
        for (int u = bid; u < 1024 + 32; u += nb) { int b, h, rq; if (u < 1024) { b = u >> 8; h = (u >> 5) & 7; rq = u & 31; } else { const int v = u - 1024; b = v >> 3; h = v & 7; rq = -1; }
          natt::na_attn_unit(Pqk, Vt, p.na_rpb + ((size_t)lp * 8 + h) * 465, UO, b, h, rq, lds); }
        const int pb = (bid + nb / 2) % nb;
#ifdef MK_P3
        if (!(dry && MK_P3 == 1))
#endif
        for (int t = pb; t < NTOK / 16; t += nb) rw::prep_tile(Prw, p.shift_w + (size_t)lp * 3 * RW_IN, p.rw_w0 + lp * 1024, wsp<bf16_t>(p, WS_WLT) + (size_t)lp * 196608, p.rw_a0 + lp * 1024, p.rw_k_k + lp * 512, p.rw_k_a + lp * 512, p.rw_r_k + lp * 512, bf, t, (LAS float*)lds); } PHASE_END
      PHASE_BEGIN_K(4) for (int u = bid * 8 + (mk::otid() >> 6); u < rw::NCHAIN * rw::NCH; u += nb * 8) rw::scan_unit(bf, p.rw_k_a + lp * 512, u / rw::NCH, u % rw::NCH, (LAS float*)lds + (mk::otid() >> 6) * 4096); PHASE_END
      PHASE_BEGIN_K(5) for (int c = bid; c < rw::NCHAIN * 4; c += nb) rw::propagate_chain(bf, c >> 2, c & 3, (LAS float*)lds); PHASE_END
      PHASE_BEGIN_K(6) for (int u = bid * 8 + (mk::otid() >> 6); u < rw::NCHAIN * (rw::NCH - 1); u += nb * 8) rw::corr_unit(bf, u / (rw::NCH - 1), 1 + u % (rw::NCH - 1)); PHASE_END
      PHASE_BEGIN_K(7) rw::finish_phase<8>(bf, p.rw_gn_g + lp * 512, p.rw_gn_b + lp * 512, UO); PHASE_END
      PHASE_BEGIN_K(8) { SchedOut S{UO, wsp<bf16_t>(p, WS_WEOUT) + (size_t)lp * D * D, Ybuf, nb, bid}; pg8::gemm_phase(lds, D, S, pg8::EpiStoreBf16{}); __syncthreads(); cvt_experts(p, l, (LAS float*)lds, 528 - 2 * nb > 0 ? 528 - 2 * nb : 0); } PHASE_END
      PHASE_BEGIN_K(9) if (l == 0) phase_ln1<true>(p, l, Ybuf, lds, dry); else phase_ln1<false>(p, l, Ybuf, lds, dry); PHASE_END
      PHASE_BEGIN_K(10) phase_scatter(p, l, lds); PHASE_END
      PHASE_BEGIN_K(11) { LAS int* mo = (LAS int*)(lds + LDS_MISC); { const int tq = mk::otid(); if (tq < 17) mo[tq] = wsp<int>(p, WS_MOFF)[l * 64 + tq]; } __syncthreads();
        SchedMoe<true> S{UO, wsp<bf16_t>(p, WS_WGU), (bf16_t*)(scr + SM_HE), mo, wsp<int>(p, WS_RL), D, DE, 128, nb, bid}; pg8::gemm_phase(lds, D, S, EpiGateUp{}); } PHASE_END
      PHASE_BEGIN_K(12) { LAS int* mo = (LAS int*)(lds + LDS_MISC); { const int tq = mk::otid(); if (tq < 17) mo[tq] = wsp<int>(p, WS_MOFF)[l * 64 + tq]; } __syncthreads();
        SchedMoe<false> S{(bf16_t*)(scr + SM_HE), wsp<bf16_t>(p, WS_WDN), (bf16_t*)(scr + SM_YS), mo, nullptr, DE, D, 256, nb, bid}; pg8::gemm_phase(lds, DE, S, pg8::EpiStoreBf16{}); } PHASE_END
      PHASE_BEGIN_K(13) phase_ln2(p, l, dry); PHASE_END
    }
    {
      const int l = 2 * lp + 1; const bool last = l == DEPTH - 1;
      bf16_t* Pqk = (bf16_t*)(scr + SO_PQK); bf16_t* Vt = (bf16_t*)(scr + SO_VT); bf16_t* O12 = (bf16_t*)(scr + SO_O12); bf16_t* Ybuf = (bf16_t*)(scr + SO_YBUF);
      PHASE_BEGIN_K(14) { SchedOddIn S{UO, wsp<bf16_t>(p, WS_WOIN) + (size_t)lp * ODD_IN * D, Pqk, Vt, nb, bid}; pg8::gemm_phase(lds, D, S, EpiOddIn{wsp<float>(p, WS_ROPE)}); } PHASE_END
      float* KN = wsp<float>(p, WS_KN) + (size_t)lp * 256 * 32;
      PHASE_BEGIN_K(23) for (int g = bid; g < 256; g += nb) att::knorm_group(Pqk, KN, g, (LAS float*)lds); PHASE_END
      PHASE_BEGIN_K(15) for (int ui = bid; ui < 2048 + (last ? 0 : 64); ui += nb) { int b, hh, q0, nlat; const int u = (nb == 256 && ui < 2048) ? ((((ui >> 8) * 8 + (bid & 7)) << 5) | (bid >> 3)) : ui;
        if (u < 2048) { b = u >> 9; hh = (u >> 5) & 15; q0 = b * T + (u & 31) * 256; nlat = T; } else { const int v = u - 2048; b = v >> 4; hh = v & 15; q0 = NLAT + b * L; nlat = 0; }
        const bool st = __builtin_amdgcn_sqrtf(att::nmax2_of(KN, b, hh, 0) * att::nmax2_of(KN, b, hh, 1)) * 1.001f <= 60.0f;
#ifdef MK_ABL
        if (dry) att::diff_attn_unit<true, MK_ABL>(Pqk, Vt, O12, hh, q0, b * T, nlat, NLAT + b * L, lds); else
#endif
        if (st) att::diff_attn_unit<true>(Pqk, Vt, O12, hh, q0, b * T, nlat, NLAT + b * L, lds); else att::diff_attn_unit<false>(Pqk, Vt, O12, hh, q0, b * T, nlat, NLAT + b * L, lds); } PHASE_END
      PHASE_BEGIN_K(16) { float d1 = 0.f, d2 = 0.f; for (int i = 0; i < 64; ++i) { d1 += p.da_lq1[lp * 64 + i] * p.da_lk1[lp * 64 + i]; d2 += p.da_lq2[lp * 64 + i] * p.da_lk2[lp * 64 + i]; }
        const float li = 0.8f - 0.6f * expf(-0.3f * (float)l), lam = expf(d1) - expf(d2) + li;
        const int tq = mk::otid(); for (int r4 = bid; r4 < (last ? NLAT : NTOK) / 4; r4 += nb) att::diff_combine_rows4(O12, p.da_subln_g + lp * 128, lam, 1.0f - li, UO, r4 * 4, tq >> 6, tq & 63); } PHASE_END
      PHASE_BEGIN_K(17) { SchedOut S{UO, wsp<bf16_t>(p, WS_WOOUT) + (size_t)lp * D * D, Ybuf, nb, bid}; pg8::gemm_phase(lds, D, S, pg8::EpiStoreBf16{}); __syncthreads(); cvt_experts(p, l, (LAS float*)lds, 528 - 2 * nb > 0 ? 528 - 2 * nb : 0); } PHASE_END
      PHASE_BEGIN_K(18) phase_ln1<false>(p, l, Ybuf, lds, dry); PHASE_END
      PHASE_BEGIN_K(19) phase_scatter(p, l, lds); PHASE_END
      PHASE_BEGIN_K(20) { LAS int* mo = (LAS int*)(lds + LDS_MISC); { const int tq = mk::otid(); if (tq < 17) mo[tq] = wsp<int>(p, WS_MOFF)[l * 64 + tq]; } __syncthreads();
        SchedMoe<true> S{UO, wsp<bf16_t>(p, WS_WGU), (bf16_t*)(scr + SM_HE), mo, wsp<int>(p, WS_RL), D, DE, 128, nb, bid}; pg8::gemm_phase(lds, D, S, EpiGateUp{}); } PHASE_END
      PHASE_BEGIN_K(21) { LAS int* mo = (LAS int*)(lds + LDS_MISC); { const int tq = mk::otid(); if (tq < 17) mo[tq] = wsp<int>(p, WS_MOFF)[l * 64 + tq]; } __syncthreads();
        SchedMoe<false> S{(bf16_t*)(scr + SM_HE), wsp<bf16_t>(p, WS_WDN), (bf16_t*)(scr + SM_YS), mo, nullptr, DE, D, 256, nb, bid}; pg8::gemm_phase(lds, DE, S, pg8::EpiStoreBf16{}); } PHASE_END
      PHASE_BEGIN_K(22) phase_ln2(p, l, dry); PHASE_END
    }
  }
#undef PHASE_BEGIN_K
#undef PHASE_END
}
}

#ifndef MK_SINGLE_LAUNCH
#define MK_SINGLE_LAUNCH 1
#endif
extern "C" void kernel_launch(void* const* d_in, const int* in_sizes, int n_in, void* d_out, int out_size, void* d_ws, size_t ws_size, hipStream_t stream) {
  using namespace mk;
  static int grid = 0;
  if (grid == 0) {
    if (n_in != 34 || out_size != NLAT * D || ws_size < WS_END) { fprintf(stderr, "kernel_launch: unexpected shapes (n_in %d out %d ws %zu need %zu)\n", n_in, out_size, ws_size, (size_t)WS_END); grid = -1; return; }
    if (hipFuncSetAttribute((const void*)mega, hipFuncAttributeMaxDynamicSharedMemorySize, LDS_BYTES) != hipSuccess) { grid = -1; return; }
    int dev = 0, cus = 0, per_cu = 0;
    if (hipGetDevice(&dev) != hipSuccess || hipDeviceGetAttribute(&cus, hipDeviceAttributeMultiprocessorCount, dev) != hipSuccess) { grid = -1; return; }
    if (hipOccupancyMaxActiveBlocksPerMultiprocessor(&per_cu, (const void*)mega, NTHR, LDS_BYTES) != hipSuccess || per_cu < 1) { fprintf(stderr, "kernel_launch: occupancy query says %d\n", per_cu); }
    (void)hipGetLastError();
    grid = cus;
  }
  if (grid < 0) return;
  (void)hipMemsetAsync((char*)d_ws + WS_BAR, 0, (size_t)XCD_BAR_WORDS * 4, stream);
  Params p{};
  const float** pp = (const float**)&p;
  for (int i = 0; i < 34; ++i) pp[i] = (const float*)d_in[i];
  p.out = (float*)d_out; p.ws = (unsigned char*)d_ws;
#if MK_SINGLE_LAUNCH
  p.ph_lo = 0; p.ph_hi = N_PHASES;
  hipLaunchKernelGGL(mega, dim3(grid), dim3(NTHR), LDS_BYTES, stream, p);
#else
  for (int ph = 0; ph < N_PHASES; ++ph) { p.ph_lo = ph; p.ph_hi = ph + 1; hipLaunchKernelGGL(mega, dim3(grid), dim3(NTHR), LDS_BYTES, stream, p); }
#endif
}
```

```cpp
#include <hip/hip_runtime.h>
#include <stdint.h>
#include <stdio.h>

typedef unsigned short bf16_t;
typedef short bf16x8 __attribute__((ext_vector_type(8)));
typedef float f32x4 __attribute__((ext_vector_type(4)));
typedef float f32x2 __attribute__((ext_vector_type(2)));
typedef float f32x16 __attribute__((ext_vector_type(16)));
typedef unsigned u32x4 __attribute__((ext_vector_type(4)));
typedef unsigned u32x2 __attribute__((ext_vector_type(2)));
#define LAS __attribute__((address_space(3)))

namespace mk {
constexpr int B = 4, T = 8192, L = 256, D = 1024, NLAT = B * T, NCTX = B * L, NTOK = NLAT + NCTX;
constexpr int DEPTH = 4, EVEN_IN = 3328, ODD_IN = 3072, RW_OFF = 1536, RW_IN = 1792, NE = 16, DE = 512;
constexpr float ALPHA = 1.681792830507429f, LN_EPS = 1e-5f;
constexpr int NTHR = 512, LDS_BYTES = 147456;
constexpr int MOE_TILES = 280, MOE_ROWS = MOE_TILES * 256;

typedef __bf16 bf16x2v __attribute__((ext_vector_type(2)));
__device__ __forceinline__ unsigned cvt_pk_bf16(float lo, float hi) { const f32x2 v = {lo, hi}; return __builtin_bit_cast(unsigned, __builtin_convertvector(v, bf16x2v)); }
__device__ __forceinline__ unsigned cvt_pk_bf16_v(float lo, float hi) { return cvt_pk_bf16(lo, hi); }
template <int V> struct IntC { static constexpr int value = V; };
__device__ __forceinline__ float bf2f(bf16_t b) { return __uint_as_float(((unsigned)b) << 16); }
__device__ __forceinline__ float bflo(unsigned w) { return __uint_as_float(w << 16); }
__device__ __forceinline__ float bfhi(unsigned w) { return __uint_as_float(w & 0xffff0000u); }
__device__ __forceinline__ bf16_t f2bf(float f) { return (bf16_t)(cvt_pk_bf16(f, 0.f) & 0xffffu); }
__device__ __forceinline__ float sigmoidf_(float x) { return 1.0f / (1.0f + __expf(-x)); }
__device__ __forceinline__ float siluf_(float x) { return x / (1.0f + __expf(-x)); }
__device__ __forceinline__ float sigmoid_r(float x) { return __builtin_amdgcn_rcpf(1.0f + __expf(-x)); }
__device__ __forceinline__ float silu_r(float x) { return x * __builtin_amdgcn_rcpf(1.0f + __expf(-x)); }
__device__ __forceinline__ float wave_sum(float v) {
#pragma unroll
  for (int o = 32; o > 0; o >>= 1) v += __shfl_xor(v, o);
  return v;
}
template <int CTRL, int RM, int BM> __device__ __forceinline__ float dpp_mov(float old, float v) { return __int_as_float(__builtin_amdgcn_update_dpp(__float_as_int(old), __float_as_int(v), CTRL, RM, BM, false)); }
__device__ __forceinline__ float wave_sum_u(float v) {
  v += dpp_mov<0xB1, 0xf, 0xf>(v, v);
  v += dpp_mov<0x4E, 0xf, 0xf>(v, v);
  v += dpp_mov<0x141, 0xf, 0xf>(v, v);
  v += dpp_mov<0x140, 0xf, 0xf>(v, v);
  v += dpp_mov<0x142, 0xa, 0xf>(0.f, v);
  v += dpp_mov<0x143, 0xc, 0xf>(0.f, v);
  return __int_as_float(__builtin_amdgcn_readlane(__float_as_int(v), 63));
}
__device__ __forceinline__ float wave_max_u(float v) {
  v = fmaxf(v, dpp_mov<0xB1, 0xf, 0xf>(v, v));
  v = fmaxf(v, dpp_mov<0x4E, 0xf, 0xf>(v, v));
  v = fmaxf(v, dpp_mov<0x141, 0xf, 0xf>(v, v));
  v = fmaxf(v, dpp_mov<0x140, 0xf, 0xf>(v, v));
  v = fmaxf(v, dpp_mov<0x142, 0xa, 0xf>(0.f, v));
  v = fmaxf(v, dpp_mov<0x143, 0xc, 0xf>(0.f, v));
  return __int_as_float(__builtin_amdgcn_readlane(__float_as_int(v), 63));
}
__device__ __forceinline__ float reduce_scatter16(const float (&acc)[16], int lane) {
  float t8[8], t4[4], t2[2];
#pragma unroll
  for (int i = 0; i < 8; ++i) { const u32x2 sw = __builtin_amdgcn_permlane32_swap(__float_as_uint(acc[i]), __float_as_uint(acc[8 + i]), false, false); t8[i] = __uint_as_float(sw.x) + __uint_as_float(sw.y); }
#pragma unroll
  for (int i = 0; i < 4; ++i) { const u32x2 sw = __builtin_amdgcn_permlane16_swap(__float_as_uint(t8[i]), __float_as_uint(t8[4 + i]), false, false); t4[i] = __uint_as_float(sw.x) + __uint_as_float(sw.y); }
  const bool b3 = (lane & 8) != 0, b2_ = (lane & 4) != 0;
#pragma unroll
  for (int i = 0; i < 2; ++i) { const float keep = b3 ? t4[2 + i] : t4[i], send = b3 ? t4[i] : t4[2 + i]; t2[i] = keep + dpp_mov<0x128, 0xf, 0xf>(send, send); }
  float tot;
  { const float keep = b2_ ? t2[1] : t2[0], send = b2_ ? t2[0] : t2[1];
    float recv = dpp_mov<0x104, 0xf, 0x5>(send, send);
    recv = dpp_mov<0x114, 0xf, 0xa>(recv, send);
    tot = keep + recv; }
  tot += dpp_mov<0xB1, 0xf, 0xf>(tot, tot); tot += dpp_mov<0x4E, 0xf, 0xf>(tot, tot);
  return tot;
}
__device__ __forceinline__ f32x16 zero16() { float z = 0.f; asm volatile("" : "+v"(z)); f32x16 r;
#pragma unroll
  for (int i = 0; i < 16; ++i) r[i] = z;
  return r; }
__device__ __forceinline__ int otid() { int t = threadIdx.x; asm volatile("" : "+v"(t)); return t; }
__device__ __forceinline__ int obid() { int b = blockIdx.x; asm volatile("" : "+s"(b)); return b; }
__device__ __forceinline__ int bidx_of_row(int row) { return row < NLAT ? row / T : 4; }
}

#include <vector>

#define XB_TMO      128
#define XB_XCNT(j)  (256  + 64 * (j))
#define XB_XSUB(j)  (1280 + 64 * (j))
#define XB_XGEN(j)  (2304 + 64 * (j))
#define XB_TOP      3328
#define XB_TOPGEN   3392
#define XCD_BAR_WORDS 3456
#define XB_SPIN_CAP (1u << 18)
#define LAS __attribute__((address_space(3)))

__device__ __forceinline__ unsigned xb_ld(unsigned* p)              { return __hip_atomic_load(p, __ATOMIC_RELAXED, __HIP_MEMORY_SCOPE_AGENT); }
__device__ __forceinline__ unsigned xb_add(unsigned* p, unsigned v) { return __hip_atomic_fetch_add(p, v, __ATOMIC_RELAXED, __HIP_MEMORY_SCOPE_AGENT); }
__device__ __forceinline__ unsigned xb_xcc_id() { return (unsigned)__builtin_amdgcn_s_getreg((3 << 11) | 20) & 0xFu; }
#define XB_SPIN(cond, bar) do { unsigned _sp = 0; while (cond) { __builtin_amdgcn_s_sleep(1); \
    if ((++_sp & 255u) == 0u) { if (xb_ld(&(bar)[XB_TMO])) break; if (_sp > XB_SPIN_CAP) { atomicAdd(&(bar)[XB_TMO], 1u); break; } } } } while (0)

struct XcdBarrier {
    unsigned* bar; unsigned x;
    volatile LAS unsigned* st;
};

__device__ __forceinline__ XcdBarrier xcd_barrier_post(unsigned* bar, volatile LAS unsigned* st) {
    XcdBarrier b; b.bar = bar; b.x = xb_xcc_id(); b.st = st;
    if (threadIdx.x == 0) (void)xb_add(&bar[XB_XCNT(b.x)], 1u);
    return b;
}
__device__ __forceinline__ void xcd_barrier_complete(unsigned* bar, unsigned x, unsigned& nloc, unsigned& nx) {
    const unsigned G = gridDim.x * gridDim.y * gridDim.z;
    unsigned sum, cnt, mine, sp = 0u;
    for (;;) {
        sum = 0u; cnt = 0u; mine = 0u;
#pragma unroll
        for (unsigned j = 0; j < 16; ++j) { const unsigned c = xb_ld(&bar[XB_XCNT(j)]); sum += c; cnt += (c > 0u) ? 1u : 0u; mine = (j == x) ? c : mine; }
        if (sum == G) break;
        __builtin_amdgcn_s_sleep(1);
        if ((++sp & 255u) == 0u) { if (xb_ld(&bar[XB_TMO])) break; if (sp > XB_SPIN_CAP) { atomicAdd(&bar[XB_TMO], 1u); break; } }
    }
    nloc = mine > 0u ? mine : 1u; nx = cnt > 0u ? cnt : 1u;
}

__device__ __forceinline__ void xcd_barrier(const XcdBarrier& b) {
    asm volatile("s_waitcnt vmcnt(0)" ::: "memory");
    __syncthreads();
    if (threadIdx.x == 0) {
        unsigned* bar = b.bar;
        __builtin_amdgcn_s_waitcnt(0);
        unsigned nloc = b.st[0], nx = b.st[1];
        if (nloc == 0u) { xcd_barrier_complete(bar, b.x, nloc, nx); b.st[0] = nloc; b.st[1] = nx; }
        const unsigned old = xb_add(&bar[XB_XSUB(b.x)], 1u);
        const unsigned gen = old / nloc;
        if (old + 1u == (gen + 1u) * nloc) {
            __builtin_amdgcn_fence(__ATOMIC_RELEASE, "agent");
            asm volatile("s_waitcnt vmcnt(0)" ::: "memory");
            const unsigned og = xb_add(&bar[XB_TOP], 1u);
            const unsigned tg = og / nx;
            if (og + 1u == (tg + 1u) * nx) xb_add(&bar[XB_TOPGEN], 1u);
            else XB_SPIN(xb_ld(&bar[XB_TOPGEN]) == tg, bar);
            __builtin_amdgcn_fence(__ATOMIC_ACQUIRE, "agent");
            xb_add(&bar[XB_XGEN(b.x)], 1u);
            asm volatile("s_waitcnt vmcnt(0)" ::: "memory");
        } else {
            XB_SPIN(xb_ld(&bar[XB_XGEN(b.x)]) == gen, bar);
            __builtin_amdgcn_fence(__ATOMIC_ACQUIRE, "agent");
            asm volatile("s_waitcnt vmcnt(0)" ::: "memory");
        }
    }
    __syncthreads();
}

namespace pg8 {
using mk::cvt_pk_bf16;
constexpr int BM = 256, BK = 64, HALF = 128, HTB = HALF * BK * 2  , STAGE_BYTES = 8 * HTB;
__host__ __device__ __forceinline__ int lds_byte(int r, int c) { const int st = (r >> 4) * 2 + (c >> 5), rr = r & 15, cc = c & 31, ob = rr * 64 + cc * 2; return st * 1024 + (ob ^ (((ob >> 9) & 1) << 5)); }
__host__ __device__ __forceinline__ void stage_rc(int b, int& R, int& C) { const int st = b / 1024, sb = b % 1024, swz = sb ^ (((sb >> 9) & 1) << 5); R = (st >> 1) * 16 + swz / 64; C = (st & 1) * 32 + (swz % 64) / 2; }
__host__ __device__ __forceinline__ int perm32(int rho) { const int n = rho >> 4, i = rho & 15; return 8 * (i >> 2) + 4 * n + (i & 3); }

struct Unit { const char* A; const char* Bt; bf16_t* out; const int* rl; int pm, pn, x0, x1, ldo, kind; };

template <class Epi, class Sched>
__device__ __forceinline__ void gemm_phase(LAS unsigned char* lds, const int K, const Sched& S, const Epi& E) {
    const int tid = mk::otid(), wid = __builtin_amdgcn_readfirstlane(tid >> 6), lane = tid & 63, wr = wid >> 2, wc = wid & 3, fr = lane & 15, fq = lane >> 4;
    const int nt = K / BK;
    constexpr bool GATH = Sched::GATHER;
    unsigned voffA[2], voffB[2]; int Rl[2], Cl[2];
#pragma unroll
    for (int i = 0; i < 2; ++i) { int R, C; stage_rc(tid * 16 + i * 8192, R, C); const int Rb = Epi::PERM ? ((R & ~31) + perm32(R & 31)) : R; Rl[i] = R; Cl[i] = C;
        voffA[i] = (unsigned)(R * K + C) * 2u; voffB[i] = (unsigned)(Rb * K + C) * 2u; }
    unsigned roC[2][2], roN[2][2];
    (void)Rl; (void)Cl;
    const size_t kstep = (size_t)(BK * 2);
    const size_t hstep = (size_t)HALF * K * 2;
    const unsigned ldsw = (unsigned)wid * 1024u;
    const int aoff = lds_byte(wr * 64 + fr, fq * 8), boff = lds_byte(wc * 32 + fr, fq * 8);
#define PG8_SA(b, h) (((b) * 2 + (h)) * HTB)
#define PG8_SB(b, h) ((4 + (b) * 2 + (h)) * HTB)
#define PG8_STAGE(bufoff, gbase, voff) do { _Pragma("unroll") for (int _i = 0; _i < 2; ++_i) \
        __builtin_amdgcn_global_load_lds((const unsigned*)((const char*)(gbase) + (voff)[_i]), (LAS unsigned*)(lds + (bufoff) + ldsw + _i * 8192), 16, 0, 0); } while (0)
#define PG8_STAGE_A(bufoff, gbase, h, ro) do { if constexpr (GATH) { _Pragma("unroll") for (int _i = 0; _i < 2; ++_i) \
        __builtin_amdgcn_global_load_lds((const unsigned*)((const char*)(gbase) + (ro)[h][_i]), (LAS unsigned*)(lds + (bufoff) + ldsw + _i * 8192), 16, 0, 0); } \
      else { PG8_STAGE(bufoff, (const char*)(gbase) + (h) * hstep, voffA); } } while (0)
#define PG8_LOAD_RO(u, ro) do { _Pragma("unroll") for (int _h = 0; _h < 2; ++_h) _Pragma("unroll") for (int _i = 0; _i < 2; ++_i) \
        (ro)[_h][_i] = (unsigned)(u).rl[Rl[_i] + _h * 128] * (unsigned)(K * 2) + (unsigned)(Cl[_i] * 2); } while (0)
#define PG8_LDA(dst, b, h) do { _Pragma("unroll") for (int m = 0; m < 4; ++m) _Pragma("unroll") for (int k = 0; k < 2; ++k) dst[m][k] = *(const LAS bf16x8*)(lds + PG8_SA(b, h) + aoff + m * 2048 + k * 1024); } while (0)
#define PG8_LDB(dst, b, h) do { _Pragma("unroll") for (int n = 0; n < 2; ++n) _Pragma("unroll") for (int k = 0; k < 2; ++k) dst[n][k] = *(const LAS bf16x8*)(lds + PG8_SB(b, h) + boff + n * 2048 + k * 1024); } while (0)
#define PG8_MMA(ai, bj, At, Bt) do { __builtin_amdgcn_s_setprio(1); _Pragma("unroll") for (int m = 0; m < 4; ++m) _Pragma("unroll") for (int n = 0; n < 2; ++n) _Pragma("unroll") for (int k = 0; k < 2; ++k) \
        acc[ai][bj][m][n] = __builtin_amdgcn_mfma_f32_16x16x32_bf16(Bt[n][k], At[m][k], acc[ai][bj][m][n], 0, 0, 0); __builtin_amdgcn_s_setprio(0); } while (0)
#define PG8_WAIT_V(n) asm volatile("s_waitcnt vmcnt(" #n ")" ::: "memory")
#define PG8_WAIT_L(n) asm volatile("s_waitcnt lgkmcnt(" #n ")" ::: "memory")
#define PG8_BAR __builtin_amdgcn_s_barrier()
#define PG8_SCHED __builtin_amdgcn_sched_barrier(0)
    Unit cur, nxt; int ui = 0;
    if (!S.next(0, cur)) return;
    f32x4 acc[2][2][4][2];
#pragma unroll
    for (int a = 0; a < 2; ++a)
#pragma unroll
        for (int b = 0; b < 2; ++b)
#pragma unroll
            for (int m = 0; m < 4; ++m)
#pragma unroll
                for (int n = 0; n < 2; ++n) acc[a][b][m][n] = (f32x4){0.f, 0.f, 0.f, 0.f};
    bf16x8 At[4][2], B0[2][2], B1[2][2];
    const char* cA = cur.A; const char* cB = cur.Bt;
    if constexpr (GATH) { PG8_LOAD_RO(cur, roC); }
    PG8_STAGE(PG8_SB(0, 0), cB, voffB); PG8_STAGE_A(PG8_SA(0, 0), cA, 0, roC); PG8_STAGE(PG8_SB(0, 1), cB + hstep, voffB); PG8_STAGE_A(PG8_SA(0, 1), cA, 1, roC);
    if (wr == 1) PG8_BAR;
    PG8_WAIT_V(4); PG8_BAR;
    PG8_STAGE(PG8_SB(1, 0), cB + kstep, voffB); PG8_STAGE_A(PG8_SA(1, 0), cA + kstep, 0, roC); PG8_STAGE(PG8_SB(1, 1), cB + hstep + kstep, voffB);
    PG8_WAIT_V(6); PG8_BAR;
    for (;;) {
        const bool has_next = S.next(ui + 1, nxt);
        const char* nA = has_next ? nxt.A : cA; const char* nB = has_next ? nxt.Bt : cB;
        if constexpr (GATH) { if (has_next) { PG8_LOAD_RO(nxt, roN); } else { _Pragma("unroll") for (int _h = 0; _h < 2; ++_h) _Pragma("unroll") for (int _i = 0; _i < 2; ++_i) roN[_h][_i] = roC[_h][_i]; } }
        for (int t = 0; t < nt; t += 2) {
            const bool last = (t == nt - 2);
            const char* a1 = cA + (size_t)(t + 1) * kstep;
            const char* a2 = last ? nA : cA + (size_t)(t + 2) * kstep; const char* b2 = last ? nB : cB + (size_t)(t + 2) * kstep;
            const char* a3 = a2 + kstep; const char* b3 = b2 + kstep;
            unsigned ro2[2][2];
            if constexpr (GATH) { _Pragma("unroll") for (int _h = 0; _h < 2; ++_h) _Pragma("unroll") for (int _i = 0; _i < 2; ++_i) ro2[_h][_i] = last ? roN[_h][_i] : roC[_h][_i]; }
            (void)ro2;
            PG8_LDB(B0, 0, 0); PG8_SCHED; PG8_LDA(At, 0, 0); PG8_STAGE_A(PG8_SA(1, 1), a1, 1, roC);
            PG8_WAIT_L(8); PG8_BAR; PG8_WAIT_L(0); PG8_MMA(0, 0, At, B0); PG8_BAR; PG8_SCHED;
            PG8_LDB(B1, 0, 1); PG8_STAGE(PG8_SB(0, 0), b2, voffB);
            PG8_BAR; PG8_WAIT_L(0); PG8_MMA(0, 1, At, B1); PG8_BAR;
            PG8_LDA(At, 0, 1); PG8_STAGE_A(PG8_SA(0, 0), a2, 0, ro2);
            PG8_BAR; PG8_WAIT_L(0); PG8_MMA(1, 0, At, B0); PG8_BAR; PG8_SCHED;
            PG8_STAGE(PG8_SB(0, 1), b2 + hstep, voffB);
            PG8_WAIT_V(6); PG8_BAR; PG8_MMA(1, 1, At, B1); PG8_BAR;
            PG8_LDB(B0, 1, 0); PG8_SCHED; PG8_LDA(At, 1, 0); PG8_STAGE_A(PG8_SA(0, 1), a2, 1, ro2);
            PG8_WAIT_L(8); PG8_BAR; PG8_WAIT_L(0); PG8_MMA(0, 0, At, B0); PG8_BAR; PG8_SCHED;
            PG8_LDB(B1, 1, 1); PG8_STAGE(PG8_SB(1, 0), b3, voffB);
            PG8_BAR; PG8_WAIT_L(0); PG8_MMA(0, 1, At, B1); PG8_BAR;
            PG8_LDA(At, 1, 1); PG8_STAGE_A(PG8_SA(1, 0), a3, 0, ro2);
            PG8_BAR; PG8_WAIT_L(0); PG8_MMA(1, 0, At, B0); PG8_BAR; PG8_SCHED;
            PG8_STAGE(PG8_SB(1, 1), b3 + hstep, voffB);
            PG8_WAIT_V(6); PG8_BAR; PG8_MMA(1, 1, At, B1); PG8_BAR;
        }
        E(acc, cur, wr, wc, fr, fq);
        if (!has_next) break;
#pragma unroll
        for (int a = 0; a < 2; ++a)
#pragma unroll
            for (int b = 0; b < 2; ++b)
#pragma unroll
                for (int m = 0; m < 4; ++m)
#pragma unroll
                    for (int n = 0; n < 2; ++n) acc[a][b][m][n] = (f32x4){0.f, 0.f, 0.f, 0.f};
        cur = nxt; cA = nA; cB = nB; ++ui;
        if constexpr (GATH) { _Pragma("unroll") for (int _h = 0; _h < 2; ++_h) _Pragma("unroll") for (int _i = 0; _i < 2; ++_i) roC[_h][_i] = roN[_h][_i]; }
    }
    PG8_WAIT_V(0);
    if (wr == 0) PG8_BAR;
    PG8_BAR;
#undef PG8_SA
#undef PG8_SB
#undef PG8_STAGE
#undef PG8_STAGE_A
#undef PG8_LOAD_RO
#undef PG8_LDA
#undef PG8_LDB
#undef PG8_MMA
#undef PG8_WAIT_V
#undef PG8_WAIT_L
#undef PG8_BAR
#undef PG8_SCHED
}

struct EpiStoreBf16 {
    static constexpr bool PERM = true;
    __device__ __forceinline__ void operator()(const f32x4 (&acc)[2][2][4][2], const Unit& u, int wr, int wc, int fr, int fq) const {
        bf16_t* O = u.out; const int ldc = u.ldo;
        const int row0 = u.x0 + wr * 64 + fr, col0 = u.x1 + wc * 32 + 8 * fq;
#pragma unroll
        for (int ai = 0; ai < 2; ++ai)
#pragma unroll
            for (int m = 0; m < 4; ++m) { bf16_t* rowp = O + (size_t)(row0 + ai * HALF + m * 16) * ldc + col0;
#pragma unroll
                for (int bj = 0; bj < 2; ++bj) { const f32x4 v0 = acc[ai][bj][m][0], v1 = acc[ai][bj][m][1];
                    u32x4 w; w.x = cvt_pk_bf16(v0[0], v0[1]); w.y = cvt_pk_bf16(v0[2], v0[3]); w.z = cvt_pk_bf16(v1[0], v1[1]); w.w = cvt_pk_bf16(v1[2], v1[3]);
                    *(u32x4*)(rowp + bj * HALF) = w; } }
    }
};
}

namespace mk {
struct NMapId { int off; __device__ __forceinline__ int operator()(int n) const { return n + off; } __device__ __forceinline__ float scl(int) const { return 1.0f; } };
struct NMapInterleave { int which; __device__ __forceinline__ int operator()(int n) const { return 2 * n + which; } __device__ __forceinline__ float scl(int) const { return 1.0f; } };
struct NMapRope { __device__ __forceinline__ int operator()(int n) const { if (n >= 2048) return n; const int ch = n >> 6, c = n & 63, half = c >> 5, w = c & 31, z = w >> 4, i = w & 15; return ch * 64 + half * 32 + 2 * i + z; }
  __device__ __forceinline__ float scl(int n) const { return n < 1024 ? 0.125f * 1.4426950408889634f : 1.0f; } };

template <class NMap>
__device__ __forceinline__ void cvt_tile(const float* __restrict__ src, int ldsrc, int K, bf16_t* __restrict__ dst, int k0, int n0, const NMap& nmap, LAS float* tile) {
  const int t = mk::otid();
  { const int k = t >> 3, c = (t & 7) * 8; const float* p = src + (size_t)(k0 + k) * ldsrc + n0 + c;
    const f32x4 a = *(const f32x4*)p, b = *(const f32x4*)(p + 4);
    LAS float* q = tile + k * 65 + c; q[0] = a[0]; q[1] = a[1]; q[2] = a[2]; q[3] = a[3]; q[4] = b[0]; q[5] = b[1]; q[6] = b[2]; q[7] = b[3]; }
  __syncthreads();
  { const int n = t >> 3, kc = (t & 7) * 8; const LAS float* q = tile + kc * 65 + n; const float sc = nmap.scl(n0 + n);
    u32x4 w; w.x = cvt_pk_bf16(q[0] * sc, q[65] * sc); w.y = cvt_pk_bf16(q[130] * sc, q[195] * sc); w.z = cvt_pk_bf16(q[260] * sc, q[325] * sc); w.w = cvt_pk_bf16(q[390] * sc, q[455] * sc);
    *(u32x4*)(dst + (size_t)nmap(n0 + n) * K + k0 + kc) = w; }
  __syncthreads();
}
template <class NMap>
__device__ __forceinline__ int cvt_matrix(const float* src, int ldsrc, int K, int N, bf16_t* dst, const NMap& nmap, LAS float* tile, int ubase, int bid, int nblk) {
  const int nkt = K / 64, nnt = N / 64, tot = nkt * nnt;
  int first = ubase + ((bid - ubase % nblk) + nblk) % nblk;
  for (int u = first; u < ubase + tot; u += nblk) { const int v = u - ubase; cvt_tile(src, ldsrc, K, dst, (v / nnt) * 64, (v % nnt) * 64, nmap, tile); }
  return tot;
}
}

namespace att {
using namespace mk;
constexpr int KB_BYTES = 64 * 128, VB_BYTES = 128 * 128, TILE_BYTES = KB_BYTES + VB_BYTES, DA_RING = 4, DA_LDS = DA_RING * TILE_BYTES;
__device__ __forceinline__ int pi32(int r) { return (r & ~12) | ((r & 4) << 1) | ((r & 8) >> 1); }
__device__ __forceinline__ int swz(int row, int chunk) { return row * 128 + ((chunk ^ ((row >> 1) & 7)) << 4); }
__device__ __forceinline__ int crow(int r, int hi) { return (r & 3) + 8 * (r >> 2) + 4 * hi; }

__device__ __forceinline__ float sumsq8(u32x4 w) { return (bflo(w.x) * bflo(w.x) + bfhi(w.x) * bfhi(w.x)) + (bflo(w.y) * bflo(w.y) + bfhi(w.y) * bfhi(w.y)) + (bflo(w.z) * bflo(w.z) + bfhi(w.z) * bfhi(w.z)) + (bflo(w.w) * bflo(w.w) + bfhi(w.w) * bfhi(w.w)); }
__device__ __forceinline__ void knorm_group(const bf16_t* __restrict__ Pqk, float* __restrict__ KN, int g, LAS float* red) {
  const int tid = mk::otid(), wid = tid >> 6, lane = tid & 63;
  float mx = 0.f, mq = 0.f;
  for (int i0 = 0; i0 < 160; i0 += 32) {
    u32x4 a[4], b[4], c[4], d[4];
#pragma unroll
    for (int j = 0; j < 4; ++j) { int i = i0 + j * 8 + wid; i = i < 132 ? i : wid; const int row = i < 128 ? g * 128 + i : NLAT + g * 4 + (i - 128);
      const bf16_t* kp = Pqk + (size_t)row * 2048 + 1024 + lane * 16; a[j] = *(const u32x4*)kp; b[j] = *(const u32x4*)(kp + 8); c[j] = *(const u32x4*)(kp - 1024); d[j] = *(const u32x4*)(kp - 1024 + 8); }
#pragma unroll
    for (int j = 0; j < 4; ++j) { float s = sumsq8(a[j]) + sumsq8(b[j]); s += dpp_mov<0xB1, 0xf, 0xf>(s, s); s += dpp_mov<0x4E, 0xf, 0xf>(s, s); mx = fmaxf(mx, s);
      float q = sumsq8(c[j]) + sumsq8(d[j]); q += dpp_mov<0xB1, 0xf, 0xf>(q, q); q += dpp_mov<0x4E, 0xf, 0xf>(q, q); mq = fmaxf(mq, q); }
  }
  if ((lane & 3) == 0) { red[wid * 32 + (lane >> 2)] = mx; red[wid * 32 + 16 + (lane >> 2)] = mq; }
  __syncthreads();
  if (tid < 32) { float m = red[tid];
#pragma unroll
    for (int w = 1; w < 8; ++w) m = fmaxf(m, red[w * 32 + tid]);
    KN[g * 32 + tid] = m; }
  __syncthreads();
}
__device__ __forceinline__ float nmax2_of(const float* __restrict__ KN, int b, int hh, int which) {
  return wave_max_u(KN[(b * 64 + (mk::otid() & 63)) * 32 + which * 16 + hh]);
}

template <bool STATIC, int ABL = 0>
__device__ __forceinline__ void diff_attn_unit(const bf16_t* __restrict__ Pqk, const bf16_t* __restrict__ Vt, bf16_t* __restrict__ O12, int hh, int q0, int klat0, int nlat, int kctx0, LAS unsigned char* lds) {
  const int tid = mk::otid(), wid = tid >> 6, lane = tid & 63, r = lane & 31, hi = lane >> 5;
  const int NT = (nlat + L) / 64, NTL = nlat / 64;
  const int wv = __builtin_amdgcn_readfirstlane(wid);
  const int drow = wv * 8 + (lane >> 3), dch = (lane & 7) ^ ((drow >> 1) & 7);
  const unsigned koff = (unsigned)(drow * 2048 + 1024 + hh * 64 + dch * 8) * 2u;
  const unsigned voff = (unsigned)(((hh >> 1) * 128 + drow) * NTOK + dch * 8) * 2u;
  bf16x8 qf[4];
  { const bf16_t* qp = Pqk + (size_t)(q0 + wid * 32 + r) * 2048 + hh * 64 + hi * 8;
#pragma unroll
    for (int ks = 0; ks < 4; ++ks) qf[ks] = *(const bf16x8*)(qp + ks * 16); }
  const unsigned kaddr0 = (unsigned)(pi32(r) * 128 + ((hi ^ ((pi32(r) >> 1) & 7)) << 4));
  const unsigned vaddr0 = (unsigned)(r * 128 + ((hi ^ ((r >> 1) & 7)) << 4)) + KB_BYTES;
  f32x16 o[4];
#pragma unroll
  for (int vb = 0; vb < 4; ++vb)
#pragma unroll
    for (int i = 0; i < 16; ++i) o[vb][i] = 0.f;
  float l_run = 0.f;
#define DA_DMA(t) do { const int tok = (t) < NTL ? klat0 + (t) * 64 : kctx0 + ((t) - NTL) * 64; LAS unsigned char* b_ = lds + ((t) & 3) * TILE_BYTES + wv * 1024; \
    const char* kt_ = (const char*)Pqk + (size_t)tok * 4096; const char* vt_ = (const char*)Vt + (size_t)tok * 2; \
    __builtin_amdgcn_global_load_lds((const unsigned*)(kt_ + koff), (LAS unsigned*)b_, 16, 0, 0); \
    __builtin_amdgcn_global_load_lds((const unsigned*)(vt_ + voff), (LAS unsigned*)(b_ + KB_BYTES), 16, 0, 0); \
    __builtin_amdgcn_global_load_lds((const unsigned*)(vt_ + (size_t)64 * NTOK * 2 + voff), (LAS unsigned*)(b_ + KB_BYTES + 8192), 16, 0, 0); } while (0)
#define DA_WAITV(n) asm volatile("s_waitcnt vmcnt(" #n ")" ::: "memory")
#define DA_PAIR_BEGIN(t) if (!(ABL & 8) && (t) + 2 < NT) { DA_DMA((t) + 2); DA_DMA((t) + 3); }
#define DA_SLOT(tt) const unsigned sb_ = (unsigned)(((tt) & 3) * TILE_BYTES); const LAS unsigned char* kb_ = lds + (kaddr0 + sb_); const LAS unsigned char* vb_ = lds + (vaddr0 + sb_)
#define DA_PAIR_END() do { DA_WAITV(0); asm volatile("s_waitcnt lgkmcnt(0)" ::: "memory"); if (!(ABL & 16)) __builtin_amdgcn_s_barrier(); } while (0)
  DA_DMA(0); DA_DMA(1);
  DA_WAITV(0); __builtin_amdgcn_s_barrier();
#define DA_XOR(ptr, x) ((const LAS unsigned char*)((unsigned)(size_t)(ptr) ^ (unsigned)(x)))
#define DA_KFRAG(ks) const LAS unsigned char* kp_ = DA_XOR(kb_, (ks) << 5); const bf16x8 a0 = (ABL & 2) ? qf[ks] : *(const LAS bf16x8*)kp_, a1 = (ABL & 2) ? qf[(ks) ^ 1] : *(const LAS bf16x8*)(kp_ + 4096)
#define DA_VFRAGS() bf16x8 va[4][4]; \
    _Pragma("unroll") for (int c4 = 0; c4 < 4; ++c4) { const LAS unsigned char* vp_ = DA_XOR(vb_, c4 << 5); \
      _Pragma("unroll") for (int vb = 0; vb < 4; ++vb) va[vb][c4] = (ABL & 1) ? qf[c4 ^ (vb & 3)] : *(const LAS bf16x8*)(vp_ + vb * 4096); }
#define DA_PACK_PV() bf16x8 pf[2][2]; \
    _Pragma("unroll") for (int s = 0; s < 2; ++s) { u32x4 w0, w1; \
      w0.x = cvt_pk_bf16(s0[8 * s + 0], s0[8 * s + 1]); w0.y = cvt_pk_bf16(s0[8 * s + 2], s0[8 * s + 3]); w0.z = cvt_pk_bf16(s0[8 * s + 4], s0[8 * s + 5]); w0.w = cvt_pk_bf16(s0[8 * s + 6], s0[8 * s + 7]); \
      w1.x = cvt_pk_bf16(s1[8 * s + 0], s1[8 * s + 1]); w1.y = cvt_pk_bf16(s1[8 * s + 2], s1[8 * s + 3]); w1.z = cvt_pk_bf16(s1[8 * s + 4], s1[8 * s + 5]); w1.w = cvt_pk_bf16(s1[8 * s + 6], s1[8 * s + 7]); \
      pf[0][s] = __builtin_bit_cast(bf16x8, w0); pf[1][s] = __builtin_bit_cast(bf16x8, w1); } \
    _Pragma("unroll") for (int vb = 0; vb < 4; ++vb) _Pragma("unroll") for (int kb = 0; kb < 2; ++kb) _Pragma("unroll") for (int s = 0; s < 2; ++s) \
      o[vb] = __builtin_amdgcn_mfma_f32_32x32x16_bf16(va[vb][kb * 2 + s], pf[kb][s], o[vb], 0, 0, 0)
  if constexpr (STATIC) {
    for (int t = 0; t < NT; t += 2) {
      DA_PAIR_BEGIN(t);
#pragma unroll
      for (int u = 0; u < 2; ++u) {
        DA_SLOT(t + u);
        f32x16 s0, s1;
#pragma unroll
        for (int i = 0; i < 16; ++i) { s0[i] = 0.f; s1[i] = 0.f; }
#pragma unroll
        for (int ks = 0; ks < 4; ++ks) { DA_KFRAG(ks); s0 = __builtin_amdgcn_mfma_f32_32x32x16_bf16(a0, qf[ks], s0, 0, 0, 0); s1 = __builtin_amdgcn_mfma_f32_32x32x16_bf16(a1, qf[ks], s1, 0, 0, 0); }
        DA_VFRAGS();
        if constexpr ((ABL & 32) != 0) {
          l_run += s0[0] + s1[0];
#pragma unroll
          for (int vb = 0; vb < 4; ++vb)
#pragma unroll
            for (int c4 = 0; c4 < 4; ++c4) o[vb] = __builtin_amdgcn_mfma_f32_32x32x16_bf16(va[vb][c4], qf[c4], o[vb], 0, 0, 0);
        } else {
          float ps = 0.f;
#pragma unroll
          for (int i = 0; i < 16; ++i) { s0[i] = (ABL & 4) ? s0[i] : __builtin_amdgcn_exp2f(s0[i]); ps += s0[i]; }
#pragma unroll
          for (int i = 0; i < 16; ++i) { s1[i] = (ABL & 4) ? s1[i] : __builtin_amdgcn_exp2f(s1[i]); ps += s1[i]; }
          l_run += ps;
          DA_PACK_PV();
        }
      }
      DA_PAIR_END();
    }
  } else {
    constexpr float THR = 8.0f * 1.4426950408889634f;
    float m_run = -1e30f;
    for (int t = 0; t < NT; ++t) {
      if (!(t & 1)) DA_PAIR_BEGIN(t);
      DA_SLOT(t);
      f32x16 s0 = zero16(), s1 = zero16();
#pragma unroll
      for (int ks = 0; ks < 4; ++ks) { DA_KFRAG(ks); s0 = __builtin_amdgcn_mfma_f32_32x32x16_bf16(a0, qf[ks], s0, 0, 0, 0); s1 = __builtin_amdgcn_mfma_f32_32x32x16_bf16(a1, qf[ks], s1, 0, 0, 0); }
      float mx = fmaxf(s0[0], s1[0]);
#pragma unroll
      for (int i = 1; i < 16; ++i) mx = fmaxf(mx, fmaxf(s0[i], s1[i]));
      { const u32x2 sw = __builtin_amdgcn_permlane32_swap(__float_as_uint(mx), __float_as_uint(mx), false, false); mx = fmaxf(__uint_as_float(sw.x), __uint_as_float(sw.y)); }
      float alpha = 1.0f;
      if (!__all(mx - m_run <= THR)) {
        const float m_new = fmaxf(m_run, mx);
        alpha = __builtin_amdgcn_exp2f(m_run - m_new);
        m_run = m_new;
#pragma unroll
        for (int vb = 0; vb < 4; ++vb)
#pragma unroll
          for (int i = 0; i < 16; ++i) o[vb][i] *= alpha;
      }
      float ps = 0.f;
#pragma unroll
      for (int i = 0; i < 16; ++i) { s0[i] = __builtin_amdgcn_exp2f(s0[i] - m_run); ps += s0[i]; }
#pragma unroll
      for (int i = 0; i < 16; ++i) { s1[i] = __builtin_amdgcn_exp2f(s1[i] - m_run); ps += s1[i]; }
      l_run = l_run * alpha + ps;
      __builtin_amdgcn_sched_barrier(0);
      DA_VFRAGS();
      DA_PACK_PV();
      if (t & 1) DA_PAIR_END();
    }
  }
#undef DA_KFRAG
#undef DA_XOR
#undef DA_VFRAGS
#undef DA_PACK_PV
#undef DA_DMA
#undef DA_WAITV
#undef DA_PAIR_BEGIN
#undef DA_PAIR_END
#undef DA_SLOT
  float l_tot; { const u32x2 sw = __builtin_amdgcn_permlane32_swap(__float_as_uint(l_run), __float_as_uint(l_run), false, false); l_tot = __uint_as_float(sw.x) + __uint_as_float(sw.y); }
  const float inv = 1.0f / l_tot;
  const int te = mk::otid();
  bf16_t* op = O12 + (size_t)(q0 + (te >> 6) * 32 + (te & 31)) * 2048 + hh * 128 + 4 * ((te >> 5) & 1);
#pragma unroll
  for (int vb = 0; vb < 4; ++vb)
#pragma unroll
    for (int g = 0; g < 4; ++g) {
      u32x2 w; w.x = cvt_pk_bf16(o[vb][4 * g] * inv, o[vb][4 * g + 1] * inv); w.y = cvt_pk_bf16(o[vb][4 * g + 2] * inv, o[vb][4 * g + 3] * inv);
      *(u32x2*)(op + vb * 32 + 8 * g) = w;
    }
}

__device__ __forceinline__ void diff_combine_rows4(const bf16_t* __restrict__ O12, const float* __restrict__ subln_g, float lam, float oml, bf16_t* __restrict__ O, int row0, int h, int lane) {
  unsigned a[4], b[4];
#pragma unroll
  for (int i = 0; i < 4; ++i) { a[i] = *(const unsigned*)(O12 + (size_t)(row0 + i) * 2048 + (2 * h) * 128 + 2 * lane); b[i] = *(const unsigned*)(O12 + (size_t)(row0 + i) * 2048 + (2 * h + 1) * 128 + 2 * lane); }
  const float g0 = subln_g[2 * lane], g1 = subln_g[2 * lane + 1];
#pragma unroll
  for (int i = 0; i < 4; ++i) {
    const float x0 = bflo(a[i]) - lam * bflo(b[i]), x1 = bfhi(a[i]) - lam * bfhi(b[i]);
    const float ss = wave_sum_u(x0 * x0 + x1 * x1);
    const float rs = rsqrtf(ss * (1.0f / 128.0f) + 1e-5f) * oml;
    *(unsigned*)(O + (size_t)(row0 + i) * 1024 + h * 128 + 2 * lane) = cvt_pk_bf16(x0 * rs * g0, x1 * rs * g1);
  }
}
}

namespace natt {
using namespace mk;
using att::pi32; using att::swz;
constexpr int TB = 64 * 128;
constexpr int NA_LDS = 4 * TB + 2048;
__device__ __forceinline__ void na_attn_unit(const bf16_t* __restrict__ Pe, const bf16_t* __restrict__ Vte, const float* __restrict__ rpb_h, bf16_t* __restrict__ O, int b, int h, int rq, LAS unsigned char* lds) {
  const int tid = mk::otid(), wid = tid >> 6, lane = tid & 63, r = lane & 31, hi = lane >> 5;
  constexpr float LOG2E = 1.4426950408889634f;
  LAS float* sb = (LAS float*)(lds + 4 * TB);
  for (int i = tid; i < 465; i += NTHR) sb[i] = rpb_h[i];
  const bool is_ctx = rq < 0;
  int qrow = 0, qcol = 0, qtok, rs_q = 0, cs_q = 0, span0 = 0, wlo = 0, whi = -1, lo = 0, ntl = 0;
  if (!is_ctx) {
    const int r0 = rq * 4, ra = r0 + (wid >> 2) * 2;
    qrow = ra + (r >> 4); qcol = (wid & 3) * 16 + (r & 15); qtok = b * T + qrow * 64 + qcol;
    rs_q = min(max(qrow - 4, 0), 120); cs_q = min(max(qcol - 8, 0), 48);
    span0 = min(max((wid & 3) * 16 - 8, 0), 32);
    wlo = min(max(ra - 4, 0), 120); whi = min(max(ra - 3, 0), 120) + 7;
    lo = min(max(r0 - 4, 0), 120); const int hi_ = min(max(r0 - 1, 0), 120) + 7; ntl = hi_ - lo + 1;
  } else qtok = NLAT + b * L + wid * 32 + r;
  const int NT = ntl + 4;
  const int srow = tid >> 3, sch = tid & 7;
  const bf16_t* kbase = Pe + 512 + h * 64 + sch * 8;
  const bf16_t* vbase = Vte + (size_t)(h * 64 + srow) * NTOK + sch * 8;
  const int sdst = swz(srow, sch);
  bf16x8 qf[4];
  { const bf16_t* qp = Pe + (size_t)qtok * 1024 + h * 64 + hi * 8;
#pragma unroll
    for (int ks = 0; ks < 4; ++ks) qf[ks] = *(const bf16x8*)(qp + ks * 16); }
  const int kx = (pi32(r) >> 1) & 7, vx = (r >> 1) & 7;
  const int ka_loc = (span0 + pi32(r)) * 128; const int kx_loc = ((span0 + pi32(r)) >> 1) & 7;
  f32x16 o[2];
#pragma unroll
  for (int vb = 0; vb < 2; ++vb)
#pragma unroll
    for (int i = 0; i < 16; ++i) o[vb][i] = 0.f;
  float m_run = -1e30f, l_run = 0.f;
  u32x4 kreg, vreg;
#define NA_LOAD(t) do { const int tok = (t) < ntl ? b * T + (lo + (t)) * 64 : NLAT + b * L + ((t) - ntl) * 64; \
    kreg = *(const u32x4*)(kbase + (size_t)(tok + srow) * 1024); vreg = *(const u32x4*)(vbase + tok); } while (0)
#define NA_WRITE(bufi) do { *(LAS u32x4*)(lds + (bufi) * TB + sdst) = kreg; *(LAS u32x4*)(lds + 2 * TB + (bufi) * TB + sdst) = vreg; } while (0)
  NA_LOAD(0); NA_WRITE(0); __syncthreads();
  for (int t = 0; t < NT; ++t) {
    const bool more = t + 1 < NT;
    if (more) NA_LOAD(t + 1);
    const LAS unsigned char* kb_ = lds + (t & 1) * TB; const LAS unsigned char* vb_ = lds + 2 * TB + (t & 1) * TB;
    const bool local = t < ntl; const int kr = lo + t;
    const bool active = !local || (kr >= wlo && kr <= whi);
    if (active) {
      f32x16 s0, s1;
#pragma unroll
      for (int i = 0; i < 16; ++i) { s0[i] = 0.f; s1[i] = 0.f; }
      if (local) {
#pragma unroll
        for (int ks = 0; ks < 4; ++ks) {
          const bf16x8 a0 = *(const LAS bf16x8*)(kb_ + ka_loc + (((ks * 2 + hi) ^ kx_loc) << 4));
          s0 = __builtin_amdgcn_mfma_f32_32x32x16_bf16(a0, qf[ks], s0, 0, 0, 0);
        }
        const bool row_ok = kr >= rs_q && kr < rs_q + 8; const int dr31 = (kr - qrow + 7) * 31;
#pragma unroll
        for (int i = 0; i < 16; ++i) {
          const int kc = span0 + (i & 7) + 8 * hi + 16 * (i >> 3);
          const bool ok = row_ok && kc >= cs_q && kc < cs_q + 16;
          const int bi = ok ? dr31 + (kc - qcol + 15) : 0;
          const float bv = sb[bi];
          s0[i] = ok ? fmaf(s0[i], 0.125f, bv) : -1e30f; s1[i] = -1e30f;
        }
      } else {
#pragma unroll
        for (int ks = 0; ks < 4; ++ks) {
          const int ch = ((ks * 2 + hi) ^ kx) << 4;
          const bf16x8 a0 = *(const LAS bf16x8*)(kb_ + pi32(r) * 128 + ch), a1 = *(const LAS bf16x8*)(kb_ + (32 + pi32(r)) * 128 + ch);
          s0 = __builtin_amdgcn_mfma_f32_32x32x16_bf16(a0, qf[ks], s0, 0, 0, 0);
          s1 = __builtin_amdgcn_mfma_f32_32x32x16_bf16(a1, qf[ks], s1, 0, 0, 0);
        }
#pragma unroll
        for (int i = 0; i < 16; ++i) { s0[i] *= 0.125f; s1[i] *= 0.125f; }
      }
      float mx = s0[0];
#pragma unroll
      for (int i = 1; i < 16; ++i) mx = fmaxf(mx, s0[i]);
#pragma unroll
      for (int i = 0; i < 16; ++i) mx = fmaxf(mx, s1[i]);
      { const u32x2 sw = __builtin_amdgcn_permlane32_swap(__float_as_uint(mx), __float_as_uint(mx), false, false); mx = fmaxf(__uint_as_float(sw.x), __uint_as_float(sw.y)); }
      const float m_new = fmaxf(m_run, mx);
      const float alpha = __builtin_amdgcn_exp2f((m_run - m_new) * LOG2E);
      m_run = m_new;
      const float mc = -m_new * LOG2E;
      float ps = 0.f;
#pragma unroll
      for (int i = 0; i < 16; ++i) { const float p = s0[i] > -1e29f ? __builtin_amdgcn_exp2f(fmaf(s0[i], LOG2E, mc)) : 0.f; s0[i] = p; ps += p; }
#pragma unroll
      for (int i = 0; i < 16; ++i) { const float p = s1[i] > -1e29f ? __builtin_amdgcn_exp2f(fmaf(s1[i], LOG2E, mc)) : 0.f; s1[i] = p; ps += p; }
      l_run = l_run * alpha + ps;
      if (__any(alpha < 1.0f)) {
#pragma unroll
        for (int vb = 0; vb < 2; ++vb)
#pragma unroll
          for (int i = 0; i < 16; ++i) o[vb][i] *= alpha;
      }
      bf16x8 pf[2][2];
#pragma unroll
      for (int s = 0; s < 2; ++s) {
        u32x4 w0, w1;
        w0.x = cvt_pk_bf16(s0[8 * s + 0], s0[8 * s + 1]); w0.y = cvt_pk_bf16(s0[8 * s + 2], s0[8 * s + 3]); w0.z = cvt_pk_bf16(s0[8 * s + 4], s0[8 * s + 5]); w0.w = cvt_pk_bf16(s0[8 * s + 6], s0[8 * s + 7]);
        w1.x = cvt_pk_bf16(s1[8 * s + 0], s1[8 * s + 1]); w1.y = cvt_pk_bf16(s1[8 * s + 2], s1[8 * s + 3]); w1.z = cvt_pk_bf16(s1[8 * s + 4], s1[8 * s + 5]); w1.w = cvt_pk_bf16(s1[8 * s + 6], s1[8 * s + 7]);
        pf[0][s] = __builtin_bit_cast(bf16x8, w0); pf[1][s] = __builtin_bit_cast(bf16x8, w1);
      }
      const int cbase = local ? (span0 >> 3) : 0;
#pragma unroll
      for (int vb = 0; vb < 2; ++vb) {
        const LAS unsigned char* vrow = vb_ + (vb * 32 + r) * 128;
#pragma unroll
        for (int s = 0; s < 2; ++s) {
          const bf16x8 a = *(const LAS bf16x8*)(vrow + (((cbase + 2 * s + hi) ^ vx) << 4));
          o[vb] = __builtin_amdgcn_mfma_f32_32x32x16_bf16(a, pf[0][s], o[vb], 0, 0, 0);
        }
        if (!local) {
#pragma unroll
          for (int s = 0; s < 2; ++s) {
            const bf16x8 a = *(const LAS bf16x8*)(vrow + (((4 + 2 * s + hi) ^ vx) << 4));
            o[vb] = __builtin_amdgcn_mfma_f32_32x32x16_bf16(a, pf[1][s], o[vb], 0, 0, 0);
          }
        }
      }
    }
    if (more) NA_WRITE((t + 1) & 1);
    __syncthreads();
  }
#undef NA_LOAD
#undef NA_WRITE
  float l_tot; { const u32x2 sw = __builtin_amdgcn_permlane32_swap(__float_as_uint(l_run), __float_as_uint(l_run), false, false); l_tot = __uint_as_float(sw.x) + __uint_as_float(sw.y); }
  const float inv = 1.0f / l_tot;
  bf16_t* op = O + (size_t)qtok * 1024 + h * 64 + 4 * hi;
#pragma unroll
  for (int vb = 0; vb < 2; ++vb)
#pragma unroll
    for (int g = 0; g < 4; ++g) {
      u32x2 w; w.x = cvt_pk_bf16(o[vb][4 * g] * inv, o[vb][4 * g + 1] * inv); w.y = cvt_pk_bf16(o[vb][4 * g + 2] * inv, o[vb][4 * g + 3] * inv);
      *(u32x2*)(op + vb * 32 + 8 * g) = w;
    }
}
}

namespace rw {
using namespace mk;
constexpr int NSTEP = L + T, NCH = 32, CL = NSTEP / NCH;
constexpr int NCHAIN = 2 * B * 8;
constexpr float LOG2E = 1.4426950408889634f;
struct Bufs {
  u32x2* SH;
  unsigned* DR;
  bf16_t* G; int gstride;
  float* CS;
  float* PQ;
  float* SST;
  bf16_t* Y;
  bf16_t* Z;
};

constexpr int XPITCH = 528;
template <int KS> struct LoraW { bf16x8 w[KS][4]; };
template <int KS>
__device__ __forceinline__ void lora_load(const bf16_t* __restrict__ W, int h, int lane, LoraW<KS>& f) {
  const int fr = lane & 15, fq = lane >> 4;
#pragma unroll
  for (int ks = 0; ks < KS; ++ks)
#pragma unroll
    for (int nb = 0; nb < 4; ++nb) f.w[ks][nb] = *(const bf16x8*)(W + (size_t)(h * 64 + nb * 16 + fr) * (KS * 32) + ks * 32 + fq * 8);
}
template <int KS>
__device__ __forceinline__ void lora_mma(const LAS unsigned char* xb, int xcol0, const LoraW<KS>& f, int lane, LAS float* tw, float (&out)[16]) {
  const int fr = lane & 15, fq = lane >> 4;
  f32x4 acc[4];
#pragma unroll
  for (int nb = 0; nb < 4; ++nb) { float z = 0.f; asm volatile("" : "+v"(z)); acc[nb] = (f32x4){z, z, z, z}; }
#pragma unroll
  for (int ks = 0; ks < KS; ++ks) {
    const bf16x8 xf = *(const LAS bf16x8*)(xb + fr * XPITCH + (xcol0 + ks * 32 + fq * 8) * 2);
#pragma unroll
    for (int nb = 0; nb < 4; ++nb) acc[nb] = __builtin_amdgcn_mfma_f32_16x16x32_bf16(xf, f.w[ks][nb], acc[nb], 0, 0, 0);
  }
#pragma unroll
  for (int nb = 0; nb < 4; ++nb) *(LAS f32x4*)(tw + (nb * 16 + fr) * 16 + fq * 4) = acc[nb];
  __builtin_amdgcn_wave_barrier(); asm volatile("s_waitcnt lgkmcnt(0)" ::: "memory"); __builtin_amdgcn_wave_barrier();
#pragma unroll
  for (int q = 0; q < 4; ++q) { const f32x4 v = *(const LAS f32x4*)(tw + lane * 16 + q * 4); out[q * 4] = v[0]; out[q * 4 + 1] = v[1]; out[q * 4 + 2] = v[2]; out[q * 4 + 3] = v[3]; }
  __builtin_amdgcn_wave_barrier(); asm volatile("s_waitcnt lgkmcnt(0)" ::: "memory"); __builtin_amdgcn_wave_barrier();
}
__device__ __forceinline__ void prep_tile(const bf16_t* __restrict__ Prw, const float* __restrict__ cw, const float* __restrict__ w0, const bf16_t* __restrict__ WLT, const float* __restrict__ a0,
                                          const float* __restrict__ k_k, const float* __restrict__ k_a, const float* __restrict__ r_k,
                                          const Bufs& bf, int tile, LAS float* xs  ) {
  const int c = mk::otid(), lane = c & 63, h = c >> 6;
  const int row0 = tile * 16;
  int lo, hi;
  if (row0 < NLAT) { lo = (row0 / T) * T; hi = lo + T - 1; } else { lo = NLAT + ((row0 - NLAT) / L) * L; hi = lo + L - 1; }
  bf16_t rraw[18], kraw[18], vraw[18];
#pragma unroll
  for (int j = 0; j < 18; ++j) { int rr_ = row0 - 1 + j; rr_ = rr_ < lo ? lo : (rr_ > hi ? hi : rr_); const bf16_t* q = Prw + (size_t)rr_ * RW_IN + c; rraw[j] = q[0]; kraw[j] = q[512]; vraw[j] = q[1024]; }
  LoraW<2> wd0, wd1; LoraW<4> wg;
  lora_load<2>(WLT, h, lane, wd0); lora_load<2>(WLT + 32768, h, lane, wd1);
#define RW_CONV(dst, col) do { const float c0 = cw[(col)], c1 = cw[RW_IN + (col)], c2 = cw[2 * RW_IN + (col)]; const bf16_t* p = Prw + (col); \
    bf16_t raw[18]; \
    _Pragma("unroll") for (int j = 0; j < 18; ++j) { int rr = row0 - 1 + j; rr = rr < lo ? lo : (rr > hi ? hi : rr); raw[j] = p[(size_t)rr * RW_IN]; } \
    float pm = row0 > lo ? bf2f(raw[0]) : 0.f, pc = bf2f(raw[1]); \
    _Pragma("unroll") for (int tt = 0; tt < 16; ++tt) { const float pn = (row0 + tt + 1 <= hi) ? bf2f(raw[tt + 2]) : 0.f; dst[tt] = pm * c0 + pc * c1 + pn * c2; pm = pc; pc = pn; } } while (0)
  if (c < 256) {
    float xv[16]; RW_CONV(xv, 1536 + c);
#pragma unroll
    for (int tt = 0; tt < 16; ++tt) { float v = xv[tt]; if (c < 64) v = 2.0f * sigmoid_r(2.0f * v) - 1.0f; else if (c >= 128) v = sigmoid_r(v);     *(LAS bf16_t*)((LAS unsigned char*)xs + tt * XPITCH + c * 2) = f2bf(v); }
  }
  __syncthreads();
  const LAS unsigned char* xb = (const LAS unsigned char*)xs; LAS float* tw = xs + 20480 + h * 1024;
  const float w00 = w0[c], w01 = w0[512 + c], a00 = a0[c], a01 = a0[512 + c], kkc = k_k[c], kac = k_a[c], rkc = r_k[c];
  float e0[16], e1[16];
  {
    float aw0[16], aw1[16];
    lora_mma<2>(xb, 0, wd0, lane, tw, aw0); lora_mma<2>(xb, 0, wd1, lane, tw, aw1);
    lora_load<2>(WLT + 2 * 32768, h, lane, wd0); lora_load<2>(WLT + 3 * 32768, h, lane, wd1);
#pragma unroll
    for (int tt = 0; tt < 16; ++tt) {
      e0[tt] = 0.6065306597126334f * __builtin_amdgcn_rcpf(1.0f + __expf(-(w00 + aw0[tt])));
      e1[tt] = 0.6065306597126334f * __builtin_amdgcn_rcpf(1.0f + __expf(-(w01 + aw1[tt])));
    }
  }
  LAS float* asl = xs + 256 * 16;
  {
    float aa0[16], aa1[16];
    lora_mma<2>(xb, 64, wd0, lane, tw, aa0); lora_mma<2>(xb, 64, wd1, lane, tw, aa1);
    lora_load<4>(WLT + 4 * 32768, h, lane, wg);
#pragma unroll
    for (int tt = 0; tt < 16; ++tt) { const unsigned d0 = cvt_pk_bf16(e0[tt], sigmoid_r(a00 + aa0[tt])), d1 = cvt_pk_bf16(e1[tt], sigmoid_r(a01 + aa1[tt]));
      bf.DR[((size_t)(row0 + tt)) * 512 + c] = d0; bf.DR[((size_t)NTOK + row0 + tt) * 512 + c] = d1; asl[tt * 512 + c] = bfhi(d0); asl[(16 + tt) * 512 + c] = bfhi(d1); }
  }
  {
    float ag[16];
    lora_mma<4>(xb, 128, wg, lane, tw, ag);
#pragma unroll
    for (int tt = 0; tt < 16; ++tt) bf.G[(size_t)(row0 + tt) * bf.gstride + c] = f2bf(ag[tt]);
  }
#undef RW_CONV
  const float cr0 = cw[c], cr1 = cw[RW_IN + c], cr2 = cw[2 * RW_IN + c], ck0 = cw[512 + c], ck1 = cw[RW_IN + 512 + c], ck2 = cw[2 * RW_IN + 512 + c], cv0 = cw[1024 + c], cv1 = cw[RW_IN + 1024 + c], cv2 = cw[2 * RW_IN + 1024 + c];
  float rm = row0 > lo ? bf2f(rraw[0]) : 0.f, km = row0 > lo ? bf2f(kraw[0]) : 0.f, vm = row0 > lo ? bf2f(vraw[0]) : 0.f;
  float rc = bf2f(rraw[1]), kc = bf2f(kraw[1]), vc = bf2f(vraw[1]);
  float rvv[16], kvvv[16], vvvv[16], q1[16];
#pragma unroll
  for (int tt = 0; tt < 16; ++tt) {
    const bool has_n = row0 + tt + 1 <= hi;
    const float rn = has_n ? bf2f(rraw[tt + 2]) : 0.f, kn = has_n ? bf2f(kraw[tt + 2]) : 0.f, vn = has_n ? bf2f(vraw[tt + 2]) : 0.f;
    rvv[tt] = rm * cr0 + rc * cr1 + rn * cr2; kvvv[tt] = km * ck0 + kc * ck1 + kn * ck2; vvvv[tt] = vm * cv0 + vc * cv1 + vn * cv2;
    rm = rc; rc = rn; km = kc; kc = kn; vm = vc; vc = vn;
    const float kk = kvvv[tt] * kkc; q1[tt] = kk * kk;
  }
  const float nrm2 = reduce_scatter16(q1, lane);
  float c0p[16], c1p[16];
#pragma unroll
  for (int tt = 0; tt < 16; ++tt) {
    const int row = row0 + tt;
    const float nrm = sqrtf(__uint_as_float(__builtin_amdgcn_readlane(__float_as_uint(nrm2), 4 * tt)));
    const float kk = kvvv[tt] * kkc * __builtin_amdgcn_rcpf(fmaxf(nrm, 1e-12f));
    u32x2 sh; sh.x = cvt_pk_bf16(rvv[tt], kvvv[tt]); sh.y = cvt_pk_bf16(kk, vvvv[tt]);
    bf.SH[(size_t)row * 512 + c] = sh;
    const float rq = bflo(sh.x), kq = bfhi(sh.x);
    c0p[tt] = rq * kq * (1.0f + (asl[tt * 512 + c] - 1.0f) * kac) * rkc; c1p[tt] = rq * kq * (1.0f + (asl[(16 + tt) * 512 + c] - 1.0f) * kac) * rkc;
  }
  const float cb0 = reduce_scatter16(c0p, lane), cb1 = reduce_scatter16(c1p, lane);
  if ((lane & 3) == 0) { const int row = row0 + (lane >> 2); bf.CS[(size_t)row * 16 + h] = cb0; bf.CS[(size_t)row * 16 + 8 + h] = cb1; }
  __syncthreads();
}

struct StepRaw { u32x2 s; unsigned d; };
__device__ __forceinline__ int scan_row(int dir, int b, int p) {
  if (p < L) return NLAT + b * L + (dir ? (L - 1 - p) : p);
  const int q = p - L; return b * T + (dir ? (T - 1 - q) : q);
}
__device__ __forceinline__ void scan_unit(const Bufs& bf, const float* __restrict__ k_a, int chain, int chunk, LAS float* wl) {
  const int lane = mk::otid() & 63, r = lane & 31, hi = lane >> 5;
  const int dir = chain >> 5, b = (chain >> 3) & 3, h = chain & 7, ch = h * 64 + lane;
  const float kac = k_a[ch];
  f32x16 TS[2][2], TP[2][2];
#pragma unroll
  for (int rb = 0; rb < 2; ++rb)
#pragma unroll
    for (int cb = 0; cb < 2; ++cb)
#pragma unroll
      for (int q = 0; q < 16; ++q) { TS[rb][cb][q] = 0.f; TP[rb][cb][q] = (32 * rb + (q & 3) + 8 * (q >> 2) + 4 * hi == 32 * cb + r) ? 1.f : 0.f; }
  LAS unsigned char* wb = (LAS unsigned char*)wl;
  const LAS unsigned char* xrow = wb + (lane & 15) * 128 + 8 * hi;
  LAS float* Gl = wl + 1024;
  const int p0 = chunk * CL;
  float Dl = 1.f;
#define RW_FRAG(base, rb, s2) ([&]() { const u32x2 lo_ = *(const LAS u32x2*)((base) + (32 * (rb) + 16 * (s2)) * 2), hi_ = *(const LAS u32x2*)((base) + (32 * (rb) + 16 * (s2) + 8) * 2); \
      return __builtin_bit_cast(bf16x8, (u32x4){lo_.x, lo_.y, hi_.x, hi_.y}); }())
#define RW_DOTS(T, o) do { _Pragma("unroll") for (int cb = 0; cb < 2; ++cb) _Pragma("unroll") for (int q = 0; q < 16; ++q) o[cb][q] = 0.f; \
    _Pragma("unroll") for (int rb = 0; rb < 2; ++rb) _Pragma("unroll") for (int s2 = 0; s2 < 2; ++s2) _Pragma("unroll") for (int cb = 0; cb < 2; ++cb) { u32x4 w_; \
      w_.x = cvt_pk_bf16(T[rb][cb][8 * s2 + 0], T[rb][cb][8 * s2 + 1]); w_.y = cvt_pk_bf16(T[rb][cb][8 * s2 + 2], T[rb][cb][8 * s2 + 3]); \
      w_.z = cvt_pk_bf16(T[rb][cb][8 * s2 + 4], T[rb][cb][8 * s2 + 5]); w_.w = cvt_pk_bf16(T[rb][cb][8 * s2 + 6], T[rb][cb][8 * s2 + 7]); \
      o[cb] = __builtin_amdgcn_mfma_f32_32x32x16_bf16(xf[rb][s2], __builtin_bit_cast(bf16x8, w_), o[cb], 0, 0, 0); \
      asm volatile("" : "+v"(o[cb]) : "v"(w_), "v"(xf[rb][s2]));   } } while (0)
#define RW_RENORM() do { wl[1280 + lane] = Dl; __builtin_amdgcn_wave_barrier(); \
    _Pragma("unroll") for (int rb = 0; rb < 2; ++rb) _Pragma("unroll") for (int g = 0; g < 4; ++g) { const f32x4 w4 = *(const LAS f32x4*)(wl + 1280 + 32 * rb + 8 * g + 4 * hi); \
      _Pragma("unroll") for (int cb = 0; cb < 2; ++cb) _Pragma("unroll") for (int u = 0; u < 4; ++u) { TS[rb][cb][4 * g + u] *= w4[u]; TP[rb][cb][4 * g + u] *= w4[u]; } } \
    __builtin_amdgcn_wave_barrier(); Dl = 1.f; } while (0)
  const int wvs = __builtin_amdgcn_readfirstlane((int)((size_t)wl));
#define RW_FETCH(tb) do { _Pragma("unroll") for (int u = 0; u < 8; ++u) { const int pn = (tb) + u < CL ? (tb) + u : CL - 1; const int row = scan_row(dir, b, p0 + pn); \
      const unsigned* gs = (const unsigned*)(bf.SH + (size_t)row * 512 + ch); const unsigned* gd = bf.DR + ((size_t)dir * NTOK + row) * 512 + ch; LAS unsigned* ld = (LAS unsigned*)(size_t)(wvs + 8192 + u * 768); \
      __builtin_amdgcn_global_load_lds(gs, ld, 4, 0, 0); __builtin_amdgcn_global_load_lds(gs + 1, ld + 64, 4, 0, 0); __builtin_amdgcn_global_load_lds(gd, ld + 128, 4, 0, 0); } } while (0)
  RW_FETCH(0);
  for (int t0 = 0; t0 < CL; t0 += 8) {
    asm volatile("s_waitcnt vmcnt(0)" ::: "memory");
    __builtin_amdgcn_wave_barrier();
#pragma unroll
    for (int u = 0; u < 8; ++u) {
      const LAS unsigned* ld = (const LAS unsigned*)(wb + 8192 + u * 768) + lane; const unsigned sx = ld[0], sy = ld[64], dd = ld[128];
      const float rr = bflo(sx), k = bfhi(sx), kk = bflo(sy), e = bflo(dd), asg = bfhi(dd);
      const float w = __builtin_amdgcn_exp2f(-e * LOG2E), keff = k * (1.0f + (asg - 1.0f) * kac);
      ((LAS bf16_t*)wb)[u * 64 + lane] = f2bf(-kk * Dl);
      Dl *= w; const float dinv = __builtin_amdgcn_rcpf(Dl);
      ((LAS bf16_t*)wb)[(8 + u) * 64 + lane] = f2bf(rr * Dl);
      ((LAS bf16_t*)wb)[1024 + u * 64 + lane] = f2bf(kk * asg * dinv); ((LAS bf16_t*)wb)[1024 + (8 + u) * 64 + lane] = f2bf(keff * dinv);
      ((LAS bf16_t*)wb)[3072 + u * 64 + lane] = (bf16_t)(sy >> 16);
    }
    asm volatile("s_waitcnt lgkmcnt(0)" ::: "memory");
    __builtin_amdgcn_wave_barrier();
    RW_FETCH(t0 + 8);
    __builtin_amdgcn_wave_barrier();
    bf16x8 xf[2][2];
#pragma unroll
    for (int rb = 0; rb < 2; ++rb)
#pragma unroll
      for (int s2 = 0; s2 < 2; ++s2) xf[rb][s2] = RW_FRAG(xrow, rb, s2);
    { f32x16 gm;
#pragma unroll
      for (int q = 0; q < 16; ++q) gm[q] = 0.f;
#pragma unroll
      for (int rb = 0; rb < 2; ++rb)
#pragma unroll
        for (int s2 = 0; s2 < 2; ++s2) { const bf16x8 yf = RW_FRAG(xrow + 2048, rb, s2); gm = __builtin_amdgcn_mfma_f32_32x32x16_bf16(xf[rb][s2], yf, gm, 0, 0, 0); asm volatile("" : "+v"(gm) : "v"(yf), "v"(xf[rb][s2])); }
      if (r < 16) {
#pragma unroll
        for (int q = 0; q < 8; ++q) Gl[((q & 3) + 8 * (q >> 2) + 4 * hi) * 16 + r] = gm[q]; }
    }
    float sa[2][8], yy[2][8];
    { f32x16 oS[2], oP[2];
      RW_DOTS(TS, oS); RW_DOTS(TP, oP);
#pragma unroll
      for (int cb = 0; cb < 2; ++cb)
#pragma unroll
        for (int q = 0; q < 4; ++q) {
          { const u32x2 sw = __builtin_amdgcn_permlane32_swap(__float_as_uint(oS[cb][q]), __float_as_uint(oP[cb][q]), false, false); sa[cb][q] = __uint_as_float(sw.x); sa[cb][4 + q] = __uint_as_float(sw.y); }
          { const u32x2 sw = __builtin_amdgcn_permlane32_swap(__float_as_uint(oS[cb][4 + q]), __float_as_uint(oP[cb][4 + q]), false, false); yy[cb][q] = __uint_as_float(sw.x); yy[cb][4 + q] = __uint_as_float(sw.y); } }
    }
    __builtin_amdgcn_wave_barrier();
    float vm[2][8];
#pragma unroll
    for (int u = 0; u < 8; ++u) { const LAS bf16_t* vr = (const LAS bf16_t*)wb + 3072 + u * 64 + r; vm[0][u] = hi ? 0.f : bf2f(vr[0]); vm[1][u] = hi ? 0.f : bf2f(vr[32]); }
#pragma unroll
    for (int s = 0; s < 8; ++s) {
      const f32x4 ga0 = *(const LAS f32x4*)(Gl + s * 16), ga1 = *(const LAS f32x4*)(Gl + s * 16 + 4), ga2 = *(const LAS f32x4*)(Gl + s * 16 + 8), ga3 = *(const LAS f32x4*)(Gl + s * 16 + 12);
      const f32x4 gr0 = *(const LAS f32x4*)(Gl + (8 + s) * 16), gr1 = *(const LAS f32x4*)(Gl + (8 + s) * 16 + 4), gr2 = *(const LAS f32x4*)(Gl + (8 + s) * 16 + 8), gr3 = *(const LAS f32x4*)(Gl + (8 + s) * 16 + 12);
      const float gab[8] = {ga0[0], ga0[1], ga0[2], ga0[3], ga1[0], ga1[1], ga1[2], ga1[3]}, gak[8] = {ga2[0], ga2[1], ga2[2], ga2[3], ga3[0], ga3[1], ga3[2], ga3[3]};
      const float grb[8] = {gr0[0], gr0[1], gr0[2], gr0[3], gr1[0], gr1[1], gr1[2], gr1[3]}, grk[8] = {gr2[0], gr2[1], gr2[2], gr2[3], gr3[0], gr3[1], gr3[2], gr3[3]};
#pragma unroll
      for (int cb = 0; cb < 2; ++cb) {
        float x = sa[cb][s], y = yy[cb][s];
#pragma unroll
        for (int u = 0; u < 8; ++u) { if (u < s) { x = fmaf(gab[u], sa[cb][u], x); x = fmaf(gak[u], vm[cb][u], x); } }
        sa[cb][s] = x;
#pragma unroll
        for (int u = 0; u < 8; ++u) { if (u <= s) { y = fmaf(grb[u], sa[cb][u], y); y = fmaf(grk[u], vm[cb][u], y); } }
        yy[cb][s] = y;
      }
    }
    { bf16_t* yz = hi ? bf.Z : bf.Y;
#pragma unroll
      for (int s = 0; s < 8; ++s) { const size_t oi = ((size_t)dir * NTOK + scan_row(dir, b, p0 + t0 + s)) * 512 + h * 64 + r; yz[oi] = f2bf(yy[0][s]); yz[oi + 32] = f2bf(yy[1][s]); } }
    { bf16x8 au[2], buS[2], buP[2];
      u32x4 a0, a1, s0, s1, p0_, p1_;
#pragma unroll
      for (int q = 0; q < 4; ++q) {
        const int u = 4 * hi + q;
        const LAS bf16_t* yb = (const LAS bf16_t*)wb + 1024 + u * 64 + r; const LAS bf16_t* vr = (const LAS bf16_t*)wb + 3072 + u * 64 + r;
        a0[q] = (unsigned)yb[0] | ((unsigned)yb[512] << 16); a1[q] = (unsigned)yb[32] | ((unsigned)yb[512 + 32] << 16);
        const u32x2 sw0 = __builtin_amdgcn_permlane32_swap(__float_as_uint(sa[0][q]), __float_as_uint(sa[0][4 + q]), false, false), sw1 = __builtin_amdgcn_permlane32_swap(__float_as_uint(sa[1][q]), __float_as_uint(sa[1][4 + q]), false, false);
        s0[q] = (cvt_pk_bf16(__uint_as_float(sw0.x), 0.f) & 0xffffu) | ((unsigned)vr[0] << 16); s1[q] = (cvt_pk_bf16(__uint_as_float(sw1.x), 0.f) & 0xffffu) | ((unsigned)vr[32] << 16);
        p0_[q] = cvt_pk_bf16(__uint_as_float(sw0.y), 0.f); p1_[q] = cvt_pk_bf16(__uint_as_float(sw1.y), 0.f); }
      au[0] = __builtin_bit_cast(bf16x8, a0); au[1] = __builtin_bit_cast(bf16x8, a1); buS[0] = __builtin_bit_cast(bf16x8, s0); buS[1] = __builtin_bit_cast(bf16x8, s1); buP[0] = __builtin_bit_cast(bf16x8, p0_); buP[1] = __builtin_bit_cast(bf16x8, p1_);
#pragma unroll
      for (int rb = 0; rb < 2; ++rb)
#pragma unroll
        for (int cb = 0; cb < 2; ++cb) { TS[rb][cb] = __builtin_amdgcn_mfma_f32_32x32x16_bf16(au[rb], buS[cb], TS[rb][cb], 0, 0, 0); TP[rb][cb] = __builtin_amdgcn_mfma_f32_32x32x16_bf16(au[rb], buP[cb], TP[rb][cb], 0, 0, 0); }
    }
    __builtin_amdgcn_wave_barrier();
    if ((t0 & 31) == 24) RW_RENORM();
  }
  RW_RENORM();
#undef RW_DOTS
#undef RW_FRAG
#undef RW_RENORM
#undef RW_FETCH
  asm volatile("s_waitcnt vmcnt(0)" ::: "memory");
  if (chunk < NCH - 1) {
    float* pq = bf.PQ + (((size_t)chain * (NCH - 1) + chunk) * 2) * 4096;
#pragma unroll
    for (int rb = 0; rb < 2; ++rb)
#pragma unroll
      for (int cb = 0; cb < 2; ++cb)
#pragma unroll
        for (int g = 0; g < 4; ++g) { float* q = pq + (size_t)(32 * cb + r) * 64 + 32 * rb + 8 * g + 4 * hi;
          *(f32x4*)q = (f32x4){TP[rb][cb][4 * g], TP[rb][cb][4 * g + 1], TP[rb][cb][4 * g + 2], TP[rb][cb][4 * g + 3]};
          *(f32x4*)(q + 4096) = (f32x4){TS[rb][cb][4 * g], TS[rb][cb][4 * g + 1], TS[rb][cb][4 * g + 2], TS[rb][cb][4 * g + 3]}; }
  }
}

__device__ __forceinline__ void propagate_chain(const Bufs& bf, int chain, int rq, LAS float* lds) {
  LAS float* Sl = lds; LAS float* Pl = lds + 16 * 65 + 15;
  Pl = lds + 1056;
  const int tid = mk::otid(), i = tid >> 5, jc = (tid & 31) * 2, row = rq * 16 + i, pi = tid >> 3, pj = (tid & 7) * 8;
  float* sst = bf.SST + (size_t)chain * NCH * 4096;
  Sl[i * 65 + jc] = 0.f; Sl[i * 65 + jc + 1] = 0.f;
  const float* pb = bf.PQ + ((size_t)chain * (NCH - 1) * 2) * 4096;
  f32x4 np0 = *(const f32x4*)(pb + pi * 64 + pj), np1 = *(const f32x4*)(pb + pi * 64 + pj + 4); f32x2 nq = *(const f32x2*)(pb + 4096 + row * 64 + jc);
  for (int c = 0; c < NCH - 1; ++c) {
    const f32x4 p0 = np0, p1 = np1; f32x2 q = nq;
    { const float* pn = pb + (size_t)(c + 1 < NCH - 1 ? c + 1 : c) * 2 * 4096;
      np0 = *(const f32x4*)(pn + pi * 64 + pj); np1 = *(const f32x4*)(pn + pi * 64 + pj + 4); nq = *(const f32x2*)(pn + 4096 + row * 64 + jc); }
    *(LAS f32x4*)(Pl + pi * 64 + pj) = p0; *(LAS f32x4*)(Pl + pi * 64 + pj + 4) = p1;
    __syncthreads();
#pragma unroll 16
    for (int k = 0; k < 64; ++k) { const float sv = Sl[i * 65 + k]; const f32x2 a = *(const LAS f32x2*)(Pl + k * 64 + jc); q += sv * a; }
    __syncthreads();
    Sl[i * 65 + jc] = q[0]; Sl[i * 65 + jc + 1] = q[1];
    *(f32x2*)(sst + (size_t)(c + 1) * 4096 + row * 64 + jc) = q;
  }
  __syncthreads();
}

__device__ __forceinline__ void corr_unit(const Bufs& bf, int chain, int chunk) {
  const int lane = mk::otid() & 63, r = lane & 31, hi = lane >> 5;
  const int dir = chain >> 5, b = (chain >> 3) & 3, h = chain & 7;
  const float* ss = bf.SST + ((size_t)chain * NCH + chunk) * 4096;
  bf16x8 bfr[2][4];
#pragma unroll
  for (int nt = 0; nt < 2; ++nt)
#pragma unroll
    for (int ks = 0; ks < 4; ++ks) { const float* q = ss + (size_t)(nt * 32 + r) * 64 + ks * 16 + hi * 8; const f32x4 x0 = *(const f32x4*)q, x1 = *(const f32x4*)(q + 4);
      u32x4 w; w.x = cvt_pk_bf16(x0[0], x0[1]); w.y = cvt_pk_bf16(x0[2], x0[3]); w.z = cvt_pk_bf16(x1[0], x1[1]); w.w = cvt_pk_bf16(x1[2], x1[3]); bfr[nt][ks] = __builtin_bit_cast(bf16x8, w); }
  const int p0 = chunk * CL;
  const size_t dbase = (size_t)dir * NTOK;
  for (int mt = 0; mt < (CL + 31) / 32; ++mt) {
    const int sa_ = min(mt * 32 + r, CL - 1);
    const bf16_t* zp = bf.Z + (dbase + scan_row(dir, b, p0 + sa_)) * 512 + h * 64 + hi * 8;
    bf16x8 af[4];
#pragma unroll
    for (int ks = 0; ks < 4; ++ks) af[ks] = *(const bf16x8*)(zp + ks * 16);
    bf16_t yo0[16], yo1[16];
#pragma unroll
    for (int i = 0; i < 16; ++i) { const int so = min(mt * 32 + (i & 3) + 8 * (i >> 2) + 4 * hi, CL - 1); const bf16_t* yp = bf.Y + (dbase + scan_row(dir, b, p0 + so)) * 512 + h * 64 + r; yo0[i] = yp[0]; yo1[i] = yp[32]; }
    f32x16 acc[2];
#pragma unroll
    for (int nt = 0; nt < 2; ++nt) { acc[nt] = zero16();
#pragma unroll
      for (int ks = 0; ks < 4; ++ks) acc[nt] = __builtin_amdgcn_mfma_f32_32x32x16_bf16(af[ks], bfr[nt][ks], acc[nt], 0, 0, 0); }
#pragma unroll
    for (int i = 0; i < 16; ++i) { const int so = mt * 32 + (i & 3) + 8 * (i >> 2) + 4 * hi;
      if (so < CL) { bf16_t* yp = bf.Y + (dbase + scan_row(dir, b, p0 + so)) * 512 + h * 64 + r;
        yp[0] = f2bf(bf2f(yo0[i]) + acc[0][i]); yp[32] = f2bf(bf2f(yo1[i]) + acc[1][i]); } }
  }
}

template <int NR> struct FinRaw { bf16_t y0[NR], y1[NR], g[NR]; unsigned v[NR]; float c0[NR], c1[NR]; };
template <int NR>
__device__ __forceinline__ void finish_load(const Bufs& bf, int row0, int c, int h, FinRaw<NR>& q) {
#pragma unroll
  for (int i = 0; i < NR; ++i) { const int row = row0 + i;
    q.y0[i] = bf.Y[(size_t)row * 512 + c]; q.y1[i] = bf.Y[((size_t)NTOK + row) * 512 + c];
    q.v[i] = bf.SH[(size_t)row * 512 + c].y; q.g[i] = bf.G[(size_t)row * bf.gstride + c];
    q.c0[i] = bf.CS[(size_t)row * 16 + h]; q.c1[i] = bf.CS[(size_t)row * 16 + 8 + h]; }
}
template <int NR>
__device__ __forceinline__ void finish_phase(const Bufs& bf, const float* __restrict__ gn_g, const float* __restrict__ gn_b, bf16_t* __restrict__ O) {
  const int c = mk::otid(), h = c >> 6, stride = gridDim.x * NR;
  const float gg = gn_g[c], gb = gn_b[c];
  int row0 = mk::obid() * NR;
  if (row0 >= NTOK) return;
  FinRaw<NR> cur, nxt; finish_load<NR>(bf, row0, c, h, cur);
  for (; row0 < NTOK; row0 += stride) {
    const int rn = row0 + stride < NTOK ? row0 + stride : row0;
    finish_load<NR>(bf, rn, c, h, nxt);
    float o[NR];
#pragma unroll
    for (int i = 0; i < NR; ++i) { const float y = bf2f(cur.y0[i]) + bf2f(cur.y1[i]);
      const float mu = wave_sum_u(y) * (1.0f / 64.0f); const float dv = y - mu; const float var = wave_sum_u(dv * dv) * (1.0f / 64.0f);
      o[i] = (dv * rsqrtf(var + 64e-5f) * gg + gb + (cur.c0[i] + cur.c1[i]) * bfhi(cur.v[i])) * bf2f(cur.g[i]); }
#pragma unroll
    for (int i = 0; i < NR; ++i) O[(size_t)(row0 + i) * 1024 + 512 + c] = f2bf(o[i]);
    cur = nxt;
  }
}
}

namespace mk {
constexpr size_t al256(size_t x) { return (x + 255) / 256 * 256; }
constexpr size_t WS_BAR = 0;
constexpr size_t WS_BCNT = al256(WS_BAR + (size_t)XCD_BAR_WORDS * 4);
constexpr size_t WS_MOFF = al256(WS_BCNT + (size_t)4 * 256 * 64 * 4);
constexpr size_t WS_KN = al256(WS_MOFF + 4 * 256);
constexpr size_t WS_MOD = al256(WS_KN + (size_t)2 * 256 * 32 * 4);
constexpr size_t WS_ROPE = al256(WS_MOD + (size_t)4 * 5 * 6144 * 4);
constexpr size_t WS_HBC = al256(WS_ROPE + 128 * 16 * 2 * 4);
constexpr size_t WS_EID = al256(WS_HBC + (size_t)NCTX * D * 2);
constexpr size_t WS_GATE = al256(WS_EID + (size_t)NTOK * 2 * 4);
constexpr size_t WS_POS = al256(WS_GATE + (size_t)NTOK * 2 * 4);
constexpr size_t WS_RL = al256(WS_POS + (size_t)NTOK * 2 * 4);
constexpr size_t WS_WEIN = al256(WS_RL + (size_t)MOE_ROWS * 4);
constexpr size_t WS_WOIN = al256(WS_WEIN + (size_t)2 * EVEN_IN * D * 2);
constexpr size_t WS_WEOUT = al256(WS_WOIN + (size_t)2 * ODD_IN * D * 2);
constexpr size_t WS_WOOUT = al256(WS_WEOUT + (size_t)2 * D * D * 2);
constexpr size_t WS_WGU = al256(WS_WOOUT + (size_t)2 * D * D * 2);
constexpr size_t WS_WDN = al256(WS_WGU + (size_t)NE * 1024 * D * 2);
constexpr size_t WS_WLT = al256(WS_WDN + (size_t)NE * D * DE * 2);
constexpr size_t WS_UO = al256(WS_WLT + (size_t)2 * 196608 * 2);
constexpr size_t WS_SCR = al256(WS_UO + (size_t)NTOK * D * 2);
constexpr size_t SE_PQK = 0;
constexpr size_t SE_VT = al256(SE_PQK + (size_t)NTOK * 1024 * 2);
constexpr size_t SE_PRW = al256(SE_VT + (size_t)512 * NTOK * 2);
constexpr size_t SE_PQ = 0;
constexpr size_t SE_SST = al256(SE_PQ + (size_t)rw::NCHAIN * (rw::NCH - 1) * 2 * 4096 * 4);
constexpr size_t SE_Y = al256(SE_SST + (size_t)rw::NCHAIN * rw::NCH * 4096 * 4);
constexpr size_t SE_Z = al256(SE_Y + (size_t)2 * NTOK * 512 * 2);
constexpr size_t SE_ZEND = al256(SE_Z + (size_t)2 * NTOK * 512 * 2);
constexpr size_t SE_PRWEND = al256(SE_PRW + (size_t)NTOK * RW_IN * 2);
constexpr size_t SE_SH = SE_PRWEND > SE_ZEND ? SE_PRWEND : SE_ZEND;
constexpr size_t SE_DR = al256(SE_SH + (size_t)NTOK * 512 * 8);
constexpr size_t SE_CS = al256(SE_DR + (size_t)2 * NTOK * 512 * 4);
constexpr size_t SE_END = al256(SE_CS + (size_t)2 * NTOK * 16 * 4);
constexpr size_t SE_YBUF = 0;
constexpr size_t SO_PQK = 0;
constexpr size_t SO_VT = al256(SO_PQK + (size_t)NTOK * 2048 * 2);
constexpr size_t SO_O12 = al256(SO_VT + (size_t)1024 * NTOK * 2);
constexpr size_t SO_END = al256(SO_O12 + (size_t)NTOK * 2048 * 2);
constexpr size_t SO_YBUF = 0;
constexpr size_t SM_XS = 0;
constexpr size_t SM_HE = al256(SM_XS + (size_t)MOE_ROWS * D * 2);
constexpr size_t SM_YS = al256(SM_HE + (size_t)MOE_ROWS * DE * 2);
constexpr size_t SM_END = al256(SM_YS + (size_t)MOE_ROWS * D * 2);
constexpr size_t SCR_BYTES = SE_END > SO_END ? (SE_END > SM_END ? SE_END : SM_END) : (SO_END > SM_END ? SO_END : SM_END);
constexpr size_t WS_END = WS_SCR + SCR_BYTES;
constexpr int LDS_BARW = 131072;
constexpr int LDS_MISC = 131072 + 64;

struct Params {
  const float *x, *c, *ctx, *c_ctx, *ada_w, *ada_b, *ln_g, *ln_b, *even_w_in, *even_w_out, *shift_w, *na_rpb, *rw_w0, *rw_w_up, *rw_a0, *rw_a_up, *rw_g_up, *rw_k_k, *rw_k_a, *rw_r_k,
      *rw_gn_g, *rw_gn_b, *odd_w_in, *odd_w_out, *da_lq1, *da_lk1, *da_lq2, *da_lk2, *da_subln_g, *router_w, *router_b, *exp_w_gate, *exp_w_up, *exp_w_down;
  float* out; unsigned char* ws; int ph_lo, ph_hi;
};
template <class Tp> __device__ __forceinline__ Tp* wsp(const Params& p, size_t off) { return (Tp*)(p.ws + off); }

__device__ __forceinline__ void ada_unit(const Params& p, int u, LAS float* lds) {
  LAS float* sc = lds; LAS float* red = lds + 5 * 1024;
  const int tid = mk::otid(), l = u / 96, n = (u % 96) * 64 + (tid & 63), kp = tid >> 6;
  for (int i = tid; i < 5 * 1024; i += NTHR) { const float v = i < 4096 ? p.c[i] : p.c_ctx[i - 4096]; sc[i] = siluf_(v); }
  __syncthreads();
  float a[5] = {0.f, 0.f, 0.f, 0.f, 0.f};
  const float* w = p.ada_w + ((size_t)l * D + kp * 128) * 6144 + n;
#pragma unroll 4
  for (int k = 0; k < 128; ++k) { const float wv = w[(size_t)k * 6144]; const int kk = kp * 128 + k;
#pragma unroll
    for (int r = 0; r < 5; ++r) a[r] = fmaf(sc[r * 1024 + kk], wv, a[r]); }
#pragma unroll
  for (int r = 0; r < 5; ++r) red[(kp * 5 + r) * 64 + (tid & 63)] = a[r];
  __syncthreads();
  if (tid < 320) { const int r = tid >> 6, nn = tid & 63; float s = 0.f;
#pragma unroll
    for (int q = 0; q < 8; ++q) s += red[(q * 5 + r) * 64 + nn];
    const int col = (u % 96) * 64 + nn;
    wsp<float>(p, WS_MOD)[((size_t)l * 5 + r) * 6144 + col] = s + p.ada_b[l * 6144 + col]; }
  __syncthreads();
}
__device__ __forceinline__ void phase_prologue(const Params& p, LAS unsigned char* lds) {
  const int bid = mk::obid(), nb = gridDim.x; LAS float* tile = (LAS float*)lds;
  int ub = 0;
  for (int i = 0; i < 2; ++i) ub += cvt_matrix(p.even_w_in + (size_t)i * D * EVEN_IN, EVEN_IN, D, EVEN_IN, wsp<bf16_t>(p, WS_WEIN) + (size_t)i * EVEN_IN * D, NMapId{0}, tile, ub, bid, nb);
  for (int i = 0; i < 2; ++i) ub += cvt_matrix(p.odd_w_in + (size_t)i * D * ODD_IN, ODD_IN, D, ODD_IN, wsp<bf16_t>(p, WS_WOIN) + (size_t)i * ODD_IN * D, NMapRope{}, tile, ub, bid, nb);
  for (int i = 0; i < 2; ++i) ub += cvt_matrix(p.even_w_out + (size_t)i * D * D, D, D, D, wsp<bf16_t>(p, WS_WEOUT) + (size_t)i * D * D, NMapId{0}, tile, ub, bid, nb);
  for (int i = 0; i < 2; ++i) ub += cvt_matrix(p.odd_w_out + (size_t)i * D * D, D, D, D, wsp<bf16_t>(p, WS_WOOUT) + (size_t)i * D * D, NMapId{0}, tile, ub, bid, nb);
  for (int i = 0; i < 2; ++i) { bf16_t* wl = wsp<bf16_t>(p, WS_WLT) + (size_t)i * 196608;
    for (int d = 0; d < 2; ++d) { ub += cvt_matrix(p.rw_w_up + (size_t)(i * 2 + d) * 64 * 512, 512, 64, 512, wl + (size_t)d * 32768, NMapId{0}, tile, ub, bid, nb);
      ub += cvt_matrix(p.rw_a_up + (size_t)(i * 2 + d) * 64 * 512, 512, 64, 512, wl + (size_t)(2 + d) * 32768, NMapId{0}, tile, ub, bid, nb); }
    ub += cvt_matrix(p.rw_g_up + (size_t)i * 128 * 512, 512, 128, 512, wl + (size_t)4 * 32768, NMapId{0}, tile, ub, bid, nb); }
  for (int u = (bid + nb - ub % nb) % nb; u < 384; u += nb) ada_unit(p, u, (LAS float*)lds);
  const int gt = bid * NTHR + mk::otid();
  if (gt < 128 * 16) { const int pos = gt >> 4, i = gt & 15; const float inv = exp2f(-(float)i * (13.287712379549449f / 16.0f)); float sn, cs; sincosf((float)pos * inv, &sn, &cs);
    wsp<float>(p, WS_ROPE)[gt * 2] = cs; wsp<float>(p, WS_ROPE)[gt * 2 + 1] = sn; }
}
#define CVT_JOB(u_, src_, dst_, ld_, K_, k0_, n0_, mode_) do { const int e_ = (u_) / 384, rem_ = (u_) % 384, v_ = rem_ & 127; mode_ = rem_ >> 7; const size_t so_ = ((size_t)l * NE + e_) * D * DE; \
    const bool dn_ = mode_ == 2; src_ = (dn_ ? wd_ : (mode_ == 0 ? wg_ : wu_)) + so_; ld_ = dn_ ? D : DE; K_ = dn_ ? DE : D; \
    k0_ = (dn_ ? (v_ >> 4) : (v_ >> 3)) * 64; n0_ = (dn_ ? (v_ & 15) : (v_ & 7)) * 64; dst_ = dn_ ? wsp<bf16_t>(p, WS_WDN) + (size_t)e_ * D * DE : wsp<bf16_t>(p, WS_WGU) + (size_t)e_ * 1024 * D; } while (0)
__device__ __forceinline__ void cvt_experts(const Params& p, int l, LAS float* tile, int b0) {
  const int bid = mk::obid() - b0, nb = (int)gridDim.x - b0, t = mk::otid();
  if (bid < 0) return;
  const float* wg_ = p.exp_w_gate; const float* wu_ = p.exp_w_up; const float* wd_ = p.exp_w_down; asm volatile("" : "+s"(wg_), "+s"(wu_), "+s"(wd_));
  constexpr int NJ = NE * 384;
  int u = bid;
  if (u >= NJ) return;
  const float* csrc; bf16_t* cdst; int cld, cK, ck0, cn0, cmode;
  CVT_JOB(u, csrc, cdst, cld, cK, ck0, cn0, cmode);
  const int lk = t >> 3, lc = (t & 7) * 8;
  f32x4 ra, rb; { const float* q = csrc + (size_t)(ck0 + lk) * cld + cn0 + lc; ra = *(const f32x4*)q; rb = *(const f32x4*)(q + 4); }
  for (; u < NJ; u += nb) {
    const int un = u + nb < NJ ? u + nb : u;
    const float* nsrc; bf16_t* ndst; int nld, nK, nk0, nn0, nmode;
    CVT_JOB(un, nsrc, ndst, nld, nK, nk0, nn0, nmode);
    f32x4 na, nbv; { const float* q = nsrc + (size_t)(nk0 + lk) * nld + nn0 + lc; na = *(const f32x4*)q; nbv = *(const f32x4*)(q + 4); }
    { LAS float* q = tile + lk * 65 + lc; q[0] = ra[0]; q[1] = ra[1]; q[2] = ra[2]; q[3] = ra[3]; q[4] = rb[0]; q[5] = rb[1]; q[6] = rb[2]; q[7] = rb[3]; }
    __syncthreads();
    { const int n = t >> 3, kc = (t & 7) * 8; const LAS float* q = tile + kc * 65 + n;
      u32x4 w; w.x = cvt_pk_bf16(q[0], q[65]); w.y = cvt_pk_bf16(q[130], q[195]); w.z = cvt_pk_bf16(q[260], q[325]); w.w = cvt_pk_bf16(q[390], q[455]);
      const int drow = cmode == 2 ? cn0 + n : 2 * (cn0 + n) + cmode;
      *(u32x4*)(cdst + (size_t)drow * cK + ck0 + kc) = w; }
    __syncthreads();
    csrc = nsrc; cdst = ndst; cld = nld; cK = nK; ck0 = nk0; cn0 = nn0; cmode = nmode; ra = na; rb = nbv;
  }
}
#undef CVT_JOB

__device__ __forceinline__ bf16_t* hb_ptr(const Params& p, int row, bool alt) {
  if (alt) return wsp<bf16_t>(p, WS_SCR + SM_END) + (size_t)row * D;
  return row < NLAT ? (bf16_t*)p.out + (size_t)row * D : wsp<bf16_t>(p, WS_HBC) + (size_t)(row - NLAT) * D;
}
__device__ __forceinline__ const float* h0_ptr(const Params& p, int row) { return row < NLAT ? p.x + (size_t)row * D : p.ctx + (size_t)(row - NLAT) * D; }
__device__ __forceinline__ void store_bf16x4(bf16_t* dst, f32x4 v) { u32x2 w; w.x = cvt_pk_bf16(v[0], v[1]); w.y = cvt_pk_bf16(v[2], v[3]); *(u32x2*)dst = w; }
__device__ __forceinline__ f32x4 load_bf16x4(const bf16_t* src) { const u32x2 w = *(const u32x2*)src; return (f32x4){bflo(w.x), bfhi(w.x), bflo(w.y), bfhi(w.y)}; }

__device__ __forceinline__ void phase_mod0(const Params& p) {
  const int lane = mk::otid() & 63, wid = mk::otid() >> 6;
  bf16_t* U = wsp<bf16_t>(p, WS_UO);
  for (int row = mk::obid() * 8 + wid; row < NTOK; row += gridDim.x * 8) {
    const float* h = h0_ptr(p, row); const float* modl = wsp<float>(p, WS_MOD) + (size_t)bidx_of_row(row) * 6144;
#pragma unroll
    for (int q = 0; q < 4; ++q) { const int col = q * 256 + lane * 4; const f32x4 hv = *(const f32x4*)(h + col), sh = *(const f32x4*)(modl + col), sc = *(const f32x4*)(modl + 1024 + col);
      store_bf16x4(U + (size_t)row * D + col, hv * (1.0f + sc) + sh); }
  }
}
__device__ __forceinline__ void ln_row(f32x4 (&v)[4], const float* __restrict__ g, const float* __restrict__ b, int lane) {
  float s = 0.f;
#pragma unroll
  for (int q = 0; q < 4; ++q) s += (v[q][0] + v[q][1]) + (v[q][2] + v[q][3]);
  const float mu = wave_sum_u(s) * (1.0f / D);
  float qq = 0.f;
#pragma unroll
  for (int q = 0; q < 4; ++q) { const f32x4 d = v[q] - mu; qq += (d[0] * d[0] + d[1] * d[1]) + (d[2] * d[2] + d[3] * d[3]); }
  const float rstd = rsqrtf(wave_sum_u(qq) * (1.0f / D) + LN_EPS);
#pragma unroll
  for (int q = 0; q < 4; ++q) { const int col = q * 256 + lane * 4; v[q] = (v[q] - mu) * rstd * *(const f32x4*)(g + col) + *(const f32x4*)(b + col); }
}
template <bool F32IN> struct Ln1Raw;
template <> struct Ln1Raw<true> { f32x4 h[4]; u32x2 y[4]; };
template <> struct Ln1Raw<false> { u32x2 h[4]; u32x2 y[4]; };
__device__ __forceinline__ f32x4 h_as_f32(f32x4 v) { return v; }
__device__ __forceinline__ f32x4 h_as_f32(u32x2 w) { return (f32x4){bflo(w.x), bfhi(w.x), bflo(w.y), bfhi(w.y)}; }
template <bool F32IN>
__device__ __forceinline__ void ln1_load(const Params& p, const bf16_t* __restrict__ Ybuf, int row, int lane, Ln1Raw<F32IN>& r) {
#pragma unroll
  for (int q = 0; q < 4; ++q) { const int col = q * 256 + lane * 4;
    if constexpr (F32IN) r.h[q] = *(const f32x4*)(h0_ptr(p, row) + col); else r.h[q] = *(const u32x2*)(hb_ptr(p, row, false) + col);
    r.y[q] = *(const u32x2*)(Ybuf + (size_t)row * D + col); }
}
template <bool F32IN>
__device__ __forceinline__ void ln1_row(const Params& p, int l, int row, int lane, const Ln1Raw<F32IN>& raw, const LAS float* rwl, LAS int* lcnt, float rbias  , bool redir) {
  bf16_t* U2 = wsp<bf16_t>(p, WS_UO); int* eid = wsp<int>(p, WS_EID); float* gatev = wsp<float>(p, WS_GATE);
  const float* lg = p.ln_g + (size_t)(l * 2) * D; const float* lb = p.ln_b + (size_t)(l * 2) * D;
  bf16_t* ho = redir ? wsp<bf16_t>(p, WS_SCR + SM_YS) + (size_t)row * D : hb_ptr(p, row, l == DEPTH - 1); const float* modl = wsp<float>(p, WS_MOD) + ((size_t)l * 5 + bidx_of_row(row)) * 6144;
  f32x4 v[4];
#pragma unroll
  for (int q = 0; q < 4; ++q) { const int col = q * 256 + lane * 4; const f32x4 yv = (f32x4){bflo(raw.y[q].x), bfhi(raw.y[q].x), bflo(raw.y[q].y), bfhi(raw.y[q].y)};
    v[q] = ALPHA * h_as_f32(raw.h[q]) + *(const f32x4*)(modl + 2 * 1024 + col) * yv; }
  ln_row(v, lg, lb, lane);
  float acc[16];
#pragma unroll
  for (int e = 0; e < 16; ++e) acc[e] = 0.f;
#pragma unroll
  for (int q = 0; q < 4; ++q) { const int col = q * 256 + lane * 4;
    store_bf16x4(ho + col, v[q]);
    const f32x4 u = v[q] * (1.0f + *(const f32x4*)(modl + 4 * 1024 + col)) + *(const f32x4*)(modl + 3 * 1024 + col);
    store_bf16x4(U2 + (size_t)row * D + col, u);
#pragma unroll
    for (int e = 0; e < 16; ++e) { const f32x4 w = *(const LAS f32x4*)(rwl + ((q * 16 + e) * 64 + lane) * 4); acc[e] += (u[0] * w[0] + u[1] * w[1]) + (u[2] * w[2] + u[3] * w[3]); }
  }
  float t8[8], t4[4], t2[2];
#pragma unroll
  for (int i = 0; i < 8; ++i) { const u32x2 sw = __builtin_amdgcn_permlane32_swap(__float_as_uint(acc[i]), __float_as_uint(acc[8 + i]), false, false); t8[i] = __uint_as_float(sw.x) + __uint_as_float(sw.y); }
#pragma unroll
  for (int i = 0; i < 4; ++i) { const u32x2 sw = __builtin_amdgcn_permlane16_swap(__float_as_uint(t8[i]), __float_as_uint(t8[4 + i]), false, false); t4[i] = __uint_as_float(sw.x) + __uint_as_float(sw.y); }
  const bool b3 = (lane & 8) != 0, b2_ = (lane & 4) != 0;
#pragma unroll
  for (int i = 0; i < 2; ++i) { const float keep = b3 ? t4[2 + i] : t4[i], send = b3 ? t4[i] : t4[2 + i]; t2[i] = keep + dpp_mov<0x128, 0xf, 0xf>(send, send); }
  float logit;
  { const float keep = b2_ ? t2[1] : t2[0], send = b2_ ? t2[0] : t2[1];
    float recv = dpp_mov<0x104, 0xf, 0x5>(send, send);
    recv = dpp_mov<0x114, 0xf, 0xa>(recv, send);
    logit = keep + recv; }
  logit += dpp_mov<0xB1, 0xf, 0xf>(logit, logit); logit += dpp_mov<0x4E, 0xf, 0xf>(logit, logit);
  const float sg = 1.0f / (1.0f + expf(-logit)), sl = sg + rbias;
  float gs;
  { const float a = sl, b2 = dpp_mov<0x124, 0xf, 0xf>(sl, sl), c = dpp_mov<0x128, 0xf, 0xf>(sl, sl), d = dpp_mov<0x12C, 0xf, 0xf>(sl, sl);
    const float lo1 = fminf(a, b2), hi1 = fmaxf(a, b2), lo2 = fminf(c, d), hi2 = fmaxf(c, d);
    gs = fmaxf(hi1, hi2) + fmaxf(fminf(hi1, hi2), fmaxf(lo1, lo2)); }
  float best = -1e30f; int grp = 0;
#pragma unroll
  for (int gI = 0; gI < 4; ++gI) { const float g = __uint_as_float(__builtin_amdgcn_readlane(__float_as_uint(gs), gI * 16)); if (g > best) { best = g; grp = gI; } }
  grp = __builtin_amdgcn_readfirstlane(grp);
  const float v0 = __uint_as_float(__builtin_amdgcn_readlane(__float_as_uint(sl), grp * 16)), v1 = __uint_as_float(__builtin_amdgcn_readlane(__float_as_uint(sl), grp * 16 + 4)),
              v2 = __uint_as_float(__builtin_amdgcn_readlane(__float_as_uint(sl), grp * 16 + 8)), v3 = __uint_as_float(__builtin_amdgcn_readlane(__float_as_uint(sl), grp * 16 + 12));
  const float s0 = __uint_as_float(__builtin_amdgcn_readlane(__float_as_uint(sg), grp * 16)), s1 = __uint_as_float(__builtin_amdgcn_readlane(__float_as_uint(sg), grp * 16 + 4)),
              s2 = __uint_as_float(__builtin_amdgcn_readlane(__float_as_uint(sg), grp * 16 + 8)), s3 = __uint_as_float(__builtin_amdgcn_readlane(__float_as_uint(sg), grp * 16 + 12));
  int i1 = 0; float b1 = v0; if (v1 > b1) { b1 = v1; i1 = 1; } if (v2 > b1) { b1 = v2; i1 = 2; } if (v3 > b1) { b1 = v3; i1 = 3; }
  int i2 = -1; float bb = -1e30f;
  if (i1 != 0 && v0 > bb) { bb = v0; i2 = 0; } if (i1 != 1 && v1 > bb) { bb = v1; i2 = 1; } if (i1 != 2 && v2 > bb) { bb = v2; i2 = 2; } if (i1 != 3 && v3 > bb) { bb = v3; i2 = 3; }
  const float g1 = i1 == 0 ? s0 : i1 == 1 ? s1 : i1 == 2 ? s2 : s3; const float g2 = i2 == 0 ? s0 : i2 == 1 ? s1 : i2 == 2 ? s2 : s3;
  if (lane == 0) { const int e1 = grp * 4 + i1, e2 = grp * 4 + i2;
    eid[row * 2] = e1; eid[row * 2 + 1] = e2; gatev[row * 2] = g1 / (g1 + g2); gatev[row * 2 + 1] = g2 / (g1 + g2);
    __hip_atomic_fetch_add(lcnt + e1, 1, __ATOMIC_RELAXED, __HIP_MEMORY_SCOPE_WORKGROUP); __hip_atomic_fetch_add(lcnt + e2, 1, __ATOMIC_RELAXED, __HIP_MEMORY_SCOPE_WORKGROUP); }
}
template <bool F32IN>
__device__ __forceinline__ void phase_ln1(const Params& p, int l, const bf16_t* __restrict__ Ybuf, LAS unsigned char* lds, bool dry) {
  const int tid = mk::otid(), lane = tid & 63, wid = tid >> 6, bid = mk::obid();
  const bool last = l == DEPTH - 1; const int ntok = last ? NLAT : NTOK;
  LAS float* rwl = (LAS float*)lds; LAS int* lcnt = (LAS int*)(lds + 65536);
  { float rv[32];
#pragma unroll
    for (int i = 0; i < 32; ++i) rv[i] = p.router_w[tid + i * NTHR];
#pragma unroll
    for (int i = 0; i < 32; ++i) { const int idx = tid + i * NTHR, d = idx >> 4, e = idx & 15; rwl[(((d >> 8) * 16 + e) * 64 + ((d >> 2) & 63)) * 4 + (d & 3)] = rv[i]; } }
  if (tid < 16) lcnt[tid] = 0;
  __syncthreads();
  const int stride = gridDim.x * 8, row0 = bid * 8 + wid;
  const float rbias = p.router_b[lane >> 2];
  if (row0 < ntok) {
    Ln1Raw<F32IN> cur, nxt; ln1_load<F32IN>(p, Ybuf, row0, lane, cur);
    for (int row = row0; row < ntok; row += stride) {
      const int rn = row + stride < ntok ? row + stride : row;
      ln1_load<F32IN>(p, Ybuf, rn, lane, nxt);
      ln1_row<F32IN>(p, l, row, lane, cur, rwl, lcnt, rbias, dry);
      cur = nxt;
    }
  }
  __syncthreads();
  if (tid < 16) wsp<int>(p, WS_BCNT)[((size_t)l * 256 + bid) * 64 + tid] = lcnt[tid];
  __syncthreads();
}
__device__ __forceinline__ void phase_scatter(const Params& p, int l, LAS unsigned char* lds) {
  const int tid = mk::otid(), bid = mk::obid(), nb = gridDim.x;
  const bool last = l == DEPTH - 1; const int ntok = last ? NLAT : NTOK;
  LAS int* tot = (LAS int*)lds; LAS int* pre = tot + 16; LAS int* base = tot + 32; LAS int* lcur = tot + 48; LAS int* offs = tot + 64; LAS int* cnts = tot + 128;
  const int* bc = wsp<int>(p, WS_BCNT) + (size_t)l * 256 * 64;
  for (int b2 = tid; b2 < nb; b2 += NTHR) { const u32x4 c0 = *(const u32x4*)(bc + b2 * 64), c1 = *(const u32x4*)(bc + b2 * 64 + 4), c2 = *(const u32x4*)(bc + b2 * 64 + 8), c3 = *(const u32x4*)(bc + b2 * 64 + 12);
    *(LAS u32x4*)(cnts + b2 * 16) = c0; *(LAS u32x4*)(cnts + b2 * 16 + 4) = c1; *(LAS u32x4*)(cnts + b2 * 16 + 8) = c2; *(LAS u32x4*)(cnts + b2 * 16 + 12) = c3; }
  __syncthreads();
  if (tid < 16) { int t = 0, pr = 0; for (int b2 = 0; b2 < nb; ++b2) { const int v = cnts[b2 * 16 + tid]; pr += b2 < bid ? v : 0; t += v; } tot[tid] = t; pre[tid] = pr; lcur[tid] = 0; }
  __syncthreads();
  if (tid == 0) { int o = 0; int* mo = wsp<int>(p, WS_MOFF) + l * 64; for (int e = 0; e < 16; ++e) { offs[e] = o; base[e] = o + pre[e]; if (bid == 0) mo[e] = o; o += (tot[e] + 255) / 256 * 256; } offs[16] = o; if (bid == 0) mo[16] = o; }
  __syncthreads();
  const int* eid = wsp<int>(p, WS_EID); int* pos = wsp<int>(p, WS_POS); int* rl = wsp<int>(p, WS_RL);
  for (int n = tid; ; n += NTHR) { const int row = bid * 8 + (n & 7) + (n >> 3) * nb * 8; if (row >= ntok) break;
    const int e1 = eid[row * 2], e2 = eid[row * 2 + 1];
    const int p1 = base[e1] + __hip_atomic_fetch_add(lcur + e1, 1, __ATOMIC_RELAXED, __HIP_MEMORY_SCOPE_WORKGROUP), p2 = base[e2] + __hip_atomic_fetch_add(lcur + e2, 1, __ATOMIC_RELAXED, __HIP_MEMORY_SCOPE_WORKGROUP);
    pos[row * 2] = p1; pos[row * 2 + 1] = p2; rl[p1] = row; rl[p2] = row; }
  if (bid == 0) for (int e = 0; e < 16; ++e) for (int q = offs[e] + tot[e] + tid; q < offs[e + 1]; q += NTHR) rl[q] = 0;
}
struct Ln2Raw { u32x4 h[2], y1[2], y2[2]; };
__device__ __forceinline__ void ln2_load(const Params& p, bool last, int row, int lane, int p1, int p2, Ln2Raw& r) {
  const bf16_t* Ys = wsp<bf16_t>(p, WS_SCR + SM_YS); const bf16_t* ho = hb_ptr(p, row, last);
#pragma unroll
  for (int q = 0; q < 2; ++q) { const int col = q * 512 + lane * 8; r.h[q] = *(const u32x4*)(ho + col); r.y1[q] = *(const u32x4*)(Ys + (size_t)p1 * D + col); r.y2[q] = *(const u32x4*)(Ys + (size_t)p2 * D + col); }
}
__device__ __forceinline__ void unpack8(const u32x4 w, float (&o)[8]) { o[0] = bflo(w.x); o[1] = bfhi(w.x); o[2] = bflo(w.y); o[3] = bfhi(w.y); o[4] = bflo(w.z); o[5] = bfhi(w.z); o[6] = bflo(w.w); o[7] = bfhi(w.w); }
__device__ __forceinline__ void load8f(const float* q, float (&o)[8]) { const f32x4 a = *(const f32x4*)q, b = *(const f32x4*)(q + 4); o[0] = a[0]; o[1] = a[1]; o[2] = a[2]; o[3] = a[3]; o[4] = b[0]; o[5] = b[1]; o[6] = b[2]; o[7] = b[3]; }
__device__ __forceinline__ u32x4 pack8(const float (&v)[8]) { u32x4 w; w.x = cvt_pk_bf16(v[0], v[1]); w.y = cvt_pk_bf16(v[2], v[3]); w.z = cvt_pk_bf16(v[4], v[5]); w.w = cvt_pk_bf16(v[6], v[7]); return w; }
__device__ __forceinline__ void phase_ln2(const Params& p, int l, bool dry) {
  const int tid = mk::otid(), lane = tid & 63, wid = tid >> 6;
  const bool last = l == DEPTH - 1; const int ntok = last ? NLAT : NTOK;
  const int* pos = wsp<int>(p, WS_POS); const float* gatev = wsp<float>(p, WS_GATE); bf16_t* U = wsp<bf16_t>(p, WS_UO);
  const float* lg = p.ln_g + (size_t)(l * 2 + 1) * D; const float* lb = p.ln_b + (size_t)(l * 2 + 1) * D;
  const int stride = gridDim.x * 8, row0 = mk::obid() * 8 + wid;
  if (row0 >= ntok) return;
  auto clampr = [&](int r) { return r < ntok ? r : row0; };
  u32x2 pc = *(const u32x2*)(pos + 2 * row0); f32x2 gc = *(const f32x2*)(gatev + 2 * row0);
  Ln2Raw cur, nxt; ln2_load(p, last, row0, lane, (int)pc.x, (int)pc.y, cur);
  int r1 = clampr(row0 + stride);
  u32x2 pn = *(const u32x2*)(pos + 2 * r1); f32x2 gn = *(const f32x2*)(gatev + 2 * r1);
  for (int row = row0; row < ntok; row += stride) {
    ln2_load(p, last, r1, lane, (int)pn.x, (int)pn.y, nxt);
    const int r2 = clampr(row + 2 * stride);
    const u32x2 pn2 = *(const u32x2*)(pos + 2 * r2); const f32x2 gn2 = *(const f32x2*)(gatev + 2 * r2);
    bf16_t* hb = dry ? wsp<bf16_t>(p, WS_SCR + SM_XS) + (size_t)row * D : hb_ptr(p, row, false); float* hf = (dry ? wsp<float>(p, WS_SCR + SM_XS) : p.out) + (size_t)row * D; const int bi = bidx_of_row(row);
    const float* modl = wsp<float>(p, WS_MOD) + ((size_t)l * 5 + bi) * 6144;
    float v[2][8]; float s1 = 0.f;
#pragma unroll
    for (int q = 0; q < 2; ++q) { const int col = q * 512 + lane * 8; float hh[8], a1[8], a2[8], g2[8];
      unpack8(cur.h[q], hh); unpack8(cur.y1[q], a1); unpack8(cur.y2[q], a2); load8f(modl + 5 * 1024 + col, g2);
#pragma unroll
      for (int e = 0; e < 8; ++e) { v[q][e] = ALPHA * hh[e] + g2[e] * (gc[0] * a1[e] + gc[1] * a2[e]); s1 += v[q][e]; } }
    const float mu = wave_sum_u(s1) * (1.0f / D);
    float s2 = 0.f;
#pragma unroll
    for (int q = 0; q < 2; ++q)
#pragma unroll
      for (int e = 0; e < 8; ++e) { const float d = v[q][e] - mu; s2 += d * d; }
    const float rstd = rsqrtf(wave_sum_u(s2) * (1.0f / D) + LN_EPS);
    const float* modn = wsp<float>(p, WS_MOD) + ((size_t)(last ? l : l + 1) * 5 + bi) * 6144;
#pragma unroll
    for (int q = 0; q < 2; ++q) { const int col = q * 512 + lane * 8; float gg[8], bb[8];
      load8f(lg + col, gg); load8f(lb + col, bb);
#pragma unroll
      for (int e = 0; e < 8; ++e) v[q][e] = (v[q][e] - mu) * rstd * gg[e] + bb[e];
      if (last) { *(f32x4*)(hf + col) = (f32x4){v[q][0], v[q][1], v[q][2], v[q][3]}; *(f32x4*)(hf + col + 4) = (f32x4){v[q][4], v[q][5], v[q][6], v[q][7]}; }
      else { *(u32x4*)(hb + col) = pack8(v[q]); float sc[8], sh[8], u[8]; load8f(modn + 1024 + col, sc); load8f(modn + col, sh);
#pragma unroll
        for (int e = 0; e < 8; ++e) u[e] = v[q][e] * (1.0f + sc[e]) + sh[e];
        *(u32x4*)(U + (size_t)row * D + col) = pack8(u); } }
    cur = nxt; gc = gn; pn = pn2; gn = gn2; r1 = r2;
  }
}

struct SchedEvenIn { static constexpr bool GATHER = false; const bf16_t* U; const bf16_t* W; bf16_t* Pqk; bf16_t* Prw; bf16_t* Vt; int G, c;
  __device__ __forceinline__ bool next(int i, pg8::Unit& u) const { const int Lx = i * G + c; u.kind = 0;
    if (Lx < 1452) { const int grp = Lx / 44, rem = Lx % 44, pm = grp * 4 + (rem & 3), pi = rem >> 2; u.pm = pm; u.pn = pi;
      u.A = (const char*)(U + (size_t)pm * 256 * D); const int brow = pi < 4 ? pi * 256 : 1536 + (pi - 4) * 256; u.Bt = (const char*)(W + (size_t)brow * D);
      if (pi < 4) { u.out = Pqk; u.ldo = 1024; u.x1 = pi * 256; } else { u.out = Prw; u.ldo = RW_IN; u.x1 = (pi - 4) * 256; } u.x0 = pm * 256; return true; }
    if (Lx < 1452 + 264) { const int v = Lx - 1452, pmv = v & 1, pnv = v >> 1; u.pm = pmv; u.pn = pnv; u.A = (const char*)(W + (size_t)(1024 + pmv * 256) * D); u.Bt = (const char*)(U + (size_t)pnv * 256 * D);
      u.out = Vt; u.ldo = NTOK; u.x0 = pmv * 256; u.x1 = pnv * 256; return true; }
    return false; } };
struct SchedOddIn { static constexpr bool GATHER = false; const bf16_t* U; const bf16_t* W; bf16_t* Pqk; bf16_t* Vt; int G, c;
  __device__ __forceinline__ bool next(int i, pg8::Unit& u) const { const int Lx = i * G + c;
    if (Lx < 1056) { const int grp = Lx / 32, rem = Lx % 32, pm = grp * 4 + (rem & 3), pi = rem >> 2; u.pm = pm; u.pn = pi; u.kind = pm < 128 ? 1 : 0;
      u.A = (const char*)(U + (size_t)pm * 256 * D); u.Bt = (const char*)(W + (size_t)pi * 256 * D); u.out = Pqk; u.ldo = 2048; u.x0 = pm * 256; u.x1 = pi * 256; return true; }
    if (Lx < 1056 + 528) { const int v = Lx - 1056, pmv = v & 3, pnv = v >> 2; u.pm = pmv; u.pn = pnv; u.kind = 0; u.A = (const char*)(W + (size_t)(2048 + pmv * 256) * D); u.Bt = (const char*)(U + (size_t)pnv * 256 * D);
      u.out = Vt; u.ldo = NTOK; u.x0 = pmv * 256; u.x1 = pnv * 256; return true; }
    return false; } };
struct SchedOut { static constexpr bool GATHER = false; const bf16_t* O; const bf16_t* W; bf16_t* Y; int G, c;
  __device__ __forceinline__ bool next(int i, pg8::Unit& u) const { const int Lx = i * G + c; if (Lx >= 528) return false; const int pm = (Lx / 16) * 4 + (Lx & 3), pn = (Lx & 15) >> 2; u.pm = pm; u.pn = pn; u.kind = 0;
    u.A = (const char*)(O + (size_t)pm * 256 * D); u.Bt = (const char*)(W + (size_t)pn * 256 * D); u.out = Y; u.ldo = 1024; u.x0 = pm * 256; u.x1 = pn * 256; return true; } };
template <bool GATH>
struct SchedMoe { static constexpr bool GATHER = GATH; const bf16_t* A; const bf16_t* W; bf16_t* out; const LAS int* moff; const int* rl; int Kd, ldo, ncol, G, c;
  __device__ __forceinline__ bool next(int i, pg8::Unit& u) const { const int Lx = i * G + c; const int ntile = moff[16] >> 8; if (Lx >= ntile * 4) return false;
    const int pm = Lx >> 2, pn = Lx & 3; int e = 0;
#pragma unroll
    for (int j = 1; j < 16; ++j) e += (pm * 256 >= moff[j]) ? 1 : 0;
    u.pm = pm; u.pn = pn; u.kind = 0; u.A = GATH ? (const char*)A : (const char*)(A + (size_t)pm * 256 * Kd); u.rl = rl + pm * 256; u.Bt = (const char*)(W + ((size_t)e * 1024 + pn * 256) * Kd); u.out = out; u.ldo = ldo; u.x0 = pm * 256; u.x1 = pn * ncol; return true; } };

struct EpiOddIn {
  static constexpr bool PERM = true; const float* rope;
  __device__ __forceinline__ void operator()(const f32x4 (&acc)[2][2][4][2], const pg8::Unit& u, int wr, int wc, int fr, int fq) const {
    if (u.kind == 0) { pg8::EpiStoreBf16{}(acc, u, wr, wc, fr, fq); return; }
    const int row0 = u.x0 + wr * 64 + fr, col0 = u.x1 + wc * 32 + 8 * fq; const int half = wc & 1;
#pragma unroll
    for (int ai = 0; ai < 2; ++ai)
#pragma unroll
      for (int m = 0; m < 4; ++m) { const int row = row0 + ai * 128 + m * 16; const int t = row & (T - 1); const int pos = half ? (t & 63) : (t >> 6);
        const f32x4 cs0 = *(const f32x4*)(rope + (pos * 16 + 4 * fq) * 2), cs1 = *(const f32x4*)(rope + (pos * 16 + 4 * fq + 2) * 2);
        bf16_t* rowp = u.out + (size_t)row * u.ldo + col0;
#pragma unroll
        for (int bj = 0; bj < 2; ++bj) { const f32x4 v0 = acc[ai][bj][m][0], v1 = acc[ai][bj][m][1];
          u32x4 w; w.x = cvt_pk_bf16(v0[0] * cs0[0] - v0[1] * cs0[1], v0[0] * cs0[1] + v0[1] * cs0[0]); w.y = cvt_pk_bf16(v0[2] * cs0[2] - v0[3] * cs0[3], v0[2] * cs0[3] + v0[3] * cs0[2]);
          w.z = cvt_pk_bf16(v1[0] * cs1[0] - v1[1] * cs1[1], v1[0] * cs1[1] + v1[1] * cs1[0]); w.w = cvt_pk_bf16(v1[2] * cs1[2] - v1[3] * cs1[3], v1[2] * cs1[3] + v1[3] * cs1[2]);
          *(u32x4*)(rowp + bj * 128) = w; } }
  }
};
struct EpiGateUp {
  static constexpr bool PERM = true;
  __device__ __forceinline__ void operator()(const f32x4 (&acc)[2][2][4][2], const pg8::Unit& u, int wr, int wc, int fr, int fq) const {
    const int row0 = u.x0 + wr * 64 + fr, col0 = u.x1 + wc * 16 + 4 * fq;
#pragma unroll
    for (int ai = 0; ai < 2; ++ai)
#pragma unroll
      for (int m = 0; m < 4; ++m) { bf16_t* rowp = u.out + (size_t)(row0 + ai * 128 + m * 16) * u.ldo + col0;
#pragma unroll
        for (int bj = 0; bj < 2; ++bj) { const f32x4 v0 = acc[ai][bj][m][0], v1 = acc[ai][bj][m][1];
          u32x2 w; w.x = cvt_pk_bf16(silu_r(v0[0]) * v0[1], silu_r(v0[2]) * v0[3]); w.y = cvt_pk_bf16(silu_r(v1[0]) * v1[1], silu_r(v1[2]) * v1[3]);
          *(u32x2*)(rowp + bj * 64) = w; } }
  }
};
}

namespace mk {
constexpr int N_PHASES = 2 + 2 * (12 + 10);
__global__ void __launch_bounds__(NTHR, 2) mega(Params p_) {
  const Params& p = p_;
  extern __shared__ __attribute__((aligned(16))) unsigned char shm[];
  LAS unsigned char* lds = (LAS unsigned char*)shm;
  const int nb = gridDim.x;
  if (threadIdx.x == 0) *(LAS u32x4*)(lds + LDS_BARW) = (u32x4){0u, 0u, 0u, 0u};
  __syncthreads();
  XcdBarrier bar = xcd_barrier_post(wsp<unsigned>(p, WS_BAR), (volatile LAS unsigned*)(lds + LDS_BARW));
  int ph = 0;
#ifndef MK_MASK
#define MK_MASK 0xFFFFFFFFu
#endif
#ifndef MK_REP
#define MK_REP 0u
#endif
#define PHASE_BEGIN_K(k) if (((MK_MASK) >> (k)) & 1u) { Params pl_ = p_; asm volatile("" : "+s"(pl_.ws)); const Params& p = pl_; bf16_t* UO = wsp<bf16_t>(p, WS_UO); unsigned char* scr = p.ws + WS_SCR; (void)UO; (void)scr; \
    const int bid = mk::obid(); const int nrep_ = ((((MK_REP) >> (k)) & 1u) ? 2 : 1); for (int rep_ = 0; rep_ < nrep_; ++rep_) { const bool dry = rep_ + 1 < nrep_; (void)dry;
#define PHASE_END   } if (ph + 1 < N_PHASES) { XcdBarrier b_ = bar; asm volatile("" : "+s"(b_.bar), "+s"(b_.x)); xcd_barrier(b_); } } ++ph;
  bf16_t* UO = wsp<bf16_t>(p, WS_UO);
  unsigned char* scr = p.ws + WS_SCR;
  PHASE_BEGIN_K(0) phase_prologue(p, lds); PHASE_END
  PHASE_BEGIN_K(1) phase_mod0(p); PHASE_END
  for (int lp = 0; lp < 2; ++lp) {
    {
      const int l = 2 * lp;
      bf16_t* Pqk = (bf16_t*)(scr + SE_PQK); bf16_t* Vt = (bf16_t*)(scr + SE_VT); bf16_t* Prw = (bf16_t*)(scr + SE_PRW); bf16_t* Ybuf = (bf16_t*)(scr + SE_YBUF);
      rw::Bufs bf; bf.SH = (u32x2*)(scr + SE_SH); bf.DR = (unsigned*)(scr + SE_DR); bf.G = UO + 512; bf.gstride = 1024; bf.CS = (float*)(scr + SE_CS) + (size_t)lp * NTOK * 16; bf.PQ = (float*)(scr + SE_PQ); bf.SST = (float*)(scr + SE_SST); bf.Y = (bf16_t*)(scr + SE_Y); bf.Z = (bf16_t*)(scr + SE_Z);
      PHASE_BEGIN_K(2) { SchedEvenIn S{UO, wsp<bf16_t>(p, WS_WEIN) + (size_t)lp * EVEN_IN * D, Pqk, Prw, Vt, nb, bid}; pg8::gemm_phase(lds, D, S, pg8::EpiStoreBf16{}); } PHASE_END
      PHASE_BEGIN_K(3) {
#ifdef MK_P3
        if (!(dry && MK_P3 == 2))
#endif
        for (int u = bid; u < 1024 + 32; u += nb) { int b, h, rq; if (u < 1024) { b = u >> 8; h = (u >> 5) & 7; rq = u & 31; } else { const int v = u - 1024; b = v >> 3; h = v & 7; rq = -1; }
          natt::na_attn_unit(Pqk, Vt, p.na_rpb + ((size_t)lp * 8 + h) * 465, UO, b, h, rq, lds); }
        const int pb = (bid + nb / 2) % nb;
#ifdef MK_P3
        if (!(dry && MK_P3 == 1))
#endif
        for (int t = pb; t < NTOK / 16; t += nb) rw::prep_tile(Prw, p.shift_w + (size_t)lp * 3 * RW_IN, p.rw_w0 + lp * 1024, wsp<bf16_t>(p, WS_WLT) + (size_t)lp * 196608, p.rw_a0 + lp * 1024, p.rw_k_k + lp * 512, p.rw_k_a + lp * 512, p.rw_r_k + lp * 512, bf, t, (LAS float*)lds); } PHASE_END
      PHASE_BEGIN_K(4) for (int u = bid * 8 + (mk::otid() >> 6); u < rw::NCHAIN * rw::NCH; u += nb * 8) rw::scan_unit(bf, p.rw_k_a + lp * 512, u / rw::NCH, u % rw::NCH, (LAS float*)lds + (mk::otid() >> 6) * 4096); PHASE_END
      PHASE_BEGIN_K(5) for (int c = bid; c < rw::NCHAIN * 4; c += nb) rw::propagate_chain(bf, c >> 2, c & 3, (LAS float*)lds); PHASE_END
      PHASE_BEGIN_K(6) for (int u = bid * 8 + (mk::otid() >> 6); u < rw::NCHAIN * (rw::NCH - 1); u += nb * 8) rw::corr_unit(bf, u / (rw::NCH - 1), 1 + u % (rw::NCH - 1)); PHASE_END
      PHASE_BEGIN_K(7) rw::finish_phase<8>(bf, p.rw_gn_g + lp * 512, p.rw_gn_b + lp * 512, UO); PHASE_END
      PHASE_BEGIN_K(8) { SchedOut S{UO, wsp<bf16_t>(p, WS_WEOUT) + (size_t)lp * D * D, Ybuf, nb, bid}; pg8::gemm_phase(lds, D, S, pg8::EpiStoreBf16{}); __syncthreads(); cvt_experts(p, l, (LAS float*)lds, 528 - 2 * nb > 0 ? 528 - 2 * nb : 0); } PHASE_END
      PHASE_BEGIN_K(9) if (l == 0) phase_ln1<true>(p, l, Ybuf, lds, dry); else phase_ln1<false>(p, l, Ybuf, lds, dry); PHASE_END
      PHASE_BEGIN_K(10) phase_scatter(p, l, lds); PHASE_END
      PHASE_BEGIN_K(11) { LAS int* mo = (LAS int*)(lds + LDS_MISC); { const int tq = mk::otid(); if (tq < 17) mo[tq] = wsp<int>(p, WS_MOFF)[l * 64 + tq]; } __syncthreads();
        SchedMoe<true> S{UO, wsp<bf16_t>(p, WS_WGU), (bf16_t*)(scr + SM_HE), mo, wsp<int>(p, WS_RL), D, DE, 128, nb, bid}; pg8::gemm_phase(lds, D, S, EpiGateUp{}); } PHASE_END
      PHASE_BEGIN_K(12) { LAS int* mo = (LAS int*)(lds + LDS_MISC); { const int tq = mk::otid(); if (tq < 17) mo[tq] = wsp<int>(p, WS_MOFF)[l * 64 + tq]; } __syncthreads();
        SchedMoe<false> S{(bf16_t*)(scr + SM_HE), wsp<bf16_t>(p, WS_WDN), (bf16_t*)(scr + SM_YS), mo, nullptr, DE, D, 256, nb, bid}; pg8::gemm_phase(lds, DE, S, pg8::EpiStoreBf16{}); } PHASE_END
      PHASE_BEGIN_K(13) phase_ln2(p, l, dry); PHASE_END
    }
    {
      const int l = 2 * lp + 1; const bool last = l == DEPTH - 1;
      bf16_t* Pqk = (bf16_t*)(scr + SO_PQK); bf16_t* Vt = (bf16_t*)(scr + SO_VT); bf16_t* O12 = (bf16_t*)(scr + SO_O12); bf16_t* Ybuf = (bf16_t*)(scr + SO_YBUF);
      PHASE_BEGIN_K(14) { SchedOddIn S{UO, wsp<bf16_t>(p, WS_WOIN) + (size_t)lp * ODD_IN * D, Pqk, Vt, nb, bid}; pg8::gemm_phase(lds, D, S, EpiOddIn{wsp<float>(p, WS_ROPE)}); } PHASE_END
      float* KN = wsp<float>(p, WS_KN) + (size_t)lp * 256 * 32;
      PHASE_BEGIN_K(23) for (int g = bid; g < 256; g += nb) att::knorm_group(Pqk, KN, g, (LAS float*)lds); PHASE_END
      PHASE_BEGIN_K(15) for (int ui = bid; ui < 2048 + (last ? 0 : 64); ui += nb) { int b, hh, q0, nlat; const int u = (nb == 256 && ui < 2048) ? ((((ui >> 8) * 8 + (bid & 7)) << 5) | (bid >> 3)) : ui;
        if (u < 2048) { b = u >> 9; hh = (u >> 5) & 15; q0 = b * T + (u & 31) * 256; nlat = T; } else { const int v = u - 2048; b = v >> 4; hh = v & 15; q0 = NLAT + b * L; nlat = 0; }
        const bool st = __builtin_amdgcn_sqrtf(att::nmax2_of(KN, b, hh, 0) * att::nmax2_of(KN, b, hh, 1)) * 1.001f <= 60.0f;
#ifdef MK_ABL
        if (dry) att::diff_attn_unit<true, MK_ABL>(Pqk, Vt, O12, hh, q0, b * T, nlat, NLAT + b * L, lds); else
#endif
        if (st) att::diff_attn_unit<true>(Pqk, Vt, O12, hh, q0, b * T, nlat, NLAT + b * L, lds); else att::diff_attn_unit<false>(Pqk, Vt, O12, hh, q0, b * T, nlat, NLAT + b * L, lds); } PHASE_END
      PHASE_BEGIN_K(16) { float d1 = 0.f, d2 = 0.f; for (int i = 0; i < 64; ++i) { d1 += p.da_lq1[lp * 64 + i] * p.da_lk1[lp * 64 + i]; d2 += p.da_lq2[lp * 64 + i] * p.da_lk2[lp * 64 + i]; }
        const float li = 0.8f - 0.6f * expf(-0.3f * (float)l), lam = expf(d1) - expf(d2) + li;
        const int tq = mk::otid(); for (int r4 = bid; r4 < (last ? NLAT : NTOK) / 4; r4 += nb) att::diff_combine_rows4(O12, p.da_subln_g + lp * 128, lam, 1.0f - li, UO, r4 * 4, tq >> 6, tq & 63); } PHASE_END
      PHASE_BEGIN_K(17) { SchedOut S{UO, wsp<bf16_t>(p, WS_WOOUT) + (size_t)lp * D * D, Ybuf, nb, bid}; pg8::gemm_phase(lds, D, S, pg8::EpiStoreBf16{}); __syncthreads(); cvt_experts(p, l, (LAS float*)lds, 528 - 2 * nb > 0 ? 528 - 2 * nb : 0); } PHASE_END
      PHASE_BEGIN_K(18) phase_ln1<false>(p, l, Ybuf, lds, dry); PHASE_END
      PHASE_BEGIN_K(19) phase_scatter(p, l, lds); PHASE_END
      PHASE_BEGIN_K(20) { LAS int* mo = (LAS int*)(lds + LDS_MISC); { const int tq = mk::otid(); if (tq < 17) mo[tq] = wsp<int>(p, WS_MOFF)[l * 64 + tq]; } __syncthreads();
        SchedMoe<true> S{UO, wsp<bf16_t>(p, WS_WGU), (bf16_t*)(scr + SM_HE), mo, wsp<int>(p, WS_RL), D, DE, 128, nb, bid}; pg8::gemm_phase(lds, D, S, EpiGateUp{}); } PHASE_END
      PHASE_BEGIN_K(21) { LAS int* mo = (LAS int*)(lds + LDS_MISC); { const int tq = mk::otid(); if (tq < 17) mo[tq] = wsp<int>(p, WS_MOFF)[l * 64 + tq]; } __syncthreads();
        SchedMoe<false> S{(bf16_t*)(scr + SM_HE), wsp<bf16_t>(p, WS_WDN), (bf16_t*)(scr + SM_YS), mo, nullptr, DE, D, 256, nb, bid}; pg8::gemm_phase(lds, DE, S, pg8::EpiStoreBf16{}); } PHASE_END
      PHASE_BEGIN_K(22) phase_ln2(p, l, dry); PHASE_END
    }
  }
#undef PHASE_BEGIN_K
#undef PHASE_END
}
}

#ifndef MK_SINGLE_LAUNCH
#define MK_SINGLE_LAUNCH 1
#endif
extern "C" void kernel_launch(void* const* d_in, const int* in_sizes, int n_in, void* d_out, int out_size, void* d_ws, size_t ws_size, hipStream_t stream) {
  using namespace mk;
  static int grid = 0;
  if (grid == 0) {
    if (n_in != 34 || out_size != NLAT * D || ws_size < WS_END) { fprintf(stderr, "kernel_launch: unexpected shapes (n_in %d out %d ws %zu need %zu)\n", n_in, out_size, ws_size, (size_t)WS_END); grid = -1; return; }
    if (hipFuncSetAttribute((const void*)mega, hipFuncAttributeMaxDynamicSharedMemorySize, LDS_BYTES) != hipSuccess) { grid = -1; return; }
    int dev = 0, cus = 0, per_cu = 0;
    if (hipGetDevice(&dev) != hipSuccess || hipDeviceGetAttribute(&cus, hipDeviceAttributeMultiprocessorCount, dev) != hipSuccess) { grid = -1; return; }
    if (hipOccupancyMaxActiveBlocksPerMultiprocessor(&per_cu, (const void*)mega, NTHR, LDS_BYTES) != hipSuccess || per_cu < 1) { fprintf(stderr, "kernel_launch: occupancy query says %d\n", per_cu); }
    (void)hipGetLastError();
    grid = cus;
  }
  if (grid < 0) return;
  (void)hipMemsetAsync((char*)d_ws + WS_BAR, 0, (size_t)XCD_BAR_WORDS * 4, stream);
  Params p{};
  const float** pp = (const float**)&p;
  for (int i = 0; i < 34; ++i) pp[i] = (const float*)d_in[i];
  p.out = (float*)d_out; p.ws = (unsigned char*)d_ws;
#if MK_SINGLE_LAUNCH
  p.ph_lo = 0; p.ph_hi = N_PHASES;
  hipLaunchKernelGGL(mega, dim3(grid), dim3(NTHR), LDS_BYTES, stream, p);
#else
  for (int ph = 0; ph < N_PHASES; ++ph) { p.ph_lo = ph; p.ph_hi = ph + 1; hipLaunchKernelGGL(mega, dim3(grid), dim3(NTHR), LDS_BYTES, stream, p); }
#endif
}
```

```cpp
#include <hip/hip_runtime.h>
#include <stdint.h>
#include <stdio.h>

typedef unsigned short bf16_t;
typedef short bf16x8 __attribute__((ext_vector_type(8)));
typedef float f32x4 __attribute__((ext_vector_type(4)));
typedef float f32x2 __attribute__((ext_vector_type(2)));
typedef float f32x16 __attribute__((ext_vector_type(16)));
typedef unsigned u32x4 __attribute__((ext_vector_type(4)));
typedef unsigned u32x2 __attribute__((ext_vector_type(2)));
#define LAS __attribute__((address_space(3)))

namespace mk {
constexpr int B = 4, T = 8192, L = 256, D = 1024, NLAT = B * T, NCTX = B * L, NTOK = NLAT + NCTX;
constexpr int DEPTH = 4, EVEN_IN = 3328, ODD_IN = 3072, RW_OFF = 1536, RW_IN = 1792, NE = 16, DE = 512;
constexpr float ALPHA = 1.681792830507429f, LN_EPS = 1e-5f;
constexpr int NTHR = 512, LDS_BYTES = 147456;
constexpr int MOE_TILES = 280, MOE_ROWS = MOE_TILES * 256;

typedef __bf16 bf16x2v __attribute__((ext_vector_type(2)));
__device__ __forceinline__ unsigned cvt_pk_bf16(float lo, float hi) { const f32x2 v = {lo, hi}; return __builtin_bit_cast(unsigned, __builtin_convertvector(v, bf16x2v)); }
__device__ __forceinline__ unsigned cvt_pk_bf16_v(float lo, float hi) { return cvt_pk_bf16(lo, hi); }
template <int V> struct IntC { static constexpr int value = V; };
__device__ __forceinline__ float bf2f(bf16_t b) { return __uint_as_float(((unsigned)b) << 16); }
__device__ __forceinline__ float bflo(unsigned w) { return __uint_as_float(w << 16); }
__device__ __forceinline__ float bfhi(unsigned w) { return __uint_as_float(w & 0xffff0000u); }
__device__ __forceinline__ bf16_t f2bf(float f) { return (bf16_t)(cvt_pk_bf16(f, 0.f) & 0xffffu); }
__device__ __forceinline__ float sigmoidf_(float x) { return 1.0f / (1.0f + __expf(-x)); }
__device__ __forceinline__ float siluf_(float x) { return x / (1.0f + __expf(-x)); }
__device__ __forceinline__ float sigmoid_r(float x) { return __builtin_amdgcn_rcpf(1.0f + __expf(-x)); }
__device__ __forceinline__ float silu_r(float x) { return x * __builtin_amdgcn_rcpf(1.0f + __expf(-x)); }
__device__ __forceinline__ float wave_sum(float v) {
#pragma unroll
  for (int o = 32; o > 0; o >>= 1) v += __shfl_xor(v, o);
  return v;
}
template <int CTRL, int RM, int BM> __device__ __forceinline__ float dpp_mov(float old, float v) { return __int_as_float(__builtin_amdgcn_update_dpp(__float_as_int(old), __float_as_int(v), CTRL, RM, BM, false)); }
__device__ __forceinline__ float wave_sum_u(float v) {
  v += dpp_mov<0xB1, 0xf, 0xf>(v, v);
  v += dpp_mov<0x4E, 0xf, 0xf>(v, v);
  v += dpp_mov<0x141, 0xf, 0xf>(v, v);
  v += dpp_mov<0x140, 0xf, 0xf>(v, v);
  v += dpp_mov<0x142, 0xa, 0xf>(0.f, v);
  v += dpp_mov<0x143, 0xc, 0xf>(0.f, v);
  return __int_as_float(__builtin_amdgcn_readlane(__float_as_int(v), 63));
}
__device__ __forceinline__ float wave_max_u(float v) {
  v = fmaxf(v, dpp_mov<0xB1, 0xf, 0xf>(v, v));
  v = fmaxf(v, dpp_mov<0x4E, 0xf, 0xf>(v, v));
  v = fmaxf(v, dpp_mov<0x141, 0xf, 0xf>(v, v));
  v = fmaxf(v, dpp_mov<0x140, 0xf, 0xf>(v, v));
  v = fmaxf(v, dpp_mov<0x142, 0xa, 0xf>(0.f, v));
  v = fmaxf(v, dpp_mov<0x143, 0xc, 0xf>(0.f, v));
  return __int_as_float(__builtin_amdgcn_readlane(__float_as_int(v), 63));
}
__device__ __forceinline__ float reduce_scatter16(const float (&acc)[16], int lane) {
  float t8[8], t4[4], t2[2];
#pragma unroll
  for (int i = 0; i < 8; ++i) { const u32x2 sw = __builtin_amdgcn_permlane32_swap(__float_as_uint(acc[i]), __float_as_uint(acc[8 + i]), false, false); t8[i] = __uint_as_float(sw.x) + __uint_as_float(sw.y); }
#pragma unroll
  for (int i = 0; i < 4; ++i) { const u32x2 sw = __builtin_amdgcn_permlane16_swap(__float_as_uint(t8[i]), __float_as_uint(t8[4 + i]), false, false); t4[i] = __uint_as_float(sw.x) + __uint_as_float(sw.y); }
  const bool b3 = (lane & 8) != 0, b2_ = (lane & 4) != 0;
#pragma unroll
  for (int i = 0; i < 2; ++i) { const float keep = b3 ? t4[2 + i] : t4[i], send = b3 ? t4[i] : t4[2 + i]; t2[i] = keep + dpp_mov<0x128, 0xf, 0xf>(send, send); }
  float tot;
  { const float keep = b2_ ? t2[1] : t2[0], send = b2_ ? t2[0] : t2[1];
    float recv = dpp_mov<0x104, 0xf, 0x5>(send, send);
    recv = dpp_mov<0x114, 0xf, 0xa>(recv, send);
    tot = keep + recv; }
  tot += dpp_mov<0xB1, 0xf, 0xf>(tot, tot); tot += dpp_mov<0x4E, 0xf, 0xf>(tot, tot);
  return tot;
}
__device__ __forceinline__ f32x16 zero16() { float z = 0.f; asm volatile("" : "+v"(z)); f32x16 r;
#pragma unroll
  for (int i = 0; i < 16; ++i) r[i] = z;
  return r; }
__device__ __forceinline__ int otid() { int t = threadIdx.x; asm volatile("" : "+v"(t)); return t; }
__device__ __forceinline__ int obid() { int b = blockIdx.x; asm volatile("" : "+s"(b)); return b; }
__device__ __forceinline__ int bidx_of_row(int row) { return row < NLAT ? row / T : 4; }
}

#include <vector>

#define XB_TMO      128
#define XB_XCNT(j)  (256  + 64 * (j))
#define XB_XSUB(j)  (1280 + 64 * (j))
#define XB_XGEN(j)  (2304 + 64 * (j))
#define XB_TOP      3328
#define XB_TOPGEN   3392
#define XCD_BAR_WORDS 3456
#define XB_SPIN_CAP (1u << 18)
#define LAS __attribute__((address_space(3)))

__device__ __forceinline__ unsigned xb_ld(unsigned* p)              { return __hip_atomic_load(p, __ATOMIC_RELAXED, __HIP_MEMORY_SCOPE_AGENT); }
__device__ __forceinline__ unsigned xb_add(unsigned* p, unsigned v) { return __hip_atomic_fetch_add(p, v, __ATOMIC_RELAXED, __HIP_MEMORY_SCOPE_AGENT); }
__device__ __forceinline__ unsigned xb_xcc_id() { return (unsigned)__builtin_amdgcn_s_getreg((3 << 11) | 20) & 0xFu; }
#define XB_SPIN(cond, bar) do { unsigned _sp = 0; while (cond) { __builtin_amdgcn_s_sleep(1); \
    if ((++_sp & 255u) == 0u) { if (xb_ld(&(bar)[XB_TMO])) break; if (_sp > XB_SPIN_CAP) { atomicAdd(&(bar)[XB_TMO], 1u); break; } } } } while (0)

struct XcdBarrier {
    unsigned* bar; unsigned x;
    volatile LAS unsigned* st;
};

__device__ __forceinline__ XcdBarrier xcd_barrier_post(unsigned* bar, volatile LAS unsigned* st) {
    XcdBarrier b; b.bar = bar; b.x = xb_xcc_id(); b.st = st;
    if (threadIdx.x == 0) (void)xb_add(&bar[XB_XCNT(b.x)], 1u);
    return b;
}
__device__ __forceinline__ void xcd_barrier_complete(unsigned* bar, unsigned x, unsigned& nloc, unsigned& nx) {
    const unsigned G = gridDim.x * gridDim.y * gridDim.z;
    unsigned sum, cnt, mine, sp = 0u;
    for (;;) {
        sum = 0u; cnt = 0u; mine = 0u;
#pragma unroll
        for (unsigned j = 0; j < 16; ++j) { const unsigned c = xb_ld(&bar[XB_XCNT(j)]); sum += c; cnt += (c > 0u) ? 1u : 0u; mine = (j == x) ? c : mine; }
        if (sum == G) break;
        __builtin_amdgcn_s_sleep(1);
        if ((++sp & 255u) == 0u) { if (xb_ld(&bar[XB_TMO])) break; if (sp > XB_SPIN_CAP) { atomicAdd(&bar[XB_TMO], 1u); break; } }
    }
    nloc = mine > 0u ? mine : 1u; nx = cnt > 0u ? cnt : 1u;
}

__device__ __forceinline__ void xcd_barrier(const XcdBarrier& b) {
    asm volatile("s_waitcnt vmcnt(0)" ::: "memory");
    __syncthreads();
    if (threadIdx.x == 0) {
        unsigned* bar = b.bar;
        __builtin_amdgcn_s_waitcnt(0);
        unsigned nloc = b.st[0], nx = b.st[1];
        if (nloc == 0u) { xcd_barrier_complete(bar, b.x, nloc, nx); b.st[0] = nloc; b.st[1] = nx; }
        const unsigned old = xb_add(&bar[XB_XSUB(b.x)], 1u);
        const unsigned gen = old / nloc;
        if (old + 1u == (gen + 1u) * nloc) {
            __builtin_amdgcn_fence(__ATOMIC_RELEASE, "agent");
            asm volatile("s_waitcnt vmcnt(0)" ::: "memory");
            const unsigned og = xb_add(&bar[XB_TOP], 1u);
            const unsigned tg = og / nx;
            if (og + 1u == (tg + 1u) * nx) xb_add(&bar[XB_TOPGEN], 1u);
            else XB_SPIN(xb_ld(&bar[XB_TOPGEN]) == tg, bar);
            __builtin_amdgcn_fence(__ATOMIC_ACQUIRE, "agent");
            xb_add(&bar[XB_XGEN(b.x)], 1u);
            asm volatile("s_waitcnt vmcnt(0)" ::: "memory");
        } else {
            XB_SPIN(xb_ld(&bar[XB_XGEN(b.x)]) == gen, bar);
            __builtin_amdgcn_fence(__ATOMIC_ACQUIRE, "agent");
            asm volatile("s_waitcnt vmcnt(0)" ::: "memory");
        }
    }
    __syncthreads();
}

namespace pg8 {
using mk::cvt_pk_bf16;
constexpr int BM = 256, BK = 64, HALF = 128, HTB = HALF * BK * 2  , STAGE_BYTES = 8 * HTB;
__host__ __device__ __forceinline__ int lds_byte(int r, int c) { const int st = (r >> 4) * 2 + (c >> 5), rr = r & 15, cc = c & 31, ob = rr * 64 + cc * 2; return st * 1024 + (ob ^ (((ob >> 9) & 1) << 5)); }
__host__ __device__ __forceinline__ void stage_rc(int b, int& R, int& C) { const int st = b / 1024, sb = b % 1024, swz = sb ^ (((sb >> 9) & 1) << 5); R = (st >> 1) * 16 + swz / 64; C = (st & 1) * 32 + (swz % 64) / 2; }
__host__ __device__ __forceinline__ int perm32(int rho) { const int n = rho >> 4, i = rho & 15; return 8 * (i >> 2) + 4 * n + (i & 3); }

struct Unit { const char* A; const char* Bt; bf16_t* out; const int* rl; int pm, pn, x0, x1, ldo, kind; };

template <class Epi, class Sched>
__device__ __forceinline__ void gemm_phase(LAS unsigned char* lds, const int K, const Sched& S, const Epi& E) {
    const int tid = mk::otid(), wid = __builtin_amdgcn_readfirstlane(tid >> 6), lane = tid & 63, wr = wid >> 2, wc = wid & 3, fr = lane & 15, fq = lane >> 4;
    const int nt = K / BK;
    constexpr bool GATH = Sched::GATHER;
    unsigned voffA[2], voffB[2]; int Rl[2], Cl[2];
#pragma unroll
    for (int i = 0; i < 2; ++i) { int R, C; stage_rc(tid * 16 + i * 8192, R, C); const int Rb = Epi::PERM ? ((R & ~31) + perm32(R & 31)) : R; Rl[i] = R; Cl[i] = C;
        voffA[i] = (unsigned)(R * K + C) * 2u; voffB[i] = (unsigned)(Rb * K + C) * 2u; }
    unsigned roC[2][2], roN[2][2];
    (void)Rl; (void)Cl;
    const size_t kstep = (size_t)(BK * 2);
    const size_t hstep = (size_t)HALF * K * 2;
    const unsigned ldsw = (unsigned)wid * 1024u;
    const int aoff = lds_byte(wr * 64 + fr, fq * 8), boff = lds_byte(wc * 32 + fr, fq * 8);
#define PG8_SA(b, h) (((b) * 2 + (h)) * HTB)
#define PG8_SB(b, h) ((4 + (b) * 2 + (h)) * HTB)
#define PG8_STAGE(bufoff, gbase, voff) do { _Pragma("unroll") for (int _i = 0; _i < 2; ++_i) \
        __builtin_amdgcn_global_load_lds((const unsigned*)((const char*)(gbase) + (voff)[_i]), (LAS unsigned*)(lds + (bufoff) + ldsw + _i * 8192), 16, 0, 0); } while (0)
#define PG8_STAGE_A(bufoff, gbase, h, ro) do { if constexpr (GATH) { _Pragma("unroll") for (int _i = 0; _i < 2; ++_i) \
        __builtin_amdgcn_global_load_lds((const unsigned*)((const char*)(gbase) + (ro)[h][_i]), (LAS unsigned*)(lds + (bufoff) + ldsw + _i * 8192), 16, 0, 0); } \
      else { PG8_STAGE(bufoff, (const char*)(gbase) + (h) * hstep, voffA); } } while (0)
#define PG8_LOAD_RO(u, ro) do { _Pragma("unroll") for (int _h = 0; _h < 2; ++_h) _Pragma("unroll") for (int _i = 0; _i < 2; ++_i) \
        (ro)[_h][_i] = (unsigned)(u).rl[Rl[_i] + _h * 128] * (unsigned)(K * 2) + (unsigned)(Cl[_i] * 2); } while (0)
#define PG8_LDA(dst, b, h) do { _Pragma("unroll") for (int m = 0; m < 4; ++m) _Pragma("unroll") for (int k = 0; k < 2; ++k) dst[m][k] = *(const LAS bf16x8*)(lds + PG8_SA(b, h) + aoff + m * 2048 + k * 1024); } while (0)
#define PG8_LDB(dst, b, h) do { _Pragma("unroll") for (int n = 0; n < 2; ++n) _Pragma("unroll") for (int k = 0; k < 2; ++k) dst[n][k] = *(const LAS bf16x8*)(lds + PG8_SB(b, h) + boff + n * 2048 + k * 1024); } while (0)
#define PG8_MMA(ai, bj, At, Bt) do { __builtin_amdgcn_s_setprio(1); _Pragma("unroll") for (int m = 0; m < 4; ++m) _Pragma("unroll") for (int n = 0; n < 2; ++n) _Pragma("unroll") for (int k = 0; k < 2; ++k) \
        acc[ai][bj][m][n] = __builtin_amdgcn_mfma_f32_16x16x32_bf16(Bt[n][k], At[m][k], acc[ai][bj][m][n], 0, 0, 0); __builtin_amdgcn_s_setprio(0); } while (0)
#define PG8_WAIT_V(n) asm volatile("s_waitcnt vmcnt(" #n ")" ::: "memory")
#define PG8_WAIT_L(n) asm volatile("s_waitcnt lgkmcnt(" #n ")" ::: "memory")
#define PG8_BAR __builtin_amdgcn_s_barrier()
#define PG8_SCHED __builtin_amdgcn_sched_barrier(0)
    Unit cur, nxt; int ui = 0;
    if (!S.next(0, cur)) return;
    f32x4 acc[2][2][4][2];
#pragma unroll
    for (int a = 0; a < 2; ++a)
#pragma unroll
        for (int b = 0; b < 2; ++b)
#pragma unroll
            for (int m = 0; m < 4; ++m)
#pragma unroll
                for (int n = 0; n < 2; ++n) acc[a][b][m][n] = (f32x4){0.f, 0.f, 0.f, 0.f};
    bf16x8 At[4][2], B0[2][2], B1[2][2];
    const char* cA = cur.A; const char* cB = cur.Bt;
    if constexpr (GATH) { PG8_LOAD_RO(cur, roC); }
    PG8_STAGE(PG8_SB(0, 0), cB, voffB); PG8_STAGE_A(PG8_SA(0, 0), cA, 0, roC); PG8_STAGE(PG8_SB(0, 1), cB + hstep, voffB); PG8_STAGE_A(PG8_SA(0, 1), cA, 1, roC);
    if (wr == 1) PG8_BAR;
    PG8_WAIT_V(4); PG8_BAR;
    PG8_STAGE(PG8_SB(1, 0), cB + kstep, voffB); PG8_STAGE_A(PG8_SA(1, 0), cA + kstep, 0, roC); PG8_STAGE(PG8_SB(1, 1), cB + hstep + kstep, voffB);
    PG8_WAIT_V(6); PG8_BAR;
    for (;;) {
        const bool has_next = S.next(ui + 1, nxt);
        const char* nA = has_next ? nxt.A : cA; const char* nB = has_next ? nxt.Bt : cB;
        if constexpr (GATH) { if (has_next) { PG8_LOAD_RO(nxt, roN); } else { _Pragma("unroll") for (int _h = 0; _h < 2; ++_h) _Pragma("unroll") for (int _i = 0; _i < 2; ++_i) roN[_h][_i] = roC[_h][_i]; } }
        for (int t = 0; t < nt; t += 2) {
            const bool last = (t == nt - 2);
            const char* a1 = cA + (size_t)(t + 1) * kstep;
            const char* a2 = last ? nA : cA + (size_t)(t + 2) * kstep; const char* b2 = last ? nB : cB + (size_t)(t + 2) * kstep;
            const char* a3 = a2 + kstep; const char* b3 = b2 + kstep;
            unsigned ro2[2][2];
            if constexpr (GATH) { _Pragma("unroll") for (int _h = 0; _h < 2; ++_h) _Pragma("unroll") for (int _i = 0; _i < 2; ++_i) ro2[_h][_i] = last ? roN[_h][_i] : roC[_h][_i]; }
            (void)ro2;
            PG8_LDB(B0, 0, 0); PG8_SCHED; PG8_LDA(At, 0, 0); PG8_STAGE_A(PG8_SA(1, 1), a1, 1, roC);
            PG8_WAIT_L(8); PG8_BAR; PG8_WAIT_L(0); PG8_MMA(0, 0, At, B0); PG8_BAR; PG8_SCHED;
            PG8_LDB(B1, 0, 1); PG8_STAGE(PG8_SB(0, 0), b2, voffB);
            PG8_BAR; PG8_WAIT_L(0); PG8_MMA(0, 1, At, B1); PG8_BAR;
            PG8_LDA(At, 0, 1); PG8_STAGE_A(PG8_SA(0, 0), a2, 0, ro2);
            PG8_BAR; PG8_WAIT_L(0); PG8_MMA(1, 0, At, B0); PG8_BAR; PG8_SCHED;
            PG8_STAGE(PG8_SB(0, 1), b2 + hstep, voffB);
            PG8_WAIT_V(6); PG8_BAR; PG8_MMA(1, 1, At, B1); PG8_BAR;
            PG8_LDB(B0, 1, 0); PG8_SCHED; PG8_LDA(At, 1, 0); PG8_STAGE_A(PG8_SA(0, 1), a2, 1, ro2);
            PG8_WAIT_L(8); PG8_BAR; PG8_WAIT_L(0); PG8_MMA(0, 0, At, B0); PG8_BAR; PG8_SCHED;
            PG8_LDB(B1, 1, 1); PG8_STAGE(PG8_SB(1, 0), b3, voffB);
            PG8_BAR; PG8_WAIT_L(0); PG8_MMA(0, 1, At, B1); PG8_BAR;
            PG8_LDA(At, 1, 1); PG8_STAGE_A(PG8_SA(1, 0), a3, 0, ro2);
            PG8_BAR; PG8_WAIT_L(0); PG8_MMA(1, 0, At, B0); PG8_BAR; PG8_SCHED;
            PG8_STAGE(PG8_SB(1, 1), b3 + hstep, voffB);
            PG8_WAIT_V(6); PG8_BAR; PG8_MMA(1, 1, At, B1); PG8_BAR;
        }
        E(acc, cur, wr, wc, fr, fq);
        if (!has_next) break;
#pragma unroll
        for (int a = 0; a < 2; ++a)
#pragma unroll
            for (int b = 0; b < 2; ++b)
#pragma unroll
                for (int m = 0; m < 4; ++m)
#pragma unroll
                    for (int n = 0; n < 2; ++n) acc[a][b][m][n] = (f32x4){0.f, 0.f, 0.f, 0.f};
        cur = nxt; cA = nA; cB = nB; ++ui;
        if constexpr (GATH) { _Pragma("unroll") for (int _h = 0; _h < 2; ++_h) _Pragma("unroll") for (int _i = 0; _i < 2; ++_i) roC[_h][_i] = roN[_h][_i]; }
    }
    PG8_WAIT_V(0);
    if (wr == 0) PG8_BAR;
    PG8_BAR;
#undef PG8_SA
#undef PG8_SB
#undef PG8_STAGE
#undef PG8_STAGE_A
#undef PG8_LOAD_RO
#undef PG8_LDA
#undef PG8_LDB
#undef PG8_MMA
#undef PG8_WAIT_V
#undef PG8_WAIT_L
#undef PG8_BAR
#undef PG8_SCHED
}

struct EpiStoreBf16 {
    static constexpr bool PERM = true;
    __device__ __forceinline__ void operator()(const f32x4 (&acc)[2][2][4][2], const Unit& u, int wr, int wc, int fr, int fq) const {
        bf16_t* O = u.out; const int ldc = u.ldo;
        const int row0 = u.x0 + wr * 64 + fr, col0 = u.x1 + wc * 32 + 8 * fq;
#pragma unroll
        for (int ai = 0; ai < 2; ++ai)
#pragma unroll
            for (int m = 0; m < 4; ++m) { bf16_t* rowp = O + (size_t)(row0 + ai * HALF + m * 16) * ldc + col0;
#pragma unroll
                for (int bj = 0; bj < 2; ++bj) { const f32x4 v0 = acc[ai][bj][m][0], v1 = acc[ai][bj][m][1];
                    u32x4 w; w.x = cvt_pk_bf16(v0[0], v0[1]); w.y = cvt_pk_bf16(v0[2], v0[3]); w.z = cvt_pk_bf16(v1[0], v1[1]); w.w = cvt_pk_bf16(v1[2], v1[3]);
                    *(u32x4*)(rowp + bj * HALF) = w; } }
    }
};
}

namespace mk {
struct NMapId { int off; __device__ __forceinline__ int operator()(int n) const { return n + off; } __device__ __forceinline__ float scl(int) const { return 1.0f; } };
struct NMapInterleave { int which; __device__ __forceinline__ int operator()(int n) const { return 2 * n + which; } __device__ __forceinline__ float scl(int) const { return 1.0f; } };
struct NMapRope { __device__ __forceinline__ int operator()(int n) const { if (n >= 2048) return n; const int ch = n >> 6, c = n & 63, half = c >> 5, w = c & 31, z = w >> 4, i = w & 15; return ch * 64 + half * 32 + 2 * i + z; }
  __device__ __forceinline__ float scl(int n) const { return n < 1024 ? 0.125f * 1.4426950408889634f : 1.0f; } };

template <class NMap>
__device__ __forceinline__ void cvt_tile(const float* __restrict__ src, int ldsrc, int K, bf16_t* __restrict__ dst, int k0, int n0, const NMap& nmap, LAS float* tile) {
  const int t = mk::otid();
  { const int k = t >> 3, c = (t & 7) * 8; const float* p = src + (size_t)(k0 + k) * ldsrc + n0 + c;
    const f32x4 a = *(const f32x4*)p, b = *(const f32x4*)(p + 4);
    LAS float* q = tile + k * 65 + c; q[0] = a[0]; q[1] = a[1]; q[2] = a[2]; q[3] = a[3]; q[4] = b[0]; q[5] = b[1]; q[6] = b[2]; q[7] = b[3]; }
  __syncthreads();
  { const int n = t >> 3, kc = (t & 7) * 8; const LAS float* q = tile + kc * 65 + n; const float sc = nmap.scl(n0 + n);
    u32x4 w; w.x = cvt_pk_bf16(q[0] * sc, q[65] * sc); w.y = cvt_pk_bf16(q[130] * sc, q[195] * sc); w.z = cvt_pk_bf16(q[260] * sc, q[325] * sc); w.w = cvt_pk_bf16(q[390] * sc, q[455] * sc);
    *(u32x4*)(dst + (size_t)nmap(n0 + n) * K + k0 + kc) = w; }
  __syncthreads();
}
template <class NMap>
__device__ __forceinline__ int cvt_matrix(const float* src, int ldsrc, int K, int N, bf16_t* dst, const NMap& nmap, LAS float* tile, int ubase, int bid, int nblk) {
  const int nkt = K / 64, nnt = N / 64, tot = nkt * nnt;
  int first = ubase + ((bid - ubase % nblk) + nblk) % nblk;
  for (int u = first; u < ubase + tot; u += nblk) { const int v = u - ubase; cvt_tile(src, ldsrc, K, dst, (v / nnt) * 64, (v % nnt) * 64, nmap, tile); }
  return tot;
}
}

namespace att {
using namespace mk;
constexpr int KB_BYTES = 64 * 128, VB_BYTES = 128 * 128, TILE_BYTES = KB_BYTES + VB_BYTES, DA_RING = 4, DA_LDS = DA_RING * TILE_BYTES;
__device__ __forceinline__ int pi32(int r) { return (r & ~12) | ((r & 4) << 1) | ((r & 8) >> 1); }
__device__ __forceinline__ int swz(int row, int chunk) { return row * 128 + ((chunk ^ ((row >> 1) & 7)) << 4); }
__device__ __forceinline__ int crow(int r, int hi) { return (r & 3) + 8 * (r >> 2) + 4 * hi; }

__device__ __forceinline__ float sumsq8(u32x4 w) { return (bflo(w.x) * bflo(w.x) + bfhi(w.x) * bfhi(w.x)) + (bflo(w.y) * bflo(w.y) + bfhi(w.y) * bfhi(w.y)) + (bflo(w.z) * bflo(w.z) + bfhi(w.z) * bfhi(w.z)) + (bflo(w.w) * bflo(w.w) + bfhi(w.w) * bfhi(w.w)); }
__device__ __forceinline__ void knorm_group(const bf16_t* __restrict__ Pqk, float* __restrict__ KN, int g, LAS float* red) {
  const int tid = mk::otid(), wid = tid >> 6, lane = tid & 63;
  float mx = 0.f, mq = 0.f;
  for (int i0 = 0; i0 < 160; i0 += 32) {
    u32x4 a[4], b[4], c[4], d[4];
#pragma unroll
    for (int j = 0; j < 4; ++j) { int i = i0 + j * 8 + wid; i = i < 132 ? i : wid; const int row = i < 128 ? g * 128 + i : NLAT + g * 4 + (i - 128);
      const bf16_t* kp = Pqk + (size_t)row * 2048 + 1024 + lane * 16; a[j] = *(const u32x4*)kp; b[j] = *(const u32x4*)(kp + 8); c[j] = *(const u32x4*)(kp - 1024); d[j] = *(const u32x4*)(kp - 1024 + 8); }
#pragma unroll
    for (int j = 0; j < 4; ++j) { float s = sumsq8(a[j]) + sumsq8(b[j]); s += dpp_mov<0xB1, 0xf, 0xf>(s, s); s += dpp_mov<0x4E, 0xf, 0xf>(s, s); mx = fmaxf(mx, s);
      float q = sumsq8(c[j]) + sumsq8(d[j]); q += dpp_mov<0xB1, 0xf, 0xf>(q, q); q += dpp_mov<0x4E, 0xf, 0xf>(q, q); mq = fmaxf(mq, q); }
  }
  if ((lane & 3) == 0) { red[wid * 32 + (lane >> 2)] = mx; red[wid * 32 + 16 + (lane >> 2)] = mq; }
  __syncthreads();
  if (tid < 32) { float m = red[tid];
#pragma unroll
    for (int w = 1; w < 8; ++w) m = fmaxf(m, red[w * 32 + tid]);
    KN[g * 32 + tid] = m; }
  __syncthreads();
}
__device__ __forceinline__ float nmax2_of(const float* __restrict__ KN, int b, int hh, int which) {
  return wave_max_u(KN[(b * 64 + (mk::otid() & 63)) * 32 + which * 16 + hh]);
}

template <bool STATIC, int ABL = 0>
__device__ __forceinline__ void diff_attn_unit(const bf16_t* __restrict__ Pqk, const bf16_t* __restrict__ Vt, bf16_t* __restrict__ O12, int hh, int q0, int klat0, int nlat, int kctx0, LAS unsigned char* lds) {
  const int tid = mk::otid(), wid = tid >> 6, lane = tid & 63, r = lane & 31, hi = lane >> 5;
  const int NT = (nlat + L) / 64, NTL = nlat / 64;
  const int wv = __builtin_amdgcn_readfirstlane(wid);
  const int drow = wv * 8 + (lane >> 3), dch = (lane & 7) ^ ((drow >> 1) & 7);
  const unsigned koff = (unsigned)(drow * 2048 + 1024 + hh * 64 + dch * 8) * 2u;
  const unsigned voff = (unsigned)(((hh >> 1) * 128 + drow) * NTOK + dch * 8) * 2u;
  bf16x8 qf[4];
  { const bf16_t* qp = Pqk + (size_t)(q0 + wid * 32 + r) * 2048 + hh * 64 + hi * 8;
#pragma unroll
    for (int ks = 0; ks < 4; ++ks) qf[ks] = *(const bf16x8*)(qp + ks * 16); }
  const unsigned kaddr0 = (unsigned)(pi32(r) * 128 + ((hi ^ ((pi32(r) >> 1) & 7)) << 4));
  const unsigned vaddr0 = (unsigned)(r * 128 + ((hi ^ ((r >> 1) & 7)) << 4)) + KB_BYTES;
  f32x16 o[4];
#pragma unroll
  for (int vb = 0; vb < 4; ++vb)
#pragma unroll
    for (int i = 0; i < 16; ++i) o[vb][i] = 0.f;
  float l_run = 0.f;
#define DA_DMA(t) do { const int tok = (t) < NTL ? klat0 + (t) * 64 : kctx0 + ((t) - NTL) * 64; LAS unsigned char* b_ = lds + ((t) & 3) * TILE_BYTES + wv * 1024; \
    const char* kt_ = (const char*)Pqk + (size_t)tok * 4096; const char* vt_ = (const char*)Vt + (size_t)tok * 2; \
    __builtin_amdgcn_global_load_lds((const unsigned*)(kt_ + koff), (LAS unsigned*)b_, 16, 0, 0); \
    __builtin_amdgcn_global_load_lds((const unsigned*)(vt_ + voff), (LAS unsigned*)(b_ + KB_BYTES), 16, 0, 0); \
    __builtin_amdgcn_global_load_lds((const unsigned*)(vt_ + (size_t)64 * NTOK * 2 + voff), (LAS unsigned*)(b_ + KB_BYTES + 8192), 16, 0, 0); } while (0)
#define DA_WAITV(n) asm volatile("s_waitcnt vmcnt(" #n ")" ::: "memory")
#define DA_PAIR_BEGIN(t) if (!(ABL & 8) && (t) + 2 < NT) { DA_DMA((t) + 2); DA_DMA((t) + 3); }
#define DA_SLOT(tt) const unsigned sb_ = (unsigned)(((tt) & 3) * TILE_BYTES); const LAS unsigned char* kb_ = lds + (kaddr0 + sb_); const LAS unsigned char* vb_ = lds + (vaddr0 + sb_)
#define DA_PAIR_END() do { DA_WAITV(0); asm volatile("s_waitcnt lgkmcnt(0)" ::: "memory"); if (!(ABL & 16)) __builtin_amdgcn_s_barrier(); } while (0)
  DA_DMA(0); DA_DMA(1);
  DA_WAITV(0); __builtin_amdgcn_s_barrier();
#define DA_XOR(ptr, x) ((const LAS unsigned char*)((unsigned)(size_t)(ptr) ^ (unsigned)(x)))
#define DA_KFRAG(ks) const LAS unsigned char* kp_ = DA_XOR(kb_, (ks) << 5); const bf16x8 a0 = (ABL & 2) ? qf[ks] : *(const LAS bf16x8*)kp_, a1 = (ABL & 2) ? qf[(ks) ^ 1] : *(const LAS bf16x8*)(kp_ + 4096)
#define DA_VFRAGS() bf16x8 va[4][4]; \
    _Pragma("unroll") for (int c4 = 0; c4 < 4; ++c4) { const LAS unsigned char* vp_ = DA_XOR(vb_, c4 << 5); \
      _Pragma("unroll") for (int vb = 0; vb < 4; ++vb) va[vb][c4] = (ABL & 1) ? qf[c4 ^ (vb & 3)] : *(const LAS bf16x8*)(vp_ + vb * 4096); }
#define DA_PACK_PV() bf16x8 pf[2][2]; \
    _Pragma("unroll") for (int s = 0; s < 2; ++s) { u32x4 w0, w1; \
      w0.x = cvt_pk_bf16(s0[8 * s + 0], s0[8 * s + 1]); w0.y = cvt_pk_bf16(s0[8 * s + 2], s0[8 * s + 3]); w0.z = cvt_pk_bf16(s0[8 * s + 4], s0[8 * s + 5]); w0.w = cvt_pk_bf16(s0[8 * s + 6], s0[8 * s + 7]); \
      w1.x = cvt_pk_bf16(s1[8 * s + 0], s1[8 * s + 1]); w1.y = cvt_pk_bf16(s1[8 * s + 2], s1[8 * s + 3]); w1.z = cvt_pk_bf16(s1[8 * s + 4], s1[8 * s + 5]); w1.w = cvt_pk_bf16(s1[8 * s + 6], s1[8 * s + 7]); \
      pf[0][s] = __builtin_bit_cast(bf16x8, w0); pf[1][s] = __builtin_bit_cast(bf16x8, w1); } \
    _Pragma("unroll") for (int vb = 0; vb < 4; ++vb) _Pragma("unroll") for (int kb = 0; kb < 2; ++kb) _Pragma("unroll") for (int s = 0; s < 2; ++s) \
      o[vb] = __builtin_amdgcn_mfma_f32_32x32x16_bf16(va[vb][kb * 2 + s], pf[kb][s], o[vb], 0, 0, 0)
  if constexpr (STATIC) {
    for (int t = 0; t < NT; t += 2) {
      DA_PAIR_BEGIN(t);
#pragma unroll
      for (int u = 0; u < 2; ++u) {
        DA_SLOT(t + u);
        f32x16 s0, s1;
#pragma unroll
        for (int i = 0; i < 16; ++i) { s0[i] = 0.f; s1[i] = 0.f; }
#pragma unroll
        for (int ks = 0; ks < 4; ++ks) { DA_KFRAG(ks); s0 = __builtin_amdgcn_mfma_f32_32x32x16_bf16(a0, qf[ks], s0, 0, 0, 0); s1 = __builtin_amdgcn_mfma_f32_32x32x16_bf16(a1, qf[ks], s1, 0, 0, 0); }
        DA_VFRAGS();
        if constexpr ((ABL & 32) != 0) {
          l_run += s0[0] + s1[0];
#pragma unroll
          for (int vb = 0; vb < 4; ++vb)
#pragma unroll
            for (int c4 = 0; c4 < 4; ++c4) o[vb] = __builtin_amdgcn_mfma_f32_32x32x16_bf16(va[vb][c4], qf[c4], o[vb], 0, 0, 0);
        } else {
          float ps = 0.f;
#pragma unroll
          for (int i = 0; i < 16; ++i) { s0[i] = (ABL & 4) ? s0[i] : __builtin_amdgcn_exp2f(s0[i]); ps += s0[i]; }
#pragma unroll
          for (int i = 0; i < 16; ++i) { s1[i] = (ABL & 4) ? s1[i] : __builtin_amdgcn_exp2f(s1[i]); ps += s1[i]; }
          l_run += ps;
          DA_PACK_PV();
        }
      }
      DA_PAIR_END();
    }
  } else {
    constexpr float THR = 8.0f * 1.4426950408889634f;
    float m_run = -1e30f;
    for (int t = 0; t < NT; ++t) {
      if (!(t & 1)) DA_PAIR_BEGIN(t);
      DA_SLOT(t);
      f32x16 s0 = zero16(), s1 = zero16();
#pragma unroll
      for (int ks = 0; ks < 4; ++ks) { DA_KFRAG(ks); s0 = __builtin_amdgcn_mfma_f32_32x32x16_bf16(a0, qf[ks], s0, 0, 0, 0); s1 = __builtin_amdgcn_mfma_f32_32x32x16_bf16(a1, qf[ks], s1, 0, 0, 0); }
      float mx = fmaxf(s0[0], s1[0]);
#pragma unroll
      for (int i = 1; i < 16; ++i) mx = fmaxf(mx, fmaxf(s0[i], s1[i]));
      { const u32x2 sw = __builtin_amdgcn_permlane32_swap(__float_as_uint(mx), __float_as_uint(mx), false, false); mx = fmaxf(__uint_as_float(sw.x), __uint_as_float(sw.y)); }
      float alpha = 1.0f;
      if (!__all(mx - m_run <= THR)) {
        const float m_new = fmaxf(m_run, mx);
        alpha = __builtin_amdgcn_exp2f(m_run - m_new);
        m_run = m_new;
#pragma unroll
        for (int vb = 0; vb < 4; ++vb)
#pragma unroll
          for (int i = 0; i < 16; ++i) o[vb][i] *= alpha;
      }
      float ps = 0.f;
#pragma unroll
      for (int i = 0; i < 16; ++i) { s0[i] = __builtin_amdgcn_exp2f(s0[i] - m_run); ps += s0[i]; }
#pragma unroll
      for (int i = 0; i < 16; ++i) { s1[i] = __builtin_amdgcn_exp2f(s1[i] - m_run); ps += s1[i]; }
      l_run = l_run * alpha + ps;
      __builtin_amdgcn_sched_barrier(0);
      DA_VFRAGS();
      DA_PACK_PV();
      if (t & 1) DA_PAIR_END();
    }
  }
#undef DA_KFRAG
#undef DA_XOR
#undef DA_VFRAGS
#undef DA_PACK_PV
#undef DA_DMA
#undef DA_WAITV
#undef DA_PAIR_BEGIN
#undef DA_PAIR_END
#undef DA_SLOT
  float l_tot; { const u32x2 sw = __builtin_amdgcn_permlane32_swap(__float_as_uint(l_run), __float_as_uint(l_run), false, false); l_tot = __uint_as_float(sw.x) + __uint_as_float(sw.y); }
  const float inv = 1.0f / l_tot;
  const int te = mk::otid();
  bf16_t* op = O12 + (size_t)(q0 + (te >> 6) * 32 + (te & 31)) * 2048 + hh * 128 + 4 * ((te >> 5) & 1);
#pragma unroll
  for (int vb = 0; vb < 4; ++vb)
#pragma unroll
    for (int g = 0; g < 4; ++g) {
      u32x2 w; w.x = cvt_pk_bf16(o[vb][4 * g] * inv, o[vb][4 * g + 1] * inv); w.y = cvt_pk_bf16(o[vb][4 * g + 2] * inv, o[vb][4 * g + 3] * inv);
      *(u32x2*)(op + vb * 32 + 8 * g) = w;
    }
}

__device__ __forceinline__ void diff_combine_rows4(const bf16_t* __restrict__ O12, const float* __restrict__ subln_g, float lam, float oml, bf16_t* __restrict__ O, int row0, int h, int lane) {
  unsigned a[4], b[4];
#pragma unroll
  for (int i = 0; i < 4; ++i) { a[i] = *(const unsigned*)(O12 + (size_t)(row0 + i) * 2048 + (2 * h) * 128 + 2 * lane); b[i] = *(const unsigned*)(O12 + (size_t)(row0 + i) * 2048 + (2 * h + 1) * 128 + 2 * lane); }
  const float g0 = subln_g[2 * lane], g1 = subln_g[2 * lane + 1];
#pragma unroll
  for (int i = 0; i < 4; ++i) {
    const float x0 = bflo(a[i]) - lam * bflo(b[i]), x1 = bfhi(a[i]) - lam * bfhi(b[i]);
    const float ss = wave_sum_u(x0 * x0 + x1 * x1);
    const float rs = rsqrtf(ss * (1.0f / 128.0f) + 1e-5f) * oml;
    *(unsigned*)(O + (size_t)(row0 + i) * 1024 + h * 128 + 2 * lane) = cvt_pk_bf16(x0 * rs * g0, x1 * rs * g1);
  }
}
}

namespace natt {
using namespace mk;
using att::pi32; using att::swz;
constexpr int TB = 64 * 128;
constexpr int NA_LDS = 4 * TB + 2048;
__device__ __forceinline__ void na_attn_unit(const bf16_t* __restrict__ Pe, const bf16_t* __restrict__ Vte, const float* __restrict__ rpb_h, bf16_t* __restrict__ O, int b, int h, int rq, LAS unsigned char* lds) {
  const int tid = mk::otid(), wid = tid >> 6, lane = tid & 63, r = lane & 31, hi = lane >> 5;
  constexpr float LOG2E = 1.4426950408889634f;
  LAS float* sb = (LAS float*)(lds + 4 * TB);
  for (int i = tid; i < 465; i += NTHR) sb[i] = rpb_h[i];
  const bool is_ctx = rq < 0;
  int qrow = 0, qcol = 0, qtok, rs_q = 0, cs_q = 0, span0 = 0, wlo = 0, whi = -1, lo = 0, ntl = 0;
  if (!is_ctx) {
    const int r0 = rq * 4, ra = r0 + (wid >> 2) * 2;
    qrow = ra + (r >> 4); qcol = (wid & 3) * 16 + (r & 15); qtok = b * T + qrow * 64 + qcol;
    rs_q = min(max(qrow - 4, 0), 120); cs_q = min(max(qcol - 8, 0), 48);
    span0 = min(max((wid & 3) * 16 - 8, 0), 32);
    wlo = min(max(ra - 4, 0), 120); whi = min(max(ra - 3, 0), 120) + 7;
    lo = min(max(r0 - 4, 0), 120); const int hi_ = min(max(r0 - 1, 0), 120) + 7; ntl = hi_ - lo + 1;
  } else qtok = NLAT + b * L + wid * 32 + r;
  const int NT = ntl + 4;
  const int srow = tid >> 3, sch = tid & 7;
  const bf16_t* kbase = Pe + 512 + h * 64 + sch * 8;
  const bf16_t* vbase = Vte + (size_t)(h * 64 + srow) * NTOK + sch * 8;
  const int sdst = swz(srow, sch);
  bf16x8 qf[4];
  { const bf16_t* qp = Pe + (size_t)qtok * 1024 + h * 64 + hi * 8;
#pragma unroll
    for (int ks = 0; ks < 4; ++ks) qf[ks] = *(const bf16x8*)(qp + ks * 16); }
  const int kx = (pi32(r) >> 1) & 7, vx = (r >> 1) & 7;
  const int ka_loc = (span0 + pi32(r)) * 128; const int kx_loc = ((span0 + pi32(r)) >> 1) & 7;
  f32x16 o[2];
#pragma unroll
  for (int vb = 0; vb < 2; ++vb)
#pragma unroll
    for (int i = 0; i < 16; ++i) o[vb][i] = 0.f;
  float m_run = -1e30f, l_run = 0.f;
  u32x4 kreg, vreg;
#define NA_LOAD(t) do { const int tok = (t) < ntl ? b * T + (lo + (t)) * 64 : NLAT + b * L + ((t) - ntl) * 64; \
    kreg = *(const u32x4*)(kbase + (size_t)(tok + srow) * 1024); vreg = *(const u32x4*)(vbase + tok); } while (0)
#define NA_WRITE(bufi) do { *(LAS u32x4*)(lds + (bufi) * TB + sdst) = kreg; *(LAS u32x4*)(lds + 2 * TB + (bufi) * TB + sdst) = vreg; } while (0)
  NA_LOAD(0); NA_WRITE(0); __syncthreads();
  for (int t = 0; t < NT; ++t) {
    const bool more = t + 1 < NT;
    if (more) NA_LOAD(t + 1);
    const LAS unsigned char* kb_ = lds + (t & 1) * TB; const LAS unsigned char* vb_ = lds + 2 * TB + (t & 1) * TB;
    const bool local = t < ntl; const int kr = lo + t;
    const bool active = !local || (kr >= wlo && kr <= whi);
    if (active) {
      f32x16 s0, s1;
#pragma unroll
      for (int i = 0; i < 16; ++i) { s0[i] = 0.f; s1[i] = 0.f; }
      if (local) {
#pragma unroll
        for (int ks = 0; ks < 4; ++ks) {
          const bf16x8 a0 = *(const LAS bf16x8*)(kb_ + ka_loc + (((ks * 2 + hi) ^ kx_loc) << 4));
          s0 = __builtin_amdgcn_mfma_f32_32x32x16_bf16(a0, qf[ks], s0, 0, 0, 0);
        }
        const bool row_ok = kr >= rs_q && kr < rs_q + 8; const int dr31 = (kr - qrow + 7) * 31;
#pragma unroll
        for (int i = 0; i < 16; ++i) {
          const int kc = span0 + (i & 7) + 8 * hi + 16 * (i >> 3);
          const bool ok = row_ok && kc >= cs_q && kc < cs_q + 16;
          const int bi = ok ? dr31 + (kc - qcol + 15) : 0;
          const float bv = sb[bi];
          s0[i] = ok ? fmaf(s0[i], 0.125f, bv) : -1e30f; s1[i] = -1e30f;
        }
      } else {
#pragma unroll
        for (int ks = 0; ks < 4; ++ks) {
          const int ch = ((ks * 2 + hi) ^ kx) << 4;
          const bf16x8 a0 = *(const LAS bf16x8*)(kb_ + pi32(r) * 128 + ch), a1 = *(const LAS bf16x8*)(kb_ + (32 + pi32(r)) * 128 + ch);
          s0 = __builtin_amdgcn_mfma_f32_32x32x16_bf16(a0, qf[ks], s0, 0, 0, 0);
          s1 = __builtin_amdgcn_mfma_f32_32x32x16_bf16(a1, qf[ks], s1, 0, 0, 0);
        }
#pragma unroll
        for (int i = 0; i < 16; ++i) { s0[i] *= 0.125f; s1[i] *= 0.125f; }
      }
      float mx = s0[0];
#pragma unroll
      for (int i = 1; i < 16; ++i) mx = fmaxf(mx, s0[i]);
#pragma unroll
      for (int i = 0; i < 16; ++i) mx = fmaxf(mx, s1[i]);
      { const u32x2 sw = __builtin_amdgcn_permlane32_swap(__float_as_uint(mx), __float_as_uint(mx), false, false); mx = fmaxf(__uint_as_float(sw.x), __uint_as_float(sw.y)); }
      const float m_new = fmaxf(m_run, mx);
      const float alpha = __builtin_amdgcn_exp2f((m_run - m_new) * LOG2E);
      m_run = m_new;
      const float mc = -m_new * LOG2E;
      float ps = 0.f;
#pragma unroll
      for (int i = 0; i < 16; ++i) { const float p = s0[i] > -1e29f ? __builtin_amdgcn_exp2f(fmaf(s0[i], LOG2E, mc)) : 0.f; s0[i] = p; ps += p; }
#pragma unroll
      for (int i = 0; i < 16; ++i) { const float p = s1[i] > -1e29f ? __builtin_amdgcn_exp2f(fmaf(s1[i], LOG2E, mc)) : 0.f; s1[i] = p; ps += p; }
      l_run = l_run * alpha + ps;
      if (__any(alpha < 1.0f)) {
#pragma unroll
        for (int vb = 0; vb < 2; ++vb)
#pragma unroll
          for (int i = 0; i < 16; ++i) o[vb][i] *= alpha;
      }
      bf16x8 pf[2][2];
#pragma unroll
      for (int s = 0; s < 2; ++s) {
        u32x4 w0, w1;
        w0.x = cvt_pk_bf16(s0[8 * s + 0], s0[8 * s + 1]); w0.y = cvt_pk_bf16(s0[8 * s + 2], s0[8 * s + 3]); w0.z = cvt_pk_bf16(s0[8 * s + 4], s0[8 * s + 5]); w0.w = cvt_pk_bf16(s0[8 * s + 6], s0[8 * s + 7]);
        w1.x = cvt_pk_bf16(s1[8 * s + 0], s1[8 * s + 1]); w1.y = cvt_pk_bf16(s1[8 * s + 2], s1[8 * s + 3]); w1.z = cvt_pk_bf16(s1[8 * s + 4], s1[8 * s + 5]); w1.w = cvt_pk_bf16(s1[8 * s + 6], s1[8 * s + 7]);
        pf[0][s] = __builtin_bit_cast(bf16x8, w0); pf[1][s] = __builtin_bit_cast(bf16x8, w1);
      }
      const int cbase = local ? (span0 >> 3) : 0;
#pragma unroll
      for (int vb = 0; vb < 2; ++vb) {
        const LAS unsigned char* vrow = vb_ + (vb * 32 + r) * 128;
#pragma unroll
        for (int s = 0; s < 2; ++s) {
          const bf16x8 a = *(const LAS bf16x8*)(vrow + (((cbase + 2 * s + hi) ^ vx) << 4));
          o[vb] = __builtin_amdgcn_mfma_f32_32x32x16_bf16(a, pf[0][s], o[vb], 0, 0, 0);
        }
        if (!local) {
#pragma unroll
          for (int s = 0; s < 2; ++s) {
            const bf16x8 a = *(const LAS bf16x8*)(vrow + (((4 + 2 * s + hi) ^ vx) << 4));
            o[vb] = __builtin_amdgcn_mfma_f32_32x32x16_bf16(a, pf[1][s], o[vb], 0, 0, 0);
          }
        }
      }
    }
    if (more) NA_WRITE((t + 1) & 1);
    __syncthreads();
  }
#undef NA_LOAD
#undef NA_WRITE
  float l_tot; { const u32x2 sw = __builtin_amdgcn_permlane32_swap(__float_as_uint(l_run), __float_as_uint(l_run), false, false); l_tot = __uint_as_float(sw.x) + __uint_as_float(sw.y); }
  const float inv = 1.0f / l_tot;
  bf16_t* op = O + (size_t)qtok * 1024 + h * 64 + 4 * hi;
#pragma unroll
  for (int vb = 0; vb < 2; ++vb)
#pragma unroll
    for (int g = 0; g < 4; ++g) {
      u32x2 w; w.x = cvt_pk_bf16(o[vb][4 * g] * inv, o[vb][4 * g + 1] * inv); w.y = cvt_pk_bf16(o[vb][4 * g + 2] * inv, o[vb][4 * g + 3] * inv);
      *(u32x2*)(op + vb * 32 + 8 * g) = w;
    }
}
}

namespace rw {
using namespace mk;
constexpr int NSTEP = L + T, NCH = 32, CL = NSTEP / NCH;
constexpr int NCHAIN = 2 * B * 8;
constexpr float LOG2E = 1.4426950408889634f;
struct Bufs {
  u32x2* SH;
  unsigned* DR;
  bf16_t* G; int gstride;
  float* CS;
  float* PQ;
  float* SST;
  bf16_t* Y;
  bf16_t* Z;
};

constexpr int XPITCH = 528;
template <int KS> struct LoraW { bf16x8 w[KS][4]; };
template <int KS>
__device__ __forceinline__ void lora_load(const bf16_t* __restrict__ W, int h, int lane, LoraW<KS>& f) {
  const int fr = lane & 15, fq = lane >> 4;
#pragma unroll
  for (int ks = 0; ks < KS; ++ks)
#pragma unroll
    for (int nb = 0; nb < 4; ++nb) f.w[ks][nb] = *(const bf16x8*)(W + (size_t)(h * 64 + nb * 16 + fr) * (KS * 32) + ks * 32 + fq * 8);
}
template <int KS>
__device__ __forceinline__ void lora_mma(const LAS unsigned char* xb, int xcol0, const LoraW<KS>& f, int lane, LAS float* tw, float (&out)[16]) {
  const int fr = lane & 15, fq = lane >> 4;
  f32x4 acc[4];
#pragma unroll
  for (int nb = 0; nb < 4; ++nb) { float z = 0.f; asm volatile("" : "+v"(z)); acc[nb] = (f32x4){z, z, z, z}; }
#pragma unroll
  for (int ks = 0; ks < KS; ++ks) {
    const bf16x8 xf = *(const LAS bf16x8*)(xb + fr * XPITCH + (xcol0 + ks * 32 + fq * 8) * 2);
#pragma unroll
    for (int nb = 0; nb < 4; ++nb) acc[nb] = __builtin_amdgcn_mfma_f32_16x16x32_bf16(xf, f.w[ks][nb], acc[nb], 0, 0, 0);
  }
#pragma unroll
  for (int nb = 0; nb < 4; ++nb) *(LAS f32x4*)(tw + (nb * 16 + fr) * 16 + fq * 4) = acc[nb];
  __builtin_amdgcn_wave_barrier(); asm volatile("s_waitcnt lgkmcnt(0)" ::: "memory"); __builtin_amdgcn_wave_barrier();
#pragma unroll
  for (int q = 0; q < 4; ++q) { const f32x4 v = *(const LAS f32x4*)(tw + lane * 16 + q * 4); out[q * 4] = v[0]; out[q * 4 + 1] = v[1]; out[q * 4 + 2] = v[2]; out[q * 4 + 3] = v[3]; }
  __builtin_amdgcn_wave_barrier(); asm volatile("s_waitcnt lgkmcnt(0)" ::: "memory"); __builtin_amdgcn_wave_barrier();
}
__device__ __forceinline__ void prep_tile(const bf16_t* __restrict__ Prw, const float* __restrict__ cw, const float* __restrict__ w0, const bf16_t* __restrict__ WLT, const float* __restrict__ a0,
                                          const float* __restrict__ k_k, const float* __restrict__ k_a, const float* __restrict__ r_k,
                                          const Bufs& bf, int tile, LAS float* xs  ) {
  const int c = mk::otid(), lane = c & 63, h = c >> 6;
  const int row0 = tile * 16;
  int lo, hi;
  if (row0 < NLAT) { lo = (row0 / T) * T; hi = lo + T - 1; } else { lo = NLAT + ((row0 - NLAT) / L) * L; hi = lo + L - 1; }
  bf16_t rraw[18], kraw[18], vraw[18];
#pragma unroll
  for (int j = 0; j < 18; ++j) { int rr_ = row0 - 1 + j; rr_ = rr_ < lo ? lo : (rr_ > hi ? hi : rr_); const bf16_t* q = Prw + (size_t)rr_ * RW_IN + c; rraw[j] = q[0]; kraw[j] = q[512]; vraw[j] = q[1024]; }
  LoraW<2> wd0, wd1; LoraW<4> wg;
  lora_load<2>(WLT, h, lane, wd0); lora_load<2>(WLT + 32768, h, lane, wd1);
#define RW_CONV(dst, col) do { const float c0 = cw[(col)], c1 = cw[RW_IN + (col)], c2 = cw[2 * RW_IN + (col)]; const bf16_t* p = Prw + (col); \
    bf16_t raw[18]; \
    _Pragma("unroll") for (int j = 0; j < 18; ++j) { int rr = row0 - 1 + j; rr = rr < lo ? lo : (rr > hi ? hi : rr); raw[j] = p[(size_t)rr * RW_IN]; } \
    float pm = row0 > lo ? bf2f(raw[0]) : 0.f, pc = bf2f(raw[1]); \
    _Pragma("unroll") for (int tt = 0; tt < 16; ++tt) { const float pn = (row0 + tt + 1 <= hi) ? bf2f(raw[tt + 2]) : 0.f; dst[tt] = pm * c0 + pc * c1 + pn * c2; pm = pc; pc = pn; } } while (0)
  if (c < 256) {
    float xv[16]; RW_CONV(xv, 1536 + c);
#pragma unroll
    for (int tt = 0; tt < 16; ++tt) { float v = xv[tt]; if (c < 64) v = 2.0f * sigmoid_r(2.0f * v) - 1.0f; else if (c >= 128) v = sigmoid_r(v);     *(LAS bf16_t*)((LAS unsigned char*)xs + tt * XPITCH + c * 2) = f2bf(v); }
  }
  __syncthreads();
  const LAS unsigned char* xb = (const LAS unsigned char*)xs; LAS float* tw = xs + 20480 + h * 1024;
  const float w00 = w0[c], w01 = w0[512 + c], a00 = a0[c], a01 = a0[512 + c], kkc = k_k[c], kac = k_a[c], rkc = r_k[c];
  float e0[16], e1[16];
  {
    float aw0[16], aw1[16];
    lora_mma<2>(xb, 0, wd0, lane, tw, aw0); lora_mma<2>(xb, 0, wd1, lane, tw, aw1);
    lora_load<2>(WLT + 2 * 32768, h, lane, wd0); lora_load<2>(WLT + 3 * 32768, h, lane, wd1);
#pragma unroll
    for (int tt = 0; tt < 16; ++tt) {
      e0[tt] = 0.6065306597126334f * __builtin_amdgcn_rcpf(1.0f + __expf(-(w00 + aw0[tt])));
      e1[tt] = 0.6065306597126334f * __builtin_amdgcn_rcpf(1.0f + __expf(-(w01 + aw1[tt])));
    }
  }
  LAS float* asl = xs + 256 * 16;
  {
    float aa0[16], aa1[16];
    lora_mma<2>(xb, 64, wd0, lane, tw, aa0); lora_mma<2>(xb, 64, wd1, lane, tw, aa1);
    lora_load<4>(WLT + 4 * 32768, h, lane, wg);
#pragma unroll
    for (int tt = 0; tt < 16; ++tt) { const unsigned d0 = cvt_pk_bf16(e0[tt], sigmoid_r(a00 + aa0[tt])), d1 = cvt_pk_bf16(e1[tt], sigmoid_r(a01 + aa1[tt]));
      bf.DR[((size_t)(row0 + tt)) * 512 + c] = d0; bf.DR[((size_t)NTOK + row0 + tt) * 512 + c] = d1; asl[tt * 512 + c] = bfhi(d0); asl[(16 + tt) * 512 + c] = bfhi(d1); }
  }
  {
    float ag[16];
    lora_mma<4>(xb, 128, wg, lane, tw, ag);
#pragma unroll
    for (int tt = 0; tt < 16; ++tt) bf.G[(size_t)(row0 + tt) * bf.gstride + c] = f2bf(ag[tt]);
  }
#undef RW_CONV
  const float cr0 = cw[c], cr1 = cw[RW_IN + c], cr2 = cw[2 * RW_IN + c], ck0 = cw[512 + c], ck1 = cw[RW_IN + 512 + c], ck2 = cw[2 * RW_IN + 512 + c], cv0 = cw[1024 + c], cv1 = cw[RW_IN + 1024 + c], cv2 = cw[2 * RW_IN + 1024 + c];
  float rm = row0 > lo ? bf2f(rraw[0]) : 0.f, km = row0 > lo ? bf2f(kraw[0]) : 0.f, vm = row0 > lo ? bf2f(vraw[0]) : 0.f;
  float rc = bf2f(rraw[1]), kc = bf2f(kraw[1]), vc = bf2f(vraw[1]);
  float rvv[16], kvvv[16], vvvv[16], q1[16];
#pragma unroll
  for (int tt = 0; tt < 16; ++tt) {
    const bool has_n = row0 + tt + 1 <= hi;
    const float rn = has_n ? bf2f(rraw[tt + 2]) : 0.f, kn = has_n ? bf2f(kraw[tt + 2]) : 0.f, vn = has_n ? bf2f(vraw[tt + 2]) : 0.f;
    rvv[tt] = rm * cr0 + rc * cr1 + rn * cr2; kvvv[tt] = km * ck0 + kc * ck1 + kn * ck2; vvvv[tt] = vm * cv0 + vc * cv1 + vn * cv2;
    rm = rc; rc = rn; km = kc; kc = kn; vm = vc; vc = vn;
    const float kk = kvvv[tt] * kkc; q1[tt] = kk * kk;
  }
  const float nrm2 = reduce_scatter16(q1, lane);
  float c0p[16], c1p[16];
#pragma unroll
  for (int tt = 0; tt < 16; ++tt) {
    const int row = row0 + tt;
    const float nrm = sqrtf(__uint_as_float(__builtin_amdgcn_readlane(__float_as_uint(nrm2), 4 * tt)));
    const float kk = kvvv[tt] * kkc * __builtin_amdgcn_rcpf(fmaxf(nrm, 1e-12f));
    u32x2 sh; sh.x = cvt_pk_bf16(rvv[tt], kvvv[tt]); sh.y = cvt_pk_bf16(kk, vvvv[tt]);
    bf.SH[(size_t)row * 512 + c] = sh;
    const float rq = bflo(sh.x), kq = bfhi(sh.x);
    c0p[tt] = rq * kq * (1.0f + (asl[tt * 512 + c] - 1.0f) * kac) * rkc; c1p[tt] = rq * kq * (1.0f + (asl[(16 + tt) * 512 + c] - 1.0f) * kac) * rkc;
  }
  const float cb0 = reduce_scatter16(c0p, lane), cb1 = reduce_scatter16(c1p, lane);
  if ((lane & 3) == 0) { const int row = row0 + (lane >> 2); bf.CS[(size_t)row * 16 + h] = cb0; bf.CS[(size_t)row * 16 + 8 + h] = cb1; }
  __syncthreads();
}

struct StepRaw { u32x2 s; unsigned d; };
__device__ __forceinline__ int scan_row(int dir, int b, int p) {
  if (p < L) return NLAT + b * L + (dir ? (L - 1 - p) : p);
  const int q = p - L; return b * T + (dir ? (T - 1 - q) : q);
}
__device__ __forceinline__ void scan_unit(const Bufs& bf, const float* __restrict__ k_a, int chain, int chunk, LAS float* wl) {
  const int lane = mk::otid() & 63, r = lane & 31, hi = lane >> 5;
  const int dir = chain >> 5, b = (chain >> 3) & 3, h = chain & 7, ch = h * 64 + lane;
  const float kac = k_a[ch];
  f32x16 TS[2][2], TP[2][2];
#pragma unroll
  for (int rb = 0; rb < 2; ++rb)
#pragma unroll
    for (int cb = 0; cb < 2; ++cb)
#pragma unroll
      for (int q = 0; q < 16; ++q) { TS[rb][cb][q] = 0.f; TP[rb][cb][q] = (32 * rb + (q & 3) + 8 * (q >> 2) + 4 * hi == 32 * cb + r) ? 1.f : 0.f; }
  LAS unsigned char* wb = (LAS unsigned char*)wl;
  const LAS unsigned char* xrow = wb + (lane & 15) * 128 + 8 * hi;
  LAS float* Gl = wl + 1024;
  const int p0 = chunk * CL;
  float Dl = 1.f;
#define RW_FRAG(base, rb, s2) ([&]() { const u32x2 lo_ = *(const LAS u32x2*)((base) + (32 * (rb) + 16 * (s2)) * 2), hi_ = *(const LAS u32x2*)((base) + (32 * (rb) + 16 * (s2) + 8) * 2); \
      return __builtin_bit_cast(bf16x8, (u32x4){lo_.x, lo_.y, hi_.x, hi_.y}); }())
#define RW_DOTS(T, o) do { _Pragma("unroll") for (int cb = 0; cb < 2; ++cb) _Pragma("unroll") for (int q = 0; q < 16; ++q) o[cb][q] = 0.f; \
    _Pragma("unroll") for (int rb = 0; rb < 2; ++rb) _Pragma("unroll") for (int s2 = 0; s2 < 2; ++s2) _Pragma("unroll") for (int cb = 0; cb < 2; ++cb) { u32x4 w_; \
      w_.x = cvt_pk_bf16(T[rb][cb][8 * s2 + 0], T[rb][cb][8 * s2 + 1]); w_.y = cvt_pk_bf16(T[rb][cb][8 * s2 + 2], T[rb][cb][8 * s2 + 3]); \
      w_.z = cvt_pk_bf16(T[rb][cb][8 * s2 + 4], T[rb][cb][8 * s2 + 5]); w_.w = cvt_pk_bf16(T[rb][cb][8 * s2 + 6], T[rb][cb][8 * s2 + 7]); \
      o[cb] = __builtin_amdgcn_mfma_f32_32x32x16_bf16(xf[rb][s2], __builtin_bit_cast(bf16x8, w_), o[cb], 0, 0, 0); \
      asm volatile("" : "+v"(o[cb]) : "v"(w_), "v"(xf[rb][s2]));   } } while (0)
#define RW_RENORM() do { wl[1280 + lane] = Dl; __builtin_amdgcn_wave_barrier(); \
    _Pragma("unroll") for (int rb = 0; rb < 2; ++rb) _Pragma("unroll") for (int g = 0; g < 4; ++g) { const f32x4 w4 = *(const LAS f32x4*)(wl + 1280 + 32 * rb + 8 * g + 4 * hi); \
      _Pragma("unroll") for (int cb = 0; cb < 2; ++cb) _Pragma("unroll") for (int u = 0; u < 4; ++u) { TS[rb][cb][4 * g + u] *= w4[u]; TP[rb][cb][4 * g + u] *= w4[u]; } } \
    __builtin_amdgcn_wave_barrier(); Dl = 1.f; } while (0)
  const int wvs = __builtin_amdgcn_readfirstlane((int)((size_t)wl));
#define RW_FETCH(tb) do { _Pragma("unroll") for (int u = 0; u < 8; ++u) { const int pn = (tb) + u < CL ? (tb) + u : CL - 1; const int row = scan_row(dir, b, p0 + pn); \
      const unsigned* gs = (const unsigned*)(bf.SH + (size_t)row * 512 + ch); const unsigned* gd = bf.DR + ((size_t)dir * NTOK + row) * 512 + ch; LAS unsigned* ld = (LAS unsigned*)(size_t)(wvs + 8192 + u * 768); \
      __builtin_amdgcn_global_load_lds(gs, ld, 4, 0, 0); __builtin_amdgcn_global_load_lds(gs + 1, ld + 64, 4, 0, 0); __builtin_amdgcn_global_load_lds(gd, ld + 128, 4, 0, 0); } } while (0)
  RW_FETCH(0);
  for (int t0 = 0; t0 < CL; t0 += 8) {
    asm volatile("s_waitcnt vmcnt(0)" ::: "memory");
    __builtin_amdgcn_wave_barrier();
#pragma unroll
    for (int u = 0; u < 8; ++u) {
      const LAS unsigned* ld = (const LAS unsigned*)(wb + 8192 + u * 768) + lane; const unsigned sx = ld[0], sy = ld[64], dd = ld[128];
      const float rr = bflo(sx), k = bfhi(sx), kk = bflo(sy), e = bflo(dd), asg = bfhi(dd);
      const float w = __builtin_amdgcn_exp2f(-e * LOG2E), keff = k * (1.0f + (asg - 1.0f) * kac);
      ((LAS bf16_t*)wb)[u * 64 + lane] = f2bf(-kk * Dl);
      Dl *= w; const float dinv = __builtin_amdgcn_rcpf(Dl);
      ((LAS bf16_t*)wb)[(8 + u) * 64 + lane] = f2bf(rr * Dl);
      ((LAS bf16_t*)wb)[1024 + u * 64 + lane] = f2bf(kk * asg * dinv); ((LAS bf16_t*)wb)[1024 + (8 + u) * 64 + lane] = f2bf(keff * dinv);
      ((LAS bf16_t*)wb)[3072 + u * 64 + lane] = (bf16_t)(sy >> 16);
    }
    asm volatile("s_waitcnt lgkmcnt(0)" ::: "memory");
    __builtin_amdgcn_wave_barrier();
    RW_FETCH(t0 + 8);
    __builtin_amdgcn_wave_barrier();
    bf16x8 xf[2][2];
#pragma unroll
    for (int rb = 0; rb < 2; ++rb)
#pragma unroll
      for (int s2 = 0; s2 < 2; ++s2) xf[rb][s2] = RW_FRAG(xrow, rb, s2);
    { f32x16 gm;
#pragma unroll
      for (int q = 0; q < 16; ++q) gm[q] = 0.f;
#pragma unroll
      for (int rb = 0; rb < 2; ++rb)
#pragma unroll
        for (int s2 = 0; s2 < 2; ++s2) { const bf16x8 yf = RW_FRAG(xrow + 2048, rb, s2); gm = __builtin_amdgcn_mfma_f32_32x32x16_bf16(xf[rb][s2], yf, gm, 0, 0, 0); asm volatile("" : "+v"(gm) : "v"(yf), "v"(xf[rb][s2])); }
      if (r < 16) {
#pragma unroll
        for (int q = 0; q < 8; ++q) Gl[((q & 3) + 8 * (q >> 2) + 4 * hi) * 16 + r] = gm[q]; }
    }
    float sa[2][8], yy[2][8];
    { f32x16 oS[2], oP[2];
      RW_DOTS(TS, oS); RW_DOTS(TP, oP);
#pragma unroll
      for (int cb = 0; cb < 2; ++cb)
#pragma unroll
        for (int q = 0; q < 4; ++q) {
          { const u32x2 sw = __builtin_amdgcn_permlane32_swap(__float_as_uint(oS[cb][q]), __float_as_uint(oP[cb][q]), false, false); sa[cb][q] = __uint_as_float(sw.x); sa[cb][4 + q] = __uint_as_float(sw.y); }
          { const u32x2 sw = __builtin_amdgcn_permlane32_swap(__float_as_uint(oS[cb][4 + q]), __float_as_uint(oP[cb][4 + q]), false, false); yy[cb][q] = __uint_as_float(sw.x); yy[cb][4 + q] = __uint_as_float(sw.y); } }
    }
    __builtin_amdgcn_wave_barrier();
    float vm[2][8];
#pragma unroll
    for (int u = 0; u < 8; ++u) { const LAS bf16_t* vr = (const LAS bf16_t*)wb + 3072 + u * 64 + r; vm[0][u] = hi ? 0.f : bf2f(vr[0]); vm[1][u] = hi ? 0.f : bf2f(vr[32]); }
#pragma unroll
    for (int s = 0; s < 8; ++s) {
      const f32x4 ga0 = *(const LAS f32x4*)(Gl + s * 16), ga1 = *(const LAS f32x4*)(Gl + s * 16 + 4), ga2 = *(const LAS f32x4*)(Gl + s * 16 + 8), ga3 = *(const LAS f32x4*)(Gl + s * 16 + 12);
      const f32x4 gr0 = *(const LAS f32x4*)(Gl + (8 + s) * 16), gr1 = *(const LAS f32x4*)(Gl + (8 + s) * 16 + 4), gr2 = *(const LAS f32x4*)(Gl + (8 + s) * 16 + 8), gr3 = *(const LAS f32x4*)(Gl + (8 + s) * 16 + 12);
      const float gab[8] = {ga0[0], ga0[1], ga0[2], ga0[3], ga1[0], ga1[1], ga1[2], ga1[3]}, gak[8] = {ga2[0], ga2[1], ga2[2], ga2[3], ga3[0], ga3[1], ga3[2], ga3[3]};
      const float grb[8] = {gr0[0], gr0[1], gr0[2], gr0[3], gr1[0], gr1[1], gr1[2], gr1[3]}, grk[8] = {gr2[0], gr2[1], gr2[2], gr2[3], gr3[0], gr3[1], gr3[2], gr3[3]};
#pragma unroll
      for (int cb = 0; cb < 2; ++cb) {
        float x = sa[cb][s], y = yy[cb][s];
#pragma unroll
        for (int u = 0; u < 8; ++u) { if (u < s) { x = fmaf(gab[u], sa[cb][u], x); x = fmaf(gak[u], vm[cb][u], x); } }
        sa[cb][s] = x;
#pragma unroll
        for (int u = 0; u < 8; ++u) { if (u <= s) { y = fmaf(grb[u], sa[cb][u], y); y = fmaf(grk[u], vm[cb][u], y); } }
        yy[cb][s] = y;
      }
    }
    { bf16_t* yz = hi ? bf.Z : bf.Y;
#pragma unroll
      for (int s = 0; s < 8; ++s) { const size_t oi = ((size_t)dir * NTOK + scan_row(dir, b, p0 + t0 + s)) * 512 + h * 64 + r; yz[oi] = f2bf(yy[0][s]); yz[oi + 32] = f2bf(yy[1][s]); } }
    { bf16x8 au[2], buS[2], buP[2];
      u32x4 a0, a1, s0, s1, p0_, p1_;
#pragma unroll
      for (int q = 0; q < 4; ++q) {
        const int u = 4 * hi + q;
        const LAS bf16_t* yb = (const LAS bf16_t*)wb + 1024 + u * 64 + r; const LAS bf16_t* vr = (const LAS bf16_t*)wb + 3072 + u * 64 + r;
        a0[q] = (unsigned)yb[0] | ((unsigned)yb[512] << 16); a1[q] = (unsigned)yb[32] | ((unsigned)yb[512 + 32] << 16);
        const u32x2 sw0 = __builtin_amdgcn_permlane32_swap(__float_as_uint(sa[0][q]), __float_as_uint(sa[0][4 + q]), false, false), sw1 = __builtin_amdgcn_permlane32_swap(__float_as_uint(sa[1][q]), __float_as_uint(sa[1][4 + q]), false, false);
        s0[q] = (cvt_pk_bf16(__uint_as_float(sw0.x), 0.f) & 0xffffu) | ((unsigned)vr[0] << 16); s1[q] = (cvt_pk_bf16(__uint_as_float(sw1.x), 0.f) & 0xffffu) | ((unsigned)vr[32] << 16);
        p0_[q] = cvt_pk_bf16(__uint_as_float(sw0.y), 0.f); p1_[q] = cvt_pk_bf16(__uint_as_float(sw1.y), 0.f); }
      au[0] = __builtin_bit_cast(bf16x8, a0); au[1] = __builtin_bit_cast(bf16x8, a1); buS[0] = __builtin_bit_cast(bf16x8, s0); buS[1] = __builtin_bit_cast(bf16x8, s1); buP[0] = __builtin_bit_cast(bf16x8, p0_); buP[1] = __builtin_bit_cast(bf16x8, p1_);
#pragma unroll
      for (int rb = 0; rb < 2; ++rb)
#pragma unroll
        for (int cb = 0; cb < 2; ++cb) { TS[rb][cb] = __builtin_amdgcn_mfma_f32_32x32x16_bf16(au[rb], buS[cb], TS[rb][cb], 0, 0, 0); TP[rb][cb] = __builtin_amdgcn_mfma_f32_32x32x16_bf16(au[rb], buP[cb], TP[rb][cb], 0, 0, 0); }
    }
    __builtin_amdgcn_wave_barrier();
    if ((t0 & 31) == 24) RW_RENORM();
  }
  RW_RENORM();
#undef RW_DOTS
#undef RW_FRAG
#undef RW_RENORM
#undef RW_FETCH
  asm volatile("s_waitcnt vmcnt(0)" ::: "memory");
  if (chunk < NCH - 1) {
    float* pq = bf.PQ + (((size_t)chain * (NCH - 1) + chunk) * 2) * 4096;
#pragma unroll
    for (int rb = 0; rb < 2; ++rb)
#pragma unroll
      for (int cb = 0; cb < 2; ++cb)
#pragma unroll
        for (int g = 0; g < 4; ++g) { float* q = pq + (size_t)(32 * cb + r) * 64 + 32 * rb + 8 * g + 4 * hi;
          *(f32x4*)q = (f32x4){TP[rb][cb][4 * g], TP[rb][cb][4 * g + 1], TP[rb][cb][4 * g + 2], TP[rb][cb][4 * g + 3]};
          *(f32x4*)(q + 4096) = (f32x4){TS[rb][cb][4 * g], TS[rb][cb][4 * g + 1], TS[rb][cb][4 * g + 2], TS[rb][cb][4 * g + 3]}; }
  }
}

__device__ __forceinline__ void propagate_chain(const Bufs& bf, int chain, int rq, LAS float* lds) {
  LAS float* Sl = lds; LAS float* Pl = lds + 16 * 65 + 15;
  Pl = lds + 1056;
  const int tid = mk::otid(), i = tid >> 5, jc = (tid & 31) * 2, row = rq * 16 + i, pi = tid >> 3, pj = (tid & 7) * 8;
  float* sst = bf.SST + (size_t)chain * NCH * 4096;
  Sl[i * 65 + jc] = 0.f; Sl[i * 65 + jc + 1] = 0.f;
  const float* pb = bf.PQ + ((size_t)chain * (NCH - 1) * 2) * 4096;
  f32x4 np0 = *(const f32x4*)(pb + pi * 64 + pj), np1 = *(const f32x4*)(pb + pi * 64 + pj + 4); f32x2 nq = *(const f32x2*)(pb + 4096 + row * 64 + jc);
  for (int c = 0; c < NCH - 1; ++c) {
    const f32x4 p0 = np0, p1 = np1; f32x2 q = nq;
    { const float* pn = pb + (size_t)(c + 1 < NCH - 1 ? c + 1 : c) * 2 * 4096;
      np0 = *(const f32x4*)(pn + pi * 64 + pj); np1 = *(const f32x4*)(pn + pi * 64 + pj + 4); nq = *(const f32x2*)(pn + 4096 + row * 64 + jc); }
    *(LAS f32x4*)(Pl + pi * 64 + pj) = p0; *(LAS f32x4*)(Pl + pi * 64 + pj + 4) = p1;
    __syncthreads();
#pragma unroll 16
    for (int k = 0; k < 64; ++k) { const float sv = Sl[i * 65 + k]; const f32x2 a = *(const LAS f32x2*)(Pl + k * 64 + jc); q += sv * a; }
    __syncthreads();
    Sl[i * 65 + jc] = q[0]; Sl[i * 65 + jc + 1] = q[1];
    *(f32x2*)(sst + (size_t)(c + 1) * 4096 + row * 64 + jc) = q;
  }
  __syncthreads();
}

__device__ __forceinline__ void corr_unit(const Bufs& bf, int chain, int chunk) {
  const int lane = mk::otid() & 63, r = lane & 31, hi = lane >> 5;
  const int dir = chain >> 5, b = (chain >> 3) & 3, h = chain & 7;
  const float* ss = bf.SST + ((size_t)chain * NCH + chunk) * 4096;
  bf16x8 bfr[2][4];
#pragma unroll
  for (int nt = 0; nt < 2; ++nt)
#pragma unroll
    for (int ks = 0; ks < 4; ++ks) { const float* q = ss + (size_t)(nt * 32 + r) * 64 + ks * 16 + hi * 8; const f32x4 x0 = *(const f32x4*)q, x1 = *(const f32x4*)(q + 4);
      u32x4 w; w.x = cvt_pk_bf16(x0[0], x0[1]); w.y = cvt_pk_bf16(x0[2], x0[3]); w.z = cvt_pk_bf16(x1[0], x1[1]); w.w = cvt_pk_bf16(x1[2], x1[3]); bfr[nt][ks] = __builtin_bit_cast(bf16x8, w); }
  const int p0 = chunk * CL;
  const size_t dbase = (size_t)dir * NTOK;
  for (int mt = 0; mt < (CL + 31) / 32; ++mt) {
    const int sa_ = min(mt * 32 + r, CL - 1);
    const bf16_t* zp = bf.Z + (dbase + scan_row(dir, b, p0 + sa_)) * 512 + h * 64 + hi * 8;
    bf16x8 af[4];
#pragma unroll
    for (int ks = 0; ks < 4; ++ks) af[ks] = *(const bf16x8*)(zp + ks * 16);
    bf16_t yo0[16], yo1[16];
#pragma unroll
    for (int i = 0; i < 16; ++i) { const int so = min(mt * 32 + (i & 3) + 8 * (i >> 2) + 4 * hi, CL - 1); const bf16_t* yp = bf.Y + (dbase + scan_row(dir, b, p0 + so)) * 512 + h * 64 + r; yo0[i] = yp[0]; yo1[i] = yp[32]; }
    f32x16 acc[2];
#pragma unroll
    for (int nt = 0; nt < 2; ++nt) { acc[nt] = zero16();
#pragma unroll
      for (int ks = 0; ks < 4; ++ks) acc[nt] = __builtin_amdgcn_mfma_f32_32x32x16_bf16(af[ks], bfr[nt][ks], acc[nt], 0, 0, 0); }
#pragma unroll
    for (int i = 0; i < 16; ++i) { const int so = mt * 32 + (i & 3) + 8 * (i >> 2) + 4 * hi;
      if (so < CL) { bf16_t* yp = bf.Y + (dbase + scan_row(dir, b, p0 + so)) * 512 + h * 64 + r;
        yp[0] = f2bf(bf2f(yo0[i]) + acc[0][i]); yp[32] = f2bf(bf2f(yo1[i]) + acc[1][i]); } }
  }
}

template <int NR> struct FinRaw { bf16_t y0[NR], y1[NR], g[NR]; unsigned v[NR]; float c0[NR], c1[NR]; };
template <int NR>
__device__ __forceinline__ void finish_load(const Bufs& bf, int row0, int c, int h, FinRaw<NR>& q) {
#pragma unroll
  for (int i = 0; i < NR; ++i) { const int row = row0 + i;
    q.y0[i] = bf.Y[(size_t)row * 512 + c]; q.y1[i] = bf.Y[((size_t)NTOK + row) * 512 + c];
    q.v[i] = bf.SH[(size_t)row * 512 + c].y; q.g[i] = bf.G[(size_t)row * bf.gstride + c];
    q.c0[i] = bf.CS[(size_t)row * 16 + h]; q.c1[i] = bf.CS[(size_t)row * 16 + 8 + h]; }
}
template <int NR>
__device__ __forceinline__ void finish_phase(const Bufs& bf, const float* __restrict__ gn_g, const float* __restrict__ gn_b, bf16_t* __restrict__ O) {
  const int c = mk::otid(), h = c >> 6, stride = gridDim.x * NR;
  const float gg = gn_g[c], gb = gn_b[c];
  int row0 = mk::obid() * NR;
  if (row0 >= NTOK) return;
  FinRaw<NR> cur, nxt; finish_load<NR>(bf, row0, c, h, cur);
  for (; row0 < NTOK; row0 += stride) {
    const int rn = row0 + stride < NTOK ? row0 + stride : row0;
    finish_load<NR>(bf, rn, c, h, nxt);
    float o[NR];
    if constexpr (NR == 8) {
      float mom[16], yv[8];
#pragma unroll
      for (int i = 0; i < 8; ++i) { yv[i] = bf2f(cur.y0[i]) + bf2f(cur.y1[i]); mom[i] = yv[i]; mom[8 + i] = yv[i] * yv[i]; }
      const float tot = reduce_scatter16(mom, c & 63);
#pragma unroll
      for (int i = 0; i < 8; ++i) { const float mu = __uint_as_float(__builtin_amdgcn_readlane(__float_as_uint(tot), 4 * i)) * (1.0f / 64.0f), m2 = __uint_as_float(__builtin_amdgcn_readlane(__float_as_uint(tot), 32 + 4 * i)) * (1.0f / 64.0f);
        const float var = fmaxf(m2 - mu * mu, 0.f);
        o[i] = ((yv[i] - mu) * rsqrtf(var + 64e-5f) * gg + gb + (cur.c0[i] + cur.c1[i]) * bfhi(cur.v[i])) * bf2f(cur.g[i]); }
    } else {
#pragma unroll
    for (int i = 0; i < NR; ++i) { const float y = bf2f(cur.y0[i]) + bf2f(cur.y1[i]);
      const float mu = wave_sum_u(y) * (1.0f / 64.0f); const float dv = y - mu; const float var = wave_sum_u(dv * dv) * (1.0f / 64.0f);
      o[i] = (dv * rsqrtf(var + 64e-5f) * gg + gb + (cur.c0[i] + cur.c1[i]) * bfhi(cur.v[i])) * bf2f(cur.g[i]); }
    }
#pragma unroll
    for (int i = 0; i < NR; ++i) O[(size_t)(row0 + i) * 1024 + 512 + c] = f2bf(o[i]);
    cur = nxt;
  }
}
}

namespace mk {
constexpr size_t al256(size_t x) { return (x + 255) / 256 * 256; }
constexpr size_t WS_BAR = 0;
constexpr size_t WS_BCNT = al256(WS_BAR + (size_t)XCD_BAR_WORDS * 4);
constexpr size_t WS_MOFF = al256(WS_BCNT + (size_t)4 * 256 * 64 * 4);
constexpr size_t WS_KN = al256(WS_MOFF + 4 * 256);
constexpr size_t WS_MOD = al256(WS_KN + (size_t)2 * 256 * 32 * 4);
constexpr size_t WS_ROPE = al256(WS_MOD + (size_t)4 * 5 * 6144 * 4);
constexpr size_t WS_HBC = al256(WS_ROPE + 128 * 16 * 2 * 4);
constexpr size_t WS_EID = al256(WS_HBC + (size_t)NCTX * D * 2);
constexpr size_t WS_GATE = al256(WS_EID + (size_t)NTOK * 2 * 4);
constexpr size_t WS_POS = al256(WS_GATE + (size_t)NTOK * 2 * 4);
constexpr size_t WS_RL = al256(WS_POS + (size_t)NTOK * 2 * 4);
constexpr size_t WS_WEIN = al256(WS_RL + (size_t)MOE_ROWS * 4);
constexpr size_t WS_WOIN = al256(WS_WEIN + (size_t)2 * EVEN_IN * D * 2);
constexpr size_t WS_WEOUT = al256(WS_WOIN + (size_t)2 * ODD_IN * D * 2);
constexpr size_t WS_WOOUT = al256(WS_WEOUT + (size_t)2 * D * D * 2);
constexpr size_t WS_WGU = al256(WS_WOOUT + (size_t)2 * D * D * 2);
constexpr size_t WS_WDN = al256(WS_WGU + (size_t)NE * 1024 * D * 2);
constexpr size_t WS_WLT = al256(WS_WDN + (size_t)NE * D * DE * 2);
constexpr size_t WS_UO = al256(WS_WLT + (size_t)2 * 196608 * 2);
constexpr size_t WS_SCR = al256(WS_UO + (size_t)NTOK * D * 2);
constexpr size_t SE_PQK = 0;
constexpr size_t SE_VT = al256(SE_PQK + (size_t)NTOK * 1024 * 2);
constexpr size_t SE_PRW = al256(SE_VT + (size_t)512 * NTOK * 2);
constexpr size_t SE_PQ = 0;
constexpr size_t SE_SST = al256(SE_PQ + (size_t)rw::NCHAIN * (rw::NCH - 1) * 2 * 4096 * 4);
constexpr size_t SE_Y = al256(SE_SST + (size_t)rw::NCHAIN * rw::NCH * 4096 * 4);
constexpr size_t SE_Z = al256(SE_Y + (size_t)2 * NTOK * 512 * 2);
constexpr size_t SE_ZEND = al256(SE_Z + (size_t)2 * NTOK * 512 * 2);
constexpr size_t SE_PRWEND = al256(SE_PRW + (size_t)NTOK * RW_IN * 2);
constexpr size_t SE_SH = SE_PRWEND > SE_ZEND ? SE_PRWEND : SE_ZEND;
constexpr size_t SE_DR = al256(SE_SH + (size_t)NTOK * 512 * 8);
constexpr size_t SE_CS = al256(SE_DR + (size_t)2 * NTOK * 512 * 4);
constexpr size_t SE_END = al256(SE_CS + (size_t)2 * NTOK * 16 * 4);
constexpr size_t SE_YBUF = 0;
constexpr size_t SO_PQK = 0;
constexpr size_t SO_VT = al256(SO_PQK + (size_t)NTOK * 2048 * 2);
constexpr size_t SO_O12 = al256(SO_VT + (size_t)1024 * NTOK * 2);
constexpr size_t SO_END = al256(SO_O12 + (size_t)NTOK * 2048 * 2);
constexpr size_t SO_YBUF = 0;
constexpr size_t SM_XS = 0;
constexpr size_t SM_HE = al256(SM_XS + (size_t)MOE_ROWS * D * 2);
constexpr size_t SM_YS = al256(SM_HE + (size_t)MOE_ROWS * DE * 2);
constexpr size_t SM_END = al256(SM_YS + (size_t)MOE_ROWS * D * 2);
constexpr size_t SCR_BYTES = SE_END > SO_END ? (SE_END > SM_END ? SE_END : SM_END) : (SO_END > SM_END ? SO_END : SM_END);
constexpr size_t WS_END = WS_SCR + SCR_BYTES;
constexpr int LDS_BARW = 131072;
constexpr int LDS_MISC = 131072 + 64;

struct Params {
  const float *x, *c, *ctx, *c_ctx, *ada_w, *ada_b, *ln_g, *ln_b, *even_w_in, *even_w_out, *shift_w, *na_rpb, *rw_w0, *rw_w_up, *rw_a0, *rw_a_up, *rw_g_up, *rw_k_k, *rw_k_a, *rw_r_k,
      *rw_gn_g, *rw_gn_b, *odd_w_in, *odd_w_out, *da_lq1, *da_lk1, *da_lq2, *da_lk2, *da_subln_g, *router_w, *router_b, *exp_w_gate, *exp_w_up, *exp_w_down;
  float* out; unsigned char* ws; int ph_lo, ph_hi;
};
template <class Tp> __device__ __forceinline__ Tp* wsp(const Params& p, size_t off) { return (Tp*)(p.ws + off); }

__device__ __forceinline__ void ada_unit(const Params& p, int u, LAS float* lds) {
  LAS float* sc = lds; LAS float* red = lds + 5 * 1024;
  const int tid = mk::otid(), l = u / 96, n = (u % 96) * 64 + (tid & 63), kp = tid >> 6;
  for (int i = tid; i < 5 * 1024; i += NTHR) { const float v = i < 4096 ? p.c[i] : p.c_ctx[i - 4096]; sc[i] = siluf_(v); }
  __syncthreads();
  float a[5] = {0.f, 0.f, 0.f, 0.f, 0.f};
  const float* w = p.ada_w + ((size_t)l * D + kp * 128) * 6144 + n;
#pragma unroll 4
  for (int k = 0; k < 128; ++k) { const float wv = w[(size_t)k * 6144]; const int kk = kp * 128 + k;
#pragma unroll
    for (int r = 0; r < 5; ++r) a[r] = fmaf(sc[r * 1024 + kk], wv, a[r]); }
#pragma unroll
  for (int r = 0; r < 5; ++r) red[(kp * 5 + r) * 64 + (tid & 63)] = a[r];
  __syncthreads();
  if (tid < 320) { const int r = tid >> 6, nn = tid & 63; float s = 0.f;
#pragma unroll
    for (int q = 0; q < 8; ++q) s += red[(q * 5 + r) * 64 + nn];
    const int col = (u % 96) * 64 + nn;
    wsp<float>(p, WS_MOD)[((size_t)l * 5 + r) * 6144 + col] = s + p.ada_b[l * 6144 + col]; }
  __syncthreads();
}
__device__ __forceinline__ void phase_prologue(const Params& p, LAS unsigned char* lds) {
  const int bid = mk::obid(), nb = gridDim.x; LAS float* tile = (LAS float*)lds;
  int ub = 0;
  for (int i = 0; i < 2; ++i) ub += cvt_matrix(p.even_w_in + (size_t)i * D * EVEN_IN, EVEN_IN, D, EVEN_IN, wsp<bf16_t>(p, WS_WEIN) + (size_t)i * EVEN_IN * D, NMapId{0}, tile, ub, bid, nb);
  for (int i = 0; i < 2; ++i) ub += cvt_matrix(p.odd_w_in + (size_t)i * D * ODD_IN, ODD_IN, D, ODD_IN, wsp<bf16_t>(p, WS_WOIN) + (size_t)i * ODD_IN * D, NMapRope{}, tile, ub, bid, nb);
  for (int i = 0; i < 2; ++i) ub += cvt_matrix(p.even_w_out + (size_t)i * D * D, D, D, D, wsp<bf16_t>(p, WS_WEOUT) + (size_t)i * D * D, NMapId{0}, tile, ub, bid, nb);
  for (int i = 0; i < 2; ++i) ub += cvt_matrix(p.odd_w_out + (size_t)i * D * D, D, D, D, wsp<bf16_t>(p, WS_WOOUT) + (size_t)i * D * D, NMapId{0}, tile, ub, bid, nb);
  for (int i = 0; i < 2; ++i) { bf16_t* wl = wsp<bf16_t>(p, WS_WLT) + (size_t)i * 196608;
    for (int d = 0; d < 2; ++d) { ub += cvt_matrix(p.rw_w_up + (size_t)(i * 2 + d) * 64 * 512, 512, 64, 512, wl + (size_t)d * 32768, NMapId{0}, tile, ub, bid, nb);
      ub += cvt_matrix(p.rw_a_up + (size_t)(i * 2 + d) * 64 * 512, 512, 64, 512, wl + (size_t)(2 + d) * 32768, NMapId{0}, tile, ub, bid, nb); }
    ub += cvt_matrix(p.rw_g_up + (size_t)i * 128 * 512, 512, 128, 512, wl + (size_t)4 * 32768, NMapId{0}, tile, ub, bid, nb); }
  for (int u = (bid + nb - ub % nb) % nb; u < 384; u += nb) ada_unit(p, u, (LAS float*)lds);
  const int gt = bid * NTHR + mk::otid();
  if (gt < 128 * 16) { const int pos = gt >> 4, i = gt & 15; const float inv = exp2f(-(float)i * (13.287712379549449f / 16.0f)); float sn, cs; sincosf((float)pos * inv, &sn, &cs);
    wsp<float>(p, WS_ROPE)[gt * 2] = cs; wsp<float>(p, WS_ROPE)[gt * 2 + 1] = sn; }
}
#define CVT_JOB(u_, src_, dst_, ld_, K_, k0_, n0_, mode_) do { const int e_ = (u_) / 384, rem_ = (u_) % 384, v_ = rem_ & 127; mode_ = rem_ >> 7; const size_t so_ = ((size_t)l * NE + e_) * D * DE; \
    const bool dn_ = mode_ == 2; src_ = (dn_ ? wd_ : (mode_ == 0 ? wg_ : wu_)) + so_; ld_ = dn_ ? D : DE; K_ = dn_ ? DE : D; \
    k0_ = (dn_ ? (v_ >> 4) : (v_ >> 3)) * 64; n0_ = (dn_ ? (v_ & 15) : (v_ & 7)) * 64; dst_ = dn_ ? wsp<bf16_t>(p, WS_WDN) + (size_t)e_ * D * DE : wsp<bf16_t>(p, WS_WGU) + (size_t)e_ * 1024 * D; } while (0)
__device__ __forceinline__ void cvt_experts(const Params& p, int l, LAS float* tile, int b0) {
  const int bid = mk::obid() - b0, nb = (int)gridDim.x - b0, t = mk::otid();
  if (bid < 0) return;
  const float* wg_ = p.exp_w_gate; const float* wu_ = p.exp_w_up; const float* wd_ = p.exp_w_down; asm volatile("" : "+s"(wg_), "+s"(wu_), "+s"(wd_));
  constexpr int NJ = NE * 384;
  int u = bid;
  if (u >= NJ) return;
  const float* csrc; bf16_t* cdst; int cld, cK, ck0, cn0, cmode;
  CVT_JOB(u, csrc, cdst, cld, cK, ck0, cn0, cmode);
  const int lk = t >> 3, lc = (t & 7) * 8;
  f32x4 ra, rb; { const float* q = csrc + (size_t)(ck0 + lk) * cld + cn0 + lc; ra = *(const f32x4*)q; rb = *(const f32x4*)(q + 4); }
  for (; u < NJ; u += nb) {
    const int un = u + nb < NJ ? u + nb : u;
    const float* nsrc; bf16_t* ndst; int nld, nK, nk0, nn0, nmode;
    CVT_JOB(un, nsrc, ndst, nld, nK, nk0, nn0, nmode);
    f32x4 na, nbv; { const float* q = nsrc + (size_t)(nk0 + lk) * nld + nn0 + lc; na = *(const f32x4*)q; nbv = *(const f32x4*)(q + 4); }
    { LAS float* q = tile + lk * 65 + lc; q[0] = ra[0]; q[1] = ra[1]; q[2] = ra[2]; q[3] = ra[3]; q[4] = rb[0]; q[5] = rb[1]; q[6] = rb[2]; q[7] = rb[3]; }
    __syncthreads();
    { const int n = t >> 3, kc = (t & 7) * 8; const LAS float* q = tile + kc * 65 + n;
      u32x4 w; w.x = cvt_pk_bf16(q[0], q[65]); w.y = cvt_pk_bf16(q[130], q[195]); w.z = cvt_pk_bf16(q[260], q[325]); w.w = cvt_pk_bf16(q[390], q[455]);
      const int drow = cmode == 2 ? cn0 + n : 2 * (cn0 + n) + cmode;
      *(u32x4*)(cdst + (size_t)drow * cK + ck0 + kc) = w; }
    __syncthreads();
    csrc = nsrc; cdst = ndst; cld = nld; cK = nK; ck0 = nk0; cn0 = nn0; cmode = nmode; ra = na; rb = nbv;
  }
}
#undef CVT_JOB

__device__ __forceinline__ bf16_t* hb_ptr(const Params& p, int row, bool alt) {
  if (alt) return wsp<bf16_t>(p, WS_SCR + SM_END) + (size_t)row * D;
  return row < NLAT ? (bf16_t*)p.out + (size_t)row * D : wsp<bf16_t>(p, WS_HBC) + (size_t)(row - NLAT) * D;
}
__device__ __forceinline__ const float* h0_ptr(const Params& p, int row) { return row < NLAT ? p.x + (size_t)row * D : p.ctx + (size_t)(row - NLAT) * D; }
__device__ __forceinline__ void store_bf16x4(bf16_t* dst, f32x4 v) { u32x2 w; w.x = cvt_pk_bf16(v[0], v[1]); w.y = cvt_pk_bf16(v[2], v[3]); *(u32x2*)dst = w; }
__device__ __forceinline__ f32x4 load_bf16x4(const bf16_t* src) { const u32x2 w = *(const u32x2*)src; return (f32x4){bflo(w.x), bfhi(w.x), bflo(w.y), bfhi(w.y)}; }

__device__ __forceinline__ void phase_mod0(const Params& p) {
  const int lane = mk::otid() & 63, wid = mk::otid() >> 6;
  bf16_t* U = wsp<bf16_t>(p, WS_UO);
  for (int row = mk::obid() * 8 + wid; row < NTOK; row += gridDim.x * 8) {
    const float* h = h0_ptr(p, row); const float* modl = wsp<float>(p, WS_MOD) + (size_t)bidx_of_row(row) * 6144;
#pragma unroll
    for (int q = 0; q < 4; ++q) { const int col = q * 256 + lane * 4; const f32x4 hv = *(const f32x4*)(h + col), sh = *(const f32x4*)(modl + col), sc = *(const f32x4*)(modl + 1024 + col);
      store_bf16x4(U + (size_t)row * D + col, hv * (1.0f + sc) + sh); }
  }
}
__device__ __forceinline__ void ln_row(f32x4 (&v)[4], const float* __restrict__ g, const float* __restrict__ b, int lane) {
  float s = 0.f;
#pragma unroll
  for (int q = 0; q < 4; ++q) s += (v[q][0] + v[q][1]) + (v[q][2] + v[q][3]);
  const float mu = wave_sum_u(s) * (1.0f / D);
  float qq = 0.f;
#pragma unroll
  for (int q = 0; q < 4; ++q) { const f32x4 d = v[q] - mu; qq += (d[0] * d[0] + d[1] * d[1]) + (d[2] * d[2] + d[3] * d[3]); }
  const float rstd = rsqrtf(wave_sum_u(qq) * (1.0f / D) + LN_EPS);
#pragma unroll
  for (int q = 0; q < 4; ++q) { const int col = q * 256 + lane * 4; v[q] = (v[q] - mu) * rstd * *(const f32x4*)(g + col) + *(const f32x4*)(b + col); }
}
template <bool F32IN> struct Ln1Raw;
template <> struct Ln1Raw<true> { f32x4 h[4]; u32x2 y[4]; };
template <> struct Ln1Raw<false> { u32x2 h[4]; u32x2 y[4]; };
__device__ __forceinline__ f32x4 h_as_f32(f32x4 v) { return v; }
__device__ __forceinline__ f32x4 h_as_f32(u32x2 w) { return (f32x4){bflo(w.x), bfhi(w.x), bflo(w.y), bfhi(w.y)}; }
template <bool F32IN>
__device__ __forceinline__ void ln1_load(const Params& p, const bf16_t* __restrict__ Ybuf, int row, int lane, Ln1Raw<F32IN>& r) {
#pragma unroll
  for (int q = 0; q < 4; ++q) { const int col = q * 256 + lane * 4;
    if constexpr (F32IN) r.h[q] = *(const f32x4*)(h0_ptr(p, row) + col); else r.h[q] = *(const u32x2*)(hb_ptr(p, row, false) + col);
    r.y[q] = *(const u32x2*)(Ybuf + (size_t)row * D + col); }
}
template <bool F32IN>
__device__ __forceinline__ void ln1_row(const Params& p, int l, int row, int lane, const Ln1Raw<F32IN>& raw, const LAS float* rwl, LAS int* lcnt, float rbias  , bool redir) {
  bf16_t* U2 = wsp<bf16_t>(p, WS_UO); int* eid = wsp<int>(p, WS_EID); float* gatev = wsp<float>(p, WS_GATE);
  const float* lg = p.ln_g + (size_t)(l * 2) * D; const float* lb = p.ln_b + (size_t)(l * 2) * D;
  bf16_t* ho = redir ? wsp<bf16_t>(p, WS_SCR + SM_YS) + (size_t)row * D : hb_ptr(p, row, l == DEPTH - 1); const float* modl = wsp<float>(p, WS_MOD) + ((size_t)l * 5 + bidx_of_row(row)) * 6144;
  f32x4 v[4];
#pragma unroll
  for (int q = 0; q < 4; ++q) { const int col = q * 256 + lane * 4; const f32x4 yv = (f32x4){bflo(raw.y[q].x), bfhi(raw.y[q].x), bflo(raw.y[q].y), bfhi(raw.y[q].y)};
    v[q] = ALPHA * h_as_f32(raw.h[q]) + *(const f32x4*)(modl + 2 * 1024 + col) * yv; }
  ln_row(v, lg, lb, lane);
  float acc[16];
#pragma unroll
  for (int e = 0; e < 16; ++e) acc[e] = 0.f;
#pragma unroll
  for (int q = 0; q < 4; ++q) { const int col = q * 256 + lane * 4;
    store_bf16x4(ho + col, v[q]);
    const f32x4 u = v[q] * (1.0f + *(const f32x4*)(modl + 4 * 1024 + col)) + *(const f32x4*)(modl + 3 * 1024 + col);
    store_bf16x4(U2 + (size_t)row * D + col, u);
#pragma unroll
    for (int e = 0; e < 16; ++e) { const f32x4 w = *(const LAS f32x4*)(rwl + ((q * 16 + e) * 64 + lane) * 4); acc[e] += (u[0] * w[0] + u[1] * w[1]) + (u[2] * w[2] + u[3] * w[3]); }
  }
  float t8[8], t4[4], t2[2];
#pragma unroll
  for (int i = 0; i < 8; ++i) { const u32x2 sw = __builtin_amdgcn_permlane32_swap(__float_as_uint(acc[i]), __float_as_uint(acc[8 + i]), false, false); t8[i] = __uint_as_float(sw.x) + __uint_as_float(sw.y); }
#pragma unroll
  for (int i = 0; i < 4; ++i) { const u32x2 sw = __builtin_amdgcn_permlane16_swap(__float_as_uint(t8[i]), __float_as_uint(t8[4 + i]), false, false); t4[i] = __uint_as_float(sw.x) + __uint_as_float(sw.y); }
  const bool b3 = (lane & 8) != 0, b2_ = (lane & 4) != 0;
#pragma unroll
  for (int i = 0; i < 2; ++i) { const float keep = b3 ? t4[2 + i] : t4[i], send = b3 ? t4[i] : t4[2 + i]; t2[i] = keep + dpp_mov<0x128, 0xf, 0xf>(send, send); }
  float logit;
  { const float keep = b2_ ? t2[1] : t2[0], send = b2_ ? t2[0] : t2[1];
    float recv = dpp_mov<0x104, 0xf, 0x5>(send, send);
    recv = dpp_mov<0x114, 0xf, 0xa>(recv, send);
    logit = keep + recv; }
  logit += dpp_mov<0xB1, 0xf, 0xf>(logit, logit); logit += dpp_mov<0x4E, 0xf, 0xf>(logit, logit);
  const float sg = 1.0f / (1.0f + expf(-logit)), sl = sg + rbias;
  float gs;
  { const float a = sl, b2 = dpp_mov<0x124, 0xf, 0xf>(sl, sl), c = dpp_mov<0x128, 0xf, 0xf>(sl, sl), d = dpp_mov<0x12C, 0xf, 0xf>(sl, sl);
    const float lo1 = fminf(a, b2), hi1 = fmaxf(a, b2), lo2 = fminf(c, d), hi2 = fmaxf(c, d);
    gs = fmaxf(hi1, hi2) + fmaxf(fminf(hi1, hi2), fmaxf(lo1, lo2)); }
  float best = -1e30f; int grp = 0;
#pragma unroll
  for (int gI = 0; gI < 4; ++gI) { const float g = __uint_as_float(__builtin_amdgcn_readlane(__float_as_uint(gs), gI * 16)); if (g > best) { best = g; grp = gI; } }
  grp = __builtin_amdgcn_readfirstlane(grp);
  const float v0 = __uint_as_float(__builtin_amdgcn_readlane(__float_as_uint(sl), grp * 16)), v1 = __uint_as_float(__builtin_amdgcn_readlane(__float_as_uint(sl), grp * 16 + 4)),
              v2 = __uint_as_float(__builtin_amdgcn_readlane(__float_as_uint(sl), grp * 16 + 8)), v3 = __uint_as_float(__builtin_amdgcn_readlane(__float_as_uint(sl), grp * 16 + 12));
  const float s0 = __uint_as_float(__builtin_amdgcn_readlane(__float_as_uint(sg), grp * 16)), s1 = __uint_as_float(__builtin_amdgcn_readlane(__float_as_uint(sg), grp * 16 + 4)),
              s2 = __uint_as_float(__builtin_amdgcn_readlane(__float_as_uint(sg), grp * 16 + 8)), s3 = __uint_as_float(__builtin_amdgcn_readlane(__float_as_uint(sg), grp * 16 + 12));
  int i1 = 0; float b1 = v0; if (v1 > b1) { b1 = v1; i1 = 1; } if (v2 > b1) { b1 = v2; i1 = 2; } if (v3 > b1) { b1 = v3; i1 = 3; }
  int i2 = -1; float bb = -1e30f;
  if (i1 != 0 && v0 > bb) { bb = v0; i2 = 0; } if (i1 != 1 && v1 > bb) { bb = v1; i2 = 1; } if (i1 != 2 && v2 > bb) { bb = v2; i2 = 2; } if (i1 != 3 && v3 > bb) { bb = v3; i2 = 3; }
  const float g1 = i1 == 0 ? s0 : i1 == 1 ? s1 : i1 == 2 ? s2 : s3; const float g2 = i2 == 0 ? s0 : i2 == 1 ? s1 : i2 == 2 ? s2 : s3;
  if (lane == 0) { const int e1 = grp * 4 + i1, e2 = grp * 4 + i2;
    eid[row * 2] = e1; eid[row * 2 + 1] = e2; gatev[row * 2] = g1 / (g1 + g2); gatev[row * 2 + 1] = g2 / (g1 + g2);
    __hip_atomic_fetch_add(lcnt + e1, 1, __ATOMIC_RELAXED, __HIP_MEMORY_SCOPE_WORKGROUP); __hip_atomic_fetch_add(lcnt + e2, 1, __ATOMIC_RELAXED, __HIP_MEMORY_SCOPE_WORKGROUP); }
}
template <bool F32IN>
__device__ __forceinline__ void phase_ln1(const Params& p, int l, const bf16_t* __restrict__ Ybuf, LAS unsigned char* lds, bool dry) {
  const int tid = mk::otid(), lane = tid & 63, wid = tid >> 6, bid = mk::obid();
  const bool last = l == DEPTH - 1; const int ntok = last ? NLAT : NTOK;
  LAS float* rwl = (LAS float*)lds; LAS int* lcnt = (LAS int*)(lds + 65536);
  { float rv[32];
#pragma unroll
    for (int i = 0; i < 32; ++i) rv[i] = p.router_w[tid + i * NTHR];
#pragma unroll
    for (int i = 0; i < 32; ++i) { const int idx = tid + i * NTHR, d = idx >> 4, e = idx & 15; rwl[(((d >> 8) * 16 + e) * 64 + ((d >> 2) & 63)) * 4 + (d & 3)] = rv[i]; } }
  if (tid < 16) lcnt[tid] = 0;
  __syncthreads();
  const int stride = gridDim.x * 8, row0 = bid * 8 + wid;
  const float rbias = p.router_b[lane >> 2];
  if (row0 < ntok) {
    Ln1Raw<F32IN> cur, nxt; ln1_load<F32IN>(p, Ybuf, row0, lane, cur);
    for (int row = row0; row < ntok; row += stride) {
      const int rn = row + stride < ntok ? row + stride : row;
      ln1_load<F32IN>(p, Ybuf, rn, lane, nxt);
      ln1_row<F32IN>(p, l, row, lane, cur, rwl, lcnt, rbias, dry);
      cur = nxt;
    }
  }
  __syncthreads();
  if (tid < 16) wsp<int>(p, WS_BCNT)[((size_t)l * 256 + bid) * 64 + tid] = lcnt[tid];
  __syncthreads();
}
__device__ __forceinline__ void phase_scatter(const Params& p, int l, LAS unsigned char* lds) {
  const int tid = mk::otid(), bid = mk::obid(), nb = gridDim.x;
  const bool last = l == DEPTH - 1; const int ntok = last ? NLAT : NTOK;
  LAS int* tot = (LAS int*)lds; LAS int* pre = tot + 16; LAS int* base = tot + 32; LAS int* lcur = tot + 48; LAS int* offs = tot + 64; LAS int* cnts = tot + 128;
  const int* bc = wsp<int>(p, WS_BCNT) + (size_t)l * 256 * 64;
  for (int b2 = tid; b2 < nb; b2 += NTHR) { const u32x4 c0 = *(const u32x4*)(bc + b2 * 64), c1 = *(const u32x4*)(bc + b2 * 64 + 4), c2 = *(const u32x4*)(bc + b2 * 64 + 8), c3 = *(const u32x4*)(bc + b2 * 64 + 12);
    *(LAS u32x4*)(cnts + b2 * 16) = c0; *(LAS u32x4*)(cnts + b2 * 16 + 4) = c1; *(LAS u32x4*)(cnts + b2 * 16 + 8) = c2; *(LAS u32x4*)(cnts + b2 * 16 + 12) = c3; }
  __syncthreads();
  if (tid < 16) { int t = 0, pr = 0; for (int b2 = 0; b2 < nb; ++b2) { const int v = cnts[b2 * 16 + tid]; pr += b2 < bid ? v : 0; t += v; } tot[tid] = t; pre[tid] = pr; lcur[tid] = 0; }
  __syncthreads();
  if (tid == 0) { int o = 0; int* mo = wsp<int>(p, WS_MOFF) + l * 64; for (int e = 0; e < 16; ++e) { offs[e] = o; base[e] = o + pre[e]; if (bid == 0) mo[e] = o; o += (tot[e] + 255) / 256 * 256; } offs[16] = o; if (bid == 0) mo[16] = o; }
  __syncthreads();
  const int* eid = wsp<int>(p, WS_EID); int* pos = wsp<int>(p, WS_POS); int* rl = wsp<int>(p, WS_RL);
  for (int n = tid; ; n += NTHR) { const int row = bid * 8 + (n & 7) + (n >> 3) * nb * 8; if (row >= ntok) break;
    const int e1 = eid[row * 2], e2 = eid[row * 2 + 1];
    const int p1 = base[e1] + __hip_atomic_fetch_add(lcur + e1, 1, __ATOMIC_RELAXED, __HIP_MEMORY_SCOPE_WORKGROUP), p2 = base[e2] + __hip_atomic_fetch_add(lcur + e2, 1, __ATOMIC_RELAXED, __HIP_MEMORY_SCOPE_WORKGROUP);
    pos[row * 2] = p1; pos[row * 2 + 1] = p2; rl[p1] = row; rl[p2] = row; }
  if (bid == 0) for (int e = 0; e < 16; ++e) for (int q = offs[e] + tot[e] + tid; q < offs[e + 1]; q += NTHR) rl[q] = 0;
}
struct Ln2Raw { u32x4 h[2], y1[2], y2[2]; };
__device__ __forceinline__ void ln2_load(const Params& p, bool last, int row, int lane, int p1, int p2, Ln2Raw& r) {
  const bf16_t* Ys = wsp<bf16_t>(p, WS_SCR + SM_YS); const bf16_t* ho = hb_ptr(p, row, last);
#pragma unroll
  for (int q = 0; q < 2; ++q) { const int col = q * 512 + lane * 8; r.h[q] = *(const u32x4*)(ho + col); r.y1[q] = *(const u32x4*)(Ys + (size_t)p1 * D + col); r.y2[q] = *(const u32x4*)(Ys + (size_t)p2 * D + col); }
}
__device__ __forceinline__ void unpack8(const u32x4 w, float (&o)[8]) { o[0] = bflo(w.x); o[1] = bfhi(w.x); o[2] = bflo(w.y); o[3] = bfhi(w.y); o[4] = bflo(w.z); o[5] = bfhi(w.z); o[6] = bflo(w.w); o[7] = bfhi(w.w); }
__device__ __forceinline__ void load8f(const float* q, float (&o)[8]) { const f32x4 a = *(const f32x4*)q, b = *(const f32x4*)(q + 4); o[0] = a[0]; o[1] = a[1]; o[2] = a[2]; o[3] = a[3]; o[4] = b[0]; o[5] = b[1]; o[6] = b[2]; o[7] = b[3]; }
__device__ __forceinline__ u32x4 pack8(const float (&v)[8]) { u32x4 w; w.x = cvt_pk_bf16(v[0], v[1]); w.y = cvt_pk_bf16(v[2], v[3]); w.z = cvt_pk_bf16(v[4], v[5]); w.w = cvt_pk_bf16(v[6], v[7]); return w; }
__device__ __forceinline__ void phase_ln2(const Params& p, int l, bool dry) {
  const int tid = mk::otid(), lane = tid & 63, wid = tid >> 6;
  const bool last = l == DEPTH - 1; const int ntok = last ? NLAT : NTOK;
  const int* pos = wsp<int>(p, WS_POS); const float* gatev = wsp<float>(p, WS_GATE); bf16_t* U = wsp<bf16_t>(p, WS_UO);
  const float* lg = p.ln_g + (size_t)(l * 2 + 1) * D; const float* lb = p.ln_b + (size_t)(l * 2 + 1) * D;
  const int stride = gridDim.x * 8, row0 = mk::obid() * 8 + wid;
  if (row0 >= ntok) return;
  auto clampr = [&](int r) { return r < ntok ? r : row0; };
  u32x2 pc = *(const u32x2*)(pos + 2 * row0); f32x2 gc = *(const f32x2*)(gatev + 2 * row0);
  Ln2Raw cur, nxt; ln2_load(p, last, row0, lane, (int)pc.x, (int)pc.y, cur);
  int r1 = clampr(row0 + stride);
  u32x2 pn = *(const u32x2*)(pos + 2 * r1); f32x2 gn = *(const f32x2*)(gatev + 2 * r1);
  for (int row = row0; row < ntok; row += stride) {
    ln2_load(p, last, r1, lane, (int)pn.x, (int)pn.y, nxt);
    const int r2 = clampr(row + 2 * stride);
    const u32x2 pn2 = *(const u32x2*)(pos + 2 * r2); const f32x2 gn2 = *(const f32x2*)(gatev + 2 * r2);
    bf16_t* hb = dry ? wsp<bf16_t>(p, WS_SCR + SM_XS) + (size_t)row * D : hb_ptr(p, row, false); float* hf = (dry ? wsp<float>(p, WS_SCR + SM_XS) : p.out) + (size_t)row * D; const int bi = bidx_of_row(row);
    const float* modl = wsp<float>(p, WS_MOD) + ((size_t)l * 5 + bi) * 6144;
    float v[2][8]; float s1 = 0.f;
#pragma unroll
    for (int q = 0; q < 2; ++q) { const int col = q * 512 + lane * 8; float hh[8], a1[8], a2[8], g2[8];
      unpack8(cur.h[q], hh); unpack8(cur.y1[q], a1); unpack8(cur.y2[q], a2); load8f(modl + 5 * 1024 + col, g2);
#pragma unroll
      for (int e = 0; e < 8; ++e) { v[q][e] = ALPHA * hh[e] + g2[e] * (gc[0] * a1[e] + gc[1] * a2[e]); s1 += v[q][e]; } }
    const float mu = wave_sum_u(s1) * (1.0f / D);
    float s2 = 0.f;
#pragma unroll
    for (int q = 0; q < 2; ++q)
#pragma unroll
      for (int e = 0; e < 8; ++e) { const float d = v[q][e] - mu; s2 += d * d; }
    const float rstd = rsqrtf(wave_sum_u(s2) * (1.0f / D) + LN_EPS);
    const float* modn = wsp<float>(p, WS_MOD) + ((size_t)(last ? l : l + 1) * 5 + bi) * 6144;
#pragma unroll
    for (int q = 0; q < 2; ++q) { const int col = q * 512 + lane * 8; float gg[8], bb[8];
      load8f(lg + col, gg); load8f(lb + col, bb);
#pragma unroll
      for (int e = 0; e < 8; ++e) v[q][e] = (v[q][e] - mu) * rstd * gg[e] + bb[e];
      if (last) { *(f32x4*)(hf + col) = (f32x4){v[q][0], v[q][1], v[q][2], v[q][3]}; *(f32x4*)(hf + col + 4) = (f32x4){v[q][4], v[q][5], v[q][6], v[q][7]}; }
      else { *(u32x4*)(hb + col) = pack8(v[q]); float sc[8], sh[8], u[8]; load8f(modn + 1024 + col, sc); load8f(modn + col, sh);
#pragma unroll
        for (int e = 0; e < 8; ++e) u[e] = v[q][e] * (1.0f + sc[e]) + sh[e];
        *(u32x4*)(U + (size_t)row * D + col) = pack8(u); } }
    cur = nxt; gc = gn; pn = pn2; gn = gn2; r1 = r2;
  }
}

struct SchedEvenIn { static constexpr bool GATHER = false; const bf16_t* U; const bf16_t* W; bf16_t* Pqk; bf16_t* Prw; bf16_t* Vt; int G, c;
  __device__ __forceinline__ bool next(int i, pg8::Unit& u) const { const int Lx = i * G + c; u.kind = 0;
    if (Lx < 1452) { const int grp = Lx / 44, rem = Lx % 44, pm = grp * 4 + (rem & 3), pi = rem >> 2; u.pm = pm; u.pn = pi;
      u.A = (const char*)(U + (size_t)pm * 256 * D); const int brow = pi < 4 ? pi * 256 : 1536 + (pi - 4) * 256; u.Bt = (const char*)(W + (size_t)brow * D);
      if (pi < 4) { u.out = Pqk; u.ldo = 1024; u.x1 = pi * 256; } else { u.out = Prw; u.ldo = RW_IN; u.x1 = (pi - 4) * 256; } u.x0 = pm * 256; return true; }
    if (Lx < 1452 + 264) { const int v = Lx - 1452, pmv = v & 1, pnv = v >> 1; u.pm = pmv; u.pn = pnv; u.A = (const char*)(W + (size_t)(1024 + pmv * 256) * D); u.Bt = (const char*)(U + (size_t)pnv * 256 * D);
      u.out = Vt; u.ldo = NTOK; u.x0 = pmv * 256; u.x1 = pnv * 256; return true; }
    return false; } };
struct SchedOddIn { static constexpr bool GATHER = false; const bf16_t* U; const bf16_t* W; bf16_t* Pqk; bf16_t* Vt; int G, c;
  __device__ __forceinline__ bool next(int i, pg8::Unit& u) const { const int Lx = i * G + c;
    if (Lx < 1056) { const int grp = Lx / 32, rem = Lx % 32, pm = grp * 4 + (rem & 3), pi = rem >> 2; u.pm = pm; u.pn = pi; u.kind = pm < 128 ? 1 : 0;
      u.A = (const char*)(U + (size_t)pm * 256 * D); u.Bt = (const char*)(W + (size_t)pi * 256 * D); u.out = Pqk; u.ldo = 2048; u.x0 = pm * 256; u.x1 = pi * 256; return true; }
    if (Lx < 1056 + 528) { const int v = Lx - 1056, pmv = v & 3, pnv = v >> 2; u.pm = pmv; u.pn = pnv; u.kind = 0; u.A = (const char*)(W + (size_t)(2048 + pmv * 256) * D); u.Bt = (const char*)(U + (size_t)pnv * 256 * D);
      u.out = Vt; u.ldo = NTOK; u.x0 = pmv * 256; u.x1 = pnv * 256; return true; }
    return false; } };
struct SchedOut { static constexpr bool GATHER = false; const bf16_t* O; const bf16_t* W; bf16_t* Y; int G, c;
  __device__ __forceinline__ bool next(int i, pg8::Unit& u) const { const int Lx = i * G + c; if (Lx >= 528) return false; const int pm = (Lx / 16) * 4 + (Lx & 3), pn = (Lx & 15) >> 2; u.pm = pm; u.pn = pn; u.kind = 0;
    u.A = (const char*)(O + (size_t)pm * 256 * D); u.Bt = (const char*)(W + (size_t)pn * 256 * D); u.out = Y; u.ldo = 1024; u.x0 = pm * 256; u.x1 = pn * 256; return true; } };
template <bool GATH>
struct SchedMoe { static constexpr bool GATHER = GATH; const bf16_t* A; const bf16_t* W; bf16_t* out; const LAS int* moff; const int* rl; int Kd, ldo, ncol, G, c;
  __device__ __forceinline__ bool next(int i, pg8::Unit& u) const { const int Lx = i * G + c; const int ntile = moff[16] >> 8; if (Lx >= ntile * 4) return false;
    const int pm = Lx >> 2, pn = Lx & 3; int e = 0;
#pragma unroll
    for (int j = 1; j < 16; ++j) e += (pm * 256 >= moff[j]) ? 1 : 0;
    u.pm = pm; u.pn = pn; u.kind = 0; u.A = GATH ? (const char*)A : (const char*)(A + (size_t)pm * 256 * Kd); u.rl = rl + pm * 256; u.Bt = (const char*)(W + ((size_t)e * 1024 + pn * 256) * Kd); u.out = out; u.ldo = ldo; u.x0 = pm * 256; u.x1 = pn * ncol; return true; } };

struct EpiOddIn {
  static constexpr bool PERM = true; const float* rope;
  __device__ __forceinline__ void operator()(const f32x4 (&acc)[2][2][4][2], const pg8::Unit& u, int wr, int wc, int fr, int fq) const {
    if (u.kind == 0) { pg8::EpiStoreBf16{}(acc, u, wr, wc, fr, fq); return; }
    const int row0 = u.x0 + wr * 64 + fr, col0 = u.x1 + wc * 32 + 8 * fq; const int half = wc & 1;
#pragma unroll
    for (int ai = 0; ai < 2; ++ai)
#pragma unroll
      for (int m = 0; m < 4; ++m) { const int row = row0 + ai * 128 + m * 16; const int t = row & (T - 1); const int pos = half ? (t & 63) : (t >> 6);
        const f32x4 cs0 = *(const f32x4*)(rope + (pos * 16 + 4 * fq) * 2), cs1 = *(const f32x4*)(rope + (pos * 16 + 4 * fq + 2) * 2);
        bf16_t* rowp = u.out + (size_t)row * u.ldo + col0;
#pragma unroll
        for (int bj = 0; bj < 2; ++bj) { const f32x4 v0 = acc[ai][bj][m][0], v1 = acc[ai][bj][m][1];
          u32x4 w; w.x = cvt_pk_bf16(v0[0] * cs0[0] - v0[1] * cs0[1], v0[0] * cs0[1] + v0[1] * cs0[0]); w.y = cvt_pk_bf16(v0[2] * cs0[2] - v0[3] * cs0[3], v0[2] * cs0[3] + v0[3] * cs0[2]);
          w.z = cvt_pk_bf16(v1[0] * cs1[0] - v1[1] * cs1[1], v1[0] * cs1[1] + v1[1] * cs1[0]); w.w = cvt_pk_bf16(v1[2] * cs1[2] - v1[3] * cs1[3], v1[2] * cs1[3] + v1[3] * cs1[2]);
          *(u32x4*)(rowp + bj * 128) = w; } }
  }
};
struct EpiGateUp {
  static constexpr bool PERM = true;
  __device__ __forceinline__ void operator()(const f32x4 (&acc)[2][2][4][2], const pg8::Unit& u, int wr, int wc, int fr, int fq) const {
    const int row0 = u.x0 + wr * 64 + fr, col0 = u.x1 + wc * 16 + 4 * fq;
#pragma unroll
    for (int ai = 0; ai < 2; ++ai)
#pragma unroll
      for (int m = 0; m < 4; ++m) { bf16_t* rowp = u.out + (size_t)(row0 + ai * 128 + m * 16) * u.ldo + col0;
#pragma unroll
        for (int bj = 0; bj < 2; ++bj) { const f32x4 v0 = acc[ai][bj][m][0], v1 = acc[ai][bj][m][1];
          u32x2 w; w.x = cvt_pk_bf16(silu_r(v0[0]) * v0[1], silu_r(v0[2]) * v0[3]); w.y = cvt_pk_bf16(silu_r(v1[0]) * v1[1], silu_r(v1[2]) * v1[3]);
          *(u32x2*)(rowp + bj * 64) = w; } }
  }
};
}

namespace mk {
constexpr int N_PHASES = 2 + 2 * (12 + 10);
__global__ void __launch_bounds__(NTHR, 2) mega(Params p_) {
  const Params& p = p_;
  extern __shared__ __attribute__((aligned(16))) unsigned char shm[];
  LAS unsigned char* lds = (LAS unsigned char*)shm;
  const int nb = gridDim.x;
  if (threadIdx.x == 0) *(LAS u32x4*)(lds + LDS_BARW) = (u32x4){0u, 0u, 0u, 0u};
  __syncthreads();
  XcdBarrier bar = xcd_barrier_post(wsp<unsigned>(p, WS_BAR), (volatile LAS unsigned*)(lds + LDS_BARW));
  int ph = 0;
#ifndef MK_MASK
#define MK_MASK 0xFFFFFFFFu
#endif
#ifndef MK_REP
#define MK_REP 0u
#endif
#define PHASE_BEGIN_K(k) if (((MK_MASK) >> (k)) & 1u) { Params pl_ = p_; asm volatile("" : "+s"(pl_.ws)); const Params& p = pl_; bf16_t* UO = wsp<bf16_t>(p, WS_UO); unsigned char* scr = p.ws + WS_SCR; (void)UO; (void)scr; \
    const int bid = mk::obid(); const int nrep_ = ((((MK_REP) >> (k)) & 1u) ? 2 : 1); for (int rep_ = 0; rep_ < nrep_; ++rep_) { const bool dry = rep_ + 1 < nrep_; (void)dry;
#define PHASE_END   } if (ph + 1 < N_PHASES) { XcdBarrier b_ = bar; asm volatile("" : "+s"(b_.bar), "+s"(b_.x)); xcd_barrier(b_); } } ++ph;
  bf16_t* UO = wsp<bf16_t>(p, WS_UO);
  unsigned char* scr = p.ws + WS_SCR;
  PHASE_BEGIN_K(0) phase_prologue(p, lds); PHASE_END
  PHASE_BEGIN_K(1) phase_mod0(p); PHASE_END
  for (int lp = 0; lp < 2; ++lp) {
    {
      const int l = 2 * lp;
      bf16_t* Pqk = (bf16_t*)(scr + SE_PQK); bf16_t* Vt = (bf16_t*)(scr + SE_VT); bf16_t* Prw = (bf16_t*)(scr + SE_PRW); bf16_t* Ybuf = (bf16_t*)(scr + SE_YBUF);
      rw::Bufs bf; bf.SH = (u32x2*)(scr + SE_SH); bf.DR = (unsigned*)(scr + SE_DR); bf.G = UO + 512; bf.gstride = 1024; bf.CS = (float*)(scr + SE_CS) + (size_t)lp * NTOK * 16; bf.PQ = (float*)(scr + SE_PQ); bf.SST = (float*)(scr + SE_SST); bf.Y = (bf16_t*)(scr + SE_Y); bf.Z = (bf16_t*)(scr + SE_Z);
      PHASE_BEGIN_K(2) { SchedEvenIn S{UO, wsp<bf16_t>(p, WS_WEIN) + (size_t)lp * EVEN_IN * D, Pqk, Prw, Vt, nb, bid}; pg8::gemm_phase(lds, D, S, pg8::EpiStoreBf16{}); } PHASE_END
      PHASE_BEGIN_K(3) {
#ifdef MK_P3
        if (!(dry && MK_P3 == 2))
#endif
        for (int u = bid; u < 1024 + 32; u += nb) { int b, h, rq; if (u < 1024) { b = u >> 8; h = (u >> 5) & 7; rq = u & 31; } else { const int v = u - 1024; b = v >> 3; h = v & 7; rq = -1; }
          natt::na_attn_unit(Pqk, Vt, p.na_rpb + ((size_t)lp * 8 + h) * 465, UO, b, h, rq, lds); }
        const int pb = (bid + nb / 2) % nb;
#ifdef MK_P3
        if (!(dry && MK_P3 == 1))
#endif
        for (int t = pb; t < NTOK / 16; t += nb) rw::prep_tile(Prw, p.shift_w + (size_t)lp * 3 * RW_IN, p.rw_w0 + lp * 1024, wsp<bf16_t>(p, WS_WLT) + (size_t)lp * 196608, p.rw_a0 + lp * 1024, p.rw_k_k + lp * 512, p.rw_k_a + lp * 512, p.rw_r_k + lp * 512, bf, t, (LAS float*)lds); } PHASE_END
      PHASE_BEGIN_K(4) for (int u = bid * 8 + (mk::otid() >> 6); u < rw::NCHAIN * rw::NCH; u += nb * 8) rw::scan_unit(bf, p.rw_k_a + lp * 512, u / rw::NCH, u % rw::NCH, (LAS float*)lds + (mk::otid() >> 6) * 4096); PHASE_END
      PHASE_BEGIN_K(5) for (int c = bid; c < rw::NCHAIN * 4; c += nb) rw::propagate_chain(bf, c >> 2, c & 3, (LAS float*)lds); PHASE_END
      PHASE_BEGIN_K(6) for (int u = bid * 8 + (mk::otid() >> 6); u < rw::NCHAIN * (rw::NCH - 1); u += nb * 8) rw::corr_unit(bf, u / (rw::NCH - 1), 1 + u % (rw::NCH - 1)); PHASE_END
      PHASE_BEGIN_K(7) rw::finish_phase<8>(bf, p.rw_gn_g + lp * 512, p.rw_gn_b + lp * 512, UO); PHASE_END
      PHASE_BEGIN_K(8) { SchedOut S{UO, wsp<bf16_t>(p, WS_WEOUT) + (size_t)lp * D * D, Ybuf, nb, bid}; pg8::gemm_phase(lds, D, S, pg8::EpiStoreBf16{}); __syncthreads(); cvt_experts(p, l, (LAS float*)lds, 528 - 2 * nb > 0 ? 528 - 2 * nb : 0); } PHASE_END
      PHASE_BEGIN_K(9) if (l == 0) phase_ln1<true>(p, l, Ybuf, lds, dry); else phase_ln1<false>(p, l, Ybuf, lds, dry); PHASE_END
      PHASE_BEGIN_K(10) phase_scatter(p, l, lds); PHASE_END
      PHASE_BEGIN_K(11) { LAS int* mo = (LAS int*)(lds + LDS_MISC); { const int tq = mk::otid(); if (tq < 17) mo[tq] = wsp<int>(p, WS_MOFF)[l * 64 + tq]; } __syncthreads();
        SchedMoe<true> S{UO, wsp<bf16_t>(p, WS_WGU), (bf16_t*)(scr + SM_HE), mo, wsp<int>(p, WS_RL), D, DE, 128, nb, bid}; pg8::gemm_phase(lds, D, S, EpiGateUp{}); } PHASE_END
      PHASE_BEGIN_K(12) { LAS int* mo = (LAS int*)(lds + LDS_MISC); { const int tq = mk::otid(); if (tq < 17) mo[tq] = wsp<int>(p, WS_MOFF)[l * 64 + tq]; } __syncthreads();
        SchedMoe<false> S{(bf16_t*)(scr + SM_HE), wsp<bf16_t>(p, WS_WDN), (bf16_t*)(scr + SM_YS), mo, nullptr, DE, D, 256, nb, bid}; pg8::gemm_phase(lds, DE, S, pg8::EpiStoreBf16{}); } PHASE_END
      PHASE_BEGIN_K(13) phase_ln2(p, l, dry); PHASE_END
    }
    {
      const int l = 2 * lp + 1; const bool last = l == DEPTH - 1;
      bf16_t* Pqk = (bf16_t*)(scr + SO_PQK); bf16_t* Vt = (bf16_t*)(scr + SO_VT); bf16_t* O12 = (bf16_t*)(scr + SO_O12); bf16_t* Ybuf = (bf16_t*)(scr + SO_YBUF);
      PHASE_BEGIN_K(14) { SchedOddIn S{UO, wsp<bf16_t>(p, WS_WOIN) + (size_t)lp * ODD_IN * D, Pqk, Vt, nb, bid}; pg8::gemm_phase(lds, D, S, EpiOddIn{wsp<float>(p, WS_ROPE)}); } PHASE_END
      float* KN = wsp<float>(p, WS_KN) + (size_t)lp * 256 * 32;
      PHASE_BEGIN_K(23) for (int g = bid; g < 256; g += nb) att::knorm_group(Pqk, KN, g, (LAS float*)lds); PHASE_END
      PHASE_BEGIN_K(15) for (int ui = bid; ui < 2048 + (last ? 0 : 64); ui += nb) { int b, hh, q0, nlat; const int u = (nb == 256 && ui < 2048) ? ((((ui >> 8) * 8 + (bid & 7)) << 5) | (bid >> 3)) : ui;
        if (u < 2048) { b = u >> 9; hh = (u >> 5) & 15; q0 = b * T + (u & 31) * 256; nlat = T; } else { const int v = u - 2048; b = v >> 4; hh = v & 15; q0 = NLAT + b * L; nlat = 0; }
        const bool st = __builtin_amdgcn_sqrtf(att::nmax2_of(KN, b, hh, 0) * att::nmax2_of(KN, b, hh, 1)) * 1.001f <= 60.0f;
#ifdef MK_ABL
        if (dry) att::diff_attn_unit<true, MK_ABL>(Pqk, Vt, O12, hh, q0, b * T, nlat, NLAT + b * L, lds); else
#endif
        if (st) att::diff_attn_unit<true>(Pqk, Vt, O12, hh, q0, b * T, nlat, NLAT + b * L, lds); else att::diff_attn_unit<false>(Pqk, Vt, O12, hh, q0, b * T, nlat, NLAT + b * L, lds); } PHASE_END
      PHASE_BEGIN_K(16) { float d1 = 0.f, d2 = 0.f; for (int i = 0; i < 64; ++i) { d1 += p.da_lq1[lp * 64 + i] * p.da_lk1[lp * 64 + i]; d2 += p.da_lq2[lp * 64 + i] * p.da_lk2[lp * 64 + i]; }
        const float li = 0.8f - 0.6f * expf(-0.3f * (float)l), lam = expf(d1) - expf(d2) + li;
        const int tq = mk::otid(); for (int r4 = bid; r4 < (last ? NLAT : NTOK) / 4; r4 += nb) att::diff_combine_rows4(O12, p.da_subln_g + lp * 128, lam, 1.0f - li, UO, r4 * 4, tq >> 6, tq & 63); } PHASE_END
      PHASE_BEGIN_K(17) { SchedOut S{UO, wsp<bf16_t>(p, WS_WOOUT) + (size_t)lp * D * D, Ybuf, nb, bid}; pg8::gemm_phase(lds, D, S, pg8::EpiStoreBf16{}); __syncthreads(); cvt_experts(p, l, (LAS float*)lds, 528 - 2 * nb > 0 ? 528 - 2 * nb : 0); } PHASE_END
      PHASE_BEGIN_K(18) phase_ln1<false>(p, l, Ybuf, lds, dry); PHASE_END
      PHASE_BEGIN_K(19) phase_scatter(p, l, lds); PHASE_END
      PHASE_BEGIN_K(20) { LAS int* mo = (LAS int*)(lds + LDS_MISC); { const int tq = mk::otid(); if (tq < 17) mo[tq] = wsp<int>(p, WS_MOFF)[l * 64 + tq]; } __syncthreads();
        SchedMoe<true> S{UO, wsp<bf16_t>(p, WS_WGU), (bf16_t*)(scr + SM_HE), mo, wsp<int>(p, WS_RL), D, DE, 128, nb, bid}; pg8::gemm_phase(lds, D, S, EpiGateUp{}); } PHASE_END
      PHASE_BEGIN_K(21) { LAS int* mo = (LAS int*)(lds + LDS_MISC); { const int tq = mk::otid(); if (tq < 17) mo[tq] = wsp<int>(p, WS_MOFF)[l * 64 + tq]; } __syncthreads();
        SchedMoe<false> S{(bf16_t*)(scr + SM_HE), wsp<bf16_t>(p, WS_WDN), (bf16_t*)(scr + SM_YS), mo, nullptr, DE, D, 256, nb, bid}; pg8::gemm_phase(lds, DE, S, pg8::EpiStoreBf16{}); } PHASE_END
      PHASE_BEGIN_K(22) phase_ln2(p, l, dry); PHASE_END
    }
  }
#undef PHASE_BEGIN_K
#undef PHASE_END
}
}

#ifndef MK_SINGLE_LAUNCH
#define MK_SINGLE_LAUNCH 1
#endif
extern "C" void kernel_launch(void* const* d_in, const int* in_sizes, int n_in, void* d_out, int out_size, void* d_ws, size_t ws_size, hipStream_t stream) {
  using namespace mk;
  static int grid = 0;
  if (grid == 0) {
    if (n_in != 34 || out_size != NLAT * D || ws_size < WS_END) { fprintf(stderr, "kernel_launch: unexpected shapes (n_in %d out %d ws %zu need %zu)\n", n_in, out_size, ws_size, (size_t)WS_END); grid = -1; return; }
    if (hipFuncSetAttribute((const void*)mega, hipFuncAttributeMaxDynamicSharedMemorySize, LDS_BYTES) != hipSuccess) { grid = -1; return; }
    int dev = 0, cus = 0, per_cu = 0;
    if (hipGetDevice(&dev) != hipSuccess || hipDeviceGetAttribute(&cus, hipDeviceAttributeMultiprocessorCount, dev) != hipSuccess) { grid = -1; return; }
    if (hipOccupancyMaxActiveBlocksPerMultiprocessor(&per_cu, (const void*)mega, NTHR, LDS_BYTES) != hipSuccess || per_cu < 1) { fprintf(stderr, "kernel_launch: occupancy query says %d\n", per_cu); }
    (void)hipGetLastError();
    grid = cus;
  }
  if (grid < 0) return;
  (void)hipMemsetAsync((char*)d_ws + WS_BAR, 0, (size_t)XCD_BAR_WORDS * 4, stream);
  Params p{};
  const float** pp = (const float**)&p;
  for (int i = 0; i < 34; ++i) pp[i] = (const float*)d_in[i];
  p.out = (float*)d_out; p.ws = (unsigned char*)d_ws;
#if MK_SINGLE_LAUNCH
  p.ph_lo = 0; p.ph_hi = N_PHASES;
  hipLaunchKernelGGL(mega, dim3(grid), dim3(NTHR), LDS_BYTES, stream, p);
#else
  for (int ph = 0; ph < N_PHASES; ++ph) { p.ph_lo = ph; p.ph_hi = ph + 1; hipLaunchKernelGGL(mega, dim3(grid), dim3(NTHR), LDS_BYTES, stream, p); }
#endif
}
```

```cpp
#include <hip/hip_runtime.h>
#include <stdint.h>
#include <stdio.h>

typedef unsigned short bf16_t;
typedef short bf16x8 __attribute__((ext_vector_type(8)));
typedef float f32x4 __attribute__((ext_vector_type(4)));
typedef float f32x2 __attribute__((ext_vector_type(2)));
typedef float f32x16 __attribute__((ext_vector_type(16)));
typedef unsigned u32x4 __attribute__((ext_vector_type(4)));
typedef unsigned u32x2 __attribute__((ext_vector_type(2)));
#define LAS __attribute__((address_space(3)))

namespace mk {
constexpr int B = 4, T = 8192, L = 256, D = 1024, NLAT = B * T, NCTX = B * L, NTOK = NLAT + NCTX;
constexpr int DEPTH = 4, EVEN_IN = 3328, ODD_IN = 3072, RW_OFF = 1536, RW_IN = 1792, NE = 16, DE = 512;
constexpr float ALPHA = 1.681792830507429f, LN_EPS = 1e-5f;
constexpr int NTHR = 512, LDS_BYTES = 147456;
constexpr int MOE_TILES = 280, MOE_ROWS = MOE_TILES * 256;

typedef __bf16 bf16x2v __attribute__((ext_vector_type(2)));
__device__ __forceinline__ unsigned cvt_pk_bf16(float lo, float hi) { const f32x2 v = {lo, hi}; return __builtin_bit_cast(unsigned, __builtin_convertvector(v, bf16x2v)); }
__device__ __forceinline__ unsigned cvt_pk_bf16_v(float lo, float hi) { return cvt_pk_bf16(lo, hi); }
template <int V> struct IntC { static constexpr int value = V; };
__device__ __forceinline__ float bf2f(bf16_t b) { return __uint_as_float(((unsigned)b) << 16); }
__device__ __forceinline__ float bflo(unsigned w) { return __uint_as_float(w << 16); }
__device__ __forceinline__ float bfhi(unsigned w) { return __uint_as_float(w & 0xffff0000u); }
__device__ __forceinline__ bf16_t f2bf(float f) { return (bf16_t)(cvt_pk_bf16(f, 0.f) & 0xffffu); }
__device__ __forceinline__ float sigmoidf_(float x) { return 1.0f / (1.0f + __expf(-x)); }
__device__ __forceinline__ float siluf_(float x) { return x / (1.0f + __expf(-x)); }
__device__ __forceinline__ float sigmoid_r(float x) { return __builtin_amdgcn_rcpf(1.0f + __expf(-x)); }
__device__ __forceinline__ float silu_r(float x) { return x * __builtin_amdgcn_rcpf(1.0f + __expf(-x)); }
__device__ __forceinline__ float wave_sum(float v) {
#pragma unroll
  for (int o = 32; o > 0; o >>= 1) v += __shfl_xor(v, o);
  return v;
}
template <int CTRL, int RM, int BM> __device__ __forceinline__ float dpp_mov(float old, float v) { return __int_as_float(__builtin_amdgcn_update_dpp(__float_as_int(old), __float_as_int(v), CTRL, RM, BM, false)); }
__device__ __forceinline__ float wave_sum_u(float v) {
  v += dpp_mov<0xB1, 0xf, 0xf>(v, v);
  v += dpp_mov<0x4E, 0xf, 0xf>(v, v);
  v += dpp_mov<0x141, 0xf, 0xf>(v, v);
  v += dpp_mov<0x140, 0xf, 0xf>(v, v);
  v += dpp_mov<0x142, 0xa, 0xf>(0.f, v);
  v += dpp_mov<0x143, 0xc, 0xf>(0.f, v);
  return __int_as_float(__builtin_amdgcn_readlane(__float_as_int(v), 63));
}
__device__ __forceinline__ float wave_max_u(float v) {
  v = fmaxf(v, dpp_mov<0xB1, 0xf, 0xf>(v, v));
  v = fmaxf(v, dpp_mov<0x4E, 0xf, 0xf>(v, v));
  v = fmaxf(v, dpp_mov<0x141, 0xf, 0xf>(v, v));
  v = fmaxf(v, dpp_mov<0x140, 0xf, 0xf>(v, v));
  v = fmaxf(v, dpp_mov<0x142, 0xa, 0xf>(0.f, v));
  v = fmaxf(v, dpp_mov<0x143, 0xc, 0xf>(0.f, v));
  return __int_as_float(__builtin_amdgcn_readlane(__float_as_int(v), 63));
}
__device__ __forceinline__ float reduce_scatter16(const float (&acc)[16], int lane) {
  float t8[8], t4[4], t2[2];
#pragma unroll
  for (int i = 0; i < 8; ++i) { const u32x2 sw = __builtin_amdgcn_permlane32_swap(__float_as_uint(acc[i]), __float_as_uint(acc[8 + i]), false, false); t8[i] = __uint_as_float(sw.x) + __uint_as_float(sw.y); }
#pragma unroll
  for (int i = 0; i < 4; ++i) { const u32x2 sw = __builtin_amdgcn_permlane16_swap(__float_as_uint(t8[i]), __float_as_uint(t8[4 + i]), false, false); t4[i] = __uint_as_float(sw.x) + __uint_as_float(sw.y); }
  const bool b3 = (lane & 8) != 0, b2_ = (lane & 4) != 0;
#pragma unroll
  for (int i = 0; i < 2; ++i) { const float keep = b3 ? t4[2 + i] : t4[i], send = b3 ? t4[i] : t4[2 + i]; t2[i] = keep + dpp_mov<0x128, 0xf, 0xf>(send, send); }
  float tot;
  { const float keep = b2_ ? t2[1] : t2[0], send = b2_ ? t2[0] : t2[1];
    float recv = dpp_mov<0x104, 0xf, 0x5>(send, send);
    recv = dpp_mov<0x114, 0xf, 0xa>(recv, send);
    tot = keep + recv; }
  tot += dpp_mov<0xB1, 0xf, 0xf>(tot, tot); tot += dpp_mov<0x4E, 0xf, 0xf>(tot, tot);
  return tot;
}
__device__ __forceinline__ f32x16 zero16() { float z = 0.f; asm volatile("" : "+v"(z)); f32x16 r;
#pragma unroll
  for (int i = 0; i < 16; ++i) r[i] = z;
  return r; }
__device__ __forceinline__ int otid() { int t = threadIdx.x; asm volatile("" : "+v"(t)); return t; }
__device__ __forceinline__ int obid() { int b = blockIdx.x; asm volatile("" : "+s"(b)); return b; }
__device__ __forceinline__ int bidx_of_row(int row) { return row < NLAT ? row / T : 4; }
}

#include <vector>

#define XB_TMO      128
#define XB_XCNT(j)  (256  + 64 * (j))
#define XB_XSUB(j)  (1280 + 64 * (j))
#define XB_XGEN(j)  (2304 + 64 * (j))
#define XB_TOP      3328
#define XB_TOPGEN   3392
#define XCD_BAR_WORDS 3456
#define XB_SPIN_CAP (1u << 18)
#define LAS __attribute__((address_space(3)))

__device__ __forceinline__ unsigned xb_ld(unsigned* p)              { return __hip_atomic_load(p, __ATOMIC_RELAXED, __HIP_MEMORY_SCOPE_AGENT); }
__device__ __forceinline__ unsigned xb_add(unsigned* p, unsigned v) { return __hip_atomic_fetch_add(p, v, __ATOMIC_RELAXED, __HIP_MEMORY_SCOPE_AGENT); }
__device__ __forceinline__ unsigned xb_xcc_id() { return (unsigned)__builtin_amdgcn_s_getreg((3 << 11) | 20) & 0xFu; }
#define XB_SPIN(cond, bar) do { unsigned _sp = 0; while (cond) { __builtin_amdgcn_s_sleep(1); \
    if ((++_sp & 255u) == 0u) { if (xb_ld(&(bar)[XB_TMO])) break; if (_sp > XB_SPIN_CAP) { atomicAdd(&(bar)[XB_TMO], 1u); break; } } } } while (0)

struct XcdBarrier {
    unsigned* bar; unsigned x;
    volatile LAS unsigned* st;
};

__device__ __forceinline__ XcdBarrier xcd_barrier_post(unsigned* bar, volatile LAS unsigned* st) {
    XcdBarrier b; b.bar = bar; b.x = xb_xcc_id(); b.st = st;
    if (threadIdx.x == 0) (void)xb_add(&bar[XB_XCNT(b.x)], 1u);
    return b;
}
__device__ __forceinline__ void xcd_barrier_complete(unsigned* bar, unsigned x, unsigned& nloc, unsigned& nx) {
    const unsigned G = gridDim.x * gridDim.y * gridDim.z;
    unsigned sum, cnt, mine, sp = 0u;
    for (;;) {
        sum = 0u; cnt = 0u; mine = 0u;
#pragma unroll
        for (unsigned j = 0; j < 16; ++j) { const unsigned c = xb_ld(&bar[XB_XCNT(j)]); sum += c; cnt += (c > 0u) ? 1u : 0u; mine = (j == x) ? c : mine; }
        if (sum == G) break;
        __builtin_amdgcn_s_sleep(1);
        if ((++sp & 255u) == 0u) { if (xb_ld(&bar[XB_TMO])) break; if (sp > XB_SPIN_CAP) { atomicAdd(&bar[XB_TMO], 1u); break; } }
    }
    nloc = mine > 0u ? mine : 1u; nx = cnt > 0u ? cnt : 1u;
}

__device__ __forceinline__ void xcd_barrier(const XcdBarrier& b) {
    asm volatile("s_waitcnt vmcnt(0)" ::: "memory");
    __syncthreads();
    if (threadIdx.x == 0) {
        unsigned* bar = b.bar;
        __builtin_amdgcn_s_waitcnt(0);
        unsigned nloc = b.st[0], nx = b.st[1];
        if (nloc == 0u) { xcd_barrier_complete(bar, b.x, nloc, nx); b.st[0] = nloc; b.st[1] = nx; }
        const unsigned old = xb_add(&bar[XB_XSUB(b.x)], 1u);
        const unsigned gen = old / nloc;
        if (old + 1u == (gen + 1u) * nloc) {
            __builtin_amdgcn_fence(__ATOMIC_RELEASE, "agent");
            asm volatile("s_waitcnt vmcnt(0)" ::: "memory");
            const unsigned og = xb_add(&bar[XB_TOP], 1u);
            const unsigned tg = og / nx;
            if (og + 1u == (tg + 1u) * nx) xb_add(&bar[XB_TOPGEN], 1u);
            else XB_SPIN(xb_ld(&bar[XB_TOPGEN]) == tg, bar);
            __builtin_amdgcn_fence(__ATOMIC_ACQUIRE, "agent");
            xb_add(&bar[XB_XGEN(b.x)], 1u);
            asm volatile("s_waitcnt vmcnt(0)" ::: "memory");
        } else {
            XB_SPIN(xb_ld(&bar[XB_XGEN(b.x)]) == gen, bar);
            __builtin_amdgcn_fence(__ATOMIC_ACQUIRE, "agent");
            asm volatile("s_waitcnt vmcnt(0)" ::: "memory");
        }
    }
    __syncthreads();
}

namespace pg8 {
using mk::cvt_pk_bf16;
constexpr int BM = 256, BK = 64, HALF = 128, HTB = HALF * BK * 2  , STAGE_BYTES = 8 * HTB;
__host__ __device__ __forceinline__ int lds_byte(int r, int c) { const int st = (r >> 4) * 2 + (c >> 5), rr = r & 15, cc = c & 31, ob = rr * 64 + cc * 2; return st * 1024 + (ob ^ (((ob >> 9) & 1) << 5)); }
__host__ __device__ __forceinline__ void stage_rc(int b, int& R, int& C) { const int st = b / 1024, sb = b % 1024, swz = sb ^ (((sb >> 9) & 1) << 5); R = (st >> 1) * 16 + swz / 64; C = (st & 1) * 32 + (swz % 64) / 2; }
__host__ __device__ __forceinline__ int perm32(int rho) { const int n = rho >> 4, i = rho & 15; return 8 * (i >> 2) + 4 * n + (i & 3); }

struct Unit { const char* A; const char* Bt; bf16_t* out; const int* rl; int pm, pn, x0, x1, ldo, kind; };

template <class Epi, class Sched>
__device__ __forceinline__ void gemm_phase(LAS unsigned char* lds, const int K, const Sched& S, const Epi& E) {
    const int tid = mk::otid(), wid = __builtin_amdgcn_readfirstlane(tid >> 6), lane = tid & 63, wr = wid >> 2, wc = wid & 3, fr = lane & 15, fq = lane >> 4;
    const int nt = K / BK;
    constexpr bool GATH = Sched::GATHER;
    unsigned voffA[2], voffB[2]; int Rl[2], Cl[2];
#pragma unroll
    for (int i = 0; i < 2; ++i) { int R, C; stage_rc(tid * 16 + i * 8192, R, C); const int Rb = Epi::PERM ? ((R & ~31) + perm32(R & 31)) : R; Rl[i] = R; Cl[i] = C;
        voffA[i] = (unsigned)(R * K + C) * 2u; voffB[i] = (unsigned)(Rb * K + C) * 2u; }
    unsigned roC[2][2], roN[2][2];
    (void)Rl; (void)Cl;
    const size_t kstep = (size_t)(BK * 2);
    const size_t hstep = (size_t)HALF * K * 2;
    const unsigned ldsw = (unsigned)wid * 1024u;
    const int aoff = lds_byte(wr * 64 + fr, fq * 8), boff = lds_byte(wc * 32 + fr, fq * 8);
#define PG8_SA(b, h) (((b) * 2 + (h)) * HTB)
#define PG8_SB(b, h) ((4 + (b) * 2 + (h)) * HTB)
#define PG8_STAGE(bufoff, gbase, voff) do { _Pragma("unroll") for (int _i = 0; _i < 2; ++_i) \
        __builtin_amdgcn_global_load_lds((const unsigned*)((const char*)(gbase) + (voff)[_i]), (LAS unsigned*)(lds + (bufoff) + ldsw + _i * 8192), 16, 0, 0); } while (0)
#define PG8_STAGE_A(bufoff, gbase, h, ro) do { if constexpr (GATH) { _Pragma("unroll") for (int _i = 0; _i < 2; ++_i) \
        __builtin_amdgcn_global_load_lds((const unsigned*)((const char*)(gbase) + (ro)[h][_i]), (LAS unsigned*)(lds + (bufoff) + ldsw + _i * 8192), 16, 0, 0); } \
      else { PG8_STAGE(bufoff, (const char*)(gbase) + (h) * hstep, voffA); } } while (0)
#define PG8_LOAD_RO(u, ro) do { _Pragma("unroll") for (int _h = 0; _h < 2; ++_h) _Pragma("unroll") for (int _i = 0; _i < 2; ++_i) \
        (ro)[_h][_i] = (unsigned)(u).rl[Rl[_i] + _h * 128] * (unsigned)(K * 2) + (unsigned)(Cl[_i] * 2); } while (0)
#define PG8_LDA(dst, b, h) do { _Pragma("unroll") for (int m = 0; m < 4; ++m) _Pragma("unroll") for (int k = 0; k < 2; ++k) dst[m][k] = *(const LAS bf16x8*)(lds + PG8_SA(b, h) + aoff + m * 2048 + k * 1024); } while (0)
#define PG8_LDB(dst, b, h) do { _Pragma("unroll") for (int n = 0; n < 2; ++n) _Pragma("unroll") for (int k = 0; k < 2; ++k) dst[n][k] = *(const LAS bf16x8*)(lds + PG8_SB(b, h) + boff + n * 2048 + k * 1024); } while (0)
#define PG8_MMA(ai, bj, At, Bt) do { __builtin_amdgcn_s_setprio(1); _Pragma("unroll") for (int m = 0; m < 4; ++m) _Pragma("unroll") for (int n = 0; n < 2; ++n) _Pragma("unroll") for (int k = 0; k < 2; ++k) \
        acc[ai][bj][m][n] = __builtin_amdgcn_mfma_f32_16x16x32_bf16(Bt[n][k], At[m][k], acc[ai][bj][m][n], 0, 0, 0); __builtin_amdgcn_s_setprio(0); } while (0)
#define PG8_WAIT_V(n) asm volatile("s_waitcnt vmcnt(" #n ")" ::: "memory")
#define PG8_WAIT_L(n) asm volatile("s_waitcnt lgkmcnt(" #n ")" ::: "memory")
#define PG8_BAR __builtin_amdgcn_s_barrier()
#define PG8_SCHED __builtin_amdgcn_sched_barrier(0)
    Unit cur, nxt; int ui = 0;
    if (!S.next(0, cur)) return;
    f32x4 acc[2][2][4][2];
#pragma unroll
    for (int a = 0; a < 2; ++a)
#pragma unroll
        for (int b = 0; b < 2; ++b)
#pragma unroll
            for (int m = 0; m < 4; ++m)
#pragma unroll
                for (int n = 0; n < 2; ++n) acc[a][b][m][n] = (f32x4){0.f, 0.f, 0.f, 0.f};
    bf16x8 At[4][2], B0[2][2], B1[2][2];
    const char* cA = cur.A; const char* cB = cur.Bt;
    if constexpr (GATH) { PG8_LOAD_RO(cur, roC); }
    PG8_STAGE(PG8_SB(0, 0), cB, voffB); PG8_STAGE_A(PG8_SA(0, 0), cA, 0, roC); PG8_STAGE(PG8_SB(0, 1), cB + hstep, voffB); PG8_STAGE_A(PG8_SA(0, 1), cA, 1, roC);
    if (wr == 1) PG8_BAR;
    PG8_WAIT_V(4); PG8_BAR;
    PG8_STAGE(PG8_SB(1, 0), cB + kstep, voffB); PG8_STAGE_A(PG8_SA(1, 0), cA + kstep, 0, roC); PG8_STAGE(PG8_SB(1, 1), cB + hstep + kstep, voffB);
    PG8_WAIT_V(6); PG8_BAR;
    for (;;) {
        const bool has_next = S.next(ui + 1, nxt);
        const char* nA = has_next ? nxt.A : cA; const char* nB = has_next ? nxt.Bt : cB;
        if constexpr (GATH) { if (has_next) { PG8_LOAD_RO(nxt, roN); } else { _Pragma("unroll") for (int _h = 0; _h < 2; ++_h) _Pragma("unroll") for (int _i = 0; _i < 2; ++_i) roN[_h][_i] = roC[_h][_i]; } }
        for (int t = 0; t < nt; t += 2) {
            const bool last = (t == nt - 2);
            const char* a1 = cA + (size_t)(t + 1) * kstep;
            const char* a2 = last ? nA : cA + (size_t)(t + 2) * kstep; const char* b2 = last ? nB : cB + (size_t)(t + 2) * kstep;
            const char* a3 = a2 + kstep; const char* b3 = b2 + kstep;
            unsigned ro2[2][2];
            if constexpr (GATH) { _Pragma("unroll") for (int _h = 0; _h < 2; ++_h) _Pragma("unroll") for (int _i = 0; _i < 2; ++_i) ro2[_h][_i] = last ? roN[_h][_i] : roC[_h][_i]; }
            (void)ro2;
            PG8_LDB(B0, 0, 0); PG8_SCHED; PG8_LDA(At, 0, 0); PG8_STAGE_A(PG8_SA(1, 1), a1, 1, roC);
            PG8_WAIT_L(8); PG8_BAR; PG8_WAIT_L(0); PG8_MMA(0, 0, At, B0); PG8_BAR; PG8_SCHED;
            PG8_LDB(B1, 0, 1); PG8_STAGE(PG8_SB(0, 0), b2, voffB);
            PG8_BAR; PG8_WAIT_L(0); PG8_MMA(0, 1, At, B1); PG8_BAR;
            PG8_LDA(At, 0, 1); PG8_STAGE_A(PG8_SA(0, 0), a2, 0, ro2);
            PG8_BAR; PG8_WAIT_L(0); PG8_MMA(1, 0, At, B0); PG8_BAR; PG8_SCHED;
            PG8_STAGE(PG8_SB(0, 1), b2 + hstep, voffB);
            PG8_WAIT_V(6); PG8_BAR; PG8_MMA(1, 1, At, B1); PG8_BAR;
            PG8_LDB(B0, 1, 0); PG8_SCHED; PG8_LDA(At, 1, 0); PG8_STAGE_A(PG8_SA(0, 1), a2, 1, ro2);
            PG8_WAIT_L(8); PG8_BAR; PG8_WAIT_L(0); PG8_MMA(0, 0, At, B0); PG8_BAR; PG8_SCHED;
            PG8_LDB(B1, 1, 1); PG8_STAGE(PG8_SB(1, 0), b3, voffB);
            PG8_BAR; PG8_WAIT_L(0); PG8_MMA(0, 1, At, B1); PG8_BAR;
            PG8_LDA(At, 1, 1); PG8_STAGE_A(PG8_SA(1, 0), a3, 0, ro2);
            PG8_BAR; PG8_WAIT_L(0); PG8_MMA(1, 0, At, B0); PG8_BAR; PG8_SCHED;
            PG8_STAGE(PG8_SB(1, 1), b3 + hstep, voffB);
            PG8_WAIT_V(6); PG8_BAR; PG8_MMA(1, 1, At, B1); PG8_BAR;
        }
        E(acc, cur, wr, wc, fr, fq);
        if (!has_next) break;
#pragma unroll
        for (int a = 0; a < 2; ++a)
#pragma unroll
            for (int b = 0; b < 2; ++b)
#pragma unroll
                for (int m = 0; m < 4; ++m)
#pragma unroll
                    for (int n = 0; n < 2; ++n) acc[a][b][m][n] = (f32x4){0.f, 0.f, 0.f, 0.f};
        cur = nxt; cA = nA; cB = nB; ++ui;
        if constexpr (GATH) { _Pragma("unroll") for (int _h = 0; _h < 2; ++_h) _Pragma("unroll") for (int _i = 0; _i < 2; ++_i) roC[_h][_i] = roN[_h][_i]; }
    }
    PG8_WAIT_V(0);
    if (wr == 0) PG8_BAR;
    PG8_BAR;
#undef PG8_SA
#undef PG8_SB
#undef PG8_STAGE
#undef PG8_STAGE_A
#undef PG8_LOAD_RO
#undef PG8_LDA
#undef PG8_LDB
#undef PG8_MMA
#undef PG8_WAIT_V
#undef PG8_WAIT_L
#undef PG8_BAR
#undef PG8_SCHED
}

struct EpiStoreBf16 {
    static constexpr bool PERM = true;
    __device__ __forceinline__ void operator()(const f32x4 (&acc)[2][2][4][2], const Unit& u, int wr, int wc, int fr, int fq) const {
        bf16_t* O = u.out; const int ldc = u.ldo;
        const int row0 = u.x0 + wr * 64 + fr, col0 = u.x1 + wc * 32 + 8 * fq;
#pragma unroll
        for (int ai = 0; ai < 2; ++ai)
#pragma unroll
            for (int m = 0; m < 4; ++m) { bf16_t* rowp = O + (size_t)(row0 + ai * HALF + m * 16) * ldc + col0;
#pragma unroll
                for (int bj = 0; bj < 2; ++bj) { const f32x4 v0 = acc[ai][bj][m][0], v1 = acc[ai][bj][m][1];
                    u32x4 w; w.x = cvt_pk_bf16(v0[0], v0[1]); w.y = cvt_pk_bf16(v0[2], v0[3]); w.z = cvt_pk_bf16(v1[0], v1[1]); w.w = cvt_pk_bf16(v1[2], v1[3]);
                    *(u32x4*)(rowp + bj * HALF) = w; } }
    }
};
}

namespace mk {
struct NMapId { int off; __device__ __forceinline__ int operator()(int n) const { return n + off; } __device__ __forceinline__ float scl(int) const { return 1.0f; } };
struct NMapInterleave { int which; __device__ __forceinline__ int operator()(int n) const { return 2 * n + which; } __device__ __forceinline__ float scl(int) const { return 1.0f; } };
struct NMapRope { __device__ __forceinline__ int operator()(int n) const { if (n >= 2048) return n; const int ch = n >> 6, c = n & 63, half = c >> 5, w = c & 31, z = w >> 4, i = w & 15; return ch * 64 + half * 32 + 2 * i + z; }
  __device__ __forceinline__ float scl(int n) const { return n < 1024 ? 0.125f * 1.4426950408889634f : 1.0f; } };

template <class NMap>
__device__ __forceinline__ void cvt_tile(const float* __restrict__ src, int ldsrc, int K, bf16_t* __restrict__ dst, int k0, int n0, const NMap& nmap, LAS float* tile) {
  const int t = mk::otid();
  { const int k = t >> 3, c = (t & 7) * 8; const float* p = src + (size_t)(k0 + k) * ldsrc + n0 + c;
    const f32x4 a = *(const f32x4*)p, b = *(const f32x4*)(p + 4);
    LAS float* q = tile + k * 65 + c; q[0] = a[0]; q[1] = a[1]; q[2] = a[2]; q[3] = a[3]; q[4] = b[0]; q[5] = b[1]; q[6] = b[2]; q[7] = b[3]; }
  __syncthreads();
  { const int n = t >> 3, kc = (t & 7) * 8; const LAS float* q = tile + kc * 65 + n; const float sc = nmap.scl(n0 + n);
    u32x4 w; w.x = cvt_pk_bf16(q[0] * sc, q[65] * sc); w.y = cvt_pk_bf16(q[130] * sc, q[195] * sc); w.z = cvt_pk_bf16(q[260] * sc, q[325] * sc); w.w = cvt_pk_bf16(q[390] * sc, q[455] * sc);
    *(u32x4*)(dst + (size_t)nmap(n0 + n) * K + k0 + kc) = w; }
  __syncthreads();
}
template <class NMap>
__device__ __forceinline__ int cvt_matrix(const float* src, int ldsrc, int K, int N, bf16_t* dst, const NMap& nmap, LAS float* tile, int ubase, int bid, int nblk) {
  const int nkt = K / 64, nnt = N / 64, tot = nkt * nnt;
  int first = ubase + ((bid - ubase % nblk) + nblk) % nblk;
  for (int u = first; u < ubase + tot; u += nblk) { const int v = u - ubase; cvt_tile(src, ldsrc, K, dst, (v / nnt) * 64, (v % nnt) * 64, nmap, tile); }
  return tot;
}
}

namespace att {
using namespace mk;
constexpr int KB_BYTES = 64 * 128, VB_BYTES = 128 * 128, TILE_BYTES = KB_BYTES + VB_BYTES, DA_RING = 4, DA_LDS = DA_RING * TILE_BYTES;
__device__ __forceinline__ int pi32(int r) { return (r & ~12) | ((r & 4) << 1) | ((r & 8) >> 1); }
__device__ __forceinline__ int swz(int row, int chunk) { return row * 128 + ((chunk ^ ((row >> 1) & 7)) << 4); }
__device__ __forceinline__ int crow(int r, int hi) { return (r & 3) + 8 * (r >> 2) + 4 * hi; }

__device__ __forceinline__ float sumsq8(u32x4 w) { return (bflo(w.x) * bflo(w.x) + bfhi(w.x) * bfhi(w.x)) + (bflo(w.y) * bflo(w.y) + bfhi(w.y) * bfhi(w.y)) + (bflo(w.z) * bflo(w.z) + bfhi(w.z) * bfhi(w.z)) + (bflo(w.w) * bflo(w.w) + bfhi(w.w) * bfhi(w.w)); }
__device__ __forceinline__ void knorm_group(const bf16_t* __restrict__ Pqk, float* __restrict__ KN, int g, LAS float* red) {
  const int tid = mk::otid(), wid = tid >> 6, lane = tid & 63;
  float mx = 0.f, mq = 0.f;
  for (int i0 = 0; i0 < 160; i0 += 32) {
    u32x4 a[4], b[4], c[4], d[4];
#pragma unroll
    for (int j = 0; j < 4; ++j) { int i = i0 + j * 8 + wid; i = i < 132 ? i : wid; const int row = i < 128 ? g * 128 + i : NLAT + g * 4 + (i - 128);
      const bf16_t* kp = Pqk + (size_t)row * 2048 + 1024 + lane * 16; a[j] = *(const u32x4*)kp; b[j] = *(const u32x4*)(kp + 8); c[j] = *(const u32x4*)(kp - 1024); d[j] = *(const u32x4*)(kp - 1024 + 8); }
#pragma unroll
    for (int j = 0; j < 4; ++j) { float s = sumsq8(a[j]) + sumsq8(b[j]); s += dpp_mov<0xB1, 0xf, 0xf>(s, s); s += dpp_mov<0x4E, 0xf, 0xf>(s, s); mx = fmaxf(mx, s);
      float q = sumsq8(c[j]) + sumsq8(d[j]); q += dpp_mov<0xB1, 0xf, 0xf>(q, q); q += dpp_mov<0x4E, 0xf, 0xf>(q, q); mq = fmaxf(mq, q); }
  }
  if ((lane & 3) == 0) { red[wid * 32 + (lane >> 2)] = mx; red[wid * 32 + 16 + (lane >> 2)] = mq; }
  __syncthreads();
  if (tid < 32) { float m = red[tid];
#pragma unroll
    for (int w = 1; w < 8; ++w) m = fmaxf(m, red[w * 32 + tid]);
    KN[g * 32 + tid] = m; }
  __syncthreads();
}
__device__ __forceinline__ float nmax2_of(const float* __restrict__ KN, int b, int hh, int which) {
  return wave_max_u(KN[(b * 64 + (mk::otid() & 63)) * 32 + which * 16 + hh]);
}

template <bool STATIC, int ABL = 0>
__device__ __forceinline__ void diff_attn_unit(const bf16_t* __restrict__ Pqk, const bf16_t* __restrict__ Vt, bf16_t* __restrict__ O12, int hh, int q0, int klat0, int nlat, int kctx0, LAS unsigned char* lds) {
  const int tid = mk::otid(), wid = tid >> 6, lane = tid & 63, r = lane & 31, hi = lane >> 5;
  const int NT = (nlat + L) / 64, NTL = nlat / 64;
  const int wv = __builtin_amdgcn_readfirstlane(wid);
  const int drow = wv * 8 + (lane >> 3), dch = (lane & 7) ^ ((drow >> 1) & 7);
  const unsigned koff = (unsigned)(drow * 2048 + 1024 + hh * 64 + dch * 8) * 2u;
  const unsigned voff = (unsigned)(((hh >> 1) * 128 + drow) * NTOK + dch * 8) * 2u;
  bf16x8 qf[4];
  { const bf16_t* qp = Pqk + (size_t)(q0 + wid * 32 + r) * 2048 + hh * 64 + hi * 8;
#pragma unroll
    for (int ks = 0; ks < 4; ++ks) qf[ks] = *(const bf16x8*)(qp + ks * 16); }
  const unsigned kaddr0 = (unsigned)(pi32(r) * 128 + ((hi ^ ((pi32(r) >> 1) & 7)) << 4));
  const unsigned vaddr0 = (unsigned)(r * 128 + ((hi ^ ((r >> 1) & 7)) << 4)) + KB_BYTES;
  f32x16 o[4];
#pragma unroll
  for (int vb = 0; vb < 4; ++vb)
#pragma unroll
    for (int i = 0; i < 16; ++i) o[vb][i] = 0.f;
  float l_run = 0.f;
#define DA_DMA(t) do { const int tok = (t) < NTL ? klat0 + (t) * 64 : kctx0 + ((t) - NTL) * 64; LAS unsigned char* b_ = lds + ((t) & 3) * TILE_BYTES + wv * 1024; \
    const char* kt_ = (const char*)Pqk + (size_t)tok * 4096; const char* vt_ = (const char*)Vt + (size_t)tok * 2; \
    __builtin_amdgcn_global_load_lds((const unsigned*)(kt_ + koff), (LAS unsigned*)b_, 16, 0, 0); \
    __builtin_amdgcn_global_load_lds((const unsigned*)(vt_ + voff), (LAS unsigned*)(b_ + KB_BYTES), 16, 0, 0); \
    __builtin_amdgcn_global_load_lds((const unsigned*)(vt_ + (size_t)64 * NTOK * 2 + voff), (LAS unsigned*)(b_ + KB_BYTES + 8192), 16, 0, 0); } while (0)
#define DA_WAITV(n) asm volatile("s_waitcnt vmcnt(" #n ")" ::: "memory")
#define DA_PAIR_BEGIN(t) if (!(ABL & 8) && (t) + 2 < NT) { DA_DMA((t) + 2); DA_DMA((t) + 3); }
#define DA_SLOT(tt) const unsigned sb_ = (unsigned)(((tt) & 3) * TILE_BYTES); const LAS unsigned char* kb_ = lds + (kaddr0 + sb_); const LAS unsigned char* vb_ = lds + (vaddr0 + sb_)
#define DA_PAIR_END() do { DA_WAITV(0); asm volatile("s_waitcnt lgkmcnt(0)" ::: "memory"); if (!(ABL & 16)) __builtin_amdgcn_s_barrier(); } while (0)
  DA_DMA(0); DA_DMA(1);
  DA_WAITV(0); __builtin_amdgcn_s_barrier();
#define DA_XOR(ptr, x) ((const LAS unsigned char*)((unsigned)(size_t)(ptr) ^ (unsigned)(x)))
#define DA_KFRAG(ks) const LAS unsigned char* kp_ = DA_XOR(kb_, (ks) << 5); const bf16x8 a0 = (ABL & 2) ? qf[ks] : *(const LAS bf16x8*)kp_, a1 = (ABL & 2) ? qf[(ks) ^ 1] : *(const LAS bf16x8*)(kp_ + 4096)
#define DA_VFRAGS() bf16x8 va[4][4]; \
    _Pragma("unroll") for (int c4 = 0; c4 < 4; ++c4) { const LAS unsigned char* vp_ = DA_XOR(vb_, c4 << 5); \
      _Pragma("unroll") for (int vb = 0; vb < 4; ++vb) va[vb][c4] = (ABL & 1) ? qf[c4 ^ (vb & 3)] : *(const LAS bf16x8*)(vp_ + vb * 4096); }
#define DA_PACK_PV() bf16x8 pf[2][2]; \
    _Pragma("unroll") for (int s = 0; s < 2; ++s) { u32x4 w0, w1; \
      w0.x = cvt_pk_bf16(s0[8 * s + 0], s0[8 * s + 1]); w0.y = cvt_pk_bf16(s0[8 * s + 2], s0[8 * s + 3]); w0.z = cvt_pk_bf16(s0[8 * s + 4], s0[8 * s + 5]); w0.w = cvt_pk_bf16(s0[8 * s + 6], s0[8 * s + 7]); \
      w1.x = cvt_pk_bf16(s1[8 * s + 0], s1[8 * s + 1]); w1.y = cvt_pk_bf16(s1[8 * s + 2], s1[8 * s + 3]); w1.z = cvt_pk_bf16(s1[8 * s + 4], s1[8 * s + 5]); w1.w = cvt_pk_bf16(s1[8 * s + 6], s1[8 * s + 7]); \
      pf[0][s] = __builtin_bit_cast(bf16x8, w0); pf[1][s] = __builtin_bit_cast(bf16x8, w1); } \
    _Pragma("unroll") for (int vb = 0; vb < 4; ++vb) _Pragma("unroll") for (int kb = 0; kb < 2; ++kb) _Pragma("unroll") for (int s = 0; s < 2; ++s) \
      o[vb] = __builtin_amdgcn_mfma_f32_32x32x16_bf16(va[vb][kb * 2 + s], pf[kb][s], o[vb], 0, 0, 0)
  if constexpr (STATIC) {
    for (int t = 0; t < NT; t += 2) {
      DA_PAIR_BEGIN(t);
#pragma unroll
      for (int u = 0; u < 2; ++u) {
        DA_SLOT(t + u);
        f32x16 s0, s1;
#pragma unroll
        for (int i = 0; i < 16; ++i) { s0[i] = 0.f; s1[i] = 0.f; }
#pragma unroll
        for (int ks = 0; ks < 4; ++ks) { DA_KFRAG(ks); s0 = __builtin_amdgcn_mfma_f32_32x32x16_bf16(a0, qf[ks], s0, 0, 0, 0); s1 = __builtin_amdgcn_mfma_f32_32x32x16_bf16(a1, qf[ks], s1, 0, 0, 0); }
        DA_VFRAGS();
        if constexpr ((ABL & 32) != 0) {
          l_run += s0[0] + s1[0];
#pragma unroll
          for (int vb = 0; vb < 4; ++vb)
#pragma unroll
            for (int c4 = 0; c4 < 4; ++c4) o[vb] = __builtin_amdgcn_mfma_f32_32x32x16_bf16(va[vb][c4], qf[c4], o[vb], 0, 0, 0);
        } else {
          float ps = 0.f;
#pragma unroll
          for (int i = 0; i < 16; ++i) { s0[i] = (ABL & 4) ? s0[i] : __builtin_amdgcn_exp2f(s0[i]); ps += s0[i]; }
#pragma unroll
          for (int i = 0; i < 16; ++i) { s1[i] = (ABL & 4) ? s1[i] : __builtin_amdgcn_exp2f(s1[i]); ps += s1[i]; }
          l_run += ps;
          DA_PACK_PV();
        }
      }
      DA_PAIR_END();
    }
  } else {
    constexpr float THR = 8.0f * 1.4426950408889634f;
    float m_run = -1e30f;
    for (int t = 0; t < NT; ++t) {
      if (!(t & 1)) DA_PAIR_BEGIN(t);
      DA_SLOT(t);
      f32x16 s0 = zero16(), s1 = zero16();
#pragma unroll
      for (int ks = 0; ks < 4; ++ks) { DA_KFRAG(ks); s0 = __builtin_amdgcn_mfma_f32_32x32x16_bf16(a0, qf[ks], s0, 0, 0, 0); s1 = __builtin_amdgcn_mfma_f32_32x32x16_bf16(a1, qf[ks], s1, 0, 0, 0); }
      float mx = fmaxf(s0[0], s1[0]);
#pragma unroll
      for (int i = 1; i < 16; ++i) mx = fmaxf(mx, fmaxf(s0[i], s1[i]));
      { const u32x2 sw = __builtin_amdgcn_permlane32_swap(__float_as_uint(mx), __float_as_uint(mx), false, false); mx = fmaxf(__uint_as_float(sw.x), __uint_as_float(sw.y)); }
      float alpha = 1.0f;
      if (!__all(mx - m_run <= THR)) {
        const float m_new = fmaxf(m_run, mx);
        alpha = __builtin_amdgcn_exp2f(m_run - m_new);
        m_run = m_new;
#pragma unroll
        for (int vb = 0; vb < 4; ++vb)
#pragma unroll
          for (int i = 0; i < 16; ++i) o[vb][i] *= alpha;
      }
      float ps = 0.f;
#pragma unroll
      for (int i = 0; i < 16; ++i) { s0[i] = __builtin_amdgcn_exp2f(s0[i] - m_run); ps += s0[i]; }
#pragma unroll
      for (int i = 0; i < 16; ++i) { s1[i] = __builtin_amdgcn_exp2f(s1[i] - m_run); ps += s1[i]; }
      l_run = l_run * alpha + ps;
      __builtin_amdgcn_sched_barrier(0);
      DA_VFRAGS();
      DA_PACK_PV();
      if (t & 1) DA_PAIR_END();
    }
  }
#undef DA_KFRAG
#undef DA_XOR
#undef DA_VFRAGS
#undef DA_PACK_PV
#undef DA_DMA
#undef DA_WAITV
#undef DA_PAIR_BEGIN
#undef DA_PAIR_END
#undef DA_SLOT
  float l_tot; { const u32x2 sw = __builtin_amdgcn_permlane32_swap(__float_as_uint(l_run), __float_as_uint(l_run), false, false); l_tot = __uint_as_float(sw.x) + __uint_as_float(sw.y); }
  const float inv = 1.0f / l_tot;
  const int te = mk::otid();
  bf16_t* op = O12 + (size_t)(q0 + (te >> 6) * 32 + (te & 31)) * 2048 + hh * 128 + 4 * ((te >> 5) & 1);
#pragma unroll
  for (int vb = 0; vb < 4; ++vb)
#pragma unroll
    for (int g = 0; g < 4; ++g) {
      u32x2 w; w.x = cvt_pk_bf16(o[vb][4 * g] * inv, o[vb][4 * g + 1] * inv); w.y = cvt_pk_bf16(o[vb][4 * g + 2] * inv, o[vb][4 * g + 3] * inv);
      *(u32x2*)(op + vb * 32 + 8 * g) = w;
    }
}

__device__ __forceinline__ void diff_combine_rows4(const bf16_t* __restrict__ O12, const float* __restrict__ subln_g, float lam, float oml, bf16_t* __restrict__ O, int row0, int h, int lane) {
  unsigned a[4], b[4];
#pragma unroll
  for (int i = 0; i < 4; ++i) { a[i] = *(const unsigned*)(O12 + (size_t)(row0 + i) * 2048 + (2 * h) * 128 + 2 * lane); b[i] = *(const unsigned*)(O12 + (size_t)(row0 + i) * 2048 + (2 * h + 1) * 128 + 2 * lane); }
  const float g0 = subln_g[2 * lane], g1 = subln_g[2 * lane + 1];
#pragma unroll
  for (int i = 0; i < 4; ++i) {
    const float x0 = bflo(a[i]) - lam * bflo(b[i]), x1 = bfhi(a[i]) - lam * bfhi(b[i]);
    const float ss = wave_sum_u(x0 * x0 + x1 * x1);
    const float rs = rsqrtf(ss * (1.0f / 128.0f) + 1e-5f) * oml;
    *(unsigned*)(O + (size_t)(row0 + i) * 1024 + h * 128 + 2 * lane) = cvt_pk_bf16(x0 * rs * g0, x1 * rs * g1);
  }
}
}

namespace natt {
using namespace mk;
using att::pi32; using att::swz;
constexpr int TB = 64 * 128;
constexpr int NA_LDS = 4 * TB + 2048;
__device__ __forceinline__ void na_attn_unit(const bf16_t* __restrict__ Pe, const bf16_t* __restrict__ Vte, const float* __restrict__ rpb_h, bf16_t* __restrict__ O, int b, int h, int rq, LAS unsigned char* lds) {
  const int tid = mk::otid(), wid = tid >> 6, lane = tid & 63, r = lane & 31, hi = lane >> 5;
  constexpr float LOG2E = 1.4426950408889634f;
  LAS float* sb = (LAS float*)(lds + 4 * TB);
  for (int i = tid; i < 465; i += NTHR) sb[i] = rpb_h[i];
  const bool is_ctx = rq < 0;
  int qrow = 0, qcol = 0, qtok, rs_q = 0, cs_q = 0, span0 = 0, wlo = 0, whi = -1, lo = 0, ntl = 0;
  if (!is_ctx) {
    const int r0 = rq * 4, ra = r0 + (wid >> 2) * 2;
    qrow = ra + (r >> 4); qcol = (wid & 3) * 16 + (r & 15); qtok = b * T + qrow * 64 + qcol;
    rs_q = min(max(qrow - 4, 0), 120); cs_q = min(max(qcol - 8, 0), 48);
    span0 = min(max((wid & 3) * 16 - 8, 0), 32);
    wlo = min(max(ra - 4, 0), 120); whi = min(max(ra - 3, 0), 120) + 7;
    lo = min(max(r0 - 4, 0), 120); const int hi_ = min(max(r0 - 1, 0), 120) + 7; ntl = hi_ - lo + 1;
  } else qtok = NLAT + b * L + wid * 32 + r;
  const int NT = ntl + 4;
  const int srow = tid >> 3, sch = tid & 7;
  const bf16_t* kbase = Pe + 512 + h * 64 + sch * 8;
  const bf16_t* vbase = Vte + (size_t)(h * 64 + srow) * NTOK + sch * 8;
  const int sdst = swz(srow, sch);
  bf16x8 qf[4];
  { const bf16_t* qp = Pe + (size_t)qtok * 1024 + h * 64 + hi * 8;
#pragma unroll
    for (int ks = 0; ks < 4; ++ks) qf[ks] = *(const bf16x8*)(qp + ks * 16); }
  const int kx = (pi32(r) >> 1) & 7, vx = (r >> 1) & 7;
  const int ka_loc = (span0 + pi32(r)) * 128; const int kx_loc = ((span0 + pi32(r)) >> 1) & 7;
  f32x16 o[2];
#pragma unroll
  for (int vb = 0; vb < 2; ++vb)
#pragma unroll
    for (int i = 0; i < 16; ++i) o[vb][i] = 0.f;
  float m_run = -1e30f, l_run = 0.f;
  u32x4 kreg, vreg;
#define NA_LOAD(t) do { const int tok = (t) < ntl ? b * T + (lo + (t)) * 64 : NLAT + b * L + ((t) - ntl) * 64; \
    kreg = *(const u32x4*)(kbase + (size_t)(tok + srow) * 1024); vreg = *(const u32x4*)(vbase + tok); } while (0)
#define NA_WRITE(bufi) do { *(LAS u32x4*)(lds + (bufi) * TB + sdst) = kreg; *(LAS u32x4*)(lds + 2 * TB + (bufi) * TB + sdst) = vreg; } while (0)
  NA_LOAD(0); NA_WRITE(0); __syncthreads();
  for (int t = 0; t < NT; ++t) {
    const bool more = t + 1 < NT;
    if (more) NA_LOAD(t + 1);
    const LAS unsigned char* kb_ = lds + (t & 1) * TB; const LAS unsigned char* vb_ = lds + 2 * TB + (t & 1) * TB;
    const bool local = t < ntl; const int kr = lo + t;
    const bool active = !local || (kr >= wlo && kr <= whi);
    if (active) {
      f32x16 s0, s1;
#pragma unroll
      for (int i = 0; i < 16; ++i) { s0[i] = 0.f; s1[i] = 0.f; }
      if (local) {
#pragma unroll
        for (int ks = 0; ks < 4; ++ks) {
          const bf16x8 a0 = *(const LAS bf16x8*)(kb_ + ka_loc + (((ks * 2 + hi) ^ kx_loc) << 4));
          s0 = __builtin_amdgcn_mfma_f32_32x32x16_bf16(a0, qf[ks], s0, 0, 0, 0);
        }
        const bool row_ok = kr >= rs_q && kr < rs_q + 8; const int dr31 = (kr - qrow + 7) * 31;
#pragma unroll
        for (int i = 0; i < 16; ++i) {
          const int kc = span0 + (i & 7) + 8 * hi + 16 * (i >> 3);
          const bool ok = row_ok && kc >= cs_q && kc < cs_q + 16;
          const int bi = ok ? dr31 + (kc - qcol + 15) : 0;
          const float bv = sb[bi];
          s0[i] = ok ? fmaf(s0[i], 0.125f, bv) : -1e30f; s1[i] = -1e30f;
        }
      } else {
#pragma unroll
        for (int ks = 0; ks < 4; ++ks) {
          const int ch = ((ks * 2 + hi) ^ kx) << 4;
          const bf16x8 a0 = *(const LAS bf16x8*)(kb_ + pi32(r) * 128 + ch), a1 = *(const LAS bf16x8*)(kb_ + (32 + pi32(r)) * 128 + ch);
          s0 = __builtin_amdgcn_mfma_f32_32x32x16_bf16(a0, qf[ks], s0, 0, 0, 0);
          s1 = __builtin_amdgcn_mfma_f32_32x32x16_bf16(a1, qf[ks], s1, 0, 0, 0);
        }
#pragma unroll
        for (int i = 0; i < 16; ++i) { s0[i] *= 0.125f; s1[i] *= 0.125f; }
      }
      float mx = s0[0];
#pragma unroll
      for (int i = 1; i < 16; ++i) mx = fmaxf(mx, s0[i]);
#pragma unroll
      for (int i = 0; i < 16; ++i) mx = fmaxf(mx, s1[i]);
      { const u32x2 sw = __builtin_amdgcn_permlane32_swap(__float_as_uint(mx), __float_as_uint(mx), false, false); mx = fmaxf(__uint_as_float(sw.x), __uint_as_float(sw.y)); }
      const float m_new = fmaxf(m_run, mx);
      const float alpha = __builtin_amdgcn_exp2f((m_run - m_new) * LOG2E);
      m_run = m_new;
      const float mc = -m_new * LOG2E;
      float ps = 0.f;
#pragma unroll
      for (int i = 0; i < 16; ++i) { const float p = s0[i] > -1e29f ? __builtin_amdgcn_exp2f(fmaf(s0[i], LOG2E, mc)) : 0.f; s0[i] = p; ps += p; }
#pragma unroll
      for (int i = 0; i < 16; ++i) { const float p = s1[i] > -1e29f ? __builtin_amdgcn_exp2f(fmaf(s1[i], LOG2E, mc)) : 0.f; s1[i] = p; ps += p; }
      l_run = l_run * alpha + ps;
      if (__any(alpha < 1.0f)) {
#pragma unroll
        for (int vb = 0; vb < 2; ++vb)
#pragma unroll
          for (int i = 0; i < 16; ++i) o[vb][i] *= alpha;
      }
      bf16x8 pf[2][2];
#pragma unroll
      for (int s = 0; s < 2; ++s) {
        u32x4 w0, w1;
        w0.x = cvt_pk_bf16(s0[8 * s + 0], s0[8 * s + 1]); w0.y = cvt_pk_bf16(s0[8 * s + 2], s0[8 * s + 3]); w0.z = cvt_pk_bf16(s0[8 * s + 4], s0[8 * s + 5]); w0.w = cvt_pk_bf16(s0[8 * s + 6], s0[8 * s + 7]);
        w1.x = cvt_pk_bf16(s1[8 * s + 0], s1[8 * s + 1]); w1.y = cvt_pk_bf16(s1[8 * s + 2], s1[8 * s + 3]); w1.z = cvt_pk_bf16(s1[8 * s + 4], s1[8 * s + 5]); w1.w = cvt_pk_bf16(s1[8 * s + 6], s1[8 * s + 7]);
        pf[0][s] = __builtin_bit_cast(bf16x8, w0); pf[1][s] = __builtin_bit_cast(bf16x8, w1);
      }
      const int cbase = local ? (span0 >> 3) : 0;
#pragma unroll
      for (int vb = 0; vb < 2; ++vb) {
        const LAS unsigned char* vrow = vb_ + (vb * 32 + r) * 128;
#pragma unroll
        for (int s = 0; s < 2; ++s) {
          const bf16x8 a = *(const LAS bf16x8*)(vrow + (((cbase + 2 * s + hi) ^ vx) << 4));
          o[vb] = __builtin_amdgcn_mfma_f32_32x32x16_bf16(a, pf[0][s], o[vb], 0, 0, 0);
        }
        if (!local) {
#pragma unroll
          for (int s = 0; s < 2; ++s) {
            const bf16x8 a = *(const LAS bf16x8*)(vrow + (((4 + 2 * s + hi) ^ vx) << 4));
            o[vb] = __builtin_amdgcn_mfma_f32_32x32x16_bf16(a, pf[1][s], o[vb], 0, 0, 0);
          }
        }
      }
    }
    if (more) NA_WRITE((t + 1) & 1);
    __syncthreads();
  }
#undef NA_LOAD
#undef NA_WRITE
  float l_tot; { const u32x2 sw = __builtin_amdgcn_permlane32_swap(__float_as_uint(l_run), __float_as_uint(l_run), false, false); l_tot = __uint_as_float(sw.x) + __uint_as_float(sw.y); }
  const float inv = 1.0f / l_tot;
  bf16_t* op = O + (size_t)qtok * 1024 + h * 64 + 4 * hi;
#pragma unroll
  for (int vb = 0; vb < 2; ++vb)
#pragma unroll
    for (int g = 0; g < 4; ++g) {
      u32x2 w; w.x = cvt_pk_bf16(o[vb][4 * g] * inv, o[vb][4 * g + 1] * inv); w.y = cvt_pk_bf16(o[vb][4 * g + 2] * inv, o[vb][4 * g + 3] * inv);
      *(u32x2*)(op + vb * 32 + 8 * g) = w;
    }
}
}

namespace rw {
using namespace mk;
constexpr int NSTEP = L + T, NCH = 32, CL = NSTEP / NCH;
constexpr int NCHAIN = 2 * B * 8;
constexpr float LOG2E = 1.4426950408889634f;
struct Bufs {
  u32x2* SH;
  unsigned* DR;
  bf16_t* G; int gstride;
  float* CS;
  float* PQ;
  float* SST;
  bf16_t* Y;
  bf16_t* Z;
};

constexpr int XPITCH = 528;
template <int KS> struct LoraW { bf16x8 w[KS][4]; };
template <int KS>
__device__ __forceinline__ void lora_load(const bf16_t* __restrict__ W, int h, int lane, LoraW<KS>& f) {
  const int fr = lane & 15, fq = lane >> 4;
#pragma unroll
  for (int ks = 0; ks < KS; ++ks)
#pragma unroll
    for (int nb = 0; nb < 4; ++nb) f.w[ks][nb] = *(const bf16x8*)(W + (size_t)(h * 64 + nb * 16 + fr) * (KS * 32) + ks * 32 + fq * 8);
}
template <int KS>
__device__ __forceinline__ void lora_mma(const LAS unsigned char* xb, int xcol0, const LoraW<KS>& f, int lane, LAS float* tw, float (&out)[16]) {
  const int fr = lane & 15, fq = lane >> 4;
  f32x4 acc[4];
#pragma unroll
  for (int nb = 0; nb < 4; ++nb) { float z = 0.f; asm volatile("" : "+v"(z)); acc[nb] = (f32x4){z, z, z, z}; }
#pragma unroll
  for (int ks = 0; ks < KS; ++ks) {
    const bf16x8 xf = *(const LAS bf16x8*)(xb + fr * XPITCH + (xcol0 + ks * 32 + fq * 8) * 2);
#pragma unroll
    for (int nb = 0; nb < 4; ++nb) acc[nb] = __builtin_amdgcn_mfma_f32_16x16x32_bf16(xf, f.w[ks][nb], acc[nb], 0, 0, 0);
  }
#pragma unroll
  for (int nb = 0; nb < 4; ++nb) *(LAS f32x4*)(tw + (nb * 16 + fr) * 16 + fq * 4) = acc[nb];
  __builtin_amdgcn_wave_barrier(); asm volatile("s_waitcnt lgkmcnt(0)" ::: "memory"); __builtin_amdgcn_wave_barrier();
#pragma unroll
  for (int q = 0; q < 4; ++q) { const f32x4 v = *(const LAS f32x4*)(tw + lane * 16 + q * 4); out[q * 4] = v[0]; out[q * 4 + 1] = v[1]; out[q * 4 + 2] = v[2]; out[q * 4 + 3] = v[3]; }
  __builtin_amdgcn_wave_barrier(); asm volatile("s_waitcnt lgkmcnt(0)" ::: "memory"); __builtin_amdgcn_wave_barrier();
}
__device__ __forceinline__ void prep_tile(const bf16_t* __restrict__ Prw, const float* __restrict__ cw, const float* __restrict__ w0, const bf16_t* __restrict__ WLT, const float* __restrict__ a0,
                                          const float* __restrict__ k_k, const float* __restrict__ k_a, const float* __restrict__ r_k,
                                          const Bufs& bf, int tile, LAS float* xs  ) {
  const int c = mk::otid(), lane = c & 63, h = c >> 6;
  const int row0 = tile * 16;
  int lo, hi;
  if (row0 < NLAT) { lo = (row0 / T) * T; hi = lo + T - 1; } else { lo = NLAT + ((row0 - NLAT) / L) * L; hi = lo + L - 1; }
  bf16_t rraw[18], kraw[18], vraw[18];
#pragma unroll
  for (int j = 0; j < 18; ++j) { int rr_ = row0 - 1 + j; rr_ = rr_ < lo ? lo : (rr_ > hi ? hi : rr_); const bf16_t* q = Prw + (size_t)rr_ * RW_IN + c; rraw[j] = q[0]; kraw[j] = q[512]; vraw[j] = q[1024]; }
  LoraW<2> wd0, wd1; LoraW<4> wg;
  lora_load<2>(WLT, h, lane, wd0); lora_load<2>(WLT + 32768, h, lane, wd1);
#define RW_CONV(dst, col) do { const float c0 = cw[(col)], c1 = cw[RW_IN + (col)], c2 = cw[2 * RW_IN + (col)]; const bf16_t* p = Prw + (col); \
    bf16_t raw[18]; \
    _Pragma("unroll") for (int j = 0; j < 18; ++j) { int rr = row0 - 1 + j; rr = rr < lo ? lo : (rr > hi ? hi : rr); raw[j] = p[(size_t)rr * RW_IN]; } \
    float pm = row0 > lo ? bf2f(raw[0]) : 0.f, pc = bf2f(raw[1]); \
    _Pragma("unroll") for (int tt = 0; tt < 16; ++tt) { const float pn = (row0 + tt + 1 <= hi) ? bf2f(raw[tt + 2]) : 0.f; dst[tt] = pm * c0 + pc * c1 + pn * c2; pm = pc; pc = pn; } } while (0)
  if (c < 256) {
    float xv[16]; RW_CONV(xv, 1536 + c);
#pragma unroll
    for (int tt = 0; tt < 16; ++tt) { float v = xv[tt]; if (c < 64) v = 2.0f * sigmoid_r(2.0f * v) - 1.0f; else if (c >= 128) v = sigmoid_r(v);     *(LAS bf16_t*)((LAS unsigned char*)xs + tt * XPITCH + c * 2) = f2bf(v); }
  }
  __syncthreads();
  const LAS unsigned char* xb = (const LAS unsigned char*)xs; LAS float* tw = xs + 20480 + h * 1024;
  const float w00 = w0[c], w01 = w0[512 + c], a00 = a0[c], a01 = a0[512 + c], kkc = k_k[c], kac = k_a[c], rkc = r_k[c];
  float e0[16], e1[16];
  {
    float aw0[16], aw1[16];
    lora_mma<2>(xb, 0, wd0, lane, tw, aw0); lora_mma<2>(xb, 0, wd1, lane, tw, aw1);
    lora_load<2>(WLT + 2 * 32768, h, lane, wd0); lora_load<2>(WLT + 3 * 32768, h, lane, wd1);
#pragma unroll
    for (int tt = 0; tt < 16; ++tt) {
      e0[tt] = 0.6065306597126334f * __builtin_amdgcn_rcpf(1.0f + __expf(-(w00 + aw0[tt])));
      e1[tt] = 0.6065306597126334f * __builtin_amdgcn_rcpf(1.0f + __expf(-(w01 + aw1[tt])));
    }
  }
  LAS float* asl = xs + 256 * 16;
  {
    float aa0[16], aa1[16];
    lora_mma<2>(xb, 64, wd0, lane, tw, aa0); lora_mma<2>(xb, 64, wd1, lane, tw, aa1);
    lora_load<4>(WLT + 4 * 32768, h, lane, wg);
#pragma unroll
    for (int tt = 0; tt < 16; ++tt) { const unsigned d0 = cvt_pk_bf16(e0[tt], sigmoid_r(a00 + aa0[tt])), d1 = cvt_pk_bf16(e1[tt], sigmoid_r(a01 + aa1[tt]));
      bf.DR[((size_t)(row0 + tt)) * 512 + c] = d0; bf.DR[((size_t)NTOK + row0 + tt) * 512 + c] = d1; asl[tt * 512 + c] = bfhi(d0); asl[(16 + tt) * 512 + c] = bfhi(d1); }
  }
  {
    float ag[16];
    lora_mma<4>(xb, 128, wg, lane, tw, ag);
#pragma unroll
    for (int tt = 0; tt < 16; ++tt) bf.G[(size_t)(row0 + tt) * bf.gstride + c] = f2bf(ag[tt]);
  }
#undef RW_CONV
  const float cr0 = cw[c], cr1 = cw[RW_IN + c], cr2 = cw[2 * RW_IN + c], ck0 = cw[512 + c], ck1 = cw[RW_IN + 512 + c], ck2 = cw[2 * RW_IN + 512 + c], cv0 = cw[1024 + c], cv1 = cw[RW_IN + 1024 + c], cv2 = cw[2 * RW_IN + 1024 + c];
  float rm = row0 > lo ? bf2f(rraw[0]) : 0.f, km = row0 > lo ? bf2f(kraw[0]) : 0.f, vm = row0 > lo ? bf2f(vraw[0]) : 0.f;
  float rc = bf2f(rraw[1]), kc = bf2f(kraw[1]), vc = bf2f(vraw[1]);
  float rvv[16], kvvv[16], vvvv[16], q1[16];
#pragma unroll
  for (int tt = 0; tt < 16; ++tt) {
    const bool has_n = row0 + tt + 1 <= hi;
    const float rn = has_n ? bf2f(rraw[tt + 2]) : 0.f, kn = has_n ? bf2f(kraw[tt + 2]) : 0.f, vn = has_n ? bf2f(vraw[tt + 2]) : 0.f;
    rvv[tt] = rm * cr0 + rc * cr1 + rn * cr2; kvvv[tt] = km * ck0 + kc * ck1 + kn * ck2; vvvv[tt] = vm * cv0 + vc * cv1 + vn * cv2;
    rm = rc; rc = rn; km = kc; kc = kn; vm = vc; vc = vn;
    const float kk = kvvv[tt] * kkc; q1[tt] = kk * kk;
  }
  const float nrm2 = reduce_scatter16(q1, lane);
  float c0p[16], c1p[16];
#pragma unroll
  for (int tt = 0; tt < 16; ++tt) {
    const int row = row0 + tt;
    const float nrm = sqrtf(__uint_as_float(__builtin_amdgcn_readlane(__float_as_uint(nrm2), 4 * tt)));
    const float kk = kvvv[tt] * kkc * __builtin_amdgcn_rcpf(fmaxf(nrm, 1e-12f));
    u32x2 sh; sh.x = cvt_pk_bf16(rvv[tt], kvvv[tt]); sh.y = cvt_pk_bf16(kk, vvvv[tt]);
    bf.SH[(size_t)row * 512 + c] = sh;
    const float rq = bflo(sh.x), kq = bfhi(sh.x);
    c0p[tt] = rq * kq * (1.0f + (asl[tt * 512 + c] - 1.0f) * kac) * rkc; c1p[tt] = rq * kq * (1.0f + (asl[(16 + tt) * 512 + c] - 1.0f) * kac) * rkc;
  }
  const float cb0 = reduce_scatter16(c0p, lane), cb1 = reduce_scatter16(c1p, lane);
  if ((lane & 3) == 0) { const int row = row0 + (lane >> 2); bf.CS[(size_t)row * 16 + h] = cb0; bf.CS[(size_t)row * 16 + 8 + h] = cb1; }
  __syncthreads();
}

struct StepRaw { u32x2 s; unsigned d; };
__device__ __forceinline__ int scan_row(int dir, int b, int p) {
  if (p < L) return NLAT + b * L + (dir ? (L - 1 - p) : p);
  const int q = p - L; return b * T + (dir ? (T - 1 - q) : q);
}
__device__ __forceinline__ void scan_unit(const Bufs& bf, const float* __restrict__ k_a, int chain, int chunk, LAS float* wl) {
  const int lane = mk::otid() & 63, r = lane & 31, hi = lane >> 5;
  const int dir = chain >> 5, b = (chain >> 3) & 3, h = chain & 7, ch = h * 64 + lane;
  const float kac = k_a[ch];
  f32x16 TS[2][2], TP[2][2];
#pragma unroll
  for (int rb = 0; rb < 2; ++rb)
#pragma unroll
    for (int cb = 0; cb < 2; ++cb)
#pragma unroll
      for (int q = 0; q < 16; ++q) { TS[rb][cb][q] = 0.f; TP[rb][cb][q] = (32 * rb + (q & 3) + 8 * (q >> 2) + 4 * hi == 32 * cb + r) ? 1.f : 0.f; }
  LAS unsigned char* wb = (LAS unsigned char*)wl;
  const LAS unsigned char* xrow = wb + (lane & 15) * 128 + 8 * hi;
  LAS float* Gl = wl + 1024;
  const int p0 = chunk * CL;
  float Dl = 1.f;
#define RW_FRAG(base, rb, s2) ([&]() { const u32x2 lo_ = *(const LAS u32x2*)((base) + (32 * (rb) + 16 * (s2)) * 2), hi_ = *(const LAS u32x2*)((base) + (32 * (rb) + 16 * (s2) + 8) * 2); \
      return __builtin_bit_cast(bf16x8, (u32x4){lo_.x, lo_.y, hi_.x, hi_.y}); }())
#define RW_DOTS(T, o) do { _Pragma("unroll") for (int cb = 0; cb < 2; ++cb) _Pragma("unroll") for (int q = 0; q < 16; ++q) o[cb][q] = 0.f; \
    _Pragma("unroll") for (int rb = 0; rb < 2; ++rb) _Pragma("unroll") for (int s2 = 0; s2 < 2; ++s2) _Pragma("unroll") for (int cb = 0; cb < 2; ++cb) { u32x4 w_; \
      w_.x = cvt_pk_bf16(T[rb][cb][8 * s2 + 0], T[rb][cb][8 * s2 + 1]); w_.y = cvt_pk_bf16(T[rb][cb][8 * s2 + 2], T[rb][cb][8 * s2 + 3]); \
      w_.z = cvt_pk_bf16(T[rb][cb][8 * s2 + 4], T[rb][cb][8 * s2 + 5]); w_.w = cvt_pk_bf16(T[rb][cb][8 * s2 + 6], T[rb][cb][8 * s2 + 7]); \
      o[cb] = __builtin_amdgcn_mfma_f32_32x32x16_bf16(xf[rb][s2], __builtin_bit_cast(bf16x8, w_), o[cb], 0, 0, 0); \
      asm volatile("" : "+v"(o[cb]) : "v"(w_), "v"(xf[rb][s2]));   } } while (0)
#define RW_RENORM() do { wl[1280 + lane] = Dl; __builtin_amdgcn_wave_barrier(); \
    _Pragma("unroll") for (int rb = 0; rb < 2; ++rb) _Pragma("unroll") for (int g = 0; g < 4; ++g) { const f32x4 w4 = *(const LAS f32x4*)(wl + 1280 + 32 * rb + 8 * g + 4 * hi); \
      _Pragma("unroll") for (int cb = 0; cb < 2; ++cb) _Pragma("unroll") for (int u = 0; u < 4; ++u) { TS[rb][cb][4 * g + u] *= w4[u]; TP[rb][cb][4 * g + u] *= w4[u]; } } \
    __builtin_amdgcn_wave_barrier(); Dl = 1.f; } while (0)
  const int wvs = __builtin_amdgcn_readfirstlane((int)((size_t)wl));
#define RW_FETCH(tb) do { _Pragma("unroll") for (int u = 0; u < 8; ++u) { const int pn = (tb) + u < CL ? (tb) + u : CL - 1; const int row = scan_row(dir, b, p0 + pn); \
      const unsigned* gs = (const unsigned*)(bf.SH + (size_t)row * 512 + ch); const unsigned* gd = bf.DR + ((size_t)dir * NTOK + row) * 512 + ch; LAS unsigned* ld = (LAS unsigned*)(size_t)(wvs + 8192 + u * 768); \
      __builtin_amdgcn_global_load_lds(gs, ld, 4, 0, 0); __builtin_amdgcn_global_load_lds(gs + 1, ld + 64, 4, 0, 0); __builtin_amdgcn_global_load_lds(gd, ld + 128, 4, 0, 0); } } while (0)
  RW_FETCH(0);
  for (int t0 = 0; t0 < CL; t0 += 8) {
    asm volatile("s_waitcnt vmcnt(0)" ::: "memory");
    __builtin_amdgcn_wave_barrier();
#pragma unroll
    for (int u = 0; u < 8; ++u) {
      const LAS unsigned* ld = (const LAS unsigned*)(wb + 8192 + u * 768) + lane; const unsigned sx = ld[0], sy = ld[64], dd = ld[128];
      const float rr = bflo(sx), k = bfhi(sx), kk = bflo(sy), e = bflo(dd), asg = bfhi(dd);
      const float w = __builtin_amdgcn_exp2f(-e * LOG2E), keff = k * (1.0f + (asg - 1.0f) * kac);
      ((LAS bf16_t*)wb)[u * 64 + lane] = f2bf(-kk * Dl);
      Dl *= w; const float dinv = __builtin_amdgcn_rcpf(Dl);
      ((LAS bf16_t*)wb)[(8 + u) * 64 + lane] = f2bf(rr * Dl);
      ((LAS bf16_t*)wb)[1024 + u * 64 + lane] = f2bf(kk * asg * dinv); ((LAS bf16_t*)wb)[1024 + (8 + u) * 64 + lane] = f2bf(keff * dinv);
      ((LAS bf16_t*)wb)[3072 + u * 64 + lane] = (bf16_t)(sy >> 16);
    }
    asm volatile("s_waitcnt lgkmcnt(0)" ::: "memory");
    __builtin_amdgcn_wave_barrier();
    RW_FETCH(t0 + 8);
    __builtin_amdgcn_wave_barrier();
    bf16x8 xf[2][2];
#pragma unroll
    for (int rb = 0; rb < 2; ++rb)
#pragma unroll
      for (int s2 = 0; s2 < 2; ++s2) xf[rb][s2] = RW_FRAG(xrow, rb, s2);
    { f32x16 gm;
#pragma unroll
      for (int q = 0; q < 16; ++q) gm[q] = 0.f;
#pragma unroll
      for (int rb = 0; rb < 2; ++rb)
#pragma unroll
        for (int s2 = 0; s2 < 2; ++s2) { const bf16x8 yf = RW_FRAG(xrow + 2048, rb, s2); gm = __builtin_amdgcn_mfma_f32_32x32x16_bf16(xf[rb][s2], yf, gm, 0, 0, 0); asm volatile("" : "+v"(gm) : "v"(yf), "v"(xf[rb][s2])); }
      if (r < 16) {
#pragma unroll
        for (int q = 0; q < 8; ++q) Gl[((q & 3) + 8 * (q >> 2) + 4 * hi) * 16 + r] = gm[q]; }
    }
    float sa[2][8], yy[2][8];
    { f32x16 oS[2], oP[2];
      RW_DOTS(TS, oS); RW_DOTS(TP, oP);
#pragma unroll
      for (int cb = 0; cb < 2; ++cb)
#pragma unroll
        for (int q = 0; q < 4; ++q) {
          { const u32x2 sw = __builtin_amdgcn_permlane32_swap(__float_as_uint(oS[cb][q]), __float_as_uint(oP[cb][q]), false, false); sa[cb][q] = __uint_as_float(sw.x); sa[cb][4 + q] = __uint_as_float(sw.y); }
          { const u32x2 sw = __builtin_amdgcn_permlane32_swap(__float_as_uint(oS[cb][4 + q]), __float_as_uint(oP[cb][4 + q]), false, false); yy[cb][q] = __uint_as_float(sw.x); yy[cb][4 + q] = __uint_as_float(sw.y); } }
    }
    __builtin_amdgcn_wave_barrier();
    float vm[2][8];
#pragma unroll
    for (int u = 0; u < 8; ++u) { const LAS bf16_t* vr = (const LAS bf16_t*)wb + 3072 + u * 64 + r; vm[0][u] = hi ? 0.f : bf2f(vr[0]); vm[1][u] = hi ? 0.f : bf2f(vr[32]); }
#pragma unroll
    for (int s = 0; s < 8; ++s) {
      const f32x4 ga0 = *(const LAS f32x4*)(Gl + s * 16), ga1 = *(const LAS f32x4*)(Gl + s * 16 + 4), ga2 = *(const LAS f32x4*)(Gl + s * 16 + 8), ga3 = *(const LAS f32x4*)(Gl + s * 16 + 12);
      const f32x4 gr0 = *(const LAS f32x4*)(Gl + (8 + s) * 16), gr1 = *(const LAS f32x4*)(Gl + (8 + s) * 16 + 4), gr2 = *(const LAS f32x4*)(Gl + (8 + s) * 16 + 8), gr3 = *(const LAS f32x4*)(Gl + (8 + s) * 16 + 12);
      const float gab[8] = {ga0[0], ga0[1], ga0[2], ga0[3], ga1[0], ga1[1], ga1[2], ga1[3]}, gak[8] = {ga2[0], ga2[1], ga2[2], ga2[3], ga3[0], ga3[1], ga3[2], ga3[3]};
      const float grb[8] = {gr0[0], gr0[1], gr0[2], gr0[3], gr1[0], gr1[1], gr1[2], gr1[3]}, grk[8] = {gr2[0], gr2[1], gr2[2], gr2[3], gr3[0], gr3[1], gr3[2], gr3[3]};
#pragma unroll
      for (int cb = 0; cb < 2; ++cb) {
        float x = sa[cb][s], y = yy[cb][s];
#pragma unroll
        for (int u = 0; u < 8; ++u) { if (u < s) { x = fmaf(gab[u], sa[cb][u], x); x = fmaf(gak[u], vm[cb][u], x); } }
        sa[cb][s] = x;
#pragma unroll
        for (int u = 0; u < 8; ++u) { if (u <= s) { y = fmaf(grb[u], sa[cb][u], y); y = fmaf(grk[u], vm[cb][u], y); } }
        yy[cb][s] = y;
      }
    }
    { bf16_t* yz = hi ? bf.Z : bf.Y;
#pragma unroll
      for (int s = 0; s < 8; ++s) { const size_t oi = ((size_t)dir * NTOK + scan_row(dir, b, p0 + t0 + s)) * 512 + h * 64 + r; yz[oi] = f2bf(yy[0][s]); yz[oi + 32] = f2bf(yy[1][s]); } }
    { bf16x8 au[2], buS[2], buP[2];
      u32x4 a0, a1, s0, s1, p0_, p1_;
#pragma unroll
      for (int q = 0; q < 4; ++q) {
        const int u = 4 * hi + q;
        const LAS bf16_t* yb = (const LAS bf16_t*)wb + 1024 + u * 64 + r; const LAS bf16_t* vr = (const LAS bf16_t*)wb + 3072 + u * 64 + r;
        a0[q] = (unsigned)yb[0] | ((unsigned)yb[512] << 16); a1[q] = (unsigned)yb[32] | ((unsigned)yb[512 + 32] << 16);
        const u32x2 sw0 = __builtin_amdgcn_permlane32_swap(__float_as_uint(sa[0][q]), __float_as_uint(sa[0][4 + q]), false, false), sw1 = __builtin_amdgcn_permlane32_swap(__float_as_uint(sa[1][q]), __float_as_uint(sa[1][4 + q]), false, false);
        s0[q] = (cvt_pk_bf16(__uint_as_float(sw0.x), 0.f) & 0xffffu) | ((unsigned)vr[0] << 16); s1[q] = (cvt_pk_bf16(__uint_as_float(sw1.x), 0.f) & 0xffffu) | ((unsigned)vr[32] << 16);
        p0_[q] = cvt_pk_bf16(__uint_as_float(sw0.y), 0.f); p1_[q] = cvt_pk_bf16(__uint_as_float(sw1.y), 0.f); }
      au[0] = __builtin_bit_cast(bf16x8, a0); au[1] = __builtin_bit_cast(bf16x8, a1); buS[0] = __builtin_bit_cast(bf16x8, s0); buS[1] = __builtin_bit_cast(bf16x8, s1); buP[0] = __builtin_bit_cast(bf16x8, p0_); buP[1] = __builtin_bit_cast(bf16x8, p1_);
#pragma unroll
      for (int rb = 0; rb < 2; ++rb)
#pragma unroll
        for (int cb = 0; cb < 2; ++cb) { TS[rb][cb] = __builtin_amdgcn_mfma_f32_32x32x16_bf16(au[rb], buS[cb], TS[rb][cb], 0, 0, 0); TP[rb][cb] = __builtin_amdgcn_mfma_f32_32x32x16_bf16(au[rb], buP[cb], TP[rb][cb], 0, 0, 0); }
    }
    __builtin_amdgcn_wave_barrier();
    if ((t0 & 31) == 24) RW_RENORM();
  }
  RW_RENORM();
#undef RW_DOTS
#undef RW_FRAG
#undef RW_RENORM
#undef RW_FETCH
  asm volatile("s_waitcnt vmcnt(0)" ::: "memory");
  if (chunk < NCH - 1) {
    float* pq = bf.PQ + (((size_t)chain * (NCH - 1) + chunk) * 2) * 4096;
#pragma unroll
    for (int rb = 0; rb < 2; ++rb)
#pragma unroll
      for (int cb = 0; cb < 2; ++cb)
#pragma unroll
        for (int g = 0; g < 4; ++g) { float* q = pq + (size_t)(32 * cb + r) * 64 + 32 * rb + 8 * g + 4 * hi;
          *(f32x4*)q = (f32x4){TP[rb][cb][4 * g], TP[rb][cb][4 * g + 1], TP[rb][cb][4 * g + 2], TP[rb][cb][4 * g + 3]};
          *(f32x4*)(q + 4096) = (f32x4){TS[rb][cb][4 * g], TS[rb][cb][4 * g + 1], TS[rb][cb][4 * g + 2], TS[rb][cb][4 * g + 3]}; }
  }
}

__device__ __forceinline__ void propagate_chain(const Bufs& bf, int chain, int rq, LAS float* lds) {
  LAS float* Sl = lds; LAS float* Pl = lds + 16 * 65 + 15;
  Pl = lds + 1056;
  const int tid = mk::otid(), i = tid >> 5, jc = (tid & 31) * 2, row = rq * 16 + i, pi = tid >> 3, pj = (tid & 7) * 8;
  float* sst = bf.SST + (size_t)chain * NCH * 4096;
  Sl[i * 65 + jc] = 0.f; Sl[i * 65 + jc + 1] = 0.f;
  const float* pb = bf.PQ + ((size_t)chain * (NCH - 1) * 2) * 4096;
  f32x4 np0 = *(const f32x4*)(pb + pi * 64 + pj), np1 = *(const f32x4*)(pb + pi * 64 + pj + 4); f32x2 nq = *(const f32x2*)(pb + 4096 + row * 64 + jc);
  for (int c = 0; c < NCH - 1; ++c) {
    const f32x4 p0 = np0, p1 = np1; f32x2 q = nq;
    { const float* pn = pb + (size_t)(c + 1 < NCH - 1 ? c + 1 : c) * 2 * 4096;
      np0 = *(const f32x4*)(pn + pi * 64 + pj); np1 = *(const f32x4*)(pn + pi * 64 + pj + 4); nq = *(const f32x2*)(pn + 4096 + row * 64 + jc); }
    *(LAS f32x4*)(Pl + pi * 64 + pj) = p0; *(LAS f32x4*)(Pl + pi * 64 + pj + 4) = p1;
    __syncthreads();
#pragma unroll 16
    for (int k = 0; k < 64; ++k) { const float sv = Sl[i * 65 + k]; const f32x2 a = *(const LAS f32x2*)(Pl + k * 64 + jc); q += sv * a; }
    __syncthreads();
    Sl[i * 65 + jc] = q[0]; Sl[i * 65 + jc + 1] = q[1];
    *(f32x2*)(sst + (size_t)(c + 1) * 4096 + row * 64 + jc) = q;
  }
  __syncthreads();
}

__device__ __forceinline__ void corr_unit(const Bufs& bf, int chain, int chunk) {
  const int lane = mk::otid() & 63, r = lane & 31, hi = lane >> 5;
  const int dir = chain >> 5, b = (chain >> 3) & 3, h = chain & 7;
  const float* ss = bf.SST + ((size_t)chain * NCH + chunk) * 4096;
  bf16x8 bfr[2][4];
#pragma unroll
  for (int nt = 0; nt < 2; ++nt)
#pragma unroll
    for (int ks = 0; ks < 4; ++ks) { const float* q = ss + (size_t)(nt * 32 + r) * 64 + ks * 16 + hi * 8; const f32x4 x0 = *(const f32x4*)q, x1 = *(const f32x4*)(q + 4);
      u32x4 w; w.x = cvt_pk_bf16(x0[0], x0[1]); w.y = cvt_pk_bf16(x0[2], x0[3]); w.z = cvt_pk_bf16(x1[0], x1[1]); w.w = cvt_pk_bf16(x1[2], x1[3]); bfr[nt][ks] = __builtin_bit_cast(bf16x8, w); }
  const int p0 = chunk * CL;
  const size_t dbase = (size_t)dir * NTOK;
  for (int mt = 0; mt < (CL + 31) / 32; ++mt) {
    const int sa_ = min(mt * 32 + r, CL - 1);
    const bf16_t* zp = bf.Z + (dbase + scan_row(dir, b, p0 + sa_)) * 512 + h * 64 + hi * 8;
    bf16x8 af[4];
#pragma unroll
    for (int ks = 0; ks < 4; ++ks) af[ks] = *(const bf16x8*)(zp + ks * 16);
    bf16_t yo0[16], yo1[16];
#pragma unroll
    for (int i = 0; i < 16; ++i) { const int so = min(mt * 32 + (i & 3) + 8 * (i >> 2) + 4 * hi, CL - 1); const bf16_t* yp = bf.Y + (dbase + scan_row(dir, b, p0 + so)) * 512 + h * 64 + r; yo0[i] = yp[0]; yo1[i] = yp[32]; }
    f32x16 acc[2];
#pragma unroll
    for (int nt = 0; nt < 2; ++nt) { acc[nt] = zero16();
#pragma unroll
      for (int ks = 0; ks < 4; ++ks) acc[nt] = __builtin_amdgcn_mfma_f32_32x32x16_bf16(af[ks], bfr[nt][ks], acc[nt], 0, 0, 0); }
#pragma unroll
    for (int i = 0; i < 16; ++i) { const int so = mt * 32 + (i & 3) + 8 * (i >> 2) + 4 * hi;
      if (so < CL) { bf16_t* yp = bf.Y + (dbase + scan_row(dir, b, p0 + so)) * 512 + h * 64 + r;
        yp[0] = f2bf(bf2f(yo0[i]) + acc[0][i]); yp[32] = f2bf(bf2f(yo1[i]) + acc[1][i]); } }
  }
}

template <int NR> struct FinRaw { bf16_t y0[NR], y1[NR], g[NR]; unsigned v[NR]; float c0[NR], c1[NR]; };
template <int NR>
__device__ __forceinline__ void finish_load(const Bufs& bf, int row0, int c, int h, FinRaw<NR>& q) {
#pragma unroll
  for (int i = 0; i < NR; ++i) { const int row = row0 + i;
    q.y0[i] = bf.Y[(size_t)row * 512 + c]; q.y1[i] = bf.Y[((size_t)NTOK + row) * 512 + c];
    q.v[i] = bf.SH[(size_t)row * 512 + c].y; q.g[i] = bf.G[(size_t)row * bf.gstride + c];
    q.c0[i] = bf.CS[(size_t)row * 16 + h]; q.c1[i] = bf.CS[(size_t)row * 16 + 8 + h]; }
}
template <int NR>
__device__ __forceinline__ void finish_phase(const Bufs& bf, const float* __restrict__ gn_g, const float* __restrict__ gn_b, bf16_t* __restrict__ O) {
  const int c = mk::otid(), h = c >> 6, stride = gridDim.x * NR;
  const float gg = gn_g[c], gb = gn_b[c];
  int row0 = mk::obid() * NR;
  if (row0 >= NTOK) return;
  FinRaw<NR> cur, nxt; finish_load<NR>(bf, row0, c, h, cur);
  for (; row0 < NTOK; row0 += stride) {
    const int rn = row0 + stride < NTOK ? row0 + stride : row0;
    finish_load<NR>(bf, rn, c, h, nxt);
    float o[NR];
    if constexpr (NR == 8) {
      float mom[16], yv[8];
#pragma unroll
      for (int i = 0; i < 8; ++i) { yv[i] = bf2f(cur.y0[i]) + bf2f(cur.y1[i]); mom[i] = yv[i]; mom[8 + i] = yv[i] * yv[i]; }
      const float tot = reduce_scatter16(mom, c & 63);
#pragma unroll
      for (int i = 0; i < 8; ++i) { const float mu = __uint_as_float(__builtin_amdgcn_readlane(__float_as_uint(tot), 4 * i)) * (1.0f / 64.0f), m2 = __uint_as_float(__builtin_amdgcn_readlane(__float_as_uint(tot), 32 + 4 * i)) * (1.0f / 64.0f);
        const float var = fmaxf(m2 - mu * mu, 0.f);
        o[i] = ((yv[i] - mu) * rsqrtf(var + 64e-5f) * gg + gb + (cur.c0[i] + cur.c1[i]) * bfhi(cur.v[i])) * bf2f(cur.g[i]); }
    } else {
#pragma unroll
    for (int i = 0; i < NR; ++i) { const float y = bf2f(cur.y0[i]) + bf2f(cur.y1[i]);
      const float mu = wave_sum_u(y) * (1.0f / 64.0f); const float dv = y - mu; const float var = wave_sum_u(dv * dv) * (1.0f / 64.0f);
      o[i] = (dv * rsqrtf(var + 64e-5f) * gg + gb + (cur.c0[i] + cur.c1[i]) * bfhi(cur.v[i])) * bf2f(cur.g[i]); }
    }
#pragma unroll
    for (int i = 0; i < NR; ++i) O[(size_t)(row0 + i) * 1024 + 512 + c] = f2bf(o[i]);
    cur = nxt;
  }
}
}

namespace mk {
constexpr size_t al256(size_t x) { return (x + 255) / 256 * 256; }
constexpr size_t WS_BAR = 0;
constexpr size_t WS_BCNT = al256(WS_BAR + (size_t)XCD_BAR_WORDS * 4);
constexpr size_t WS_MOFF = al256(WS_BCNT + (size_t)4 * 256 * 64 * 4);
constexpr size_t WS_KN = al256(WS_MOFF + 4 * 256);
constexpr size_t WS_MOD = al256(WS_KN + (size_t)2 * 256 * 32 * 4);
constexpr size_t WS_ROPE = al256(WS_MOD + (size_t)4 * 5 * 6144 * 4);
constexpr size_t WS_HBC = al256(WS_ROPE + 128 * 16 * 2 * 4);
constexpr size_t WS_EID = al256(WS_HBC + (size_t)NCTX * D * 2);
constexpr size_t WS_GATE = al256(WS_EID + (size_t)NTOK * 2 * 4);
constexpr size_t WS_POS = al256(WS_GATE + (size_t)NTOK * 2 * 4);
constexpr size_t WS_RL = al256(WS_POS + (size_t)NTOK * 2 * 4);
constexpr size_t WS_WEIN = al256(WS_RL + (size_t)MOE_ROWS * 4);
constexpr size_t WS_WOIN = al256(WS_WEIN + (size_t)2 * EVEN_IN * D * 2);
constexpr size_t WS_WEOUT = al256(WS_WOIN + (size_t)2 * ODD_IN * D * 2);
constexpr size_t WS_WOOUT = al256(WS_WEOUT + (size_t)2 * D * D * 2);
constexpr size_t WS_WGU = al256(WS_WOOUT + (size_t)2 * D * D * 2);
constexpr size_t WS_WDN = al256(WS_WGU + (size_t)NE * 1024 * D * 2);
constexpr size_t WS_WLT = al256(WS_WDN + (size_t)NE * D * DE * 2);
constexpr size_t WS_UO = al256(WS_WLT + (size_t)2 * 196608 * 2);
constexpr size_t WS_SCR = al256(WS_UO + (size_t)NTOK * D * 2);
constexpr size_t SE_PQK = 0;
constexpr size_t SE_VT = al256(SE_PQK + (size_t)NTOK * 1024 * 2);
constexpr size_t SE_PRW = al256(SE_VT + (size_t)512 * NTOK * 2);
constexpr size_t SE_PQ = 0;
constexpr size_t SE_SST = al256(SE_PQ + (size_t)rw::NCHAIN * (rw::NCH - 1) * 2 * 4096 * 4);
constexpr size_t SE_Y = al256(SE_SST + (size_t)rw::NCHAIN * rw::NCH * 4096 * 4);
constexpr size_t SE_Z = al256(SE_Y + (size_t)2 * NTOK * 512 * 2);
constexpr size_t SE_ZEND = al256(SE_Z + (size_t)2 * NTOK * 512 * 2);
constexpr size_t SE_PRWEND = al256(SE_PRW + (size_t)NTOK * RW_IN * 2);
constexpr size_t SE_SH = SE_PRWEND > SE_ZEND ? SE_PRWEND : SE_ZEND;
constexpr size_t SE_DR = al256(SE_SH + (size_t)NTOK * 512 * 8);
constexpr size_t SE_CS = al256(SE_DR + (size_t)2 * NTOK * 512 * 4);
constexpr size_t SE_END = al256(SE_CS + (size_t)2 * NTOK * 16 * 4);
constexpr size_t SE_YBUF = 0;
constexpr size_t SO_PQK = 0;
constexpr size_t SO_VT = al256(SO_PQK + (size_t)NTOK * 2048 * 2);
constexpr size_t SO_O12 = al256(SO_VT + (size_t)1024 * NTOK * 2);
constexpr size_t SO_END = al256(SO_O12 + (size_t)NTOK * 2048 * 2);
constexpr size_t SO_YBUF = 0;
constexpr size_t SM_XS = 0;
constexpr size_t SM_HE = al256(SM_XS + (size_t)MOE_ROWS * D * 2);
constexpr size_t SM_YS = al256(SM_HE + (size_t)MOE_ROWS * DE * 2);
constexpr size_t SM_END = al256(SM_YS + (size_t)MOE_ROWS * D * 2);
constexpr size_t SCR_BYTES = SE_END > SO_END ? (SE_END > SM_END ? SE_END : SM_END) : (SO_END > SM_END ? SO_END : SM_END);
constexpr size_t WS_END = WS_SCR + SCR_BYTES;
constexpr int LDS_BARW = 131072;
constexpr int LDS_MISC = 131072 + 64;

struct Params {
  const float *x, *c, *ctx, *c_ctx, *ada_w, *ada_b, *ln_g, *ln_b, *even_w_in, *even_w_out, *shift_w, *na_rpb, *rw_w0, *rw_w_up, *rw_a0, *rw_a_up, *rw_g_up, *rw_k_k, *rw_k_a, *rw_r_k,
      *rw_gn_g, *rw_gn_b, *odd_w_in, *odd_w_out, *da_lq1, *da_lk1, *da_lq2, *da_lk2, *da_subln_g, *router_w, *router_b, *exp_w_gate, *exp_w_up, *exp_w_down;
  float* out; unsigned char* ws; int ph_lo, ph_hi;
};
template <class Tp> __device__ __forceinline__ Tp* wsp(const Params& p, size_t off) { return (Tp*)(p.ws + off); }

__device__ __forceinline__ void ada_unit(const Params& p, int u, LAS float* lds) {
  LAS float* sc = lds; LAS float* red = lds + 5 * 1024;
  const int tid = mk::otid(), l = u / 96, n = (u % 96) * 64 + (tid & 63), kp = tid >> 6;
  for (int i = tid; i < 5 * 1024; i += NTHR) { const float v = i < 4096 ? p.c[i] : p.c_ctx[i - 4096]; sc[i] = siluf_(v); }
  __syncthreads();
  float a[5] = {0.f, 0.f, 0.f, 0.f, 0.f};
  const float* w = p.ada_w + ((size_t)l * D + kp * 128) * 6144 + n;
#pragma unroll 4
  for (int k = 0; k < 128; ++k) { const float wv = w[(size_t)k * 6144]; const int kk = kp * 128 + k;
#pragma unroll
    for (int r = 0; r < 5; ++r) a[r] = fmaf(sc[r * 1024 + kk], wv, a[r]); }
#pragma unroll
  for (int r = 0; r < 5; ++r) red[(kp * 5 + r) * 64 + (tid & 63)] = a[r];
  __syncthreads();
  if (tid < 320) { const int r = tid >> 6, nn = tid & 63; float s = 0.f;
#pragma unroll
    for (int q = 0; q < 8; ++q) s += red[(q * 5 + r) * 64 + nn];
    const int col = (u % 96) * 64 + nn;
    wsp<float>(p, WS_MOD)[((size_t)l * 5 + r) * 6144 + col] = s + p.ada_b[l * 6144 + col]; }
  __syncthreads();
}
__device__ __forceinline__ void phase_prologue(const Params& p, LAS unsigned char* lds) {
  const int bid = mk::obid(), nb = gridDim.x; LAS float* tile = (LAS float*)lds;
  int ub = 0;
  for (int i = 0; i < 2; ++i) ub += cvt_matrix(p.even_w_in + (size_t)i * D * EVEN_IN, EVEN_IN, D, EVEN_IN, wsp<bf16_t>(p, WS_WEIN) + (size_t)i * EVEN_IN * D, NMapId{0}, tile, ub, bid, nb);
  for (int i = 0; i < 2; ++i) ub += cvt_matrix(p.odd_w_in + (size_t)i * D * ODD_IN, ODD_IN, D, ODD_IN, wsp<bf16_t>(p, WS_WOIN) + (size_t)i * ODD_IN * D, NMapRope{}, tile, ub, bid, nb);
  for (int i = 0; i < 2; ++i) ub += cvt_matrix(p.even_w_out + (size_t)i * D * D, D, D, D, wsp<bf16_t>(p, WS_WEOUT) + (size_t)i * D * D, NMapId{0}, tile, ub, bid, nb);
  for (int i = 0; i < 2; ++i) ub += cvt_matrix(p.odd_w_out + (size_t)i * D * D, D, D, D, wsp<bf16_t>(p, WS_WOOUT) + (size_t)i * D * D, NMapId{0}, tile, ub, bid, nb);
  for (int i = 0; i < 2; ++i) { bf16_t* wl = wsp<bf16_t>(p, WS_WLT) + (size_t)i * 196608;
    for (int d = 0; d < 2; ++d) { ub += cvt_matrix(p.rw_w_up + (size_t)(i * 2 + d) * 64 * 512, 512, 64, 512, wl + (size_t)d * 32768, NMapId{0}, tile, ub, bid, nb);
      ub += cvt_matrix(p.rw_a_up + (size_t)(i * 2 + d) * 64 * 512, 512, 64, 512, wl + (size_t)(2 + d) * 32768, NMapId{0}, tile, ub, bid, nb); }
    ub += cvt_matrix(p.rw_g_up + (size_t)i * 128 * 512, 512, 128, 512, wl + (size_t)4 * 32768, NMapId{0}, tile, ub, bid, nb); }
  for (int u = (bid + nb - ub % nb) % nb; u < 384; u += nb) ada_unit(p, u, (LAS float*)lds);
  const int gt = bid * NTHR + mk::otid();
  if (gt < 128 * 16) { const int pos = gt >> 4, i = gt & 15; const float inv = exp2f(-(float)i * (13.287712379549449f / 16.0f)); float sn, cs; sincosf((float)pos * inv, &sn, &cs);
    wsp<float>(p, WS_ROPE)[gt * 2] = cs; wsp<float>(p, WS_ROPE)[gt * 2 + 1] = sn; }
}
#define CVT_JOB(u_, src_, dst_, ld_, K_, k0_, n0_, mode_) do { const int e_ = (u_) / 384, rem_ = (u_) % 384, v_ = rem_ & 127; mode_ = rem_ >> 7; const size_t so_ = ((size_t)l * NE + e_) * D * DE; \
    const bool dn_ = mode_ == 2; src_ = (dn_ ? wd_ : (mode_ == 0 ? wg_ : wu_)) + so_; ld_ = dn_ ? D : DE; K_ = dn_ ? DE : D; \
    k0_ = (dn_ ? (v_ >> 4) : (v_ >> 3)) * 64; n0_ = (dn_ ? (v_ & 15) : (v_ & 7)) * 64; dst_ = dn_ ? wsp<bf16_t>(p, WS_WDN) + (size_t)e_ * D * DE : wsp<bf16_t>(p, WS_WGU) + (size_t)e_ * 1024 * D; } while (0)
__device__ __forceinline__ void cvt_experts(const Params& p, int l, LAS float* tile, int b0) {
  const int bid = mk::obid() - b0, nb = (int)gridDim.x - b0, t = mk::otid();
  if (bid < 0) return;
  const float* wg_ = p.exp_w_gate; const float* wu_ = p.exp_w_up; const float* wd_ = p.exp_w_down; asm volatile("" : "+s"(wg_), "+s"(wu_), "+s"(wd_));
  constexpr int NJ = NE * 384;
  int u = bid;
  if (u >= NJ) return;
  const float* csrc; bf16_t* cdst; int cld, cK, ck0, cn0, cmode;
  CVT_JOB(u, csrc, cdst, cld, cK, ck0, cn0, cmode);
  const int lk = t >> 3, lc = (t & 7) * 8;
  f32x4 ra, rb; { const float* q = csrc + (size_t)(ck0 + lk) * cld + cn0 + lc; ra = *(const f32x4*)q; rb = *(const f32x4*)(q + 4); }
  for (; u < NJ; u += nb) {
    const int un = u + nb < NJ ? u + nb : u;
    const float* nsrc; bf16_t* ndst; int nld, nK, nk0, nn0, nmode;
    CVT_JOB(un, nsrc, ndst, nld, nK, nk0, nn0, nmode);
    f32x4 na, nbv; { const float* q = nsrc + (size_t)(nk0 + lk) * nld + nn0 + lc; na = *(const f32x4*)q; nbv = *(const f32x4*)(q + 4); }
    { LAS float* q = tile + lk * 65 + lc; q[0] = ra[0]; q[1] = ra[1]; q[2] = ra[2]; q[3] = ra[3]; q[4] = rb[0]; q[5] = rb[1]; q[6] = rb[2]; q[7] = rb[3]; }
    __syncthreads();
    { const int n = t >> 3, kc = (t & 7) * 8; const LAS float* q = tile + kc * 65 + n;
      u32x4 w; w.x = cvt_pk_bf16(q[0], q[65]); w.y = cvt_pk_bf16(q[130], q[195]); w.z = cvt_pk_bf16(q[260], q[325]); w.w = cvt_pk_bf16(q[390], q[455]);
      const int drow = cmode == 2 ? cn0 + n : 2 * (cn0 + n) + cmode;
      *(u32x4*)(cdst + (size_t)drow * cK + ck0 + kc) = w; }
    __syncthreads();
    csrc = nsrc; cdst = ndst; cld = nld; cK = nK; ck0 = nk0; cn0 = nn0; cmode = nmode; ra = na; rb = nbv;
  }
}
#undef CVT_JOB

__device__ __forceinline__ bf16_t* hb_ptr(const Params& p, int row, bool alt) {
  if (alt) return wsp<bf16_t>(p, WS_SCR + SM_END) + (size_t)row * D;
  return row < NLAT ? (bf16_t*)p.out + (size_t)row * D : wsp<bf16_t>(p, WS_HBC) + (size_t)(row - NLAT) * D;
}
__device__ __forceinline__ const float* h0_ptr(const Params& p, int row) { return row < NLAT ? p.x + (size_t)row * D : p.ctx + (size_t)(row - NLAT) * D; }
__device__ __forceinline__ void store_bf16x4(bf16_t* dst, f32x4 v) { u32x2 w; w.x = cvt_pk_bf16(v[0], v[1]); w.y = cvt_pk_bf16(v[2], v[3]); *(u32x2*)dst = w; }
__device__ __forceinline__ f32x4 load_bf16x4(const bf16_t* src) { const u32x2 w = *(const u32x2*)src; return (f32x4){bflo(w.x), bfhi(w.x), bflo(w.y), bfhi(w.y)}; }

__device__ __forceinline__ void phase_mod0(const Params& p) {
  const int lane = mk::otid() & 63, wid = mk::otid() >> 6;
  bf16_t* U = wsp<bf16_t>(p, WS_UO);
  for (int row = mk::obid() * 8 + wid; row < NTOK; row += gridDim.x * 8) {
    const float* h = h0_ptr(p, row); const float* modl = wsp<float>(p, WS_MOD) + (size_t)bidx_of_row(row) * 6144;
#pragma unroll
    for (int q = 0; q < 4; ++q) { const int col = q * 256 + lane * 4; const f32x4 hv = *(const f32x4*)(h + col), sh = *(const f32x4*)(modl + col), sc = *(const f32x4*)(modl + 1024 + col);
      store_bf16x4(U + (size_t)row * D + col, hv * (1.0f + sc) + sh); }
  }
}
__device__ __forceinline__ void ln_row(f32x4 (&v)[4], const float* __restrict__ g, const float* __restrict__ b, int lane) {
  float s = 0.f;
#pragma unroll
  for (int q = 0; q < 4; ++q) s += (v[q][0] + v[q][1]) + (v[q][2] + v[q][3]);
  const float mu = wave_sum_u(s) * (1.0f / D);
  float qq = 0.f;
#pragma unroll
  for (int q = 0; q < 4; ++q) { const f32x4 d = v[q] - mu; qq += (d[0] * d[0] + d[1] * d[1]) + (d[2] * d[2] + d[3] * d[3]); }
  const float rstd = rsqrtf(wave_sum_u(qq) * (1.0f / D) + LN_EPS);
#pragma unroll
  for (int q = 0; q < 4; ++q) { const int col = q * 256 + lane * 4; v[q] = (v[q] - mu) * rstd * *(const f32x4*)(g + col) + *(const f32x4*)(b + col); }
}
struct LnVec { f32x4 lg[4], lb[4], m0[4], m1[4], m2[4]; int bi; };
__device__ __forceinline__ void ln_row_c(f32x4 (&v)[4], const LnVec& c) {
  float s = 0.f;
#pragma unroll
  for (int q = 0; q < 4; ++q) s += (v[q][0] + v[q][1]) + (v[q][2] + v[q][3]);
  const float mu = wave_sum_u(s) * (1.0f / D);
  float qq = 0.f;
#pragma unroll
  for (int q = 0; q < 4; ++q) { const f32x4 d = v[q] - mu; qq += (d[0] * d[0] + d[1] * d[1]) + (d[2] * d[2] + d[3] * d[3]); }
  const float rstd = rsqrtf(wave_sum_u(qq) * (1.0f / D) + LN_EPS);
#pragma unroll
  for (int q = 0; q < 4; ++q) v[q] = (v[q] - mu) * rstd * c.lg[q] + c.lb[q];
}
template <bool F32IN> struct Ln1Raw;
template <> struct Ln1Raw<true> { f32x4 h[4]; u32x2 y[4]; };
template <> struct Ln1Raw<false> { u32x2 h[4]; u32x2 y[4]; };
__device__ __forceinline__ f32x4 h_as_f32(f32x4 v) { return v; }
__device__ __forceinline__ f32x4 h_as_f32(u32x2 w) { return (f32x4){bflo(w.x), bfhi(w.x), bflo(w.y), bfhi(w.y)}; }
template <bool F32IN>
__device__ __forceinline__ void ln1_load(const Params& p, const bf16_t* __restrict__ Ybuf, int row, int lane, Ln1Raw<F32IN>& r) {
#pragma unroll
  for (int q = 0; q < 4; ++q) { const int col = q * 256 + lane * 4;
    if constexpr (F32IN) r.h[q] = *(const f32x4*)(h0_ptr(p, row) + col); else r.h[q] = *(const u32x2*)(hb_ptr(p, row, false) + col);
    r.y[q] = *(const u32x2*)(Ybuf + (size_t)row * D + col); }
}
template <bool F32IN>
__device__ __forceinline__ void ln1_row(const Params& p, int l, int row, int lane, const Ln1Raw<F32IN>& raw, const LAS float* rwl, LAS int* lcnt, float rbias  , bool redir, const LnVec& cv  ) {
  bf16_t* U2 = wsp<bf16_t>(p, WS_UO); int* eid = wsp<int>(p, WS_EID); float* gatev = wsp<float>(p, WS_GATE);
  bf16_t* ho = redir ? wsp<bf16_t>(p, WS_SCR + SM_YS) + (size_t)row * D : hb_ptr(p, row, l == DEPTH - 1);
  f32x4 v[4];
#pragma unroll
  for (int q = 0; q < 4; ++q) { const int col = q * 256 + lane * 4; const f32x4 yv = (f32x4){bflo(raw.y[q].x), bfhi(raw.y[q].x), bflo(raw.y[q].y), bfhi(raw.y[q].y)};
    v[q] = ALPHA * h_as_f32(raw.h[q]) + cv.m0[q] * yv; (void)col; }
  ln_row_c(v, cv);
  float acc[16];
#pragma unroll
  for (int e = 0; e < 16; ++e) acc[e] = 0.f;
#pragma unroll
  for (int q = 0; q < 4; ++q) { const int col = q * 256 + lane * 4;
    store_bf16x4(ho + col, v[q]);
    const f32x4 u = v[q] * (1.0f + cv.m2[q]) + cv.m1[q];
    store_bf16x4(U2 + (size_t)row * D + col, u);
#pragma unroll
    for (int e = 0; e < 16; ++e) { const f32x4 w = *(const LAS f32x4*)(rwl + ((q * 16 + e) * 64 + lane) * 4); acc[e] += (u[0] * w[0] + u[1] * w[1]) + (u[2] * w[2] + u[3] * w[3]); }
  }
  float t8[8], t4[4], t2[2];
#pragma unroll
  for (int i = 0; i < 8; ++i) { const u32x2 sw = __builtin_amdgcn_permlane32_swap(__float_as_uint(acc[i]), __float_as_uint(acc[8 + i]), false, false); t8[i] = __uint_as_float(sw.x) + __uint_as_float(sw.y); }
#pragma unroll
  for (int i = 0; i < 4; ++i) { const u32x2 sw = __builtin_amdgcn_permlane16_swap(__float_as_uint(t8[i]), __float_as_uint(t8[4 + i]), false, false); t4[i] = __uint_as_float(sw.x) + __uint_as_float(sw.y); }
  const bool b3 = (lane & 8) != 0, b2_ = (lane & 4) != 0;
#pragma unroll
  for (int i = 0; i < 2; ++i) { const float keep = b3 ? t4[2 + i] : t4[i], send = b3 ? t4[i] : t4[2 + i]; t2[i] = keep + dpp_mov<0x128, 0xf, 0xf>(send, send); }
  float logit;
  { const float keep = b2_ ? t2[1] : t2[0], send = b2_ ? t2[0] : t2[1];
    float recv = dpp_mov<0x104, 0xf, 0x5>(send, send);
    recv = dpp_mov<0x114, 0xf, 0xa>(recv, send);
    logit = keep + recv; }
  logit += dpp_mov<0xB1, 0xf, 0xf>(logit, logit); logit += dpp_mov<0x4E, 0xf, 0xf>(logit, logit);
  const float sg = 1.0f / (1.0f + expf(-logit)), sl = sg + rbias;
  float gs;
  { const float a = sl, b2 = dpp_mov<0x124, 0xf, 0xf>(sl, sl), c = dpp_mov<0x128, 0xf, 0xf>(sl, sl), d = dpp_mov<0x12C, 0xf, 0xf>(sl, sl);
    const float lo1 = fminf(a, b2), hi1 = fmaxf(a, b2), lo2 = fminf(c, d), hi2 = fmaxf(c, d);
    gs = fmaxf(hi1, hi2) + fmaxf(fminf(hi1, hi2), fmaxf(lo1, lo2)); }
  float best = -1e30f; int grp = 0;
#pragma unroll
  for (int gI = 0; gI < 4; ++gI) { const float g = __uint_as_float(__builtin_amdgcn_readlane(__float_as_uint(gs), gI * 16)); if (g > best) { best = g; grp = gI; } }
  grp = __builtin_amdgcn_readfirstlane(grp);
  const float v0 = __uint_as_float(__builtin_amdgcn_readlane(__float_as_uint(sl), grp * 16)), v1 = __uint_as_float(__builtin_amdgcn_readlane(__float_as_uint(sl), grp * 16 + 4)),
              v2 = __uint_as_float(__builtin_amdgcn_readlane(__float_as_uint(sl), grp * 16 + 8)), v3 = __uint_as_float(__builtin_amdgcn_readlane(__float_as_uint(sl), grp * 16 + 12));
  const float s0 = __uint_as_float(__builtin_amdgcn_readlane(__float_as_uint(sg), grp * 16)), s1 = __uint_as_float(__builtin_amdgcn_readlane(__float_as_uint(sg), grp * 16 + 4)),
              s2 = __uint_as_float(__builtin_amdgcn_readlane(__float_as_uint(sg), grp * 16 + 8)), s3 = __uint_as_float(__builtin_amdgcn_readlane(__float_as_uint(sg), grp * 16 + 12));
  int i1 = 0; float b1 = v0; if (v1 > b1) { b1 = v1; i1 = 1; } if (v2 > b1) { b1 = v2; i1 = 2; } if (v3 > b1) { b1 = v3; i1 = 3; }
  int i2 = -1; float bb = -1e30f;
  if (i1 != 0 && v0 > bb) { bb = v0; i2 = 0; } if (i1 != 1 && v1 > bb) { bb = v1; i2 = 1; } if (i1 != 2 && v2 > bb) { bb = v2; i2 = 2; } if (i1 != 3 && v3 > bb) { bb = v3; i2 = 3; }
  const float g1 = i1 == 0 ? s0 : i1 == 1 ? s1 : i1 == 2 ? s2 : s3; const float g2 = i2 == 0 ? s0 : i2 == 1 ? s1 : i2 == 2 ? s2 : s3;
  if (lane == 0) { const int e1 = grp * 4 + i1, e2 = grp * 4 + i2;
    eid[row * 2] = e1; eid[row * 2 + 1] = e2; gatev[row * 2] = g1 / (g1 + g2); gatev[row * 2 + 1] = g2 / (g1 + g2);
    __hip_atomic_fetch_add(lcnt + e1, 1, __ATOMIC_RELAXED, __HIP_MEMORY_SCOPE_WORKGROUP); __hip_atomic_fetch_add(lcnt + e2, 1, __ATOMIC_RELAXED, __HIP_MEMORY_SCOPE_WORKGROUP); }
}
template <bool F32IN>
__device__ __forceinline__ void phase_ln1(const Params& p, int l, const bf16_t* __restrict__ Ybuf, LAS unsigned char* lds, bool dry) {
  const int tid = mk::otid(), lane = tid & 63, wid = tid >> 6, bid = mk::obid();
  const bool last = l == DEPTH - 1; const int ntok = last ? NLAT : NTOK;
  LAS float* rwl = (LAS float*)lds; LAS int* lcnt = (LAS int*)(lds + 65536);
  { float rv[32];
#pragma unroll
    for (int i = 0; i < 32; ++i) rv[i] = p.router_w[tid + i * NTHR];
#pragma unroll
    for (int i = 0; i < 32; ++i) { const int idx = tid + i * NTHR, d = idx >> 4, e = idx & 15; rwl[(((d >> 8) * 16 + e) * 64 + ((d >> 2) & 63)) * 4 + (d & 3)] = rv[i]; } }
  if (tid < 16) lcnt[tid] = 0;
  __syncthreads();
  const int stride = gridDim.x * 8, row0 = bid * 8 + wid;
  const float rbias = p.router_b[lane >> 2];
  if (row0 < ntok) {
    LnVec cv; cv.bi = -1;
    { const float* lg = p.ln_g + (size_t)(l * 2) * D; const float* lb = p.ln_b + (size_t)(l * 2) * D;
#pragma unroll
      for (int q = 0; q < 4; ++q) { const int col = q * 256 + lane * 4; cv.lg[q] = *(const f32x4*)(lg + col); cv.lb[q] = *(const f32x4*)(lb + col); } }
    Ln1Raw<F32IN> cur, nxt; ln1_load<F32IN>(p, Ybuf, row0, lane, cur);
    for (int row = row0; row < ntok; row += stride) {
      { const int bi = bidx_of_row(row);
        if (bi != cv.bi) { cv.bi = bi; const float* modl = wsp<float>(p, WS_MOD) + ((size_t)l * 5 + bi) * 6144;
#pragma unroll
          for (int q = 0; q < 4; ++q) { const int col = q * 256 + lane * 4; cv.m0[q] = *(const f32x4*)(modl + 2 * 1024 + col); cv.m1[q] = *(const f32x4*)(modl + 3 * 1024 + col); cv.m2[q] = *(const f32x4*)(modl + 4 * 1024 + col); } } }
      const int rn = row + stride < ntok ? row + stride : row;
      ln1_load<F32IN>(p, Ybuf, rn, lane, nxt);
      ln1_row<F32IN>(p, l, row, lane, cur, rwl, lcnt, rbias, dry, cv);
      cur = nxt;
    }
  }
  __syncthreads();
  if (tid < 16) wsp<int>(p, WS_BCNT)[((size_t)l * 256 + bid) * 64 + tid] = lcnt[tid];
  __syncthreads();
}
__device__ __forceinline__ void phase_scatter(const Params& p, int l, LAS unsigned char* lds) {
  const int tid = mk::otid(), bid = mk::obid(), nb = gridDim.x;
  const bool last = l == DEPTH - 1; const int ntok = last ? NLAT : NTOK;
  LAS int* tot = (LAS int*)lds; LAS int* pre = tot + 16; LAS int* base = tot + 32; LAS int* lcur = tot + 48; LAS int* offs = tot + 64; LAS int* cnts = tot + 128;
  const int* bc = wsp<int>(p, WS_BCNT) + (size_t)l * 256 * 64;
  for (int b2 = tid; b2 < nb; b2 += NTHR) { const u32x4 c0 = *(const u32x4*)(bc + b2 * 64), c1 = *(const u32x4*)(bc + b2 * 64 + 4), c2 = *(const u32x4*)(bc + b2 * 64 + 8), c3 = *(const u32x4*)(bc + b2 * 64 + 12);
    *(LAS u32x4*)(cnts + b2 * 16) = c0; *(LAS u32x4*)(cnts + b2 * 16 + 4) = c1; *(LAS u32x4*)(cnts + b2 * 16 + 8) = c2; *(LAS u32x4*)(cnts + b2 * 16 + 12) = c3; }
  __syncthreads();
  if (tid < 16) { int t = 0, pr = 0; for (int b2 = 0; b2 < nb; ++b2) { const int v = cnts[b2 * 16 + tid]; pr += b2 < bid ? v : 0; t += v; } tot[tid] = t; pre[tid] = pr; lcur[tid] = 0; }
  __syncthreads();
  if (tid == 0) { int o = 0; int* mo = wsp<int>(p, WS_MOFF) + l * 64; for (int e = 0; e < 16; ++e) { offs[e] = o; base[e] = o + pre[e]; if (bid == 0) mo[e] = o; o += (tot[e] + 255) / 256 * 256; } offs[16] = o; if (bid == 0) mo[16] = o; }
  __syncthreads();
  const int* eid = wsp<int>(p, WS_EID); int* pos = wsp<int>(p, WS_POS); int* rl = wsp<int>(p, WS_RL);
  for (int n = tid; ; n += NTHR) { const int row = bid * 8 + (n & 7) + (n >> 3) * nb * 8; if (row >= ntok) break;
    const int e1 = eid[row * 2], e2 = eid[row * 2 + 1];
    const int p1 = base[e1] + __hip_atomic_fetch_add(lcur + e1, 1, __ATOMIC_RELAXED, __HIP_MEMORY_SCOPE_WORKGROUP), p2 = base[e2] + __hip_atomic_fetch_add(lcur + e2, 1, __ATOMIC_RELAXED, __HIP_MEMORY_SCOPE_WORKGROUP);
    pos[row * 2] = p1; pos[row * 2 + 1] = p2; rl[p1] = row; rl[p2] = row; }
  if (bid == 0) for (int e = 0; e < 16; ++e) for (int q = offs[e] + tot[e] + tid; q < offs[e + 1]; q += NTHR) rl[q] = 0;
}
struct Ln2Raw { u32x4 h[2], y1[2], y2[2]; };
__device__ __forceinline__ void ln2_load(const Params& p, bool last, int row, int lane, int p1, int p2, Ln2Raw& r) {
  const bf16_t* Ys = wsp<bf16_t>(p, WS_SCR + SM_YS); const bf16_t* ho = hb_ptr(p, row, last);
#pragma unroll
  for (int q = 0; q < 2; ++q) { const int col = q * 512 + lane * 8; r.h[q] = *(const u32x4*)(ho + col); r.y1[q] = *(const u32x4*)(Ys + (size_t)p1 * D + col); r.y2[q] = *(const u32x4*)(Ys + (size_t)p2 * D + col); }
}
__device__ __forceinline__ void unpack8(const u32x4 w, float (&o)[8]) { o[0] = bflo(w.x); o[1] = bfhi(w.x); o[2] = bflo(w.y); o[3] = bfhi(w.y); o[4] = bflo(w.z); o[5] = bfhi(w.z); o[6] = bflo(w.w); o[7] = bfhi(w.w); }
__device__ __forceinline__ void load8f(const float* q, float (&o)[8]) { const f32x4 a = *(const f32x4*)q, b = *(const f32x4*)(q + 4); o[0] = a[0]; o[1] = a[1]; o[2] = a[2]; o[3] = a[3]; o[4] = b[0]; o[5] = b[1]; o[6] = b[2]; o[7] = b[3]; }
__device__ __forceinline__ u32x4 pack8(const float (&v)[8]) { u32x4 w; w.x = cvt_pk_bf16(v[0], v[1]); w.y = cvt_pk_bf16(v[2], v[3]); w.z = cvt_pk_bf16(v[4], v[5]); w.w = cvt_pk_bf16(v[6], v[7]); return w; }
__device__ __forceinline__ void phase_ln2(const Params& p, int l, bool dry) {
  const int tid = mk::otid(), lane = tid & 63, wid = tid >> 6;
  const bool last = l == DEPTH - 1; const int ntok = last ? NLAT : NTOK;
  const int* pos = wsp<int>(p, WS_POS); const float* gatev = wsp<float>(p, WS_GATE); bf16_t* U = wsp<bf16_t>(p, WS_UO);
  const float* lg = p.ln_g + (size_t)(l * 2 + 1) * D; const float* lb = p.ln_b + (size_t)(l * 2 + 1) * D;
  const int stride = gridDim.x * 8, row0 = mk::obid() * 8 + wid;
  if (row0 >= ntok) return;
  auto clampr = [&](int r) { return r < ntok ? r : row0; };
  float cg[2][8], cb[2][8], cg2[2][8], csc[2][8], csh[2][8]; int cbi = -1;
#pragma unroll
  for (int q = 0; q < 2; ++q) { const int col = q * 512 + lane * 8; load8f(lg + col, cg[q]); load8f(lb + col, cb[q]); }
  u32x2 pc = *(const u32x2*)(pos + 2 * row0); f32x2 gc = *(const f32x2*)(gatev + 2 * row0);
  Ln2Raw cur, nxt; ln2_load(p, last, row0, lane, (int)pc.x, (int)pc.y, cur);
  int r1 = clampr(row0 + stride);
  u32x2 pn = *(const u32x2*)(pos + 2 * r1); f32x2 gn = *(const f32x2*)(gatev + 2 * r1);
  for (int row = row0; row < ntok; row += stride) {
    ln2_load(p, last, r1, lane, (int)pn.x, (int)pn.y, nxt);
    const int r2 = clampr(row + 2 * stride);
    const u32x2 pn2 = *(const u32x2*)(pos + 2 * r2); const f32x2 gn2 = *(const f32x2*)(gatev + 2 * r2);
    bf16_t* hb = dry ? wsp<bf16_t>(p, WS_SCR + SM_XS) + (size_t)row * D : hb_ptr(p, row, false); float* hf = (dry ? wsp<float>(p, WS_SCR + SM_XS) : p.out) + (size_t)row * D; const int bi = bidx_of_row(row);
    if (bi != cbi) { cbi = bi; const float* modl = wsp<float>(p, WS_MOD) + ((size_t)l * 5 + bi) * 6144; const float* modn = wsp<float>(p, WS_MOD) + ((size_t)(last ? l : l + 1) * 5 + bi) * 6144;
#pragma unroll
      for (int q = 0; q < 2; ++q) { const int col = q * 512 + lane * 8; load8f(modl + 5 * 1024 + col, cg2[q]); load8f(modn + 1024 + col, csc[q]); load8f(modn + col, csh[q]); } }
    float v[2][8]; float s1 = 0.f;
#pragma unroll
    for (int q = 0; q < 2; ++q) { float hh[8], a1[8], a2[8];
      unpack8(cur.h[q], hh); unpack8(cur.y1[q], a1); unpack8(cur.y2[q], a2);
#pragma unroll
      for (int e = 0; e < 8; ++e) { v[q][e] = ALPHA * hh[e] + cg2[q][e] * (gc[0] * a1[e] + gc[1] * a2[e]); s1 += v[q][e]; } }
    const float mu = wave_sum_u(s1) * (1.0f / D);
    float s2 = 0.f;
#pragma unroll
    for (int q = 0; q < 2; ++q)
#pragma unroll
      for (int e = 0; e < 8; ++e) { const float d = v[q][e] - mu; s2 += d * d; }
    const float rstd = rsqrtf(wave_sum_u(s2) * (1.0f / D) + LN_EPS);
#pragma unroll
    for (int q = 0; q < 2; ++q) { const int col = q * 512 + lane * 8;
#pragma unroll
      for (int e = 0; e < 8; ++e) v[q][e] = (v[q][e] - mu) * rstd * cg[q][e] + cb[q][e];
      if (last) { *(f32x4*)(hf + col) = (f32x4){v[q][0], v[q][1], v[q][2], v[q][3]}; *(f32x4*)(hf + col + 4) = (f32x4){v[q][4], v[q][5], v[q][6], v[q][7]}; }
      else { *(u32x4*)(hb + col) = pack8(v[q]); float u[8];
#pragma unroll
        for (int e = 0; e < 8; ++e) u[e] = v[q][e] * (1.0f + csc[q][e]) + csh[q][e];
        *(u32x4*)(U + (size_t)row * D + col) = pack8(u); } }
    cur = nxt; gc = gn; pn = pn2; gn = gn2; r1 = r2;
  }
}

struct SchedEvenIn { static constexpr bool GATHER = false; const bf16_t* U; const bf16_t* W; bf16_t* Pqk; bf16_t* Prw; bf16_t* Vt; int G, c;
  __device__ __forceinline__ bool next(int i, pg8::Unit& u) const { const int Lx = i * G + c; u.kind = 0;
    if (Lx < 1452) { const int grp = Lx / 44, rem = Lx % 44, pm = grp * 4 + (rem & 3), pi = rem >> 2; u.pm = pm; u.pn = pi;
      u.A = (const char*)(U + (size_t)pm * 256 * D); const int brow = pi < 4 ? pi * 256 : 1536 + (pi - 4) * 256; u.Bt = (const char*)(W + (size_t)brow * D);
      if (pi < 4) { u.out = Pqk; u.ldo = 1024; u.x1 = pi * 256; } else { u.out = Prw; u.ldo = RW_IN; u.x1 = (pi - 4) * 256; } u.x0 = pm * 256; return true; }
    if (Lx < 1452 + 264) { const int v = Lx - 1452, pmv = v & 1, pnv = v >> 1; u.pm = pmv; u.pn = pnv; u.A = (const char*)(W + (size_t)(1024 + pmv * 256) * D); u.Bt = (const char*)(U + (size_t)pnv * 256 * D);
      u.out = Vt; u.ldo = NTOK; u.x0 = pmv * 256; u.x1 = pnv * 256; return true; }
    return false; } };
struct SchedOddIn { static constexpr bool GATHER = false; const bf16_t* U; const bf16_t* W; bf16_t* Pqk; bf16_t* Vt; int G, c;
  __device__ __forceinline__ bool next(int i, pg8::Unit& u) const { const int Lx = i * G + c;
    if (Lx < 1056) { const int grp = Lx / 32, rem = Lx % 32, pm = grp * 4 + (rem & 3), pi = rem >> 2; u.pm = pm; u.pn = pi; u.kind = pm < 128 ? 1 : 0;
      u.A = (const char*)(U + (size_t)pm * 256 * D); u.Bt = (const char*)(W + (size_t)pi * 256 * D); u.out = Pqk; u.ldo = 2048; u.x0 = pm * 256; u.x1 = pi * 256; return true; }
    if (Lx < 1056 + 528) { const int v = Lx - 1056, pmv = v & 3, pnv = v >> 2; u.pm = pmv; u.pn = pnv; u.kind = 0; u.A = (const char*)(W + (size_t)(2048 + pmv * 256) * D); u.Bt = (const char*)(U + (size_t)pnv * 256 * D);
      u.out = Vt; u.ldo = NTOK; u.x0 = pmv * 256; u.x1 = pnv * 256; return true; }
    return false; } };
struct SchedOut { static constexpr bool GATHER = false; const bf16_t* O; const bf16_t* W; bf16_t* Y; int G, c;
  __device__ __forceinline__ bool next(int i, pg8::Unit& u) const { const int Lx = i * G + c; if (Lx >= 528) return false; const int pm = (Lx / 16) * 4 + (Lx & 3), pn = (Lx & 15) >> 2; u.pm = pm; u.pn = pn; u.kind = 0;
    u.A = (const char*)(O + (size_t)pm * 256 * D); u.Bt = (const char*)(W + (size_t)pn * 256 * D); u.out = Y; u.ldo = 1024; u.x0 = pm * 256; u.x1 = pn * 256; return true; } };
template <bool GATH>
struct SchedMoe { static constexpr bool GATHER = GATH; const bf16_t* A; const bf16_t* W; bf16_t* out; const LAS int* moff; const int* rl; int Kd, ldo, ncol, G, c;
  __device__ __forceinline__ bool next(int i, pg8::Unit& u) const { const int Lx = i * G + c; const int ntile = moff[16] >> 8; if (Lx >= ntile * 4) return false;
    const int pm = Lx >> 2, pn = Lx & 3; int e = 0;
#pragma unroll
    for (int j = 1; j < 16; ++j) e += (pm * 256 >= moff[j]) ? 1 : 0;
    u.pm = pm; u.pn = pn; u.kind = 0; u.A = GATH ? (const char*)A : (const char*)(A + (size_t)pm * 256 * Kd); u.rl = rl + pm * 256; u.Bt = (const char*)(W + ((size_t)e * 1024 + pn * 256) * Kd); u.out = out; u.ldo = ldo; u.x0 = pm * 256; u.x1 = pn * ncol; return true; } };

struct EpiOddIn {
  static constexpr bool PERM = true; const float* rope;
  __device__ __forceinline__ void operator()(const f32x4 (&acc)[2][2][4][2], const pg8::Unit& u, int wr, int wc, int fr, int fq) const {
    if (u.kind == 0) { pg8::EpiStoreBf16{}(acc, u, wr, wc, fr, fq); return; }
    const int row0 = u.x0 + wr * 64 + fr, col0 = u.x1 + wc * 32 + 8 * fq; const int half = wc & 1;
#pragma unroll
    for (int ai = 0; ai < 2; ++ai)
#pragma unroll
      for (int m = 0; m < 4; ++m) { const int row = row0 + ai * 128 + m * 16; const int t = row & (T - 1); const int pos = half ? (t & 63) : (t >> 6);
        const f32x4 cs0 = *(const f32x4*)(rope + (pos * 16 + 4 * fq) * 2), cs1 = *(const f32x4*)(rope + (pos * 16 + 4 * fq + 2) * 2);
        bf16_t* rowp = u.out + (size_t)row * u.ldo + col0;
#pragma unroll
        for (int bj = 0; bj < 2; ++bj) { const f32x4 v0 = acc[ai][bj][m][0], v1 = acc[ai][bj][m][1];
          u32x4 w; w.x = cvt_pk_bf16(v0[0] * cs0[0] - v0[1] * cs0[1], v0[0] * cs0[1] + v0[1] * cs0[0]); w.y = cvt_pk_bf16(v0[2] * cs0[2] - v0[3] * cs0[3], v0[2] * cs0[3] + v0[3] * cs0[2]);
          w.z = cvt_pk_bf16(v1[0] * cs1[0] - v1[1] * cs1[1], v1[0] * cs1[1] + v1[1] * cs1[0]); w.w = cvt_pk_bf16(v1[2] * cs1[2] - v1[3] * cs1[3], v1[2] * cs1[3] + v1[3] * cs1[2]);
          *(u32x4*)(rowp + bj * 128) = w; } }
  }
};
struct EpiGateUp {
  static constexpr bool PERM = true;
  __device__ __forceinline__ void operator()(const f32x4 (&acc)[2][2][4][2], const pg8::Unit& u, int wr, int wc, int fr, int fq) const {
    const int row0 = u.x0 + wr * 64 + fr, col0 = u.x1 + wc * 16 + 4 * fq;
#pragma unroll
    for (int ai = 0; ai < 2; ++ai)
#pragma unroll
      for (int m = 0; m < 4; ++m) { bf16_t* rowp = u.out + (size_t)(row0 + ai * 128 + m * 16) * u.ldo + col0;
#pragma unroll
        for (int bj = 0; bj < 2; ++bj) { const f32x4 v0 = acc[ai][bj][m][0], v1 = acc[ai][bj][m][1];
          u32x2 w; w.x = cvt_pk_bf16(silu_r(v0[0]) * v0[1], silu_r(v0[2]) * v0[3]); w.y = cvt_pk_bf16(silu_r(v1[0]) * v1[1], silu_r(v1[2]) * v1[3]);
          *(u32x2*)(rowp + bj * 64) = w; } }
  }
};
}

namespace mk {
constexpr int N_PHASES = 2 + 2 * (12 + 10);
__global__ void __launch_bounds__(NTHR, 2) mega(Params p_) {
  const Params& p = p_;
  extern __shared__ __attribute__((aligned(16))) unsigned char shm[];
  LAS unsigned char* lds = (LAS unsigned char*)shm;
  const int nb = gridDim.x;
  if (threadIdx.x == 0) *(LAS u32x4*)(lds + LDS_BARW) = (u32x4){0u, 0u, 0u, 0u};
  __syncthreads();
  XcdBarrier bar = xcd_barrier_post(wsp<unsigned>(p, WS_BAR), (volatile LAS unsigned*)(lds + LDS_BARW));
  int ph = 0;
#ifndef MK_MASK
#define MK_MASK 0xFFFFFFFFu
#endif
#ifndef MK_REP
#define MK_REP 0u
#endif
#define PHASE_BEGIN_K(k) if (((MK_MASK) >> (k)) & 1u) { Params pl_ = p_; asm volatile("" : "+s"(pl_.ws)); const Params& p = pl_; bf16_t* UO = wsp<bf16_t>(p, WS_UO); unsigned char* scr = p.ws + WS_SCR; (void)UO; (void)scr; \
    const int bid = mk::obid(); const int nrep_ = ((((MK_REP) >> (k)) & 1u) ? 2 : 1); for (int rep_ = 0; rep_ < nrep_; ++rep_) { const bool dry = rep_ + 1 < nrep_; (void)dry;
#define PHASE_END   } if (ph + 1 < N_PHASES) { XcdBarrier b_ = bar; asm volatile("" : "+s"(b_.bar), "+s"(b_.x)); xcd_barrier(b_); } } ++ph;
  bf16_t* UO = wsp<bf16_t>(p, WS_UO);
  unsigned char* scr = p.ws + WS_SCR;
  PHASE_BEGIN_K(0) phase_prologue(p, lds); PHASE_END
  PHASE_BEGIN_K(1) phase_mod0(p); PHASE_END
  for (int lp = 0; lp < 2; ++lp) {
    {
      const int l = 2 * lp;
      bf16_t* Pqk = (bf16_t*)(scr + SE_PQK); bf16_t* Vt = (bf16_t*)(scr + SE_VT); bf16_t* Prw = (bf16_t*)(scr + SE_PRW); bf16_t* Ybuf = (bf16_t*)(scr + SE_YBUF);
      rw::Bufs bf; bf.SH = (u32x2*)(scr + SE_SH); bf.DR = (unsigned*)(scr + SE_DR); bf.G = UO + 512; bf.gstride = 1024; bf.CS = (float*)(scr + SE_CS) + (size_t)lp * NTOK * 16; bf.PQ = (float*)(scr + SE_PQ); bf.SST = (float*)(scr + SE_SST); bf.Y = (bf16_t*)(scr + SE_Y); bf.Z = (bf16_t*)(scr + SE_Z);
      PHASE_BEGIN_K(2) { SchedEvenIn S{UO, wsp<bf16_t>(p, WS_WEIN) + (size_t)lp * EVEN_IN * D, Pqk, Prw, Vt, nb, bid}; pg8::gemm_phase(lds, D, S, pg8::EpiStoreBf16{}); } PHASE_END
      PHASE_BEGIN_K(3) {
#ifdef MK_P3
        if (!(dry && MK_P3 == 2))
#endif
        for (int u = bid; u < 1024 + 32; u += nb) { int b, h, rq; if (u < 1024) { b = u >> 8; h = (u >> 5) & 7; rq = u & 31; } else { const int v = u - 1024; b = v >> 3; h = v & 7; rq = -1; }
          natt::na_attn_unit(Pqk, Vt, p.na_rpb + ((size_t)lp * 8 + h) * 465, UO, b, h, rq, lds); }
        const int pb = (bid + nb / 2) % nb;
#ifdef MK_P3
        if (!(dry && MK_P3 == 1))
#endif
        for (int t = pb; t < NTOK / 16; t += nb) rw::prep_tile(Prw, p.shift_w + (size_t)lp * 3 * RW_IN, p.rw_w0 + lp * 1024, wsp<bf16_t>(p, WS_WLT) + (size_t)lp * 196608, p.rw_a0 + lp * 1024, p.rw_k_k + lp * 512, p.rw_k_a + lp * 512, p.rw_r_k + lp * 512, bf, t, (LAS float*)lds); } PHASE_END
      PHASE_BEGIN_K(4) for (int u = bid * 8 + (mk::otid() >> 6); u < rw::NCHAIN * rw::NCH; u += nb * 8) rw::scan_unit(bf, p.rw_k_a + lp * 512, u / rw::NCH, u % rw::NCH, (LAS float*)lds + (mk::otid() >> 6) * 4096); PHASE_END
      PHASE_BEGIN_K(5) for (int c = bid; c < rw::NCHAIN * 4; c += nb) rw::propagate_chain(bf, c >> 2, c & 3, (LAS float*)lds); PHASE_END
      PHASE_BEGIN_K(6) for (int u = bid * 8 + (mk::otid() >> 6); u < rw::NCHAIN * (rw::NCH - 1); u += nb * 8) rw::corr_unit(bf, u / (rw::NCH - 1), 1 + u % (rw::NCH - 1)); PHASE_END
      PHASE_BEGIN_K(7) rw::finish_phase<8>(bf, p.rw_gn_g + lp * 512, p.rw_gn_b + lp * 512, UO); PHASE_END
      PHASE_BEGIN_K(8) { SchedOut S{UO, wsp<bf16_t>(p, WS_WEOUT) + (size_t)lp * D * D, Ybuf, nb, bid}; pg8::gemm_phase(lds, D, S, pg8::EpiStoreBf16{}); __syncthreads(); cvt_experts(p, l, (LAS float*)lds, 528 - 2 * nb > 0 ? 528 - 2 * nb : 0); } PHASE_END
      PHASE_BEGIN_K(9) if (l == 0) phase_ln1<true>(p, l, Ybuf, lds, dry); else phase_ln1<false>(p, l, Ybuf, lds, dry); PHASE_END
      PHASE_BEGIN_K(10) phase_scatter(p, l, lds); PHASE_END
      PHASE_BEGIN_K(11) { LAS int* mo = (LAS int*)(lds + LDS_MISC); { const int tq = mk::otid(); if (tq < 17) mo[tq] = wsp<int>(p, WS_MOFF)[l * 64 + tq]; } __syncthreads();
        SchedMoe<true> S{UO, wsp<bf16_t>(p, WS_WGU), (bf16_t*)(scr + SM_HE), mo, wsp<int>(p, WS_RL), D, DE, 128, nb, bid}; pg8::gemm_phase(lds, D, S, EpiGateUp{}); } PHASE_END
      PHASE_BEGIN_K(12) { LAS int* mo = (LAS int*)(lds + LDS_MISC); { const int tq = mk::otid(); if (tq < 17) mo[tq] = wsp<int>(p, WS_MOFF)[l * 64 + tq]; } __syncthreads();
        SchedMoe<false> S{(bf16_t*)(scr + SM_HE), wsp<bf16_t>(p, WS_WDN), (bf16_t*)(scr + SM_YS), mo, nullptr, DE, D, 256, nb, bid}; pg8::gemm_phase(lds, DE, S, pg8::EpiStoreBf16{}); } PHASE_END
      PHASE_BEGIN_K(13) phase_ln2(p, l, dry); PHASE_END
    }
    {
      const int l = 2 * lp + 1; const bool last = l == DEPTH - 1;
      bf16_t* Pqk = (bf16_t*)(scr + SO_PQK); bf16_t* Vt = (bf16_t*)(scr + SO_VT); bf16_t* O12 = (bf16_t*)(scr + SO_O12); bf16_t* Ybuf = (bf16_t*)(scr + SO_YBUF);
      PHASE_BEGIN_K(14) { SchedOddIn S{UO, wsp<bf16_t>(p, WS_WOIN) + (size_t)lp * ODD_IN * D, Pqk, Vt, nb, bid}; pg8::gemm_phase(lds, D, S, EpiOddIn{wsp<float>(p, WS_ROPE)}); } PHASE_END
      float* KN = wsp<float>(p, WS_KN) + (size_t)lp * 256 * 32;
      PHASE_BEGIN_K(23) for (int g = bid; g < 256; g += nb) att::knorm_group(Pqk, KN, g, (LAS float*)lds); PHASE_END
      PHASE_BEGIN_K(15) for (int ui = bid; ui < 2048 + (last ? 0 : 64); ui += nb) { int b, hh, q0, nlat; const int u = (nb == 256 && ui < 2048) ? ((((ui >> 8) * 8 + (bid & 7)) << 5) | (bid >> 3)) : ui;
        if (u < 2048) { b = u >> 9; hh = (u >> 5) & 15; q0 = b * T + (u & 31) * 256; nlat = T; } else { const int v = u - 2048; b = v >> 4; hh = v & 15; q0 = NLAT + b * L; nlat = 0; }
        const bool st = __builtin_amdgcn_sqrtf(att::nmax2_of(KN, b, hh, 0) * att::nmax2_of(KN, b, hh, 1)) * 1.001f <= 60.0f;
#ifdef MK_ABL
        if (dry) att::diff_attn_unit<true, MK_ABL>(Pqk, Vt, O12, hh, q0, b * T, nlat, NLAT + b * L, lds); else
#endif
        if (st) att::diff_attn_unit<true>(Pqk, Vt, O12, hh, q0, b * T, nlat, NLAT + b * L, lds); else att::diff_attn_unit<false>(Pqk, Vt, O12, hh, q0, b * T, nlat, NLAT + b * L, lds); } PHASE_END
      PHASE_BEGIN_K(16) { float d1 = 0.f, d2 = 0.f; for (int i = 0; i < 64; ++i) { d1 += p.da_lq1[lp * 64 + i] * p.da_lk1[lp * 64 + i]; d2 += p.da_lq2[lp * 64 + i] * p.da_lk2[lp * 64 + i]; }
        const float li = 0.8f - 0.6f * expf(-0.3f * (float)l), lam = expf(d1) - expf(d2) + li;
        const int tq = mk::otid(); for (int r4 = bid; r4 < (last ? NLAT : NTOK) / 4; r4 += nb) att::diff_combine_rows4(O12, p.da_subln_g + lp * 128, lam, 1.0f - li, UO, r4 * 4, tq >> 6, tq & 63); } PHASE_END
      PHASE_BEGIN_K(17) { SchedOut S{UO, wsp<bf16_t>(p, WS_WOOUT) + (size_t)lp * D * D, Ybuf, nb, bid}; pg8::gemm_phase(lds, D, S, pg8::EpiStoreBf16{}); __syncthreads(); cvt_experts(p, l, (LAS float*)lds, 528 - 2 * nb > 0 ? 528 - 2 * nb : 0); } PHASE_END
      PHASE_BEGIN_K(18) phase_ln1<false>(p, l, Ybuf, lds, dry); PHASE_END
      PHASE_BEGIN_K(19) phase_scatter(p, l, lds); PHASE_END
      PHASE_BEGIN_K(20) { LAS int* mo = (LAS int*)(lds + LDS_MISC); { const int tq = mk::otid(); if (tq < 17) mo[tq] = wsp<int>(p, WS_MOFF)[l * 64 + tq]; } __syncthreads();
        SchedMoe<true> S{UO, wsp<bf16_t>(p, WS_WGU), (bf16_t*)(scr + SM_HE), mo, wsp<int>(p, WS_RL), D, DE, 128, nb, bid}; pg8::gemm_phase(lds, D, S, EpiGateUp{}); } PHASE_END
      PHASE_BEGIN_K(21) { LAS int* mo = (LAS int*)(lds + LDS_MISC); { const int tq = mk::otid(); if (tq < 17) mo[tq] = wsp<int>(p, WS_MOFF)[l * 64 + tq]; } __syncthreads();
        SchedMoe<false> S{(bf16_t*)(scr + SM_HE), wsp<bf16_t>(p, WS_WDN), (bf16_t*)(scr + SM_YS), mo, nullptr, DE, D, 256, nb, bid}; pg8::gemm_phase(lds, DE, S, pg8::EpiStoreBf16{}); } PHASE_END
      PHASE_BEGIN_K(22) phase_ln2(p, l, dry); PHASE_END
    }
  }
#undef PHASE_BEGIN_K
#undef PHASE_END
}
}

#ifndef MK_SINGLE_LAUNCH
#define MK_SINGLE_LAUNCH 1
#endif
extern "C" void kernel_launch(void* const* d_in, const int* in_sizes, int n_in, void* d_out, int out_size, void* d_ws, size_t ws_size, hipStream_t stream) {
  using namespace mk;
  static int grid = 0;
  if (grid == 0) {
    if (n_in != 34 || out_size != NLAT * D || ws_size < WS_END) { fprintf(stderr, "kernel_launch: unexpected shapes (n_in %d out %d ws %zu need %zu)\n", n_in, out_size, ws_size, (size_t)WS_END); grid = -1; return; }
    if (hipFuncSetAttribute((const void*)mega, hipFuncAttributeMaxDynamicSharedMemorySize, LDS_BYTES) != hipSuccess) { grid = -1; return; }
    int dev = 0, cus = 0, per_cu = 0;
    if (hipGetDevice(&dev) != hipSuccess || hipDeviceGetAttribute(&cus, hipDeviceAttributeMultiprocessorCount, dev) != hipSuccess) { grid = -1; return; }
    if (hipOccupancyMaxActiveBlocksPerMultiprocessor(&per_cu, (const void*)mega, NTHR, LDS_BYTES) != hipSuccess || per_cu < 1) { fprintf(stderr, "kernel_launch: occupancy query says %d\n", per_cu); }
    (void)hipGetLastError();
    grid = cus;
  }
  if (grid < 0) return;
  (void)hipMemsetAsync((char*)d_ws + WS_BAR, 0, (size_t)XCD_BAR_WORDS * 4, stream);
  Params p{};
  const float** pp = (const float**)&p;
  for (int i = 0; i < 34; ++i) pp[i] = (const float*)d_in[i];
  p.out = (float*)d_out; p.ws = (unsigned char*)d_ws;
#if MK_SINGLE_LAUNCH
  p.ph_lo = 0; p.ph_hi = N_PHASES;
  hipLaunchKernelGGL(mega, dim3(grid), dim3(NTHR), LDS_BYTES, stream, p);
#else
  for (int ph = 0; ph < N_PHASES; ++ph) { p.ph_lo = ph; p.ph_hi = ph + 1; hipLaunchKernelGGL(mega, dim3(grid), dim3(NTHR), LDS_BYTES, stream, p); }
#endif
}
```

```cpp
#include <hip/hip_runtime.h>
#include <stdint.h>
#include <stdio.h>

typedef unsigned short bf16_t;
typedef short bf16x8 __attribute__((ext_vector_type(8)));
typedef float f32x4 __attribute__((ext_vector_type(4)));
typedef float f32x2 __attribute__((ext_vector_type(2)));
typedef float f32x16 __attribute__((ext_vector_type(16)));
typedef unsigned u32x4 __attribute__((ext_vector_type(4)));
typedef unsigned u32x2 __attribute__((ext_vector_type(2)));
#define LAS __attribute__((address_space(3)))

namespace mk {
constexpr int B = 4, T = 8192, L = 256, D = 1024, NLAT = B * T, NCTX = B * L, NTOK = NLAT + NCTX;
constexpr int DEPTH = 4, EVEN_IN = 3328, ODD_IN = 3072, RW_OFF = 1536, RW_IN = 1792, NE = 16, DE = 512;
constexpr float ALPHA = 1.681792830507429f, LN_EPS = 1e-5f;
constexpr int NTHR = 512, LDS_BYTES = 147456;
constexpr int MOE_TILES = 280, MOE_ROWS = MOE_TILES * 256;

typedef __bf16 bf16x2v __attribute__((ext_vector_type(2)));
__device__ __forceinline__ unsigned cvt_pk_bf16(float lo, float hi) { const f32x2 v = {lo, hi}; return __builtin_bit_cast(unsigned, __builtin_convertvector(v, bf16x2v)); }
__device__ __forceinline__ unsigned cvt_pk_bf16_v(float lo, float hi) { return cvt_pk_bf16(lo, hi); }
template <int V> struct IntC { static constexpr int value = V; };
__device__ __forceinline__ float bf2f(bf16_t b) { return __uint_as_float(((unsigned)b) << 16); }
__device__ __forceinline__ float bflo(unsigned w) { return __uint_as_float(w << 16); }
__device__ __forceinline__ float bfhi(unsigned w) { return __uint_as_float(w & 0xffff0000u); }
__device__ __forceinline__ bf16_t f2bf(float f) { return (bf16_t)(cvt_pk_bf16(f, 0.f) & 0xffffu); }
__device__ __forceinline__ float sigmoidf_(float x) { return 1.0f / (1.0f + __expf(-x)); }
__device__ __forceinline__ float siluf_(float x) { return x / (1.0f + __expf(-x)); }
__device__ __forceinline__ float sigmoid_r(float x) { return __builtin_amdgcn_rcpf(1.0f + __expf(-x)); }
__device__ __forceinline__ float silu_r(float x) { return x * __builtin_amdgcn_rcpf(1.0f + __expf(-x)); }
__device__ __forceinline__ float wave_sum(float v) {
#pragma unroll
  for (int o = 32; o > 0; o >>= 1) v += __shfl_xor(v, o);
  return v;
}
template <int CTRL, int RM, int BM> __device__ __forceinline__ float dpp_mov(float old, float v) { return __int_as_float(__builtin_amdgcn_update_dpp(__float_as_int(old), __float_as_int(v), CTRL, RM, BM, false)); }
__device__ __forceinline__ float wave_sum_u(float v) {
  v += dpp_mov<0xB1, 0xf, 0xf>(v, v);
  v += dpp_mov<0x4E, 0xf, 0xf>(v, v);
  v += dpp_mov<0x141, 0xf, 0xf>(v, v);
  v += dpp_mov<0x140, 0xf, 0xf>(v, v);
  v += dpp_mov<0x142, 0xa, 0xf>(0.f, v);
  v += dpp_mov<0x143, 0xc, 0xf>(0.f, v);
  return __int_as_float(__builtin_amdgcn_readlane(__float_as_int(v), 63));
}
__device__ __forceinline__ float wave_max_u(float v) {
  v = fmaxf(v, dpp_mov<0xB1, 0xf, 0xf>(v, v));
  v = fmaxf(v, dpp_mov<0x4E, 0xf, 0xf>(v, v));
  v = fmaxf(v, dpp_mov<0x141, 0xf, 0xf>(v, v));
  v = fmaxf(v, dpp_mov<0x140, 0xf, 0xf>(v, v));
  v = fmaxf(v, dpp_mov<0x142, 0xa, 0xf>(0.f, v));
  v = fmaxf(v, dpp_mov<0x143, 0xc, 0xf>(0.f, v));
  return __int_as_float(__builtin_amdgcn_readlane(__float_as_int(v), 63));
}
__device__ __forceinline__ float reduce_scatter16(const float (&acc)[16], int lane) {
  float t8[8], t4[4], t2[2];
#pragma unroll
  for (int i = 0; i < 8; ++i) { const u32x2 sw = __builtin_amdgcn_permlane32_swap(__float_as_uint(acc[i]), __float_as_uint(acc[8 + i]), false, false); t8[i] = __uint_as_float(sw.x) + __uint_as_float(sw.y); }
#pragma unroll
  for (int i = 0; i < 4; ++i) { const u32x2 sw = __builtin_amdgcn_permlane16_swap(__float_as_uint(t8[i]), __float_as_uint(t8[4 + i]), false, false); t4[i] = __uint_as_float(sw.x) + __uint_as_float(sw.y); }
  const bool b3 = (lane & 8) != 0, b2_ = (lane & 4) != 0;
#pragma unroll
  for (int i = 0; i < 2; ++i) { const float keep = b3 ? t4[2 + i] : t4[i], send = b3 ? t4[i] : t4[2 + i]; t2[i] = keep + dpp_mov<0x128, 0xf, 0xf>(send, send); }
  float tot;
  { const float keep = b2_ ? t2[1] : t2[0], send = b2_ ? t2[0] : t2[1];
    float recv = dpp_mov<0x104, 0xf, 0x5>(send, send);
    recv = dpp_mov<0x114, 0xf, 0xa>(recv, send);
    tot = keep + recv; }
  tot += dpp_mov<0xB1, 0xf, 0xf>(tot, tot); tot += dpp_mov<0x4E, 0xf, 0xf>(tot, tot);
  return tot;
}
__device__ __forceinline__ f32x16 zero16() { float z = 0.f; asm volatile("" : "+v"(z)); f32x16 r;
#pragma unroll
  for (int i = 0; i < 16; ++i) r[i] = z;
  return r; }
__device__ __forceinline__ int otid() { int t = threadIdx.x; asm volatile("" : "+v"(t)); return t; }
__device__ __forceinline__ int obid() { int b = blockIdx.x; asm volatile("" : "+s"(b)); return b; }
__device__ __forceinline__ int bidx_of_row(int row) { return row < NLAT ? row / T : 4; }
}

#include <vector>

#define XB_TMO      128
#define XB_XCNT(j)  (256  + 64 * (j))
#define XB_XSUB(j)  (1280 + 64 * (j))
#define XB_XGEN(j)  (2304 + 64 * (j))
#define XB_TOP      3328
#define XB_TOPGEN   3392
#define XCD_BAR_WORDS 3456
#define XB_SPIN_CAP (1u << 18)
#define LAS __attribute__((address_space(3)))

__device__ __forceinline__ unsigned xb_ld(unsigned* p)              { return __hip_atomic_load(p, __ATOMIC_RELAXED, __HIP_MEMORY_SCOPE_AGENT); }
__device__ __forceinline__ unsigned xb_add(unsigned* p, unsigned v) { return __hip_atomic_fetch_add(p, v, __ATOMIC_RELAXED, __HIP_MEMORY_SCOPE_AGENT); }
__device__ __forceinline__ unsigned xb_xcc_id() { return (unsigned)__builtin_amdgcn_s_getreg((3 << 11) | 20) & 0xFu; }
#define XB_SPIN(cond, bar) do { unsigned _sp = 0; while (cond) { __builtin_amdgcn_s_sleep(1); \
    if ((++_sp & 255u) == 0u) { if (xb_ld(&(bar)[XB_TMO])) break; if (_sp > XB_SPIN_CAP) { atomicAdd(&(bar)[XB_TMO], 1u); break; } } } } while (0)

struct XcdBarrier {
    unsigned* bar; unsigned x;
    volatile LAS unsigned* st;
};

__device__ __forceinline__ XcdBarrier xcd_barrier_post(unsigned* bar, volatile LAS unsigned* st) {
    XcdBarrier b; b.bar = bar; b.x = xb_xcc_id(); b.st = st;
    if (threadIdx.x == 0) (void)xb_add(&bar[XB_XCNT(b.x)], 1u);
    return b;
}
__device__ __forceinline__ void xcd_barrier_complete(unsigned* bar, unsigned x, unsigned& nloc, unsigned& nx) {
    const unsigned G = gridDim.x * gridDim.y * gridDim.z;
    unsigned sum, cnt, mine, sp = 0u;
    for (;;) {
        sum = 0u; cnt = 0u; mine = 0u;
#pragma unroll
        for (unsigned j = 0; j < 16; ++j) { const unsigned c = xb_ld(&bar[XB_XCNT(j)]); sum += c; cnt += (c > 0u) ? 1u : 0u; mine = (j == x) ? c : mine; }
        if (sum == G) break;
        __builtin_amdgcn_s_sleep(1);
        if ((++sp & 255u) == 0u) { if (xb_ld(&bar[XB_TMO])) break; if (sp > XB_SPIN_CAP) { atomicAdd(&bar[XB_TMO], 1u); break; } }
    }
    nloc = mine > 0u ? mine : 1u; nx = cnt > 0u ? cnt : 1u;
}

__device__ __forceinline__ void xcd_barrier(const XcdBarrier& b) {
    asm volatile("s_waitcnt vmcnt(0)" ::: "memory");
    __syncthreads();
    if (threadIdx.x == 0) {
        unsigned* bar = b.bar;
        __builtin_amdgcn_s_waitcnt(0);
        unsigned nloc = b.st[0], nx = b.st[1];
        if (nloc == 0u) { xcd_barrier_complete(bar, b.x, nloc, nx); b.st[0] = nloc; b.st[1] = nx; }
        const unsigned old = xb_add(&bar[XB_XSUB(b.x)], 1u);
        const unsigned gen = old / nloc;
        if (old + 1u == (gen + 1u) * nloc) {
            __builtin_amdgcn_fence(__ATOMIC_RELEASE, "agent");
            asm volatile("s_waitcnt vmcnt(0)" ::: "memory");
            const unsigned og = xb_add(&bar[XB_TOP], 1u);
            const unsigned tg = og / nx;
            if (og + 1u == (tg + 1u) * nx) xb_add(&bar[XB_TOPGEN], 1u);
            else XB_SPIN(xb_ld(&bar[XB_TOPGEN]) == tg, bar);
            __builtin_amdgcn_fence(__ATOMIC_ACQUIRE, "agent");
            xb_add(&bar[XB_XGEN(b.x)], 1u);
            asm volatile("s_waitcnt vmcnt(0)" ::: "memory");
        } else {
            XB_SPIN(xb_ld(&bar[XB_XGEN(b.x)]) == gen, bar);
            __builtin_amdgcn_fence(__ATOMIC_ACQUIRE, "agent");
            asm volatile("s_waitcnt vmcnt(0)" ::: "memory");
        }
    }
    __syncthreads();
}

namespace pg8 {
using mk::cvt_pk_bf16;
constexpr int BM = 256, BK = 64, HALF = 128, HTB = HALF * BK * 2  , STAGE_BYTES = 8 * HTB;
__host__ __device__ __forceinline__ int lds_byte(int r, int c) { const int st = (r >> 4) * 2 + (c >> 5), rr = r & 15, cc = c & 31, ob = rr * 64 + cc * 2; return st * 1024 + (ob ^ (((ob >> 9) & 1) << 5)); }
__host__ __device__ __forceinline__ void stage_rc(int b, int& R, int& C) { const int st = b / 1024, sb = b % 1024, swz = sb ^ (((sb >> 9) & 1) << 5); R = (st >> 1) * 16 + swz / 64; C = (st & 1) * 32 + (swz % 64) / 2; }
__host__ __device__ __forceinline__ int perm32(int rho) { const int n = rho >> 4, i = rho & 15; return 8 * (i >> 2) + 4 * n + (i & 3); }

struct Unit { const char* A; const char* Bt; bf16_t* out; const int* rl; int pm, pn, x0, x1, ldo, kind; };

template <class Epi, class Sched>
__device__ __forceinline__ void gemm_phase(LAS unsigned char* lds, const int K, const Sched& S, const Epi& E) {
    const int tid = mk::otid(), wid = __builtin_amdgcn_readfirstlane(tid >> 6), lane = tid & 63, wr = wid >> 2, wc = wid & 3, fr = lane & 15, fq = lane >> 4;
    const int nt = K / BK;
    constexpr bool GATH = Sched::GATHER;
    unsigned voffA[2], voffB[2]; int Rl[2], Cl[2];
#pragma unroll
    for (int i = 0; i < 2; ++i) { int R, C; stage_rc(tid * 16 + i * 8192, R, C); const int Rb = Epi::PERM ? ((R & ~31) + perm32(R & 31)) : R; Rl[i] = R; Cl[i] = C;
        voffA[i] = (unsigned)(R * K + C) * 2u; voffB[i] = (unsigned)(Rb * K + C) * 2u; }
    unsigned roC[2][2], roN[2][2];
    (void)Rl; (void)Cl;
    const size_t kstep = (size_t)(BK * 2);
    const size_t hstep = (size_t)HALF * K * 2;
    const unsigned ldsw = (unsigned)wid * 1024u;
    const int aoff = lds_byte(wr * 64 + fr, fq * 8), boff = lds_byte(wc * 32 + fr, fq * 8);
#define PG8_SA(b, h) (((b) * 2 + (h)) * HTB)
#define PG8_SB(b, h) ((4 + (b) * 2 + (h)) * HTB)
#define PG8_STAGE(bufoff, gbase, voff) do { _Pragma("unroll") for (int _i = 0; _i < 2; ++_i) \
        __builtin_amdgcn_global_load_lds((const unsigned*)((const char*)(gbase) + (voff)[_i]), (LAS unsigned*)(lds + (bufoff) + ldsw + _i * 8192), 16, 0, 0); } while (0)
#define PG8_STAGE_A(bufoff, gbase, h, ro) do { if constexpr (GATH) { _Pragma("unroll") for (int _i = 0; _i < 2; ++_i) \
        __builtin_amdgcn_global_load_lds((const unsigned*)((const char*)(gbase) + (ro)[h][_i]), (LAS unsigned*)(lds + (bufoff) + ldsw + _i * 8192), 16, 0, 0); } \
      else { PG8_STAGE(bufoff, (const char*)(gbase) + (h) * hstep, voffA); } } while (0)
#define PG8_LOAD_RO(u, ro) do { _Pragma("unroll") for (int _h = 0; _h < 2; ++_h) _Pragma("unroll") for (int _i = 0; _i < 2; ++_i) \
        (ro)[_h][_i] = (unsigned)(u).rl[Rl[_i] + _h * 128] * (unsigned)(K * 2) + (unsigned)(Cl[_i] * 2); } while (0)
#define PG8_LDA(dst, b, h) do { _Pragma("unroll") for (int m = 0; m < 4; ++m) _Pragma("unroll") for (int k = 0; k < 2; ++k) dst[m][k] = *(const LAS bf16x8*)(lds + PG8_SA(b, h) + aoff + m * 2048 + k * 1024); } while (0)
#define PG8_LDB(dst, b, h) do { _Pragma("unroll") for (int n = 0; n < 2; ++n) _Pragma("unroll") for (int k = 0; k < 2; ++k) dst[n][k] = *(const LAS bf16x8*)(lds + PG8_SB(b, h) + boff + n * 2048 + k * 1024); } while (0)
#define PG8_MMA(ai, bj, At, Bt) do { __builtin_amdgcn_s_setprio(1); _Pragma("unroll") for (int m = 0; m < 4; ++m) _Pragma("unroll") for (int n = 0; n < 2; ++n) _Pragma("unroll") for (int k = 0; k < 2; ++k) \
        acc[ai][bj][m][n] = __builtin_amdgcn_mfma_f32_16x16x32_bf16(Bt[n][k], At[m][k], acc[ai][bj][m][n], 0, 0, 0); __builtin_amdgcn_s_setprio(0); } while (0)
#define PG8_WAIT_V(n) asm volatile("s_waitcnt vmcnt(" #n ")" ::: "memory")
#define PG8_WAIT_L(n) asm volatile("s_waitcnt lgkmcnt(" #n ")" ::: "memory")
#define PG8_BAR __builtin_amdgcn_s_barrier()
#define PG8_SCHED __builtin_amdgcn_sched_barrier(0)
    Unit cur, nxt; int ui = 0;
    if (!S.next(0, cur)) return;
    f32x4 acc[2][2][4][2];
#pragma unroll
    for (int a = 0; a < 2; ++a)
#pragma unroll
        for (int b = 0; b < 2; ++b)
#pragma unroll
            for (int m = 0; m < 4; ++m)
#pragma unroll
                for (int n = 0; n < 2; ++n) acc[a][b][m][n] = (f32x4){0.f, 0.f, 0.f, 0.f};
    bf16x8 At[4][2], B0[2][2], B1[2][2];
    const char* cA = cur.A; const char* cB = cur.Bt;
    if constexpr (GATH) { PG8_LOAD_RO(cur, roC); }
    PG8_STAGE(PG8_SB(0, 0), cB, voffB); PG8_STAGE_A(PG8_SA(0, 0), cA, 0, roC); PG8_STAGE(PG8_SB(0, 1), cB + hstep, voffB); PG8_STAGE_A(PG8_SA(0, 1), cA, 1, roC);
    if (wr == 1) PG8_BAR;
    PG8_WAIT_V(4); PG8_BAR;
    PG8_STAGE(PG8_SB(1, 0), cB + kstep, voffB); PG8_STAGE_A(PG8_SA(1, 0), cA + kstep, 0, roC); PG8_STAGE(PG8_SB(1, 1), cB + hstep + kstep, voffB);
    PG8_WAIT_V(6); PG8_BAR;
    for (;;) {
        const bool has_next = S.next(ui + 1, nxt);
        const char* nA = has_next ? nxt.A : cA; const char* nB = has_next ? nxt.Bt : cB;
        if constexpr (GATH) { if (has_next) { PG8_LOAD_RO(nxt, roN); } else { _Pragma("unroll") for (int _h = 0; _h < 2; ++_h) _Pragma("unroll") for (int _i = 0; _i < 2; ++_i) roN[_h][_i] = roC[_h][_i]; } }
        for (int t = 0; t < nt; t += 2) {
            const bool last = (t == nt - 2);
            const char* a1 = cA + (size_t)(t + 1) * kstep;
            const char* a2 = last ? nA : cA + (size_t)(t + 2) * kstep; const char* b2 = last ? nB : cB + (size_t)(t + 2) * kstep;
            const char* a3 = a2 + kstep; const char* b3 = b2 + kstep;
            unsigned ro2[2][2];
            if constexpr (GATH) { _Pragma("unroll") for (int _h = 0; _h < 2; ++_h) _Pragma("unroll") for (int _i = 0; _i < 2; ++_i) ro2[_h][_i] = last ? roN[_h][_i] : roC[_h][_i]; }
            (void)ro2;
            PG8_LDB(B0, 0, 0); PG8_SCHED; PG8_LDA(At, 0, 0); PG8_STAGE_A(PG8_SA(1, 1), a1, 1, roC);
            PG8_WAIT_L(8); PG8_BAR; PG8_WAIT_L(0); PG8_MMA(0, 0, At, B0); PG8_BAR; PG8_SCHED;
            PG8_LDB(B1, 0, 1); PG8_STAGE(PG8_SB(0, 0), b2, voffB);
            PG8_BAR; PG8_WAIT_L(0); PG8_MMA(0, 1, At, B1); PG8_BAR;
            PG8_LDA(At, 0, 1); PG8_STAGE_A(PG8_SA(0, 0), a2, 0, ro2);
            PG8_BAR; PG8_WAIT_L(0); PG8_MMA(1, 0, At, B0); PG8_BAR; PG8_SCHED;
            PG8_STAGE(PG8_SB(0, 1), b2 + hstep, voffB);
            PG8_WAIT_V(6); PG8_BAR; PG8_MMA(1, 1, At, B1); PG8_BAR;
            PG8_LDB(B0, 1, 0); PG8_SCHED; PG8_LDA(At, 1, 0); PG8_STAGE_A(PG8_SA(0, 1), a2, 1, ro2);
            PG8_WAIT_L(8); PG8_BAR; PG8_WAIT_L(0); PG8_MMA(0, 0, At, B0); PG8_BAR; PG8_SCHED;
            PG8_LDB(B1, 1, 1); PG8_STAGE(PG8_SB(1, 0), b3, voffB);
            PG8_BAR; PG8_WAIT_L(0); PG8_MMA(0, 1, At, B1); PG8_BAR;
            PG8_LDA(At, 1, 1); PG8_STAGE_A(PG8_SA(1, 0), a3, 0, ro2);
            PG8_BAR; PG8_WAIT_L(0); PG8_MMA(1, 0, At, B0); PG8_BAR; PG8_SCHED;
            PG8_STAGE(PG8_SB(1, 1), b3 + hstep, voffB);
            PG8_WAIT_V(6); PG8_BAR; PG8_MMA(1, 1, At, B1); PG8_BAR;
        }
        E(acc, cur, wr, wc, fr, fq);
        if (!has_next) break;
#pragma unroll
        for (int a = 0; a < 2; ++a)
#pragma unroll
            for (int b = 0; b < 2; ++b)
#pragma unroll
                for (int m = 0; m < 4; ++m)
#pragma unroll
                    for (int n = 0; n < 2; ++n) acc[a][b][m][n] = (f32x4){0.f, 0.f, 0.f, 0.f};
        cur = nxt; cA = nA; cB = nB; ++ui;
        if constexpr (GATH) { _Pragma("unroll") for (int _h = 0; _h < 2; ++_h) _Pragma("unroll") for (int _i = 0; _i < 2; ++_i) roC[_h][_i] = roN[_h][_i]; }
    }
    PG8_WAIT_V(0);
    if (wr == 0) PG8_BAR;
    PG8_BAR;
#undef PG8_SA
#undef PG8_SB
#undef PG8_STAGE
#undef PG8_STAGE_A
#undef PG8_LOAD_RO
#undef PG8_LDA
#undef PG8_LDB
#undef PG8_MMA
#undef PG8_WAIT_V
#undef PG8_WAIT_L
#undef PG8_BAR
#undef PG8_SCHED
}

struct EpiStoreBf16 {
    static constexpr bool PERM = true;
    __device__ __forceinline__ void operator()(const f32x4 (&acc)[2][2][4][2], const Unit& u, int wr, int wc, int fr, int fq) const {
        bf16_t* O = u.out; const int ldc = u.ldo;
        const int row0 = u.x0 + wr * 64 + fr, col0 = u.x1 + wc * 32 + 8 * fq;
#pragma unroll
        for (int ai = 0; ai < 2; ++ai)
#pragma unroll
            for (int m = 0; m < 4; ++m) { bf16_t* rowp = O + (size_t)(row0 + ai * HALF + m * 16) * ldc + col0;
#pragma unroll
                for (int bj = 0; bj < 2; ++bj) { const f32x4 v0 = acc[ai][bj][m][0], v1 = acc[ai][bj][m][1];
                    u32x4 w; w.x = cvt_pk_bf16(v0[0], v0[1]); w.y = cvt_pk_bf16(v0[2], v0[3]); w.z = cvt_pk_bf16(v1[0], v1[1]); w.w = cvt_pk_bf16(v1[2], v1[3]);
                    *(u32x4*)(rowp + bj * HALF) = w; } }
    }
};
}

namespace mk {
struct NMapId { int off; __device__ __forceinline__ int operator()(int n) const { return n + off; } __device__ __forceinline__ float scl(int) const { return 1.0f; } };
struct NMapInterleave { int which; __device__ __forceinline__ int operator()(int n) const { return 2 * n + which; } __device__ __forceinline__ float scl(int) const { return 1.0f; } };
struct NMapRope { __device__ __forceinline__ int operator()(int n) const { if (n >= 2048) return n; const int ch = n >> 6, c = n & 63, half = c >> 5, w = c & 31, z = w >> 4, i = w & 15; return ch * 64 + half * 32 + 2 * i + z; }
  __device__ __forceinline__ float scl(int n) const { return n < 1024 ? 0.125f * 1.4426950408889634f : 1.0f; } };

template <class NMap>
__device__ __forceinline__ void cvt_tile(const float* __restrict__ src, int ldsrc, int K, bf16_t* __restrict__ dst, int k0, int n0, const NMap& nmap, LAS float* tile) {
  const int t = mk::otid();
  { const int k = t >> 3, c = (t & 7) * 8; const float* p = src + (size_t)(k0 + k) * ldsrc + n0 + c;
    const f32x4 a = *(const f32x4*)p, b = *(const f32x4*)(p + 4);
    LAS float* q = tile + k * 65 + c; q[0] = a[0]; q[1] = a[1]; q[2] = a[2]; q[3] = a[3]; q[4] = b[0]; q[5] = b[1]; q[6] = b[2]; q[7] = b[3]; }
  __syncthreads();
  { const int n = t >> 3, kc = (t & 7) * 8; const LAS float* q = tile + kc * 65 + n; const float sc = nmap.scl(n0 + n);
    u32x4 w; w.x = cvt_pk_bf16(q[0] * sc, q[65] * sc); w.y = cvt_pk_bf16(q[130] * sc, q[195] * sc); w.z = cvt_pk_bf16(q[260] * sc, q[325] * sc); w.w = cvt_pk_bf16(q[390] * sc, q[455] * sc);
    *(u32x4*)(dst + (size_t)nmap(n0 + n) * K + k0 + kc) = w; }
  __syncthreads();
}
template <class NMap>
__device__ __forceinline__ int cvt_matrix(const float* src, int ldsrc, int K, int N, bf16_t* dst, const NMap& nmap, LAS float* tile, int ubase, int bid, int nblk) {
  const int nkt = K / 64, nnt = N / 64, tot = nkt * nnt;
  int first = ubase + ((bid - ubase % nblk) + nblk) % nblk;
  for (int u = first; u < ubase + tot; u += nblk) { const int v = u - ubase; cvt_tile(src, ldsrc, K, dst, (v / nnt) * 64, (v % nnt) * 64, nmap, tile); }
  return tot;
}
}

namespace att {
using namespace mk;
constexpr int KB_BYTES = 64 * 128, VB_BYTES = 128 * 128, TILE_BYTES = KB_BYTES + VB_BYTES, DA_RING = 4, DA_LDS = DA_RING * TILE_BYTES;
__device__ __forceinline__ int pi32(int r) { return (r & ~12) | ((r & 4) << 1) | ((r & 8) >> 1); }
__device__ __forceinline__ int swz(int row, int chunk) { return row * 128 + ((chunk ^ ((row >> 1) & 7)) << 4); }
__device__ __forceinline__ int crow(int r, int hi) { return (r & 3) + 8 * (r >> 2) + 4 * hi; }

__device__ __forceinline__ float sumsq8(u32x4 w) { return (bflo(w.x) * bflo(w.x) + bfhi(w.x) * bfhi(w.x)) + (bflo(w.y) * bflo(w.y) + bfhi(w.y) * bfhi(w.y)) + (bflo(w.z) * bflo(w.z) + bfhi(w.z) * bfhi(w.z)) + (bflo(w.w) * bflo(w.w) + bfhi(w.w) * bfhi(w.w)); }
__device__ __forceinline__ void knorm_group(const bf16_t* __restrict__ Pqk, float* __restrict__ KN, int g, LAS float* red) {
  const int tid = mk::otid(), wid = tid >> 6, lane = tid & 63;
  float mx = 0.f, mq = 0.f;
  for (int i0 = 0; i0 < 160; i0 += 32) {
    u32x4 a[4], b[4], c[4], d[4];
#pragma unroll
    for (int j = 0; j < 4; ++j) { int i = i0 + j * 8 + wid; i = i < 132 ? i : wid; const int row = i < 128 ? g * 128 + i : NLAT + g * 4 + (i - 128);
      const bf16_t* kp = Pqk + (size_t)row * 2048 + 1024 + lane * 16; a[j] = *(const u32x4*)kp; b[j] = *(const u32x4*)(kp + 8); c[j] = *(const u32x4*)(kp - 1024); d[j] = *(const u32x4*)(kp - 1024 + 8); }
#pragma unroll
    for (int j = 0; j < 4; ++j) { float s = sumsq8(a[j]) + sumsq8(b[j]); s += dpp_mov<0xB1, 0xf, 0xf>(s, s); s += dpp_mov<0x4E, 0xf, 0xf>(s, s); mx = fmaxf(mx, s);
      float q = sumsq8(c[j]) + sumsq8(d[j]); q += dpp_mov<0xB1, 0xf, 0xf>(q, q); q += dpp_mov<0x4E, 0xf, 0xf>(q, q); mq = fmaxf(mq, q); }
  }
  if ((lane & 3) == 0) { red[wid * 32 + (lane >> 2)] = mx; red[wid * 32 + 16 + (lane >> 2)] = mq; }
  __syncthreads();
  if (tid < 32) { float m = red[tid];
#pragma unroll
    for (int w = 1; w < 8; ++w) m = fmaxf(m, red[w * 32 + tid]);
    KN[g * 32 + tid] = m; }
  __syncthreads();
}
__device__ __forceinline__ float nmax2_of(const float* __restrict__ KN, int b, int hh, int which) {
  return wave_max_u(KN[(b * 64 + (mk::otid() & 63)) * 32 + which * 16 + hh]);
}

template <bool STATIC, int ABL = 0>
__device__ __forceinline__ void diff_attn_unit(const bf16_t* __restrict__ Pqk, const bf16_t* __restrict__ Vt, bf16_t* __restrict__ O12, int hh, int q0, int klat0, int nlat, int kctx0, LAS unsigned char* lds) {
  const int tid = mk::otid(), wid = tid >> 6, lane = tid & 63, r = lane & 31, hi = lane >> 5;
  const int NT = (nlat + L) / 64, NTL = nlat / 64;
  const int wv = __builtin_amdgcn_readfirstlane(wid);
  const int drow = wv * 8 + (lane >> 3), dch = (lane & 7) ^ ((drow >> 1) & 7);
  const unsigned koff = (unsigned)(drow * 2048 + 1024 + hh * 64 + dch * 8) * 2u;
  const unsigned voff = (unsigned)(((hh >> 1) * 128 + drow) * NTOK + dch * 8) * 2u;
  bf16x8 qf[4];
  { const bf16_t* qp = Pqk + (size_t)(q0 + wid * 32 + r) * 2048 + hh * 64 + hi * 8;
#pragma unroll
    for (int ks = 0; ks < 4; ++ks) qf[ks] = *(const bf16x8*)(qp + ks * 16); }
  const unsigned kaddr0 = (unsigned)(pi32(r) * 128 + ((hi ^ ((pi32(r) >> 1) & 7)) << 4));
  const unsigned vaddr0 = (unsigned)(r * 128 + ((hi ^ ((r >> 1) & 7)) << 4)) + KB_BYTES;
  f32x16 o[4];
#pragma unroll
  for (int vb = 0; vb < 4; ++vb)
#pragma unroll
    for (int i = 0; i < 16; ++i) o[vb][i] = 0.f;
  float l_run = 0.f;
#define DA_DMA(t) do { const int tok = (t) < NTL ? klat0 + (t) * 64 : kctx0 + ((t) - NTL) * 64; LAS unsigned char* b_ = lds + ((t) & 3) * TILE_BYTES + wv * 1024; \
    const char* kt_ = (const char*)Pqk + (size_t)tok * 4096; const char* vt_ = (const char*)Vt + (size_t)tok * 2; \
    __builtin_amdgcn_global_load_lds((const unsigned*)(kt_ + koff), (LAS unsigned*)b_, 16, 0, 0); \
    __builtin_amdgcn_global_load_lds((const unsigned*)(vt_ + voff), (LAS unsigned*)(b_ + KB_BYTES), 16, 0, 0); \
    __builtin_amdgcn_global_load_lds((const unsigned*)(vt_ + (size_t)64 * NTOK * 2 + voff), (LAS unsigned*)(b_ + KB_BYTES + 8192), 16, 0, 0); } while (0)
#define DA_WAITV(n) asm volatile("s_waitcnt vmcnt(" #n ")" ::: "memory")
#define DA_PAIR_BEGIN(t) if (!(ABL & 8) && (t) + 2 < NT) { DA_DMA((t) + 2); DA_DMA((t) + 3); }
#define DA_SLOT(tt) const unsigned sb_ = (unsigned)(((tt) & 3) * TILE_BYTES); const LAS unsigned char* kb_ = lds + (kaddr0 + sb_); const LAS unsigned char* vb_ = lds + (vaddr0 + sb_)
#define DA_PAIR_END() do { DA_WAITV(0); asm volatile("s_waitcnt lgkmcnt(0)" ::: "memory"); if (!(ABL & 16)) __builtin_amdgcn_s_barrier(); } while (0)
  DA_DMA(0); DA_DMA(1);
  DA_WAITV(0); __builtin_amdgcn_s_barrier();
#define DA_XOR(ptr, x) ((const LAS unsigned char*)((unsigned)(size_t)(ptr) ^ (unsigned)(x)))
#define DA_KFRAG(ks) const LAS unsigned char* kp_ = DA_XOR(kb_, (ks) << 5); const bf16x8 a0 = (ABL & 2) ? qf[ks] : *(const LAS bf16x8*)kp_, a1 = (ABL & 2) ? qf[(ks) ^ 1] : *(const LAS bf16x8*)(kp_ + 4096)
#define DA_VFRAGS() bf16x8 va[4][4]; \
    _Pragma("unroll") for (int c4 = 0; c4 < 4; ++c4) { const LAS unsigned char* vp_ = DA_XOR(vb_, c4 << 5); \
      _Pragma("unroll") for (int vb = 0; vb < 4; ++vb) va[vb][c4] = (ABL & 1) ? qf[c4 ^ (vb & 3)] : *(const LAS bf16x8*)(vp_ + vb * 4096); }
#define DA_PACK_PV() bf16x8 pf[2][2]; \
    _Pragma("unroll") for (int s = 0; s < 2; ++s) { u32x4 w0; \
      w0.x = cvt_pk_bf16(s0[8 * s + 0], s0[8 * s + 1]); w0.y = cvt_pk_bf16(s0[8 * s + 2], s0[8 * s + 3]); w0.z = cvt_pk_bf16(s0[8 * s + 4], s0[8 * s + 5]); w0.w = cvt_pk_bf16(s0[8 * s + 6], s0[8 * s + 7]); \
      pf[0][s] = __builtin_bit_cast(bf16x8, w0); } \
    _Pragma("unroll") for (int s = 0; s < 2; ++s) { u32x4 w1; \
      w1.x = cvt_pk_bf16(s1[8 * s + 0], s1[8 * s + 1]); w1.y = cvt_pk_bf16(s1[8 * s + 2], s1[8 * s + 3]); w1.z = cvt_pk_bf16(s1[8 * s + 4], s1[8 * s + 5]); w1.w = cvt_pk_bf16(s1[8 * s + 6], s1[8 * s + 7]); \
      pf[1][s] = __builtin_bit_cast(bf16x8, w1); } \
    _Pragma("unroll") for (int kb = 0; kb < 2; ++kb) _Pragma("unroll") for (int s = 0; s < 2; ++s) _Pragma("unroll") for (int vb = 0; vb < 4; ++vb) \
      o[vb] = __builtin_amdgcn_mfma_f32_32x32x16_bf16(va[vb][kb * 2 + s], pf[kb][s], o[vb], 0, 0, 0)
  if constexpr (STATIC) {
    for (int t = 0; t < NT; t += 2) {
      DA_PAIR_BEGIN(t);
#pragma unroll
      for (int u = 0; u < 2; ++u) {
        DA_SLOT(t + u);
        f32x16 s0, s1;
#pragma unroll
        for (int i = 0; i < 16; ++i) { s0[i] = 0.f; s1[i] = 0.f; }
#pragma unroll
        for (int ks = 0; ks < 4; ++ks) { DA_KFRAG(ks); s0 = __builtin_amdgcn_mfma_f32_32x32x16_bf16(a0, qf[ks], s0, 0, 0, 0); s1 = __builtin_amdgcn_mfma_f32_32x32x16_bf16(a1, qf[ks], s1, 0, 0, 0); }
        DA_VFRAGS();
        if constexpr ((ABL & 32) != 0) {
          l_run += s0[0] + s1[0];
#pragma unroll
          for (int vb = 0; vb < 4; ++vb)
#pragma unroll
            for (int c4 = 0; c4 < 4; ++c4) o[vb] = __builtin_amdgcn_mfma_f32_32x32x16_bf16(va[vb][c4], qf[c4], o[vb], 0, 0, 0);
        } else {
          float ps = 0.f;
#pragma unroll
          for (int i = 0; i < 16; ++i) { s0[i] = (ABL & 4) ? s0[i] : __builtin_amdgcn_exp2f(s0[i]); ps += s0[i]; }
#pragma unroll
          for (int i = 0; i < 16; ++i) { s1[i] = (ABL & 4) ? s1[i] : __builtin_amdgcn_exp2f(s1[i]); ps += s1[i]; }
          l_run += ps;
          DA_PACK_PV();
        }
      }
      DA_PAIR_END();
    }
  } else {
    constexpr float THR = 8.0f * 1.4426950408889634f;
    float m_run = -1e30f;
    for (int t = 0; t < NT; ++t) {
      if (!(t & 1)) DA_PAIR_BEGIN(t);
      DA_SLOT(t);
      f32x16 s0 = zero16(), s1 = zero16();
#pragma unroll
      for (int ks = 0; ks < 4; ++ks) { DA_KFRAG(ks); s0 = __builtin_amdgcn_mfma_f32_32x32x16_bf16(a0, qf[ks], s0, 0, 0, 0); s1 = __builtin_amdgcn_mfma_f32_32x32x16_bf16(a1, qf[ks], s1, 0, 0, 0); }
      float mx = fmaxf(s0[0], s1[0]);
#pragma unroll
      for (int i = 1; i < 16; ++i) mx = fmaxf(mx, fmaxf(s0[i], s1[i]));
      { const u32x2 sw = __builtin_amdgcn_permlane32_swap(__float_as_uint(mx), __float_as_uint(mx), false, false); mx = fmaxf(__uint_as_float(sw.x), __uint_as_float(sw.y)); }
      float alpha = 1.0f;
      if (!__all(mx - m_run <= THR)) {
        const float m_new = fmaxf(m_run, mx);
        alpha = __builtin_amdgcn_exp2f(m_run - m_new);
        m_run = m_new;
#pragma unroll
        for (int vb = 0; vb < 4; ++vb)
#pragma unroll
          for (int i = 0; i < 16; ++i) o[vb][i] *= alpha;
      }
      float ps = 0.f;
#pragma unroll
      for (int i = 0; i < 16; ++i) { s0[i] = __builtin_amdgcn_exp2f(s0[i] - m_run); ps += s0[i]; }
#pragma unroll
      for (int i = 0; i < 16; ++i) { s1[i] = __builtin_amdgcn_exp2f(s1[i] - m_run); ps += s1[i]; }
      l_run = l_run * alpha + ps;
      __builtin_amdgcn_sched_barrier(0);
      DA_VFRAGS();
      DA_PACK_PV();
      if (t & 1) DA_PAIR_END();
    }
  }
#undef DA_KFRAG
#undef DA_XOR
#undef DA_VFRAGS
#undef DA_PACK_PV
#undef DA_DMA
#undef DA_WAITV
#undef DA_PAIR_BEGIN
#undef DA_PAIR_END
#undef DA_SLOT
  float l_tot; { const u32x2 sw = __builtin_amdgcn_permlane32_swap(__float_as_uint(l_run), __float_as_uint(l_run), false, false); l_tot = __uint_as_float(sw.x) + __uint_as_float(sw.y); }
  const float inv = 1.0f / l_tot;
  const int te = mk::otid();
  bf16_t* op = O12 + (size_t)(q0 + (te >> 6) * 32 + (te & 31)) * 2048 + hh * 128 + 4 * ((te >> 5) & 1);
#pragma unroll
  for (int vb = 0; vb < 4; ++vb)
#pragma unroll
    for (int g = 0; g < 4; ++g) {
      u32x2 w; w.x = cvt_pk_bf16(o[vb][4 * g] * inv, o[vb][4 * g + 1] * inv); w.y = cvt_pk_bf16(o[vb][4 * g + 2] * inv, o[vb][4 * g + 3] * inv);
      *(u32x2*)(op + vb * 32 + 8 * g) = w;
    }
}

__device__ __forceinline__ void diff_combine_rows4(const bf16_t* __restrict__ O12, const float* __restrict__ subln_g, float lam, float oml, bf16_t* __restrict__ O, int row0, int h, int lane) {
  unsigned a[4], b[4];
#pragma unroll
  for (int i = 0; i < 4; ++i) { a[i] = *(const unsigned*)(O12 + (size_t)(row0 + i) * 2048 + (2 * h) * 128 + 2 * lane); b[i] = *(const unsigned*)(O12 + (size_t)(row0 + i) * 2048 + (2 * h + 1) * 128 + 2 * lane); }
  const float g0 = subln_g[2 * lane], g1 = subln_g[2 * lane + 1];
#pragma unroll
  for (int i = 0; i < 4; ++i) {
    const float x0 = bflo(a[i]) - lam * bflo(b[i]), x1 = bfhi(a[i]) - lam * bfhi(b[i]);
    const float ss = wave_sum_u(x0 * x0 + x1 * x1);
    const float rs = rsqrtf(ss * (1.0f / 128.0f) + 1e-5f) * oml;
    *(unsigned*)(O + (size_t)(row0 + i) * 1024 + h * 128 + 2 * lane) = cvt_pk_bf16(x0 * rs * g0, x1 * rs * g1);
  }
}
}

namespace natt {
using namespace mk;
using att::pi32; using att::swz;
constexpr int TB = 64 * 128;
constexpr int NA_LDS = 4 * TB + 2048;
__device__ __forceinline__ void na_attn_unit(const bf16_t* __restrict__ Pe, const bf16_t* __restrict__ Vte, const float* __restrict__ rpb_h, bf16_t* __restrict__ O, int b, int h, int rq, LAS unsigned char* lds) {
  const int tid = mk::otid(), wid = tid >> 6, lane = tid & 63, r = lane & 31, hi = lane >> 5;
  constexpr float LOG2E = 1.4426950408889634f;
  LAS float* sb = (LAS float*)(lds + 4 * TB);
  for (int i = tid; i < 465; i += NTHR) sb[i] = rpb_h[i];
  const bool is_ctx = rq < 0;
  int qrow = 0, qcol = 0, qtok, rs_q = 0, cs_q = 0, span0 = 0, wlo = 0, whi = -1, lo = 0, ntl = 0;
  if (!is_ctx) {
    const int r0 = rq * 4, ra = r0 + (wid >> 2) * 2;
    qrow = ra + (r >> 4); qcol = (wid & 3) * 16 + (r & 15); qtok = b * T + qrow * 64 + qcol;
    rs_q = min(max(qrow - 4, 0), 120); cs_q = min(max(qcol - 8, 0), 48);
    span0 = min(max((wid & 3) * 16 - 8, 0), 32);
    wlo = min(max(ra - 4, 0), 120); whi = min(max(ra - 3, 0), 120) + 7;
    lo = min(max(r0 - 4, 0), 120); const int hi_ = min(max(r0 - 1, 0), 120) + 7; ntl = hi_ - lo + 1;
  } else qtok = NLAT + b * L + wid * 32 + r;
  const int NT = ntl + 4;
  const int srow = tid >> 3, sch = tid & 7;
  const bf16_t* kbase = Pe + 512 + h * 64 + sch * 8;
  const bf16_t* vbase = Vte + (size_t)(h * 64 + srow) * NTOK + sch * 8;
  const int sdst = swz(srow, sch);
  bf16x8 qf[4];
  { const bf16_t* qp = Pe + (size_t)qtok * 1024 + h * 64 + hi * 8;
#pragma unroll
    for (int ks = 0; ks < 4; ++ks) qf[ks] = *(const bf16x8*)(qp + ks * 16); }
  const int kx = (pi32(r) >> 1) & 7, vx = (r >> 1) & 7;
  const int ka_loc = (span0 + pi32(r)) * 128; const int kx_loc = ((span0 + pi32(r)) >> 1) & 7;
  f32x16 o[2];
#pragma unroll
  for (int vb = 0; vb < 2; ++vb)
#pragma unroll
    for (int i = 0; i < 16; ++i) o[vb][i] = 0.f;
  float m_run = -1e30f, l_run = 0.f;
  u32x4 kreg, vreg;
#define NA_LOAD(t) do { const int tok = (t) < ntl ? b * T + (lo + (t)) * 64 : NLAT + b * L + ((t) - ntl) * 64; \
    kreg = *(const u32x4*)(kbase + (size_t)(tok + srow) * 1024); vreg = *(const u32x4*)(vbase + tok); } while (0)
#define NA_WRITE(bufi) do { *(LAS u32x4*)(lds + (bufi) * TB + sdst) = kreg; *(LAS u32x4*)(lds + 2 * TB + (bufi) * TB + sdst) = vreg; } while (0)
  NA_LOAD(0); NA_WRITE(0); __syncthreads();
  for (int t = 0; t < NT; ++t) {
    const bool more = t + 1 < NT;
    if (more) NA_LOAD(t + 1);
    const LAS unsigned char* kb_ = lds + (t & 1) * TB; const LAS unsigned char* vb_ = lds + 2 * TB + (t & 1) * TB;
    const bool local = t < ntl; const int kr = lo + t;
    const bool active = !local || (kr >= wlo && kr <= whi);
    if (active) {
      f32x16 s0, s1;
#pragma unroll
      for (int i = 0; i < 16; ++i) { s0[i] = 0.f; s1[i] = 0.f; }
      if (local) {
#pragma unroll
        for (int ks = 0; ks < 4; ++ks) {
          const bf16x8 a0 = *(const LAS bf16x8*)(kb_ + ka_loc + (((ks * 2 + hi) ^ kx_loc) << 4));
          s0 = __builtin_amdgcn_mfma_f32_32x32x16_bf16(a0, qf[ks], s0, 0, 0, 0);
        }
        const bool row_ok = kr >= rs_q && kr < rs_q + 8; const int dr31 = (kr - qrow + 7) * 31;
#pragma unroll
        for (int i = 0; i < 16; ++i) {
          const int kc = span0 + (i & 7) + 8 * hi + 16 * (i >> 3);
          const bool ok = row_ok && kc >= cs_q && kc < cs_q + 16;
          const int bi = ok ? dr31 + (kc - qcol + 15) : 0;
          const float bv = sb[bi];
          s0[i] = ok ? fmaf(s0[i], 0.125f, bv) : -1e30f; s1[i] = -1e30f;
        }
      } else {
#pragma unroll
        for (int ks = 0; ks < 4; ++ks) {
          const int ch = ((ks * 2 + hi) ^ kx) << 4;
          const bf16x8 a0 = *(const LAS bf16x8*)(kb_ + pi32(r) * 128 + ch), a1 = *(const LAS bf16x8*)(kb_ + (32 + pi32(r)) * 128 + ch);
          s0 = __builtin_amdgcn_mfma_f32_32x32x16_bf16(a0, qf[ks], s0, 0, 0, 0);
          s1 = __builtin_amdgcn_mfma_f32_32x32x16_bf16(a1, qf[ks], s1, 0, 0, 0);
        }
#pragma unroll
        for (int i = 0; i < 16; ++i) { s0[i] *= 0.125f; s1[i] *= 0.125f; }
      }
      float mx = s0[0];
#pragma unroll
      for (int i = 1; i < 16; ++i) mx = fmaxf(mx, s0[i]);
#pragma unroll
      for (int i = 0; i < 16; ++i) mx = fmaxf(mx, s1[i]);
      { const u32x2 sw = __builtin_amdgcn_permlane32_swap(__float_as_uint(mx), __float_as_uint(mx), false, false); mx = fmaxf(__uint_as_float(sw.x), __uint_as_float(sw.y)); }
      const float m_new = fmaxf(m_run, mx);
      const float alpha = __builtin_amdgcn_exp2f((m_run - m_new) * LOG2E);
      m_run = m_new;
      const float mc = -m_new * LOG2E;
      float ps = 0.f;
#pragma unroll
      for (int i = 0; i < 16; ++i) { const float p = s0[i] > -1e29f ? __builtin_amdgcn_exp2f(fmaf(s0[i], LOG2E, mc)) : 0.f; s0[i] = p; ps += p; }
#pragma unroll
      for (int i = 0; i < 16; ++i) { const float p = s1[i] > -1e29f ? __builtin_amdgcn_exp2f(fmaf(s1[i], LOG2E, mc)) : 0.f; s1[i] = p; ps += p; }
      l_run = l_run * alpha + ps;
      if (__any(alpha < 1.0f)) {
#pragma unroll
        for (int vb = 0; vb < 2; ++vb)
#pragma unroll
          for (int i = 0; i < 16; ++i) o[vb][i] *= alpha;
      }
      bf16x8 pf[2][2];
#pragma unroll
      for (int s = 0; s < 2; ++s) {
        u32x4 w0, w1;
        w0.x = cvt_pk_bf16(s0[8 * s + 0], s0[8 * s + 1]); w0.y = cvt_pk_bf16(s0[8 * s + 2], s0[8 * s + 3]); w0.z = cvt_pk_bf16(s0[8 * s + 4], s0[8 * s + 5]); w0.w = cvt_pk_bf16(s0[8 * s + 6], s0[8 * s + 7]);
        w1.x = cvt_pk_bf16(s1[8 * s + 0], s1[8 * s + 1]); w1.y = cvt_pk_bf16(s1[8 * s + 2], s1[8 * s + 3]); w1.z = cvt_pk_bf16(s1[8 * s + 4], s1[8 * s + 5]); w1.w = cvt_pk_bf16(s1[8 * s + 6], s1[8 * s + 7]);
        pf[0][s] = __builtin_bit_cast(bf16x8, w0); pf[1][s] = __builtin_bit_cast(bf16x8, w1);
      }
      const int cbase = local ? (span0 >> 3) : 0;
#pragma unroll
      for (int vb = 0; vb < 2; ++vb) {
        const LAS unsigned char* vrow = vb_ + (vb * 32 + r) * 128;
#pragma unroll
        for (int s = 0; s < 2; ++s) {
          const bf16x8 a = *(const LAS bf16x8*)(vrow + (((cbase + 2 * s + hi) ^ vx) << 4));
          o[vb] = __builtin_amdgcn_mfma_f32_32x32x16_bf16(a, pf[0][s], o[vb], 0, 0, 0);
        }
        if (!local) {
#pragma unroll
          for (int s = 0; s < 2; ++s) {
            const bf16x8 a = *(const LAS bf16x8*)(vrow + (((4 + 2 * s + hi) ^ vx) << 4));
            o[vb] = __builtin_amdgcn_mfma_f32_32x32x16_bf16(a, pf[1][s], o[vb], 0, 0, 0);
          }
        }
      }
    }
    if (more) NA_WRITE((t + 1) & 1);
    __syncthreads();
  }
#undef NA_LOAD
#undef NA_WRITE
  float l_tot; { const u32x2 sw = __builtin_amdgcn_permlane32_swap(__float_as_uint(l_run), __float_as_uint(l_run), false, false); l_tot = __uint_as_float(sw.x) + __uint_as_float(sw.y); }
  const float inv = 1.0f / l_tot;
  bf16_t* op = O + (size_t)qtok * 1024 + h * 64 + 4 * hi;
#pragma unroll
  for (int vb = 0; vb < 2; ++vb)
#pragma unroll
    for (int g = 0; g < 4; ++g) {
      u32x2 w; w.x = cvt_pk_bf16(o[vb][4 * g] * inv, o[vb][4 * g + 1] * inv); w.y = cvt_pk_bf16(o[vb][4 * g + 2] * inv, o[vb][4 * g + 3] * inv);
      *(u32x2*)(op + vb * 32 + 8 * g) = w;
    }
}
}

namespace rw {
using namespace mk;
constexpr int NSTEP = L + T, NCH = 32, CL = NSTEP / NCH;
constexpr int NCHAIN = 2 * B * 8;
constexpr float LOG2E = 1.4426950408889634f;
struct Bufs {
  u32x2* SH;
  unsigned* DR;
  bf16_t* G; int gstride;
  float* CS;
  float* PQ;
  float* SST;
  bf16_t* Y;
  bf16_t* Z;
};

constexpr int XPITCH = 528;
template <int KS> struct LoraW { bf16x8 w[KS][4]; };
template <int KS>
__device__ __forceinline__ void lora_load(const bf16_t* __restrict__ W, int h, int lane, LoraW<KS>& f) {
  const int fr = lane & 15, fq = lane >> 4;
#pragma unroll
  for (int ks = 0; ks < KS; ++ks)
#pragma unroll
    for (int nb = 0; nb < 4; ++nb) f.w[ks][nb] = *(const bf16x8*)(W + (size_t)(h * 64 + nb * 16 + fr) * (KS * 32) + ks * 32 + fq * 8);
}
template <int KS>
__device__ __forceinline__ void lora_mma(const LAS unsigned char* xb, int xcol0, const LoraW<KS>& f, int lane, LAS float* tw, float (&out)[16]) {
  const int fr = lane & 15, fq = lane >> 4;
  f32x4 acc[4];
#pragma unroll
  for (int nb = 0; nb < 4; ++nb) { float z = 0.f; asm volatile("" : "+v"(z)); acc[nb] = (f32x4){z, z, z, z}; }
#pragma unroll
  for (int ks = 0; ks < KS; ++ks) {
    const bf16x8 xf = *(const LAS bf16x8*)(xb + fr * XPITCH + (xcol0 + ks * 32 + fq * 8) * 2);
#pragma unroll
    for (int nb = 0; nb < 4; ++nb) acc[nb] = __builtin_amdgcn_mfma_f32_16x16x32_bf16(xf, f.w[ks][nb], acc[nb], 0, 0, 0);
  }
#pragma unroll
  for (int nb = 0; nb < 4; ++nb) *(LAS f32x4*)(tw + (nb * 16 + fr) * 16 + fq * 4) = acc[nb];
  __builtin_amdgcn_wave_barrier(); asm volatile("s_waitcnt lgkmcnt(0)" ::: "memory"); __builtin_amdgcn_wave_barrier();
#pragma unroll
  for (int q = 0; q < 4; ++q) { const f32x4 v = *(const LAS f32x4*)(tw + lane * 16 + q * 4); out[q * 4] = v[0]; out[q * 4 + 1] = v[1]; out[q * 4 + 2] = v[2]; out[q * 4 + 3] = v[3]; }
  __builtin_amdgcn_wave_barrier(); asm volatile("s_waitcnt lgkmcnt(0)" ::: "memory"); __builtin_amdgcn_wave_barrier();
}
__device__ __forceinline__ void prep_tile(const bf16_t* __restrict__ Prw, const float* __restrict__ cw, const float* __restrict__ w0, const bf16_t* __restrict__ WLT, const float* __restrict__ a0,
                                          const float* __restrict__ k_k, const float* __restrict__ k_a, const float* __restrict__ r_k,
                                          const Bufs& bf, int tile, LAS float* xs  ) {
  const int c = mk::otid(), lane = c & 63, h = c >> 6;
  const int row0 = tile * 16;
  int lo, hi;
  if (row0 < NLAT) { lo = (row0 / T) * T; hi = lo + T - 1; } else { lo = NLAT + ((row0 - NLAT) / L) * L; hi = lo + L - 1; }
  bf16_t rraw[18], kraw[18], vraw[18];
#pragma unroll
  for (int j = 0; j < 18; ++j) { int rr_ = row0 - 1 + j; rr_ = rr_ < lo ? lo : (rr_ > hi ? hi : rr_); const bf16_t* q = Prw + (size_t)rr_ * RW_IN + c; rraw[j] = q[0]; kraw[j] = q[512]; vraw[j] = q[1024]; }
  LoraW<2> wd0, wd1; LoraW<4> wg;
  lora_load<2>(WLT, h, lane, wd0); lora_load<2>(WLT + 32768, h, lane, wd1);
#define RW_CONV(dst, col) do { const float c0 = cw[(col)], c1 = cw[RW_IN + (col)], c2 = cw[2 * RW_IN + (col)]; const bf16_t* p = Prw + (col); \
    bf16_t raw[18]; \
    _Pragma("unroll") for (int j = 0; j < 18; ++j) { int rr = row0 - 1 + j; rr = rr < lo ? lo : (rr > hi ? hi : rr); raw[j] = p[(size_t)rr * RW_IN]; } \
    float pm = bf2f(raw[0]) * (row0 > lo ? 1.0f : 0.0f), pc = bf2f(raw[1]);     \
    _Pragma("unroll") for (int tt = 0; tt < 16; ++tt) { const float pn = (row0 + tt + 1 <= hi) ? bf2f(raw[tt + 2]) : 0.f; dst[tt] = pm * c0 + pc * c1 + pn * c2; pm = pc; pc = pn; } } while (0)
  if (c < 256) {
    float xv[16]; RW_CONV(xv, 1536 + c);
#pragma unroll
    for (int tt = 0; tt < 16; ++tt) { float v = xv[tt]; if (c < 64) v = 2.0f * sigmoid_r(2.0f * v) - 1.0f; else if (c >= 128) v = sigmoid_r(v);     *(LAS bf16_t*)((LAS unsigned char*)xs + tt * XPITCH + c * 2) = f2bf(v); }
  }
  __syncthreads();
  const LAS unsigned char* xb = (const LAS unsigned char*)xs; LAS float* tw = xs + 20480 + h * 1024;
  const float w00 = w0[c], w01 = w0[512 + c], a00 = a0[c], a01 = a0[512 + c], kkc = k_k[c], kac = k_a[c], rkc = r_k[c];
  float e0[16], e1[16];
  {
    float aw0[16], aw1[16];
    lora_mma<2>(xb, 0, wd0, lane, tw, aw0); lora_mma<2>(xb, 0, wd1, lane, tw, aw1);
    lora_load<2>(WLT + 2 * 32768, h, lane, wd0); lora_load<2>(WLT + 3 * 32768, h, lane, wd1);
#pragma unroll
    for (int tt = 0; tt < 16; ++tt) {
      e0[tt] = 0.6065306597126334f * __builtin_amdgcn_rcpf(1.0f + __expf(-(w00 + aw0[tt])));
      e1[tt] = 0.6065306597126334f * __builtin_amdgcn_rcpf(1.0f + __expf(-(w01 + aw1[tt])));
    }
  }
  LAS float* asl = xs + 256 * 16;
  {
    float aa0[16], aa1[16];
    lora_mma<2>(xb, 64, wd0, lane, tw, aa0); lora_mma<2>(xb, 64, wd1, lane, tw, aa1);
    lora_load<4>(WLT + 4 * 32768, h, lane, wg);
#pragma unroll
    for (int tt = 0; tt < 16; ++tt) { const unsigned d0 = cvt_pk_bf16(e0[tt], sigmoid_r(a00 + aa0[tt])), d1 = cvt_pk_bf16(e1[tt], sigmoid_r(a01 + aa1[tt]));
      bf.DR[((size_t)(row0 + tt)) * 512 + c] = d0; bf.DR[((size_t)NTOK + row0 + tt) * 512 + c] = d1; asl[tt * 512 + c] = bfhi(d0); asl[(16 + tt) * 512 + c] = bfhi(d1); }
  }
  {
    float ag[16];
    lora_mma<4>(xb, 128, wg, lane, tw, ag);
#pragma unroll
    for (int tt = 0; tt < 16; ++tt) bf.G[(size_t)(row0 + tt) * bf.gstride + c] = f2bf(ag[tt]);
  }
#undef RW_CONV
  const float cr0 = cw[c], cr1 = cw[RW_IN + c], cr2 = cw[2 * RW_IN + c], ck0 = cw[512 + c], ck1 = cw[RW_IN + 512 + c], ck2 = cw[2 * RW_IN + 512 + c], cv0 = cw[1024 + c], cv1 = cw[RW_IN + 1024 + c], cv2 = cw[2 * RW_IN + 1024 + c];
  const float m0f = row0 > lo ? 1.0f : 0.0f;
  float rm = bf2f(rraw[0]) * m0f, km = bf2f(kraw[0]) * m0f, vm = bf2f(vraw[0]) * m0f;
  float rc = bf2f(rraw[1]), kc = bf2f(kraw[1]), vc = bf2f(vraw[1]);
  float rvv[16], kvvv[16], vvvv[16], q1[16];
#pragma unroll
  for (int tt = 0; tt < 16; ++tt) {
    const bool has_n = row0 + tt + 1 <= hi;
    const float rn = has_n ? bf2f(rraw[tt + 2]) : 0.f, kn = has_n ? bf2f(kraw[tt + 2]) : 0.f, vn = has_n ? bf2f(vraw[tt + 2]) : 0.f;
    rvv[tt] = rm * cr0 + rc * cr1 + rn * cr2; kvvv[tt] = km * ck0 + kc * ck1 + kn * ck2; vvvv[tt] = vm * cv0 + vc * cv1 + vn * cv2;
    rm = rc; rc = rn; km = kc; kc = kn; vm = vc; vc = vn;
    const float kk = kvvv[tt] * kkc; q1[tt] = kk * kk;
  }
  const float nrm2 = reduce_scatter16(q1, lane);
  float c0p[16], c1p[16];
#pragma unroll
  for (int tt = 0; tt < 16; ++tt) {
    const int row = row0 + tt;
    const float nrm = sqrtf(__uint_as_float(__builtin_amdgcn_readlane(__float_as_uint(nrm2), 4 * tt)));
    const float kk = kvvv[tt] * kkc * __builtin_amdgcn_rcpf(fmaxf(nrm, 1e-12f));
    u32x2 sh; sh.x = cvt_pk_bf16(rvv[tt], kvvv[tt]); sh.y = cvt_pk_bf16(kk, vvvv[tt]);
    bf.SH[(size_t)row * 512 + c] = sh;
    const float rq = bflo(sh.x), kq = bfhi(sh.x);
    c0p[tt] = rq * kq * (1.0f + (asl[tt * 512 + c] - 1.0f) * kac) * rkc; c1p[tt] = rq * kq * (1.0f + (asl[(16 + tt) * 512 + c] - 1.0f) * kac) * rkc;
  }
  const float cb0 = reduce_scatter16(c0p, lane), cb1 = reduce_scatter16(c1p, lane);
  if ((lane & 3) == 0) { const int row = row0 + (lane >> 2); bf.CS[(size_t)row * 16 + h] = cb0; bf.CS[(size_t)row * 16 + 8 + h] = cb1; }
  __syncthreads();
}

struct StepRaw { u32x2 s; unsigned d; };
__device__ __forceinline__ int scan_row(int dir, int b, int p) {
  if (p < L) return NLAT + b * L + (dir ? (L - 1 - p) : p);
  const int q = p - L; return b * T + (dir ? (T - 1 - q) : q);
}
__device__ __forceinline__ void scan_unit(const Bufs& bf, const float* __restrict__ k_a, int chain, int chunk, LAS float* wl) {
  const int lane = mk::otid() & 63, r = lane & 31, hi = lane >> 5;
  const int dir = chain >> 5, b = (chain >> 3) & 3, h = chain & 7, ch = h * 64 + lane;
  const float kac = k_a[ch];
  f32x16 TS[2][2], TP[2][2];
#pragma unroll
  for (int rb = 0; rb < 2; ++rb)
#pragma unroll
    for (int cb = 0; cb < 2; ++cb)
#pragma unroll
      for (int q = 0; q < 16; ++q) { TS[rb][cb][q] = 0.f; TP[rb][cb][q] = (32 * rb + (q & 3) + 8 * (q >> 2) + 4 * hi == 32 * cb + r) ? 1.f : 0.f; }
  LAS unsigned char* wb = (LAS unsigned char*)wl;
  const LAS unsigned char* xrow = wb + (lane & 15) * 128 + 8 * hi;
  LAS float* Gl = wl + 1024;
  const int p0 = chunk * CL;
  float Dl = 1.f;
#define RW_FRAG(base, rb, s2) ([&]() { const u32x2 lo_ = *(const LAS u32x2*)((base) + (32 * (rb) + 16 * (s2)) * 2), hi_ = *(const LAS u32x2*)((base) + (32 * (rb) + 16 * (s2) + 8) * 2); \
      return __builtin_bit_cast(bf16x8, (u32x4){lo_.x, lo_.y, hi_.x, hi_.y}); }())
#define RW_DOTS(T, o) do { _Pragma("unroll") for (int cb = 0; cb < 2; ++cb) _Pragma("unroll") for (int q = 0; q < 16; ++q) o[cb][q] = 0.f; \
    _Pragma("unroll") for (int rb = 0; rb < 2; ++rb) _Pragma("unroll") for (int s2 = 0; s2 < 2; ++s2) _Pragma("unroll") for (int cb = 0; cb < 2; ++cb) { u32x4 w_; \
      w_.x = cvt_pk_bf16(T[rb][cb][8 * s2 + 0], T[rb][cb][8 * s2 + 1]); w_.y = cvt_pk_bf16(T[rb][cb][8 * s2 + 2], T[rb][cb][8 * s2 + 3]); \
      w_.z = cvt_pk_bf16(T[rb][cb][8 * s2 + 4], T[rb][cb][8 * s2 + 5]); w_.w = cvt_pk_bf16(T[rb][cb][8 * s2 + 6], T[rb][cb][8 * s2 + 7]); \
      o[cb] = __builtin_amdgcn_mfma_f32_32x32x16_bf16(xf[rb][s2], __builtin_bit_cast(bf16x8, w_), o[cb], 0, 0, 0); \
      asm volatile("" : "+v"(o[cb]) : "v"(w_), "v"(xf[rb][s2]));   } } while (0)
#define RW_RENORM() do { wl[1280 + lane] = Dl; __builtin_amdgcn_wave_barrier(); \
    _Pragma("unroll") for (int rb = 0; rb < 2; ++rb) _Pragma("unroll") for (int g = 0; g < 4; ++g) { const f32x4 w4 = *(const LAS f32x4*)(wl + 1280 + 32 * rb + 8 * g + 4 * hi); \
      _Pragma("unroll") for (int cb = 0; cb < 2; ++cb) _Pragma("unroll") for (int u = 0; u < 4; ++u) { TS[rb][cb][4 * g + u] *= w4[u]; TP[rb][cb][4 * g + u] *= w4[u]; } } \
    __builtin_amdgcn_wave_barrier(); Dl = 1.f; } while (0)
  const int wvs = __builtin_amdgcn_readfirstlane((int)((size_t)wl));
#define RW_FETCH(tb) do { _Pragma("unroll") for (int u = 0; u < 8; ++u) { const int pn = (tb) + u < CL ? (tb) + u : CL - 1; const int row = scan_row(dir, b, p0 + pn); \
      const unsigned* gs = (const unsigned*)(bf.SH + (size_t)row * 512 + ch); const unsigned* gd = bf.DR + ((size_t)dir * NTOK + row) * 512 + ch; LAS unsigned* ld = (LAS unsigned*)(size_t)(wvs + 8192 + u * 768); \
      __builtin_amdgcn_global_load_lds(gs, ld, 4, 0, 0); __builtin_amdgcn_global_load_lds(gs + 1, ld + 64, 4, 0, 0); __builtin_amdgcn_global_load_lds(gd, ld + 128, 4, 0, 0); } } while (0)
  RW_FETCH(0);
  for (int t0 = 0; t0 < CL; t0 += 8) {
    asm volatile("s_waitcnt vmcnt(0)" ::: "memory");
    __builtin_amdgcn_wave_barrier();
#pragma unroll
    for (int u = 0; u < 8; ++u) {
      const LAS unsigned* ld = (const LAS unsigned*)(wb + 8192 + u * 768) + lane; const unsigned sx = ld[0], sy = ld[64], dd = ld[128];
      const float rr = bflo(sx), k = bfhi(sx), kk = bflo(sy), e = bflo(dd), asg = bfhi(dd);
      const float w = __builtin_amdgcn_exp2f(-e * LOG2E), keff = k * (1.0f + (asg - 1.0f) * kac);
      ((LAS bf16_t*)wb)[u * 64 + lane] = f2bf(-kk * Dl);
      Dl *= w; const float dinv = __builtin_amdgcn_rcpf(Dl);
      ((LAS bf16_t*)wb)[(8 + u) * 64 + lane] = f2bf(rr * Dl);
      ((LAS bf16_t*)wb)[1024 + u * 64 + lane] = f2bf(kk * asg * dinv); ((LAS bf16_t*)wb)[1024 + (8 + u) * 64 + lane] = f2bf(keff * dinv);
      ((LAS bf16_t*)wb)[3072 + u * 64 + lane] = (bf16_t)(sy >> 16);
    }
    asm volatile("s_waitcnt lgkmcnt(0)" ::: "memory");
    __builtin_amdgcn_wave_barrier();
    RW_FETCH(t0 + 8);
    __builtin_amdgcn_wave_barrier();
    bf16x8 xf[2][2];
#pragma unroll
    for (int rb = 0; rb < 2; ++rb)
#pragma unroll
      for (int s2 = 0; s2 < 2; ++s2) xf[rb][s2] = RW_FRAG(xrow, rb, s2);
    { f32x16 gm;
#pragma unroll
      for (int q = 0; q < 16; ++q) gm[q] = 0.f;
#pragma unroll
      for (int rb = 0; rb < 2; ++rb)
#pragma unroll
        for (int s2 = 0; s2 < 2; ++s2) { const bf16x8 yf = RW_FRAG(xrow + 2048, rb, s2); gm = __builtin_amdgcn_mfma_f32_32x32x16_bf16(xf[rb][s2], yf, gm, 0, 0, 0); asm volatile("" : "+v"(gm) : "v"(yf), "v"(xf[rb][s2])); }
      if (r < 16) {
#pragma unroll
        for (int q = 0; q < 8; ++q) Gl[((q & 3) + 8 * (q >> 2) + 4 * hi) * 16 + r] = gm[q]; }
    }
    float sa[2][8], yy[2][8];
    { f32x16 oS[2], oP[2];
      RW_DOTS(TS, oS); RW_DOTS(TP, oP);
#pragma unroll
      for (int cb = 0; cb < 2; ++cb)
#pragma unroll
        for (int q = 0; q < 4; ++q) {
          { const u32x2 sw = __builtin_amdgcn_permlane32_swap(__float_as_uint(oS[cb][q]), __float_as_uint(oP[cb][q]), false, false); sa[cb][q] = __uint_as_float(sw.x); sa[cb][4 + q] = __uint_as_float(sw.y); }
          { const u32x2 sw = __builtin_amdgcn_permlane32_swap(__float_as_uint(oS[cb][4 + q]), __float_as_uint(oP[cb][4 + q]), false, false); yy[cb][q] = __uint_as_float(sw.x); yy[cb][4 + q] = __uint_as_float(sw.y); } }
    }
    __builtin_amdgcn_wave_barrier();
    float vm[2][8];
#pragma unroll
    for (int u = 0; u < 8; ++u) { const LAS bf16_t* vr = (const LAS bf16_t*)wb + 3072 + u * 64 + r; vm[0][u] = hi ? 0.f : bf2f(vr[0]); vm[1][u] = hi ? 0.f : bf2f(vr[32]); }
#pragma unroll
    for (int s = 0; s < 8; ++s) {
      const f32x4 ga0 = *(const LAS f32x4*)(Gl + s * 16), ga1 = *(const LAS f32x4*)(Gl + s * 16 + 4), ga2 = *(const LAS f32x4*)(Gl + s * 16 + 8), ga3 = *(const LAS f32x4*)(Gl + s * 16 + 12);
      const f32x4 gr0 = *(const LAS f32x4*)(Gl + (8 + s) * 16), gr1 = *(const LAS f32x4*)(Gl + (8 + s) * 16 + 4), gr2 = *(const LAS f32x4*)(Gl + (8 + s) * 16 + 8), gr3 = *(const LAS f32x4*)(Gl + (8 + s) * 16 + 12);
      const float gab[8] = {ga0[0], ga0[1], ga0[2], ga0[3], ga1[0], ga1[1], ga1[2], ga1[3]}, gak[8] = {ga2[0], ga2[1], ga2[2], ga2[3], ga3[0], ga3[1], ga3[2], ga3[3]};
      const float grb[8] = {gr0[0], gr0[1], gr0[2], gr0[3], gr1[0], gr1[1], gr1[2], gr1[3]}, grk[8] = {gr2[0], gr2[1], gr2[2], gr2[3], gr3[0], gr3[1], gr3[2], gr3[3]};
#pragma unroll
      for (int cb = 0; cb < 2; ++cb) {
        float x = sa[cb][s], y = yy[cb][s];
#pragma unroll
        for (int u = 0; u < 8; ++u) { if (u < s) { x = fmaf(gab[u], sa[cb][u], x); x = fmaf(gak[u], vm[cb][u], x); } }
        sa[cb][s] = x;
#pragma unroll
        for (int u = 0; u < 8; ++u) { if (u <= s) { y = fmaf(grb[u], sa[cb][u], y); y = fmaf(grk[u], vm[cb][u], y); } }
        yy[cb][s] = y;
      }
    }
    { bf16_t* yz = hi ? bf.Z : bf.Y;
#pragma unroll
      for (int s = 0; s < 8; ++s) { const size_t oi = ((size_t)dir * NTOK + scan_row(dir, b, p0 + t0 + s)) * 512 + h * 64 + r; yz[oi] = f2bf(yy[0][s]); yz[oi + 32] = f2bf(yy[1][s]); } }
    { bf16x8 au[2], buS[2], buP[2];
      u32x4 a0, a1, s0, s1, p0_, p1_;
#pragma unroll
      for (int q = 0; q < 4; ++q) {
        const int u = 4 * hi + q;
        const LAS bf16_t* yb = (const LAS bf16_t*)wb + 1024 + u * 64 + r; const LAS bf16_t* vr = (const LAS bf16_t*)wb + 3072 + u * 64 + r;
        a0[q] = (unsigned)yb[0] | ((unsigned)yb[512] << 16); a1[q] = (unsigned)yb[32] | ((unsigned)yb[512 + 32] << 16);
        const u32x2 sw0 = __builtin_amdgcn_permlane32_swap(__float_as_uint(sa[0][q]), __float_as_uint(sa[0][4 + q]), false, false), sw1 = __builtin_amdgcn_permlane32_swap(__float_as_uint(sa[1][q]), __float_as_uint(sa[1][4 + q]), false, false);
        s0[q] = (cvt_pk_bf16(__uint_as_float(sw0.x), 0.f) & 0xffffu) | ((unsigned)vr[0] << 16); s1[q] = (cvt_pk_bf16(__uint_as_float(sw1.x), 0.f) & 0xffffu) | ((unsigned)vr[32] << 16);
        p0_[q] = cvt_pk_bf16(__uint_as_float(sw0.y), 0.f); p1_[q] = cvt_pk_bf16(__uint_as_float(sw1.y), 0.f); }
      au[0] = __builtin_bit_cast(bf16x8, a0); au[1] = __builtin_bit_cast(bf16x8, a1); buS[0] = __builtin_bit_cast(bf16x8, s0); buS[1] = __builtin_bit_cast(bf16x8, s1); buP[0] = __builtin_bit_cast(bf16x8, p0_); buP[1] = __builtin_bit_cast(bf16x8, p1_);
#pragma unroll
      for (int rb = 0; rb < 2; ++rb)
#pragma unroll
        for (int cb = 0; cb < 2; ++cb) { TS[rb][cb] = __builtin_amdgcn_mfma_f32_32x32x16_bf16(au[rb], buS[cb], TS[rb][cb], 0, 0, 0); TP[rb][cb] = __builtin_amdgcn_mfma_f32_32x32x16_bf16(au[rb], buP[cb], TP[rb][cb], 0, 0, 0); }
    }
    __builtin_amdgcn_wave_barrier();
    if ((t0 & 31) == 24) RW_RENORM();
  }
  RW_RENORM();
#undef RW_DOTS
#undef RW_FRAG
#undef RW_RENORM
#undef RW_FETCH
  asm volatile("s_waitcnt vmcnt(0)" ::: "memory");
  if (chunk < NCH - 1) {
    float* pq = bf.PQ + (((size_t)chain * (NCH - 1) + chunk) * 2) * 4096;
#pragma unroll
    for (int rb = 0; rb < 2; ++rb)
#pragma unroll
      for (int cb = 0; cb < 2; ++cb)
#pragma unroll
        for (int g = 0; g < 4; ++g) { float* q = pq + (size_t)(32 * cb + r) * 64 + 32 * rb + 8 * g + 4 * hi;
          *(f32x4*)q = (f32x4){TP[rb][cb][4 * g], TP[rb][cb][4 * g + 1], TP[rb][cb][4 * g + 2], TP[rb][cb][4 * g + 3]};
          *(f32x4*)(q + 4096) = (f32x4){TS[rb][cb][4 * g], TS[rb][cb][4 * g + 1], TS[rb][cb][4 * g + 2], TS[rb][cb][4 * g + 3]}; }
  }
}

__device__ __forceinline__ void propagate_chain(const Bufs& bf, int chain, int rq, LAS float* lds) {
  LAS float* Sl = lds; LAS float* Pl = lds + 16 * 65 + 15;
  Pl = lds + 1056;
  const int tid = mk::otid(), i = tid >> 5, jc = (tid & 31) * 2, row = rq * 16 + i, pi = tid >> 3, pj = (tid & 7) * 8;
  float* sst = bf.SST + (size_t)chain * NCH * 4096;
  Sl[i * 65 + jc] = 0.f; Sl[i * 65 + jc + 1] = 0.f;
  const float* pb = bf.PQ + ((size_t)chain * (NCH - 1) * 2) * 4096;
  f32x4 np0 = *(const f32x4*)(pb + pi * 64 + pj), np1 = *(const f32x4*)(pb + pi * 64 + pj + 4); f32x2 nq = *(const f32x2*)(pb + 4096 + row * 64 + jc);
  for (int c = 0; c < NCH - 1; ++c) {
    const f32x4 p0 = np0, p1 = np1; f32x2 q = nq;
    { const float* pn = pb + (size_t)(c + 1 < NCH - 1 ? c + 1 : c) * 2 * 4096;
      np0 = *(const f32x4*)(pn + pi * 64 + pj); np1 = *(const f32x4*)(pn + pi * 64 + pj + 4); nq = *(const f32x2*)(pn + 4096 + row * 64 + jc); }
    *(LAS f32x4*)(Pl + pi * 64 + pj) = p0; *(LAS f32x4*)(Pl + pi * 64 + pj + 4) = p1;
    __syncthreads();
#pragma unroll 16
    for (int k = 0; k < 64; ++k) { const float sv = Sl[i * 65 + k]; const f32x2 a = *(const LAS f32x2*)(Pl + k * 64 + jc); q += sv * a; }
    __syncthreads();
    Sl[i * 65 + jc] = q[0]; Sl[i * 65 + jc + 1] = q[1];
    *(f32x2*)(sst + (size_t)(c + 1) * 4096 + row * 64 + jc) = q;
  }
  __syncthreads();
}

__device__ __forceinline__ void corr_unit(const Bufs& bf, int chain, int chunk) {
  const int lane = mk::otid() & 63, r = lane & 31, hi = lane >> 5;
  const int dir = chain >> 5, b = (chain >> 3) & 3, h = chain & 7;
  const float* ss = bf.SST + ((size_t)chain * NCH + chunk) * 4096;
  bf16x8 bfr[2][4];
#pragma unroll
  for (int nt = 0; nt < 2; ++nt)
#pragma unroll
    for (int ks = 0; ks < 4; ++ks) { const float* q = ss + (size_t)(nt * 32 + r) * 64 + ks * 16 + hi * 8; const f32x4 x0 = *(const f32x4*)q, x1 = *(const f32x4*)(q + 4);
      u32x4 w; w.x = cvt_pk_bf16(x0[0], x0[1]); w.y = cvt_pk_bf16(x0[2], x0[3]); w.z = cvt_pk_bf16(x1[0], x1[1]); w.w = cvt_pk_bf16(x1[2], x1[3]); bfr[nt][ks] = __builtin_bit_cast(bf16x8, w); }
  const int p0 = chunk * CL;
  const size_t dbase = (size_t)dir * NTOK;
  for (int mt = 0; mt < (CL + 31) / 32; ++mt) {
    const int sa_ = min(mt * 32 + r, CL - 1);
    const bf16_t* zp = bf.Z + (dbase + scan_row(dir, b, p0 + sa_)) * 512 + h * 64 + hi * 8;
    bf16x8 af[4];
#pragma unroll
    for (int ks = 0; ks < 4; ++ks) af[ks] = *(const bf16x8*)(zp + ks * 16);
    bf16_t yo0[16], yo1[16];
#pragma unroll
    for (int i = 0; i < 16; ++i) { const int so = min(mt * 32 + (i & 3) + 8 * (i >> 2) + 4 * hi, CL - 1); const bf16_t* yp = bf.Y + (dbase + scan_row(dir, b, p0 + so)) * 512 + h * 64 + r; yo0[i] = yp[0]; yo1[i] = yp[32]; }
    f32x16 acc[2];
#pragma unroll
    for (int nt = 0; nt < 2; ++nt) { acc[nt] = zero16();
#pragma unroll
      for (int ks = 0; ks < 4; ++ks) acc[nt] = __builtin_amdgcn_mfma_f32_32x32x16_bf16(af[ks], bfr[nt][ks], acc[nt], 0, 0, 0); }
#pragma unroll
    for (int i = 0; i < 16; ++i) { const int so = mt * 32 + (i & 3) + 8 * (i >> 2) + 4 * hi;
      if (so < CL) { bf16_t* yp = bf.Y + (dbase + scan_row(dir, b, p0 + so)) * 512 + h * 64 + r;
        yp[0] = f2bf(bf2f(yo0[i]) + acc[0][i]); yp[32] = f2bf(bf2f(yo1[i]) + acc[1][i]); } }
  }
}

template <int NR> struct FinRaw { bf16_t y0[NR], y1[NR], g[NR]; unsigned v[NR]; float c0[NR], c1[NR]; };
template <int NR>
__device__ __forceinline__ void finish_load(const Bufs& bf, int row0, int c, int h, FinRaw<NR>& q) {
#pragma unroll
  for (int i = 0; i < NR; ++i) { const int row = row0 + i;
    q.y0[i] = bf.Y[(size_t)row * 512 + c]; q.y1[i] = bf.Y[((size_t)NTOK + row) * 512 + c];
    q.v[i] = bf.SH[(size_t)row * 512 + c].y; q.g[i] = bf.G[(size_t)row * bf.gstride + c];
    q.c0[i] = bf.CS[(size_t)row * 16 + h]; q.c1[i] = bf.CS[(size_t)row * 16 + 8 + h]; }
}
template <int NR>
__device__ __forceinline__ void finish_phase(const Bufs& bf, const float* __restrict__ gn_g, const float* __restrict__ gn_b, bf16_t* __restrict__ O) {
  const int c = mk::otid(), h = c >> 6, stride = gridDim.x * NR;
  const float gg = gn_g[c], gb = gn_b[c];
  int row0 = mk::obid() * NR;
  if (row0 >= NTOK) return;
  FinRaw<NR> cur, nxt; finish_load<NR>(bf, row0, c, h, cur);
  for (; row0 < NTOK; row0 += stride) {
    const int rn = row0 + stride < NTOK ? row0 + stride : row0;
    finish_load<NR>(bf, rn, c, h, nxt);
    float o[NR];
    if constexpr (NR == 8) {
      float mom[16], yv[8];
#pragma unroll
      for (int i = 0; i < 8; ++i) { yv[i] = bf2f(cur.y0[i]) + bf2f(cur.y1[i]); mom[i] = yv[i]; mom[8 + i] = yv[i] * yv[i]; }
      const float tot = reduce_scatter16(mom, c & 63);
#pragma unroll
      for (int i = 0; i < 8; ++i) { const float mu = __uint_as_float(__builtin_amdgcn_readlane(__float_as_uint(tot), 4 * i)) * (1.0f / 64.0f), m2 = __uint_as_float(__builtin_amdgcn_readlane(__float_as_uint(tot), 32 + 4 * i)) * (1.0f / 64.0f);
        const float var = fmaxf(m2 - mu * mu, 0.f);
        o[i] = ((yv[i] - mu) * rsqrtf(var + 64e-5f) * gg + gb + (cur.c0[i] + cur.c1[i]) * bfhi(cur.v[i])) * bf2f(cur.g[i]); }
    } else {
#pragma unroll
    for (int i = 0; i < NR; ++i) { const float y = bf2f(cur.y0[i]) + bf2f(cur.y1[i]);
      const float mu = wave_sum_u(y) * (1.0f / 64.0f); const float dv = y - mu; const float var = wave_sum_u(dv * dv) * (1.0f / 64.0f);
      o[i] = (dv * rsqrtf(var + 64e-5f) * gg + gb + (cur.c0[i] + cur.c1[i]) * bfhi(cur.v[i])) * bf2f(cur.g[i]); }
    }
#pragma unroll
    for (int i = 0; i < NR; ++i) O[(size_t)(row0 + i) * 1024 + 512 + c] = f2bf(o[i]);
    cur = nxt;
  }
}
}

namespace mk {
constexpr size_t al256(size_t x) { return (x + 255) / 256 * 256; }
constexpr size_t WS_BAR = 0;
constexpr size_t WS_BCNT = al256(WS_BAR + (size_t)XCD_BAR_WORDS * 4);
constexpr size_t WS_MOFF = al256(WS_BCNT + (size_t)4 * 256 * 64 * 4);
constexpr size_t WS_KN = al256(WS_MOFF + 4 * 256);
constexpr size_t WS_MOD = al256(WS_KN + (size_t)2 * 256 * 32 * 4);
constexpr size_t WS_ROPE = al256(WS_MOD + (size_t)4 * 5 * 6144 * 4);
constexpr size_t WS_HBC = al256(WS_ROPE + 128 * 16 * 2 * 4);
constexpr size_t WS_EID = al256(WS_HBC + (size_t)NCTX * D * 2);
constexpr size_t WS_GATE = al256(WS_EID + (size_t)NTOK * 2 * 4);
constexpr size_t WS_POS = al256(WS_GATE + (size_t)NTOK * 2 * 4);
constexpr size_t WS_RL = al256(WS_POS + (size_t)NTOK * 2 * 4);
constexpr size_t WS_WEIN = al256(WS_RL + (size_t)MOE_ROWS * 4);
constexpr size_t WS_WOIN = al256(WS_WEIN + (size_t)2 * EVEN_IN * D * 2);
constexpr size_t WS_WEOUT = al256(WS_WOIN + (size_t)2 * ODD_IN * D * 2);
constexpr size_t WS_WOOUT = al256(WS_WEOUT + (size_t)2 * D * D * 2);
constexpr size_t WS_WGU = al256(WS_WOOUT + (size_t)2 * D * D * 2);
constexpr size_t WS_WDN = al256(WS_WGU + (size_t)NE * 1024 * D * 2);
constexpr size_t WS_WLT = al256(WS_WDN + (size_t)NE * D * DE * 2);
constexpr size_t WS_UO = al256(WS_WLT + (size_t)2 * 196608 * 2);
constexpr size_t WS_SCR = al256(WS_UO + (size_t)NTOK * D * 2);
constexpr size_t SE_PQK = 0;
constexpr size_t SE_VT = al256(SE_PQK + (size_t)NTOK * 1024 * 2);
constexpr size_t SE_PRW = al256(SE_VT + (size_t)512 * NTOK * 2);
constexpr size_t SE_PQ = 0;
constexpr size_t SE_SST = al256(SE_PQ + (size_t)rw::NCHAIN * (rw::NCH - 1) * 2 * 4096 * 4);
constexpr size_t SE_Y = al256(SE_SST + (size_t)rw::NCHAIN * rw::NCH * 4096 * 4);
constexpr size_t SE_Z = al256(SE_Y + (size_t)2 * NTOK * 512 * 2);
constexpr size_t SE_ZEND = al256(SE_Z + (size_t)2 * NTOK * 512 * 2);
constexpr size_t SE_PRWEND = al256(SE_PRW + (size_t)NTOK * RW_IN * 2);
constexpr size_t SE_SH = SE_PRWEND > SE_ZEND ? SE_PRWEND : SE_ZEND;
constexpr size_t SE_DR = al256(SE_SH + (size_t)NTOK * 512 * 8);
constexpr size_t SE_CS = al256(SE_DR + (size_t)2 * NTOK * 512 * 4);
constexpr size_t SE_END = al256(SE_CS + (size_t)2 * NTOK * 16 * 4);
constexpr size_t SE_YBUF = 0;
constexpr size_t SO_PQK = 0;
constexpr size_t SO_VT = al256(SO_PQK + (size_t)NTOK * 2048 * 2);
constexpr size_t SO_O12 = al256(SO_VT + (size_t)1024 * NTOK * 2);
constexpr size_t SO_END = al256(SO_O12 + (size_t)NTOK * 2048 * 2);
constexpr size_t SO_YBUF = 0;
constexpr size_t SM_XS = 0;
constexpr size_t SM_HE = al256(SM_XS + (size_t)MOE_ROWS * D * 2);
constexpr size_t SM_YS = al256(SM_HE + (size_t)MOE_ROWS * DE * 2);
constexpr size_t SM_END = al256(SM_YS + (size_t)MOE_ROWS * D * 2);
constexpr size_t SCR_BYTES = SE_END > SO_END ? (SE_END > SM_END ? SE_END : SM_END) : (SO_END > SM_END ? SO_END : SM_END);
constexpr size_t WS_END = WS_SCR + SCR_BYTES;
constexpr int LDS_BARW = 131072;
constexpr int LDS_MISC = 131072 + 64;

struct Params {
  const float *x, *c, *ctx, *c_ctx, *ada_w, *ada_b, *ln_g, *ln_b, *even_w_in, *even_w_out, *shift_w, *na_rpb, *rw_w0, *rw_w_up, *rw_a0, *rw_a_up, *rw_g_up, *rw_k_k, *rw_k_a, *rw_r_k,
      *rw_gn_g, *rw_gn_b, *odd_w_in, *odd_w_out, *da_lq1, *da_lk1, *da_lq2, *da_lk2, *da_subln_g, *router_w, *router_b, *exp_w_gate, *exp_w_up, *exp_w_down;
  float* out; unsigned char* ws; int ph_lo, ph_hi;
};
template <class Tp> __device__ __forceinline__ Tp* wsp(const Params& p, size_t off) { return (Tp*)(p.ws + off); }

__device__ __forceinline__ void ada_unit(const Params& p, int u, LAS float* lds) {
  LAS float* sc = lds; LAS float* red = lds + 5 * 1024;
  const int tid = mk::otid(), l = u / 96, n = (u % 96) * 64 + (tid & 63), kp = tid >> 6;
  for (int i = tid; i < 5 * 1024; i += NTHR) { const float v = i < 4096 ? p.c[i] : p.c_ctx[i - 4096]; sc[i] = siluf_(v); }
  __syncthreads();
  float a[5] = {0.f, 0.f, 0.f, 0.f, 0.f};
  const float* w = p.ada_w + ((size_t)l * D + kp * 128) * 6144 + n;
#pragma unroll 4
  for (int k = 0; k < 128; ++k) { const float wv = w[(size_t)k * 6144]; const int kk = kp * 128 + k;
#pragma unroll
    for (int r = 0; r < 5; ++r) a[r] = fmaf(sc[r * 1024 + kk], wv, a[r]); }
#pragma unroll
  for (int r = 0; r < 5; ++r) red[(kp * 5 + r) * 64 + (tid & 63)] = a[r];
  __syncthreads();
  if (tid < 320) { const int r = tid >> 6, nn = tid & 63; float s = 0.f;
#pragma unroll
    for (int q = 0; q < 8; ++q) s += red[(q * 5 + r) * 64 + nn];
    const int col = (u % 96) * 64 + nn;
    wsp<float>(p, WS_MOD)[((size_t)l * 5 + r) * 6144 + col] = s + p.ada_b[l * 6144 + col]; }
  __syncthreads();
}
__device__ __forceinline__ void phase_prologue(const Params& p, LAS unsigned char* lds) {
  const int bid = mk::obid(), nb = gridDim.x; LAS float* tile = (LAS float*)lds;
  int ub = 0;
  for (int i = 0; i < 2; ++i) ub += cvt_matrix(p.even_w_in + (size_t)i * D * EVEN_IN, EVEN_IN, D, EVEN_IN, wsp<bf16_t>(p, WS_WEIN) + (size_t)i * EVEN_IN * D, NMapId{0}, tile, ub, bid, nb);
  for (int i = 0; i < 2; ++i) ub += cvt_matrix(p.odd_w_in + (size_t)i * D * ODD_IN, ODD_IN, D, ODD_IN, wsp<bf16_t>(p, WS_WOIN) + (size_t)i * ODD_IN * D, NMapRope{}, tile, ub, bid, nb);
  for (int i = 0; i < 2; ++i) ub += cvt_matrix(p.even_w_out + (size_t)i * D * D, D, D, D, wsp<bf16_t>(p, WS_WEOUT) + (size_t)i * D * D, NMapId{0}, tile, ub, bid, nb);
  for (int i = 0; i < 2; ++i) ub += cvt_matrix(p.odd_w_out + (size_t)i * D * D, D, D, D, wsp<bf16_t>(p, WS_WOOUT) + (size_t)i * D * D, NMapId{0}, tile, ub, bid, nb);
  for (int i = 0; i < 2; ++i) { bf16_t* wl = wsp<bf16_t>(p, WS_WLT) + (size_t)i * 196608;
    for (int d = 0; d < 2; ++d) { ub += cvt_matrix(p.rw_w_up + (size_t)(i * 2 + d) * 64 * 512, 512, 64, 512, wl + (size_t)d * 32768, NMapId{0}, tile, ub, bid, nb);
      ub += cvt_matrix(p.rw_a_up + (size_t)(i * 2 + d) * 64 * 512, 512, 64, 512, wl + (size_t)(2 + d) * 32768, NMapId{0}, tile, ub, bid, nb); }
    ub += cvt_matrix(p.rw_g_up + (size_t)i * 128 * 512, 512, 128, 512, wl + (size_t)4 * 32768, NMapId{0}, tile, ub, bid, nb); }
  for (int u = (bid + nb - ub % nb) % nb; u < 384; u += nb) ada_unit(p, u, (LAS float*)lds);
  const int gt = bid * NTHR + mk::otid();
  if (gt < 128 * 16) { const int pos = gt >> 4, i = gt & 15; const float inv = exp2f(-(float)i * (13.287712379549449f / 16.0f)); float sn, cs; sincosf((float)pos * inv, &sn, &cs);
    wsp<float>(p, WS_ROPE)[gt * 2] = cs; wsp<float>(p, WS_ROPE)[gt * 2 + 1] = sn; }
}
#define CVT_JOB(u_, src_, dst_, ld_, K_, k0_, n0_, mode_) do { const int e_ = (u_) / 384, rem_ = (u_) % 384, v_ = rem_ & 127; mode_ = rem_ >> 7; const size_t so_ = ((size_t)l * NE + e_) * D * DE; \
    const bool dn_ = mode_ == 2; src_ = (dn_ ? wd_ : (mode_ == 0 ? wg_ : wu_)) + so_; ld_ = dn_ ? D : DE; K_ = dn_ ? DE : D; \
    k0_ = (dn_ ? (v_ >> 4) : (v_ >> 3)) * 64; n0_ = (dn_ ? (v_ & 15) : (v_ & 7)) * 64; dst_ = dn_ ? wsp<bf16_t>(p, WS_WDN) + (size_t)e_ * D * DE : wsp<bf16_t>(p, WS_WGU) + (size_t)e_ * 1024 * D; } while (0)
__device__ __forceinline__ void cvt_experts(const Params& p, int l, LAS float* tile, int b0) {
  const int bid = mk::obid() - b0, nb = (int)gridDim.x - b0, t = mk::otid();
  if (bid < 0) return;
  size_t z3_ = 0; asm volatile("" : "+s"(z3_));
  const float* wg_ = p.exp_w_gate + z3_; const float* wu_ = p.exp_w_up + z3_; const float* wd_ = p.exp_w_down + z3_;
  constexpr int NJ = NE * 384;
  int u = bid;
  if (u >= NJ) return;
  const float* csrc; bf16_t* cdst; int cld, cK, ck0, cn0, cmode;
  CVT_JOB(u, csrc, cdst, cld, cK, ck0, cn0, cmode);
  const int lk = t >> 3, lc = (t & 7) * 8;
  f32x4 ra, rb; { const float* q = csrc + (size_t)(ck0 + lk) * cld + cn0 + lc; ra = *(const f32x4*)q; rb = *(const f32x4*)(q + 4); }
  for (; u < NJ; u += nb) {
    const int un = u + nb < NJ ? u + nb : u;
    const float* nsrc; bf16_t* ndst; int nld, nK, nk0, nn0, nmode;
    CVT_JOB(un, nsrc, ndst, nld, nK, nk0, nn0, nmode);
    f32x4 na, nbv; { const float* q = nsrc + (size_t)(nk0 + lk) * nld + nn0 + lc; na = *(const f32x4*)q; nbv = *(const f32x4*)(q + 4); }
    { LAS float* q = tile + lk * 65 + lc; q[0] = ra[0]; q[1] = ra[1]; q[2] = ra[2]; q[3] = ra[3]; q[4] = rb[0]; q[5] = rb[1]; q[6] = rb[2]; q[7] = rb[3]; }
    __syncthreads();
    { const int n = t >> 3, kc = (t & 7) * 8; const LAS float* q = tile + kc * 65 + n;
      u32x4 w; w.x = cvt_pk_bf16(q[0], q[65]); w.y = cvt_pk_bf16(q[130], q[195]); w.z = cvt_pk_bf16(q[260], q[325]); w.w = cvt_pk_bf16(q[390], q[455]);
      const int drow = cmode == 2 ? cn0 + n : 2 * (cn0 + n) + cmode;
      *(u32x4*)(cdst + (size_t)drow * cK + ck0 + kc) = w; }
    __syncthreads();
    csrc = nsrc; cdst = ndst; cld = nld; cK = nK; ck0 = nk0; cn0 = nn0; cmode = nmode; ra = na; rb = nbv;
  }
}
#undef CVT_JOB

__device__ __forceinline__ bf16_t* hb_ptr(const Params& p, int row, bool alt) {
  if (alt) return wsp<bf16_t>(p, WS_SCR + SM_END) + (size_t)row * D;
  return row < NLAT ? (bf16_t*)p.out + (size_t)row * D : wsp<bf16_t>(p, WS_HBC) + (size_t)(row - NLAT) * D;
}
__device__ __forceinline__ const float* h0_ptr(const Params& p, int row) { return row < NLAT ? p.x + (size_t)row * D : p.ctx + (size_t)(row - NLAT) * D; }
__device__ __forceinline__ void store_bf16x4(bf16_t* dst, f32x4 v) { u32x2 w; w.x = cvt_pk_bf16(v[0], v[1]); w.y = cvt_pk_bf16(v[2], v[3]); *(u32x2*)dst = w; }
__device__ __forceinline__ f32x4 load_bf16x4(const bf16_t* src) { const u32x2 w = *(const u32x2*)src; return (f32x4){bflo(w.x), bfhi(w.x), bflo(w.y), bfhi(w.y)}; }

__device__ __forceinline__ void phase_mod0(const Params& p) {
  const int lane = mk::otid() & 63, wid = mk::otid() >> 6;
  bf16_t* U = wsp<bf16_t>(p, WS_UO);
  for (int row = mk::obid() * 8 + wid; row < NTOK; row += gridDim.x * 8) {
    const float* h = h0_ptr(p, row); const float* modl = wsp<float>(p, WS_MOD) + (size_t)bidx_of_row(row) * 6144;
#pragma unroll
    for (int q = 0; q < 4; ++q) { const int col = q * 256 + lane * 4; const f32x4 hv = *(const f32x4*)(h + col), sh = *(const f32x4*)(modl + col), sc = *(const f32x4*)(modl + 1024 + col);
      store_bf16x4(U + (size_t)row * D + col, hv * (1.0f + sc) + sh); }
  }
}
__device__ __forceinline__ void ln_row(f32x4 (&v)[4], const float* __restrict__ g, const float* __restrict__ b, int lane) {
  float s = 0.f;
#pragma unroll
  for (int q = 0; q < 4; ++q) s += (v[q][0] + v[q][1]) + (v[q][2] + v[q][3]);
  const float mu = wave_sum_u(s) * (1.0f / D);
  float qq = 0.f;
#pragma unroll
  for (int q = 0; q < 4; ++q) { const f32x4 d = v[q] - mu; qq += (d[0] * d[0] + d[1] * d[1]) + (d[2] * d[2] + d[3] * d[3]); }
  const float rstd = rsqrtf(wave_sum_u(qq) * (1.0f / D) + LN_EPS);
#pragma unroll
  for (int q = 0; q < 4; ++q) { const int col = q * 256 + lane * 4; v[q] = (v[q] - mu) * rstd * *(const f32x4*)(g + col) + *(const f32x4*)(b + col); }
}
struct LnVec { f32x4 lg[4], lb[4], m0[4], m1[4], m2[4]; int bi; };
__device__ __forceinline__ void ln_row_c(f32x4 (&v)[4], const LnVec& c) {
  float s = 0.f;
#pragma unroll
  for (int q = 0; q < 4; ++q) s += (v[q][0] + v[q][1]) + (v[q][2] + v[q][3]);
  const float mu = wave_sum_u(s) * (1.0f / D);
  float qq = 0.f;
#pragma unroll
  for (int q = 0; q < 4; ++q) { const f32x4 d = v[q] - mu; qq += (d[0] * d[0] + d[1] * d[1]) + (d[2] * d[2] + d[3] * d[3]); }
  const float rstd = rsqrtf(wave_sum_u(qq) * (1.0f / D) + LN_EPS);
#pragma unroll
  for (int q = 0; q < 4; ++q) v[q] = (v[q] - mu) * rstd * c.lg[q] + c.lb[q];
}
template <bool F32IN> struct Ln1Raw;
template <> struct Ln1Raw<true> { f32x4 h[4]; u32x2 y[4]; };
template <> struct Ln1Raw<false> { u32x2 h[4]; u32x2 y[4]; };
__device__ __forceinline__ f32x4 h_as_f32(f32x4 v) { return v; }
__device__ __forceinline__ f32x4 h_as_f32(u32x2 w) { return (f32x4){bflo(w.x), bfhi(w.x), bflo(w.y), bfhi(w.y)}; }
template <bool F32IN>
__device__ __forceinline__ void ln1_load(const Params& p, const bf16_t* __restrict__ Ybuf, int row, int lane, Ln1Raw<F32IN>& r) {
#pragma unroll
  for (int q = 0; q < 4; ++q) { const int col = q * 256 + lane * 4;
    if constexpr (F32IN) r.h[q] = *(const f32x4*)(h0_ptr(p, row) + col); else r.h[q] = *(const u32x2*)(hb_ptr(p, row, false) + col);
    r.y[q] = *(const u32x2*)(Ybuf + (size_t)row * D + col); }
}
template <bool F32IN>
__device__ __forceinline__ void ln1_norm(const Ln1Raw<F32IN>& raw, const LnVec& cv, f32x4 (&v)[4]) {
#pragma unroll
  for (int q = 0; q < 4; ++q) { const f32x4 yv = (f32x4){bflo(raw.y[q].x), bfhi(raw.y[q].x), bflo(raw.y[q].y), bfhi(raw.y[q].y)};
    v[q] = ALPHA * h_as_f32(raw.h[q]) + cv.m0[q] * yv; }
  ln_row_c(v, cv);
}
__device__ __forceinline__ void ln1_route(const Params& p, int row, int lane, const float (&acc)[16], LAS int* lcnt, float rbias);
template <bool F32IN>
__device__ __forceinline__ void ln1_row(const Params& p, int l, int row, int lane, const Ln1Raw<F32IN>& raw, const LAS float* rwl, LAS int* lcnt, float rbias  , bool redir, const LnVec& cv  ) {
  bf16_t* U2 = wsp<bf16_t>(p, WS_UO);
  bf16_t* ho = redir ? wsp<bf16_t>(p, WS_SCR + SM_YS) + (size_t)row * D : hb_ptr(p, row, l == DEPTH - 1);
  f32x4 v[4];
  ln1_norm<F32IN>(raw, cv, v);
  float acc[16];
#pragma unroll
  for (int e = 0; e < 16; ++e) acc[e] = 0.f;
#pragma unroll
  for (int q = 0; q < 4; ++q) { const int col = q * 256 + lane * 4;
    store_bf16x4(ho + col, v[q]);
    const f32x4 u = v[q] * (1.0f + cv.m2[q]) + cv.m1[q];
    store_bf16x4(U2 + (size_t)row * D + col, u);
#pragma unroll
    for (int e = 0; e < 16; ++e) { const f32x4 w = *(const LAS f32x4*)(rwl + ((q * 16 + e) * 64 + lane) * 4); acc[e] = fmaf(u[3], w[3], fmaf(u[2], w[2], fmaf(u[1], w[1], fmaf(u[0], w[0], acc[e])))); }
  }
  ln1_route(p, row, lane, acc, lcnt, rbias);
}
__device__ __forceinline__ void ln1_row2(const Params& p, int l, int row, int lane, const Ln1Raw<false>& ra, const Ln1Raw<false>& rb, const LAS float* rwl, const LAS float* mv, const LAS float* lgb,
                                         LAS int* lcnt, float rbias, bool redir) {
  bf16_t* U2 = wsp<bf16_t>(p, WS_UO) + (size_t)row * D;
  bf16_t* ho = redir ? wsp<bf16_t>(p, WS_SCR + SM_YS) + (size_t)row * D : hb_ptr(p, row, l == DEPTH - 1);
  f32x4 va[4], vb[4]; float sa = 0.f, sb = 0.f;
#pragma unroll
  for (int q = 0; q < 4; ++q) { const f32x4 m0 = *(const LAS f32x4*)(mv + q * 256 + lane * 4);
    const f32x4 ya = (f32x4){bflo(ra.y[q].x), bfhi(ra.y[q].x), bflo(ra.y[q].y), bfhi(ra.y[q].y)}, yb = (f32x4){bflo(rb.y[q].x), bfhi(rb.y[q].x), bflo(rb.y[q].y), bfhi(rb.y[q].y)};
    va[q] = ALPHA * h_as_f32(ra.h[q]) + m0 * ya; vb[q] = ALPHA * h_as_f32(rb.h[q]) + m0 * yb;
    sa += (va[q][0] + va[q][1]) + (va[q][2] + va[q][3]); sb += (vb[q][0] + vb[q][1]) + (vb[q][2] + vb[q][3]); }
  const float mua = wave_sum_u(sa) * (1.0f / D), mub = wave_sum_u(sb) * (1.0f / D);
  float qa = 0.f, qb = 0.f;
#pragma unroll
  for (int q = 0; q < 4; ++q) { const f32x4 da = va[q] - mua, db = vb[q] - mub; qa += (da[0] * da[0] + da[1] * da[1]) + (da[2] * da[2] + da[3] * da[3]); qb += (db[0] * db[0] + db[1] * db[1]) + (db[2] * db[2] + db[3] * db[3]); }
  const float rsa = rsqrtf(wave_sum_u(qa) * (1.0f / D) + LN_EPS), rsb = rsqrtf(wave_sum_u(qb) * (1.0f / D) + LN_EPS);
  float aA[16], aB[16];
#pragma unroll
  for (int e = 0; e < 16; ++e) { aA[e] = 0.f; aB[e] = 0.f; }
#pragma unroll
  for (int q = 0; q < 4; ++q) { const int col = q * 256 + lane * 4;
    const f32x4 lg = *(const LAS f32x4*)(lgb + col), lb = *(const LAS f32x4*)(lgb + 1024 + col), m1 = *(const LAS f32x4*)(mv + 1024 + col), m2 = *(const LAS f32x4*)(mv + 2048 + col);
    const f32x4 na = (va[q] - mua) * rsa * lg + lb, nb = (vb[q] - mub) * rsb * lg + lb;
    store_bf16x4(ho + col, na); store_bf16x4(ho + D + col, nb);
    const f32x4 uA = na * (1.0f + m2) + m1, uB = nb * (1.0f + m2) + m1;
    store_bf16x4(U2 + col, uA); store_bf16x4(U2 + D + col, uB);
#pragma unroll
    for (int e4 = 0; e4 < 16; e4 += 4) { f32x4 w[4];
#pragma unroll
      for (int j = 0; j < 4; ++j) w[j] = *(const LAS f32x4*)(rwl + ((q * 16 + e4 + j) * 64 + lane) * 4);
#pragma unroll
      for (int j = 0; j < 4; ++j) { const int e = e4 + j;
        aA[e] = fmaf(uA[3], w[j][3], fmaf(uA[2], w[j][2], fmaf(uA[1], w[j][1], fmaf(uA[0], w[j][0], aA[e]))));
        aB[e] = fmaf(uB[3], w[j][3], fmaf(uB[2], w[j][2], fmaf(uB[1], w[j][1], fmaf(uB[0], w[j][0], aB[e])))); }
      __builtin_amdgcn_sched_barrier(0); }
  }
#pragma unroll
  for (int e = 0; e < 16; ++e) asm volatile("" : "+v"(aB[e]));
  ln1_route(p, row, lane, aA, lcnt, rbias); ln1_route(p, row + 1, lane, aB, lcnt, rbias);
}
__device__ __forceinline__ void ln1_route(const Params& p, int row, int lane, const float (&acc)[16], LAS int* lcnt, float rbias) {
  int* eid = wsp<int>(p, WS_EID); float* gatev = wsp<float>(p, WS_GATE);
  float t8[8], t4[4], t2[2];
#pragma unroll
  for (int i = 0; i < 8; ++i) { const u32x2 sw = __builtin_amdgcn_permlane32_swap(__float_as_uint(acc[i]), __float_as_uint(acc[8 + i]), false, false); t8[i] = __uint_as_float(sw.x) + __uint_as_float(sw.y); }
#pragma unroll
  for (int i = 0; i < 4; ++i) { const u32x2 sw = __builtin_amdgcn_permlane16_swap(__float_as_uint(t8[i]), __float_as_uint(t8[4 + i]), false, false); t4[i] = __uint_as_float(sw.x) + __uint_as_float(sw.y); }
  const bool b3 = (lane & 8) != 0, b2_ = (lane & 4) != 0;
#pragma unroll
  for (int i = 0; i < 2; ++i) { const float keep = b3 ? t4[2 + i] : t4[i], send = b3 ? t4[i] : t4[2 + i]; t2[i] = keep + dpp_mov<0x128, 0xf, 0xf>(send, send); }
  float logit;
  { const float keep = b2_ ? t2[1] : t2[0], send = b2_ ? t2[0] : t2[1];
    float recv = dpp_mov<0x104, 0xf, 0x5>(send, send);
    recv = dpp_mov<0x114, 0xf, 0xa>(recv, send);
    logit = keep + recv; }
  logit += dpp_mov<0xB1, 0xf, 0xf>(logit, logit); logit += dpp_mov<0x4E, 0xf, 0xf>(logit, logit);
  const float sg = 1.0f / (1.0f + expf(-logit)), sl = sg + rbias;
  float gs;
  { const float a = sl, b2 = dpp_mov<0x124, 0xf, 0xf>(sl, sl), c = dpp_mov<0x128, 0xf, 0xf>(sl, sl), d = dpp_mov<0x12C, 0xf, 0xf>(sl, sl);
    const float lo1 = fminf(a, b2), hi1 = fmaxf(a, b2), lo2 = fminf(c, d), hi2 = fmaxf(c, d);
    gs = fmaxf(hi1, hi2) + fmaxf(fminf(hi1, hi2), fmaxf(lo1, lo2)); }
  float best = -1e30f; int grp = 0;
#pragma unroll
  for (int gI = 0; gI < 4; ++gI) { const float g = __uint_as_float(__builtin_amdgcn_readlane(__float_as_uint(gs), gI * 16)); if (g > best) { best = g; grp = gI; } }
  grp = __builtin_amdgcn_readfirstlane(grp);
  const float v0 = __uint_as_float(__builtin_amdgcn_readlane(__float_as_uint(sl), grp * 16)), v1 = __uint_as_float(__builtin_amdgcn_readlane(__float_as_uint(sl), grp * 16 + 4)),
              v2 = __uint_as_float(__builtin_amdgcn_readlane(__float_as_uint(sl), grp * 16 + 8)), v3 = __uint_as_float(__builtin_amdgcn_readlane(__float_as_uint(sl), grp * 16 + 12));
  const float s0 = __uint_as_float(__builtin_amdgcn_readlane(__float_as_uint(sg), grp * 16)), s1 = __uint_as_float(__builtin_amdgcn_readlane(__float_as_uint(sg), grp * 16 + 4)),
              s2 = __uint_as_float(__builtin_amdgcn_readlane(__float_as_uint(sg), grp * 16 + 8)), s3 = __uint_as_float(__builtin_amdgcn_readlane(__float_as_uint(sg), grp * 16 + 12));
  int i1 = 0; float b1 = v0; if (v1 > b1) { b1 = v1; i1 = 1; } if (v2 > b1) { b1 = v2; i1 = 2; } if (v3 > b1) { b1 = v3; i1 = 3; }
  int i2 = -1; float bb = -1e30f;
  if (i1 != 0 && v0 > bb) { bb = v0; i2 = 0; } if (i1 != 1 && v1 > bb) { bb = v1; i2 = 1; } if (i1 != 2 && v2 > bb) { bb = v2; i2 = 2; } if (i1 != 3 && v3 > bb) { bb = v3; i2 = 3; }
  const float g1 = i1 == 0 ? s0 : i1 == 1 ? s1 : i1 == 2 ? s2 : s3; const float g2 = i2 == 0 ? s0 : i2 == 1 ? s1 : i2 == 2 ? s2 : s3;
  if (lane == 0) { const int e1 = grp * 4 + i1, e2 = grp * 4 + i2;
    eid[row * 2] = e1; eid[row * 2 + 1] = e2; gatev[row * 2] = g1 / (g1 + g2); gatev[row * 2 + 1] = g2 / (g1 + g2);
    __hip_atomic_fetch_add(lcnt + e1, 1, __ATOMIC_RELAXED, __HIP_MEMORY_SCOPE_WORKGROUP); __hip_atomic_fetch_add(lcnt + e2, 1, __ATOMIC_RELAXED, __HIP_MEMORY_SCOPE_WORKGROUP); }
}
template <bool F32IN>
__device__ __forceinline__ void phase_ln1(const Params& p, int l, const bf16_t* __restrict__ Ybuf, LAS unsigned char* lds, bool dry) {
  const int tid = mk::otid(), lane = tid & 63, wid = tid >> 6, bid = mk::obid();
  const bool last = l == DEPTH - 1; const int ntok = last ? NLAT : NTOK;
  LAS float* rwl = (LAS float*)lds; LAS int* lcnt = (LAS int*)(lds + 65536);
  { float rv[32];
#pragma unroll
    for (int i = 0; i < 32; ++i) rv[i] = p.router_w[tid + i * NTHR];
#pragma unroll
    for (int i = 0; i < 32; ++i) { const int idx = tid + i * NTHR, d = idx >> 4, e = idx & 15; rwl[(((d >> 8) * 16 + e) * 64 + ((d >> 2) & 63)) * 4 + (d & 3)] = rv[i]; } }
  if (tid < 16) lcnt[tid] = 0;
  LAS float* mvl = (LAS float*)(lds + 66560); LAS float* lgbl = (LAS float*)(lds + 131072 + 1024);
  if constexpr (!F32IN) { float mr[30], gr[4];
#pragma unroll
    for (int i = 0; i < 30; ++i) { const int idx = tid + i * NTHR, bj = idx >> 10, col = idx & 1023; mr[i] = wsp<float>(p, WS_MOD)[((size_t)l * 5 + bj / 3) * 6144 + (2 + bj % 3) * 1024 + col]; }
#pragma unroll
    for (int i = 0; i < 4; ++i) { const int idx = tid + i * NTHR; gr[i] = (idx < 1024 ? p.ln_g + (size_t)(l * 2) * D : p.ln_b + (size_t)(l * 2) * D - 1024)[idx]; }
#pragma unroll
    for (int i = 0; i < 30; ++i) mvl[tid + i * NTHR] = mr[i];
#pragma unroll
    for (int i = 0; i < 4; ++i) lgbl[tid + i * NTHR] = gr[i]; }
  __syncthreads();
  const int stride = gridDim.x * 8, row0 = bid * 8 + wid;
  const float rbias = p.router_b[lane >> 2];
  if (row0 < ntok) {
    LnVec cv; cv.bi = -1;
    { const float* lg = p.ln_g + (size_t)(l * 2) * D; const float* lb = p.ln_b + (size_t)(l * 2) * D;
#pragma unroll
      for (int q = 0; q < 4; ++q) { const int col = q * 256 + lane * 4; cv.lg[q] = *(const f32x4*)(lg + col); cv.lb[q] = *(const f32x4*)(lb + col); } }
    if constexpr (!F32IN) {
      const int rp0 = bid * 8 + 2 * (wid & 3) + (wid >> 2) * stride;
      if (rp0 < ntok) {
        Ln1Raw<false> ca, cb, na, nb2; ln1_load<false>(p, Ybuf, rp0, lane, ca); ln1_load<false>(p, Ybuf, rp0 + 1, lane, cb);
        for (int row = rp0; row < ntok; row += 2 * stride) {
          const int rn = row + 2 * stride < ntok ? row + 2 * stride : row;
          ln1_load<false>(p, Ybuf, rn, lane, na); ln1_load<false>(p, Ybuf, rn + 1, lane, nb2);
          ln1_row2(p, l, row, lane, ca, cb, rwl, mvl + bidx_of_row(row) * 3072, lgbl, lcnt, rbias, dry);
          ca = na; cb = nb2;
        }
      }
    } else {
    Ln1Raw<F32IN> cur, nxt; ln1_load<F32IN>(p, Ybuf, row0, lane, cur);
    for (int row = row0; row < ntok; row += stride) {
      { const int bi = bidx_of_row(row);
        if (bi != cv.bi) { cv.bi = bi; const float* modl = wsp<float>(p, WS_MOD) + ((size_t)l * 5 + bi) * 6144;
#pragma unroll
          for (int q = 0; q < 4; ++q) { const int col = q * 256 + lane * 4; cv.m0[q] = *(const f32x4*)(modl + 2 * 1024 + col); cv.m1[q] = *(const f32x4*)(modl + 3 * 1024 + col); cv.m2[q] = *(const f32x4*)(modl + 4 * 1024 + col); } } }
      const int rn = row + stride < ntok ? row + stride : row;
      ln1_load<F32IN>(p, Ybuf, rn, lane, nxt);
      ln1_row<F32IN>(p, l, row, lane, cur, rwl, lcnt, rbias, dry, cv);
      cur = nxt;
    }
    }
  }
  __syncthreads();
  if (tid < 16) wsp<int>(p, WS_BCNT)[((size_t)l * 256 + bid) * 64 + tid] = lcnt[tid];
  __syncthreads();
}
__device__ __forceinline__ void phase_scatter(const Params& p, int l, LAS unsigned char* lds) {
  const int tid = mk::otid(), bid = mk::obid(), nb = gridDim.x;
  const bool last = l == DEPTH - 1; const int ntok = last ? NLAT : NTOK;
  LAS int* tot = (LAS int*)lds; LAS int* pre = tot + 16; LAS int* base = tot + 32; LAS int* lcur = tot + 48; LAS int* offs = tot + 64; LAS int* cnts = tot + 128;
  const int* bc = wsp<int>(p, WS_BCNT) + (size_t)l * 256 * 64;
  for (int b2 = tid; b2 < nb; b2 += NTHR) { const u32x4 c0 = *(const u32x4*)(bc + b2 * 64), c1 = *(const u32x4*)(bc + b2 * 64 + 4), c2 = *(const u32x4*)(bc + b2 * 64 + 8), c3 = *(const u32x4*)(bc + b2 * 64 + 12);
    *(LAS u32x4*)(cnts + b2 * 16) = c0; *(LAS u32x4*)(cnts + b2 * 16 + 4) = c1; *(LAS u32x4*)(cnts + b2 * 16 + 8) = c2; *(LAS u32x4*)(cnts + b2 * 16 + 12) = c3; }
  __syncthreads();
  if (tid < 16) { int t = 0, pr = 0; for (int b2 = 0; b2 < nb; ++b2) { const int v = cnts[b2 * 16 + tid]; pr += b2 < bid ? v : 0; t += v; } tot[tid] = t; pre[tid] = pr; lcur[tid] = 0; }
  __syncthreads();
  if (tid == 0) { int o = 0; int* mo = wsp<int>(p, WS_MOFF) + l * 64; for (int e = 0; e < 16; ++e) { offs[e] = o; base[e] = o + pre[e]; if (bid == 0) mo[e] = o; o += (tot[e] + 255) / 256 * 256; } offs[16] = o; if (bid == 0) mo[16] = o; }
  __syncthreads();
  const int* eid = wsp<int>(p, WS_EID); int* pos = wsp<int>(p, WS_POS); int* rl = wsp<int>(p, WS_RL);
  for (int n = tid; ; n += NTHR) { const int row = bid * 8 + (n & 7) + (n >> 3) * nb * 8; if (row >= ntok) break;
    const int e1 = eid[row * 2], e2 = eid[row * 2 + 1];
    const int p1 = base[e1] + __hip_atomic_fetch_add(lcur + e1, 1, __ATOMIC_RELAXED, __HIP_MEMORY_SCOPE_WORKGROUP), p2 = base[e2] + __hip_atomic_fetch_add(lcur + e2, 1, __ATOMIC_RELAXED, __HIP_MEMORY_SCOPE_WORKGROUP);
    pos[row * 2] = p1; pos[row * 2 + 1] = p2; rl[p1] = row; rl[p2] = row; }
  if (bid == 0) for (int e = 0; e < 16; ++e) for (int q = offs[e] + tot[e] + tid; q < offs[e + 1]; q += NTHR) rl[q] = 0;
}
struct Ln2Raw { u32x4 h[2], y1[2], y2[2]; };
__device__ __forceinline__ void ln2_load(const Params& p, bool last, int row, int lane, int p1, int p2, Ln2Raw& r) {
  const bf16_t* Ys = wsp<bf16_t>(p, WS_SCR + SM_YS); const bf16_t* ho = hb_ptr(p, row, last);
#pragma unroll
  for (int q = 0; q < 2; ++q) { const int col = q * 512 + lane * 8; r.h[q] = *(const u32x4*)(ho + col); r.y1[q] = *(const u32x4*)(Ys + (size_t)p1 * D + col); r.y2[q] = *(const u32x4*)(Ys + (size_t)p2 * D + col); }
}
__device__ __forceinline__ void unpack8(const u32x4 w, float (&o)[8]) { o[0] = bflo(w.x); o[1] = bfhi(w.x); o[2] = bflo(w.y); o[3] = bfhi(w.y); o[4] = bflo(w.z); o[5] = bfhi(w.z); o[6] = bflo(w.w); o[7] = bfhi(w.w); }
__device__ __forceinline__ void load8f(const float* q, float (&o)[8]) { const f32x4 a = *(const f32x4*)q, b = *(const f32x4*)(q + 4); o[0] = a[0]; o[1] = a[1]; o[2] = a[2]; o[3] = a[3]; o[4] = b[0]; o[5] = b[1]; o[6] = b[2]; o[7] = b[3]; }
__device__ __forceinline__ u32x4 pack8(const float (&v)[8]) { u32x4 w; w.x = cvt_pk_bf16(v[0], v[1]); w.y = cvt_pk_bf16(v[2], v[3]); w.z = cvt_pk_bf16(v[4], v[5]); w.w = cvt_pk_bf16(v[6], v[7]); return w; }
__device__ __forceinline__ void phase_ln2(const Params& p, int l, bool dry) {
  const int tid = mk::otid(), lane = tid & 63, wid = tid >> 6;
  const bool last = l == DEPTH - 1; const int ntok = last ? NLAT : NTOK;
  const int* pos = wsp<int>(p, WS_POS); const float* gatev = wsp<float>(p, WS_GATE); bf16_t* U = wsp<bf16_t>(p, WS_UO);
  const float* lg = p.ln_g + (size_t)(l * 2 + 1) * D; const float* lb = p.ln_b + (size_t)(l * 2 + 1) * D;
  const int stride = gridDim.x * 8, row0 = mk::obid() * 8 + wid;
  if (row0 >= ntok) return;
  auto clampr = [&](int r) { return r < ntok ? r : row0; };
  float cg[2][8], cb[2][8], cg2[2][8], csc[2][8], csh[2][8]; int cbi = -1;
#pragma unroll
  for (int q = 0; q < 2; ++q) { const int col = q * 512 + lane * 8; load8f(lg + col, cg[q]); load8f(lb + col, cb[q]); }
  u32x2 pc = *(const u32x2*)(pos + 2 * row0); f32x2 gc = *(const f32x2*)(gatev + 2 * row0);
  Ln2Raw cur, nxt; ln2_load(p, last, row0, lane, (int)pc.x, (int)pc.y, cur);
  int r1 = clampr(row0 + stride);
  u32x2 pn = *(const u32x2*)(pos + 2 * r1); f32x2 gn = *(const f32x2*)(gatev + 2 * r1);
  for (int row = row0; row < ntok; row += stride) {
    ln2_load(p, last, r1, lane, (int)pn.x, (int)pn.y, nxt);
    const int r2 = clampr(row + 2 * stride);
    const u32x2 pn2 = *(const u32x2*)(pos + 2 * r2); const f32x2 gn2 = *(const f32x2*)(gatev + 2 * r2);
    bf16_t* hb = dry ? wsp<bf16_t>(p, WS_SCR + SM_XS) + (size_t)row * D : hb_ptr(p, row, false); float* hf = (dry ? wsp<float>(p, WS_SCR + SM_XS) : p.out) + (size_t)row * D; const int bi = bidx_of_row(row);
    if (bi != cbi) { cbi = bi; const float* modl = wsp<float>(p, WS_MOD) + ((size_t)l * 5 + bi) * 6144; const float* modn = wsp<float>(p, WS_MOD) + ((size_t)(last ? l : l + 1) * 5 + bi) * 6144;
#pragma unroll
      for (int q = 0; q < 2; ++q) { const int col = q * 512 + lane * 8; load8f(modl + 5 * 1024 + col, cg2[q]); load8f(modn + 1024 + col, csc[q]); load8f(modn + col, csh[q]); } }
    float v[2][8]; float s1 = 0.f;
#pragma unroll
    for (int q = 0; q < 2; ++q) { float hh[8], a1[8], a2[8];
      unpack8(cur.h[q], hh); unpack8(cur.y1[q], a1); unpack8(cur.y2[q], a2);
#pragma unroll
      for (int e = 0; e < 8; ++e) { v[q][e] = ALPHA * hh[e] + cg2[q][e] * (gc[0] * a1[e] + gc[1] * a2[e]); s1 += v[q][e]; } }
    const float mu = wave_sum_u(s1) * (1.0f / D);
    float s2 = 0.f;
#pragma unroll
    for (int q = 0; q < 2; ++q)
#pragma unroll
      for (int e = 0; e < 8; ++e) { const float d = v[q][e] - mu; s2 += d * d; }
    const float rstd = rsqrtf(wave_sum_u(s2) * (1.0f / D) + LN_EPS);
#pragma unroll
    for (int q = 0; q < 2; ++q) { const int col = q * 512 + lane * 8;
#pragma unroll
      for (int e = 0; e < 8; ++e) v[q][e] = (v[q][e] - mu) * rstd * cg[q][e] + cb[q][e];
      if (last) { *(f32x4*)(hf + col) = (f32x4){v[q][0], v[q][1], v[q][2], v[q][3]}; *(f32x4*)(hf + col + 4) = (f32x4){v[q][4], v[q][5], v[q][6], v[q][7]}; }
      else { *(u32x4*)(hb + col) = pack8(v[q]); float u[8];
#pragma unroll
        for (int e = 0; e < 8; ++e) u[e] = v[q][e] * (1.0f + csc[q][e]) + csh[q][e];
        *(u32x4*)(U + (size_t)row * D + col) = pack8(u); } }
    cur = nxt; gc = gn; pn = pn2; gn = gn2; r1 = r2;
  }
}

struct SchedEvenIn { static constexpr bool GATHER = false; const bf16_t* U; const bf16_t* W; bf16_t* Pqk; bf16_t* Prw; bf16_t* Vt; int G, c;
  __device__ __forceinline__ bool next(int i, pg8::Unit& u) const { const int Lx = i * G + c; u.kind = 0;
    if (Lx < 1452) { const int grp = Lx / 44, rem = Lx % 44, pm = grp * 4 + (rem & 3), pi = rem >> 2; u.pm = pm; u.pn = pi;
      u.A = (const char*)(U + (size_t)pm * 256 * D); const int brow = pi < 4 ? pi * 256 : 1536 + (pi - 4) * 256; u.Bt = (const char*)(W + (size_t)brow * D);
      if (pi < 4) { u.out = Pqk; u.ldo = 1024; u.x1 = pi * 256; } else { u.out = Prw; u.ldo = RW_IN; u.x1 = (pi - 4) * 256; } u.x0 = pm * 256; return true; }
    if (Lx < 1452 + 264) { const int v = Lx - 1452, pmv = v & 1, pnv = v >> 1; u.pm = pmv; u.pn = pnv; u.A = (const char*)(W + (size_t)(1024 + pmv * 256) * D); u.Bt = (const char*)(U + (size_t)pnv * 256 * D);
      u.out = Vt; u.ldo = NTOK; u.x0 = pmv * 256; u.x1 = pnv * 256; return true; }
    return false; } };
struct SchedOddIn { static constexpr bool GATHER = false; const bf16_t* U; const bf16_t* W; bf16_t* Pqk; bf16_t* Vt; int G, c;
  __device__ __forceinline__ bool next(int i, pg8::Unit& u) const { const int Lx = i * G + c;
    if (Lx < 1056) { const int grp = Lx / 32, rem = Lx % 32, pm = grp * 4 + (rem & 3), pi = rem >> 2; u.pm = pm; u.pn = pi; u.kind = pm < 128 ? 1 : 0;
      u.A = (const char*)(U + (size_t)pm * 256 * D); u.Bt = (const char*)(W + (size_t)pi * 256 * D); u.out = Pqk; u.ldo = 2048; u.x0 = pm * 256; u.x1 = pi * 256; return true; }
    if (Lx < 1056 + 528) { const int v = Lx - 1056, pmv = v & 3, pnv = v >> 2; u.pm = pmv; u.pn = pnv; u.kind = 0; u.A = (const char*)(W + (size_t)(2048 + pmv * 256) * D); u.Bt = (const char*)(U + (size_t)pnv * 256 * D);
      u.out = Vt; u.ldo = NTOK; u.x0 = pmv * 256; u.x1 = pnv * 256; return true; }
    return false; } };
struct SchedOut { static constexpr bool GATHER = false; const bf16_t* O; const bf16_t* W; bf16_t* Y; int G, c;
  __device__ __forceinline__ bool next(int i, pg8::Unit& u) const { const int Lx = i * G + c; if (Lx >= 528) return false; const int pm = (Lx / 16) * 4 + (Lx & 3), pn = (Lx & 15) >> 2; u.pm = pm; u.pn = pn; u.kind = 0;
    u.A = (const char*)(O + (size_t)pm * 256 * D); u.Bt = (const char*)(W + (size_t)pn * 256 * D); u.out = Y; u.ldo = 1024; u.x0 = pm * 256; u.x1 = pn * 256; return true; } };
template <bool GATH>
struct SchedMoe { static constexpr bool GATHER = GATH; const bf16_t* A; const bf16_t* W; bf16_t* out; const LAS int* moff; const int* rl; int Kd, ldo, ncol, G, c;
  __device__ __forceinline__ bool next(int i, pg8::Unit& u) const { const int Lx = i * G + c; const int ntile = moff[16] >> 8; if (Lx >= ntile * 4) return false;
    const int pm = Lx >> 2, pn = Lx & 3; int e = 0;
#pragma unroll
    for (int j = 1; j < 16; ++j) e += (pm * 256 >= moff[j]) ? 1 : 0;
    u.pm = pm; u.pn = pn; u.kind = 0; u.A = GATH ? (const char*)A : (const char*)(A + (size_t)pm * 256 * Kd); u.rl = rl + pm * 256; u.Bt = (const char*)(W + ((size_t)e * 1024 + pn * 256) * Kd); u.out = out; u.ldo = ldo; u.x0 = pm * 256; u.x1 = pn * ncol; return true; } };

struct EpiOddIn {
  static constexpr bool PERM = true; const float* rope;
  __device__ __forceinline__ void operator()(const f32x4 (&acc)[2][2][4][2], const pg8::Unit& u, int wr, int wc, int fr, int fq) const {
    if (u.kind == 0) { pg8::EpiStoreBf16{}(acc, u, wr, wc, fr, fq); return; }
    const int row0 = u.x0 + wr * 64 + fr, col0 = u.x1 + wc * 32 + 8 * fq; const int half = wc & 1;
#pragma unroll
    for (int ai = 0; ai < 2; ++ai)
#pragma unroll
      for (int m = 0; m < 4; ++m) { const int row = row0 + ai * 128 + m * 16; const int t = row & (T - 1); const int pos = half ? (t & 63) : (t >> 6);
        const f32x4 cs0 = *(const f32x4*)(rope + (pos * 16 + 4 * fq) * 2), cs1 = *(const f32x4*)(rope + (pos * 16 + 4 * fq + 2) * 2);
        bf16_t* rowp = u.out + (size_t)row * u.ldo + col0;
#pragma unroll
        for (int bj = 0; bj < 2; ++bj) { const f32x4 v0 = acc[ai][bj][m][0], v1 = acc[ai][bj][m][1];
          u32x4 w; w.x = cvt_pk_bf16(v0[0] * cs0[0] - v0[1] * cs0[1], v0[0] * cs0[1] + v0[1] * cs0[0]); w.y = cvt_pk_bf16(v0[2] * cs0[2] - v0[3] * cs0[3], v0[2] * cs0[3] + v0[3] * cs0[2]);
          w.z = cvt_pk_bf16(v1[0] * cs1[0] - v1[1] * cs1[1], v1[0] * cs1[1] + v1[1] * cs1[0]); w.w = cvt_pk_bf16(v1[2] * cs1[2] - v1[3] * cs1[3], v1[2] * cs1[3] + v1[3] * cs1[2]);
          *(u32x4*)(rowp + bj * 128) = w; } }
  }
};
struct EpiGateUp {
  static constexpr bool PERM = true;
  __device__ __forceinline__ void operator()(const f32x4 (&acc)[2][2][4][2], const pg8::Unit& u, int wr, int wc, int fr, int fq) const {
    const int row0 = u.x0 + wr * 64 + fr, col0 = u.x1 + wc * 16 + 4 * fq;
#pragma unroll
    for (int ai = 0; ai < 2; ++ai)
#pragma unroll
      for (int m = 0; m < 4; ++m) { bf16_t* rowp = u.out + (size_t)(row0 + ai * 128 + m * 16) * u.ldo + col0;
#pragma unroll
        for (int bj = 0; bj < 2; ++bj) { const f32x4 v0 = acc[ai][bj][m][0], v1 = acc[ai][bj][m][1];
          u32x2 w; w.x = cvt_pk_bf16(silu_r(v0[0]) * v0[1], silu_r(v0[2]) * v0[3]); w.y = cvt_pk_bf16(silu_r(v1[0]) * v1[1], silu_r(v1[2]) * v1[3]);
          *(u32x2*)(rowp + bj * 64) = w; } }
  }
};
}

namespace mk {
constexpr int N_PHASES = 2 + 2 * (12 + 10);
__global__ void __launch_bounds__(NTHR, 2) mega(Params p_) {
  const Params& p = p_;
  extern __shared__ __attribute__((aligned(16))) unsigned char shm[];
  LAS unsigned char* lds = (LAS unsigned char*)shm;
  const int nb = gridDim.x;
  if (threadIdx.x == 0) *(LAS u32x4*)(lds + LDS_BARW) = (u32x4){0u, 0u, 0u, 0u};
  __syncthreads();
  XcdBarrier bar = xcd_barrier_post(wsp<unsigned>(p, WS_BAR), (volatile LAS unsigned*)(lds + LDS_BARW));
  int ph = 0;
#ifndef MK_MASK
#define MK_MASK 0xFFFFFFFFu
#endif
#ifndef MK_REP
#define MK_REP 0u
#endif
#define PHASE_BEGIN_K(k) if (((MK_MASK) >> (k)) & 1u) { Params pl_ = p_; { size_t z_ = 0; asm volatile("" : "+s"(z_)); pl_.ws = p_.ws + z_; }   const Params& p = pl_; bf16_t* UO = wsp<bf16_t>(p, WS_UO); unsigned char* scr = p.ws + WS_SCR; (void)UO; (void)scr; \
    const int bid = mk::obid(); const int nrep_ = ((((MK_REP) >> (k)) & 1u) ? 2 : 1); for (int rep_ = 0; rep_ < nrep_; ++rep_) { const bool dry = rep_ + 1 < nrep_; (void)dry;
#define PHASE_END   } if (ph + 1 < N_PHASES) { XcdBarrier b_ = bar; { size_t z_ = 0; asm volatile("" : "+s"(z_), "+s"(b_.x)); b_.bar = bar.bar + z_; } xcd_barrier(b_); } } ++ph;
  bf16_t* UO = wsp<bf16_t>(p, WS_UO);
  unsigned char* scr = p.ws + WS_SCR;
  PHASE_BEGIN_K(0) phase_prologue(p, lds); PHASE_END
  PHASE_BEGIN_K(1) phase_mod0(p); PHASE_END
  for (int lp = 0; lp < 2; ++lp) {
    {
      const int l = 2 * lp;
      bf16_t* Pqk = (bf16_t*)(scr + SE_PQK); bf16_t* Vt = (bf16_t*)(scr + SE_VT); bf16_t* Prw = (bf16_t*)(scr + SE_PRW); bf16_t* Ybuf = (bf16_t*)(scr + SE_YBUF);
      rw::Bufs bf; bf.SH = (u32x2*)(scr + SE_SH); bf.DR = (unsigned*)(scr + SE_DR); bf.G = UO + 512; bf.gstride = 1024; bf.CS = (float*)(scr + SE_CS) + (size_t)lp * NTOK * 16; bf.PQ = (float*)(scr + SE_PQ); bf.SST = (float*)(scr + SE_SST); bf.Y = (bf16_t*)(scr + SE_Y); bf.Z = (bf16_t*)(scr + SE_Z);
      PHASE_BEGIN_K(2) { SchedEvenIn S{UO, wsp<bf16_t>(p, WS_WEIN) + (size_t)lp * EVEN_IN * D, Pqk, Prw, Vt, nb, bid}; pg8::gemm_phase(lds, D, S, pg8::EpiStoreBf16{}); } PHASE_END
      PHASE_BEGIN_K(3) {
#ifdef MK_P3
        if (!(dry && MK_P3 == 2))
#endif
        for (int u = bid; u < 1024 + 32; u += nb) { int b, h, rq; if (u < 1024) { b = u >> 8; h = (u >> 5) & 7; rq = u & 31; } else { const int v = u - 1024; b = v >> 3; h = v & 7; rq = -1; }
          natt::na_attn_unit(Pqk, Vt, p.na_rpb + ((size_t)lp * 8 + h) * 465, UO, b, h, rq, lds); }
        const int pb = (bid + nb / 2) % nb;
#ifdef MK_P3
        if (!(dry && MK_P3 == 1))
#endif
        for (int t = pb; t < NTOK / 16; t += nb) rw::prep_tile(Prw, p.shift_w + (size_t)lp * 3 * RW_IN, p.rw_w0 + lp * 1024, wsp<bf16_t>(p, WS_WLT) + (size_t)lp * 196608, p.rw_a0 + lp * 1024, p.rw_k_k + lp * 512, p.rw_k_a + lp * 512, p.rw_r_k + lp * 512, bf, t, (LAS float*)lds); } PHASE_END
      PHASE_BEGIN_K(4) for (int u = bid * 8 + (mk::otid() >> 6); u < rw::NCHAIN * rw::NCH; u += nb * 8) rw::scan_unit(bf, p.rw_k_a + lp * 512, u / rw::NCH, u % rw::NCH, (LAS float*)lds + (mk::otid() >> 6) * 4096); PHASE_END
      PHASE_BEGIN_K(5) for (int c = bid; c < rw::NCHAIN * 4; c += nb) rw::propagate_chain(bf, c >> 2, c & 3, (LAS float*)lds); PHASE_END
      PHASE_BEGIN_K(6) for (int u = bid * 8 + (mk::otid() >> 6); u < rw::NCHAIN * (rw::NCH - 1); u += nb * 8) rw::corr_unit(bf, u / (rw::NCH - 1), 1 + u % (rw::NCH - 1)); PHASE_END
      PHASE_BEGIN_K(7) rw::finish_phase<8>(bf, p.rw_gn_g + lp * 512, p.rw_gn_b + lp * 512, UO); PHASE_END
      PHASE_BEGIN_K(8) { SchedOut S{UO, wsp<bf16_t>(p, WS_WEOUT) + (size_t)lp * D * D, Ybuf, nb, bid}; pg8::gemm_phase(lds, D, S, pg8::EpiStoreBf16{}); __syncthreads(); cvt_experts(p, l, (LAS float*)lds, 528 - 2 * nb > 0 ? 528 - 2 * nb : 0); } PHASE_END
      PHASE_BEGIN_K(9) if (l == 0) phase_ln1<true>(p, l, Ybuf, lds, dry); else phase_ln1<false>(p, l, Ybuf, lds, dry); PHASE_END
      PHASE_BEGIN_K(10) phase_scatter(p, l, lds); PHASE_END
      PHASE_BEGIN_K(11) { LAS int* mo = (LAS int*)(lds + LDS_MISC); { const int tq = mk::otid(); if (tq < 17) mo[tq] = wsp<int>(p, WS_MOFF)[l * 64 + tq]; } __syncthreads();
        SchedMoe<true> S{UO, wsp<bf16_t>(p, WS_WGU), (bf16_t*)(scr + SM_HE), mo, wsp<int>(p, WS_RL), D, DE, 128, nb, bid}; pg8::gemm_phase(lds, D, S, EpiGateUp{}); } PHASE_END
      PHASE_BEGIN_K(12) { LAS int* mo = (LAS int*)(lds + LDS_MISC); { const int tq = mk::otid(); if (tq < 17) mo[tq] = wsp<int>(p, WS_MOFF)[l * 64 + tq]; } __syncthreads();
        SchedMoe<false> S{(bf16_t*)(scr + SM_HE), wsp<bf16_t>(p, WS_WDN), (bf16_t*)(scr + SM_YS), mo, nullptr, DE, D, 256, nb, bid}; pg8::gemm_phase(lds, DE, S, pg8::EpiStoreBf16{}); } PHASE_END
      PHASE_BEGIN_K(13) phase_ln2(p, l, dry); PHASE_END
    }
    {
      const int l = 2 * lp + 1; const bool last = l == DEPTH - 1;
      bf16_t* Pqk = (bf16_t*)(scr + SO_PQK); bf16_t* Vt = (bf16_t*)(scr + SO_VT); bf16_t* O12 = (bf16_t*)(scr + SO_O12); bf16_t* Ybuf = (bf16_t*)(scr + SO_YBUF);
      PHASE_BEGIN_K(14) { SchedOddIn S{UO, wsp<bf16_t>(p, WS_WOIN) + (size_t)lp * ODD_IN * D, Pqk, Vt, nb, bid}; pg8::gemm_phase(lds, D, S, EpiOddIn{wsp<float>(p, WS_ROPE)}); } PHASE_END
      float* KN = wsp<float>(p, WS_KN) + (size_t)lp * 256 * 32;
      PHASE_BEGIN_K(23) for (int g = bid; g < 256; g += nb) att::knorm_group(Pqk, KN, g, (LAS float*)lds); PHASE_END
      PHASE_BEGIN_K(15) for (int ui = bid; ui < 2048 + (last ? 0 : 64); ui += nb) { int b, hh, q0, nlat; const int u = (nb == 256 && ui < 2048) ? ((((ui >> 8) * 8 + (bid & 7)) << 5) | (bid >> 3)) : ui;
        if (u < 2048) { b = u >> 9; hh = (u >> 5) & 15; q0 = b * T + (u & 31) * 256; nlat = T; } else { const int v = u - 2048; b = v >> 4; hh = v & 15; q0 = NLAT + b * L; nlat = 0; }
        const bool st = __builtin_amdgcn_sqrtf(att::nmax2_of(KN, b, hh, 0) * att::nmax2_of(KN, b, hh, 1)) * 1.001f <= 60.0f;
#ifdef MK_ABL
        if (dry) att::diff_attn_unit<true, MK_ABL>(Pqk, Vt, O12, hh, q0, b * T, nlat, NLAT + b * L, lds); else
#endif
        if (st) att::diff_attn_unit<true>(Pqk, Vt, O12, hh, q0, b * T, nlat, NLAT + b * L, lds); else att::diff_attn_unit<false>(Pqk, Vt, O12, hh, q0, b * T, nlat, NLAT + b * L, lds); } PHASE_END
      PHASE_BEGIN_K(16) { float d1 = 0.f, d2 = 0.f; for (int i = 0; i < 64; ++i) { d1 += p.da_lq1[lp * 64 + i] * p.da_lk1[lp * 64 + i]; d2 += p.da_lq2[lp * 64 + i] * p.da_lk2[lp * 64 + i]; }
        const float li = 0.8f - 0.6f * expf(-0.3f * (float)l), lam = expf(d1) - expf(d2) + li;
        const int tq = mk::otid(); for (int r4 = bid; r4 < (last ? NLAT : NTOK) / 4; r4 += nb) att::diff_combine_rows4(O12, p.da_subln_g + lp * 128, lam, 1.0f - li, UO, r4 * 4, tq >> 6, tq & 63); } PHASE_END
      PHASE_BEGIN_K(17) { SchedOut S{UO, wsp<bf16_t>(p, WS_WOOUT) + (size_t)lp * D * D, Ybuf, nb, bid}; pg8::gemm_phase(lds, D, S, pg8::EpiStoreBf16{}); __syncthreads(); cvt_experts(p, l, (LAS float*)lds, 528 - 2 * nb > 0 ? 528 - 2 * nb : 0); } PHASE_END
      PHASE_BEGIN_K(18) phase_ln1<false>(p, l, Ybuf, lds, dry); PHASE_END
      PHASE_BEGIN_K(19) phase_scatter(p, l, lds); PHASE_END
      PHASE_BEGIN_K(20) { LAS int* mo = (LAS int*)(lds + LDS_MISC); { const int tq = mk::otid(); if (tq < 17) mo[tq] = wsp<int>(p, WS_MOFF)[l * 64 + tq]; } __syncthreads();
        SchedMoe<true> S{UO, wsp<bf16_t>(p, WS_WGU), (bf16_t*)(scr + SM_HE), mo, wsp<int>(p, WS_RL), D, DE, 128, nb, bid}; pg8::gemm_phase(lds, D, S, EpiGateUp{}); } PHASE_END
      PHASE_BEGIN_K(21) { LAS int* mo = (LAS int*)(lds + LDS_MISC); { const int tq = mk::otid(); if (tq < 17) mo[tq] = wsp<int>(p, WS_MOFF)[l * 64 + tq]; } __syncthreads();
        SchedMoe<false> S{(bf16_t*)(scr + SM_HE), wsp<bf16_t>(p, WS_WDN), (bf16_t*)(scr + SM_YS), mo, nullptr, DE, D, 256, nb, bid}; pg8::gemm_phase(lds, DE, S, pg8::EpiStoreBf16{}); } PHASE_END
      PHASE_BEGIN_K(22) phase_ln2(p, l, dry); PHASE_END
    }
  }
#undef PHASE_BEGIN_K
#undef PHASE_END
}
}

#ifndef MK_SINGLE_LAUNCH
#define MK_SINGLE_LAUNCH 1
#endif
extern "C" void kernel_launch(void* const* d_in, const int* in_sizes, int n_in, void* d_out, int out_size, void* d_ws, size_t ws_size, hipStream_t stream) {
  using namespace mk;
  static int grid = 0;
  if (grid == 0) {
    if (n_in != 34 || out_size != NLAT * D || ws_size < WS_END) { fprintf(stderr, "kernel_launch: unexpected shapes (n_in %d out %d ws %zu need %zu)\n", n_in, out_size, ws_size, (size_t)WS_END); grid = -1; return; }
    if (hipFuncSetAttribute((const void*)mega, hipFuncAttributeMaxDynamicSharedMemorySize, LDS_BYTES) != hipSuccess) { grid = -1; return; }
    int dev = 0, cus = 0, per_cu = 0;
    if (hipGetDevice(&dev) != hipSuccess || hipDeviceGetAttribute(&cus, hipDeviceAttributeMultiprocessorCount, dev) != hipSuccess) { grid = -1; return; }
    if (hipOccupancyMaxActiveBlocksPerMultiprocessor(&per_cu, (const void*)mega, NTHR, LDS_BYTES) != hipSuccess || per_cu < 1) { fprintf(stderr, "kernel_launch: occupancy query says %d\n", per_cu); }
    (void)hipGetLastError();
    grid = cus;
  }
  if (grid < 0) return;
  (void)hipMemsetAsync((char*)d_ws + WS_BAR, 0, (size_t)XCD_BAR_WORDS * 4, stream);
  Params p{};
  const float** pp = (const float**)&p;
  for (int i = 0; i < 34; ++i) pp[i] = (const float*)d_in[i];
  p.out = (float*)d_out; p.ws = (unsigned char*)d_ws;
#if MK_SINGLE_LAUNCH
  p.ph_lo = 0; p.ph_hi = N_PHASES;
  hipLaunchKernelGGL(mega, dim3(grid), dim3(NTHR), LDS_BYTES, stream, p);
#else
  for (int ph = 0; ph < N_PHASES; ++ph) { p.ph_lo = ph; p.ph_hi = ph + 1; hipLaunchKernelGGL(mega, dim3(grid), dim3(NTHR), LDS_BYTES, stream, p); }
#endif
}
```
